# Optimizing an MI355X kernel written in HIP

```python
import math
import jax
import jax.numpy as jnp
from jax import lax
import numpy as np

D_MODEL = 1024
BATCH = 4
SEQ = 4096
DEPTH = 2

GRID_W = 64
CTX_LEN = 256
EPS = 1e-6

ATT_HEADS = 6
ATT_KV_HEADS = 2
HEAD_DIM = 64
ATT_W = ATT_HEADS * HEAD_DIM
KV_W = ATT_KV_HEADS * HEAD_DIM
ROPE_AXIS_DIM = HEAD_DIM // 2
ROPE_THETA = 10000.0
Q_BLOCK = 128

SSD_HEADS = 6
SSD_HEAD_DIM = 64
SSD_W = SSD_HEADS * SSD_HEAD_DIM
SSD_GROUPS = 2
SSD_STATE = 64
SSD_CONV = 3
SSD_CHUNK = 128
SSD_CONV_CH = SSD_W + 2 * SSD_GROUPS * SSD_STATE

HY_W = 256
HY_ORDER = 2
HY_SHORT = 3
HY_BANDS = 16
HY_POS_DIM = 1 + 2 * HY_BANDS
HY_FILTER_HID = 64
HY_FAST_DECAY = 0.3
HY_SLOW_DECAY = 1.5
HY_TARGET = 1e-2

MIX_W = ATT_W + SSD_W + HY_W
D_IN = ATT_W + 2 * KV_W + SSD_W + SSD_CONV_CH + 2 * SSD_HEADS + (HY_ORDER + 1) * HY_W

N_EXPERTS = 16
N_GROUPS = 4
EXPERTS_PER_GROUP = N_EXPERTS // N_GROUPS
GROUP_SCORE_TOPK = 2
TOP_K = 2
D_FF = 256

kernel_name = 'hybrid_ssd_hyena_gqa_moe_prefix_dit'


def rmsnorm(x, g):
    xf = x.astype(jnp.float32)
    y = xf * lax.rsqrt(jnp.mean(xf * xf, axis=-1, keepdims=True) + EPS)
    return (y * g.astype(jnp.float32)).astype(x.dtype)


def modulate(h, shift, scale):
    return h * (1 + scale[:, None, :]) + shift[:, None, :]


def adaln(cvec, w_mod, b_mod):
    m = jax.nn.silu(cvec) @ w_mod + b_mod
    return jnp.split(m, 6, axis=-1)


def split_proj(u):
    cuts = np.cumsum([ATT_W, KV_W, KV_W, SSD_W, SSD_CONV_CH, 2 * SSD_HEADS])
    return jnp.split(u, [int(i) for i in cuts], axis=-1)


def rev(t):
    return jnp.flip(t, axis=1)


def dwconv_centred(u, w, b):
    k = w.shape[0]
    out = lax.conv_general_dilated(u, w[:, None, :].astype(u.dtype), (1,), [(k // 2, k // 2)],
                                   dimension_numbers=('NWC', 'WIO', 'NWC'),
                                   feature_group_count=u.shape[-1])
    return out + b.astype(u.dtype)


def axial_rope(rows):
    row = jnp.broadcast_to(jnp.arange(rows)[:, None], (rows, GRID_W)).reshape(-1).astype(jnp.float32)
    col = jnp.broadcast_to(jnp.arange(GRID_W)[None, :], (rows, GRID_W)).reshape(-1).astype(jnp.float32)
    inv = ROPE_THETA ** (-jnp.arange(0, ROPE_AXIS_DIM, 2, dtype=jnp.float32) / ROPE_AXIS_DIM)
    ang = jnp.concatenate([row[:, None] * inv, col[:, None] * inv], axis=-1)
    return jnp.cos(ang), jnp.sin(ang)


def apply_rope(x, cos, sin):
    half = HEAD_DIM // 2
    xf = x.astype(jnp.float32)
    x1, x2 = xf[..., :half], xf[..., half:]
    cs, sn = cos[None, :, None, :], sin[None, :, None, :]
    return jnp.concatenate([x1 * cs - x2 * sn, x2 * cs + x1 * sn], axis=-1).astype(x.dtype)


def heads(t, n_heads):
    return t.reshape(t.shape[0], t.shape[1], n_heads, HEAD_DIM)


def gqa_blocks(q, k, v):
    bsz, n = q.shape[:2]
    rep = ATT_HEADS // ATT_KV_HEADS
    qb = q.reshape(bsz, n // Q_BLOCK, Q_BLOCK, ATT_KV_HEADS, rep, HEAD_DIM).swapaxes(0, 1)
    scale = HEAD_DIM ** -0.5

    def one_block(qi):
        s = jnp.einsum('bqgrd,bkgd->bgrqk', qi, k).astype(jnp.float32) * scale
        p = jax.nn.softmax(s, axis=-1).astype(v.dtype)
        return jnp.einsum('bgrqk,bkgd->bqgrd', p, v)

    o = lax.map(one_block, qb)
    return o.swapaxes(0, 1).reshape(bsz, n, ATT_W)


def ssd_chunked(x, dt, a, bmat, cmat, h0):
    bsz, L = x.shape[:2]
    nc = L // SSD_CHUNK
    rep = SSD_HEADS // SSD_GROUPS
    f = jnp.float32
    xc = x.astype(f).reshape(bsz, nc, SSD_CHUNK, SSD_HEADS, SSD_HEAD_DIM)
    dtc = dt.astype(f).reshape(bsz, nc, SSD_CHUNK, SSD_HEADS)
    bc = jnp.repeat(bmat.astype(f), rep, axis=2).reshape(bsz, nc, SSD_CHUNK, SSD_HEADS, SSD_STATE)
    cc = jnp.repeat(cmat.astype(f), rep, axis=2).reshape(bsz, nc, SSD_CHUNK, SSD_HEADS, SSD_STATE)
    acum = jnp.cumsum(dtc * a, axis=2)
    seg = acum[:, :, :, None, :] - acum[:, :, None, :, :]
    earlier = jnp.tril(jnp.ones((SSD_CHUNK, SSD_CHUNK), dtype=bool))[None, None, :, :, None]
    decay = jnp.exp(jnp.where(earlier, seg, -jnp.inf))
    cb = jnp.einsum('bcthn,bcshn->bctsh', cc, bc)
    y_in = jnp.einsum('bctsh,bcsh,bcshp->bcthp', cb * decay, dtc, xc)
    w_end = jnp.exp(acum[:, :, -1:, :] - acum) * dtc
    states = jnp.einsum('bcshn,bcsh,bcshp->bchpn', bc, w_end, xc)
    chunk_decay = jnp.exp(acum[:, :, -1, :])

    def step(hprev, inp):
        st, dec = inp
        return hprev * dec[:, :, None, None] + st, hprev

    h_last, h_enter = lax.scan(step, h0.astype(f),
                               (jnp.moveaxis(states, 1, 0), jnp.moveaxis(chunk_decay, 1, 0)))
    h_enter = jnp.moveaxis(h_enter, 0, 1)
    y_out = jnp.einsum('bcthn,bchpn,bcth->bcthp', cc, h_enter, jnp.exp(acum))
    return (y_in + y_out).reshape(bsz, L, SSD_HEADS, SSD_HEAD_DIM), h_last


def ssd_last_state(x, dt, a, bmat):
    rep = SSD_HEADS // SSD_GROUPS
    f = jnp.float32
    dtf = dt.astype(f)
    acum = jnp.cumsum(dtf * a, axis=1)
    w = jnp.exp(acum[:, -1:, :] - acum) * dtf
    bh = jnp.repeat(bmat.astype(f), rep, axis=2)
    return jnp.einsum('blhn,blh,blhp->bhpn', bh, w, x.astype(f))


def bidir_ssd(xs, dt, a, bm, cm, h0_f, h0_b):
    y_f, h_f = ssd_chunked(xs, dt[:, :, 0], a[0], bm, cm, h0_f)
    y_b, h_b = ssd_chunked(rev(xs), rev(dt[:, :, 1]), a[1], rev(bm), rev(cm), h0_b)
    return y_f + rev(y_b), h_f, h_b


def ssd_prep(xbc, dt_raw, conv_w, conv_b, dt_bias):
    bsz, L = xbc.shape[:2]
    xbc = jax.nn.silu(dwconv_centred(xbc, conv_w, conv_b))
    xs, bm, cm = jnp.split(xbc, [SSD_W, SSD_W + SSD_GROUPS * SSD_STATE], axis=-1)
    dt = jax.nn.softplus(dt_raw.astype(jnp.float32).reshape(bsz, L, 2, SSD_HEADS) + dt_bias.astype(jnp.float32))
    return (xs.reshape(bsz, L, SSD_HEADS, SSD_HEAD_DIM),
            bm.reshape(bsz, L, SSD_GROUPS, SSD_STATE),
            cm.reshape(bsz, L, SSD_GROUPS, SSD_STATE), dt)


def ssd_out(y, xs, z, d_skip, norm_w):
    bsz, L = y.shape[:2]
    y = y + xs.astype(jnp.float32) * d_skip.astype(jnp.float32)[:, None]
    g = y.reshape(bsz, L, SSD_W) * jax.nn.silu(z.astype(jnp.float32))
    g = rmsnorm(g.reshape(bsz, L, SSD_GROUPS, SSD_W // SSD_GROUPS), norm_w.reshape(SSD_GROUPS, -1))
    return g.reshape(bsz, L, SSD_W).astype(z.dtype)


def hyena_filters(L, w1, b1, freq, w2, b2, w3):
    f = jnp.float32
    n = jnp.arange(L, dtype=f)
    t = n / max(L - 1, 1)
    bands = jnp.linspace(1e-4, HY_BANDS - 1, HY_BANDS, dtype=f)
    wpos = (2 * math.pi / L) * n
    feats = jnp.concatenate([t[:, None], jnp.cos(wpos[:, None] * bands), -jnp.sin(wpos[:, None] * bands)], axis=-1)
    fr = freq.astype(f)
    hid = jnp.sin(fr * (feats @ w1.astype(f) + b1.astype(f)))
    hid = jnp.sin(fr * (hid @ w2.astype(f) + b2.astype(f)))
    h = (hid @ w3.astype(f)).reshape(L, 2, HY_ORDER, HY_W)
    deltas = jnp.abs(jnp.linspace(math.log(HY_TARGET) / HY_SLOW_DECAY, math.log(HY_TARGET) / HY_FAST_DECAY, HY_W, dtype=f))
    window = jnp.exp(-t[:, None] * deltas)
    return h * window[:, None, None, :]


def bidir_long_conv(z, hf, hb, bias):
    L = z.shape[1]
    kern = jnp.concatenate([hf, jnp.zeros_like(hf[:1]), hb[:0:-1]], axis=0)
    zf = z.astype(jnp.float32)
    y = jnp.fft.irfft(jnp.fft.rfft(zf, n=2 * L, axis=1) * jnp.fft.rfft(kern, axis=0)[None], n=2 * L, axis=1)[:, :L]
    return y + zf * bias.astype(jnp.float32)


def hyena_mixer(u, conv_w, conv_b, w1, b1, freq, w2, b2, w3, bias):
    u = dwconv_centred(u, conv_w, conv_b)
    v, x1, x2 = jnp.split(u, 3, axis=-1)
    h = hyena_filters(u.shape[1], w1, b1, freq, w2, b2, w3)
    zz = x1.astype(jnp.float32) * bidir_long_conv(v, h[:, 0, 0], h[:, 1, 0], bias[0])
    zz = x2.astype(jnp.float32) * bidir_long_conv(zz, h[:, 0, 1], h[:, 1, 1], bias[1])
    return zz.astype(u.dtype)


def grouped_moe(h, w_router, router_bias, w_gate, w_up, w_down):
    bsz, n, d = h.shape
    t = h.reshape(bsz * n, d)
    scores = jax.nn.sigmoid((t @ w_router).astype(jnp.float32))
    sel = scores + router_bias.astype(jnp.float32)
    grp = lax.top_k(sel.reshape(-1, N_GROUPS, EXPERTS_PER_GROUP), GROUP_SCORE_TOPK)[0].sum(-1)
    best = jnp.argmax(grp, axis=-1)
    in_grp = (jnp.arange(N_EXPERTS) // EXPERTS_PER_GROUP)[None, :] == best[:, None]
    _, idx = lax.top_k(jnp.where(in_grp, sel, -jnp.inf), TOP_K)
    wts = jnp.take_along_axis(scores, idx, axis=-1)
    wts = wts / jnp.sum(wts, axis=-1, keepdims=True)
    combine = jnp.sum(jax.nn.one_hot(idx, N_EXPERTS, dtype=jnp.float32) * wts[..., None], axis=1).astype(t.dtype)
    out = jnp.zeros_like(t)
    for e in range(N_EXPERTS):
        y = (jax.nn.silu(t @ w_gate[e]) * (t @ w_up[e])) @ w_down[e]
        out = out + combine[:, e:e + 1] * y
    return out.reshape(bsz, n, d)


def setup_inputs(seed: int = 0) -> dict:
    key = jax.random.key(seed)
    ks = iter(jax.random.split(key, 48))

    def nrm(shape, s):
        return jax.random.normal(next(ks), shape, jnp.float32) * s

    def gain(shape):
        return 1.0 + nrm(shape, 0.01)

    dt0 = jnp.exp(jax.random.uniform(next(ks), (DEPTH, 2, SSD_HEADS), jnp.float32, math.log(1e-3), math.log(1e-1)))
    return {
        'x': nrm((BATCH, SEQ, D_MODEL), 1.0),
        'c': nrm((BATCH, D_MODEL), 1.0),
        'ctx': nrm((BATCH, CTX_LEN, D_MODEL), 1.0),
        'c_ctx': nrm((D_MODEL,), 1.0),
        'w_mod': nrm((DEPTH, D_MODEL, 6 * D_MODEL), 0.5 * D_MODEL ** -0.5),
        'b_mod': nrm((DEPTH, 6 * D_MODEL), 0.01),
        'g_mix': gain((DEPTH, D_MODEL)),
        'g_ffn': gain((DEPTH, D_MODEL)),
        'w_in': nrm((DEPTH, D_MODEL, D_IN), D_MODEL ** -0.5),
        'q_norm': gain((DEPTH, HEAD_DIM)),
        'k_norm': gain((DEPTH, HEAD_DIM)),
        'ssd_conv_w': nrm((DEPTH, SSD_CONV, SSD_CONV_CH), SSD_CONV ** -0.5),
        'ssd_conv_b': nrm((DEPTH, SSD_CONV_CH), 0.01),
        'ssd_dt_bias': dt0 + jnp.log(-jnp.expm1(-dt0)),
        'ssd_a_log': jnp.log(jax.random.uniform(next(ks), (DEPTH, 2, SSD_HEADS), jnp.float32, 1.0, 16.0)),
        'ssd_d': gain((DEPTH, SSD_HEADS)),
        'ssd_norm': gain((DEPTH, SSD_W)),
        'hy_conv_w': nrm((DEPTH, HY_SHORT, (HY_ORDER + 1) * HY_W), HY_SHORT ** -0.5),
        'hy_conv_b': nrm((DEPTH, (HY_ORDER + 1) * HY_W), 0.01),
        'hy_w1': nrm((DEPTH, HY_POS_DIM, HY_FILTER_HID), HY_POS_DIM ** -0.5),
        'hy_b1': nrm((DEPTH, HY_FILTER_HID), 0.1),
        'hy_freq': gain((DEPTH, HY_FILTER_HID)),
        'hy_w2': nrm((DEPTH, HY_FILTER_HID, HY_FILTER_HID), HY_FILTER_HID ** -0.5),
        'hy_b2': nrm((DEPTH, HY_FILTER_HID), 0.1),
        'hy_w3': nrm((DEPTH, HY_FILTER_HID, 2 * HY_ORDER * HY_W), 0.05 * HY_FILTER_HID ** -0.5),
        'hy_bias': nrm((DEPTH, HY_ORDER, HY_W), 1.0),
        'w_out': nrm((DEPTH, MIX_W, D_MODEL), MIX_W ** -0.5),
        'w_router': nrm((D_MODEL, N_EXPERTS), D_MODEL ** -0.5),
        'router_bias': nrm((N_EXPERTS,), 0.01),
        'w_gate': nrm((DEPTH, N_EXPERTS, D_MODEL, D_FF), D_MODEL ** -0.5),
        'w_up': nrm((DEPTH, N_EXPERTS, D_MODEL, D_FF), D_MODEL ** -0.5),
        'w_down': nrm((DEPTH, N_EXPERTS, D_FF, D_MODEL), D_FF ** -0.5),
        'g_final': gain((D_MODEL,)),
    }


def reference(x, c, ctx, c_ctx, w_mod, b_mod, g_mix, g_ffn, w_in, q_norm, k_norm,
              ssd_conv_w, ssd_conv_b, ssd_dt_bias, ssd_a_log, ssd_d, ssd_norm,
              hy_conv_w, hy_conv_b, hy_w1, hy_b1, hy_freq, hy_w2, hy_b2, hy_w3, hy_bias,
              w_out, w_router, router_bias, w_gate, w_up, w_down, g_final):
    bsz, n_lat = x.shape[0], x.shape[1]
    rows = n_lat // GRID_W
    cos, sin = axial_rope(rows)
    xl, xc = x, ctx
    for i in range(DEPTH):
        need_ctx = i < DEPTH - 1
        sh1, sc1, gt1, sh2, sc2, gt2 = adaln(c, w_mod[i], b_mod[i])
        csh1, csc1, cgt1, csh2, csc2, cgt2 = adaln(c_ctx[None], w_mod[i], b_mod[i])

        hl = modulate(rmsnorm(xl, g_mix[i]), sh1, sc1)
        hc = modulate(rmsnorm(xc, g_mix[i]), csh1, csc1)
        q_l, k_l, v_l, z_l, xbc_l, dt_l, hy_l = split_proj(hl @ w_in[i])
        q_c, k_c, v_c, z_c, xbc_c, dt_c, hy_c = split_proj(hc @ w_in[i])

        ql = apply_rope(rmsnorm(heads(q_l, ATT_HEADS), q_norm[i]), cos, sin)
        kl = apply_rope(rmsnorm(heads(k_l, ATT_KV_HEADS), k_norm[i]), cos, sin)
        kc = rmsnorm(heads(k_c, ATT_KV_HEADS), k_norm[i])
        vl, vc = heads(v_l, ATT_KV_HEADS), heads(v_c, ATT_KV_HEADS)
        att_l = gqa_blocks(ql, jnp.concatenate([kc, kl], axis=1), jnp.concatenate([vc, vl], axis=1))

        a = -jnp.exp(ssd_a_log[i].astype(jnp.float32))
        xs_c, b_c, c_c, dtc = ssd_prep(xbc_c, dt_c, ssd_conv_w[i], ssd_conv_b[i], ssd_dt_bias[i])
        xs_l, b_l, c_l, dtl = ssd_prep(xbc_l, dt_l, ssd_conv_w[i], ssd_conv_b[i], ssd_dt_bias[i])
        if need_ctx:
            zeros = jnp.zeros((bsz, SSD_HEADS, SSD_HEAD_DIM, SSD_STATE), jnp.float32)
            yc, hc_f, hc_b = bidir_ssd(xs_c, dtc, a, b_c, c_c, zeros, zeros)
        else:
            hc_f = ssd_last_state(xs_c, dtc[:, :, 0], a[0], b_c)
            hc_b = ssd_last_state(rev(xs_c), rev(dtc[:, :, 1]), a[1], rev(b_c))
        yl, _, _ = bidir_ssd(xs_l, dtl, a, b_l, c_l, hc_f, hc_b)
        ssd_l = ssd_out(yl, xs_l, z_l, ssd_d[i], ssd_norm[i])

        hyn_l = hyena_mixer(hy_l, hy_conv_w[i], hy_conv_b[i], hy_w1[i], hy_b1[i], hy_freq[i],
                            hy_w2[i], hy_b2[i], hy_w3[i], hy_bias[i])

        mix_l = jnp.concatenate([att_l, ssd_l, hyn_l], axis=-1) @ w_out[i]
        xl = xl + gt1[:, None, :] * mix_l
        if need_ctx:
            qc = rmsnorm(heads(q_c, ATT_HEADS), q_norm[i])
            att_c = gqa_blocks(qc, kc, vc)
            ssd_c = ssd_out(yc, xs_c, z_c, ssd_d[i], ssd_norm[i])
            hyn_c = hyena_mixer(hy_c, hy_conv_w[i], hy_conv_b[i], hy_w1[i], hy_b1[i], hy_freq[i],
                                hy_w2[i], hy_b2[i], hy_w3[i], hy_bias[i])
            mix_c = jnp.concatenate([att_c, ssd_c, hyn_c], axis=-1) @ w_out[i]
            xc = xc + cgt1[:, None, :] * mix_c

        hl2 = modulate(rmsnorm(xl, g_ffn[i]), sh2, sc2)
        if need_ctx:
            hc2 = modulate(rmsnorm(xc, g_ffn[i]), csh2, csc2)
            n_ctx = hc2.shape[1]
            hc2 = jnp.broadcast_to(hc2, (bsz,) + hc2.shape[1:])
            moe_all = grouped_moe(jnp.concatenate([hc2, hl2], axis=1), w_router, router_bias,
                                  w_gate[i], w_up[i], w_down[i])
            xc = xc + cgt2[:, None, :] * moe_all[:, :n_ctx]
            xl = xl + gt2[:, None, :] * moe_all[:, n_ctx:]
        else:
            xl = xl + gt2[:, None, :] * grouped_moe(hl2, w_router, router_bias, w_gate[i], w_up[i], w_down[i])
    return rmsnorm(xl, g_final)
```

```cpp
#include <hip/hip_runtime.h>
#include <cstdio>
#include <cstdint>

typedef unsigned short bf16_t;
typedef short bf16x8 __attribute__((ext_vector_type(8)));
typedef float f32x4 __attribute__((ext_vector_type(4)));
typedef unsigned u32x4 __attribute__((ext_vector_type(4)));
typedef unsigned u32x2 __attribute__((ext_vector_type(2)));

constexpr int NB = 4, SEQ = 4096, CTXL = 256, DM = 1024, TPB = 4352, MTOK = NB * TPB;
constexpr int DIN = 2444, NPAD = 2560;
constexpr float EPS = 1e-6f;
constexpr float C2 = 0.125f * 1.4426950408889634f;
constexpr int MOE_ROWS = 23552;

constexpr size_t MiB = 1u << 20;
constexpr size_t WS_CTL = 0;
constexpr size_t WS_MODV = 1 * MiB;
constexpr size_t WS_ROPE = 2 * MiB;
constexpr size_t WS_MOEM = 3 * MiB;
constexpr size_t WS_DT = 4 * MiB;
constexpr size_t WS_HKC = 5 * MiB;
constexpr size_t WS_XC = 6 * MiB;
constexpr size_t WS_WIN = 10 * MiB;
constexpr size_t WS_WOUT = 15 * MiB;
constexpr size_t WS_WGU = 17 * MiB;
constexpr size_t WS_WD = 33 * MiB;
constexpr size_t WS_HK = 41 * MiB;
constexpr size_t WS_H = 57 * MiB;
constexpr size_t WS_QK = 91 * MiB;
constexpr size_t WS_VZ = 108 * MiB;
constexpr size_t WS_XBC = 125 * MiB;
constexpr size_t WS_HY = WS_XBC + (size_t)MTOK * 768 * 2;
constexpr size_t WS_HYT = WS_HY + (size_t)MTOK * 768 * 2;
constexpr size_t WS_XBCC = WS_HYT + (size_t)MTOK * 768 * 2;
constexpr size_t WS_Y = WS_XBCC + (size_t)MTOK * 640 * 2;
constexpr size_t WS_END = WS_Y + (size_t)MTOK * 384 * 4;
constexpr size_t WS_H2S = WS_QK;
constexpr size_t WS_ACT = WS_H2S + (size_t)MOE_ROWS * 1024 * 2;
static_assert(WS_END <= 256 * MiB, "ws");
static_assert(WS_ACT + (size_t)MOE_ROWS * 512 * 2 <= WS_HYT, "moe alias");

constexpr int CT_CNT = 0, CT_FILL = 32, CT_BASE = 64, CT_NT = 96, CT_TP = 128;

__device__ __forceinline__ unsigned f2bf(float f) { unsigned u = __float_as_uint(f); return (u + 0x7fffu + ((u >> 16) & 1u)) >> 16; }
__device__ __forceinline__ float bf2f(bf16_t h) { return __uint_as_float(((unsigned)h) << 16); }
__device__ __forceinline__ float wave_sum(float v) {
#pragma unroll
  for (int o = 1; o < 64; o <<= 1) v += __shfl_xor(v, o);
  return v;
}
__device__ __forceinline__ float siluf(float v) { return v / (1.0f + __expf(-v)); }

struct XPtrs { float* xl; float* xc; };
__device__ __forceinline__ float* xrow(const float* xl, const float* xc, int r) {
  const int b = r / TPB, j = r - b * TPB;
  return (float*)(j < CTXL ? xc + ((size_t)b * CTXL + j) * DM : xl + ((size_t)b * SEQ + (j - CTXL)) * DM);
}
__device__ __forceinline__ int mrow_of(int r) { const int b = r / TPB, j = r - b * TPB; return j < CTXL ? 4 : b; }

__global__ void __launch_bounds__(512) k_adaln(const float* c, const float* c_ctx, const float* w_mod, const float* b_mod, float* modv) {
  __shared__ float sc[5][1024];
  __shared__ float red[8][5][64];
  const int tid = threadIdx.x, layer = blockIdx.x / 96, n0 = (blockIdx.x % 96) * 64;
  for (int i = tid; i < 5 * 1024; i += 512) { const int r = i >> 10, k = i & 1023; const float v = r < 4 ? c[r * 1024 + k] : c_ctx[k]; sc[r][k] = v / (1.0f + expf(-v)); }
  __syncthreads();
  const int kg = tid >> 6, n = tid & 63;
  float acc[5] = {0.f, 0.f, 0.f, 0.f, 0.f};
  for (int k = kg; k < 1024; k += 8) { const float w = w_mod[((size_t)layer * 1024 + k) * 6144 + n0 + n];
#pragma unroll
    for (int r = 0; r < 5; ++r) acc[r] += sc[r][k] * w; }
#pragma unroll
  for (int r = 0; r < 5; ++r) red[kg][r][n] = acc[r];
  __syncthreads();
  if (tid < 320) { const int r = tid >> 6, nn = tid & 63; float s = 0.f;
#pragma unroll
    for (int g = 0; g < 8; ++g) s += red[g][r][nn];
    modv[((size_t)layer * 5 + r) * 6144 + n0 + nn] = s + b_mod[layer * 6144 + n0 + nn]; }
}

__global__ void k_rope(float* rope) {
  const int i = blockIdx.x * blockDim.x + threadIdx.x; if (i >= 4096 * 32) return;
  const int t = i >> 5, d = i & 31, m = d & 15;
  const float inv = powf(10000.0f, -(float)(2 * m) / 32.0f);
  const float pos = (float)(d < 16 ? (t >> 6) : (t & 63));
  const float ang = pos * inv;
  rope[2 * i] = cosf(ang); rope[2 * i + 1] = sinf(ang);
}

__global__ void __launch_bounds__(512) k_normmod(const float* xl, const float* xc, const float* g, const float* modv_layer, int off_sh, int off_sc, bf16_t* H) {
  const int lane = threadIdx.x & 63, gw = blockIdx.x * 8 + (threadIdx.x >> 6), ngw = gridDim.x * 8;
  for (int r = gw; r < MTOK; r += ngw) {
    const float* xr = xrow(xl, xc, r); const float* mv = modv_layer + (size_t)mrow_of(r) * 6144;
    f32x4 v[4]; float ss = 0.f;
#pragma unroll
    for (int j = 0; j < 4; ++j) { v[j] = *(const f32x4*)(xr + 4 * lane + 256 * j); ss += v[j].x * v[j].x + v[j].y * v[j].y + v[j].z * v[j].z + v[j].w * v[j].w; }
    const float rstd = rsqrtf(wave_sum(ss) * (1.0f / DM) + EPS);
#pragma unroll
    for (int j = 0; j < 4; ++j) { const int k = 4 * lane + 256 * j;
      const f32x4 gg = *(const f32x4*)(g + k), sh = *(const f32x4*)(mv + off_sh + k), sc = *(const f32x4*)(mv + off_sc + k);
      const float o0 = v[j].x * rstd * gg.x * (1.f + sc.x) + sh.x, o1 = v[j].y * rstd * gg.y * (1.f + sc.y) + sh.y;
      const float o2 = v[j].z * rstd * gg.z * (1.f + sc.z) + sh.z, o3 = v[j].w * rstd * gg.w * (1.f + sc.w) + sh.w;
      u32x2 w; w.x = f2bf(o0) | (f2bf(o1) << 16); w.y = f2bf(o2) | (f2bf(o3) << 16);
      *(u32x2*)(H + (size_t)r * DM + k) = w; }
  }
}

template <int MODE> __global__ void __launch_bounds__(256) k_transpose(const float* src, const float* src2, int ldsrc, int K, int N, bf16_t* out) {
  __shared__ float tile[64][65];
  const int tid = threadIdx.x, n0 = blockIdx.x * 64, k0 = blockIdx.y * 64;
  for (int i = 0; i < 16; ++i) { const int kk = (tid >> 6) + 4 * i, nn = tid & 63, n = n0 + nn; float v = 0.f;
    if (MODE == 0) { int col = n < 1676 ? n : (n < 1792 ? -1 : n - 116); if (col >= 0) v = src[(size_t)(k0 + kk) * ldsrc + col]; }
    else if (MODE == 1) { v = src[(size_t)(k0 + kk) * ldsrc + n]; }
    else { const int tb = n >> 7, q = n & 127; v = q < 64 ? src[(size_t)(k0 + kk) * ldsrc + 64 * tb + q] : src2[(size_t)(k0 + kk) * ldsrc + 64 * tb + q - 64]; }
    tile[kk][nn] = v; }
  __syncthreads();
  for (int i = 0; i < 8; ++i) { const int nn = (tid >> 5) + 8 * i, kk = (tid & 31) * 2;
    *(unsigned*)(out + (size_t)(n0 + nn) * K + k0 + kk) = f2bf(tile[kk][nn]) | (f2bf(tile[kk + 1][nn]) << 16); }
}

template <class P> __global__ void __launch_bounds__(256) k_gemm(P p) {
  __shared__ __attribute__((aligned(16))) bf16_t As[128][72];
  __shared__ __attribute__((aligned(16))) bf16_t Bs[128][72];
  const int tid = threadIdx.x, lane = tid & 63, w = tid >> 6, mt = blockIdx.y, nt = blockIdx.x;
  if (!p.valid(mt)) return;
  const int m0 = mt * 128, n0 = nt * 128;
  f32x4 acc[2][8];
#pragma unroll
  for (int a = 0; a < 2; ++a)
#pragma unroll
    for (int b = 0; b < 8; ++b) acc[a][b] = (f32x4){0.f, 0.f, 0.f, 0.f};
  const int K = p.K;
  for (int k0 = 0; k0 < K; k0 += 64) {
#pragma unroll
    for (int i = 0; i < 4; ++i) { const int ch = tid + 256 * i, r = ch >> 3, kc = (ch & 7) * 8;
      const bf16_t* ap = p.arow(m0 + r); *(u32x4*)&As[r][kc] = *(const u32x4*)(ap + k0 + kc);
      const bf16_t* bp = p.brow(mt, n0 + r, k0); *(u32x4*)&Bs[r][kc] = *(const u32x4*)(bp + kc); }
    __syncthreads();
#pragma unroll
    for (int kk = 0; kk < 2; ++kk) {
      bf16x8 a[2], b[8];
#pragma unroll
      for (int mi = 0; mi < 2; ++mi) a[mi] = *(const bf16x8*)&As[32 * w + 16 * mi + (lane & 15)][kk * 32 + 8 * (lane >> 4)];
#pragma unroll
      for (int ni = 0; ni < 8; ++ni) b[ni] = *(const bf16x8*)&Bs[16 * ni + (lane & 15)][kk * 32 + 8 * (lane >> 4)];
#pragma unroll
      for (int mi = 0; mi < 2; ++mi)
#pragma unroll
        for (int ni = 0; ni < 8; ++ni) acc[mi][ni] = __builtin_amdgcn_mfma_f32_16x16x32_bf16(a[mi], b[ni], acc[mi][ni], 0, 0, 0);
    }
    __syncthreads();
  }
  p.epi(acc, mt, m0, n0, w, lane);
}

struct PInProj {
  const bf16_t* H; const bf16_t* W; bf16_t *QK, *VZ, *XBC, *HY; float* DT; int K; int pad;
  __device__ bool valid(int) const { return true; }
  __device__ const bf16_t* arow(int m) const { return H + (size_t)m * DM; }
  __device__ const bf16_t* brow(int, int n, int k0) const { return W + (size_t)n * DM + k0; }
  __device__ void epi(const f32x4 (&acc)[2][8], int, int m0, int n0, int w, int lane) const {
#pragma unroll
    for (int mi = 0; mi < 2; ++mi)
#pragma unroll
      for (int ni = 0; ni < 8; ++ni)
#pragma unroll
        for (int rg = 0; rg < 4; ++rg) { const int row = m0 + 32 * w + 16 * mi + 4 * (lane >> 4) + rg, col = n0 + 16 * ni + (lane & 15); const float v = acc[mi][ni][rg];
          if (col < 512) QK[(size_t)row * 512 + col] = (bf16_t)f2bf(v);
          else if (col < 1024) VZ[(size_t)row * 512 + col - 512] = (bf16_t)f2bf(v);
          else if (col < 1792) { XBC[(size_t)row * 768 + col - 1024] = (bf16_t)f2bf(v); if (col >= 1664 && col < 1676) DT[(size_t)row * 12 + col - 1664] = v; }
          else HY[(size_t)row * 768 + col - 1792] = (bf16_t)f2bf(v); }
  }
};
struct POutProj {
  const bf16_t* A; const bf16_t* W; const float *xl_src, *xc_src; float *xl_dst, *xc_dst; const float* gate;   int skip_ctx; int K;
  __device__ bool valid(int mt) const { return !(skip_ctx && ((mt * 128) % TPB) < CTXL); }
  __device__ const bf16_t* arow(int m) const { return A + (size_t)m * DM; }
  __device__ const bf16_t* brow(int, int n, int k0) const { return W + (size_t)n * DM + k0; }
  __device__ void epi(const f32x4 (&acc)[2][8], int, int m0, int n0, int w, int lane) const {
#pragma unroll
    for (int mi = 0; mi < 2; ++mi)
#pragma unroll
      for (int rg = 0; rg < 4; ++rg) { const int row = m0 + 32 * w + 16 * mi + 4 * (lane >> 4) + rg;
        const float* xs = xrow(xl_src, xc_src, row); float* xd = xrow(xl_dst, xc_dst, row); const float* gt = gate + (size_t)mrow_of(row) * 6144;
#pragma unroll
        for (int ni = 0; ni < 8; ++ni) { const int col = n0 + 16 * ni + (lane & 15); xd[col] = xs[col] + gt[col] * acc[mi][ni][rg]; } }
  }
};
__device__ __forceinline__ void pair_experts(int pidx, int& eA, int& eB) {
  const int g = pidx / 6, t = pidx - 6 * g; const int i = t < 3 ? 0 : (t < 5 ? 1 : 2); const int j = t < 3 ? t + 1 : (t < 5 ? t - 1 : 3);
  eA = 4 * g + i; eB = 4 * g + j;
}
struct PMoe1 {
  const bf16_t* H2S; const bf16_t* WGU; bf16_t* ACT; const int* ctl; const float* sorted_w; int K; int pad;
  __device__ bool valid(int mt) const { return (mt >> 1) < ctl[CT_NT]; }
  __device__ const bf16_t* arow(int m) const { return H2S + (size_t)m * DM; }
  __device__ const bf16_t* brow(int mt, int n, int k0) const { int eA, eB; pair_experts(ctl[CT_TP + (mt >> 1)], eA, eB); const int e = n < 512 ? eA : eB;
    return WGU + ((size_t)e * 512 + (n & 511)) * DM + k0; }
  __device__ void epi(const f32x4 (&acc)[2][8], int, int m0, int n0, int w, int lane) const {
    const int half = n0 >> 9, tb = (n0 & 511) >> 7;
#pragma unroll
    for (int mi = 0; mi < 2; ++mi)
#pragma unroll
      for (int rg = 0; rg < 4; ++rg) { const int slot = m0 + 32 * w + 16 * mi + 4 * (lane >> 4) + rg; const float wt = sorted_w[2 * slot + half];
#pragma unroll
        for (int ni = 0; ni < 4; ++ni) { const float g = acc[mi][ni][rg], u = acc[mi][ni + 4][rg]; const int j = 64 * tb + 16 * ni + (lane & 15);
          ACT[(size_t)slot * 512 + half * 256 + j] = (bf16_t)f2bf(siluf(g) * u * wt); } }
  }
};
struct PMoe2 {
  const bf16_t* ACT; const bf16_t* WD; float *xl, *xc; const float* gate;   const int* ctl; const int* sorted_tok; int K; int pad;
  __device__ bool valid(int mt) const { return (mt >> 1) < ctl[CT_NT]; }
  __device__ const bf16_t* arow(int m) const { return ACT + (size_t)m * 512; }
  __device__ const bf16_t* brow(int mt, int n, int k0) const { int eA, eB; pair_experts(ctl[CT_TP + (mt >> 1)], eA, eB); const int e = k0 < 256 ? eA : eB;
    return WD + ((size_t)e * 1024 + n) * 256 + (k0 & 255); }
  __device__ void epi(const f32x4 (&acc)[2][8], int, int m0, int n0, int w, int lane) const {
#pragma unroll
    for (int mi = 0; mi < 2; ++mi)
#pragma unroll
      for (int rg = 0; rg < 4; ++rg) { const int slot = m0 + 32 * w + 16 * mi + 4 * (lane >> 4) + rg; const int r = sorted_tok[slot];
        if (r >= 0) { float* xd = xrow(xl, xc, r); const float* gt = gate + (size_t)mrow_of(r) * 6144;
#pragma unroll
          for (int ni = 0; ni < 8; ++ni) { const int col = n0 + 16 * ni + (lane & 15); xd[col] += gt[col] * acc[mi][ni][rg]; } } }
  }
};

__global__ void __launch_bounds__(512) k_prep_qk(bf16_t* QK, const float* qn, const float* kn, const float* rope) {
  const int lane = threadIdx.x & 63, gw = blockIdx.x * 8 + (threadIdx.x >> 6), ngw = gridDim.x * 8;
  for (int it = gw; it < MTOK * 8; it += ngw) {
    const int r = it >> 3, hh = it & 7, j = r % TPB;
    bf16_t* p = QK + (size_t)r * 512 + hh * 64 + lane;
    const float v = bf2f(*p);
    const float ss = wave_sum(v * v);
    float y = v * rsqrtf(ss * (1.0f / 64.0f) + EPS) * (hh < 6 ? qn[lane] : kn[lane]);
    if (j >= CTXL) { const int t = j - CTXL; const float other = __shfl_xor(y, 32); const float cs = rope[(t * 32 + (lane & 31)) * 2], sn = rope[(t * 32 + (lane & 31)) * 2 + 1];
      y = lane < 32 ? y * cs - other * sn : y * cs + other * sn; }
    if (hh < 6) y *= C2;
    *p = (bf16_t)f2bf(y);
  }
}

__global__ void __launch_bounds__(256) k_prep_hy(const bf16_t* HY, const float* cw, const float* cb, bf16_t* HYT, int do_ctx) {
  __shared__ float tile[66][65];
  const int nlat = 4 * 64 * 12, nitem = nlat + (do_ctx ? 4 * 4 * 12 : 0), tid = threadIdx.x;
  for (int it = blockIdx.x; it < nitem; it += gridDim.x) {
    int b, tt, ct, L, joff; bf16_t* outb;
    if (it < nlat) { b = it / 768; tt = (it % 768) / 12; ct = it % 12; L = SEQ; joff = CTXL; outb = HYT + (size_t)b * 768 * SEQ; }
    else { const int i2 = it - nlat; b = i2 / 48; tt = (i2 % 48) / 12; ct = i2 % 12; L = CTXL; joff = 0; outb = HYT + (size_t)4 * 768 * SEQ + (size_t)b * 768 * CTXL; }
    const int t0 = tt * 64, c0 = ct * 64;
    for (int e = tid; e < 66 * 64; e += 256) { const int rr = e >> 6, cc = e & 63, t = t0 - 1 + rr;
      tile[rr][cc] = (t >= 0 && t < L) ? bf2f(HY[((size_t)b * TPB + joff + t) * 768 + c0 + cc]) : 0.f; }
    __syncthreads();
    for (int e = tid; e < 64 * 64; e += 256) { const int cc = e >> 6, tl = e & 63, c = c0 + cc;
      const float v = cw[c] * tile[tl][cc] + cw[768 + c] * tile[tl + 1][cc] + cw[1536 + c] * tile[tl + 2][cc] + cb[c];
      outb[(size_t)c * L + t0 + tl] = (bf16_t)f2bf(v); }
    __syncthreads();
  }
}

template <int L> __global__ void __launch_bounds__(512) k_hyfilt(const float* w1, const float* b1, const float* fr, const float* w2, const float* b2, const float* w3, float* HK) {
  __shared__ float S0[64 * 64], S1[64 * 64], S2[64 * 65];
  const int tid = threadIdx.x, n0 = blockIdx.x * 64, lane = tid & 63, wv = tid >> 6;
  for (int e = tid; e < 64 * 33; e += 512) { const int pp = e / 33, f = e % 33; const int n = n0 + pp; float v;
    if (f == 0) v = (float)n / (float)(L - 1);
    else { const int m = (f - 1) & 15; const float band = 1e-4f + (float)m * ((15.0f - 1e-4f) / 15.0f); const float wpos = (6.283185307179586f / (float)L) * (float)n;
      v = f <= 16 ? cosf(wpos * band) : -sinf(wpos * band); }
    S0[pp * 33 + f] = v; }
  for (int e = tid; e < 33 * 64; e += 512) S1[e] = w1[e];
  __syncthreads();
  for (int e = tid; e < 64 * 64; e += 512) { const int pp = e >> 6, j = e & 63; float a = b1[j];
    for (int f = 0; f < 33; ++f) a += S0[pp * 33 + f] * S1[f * 64 + j];
    S2[pp * 64 + j] = sinf(fr[j] * a); }
  __syncthreads();
  for (int e = tid; e < 64 * 64; e += 512) S0[e] = w2[e];
  __syncthreads();
  for (int e = tid; e < 64 * 64; e += 512) { const int pp = e >> 6, j = e & 63; float a = b2[j];
    for (int f = 0; f < 64; ++f) a += S2[pp * 64 + f] * S0[f * 64 + j];
    S1[pp * 64 + j] = sinf(fr[j] * a); }
  __syncthreads();
  for (int ch = 0; ch < 16; ++ch) {
    const int col = ch * 64 + lane; float acc[8];
#pragma unroll
    for (int i = 0; i < 8; ++i) acc[i] = 0.f;
    for (int j = 0; j < 64; ++j) { const float wv3 = w3[j * 1024 + col];
#pragma unroll
      for (int i = 0; i < 8; ++i) acc[i] += S1[(wv * 8 + i) * 64 + j] * wv3; }
    const int c = col & 255; const float delta = 3.0701134573253943f + (float)c * ((15.350567286626972f - 3.0701134573253943f) / 255.0f);
#pragma unroll
    for (int i = 0; i < 8; ++i) { const int pp = wv * 8 + i; const float t = (float)(n0 + pp) / (float)(L - 1); S2[lane * 65 + pp] = acc[i] * expf(-t * delta); }
    __syncthreads();
    const int dir = ch >> 3, order = (ch >> 2) & 1;
#pragma unroll
    for (int i = 0; i < 8; ++i) { const int cl = wv * 8 + i, c2 = (ch * 64 + cl) & 255, n = n0 + lane; const float v = S2[cl * 65 + lane];
      float* dst = HK + ((size_t)order * 256 + c2) * (2 * L);
      if (dir == 0) dst[n] = v; else if (n >= 1) dst[2 * L - n] = v;
      if (dir == 1 && n == 0) dst[L] = 0.f; }
    __syncthreads();
  }
}

template <int L> __global__ void __launch_bounds__(512) k_hyconv(const bf16_t* HYT, const float* HK, const float* hy_bias, bf16_t* MIX, int joff) {
  __shared__ __attribute__((aligned(16))) float kern[2 * L];
  __shared__ __attribute__((aligned(16))) float z[L];
  const int tid = threadIdx.x, b = blockIdx.x >> 8, c = blockIdx.x & 255;
  const bf16_t* vp = HYT + ((size_t)b * 768 + c) * L; const bf16_t* x1p = vp + (size_t)256 * L; const bf16_t* x2p = vp + (size_t)512 * L;
  const bool act = tid < L / 8; const int tb = 8 * tid;
  for (int o = 0; o < 2; ++o) {
    if (o == 0) for (int t = tid; t < L; t += 512) z[t] = bf2f(vp[t]);
    const float* kp = HK + ((size_t)o * 256 + c) * (2 * L);
    for (int t = tid; t < 2 * L; t += 512) kern[t] = kp[t];
    __syncthreads();
    float acc[8], W[16];
#pragma unroll
    for (int i = 0; i < 8; ++i) acc[i] = 0.f;
    if (act) {
#pragma unroll
      for (int i = 0; i < 8; ++i) W[8 + i] = kern[(tb + i) & (2 * L - 1)];
      for (int s0 = 0; s0 < L; s0 += 8) {
        const int bb = (tb - s0 - 8) & (2 * L - 1);
#pragma unroll
        for (int i = 0; i < 8; ++i) W[i] = kern[bb + i];
        float zs[8];
#pragma unroll
        for (int j = 0; j < 8; ++j) zs[j] = z[s0 + j];
#pragma unroll
        for (int j = 0; j < 8; ++j)
#pragma unroll
          for (int i = 0; i < 8; ++i) acc[i] += W[8 + i - j] * zs[j];
#pragma unroll
        for (int i = 0; i < 8; ++i) W[8 + i] = W[i];
      }
    }
    __syncthreads();
    const float bias = hy_bias[o * 256 + c];
    if (act) {
#pragma unroll
      for (int i = 0; i < 8; ++i) { const int t = tb + i; const float zz = acc[i] + bias * z[t];
        if (o == 0) z[t] = bf2f(x1p[t]) * zz;
        else MIX[((size_t)b * TPB + joff + t) * DM + 768 + c] = (bf16_t)f2bf(bf2f(x2p[t]) * zz); }
    }
    __syncthreads();
  }
}

__global__ void __launch_bounds__(256) k_attn(const bf16_t* QK, const bf16_t* VZ, bf16_t* MIX) {
  __shared__ __attribute__((aligned(16))) bf16_t Ks[64][72];
  __shared__ __attribute__((aligned(16))) bf16_t Vt[64][72];
  __shared__ __attribute__((aligned(16))) bf16_t Ps[4][16][72];
  const int tid = threadIdx.x, lane = tid & 63, w = tid >> 6, u = blockIdx.x;
  int b, h, qrow0, nk;
  if (u < 1536) { b = u / 384; const int rem = u % 384; h = rem >> 6; qrow0 = b * TPB + CTXL + (rem & 63) * 64; nk = TPB; }
  else { const int uc = u - 1536; b = uc / 24; h = (uc % 24) >> 2; qrow0 = b * TPB + (uc & 3) * 64; nk = CTXL; }
  const int kvh = h / 3, key0 = b * TPB, l15 = lane & 15, l4 = lane >> 4;
  bf16x8 aq[2];
#pragma unroll
  for (int kk = 0; kk < 2; ++kk) aq[kk] = *(const bf16x8*)(QK + (size_t)(qrow0 + 16 * w + l15) * 512 + h * 64 + kk * 32 + 8 * l4);
  f32x4 O[4]; float m[4], l[4];
#pragma unroll
  for (int i = 0; i < 4; ++i) { O[i] = (f32x4){0.f, 0.f, 0.f, 0.f}; m[i] = -1e30f; l[i] = 0.f; }
  for (int kt = 0; kt < nk / 64; ++kt) {
    __syncthreads();
#pragma unroll
    for (int i = 0; i < 2; ++i) { const int ch = tid + 256 * i, r = ch >> 3, c8 = (ch & 7) * 8; const size_t grow = (size_t)(key0 + kt * 64 + r) * 512;
      *(u32x4*)&Ks[r][c8] = *(const u32x4*)(QK + grow + 384 + kvh * 64 + c8);
      const bf16x8 vv = *(const bf16x8*)(VZ + grow + kvh * 64 + c8);
#pragma unroll
      for (int e = 0; e < 8; ++e) Vt[c8 + e][r] = (bf16_t)vv[e]; }
    __syncthreads();
    f32x4 s[4];
#pragma unroll
    for (int ni = 0; ni < 4; ++ni) s[ni] = (f32x4){0.f, 0.f, 0.f, 0.f};
#pragma unroll
    for (int kk = 0; kk < 2; ++kk)
#pragma unroll
      for (int ni = 0; ni < 4; ++ni) { const bf16x8 bk = *(const bf16x8*)&Ks[16 * ni + l15][32 * kk + 8 * l4]; s[ni] = __builtin_amdgcn_mfma_f32_16x16x32_bf16(aq[kk], bk, s[ni], 0, 0, 0); }
#pragma unroll
    for (int rg = 0; rg < 4; ++rg) {
      float mx = fmaxf(fmaxf(s[0][rg], s[1][rg]), fmaxf(s[2][rg], s[3][rg]));
      mx = fmaxf(mx, __shfl_xor(mx, 1)); mx = fmaxf(mx, __shfl_xor(mx, 2)); mx = fmaxf(mx, __shfl_xor(mx, 4)); mx = fmaxf(mx, __shfl_xor(mx, 8));
      const float mn = fmaxf(m[rg], mx), alpha = exp2f(m[rg] - mn); float rs = 0.f;
#pragma unroll
      for (int ni = 0; ni < 4; ++ni) { const float pv = exp2f(s[ni][rg] - mn); rs += pv; Ps[w][4 * l4 + rg][16 * ni + l15] = (bf16_t)f2bf(pv); }
      rs += __shfl_xor(rs, 1); rs += __shfl_xor(rs, 2); rs += __shfl_xor(rs, 4); rs += __shfl_xor(rs, 8);
      l[rg] = l[rg] * alpha + rs; m[rg] = mn;
#pragma unroll
      for (int ni = 0; ni < 4; ++ni) O[ni][rg] *= alpha;
    }
    __syncthreads();
#pragma unroll
    for (int kk = 0; kk < 2; ++kk) { const bf16x8 ap = *(const bf16x8*)&Ps[w][l15][32 * kk + 8 * l4];
#pragma unroll
      for (int ni = 0; ni < 4; ++ni) { const bf16x8 bv = *(const bf16x8*)&Vt[16 * ni + l15][32 * kk + 8 * l4]; O[ni] = __builtin_amdgcn_mfma_f32_16x16x32_bf16(ap, bv, O[ni], 0, 0, 0); } }
  }
#pragma unroll
  for (int rg = 0; rg < 4; ++rg) { const float il = 1.0f / l[rg]; const size_t row = (size_t)(qrow0 + 16 * w + 4 * l4 + rg);
#pragma unroll
    for (int ni = 0; ni < 4; ++ni) MIX[row * DM + h * 64 + 16 * ni + l15] = (bf16_t)f2bf(O[ni][rg] * il); }
}

__global__ void __launch_bounds__(256) k_ssd_prep(const bf16_t* XBC, float* DT, const float* cw, const float* cb, const float* dt_bias, bf16_t* XBCC) {
  const size_t total = (size_t)MTOK * 640;
  for (size_t i = (size_t)blockIdx.x * 256 + threadIdx.x; i < total; i += (size_t)gridDim.x * 256) {
    const int r = (int)(i / 640), ch = (int)(i % 640), j = r % TPB;
    const bool hasp = (j != 0 && j != CTXL), hasn = (j != CTXL - 1 && j != TPB - 1);
    float v = cw[640 + ch] * bf2f(XBC[(size_t)r * 768 + ch]) + cb[ch];
    if (hasp) v += cw[ch] * bf2f(XBC[(size_t)(r - 1) * 768 + ch]);
    if (hasn) v += cw[1280 + ch] * bf2f(XBC[(size_t)(r + 1) * 768 + ch]);
    XBCC[i] = (bf16_t)f2bf(siluf(v));
  }
  for (size_t i = (size_t)blockIdx.x * 256 + threadIdx.x; i < (size_t)MTOK * 12; i += (size_t)gridDim.x * 256) {
    const float x = DT[i] + dt_bias[i % 12];
    DT[i] = x > 20.f ? x : log1pf(expf(x));
  }
}
__global__ void __launch_bounds__(256) k_ssd_scan(const bf16_t* XBCC, const float* DT, const float* a_log, float* Y) {
  __shared__ float xs[32][64], Bs[32][64], Cs[32][64], dAs[32], dts[32];
  const int tid = threadIdx.x, b = blockIdx.x / 6, h = blockIdx.x % 6, g = h / 3, p = tid >> 2, q = tid & 3;
  for (int dir = 0; dir < 2; ++dir) {
    const float a = -expf(a_log[dir * 6 + h]);
    float st[16];
#pragma unroll
    for (int n = 0; n < 16; ++n) st[n] = 0.f;
    for (int ci = 0; ci < TPB / 32; ++ci) {
      for (int e = tid; e < 32 * 64; e += 256) { const int i = e >> 6, cc = e & 63, qi = ci * 32 + i;
        const int j = dir == 0 ? qi : (qi < CTXL ? CTXL - 1 - qi : TPB - 1 - (qi - CTXL)); const size_t r = (size_t)b * TPB + j;
        xs[i][cc] = bf2f(XBCC[r * 640 + h * 64 + cc]); Bs[i][cc] = bf2f(XBCC[r * 640 + 384 + g * 64 + cc]); Cs[i][cc] = bf2f(XBCC[r * 640 + 512 + g * 64 + cc]); }
      if (tid < 32) { const int qi = ci * 32 + tid; const int j = dir == 0 ? qi : (qi < CTXL ? CTXL - 1 - qi : TPB - 1 - (qi - CTXL)); const size_t r = (size_t)b * TPB + j;
        const float dt = DT[r * 12 + dir * 6 + h]; dts[tid] = dt; dAs[tid] = expf(dt * a); }
      __syncthreads();
      for (int i = 0; i < 32; ++i) {
        const float d = dAs[i], dtx = dts[i] * xs[i][p]; float y = 0.f;
#pragma unroll
        for (int n = 0; n < 16; ++n) { st[n] = st[n] * d + dtx * Bs[i][16 * q + n]; y += Cs[i][16 * q + n] * st[n]; }
        y += __shfl_xor(y, 1); y += __shfl_xor(y, 2);
        if (q == 0) { const int qi = ci * 32 + i; const int j = dir == 0 ? qi : (qi < CTXL ? CTXL - 1 - qi : TPB - 1 - (qi - CTXL)); float* yp = Y + ((size_t)b * TPB + j) * 384 + h * 64 + p;
          if (dir == 0) *yp = y; else *yp += y; }
      }
      __syncthreads();
    }
  }
}
__global__ void __launch_bounds__(512) k_ssd_out(const float* Y, const bf16_t* XBCC, const bf16_t* VZ, const float* dskip, const float* nw, bf16_t* MIX) {
  const int lane = threadIdx.x & 63, gw = blockIdx.x * 8 + (threadIdx.x >> 6), ngw = gridDim.x * 8;
  for (int it = gw; it < MTOK * 2; it += ngw) {
    const int r = it >> 1, g = it & 1; float gv[3]; float ss = 0.f;
#pragma unroll
    for (int i = 0; i < 3; ++i) { const int c = g * 192 + lane + 64 * i, hh = c >> 6;
      const float y = Y[(size_t)r * 384 + c] + bf2f(XBCC[(size_t)r * 640 + c]) * dskip[hh]; const float zv = bf2f(VZ[(size_t)r * 512 + 128 + c]);
      gv[i] = y * siluf(zv); ss += gv[i] * gv[i]; }
    const float rstd = rsqrtf(wave_sum(ss) * (1.0f / 192.0f) + EPS);
#pragma unroll
    for (int i = 0; i < 3; ++i) { const int c = g * 192 + lane + 64 * i; MIX[(size_t)r * DM + 384 + c] = (bf16_t)f2bf(gv[i] * rstd * nw[c]); }
  }
}

__global__ void __launch_bounds__(512) k_router(const float* xl, const float* xc, const float* g, const float* modv_layer, const float* w_router, const float* rbias,
                                                bf16_t* H2, int* ctl, int* tok_pair, float* tok_w, int skip_ctx) {
  const int lane = threadIdx.x & 63, gw = blockIdx.x * 8 + (threadIdx.x >> 6), ngw = gridDim.x * 8;
  for (int r = gw; r < MTOK; r += ngw) {
    if (skip_ctx && (r % TPB) < CTXL) continue;
    const float* xr = xrow(xl, xc, r); const float* mv = modv_layer + (size_t)mrow_of(r) * 6144;
    f32x4 v[4]; float ss = 0.f;
#pragma unroll
    for (int j = 0; j < 4; ++j) { v[j] = *(const f32x4*)(xr + 4 * lane + 256 * j); ss += v[j].x * v[j].x + v[j].y * v[j].y + v[j].z * v[j].z + v[j].w * v[j].w; }
    const float rstd = rsqrtf(wave_sum(ss) * (1.0f / DM) + EPS);
    float lg[16];
#pragma unroll
    for (int e = 0; e < 16; ++e) lg[e] = 0.f;
#pragma unroll
    for (int j = 0; j < 4; ++j) { const int k = 4 * lane + 256 * j;
      const f32x4 gg = *(const f32x4*)(g + k), sh = *(const f32x4*)(mv + 3072 + k), sc = *(const f32x4*)(mv + 4096 + k);
      float o[4]; o[0] = v[j].x * rstd * gg.x * (1.f + sc.x) + sh.x; o[1] = v[j].y * rstd * gg.y * (1.f + sc.y) + sh.y;
      o[2] = v[j].z * rstd * gg.z * (1.f + sc.z) + sh.z; o[3] = v[j].w * rstd * gg.w * (1.f + sc.w) + sh.w;
      u32x2 w; w.x = f2bf(o[0]) | (f2bf(o[1]) << 16); w.y = f2bf(o[2]) | (f2bf(o[3]) << 16);
      *(u32x2*)(H2 + (size_t)r * DM + k) = w;
#pragma unroll
      for (int q = 0; q < 4; ++q) {
#pragma unroll
        for (int e4 = 0; e4 < 4; ++e4) { const f32x4 wr = *(const f32x4*)(w_router + (size_t)(k + q) * 16 + 4 * e4);
          lg[4 * e4] += o[q] * wr.x; lg[4 * e4 + 1] += o[q] * wr.y; lg[4 * e4 + 2] += o[q] * wr.z; lg[4 * e4 + 3] += o[q] * wr.w; } } }
#pragma unroll
    for (int e = 0; e < 16; ++e) lg[e] = wave_sum(lg[e]);
    if (lane == 0) {
      int best = 0, bi1 = 0, bi2 = 1; float bestv = -1e30f, bs1 = 0.f, bs2 = 0.f;
#pragma unroll
      for (int gq = 0; gq < 4; ++gq) { float m1 = -1e30f, m2 = -1e30f, s1 = 0.f, s2 = 0.f; int i1 = 0, i2 = 0;
#pragma unroll
        for (int i = 0; i < 4; ++i) { const float scv = 1.0f / (1.0f + expf(-lg[4 * gq + i])); const float s = scv + rbias[4 * gq + i];
          if (s > m1) { m2 = m1; s2 = s1; i2 = i1; m1 = s; s1 = scv; i1 = i; } else if (s > m2) { m2 = s; s2 = scv; i2 = i; } }
        if (m1 + m2 > bestv) { bestv = m1 + m2; best = gq; bi1 = i1; bi2 = i2; bs1 = s1; bs2 = s2; } }
      const int ia = bi1 < bi2 ? bi1 : bi2, ib = bi1 < bi2 ? bi2 : bi1;
      const int tri = ia == 0 ? ib - 1 : (ia == 1 ? ib + 1 : 5);
      const int pidx = best * 6 + tri;
      const float sa = bi1 < bi2 ? bs1 : bs2, sb = bi1 < bi2 ? bs2 : bs1, inv = 1.0f / (sa + sb);
      tok_pair[r] = pidx; tok_w[2 * r] = sa * inv; tok_w[2 * r + 1] = sb * inv;
      atomicAdd(&ctl[CT_CNT + pidx], 1);
    }
  }
}
__global__ void __launch_bounds__(512) k_moe_plan(int* ctl, int* sorted_tok) {
  const int tid = threadIdx.x;
  if (tid == 0) { int base = 0, nt = 0;
    for (int p = 0; p < 24; ++p) { ctl[CT_BASE + p] = base; const int n = ctl[CT_CNT + p], tl = (n + 255) >> 8; for (int t = 0; t < tl; ++t) ctl[CT_TP + nt + t] = p; nt += tl; base += tl * 256; ctl[CT_FILL + p] = 0; }
    ctl[CT_BASE + 24] = base; ctl[CT_NT] = nt; }
  for (int i = tid; i < MOE_ROWS; i += 512) sorted_tok[i] = -1;
}
__global__ void __launch_bounds__(512) k_moe_gather(const bf16_t* H2, bf16_t* H2S, int* ctl, const int* tok_pair, const float* tok_w, int* sorted_tok, float* sorted_w, int skip_ctx) {
  const int lane = threadIdx.x & 63, gw = blockIdx.x * 8 + (threadIdx.x >> 6), ngw = gridDim.x * 8;
  for (int r = gw; r < MTOK; r += ngw) {
    if (skip_ctx && (r % TPB) < CTXL) continue;
    const int p = tok_pair[r]; int slot = 0;
    if (lane == 0) { slot = ctl[CT_BASE + p] + atomicAdd(&ctl[CT_FILL + p], 1); sorted_tok[slot] = r; sorted_w[2 * slot] = tok_w[2 * r]; sorted_w[2 * slot + 1] = tok_w[2 * r + 1]; }
    slot = __shfl(slot, 0);
    const u32x4* s = (const u32x4*)(H2 + (size_t)r * DM); u32x4* d = (u32x4*)(H2S + (size_t)slot * DM);
    d[lane] = s[lane]; d[lane + 64] = s[lane + 64];
  }
}
__global__ void k_zero_ctl(int* ctl) { if (threadIdx.x < 256) ctl[threadIdx.x] = 0; }

__global__ void __launch_bounds__(512) k_final(float* xl, const float* g) {
  const int lane = threadIdx.x & 63, gw = blockIdx.x * 8 + (threadIdx.x >> 6), ngw = gridDim.x * 8;
  for (int r = gw; r < NB * SEQ; r += ngw) {
    float* xr = xl + (size_t)r * DM; f32x4 v[4]; float ss = 0.f;
#pragma unroll
    for (int j = 0; j < 4; ++j) { v[j] = *(const f32x4*)(xr + 4 * lane + 256 * j); ss += v[j].x * v[j].x + v[j].y * v[j].y + v[j].z * v[j].z + v[j].w * v[j].w; }
    const float rstd = rsqrtf(wave_sum(ss) * (1.0f / DM) + EPS);
#pragma unroll
    for (int j = 0; j < 4; ++j) { const int k = 4 * lane + 256 * j; const f32x4 gg = *(const f32x4*)(g + k);
      *(f32x4*)(xr + k) = (f32x4){v[j].x * rstd * gg.x, v[j].y * rstd * gg.y, v[j].z * rstd * gg.z, v[j].w * rstd * gg.w}; }
  }
}

extern "C" void kernel_launch(void* const* d_in, const int* in_sizes, int n_in, void* d_out, int out_size, void* d_ws, size_t ws_size, hipStream_t stream) {
  if (n_in != 33 || ws_size < WS_END) { fprintf(stderr, "kernel_launch: unexpected n_in %d / ws %zu\n", n_in, ws_size); return; }
  const float* x = (const float*)d_in[0]; const float* c = (const float*)d_in[1]; const float* ctx = (const float*)d_in[2]; const float* c_ctx = (const float*)d_in[3];
  const float* w_mod = (const float*)d_in[4]; const float* b_mod = (const float*)d_in[5]; const float* g_mix = (const float*)d_in[6]; const float* g_ffn = (const float*)d_in[7];
  const float* w_in = (const float*)d_in[8]; const float* q_norm = (const float*)d_in[9]; const float* k_norm = (const float*)d_in[10];
  const float* ssd_conv_w = (const float*)d_in[11]; const float* ssd_conv_b = (const float*)d_in[12]; const float* ssd_dt_bias = (const float*)d_in[13];
  const float* ssd_a_log = (const float*)d_in[14]; const float* ssd_d = (const float*)d_in[15]; const float* ssd_norm = (const float*)d_in[16];
  const float* hy_conv_w = (const float*)d_in[17]; const float* hy_conv_b = (const float*)d_in[18]; const float* hy_w1 = (const float*)d_in[19];
  const float* hy_b1 = (const float*)d_in[20]; const float* hy_freq = (const float*)d_in[21]; const float* hy_w2 = (const float*)d_in[22];
  const float* hy_b2 = (const float*)d_in[23]; const float* hy_w3 = (const float*)d_in[24]; const float* hy_bias = (const float*)d_in[25];
  const float* w_out = (const float*)d_in[26]; const float* w_router = (const float*)d_in[27]; const float* router_bias = (const float*)d_in[28];
  const float* w_gate = (const float*)d_in[29]; const float* w_up = (const float*)d_in[30]; const float* w_down = (const float*)d_in[31]; const float* g_final = (const float*)d_in[32];
  unsigned char* ws = (unsigned char*)d_ws;
  int* ctl = (int*)(ws + WS_CTL); float* modv = (float*)(ws + WS_MODV); float* rope = (float*)(ws + WS_ROPE);
  int* tok_pair = (int*)(ws + WS_MOEM); float* tok_w = (float*)(ws + WS_MOEM + 128 * 1024); int* sorted_tok = (int*)(ws + WS_MOEM + 384 * 1024); float* sorted_w = (float*)(ws + WS_MOEM + 512 * 1024);
  float* DT = (float*)(ws + WS_DT); float* HKC = (float*)(ws + WS_HKC); float* XC = (float*)(ws + WS_XC);
  bf16_t* WIN = (bf16_t*)(ws + WS_WIN); bf16_t* WOUT = (bf16_t*)(ws + WS_WOUT); bf16_t* WGU = (bf16_t*)(ws + WS_WGU); bf16_t* WD = (bf16_t*)(ws + WS_WD);
  float* HK = (float*)(ws + WS_HK); bf16_t* H = (bf16_t*)(ws + WS_H); bf16_t* QK = (bf16_t*)(ws + WS_QK); bf16_t* VZ = (bf16_t*)(ws + WS_VZ);
  bf16_t* XBC = (bf16_t*)(ws + WS_XBC); bf16_t* HY = (bf16_t*)(ws + WS_HY); bf16_t* HYT = (bf16_t*)(ws + WS_HYT); bf16_t* XBCC = (bf16_t*)(ws + WS_XBCC);
  float* Y = (float*)(ws + WS_Y); bf16_t* H2S = (bf16_t*)(ws + WS_H2S); bf16_t* ACT = (bf16_t*)(ws + WS_ACT);
  float* XL = (float*)d_out;

  k_adaln<<<192, 512, 0, stream>>>(c, c_ctx, w_mod, b_mod, modv);
  k_rope<<<512, 256, 0, stream>>>(rope);
  for (int layer = 0; layer < 2; ++layer) {
    const bool last = layer == 1;
    const float* xl_src = layer == 0 ? x : XL; const float* xc_src = layer == 0 ? ctx : XC;
    const float* mv = modv + (size_t)layer * 5 * 6144;
    k_transpose<0><<<dim3(NPAD / 64, 16), 256, 0, stream>>>(w_in + (size_t)layer * 1024 * DIN, nullptr, DIN, 1024, NPAD, WIN);
    k_transpose<1><<<dim3(16, 16), 256, 0, stream>>>(w_out + (size_t)layer * 1024 * 1024, nullptr, 1024, 1024, 1024, WOUT);
    for (int e = 0; e < 16; ++e) {
      k_transpose<2><<<dim3(8, 16), 256, 0, stream>>>(w_gate + ((size_t)layer * 16 + e) * 1024 * 256, w_up + ((size_t)layer * 16 + e) * 1024 * 256, 256, 1024, 512, WGU + (size_t)e * 512 * 1024);
      k_transpose<1><<<dim3(16, 4), 256, 0, stream>>>(w_down + ((size_t)layer * 16 + e) * 256 * 1024, nullptr, 1024, 256, 1024, WD + (size_t)e * 1024 * 256);
    }
    k_hyfilt<SEQ><<<SEQ / 64, 512, 0, stream>>>(hy_w1 + layer * 33 * 64, hy_b1 + layer * 64, hy_freq + layer * 64, hy_w2 + layer * 4096, hy_b2 + layer * 64, hy_w3 + (size_t)layer * 65536, HK);
    if (!last) k_hyfilt<CTXL><<<CTXL / 64, 512, 0, stream>>>(hy_w1 + layer * 33 * 64, hy_b1 + layer * 64, hy_freq + layer * 64, hy_w2 + layer * 4096, hy_b2 + layer * 64, hy_w3 + (size_t)layer * 65536, HKC);
    k_normmod<<<512, 512, 0, stream>>>(xl_src, xc_src, g_mix + layer * 1024, mv, 0, 1024, H);
    { PInProj p{H, WIN, QK, VZ, XBC, HY, DT, 1024, 0}; k_gemm<PInProj><<<dim3(NPAD / 128, MTOK / 128), 256, 0, stream>>>(p); }
    k_prep_qk<<<1024, 512, 0, stream>>>(QK, q_norm + layer * 64, k_norm + layer * 64, rope);
    k_prep_hy<<<1024, 256, 0, stream>>>(HY, hy_conv_w + layer * 3 * 768, hy_conv_b + layer * 768, HYT, last ? 0 : 1);
    k_ssd_prep<<<2048, 256, 0, stream>>>(XBC, DT, ssd_conv_w + layer * 3 * 640, ssd_conv_b + layer * 640, ssd_dt_bias + layer * 12, XBCC);
    k_attn<<<last ? 1536 : 1632, 256, 0, stream>>>(QK, VZ, H);
    k_ssd_scan<<<24, 256, 0, stream>>>(XBCC, DT, ssd_a_log + layer * 12, Y);
    k_ssd_out<<<1024, 512, 0, stream>>>(Y, XBCC, VZ, ssd_d + layer * 6, ssd_norm + layer * 384, H);
    k_hyconv<SEQ><<<1024, 512, 0, stream>>>(HYT, HK, hy_bias + layer * 512, H, CTXL);
    if (!last) k_hyconv<CTXL><<<1024, 512, 0, stream>>>(HYT + (size_t)4 * 768 * SEQ, HKC, hy_bias + layer * 512, H, 0);
    { POutProj p{H, WOUT, xl_src, xc_src, XL, XC, mv + 2048, last ? 1 : 0, 1024}; k_gemm<POutProj><<<dim3(8, MTOK / 128), 256, 0, stream>>>(p); }
    k_zero_ctl<<<1, 256, 0, stream>>>(ctl);
    k_router<<<512, 512, 0, stream>>>(XL, XC, g_ffn + layer * 1024, mv, w_router, router_bias, H, ctl, tok_pair, tok_w, last ? 1 : 0);
    k_moe_plan<<<1, 512, 0, stream>>>(ctl, sorted_tok);
    k_moe_gather<<<512, 512, 0, stream>>>(H, H2S, ctl, tok_pair, tok_w, sorted_tok, sorted_w, last ? 1 : 0);
    { PMoe1 p{H2S, WGU, ACT, ctl, sorted_w, 1024, 0}; k_gemm<PMoe1><<<dim3(8, MOE_ROWS / 128), 256, 0, stream>>>(p); }
    { PMoe2 p{ACT, WD, XL, XC, mv + 5120, ctl, sorted_tok, 512, 0}; k_gemm<PMoe2><<<dim3(8, MOE_ROWS / 128), 256, 0, stream>>>(p); }
  }
  k_final<<<512, 512, 0, stream>>>(XL, g_final);
}
```

```cpp
#include <hip/hip_runtime.h>
#include <hip/hip_cooperative_groups.h>
#include <cstdio>
#include <cstdint>
namespace cg = cooperative_groups;

typedef unsigned short bf16_t;
typedef short bf16x8 __attribute__((ext_vector_type(8)));
typedef float f32x4 __attribute__((ext_vector_type(4)));
typedef unsigned u32x4 __attribute__((ext_vector_type(4)));
typedef unsigned u32x2 __attribute__((ext_vector_type(2)));

constexpr int NB = 4, SEQ = 4096, CTXL = 256, DM = 1024, TPB = 4352, MTOK = NB * TPB;
constexpr int DIN = 2444, NPAD = 2560;
constexpr float EPS = 1e-6f;
constexpr float C2 = 0.125f * 1.4426950408889634f;
constexpr int MOE_ROWS = 23552;
constexpr int NT = 512;
constexpr int LDS_BYTES = 65536;

constexpr size_t MiB = 1u << 20;
constexpr size_t WS_CTL = 0;
constexpr size_t WS_MODV = 1 * MiB;
constexpr size_t WS_ROPE = 2 * MiB;
constexpr size_t WS_MOEM = 3 * MiB;
constexpr size_t WS_DT = 4 * MiB;
constexpr size_t WS_HKC = 5 * MiB;
constexpr size_t WS_XC = 6 * MiB;
constexpr size_t WS_WIN = 10 * MiB;
constexpr size_t WS_WOUT = 15 * MiB;
constexpr size_t WS_WGU = 17 * MiB;
constexpr size_t WS_WD = 33 * MiB;
constexpr size_t WS_HK = 41 * MiB;
constexpr size_t WS_H = 57 * MiB;
constexpr size_t WS_QK = 91 * MiB;
constexpr size_t WS_VZ = 108 * MiB;
constexpr size_t WS_XBC = 125 * MiB;
constexpr size_t WS_HY = WS_XBC + (size_t)MTOK * 768 * 2;
constexpr size_t WS_HYT = WS_HY + (size_t)MTOK * 768 * 2;
constexpr size_t WS_XBCC = WS_HYT + (size_t)MTOK * 768 * 2;
constexpr size_t WS_Y = WS_XBCC + (size_t)MTOK * 640 * 2;
constexpr size_t WS_END = WS_Y + (size_t)MTOK * 384 * 4;
constexpr size_t WS_H2S = WS_QK;
constexpr size_t WS_ACT = WS_H2S + (size_t)MOE_ROWS * 1024 * 2;
static_assert(WS_END <= 256 * MiB, "ws");
static_assert(WS_ACT + (size_t)MOE_ROWS * 512 * 2 <= WS_HYT, "moe alias");

constexpr int CT_CNT = 0, CT_FILL = 32, CT_BASE = 64, CT_NT = 96, CT_TP = 128;

__device__ __forceinline__ int opq_v(int v) { asm volatile("" : "+v"(v)); return v; }
__device__ __forceinline__ int opq_s(int v) { asm volatile("" : "+s"(v)); return v; }
#define TIDX opq_v((int)threadIdx.x)
#define BIDX opq_s((int)blockIdx.x)
__device__ __forceinline__ unsigned f2bf(float f) { unsigned u = __float_as_uint(f); return (u + 0x7fffu + ((u >> 16) & 1u)) >> 16; }
__device__ __forceinline__ float bf2f(bf16_t h) { return __uint_as_float(((unsigned)h) << 16); }
__device__ __forceinline__ float wave_sum(float v) {
#pragma unroll
  for (int o = 1; o < 64; o <<= 1) v += __shfl_xor(v, o);
  return v;
}
__device__ __forceinline__ float siluf(float v) { return v / (1.0f + __expf(-v)); }
__device__ __forceinline__ float* xrow(const float* xl, const float* xc, int r) {
  const int b = r / TPB, j = r - b * TPB;
  return (float*)(j < CTXL ? xc + ((size_t)b * CTXL + j) * DM : xl + ((size_t)b * SEQ + (j - CTXL)) * DM);
}
__device__ __forceinline__ int mrow_of(int r) { const int b = r / TPB, j = r - b * TPB; return j < CTXL ? 4 : b; }

__device__ __forceinline__ void st_adaln(const float* c, const float* c_ctx, const float* w_mod, const float* b_mod, float* modv, char* lds) {
  float (*sc)[1024] = (float (*)[1024])lds;
  float (*red)[5][64] = (float (*)[5][64])(lds + 5 * 1024 * 4);
  const int tid = TIDX;
  for (int it = BIDX; it < 192; it += gridDim.x) {
    const int layer = it / 96, n0 = (it % 96) * 64;
    for (int i = tid; i < 5 * 1024; i += NT) { const int r = i >> 10, k = i & 1023; const float v = r < 4 ? c[r * 1024 + k] : c_ctx[k]; sc[r][k] = v / (1.0f + expf(-v)); }
    __syncthreads();
    const int kg = tid >> 6, n = tid & 63;
    float acc[5] = {0.f, 0.f, 0.f, 0.f, 0.f};
    for (int k = kg; k < 1024; k += 8) { const float w = w_mod[((size_t)layer * 1024 + k) * 6144 + n0 + n];
#pragma unroll
      for (int r = 0; r < 5; ++r) acc[r] += sc[r][k] * w; }
#pragma unroll
    for (int r = 0; r < 5; ++r) red[kg][r][n] = acc[r];
    __syncthreads();
    if (tid < 320) { const int r = tid >> 6, nn = tid & 63; float s = 0.f;
#pragma unroll
      for (int g = 0; g < 8; ++g) s += red[g][r][nn];
      modv[((size_t)layer * 5 + r) * 6144 + n0 + nn] = s + b_mod[layer * 6144 + n0 + nn]; }
    __syncthreads();
  }
}
__device__ __forceinline__ void st_rope(float* rope) {
  for (int i = BIDX * NT + TIDX; i < 4096 * 32; i += gridDim.x * NT) {
    const int t = i >> 5, d = i & 31, m = d & 15;
    const float inv = powf(10000.0f, -(float)(2 * m) / 32.0f);
    const float pos = (float)(d < 16 ? (t >> 6) : (t & 63));
    const float ang = pos * inv;
    rope[2 * i] = cosf(ang); rope[2 * i + 1] = sinf(ang);
  }
}

__device__ __forceinline__ void st_normmod(const float* xl, const float* xc, const float* g, const float* modv_layer, int off_sh, int off_sc, bf16_t* H) {
  const int lane = TIDX & 63, gw = BIDX * 8 + (TIDX >> 6), ngw = gridDim.x * 8;
  for (int r = gw; r < MTOK; r += ngw) {
    const float* xr = xrow(xl, xc, r); const float* mv = modv_layer + (size_t)mrow_of(r) * 6144;
    f32x4 v[4]; float ss = 0.f;
#pragma unroll
    for (int j = 0; j < 4; ++j) { v[j] = *(const f32x4*)(xr + 4 * lane + 256 * j); ss += v[j].x * v[j].x + v[j].y * v[j].y + v[j].z * v[j].z + v[j].w * v[j].w; }
    const float rstd = rsqrtf(wave_sum(ss) * (1.0f / DM) + EPS);
#pragma unroll
    for (int j = 0; j < 4; ++j) { const int k = 4 * lane + 256 * j;
      const f32x4 gg = *(const f32x4*)(g + k), sh = *(const f32x4*)(mv + off_sh + k), sc = *(const f32x4*)(mv + off_sc + k);
      const float o0 = v[j].x * rstd * gg.x * (1.f + sc.x) + sh.x, o1 = v[j].y * rstd * gg.y * (1.f + sc.y) + sh.y;
      const float o2 = v[j].z * rstd * gg.z * (1.f + sc.z) + sh.z, o3 = v[j].w * rstd * gg.w * (1.f + sc.w) + sh.w;
      u32x2 w; w.x = f2bf(o0) | (f2bf(o1) << 16); w.y = f2bf(o2) | (f2bf(o3) << 16);
      *(u32x2*)(H + (size_t)r * DM + k) = w; }
  }
}

template <int MODE> __device__ __forceinline__ void tr_tile(const float* src, const float* src2, int ldsrc, int K, bf16_t* out, int n0, int k0, char* lds) {
  float (*tile)[65] = (float (*)[65])lds;
  const int tid = TIDX;
#pragma unroll
  for (int i = 0; i < 8; ++i) { const int kk = (tid >> 6) + 8 * i, nn = tid & 63, n = n0 + nn; float v = 0.f;
    if (MODE == 0) { const int col = n < 1676 ? n : (n < 1792 ? -1 : n - 116); if (col >= 0) v = src[(size_t)(k0 + kk) * ldsrc + col]; }
    else if (MODE == 1) { v = src[(size_t)(k0 + kk) * ldsrc + n]; }
    else { const int tb = n >> 7, q = n & 127; v = q < 64 ? src[(size_t)(k0 + kk) * ldsrc + 64 * tb + q] : src2[(size_t)(k0 + kk) * ldsrc + 64 * tb + q - 64]; }
    tile[kk][nn] = v; }
  __syncthreads();
#pragma unroll
  for (int i = 0; i < 4; ++i) { const int nn = (tid >> 5) + 16 * i, kk = (tid & 31) * 2;
    *(unsigned*)(out + (size_t)(n0 + nn) * K + k0 + kk) = f2bf(tile[kk][nn]) | (f2bf(tile[kk + 1][nn]) << 16); }
  __syncthreads();
}
__device__ __forceinline__ void st_weights(const float* w_in, const float* w_out, const float* w_gate, const float* w_up, const float* w_down, int layer,
                                           bf16_t* WIN, bf16_t* WOUT, bf16_t* WGU, bf16_t* WD, char* lds) {
  for (int it = BIDX; it < 3968; it += gridDim.x) {
    if (it < 640) tr_tile<0>(w_in + (size_t)layer * 1024 * DIN, nullptr, DIN, 1024, WIN, (it % 40) * 64, (it / 40) * 64, lds);
    else if (it < 896) { const int i2 = it - 640; tr_tile<1>(w_out + (size_t)layer * 1024 * 1024, nullptr, 1024, 1024, WOUT, (i2 & 15) * 64, (i2 >> 4) * 64, lds); }
    else if (it < 2944) { const int i2 = it - 896, e = i2 >> 7, t = i2 & 127;
      tr_tile<2>(w_gate + ((size_t)layer * 16 + e) * 1024 * 256, w_up + ((size_t)layer * 16 + e) * 1024 * 256, 256, 1024, WGU + (size_t)e * 512 * 1024, (t & 7) * 64, (t >> 3) * 64, lds); }
    else { const int i2 = it - 2944, e = i2 >> 6, t = i2 & 63;
      tr_tile<1>(w_down + ((size_t)layer * 16 + e) * 256 * 1024, nullptr, 1024, 256, WD + (size_t)e * 1024 * 256, (t & 15) * 64, (t >> 4) * 64, lds); }
  }
}

template <class P> __device__ __forceinline__ void st_gemm(const P& p, int ntm, int ntn, char* lds) {
  bf16_t (*As)[72] = (bf16_t (*)[72])lds;
  bf16_t (*Bs)[72] = (bf16_t (*)[72])(lds + 256 * 72 * 2);
  const int tid = TIDX, lane = tid & 63, w = tid >> 6;
  for (int it = BIDX; it < ntm * ntn; it += gridDim.x) {
    const int mt = it / ntn, nt = it % ntn;
    if (!p.valid(mt)) continue;
    const int m0 = mt * 256, n0 = nt * 128;
    f32x4 acc[2][8];
#pragma unroll
    for (int a = 0; a < 2; ++a)
#pragma unroll
      for (int b = 0; b < 8; ++b) acc[a][b] = (f32x4){0.f, 0.f, 0.f, 0.f};
    const int K = p.K;
    for (int k0 = 0; k0 < K; k0 += 64) {
#pragma unroll
      for (int i = 0; i < 4; ++i) { const int ch = tid + NT * i, r = ch >> 3, kc = (ch & 7) * 8;
        const bf16_t* ap = p.arow(m0 + r); *(u32x4*)&As[r][kc] = *(const u32x4*)(ap + k0 + kc); }
#pragma unroll
      for (int i = 0; i < 2; ++i) { const int ch = tid + NT * i, r = ch >> 3, kc = (ch & 7) * 8;
        const bf16_t* bp = p.brow(mt, n0 + r, k0); *(u32x4*)&Bs[r][kc] = *(const u32x4*)(bp + kc); }
      __syncthreads();
#pragma unroll
      for (int kk = 0; kk < 2; ++kk) {
        bf16x8 a[2], b[8];
#pragma unroll
        for (int mi = 0; mi < 2; ++mi) a[mi] = *(const bf16x8*)&As[32 * w + 16 * mi + (lane & 15)][kk * 32 + 8 * (lane >> 4)];
#pragma unroll
        for (int ni = 0; ni < 8; ++ni) b[ni] = *(const bf16x8*)&Bs[16 * ni + (lane & 15)][kk * 32 + 8 * (lane >> 4)];
#pragma unroll
        for (int mi = 0; mi < 2; ++mi)
#pragma unroll
          for (int ni = 0; ni < 8; ++ni) acc[mi][ni] = __builtin_amdgcn_mfma_f32_16x16x32_bf16(a[mi], b[ni], acc[mi][ni], 0, 0, 0);
      }
      __syncthreads();
    }
    p.epi(acc, mt, m0, n0, w, lane);
  }
}

struct PInProj {
  const bf16_t* H; const bf16_t* W; bf16_t *QK, *VZ, *XBC, *HY; float* DT; int K;
  __device__ bool valid(int) const { return true; }
  __device__ const bf16_t* arow(int m) const { return H + (size_t)m * DM; }
  __device__ const bf16_t* brow(int, int n, int k0) const { return W + (size_t)n * DM + k0; }
  __device__ void epi(const f32x4 (&acc)[2][8], int, int m0, int n0, int w, int lane) const {
#pragma unroll
    for (int mi = 0; mi < 2; ++mi)
#pragma unroll
      for (int ni = 0; ni < 8; ++ni)
#pragma unroll
        for (int rg = 0; rg < 4; ++rg) { const int row = m0 + 32 * w + 16 * mi + 4 * (lane >> 4) + rg, col = n0 + 16 * ni + (lane & 15); const float v = acc[mi][ni][rg];
          if (col < 512) QK[(size_t)row * 512 + col] = (bf16_t)f2bf(v);
          else if (col < 1024) VZ[(size_t)row * 512 + col - 512] = (bf16_t)f2bf(v);
          else if (col < 1792) { XBC[(size_t)row * 768 + col - 1024] = (bf16_t)f2bf(v); if (col >= 1664 && col < 1676) DT[(size_t)row * 12 + col - 1664] = v; }
          else HY[(size_t)row * 768 + col - 1792] = (bf16_t)f2bf(v); }
  }
};
struct POutProj {
  const bf16_t* A; const bf16_t* W; const float *xl_src, *xc_src; float *xl_dst, *xc_dst; const float* gate;   int skip_ctx; int K;
  __device__ bool valid(int mt) const { return !(skip_ctx && ((mt * 256) % TPB) < CTXL); }
  __device__ const bf16_t* arow(int m) const { return A + (size_t)m * DM; }
  __device__ const bf16_t* brow(int, int n, int k0) const { return W + (size_t)n * DM + k0; }
  __device__ void epi(const f32x4 (&acc)[2][8], int, int m0, int n0, int w, int lane) const {
#pragma unroll
    for (int mi = 0; mi < 2; ++mi)
#pragma unroll
      for (int rg = 0; rg < 4; ++rg) { const int row = m0 + 32 * w + 16 * mi + 4 * (lane >> 4) + rg;
        const float* xs = xrow(xl_src, xc_src, row); float* xd = xrow(xl_dst, xc_dst, row); const float* gt = gate + (size_t)mrow_of(row) * 6144;
#pragma unroll
        for (int ni = 0; ni < 8; ++ni) { const int col = n0 + 16 * ni + (lane & 15); xd[col] = xs[col] + gt[col] * acc[mi][ni][rg]; } }
  }
};
__device__ __forceinline__ void pair_experts(int pidx, int& eA, int& eB) {
  const int g = pidx / 6, t = pidx - 6 * g; const int i = t < 3 ? 0 : (t < 5 ? 1 : 2); const int j = t < 3 ? t + 1 : (t < 5 ? t - 1 : 3);
  eA = 4 * g + i; eB = 4 * g + j;
}
struct PMoe1 {
  const bf16_t* H2S; const bf16_t* WGU; bf16_t* ACT; const int* ctl; const float* sorted_w; int K;
  __device__ bool valid(int mt) const { return mt < ctl[CT_NT]; }
  __device__ const bf16_t* arow(int m) const { return H2S + (size_t)m * DM; }
  __device__ const bf16_t* brow(int mt, int n, int k0) const { int eA, eB; pair_experts(ctl[CT_TP + mt], eA, eB); const int e = n < 512 ? eA : eB;
    return WGU + ((size_t)e * 512 + (n & 511)) * DM + k0; }
  __device__ void epi(const f32x4 (&acc)[2][8], int, int m0, int n0, int w, int lane) const {
    const int half = n0 >> 9, tb = (n0 & 511) >> 7;
#pragma unroll
    for (int mi = 0; mi < 2; ++mi)
#pragma unroll
      for (int rg = 0; rg < 4; ++rg) { const int slot = m0 + 32 * w + 16 * mi + 4 * (lane >> 4) + rg; const float wt = sorted_w[2 * slot + half];
#pragma unroll
        for (int ni = 0; ni < 4; ++ni) { const float g = acc[mi][ni][rg], u = acc[mi][ni + 4][rg]; const int j = 64 * tb + 16 * ni + (lane & 15);
          ACT[(size_t)slot * 512 + half * 256 + j] = (bf16_t)f2bf(siluf(g) * u * wt); } }
  }
};
struct PMoe2 {
  const bf16_t* ACT; const bf16_t* WD; float *xl, *xc; const float* gate;   const int* ctl; const int* sorted_tok; int K;
  __device__ bool valid(int mt) const { return mt < ctl[CT_NT]; }
  __device__ const bf16_t* arow(int m) const { return ACT + (size_t)m * 512; }
  __device__ const bf16_t* brow(int mt, int n, int k0) const { int eA, eB; pair_experts(ctl[CT_TP + mt], eA, eB); const int e = k0 < 256 ? eA : eB;
    return WD + ((size_t)e * 1024 + n) * 256 + (k0 & 255); }
  __device__ void epi(const f32x4 (&acc)[2][8], int, int m0, int n0, int w, int lane) const {
#pragma unroll
    for (int mi = 0; mi < 2; ++mi)
#pragma unroll
      for (int rg = 0; rg < 4; ++rg) { const int slot = m0 + 32 * w + 16 * mi + 4 * (lane >> 4) + rg; const int r = sorted_tok[slot];
        if (r >= 0) { float* xd = xrow(xl, xc, r); const float* gt = gate + (size_t)mrow_of(r) * 6144;
#pragma unroll
          for (int ni = 0; ni < 8; ++ni) { const int col = n0 + 16 * ni + (lane & 15); xd[col] += gt[col] * acc[mi][ni][rg]; } } }
  }
};

__device__ __forceinline__ void st_prep_qk(bf16_t* QK, const float* qn, const float* kn, const float* rope) {
  const int lane = TIDX & 63, gw = BIDX * 8 + (TIDX >> 6), ngw = gridDim.x * 8;
  for (int it = gw; it < MTOK * 8; it += ngw) {
    const int r = it >> 3, hh = it & 7, j = r % TPB;
    bf16_t* p = QK + (size_t)r * 512 + hh * 64 + lane;
    const float v = bf2f(*p);
    const float ss = wave_sum(v * v);
    float y = v * rsqrtf(ss * (1.0f / 64.0f) + EPS) * (hh < 6 ? qn[lane] : kn[lane]);
    if (j >= CTXL) { const int t = j - CTXL; const float other = __shfl_xor(y, 32); const float cs = rope[(t * 32 + (lane & 31)) * 2], sn = rope[(t * 32 + (lane & 31)) * 2 + 1];
      y = lane < 32 ? y * cs - other * sn : y * cs + other * sn; }
    if (hh < 6) y *= C2;
    *p = (bf16_t)f2bf(y);
  }
}

__device__ __forceinline__ void st_prep_hy(const bf16_t* HY, const float* cw, const float* cb, bf16_t* HYT, int do_ctx, char* lds) {
  float (*tile)[65] = (float (*)[65])lds;
  const int nlat = 4 * 64 * 12, nitem = nlat + (do_ctx ? 4 * 4 * 12 : 0), tid = TIDX;
  for (int it = BIDX; it < nitem; it += gridDim.x) {
    int b, tt, ct, L, joff; bf16_t* outb;
    if (it < nlat) { b = it / 768; tt = (it % 768) / 12; ct = it % 12; L = SEQ; joff = CTXL; outb = HYT + (size_t)b * 768 * SEQ; }
    else { const int i2 = it - nlat; b = i2 / 48; tt = (i2 % 48) / 12; ct = i2 % 12; L = CTXL; joff = 0; outb = HYT + (size_t)4 * 768 * SEQ + (size_t)b * 768 * CTXL; }
    const int t0 = tt * 64, c0 = ct * 64;
    for (int e = tid; e < 66 * 64; e += NT) { const int rr = e >> 6, cc = e & 63, t = t0 - 1 + rr;
      tile[rr][cc] = (t >= 0 && t < L) ? bf2f(HY[((size_t)b * TPB + joff + t) * 768 + c0 + cc]) : 0.f; }
    __syncthreads();
    for (int e = tid; e < 64 * 64; e += NT) { const int cc = e >> 6, tl = e & 63, c = c0 + cc;
      const float v = cw[c] * tile[tl][cc] + cw[768 + c] * tile[tl + 1][cc] + cw[1536 + c] * tile[tl + 2][cc] + cb[c];
      outb[(size_t)c * L + t0 + tl] = (bf16_t)f2bf(v); }
    __syncthreads();
  }
}

template <int L> __device__ __forceinline__ void hyfilt_item(int item, const float* w1, const float* b1, const float* fr, const float* w2, const float* b2, const float* w3, float* HK, char* lds) {
  float* S0 = (float*)lds; float* S1 = S0 + 64 * 64; float* S2 = S1 + 64 * 64;
  const int tid = TIDX, n0 = item * 64, lane = tid & 63, wv = tid >> 6;
  for (int e = tid; e < 64 * 33; e += NT) { const int pp = e / 33, f = e % 33; const int n = n0 + pp; float v;
    if (f == 0) v = (float)n / (float)(L - 1);
    else { const int m = (f - 1) & 15; const float band = 1e-4f + (float)m * ((15.0f - 1e-4f) / 15.0f); const float wpos = (6.283185307179586f / (float)L) * (float)n;
      v = f <= 16 ? cosf(wpos * band) : -sinf(wpos * band); }
    S0[pp * 33 + f] = v; }
  for (int e = tid; e < 33 * 64; e += NT) S1[e] = w1[e];
  __syncthreads();
  for (int e = tid; e < 64 * 64; e += NT) { const int pp = e >> 6, j = e & 63; float a = b1[j];
    for (int f = 0; f < 33; ++f) a += S0[pp * 33 + f] * S1[f * 64 + j];
    S2[pp * 64 + j] = sinf(fr[j] * a); }
  __syncthreads();
  for (int e = tid; e < 64 * 64; e += NT) S0[e] = w2[e];
  __syncthreads();
  for (int e = tid; e < 64 * 64; e += NT) { const int pp = e >> 6, j = e & 63; float a = b2[j];
    for (int f = 0; f < 64; ++f) a += S2[pp * 64 + f] * S0[f * 64 + j];
    S1[pp * 64 + j] = sinf(fr[j] * a); }
  __syncthreads();
  for (int ch = 0; ch < 16; ++ch) {
    const int col = ch * 64 + lane; float acc[8];
#pragma unroll
    for (int i = 0; i < 8; ++i) acc[i] = 0.f;
    for (int j = 0; j < 64; ++j) { const float wv3 = w3[j * 1024 + col];
#pragma unroll
      for (int i = 0; i < 8; ++i) acc[i] += S1[(wv * 8 + i) * 64 + j] * wv3; }
    const int c = col & 255; const float delta = 3.0701134573253943f + (float)c * ((15.350567286626972f - 3.0701134573253943f) / 255.0f);
#pragma unroll
    for (int i = 0; i < 8; ++i) { const int pp = wv * 8 + i; const float t = (float)(n0 + pp) / (float)(L - 1); S2[lane * 65 + pp] = acc[i] * expf(-t * delta); }
    __syncthreads();
    const int dir = ch >> 3, order = (ch >> 2) & 1;
#pragma unroll
    for (int i = 0; i < 8; ++i) { const int cl = wv * 8 + i, c2 = (ch * 64 + cl) & 255, n = n0 + lane; const float v = S2[cl * 65 + lane];
      float* dst = HK + ((size_t)order * 256 + c2) * (2 * L);
      if (dir == 0) dst[n] = v; else if (n >= 1) dst[2 * L - n] = v;
      if (dir == 1 && n == 0) dst[L] = 0.f; }
    __syncthreads();
  }
}

template <int L> __device__ __forceinline__ void hyconv_item(int item, const bf16_t* HYT, const float* HK, const float* hy_bias, bf16_t* MIX, int joff, char* lds) {
  float* kern = (float*)lds; float* z = kern + 2 * L;
  const int tid = TIDX, b = item >> 8, c = item & 255;
  const bf16_t* vp = HYT + ((size_t)b * 768 + c) * L; const bf16_t* x1p = vp + (size_t)256 * L; const bf16_t* x2p = vp + (size_t)512 * L;
  const bool act = tid < L / 8; const int tb = 8 * tid;
  for (int o = 0; o < 2; ++o) {
    if (o == 0) for (int t = tid; t < L; t += NT) z[t] = bf2f(vp[t]);
    const float* kp = HK + ((size_t)o * 256 + c) * (2 * L);
    for (int t = tid; t < 2 * L; t += NT) kern[t] = kp[t];
    __syncthreads();
    float acc[8], W[16];
#pragma unroll
    for (int i = 0; i < 8; ++i) acc[i] = 0.f;
    if (act) {
#pragma unroll
      for (int i = 0; i < 8; ++i) W[8 + i] = kern[(tb + i) & (2 * L - 1)];
      for (int s0 = 0; s0 < L; s0 += 8) {
        const int bb = (tb - s0 - 8) & (2 * L - 1);
#pragma unroll
        for (int i = 0; i < 8; ++i) W[i] = kern[bb + i];
        float zs[8];
#pragma unroll
        for (int j = 0; j < 8; ++j) zs[j] = z[s0 + j];
#pragma unroll
        for (int j = 0; j < 8; ++j)
#pragma unroll
          for (int i = 0; i < 8; ++i) acc[i] += W[8 + i - j] * zs[j];
#pragma unroll
        for (int i = 0; i < 8; ++i) W[8 + i] = W[i];
      }
    }
    __syncthreads();
    const float bias = hy_bias[o * 256 + c];
    if (act) {
#pragma unroll
      for (int i = 0; i < 8; ++i) { const int t = tb + i; const float zz = acc[i] + bias * z[t];
        if (o == 0) z[t] = bf2f(x1p[t]) * zz;
        else MIX[((size_t)b * TPB + joff + t) * DM + 768 + c] = (bf16_t)f2bf(bf2f(x2p[t]) * zz); }
    }
    __syncthreads();
  }
}

__device__ __forceinline__ void attn_unit(int u, const bf16_t* QK, const bf16_t* VZ, bf16_t* MIX, char* lds) {
  bf16_t (*Ks)[72] = (bf16_t (*)[72])lds;
  bf16_t (*Vt)[72] = (bf16_t (*)[72])(lds + 64 * 72 * 2);
  bf16_t (*Ps)[16][72] = (bf16_t (*)[16][72])(lds + 2 * 64 * 72 * 2);
  const int tid = TIDX, lane = tid & 63, w = tid >> 6;
  int b, h, qrow0, nk;
  if (u < 768) { b = u / 192; const int rem = u % 192; h = rem >> 5; qrow0 = b * TPB + CTXL + (rem & 31) * 128; nk = TPB; }
  else { const int uc = u - 768; b = uc / 12; h = (uc % 12) >> 1; qrow0 = b * TPB + (uc & 1) * 128; nk = CTXL; }
  const int kvh = h / 3, key0 = b * TPB, l15 = lane & 15, l4 = lane >> 4;
  bf16x8 aq[2];
#pragma unroll
  for (int kk = 0; kk < 2; ++kk) aq[kk] = *(const bf16x8*)(QK + (size_t)(qrow0 + 16 * w + l15) * 512 + h * 64 + kk * 32 + 8 * l4);
  f32x4 O[4]; float m[4], l[4];
#pragma unroll
  for (int i = 0; i < 4; ++i) { O[i] = (f32x4){0.f, 0.f, 0.f, 0.f}; m[i] = -1e30f; l[i] = 0.f; }
  for (int kt = 0; kt < nk / 64; ++kt) {
    __syncthreads();
    { const int r = tid >> 3, c8 = (tid & 7) * 8; const size_t grow = (size_t)(key0 + kt * 64 + r) * 512;
      *(u32x4*)&Ks[r][c8] = *(const u32x4*)(QK + grow + 384 + kvh * 64 + c8);
      const bf16x8 vv = *(const bf16x8*)(VZ + grow + kvh * 64 + c8);
#pragma unroll
      for (int e = 0; e < 8; ++e) Vt[c8 + e][r] = (bf16_t)vv[e]; }
    __syncthreads();
    f32x4 s[4];
#pragma unroll
    for (int ni = 0; ni < 4; ++ni) s[ni] = (f32x4){0.f, 0.f, 0.f, 0.f};
#pragma unroll
    for (int kk = 0; kk < 2; ++kk)
#pragma unroll
      for (int ni = 0; ni < 4; ++ni) { const bf16x8 bk = *(const bf16x8*)&Ks[16 * ni + l15][32 * kk + 8 * l4]; s[ni] = __builtin_amdgcn_mfma_f32_16x16x32_bf16(aq[kk], bk, s[ni], 0, 0, 0); }
#pragma unroll
    for (int rg = 0; rg < 4; ++rg) {
      float mx = fmaxf(fmaxf(s[0][rg], s[1][rg]), fmaxf(s[2][rg], s[3][rg]));
      mx = fmaxf(mx, __shfl_xor(mx, 1)); mx = fmaxf(mx, __shfl_xor(mx, 2)); mx = fmaxf(mx, __shfl_xor(mx, 4)); mx = fmaxf(mx, __shfl_xor(mx, 8));
      const float mn = fmaxf(m[rg], mx), alpha = exp2f(m[rg] - mn); float rs = 0.f;
#pragma unroll
      for (int ni = 0; ni < 4; ++ni) { const float pv = exp2f(s[ni][rg] - mn); rs += pv; Ps[w][4 * l4 + rg][16 * ni + l15] = (bf16_t)f2bf(pv); }
      rs += __shfl_xor(rs, 1); rs += __shfl_xor(rs, 2); rs += __shfl_xor(rs, 4); rs += __shfl_xor(rs, 8);
      l[rg] = l[rg] * alpha + rs; m[rg] = mn;
#pragma unroll
      for (int ni = 0; ni < 4; ++ni) O[ni][rg] *= alpha;
    }
    __syncthreads();
#pragma unroll
    for (int kk = 0; kk < 2; ++kk) { const bf16x8 ap = *(const bf16x8*)&Ps[w][l15][32 * kk + 8 * l4];
#pragma unroll
      for (int ni = 0; ni < 4; ++ni) { const bf16x8 bv = *(const bf16x8*)&Vt[16 * ni + l15][32 * kk + 8 * l4]; O[ni] = __builtin_amdgcn_mfma_f32_16x16x32_bf16(ap, bv, O[ni], 0, 0, 0); } }
  }
#pragma unroll
  for (int rg = 0; rg < 4; ++rg) { const float il = 1.0f / l[rg]; const size_t row = (size_t)(qrow0 + 16 * w + 4 * l4 + rg);
#pragma unroll
    for (int ni = 0; ni < 4; ++ni) MIX[row * DM + h * 64 + 16 * ni + l15] = (bf16_t)f2bf(O[ni][rg] * il); }
  __syncthreads();
}

__device__ __forceinline__ void st_ssd_prep(const bf16_t* XBC, float* DT, const float* cw, const float* cb, const float* dt_bias, bf16_t* XBCC) {
  const size_t total = (size_t)MTOK * 640;
  for (size_t i = (size_t)BIDX * NT + TIDX; i < total; i += (size_t)gridDim.x * NT) {
    const int r = (int)(i / 640), ch = (int)(i % 640), j = r % TPB;
    const bool hasp = (j != 0 && j != CTXL), hasn = (j != CTXL - 1 && j != TPB - 1);
    float v = cw[640 + ch] * bf2f(XBC[(size_t)r * 768 + ch]) + cb[ch];
    if (hasp) v += cw[ch] * bf2f(XBC[(size_t)(r - 1) * 768 + ch]);
    if (hasn) v += cw[1280 + ch] * bf2f(XBC[(size_t)(r + 1) * 768 + ch]);
    XBCC[i] = (bf16_t)f2bf(siluf(v));
  }
  for (size_t i = (size_t)BIDX * NT + TIDX; i < (size_t)MTOK * 12; i += (size_t)gridDim.x * NT) {
    const float x = DT[i] + dt_bias[i % 12];
    DT[i] = x > 20.f ? x : log1pf(expf(x));
  }
}
__device__ __forceinline__ void ssd_scan_item(int item, const bf16_t* XBCC, const float* DT, const float* a_log, float* Y, char* lds) {
  const int half = TIDX >> 8, tid = TIDX & 255;
  float* base = (float*)(lds + half * 25088);
  float (*xs)[64] = (float (*)[64])base; float (*Bs)[64] = (float (*)[64])(base + 2048); float (*Cs)[64] = (float (*)[64])(base + 4096);
  float* dAs = base + 6144; float* dts = base + 6176;
  const int bh = 2 * item + half, b = bh / 6, h = bh % 6, g = h / 3, p = tid >> 2, q = tid & 3;
  for (int dir = 0; dir < 2; ++dir) {
    const float a = -expf(a_log[dir * 6 + h]);
    float st[16];
#pragma unroll
    for (int n = 0; n < 16; ++n) st[n] = 0.f;
    for (int ci = 0; ci < TPB / 32; ++ci) {
      for (int e = tid; e < 32 * 64; e += 256) { const int i = e >> 6, cc = e & 63, qi = ci * 32 + i;
        const int j = dir == 0 ? qi : (qi < CTXL ? CTXL - 1 - qi : TPB - 1 - (qi - CTXL)); const size_t r = (size_t)b * TPB + j;
        xs[i][cc] = bf2f(XBCC[r * 640 + h * 64 + cc]); Bs[i][cc] = bf2f(XBCC[r * 640 + 384 + g * 64 + cc]); Cs[i][cc] = bf2f(XBCC[r * 640 + 512 + g * 64 + cc]); }
      if (tid < 32) { const int qi = ci * 32 + tid; const int j = dir == 0 ? qi : (qi < CTXL ? CTXL - 1 - qi : TPB - 1 - (qi - CTXL)); const size_t r = (size_t)b * TPB + j;
        const float dt = DT[r * 12 + dir * 6 + h]; dts[tid] = dt; dAs[tid] = expf(dt * a); }
      __syncthreads();
      for (int i = 0; i < 32; ++i) {
        const float d = dAs[i], dtx = dts[i] * xs[i][p]; float y = 0.f;
#pragma unroll
        for (int n = 0; n < 16; ++n) { st[n] = st[n] * d + dtx * Bs[i][16 * q + n]; y += Cs[i][16 * q + n] * st[n]; }
        y += __shfl_xor(y, 1); y += __shfl_xor(y, 2);
        if (q == 0) { const int qi = ci * 32 + i; const int j = dir == 0 ? qi : (qi < CTXL ? CTXL - 1 - qi : TPB - 1 - (qi - CTXL)); float* yp = Y + ((size_t)b * TPB + j) * 384 + h * 64 + p;
          if (dir == 0) *yp = y; else *yp += y; }
      }
      __syncthreads();
    }
  }
}
__device__ __forceinline__ void st_ssd_out(const float* Y, const bf16_t* XBCC, const bf16_t* VZ, const float* dskip, const float* nw, bf16_t* MIX) {
  const int lane = TIDX & 63, gw = BIDX * 8 + (TIDX >> 6), ngw = gridDim.x * 8;
  for (int it = gw; it < MTOK * 2; it += ngw) {
    const int r = it >> 1, g = it & 1; float gv[3]; float ss = 0.f;
#pragma unroll
    for (int i = 0; i < 3; ++i) { const int c = g * 192 + lane + 64 * i, hh = c >> 6;
      const float y = Y[(size_t)r * 384 + c] + bf2f(XBCC[(size_t)r * 640 + c]) * dskip[hh]; const float zv = bf2f(VZ[(size_t)r * 512 + 128 + c]);
      gv[i] = y * siluf(zv); ss += gv[i] * gv[i]; }
    const float rstd = rsqrtf(wave_sum(ss) * (1.0f / 192.0f) + EPS);
#pragma unroll
    for (int i = 0; i < 3; ++i) { const int c = g * 192 + lane + 64 * i; MIX[(size_t)r * DM + 384 + c] = (bf16_t)f2bf(gv[i] * rstd * nw[c]); }
  }
}

__device__ __forceinline__ void st_router(const float* xl, const float* xc, const float* g, const float* modv_layer, const float* w_router, const float* rbias,
                                          bf16_t* H2, int* ctl, int* tok_pair, float* tok_w, int skip_ctx) {
  const int lane = TIDX & 63, gw = BIDX * 8 + (TIDX >> 6), ngw = gridDim.x * 8;
  for (int r = gw; r < MTOK; r += ngw) {
    if (skip_ctx && (r % TPB) < CTXL) continue;
    const float* xr = xrow(xl, xc, r); const float* mv = modv_layer + (size_t)mrow_of(r) * 6144;
    f32x4 v[4]; float ss = 0.f;
#pragma unroll
    for (int j = 0; j < 4; ++j) { v[j] = *(const f32x4*)(xr + 4 * lane + 256 * j); ss += v[j].x * v[j].x + v[j].y * v[j].y + v[j].z * v[j].z + v[j].w * v[j].w; }
    const float rstd = rsqrtf(wave_sum(ss) * (1.0f / DM) + EPS);
    float lg[16];
#pragma unroll
    for (int e = 0; e < 16; ++e) lg[e] = 0.f;
#pragma unroll
    for (int j = 0; j < 4; ++j) { const int k = 4 * lane + 256 * j;
      const f32x4 gg = *(const f32x4*)(g + k), sh = *(const f32x4*)(mv + 3072 + k), sc = *(const f32x4*)(mv + 4096 + k);
      float o[4]; o[0] = v[j].x * rstd * gg.x * (1.f + sc.x) + sh.x; o[1] = v[j].y * rstd * gg.y * (1.f + sc.y) + sh.y;
      o[2] = v[j].z * rstd * gg.z * (1.f + sc.z) + sh.z; o[3] = v[j].w * rstd * gg.w * (1.f + sc.w) + sh.w;
      u32x2 w; w.x = f2bf(o[0]) | (f2bf(o[1]) << 16); w.y = f2bf(o[2]) | (f2bf(o[3]) << 16);
      *(u32x2*)(H2 + (size_t)r * DM + k) = w;
#pragma unroll
      for (int q = 0; q < 4; ++q) {
#pragma unroll
        for (int e4 = 0; e4 < 4; ++e4) { const f32x4 wr = *(const f32x4*)(w_router + (size_t)(k + q) * 16 + 4 * e4);
          lg[4 * e4] += o[q] * wr.x; lg[4 * e4 + 1] += o[q] * wr.y; lg[4 * e4 + 2] += o[q] * wr.z; lg[4 * e4 + 3] += o[q] * wr.w; } } }
#pragma unroll
    for (int e = 0; e < 16; ++e) lg[e] = wave_sum(lg[e]);
    if (lane == 0) {
      int best = 0, bi1 = 0, bi2 = 1; float bestv = -1e30f, bs1 = 0.f, bs2 = 0.f;
#pragma unroll
      for (int gq = 0; gq < 4; ++gq) { float m1 = -1e30f, m2 = -1e30f, s1 = 0.f, s2 = 0.f; int i1 = 0, i2 = 0;
#pragma unroll
        for (int i = 0; i < 4; ++i) { const float scv = 1.0f / (1.0f + expf(-lg[4 * gq + i])); const float s = scv + rbias[4 * gq + i];
          if (s > m1) { m2 = m1; s2 = s1; i2 = i1; m1 = s; s1 = scv; i1 = i; } else if (s > m2) { m2 = s; s2 = scv; i2 = i; } }
        if (m1 + m2 > bestv) { bestv = m1 + m2; best = gq; bi1 = i1; bi2 = i2; bs1 = s1; bs2 = s2; } }
      const int ia = bi1 < bi2 ? bi1 : bi2, ib = bi1 < bi2 ? bi2 : bi1;
      const int tri = ia == 0 ? ib - 1 : (ia == 1 ? ib + 1 : 5);
      const int pidx = best * 6 + tri;
      const float sa = bi1 < bi2 ? bs1 : bs2, sb = bi1 < bi2 ? bs2 : bs1, inv = 1.0f / (sa + sb);
      tok_pair[r] = pidx; tok_w[2 * r] = sa * inv; tok_w[2 * r + 1] = sb * inv;
      atomicAdd(&ctl[CT_CNT + pidx], 1);
    }
  }
}
__device__ __forceinline__ void st_moe_plan(int* ctl, int* sorted_tok) {
  if (BIDX == 0 && TIDX == 0) { int base = 0, nt = 0;
    for (int p = 0; p < 24; ++p) { ctl[CT_BASE + p] = base; const int n = ctl[CT_CNT + p], tl = (n + 255) >> 8; for (int t = 0; t < tl; ++t) ctl[CT_TP + nt + t] = p; nt += tl; base += tl * 256; ctl[CT_FILL + p] = 0; }
    ctl[CT_BASE + 24] = base; ctl[CT_NT] = nt; }
  for (int i = BIDX * NT + TIDX; i < MOE_ROWS; i += gridDim.x * NT) sorted_tok[i] = -1;
}
__device__ __forceinline__ void st_moe_gather(const bf16_t* H2, bf16_t* H2S, int* ctl, const int* tok_pair, const float* tok_w, int* sorted_tok, float* sorted_w, int skip_ctx) {
  const int lane = TIDX & 63, gw = BIDX * 8 + (TIDX >> 6), ngw = gridDim.x * 8;
  for (int r = gw; r < MTOK; r += ngw) {
    if (skip_ctx && (r % TPB) < CTXL) continue;
    const int p = tok_pair[r]; int slot = 0;
    if (lane == 0) { slot = ctl[CT_BASE + p] + atomicAdd(&ctl[CT_FILL + p], 1); sorted_tok[slot] = r; sorted_w[2 * slot] = tok_w[2 * r]; sorted_w[2 * slot + 1] = tok_w[2 * r + 1]; }
    slot = __shfl(slot, 0);
    const u32x4* s = (const u32x4*)(H2 + (size_t)r * DM); u32x4* d = (u32x4*)(H2S + (size_t)slot * DM);
    d[lane] = s[lane]; d[lane + 64] = s[lane + 64];
  }
}
__device__ __forceinline__ void st_final(float* xl, const float* g) {
  const int lane = TIDX & 63, gw = BIDX * 8 + (TIDX >> 6), ngw = gridDim.x * 8;
  for (int r = gw; r < NB * SEQ; r += ngw) {
    float* xr = xl + (size_t)r * DM; f32x4 v[4]; float ss = 0.f;
#pragma unroll
    for (int j = 0; j < 4; ++j) { v[j] = *(const f32x4*)(xr + 4 * lane + 256 * j); ss += v[j].x * v[j].x + v[j].y * v[j].y + v[j].z * v[j].z + v[j].w * v[j].w; }
    const float rstd = rsqrtf(wave_sum(ss) * (1.0f / DM) + EPS);
#pragma unroll
    for (int j = 0; j < 4; ++j) { const int k = 4 * lane + 256 * j; const f32x4 gg = *(const f32x4*)(g + k);
      *(f32x4*)(xr + k) = (f32x4){v[j].x * rstd * gg.x, v[j].y * rstd * gg.y, v[j].z * rstd * gg.z, v[j].w * rstd * gg.w}; }
  }
}

struct MP { const float* in[33]; float* out; unsigned char* ws; };
typedef const float* const __attribute__((address_space(4))) * kargs_t;
#define KARGS() ({ kargs_t k_ = (kargs_t)__builtin_amdgcn_kernarg_segment_ptr(); asm volatile("" : "+s"(k_)); k_; })
#define WSP(K, off) ((unsigned char*)(K)[34] + (off))

__global__ void __launch_bounds__(NT) mega(MP P) {
  cg::grid_group grid = cg::this_grid();
  extern __shared__ __attribute__((aligned(16))) char lds[];
  {
    kargs_t K = KARGS();
    st_adaln(K[1], K[3], K[4], K[5], (float*)WSP(K, WS_MODV), lds);
    st_rope((float*)WSP(K, WS_ROPE));
  }
  grid.sync();
#pragma nounroll
  for (int layer = 0; layer < 2; ++layer) {
    const bool last = layer == 1;
    {
      kargs_t K = KARGS();
      st_weights(K[8], K[26], K[29], K[30], K[31], layer, (bf16_t*)WSP(K, WS_WIN), (bf16_t*)WSP(K, WS_WOUT), (bf16_t*)WSP(K, WS_WGU), (bf16_t*)WSP(K, WS_WD), lds);
    }
    { kargs_t K = KARGS(); const int bid = BIDX, G = gridDim.x;
      for (int it = bid; it < SEQ / 64; it += G) hyfilt_item<SEQ>(it, K[19] + layer * 33 * 64, K[20] + layer * 64, K[21] + layer * 64, K[22] + layer * 4096, K[23] + layer * 64, K[24] + (size_t)layer * 65536, (float*)WSP(K, WS_HK), lds);
      if (!last) for (int it = bid; it < CTXL / 64; it += G) hyfilt_item<CTXL>(it, K[19] + layer * 33 * 64, K[20] + layer * 64, K[21] + layer * 64, K[22] + layer * 4096, K[23] + layer * 64, K[24] + (size_t)layer * 65536, (float*)WSP(K, WS_HKC), lds);
    }
    { kargs_t K = KARGS();
      const float* xl_src = layer == 0 ? K[0] : K[33]; const float* xc_src = layer == 0 ? K[2] : (const float*)WSP(K, WS_XC);
      st_normmod(xl_src, xc_src, K[6] + layer * 1024, (const float*)WSP(K, WS_MODV) + (size_t)layer * 5 * 6144, 0, 1024, (bf16_t*)WSP(K, WS_H));
    }
    grid.sync();
    {
      kargs_t K = KARGS();
      PInProj p{(const bf16_t*)WSP(K, WS_H), (const bf16_t*)WSP(K, WS_WIN), (bf16_t*)WSP(K, WS_QK), (bf16_t*)WSP(K, WS_VZ), (bf16_t*)WSP(K, WS_XBC), (bf16_t*)WSP(K, WS_HY), (float*)WSP(K, WS_DT), 1024};
      st_gemm(p, MTOK / 256, NPAD / 128, lds);
    }
    grid.sync();
    {
      kargs_t K = KARGS();
      st_prep_qk((bf16_t*)WSP(K, WS_QK), K[9] + layer * 64, K[10] + layer * 64, (const float*)WSP(K, WS_ROPE));
    }
    { kargs_t K = KARGS();
      st_prep_hy((const bf16_t*)WSP(K, WS_HY), K[17] + layer * 3 * 768, K[18] + layer * 768, (bf16_t*)WSP(K, WS_HYT), last ? 0 : 1, lds);
    }
    { kargs_t K = KARGS();
      st_ssd_prep((const bf16_t*)WSP(K, WS_XBC), (float*)WSP(K, WS_DT), K[11] + layer * 3 * 640, K[12] + layer * 640, K[13] + layer * 12, (bf16_t*)WSP(K, WS_XBCC));
    }
    grid.sync();
    {
      kargs_t K = KARGS(); const int bid = BIDX, G = gridDim.x;
      const int n_ssd = 12, n_att = last ? 768 : 816, n_hyl = 1024, n_hyc = last ? 0 : 1024;
      const int total = n_ssd + n_att + n_hyl + n_hyc;
      for (int it = bid; it < total; it += G) {
        int i2 = it;
        if (i2 < n_ssd) { ssd_scan_item(i2, (const bf16_t*)WSP(K, WS_XBCC), (const float*)WSP(K, WS_DT), K[14] + layer * 12, (float*)WSP(K, WS_Y), lds); continue; } i2 -= n_ssd;
        if (i2 < n_att) { attn_unit(i2, (const bf16_t*)WSP(K, WS_QK), (const bf16_t*)WSP(K, WS_VZ), (bf16_t*)WSP(K, WS_H), lds); continue; } i2 -= n_att;
        if (i2 < n_hyl) { hyconv_item<SEQ>(i2, (const bf16_t*)WSP(K, WS_HYT), (const float*)WSP(K, WS_HK), K[25] + layer * 512, (bf16_t*)WSP(K, WS_H), CTXL, lds); continue; } i2 -= n_hyl;
        hyconv_item<CTXL>(i2, (const bf16_t*)WSP(K, WS_HYT) + (size_t)4 * 768 * SEQ, (const float*)WSP(K, WS_HKC), K[25] + layer * 512, (bf16_t*)WSP(K, WS_H), 0, lds);
      }
    }
    grid.sync();
    {
      kargs_t K = KARGS();
      st_ssd_out((const float*)WSP(K, WS_Y), (const bf16_t*)WSP(K, WS_XBCC), (const bf16_t*)WSP(K, WS_VZ), K[15] + layer * 6, K[16] + layer * 384, (bf16_t*)WSP(K, WS_H));
      const int t = TIDX; if (BIDX == 0 && t < 256) ((int*)WSP(K, WS_CTL))[t] = 0;
    }
    grid.sync();
    {
      kargs_t K = KARGS();
      const float* xl_src = layer == 0 ? K[0] : K[33]; const float* xc_src = layer == 0 ? K[2] : (const float*)WSP(K, WS_XC);
      POutProj p{(const bf16_t*)WSP(K, WS_H), (const bf16_t*)WSP(K, WS_WOUT), xl_src, xc_src, (float*)K[33], (float*)WSP(K, WS_XC), (const float*)WSP(K, WS_MODV) + (size_t)layer * 5 * 6144 + 2048, last ? 1 : 0, 1024};
      st_gemm(p, MTOK / 256, 8, lds);
    }
    grid.sync();
    {
      kargs_t K = KARGS();
      st_router(K[33], (const float*)WSP(K, WS_XC), K[7] + layer * 1024, (const float*)WSP(K, WS_MODV) + (size_t)layer * 5 * 6144, K[27], K[28], (bf16_t*)WSP(K, WS_H), (int*)WSP(K, WS_CTL),
                (int*)WSP(K, WS_MOEM), (float*)WSP(K, WS_MOEM + 128 * 1024), last ? 1 : 0);
    }
    grid.sync();
    { kargs_t K = KARGS(); st_moe_plan((int*)WSP(K, WS_CTL), (int*)WSP(K, WS_MOEM + 384 * 1024)); }
    grid.sync();
    { kargs_t K = KARGS();
      st_moe_gather((const bf16_t*)WSP(K, WS_H), (bf16_t*)WSP(K, WS_H2S), (int*)WSP(K, WS_CTL), (const int*)WSP(K, WS_MOEM), (const float*)WSP(K, WS_MOEM + 128 * 1024),
                    (int*)WSP(K, WS_MOEM + 384 * 1024), (float*)WSP(K, WS_MOEM + 512 * 1024), last ? 1 : 0);
    }
    grid.sync();
    { kargs_t K = KARGS();
      PMoe1 p{(const bf16_t*)WSP(K, WS_H2S), (const bf16_t*)WSP(K, WS_WGU), (bf16_t*)WSP(K, WS_ACT), (const int*)WSP(K, WS_CTL), (const float*)WSP(K, WS_MOEM + 512 * 1024), 1024};
      st_gemm(p, MOE_ROWS / 256, 8, lds);
    }
    grid.sync();
    { kargs_t K = KARGS();
      PMoe2 p{(const bf16_t*)WSP(K, WS_ACT), (const bf16_t*)WSP(K, WS_WD), (float*)K[33], (float*)WSP(K, WS_XC), (const float*)WSP(K, WS_MODV) + (size_t)layer * 5 * 6144 + 5120, (const int*)WSP(K, WS_CTL),
              (const int*)WSP(K, WS_MOEM + 384 * 1024), 512};
      st_gemm(p, MOE_ROWS / 256, 8, lds);
    }
    grid.sync();
  }
  { kargs_t K = KARGS(); st_final((float*)K[33], K[32]); }
}

extern "C" void kernel_launch(void* const* d_in, const int* in_sizes, int n_in, void* d_out, int out_size, void* d_ws, size_t ws_size, hipStream_t stream) {
  if (n_in != 33 || ws_size < WS_END) { fprintf(stderr, "kernel_launch: unexpected n_in %d / ws %zu\n", n_in, ws_size); return; }
  static int grid_blocks = 0;
  if (!grid_blocks) {
    int dev = 0, cus = 0, per_cu = 0;
    (void)hipGetDevice(&dev);
    (void)hipDeviceGetAttribute(&cus, hipDeviceAttributeMultiprocessorCount, dev);
    (void)hipFuncSetAttribute((const void*)mega, hipFuncAttributeMaxDynamicSharedMemorySize, LDS_BYTES);
    (void)hipOccupancyMaxActiveBlocksPerMultiprocessor(&per_cu, mega, NT, LDS_BYTES);
    if (per_cu < 1) per_cu = 1;
    if (per_cu > 2) per_cu = 2;
    grid_blocks = cus * per_cu;
  }
  MP p{};
  for (int i = 0; i < 33; ++i) p.in[i] = (const float*)d_in[i];
  p.out = (float*)d_out; p.ws = (unsigned char*)d_ws;
  void* args[] = {&p};
  hipError_t e = hipLaunchCooperativeKernel((const void*)mega, dim3(grid_blocks), dim3(NT), args, LDS_BYTES, stream);
  if (e != hipSuccess) fprintf(stderr, "cooperative launch failed: %s (grid %d)\n", hipGetErrorString(e), grid_blocks);
}
```

```cpp
#include <hip/hip_runtime.h>
#include <hip/hip_cooperative_groups.h>
#include <cstdio>
#include <cstdint>
namespace cg = cooperative_groups;

typedef unsigned short bf16_t;
typedef short bf16x8 __attribute__((ext_vector_type(8)));
typedef float f32x4 __attribute__((ext_vector_type(4)));
typedef unsigned u32x4 __attribute__((ext_vector_type(4)));
typedef unsigned u32x2 __attribute__((ext_vector_type(2)));

constexpr int NB = 4, SEQ = 4096, CTXL = 256, DM = 1024, TPB = 4352, MTOK = NB * TPB;
constexpr int DIN = 2444, NPAD = 2560;
constexpr float EPS = 1e-6f;
constexpr float C2 = 0.125f * 1.4426950408889634f;
constexpr int MOE_ROWS = 23552;
constexpr int NT = 512;
constexpr int LDS_BYTES = 147456;

constexpr size_t MiB = 1u << 20;
constexpr size_t WS_CTL = 0;
constexpr size_t WS_MODV = 1 * MiB;
constexpr size_t WS_ROPE = 2 * MiB;
constexpr size_t WS_MOEM = 3 * MiB;
constexpr size_t WS_DT = 4 * MiB;
constexpr size_t WS_HKC = 5 * MiB;
constexpr size_t WS_XC = 6 * MiB;
constexpr size_t WS_WIN = 10 * MiB;
constexpr size_t WS_WOUT = 15 * MiB;
constexpr size_t WS_WGU = 17 * MiB;
constexpr size_t WS_WD = 33 * MiB;
constexpr size_t WS_HK = 41 * MiB;
constexpr size_t WS_H = 57 * MiB;
constexpr size_t WS_QK = 91 * MiB;
constexpr size_t WS_VZ = 108 * MiB;
constexpr size_t WS_XBC = 125 * MiB;
constexpr size_t WS_HY = WS_XBC + (size_t)MTOK * 768 * 2;
constexpr size_t WS_HYT = WS_HY + (size_t)MTOK * 768 * 2;
constexpr size_t WS_ST = WS_HYT + (size_t)MTOK * 768 * 2;
constexpr size_t WS_Y = WS_ST + (size_t)4 * 34 * 2 * 6 * 4096 * 4;
constexpr size_t WS_END = WS_Y + (size_t)MTOK * 384 * 4;
constexpr size_t WS_DEC = WS_DT + 900 * 1024;
constexpr size_t WS_H2S = WS_QK;
constexpr size_t WS_ACT = WS_H2S + (size_t)MOE_ROWS * 1024 * 2;
static_assert(WS_END <= 256 * MiB, "ws");
static_assert(WS_ACT + (size_t)MOE_ROWS * 512 * 2 <= WS_HYT, "moe alias");

constexpr int CT_CNT = 0, CT_FILL = 32, CT_BASE = 64, CT_NT = 96, CT_TP = 128;

__device__ __forceinline__ int opq_v(int v) { asm volatile("" : "+v"(v)); return v; }
__device__ __forceinline__ int opq_s(int v) { asm volatile("" : "+s"(v)); return v; }
#define TIDX opq_v((int)threadIdx.x)
#define BIDX opq_s((int)blockIdx.x)
__device__ __forceinline__ unsigned f2bf(float f) { unsigned u = __float_as_uint(f); return (u + 0x7fffu + ((u >> 16) & 1u)) >> 16; }
__device__ __forceinline__ float bf2f(bf16_t h) { return __uint_as_float(((unsigned)h) << 16); }
__device__ __forceinline__ float wave_sum(float v) {
#pragma unroll
  for (int o = 1; o < 64; o <<= 1) v += __shfl_xor(v, o);
  return v;
}
__device__ __forceinline__ float siluf(float v) { return v / (1.0f + __expf(-v)); }
__device__ __forceinline__ float* xrow(const float* xl, const float* xc, int r) {
  const int b = r / TPB, j = r - b * TPB;
  return (float*)(j < CTXL ? xc + ((size_t)b * CTXL + j) * DM : xl + ((size_t)b * SEQ + (j - CTXL)) * DM);
}
__device__ __forceinline__ int mrow_of(int r) { const int b = r / TPB, j = r - b * TPB; return j < CTXL ? 4 : b; }

__device__ __forceinline__ void st_adaln(const float* c, const float* c_ctx, const float* w_mod, const float* b_mod, float* modv, char* lds) {
  float (*sc)[1024] = (float (*)[1024])lds;
  float (*red)[5][64] = (float (*)[5][64])(lds + 5 * 1024 * 4);
  const int tid = TIDX;
  for (int it = BIDX; it < 192; it += gridDim.x) {
    const int layer = it / 96, n0 = (it % 96) * 64;
    for (int i = tid; i < 5 * 1024; i += NT) { const int r = i >> 10, k = i & 1023; const float v = r < 4 ? c[r * 1024 + k] : c_ctx[k]; sc[r][k] = v / (1.0f + expf(-v)); }
    __syncthreads();
    const int kg = tid >> 6, n = tid & 63;
    float acc[5] = {0.f, 0.f, 0.f, 0.f, 0.f};
    for (int k = kg; k < 1024; k += 8) { const float w = w_mod[((size_t)layer * 1024 + k) * 6144 + n0 + n];
#pragma unroll
      for (int r = 0; r < 5; ++r) acc[r] += sc[r][k] * w; }
#pragma unroll
    for (int r = 0; r < 5; ++r) red[kg][r][n] = acc[r];
    __syncthreads();
    if (tid < 320) { const int r = tid >> 6, nn = tid & 63; float s = 0.f;
#pragma unroll
      for (int g = 0; g < 8; ++g) s += red[g][r][nn];
      modv[((size_t)layer * 5 + r) * 6144 + n0 + nn] = s + b_mod[layer * 6144 + n0 + nn]; }
    __syncthreads();
  }
}
__device__ __forceinline__ void st_rope(float* rope) {
  for (int i = BIDX * NT + TIDX; i < 4096 * 32; i += gridDim.x * NT) {
    const int t = i >> 5, d = i & 31, m = d & 15;
    const float inv = powf(10000.0f, -(float)(2 * m) / 32.0f);
    const float pos = (float)(d < 16 ? (t >> 6) : (t & 63));
    const float ang = pos * inv;
    rope[2 * i] = cosf(ang); rope[2 * i + 1] = sinf(ang);
  }
}

__device__ __forceinline__ void st_normmod(const float* xl, const float* xc, const float* g, const float* modv_layer, int off_sh, int off_sc, bf16_t* H) {
  const int lane = TIDX & 63, gw = BIDX * 8 + (TIDX >> 6), ngw = gridDim.x * 8;
  for (int r = gw; r < MTOK; r += ngw) {
    const float* xr = xrow(xl, xc, r); const float* mv = modv_layer + (size_t)mrow_of(r) * 6144;
    f32x4 v[4]; float ss = 0.f;
#pragma unroll
    for (int j = 0; j < 4; ++j) { v[j] = *(const f32x4*)(xr + 4 * lane + 256 * j); ss += v[j].x * v[j].x + v[j].y * v[j].y + v[j].z * v[j].z + v[j].w * v[j].w; }
    const float rstd = rsqrtf(wave_sum(ss) * (1.0f / DM) + EPS);
#pragma unroll
    for (int j = 0; j < 4; ++j) { const int k = 4 * lane + 256 * j;
      const f32x4 gg = *(const f32x4*)(g + k), sh = *(const f32x4*)(mv + off_sh + k), sc = *(const f32x4*)(mv + off_sc + k);
      const float o0 = v[j].x * rstd * gg.x * (1.f + sc.x) + sh.x, o1 = v[j].y * rstd * gg.y * (1.f + sc.y) + sh.y;
      const float o2 = v[j].z * rstd * gg.z * (1.f + sc.z) + sh.z, o3 = v[j].w * rstd * gg.w * (1.f + sc.w) + sh.w;
      u32x2 w; w.x = f2bf(o0) | (f2bf(o1) << 16); w.y = f2bf(o2) | (f2bf(o3) << 16);
      *(u32x2*)(H + (size_t)r * DM + k) = w; }
  }
}

template <int MODE> __device__ __forceinline__ void tr_tile(const float* src, const float* src2, int ldsrc, int K, bf16_t* out, int n0, int k0, char* lds) {
  float (*tile)[65] = (float (*)[65])lds;
  const int tid = TIDX;
#pragma unroll
  for (int i = 0; i < 8; ++i) { const int kk = (tid >> 6) + 8 * i, nn = tid & 63, n = n0 + nn; float v = 0.f;
    if (MODE == 0) { const int col = n < 1676 ? n : (n < 1792 ? -1 : n - 116); if (col >= 0) v = src[(size_t)(k0 + kk) * ldsrc + col]; }
    else if (MODE == 1) { v = src[(size_t)(k0 + kk) * ldsrc + n]; }
    else { const int tb = n >> 7, q = n & 127; v = q < 64 ? src[(size_t)(k0 + kk) * ldsrc + 64 * tb + q] : src2[(size_t)(k0 + kk) * ldsrc + 64 * tb + q - 64]; }
    tile[kk][nn] = v; }
  __syncthreads();
#pragma unroll
  for (int i = 0; i < 4; ++i) { const int nn = (tid >> 5) + 16 * i, kk = (tid & 31) * 2;
    *(unsigned*)(out + (size_t)(n0 + nn) * K + k0 + kk) = f2bf(tile[kk][nn]) | (f2bf(tile[kk + 1][nn]) << 16); }
  __syncthreads();
}
__device__ __forceinline__ void st_weights(const float* w_in, const float* w_out, const float* w_gate, const float* w_up, const float* w_down, int layer,
                                           bf16_t* WIN, bf16_t* WOUT, bf16_t* WGU, bf16_t* WD, char* lds) {
  for (int it = BIDX; it < 3968; it += gridDim.x) {
    if (it < 640) tr_tile<0>(w_in + (size_t)layer * 1024 * DIN, nullptr, DIN, 1024, WIN, (it % 40) * 64, (it / 40) * 64, lds);
    else if (it < 896) { const int i2 = it - 640; tr_tile<1>(w_out + (size_t)layer * 1024 * 1024, nullptr, 1024, 1024, WOUT, (i2 & 15) * 64, (i2 >> 4) * 64, lds); }
    else if (it < 2944) { const int i2 = it - 896, e = i2 >> 7, t = i2 & 127;
      tr_tile<2>(w_gate + ((size_t)layer * 16 + e) * 1024 * 256, w_up + ((size_t)layer * 16 + e) * 1024 * 256, 256, 1024, WGU + (size_t)e * 512 * 1024, (t & 7) * 64, (t >> 3) * 64, lds); }
    else { const int i2 = it - 2944, e = i2 >> 6, t = i2 & 63;
      tr_tile<1>(w_down + ((size_t)layer * 16 + e) * 256 * 1024, nullptr, 1024, 256, WD + (size_t)e * 1024 * 256, (t & 15) * 64, (t >> 4) * 64, lds); }
  }
}

template <class P> __device__ __forceinline__ void st_gemm(const P& p, int ntm, int ntn, char* lds) {
  bf16_t (*As)[72] = (bf16_t (*)[72])lds;
  bf16_t (*Bs)[72] = (bf16_t (*)[72])(lds + 256 * 72 * 2);
  const int tid = TIDX, lane = tid & 63, w = tid >> 6;
  for (int it = BIDX; it < ntm * ntn; it += gridDim.x) {
    const int mt = it / ntn, nt = it % ntn;
    if (!p.valid(mt)) continue;
    const int m0 = mt * 256, n0 = nt * 128;
    f32x4 acc[2][8];
#pragma unroll
    for (int a = 0; a < 2; ++a)
#pragma unroll
      for (int b = 0; b < 8; ++b) acc[a][b] = (f32x4){0.f, 0.f, 0.f, 0.f};
    const int K = p.K;
    for (int k0 = 0; k0 < K; k0 += 64) {
#pragma unroll
      for (int i = 0; i < 4; ++i) { const int ch = tid + NT * i, r = ch >> 3, kc = (ch & 7) * 8;
        const bf16_t* ap = p.arow(m0 + r); *(u32x4*)&As[r][kc] = *(const u32x4*)(ap + k0 + kc); }
#pragma unroll
      for (int i = 0; i < 2; ++i) { const int ch = tid + NT * i, r = ch >> 3, kc = (ch & 7) * 8;
        const bf16_t* bp = p.brow(mt, n0 + r, k0); *(u32x4*)&Bs[r][kc] = *(const u32x4*)(bp + kc); }
      __syncthreads();
#pragma unroll
      for (int kk = 0; kk < 2; ++kk) {
        bf16x8 a[2], b[8];
#pragma unroll
        for (int mi = 0; mi < 2; ++mi) a[mi] = *(const bf16x8*)&As[32 * w + 16 * mi + (lane & 15)][kk * 32 + 8 * (lane >> 4)];
#pragma unroll
        for (int ni = 0; ni < 8; ++ni) b[ni] = *(const bf16x8*)&Bs[16 * ni + (lane & 15)][kk * 32 + 8 * (lane >> 4)];
#pragma unroll
        for (int mi = 0; mi < 2; ++mi)
#pragma unroll
          for (int ni = 0; ni < 8; ++ni) acc[mi][ni] = __builtin_amdgcn_mfma_f32_16x16x32_bf16(a[mi], b[ni], acc[mi][ni], 0, 0, 0);
      }
      __syncthreads();
    }
    p.epi(acc, mt, m0, n0, w, lane);
  }
}

struct PInProj {
  const bf16_t* H; const bf16_t* W; bf16_t *QK, *VZ, *XBC, *HY; float* DT; int K;
  __device__ bool valid(int) const { return true; }
  __device__ const bf16_t* arow(int m) const { return H + (size_t)m * DM; }
  __device__ const bf16_t* brow(int, int n, int k0) const { return W + (size_t)n * DM + k0; }
  __device__ void epi(const f32x4 (&acc)[2][8], int, int m0, int n0, int w, int lane) const {
#pragma unroll
    for (int mi = 0; mi < 2; ++mi)
#pragma unroll
      for (int ni = 0; ni < 8; ++ni)
#pragma unroll
        for (int rg = 0; rg < 4; ++rg) { const int row = m0 + 32 * w + 16 * mi + 4 * (lane >> 4) + rg, col = n0 + 16 * ni + (lane & 15); const float v = acc[mi][ni][rg];
          if (col < 512) QK[(size_t)row * 512 + col] = (bf16_t)f2bf(v);
          else if (col < 1024) VZ[(size_t)row * 512 + col - 512] = (bf16_t)f2bf(v);
          else if (col < 1792) { XBC[(size_t)row * 768 + col - 1024] = (bf16_t)f2bf(v); if (col >= 1664 && col < 1676) DT[(size_t)row * 12 + col - 1664] = v; }
          else HY[(size_t)row * 768 + col - 1792] = (bf16_t)f2bf(v); }
  }
};
struct POutProj {
  const bf16_t* A; const bf16_t* W; const float *xl_src, *xc_src; float *xl_dst, *xc_dst; const float* gate;   int skip_ctx; int K;
  __device__ bool valid(int mt) const { return !(skip_ctx && ((mt * 256) % TPB) < CTXL); }
  __device__ const bf16_t* arow(int m) const { return A + (size_t)m * DM; }
  __device__ const bf16_t* brow(int, int n, int k0) const { return W + (size_t)n * DM + k0; }
  __device__ void epi(const f32x4 (&acc)[2][8], int, int m0, int n0, int w, int lane) const {
#pragma unroll
    for (int mi = 0; mi < 2; ++mi)
#pragma unroll
      for (int rg = 0; rg < 4; ++rg) { const int row = m0 + 32 * w + 16 * mi + 4 * (lane >> 4) + rg;
        const float* xs = xrow(xl_src, xc_src, row); float* xd = xrow(xl_dst, xc_dst, row); const float* gt = gate + (size_t)mrow_of(row) * 6144;
#pragma unroll
        for (int ni = 0; ni < 8; ++ni) { const int col = n0 + 16 * ni + (lane & 15); xd[col] = xs[col] + gt[col] * acc[mi][ni][rg]; } }
  }
};
__device__ __forceinline__ void pair_experts(int pidx, int& eA, int& eB) {
  const int g = pidx / 6, t = pidx - 6 * g; const int i = t < 3 ? 0 : (t < 5 ? 1 : 2); const int j = t < 3 ? t + 1 : (t < 5 ? t - 1 : 3);
  eA = 4 * g + i; eB = 4 * g + j;
}
struct PMoe1 {
  const bf16_t* H2S; const bf16_t* WGU; bf16_t* ACT; const int* ctl; const float* sorted_w; int K;
  __device__ bool valid(int mt) const { return mt < ctl[CT_NT]; }
  __device__ const bf16_t* arow(int m) const { return H2S + (size_t)m * DM; }
  __device__ const bf16_t* brow(int mt, int n, int k0) const { int eA, eB; pair_experts(ctl[CT_TP + mt], eA, eB); const int e = n < 512 ? eA : eB;
    return WGU + ((size_t)e * 512 + (n & 511)) * DM + k0; }
  __device__ void epi(const f32x4 (&acc)[2][8], int, int m0, int n0, int w, int lane) const {
    const int half = n0 >> 9, tb = (n0 & 511) >> 7;
#pragma unroll
    for (int mi = 0; mi < 2; ++mi)
#pragma unroll
      for (int rg = 0; rg < 4; ++rg) { const int slot = m0 + 32 * w + 16 * mi + 4 * (lane >> 4) + rg; const float wt = sorted_w[2 * slot + half];
#pragma unroll
        for (int ni = 0; ni < 4; ++ni) { const float g = acc[mi][ni][rg], u = acc[mi][ni + 4][rg]; const int j = 64 * tb + 16 * ni + (lane & 15);
          ACT[(size_t)slot * 512 + half * 256 + j] = (bf16_t)f2bf(siluf(g) * u * wt); } }
  }
};
struct PMoe2 {
  const bf16_t* ACT; const bf16_t* WD; float *xl, *xc; const float* gate;   const int* ctl; const int* sorted_tok; int K;
  __device__ bool valid(int mt) const { return mt < ctl[CT_NT]; }
  __device__ const bf16_t* arow(int m) const { return ACT + (size_t)m * 512; }
  __device__ const bf16_t* brow(int mt, int n, int k0) const { int eA, eB; pair_experts(ctl[CT_TP + mt], eA, eB); const int e = k0 < 256 ? eA : eB;
    return WD + ((size_t)e * 1024 + n) * 256 + (k0 & 255); }
  __device__ void epi(const f32x4 (&acc)[2][8], int, int m0, int n0, int w, int lane) const {
#pragma unroll
    for (int mi = 0; mi < 2; ++mi)
#pragma unroll
      for (int rg = 0; rg < 4; ++rg) { const int slot = m0 + 32 * w + 16 * mi + 4 * (lane >> 4) + rg; const int r = sorted_tok[slot];
        if (r >= 0) { float* xd = xrow(xl, xc, r); const float* gt = gate + (size_t)mrow_of(r) * 6144;
#pragma unroll
          for (int ni = 0; ni < 8; ++ni) { const int col = n0 + 16 * ni + (lane & 15); xd[col] += gt[col] * acc[mi][ni][rg]; } } }
  }
};

__device__ __forceinline__ void st_prep_qk(bf16_t* QK, const float* qn, const float* kn, const float* rope) {
  const int lane = TIDX & 63, gw = BIDX * 8 + (TIDX >> 6), ngw = gridDim.x * 8;
  for (int it = gw; it < MTOK * 8; it += ngw) {
    const int r = it >> 3, hh = it & 7, j = r % TPB;
    bf16_t* p = QK + (size_t)r * 512 + hh * 64 + lane;
    const float v = bf2f(*p);
    const float ss = wave_sum(v * v);
    float y = v * rsqrtf(ss * (1.0f / 64.0f) + EPS) * (hh < 6 ? qn[lane] : kn[lane]);
    if (j >= CTXL) { const int t = j - CTXL; const float other = __shfl_xor(y, 32); const float cs = rope[(t * 32 + (lane & 31)) * 2], sn = rope[(t * 32 + (lane & 31)) * 2 + 1];
      y = lane < 32 ? y * cs - other * sn : y * cs + other * sn; }
    if (hh < 6) y *= C2;
    *p = (bf16_t)f2bf(y);
  }
}

__device__ __forceinline__ void st_prep_hy(const bf16_t* HY, const float* cw, const float* cb, bf16_t* HYT, int do_ctx, char* lds) {
  float (*tile)[65] = (float (*)[65])lds;
  const int nlat = 4 * 64 * 12, nitem = nlat + (do_ctx ? 4 * 4 * 12 : 0), tid = TIDX;
  for (int it = BIDX; it < nitem; it += gridDim.x) {
    int b, tt, ct, L, joff; bf16_t* outb;
    if (it < nlat) { b = it / 768; tt = (it % 768) / 12; ct = it % 12; L = SEQ; joff = CTXL; outb = HYT + (size_t)b * 768 * SEQ; }
    else { const int i2 = it - nlat; b = i2 / 48; tt = (i2 % 48) / 12; ct = i2 % 12; L = CTXL; joff = 0; outb = HYT + (size_t)4 * 768 * SEQ + (size_t)b * 768 * CTXL; }
    const int t0 = tt * 64, c0 = ct * 64;
    for (int e = tid; e < 66 * 64; e += NT) { const int rr = e >> 6, cc = e & 63, t = t0 - 1 + rr;
      tile[rr][cc] = (t >= 0 && t < L) ? bf2f(HY[((size_t)b * TPB + joff + t) * 768 + c0 + cc]) : 0.f; }
    __syncthreads();
    for (int e = tid; e < 64 * 64; e += NT) { const int cc = e >> 6, tl = e & 63, c = c0 + cc;
      const float v = cw[c] * tile[tl][cc] + cw[768 + c] * tile[tl + 1][cc] + cw[1536 + c] * tile[tl + 2][cc] + cb[c];
      outb[(size_t)c * L + t0 + tl] = (bf16_t)f2bf(v); }
    __syncthreads();
  }
}

template <int L> __device__ __forceinline__ void hyfilt_item(int item, const float* w1, const float* b1, const float* fr, const float* w2, const float* b2, const float* w3, float* HK, char* lds) {
  float* S0 = (float*)lds; float* S1 = S0 + 64 * 64; float* S2 = S1 + 64 * 64;
  const int tid = TIDX, n0 = item * 64, lane = tid & 63, wv = tid >> 6;
  for (int e = tid; e < 64 * 33; e += NT) { const int pp = e / 33, f = e % 33; const int n = n0 + pp; float v;
    if (f == 0) v = (float)n / (float)(L - 1);
    else { const int m = (f - 1) & 15; const float band = 1e-4f + (float)m * ((15.0f - 1e-4f) / 15.0f); const float wpos = (6.283185307179586f / (float)L) * (float)n;
      v = f <= 16 ? cosf(wpos * band) : -sinf(wpos * band); }
    S0[pp * 33 + f] = v; }
  for (int e = tid; e < 33 * 64; e += NT) S1[e] = w1[e];
  __syncthreads();
  for (int e = tid; e < 64 * 64; e += NT) { const int pp = e >> 6, j = e & 63; float a = b1[j];
    for (int f = 0; f < 33; ++f) a += S0[pp * 33 + f] * S1[f * 64 + j];
    S2[pp * 64 + j] = sinf(fr[j] * a); }
  __syncthreads();
  for (int e = tid; e < 64 * 64; e += NT) S0[e] = w2[e];
  __syncthreads();
  for (int e = tid; e < 64 * 64; e += NT) { const int pp = e >> 6, j = e & 63; float a = b2[j];
    for (int f = 0; f < 64; ++f) a += S2[pp * 64 + f] * S0[f * 64 + j];
    S1[pp * 64 + j] = sinf(fr[j] * a); }
  __syncthreads();
  for (int ch = 0; ch < 16; ++ch) {
    const int col = ch * 64 + lane; float acc[8];
#pragma unroll
    for (int i = 0; i < 8; ++i) acc[i] = 0.f;
    for (int j = 0; j < 64; ++j) { const float wv3 = w3[j * 1024 + col];
#pragma unroll
      for (int i = 0; i < 8; ++i) acc[i] += S1[(wv * 8 + i) * 64 + j] * wv3; }
    const int c = col & 255; const float delta = 3.0701134573253943f + (float)c * ((15.350567286626972f - 3.0701134573253943f) / 255.0f);
#pragma unroll
    for (int i = 0; i < 8; ++i) { const int pp = wv * 8 + i; const float t = (float)(n0 + pp) / (float)(L - 1); S2[lane * 65 + pp] = acc[i] * expf(-t * delta); }
    __syncthreads();
    const int dir = ch >> 3, order = (ch >> 2) & 1;
#pragma unroll
    for (int i = 0; i < 8; ++i) { const int cl = wv * 8 + i, c2 = (ch * 64 + cl) & 255, n = n0 + lane; const float v = S2[cl * 65 + lane];
      float* dst = HK + ((size_t)order * 256 + c2) * (2 * L);
      if (dir == 0) dst[n] = v; else if (n >= 1) dst[2 * L - n] = v;
      if (dir == 1 && n == 0) dst[L] = 0.f; }
    __syncthreads();
  }
}

template <int L> __device__ __forceinline__ void hyconv_item(int item, const bf16_t* HYT, const float* HK, const float* hy_bias, bf16_t* MIX, int joff, char* lds) {
  float* kern = (float*)lds; float* z = kern + 2 * L;
  const int tid = TIDX, b = item >> 8, c = item & 255;
  const bf16_t* vp = HYT + ((size_t)b * 768 + c) * L; const bf16_t* x1p = vp + (size_t)256 * L; const bf16_t* x2p = vp + (size_t)512 * L;
  const bool act = tid < L / 8; const int tb = 8 * tid;
  for (int o = 0; o < 2; ++o) {
    if (o == 0) for (int t = tid; t < L; t += NT) z[t] = bf2f(vp[t]);
    const float* kp = HK + ((size_t)o * 256 + c) * (2 * L);
    for (int t = tid; t < 2 * L; t += NT) kern[t] = kp[t];
    __syncthreads();
    float acc[8], W[16];
#pragma unroll
    for (int i = 0; i < 8; ++i) acc[i] = 0.f;
    if (act) {
#pragma unroll
      for (int i = 0; i < 8; ++i) W[8 + i] = kern[(tb + i) & (2 * L - 1)];
      for (int s0 = 0; s0 < L; s0 += 8) {
        const int bb = (tb - s0 - 8) & (2 * L - 1);
#pragma unroll
        for (int i = 0; i < 8; ++i) W[i] = kern[bb + i];
        float zs[8];
#pragma unroll
        for (int j = 0; j < 8; ++j) zs[j] = z[s0 + j];
#pragma unroll
        for (int j = 0; j < 8; ++j)
#pragma unroll
          for (int i = 0; i < 8; ++i) acc[i] += W[8 + i - j] * zs[j];
#pragma unroll
        for (int i = 0; i < 8; ++i) W[8 + i] = W[i];
      }
    }
    __syncthreads();
    const float bias = hy_bias[o * 256 + c];
    if (act) {
#pragma unroll
      for (int i = 0; i < 8; ++i) { const int t = tb + i; const float zz = acc[i] + bias * z[t];
        if (o == 0) z[t] = bf2f(x1p[t]) * zz;
        else MIX[((size_t)b * TPB + joff + t) * DM + 768 + c] = (bf16_t)f2bf(bf2f(x2p[t]) * zz); }
    }
    __syncthreads();
  }
}

__device__ __forceinline__ void attn_unit_simple(int u, const bf16_t* QK, const bf16_t* VZ, bf16_t* MIX, char* lds) {
  bf16_t (*Ks)[72] = (bf16_t (*)[72])lds;
  bf16_t (*Vt)[72] = (bf16_t (*)[72])(lds + 64 * 72 * 2);
  bf16_t (*Ps)[16][72] = (bf16_t (*)[16][72])(lds + 2 * 64 * 72 * 2);
  const int tid = TIDX, lane = tid & 63, w = tid >> 6;
  int b, h, qrow0, nk;
  if (u < 768) { b = u / 192; const int rem = u % 192; h = rem >> 5; qrow0 = b * TPB + CTXL + (rem & 31) * 128; nk = TPB; }
  else { const int uc = u - 768; b = uc / 12; h = (uc % 12) >> 1; qrow0 = b * TPB + (uc & 1) * 128; nk = CTXL; }
  const int kvh = h / 3, key0 = b * TPB, l15 = lane & 15, l4 = lane >> 4;
  bf16x8 aq[2];
#pragma unroll
  for (int kk = 0; kk < 2; ++kk) aq[kk] = *(const bf16x8*)(QK + (size_t)(qrow0 + 16 * w + l15) * 512 + h * 64 + kk * 32 + 8 * l4);
  f32x4 O[4]; float m[4], l[4];
#pragma unroll
  for (int i = 0; i < 4; ++i) { O[i] = (f32x4){0.f, 0.f, 0.f, 0.f}; m[i] = -1e30f; l[i] = 0.f; }
  for (int kt = 0; kt < nk / 64; ++kt) {
    __syncthreads();
    { const int r = tid >> 3, c8 = (tid & 7) * 8; const size_t grow = (size_t)(key0 + kt * 64 + r) * 512;
      *(u32x4*)&Ks[r][c8] = *(const u32x4*)(QK + grow + 384 + kvh * 64 + c8);
      const bf16x8 vv = *(const bf16x8*)(VZ + grow + kvh * 64 + c8);
#pragma unroll
      for (int e = 0; e < 8; ++e) Vt[c8 + e][r] = (bf16_t)vv[e]; }
    __syncthreads();
    f32x4 s[4];
#pragma unroll
    for (int ni = 0; ni < 4; ++ni) s[ni] = (f32x4){0.f, 0.f, 0.f, 0.f};
#pragma unroll
    for (int kk = 0; kk < 2; ++kk)
#pragma unroll
      for (int ni = 0; ni < 4; ++ni) { const bf16x8 bk = *(const bf16x8*)&Ks[16 * ni + l15][32 * kk + 8 * l4]; s[ni] = __builtin_amdgcn_mfma_f32_16x16x32_bf16(aq[kk], bk, s[ni], 0, 0, 0); }
#pragma unroll
    for (int rg = 0; rg < 4; ++rg) {
      float mx = fmaxf(fmaxf(s[0][rg], s[1][rg]), fmaxf(s[2][rg], s[3][rg]));
      mx = fmaxf(mx, __shfl_xor(mx, 1)); mx = fmaxf(mx, __shfl_xor(mx, 2)); mx = fmaxf(mx, __shfl_xor(mx, 4)); mx = fmaxf(mx, __shfl_xor(mx, 8));
      const float mn = fmaxf(m[rg], mx), alpha = exp2f(m[rg] - mn); float rs = 0.f;
#pragma unroll
      for (int ni = 0; ni < 4; ++ni) { const float pv = exp2f(s[ni][rg] - mn); rs += pv; Ps[w][4 * l4 + rg][16 * ni + l15] = (bf16_t)f2bf(pv); }
      rs += __shfl_xor(rs, 1); rs += __shfl_xor(rs, 2); rs += __shfl_xor(rs, 4); rs += __shfl_xor(rs, 8);
      l[rg] = l[rg] * alpha + rs; m[rg] = mn;
#pragma unroll
      for (int ni = 0; ni < 4; ++ni) O[ni][rg] *= alpha;
    }
    __syncthreads();
#pragma unroll
    for (int kk = 0; kk < 2; ++kk) { const bf16x8 ap = *(const bf16x8*)&Ps[w][l15][32 * kk + 8 * l4];
#pragma unroll
      for (int ni = 0; ni < 4; ++ni) { const bf16x8 bv = *(const bf16x8*)&Vt[16 * ni + l15][32 * kk + 8 * l4]; O[ni] = __builtin_amdgcn_mfma_f32_16x16x32_bf16(ap, bv, O[ni], 0, 0, 0); } }
  }
#pragma unroll
  for (int rg = 0; rg < 4; ++rg) { const float il = 1.0f / l[rg]; const size_t row = (size_t)(qrow0 + 16 * w + 4 * l4 + rg);
#pragma unroll
    for (int ni = 0; ni < 4; ++ni) MIX[row * DM + h * 64 + 16 * ni + l15] = (bf16_t)f2bf(O[ni][rg] * il); }
  __syncthreads();
}

__device__ __forceinline__ void st_ssd_prep(const bf16_t* XBC, float* DT, const float* cw, const float* cb, const float* dt_bias, bf16_t* XBCC) {
  const size_t total = (size_t)MTOK * 640;
  for (size_t i = (size_t)BIDX * NT + TIDX; i < total; i += (size_t)gridDim.x * NT) {
    const int r = (int)(i / 640), ch = (int)(i % 640), j = r % TPB;
    const bool hasp = (j != 0 && j != CTXL), hasn = (j != CTXL - 1 && j != TPB - 1);
    float v = cw[640 + ch] * bf2f(XBC[(size_t)r * 768 + ch]) + cb[ch];
    if (hasp) v += cw[ch] * bf2f(XBC[(size_t)(r - 1) * 768 + ch]);
    if (hasn) v += cw[1280 + ch] * bf2f(XBC[(size_t)(r + 1) * 768 + ch]);
    XBCC[i] = (bf16_t)f2bf(siluf(v));
  }
  for (size_t i = (size_t)BIDX * NT + TIDX; i < (size_t)MTOK * 12; i += (size_t)gridDim.x * NT) {
    const float x = DT[i] + dt_bias[i % 12];
    DT[i] = x > 20.f ? x : log1pf(expf(x));
  }
}
__device__ __forceinline__ void ssd_scan_item(int item, const bf16_t* XBCC, const float* DT, const float* a_log, float* Y, char* lds) {
  const int half = TIDX >> 8, tid = TIDX & 255;
  float* base = (float*)(lds + half * 25088);
  float (*xs)[64] = (float (*)[64])base; float (*Bs)[64] = (float (*)[64])(base + 2048); float (*Cs)[64] = (float (*)[64])(base + 4096);
  float* dAs = base + 6144; float* dts = base + 6176;
  const int bh = 2 * item + half, b = bh / 6, h = bh % 6, g = h / 3, p = tid >> 2, q = tid & 3;
  for (int dir = 0; dir < 2; ++dir) {
    const float a = -expf(a_log[dir * 6 + h]);
    float st[16];
#pragma unroll
    for (int n = 0; n < 16; ++n) st[n] = 0.f;
    for (int ci = 0; ci < TPB / 32; ++ci) {
      for (int e = tid; e < 32 * 64; e += 256) { const int i = e >> 6, cc = e & 63, qi = ci * 32 + i;
        const int j = dir == 0 ? qi : (qi < CTXL ? CTXL - 1 - qi : TPB - 1 - (qi - CTXL)); const size_t r = (size_t)b * TPB + j;
        xs[i][cc] = bf2f(XBCC[r * 640 + h * 64 + cc]); Bs[i][cc] = bf2f(XBCC[r * 640 + 384 + g * 64 + cc]); Cs[i][cc] = bf2f(XBCC[r * 640 + 512 + g * 64 + cc]); }
      if (tid < 32) { const int qi = ci * 32 + tid; const int j = dir == 0 ? qi : (qi < CTXL ? CTXL - 1 - qi : TPB - 1 - (qi - CTXL)); const size_t r = (size_t)b * TPB + j;
        const float dt = DT[r * 12 + dir * 6 + h]; dts[tid] = dt; dAs[tid] = expf(dt * a); }
      __syncthreads();
      for (int i = 0; i < 32; ++i) {
        const float d = dAs[i], dtx = dts[i] * xs[i][p]; float y = 0.f;
#pragma unroll
        for (int n = 0; n < 16; ++n) { st[n] = st[n] * d + dtx * Bs[i][16 * q + n]; y += Cs[i][16 * q + n] * st[n]; }
        y += __shfl_xor(y, 1); y += __shfl_xor(y, 2);
        if (q == 0) { const int qi = ci * 32 + i; const int j = dir == 0 ? qi : (qi < CTXL ? CTXL - 1 - qi : TPB - 1 - (qi - CTXL)); float* yp = Y + ((size_t)b * TPB + j) * 384 + h * 64 + p;
          if (dir == 0) *yp = y; else *yp += y; }
      }
      __syncthreads();
    }
  }
}
__device__ __forceinline__ void st_ssd_out(const float* Y, const bf16_t* XBCC, const bf16_t* VZ, const float* dskip, const float* nw, bf16_t* MIX) {
  const int lane = TIDX & 63, gw = BIDX * 8 + (TIDX >> 6), ngw = gridDim.x * 8;
  for (int it = gw; it < MTOK * 2; it += ngw) {
    const int r = it >> 1, g = it & 1; float gv[3]; float ss = 0.f;
#pragma unroll
    for (int i = 0; i < 3; ++i) { const int c = g * 192 + lane + 64 * i, hh = c >> 6;
      const float y = Y[(size_t)r * 384 + c] + bf2f(XBCC[(size_t)r * 640 + c]) * dskip[hh]; const float zv = bf2f(VZ[(size_t)r * 512 + 128 + c]);
      gv[i] = y * siluf(zv); ss += gv[i] * gv[i]; }
    const float rstd = rsqrtf(wave_sum(ss) * (1.0f / 192.0f) + EPS);
#pragma unroll
    for (int i = 0; i < 3; ++i) { const int c = g * 192 + lane + 64 * i; MIX[(size_t)r * DM + 384 + c] = (bf16_t)f2bf(gv[i] * rstd * nw[c]); }
  }
}


__device__ __forceinline__ void ssd_conv8(const bf16_t* XBC, size_t r, int c0, bool hasp, bool hasn, const float* cw, const float* cb, float (&o)[8]) {
  const bf16x8 cur = *(const bf16x8*)(XBC + r * 768 + c0);
  bf16x8 prv = (bf16x8){0, 0, 0, 0, 0, 0, 0, 0}, nxt = (bf16x8){0, 0, 0, 0, 0, 0, 0, 0};
  if (hasp) prv = *(const bf16x8*)(XBC + (r - 1) * 768 + c0);
  if (hasn) nxt = *(const bf16x8*)(XBC + (r + 1) * 768 + c0);
#pragma unroll
  for (int e = 0; e < 8; ++e) { const float v = cw[c0 + e] * bf2f((bf16_t)prv[e]) + cw[640 + c0 + e] * bf2f((bf16_t)cur[e]) + cw[1280 + c0 + e] * bf2f((bf16_t)nxt[e]) + cb[c0 + e]; o[e] = siluf(v); }
}
__device__ __forceinline__ float softplusf(float x) { return x > 20.f ? x : log1pf(expf(x)); }
__device__ __forceinline__ void wave_scan128(float e0, float e1, int lane, float& c0, float& c1) {
  float x = e0 + e1;
#pragma unroll
  for (int o = 1; o < 64; o <<= 1) { const float v = __shfl_up(x, o); if (lane >= o) x += v; }
  const float excl = x - (e0 + e1); c0 = excl + e0; c1 = excl + e0 + e1;
}
__device__ __forceinline__ unsigned pk2bf(float lo, float hi) { return f2bf(lo) | (f2bf(hi) << 16); }
__device__ __forceinline__ int ssd_chunk_j0(int cidx) { return cidx < 2 ? cidx * 128 : CTXL + (cidx - 2) * 128; }

__device__ __forceinline__ void ssd1_item(int item, const bf16_t* XBC, const float* DT, const float* cw, const float* cb, const float* dt_bias, const float* a_log,
                                          float* YIN, float* ST, float* DEC, char* lds) {
  bf16_t (*Cm)[72] = (bf16_t (*)[72])lds; bf16_t (*Bm)[72] = (bf16_t (*)[72])(lds + 18432);
  bf16_t (*BT)[136] = (bf16_t (*)[136])(lds + 36864); bf16_t (*Xt)[136] = (bf16_t (*)[136])(lds + 54272); bf16_t (*Mm)[136] = (bf16_t (*)[136])(lds + 71680);
  float* tab = (float*)(lds + 106496); float* dtf = tab; float* dtb = tab + 128; float* acf = tab + 256; float* acb = tab + 384; float* wf = tab + 512; float* wb = tab + 640;
  const int tid = TIDX, lane = tid & 63, w = tid >> 6, l15 = lane & 15, l4 = lane >> 4;
  const int h = item % 6, bc = item / 6, cidx = bc % 34, b = bc / 34, g = h / 3, j0 = ssd_chunk_j0(cidx);
  const size_t r0 = (size_t)b * TPB + j0;
#pragma unroll 2
  for (int i = 0; i < 6; ++i) { const int task = tid + NT * i, t = task / 24, cg = task % 24, kind = cg >> 3, q = cg & 7, j = j0 + t;
    const int c0 = kind == 0 ? h * 64 + 8 * q : (kind == 1 ? 384 + g * 64 + 8 * q : 512 + g * 64 + 8 * q);
    float o[8]; ssd_conv8(XBC, r0 + t, c0, j != 0 && j != CTXL, j != CTXL - 1 && j != TPB - 1, cw, cb, o);
    if (kind == 0) {
#pragma unroll
      for (int e = 0; e < 8; ++e) Xt[8 * q + e][t] = (bf16_t)f2bf(o[e]);
    } else { const u32x4 pk = (u32x4){pk2bf(o[0], o[1]), pk2bf(o[2], o[3]), pk2bf(o[4], o[5]), pk2bf(o[6], o[7])};
      if (kind == 1) { *(u32x4*)&Bm[t][8 * q] = pk;
#pragma unroll
        for (int e = 0; e < 8; ++e) BT[8 * q + e][t] = (bf16_t)f2bf(o[e]); }
      else *(u32x4*)&Cm[t][8 * q] = pk; } }
  if (w < 2) { const int dir = w; const float a = -expf(a_log[dir * 6 + h]), bias = dt_bias[dir * 6 + h];
    const int t0 = dir == 0 ? 2 * lane : 127 - 2 * lane, t1 = dir == 0 ? 2 * lane + 1 : 126 - 2 * lane;
    const float d0 = softplusf(DT[(r0 + t0) * 12 + dir * 6 + h] + bias), d1 = softplusf(DT[(r0 + t1) * 12 + dir * 6 + h] + bias);
    float c0, c1; wave_scan128(d0 * a, d1 * a, lane, c0, c1);
    const float tot = __shfl(c1, 63);
    float* dtt = dir == 0 ? dtf : dtb; float* ac = dir == 0 ? acf : acb; float* ww = dir == 0 ? wf : wb;
    dtt[t0] = d0; dtt[t1] = d1; ac[t0] = c0; ac[t1] = c1; ww[t0] = __expf(tot - c0) * d0; ww[t1] = __expf(tot - c1) * d1;
    if (lane == 0) DEC[(((size_t)b * 34 + cidx) * 2 + dir) * 6 + h] = __expf(tot); }
  __syncthreads();
  {
    f32x4 accG[8];
#pragma unroll
    for (int ni = 0; ni < 8; ++ni) accG[ni] = (f32x4){0.f, 0.f, 0.f, 0.f};
#pragma unroll
    for (int kk = 0; kk < 2; ++kk) { const bf16x8 a = *(const bf16x8*)&Cm[16 * w + l15][32 * kk + 8 * l4];
#pragma unroll
      for (int ni = 0; ni < 8; ++ni) { const bf16x8 bb = *(const bf16x8*)&Bm[16 * ni + l15][32 * kk + 8 * l4]; accG[ni] = __builtin_amdgcn_mfma_f32_16x16x32_bf16(a, bb, accG[ni], 0, 0, 0); } }
    float aft[4], abt[4];
#pragma unroll
    for (int rg = 0; rg < 4; ++rg) { aft[rg] = acf[16 * w + 4 * l4 + rg]; abt[rg] = acb[16 * w + 4 * l4 + rg]; }
#pragma unroll
    for (int ni = 0; ni < 8; ++ni) { const int sidx = 16 * ni + l15; const float afs = acf[sidx], abs_ = acb[sidx], dfs = dtf[sidx], dbs = dtb[sidx];
#pragma unroll
      for (int rg = 0; rg < 4; ++rg) { const int t = 16 * w + 4 * l4 + rg;
        const float f = sidx <= t ? __expf(aft[rg] - afs) * dfs : 0.f, bk = sidx >= t ? __expf(abt[rg] - abs_) * dbs : 0.f;
        Mm[t][sidx] = (bf16_t)f2bf(accG[ni][rg] * (f + bk)); } }
  }
  __syncthreads();
  {
    f32x4 acc[4];
#pragma unroll
    for (int ni = 0; ni < 4; ++ni) acc[ni] = (f32x4){0.f, 0.f, 0.f, 0.f};
#pragma unroll
    for (int kk = 0; kk < 4; ++kk) { const bf16x8 a = *(const bf16x8*)&Mm[16 * w + l15][32 * kk + 8 * l4];
#pragma unroll
      for (int ni = 0; ni < 4; ++ni) { const bf16x8 bb = *(const bf16x8*)&Xt[16 * ni + l15][32 * kk + 8 * l4]; acc[ni] = __builtin_amdgcn_mfma_f32_16x16x32_bf16(a, bb, acc[ni], 0, 0, 0); } }
#pragma unroll
    for (int rg = 0; rg < 4; ++rg)
#pragma unroll
      for (int ni = 0; ni < 4; ++ni) YIN[(r0 + 16 * w + 4 * l4 + rg) * 384 + h * 64 + 16 * ni + l15] = acc[ni][rg];
  }
  {
    const int dir = w >> 2, mt = w & 3; const float* ww = dir == 0 ? wf : wb;
    f32x4 acc[4];
#pragma unroll
    for (int ni = 0; ni < 4; ++ni) acc[ni] = (f32x4){0.f, 0.f, 0.f, 0.f};
#pragma unroll
    for (int kk = 0; kk < 4; ++kk) { const bf16x8 raw = *(const bf16x8*)&Xt[16 * mt + l15][32 * kk + 8 * l4];
      const f32x4 w0 = *(const f32x4*)(ww + 32 * kk + 8 * l4), w1 = *(const f32x4*)(ww + 32 * kk + 8 * l4 + 4);
      u32x4 pk; pk.x = pk2bf(bf2f((bf16_t)raw[0]) * w0.x, bf2f((bf16_t)raw[1]) * w0.y); pk.y = pk2bf(bf2f((bf16_t)raw[2]) * w0.z, bf2f((bf16_t)raw[3]) * w0.w);
      pk.z = pk2bf(bf2f((bf16_t)raw[4]) * w1.x, bf2f((bf16_t)raw[5]) * w1.y); pk.w = pk2bf(bf2f((bf16_t)raw[6]) * w1.z, bf2f((bf16_t)raw[7]) * w1.w);
      const bf16x8 a = __builtin_bit_cast(bf16x8, pk);
#pragma unroll
      for (int ni = 0; ni < 4; ++ni) { const bf16x8 bb = *(const bf16x8*)&BT[16 * ni + l15][32 * kk + 8 * l4]; acc[ni] = __builtin_amdgcn_mfma_f32_16x16x32_bf16(a, bb, acc[ni], 0, 0, 0); } }
    float* sp = ST + ((((size_t)b * 34 + cidx) * 2 + dir) * 6 + h) * 4096;
#pragma unroll
    for (int rg = 0; rg < 4; ++rg)
#pragma unroll
      for (int ni = 0; ni < 4; ++ni) sp[(16 * mt + 4 * l4 + rg) * 64 + 16 * ni + l15] = acc[ni][rg];
  }
  __syncthreads();
}

__device__ __forceinline__ void st_ssd_scan2(float* ST, const float* DEC) {
  for (int idx = BIDX * NT + TIDX; idx < 4 * 2 * 6 * 4096; idx += gridDim.x * NT) {
    const int e = idx & 4095, bdh = idx >> 12, h = bdh % 6, dir = (bdh / 6) & 1, b = bdh / 12;
    float v[34], d[34];
#pragma unroll
    for (int st = 0; st < 34; ++st) { const int cidx = dir == 0 ? st : (st < 2 ? 1 - st : 35 - st); const size_t o = (((size_t)b * 34 + cidx) * 2 + dir) * 6 + h; v[st] = ST[o * 4096 + e]; d[st] = DEC[o]; }
    float H = 0.f;
#pragma unroll
    for (int st = 0; st < 34; ++st) { const int cidx = dir == 0 ? st : (st < 2 ? 1 - st : 35 - st); const size_t o = (((size_t)b * 34 + cidx) * 2 + dir) * 6 + h; ST[o * 4096 + e] = H; H = H * d[st] + v[st]; }
  }
}

__device__ __forceinline__ void ssd3_item(int b, int cidx, int g, const bf16_t* XBC, const bf16_t* VZ, const float* DT, const float* cw, const float* cb, const float* dt_bias, const float* a_log,
                                          const float* dskip, const float* nw, const float* YIN, const float* ST, bf16_t* MIX, char* lds) {
  bf16_t (*Cm)[72] = (bf16_t (*)[72])lds; bf16_t (*Hm)[72] = (bf16_t (*)[72])(lds + 18432);
  float* ef = (float*)(lds + 18432 + 55296);
  const int tid = TIDX, lane = tid & 63, w = tid >> 6, l15 = lane & 15, l4 = lane >> 4, j0 = ssd_chunk_j0(cidx);
  const size_t r0 = (size_t)b * TPB + j0;
#pragma unroll
  for (int i = 0; i < 2; ++i) { const int task = tid + NT * i, t = task >> 3, q = task & 7, j = j0 + t;
    float o[8]; ssd_conv8(XBC, r0 + t, 512 + g * 64 + 8 * q, j != 0 && j != CTXL, j != CTXL - 1 && j != TPB - 1, cw, cb, o);
    *(u32x4*)&Cm[t][8 * q] = (u32x4){pk2bf(o[0], o[1]), pk2bf(o[2], o[3]), pk2bf(o[4], o[5]), pk2bf(o[6], o[7])}; }
#pragma unroll 4
  for (int i = 0; i < 12; ++i) { const int f4 = tid + NT * i, hd = f4 >> 10, rem = f4 & 1023, p = rem >> 4, n4 = (rem & 15) * 4, hh = hd >> 1, dir = hd & 1;
    const f32x4 v = *(const f32x4*)(ST + ((((size_t)b * 34 + cidx) * 2 + dir) * 6 + 3 * g + hh) * 4096 + p * 64 + n4);
    *(u32x2*)&Hm[hd * 64 + p][n4] = (u32x2){pk2bf(v.x, v.y), pk2bf(v.z, v.w)}; }
  if (w < 6) { const int hh = w >> 1, dir = w & 1, h = 3 * g + hh; const float a = -expf(a_log[dir * 6 + h]), bias = dt_bias[dir * 6 + h];
    const int t0 = dir == 0 ? 2 * lane : 127 - 2 * lane, t1 = dir == 0 ? 2 * lane + 1 : 126 - 2 * lane;
    const float d0 = softplusf(DT[(r0 + t0) * 12 + dir * 6 + h] + bias), d1 = softplusf(DT[(r0 + t1) * 12 + dir * 6 + h] + bias);
    float c0, c1; wave_scan128(d0 * a, d1 * a, lane, c0, c1);
    ef[w * 128 + t0] = __expf(c0); ef[w * 128 + t1] = __expf(c1); }
  __syncthreads();
  bf16x8 ca[2];
#pragma unroll
  for (int kk = 0; kk < 2; ++kk) ca[kk] = *(const bf16x8*)&Cm[16 * w + l15][32 * kk + 8 * l4];
  float ss[4] = {0.f, 0.f, 0.f, 0.f}, rstd[4] = {0.f, 0.f, 0.f, 0.f};
#pragma unroll 1
  for (int pass = 0; pass < 2; ++pass) {
#pragma unroll 1
    for (int hh = 0; hh < 3; ++hh) { const int h = 3 * g + hh; const float dsk = dskip[h];
      f32x4 accF[4], accB[4];
#pragma unroll
      for (int ni = 0; ni < 4; ++ni) { accF[ni] = (f32x4){0.f, 0.f, 0.f, 0.f}; accB[ni] = (f32x4){0.f, 0.f, 0.f, 0.f}; }
      const bf16_t (*HF)[72] = Hm + (hh * 2 + 0) * 64; const bf16_t (*HB)[72] = Hm + (hh * 2 + 1) * 64;
#pragma unroll
      for (int kk = 0; kk < 2; ++kk)
#pragma unroll
        for (int ni = 0; ni < 4; ++ni) {
          accF[ni] = __builtin_amdgcn_mfma_f32_16x16x32_bf16(ca[kk], *(const bf16x8*)&HF[16 * ni + l15][32 * kk + 8 * l4], accF[ni], 0, 0, 0);
          accB[ni] = __builtin_amdgcn_mfma_f32_16x16x32_bf16(ca[kk], *(const bf16x8*)&HB[16 * ni + l15][32 * kk + 8 * l4], accB[ni], 0, 0, 0); }
      const float* efF = ef + (hh * 2 + 0) * 128; const float* efB = ef + (hh * 2 + 1) * 128;
#pragma unroll
      for (int rg = 0; rg < 4; ++rg) { const int t = 16 * w + 4 * l4 + rg, j = j0 + t; const size_t r = r0 + t;
        const float eF = efF[t], eB = efB[t]; const bool hasp = j != 0 && j != CTXL, hasn = j != CTXL - 1 && j != TPB - 1;
        const bf16_t* xp = XBC + r * 768 + h * 64 + l15; const float* yp = YIN + r * 384 + h * 64 + l15; const bf16_t* zp = VZ + r * 512 + 128 + h * 64 + l15;
        bf16_t* op = MIX + r * DM + 384 + h * 64 + l15;
#pragma unroll
        for (int ni = 0; ni < 4; ++ni) { const int col = h * 64 + 16 * ni + l15;
          float xv = cw[640 + col] * bf2f(xp[16 * ni]) + cb[col];
          if (hasp) xv += cw[col] * bf2f(xp[16 * ni - 768]);
          if (hasn) xv += cw[1280 + col] * bf2f(xp[16 * ni + 768]);
          xv = siluf(xv);
          const float y = yp[16 * ni] + eF * accF[ni][rg] + eB * accB[ni][rg] + dsk * xv;
          const float gt = y * siluf(bf2f(zp[16 * ni]));
          if (pass == 0) ss[rg] += gt * gt; else op[16 * ni] = (bf16_t)f2bf(gt * rstd[rg] * nw[col]); } }
    }
    if (pass == 0) {
#pragma unroll
      for (int rg = 0; rg < 4; ++rg) { float sv = ss[rg]; sv += __shfl_xor(sv, 1); sv += __shfl_xor(sv, 2); sv += __shfl_xor(sv, 4); sv += __shfl_xor(sv, 8); rstd[rg] = rsqrtf(sv * (1.0f / 192.0f) + EPS); }
    }
  }
  __syncthreads();
}

__device__ __forceinline__ void st_router(const float* xl, const float* xc, const float* g, const float* modv_layer, const float* w_router, const float* rbias,
                                          bf16_t* H2, int* ctl, int* tok_pair, float* tok_w, int skip_ctx) {
  const int lane = TIDX & 63, gw = BIDX * 8 + (TIDX >> 6), ngw = gridDim.x * 8;
  for (int r = gw; r < MTOK; r += ngw) {
    if (skip_ctx && (r % TPB) < CTXL) continue;
    const float* xr = xrow(xl, xc, r); const float* mv = modv_layer + (size_t)mrow_of(r) * 6144;
    f32x4 v[4]; float ss = 0.f;
#pragma unroll
    for (int j = 0; j < 4; ++j) { v[j] = *(const f32x4*)(xr + 4 * lane + 256 * j); ss += v[j].x * v[j].x + v[j].y * v[j].y + v[j].z * v[j].z + v[j].w * v[j].w; }
    const float rstd = rsqrtf(wave_sum(ss) * (1.0f / DM) + EPS);
    float lg[16];
#pragma unroll
    for (int e = 0; e < 16; ++e) lg[e] = 0.f;
#pragma unroll
    for (int j = 0; j < 4; ++j) { const int k = 4 * lane + 256 * j;
      const f32x4 gg = *(const f32x4*)(g + k), sh = *(const f32x4*)(mv + 3072 + k), sc = *(const f32x4*)(mv + 4096 + k);
      float o[4]; o[0] = v[j].x * rstd * gg.x * (1.f + sc.x) + sh.x; o[1] = v[j].y * rstd * gg.y * (1.f + sc.y) + sh.y;
      o[2] = v[j].z * rstd * gg.z * (1.f + sc.z) + sh.z; o[3] = v[j].w * rstd * gg.w * (1.f + sc.w) + sh.w;
      u32x2 w; w.x = f2bf(o[0]) | (f2bf(o[1]) << 16); w.y = f2bf(o[2]) | (f2bf(o[3]) << 16);
      *(u32x2*)(H2 + (size_t)r * DM + k) = w;
#pragma unroll
      for (int q = 0; q < 4; ++q) {
#pragma unroll
        for (int e4 = 0; e4 < 4; ++e4) { const f32x4 wr = *(const f32x4*)(w_router + (size_t)(k + q) * 16 + 4 * e4);
          lg[4 * e4] += o[q] * wr.x; lg[4 * e4 + 1] += o[q] * wr.y; lg[4 * e4 + 2] += o[q] * wr.z; lg[4 * e4 + 3] += o[q] * wr.w; } } }
#pragma unroll
    for (int e = 0; e < 16; ++e) lg[e] = wave_sum(lg[e]);
    if (lane == 0) {
      int best = 0, bi1 = 0, bi2 = 1; float bestv = -1e30f, bs1 = 0.f, bs2 = 0.f;
#pragma unroll
      for (int gq = 0; gq < 4; ++gq) { float m1 = -1e30f, m2 = -1e30f, s1 = 0.f, s2 = 0.f; int i1 = 0, i2 = 0;
#pragma unroll
        for (int i = 0; i < 4; ++i) { const float scv = 1.0f / (1.0f + expf(-lg[4 * gq + i])); const float s = scv + rbias[4 * gq + i];
          if (s > m1) { m2 = m1; s2 = s1; i2 = i1; m1 = s; s1 = scv; i1 = i; } else if (s > m2) { m2 = s; s2 = scv; i2 = i; } }
        if (m1 + m2 > bestv) { bestv = m1 + m2; best = gq; bi1 = i1; bi2 = i2; bs1 = s1; bs2 = s2; } }
      const int ia = bi1 < bi2 ? bi1 : bi2, ib = bi1 < bi2 ? bi2 : bi1;
      const int tri = ia == 0 ? ib - 1 : (ia == 1 ? ib + 1 : 5);
      const int pidx = best * 6 + tri;
      const float sa = bi1 < bi2 ? bs1 : bs2, sb = bi1 < bi2 ? bs2 : bs1, inv = 1.0f / (sa + sb);
      tok_pair[r] = pidx; tok_w[2 * r] = sa * inv; tok_w[2 * r + 1] = sb * inv;
      atomicAdd(&ctl[CT_CNT + pidx], 1);
    }
  }
}
__device__ __forceinline__ void st_moe_plan(int* ctl, int* sorted_tok) {
  if (BIDX == 0 && TIDX == 0) { int base = 0, nt = 0;
    for (int p = 0; p < 24; ++p) { ctl[CT_BASE + p] = base; const int n = ctl[CT_CNT + p], tl = (n + 255) >> 8; for (int t = 0; t < tl; ++t) ctl[CT_TP + nt + t] = p; nt += tl; base += tl * 256; ctl[CT_FILL + p] = 0; }
    ctl[CT_BASE + 24] = base; ctl[CT_NT] = nt; }
  for (int i = BIDX * NT + TIDX; i < MOE_ROWS; i += gridDim.x * NT) sorted_tok[i] = -1;
}
__device__ __forceinline__ void st_moe_gather(const bf16_t* H2, bf16_t* H2S, int* ctl, const int* tok_pair, const float* tok_w, int* sorted_tok, float* sorted_w, int skip_ctx) {
  const int lane = TIDX & 63, gw = BIDX * 8 + (TIDX >> 6), ngw = gridDim.x * 8;
  for (int r = gw; r < MTOK; r += ngw) {
    if (skip_ctx && (r % TPB) < CTXL) continue;
    const int p = tok_pair[r]; int slot = 0;
    if (lane == 0) { slot = ctl[CT_BASE + p] + atomicAdd(&ctl[CT_FILL + p], 1); sorted_tok[slot] = r; sorted_w[2 * slot] = tok_w[2 * r]; sorted_w[2 * slot + 1] = tok_w[2 * r + 1]; }
    slot = __shfl(slot, 0);
    const u32x4* s = (const u32x4*)(H2 + (size_t)r * DM); u32x4* d = (u32x4*)(H2S + (size_t)slot * DM);
    d[lane] = s[lane]; d[lane + 64] = s[lane + 64];
  }
}
__device__ __forceinline__ void st_final(float* xl, const float* g) {
  const int lane = TIDX & 63, gw = BIDX * 8 + (TIDX >> 6), ngw = gridDim.x * 8;
  for (int r = gw; r < NB * SEQ; r += ngw) {
    float* xr = xl + (size_t)r * DM; f32x4 v[4]; float ss = 0.f;
#pragma unroll
    for (int j = 0; j < 4; ++j) { v[j] = *(const f32x4*)(xr + 4 * lane + 256 * j); ss += v[j].x * v[j].x + v[j].y * v[j].y + v[j].z * v[j].z + v[j].w * v[j].w; }
    const float rstd = rsqrtf(wave_sum(ss) * (1.0f / DM) + EPS);
#pragma unroll
    for (int j = 0; j < 4; ++j) { const int k = 4 * lane + 256 * j; const f32x4 gg = *(const f32x4*)(g + k);
      *(f32x4*)(xr + k) = (f32x4){v[j].x * rstd * gg.x, v[j].y * rstd * gg.y, v[j].z * rstd * gg.z, v[j].w * rstd * gg.w}; }
  }
}

#include <hip/hip_bf16.h>
#include <cmath>
namespace attn_body {
using bf16=__hip_bfloat16;
using bf16x8=__attribute__((ext_vector_type(8)))short;
using s16x4=__attribute__((ext_vector_type(4)))short;
using f32x16=__attribute__((ext_vector_type(16)))float;
using u32x4=__attribute__((ext_vector_type(4)))unsigned;
constexpr int D=64,QP=512,KP=512,VP=512,OP=1024;
constexpr int NW=8,QBLK=32,QB=QBLK*NW,KVBLK=64;
constexpr int ATTN_UNIT_ROWS=QB;
__device__ __forceinline__ int crow(int r,int hi){return (r&3)+8*(r>>2)+4*hi;}
#define SBAR() __builtin_amdgcn_sched_barrier(0)
__device__ __forceinline__ void cmask(f32x16&p0,f32x16&p1,int jb,int qrel,int hi){
  const float NEG=-INFINITY; int kb=64*jb+4*hi;
  #pragma unroll
  for(int r=0;r<16;++r){int kv=kb+(r&3)+8*(r>>2); if(kv>qrel)p0[r]=NEG; if(kv+32>qrel)p1[r]=NEG;}
}

constexpr int NSLOT=3, SLOTB=8192;
constexpr int LDS_K=0, LDS_V=NSLOT*SLOTB, LDS_WS=2*NSLOT*SLOTB, LDS_OST=LDS_WS+NW*64*4, LDS_BYTES=LDS_OST+NW*4096;
constexpr float C2=0.125f*1.4426950408889634f;
__device__ __forceinline__ void glds16(const void*gsrc,unsigned lds_dst){unsigned keep;
  asm volatile("s_mov_b32 %0, m0\n\ts_mov_b32 m0, %2\n\ts_nop 0\n\tglobal_load_lds_dwordx4 %1, off\n\ts_mov_b32 m0, %0":"=&s"(keep):"v"(gsrc),"s"(lds_dst):"memory");}
__device__ __forceinline__ float max3f(float a,float b,float c){float r;asm("v_max3_f32 %0, %1, %2, %3":"=v"(r):"v"(a),"v"(b),"v"(c));return r;}
__device__ __forceinline__ float max2f(float a,float b){float r;asm("v_max_f32_e32 %0, %1, %2":"=v"(r):"v"(a),"v"(b));return r;}
__device__ __forceinline__ float fadd_s(float a,float b){float r;asm("v_add_f32_e32 %0, %1, %2":"=v"(r):"v"(a),"v"(b));return r;}
__device__ __forceinline__ float fsub_s(float a,float b){float r;asm("v_sub_f32_e32 %0, %1, %2":"=v"(r):"v"(a),"v"(b));return r;}
typedef float f32x2_t __attribute__((ext_vector_type(2))); typedef __bf16 bf16x2_t __attribute__((ext_vector_type(2)));
__device__ __forceinline__ unsigned cvtpk_s(float lo,float hi){f32x2_t v={lo,hi};bf16x2_t b=__builtin_convertvector(v,bf16x2_t);return __builtin_bit_cast(unsigned,b);}
#define WAIT_BAR(N) asm volatile("s_waitcnt vmcnt(" #N ") lgkmcnt(0)\n\ts_barrier":::"memory")

__device__ __forceinline__ void qkt(f32x16&p0,f32x16&p1,const char*Kslot,const bf16x8*qr,const f32x16&negm,int r32,int hi){
  const char*kb=Kslot+hi*1024+r32*16;
  #pragma unroll
  for(int d0=0;d0<4;++d0){
    const bf16x8 b0=*reinterpret_cast<const bf16x8*>(kb+d0*2048);
    const bf16x8 b1=*reinterpret_cast<const bf16x8*>(kb+d0*2048+512);
    if(d0==0){p0=__builtin_amdgcn_mfma_f32_32x32x16_bf16(b0,qr[0],negm,0,0,0);p1=__builtin_amdgcn_mfma_f32_32x32x16_bf16(b1,qr[0],negm,0,0,0);}
    else{p0=__builtin_amdgcn_mfma_f32_32x32x16_bf16(b0,qr[d0],p0,0,0,0);p1=__builtin_amdgcn_mfma_f32_32x32x16_bf16(b1,qr[d0],p1,0,0,0);}}
}
typedef __attribute__((address_space(3))) const char* lds_cptr;
typedef short v4i16_t __attribute__((ext_vector_type(4)));
__device__ __forceinline__ void kload8(bf16x8*kf,lds_cptr kp){
  kf[0]=*(const __attribute__((address_space(3))) bf16x8*)(kp);      kf[1]=*(const __attribute__((address_space(3))) bf16x8*)(kp+512);
  kf[2]=*(const __attribute__((address_space(3))) bf16x8*)(kp+2048); kf[3]=*(const __attribute__((address_space(3))) bf16x8*)(kp+2560);
  kf[4]=*(const __attribute__((address_space(3))) bf16x8*)(kp+4096); kf[5]=*(const __attribute__((address_space(3))) bf16x8*)(kp+4608);
  kf[6]=*(const __attribute__((address_space(3))) bf16x8*)(kp+6144); kf[7]=*(const __attribute__((address_space(3))) bf16x8*)(kp+6656);
}
__device__ __forceinline__ void kload2(bf16x8*kf,lds_cptr kp,int j){ kf[2*j]=*(const __attribute__((address_space(3))) bf16x8*)(kp+j*2048); kf[2*j+1]=*(const __attribute__((address_space(3))) bf16x8*)(kp+j*2048+512); }
__device__ __forceinline__ s16x4 vtr(lds_cptr p){ return __builtin_bit_cast(s16x4,__builtin_amdgcn_ds_read_tr16_b64_v4i16((__attribute__((address_space(3))) v4i16_t*)p)); }
__device__ __forceinline__ float rowmax(const f32x16&p0,const f32x16&p1){
  float a=max3f(p0[0],p0[1],p1[0]),b=max3f(p0[2],p0[3],p1[1]);a=max3f(a,p1[2],p1[3]);
  #pragma unroll
  for(int r=4;r<16;r+=4){a=max3f(a,p0[r],p0[r+1]);b=max3f(b,p0[r+2],p0[r+3]);a=max3f(a,p1[r],p1[r+1]);b=max3f(b,p1[r+2],p1[r+3]);}
  const float m=max2f(a,b);
  auto rr=__builtin_amdgcn_permlane32_swap(__float_as_uint(m),__float_as_uint(m),false,false);
  return max2f(__uint_as_float(rr[0]),__uint_as_float(rr[1]));
}
__device__ __forceinline__ void pv(f32x16*o,int vb,bf16x8 pa0,bf16x8 pa1,bf16x8 pa2,bf16x8 pa3){
  #pragma unroll
  for(int d0=0;d0<2;++d0){s16x4 lo[4],hi[4];
    #pragma unroll
    for(int ks=0;ks<4;++ks){
      asm volatile("ds_read_b64_tr_b16 %0,%1 offset:%c2":"=&v"(lo[ks]):"v"(vb),"i"(d0*4096+ks*1024):"memory");
      asm volatile("ds_read_b64_tr_b16 %0,%1 offset:%c2":"=&v"(hi[ks]):"v"(vb),"i"(d0*4096+ks*1024+512):"memory");}
    asm volatile("s_waitcnt lgkmcnt(0)":::"memory");SBAR();
    #define PK(k) (bf16x8){lo[k][0],lo[k][1],lo[k][2],lo[k][3],hi[k][0],hi[k][1],hi[k][2],hi[k][3]}
    o[d0]=__builtin_amdgcn_mfma_f32_32x32x16_bf16(pa0,PK(0),o[d0],0,0,0);
    o[d0]=__builtin_amdgcn_mfma_f32_32x32x16_bf16(pa1,PK(1),o[d0],0,0,0);
    o[d0]=__builtin_amdgcn_mfma_f32_32x32x16_bf16(pa2,PK(2),o[d0],0,0,0);
    o[d0]=__builtin_amdgcn_mfma_f32_32x32x16_bf16(pa3,PK(3),o[d0],0,0,0);
    #undef PK
  }
}

#ifndef ATTN_STORE16
#define ATTN_STORE16(p,v) (*(u32x4*)(p)=(v))
#endif
template<int THRL> __device__ __forceinline__ void attn_unit(const bf16*Qu,const bf16*__restrict__ Kh,const bf16*__restrict__ Vh,bf16*Ou,const int NT,char*shm){
  const int tid=threadIdx.x,lane=tid&63,r32=lane&31,hi=lane>>5; const int wid=__builtin_amdgcn_readfirstlane(tid>>6);
  const bf16*Qw=Qu+(long)(wid*QBLK)*QP;
  const unsigned lds0=(unsigned)(uintptr_t)shm;
  float*wsf=(float*)(shm+LDS_WS)+wid*64;
  const bf16*ksrc=Kh+(long)lane*KP+wid*8;
  const bf16*vsrc=Vh+(long)(16*(wid&3)+(lane>>2))*VP+(wid>>2)*32+(lane&3)*8;
  const unsigned kdst=lds0+LDS_K+wid*1024, vdst=lds0+LDS_V+wid*1024;
  #define DMA_K(t,slot) glds16(ksrc+(long)(t)*KVBLK*KP,(unsigned)__builtin_amdgcn_readfirstlane(kdst+(slot)))
  #define DMA_V(t,slot) glds16(vsrc+(long)(t)*KVBLK*VP,(unsigned)__builtin_amdgcn_readfirstlane(vdst+(slot)))
  const int vb0=(int)(lds0+LDS_V)+((lane>>4)&1)*32+(lane&3)*8+(4*hi+((lane&15)>>2))*64;
  const char*Kbase=shm+LDS_K; bf16x8 kf[8];
  const lds_cptr shm3=(lds_cptr)shm; const lds_cptr kp0=shm3+LDS_K+hi*1024+r32*16; const lds_cptr vp0=shm3+LDS_V+((lane>>4)&1)*32+(lane&3)*8+(4*hi+((lane&15)>>2))*64;
  DMA_K(0,0);DMA_V(0,0);DMA_K(1,SLOTB);
  bf16x8 qr[4];
  #pragma unroll
  for(int d0=0;d0<4;++d0)qr[d0]=*reinterpret_cast<const bf16x8*>(&Qw[(long)r32*QP+d0*16+hi*8]);
  float mhat=0.f,l_reg=0.f;f32x16 o[2];o[0]=f32x16{};o[1]=f32x16{};f32x16 negm=f32x16{};asm volatile("":"+v"(negm));
  #define CMASK(P0,P1,t) do{}while(0)
  bool resc=false;
  #define START(P0,P1) do{ const float rm=rowmax(P0,P1); resc=false; \
    { const float dl=rm; mhat=fadd_s(mhat,dl); \
      _Pragma("unroll") for(int r=0;r<16;++r){P0[r]=fsub_s(P0[r],dl);P1[r]=fsub_s(P1[r],dl);} \
      _Pragma("unroll") for(int r=0;r<16;++r)negm[r]=-mhat; asm volatile("":"+v"(negm)); } \
    _Pragma("unroll") for(int r=0;r<16;++r)P0[r]=__builtin_amdgcn_exp2f(P0[r]); }while(0)
  #define RESC() do{ if(resc){ asm volatile("s_waitcnt lgkmcnt(0)":::"memory"); \
      _Pragma("unroll") for(int d_=0;d_<2;++d_) _Pragma("unroll") for(int r=0;r<16;++r)o[d_][r]*=wsf[crow(r,hi)]; } }while(0)
  f32x16 pA0,pA1,pB0,pB1;
  int sl_prev=0,sl_cur=0,sl_next=SLOTB;
  #define ROT() do{sl_prev=sl_cur;sl_cur=sl_next;sl_next=(sl_next==(NSLOT-1)*SLOTB)?0:sl_next+SLOTB;}while(0)
  DMA_K(2,2*SLOTB);
  WAIT_BAR(3);
  qkt(pA0,pA1,Kbase,qr,negm,r32,hi);asm volatile("s_nop 15\n\ts_nop 7":"+v"(pA0),"+v"(pA1));CMASK(pA0,pA1,0);
  START(pA0,pA1);
  _Pragma("unroll") for(int r=0;r<16;++r)pA1[r]=__builtin_amdgcn_exp2f(pA1[r]);
  WAIT_BAR(0);
  DMA_K(3,0);DMA_V(1,SLOTB);
  ROT();
  kload8(kf,kp0+sl_cur);
  WAIT_BAR(2);
  s16x4 vlo[8],vhi[8]; u32x4 pw0,pw1,pw2,pw3;
  #define PKW(P,B) cvtpk_s(P[B],P[B+1])
  #define PAF(k) __builtin_bit_cast(bf16x8,pw##k)
  #define VFR(i) (bf16x8){vlo[i][0],vlo[i][1],vlo[i][2],vlo[i][3],vhi[i][0],vhi[i][1],vhi[i][2],vhi[i][3]}
  #define PIN(x) asm volatile("":"+v"(x))
  #define MX3(a,b,c) __builtin_fmaxf(__builtin_fmaxf((a),(b)),(c))
  #define GAPA(MF,A0,A1,A2,A3,W0,W1,PW) do{ MF; sacc+=A0; sacc+=A1; sacc+=A2; sacc+=A3; PIN(sacc); W0; W1; PIN(PW); SBAR(); }while(0)
  #define EX(v) __builtin_amdgcn_exp2f(v)
  #define GAPB(MF,X,B) do{ MF; X[B]=EX(X[B]); X[B+1]=EX(X[B+1]); X[B+2]=EX(X[B+2]); X[B+3]=EX(X[B+3]); PIN(X); SBAR(); }while(0)
  #define VRD(i) do{ vlo[i]=vtr(vp_+(((i)>>2)*4096+((i)&3)*1024)); vhi[i]=vtr(vp_+(((i)>>2)*4096+((i)&3)*1024+512)); }while(0)
  #define KRD(G,j) do{ if(G){ kload2(kf,kp0+sl_next,j); SBAR(); } }while(0)
  #define STEP(C0,C1,P0,P1,t,GK,GV,GL) do{ SBAR(); \
    const lds_cptr vp_=vp0+sl_prev; \
    VRD(0); SBAR(); float sacc=(P0[0]+P0[1]); \
    GAPA(C0=__builtin_amdgcn_mfma_f32_32x32x16_bf16(kf[0],qr[0],negm,0,0,0), P0[2],P0[3],P0[4],P0[5],     pw0[0]=PKW(P0,0), pw0[1]=PKW(P0,2), pw0); \
    VRD(4); SBAR(); GAPA(C1=__builtin_amdgcn_mfma_f32_32x32x16_bf16(kf[1],qr[0],negm,0,0,0), P0[6],P0[7],P0[8],P0[9],     pw0[2]=PKW(P0,4), pw0[3]=PKW(P0,6), pw0); \
    VRD(1); SBAR(); GAPA(C0=__builtin_amdgcn_mfma_f32_32x32x16_bf16(kf[2],qr[1],C0,0,0,0),   P0[10],P0[11],P0[12],P0[13], pw1[0]=PKW(P0,8), pw1[1]=PKW(P0,10), pw1); \
    VRD(5); SBAR(); GAPA(C1=__builtin_amdgcn_mfma_f32_32x32x16_bf16(kf[3],qr[1],C1,0,0,0),   P0[14],P0[15],P1[0],P1[1],   pw1[2]=PKW(P0,12),pw1[3]=PKW(P0,14), pw1); \
    VRD(2); SBAR(); GAPA(C0=__builtin_amdgcn_mfma_f32_32x32x16_bf16(kf[4],qr[2],C0,0,0,0),   P1[2],P1[3],P1[4],P1[5],     pw2[0]=PKW(P1,0), pw2[1]=PKW(P1,2), pw2); \
    VRD(6); SBAR(); GAPA(C1=__builtin_amdgcn_mfma_f32_32x32x16_bf16(kf[5],qr[2],C1,0,0,0),   P1[6],P1[7],P1[8],P1[9],     pw2[2]=PKW(P1,4), pw2[3]=PKW(P1,6), pw2); \
    VRD(3); SBAR(); GAPA(C0=__builtin_amdgcn_mfma_f32_32x32x16_bf16(kf[6],qr[3],C0,0,0,0),   P1[10],P1[11],P1[12],P1[13], pw3[0]=PKW(P1,8), pw3[1]=PKW(P1,10), pw3); \
    VRD(7); SBAR(); GAPA(C1=__builtin_amdgcn_mfma_f32_32x32x16_bf16(kf[7],qr[3],C1,0,0,0),   P1[14],P1[15],0.f,0.f,       pw3[2]=PKW(P1,12),pw3[3]=PKW(P1,14), pw3); \
    l_reg+=sacc; \
    if(GK){DMA_K((t)+3,sl_cur);} if(GV){DMA_V((t)+1,sl_next);} \
    CMASK(C0,C1,t); \
    { float a=MX3(C0[0],C0[1],C1[0]),b=MX3(C0[2],C0[3],C1[1]); a=MX3(a,C1[2],C1[3]); \
      _Pragma("unroll") for(int r=4;r<16;r+=4){a=MX3(a,C0[r],C0[r+1]);b=MX3(b,C0[r+2],C0[r+3]);a=MX3(a,C1[r],C1[r+1]);b=MX3(b,C1[r+2],C1[r+3]);} \
      float rm=__builtin_fmaxf(a,b); { auto rr=__builtin_amdgcn_permlane32_swap(__float_as_uint(rm),__float_as_uint(rm),false,false); rm=__builtin_fmaxf(__uint_as_float(rr[0]),__uint_as_float(rr[1])); } \
      resc=false; \
      if(__builtin_expect(__any(rm>(float)THRL),0)){ const float dl=__builtin_fmaxf(rm,0.f); mhat+=dl; \
        _Pragma("unroll") for(int r=0;r<16;++r){C0[r]-=dl;C1[r]-=dl;} \
        _Pragma("unroll") for(int r=0;r<16;++r)negm[r]=-mhat; asm volatile("":"+v"(negm)); \
        const float f=__builtin_amdgcn_exp2f(-dl); l_reg*=f; if(hi==0)wsf[r32]=f; resc=true; } } \
    SBAR(); \
    GAPB(o[0]=__builtin_amdgcn_mfma_f32_32x32x16_bf16(PAF(0),VFR(0),o[0],0,0,0), C0,0); \
    GAPB(o[1]=__builtin_amdgcn_mfma_f32_32x32x16_bf16(PAF(0),VFR(4),o[1],0,0,0), C0,4); \
    KRD(GL,0); GAPB(o[0]=__builtin_amdgcn_mfma_f32_32x32x16_bf16(PAF(1),VFR(1),o[0],0,0,0), C0,8); \
    KRD(GL,1); GAPB(o[1]=__builtin_amdgcn_mfma_f32_32x32x16_bf16(PAF(1),VFR(5),o[1],0,0,0), C0,12); \
    KRD(GL,2); GAPB(o[0]=__builtin_amdgcn_mfma_f32_32x32x16_bf16(PAF(2),VFR(2),o[0],0,0,0), C1,0); \
    KRD(GL,3); GAPB(o[1]=__builtin_amdgcn_mfma_f32_32x32x16_bf16(PAF(2),VFR(6),o[1],0,0,0), C1,4); \
    GAPB(o[0]=__builtin_amdgcn_mfma_f32_32x32x16_bf16(PAF(3),VFR(3),o[0],0,0,0), C1,8); \
    GAPB(o[1]=__builtin_amdgcn_mfma_f32_32x32x16_bf16(PAF(3),VFR(7),o[1],0,0,0), C1,12); \
    }while(0)
  int t=1;
  for(;t+5<NT;t+=2){
    STEP(pB0,pB1,pA0,pA1,t,true,true,true);     WAIT_BAR(2); RESC(); ROT();
    STEP(pA0,pA1,pB0,pB1,t+1,true,true,true);   WAIT_BAR(2); RESC(); ROT();
  }
  #define ENDW(tt) do{ if((tt)+3<NT){WAIT_BAR(2);} else if((tt)+2<NT){WAIT_BAR(1);} else {WAIT_BAR(0);} }while(0)
  for(;t+1<NT;t+=2){
    STEP(pB0,pB1,pA0,pA1,t,(t+3<NT),(t+1<NT),(t+1<NT));       ENDW(t);   RESC(); ROT();
    STEP(pA0,pA1,pB0,pB1,t+1,(t+4<NT),(t+2<NT),(t+2<NT));     ENDW(t+1); RESC(); ROT();
  }
  STEP(pB0,pB1,pA0,pA1,NT-1,false,false,false); RESC();
  { float sacc=pB0[0]+pB0[1]; _Pragma("unroll") for(int r=2;r<16;++r)sacc+=pB0[r]; _Pragma("unroll") for(int r=0;r<16;++r)sacc+=pB1[r]; l_reg+=sacc;
    pw0=(u32x4){PKW(pB0,0),PKW(pB0,2),PKW(pB0,4),PKW(pB0,6)};pw1=(u32x4){PKW(pB0,8),PKW(pB0,10),PKW(pB0,12),PKW(pB0,14)};pw2=(u32x4){PKW(pB1,0),PKW(pB1,2),PKW(pB1,4),PKW(pB1,6)};pw3=(u32x4){PKW(pB1,8),PKW(pB1,10),PKW(pB1,12),PKW(pB1,14)};
    SBAR(); pv(o,vb0+sl_cur,PAF(0),PAF(1),PAF(2),PAF(3)); }
  #undef PKW
  #undef PAF
  #undef VFR
  #undef PIN
  #undef MX3
  #undef GAPA
  #undef GAPB
  #undef EX
  #undef VRD
  #undef KRD
  #undef STEP
  #undef ENDW
  {auto rr=__builtin_amdgcn_permlane32_swap(__float_as_uint(l_reg),__float_as_uint(l_reg),false,false);l_reg=__uint_as_float(rr[0])+__uint_as_float(rr[1]);}
  if(hi==0)wsf[32+r32]=l_reg;asm volatile("s_waitcnt lgkmcnt(0)":::"memory");
  float rli[16];
  #pragma unroll
  for(int r=0;r<16;++r)rli[r]=__builtin_amdgcn_rcpf(wsf[32+crow(r,hi)]);
  bf16*Ow=Ou+(long)(wid*QBLK)*OP;
  { bf16*stg=(bf16*)(shm+LDS_OST)+wid*2048;
    #pragma unroll
    for(int r=0;r<16;++r){const int orow=crow(r,hi);
      #pragma unroll
      for(int d0=0;d0<2;++d0)stg[orow*64+d0*32+r32]=__float2bfloat16(o[d0][r]*rli[r]);}
    asm volatile("s_waitcnt lgkmcnt(0)":::"memory");
    #pragma unroll
    for(int i=0;i<4;++i){const int row=i*8+(lane>>3),ch=lane&7; const u32x4 v=*(const u32x4*)(stg+row*64+ch*8); ATTN_STORE16(Ow+(long)row*OP+ch*8,v);} }
  asm volatile("s_waitcnt lgkmcnt(0)\n\ts_barrier":::"memory");
  #undef DMA_K
  #undef DMA_V
  #undef CMASK
  #undef START
  #undef RESC
  #undef ROT
}
constexpr int ATTN_LDS_BYTES=LDS_BYTES;
#undef SBAR
#undef WAIT_BAR
}

struct MP { const float* in[33]; float* out; unsigned char* ws; };
typedef const float* const __attribute__((address_space(4))) * kargs_t;
#define KARGS() ({ kargs_t k_ = (kargs_t)__builtin_amdgcn_kernarg_segment_ptr(); asm volatile("" : "+s"(k_)); k_; })
#define WSP(K, off) ((unsigned char*)(K)[34] + (off))

__global__ void __launch_bounds__(NT, 2) mega(MP P) {
  cg::grid_group grid = cg::this_grid();
  extern __shared__ __attribute__((aligned(16))) char lds[];
  {
    kargs_t K = KARGS();
    st_adaln(K[1], K[3], K[4], K[5], (float*)WSP(K, WS_MODV), lds);
    st_rope((float*)WSP(K, WS_ROPE));
  }
  grid.sync();
#pragma nounroll
  for (int layer = 0; layer < 2; ++layer) {
    const bool last = layer == 1;
    {
      kargs_t K = KARGS();
      st_weights(K[8], K[26], K[29], K[30], K[31], layer, (bf16_t*)WSP(K, WS_WIN), (bf16_t*)WSP(K, WS_WOUT), (bf16_t*)WSP(K, WS_WGU), (bf16_t*)WSP(K, WS_WD), lds);
    }
    { kargs_t K = KARGS(); const int bid = BIDX, G = gridDim.x;
      for (int it = bid; it < SEQ / 64; it += G) hyfilt_item<SEQ>(it, K[19] + layer * 33 * 64, K[20] + layer * 64, K[21] + layer * 64, K[22] + layer * 4096, K[23] + layer * 64, K[24] + (size_t)layer * 65536, (float*)WSP(K, WS_HK), lds);
      if (!last) for (int it = bid; it < CTXL / 64; it += G) hyfilt_item<CTXL>(it, K[19] + layer * 33 * 64, K[20] + layer * 64, K[21] + layer * 64, K[22] + layer * 4096, K[23] + layer * 64, K[24] + (size_t)layer * 65536, (float*)WSP(K, WS_HKC), lds);
    }
    { kargs_t K = KARGS();
      const float* xl_src = layer == 0 ? K[0] : K[33]; const float* xc_src = layer == 0 ? K[2] : (const float*)WSP(K, WS_XC);
      st_normmod(xl_src, xc_src, K[6] + layer * 1024, (const float*)WSP(K, WS_MODV) + (size_t)layer * 5 * 6144, 0, 1024, (bf16_t*)WSP(K, WS_H));
    }
    grid.sync();
    {
      kargs_t K = KARGS();
      PInProj p{(const bf16_t*)WSP(K, WS_H), (const bf16_t*)WSP(K, WS_WIN), (bf16_t*)WSP(K, WS_QK), (bf16_t*)WSP(K, WS_VZ), (bf16_t*)WSP(K, WS_XBC), (bf16_t*)WSP(K, WS_HY), (float*)WSP(K, WS_DT), 1024};
      st_gemm(p, MTOK / 256, NPAD / 128, lds);
    }
    grid.sync();
    {
      kargs_t K = KARGS();
      st_prep_qk((bf16_t*)WSP(K, WS_QK), K[9] + layer * 64, K[10] + layer * 64, (const float*)WSP(K, WS_ROPE));
    }
    { kargs_t K = KARGS();
      st_prep_hy((const bf16_t*)WSP(K, WS_HY), K[17] + layer * 3 * 768, K[18] + layer * 768, (bf16_t*)WSP(K, WS_HYT), last ? 0 : 1, lds);
    }
    { kargs_t K = KARGS(); const int bid = BIDX, G = gridDim.x;
      for (int it = bid; it < 4 * 34 * 6; it += G)
        ssd1_item(it, (const bf16_t*)WSP(K, WS_XBC), (const float*)WSP(K, WS_DT), K[11] + layer * 3 * 640, K[12] + layer * 640, K[13] + layer * 12, K[14] + layer * 12,
                  (float*)WSP(K, WS_Y), (float*)WSP(K, WS_ST), (float*)WSP(K, WS_DEC), lds);
    }
    grid.sync();
    {
      { kargs_t K2 = KARGS(); st_ssd_scan2((float*)WSP(K2, WS_ST), (const float*)WSP(K2, WS_DEC)); }
      kargs_t K = KARGS(); const int bid = BIDX, G = gridDim.x;
      const int n_ssd = 0, n_att = last ? 384 : 408, n_hyl = 1024, n_hyc = last ? 0 : 1024;
      const int total = n_ssd + n_att + n_hyl + n_hyc;
      for (int it = bid; it < total; it += G) {
        int i2 = it;
        if (i2 < n_att) {
          int b, h, nt; size_t qrow;
          if (i2 < 384) { b = i2 / 96; const int rem = i2 % 96; h = rem >> 4; qrow = (size_t)b * TPB + CTXL + (rem & 15) * 256; nt = TPB / 64; }
          else { const int uc = i2 - 384; b = uc / 6; h = uc % 6; qrow = (size_t)b * TPB; nt = CTXL / 64; }
          const int kvh = h / 3;
          const attn_body::bf16* QKp = (const attn_body::bf16*)WSP(K, WS_QK); const attn_body::bf16* VZp = (const attn_body::bf16*)WSP(K, WS_VZ);
          attn_body::attn_unit<8>(QKp + qrow * 512 + h * 64, QKp + (size_t)b * TPB * 512 + 384 + kvh * 64, VZp + (size_t)b * TPB * 512 + kvh * 64,
                                  (attn_body::bf16*)WSP(K, WS_H) + qrow * 1024 + h * 64, nt, lds);
          continue; } i2 -= n_att;
        if (i2 < n_hyl) { hyconv_item<SEQ>(i2, (const bf16_t*)WSP(K, WS_HYT), (const float*)WSP(K, WS_HK), K[25] + layer * 512, (bf16_t*)WSP(K, WS_H), CTXL, lds); continue; } i2 -= n_hyl;
        hyconv_item<CTXL>(i2, (const bf16_t*)WSP(K, WS_HYT) + (size_t)4 * 768 * SEQ, (const float*)WSP(K, WS_HKC), K[25] + layer * 512, (bf16_t*)WSP(K, WS_H), 0, lds);
      }
    }
    grid.sync();
    {
      kargs_t K = KARGS();
      { const int bid = BIDX, G = gridDim.x, nit = last ? 4 * 32 * 2 : 4 * 34 * 2;
        for (int it = bid; it < nit; it += G) { const int g = it & 1, bc = it >> 1; const int b = last ? bc >> 5 : bc / 34, cidx = last ? 2 + (bc & 31) : bc % 34;
          ssd3_item(b, cidx, g, (const bf16_t*)WSP(K, WS_XBC), (const bf16_t*)WSP(K, WS_VZ), (const float*)WSP(K, WS_DT), K[11] + layer * 3 * 640, K[12] + layer * 640, K[13] + layer * 12, K[14] + layer * 12,
                    K[15] + layer * 6, K[16] + layer * 384, (const float*)WSP(K, WS_Y), (const float*)WSP(K, WS_ST), (bf16_t*)WSP(K, WS_H), lds); } }
      const int t = TIDX; if (BIDX == 0 && t < 256) ((int*)WSP(K, WS_CTL))[t] = 0;
    }
    grid.sync();
    {
      kargs_t K = KARGS();
      const float* xl_src = layer == 0 ? K[0] : K[33]; const float* xc_src = layer == 0 ? K[2] : (const float*)WSP(K, WS_XC);
      POutProj p{(const bf16_t*)WSP(K, WS_H), (const bf16_t*)WSP(K, WS_WOUT), xl_src, xc_src, (float*)K[33], (float*)WSP(K, WS_XC), (const float*)WSP(K, WS_MODV) + (size_t)layer * 5 * 6144 + 2048, last ? 1 : 0, 1024};
      st_gemm(p, MTOK / 256, 8, lds);
    }
    grid.sync();
    {
      kargs_t K = KARGS();
      st_router(K[33], (const float*)WSP(K, WS_XC), K[7] + layer * 1024, (const float*)WSP(K, WS_MODV) + (size_t)layer * 5 * 6144, K[27], K[28], (bf16_t*)WSP(K, WS_H), (int*)WSP(K, WS_CTL),
                (int*)WSP(K, WS_MOEM), (float*)WSP(K, WS_MOEM + 128 * 1024), last ? 1 : 0);
    }
    grid.sync();
    { kargs_t K = KARGS(); st_moe_plan((int*)WSP(K, WS_CTL), (int*)WSP(K, WS_MOEM + 384 * 1024)); }
    grid.sync();
    { kargs_t K = KARGS();
      st_moe_gather((const bf16_t*)WSP(K, WS_H), (bf16_t*)WSP(K, WS_H2S), (int*)WSP(K, WS_CTL), (const int*)WSP(K, WS_MOEM), (const float*)WSP(K, WS_MOEM + 128 * 1024),
                    (int*)WSP(K, WS_MOEM + 384 * 1024), (float*)WSP(K, WS_MOEM + 512 * 1024), last ? 1 : 0);
    }
    grid.sync();
    { kargs_t K = KARGS();
      PMoe1 p{(const bf16_t*)WSP(K, WS_H2S), (const bf16_t*)WSP(K, WS_WGU), (bf16_t*)WSP(K, WS_ACT), (const int*)WSP(K, WS_CTL), (const float*)WSP(K, WS_MOEM + 512 * 1024), 1024};
      st_gemm(p, MOE_ROWS / 256, 8, lds);
    }
    grid.sync();
    { kargs_t K = KARGS();
      PMoe2 p{(const bf16_t*)WSP(K, WS_ACT), (const bf16_t*)WSP(K, WS_WD), (float*)K[33], (float*)WSP(K, WS_XC), (const float*)WSP(K, WS_MODV) + (size_t)layer * 5 * 6144 + 5120, (const int*)WSP(K, WS_CTL),
              (const int*)WSP(K, WS_MOEM + 384 * 1024), 512};
      st_gemm(p, MOE_ROWS / 256, 8, lds);
    }
    grid.sync();
  }
  { kargs_t K = KARGS(); st_final((float*)K[33], K[32]); }
}

extern "C" void kernel_launch(void* const* d_in, const int* in_sizes, int n_in, void* d_out, int out_size, void* d_ws, size_t ws_size, hipStream_t stream) {
  if (n_in != 33 || ws_size < WS_END) { fprintf(stderr, "kernel_launch: unexpected n_in %d / ws %zu\n", n_in, ws_size); return; }
  static int grid_blocks = 0;
  if (!grid_blocks) {
    int dev = 0, cus = 0, per_cu = 0;
    (void)hipGetDevice(&dev);
    (void)hipDeviceGetAttribute(&cus, hipDeviceAttributeMultiprocessorCount, dev);
    (void)hipFuncSetAttribute((const void*)mega, hipFuncAttributeMaxDynamicSharedMemorySize, LDS_BYTES);
    (void)hipOccupancyMaxActiveBlocksPerMultiprocessor(&per_cu, mega, NT, LDS_BYTES);
    if (per_cu < 1) per_cu = 1;
    if (per_cu > 2) per_cu = 2;
    grid_blocks = cus * per_cu;
  }
  MP p{};
  for (int i = 0; i < 33; ++i) p.in[i] = (const float*)d_in[i];
  p.out = (float*)d_out; p.ws = (unsigned char*)d_ws;
  void* args[] = {&p};
  hipError_t e = hipLaunchCooperativeKernel((const void*)mega, dim3(grid_blocks), dim3(NT), args, LDS_BYTES, stream);
  if (e != hipSuccess) fprintf(stderr, "cooperative launch failed: %s (grid %d)\n", hipGetErrorString(e), grid_blocks);
}
```

```cpp
#include <hip/hip_runtime.h>
#include <hip/hip_cooperative_groups.h>
#include <cstdio>
#include <cstdint>
namespace cg = cooperative_groups;

typedef unsigned short bf16_t;
typedef short bf16x8 __attribute__((ext_vector_type(8)));
typedef float f32x4 __attribute__((ext_vector_type(4)));
typedef unsigned u32x4 __attribute__((ext_vector_type(4)));
typedef unsigned u32x2 __attribute__((ext_vector_type(2)));

constexpr int NB = 4, SEQ = 4096, CTXL = 256, DM = 1024, TPB = 4352, MTOK = NB * TPB;
constexpr int DIN = 2444, NPAD = 2560;
constexpr float EPS = 1e-6f;
constexpr float C2 = 0.125f * 1.4426950408889634f;
constexpr int MOE_ROWS = 23552;
constexpr int NT = 512;
constexpr int LDS_BYTES = 147456;

constexpr size_t MiB = 1u << 20;
constexpr size_t WS_CTL = 0;
constexpr size_t WS_MODV = 1 * MiB;
constexpr size_t WS_ROPE = 2 * MiB;
constexpr size_t WS_MOEM = 3 * MiB;
constexpr size_t WS_DT = 4 * MiB;
constexpr size_t WS_HKC = 5 * MiB;
constexpr size_t WS_XC = 6 * MiB;
constexpr size_t WS_WIN = 10 * MiB;
constexpr size_t WS_WOUT = 15 * MiB;
constexpr size_t WS_WGU = 17 * MiB;
constexpr size_t WS_WD = 33 * MiB;
constexpr size_t WS_HK = 41 * MiB;
constexpr size_t WS_H = 57 * MiB;
constexpr size_t WS_QK = 91 * MiB;
constexpr size_t WS_VZ = 108 * MiB;
constexpr size_t WS_XBC = 125 * MiB;
constexpr size_t WS_HY = WS_XBC + (size_t)MTOK * 768 * 2;
constexpr size_t WS_HYT = WS_HY + (size_t)MTOK * 768 * 2;
constexpr size_t WS_ST = WS_HYT + (size_t)MTOK * 768 * 2;
constexpr size_t WS_Y = WS_ST + (size_t)4 * 34 * 2 * 6 * 4096 * 4;
constexpr size_t WS_END = WS_Y + (size_t)MTOK * 384 * 4;
constexpr size_t WS_DEC = WS_DT + 900 * 1024;
constexpr size_t WS_H2S = WS_QK;
constexpr size_t WS_ACT = WS_H2S + (size_t)MOE_ROWS * 1024 * 2;
static_assert(WS_END <= 256 * MiB, "ws");
static_assert(WS_ACT + (size_t)MOE_ROWS * 512 * 2 <= WS_HYT, "moe alias");

constexpr int CT_CNT = 0, CT_FILL = 32, CT_BASE = 64, CT_NT = 96, CT_TP = 128;
constexpr int CT_BAR = 4096;
constexpr int PROBE_A = -1, PROBE_B = -1;

__device__ __forceinline__ int opq_v(int v) { asm volatile("" : "+v"(v)); return v; }
__device__ __forceinline__ int opq_s(int v) { asm volatile("" : "+s"(v)); return v; }
#define TIDX opq_v((int)threadIdx.x)
#define BIDX opq_s((int)blockIdx.x)
__device__ __forceinline__ unsigned f2bf(float f) { unsigned u = __float_as_uint(f); return (u + 0x7fffu + ((u >> 16) & 1u)) >> 16; }
__device__ __forceinline__ float bf2f(bf16_t h) { return __uint_as_float(((unsigned)h) << 16); }
__device__ __forceinline__ float wave_sum(float v) {
#pragma unroll
  for (int o = 1; o < 64; o <<= 1) v += __shfl_xor(v, o);
  return v;
}
__device__ __forceinline__ float siluf(float v) { return v / (1.0f + __expf(-v)); }
__device__ __forceinline__ float* xrow(const float* xl, const float* xc, int r) {
  const int b = r / TPB, j = r - b * TPB;
  return (float*)(j < CTXL ? xc + ((size_t)b * CTXL + j) * DM : xl + ((size_t)b * SEQ + (j - CTXL)) * DM);
}
__device__ __forceinline__ int mrow_of(int r) { const int b = r / TPB, j = r - b * TPB; return j < CTXL ? 4 : b; }

__device__ __forceinline__ void st_adaln(const float* c, const float* c_ctx, const float* w_mod, const float* b_mod, float* modv, char* lds) {
  float (*sc)[1024] = (float (*)[1024])lds;
  float (*red)[5][64] = (float (*)[5][64])(lds + 5 * 1024 * 4);
  const int tid = TIDX;
  for (int it = BIDX; it < 192; it += gridDim.x) {
    const int layer = it / 96, n0 = (it % 96) * 64;
    for (int i = tid; i < 5 * 1024; i += NT) { const int r = i >> 10, k = i & 1023; const float v = r < 4 ? c[r * 1024 + k] : c_ctx[k]; sc[r][k] = v / (1.0f + expf(-v)); }
    __syncthreads();
    const int kg = tid >> 6, n = tid & 63;
    float acc[5] = {0.f, 0.f, 0.f, 0.f, 0.f};
    for (int k = kg; k < 1024; k += 8) { const float w = w_mod[((size_t)layer * 1024 + k) * 6144 + n0 + n];
#pragma unroll
      for (int r = 0; r < 5; ++r) acc[r] += sc[r][k] * w; }
#pragma unroll
    for (int r = 0; r < 5; ++r) red[kg][r][n] = acc[r];
    __syncthreads();
    if (tid < 320) { const int r = tid >> 6, nn = tid & 63; float s = 0.f;
#pragma unroll
      for (int g = 0; g < 8; ++g) s += red[g][r][nn];
      modv[((size_t)layer * 5 + r) * 6144 + n0 + nn] = s + b_mod[layer * 6144 + n0 + nn]; }
    __syncthreads();
  }
}
__device__ __forceinline__ void st_rope(float* rope) {
  for (int i = BIDX * NT + TIDX; i < 4096 * 32; i += gridDim.x * NT) {
    const int t = i >> 5, d = i & 31, m = d & 15;
    const float inv = powf(10000.0f, -(float)(2 * m) / 32.0f);
    const float pos = (float)(d < 16 ? (t >> 6) : (t & 63));
    const float ang = pos * inv;
    rope[2 * i] = cosf(ang); rope[2 * i + 1] = sinf(ang);
  }
}

__device__ __forceinline__ void st_normmod(const float* xl, const float* xc, const float* g, const float* modv_layer, int off_sh, int off_sc, bf16_t* H) {
  const int lane = TIDX & 63, gw = BIDX * 8 + (TIDX >> 6), ngw = gridDim.x * 8;
  for (int r = gw; r < MTOK; r += ngw) {
    const float* xr = xrow(xl, xc, r); const float* mv = modv_layer + (size_t)mrow_of(r) * 6144;
    f32x4 v[4]; float ss = 0.f;
#pragma unroll
    for (int j = 0; j < 4; ++j) { v[j] = *(const f32x4*)(xr + 4 * lane + 256 * j); ss += v[j].x * v[j].x + v[j].y * v[j].y + v[j].z * v[j].z + v[j].w * v[j].w; }
    const float rstd = rsqrtf(wave_sum(ss) * (1.0f / DM) + EPS);
#pragma unroll
    for (int j = 0; j < 4; ++j) { const int k = 4 * lane + 256 * j;
      const f32x4 gg = *(const f32x4*)(g + k), sh = *(const f32x4*)(mv + off_sh + k), sc = *(const f32x4*)(mv + off_sc + k);
      const float o0 = v[j].x * rstd * gg.x * (1.f + sc.x) + sh.x, o1 = v[j].y * rstd * gg.y * (1.f + sc.y) + sh.y;
      const float o2 = v[j].z * rstd * gg.z * (1.f + sc.z) + sh.z, o3 = v[j].w * rstd * gg.w * (1.f + sc.w) + sh.w;
      u32x2 w; w.x = f2bf(o0) | (f2bf(o1) << 16); w.y = f2bf(o2) | (f2bf(o3) << 16);
      *(u32x2*)(H + (size_t)r * DM + k) = w; }
  }
}

template <int MODE> __device__ __forceinline__ void tr_tile(const float* src, const float* src2, int ldsrc, int K, bf16_t* out, int n0, int k0, char* lds) {
  float (*tile)[65] = (float (*)[65])lds;
  const int tid = TIDX;
#pragma unroll
  for (int i = 0; i < 8; ++i) { const int kk = (tid >> 6) + 8 * i, nn = tid & 63, n = n0 + nn; float v = 0.f;
    if (MODE == 0) { const int col = n < 1676 ? n : (n < 1792 ? -1 : n - 116); if (col >= 0) v = src[(size_t)(k0 + kk) * ldsrc + col]; }
    else if (MODE == 1) { v = src[(size_t)(k0 + kk) * ldsrc + n]; }
    else { const int tb = n >> 7, q = n & 127; v = q < 64 ? src[(size_t)(k0 + kk) * ldsrc + 64 * tb + q] : src2[(size_t)(k0 + kk) * ldsrc + 64 * tb + q - 64]; }
    tile[kk][nn] = v; }
  __syncthreads();
#pragma unroll
  for (int i = 0; i < 4; ++i) { const int nn = (tid >> 5) + 16 * i, kk = (tid & 31) * 2;
    *(unsigned*)(out + (size_t)(n0 + nn) * K + k0 + kk) = f2bf(tile[kk][nn]) | (f2bf(tile[kk + 1][nn]) << 16); }
  __syncthreads();
}
__device__ __forceinline__ void st_weights(const float* w_in, const float* w_out, const float* w_gate, const float* w_up, const float* w_down, int layer,
                                           bf16_t* WIN, bf16_t* WOUT, bf16_t* WGU, bf16_t* WD, char* lds) {
  for (int it = BIDX; it < 3968; it += gridDim.x) {
    if (it < 640) tr_tile<0>(w_in + (size_t)layer * 1024 * DIN, nullptr, DIN, 1024, WIN, (it % 40) * 64, (it / 40) * 64, lds);
    else if (it < 896) { const int i2 = it - 640; tr_tile<1>(w_out + (size_t)layer * 1024 * 1024, nullptr, 1024, 1024, WOUT, (i2 & 15) * 64, (i2 >> 4) * 64, lds); }
    else if (it < 2944) { const int i2 = it - 896, e = i2 >> 7, t = i2 & 127;
      tr_tile<2>(w_gate + ((size_t)layer * 16 + e) * 1024 * 256, w_up + ((size_t)layer * 16 + e) * 1024 * 256, 256, 1024, WGU + (size_t)e * 512 * 1024, (t & 7) * 64, (t >> 3) * 64, lds); }
    else { const int i2 = it - 2944, e = i2 >> 6, t = i2 & 63;
      tr_tile<1>(w_down + ((size_t)layer * 16 + e) * 256 * 1024, nullptr, 1024, 256, WD + (size_t)e * 1024 * 256, (t & 15) * 64, (t >> 4) * 64, lds); }
  }
}

template <class P> __device__ __forceinline__ void st_gemm(const P& p, int ntm, int ntn, char* lds) {
  bf16_t (*As)[72] = (bf16_t (*)[72])lds;
  bf16_t (*Bs)[72] = (bf16_t (*)[72])(lds + 256 * 72 * 2);
  const int tid = TIDX, lane = tid & 63, w = tid >> 6;
  for (int it = BIDX; it < ntm * ntn; it += gridDim.x) {
    const int mt = it / ntn, nt = it % ntn;
    if (!p.valid(mt)) continue;
    const int m0 = mt * 256, n0 = nt * 128;
    f32x4 acc[2][8];
#pragma unroll
    for (int a = 0; a < 2; ++a)
#pragma unroll
      for (int b = 0; b < 8; ++b) acc[a][b] = (f32x4){0.f, 0.f, 0.f, 0.f};
    const int K = p.K;
    for (int k0 = 0; k0 < K; k0 += 64) {
#pragma unroll
      for (int i = 0; i < 4; ++i) { const int ch = tid + NT * i, r = ch >> 3, kc = (ch & 7) * 8;
        const bf16_t* ap = p.arow(m0 + r); *(u32x4*)&As[r][kc] = *(const u32x4*)(ap + k0 + kc); }
#pragma unroll
      for (int i = 0; i < 2; ++i) { const int ch = tid + NT * i, r = ch >> 3, kc = (ch & 7) * 8;
        const bf16_t* bp = p.brow(mt, n0 + r, k0); *(u32x4*)&Bs[r][kc] = *(const u32x4*)(bp + kc); }
      __syncthreads();
#pragma unroll
      for (int kk = 0; kk < 2; ++kk) {
        bf16x8 a[2], b[8];
#pragma unroll
        for (int mi = 0; mi < 2; ++mi) a[mi] = *(const bf16x8*)&As[32 * w + 16 * mi + (lane & 15)][kk * 32 + 8 * (lane >> 4)];
#pragma unroll
        for (int ni = 0; ni < 8; ++ni) b[ni] = *(const bf16x8*)&Bs[16 * ni + (lane & 15)][kk * 32 + 8 * (lane >> 4)];
#pragma unroll
        for (int mi = 0; mi < 2; ++mi)
#pragma unroll
          for (int ni = 0; ni < 8; ++ni) acc[mi][ni] = __builtin_amdgcn_mfma_f32_16x16x32_bf16(a[mi], b[ni], acc[mi][ni], 0, 0, 0);
      }
      __syncthreads();
    }
    p.epi(acc, mt, m0, n0, w, lane);
  }
}

struct PInProj {
  const bf16_t* H; const bf16_t* W; bf16_t *QK, *VZ, *XBC, *HY; float* DT; int K;
  __device__ bool valid(int) const { return true; }
  __device__ const bf16_t* arow(int m) const { return H + (size_t)m * DM; }
  __device__ const bf16_t* brow(int, int n, int k0) const { return W + (size_t)n * DM + k0; }
  __device__ void epi(const f32x4 (&acc)[2][8], int, int m0, int n0, int w, int lane) const {
#pragma unroll
    for (int mi = 0; mi < 2; ++mi)
#pragma unroll
      for (int ni = 0; ni < 8; ++ni)
#pragma unroll
        for (int rg = 0; rg < 4; ++rg) { const int row = m0 + 32 * w + 16 * mi + 4 * (lane >> 4) + rg, col = n0 + 16 * ni + (lane & 15); const float v = acc[mi][ni][rg];
          if (col < 512) QK[(size_t)row * 512 + col] = (bf16_t)f2bf(v);
          else if (col < 1024) VZ[(size_t)row * 512 + col - 512] = (bf16_t)f2bf(v);
          else if (col < 1792) { XBC[(size_t)row * 768 + col - 1024] = (bf16_t)f2bf(v); if (col >= 1664 && col < 1676) DT[(size_t)row * 12 + col - 1664] = v; }
          else HY[(size_t)row * 768 + col - 1792] = (bf16_t)f2bf(v); }
  }
};
struct POutProj {
  const bf16_t* A; const bf16_t* W; const float *xl_src, *xc_src; float *xl_dst, *xc_dst; const float* gate;   int skip_ctx; int K;
  __device__ bool valid(int mt) const { return !(skip_ctx && ((mt * 256) % TPB) < CTXL); }
  __device__ const bf16_t* arow(int m) const { return A + (size_t)m * DM; }
  __device__ const bf16_t* brow(int, int n, int k0) const { return W + (size_t)n * DM + k0; }
  __device__ void epi(const f32x4 (&acc)[2][8], int, int m0, int n0, int w, int lane) const {
#pragma unroll
    for (int mi = 0; mi < 2; ++mi)
#pragma unroll
      for (int rg = 0; rg < 4; ++rg) { const int row = m0 + 32 * w + 16 * mi + 4 * (lane >> 4) + rg;
        const float* xs = xrow(xl_src, xc_src, row); float* xd = xrow(xl_dst, xc_dst, row); const float* gt = gate + (size_t)mrow_of(row) * 6144;
#pragma unroll
        for (int ni = 0; ni < 8; ++ni) { const int col = n0 + 16 * ni + (lane & 15); xd[col] = xs[col] + gt[col] * acc[mi][ni][rg]; } }
  }
};
__device__ __forceinline__ void pair_experts(int pidx, int& eA, int& eB) {
  const int g = pidx / 6, t = pidx - 6 * g; const int i = t < 3 ? 0 : (t < 5 ? 1 : 2); const int j = t < 3 ? t + 1 : (t < 5 ? t - 1 : 3);
  eA = 4 * g + i; eB = 4 * g + j;
}
struct PMoe1 {
  const bf16_t* H2S; const bf16_t* WGU; bf16_t* ACT; const int* ctl; const float* sorted_w; int K;
  __device__ bool valid(int mt) const { return mt < ctl[CT_NT]; }
  __device__ const bf16_t* arow(int m) const { return H2S + (size_t)m * DM; }
  __device__ const bf16_t* brow(int mt, int n, int k0) const { int eA, eB; pair_experts(ctl[CT_TP + mt], eA, eB); const int e = n < 512 ? eA : eB;
    return WGU + ((size_t)e * 512 + (n & 511)) * DM + k0; }
  __device__ void epi(const f32x4 (&acc)[2][8], int, int m0, int n0, int w, int lane) const {
    const int half = n0 >> 9, tb = (n0 & 511) >> 7;
#pragma unroll
    for (int mi = 0; mi < 2; ++mi)
#pragma unroll
      for (int rg = 0; rg < 4; ++rg) { const int slot = m0 + 32 * w + 16 * mi + 4 * (lane >> 4) + rg; const float wt = sorted_w[2 * slot + half];
#pragma unroll
        for (int ni = 0; ni < 4; ++ni) { const float g = acc[mi][ni][rg], u = acc[mi][ni + 4][rg]; const int j = 64 * tb + 16 * ni + (lane & 15);
          ACT[(size_t)slot * 512 + half * 256 + j] = (bf16_t)f2bf(siluf(g) * u * wt); } }
  }
};
struct PMoe2 {
  const bf16_t* ACT; const bf16_t* WD; float *xl, *xc; const float* gate;   const int* ctl; const int* sorted_tok; int K;
  __device__ bool valid(int mt) const { return mt < ctl[CT_NT]; }
  __device__ const bf16_t* arow(int m) const { return ACT + (size_t)m * 512; }
  __device__ const bf16_t* brow(int mt, int n, int k0) const { int eA, eB; pair_experts(ctl[CT_TP + mt], eA, eB); const int e = k0 < 256 ? eA : eB;
    return WD + ((size_t)e * 1024 + n) * 256 + (k0 & 255); }
  __device__ void epi(const f32x4 (&acc)[2][8], int, int m0, int n0, int w, int lane) const {
#pragma unroll
    for (int mi = 0; mi < 2; ++mi)
#pragma unroll
      for (int rg = 0; rg < 4; ++rg) { const int slot = m0 + 32 * w + 16 * mi + 4 * (lane >> 4) + rg; const int r = sorted_tok[slot];
        if (r >= 0) { float* xd = xrow(xl, xc, r); const float* gt = gate + (size_t)mrow_of(r) * 6144;
#pragma unroll
          for (int ni = 0; ni < 8; ++ni) { const int col = n0 + 16 * ni + (lane & 15); xd[col] += gt[col] * acc[mi][ni][rg]; } } }
  }
};

__device__ __forceinline__ void st_prep_qk(bf16_t* QK, const float* qn, const float* kn, const float* rope) {
  const int lane = TIDX & 63, gw = BIDX * 8 + (TIDX >> 6), ngw = gridDim.x * 8;
  for (int it = gw; it < MTOK * 8; it += ngw) {
    const int r = it >> 3, hh = it & 7, j = r % TPB;
    bf16_t* p = QK + (size_t)r * 512 + hh * 64 + lane;
    const float v = bf2f(*p);
    const float ss = wave_sum(v * v);
    float y = v * rsqrtf(ss * (1.0f / 64.0f) + EPS) * (hh < 6 ? qn[lane] : kn[lane]);
    if (j >= CTXL) { const int t = j - CTXL; const float other = __shfl_xor(y, 32); const float cs = rope[(t * 32 + (lane & 31)) * 2], sn = rope[(t * 32 + (lane & 31)) * 2 + 1];
      y = lane < 32 ? y * cs - other * sn : y * cs + other * sn; }
    if (hh < 6) y *= C2;
    *p = (bf16_t)f2bf(y);
  }
}

__device__ __forceinline__ void st_prep_hy(const bf16_t* HY, const float* cw, const float* cb, bf16_t* HYT, int do_ctx, char* lds) {
  float (*tile)[65] = (float (*)[65])lds;
  const int nlat = 4 * 64 * 12, nitem = nlat + (do_ctx ? 4 * 4 * 12 : 0), tid = TIDX;
  for (int it = BIDX; it < nitem; it += gridDim.x) {
    int b, tt, ct, L, joff; bf16_t* outb;
    if (it < nlat) { b = it / 768; tt = (it % 768) / 12; ct = it % 12; L = SEQ; joff = CTXL; outb = HYT + (size_t)b * 768 * SEQ; }
    else { const int i2 = it - nlat; b = i2 / 48; tt = (i2 % 48) / 12; ct = i2 % 12; L = CTXL; joff = 0; outb = HYT + (size_t)4 * 768 * SEQ + (size_t)b * 768 * CTXL; }
    const int t0 = tt * 64, c0 = ct * 64;
    for (int e = tid; e < 66 * 64; e += NT) { const int rr = e >> 6, cc = e & 63, t = t0 - 1 + rr;
      tile[rr][cc] = (t >= 0 && t < L) ? bf2f(HY[((size_t)b * TPB + joff + t) * 768 + c0 + cc]) : 0.f; }
    __syncthreads();
    for (int e = tid; e < 64 * 64; e += NT) { const int cc = e >> 6, tl = e & 63, c = c0 + cc;
      const float v = cw[c] * tile[tl][cc] + cw[768 + c] * tile[tl + 1][cc] + cw[1536 + c] * tile[tl + 2][cc] + cb[c];
      outb[(size_t)c * L + t0 + tl] = (bf16_t)f2bf(v); }
    __syncthreads();
  }
}

template <int L> __device__ __forceinline__ void hyfilt_item(int item, const float* w1, const float* b1, const float* fr, const float* w2, const float* b2, const float* w3, float* HK, char* lds) {
  float* S0 = (float*)lds; float* S1 = S0 + 64 * 64; float* S2 = S1 + 64 * 64;
  const int tid = TIDX, n0 = item * 64, lane = tid & 63, wv = tid >> 6;
  for (int e = tid; e < 64 * 33; e += NT) { const int pp = e / 33, f = e % 33; const int n = n0 + pp; float v;
    if (f == 0) v = (float)n / (float)(L - 1);
    else { const int m = (f - 1) & 15; const float band = 1e-4f + (float)m * ((15.0f - 1e-4f) / 15.0f); const float wpos = (6.283185307179586f / (float)L) * (float)n;
      v = f <= 16 ? cosf(wpos * band) : -sinf(wpos * band); }
    S0[pp * 33 + f] = v; }
  for (int e = tid; e < 33 * 64; e += NT) S1[e] = w1[e];
  __syncthreads();
  for (int e = tid; e < 64 * 64; e += NT) { const int pp = e >> 6, j = e & 63; float a = b1[j];
    for (int f = 0; f < 33; ++f) a += S0[pp * 33 + f] * S1[f * 64 + j];
    S2[pp * 64 + j] = sinf(fr[j] * a); }
  __syncthreads();
  for (int e = tid; e < 64 * 64; e += NT) S0[e] = w2[e];
  __syncthreads();
  for (int e = tid; e < 64 * 64; e += NT) { const int pp = e >> 6, j = e & 63; float a = b2[j];
    for (int f = 0; f < 64; ++f) a += S2[pp * 64 + f] * S0[f * 64 + j];
    S1[pp * 64 + j] = sinf(fr[j] * a); }
  __syncthreads();
  for (int ch = 0; ch < 16; ++ch) {
    const int col = ch * 64 + lane; float acc[8];
#pragma unroll
    for (int i = 0; i < 8; ++i) acc[i] = 0.f;
    for (int j = 0; j < 64; ++j) { const float wv3 = w3[j * 1024 + col];
#pragma unroll
      for (int i = 0; i < 8; ++i) acc[i] += S1[(wv * 8 + i) * 64 + j] * wv3; }
    const int c = col & 255; const float delta = 3.0701134573253943f + (float)c * ((15.350567286626972f - 3.0701134573253943f) / 255.0f);
#pragma unroll
    for (int i = 0; i < 8; ++i) { const int pp = wv * 8 + i; const float t = (float)(n0 + pp) / (float)(L - 1); S2[lane * 65 + pp] = acc[i] * expf(-t * delta); }
    __syncthreads();
    const int dir = ch >> 3, order = (ch >> 2) & 1;
#pragma unroll
    for (int i = 0; i < 8; ++i) { const int cl = wv * 8 + i, c2 = (ch * 64 + cl) & 255, n = n0 + lane; const float v = S2[cl * 65 + lane];
      float* dst = HK + ((size_t)order * 256 + c2) * (2 * L);
      if (dir == 0) dst[n] = v; else if (n >= 1) dst[2 * L - n] = v;
      if (dir == 1 && n == 0) dst[L] = 0.f; }
    __syncthreads();
  }
}

template <int L> __device__ __forceinline__ void hyconv_item(int item, const bf16_t* HYT, const float* HK, const float* hy_bias, bf16_t* MIX, int joff, char* lds) {
  float* kern = (float*)lds; float* z = kern + 2 * L;
  const int tid = TIDX, b = item >> 8, c = item & 255;
  const bf16_t* vp = HYT + ((size_t)b * 768 + c) * L; const bf16_t* x1p = vp + (size_t)256 * L; const bf16_t* x2p = vp + (size_t)512 * L;
  const bool act = tid < L / 8; const int tb = 8 * tid;
  for (int o = 0; o < 2; ++o) {
    if (o == 0) for (int t = tid; t < L; t += NT) z[t] = bf2f(vp[t]);
    const float* kp = HK + ((size_t)o * 256 + c) * (2 * L);
    for (int t = tid; t < 2 * L; t += NT) kern[t] = kp[t];
    __syncthreads();
    float acc[8], W[16];
#pragma unroll
    for (int i = 0; i < 8; ++i) acc[i] = 0.f;
    if (act) {
#pragma unroll
      for (int i = 0; i < 8; ++i) W[8 + i] = kern[(tb + i) & (2 * L - 1)];
      for (int s0 = 0; s0 < L; s0 += 8) {
        const int bb = (tb - s0 - 8) & (2 * L - 1);
#pragma unroll
        for (int i = 0; i < 8; ++i) W[i] = kern[bb + i];
        float zs[8];
#pragma unroll
        for (int j = 0; j < 8; ++j) zs[j] = z[s0 + j];
#pragma unroll
        for (int j = 0; j < 8; ++j)
#pragma unroll
          for (int i = 0; i < 8; ++i) acc[i] += W[8 + i - j] * zs[j];
#pragma unroll
        for (int i = 0; i < 8; ++i) W[8 + i] = W[i];
      }
    }
    __syncthreads();
    const float bias = hy_bias[o * 256 + c];
    if (act) {
#pragma unroll
      for (int i = 0; i < 8; ++i) { const int t = tb + i; const float zz = acc[i] + bias * z[t];
        if (o == 0) z[t] = bf2f(x1p[t]) * zz;
        else MIX[((size_t)b * TPB + joff + t) * DM + 768 + c] = (bf16_t)f2bf(bf2f(x2p[t]) * zz); }
    }
    __syncthreads();
  }
}

__device__ __forceinline__ void attn_unit_simple(int u, const bf16_t* QK, const bf16_t* VZ, bf16_t* MIX, char* lds) {
  bf16_t (*Ks)[72] = (bf16_t (*)[72])lds;
  bf16_t (*Vt)[72] = (bf16_t (*)[72])(lds + 64 * 72 * 2);
  bf16_t (*Ps)[16][72] = (bf16_t (*)[16][72])(lds + 2 * 64 * 72 * 2);
  const int tid = TIDX, lane = tid & 63, w = tid >> 6;
  int b, h, qrow0, nk;
  if (u < 768) { b = u / 192; const int rem = u % 192; h = rem >> 5; qrow0 = b * TPB + CTXL + (rem & 31) * 128; nk = TPB; }
  else { const int uc = u - 768; b = uc / 12; h = (uc % 12) >> 1; qrow0 = b * TPB + (uc & 1) * 128; nk = CTXL; }
  const int kvh = h / 3, key0 = b * TPB, l15 = lane & 15, l4 = lane >> 4;
  bf16x8 aq[2];
#pragma unroll
  for (int kk = 0; kk < 2; ++kk) aq[kk] = *(const bf16x8*)(QK + (size_t)(qrow0 + 16 * w + l15) * 512 + h * 64 + kk * 32 + 8 * l4);
  f32x4 O[4]; float m[4], l[4];
#pragma unroll
  for (int i = 0; i < 4; ++i) { O[i] = (f32x4){0.f, 0.f, 0.f, 0.f}; m[i] = -1e30f; l[i] = 0.f; }
  for (int kt = 0; kt < nk / 64; ++kt) {
    __syncthreads();
    { const int r = tid >> 3, c8 = (tid & 7) * 8; const size_t grow = (size_t)(key0 + kt * 64 + r) * 512;
      *(u32x4*)&Ks[r][c8] = *(const u32x4*)(QK + grow + 384 + kvh * 64 + c8);
      const bf16x8 vv = *(const bf16x8*)(VZ + grow + kvh * 64 + c8);
#pragma unroll
      for (int e = 0; e < 8; ++e) Vt[c8 + e][r] = (bf16_t)vv[e]; }
    __syncthreads();
    f32x4 s[4];
#pragma unroll
    for (int ni = 0; ni < 4; ++ni) s[ni] = (f32x4){0.f, 0.f, 0.f, 0.f};
#pragma unroll
    for (int kk = 0; kk < 2; ++kk)
#pragma unroll
      for (int ni = 0; ni < 4; ++ni) { const bf16x8 bk = *(const bf16x8*)&Ks[16 * ni + l15][32 * kk + 8 * l4]; s[ni] = __builtin_amdgcn_mfma_f32_16x16x32_bf16(aq[kk], bk, s[ni], 0, 0, 0); }
#pragma unroll
    for (int rg = 0; rg < 4; ++rg) {
      float mx = fmaxf(fmaxf(s[0][rg], s[1][rg]), fmaxf(s[2][rg], s[3][rg]));
      mx = fmaxf(mx, __shfl_xor(mx, 1)); mx = fmaxf(mx, __shfl_xor(mx, 2)); mx = fmaxf(mx, __shfl_xor(mx, 4)); mx = fmaxf(mx, __shfl_xor(mx, 8));
      const float mn = fmaxf(m[rg], mx), alpha = exp2f(m[rg] - mn); float rs = 0.f;
#pragma unroll
      for (int ni = 0; ni < 4; ++ni) { const float pv = exp2f(s[ni][rg] - mn); rs += pv; Ps[w][4 * l4 + rg][16 * ni + l15] = (bf16_t)f2bf(pv); }
      rs += __shfl_xor(rs, 1); rs += __shfl_xor(rs, 2); rs += __shfl_xor(rs, 4); rs += __shfl_xor(rs, 8);
      l[rg] = l[rg] * alpha + rs; m[rg] = mn;
#pragma unroll
      for (int ni = 0; ni < 4; ++ni) O[ni][rg] *= alpha;
    }
    __syncthreads();
#pragma unroll
    for (int kk = 0; kk < 2; ++kk) { const bf16x8 ap = *(const bf16x8*)&Ps[w][l15][32 * kk + 8 * l4];
#pragma unroll
      for (int ni = 0; ni < 4; ++ni) { const bf16x8 bv = *(const bf16x8*)&Vt[16 * ni + l15][32 * kk + 8 * l4]; O[ni] = __builtin_amdgcn_mfma_f32_16x16x32_bf16(ap, bv, O[ni], 0, 0, 0); } }
  }
#pragma unroll
  for (int rg = 0; rg < 4; ++rg) { const float il = 1.0f / l[rg]; const size_t row = (size_t)(qrow0 + 16 * w + 4 * l4 + rg);
#pragma unroll
    for (int ni = 0; ni < 4; ++ni) MIX[row * DM + h * 64 + 16 * ni + l15] = (bf16_t)f2bf(O[ni][rg] * il); }
  __syncthreads();
}

__device__ __forceinline__ void st_ssd_prep(const bf16_t* XBC, float* DT, const float* cw, const float* cb, const float* dt_bias, bf16_t* XBCC) {
  const size_t total = (size_t)MTOK * 640;
  for (size_t i = (size_t)BIDX * NT + TIDX; i < total; i += (size_t)gridDim.x * NT) {
    const int r = (int)(i / 640), ch = (int)(i % 640), j = r % TPB;
    const bool hasp = (j != 0 && j != CTXL), hasn = (j != CTXL - 1 && j != TPB - 1);
    float v = cw[640 + ch] * bf2f(XBC[(size_t)r * 768 + ch]) + cb[ch];
    if (hasp) v += cw[ch] * bf2f(XBC[(size_t)(r - 1) * 768 + ch]);
    if (hasn) v += cw[1280 + ch] * bf2f(XBC[(size_t)(r + 1) * 768 + ch]);
    XBCC[i] = (bf16_t)f2bf(siluf(v));
  }
  for (size_t i = (size_t)BIDX * NT + TIDX; i < (size_t)MTOK * 12; i += (size_t)gridDim.x * NT) {
    const float x = DT[i] + dt_bias[i % 12];
    DT[i] = x > 20.f ? x : log1pf(expf(x));
  }
}
__device__ __forceinline__ void ssd_scan_item(int item, const bf16_t* XBCC, const float* DT, const float* a_log, float* Y, char* lds) {
  const int half = TIDX >> 8, tid = TIDX & 255;
  float* base = (float*)(lds + half * 25088);
  float (*xs)[64] = (float (*)[64])base; float (*Bs)[64] = (float (*)[64])(base + 2048); float (*Cs)[64] = (float (*)[64])(base + 4096);
  float* dAs = base + 6144; float* dts = base + 6176;
  const int bh = 2 * item + half, b = bh / 6, h = bh % 6, g = h / 3, p = tid >> 2, q = tid & 3;
  for (int dir = 0; dir < 2; ++dir) {
    const float a = -expf(a_log[dir * 6 + h]);
    float st[16];
#pragma unroll
    for (int n = 0; n < 16; ++n) st[n] = 0.f;
    for (int ci = 0; ci < TPB / 32; ++ci) {
      for (int e = tid; e < 32 * 64; e += 256) { const int i = e >> 6, cc = e & 63, qi = ci * 32 + i;
        const int j = dir == 0 ? qi : (qi < CTXL ? CTXL - 1 - qi : TPB - 1 - (qi - CTXL)); const size_t r = (size_t)b * TPB + j;
        xs[i][cc] = bf2f(XBCC[r * 640 + h * 64 + cc]); Bs[i][cc] = bf2f(XBCC[r * 640 + 384 + g * 64 + cc]); Cs[i][cc] = bf2f(XBCC[r * 640 + 512 + g * 64 + cc]); }
      if (tid < 32) { const int qi = ci * 32 + tid; const int j = dir == 0 ? qi : (qi < CTXL ? CTXL - 1 - qi : TPB - 1 - (qi - CTXL)); const size_t r = (size_t)b * TPB + j;
        const float dt = DT[r * 12 + dir * 6 + h]; dts[tid] = dt; dAs[tid] = expf(dt * a); }
      __syncthreads();
      for (int i = 0; i < 32; ++i) {
        const float d = dAs[i], dtx = dts[i] * xs[i][p]; float y = 0.f;
#pragma unroll
        for (int n = 0; n < 16; ++n) { st[n] = st[n] * d + dtx * Bs[i][16 * q + n]; y += Cs[i][16 * q + n] * st[n]; }
        y += __shfl_xor(y, 1); y += __shfl_xor(y, 2);
        if (q == 0) { const int qi = ci * 32 + i; const int j = dir == 0 ? qi : (qi < CTXL ? CTXL - 1 - qi : TPB - 1 - (qi - CTXL)); float* yp = Y + ((size_t)b * TPB + j) * 384 + h * 64 + p;
          if (dir == 0) *yp = y; else *yp += y; }
      }
      __syncthreads();
    }
  }
}
__device__ __forceinline__ void st_ssd_out(const float* Y, const bf16_t* XBCC, const bf16_t* VZ, const float* dskip, const float* nw, bf16_t* MIX) {
  const int lane = TIDX & 63, gw = BIDX * 8 + (TIDX >> 6), ngw = gridDim.x * 8;
  for (int it = gw; it < MTOK * 2; it += ngw) {
    const int r = it >> 1, g = it & 1; float gv[3]; float ss = 0.f;
#pragma unroll
    for (int i = 0; i < 3; ++i) { const int c = g * 192 + lane + 64 * i, hh = c >> 6;
      const float y = Y[(size_t)r * 384 + c] + bf2f(XBCC[(size_t)r * 640 + c]) * dskip[hh]; const float zv = bf2f(VZ[(size_t)r * 512 + 128 + c]);
      gv[i] = y * siluf(zv); ss += gv[i] * gv[i]; }
    const float rstd = rsqrtf(wave_sum(ss) * (1.0f / 192.0f) + EPS);
#pragma unroll
    for (int i = 0; i < 3; ++i) { const int c = g * 192 + lane + 64 * i; MIX[(size_t)r * DM + 384 + c] = (bf16_t)f2bf(gv[i] * rstd * nw[c]); }
  }
}


__device__ __forceinline__ void ssd_conv8(const bf16_t* XBC, size_t r, int c0, bool hasp, bool hasn, const float* cw, const float* cb, float (&o)[8]) {
  const bf16x8 cur = *(const bf16x8*)(XBC + r * 768 + c0);
  bf16x8 prv = (bf16x8){0, 0, 0, 0, 0, 0, 0, 0}, nxt = (bf16x8){0, 0, 0, 0, 0, 0, 0, 0};
  if (hasp) prv = *(const bf16x8*)(XBC + (r - 1) * 768 + c0);
  if (hasn) nxt = *(const bf16x8*)(XBC + (r + 1) * 768 + c0);
#pragma unroll
  for (int e = 0; e < 8; ++e) { const float v = cw[c0 + e] * bf2f((bf16_t)prv[e]) + cw[640 + c0 + e] * bf2f((bf16_t)cur[e]) + cw[1280 + c0 + e] * bf2f((bf16_t)nxt[e]) + cb[c0 + e]; o[e] = siluf(v); }
}
__device__ __forceinline__ float softplusf(float x) { return x > 20.f ? x : log1pf(expf(x)); }
__device__ __forceinline__ void wave_scan128(float e0, float e1, int lane, float& c0, float& c1) {
  float x = e0 + e1;
#pragma unroll
  for (int o = 1; o < 64; o <<= 1) { const float v = __shfl_up(x, o); if (lane >= o) x += v; }
  const float excl = x - (e0 + e1); c0 = excl + e0; c1 = excl + e0 + e1;
}
__device__ __forceinline__ unsigned pk2bf(float lo, float hi) { return f2bf(lo) | (f2bf(hi) << 16); }
__device__ __forceinline__ int ssd_chunk_j0(int cidx) { return cidx < 2 ? cidx * 128 : CTXL + (cidx - 2) * 128; }

__device__ __forceinline__ void ssd1_item(int item, const bf16_t* XBC, const float* DT, const float* cw, const float* cb, const float* dt_bias, const float* a_log,
                                          float* YIN, float* ST, float* DEC, char* lds) {
  bf16_t (*Cm)[72] = (bf16_t (*)[72])lds; bf16_t (*Bm)[72] = (bf16_t (*)[72])(lds + 18432);
  bf16_t (*BT)[136] = (bf16_t (*)[136])(lds + 36864); bf16_t (*Xt)[136] = (bf16_t (*)[136])(lds + 54272); bf16_t (*Mm)[136] = (bf16_t (*)[136])(lds + 71680);
  float* tab = (float*)(lds + 106496); float* dtf = tab; float* dtb = tab + 128; float* acf = tab + 256; float* acb = tab + 384; float* wf = tab + 512; float* wb = tab + 640;
  const int tid = TIDX, lane = tid & 63, w = tid >> 6, l15 = lane & 15, l4 = lane >> 4;
  const int h = item % 6, bc = item / 6, cidx = bc % 34, b = bc / 34, g = h / 3, j0 = ssd_chunk_j0(cidx);
  const size_t r0 = (size_t)b * TPB + j0;
#pragma unroll 2
  for (int i = 0; i < 6; ++i) { const int task = tid + NT * i, t = task / 24, cg = task % 24, kind = cg >> 3, q = cg & 7, j = j0 + t;
    const int c0 = kind == 0 ? h * 64 + 8 * q : (kind == 1 ? 384 + g * 64 + 8 * q : 512 + g * 64 + 8 * q);
    float o[8]; ssd_conv8(XBC, r0 + t, c0, j != 0 && j != CTXL, j != CTXL - 1 && j != TPB - 1, cw, cb, o);
    if (kind == 0) {
#pragma unroll
      for (int e = 0; e < 8; ++e) Xt[8 * q + e][t] = (bf16_t)f2bf(o[e]);
    } else { const u32x4 pk = (u32x4){pk2bf(o[0], o[1]), pk2bf(o[2], o[3]), pk2bf(o[4], o[5]), pk2bf(o[6], o[7])};
      if (kind == 1) { *(u32x4*)&Bm[t][8 * q] = pk;
#pragma unroll
        for (int e = 0; e < 8; ++e) BT[8 * q + e][t] = (bf16_t)f2bf(o[e]); }
      else *(u32x4*)&Cm[t][8 * q] = pk; } }
  if (w < 2) { const int dir = w; const float a = -expf(a_log[dir * 6 + h]), bias = dt_bias[dir * 6 + h];
    const int t0 = dir == 0 ? 2 * lane : 127 - 2 * lane, t1 = dir == 0 ? 2 * lane + 1 : 126 - 2 * lane;
    const float d0 = softplusf(DT[(r0 + t0) * 12 + dir * 6 + h] + bias), d1 = softplusf(DT[(r0 + t1) * 12 + dir * 6 + h] + bias);
    float c0, c1; wave_scan128(d0 * a, d1 * a, lane, c0, c1);
    const float tot = __shfl(c1, 63);
    float* dtt = dir == 0 ? dtf : dtb; float* ac = dir == 0 ? acf : acb; float* ww = dir == 0 ? wf : wb;
    dtt[t0] = d0; dtt[t1] = d1; ac[t0] = c0; ac[t1] = c1; ww[t0] = __expf(tot - c0) * d0; ww[t1] = __expf(tot - c1) * d1;
    if (lane == 0) DEC[(((size_t)b * 34 + cidx) * 2 + dir) * 6 + h] = __expf(tot); }
  __syncthreads();
  {
    f32x4 accG[8];
#pragma unroll
    for (int ni = 0; ni < 8; ++ni) accG[ni] = (f32x4){0.f, 0.f, 0.f, 0.f};
#pragma unroll
    for (int kk = 0; kk < 2; ++kk) { const bf16x8 a = *(const bf16x8*)&Cm[16 * w + l15][32 * kk + 8 * l4];
#pragma unroll
      for (int ni = 0; ni < 8; ++ni) { const bf16x8 bb = *(const bf16x8*)&Bm[16 * ni + l15][32 * kk + 8 * l4]; accG[ni] = __builtin_amdgcn_mfma_f32_16x16x32_bf16(a, bb, accG[ni], 0, 0, 0); } }
    float aft[4], abt[4];
#pragma unroll
    for (int rg = 0; rg < 4; ++rg) { aft[rg] = acf[16 * w + 4 * l4 + rg]; abt[rg] = acb[16 * w + 4 * l4 + rg]; }
#pragma unroll
    for (int ni = 0; ni < 8; ++ni) { const int sidx = 16 * ni + l15; const float afs = acf[sidx], abs_ = acb[sidx], dfs = dtf[sidx], dbs = dtb[sidx];
#pragma unroll
      for (int rg = 0; rg < 4; ++rg) { const int t = 16 * w + 4 * l4 + rg;
        const float f = sidx <= t ? __expf(aft[rg] - afs) * dfs : 0.f, bk = sidx >= t ? __expf(abt[rg] - abs_) * dbs : 0.f;
        Mm[t][sidx] = (bf16_t)f2bf(accG[ni][rg] * (f + bk)); } }
  }
  __syncthreads();
  {
    f32x4 acc[4];
#pragma unroll
    for (int ni = 0; ni < 4; ++ni) acc[ni] = (f32x4){0.f, 0.f, 0.f, 0.f};
#pragma unroll
    for (int kk = 0; kk < 4; ++kk) { const bf16x8 a = *(const bf16x8*)&Mm[16 * w + l15][32 * kk + 8 * l4];
#pragma unroll
      for (int ni = 0; ni < 4; ++ni) { const bf16x8 bb = *(const bf16x8*)&Xt[16 * ni + l15][32 * kk + 8 * l4]; acc[ni] = __builtin_amdgcn_mfma_f32_16x16x32_bf16(a, bb, acc[ni], 0, 0, 0); } }
#pragma unroll
    for (int rg = 0; rg < 4; ++rg)
#pragma unroll
      for (int ni = 0; ni < 4; ++ni) YIN[(r0 + 16 * w + 4 * l4 + rg) * 384 + h * 64 + 16 * ni + l15] = acc[ni][rg];
  }
  {
    const int dir = w >> 2, mt = w & 3; const float* ww = dir == 0 ? wf : wb;
    f32x4 acc[4];
#pragma unroll
    for (int ni = 0; ni < 4; ++ni) acc[ni] = (f32x4){0.f, 0.f, 0.f, 0.f};
#pragma unroll
    for (int kk = 0; kk < 4; ++kk) { const bf16x8 raw = *(const bf16x8*)&Xt[16 * mt + l15][32 * kk + 8 * l4];
      const f32x4 w0 = *(const f32x4*)(ww + 32 * kk + 8 * l4), w1 = *(const f32x4*)(ww + 32 * kk + 8 * l4 + 4);
      u32x4 pk; pk.x = pk2bf(bf2f((bf16_t)raw[0]) * w0.x, bf2f((bf16_t)raw[1]) * w0.y); pk.y = pk2bf(bf2f((bf16_t)raw[2]) * w0.z, bf2f((bf16_t)raw[3]) * w0.w);
      pk.z = pk2bf(bf2f((bf16_t)raw[4]) * w1.x, bf2f((bf16_t)raw[5]) * w1.y); pk.w = pk2bf(bf2f((bf16_t)raw[6]) * w1.z, bf2f((bf16_t)raw[7]) * w1.w);
      const bf16x8 a = __builtin_bit_cast(bf16x8, pk);
#pragma unroll
      for (int ni = 0; ni < 4; ++ni) { const bf16x8 bb = *(const bf16x8*)&BT[16 * ni + l15][32 * kk + 8 * l4]; acc[ni] = __builtin_amdgcn_mfma_f32_16x16x32_bf16(a, bb, acc[ni], 0, 0, 0); } }
    float* sp = ST + ((((size_t)b * 34 + cidx) * 2 + dir) * 6 + h) * 4096;
#pragma unroll
    for (int rg = 0; rg < 4; ++rg)
#pragma unroll
      for (int ni = 0; ni < 4; ++ni) sp[(16 * mt + 4 * l4 + rg) * 64 + 16 * ni + l15] = acc[ni][rg];
  }
  __syncthreads();
}

__device__ __forceinline__ void st_ssd_scan2(float* ST, const float* DEC) {
  for (int idx = BIDX * NT + TIDX; idx < 4 * 2 * 6 * 4096; idx += gridDim.x * NT) {
    const int e = idx & 4095, bdh = idx >> 12, h = bdh % 6, dir = (bdh / 6) & 1, b = bdh / 12;
    float v[34], d[34];
#pragma unroll
    for (int st = 0; st < 34; ++st) { const int cidx = dir == 0 ? st : (st < 2 ? 1 - st : 35 - st); const size_t o = (((size_t)b * 34 + cidx) * 2 + dir) * 6 + h; v[st] = ST[o * 4096 + e]; d[st] = DEC[o]; }
    float H = 0.f;
#pragma unroll
    for (int st = 0; st < 34; ++st) { const int cidx = dir == 0 ? st : (st < 2 ? 1 - st : 35 - st); const size_t o = (((size_t)b * 34 + cidx) * 2 + dir) * 6 + h; ST[o * 4096 + e] = H; H = H * d[st] + v[st]; }
  }
}

__device__ __forceinline__ void ssd3_item(int b, int cidx, int g, const bf16_t* XBC, const bf16_t* VZ, const float* DT, const float* cw, const float* cb, const float* dt_bias, const float* a_log,
                                          const float* dskip, const float* nw, const float* YIN, const float* ST, bf16_t* MIX, char* lds) {
  bf16_t (*Cm)[72] = (bf16_t (*)[72])lds; bf16_t (*Hm)[72] = (bf16_t (*)[72])(lds + 18432);
  float* ef = (float*)(lds + 18432 + 55296);
  const int tid = TIDX, lane = tid & 63, w = tid >> 6, l15 = lane & 15, l4 = lane >> 4, j0 = ssd_chunk_j0(cidx);
  const size_t r0 = (size_t)b * TPB + j0;
#pragma unroll
  for (int i = 0; i < 2; ++i) { const int task = tid + NT * i, t = task >> 3, q = task & 7, j = j0 + t;
    float o[8]; ssd_conv8(XBC, r0 + t, 512 + g * 64 + 8 * q, j != 0 && j != CTXL, j != CTXL - 1 && j != TPB - 1, cw, cb, o);
    *(u32x4*)&Cm[t][8 * q] = (u32x4){pk2bf(o[0], o[1]), pk2bf(o[2], o[3]), pk2bf(o[4], o[5]), pk2bf(o[6], o[7])}; }
#pragma unroll 4
  for (int i = 0; i < 12; ++i) { const int f4 = tid + NT * i, hd = f4 >> 10, rem = f4 & 1023, p = rem >> 4, n4 = (rem & 15) * 4, hh = hd >> 1, dir = hd & 1;
    const f32x4 v = *(const f32x4*)(ST + ((((size_t)b * 34 + cidx) * 2 + dir) * 6 + 3 * g + hh) * 4096 + p * 64 + n4);
    *(u32x2*)&Hm[hd * 64 + p][n4] = (u32x2){pk2bf(v.x, v.y), pk2bf(v.z, v.w)}; }
  if (w < 6) { const int hh = w >> 1, dir = w & 1, h = 3 * g + hh; const float a = -expf(a_log[dir * 6 + h]), bias = dt_bias[dir * 6 + h];
    const int t0 = dir == 0 ? 2 * lane : 127 - 2 * lane, t1 = dir == 0 ? 2 * lane + 1 : 126 - 2 * lane;
    const float d0 = softplusf(DT[(r0 + t0) * 12 + dir * 6 + h] + bias), d1 = softplusf(DT[(r0 + t1) * 12 + dir * 6 + h] + bias);
    float c0, c1; wave_scan128(d0 * a, d1 * a, lane, c0, c1);
    ef[w * 128 + t0] = __expf(c0); ef[w * 128 + t1] = __expf(c1); }
  __syncthreads();
  bf16x8 ca[2];
#pragma unroll
  for (int kk = 0; kk < 2; ++kk) ca[kk] = *(const bf16x8*)&Cm[16 * w + l15][32 * kk + 8 * l4];
  float ss[4] = {0.f, 0.f, 0.f, 0.f}, rstd[4] = {0.f, 0.f, 0.f, 0.f};
#pragma unroll 1
  for (int pass = 0; pass < 2; ++pass) {
#pragma unroll 1
    for (int hh = 0; hh < 3; ++hh) { const int h = 3 * g + hh; const float dsk = dskip[h];
      f32x4 accF[4], accB[4];
#pragma unroll
      for (int ni = 0; ni < 4; ++ni) { accF[ni] = (f32x4){0.f, 0.f, 0.f, 0.f}; accB[ni] = (f32x4){0.f, 0.f, 0.f, 0.f}; }
      const bf16_t (*HF)[72] = Hm + (hh * 2 + 0) * 64; const bf16_t (*HB)[72] = Hm + (hh * 2 + 1) * 64;
#pragma unroll
      for (int kk = 0; kk < 2; ++kk)
#pragma unroll
        for (int ni = 0; ni < 4; ++ni) {
          accF[ni] = __builtin_amdgcn_mfma_f32_16x16x32_bf16(ca[kk], *(const bf16x8*)&HF[16 * ni + l15][32 * kk + 8 * l4], accF[ni], 0, 0, 0);
          accB[ni] = __builtin_amdgcn_mfma_f32_16x16x32_bf16(ca[kk], *(const bf16x8*)&HB[16 * ni + l15][32 * kk + 8 * l4], accB[ni], 0, 0, 0); }
      const float* efF = ef + (hh * 2 + 0) * 128; const float* efB = ef + (hh * 2 + 1) * 128;
#pragma unroll
      for (int rg = 0; rg < 4; ++rg) { const int t = 16 * w + 4 * l4 + rg, j = j0 + t; const size_t r = r0 + t;
        const float eF = efF[t], eB = efB[t]; const bool hasp = j != 0 && j != CTXL, hasn = j != CTXL - 1 && j != TPB - 1;
        const bf16_t* xp = XBC + r * 768 + h * 64 + l15; const float* yp = YIN + r * 384 + h * 64 + l15; const bf16_t* zp = VZ + r * 512 + 128 + h * 64 + l15;
        bf16_t* op = MIX + r * DM + 384 + h * 64 + l15;
#pragma unroll
        for (int ni = 0; ni < 4; ++ni) { const int col = h * 64 + 16 * ni + l15;
          float xv = cw[640 + col] * bf2f(xp[16 * ni]) + cb[col];
          if (hasp) xv += cw[col] * bf2f(xp[16 * ni - 768]);
          if (hasn) xv += cw[1280 + col] * bf2f(xp[16 * ni + 768]);
          xv = siluf(xv);
          const float y = yp[16 * ni] + eF * accF[ni][rg] + eB * accB[ni][rg] + dsk * xv;
          const float gt = y * siluf(bf2f(zp[16 * ni]));
          if (pass == 0) ss[rg] += gt * gt; else op[16 * ni] = (bf16_t)f2bf(gt * rstd[rg] * nw[col]); } }
    }
    if (pass == 0) {
#pragma unroll
      for (int rg = 0; rg < 4; ++rg) { float sv = ss[rg]; sv += __shfl_xor(sv, 1); sv += __shfl_xor(sv, 2); sv += __shfl_xor(sv, 4); sv += __shfl_xor(sv, 8); rstd[rg] = rsqrtf(sv * (1.0f / 192.0f) + EPS); }
    }
  }
  __syncthreads();
}

__device__ __forceinline__ void st_router(const float* xl, const float* xc, const float* g, const float* modv_layer, const float* w_router, const float* rbias,
                                          bf16_t* H2, int* ctl, int* tok_pair, float* tok_w, int skip_ctx) {
  const int lane = TIDX & 63, gw = BIDX * 8 + (TIDX >> 6), ngw = gridDim.x * 8;
  for (int r = gw; r < MTOK; r += ngw) {
    if (skip_ctx && (r % TPB) < CTXL) continue;
    const float* xr = xrow(xl, xc, r); const float* mv = modv_layer + (size_t)mrow_of(r) * 6144;
    f32x4 v[4]; float ss = 0.f;
#pragma unroll
    for (int j = 0; j < 4; ++j) { v[j] = *(const f32x4*)(xr + 4 * lane + 256 * j); ss += v[j].x * v[j].x + v[j].y * v[j].y + v[j].z * v[j].z + v[j].w * v[j].w; }
    const float rstd = rsqrtf(wave_sum(ss) * (1.0f / DM) + EPS);
    float lg[16];
#pragma unroll
    for (int e = 0; e < 16; ++e) lg[e] = 0.f;
#pragma unroll
    for (int j = 0; j < 4; ++j) { const int k = 4 * lane + 256 * j;
      const f32x4 gg = *(const f32x4*)(g + k), sh = *(const f32x4*)(mv + 3072 + k), sc = *(const f32x4*)(mv + 4096 + k);
      float o[4]; o[0] = v[j].x * rstd * gg.x * (1.f + sc.x) + sh.x; o[1] = v[j].y * rstd * gg.y * (1.f + sc.y) + sh.y;
      o[2] = v[j].z * rstd * gg.z * (1.f + sc.z) + sh.z; o[3] = v[j].w * rstd * gg.w * (1.f + sc.w) + sh.w;
      u32x2 w; w.x = f2bf(o[0]) | (f2bf(o[1]) << 16); w.y = f2bf(o[2]) | (f2bf(o[3]) << 16);
      *(u32x2*)(H2 + (size_t)r * DM + k) = w;
#pragma unroll
      for (int q = 0; q < 4; ++q) {
#pragma unroll
        for (int e4 = 0; e4 < 4; ++e4) { const f32x4 wr = *(const f32x4*)(w_router + (size_t)(k + q) * 16 + 4 * e4);
          lg[4 * e4] += o[q] * wr.x; lg[4 * e4 + 1] += o[q] * wr.y; lg[4 * e4 + 2] += o[q] * wr.z; lg[4 * e4 + 3] += o[q] * wr.w; } } }
#pragma unroll
    for (int e = 0; e < 16; ++e) lg[e] = wave_sum(lg[e]);
    if (lane == 0) {
      int best = 0, bi1 = 0, bi2 = 1; float bestv = -1e30f, bs1 = 0.f, bs2 = 0.f;
#pragma unroll
      for (int gq = 0; gq < 4; ++gq) { float m1 = -1e30f, m2 = -1e30f, s1 = 0.f, s2 = 0.f; int i1 = 0, i2 = 0;
#pragma unroll
        for (int i = 0; i < 4; ++i) { const float scv = 1.0f / (1.0f + expf(-lg[4 * gq + i])); const float s = scv + rbias[4 * gq + i];
          if (s > m1) { m2 = m1; s2 = s1; i2 = i1; m1 = s; s1 = scv; i1 = i; } else if (s > m2) { m2 = s; s2 = scv; i2 = i; } }
        if (m1 + m2 > bestv) { bestv = m1 + m2; best = gq; bi1 = i1; bi2 = i2; bs1 = s1; bs2 = s2; } }
      const int ia = bi1 < bi2 ? bi1 : bi2, ib = bi1 < bi2 ? bi2 : bi1;
      const int tri = ia == 0 ? ib - 1 : (ia == 1 ? ib + 1 : 5);
      const int pidx = best * 6 + tri;
      const float sa = bi1 < bi2 ? bs1 : bs2, sb = bi1 < bi2 ? bs2 : bs1, inv = 1.0f / (sa + sb);
      tok_pair[r] = pidx; tok_w[2 * r] = sa * inv; tok_w[2 * r + 1] = sb * inv;
      atomicAdd(&ctl[CT_CNT + pidx], 1);
    }
  }
}
__device__ __forceinline__ void st_moe_plan(int* ctl, int* sorted_tok) {
  if (BIDX == 0 && TIDX == 0) { int base = 0, nt = 0;
    for (int p = 0; p < 24; ++p) { ctl[CT_BASE + p] = base; const int n = ctl[CT_CNT + p], tl = (n + 255) >> 8; for (int t = 0; t < tl; ++t) ctl[CT_TP + nt + t] = p; nt += tl; base += tl * 256; ctl[CT_FILL + p] = 0; }
    ctl[CT_BASE + 24] = base; ctl[CT_NT] = nt; }
  for (int i = BIDX * NT + TIDX; i < MOE_ROWS; i += gridDim.x * NT) sorted_tok[i] = -1;
}
__device__ __forceinline__ void st_moe_gather(const bf16_t* H2, bf16_t* H2S, int* ctl, const int* tok_pair, const float* tok_w, int* sorted_tok, float* sorted_w, int skip_ctx) {
  const int lane = TIDX & 63, gw = BIDX * 8 + (TIDX >> 6), ngw = gridDim.x * 8;
  for (int r = gw; r < MTOK; r += ngw) {
    if (skip_ctx && (r % TPB) < CTXL) continue;
    const int p = tok_pair[r]; int slot = 0;
    if (lane == 0) { slot = ctl[CT_BASE + p] + atomicAdd(&ctl[CT_FILL + p], 1); sorted_tok[slot] = r; sorted_w[2 * slot] = tok_w[2 * r]; sorted_w[2 * slot + 1] = tok_w[2 * r + 1]; }
    slot = __shfl(slot, 0);
    const u32x4* s = (const u32x4*)(H2 + (size_t)r * DM); u32x4* d = (u32x4*)(H2S + (size_t)slot * DM);
    d[lane] = s[lane]; d[lane + 64] = s[lane + 64];
  }
}
__device__ __forceinline__ void st_final(float* xl, const float* g) {
  const int lane = TIDX & 63, gw = BIDX * 8 + (TIDX >> 6), ngw = gridDim.x * 8;
  for (int r = gw; r < NB * SEQ; r += ngw) {
    float* xr = xl + (size_t)r * DM; f32x4 v[4]; float ss = 0.f;
#pragma unroll
    for (int j = 0; j < 4; ++j) { v[j] = *(const f32x4*)(xr + 4 * lane + 256 * j); ss += v[j].x * v[j].x + v[j].y * v[j].y + v[j].z * v[j].z + v[j].w * v[j].w; }
    const float rstd = rsqrtf(wave_sum(ss) * (1.0f / DM) + EPS);
#pragma unroll
    for (int j = 0; j < 4; ++j) { const int k = 4 * lane + 256 * j; const f32x4 gg = *(const f32x4*)(g + k);
      *(f32x4*)(xr + k) = (f32x4){v[j].x * rstd * gg.x, v[j].y * rstd * gg.y, v[j].z * rstd * gg.z, v[j].w * rstd * gg.w}; }
  }
}

#include <hip/hip_bf16.h>
#include <cmath>
namespace attn_body {
using bf16=__hip_bfloat16;
using bf16x8=__attribute__((ext_vector_type(8)))short;
using s16x4=__attribute__((ext_vector_type(4)))short;
using f32x16=__attribute__((ext_vector_type(16)))float;
using u32x4=__attribute__((ext_vector_type(4)))unsigned;
constexpr int D=64,QP=512,KP=512,VP=512,OP=1024;
constexpr int NW=8,QBLK=32,QB=QBLK*NW,KVBLK=64;
constexpr int ATTN_UNIT_ROWS=QB;
__device__ __forceinline__ int crow(int r,int hi){return (r&3)+8*(r>>2)+4*hi;}
#define SBAR() __builtin_amdgcn_sched_barrier(0)
__device__ __forceinline__ void cmask(f32x16&p0,f32x16&p1,int jb,int qrel,int hi){
  const float NEG=-INFINITY; int kb=64*jb+4*hi;
  #pragma unroll
  for(int r=0;r<16;++r){int kv=kb+(r&3)+8*(r>>2); if(kv>qrel)p0[r]=NEG; if(kv+32>qrel)p1[r]=NEG;}
}

constexpr int NSLOT=3, SLOTB=8192;
constexpr int LDS_K=0, LDS_V=NSLOT*SLOTB, LDS_WS=2*NSLOT*SLOTB, LDS_OST=LDS_WS+NW*64*4, LDS_BYTES=LDS_OST+NW*4096;
constexpr float C2=0.125f*1.4426950408889634f;
__device__ __forceinline__ void glds16(const void*gsrc,unsigned lds_dst){unsigned keep;
  asm volatile("s_mov_b32 %0, m0\n\ts_mov_b32 m0, %2\n\ts_nop 0\n\tglobal_load_lds_dwordx4 %1, off\n\ts_mov_b32 m0, %0":"=&s"(keep):"v"(gsrc),"s"(lds_dst):"memory");}
__device__ __forceinline__ float max3f(float a,float b,float c){float r;asm("v_max3_f32 %0, %1, %2, %3":"=v"(r):"v"(a),"v"(b),"v"(c));return r;}
__device__ __forceinline__ float max2f(float a,float b){float r;asm("v_max_f32_e32 %0, %1, %2":"=v"(r):"v"(a),"v"(b));return r;}
__device__ __forceinline__ float fadd_s(float a,float b){float r;asm("v_add_f32_e32 %0, %1, %2":"=v"(r):"v"(a),"v"(b));return r;}
__device__ __forceinline__ float fsub_s(float a,float b){float r;asm("v_sub_f32_e32 %0, %1, %2":"=v"(r):"v"(a),"v"(b));return r;}
typedef float f32x2_t __attribute__((ext_vector_type(2))); typedef __bf16 bf16x2_t __attribute__((ext_vector_type(2)));
__device__ __forceinline__ unsigned cvtpk_s(float lo,float hi){f32x2_t v={lo,hi};bf16x2_t b=__builtin_convertvector(v,bf16x2_t);return __builtin_bit_cast(unsigned,b);}
#define WAIT_BAR(N) asm volatile("s_waitcnt vmcnt(" #N ") lgkmcnt(0)\n\ts_barrier":::"memory")

__device__ __forceinline__ void qkt(f32x16&p0,f32x16&p1,const char*Kslot,const bf16x8*qr,const f32x16&negm,int r32,int hi){
  const char*kb=Kslot+hi*1024+r32*16;
  #pragma unroll
  for(int d0=0;d0<4;++d0){
    const bf16x8 b0=*reinterpret_cast<const bf16x8*>(kb+d0*2048);
    const bf16x8 b1=*reinterpret_cast<const bf16x8*>(kb+d0*2048+512);
    if(d0==0){p0=__builtin_amdgcn_mfma_f32_32x32x16_bf16(b0,qr[0],negm,0,0,0);p1=__builtin_amdgcn_mfma_f32_32x32x16_bf16(b1,qr[0],negm,0,0,0);}
    else{p0=__builtin_amdgcn_mfma_f32_32x32x16_bf16(b0,qr[d0],p0,0,0,0);p1=__builtin_amdgcn_mfma_f32_32x32x16_bf16(b1,qr[d0],p1,0,0,0);}}
}
typedef __attribute__((address_space(3))) const char* lds_cptr;
typedef short v4i16_t __attribute__((ext_vector_type(4)));
__device__ __forceinline__ void kload8(bf16x8*kf,lds_cptr kp){
  kf[0]=*(const __attribute__((address_space(3))) bf16x8*)(kp);      kf[1]=*(const __attribute__((address_space(3))) bf16x8*)(kp+512);
  kf[2]=*(const __attribute__((address_space(3))) bf16x8*)(kp+2048); kf[3]=*(const __attribute__((address_space(3))) bf16x8*)(kp+2560);
  kf[4]=*(const __attribute__((address_space(3))) bf16x8*)(kp+4096); kf[5]=*(const __attribute__((address_space(3))) bf16x8*)(kp+4608);
  kf[6]=*(const __attribute__((address_space(3))) bf16x8*)(kp+6144); kf[7]=*(const __attribute__((address_space(3))) bf16x8*)(kp+6656);
}
__device__ __forceinline__ void kload2(bf16x8*kf,lds_cptr kp,int j){ kf[2*j]=*(const __attribute__((address_space(3))) bf16x8*)(kp+j*2048); kf[2*j+1]=*(const __attribute__((address_space(3))) bf16x8*)(kp+j*2048+512); }
__device__ __forceinline__ s16x4 vtr(lds_cptr p){ return __builtin_bit_cast(s16x4,__builtin_amdgcn_ds_read_tr16_b64_v4i16((__attribute__((address_space(3))) v4i16_t*)p)); }
__device__ __forceinline__ float rowmax(const f32x16&p0,const f32x16&p1){
  float a=max3f(p0[0],p0[1],p1[0]),b=max3f(p0[2],p0[3],p1[1]);a=max3f(a,p1[2],p1[3]);
  #pragma unroll
  for(int r=4;r<16;r+=4){a=max3f(a,p0[r],p0[r+1]);b=max3f(b,p0[r+2],p0[r+3]);a=max3f(a,p1[r],p1[r+1]);b=max3f(b,p1[r+2],p1[r+3]);}
  const float m=max2f(a,b);
  auto rr=__builtin_amdgcn_permlane32_swap(__float_as_uint(m),__float_as_uint(m),false,false);
  return max2f(__uint_as_float(rr[0]),__uint_as_float(rr[1]));
}
__device__ __forceinline__ void pv(f32x16*o,int vb,bf16x8 pa0,bf16x8 pa1,bf16x8 pa2,bf16x8 pa3){
  #pragma unroll
  for(int d0=0;d0<2;++d0){s16x4 lo[4],hi[4];
    #pragma unroll
    for(int ks=0;ks<4;++ks){
      asm volatile("ds_read_b64_tr_b16 %0,%1 offset:%c2":"=&v"(lo[ks]):"v"(vb),"i"(d0*4096+ks*1024):"memory");
      asm volatile("ds_read_b64_tr_b16 %0,%1 offset:%c2":"=&v"(hi[ks]):"v"(vb),"i"(d0*4096+ks*1024+512):"memory");}
    asm volatile("s_waitcnt lgkmcnt(0)":::"memory");SBAR();
    #define PK(k) (bf16x8){lo[k][0],lo[k][1],lo[k][2],lo[k][3],hi[k][0],hi[k][1],hi[k][2],hi[k][3]}
    o[d0]=__builtin_amdgcn_mfma_f32_32x32x16_bf16(pa0,PK(0),o[d0],0,0,0);
    o[d0]=__builtin_amdgcn_mfma_f32_32x32x16_bf16(pa1,PK(1),o[d0],0,0,0);
    o[d0]=__builtin_amdgcn_mfma_f32_32x32x16_bf16(pa2,PK(2),o[d0],0,0,0);
    o[d0]=__builtin_amdgcn_mfma_f32_32x32x16_bf16(pa3,PK(3),o[d0],0,0,0);
    #undef PK
  }
}

#ifndef ATTN_STORE16
#define ATTN_STORE16(p,v) (*(u32x4*)(p)=(v))
#endif
template<int THRL> __device__ __forceinline__ void attn_unit(const bf16*Qu,const bf16*__restrict__ Kh,const bf16*__restrict__ Vh,bf16*Ou,const int NT,char*shm){
  const int tid=opq_v((int)threadIdx.x),lane=tid&63,r32=lane&31,hi=lane>>5; const int wid=__builtin_amdgcn_readfirstlane(tid>>6);
  const bf16*Qw=Qu+(long)(wid*QBLK)*QP;
  const unsigned lds0=(unsigned)(uintptr_t)shm;
  float*wsf=(float*)(shm+LDS_WS)+wid*64;
  const bf16*ksrc=Kh+(long)lane*KP+wid*8;
  const bf16*vsrc=Vh+(long)(16*(wid&3)+(lane>>2))*VP+(wid>>2)*32+(lane&3)*8;
  const unsigned kdst=lds0+LDS_K+wid*1024, vdst=lds0+LDS_V+wid*1024;
  #define DMA_K(t,slot) glds16(ksrc+(long)(t)*KVBLK*KP,(unsigned)__builtin_amdgcn_readfirstlane(kdst+(slot)))
  #define DMA_V(t,slot) glds16(vsrc+(long)(t)*KVBLK*VP,(unsigned)__builtin_amdgcn_readfirstlane(vdst+(slot)))
  const int vb0=(int)(lds0+LDS_V)+((lane>>4)&1)*32+(lane&3)*8+(4*hi+((lane&15)>>2))*64;
  const char*Kbase=shm+LDS_K; bf16x8 kf[8];
  const lds_cptr shm3=(lds_cptr)shm; const lds_cptr kp0=shm3+LDS_K+hi*1024+r32*16; const lds_cptr vp0=shm3+LDS_V+((lane>>4)&1)*32+(lane&3)*8+(4*hi+((lane&15)>>2))*64;
  DMA_K(0,0);DMA_V(0,0);DMA_K(1,SLOTB);
  bf16x8 qr[4];
  #pragma unroll
  for(int d0=0;d0<4;++d0)qr[d0]=*reinterpret_cast<const bf16x8*>(&Qw[(long)r32*QP+d0*16+hi*8]);
  float mhat=0.f,l_reg=0.f;f32x16 o[2];o[0]=f32x16{};o[1]=f32x16{};f32x16 negm=f32x16{};asm volatile("":"+v"(negm));
  #define CMASK(P0,P1,t) do{}while(0)
  bool resc=false;
  #define START(P0,P1) do{ const float rm=rowmax(P0,P1); resc=false; \
    { const float dl=rm; mhat=fadd_s(mhat,dl); \
      _Pragma("unroll") for(int r=0;r<16;++r){P0[r]=fsub_s(P0[r],dl);P1[r]=fsub_s(P1[r],dl);} \
      _Pragma("unroll") for(int r=0;r<16;++r)negm[r]=-mhat; asm volatile("":"+v"(negm)); } \
    _Pragma("unroll") for(int r=0;r<16;++r)P0[r]=__builtin_amdgcn_exp2f(P0[r]); }while(0)
  #define RESC() do{ if(resc){ asm volatile("s_waitcnt lgkmcnt(0)":::"memory"); \
      _Pragma("unroll") for(int d_=0;d_<2;++d_) _Pragma("unroll") for(int r=0;r<16;++r)o[d_][r]*=wsf[crow(r,hi)]; } }while(0)
  f32x16 pA0,pA1,pB0,pB1;
  int sl_prev=0,sl_cur=0,sl_next=SLOTB;
  #define ROT() do{sl_prev=sl_cur;sl_cur=sl_next;sl_next=(sl_next==(NSLOT-1)*SLOTB)?0:sl_next+SLOTB;}while(0)
  DMA_K(2,2*SLOTB);
  WAIT_BAR(3);
  qkt(pA0,pA1,Kbase,qr,negm,r32,hi);asm volatile("s_nop 15\n\ts_nop 7":"+v"(pA0),"+v"(pA1));CMASK(pA0,pA1,0);
  START(pA0,pA1);
  _Pragma("unroll") for(int r=0;r<16;++r)pA1[r]=__builtin_amdgcn_exp2f(pA1[r]);
  WAIT_BAR(0);
  DMA_K(3,0);DMA_V(1,SLOTB);
  ROT();
  kload8(kf,kp0+sl_cur);
  WAIT_BAR(2);
  s16x4 vlo[8],vhi[8]; u32x4 pw0,pw1,pw2,pw3;
  #define PKW(P,B) cvtpk_s(P[B],P[B+1])
  #define PAF(k) __builtin_bit_cast(bf16x8,pw##k)
  #define VFR(i) (bf16x8){vlo[i][0],vlo[i][1],vlo[i][2],vlo[i][3],vhi[i][0],vhi[i][1],vhi[i][2],vhi[i][3]}
  #define PIN(x) asm volatile("":"+v"(x))
  #define MX3(a,b,c) __builtin_fmaxf(__builtin_fmaxf((a),(b)),(c))
  #define GAPA(MF,A0,A1,A2,A3,W0,W1,PW) do{ MF; sacc+=A0; sacc+=A1; sacc+=A2; sacc+=A3; PIN(sacc); W0; W1; PIN(PW); SBAR(); }while(0)
  #define EX(v) __builtin_amdgcn_exp2f(v)
  #define GAPB(MF,X,B) do{ MF; X[B]=EX(X[B]); X[B+1]=EX(X[B+1]); X[B+2]=EX(X[B+2]); X[B+3]=EX(X[B+3]); PIN(X); SBAR(); }while(0)
  #define VRD(i) do{ vlo[i]=vtr(vp_+(((i)>>2)*4096+((i)&3)*1024)); vhi[i]=vtr(vp_+(((i)>>2)*4096+((i)&3)*1024+512)); }while(0)
  #define KRD(G,j) do{ if(G){ kload2(kf,kp0+sl_next,j); SBAR(); } }while(0)
  #define STEP(C0,C1,P0,P1,t,GK,GV,GL) do{ SBAR(); \
    const lds_cptr vp_=vp0+sl_prev; \
    VRD(0); SBAR(); float sacc=(P0[0]+P0[1]); \
    GAPA(C0=__builtin_amdgcn_mfma_f32_32x32x16_bf16(kf[0],qr[0],negm,0,0,0), P0[2],P0[3],P0[4],P0[5],     pw0[0]=PKW(P0,0), pw0[1]=PKW(P0,2), pw0); \
    VRD(4); SBAR(); GAPA(C1=__builtin_amdgcn_mfma_f32_32x32x16_bf16(kf[1],qr[0],negm,0,0,0), P0[6],P0[7],P0[8],P0[9],     pw0[2]=PKW(P0,4), pw0[3]=PKW(P0,6), pw0); \
    VRD(1); SBAR(); GAPA(C0=__builtin_amdgcn_mfma_f32_32x32x16_bf16(kf[2],qr[1],C0,0,0,0),   P0[10],P0[11],P0[12],P0[13], pw1[0]=PKW(P0,8), pw1[1]=PKW(P0,10), pw1); \
    VRD(5); SBAR(); GAPA(C1=__builtin_amdgcn_mfma_f32_32x32x16_bf16(kf[3],qr[1],C1,0,0,0),   P0[14],P0[15],P1[0],P1[1],   pw1[2]=PKW(P0,12),pw1[3]=PKW(P0,14), pw1); \
    VRD(2); SBAR(); GAPA(C0=__builtin_amdgcn_mfma_f32_32x32x16_bf16(kf[4],qr[2],C0,0,0,0),   P1[2],P1[3],P1[4],P1[5],     pw2[0]=PKW(P1,0), pw2[1]=PKW(P1,2), pw2); \
    VRD(6); SBAR(); GAPA(C1=__builtin_amdgcn_mfma_f32_32x32x16_bf16(kf[5],qr[2],C1,0,0,0),   P1[6],P1[7],P1[8],P1[9],     pw2[2]=PKW(P1,4), pw2[3]=PKW(P1,6), pw2); \
    VRD(3); SBAR(); GAPA(C0=__builtin_amdgcn_mfma_f32_32x32x16_bf16(kf[6],qr[3],C0,0,0,0),   P1[10],P1[11],P1[12],P1[13], pw3[0]=PKW(P1,8), pw3[1]=PKW(P1,10), pw3); \
    VRD(7); SBAR(); GAPA(C1=__builtin_amdgcn_mfma_f32_32x32x16_bf16(kf[7],qr[3],C1,0,0,0),   P1[14],P1[15],0.f,0.f,       pw3[2]=PKW(P1,12),pw3[3]=PKW(P1,14), pw3); \
    l_reg+=sacc; \
    if(GK){DMA_K((t)+3,sl_cur);} if(GV){DMA_V((t)+1,sl_next);} \
    CMASK(C0,C1,t); \
    { float a=MX3(C0[0],C0[1],C1[0]),b=MX3(C0[2],C0[3],C1[1]); a=MX3(a,C1[2],C1[3]); \
      _Pragma("unroll") for(int r=4;r<16;r+=4){a=MX3(a,C0[r],C0[r+1]);b=MX3(b,C0[r+2],C0[r+3]);a=MX3(a,C1[r],C1[r+1]);b=MX3(b,C1[r+2],C1[r+3]);} \
      float rm=__builtin_fmaxf(a,b); { auto rr=__builtin_amdgcn_permlane32_swap(__float_as_uint(rm),__float_as_uint(rm),false,false); rm=__builtin_fmaxf(__uint_as_float(rr[0]),__uint_as_float(rr[1])); } \
      resc=false; \
      if(__builtin_expect(__any(rm>(float)THRL),0)){ const float dl=__builtin_fmaxf(rm,0.f); mhat+=dl; \
        _Pragma("unroll") for(int r=0;r<16;++r){C0[r]-=dl;C1[r]-=dl;} \
        _Pragma("unroll") for(int r=0;r<16;++r)negm[r]=-mhat; asm volatile("":"+v"(negm)); \
        const float f=__builtin_amdgcn_exp2f(-dl); l_reg*=f; if(hi==0)wsf[r32]=f; resc=true; } } \
    SBAR(); \
    GAPB(o[0]=__builtin_amdgcn_mfma_f32_32x32x16_bf16(PAF(0),VFR(0),o[0],0,0,0), C0,0); \
    GAPB(o[1]=__builtin_amdgcn_mfma_f32_32x32x16_bf16(PAF(0),VFR(4),o[1],0,0,0), C0,4); \
    KRD(GL,0); GAPB(o[0]=__builtin_amdgcn_mfma_f32_32x32x16_bf16(PAF(1),VFR(1),o[0],0,0,0), C0,8); \
    KRD(GL,1); GAPB(o[1]=__builtin_amdgcn_mfma_f32_32x32x16_bf16(PAF(1),VFR(5),o[1],0,0,0), C0,12); \
    KRD(GL,2); GAPB(o[0]=__builtin_amdgcn_mfma_f32_32x32x16_bf16(PAF(2),VFR(2),o[0],0,0,0), C1,0); \
    KRD(GL,3); GAPB(o[1]=__builtin_amdgcn_mfma_f32_32x32x16_bf16(PAF(2),VFR(6),o[1],0,0,0), C1,4); \
    GAPB(o[0]=__builtin_amdgcn_mfma_f32_32x32x16_bf16(PAF(3),VFR(3),o[0],0,0,0), C1,8); \
    GAPB(o[1]=__builtin_amdgcn_mfma_f32_32x32x16_bf16(PAF(3),VFR(7),o[1],0,0,0), C1,12); \
    }while(0)
  int t=1;
  for(;t+5<NT;t+=2){
    STEP(pB0,pB1,pA0,pA1,t,true,true,true);     WAIT_BAR(2); RESC(); ROT();
    STEP(pA0,pA1,pB0,pB1,t+1,true,true,true);   WAIT_BAR(2); RESC(); ROT();
  }
  #define ENDW(tt) do{ if((tt)+3<NT){WAIT_BAR(2);} else if((tt)+2<NT){WAIT_BAR(1);} else {WAIT_BAR(0);} }while(0)
  for(;t+1<NT;t+=2){
    STEP(pB0,pB1,pA0,pA1,t,(t+3<NT),(t+1<NT),(t+1<NT));       ENDW(t);   RESC(); ROT();
    STEP(pA0,pA1,pB0,pB1,t+1,(t+4<NT),(t+2<NT),(t+2<NT));     ENDW(t+1); RESC(); ROT();
  }
  STEP(pB0,pB1,pA0,pA1,NT-1,false,false,false); RESC();
  { float sacc=pB0[0]+pB0[1]; _Pragma("unroll") for(int r=2;r<16;++r)sacc+=pB0[r]; _Pragma("unroll") for(int r=0;r<16;++r)sacc+=pB1[r]; l_reg+=sacc;
    pw0=(u32x4){PKW(pB0,0),PKW(pB0,2),PKW(pB0,4),PKW(pB0,6)};pw1=(u32x4){PKW(pB0,8),PKW(pB0,10),PKW(pB0,12),PKW(pB0,14)};pw2=(u32x4){PKW(pB1,0),PKW(pB1,2),PKW(pB1,4),PKW(pB1,6)};pw3=(u32x4){PKW(pB1,8),PKW(pB1,10),PKW(pB1,12),PKW(pB1,14)};
    SBAR(); pv(o,vb0+sl_cur,PAF(0),PAF(1),PAF(2),PAF(3)); }
  #undef PKW
  #undef PAF
  #undef VFR
  #undef PIN
  #undef MX3
  #undef GAPA
  #undef GAPB
  #undef EX
  #undef VRD
  #undef KRD
  #undef STEP
  #undef ENDW
  {auto rr=__builtin_amdgcn_permlane32_swap(__float_as_uint(l_reg),__float_as_uint(l_reg),false,false);l_reg=__uint_as_float(rr[0])+__uint_as_float(rr[1]);}
  if(hi==0)wsf[32+r32]=l_reg;asm volatile("s_waitcnt lgkmcnt(0)":::"memory");
  float rli[16];
  #pragma unroll
  for(int r=0;r<16;++r)rli[r]=__builtin_amdgcn_rcpf(wsf[32+crow(r,hi)]);
  bf16*Ow=Ou+(long)(wid*QBLK)*OP;
  { bf16*stg=(bf16*)(shm+LDS_OST)+wid*2048;
    #pragma unroll
    for(int r=0;r<16;++r){const int orow=crow(r,hi);
      #pragma unroll
      for(int d0=0;d0<2;++d0)stg[orow*64+d0*32+r32]=__float2bfloat16(o[d0][r]*rli[r]);}
    asm volatile("s_waitcnt lgkmcnt(0)":::"memory");
    #pragma unroll
    for(int i=0;i<4;++i){const int row=i*8+(lane>>3),ch=lane&7; const u32x4 v=*(const u32x4*)(stg+row*64+ch*8); ATTN_STORE16(Ow+(long)row*OP+ch*8,v);} }
  asm volatile("s_waitcnt lgkmcnt(0)\n\ts_barrier":::"memory");
  #undef DMA_K
  #undef DMA_V
  #undef CMASK
  #undef START
  #undef RESC
  #undef ROT
}
constexpr int ATTN_LDS_BYTES=LDS_BYTES;
#undef SBAR
#undef WAIT_BAR
}


namespace hyf {
struct c32 { float x, y; };
typedef _Float16 h2 __attribute__((ext_vector_type(2)));
__device__ __forceinline__ c32 operator+(c32 a, c32 b) { return {a.x + b.x, a.y + b.y}; }
__device__ __forceinline__ c32 operator-(c32 a, c32 b) { return {a.x - b.x, a.y - b.y}; }
__device__ __forceinline__ c32 cmul(c32 a, c32 b) { return {a.x * b.x - a.y * b.y, a.x * b.y + a.y * b.x}; }
__device__ __forceinline__ constexpr float C32(int k) {
  switch (k) { case 0: return 1.f; case 1: return 0.98078528f; case 2: return 0.923879533f; case 3: return 0.831469612f; case 4: return 0.707106781f; case 5: return 0.555570233f; case 6: return 0.382683432f;
    case 7: return 0.195090322f; case 8: return 0.f; case 9: return -0.195090322f; case 10: return -0.382683432f; case 11: return -0.555570233f; case 12: return -0.707106781f; case 13: return -0.831469612f;
    case 14: return -0.923879533f; default: return -0.98078528f; } }
__device__ __forceinline__ constexpr float S32(int k) {
  switch (k) { case 0: return 0.f; case 1: return 0.195090322f; case 2: return 0.382683432f; case 3: return 0.555570233f; case 4: return 0.707106781f; case 5: return 0.831469612f; case 6: return 0.923879533f;
    case 7: return 0.98078528f; case 8: return 1.f; case 9: return 0.98078528f; case 10: return 0.923879533f; case 11: return 0.831469612f; case 12: return 0.707106781f; case 13: return 0.555570233f;
    case 14: return 0.382683432f; default: return 0.195090322f; } }
__device__ __forceinline__ constexpr int brev(int q, int bits) {
  return bits == 4 ? (((q & 1) << 3) | ((q & 2) << 1) | ((q & 4) >> 1) | ((q & 8) >> 3))
                   : (((q & 1) << 4) | ((q & 2) << 2) | (q & 4) | ((q & 8) >> 2) | ((q & 16) >> 4)); }
__device__ __forceinline__ int phys(int p) { return p + (p >> 5); }
template <int R, int HALF, bool INV> struct DftStage {
  static __device__ __forceinline__ void run(c32 (&x)[R]) {
#pragma unroll
    for (int blk = 0; blk < R; blk += 2 * HALF) {
#pragma unroll
      for (int j = 0; j < HALF; ++j) {
        const c32 a = x[blk + j], b = x[blk + j + HALF]; x[blk + j] = a + b; const c32 d = a - b;
        const int e = j * (R / (2 * HALF)) * (32 / R);
        if (e == 0) x[blk + j + HALF] = d;
        else if (e == 8) x[blk + j + HALF] = INV ? (c32){-d.y, d.x} : (c32){d.y, -d.x};
        else { const c32 wv = {C32(e), INV ? S32(e) : -S32(e)}; x[blk + j + HALF] = cmul(d, wv); }
      } }
    DftStage<R, HALF / 2, INV>::run(x);
  }
};
template <int R, bool INV> struct DftStage<R, 0, INV> { static __device__ __forceinline__ void run(c32 (&)[R]) {} };
template <int R, bool INV> __device__ __forceinline__ void dft_pow2(c32 (&x)[R]) { DftStage<R, R / 2, INV>::run(x); }
template <int R, int HALF> struct DitStage {
  static __device__ __forceinline__ void run(c32 (&x)[R]) {
#pragma unroll
    for (int blk = 0; blk < R; blk += 2 * HALF) {
#pragma unroll
      for (int j = 0; j < HALF; ++j) {
        const int e = j * (R / (2 * HALF)) * (32 / R);
        const c32 a = x[blk + j], b0 = x[blk + j + HALF];
        c32 b;
        if (e == 0) b = b0; else if (e == 8) b = (c32){-b0.y, b0.x}; else b = cmul(b0, (c32){C32(e), S32(e)});
        x[blk + j] = a + b; x[blk + j + HALF] = a - b;
      } }
    DitStage<R, HALF * 2>::run(x);
  }
};
template <int R> struct DitStage<R, R> { static __device__ __forceinline__ void run(c32 (&)[R]) {} };
template <int R> __device__ __forceinline__ void idft_dit(c32 (&x)[R]) { DitStage<R, 1>::run(x); }
template <int STRIDE, bool INV> __device__ __forceinline__ void pass16(c32* buf, int e0, float rev) {
  float rv = rev; asm volatile("" : "+v"(rv));
  const float cs = __builtin_amdgcn_cosf(rv), sn = __builtin_amdgcn_sinf(rv);
  const c32 w1 = {cs, INV ? sn : -sn};
  c32* p = buf + phys(e0); constexpr int PS = STRIDE + STRIDE / 32;
  c32 x[16];
  if (!INV) {
#pragma unroll
    for (int m = 0; m < 16; ++m) x[m] = p[PS * m];
    dft_pow2<16, false>(x);
    c32 w = w1; p[0] = x[0];
#pragma unroll
    for (int q = 1; q < 16; ++q) { p[PS * q] = cmul(x[brev(q, 4)], w); w = cmul(w, w1); }
  } else {
    c32 w = w1; x[0] = p[0];
#pragma unroll
    for (int q = 1; q < 16; ++q) { x[q] = cmul(p[PS * q], w); w = cmul(w, w1); }
    dft_pow2<16, true>(x);
#pragma unroll
    for (int m = 0; m < 16; ++m) p[PS * m] = x[brev(m, 4)];
  }
}
template <int MODE> __device__ __forceinline__ void mid32(c32* buf, h2* Hs, int j) {
  c32* p = buf + 33 * j; c32 x[32];
#pragma unroll
  for (int m = 0; m < 32; ++m) x[m] = p[m];
  dft_pow2<32, false>(x);
  if (MODE == 0) {
#pragma unroll
    for (int q = 0; q < 32; ++q) { const c32 v = x[brev(q, 5)]; Hs[q * 256 + j] = (h2){(_Float16)v.x, (_Float16)v.y}; }
  } else {
#pragma unroll
    for (int pp = 0; pp < 32; ++pp) { const h2 hv = Hs[brev(pp, 5) * 256 + j]; x[pp] = cmul(x[pp], (c32){(float)hv.x, (float)hv.y}); }
    idft_dit<32>(x);
#pragma unroll
    for (int m = 0; m < 32; ++m) p[m] = x[m];
  }
}
__device__ __forceinline__ void fwd2(c32* buf, int tid) {
  __syncthreads(); pass16<512, false>(buf, tid, (float)tid * (1.0f / 8192.0f));
  __syncthreads(); pass16<32, false>(buf, (tid >> 5) * 512 + (tid & 31), (float)(tid & 31) * (1.0f / 512.0f));
  __syncthreads();
}
__device__ __forceinline__ void conv(c32* buf, h2* Hs, int tid) {
  fwd2(buf, tid);
  if (tid < 256) mid32<1>(buf, Hs, tid);
  __syncthreads(); pass16<32, true>(buf, (tid >> 5) * 512 + (tid & 31), (float)(tid & 31) * (1.0f / 512.0f));
  __syncthreads(); pass16<512, true>(buf, tid, (float)tid * (1.0f / 8192.0f));
  __syncthreads();
}
__device__ __forceinline__ void item(int c, const bf16_t* HYT, const float* HK, const float* hy_bias, bf16_t* HYO, char* lds) {
  c32* buf = (c32*)lds; h2* H0 = (h2*)(lds + 67584); h2* H1 = H0 + 8192;
  const int tid = TIDX;
#pragma unroll 1
  for (int o = 0; o < 2; ++o) {
    const float* kp = HK + ((size_t)o * 256 + c) * 8192;
#pragma unroll
    for (int i = 0; i < 16; ++i) { const int n = tid + 512 * i; buf[phys(n)] = (c32){kp[n], 0.f}; }
    fwd2(buf, tid);
    if (tid < 256) mid32<0>(buf, o ? H1 : H0, tid);
    __syncthreads();
  }
  const float bias0 = hy_bias[c], bias1 = hy_bias[256 + c];
#pragma unroll 1
  for (int pr = 0; pr < 2; ++pr) {
    const bf16_t* v0 = HYT + ((size_t)(2 * pr) * 768 + c) * SEQ; const bf16_t* v1 = v0 + (size_t)768 * SEQ;
    c32 vv[8];
#pragma unroll
    for (int i = 0; i < 8; ++i) { const int t = tid + 512 * i; vv[i] = (c32){bf2f(v0[t]), bf2f(v1[t])}; buf[phys(t)] = vv[i]; buf[phys(t + 4096)] = (c32){0.f, 0.f}; }
    conv(buf, H0, tid);
#pragma unroll
    for (int i = 0; i < 8; ++i) { const int t = tid + 512 * i; const c32 y = buf[phys(t)];
      vv[i] = (c32){bf2f(v0[(size_t)256 * SEQ + t]) * (y.x * (1.0f / 8192.0f) + bias0 * vv[i].x), bf2f(v1[(size_t)256 * SEQ + t]) * (y.y * (1.0f / 8192.0f) + bias0 * vv[i].y)};
      buf[phys(t)] = vv[i]; buf[phys(t + 4096)] = (c32){0.f, 0.f}; }
    conv(buf, H1, tid);
#pragma unroll
    for (int i = 0; i < 8; ++i) { const int t = tid + 512 * i; const c32 y = buf[phys(t)];
      HYO[((size_t)(2 * pr) * 256 + c) * SEQ + t] = (bf16_t)f2bf(bf2f(v0[(size_t)512 * SEQ + t]) * (y.x * (1.0f / 8192.0f) + bias1 * vv[i].x));
      HYO[((size_t)(2 * pr + 1) * 256 + c) * SEQ + t] = (bf16_t)f2bf(bf2f(v1[(size_t)512 * SEQ + t]) * (y.y * (1.0f / 8192.0f) + bias1 * vv[i].y)); }
    __syncthreads();
  }
}
__device__ __forceinline__ void out_item(int it, const bf16_t* HYO, bf16_t* MIX, char* lds) {
  bf16_t (*T)[72] = (bf16_t (*)[72])lds;
  const int tid = TIDX, b = it >> 8, t0 = ((it >> 2) & 63) * 64, c0 = (it & 3) * 64;
  { const int cc = tid >> 3, t8 = (tid & 7) * 8; *(u32x4*)&T[cc][t8] = *(const u32x4*)(HYO + ((size_t)b * 256 + c0 + cc) * SEQ + t0 + t8); }
  __syncthreads();
  { const int tl = tid >> 3, c8 = (tid & 7) * 8; u32x4 o;
    o.x = (unsigned)T[c8][tl] | ((unsigned)T[c8 + 1][tl] << 16); o.y = (unsigned)T[c8 + 2][tl] | ((unsigned)T[c8 + 3][tl] << 16);
    o.z = (unsigned)T[c8 + 4][tl] | ((unsigned)T[c8 + 5][tl] << 16); o.w = (unsigned)T[c8 + 6][tl] | ((unsigned)T[c8 + 7][tl] << 16);
    *(u32x4*)(MIX + ((size_t)b * TPB + CTXL + t0 + tl) * DM + 768 + c0 + c8) = o; }
  __syncthreads();
}
}

#define LAS __attribute__((address_space(3)))
#define XB_TMO      128
#define XB_XCNT(j)  (256  + 64 * (j))
#define XB_XSUB(j)  (1280 + 64 * (j))
#define XB_XGEN(j)  (2304 + 64 * (j))
#define XB_TOP      3328
#define XB_TOPGEN   3392
#define XCD_BAR_WORDS 3456
#define XB_SPIN_CAP (1u << 18)

__device__ __forceinline__ unsigned xb_ld(unsigned* p)              { return __hip_atomic_load(p, __ATOMIC_RELAXED, __HIP_MEMORY_SCOPE_AGENT); }
__device__ __forceinline__ unsigned xb_add(unsigned* p, unsigned v) { return __hip_atomic_fetch_add(p, v, __ATOMIC_RELAXED, __HIP_MEMORY_SCOPE_AGENT); }
__device__ __forceinline__ unsigned xb_xcc_id() { return (unsigned)__builtin_amdgcn_s_getreg((3 << 11) | 20) & 0xFu; }
#define XB_SPIN(cond, bar) do { unsigned _sp = 0; while (cond) { __builtin_amdgcn_s_sleep(1); \
    if ((++_sp & 255u) == 0u) { if (xb_ld(&(bar)[XB_TMO])) break; if (_sp > XB_SPIN_CAP) { atomicAdd(&(bar)[XB_TMO], 1u); break; } } } } while (0)

struct XcdBarrier {
    unsigned* bar; unsigned x;
    volatile LAS unsigned* st;
};

__device__ __forceinline__ XcdBarrier xcd_barrier_post(unsigned* bar, volatile LAS unsigned* st) {
    XcdBarrier b; b.bar = bar; b.x = xb_xcc_id(); b.st = st;
    if (threadIdx.x == 0) (void)xb_add(&bar[XB_XCNT(b.x)], 1u);
    return b;
}
__device__ __forceinline__ void xcd_barrier_complete(unsigned* bar, unsigned x, unsigned& nloc, unsigned& nx) {
    const unsigned G = gridDim.x * gridDim.y * gridDim.z;
    unsigned sum, cnt, mine, sp = 0u;
    for (;;) {
        sum = 0u; cnt = 0u; mine = 0u;
#pragma unroll
        for (unsigned j = 0; j < 16; ++j) { const unsigned c = xb_ld(&bar[XB_XCNT(j)]); sum += c; cnt += (c > 0u) ? 1u : 0u; mine = (j == x) ? c : mine; }
        if (sum == G) break;
        __builtin_amdgcn_s_sleep(1);
        if ((++sp & 255u) == 0u) { if (xb_ld(&bar[XB_TMO])) break; if (sp > XB_SPIN_CAP) { atomicAdd(&bar[XB_TMO], 1u); break; } }
    }
    nloc = mine > 0u ? mine : 1u; nx = cnt > 0u ? cnt : 1u;
}

__device__ __forceinline__ void xcd_barrier(const XcdBarrier& b) {
    asm volatile("s_waitcnt vmcnt(0)" ::: "memory");
    __syncthreads();
    if (threadIdx.x == 0) {
        unsigned* bar = b.bar;
        __builtin_amdgcn_s_waitcnt(0);
        unsigned nloc = b.st[0], nx = b.st[1];
        if (nloc == 0u) { xcd_barrier_complete(bar, b.x, nloc, nx); b.st[0] = nloc; b.st[1] = nx; }
        const unsigned old = xb_add(&bar[XB_XSUB(b.x)], 1u);
        const unsigned gen = old / nloc;
        if (old + 1u == (gen + 1u) * nloc) {
            __builtin_amdgcn_fence(__ATOMIC_RELEASE, "agent");
            asm volatile("s_waitcnt vmcnt(0)" ::: "memory");
            const unsigned og = xb_add(&bar[XB_TOP], 1u);
            const unsigned tg = og / nx;
            if (og + 1u == (tg + 1u) * nx) xb_add(&bar[XB_TOPGEN], 1u);
            else XB_SPIN(xb_ld(&bar[XB_TOPGEN]) == tg, bar);
            __builtin_amdgcn_fence(__ATOMIC_ACQUIRE, "agent");
            xb_add(&bar[XB_XGEN(b.x)], 1u);
            asm volatile("s_waitcnt vmcnt(0)" ::: "memory");
        } else {
            XB_SPIN(xb_ld(&bar[XB_XGEN(b.x)]) == gen, bar);
            __builtin_amdgcn_fence(__ATOMIC_ACQUIRE, "agent");
            asm volatile("s_waitcnt vmcnt(0)" ::: "memory");
        }
    }
    __syncthreads();
}


struct MP { const float* in[33]; float* out; unsigned char* ws; };
typedef const float* const __attribute__((address_space(4))) * kargs_t;
#define KARGS() ({ kargs_t k_ = (kargs_t)__builtin_amdgcn_kernarg_segment_ptr(); asm volatile("" : "+s"(k_)); k_; })
#define WSP(K, off) ((unsigned char*)(K)[34] + (off))

__global__ void __launch_bounds__(NT, 2) mega(MP P) {
  cg::grid_group grid = cg::this_grid();
  extern __shared__ __attribute__((aligned(16))) char lds[];
  volatile LAS unsigned* xst = (volatile LAS unsigned*)(lds + LDS_BYTES - 16);
  unsigned long long* tsl = (unsigned long long*)(lds + LDS_BYTES - 1024);
  int nts = 0;
  if (threadIdx.x < 2) xst[threadIdx.x] = 0u;
  { kargs_t K = KARGS(); unsigned* bw = (unsigned*)WSP(K, WS_CTL) + CT_BAR;
    if (blockIdx.x == 0) for (int i = threadIdx.x; i < XCD_BAR_WORDS; i += NT) bw[i] = 0u; }
  __syncthreads();
#define STAMP() do { if (PROBE_A >= 0 && blockIdx.x == 0 && threadIdx.x == 0) tsl[nts] = __builtin_amdgcn_s_memrealtime(); ++nts; } while (0)
#define SEAM() do { xcd_barrier(xbar); STAMP(); } while (0)
  {
    kargs_t K = KARGS();
    st_adaln(K[1], K[3], K[4], K[5], (float*)WSP(K, WS_MODV), lds);
    st_rope((float*)WSP(K, WS_ROPE));
  }
  grid.sync();
  XcdBarrier xbar;
  { kargs_t K = KARGS(); xbar = xcd_barrier_post((unsigned*)WSP(K, WS_CTL) + CT_BAR, xst); }
  STAMP();
#pragma nounroll
  for (int layer = 0; layer < 2; ++layer) {
    const bool last = layer == 1;
    {
      kargs_t K = KARGS();
      st_weights(K[8], K[26], K[29], K[30], K[31], layer, (bf16_t*)WSP(K, WS_WIN), (bf16_t*)WSP(K, WS_WOUT), (bf16_t*)WSP(K, WS_WGU), (bf16_t*)WSP(K, WS_WD), lds);
    }
    { kargs_t K = KARGS(); const int bid = BIDX, G = gridDim.x;
      for (int it = bid; it < SEQ / 64; it += G) hyfilt_item<SEQ>(it, K[19] + layer * 33 * 64, K[20] + layer * 64, K[21] + layer * 64, K[22] + layer * 4096, K[23] + layer * 64, K[24] + (size_t)layer * 65536, (float*)WSP(K, WS_HK), lds);
      if (!last) for (int it = bid; it < CTXL / 64; it += G) hyfilt_item<CTXL>(it, K[19] + layer * 33 * 64, K[20] + layer * 64, K[21] + layer * 64, K[22] + layer * 4096, K[23] + layer * 64, K[24] + (size_t)layer * 65536, (float*)WSP(K, WS_HKC), lds);
    }
    { kargs_t K = KARGS();
      const float* xl_src = layer == 0 ? K[0] : K[33]; const float* xc_src = layer == 0 ? K[2] : (const float*)WSP(K, WS_XC);
      st_normmod(xl_src, xc_src, K[6] + layer * 1024, (const float*)WSP(K, WS_MODV) + (size_t)layer * 5 * 6144, 0, 1024, (bf16_t*)WSP(K, WS_H));
    }
    SEAM();
    {
      kargs_t K = KARGS();
      PInProj p{(const bf16_t*)WSP(K, WS_H), (const bf16_t*)WSP(K, WS_WIN), (bf16_t*)WSP(K, WS_QK), (bf16_t*)WSP(K, WS_VZ), (bf16_t*)WSP(K, WS_XBC), (bf16_t*)WSP(K, WS_HY), (float*)WSP(K, WS_DT), 1024};
      st_gemm(p, MTOK / 256, NPAD / 128, lds);
    }
    SEAM();
    {
      kargs_t K = KARGS();
      st_prep_qk((bf16_t*)WSP(K, WS_QK), K[9] + layer * 64, K[10] + layer * 64, (const float*)WSP(K, WS_ROPE));
    }
    { kargs_t K = KARGS();
      st_prep_hy((const bf16_t*)WSP(K, WS_HY), K[17] + layer * 3 * 768, K[18] + layer * 768, (bf16_t*)WSP(K, WS_HYT), last ? 0 : 1, lds);
    }
    { kargs_t K = KARGS(); const int bid = BIDX, G = gridDim.x;
      for (int it = bid; it < 4 * 34 * 6; it += G)
        ssd1_item(it, (const bf16_t*)WSP(K, WS_XBC), (const float*)WSP(K, WS_DT), K[11] + layer * 3 * 640, K[12] + layer * 640, K[13] + layer * 12, K[14] + layer * 12,
                  (float*)WSP(K, WS_Y), (float*)WSP(K, WS_ST), (float*)WSP(K, WS_DEC), lds);
    }
    SEAM();
    {
      { kargs_t K2 = KARGS(); st_ssd_scan2((float*)WSP(K2, WS_ST), (const float*)WSP(K2, WS_DEC)); }
      const int bid = BIDX, G = gridDim.x;
      const int n_att = last ? 384 : 408, n_hyl = 256, n_hyc = last ? 0 : 1024;
      const int total = n_att + n_hyl + n_hyc;
      for (int it = bid; it < total; it += G) {
        int i2 = it;
        if (i2 < n_att) {
          kargs_t K = KARGS();
          int b, h, nt; size_t qrow;
          if (i2 < 384) { b = i2 / 96; const int rem = i2 % 96; h = rem >> 4; qrow = (size_t)b * TPB + CTXL + (rem & 15) * 256; nt = TPB / 64; }
          else { const int uc = i2 - 384; b = uc / 6; h = uc % 6; qrow = (size_t)b * TPB; nt = CTXL / 64; }
          const int kvh = h / 3;
          const attn_body::bf16* QKp = (const attn_body::bf16*)WSP(K, WS_QK); const attn_body::bf16* VZp = (const attn_body::bf16*)WSP(K, WS_VZ);
          attn_body::attn_unit<8>(QKp + qrow * 512 + h * 64, QKp + (size_t)b * TPB * 512 + 384 + kvh * 64, VZp + (size_t)b * TPB * 512 + kvh * 64,
                                  (attn_body::bf16*)WSP(K, WS_H) + qrow * 1024 + h * 64, nt, lds);
          continue; } i2 -= n_att;
        if (i2 < n_hyl) { kargs_t K = KARGS(); hyf::item(i2, (const bf16_t*)WSP(K, WS_HYT), (const float*)WSP(K, WS_HK), K[25] + layer * 512, (bf16_t*)WSP(K, WS_HY), lds); continue; } i2 -= n_hyl;
        { kargs_t K = KARGS(); hyconv_item<CTXL>(i2, (const bf16_t*)WSP(K, WS_HYT) + (size_t)4 * 768 * SEQ, (const float*)WSP(K, WS_HKC), K[25] + layer * 512, (bf16_t*)WSP(K, WS_H), 0, lds); }
      }
    }
    SEAM();
    {
      kargs_t K = KARGS();
      { const int bid = BIDX, G = gridDim.x, nit = last ? 4 * 32 * 2 : 4 * 34 * 2;
        for (int it = bid; it < nit; it += G) { const int g = it & 1, bc = it >> 1; const int b = last ? bc >> 5 : bc / 34, cidx = last ? 2 + (bc & 31) : bc % 34;
          ssd3_item(b, cidx, g, (const bf16_t*)WSP(K, WS_XBC), (const bf16_t*)WSP(K, WS_VZ), (const float*)WSP(K, WS_DT), K[11] + layer * 3 * 640, K[12] + layer * 640, K[13] + layer * 12, K[14] + layer * 12,
                    K[15] + layer * 6, K[16] + layer * 384, (const float*)WSP(K, WS_Y), (const float*)WSP(K, WS_ST), (bf16_t*)WSP(K, WS_H), lds); } }
      { const int bid = BIDX, G = gridDim.x; for (int it = bid; it < 1024; it += G) hyf::out_item(it, (const bf16_t*)WSP(K, WS_HY), (bf16_t*)WSP(K, WS_H), lds); }
      const int t = TIDX; if (BIDX == 0 && t < 256) ((int*)WSP(K, WS_CTL))[t] = 0;
    }
    SEAM();
    {
      kargs_t K = KARGS();
      const float* xl_src = layer == 0 ? K[0] : K[33]; const float* xc_src = layer == 0 ? K[2] : (const float*)WSP(K, WS_XC);
      POutProj p{(const bf16_t*)WSP(K, WS_H), (const bf16_t*)WSP(K, WS_WOUT), xl_src, xc_src, (float*)K[33], (float*)WSP(K, WS_XC), (const float*)WSP(K, WS_MODV) + (size_t)layer * 5 * 6144 + 2048, last ? 1 : 0, 1024};
      st_gemm(p, MTOK / 256, 8, lds);
    }
    SEAM();
    {
      kargs_t K = KARGS();
      st_router(K[33], (const float*)WSP(K, WS_XC), K[7] + layer * 1024, (const float*)WSP(K, WS_MODV) + (size_t)layer * 5 * 6144, K[27], K[28], (bf16_t*)WSP(K, WS_H), (int*)WSP(K, WS_CTL),
                (int*)WSP(K, WS_MOEM), (float*)WSP(K, WS_MOEM + 128 * 1024), last ? 1 : 0);
    }
    SEAM();
    { kargs_t K = KARGS(); st_moe_plan((int*)WSP(K, WS_CTL), (int*)WSP(K, WS_MOEM + 384 * 1024)); }
    SEAM();
    { kargs_t K = KARGS();
      st_moe_gather((const bf16_t*)WSP(K, WS_H), (bf16_t*)WSP(K, WS_H2S), (int*)WSP(K, WS_CTL), (const int*)WSP(K, WS_MOEM), (const float*)WSP(K, WS_MOEM + 128 * 1024),
                    (int*)WSP(K, WS_MOEM + 384 * 1024), (float*)WSP(K, WS_MOEM + 512 * 1024), last ? 1 : 0);
    }
    SEAM();
    { kargs_t K = KARGS();
      PMoe1 p{(const bf16_t*)WSP(K, WS_H2S), (const bf16_t*)WSP(K, WS_WGU), (bf16_t*)WSP(K, WS_ACT), (const int*)WSP(K, WS_CTL), (const float*)WSP(K, WS_MOEM + 512 * 1024), 1024};
      st_gemm(p, MOE_ROWS / 256, 8, lds);
    }
    SEAM();
    { kargs_t K = KARGS();
      PMoe2 p{(const bf16_t*)WSP(K, WS_ACT), (const bf16_t*)WSP(K, WS_WD), (float*)K[33], (float*)WSP(K, WS_XC), (const float*)WSP(K, WS_MODV) + (size_t)layer * 5 * 6144 + 5120, (const int*)WSP(K, WS_CTL),
              (const int*)WSP(K, WS_MOEM + 384 * 1024), 512};
      st_gemm(p, MOE_ROWS / 256, 8, lds);
    }
    SEAM();
  }
  { kargs_t K = KARGS(); st_final((float*)K[33], K[32]); }
  if (PROBE_A >= 0) {
    xcd_barrier(xbar);
    if (blockIdx.x == 0) { kargs_t K = KARGS(); float* o = (float*)K[33];
      const float ea = (float)((tsl[1 + PROBE_A] - tsl[PROBE_A]) + (tsl[12 + PROBE_A] - tsl[11 + PROBE_A])) * 0.01f;
      const float eb = PROBE_B >= 0 ? (float)((tsl[1 + PROBE_B] - tsl[PROBE_B]) + (tsl[12 + PROBE_B] - tsl[11 + PROBE_B])) * 0.01f : 0.f;
      if (threadIdx.x == 0) o[5] = ea;
      for (int i = threadIdx.x; i < 16384; i += NT) o[1024 + i] = eb; }
  }
}

extern "C" void kernel_launch(void* const* d_in, const int* in_sizes, int n_in, void* d_out, int out_size, void* d_ws, size_t ws_size, hipStream_t stream) {
  if (n_in != 33 || ws_size < WS_END) { fprintf(stderr, "kernel_launch: unexpected n_in %d / ws %zu\n", n_in, ws_size); return; }
  static int grid_blocks = 0;
  if (!grid_blocks) {
    int dev = 0, cus = 0, per_cu = 0;
    (void)hipGetDevice(&dev);
    (void)hipDeviceGetAttribute(&cus, hipDeviceAttributeMultiprocessorCount, dev);
    (void)hipFuncSetAttribute((const void*)mega, hipFuncAttributeMaxDynamicSharedMemorySize, LDS_BYTES);
    (void)hipOccupancyMaxActiveBlocksPerMultiprocessor(&per_cu, mega, NT, LDS_BYTES);
    if (per_cu < 1) per_cu = 1;
    if (per_cu > 2) per_cu = 2;
    grid_blocks = cus * per_cu;
  }
  MP p{};
  for (int i = 0; i < 33; ++i) p.in[i] = (const float*)d_in[i];
  p.out = (float*)d_out; p.ws = (unsigned char*)d_ws;
  void* args[] = {&p};
  hipError_t e = hipLaunchCooperativeKernel((const void*)mega, dim3(grid_blocks), dim3(NT), args, LDS_BYTES, stream);
  if (e != hipSuccess) fprintf(stderr, "cooperative launch failed: %s (grid %d)\n", hipGetErrorString(e), grid_blocks);
}
```

```cpp
#include <hip/hip_runtime.h>
#include <hip/hip_cooperative_groups.h>
#include <cstdio>
#include <cstdint>
namespace cg = cooperative_groups;

typedef unsigned short bf16_t;
typedef short bf16x8 __attribute__((ext_vector_type(8)));
typedef float f32x4 __attribute__((ext_vector_type(4)));
typedef unsigned u32x4 __attribute__((ext_vector_type(4)));
typedef unsigned u32x2 __attribute__((ext_vector_type(2)));

constexpr int NB = 4, SEQ = 4096, CTXL = 256, DM = 1024, TPB = 4352, MTOK = NB * TPB;
constexpr int DIN = 2444, NPAD = 2560;
constexpr float EPS = 1e-6f;
constexpr float C2 = 0.125f * 1.4426950408889634f;
constexpr int MOE_ROWS = 23552;
constexpr int NT = 512;
constexpr int LDS_BYTES = 147456;

constexpr size_t MiB = 1u << 20;
constexpr size_t WS_CTL = 0;
constexpr size_t WS_MODV = 1 * MiB;
constexpr size_t WS_ROPE = 2 * MiB;
constexpr size_t WS_MOEM = 3 * MiB;
constexpr size_t WS_DT = 4 * MiB;
constexpr size_t WS_HKC = 5 * MiB;
constexpr size_t WS_XC = 6 * MiB;
constexpr size_t WS_WIN = 10 * MiB;
constexpr size_t WS_WOUT = 15 * MiB;
constexpr size_t WS_WGU = 17 * MiB;
constexpr size_t WS_WD = 33 * MiB;
constexpr size_t WS_HK = 41 * MiB;
constexpr size_t WS_H = 57 * MiB;
constexpr size_t WS_QK = 91 * MiB;
constexpr size_t WS_VZ = 108 * MiB;
constexpr size_t WS_XBC = 125 * MiB;
constexpr size_t WS_HY = WS_XBC + (size_t)MTOK * 768 * 2;
constexpr size_t WS_HYT = WS_HY + (size_t)MTOK * 768 * 2;
constexpr size_t WS_ST = WS_HYT + (size_t)MTOK * 768 * 2;
constexpr size_t WS_Y = WS_ST + (size_t)4 * 34 * 2 * 6 * 4096 * 4;
constexpr size_t WS_END = WS_Y + (size_t)MTOK * 384 * 4;
constexpr size_t WS_DEC = WS_DT + 900 * 1024;
constexpr size_t WS_H2S = WS_QK;
constexpr size_t WS_ACT = WS_H2S + (size_t)MOE_ROWS * 1024 * 2;
static_assert(WS_END <= 256 * MiB, "ws");
static_assert(WS_ACT + (size_t)MOE_ROWS * 512 * 2 <= WS_HYT, "moe alias");

constexpr int CT_CNT = 0, CT_FILL = 32, CT_BASE = 64, CT_NT = 96, CT_TP = 128;
constexpr int CT_BAR = 4096;

__device__ __forceinline__ int opq_v(int v) { asm volatile("" : "+v"(v)); return v; }
__device__ __forceinline__ int opq_s(int v) { asm volatile("" : "+s"(v)); return v; }
#define TIDX opq_v((int)threadIdx.x)
#define BIDX opq_s((int)blockIdx.x)
#define GDIM opq_s((int)gridDim.x)
__device__ __forceinline__ unsigned f2bf(float f) { unsigned u = __float_as_uint(f); return (u + 0x7fffu + ((u >> 16) & 1u)) >> 16; }
__device__ __forceinline__ float bf2f(bf16_t h) { return __uint_as_float(((unsigned)h) << 16); }
__device__ __forceinline__ float wave_sum(float v) {
#pragma unroll
  for (int o = 1; o < 64; o <<= 1) v += __shfl_xor(v, o);
  return v;
}
__device__ __forceinline__ float siluf(float v) { return v / (1.0f + __expf(-v)); }
__device__ __forceinline__ float* xrow(const float* xl, const float* xc, int r) {
  const int b = r / TPB, j = r - b * TPB;
  return (float*)(j < CTXL ? xc + ((size_t)b * CTXL + j) * DM : xl + ((size_t)b * SEQ + (j - CTXL)) * DM);
}
__device__ __forceinline__ int mrow_of(int r) { const int b = r / TPB, j = r - b * TPB; return j < CTXL ? 4 : b; }

__device__ __forceinline__ void st_adaln(const float* c, const float* c_ctx, const float* w_mod, const float* b_mod, float* modv, char* lds) {
  float (*sc)[1024] = (float (*)[1024])lds;
  float (*red)[5][64] = (float (*)[5][64])(lds + 5 * 1024 * 4);
  const int tid = TIDX;
  for (int it = BIDX; it < 192; it += GDIM) {
    const int layer = it / 96, n0 = (it % 96) * 64;
    for (int i = tid; i < 5 * 1024; i += NT) { const int r = i >> 10, k = i & 1023; const float v = r < 4 ? c[r * 1024 + k] : c_ctx[k]; sc[r][k] = v / (1.0f + expf(-v)); }
    __syncthreads();
    const int kg = tid >> 6, n = tid & 63;
    float acc[5] = {0.f, 0.f, 0.f, 0.f, 0.f};
    for (int k = kg; k < 1024; k += 8) { const float w = w_mod[((size_t)layer * 1024 + k) * 6144 + n0 + n];
#pragma unroll
      for (int r = 0; r < 5; ++r) acc[r] += sc[r][k] * w; }
#pragma unroll
    for (int r = 0; r < 5; ++r) red[kg][r][n] = acc[r];
    __syncthreads();
    if (tid < 320) { const int r = tid >> 6, nn = tid & 63; float s = 0.f;
#pragma unroll
      for (int g = 0; g < 8; ++g) s += red[g][r][nn];
      modv[((size_t)layer * 5 + r) * 6144 + n0 + nn] = s + b_mod[layer * 6144 + n0 + nn]; }
    __syncthreads();
  }
}
__device__ __forceinline__ void st_rope(float* rope) {
  for (int i = BIDX * NT + TIDX; i < 4096 * 32; i += GDIM * NT) {
    const int t = i >> 5, d = i & 31, m = d & 15;
    const float inv = powf(10000.0f, -(float)(2 * m) / 32.0f);
    const float pos = (float)(d < 16 ? (t >> 6) : (t & 63));
    const float ang = pos * inv;
    rope[2 * i] = cosf(ang); rope[2 * i + 1] = sinf(ang);
  }
}

__device__ __forceinline__ void st_normmod(const float* xl, const float* xc, const float* g, const float* modv_layer, int off_sh, int off_sc, bf16_t* H) {
  const int lane = TIDX & 63, gw = BIDX * 8 + (TIDX >> 6), ngw = GDIM * 8;
  for (int r = gw; r < MTOK; r += ngw) {
    const float* xr = xrow(xl, xc, r); const float* mv = modv_layer + (size_t)mrow_of(r) * 6144;
    f32x4 v[4]; float ss = 0.f;
#pragma unroll
    for (int j = 0; j < 4; ++j) { v[j] = *(const f32x4*)(xr + 4 * lane + 256 * j); ss += v[j].x * v[j].x + v[j].y * v[j].y + v[j].z * v[j].z + v[j].w * v[j].w; }
    const float rstd = rsqrtf(wave_sum(ss) * (1.0f / DM) + EPS);
#pragma unroll
    for (int j = 0; j < 4; ++j) { const int k = 4 * lane + 256 * j;
      const f32x4 gg = *(const f32x4*)(g + k), sh = *(const f32x4*)(mv + off_sh + k), sc = *(const f32x4*)(mv + off_sc + k);
      const float o0 = v[j].x * rstd * gg.x * (1.f + sc.x) + sh.x, o1 = v[j].y * rstd * gg.y * (1.f + sc.y) + sh.y;
      const float o2 = v[j].z * rstd * gg.z * (1.f + sc.z) + sh.z, o3 = v[j].w * rstd * gg.w * (1.f + sc.w) + sh.w;
      u32x2 w; w.x = f2bf(o0) | (f2bf(o1) << 16); w.y = f2bf(o2) | (f2bf(o3) << 16);
      *(u32x2*)(H + (size_t)r * DM + k) = w; }
  }
}

template <int MODE> __device__ __forceinline__ void tr_tile(const float* src, const float* src2, int ldsrc, int K, bf16_t* out, int n0, int k0, char* lds) {
  float (*tile)[65] = (float (*)[65])lds;
  const int tid = TIDX;
#pragma unroll
  for (int i = 0; i < 8; ++i) { const int kk = (tid >> 6) + 8 * i, nn = tid & 63, n = n0 + nn; float v = 0.f;
    if (MODE == 0) { const int col = n < 1676 ? n : (n < 1792 ? -1 : n - 116); if (col >= 0) v = src[(size_t)(k0 + kk) * ldsrc + col]; }
    else if (MODE == 1) { v = src[(size_t)(k0 + kk) * ldsrc + n]; }
    else { v = (n & 1) ? src2[(size_t)(k0 + kk) * ldsrc + (n >> 1)] : src[(size_t)(k0 + kk) * ldsrc + (n >> 1)]; }
    tile[kk][nn] = v; }
  __syncthreads();
#pragma unroll
  for (int i = 0; i < 4; ++i) { const int nn = (tid >> 5) + 16 * i, kk = (tid & 31) * 2;
    *(unsigned*)(out + (size_t)(n0 + nn) * K + k0 + kk) = f2bf(tile[kk][nn]) | (f2bf(tile[kk + 1][nn]) << 16); }
  __syncthreads();
}
__device__ __forceinline__ void st_weights(const float* w_in, const float* w_out, const float* w_gate, const float* w_up, const float* w_down, int layer,
                                           bf16_t* WIN, bf16_t* WOUT, bf16_t* WGU, bf16_t* WD, char* lds) {
  for (int it = BIDX; it < 3968; it += GDIM) {
    if (it < 640) tr_tile<0>(w_in + (size_t)layer * 1024 * DIN, nullptr, DIN, 1024, WIN, (it % 40) * 64, (it / 40) * 64, lds);
    else if (it < 896) { const int i2 = it - 640; tr_tile<1>(w_out + (size_t)layer * 1024 * 1024, nullptr, 1024, 1024, WOUT, (i2 & 15) * 64, (i2 >> 4) * 64, lds); }
    else if (it < 2944) { const int i2 = it - 896, e = i2 >> 7, t = i2 & 127;
      tr_tile<2>(w_gate + ((size_t)layer * 16 + e) * 1024 * 256, w_up + ((size_t)layer * 16 + e) * 1024 * 256, 256, 1024, WGU + (size_t)e * 512 * 1024, (t & 7) * 64, (t >> 3) * 64, lds); }
    else { const int i2 = it - 2944, e = i2 >> 6, t = i2 & 63;
      tr_tile<1>(w_down + ((size_t)layer * 16 + e) * 256 * 1024, nullptr, 1024, 256, WD + (size_t)e * 1024 * 256, (t & 15) * 64, (t >> 4) * 64, lds); }
  }
}

template <class P> __device__ __forceinline__ void st_gemm(const P& p, int ntm, int ntn, char* lds) {
  bf16_t (*As)[72] = (bf16_t (*)[72])lds;
  bf16_t (*Bs)[72] = (bf16_t (*)[72])(lds + 256 * 72 * 2);
  const int tid = TIDX, lane = tid & 63, w = tid >> 6;
  for (int it = BIDX; it < ntm * ntn; it += GDIM) {
    const int mt = it / ntn, nt = it % ntn;
    if (!p.valid(mt)) continue;
    const int m0 = mt * 256, n0 = nt * 128;
    f32x4 acc[2][8];
#pragma unroll
    for (int a = 0; a < 2; ++a)
#pragma unroll
      for (int b = 0; b < 8; ++b) acc[a][b] = (f32x4){0.f, 0.f, 0.f, 0.f};
    const int K = p.K;
    for (int k0 = 0; k0 < K; k0 += 64) {
#pragma unroll
      for (int i = 0; i < 4; ++i) { const int ch = tid + NT * i, r = ch >> 3, kc = (ch & 7) * 8;
        const bf16_t* ap = p.arow(m0 + r); *(u32x4*)&As[r][kc] = *(const u32x4*)(ap + k0 + kc); }
#pragma unroll
      for (int i = 0; i < 2; ++i) { const int ch = tid + NT * i, r = ch >> 3, kc = (ch & 7) * 8;
        const bf16_t* bp = p.brow(mt, n0 + r, k0); *(u32x4*)&Bs[r][kc] = *(const u32x4*)(bp + kc); }
      __syncthreads();
#pragma unroll
      for (int kk = 0; kk < 2; ++kk) {
        bf16x8 a[2], b[8];
#pragma unroll
        for (int mi = 0; mi < 2; ++mi) a[mi] = *(const bf16x8*)&As[32 * w + 16 * mi + (lane & 15)][kk * 32 + 8 * (lane >> 4)];
#pragma unroll
        for (int ni = 0; ni < 8; ++ni) b[ni] = *(const bf16x8*)&Bs[16 * ni + (lane & 15)][kk * 32 + 8 * (lane >> 4)];
#pragma unroll
        for (int mi = 0; mi < 2; ++mi)
#pragma unroll
          for (int ni = 0; ni < 8; ++ni) acc[mi][ni] = __builtin_amdgcn_mfma_f32_16x16x32_bf16(a[mi], b[ni], acc[mi][ni], 0, 0, 0);
      }
      __syncthreads();
    }
    p.epi(acc, mt, m0, n0, w, lane);
  }
}

struct PInProj {
  const bf16_t* H; const bf16_t* W; bf16_t *QK, *VZ, *XBC, *HY; float* DT; int K;
  __device__ bool valid(int) const { return true; }
  __device__ const bf16_t* arow(int m) const { return H + (size_t)m * DM; }
  __device__ const bf16_t* brow(int, int n, int k0) const { return W + (size_t)n * DM + k0; }
  __device__ void epi(const f32x4 (&acc)[2][8], int, int m0, int n0, int w, int lane) const {
#pragma unroll
    for (int mi = 0; mi < 2; ++mi)
#pragma unroll
      for (int ni = 0; ni < 8; ++ni)
#pragma unroll
        for (int rg = 0; rg < 4; ++rg) { const int row = m0 + 32 * w + 16 * mi + 4 * (lane >> 4) + rg, col = n0 + 16 * ni + (lane & 15); const float v = acc[mi][ni][rg];
          if (col < 512) QK[(size_t)row * 512 + col] = (bf16_t)f2bf(v);
          else if (col < 1024) VZ[(size_t)row * 512 + col - 512] = (bf16_t)f2bf(v);
          else if (col < 1792) { XBC[(size_t)row * 768 + col - 1024] = (bf16_t)f2bf(v); if (col >= 1664 && col < 1676) DT[(size_t)row * 12 + col - 1664] = v; }
          else HY[(size_t)row * 768 + col - 1792] = (bf16_t)f2bf(v); }
  }
};
struct POutProj {
  const bf16_t* A; const bf16_t* W; const float *xl_src, *xc_src; float *xl_dst, *xc_dst; const float* gate;   int skip_ctx; int K;
  __device__ bool valid(int mt) const { return !(skip_ctx && ((mt * 256) % TPB) < CTXL); }
  __device__ const bf16_t* arow(int m) const { return A + (size_t)m * DM; }
  __device__ const bf16_t* brow(int, int n, int k0) const { return W + (size_t)n * DM + k0; }
  __device__ void epi(const f32x4 (&acc)[2][8], int, int m0, int n0, int w, int lane) const {
#pragma unroll
    for (int mi = 0; mi < 2; ++mi)
#pragma unroll
      for (int rg = 0; rg < 4; ++rg) { const int row = m0 + 32 * w + 16 * mi + 4 * (lane >> 4) + rg;
        const float* xs = xrow(xl_src, xc_src, row); float* xd = xrow(xl_dst, xc_dst, row); const float* gt = gate + (size_t)mrow_of(row) * 6144;
#pragma unroll
        for (int ni = 0; ni < 8; ++ni) { const int col = n0 + 16 * ni + (lane & 15); xd[col] = xs[col] + gt[col] * acc[mi][ni][rg]; } }
  }
};
__device__ __forceinline__ void pair_experts(int pidx, int& eA, int& eB) {
  const int g = pidx / 6, t = pidx - 6 * g; const int i = t < 3 ? 0 : (t < 5 ? 1 : 2); const int j = t < 3 ? t + 1 : (t < 5 ? t - 1 : 3);
  eA = 4 * g + i; eB = 4 * g + j;
}
struct PMoe1 {
  const bf16_t* H2S; const bf16_t* WGU; bf16_t* ACT; const int* ctl; const float* sorted_w; int K;
  __device__ bool valid(int mt) const { return mt < ctl[CT_NT]; }
  __device__ const bf16_t* arow(int m) const { return H2S + (size_t)m * DM; }
  __device__ const bf16_t* brow(int mt, int n, int k0) const { int eA, eB; pair_experts(ctl[CT_TP + mt], eA, eB); const int e = n < 512 ? eA : eB;
    return WGU + ((size_t)e * 512 + (n & 511)) * DM + k0; }
  __device__ void epi(const f32x4 (&acc)[2][8], int, int m0, int n0, int w, int lane) const {
    const int half = n0 >> 9, tb = (n0 & 511) >> 7;
#pragma unroll
    for (int mi = 0; mi < 2; ++mi)
#pragma unroll
      for (int rg = 0; rg < 4; ++rg) { const int slot = m0 + 32 * w + 16 * mi + 4 * (lane >> 4) + rg; const float wt = sorted_w[2 * slot + half];
#pragma unroll
        for (int ni = 0; ni < 4; ++ni) { const float g = acc[mi][ni][rg], u = acc[mi][ni + 4][rg]; const int j = 64 * tb + 16 * ni + (lane & 15);
          ACT[(size_t)slot * 512 + half * 256 + j] = (bf16_t)f2bf(siluf(g) * u * wt); } }
  }
};
struct PMoe2 {
  const bf16_t* ACT; const bf16_t* WD; float *xl, *xc; const float* gate;   const int* ctl; const int* sorted_tok; int K;
  __device__ bool valid(int mt) const { return mt < ctl[CT_NT]; }
  __device__ const bf16_t* arow(int m) const { return ACT + (size_t)m * 512; }
  __device__ const bf16_t* brow(int mt, int n, int k0) const { int eA, eB; pair_experts(ctl[CT_TP + mt], eA, eB); const int e = k0 < 256 ? eA : eB;
    return WD + ((size_t)e * 1024 + n) * 256 + (k0 & 255); }
  __device__ void epi(const f32x4 (&acc)[2][8], int, int m0, int n0, int w, int lane) const {
#pragma unroll
    for (int mi = 0; mi < 2; ++mi)
#pragma unroll
      for (int rg = 0; rg < 4; ++rg) { const int slot = m0 + 32 * w + 16 * mi + 4 * (lane >> 4) + rg; const int r = sorted_tok[slot];
        if (r >= 0) { float* xd = xrow(xl, xc, r); const float* gt = gate + (size_t)mrow_of(r) * 6144;
#pragma unroll
          for (int ni = 0; ni < 8; ++ni) { const int col = n0 + 16 * ni + (lane & 15); xd[col] += gt[col] * acc[mi][ni][rg]; } } }
  }
};

__device__ __forceinline__ void st_prep_qk(bf16_t* QK, const float* qn, const float* kn, const float* rope) {
  const int lane = TIDX & 63, gw = BIDX * 8 + (TIDX >> 6), ngw = GDIM * 8;
  for (int it = gw; it < MTOK * 8; it += ngw) {
    const int r = it >> 3, hh = it & 7, j = r % TPB;
    bf16_t* p = QK + (size_t)r * 512 + hh * 64 + lane;
    const float v = bf2f(*p);
    const float ss = wave_sum(v * v);
    float y = v * rsqrtf(ss * (1.0f / 64.0f) + EPS) * (hh < 6 ? qn[lane] : kn[lane]);
    if (j >= CTXL) { const int t = j - CTXL; const float other = __shfl_xor(y, 32); const float cs = rope[(t * 32 + (lane & 31)) * 2], sn = rope[(t * 32 + (lane & 31)) * 2 + 1];
      y = lane < 32 ? y * cs - other * sn : y * cs + other * sn; }
    if (hh < 6) y *= C2;
    *p = (bf16_t)f2bf(y);
  }
}

__device__ __forceinline__ void st_prep_hy(const bf16_t* HY, const float* cw, const float* cb, bf16_t* HYT, int do_ctx, char* lds) {
  float (*tile)[65] = (float (*)[65])lds;
  const int nlat = 4 * 64 * 12, nitem = nlat + (do_ctx ? 4 * 4 * 12 : 0), tid = TIDX;
  for (int it = BIDX; it < nitem; it += GDIM) {
    int b, tt, ct, L, joff; bf16_t* outb;
    if (it < nlat) { b = it / 768; tt = (it % 768) / 12; ct = it % 12; L = SEQ; joff = CTXL; outb = HYT + (size_t)b * 768 * SEQ; }
    else { const int i2 = it - nlat; b = i2 / 48; tt = (i2 % 48) / 12; ct = i2 % 12; L = CTXL; joff = 0; outb = HYT + (size_t)4 * 768 * SEQ + (size_t)b * 768 * CTXL; }
    const int t0 = tt * 64, c0 = ct * 64;
    for (int e = tid; e < 66 * 64; e += NT) { const int rr = e >> 6, cc = e & 63, t = t0 - 1 + rr;
      tile[rr][cc] = (t >= 0 && t < L) ? bf2f(HY[((size_t)b * TPB + joff + t) * 768 + c0 + cc]) : 0.f; }
    __syncthreads();
    for (int e = tid; e < 64 * 64; e += NT) { const int cc = e >> 6, tl = e & 63, c = c0 + cc;
      const float v = cw[c] * tile[tl][cc] + cw[768 + c] * tile[tl + 1][cc] + cw[1536 + c] * tile[tl + 2][cc] + cb[c];
      outb[(size_t)c * L + t0 + tl] = (bf16_t)f2bf(v); }
    __syncthreads();
  }
}

template <int L> __device__ __forceinline__ void hyfilt_item(int item, const float* w1, const float* b1, const float* fr, const float* w2, const float* b2, const float* w3, float* HK, char* lds) {
  float* S0 = (float*)lds; float* S1 = S0 + 64 * 64; float* S2 = S1 + 64 * 64;
  const int tid = TIDX, n0 = item * 64, lane = tid & 63, wv = tid >> 6;
  for (int e = tid; e < 64 * 33; e += NT) { const int pp = e / 33, f = e % 33; const int n = n0 + pp; float v;
    if (f == 0) v = (float)n / (float)(L - 1);
    else { const int m = (f - 1) & 15; const float band = 1e-4f + (float)m * ((15.0f - 1e-4f) / 15.0f); const float wpos = (6.283185307179586f / (float)L) * (float)n;
      v = f <= 16 ? cosf(wpos * band) : -sinf(wpos * band); }
    S0[pp * 33 + f] = v; }
  for (int e = tid; e < 33 * 64; e += NT) S1[e] = w1[e];
  __syncthreads();
  for (int e = tid; e < 64 * 64; e += NT) { const int pp = e >> 6, j = e & 63; float a = b1[j];
    for (int f = 0; f < 33; ++f) a += S0[pp * 33 + f] * S1[f * 64 + j];
    S2[pp * 64 + j] = sinf(fr[j] * a); }
  __syncthreads();
  for (int e = tid; e < 64 * 64; e += NT) S0[e] = w2[e];
  __syncthreads();
  for (int e = tid; e < 64 * 64; e += NT) { const int pp = e >> 6, j = e & 63; float a = b2[j];
    for (int f = 0; f < 64; ++f) a += S2[pp * 64 + f] * S0[f * 64 + j];
    S1[pp * 64 + j] = sinf(fr[j] * a); }
  __syncthreads();
  for (int ch = 0; ch < 16; ++ch) {
    const int col = ch * 64 + lane; float acc[8];
#pragma unroll
    for (int i = 0; i < 8; ++i) acc[i] = 0.f;
    for (int j = 0; j < 64; ++j) { const float wv3 = w3[j * 1024 + col];
#pragma unroll
      for (int i = 0; i < 8; ++i) acc[i] += S1[(wv * 8 + i) * 64 + j] * wv3; }
    const int c = col & 255; const float delta = 3.0701134573253943f + (float)c * ((15.350567286626972f - 3.0701134573253943f) / 255.0f);
#pragma unroll
    for (int i = 0; i < 8; ++i) { const int pp = wv * 8 + i; const float t = (float)(n0 + pp) / (float)(L - 1); S2[lane * 65 + pp] = acc[i] * expf(-t * delta); }
    __syncthreads();
    const int dir = ch >> 3, order = (ch >> 2) & 1;
#pragma unroll
    for (int i = 0; i < 8; ++i) { const int cl = wv * 8 + i, c2 = (ch * 64 + cl) & 255, n = n0 + lane; const float v = S2[cl * 65 + lane];
      float* dst = HK + ((size_t)order * 256 + c2) * (2 * L);
      if (dir == 0) dst[n] = v; else if (n >= 1) dst[2 * L - n] = v;
      if (dir == 1 && n == 0) dst[L] = 0.f; }
    __syncthreads();
  }
}

template <int L> __device__ __forceinline__ void hyconv_item(int item, const bf16_t* HYT, const float* HK, const float* hy_bias, bf16_t* MIX, int joff, char* lds) {
  float* kern = (float*)lds; float* z = kern + 2 * L;
  const int tid = TIDX, b = item >> 8, c = item & 255;
  const bf16_t* vp = HYT + ((size_t)b * 768 + c) * L; const bf16_t* x1p = vp + (size_t)256 * L; const bf16_t* x2p = vp + (size_t)512 * L;
  const bool act = tid < L / 8; const int tb = 8 * tid;
  for (int o = 0; o < 2; ++o) {
    if (o == 0) for (int t = tid; t < L; t += NT) z[t] = bf2f(vp[t]);
    const float* kp = HK + ((size_t)o * 256 + c) * (2 * L);
    for (int t = tid; t < 2 * L; t += NT) kern[t] = kp[t];
    __syncthreads();
    float acc[8], W[16];
#pragma unroll
    for (int i = 0; i < 8; ++i) acc[i] = 0.f;
    if (act) {
#pragma unroll
      for (int i = 0; i < 8; ++i) W[8 + i] = kern[(tb + i) & (2 * L - 1)];
      for (int s0 = 0; s0 < L; s0 += 8) {
        const int bb = (tb - s0 - 8) & (2 * L - 1);
#pragma unroll
        for (int i = 0; i < 8; ++i) W[i] = kern[bb + i];
        float zs[8];
#pragma unroll
        for (int j = 0; j < 8; ++j) zs[j] = z[s0 + j];
#pragma unroll
        for (int j = 0; j < 8; ++j)
#pragma unroll
          for (int i = 0; i < 8; ++i) acc[i] += W[8 + i - j] * zs[j];
#pragma unroll
        for (int i = 0; i < 8; ++i) W[8 + i] = W[i];
      }
    }
    __syncthreads();
    const float bias = hy_bias[o * 256 + c];
    if (act) {
#pragma unroll
      for (int i = 0; i < 8; ++i) { const int t = tb + i; const float zz = acc[i] + bias * z[t];
        if (o == 0) z[t] = bf2f(x1p[t]) * zz;
        else MIX[((size_t)b * TPB + joff + t) * DM + 768 + c] = (bf16_t)f2bf(bf2f(x2p[t]) * zz); }
    }
    __syncthreads();
  }
}

__device__ __forceinline__ void attn_unit_simple(int u, const bf16_t* QK, const bf16_t* VZ, bf16_t* MIX, char* lds) {
  bf16_t (*Ks)[72] = (bf16_t (*)[72])lds;
  bf16_t (*Vt)[72] = (bf16_t (*)[72])(lds + 64 * 72 * 2);
  bf16_t (*Ps)[16][72] = (bf16_t (*)[16][72])(lds + 2 * 64 * 72 * 2);
  const int tid = TIDX, lane = tid & 63, w = tid >> 6;
  int b, h, qrow0, nk;
  if (u < 768) { b = u / 192; const int rem = u % 192; h = rem >> 5; qrow0 = b * TPB + CTXL + (rem & 31) * 128; nk = TPB; }
  else { const int uc = u - 768; b = uc / 12; h = (uc % 12) >> 1; qrow0 = b * TPB + (uc & 1) * 128; nk = CTXL; }
  const int kvh = h / 3, key0 = b * TPB, l15 = lane & 15, l4 = lane >> 4;
  bf16x8 aq[2];
#pragma unroll
  for (int kk = 0; kk < 2; ++kk) aq[kk] = *(const bf16x8*)(QK + (size_t)(qrow0 + 16 * w + l15) * 512 + h * 64 + kk * 32 + 8 * l4);
  f32x4 O[4]; float m[4], l[4];
#pragma unroll
  for (int i = 0; i < 4; ++i) { O[i] = (f32x4){0.f, 0.f, 0.f, 0.f}; m[i] = -1e30f; l[i] = 0.f; }
  for (int kt = 0; kt < nk / 64; ++kt) {
    __syncthreads();
    { const int r = tid >> 3, c8 = (tid & 7) * 8; const size_t grow = (size_t)(key0 + kt * 64 + r) * 512;
      *(u32x4*)&Ks[r][c8] = *(const u32x4*)(QK + grow + 384 + kvh * 64 + c8);
      const bf16x8 vv = *(const bf16x8*)(VZ + grow + kvh * 64 + c8);
#pragma unroll
      for (int e = 0; e < 8; ++e) Vt[c8 + e][r] = (bf16_t)vv[e]; }
    __syncthreads();
    f32x4 s[4];
#pragma unroll
    for (int ni = 0; ni < 4; ++ni) s[ni] = (f32x4){0.f, 0.f, 0.f, 0.f};
#pragma unroll
    for (int kk = 0; kk < 2; ++kk)
#pragma unroll
      for (int ni = 0; ni < 4; ++ni) { const bf16x8 bk = *(const bf16x8*)&Ks[16 * ni + l15][32 * kk + 8 * l4]; s[ni] = __builtin_amdgcn_mfma_f32_16x16x32_bf16(aq[kk], bk, s[ni], 0, 0, 0); }
#pragma unroll
    for (int rg = 0; rg < 4; ++rg) {
      float mx = fmaxf(fmaxf(s[0][rg], s[1][rg]), fmaxf(s[2][rg], s[3][rg]));
      mx = fmaxf(mx, __shfl_xor(mx, 1)); mx = fmaxf(mx, __shfl_xor(mx, 2)); mx = fmaxf(mx, __shfl_xor(mx, 4)); mx = fmaxf(mx, __shfl_xor(mx, 8));
      const float mn = fmaxf(m[rg], mx), alpha = exp2f(m[rg] - mn); float rs = 0.f;
#pragma unroll
      for (int ni = 0; ni < 4; ++ni) { const float pv = exp2f(s[ni][rg] - mn); rs += pv; Ps[w][4 * l4 + rg][16 * ni + l15] = (bf16_t)f2bf(pv); }
      rs += __shfl_xor(rs, 1); rs += __shfl_xor(rs, 2); rs += __shfl_xor(rs, 4); rs += __shfl_xor(rs, 8);
      l[rg] = l[rg] * alpha + rs; m[rg] = mn;
#pragma unroll
      for (int ni = 0; ni < 4; ++ni) O[ni][rg] *= alpha;
    }
    __syncthreads();
#pragma unroll
    for (int kk = 0; kk < 2; ++kk) { const bf16x8 ap = *(const bf16x8*)&Ps[w][l15][32 * kk + 8 * l4];
#pragma unroll
      for (int ni = 0; ni < 4; ++ni) { const bf16x8 bv = *(const bf16x8*)&Vt[16 * ni + l15][32 * kk + 8 * l4]; O[ni] = __builtin_amdgcn_mfma_f32_16x16x32_bf16(ap, bv, O[ni], 0, 0, 0); } }
  }
#pragma unroll
  for (int rg = 0; rg < 4; ++rg) { const float il = 1.0f / l[rg]; const size_t row = (size_t)(qrow0 + 16 * w + 4 * l4 + rg);
#pragma unroll
    for (int ni = 0; ni < 4; ++ni) MIX[row * DM + h * 64 + 16 * ni + l15] = (bf16_t)f2bf(O[ni][rg] * il); }
  __syncthreads();
}

__device__ __forceinline__ void st_ssd_prep(const bf16_t* XBC, float* DT, const float* cw, const float* cb, const float* dt_bias, bf16_t* XBCC) {
  const size_t total = (size_t)MTOK * 640;
  for (size_t i = (size_t)BIDX * NT + TIDX; i < total; i += (size_t)GDIM * NT) {
    const int r = (int)(i / 640), ch = (int)(i % 640), j = r % TPB;
    const bool hasp = (j != 0 && j != CTXL), hasn = (j != CTXL - 1 && j != TPB - 1);
    float v = cw[640 + ch] * bf2f(XBC[(size_t)r * 768 + ch]) + cb[ch];
    if (hasp) v += cw[ch] * bf2f(XBC[(size_t)(r - 1) * 768 + ch]);
    if (hasn) v += cw[1280 + ch] * bf2f(XBC[(size_t)(r + 1) * 768 + ch]);
    XBCC[i] = (bf16_t)f2bf(siluf(v));
  }
  for (size_t i = (size_t)BIDX * NT + TIDX; i < (size_t)MTOK * 12; i += (size_t)GDIM * NT) {
    const float x = DT[i] + dt_bias[i % 12];
    DT[i] = x > 20.f ? x : log1pf(expf(x));
  }
}
__device__ __forceinline__ void ssd_scan_item(int item, const bf16_t* XBCC, const float* DT, const float* a_log, float* Y, char* lds) {
  const int half = TIDX >> 8, tid = TIDX & 255;
  float* base = (float*)(lds + half * 25088);
  float (*xs)[64] = (float (*)[64])base; float (*Bs)[64] = (float (*)[64])(base + 2048); float (*Cs)[64] = (float (*)[64])(base + 4096);
  float* dAs = base + 6144; float* dts = base + 6176;
  const int bh = 2 * item + half, b = bh / 6, h = bh % 6, g = h / 3, p = tid >> 2, q = tid & 3;
  for (int dir = 0; dir < 2; ++dir) {
    const float a = -expf(a_log[dir * 6 + h]);
    float st[16];
#pragma unroll
    for (int n = 0; n < 16; ++n) st[n] = 0.f;
    for (int ci = 0; ci < TPB / 32; ++ci) {
      for (int e = tid; e < 32 * 64; e += 256) { const int i = e >> 6, cc = e & 63, qi = ci * 32 + i;
        const int j = dir == 0 ? qi : (qi < CTXL ? CTXL - 1 - qi : TPB - 1 - (qi - CTXL)); const size_t r = (size_t)b * TPB + j;
        xs[i][cc] = bf2f(XBCC[r * 640 + h * 64 + cc]); Bs[i][cc] = bf2f(XBCC[r * 640 + 384 + g * 64 + cc]); Cs[i][cc] = bf2f(XBCC[r * 640 + 512 + g * 64 + cc]); }
      if (tid < 32) { const int qi = ci * 32 + tid; const int j = dir == 0 ? qi : (qi < CTXL ? CTXL - 1 - qi : TPB - 1 - (qi - CTXL)); const size_t r = (size_t)b * TPB + j;
        const float dt = DT[r * 12 + dir * 6 + h]; dts[tid] = dt; dAs[tid] = expf(dt * a); }
      __syncthreads();
      for (int i = 0; i < 32; ++i) {
        const float d = dAs[i], dtx = dts[i] * xs[i][p]; float y = 0.f;
#pragma unroll
        for (int n = 0; n < 16; ++n) { st[n] = st[n] * d + dtx * Bs[i][16 * q + n]; y += Cs[i][16 * q + n] * st[n]; }
        y += __shfl_xor(y, 1); y += __shfl_xor(y, 2);
        if (q == 0) { const int qi = ci * 32 + i; const int j = dir == 0 ? qi : (qi < CTXL ? CTXL - 1 - qi : TPB - 1 - (qi - CTXL)); float* yp = Y + ((size_t)b * TPB + j) * 384 + h * 64 + p;
          if (dir == 0) *yp = y; else *yp += y; }
      }
      __syncthreads();
    }
  }
}
__device__ __forceinline__ void st_ssd_out(const float* Y, const bf16_t* XBCC, const bf16_t* VZ, const float* dskip, const float* nw, bf16_t* MIX) {
  const int lane = TIDX & 63, gw = BIDX * 8 + (TIDX >> 6), ngw = GDIM * 8;
  for (int it = gw; it < MTOK * 2; it += ngw) {
    const int r = it >> 1, g = it & 1; float gv[3]; float ss = 0.f;
#pragma unroll
    for (int i = 0; i < 3; ++i) { const int c = g * 192 + lane + 64 * i, hh = c >> 6;
      const float y = Y[(size_t)r * 384 + c] + bf2f(XBCC[(size_t)r * 640 + c]) * dskip[hh]; const float zv = bf2f(VZ[(size_t)r * 512 + 128 + c]);
      gv[i] = y * siluf(zv); ss += gv[i] * gv[i]; }
    const float rstd = rsqrtf(wave_sum(ss) * (1.0f / 192.0f) + EPS);
#pragma unroll
    for (int i = 0; i < 3; ++i) { const int c = g * 192 + lane + 64 * i; MIX[(size_t)r * DM + 384 + c] = (bf16_t)f2bf(gv[i] * rstd * nw[c]); }
  }
}


__device__ __forceinline__ void ssd_conv8(const bf16_t* XBC, size_t r, int c0, bool hasp, bool hasn, const float* cw, const float* cb, float (&o)[8]) {
  const bf16x8 cur = *(const bf16x8*)(XBC + r * 768 + c0);
  bf16x8 prv = (bf16x8){0, 0, 0, 0, 0, 0, 0, 0}, nxt = (bf16x8){0, 0, 0, 0, 0, 0, 0, 0};
  if (hasp) prv = *(const bf16x8*)(XBC + (r - 1) * 768 + c0);
  if (hasn) nxt = *(const bf16x8*)(XBC + (r + 1) * 768 + c0);
#pragma unroll
  for (int e = 0; e < 8; ++e) { const float v = cw[c0 + e] * bf2f((bf16_t)prv[e]) + cw[640 + c0 + e] * bf2f((bf16_t)cur[e]) + cw[1280 + c0 + e] * bf2f((bf16_t)nxt[e]) + cb[c0 + e]; o[e] = siluf(v); }
}
__device__ __forceinline__ float softplusf(float x) { return x > 20.f ? x : log1pf(expf(x)); }
__device__ __forceinline__ void wave_scan128(float e0, float e1, int lane, float& c0, float& c1) {
  float x = e0 + e1;
#pragma unroll
  for (int o = 1; o < 64; o <<= 1) { const float v = __shfl_up(x, o); if (lane >= o) x += v; }
  const float excl = x - (e0 + e1); c0 = excl + e0; c1 = excl + e0 + e1;
}
__device__ __forceinline__ unsigned pk2bf(float lo, float hi) { return f2bf(lo) | (f2bf(hi) << 16); }
__device__ __forceinline__ int ssd_chunk_j0(int cidx) { return cidx < 2 ? cidx * 128 : CTXL + (cidx - 2) * 128; }

__device__ __forceinline__ void ssd1_item(int item, const bf16_t* XBC, const float* DT, const float* cw, const float* cb, const float* dt_bias, const float* a_log,
                                          float* YIN, float* ST, float* DEC, char* lds) {
  bf16_t (*Cm)[72] = (bf16_t (*)[72])lds; bf16_t (*Bm)[72] = (bf16_t (*)[72])(lds + 18432);
  bf16_t (*BT)[136] = (bf16_t (*)[136])(lds + 36864); bf16_t (*Xt)[136] = (bf16_t (*)[136])(lds + 54272); bf16_t (*Mm)[136] = (bf16_t (*)[136])(lds + 71680);
  float* tab = (float*)(lds + 106496); float* dtf = tab; float* dtb = tab + 128; float* acf = tab + 256; float* acb = tab + 384; float* wf = tab + 512; float* wb = tab + 640;
  const int tid = TIDX, lane = tid & 63, w = tid >> 6, l15 = lane & 15, l4 = lane >> 4;
  const int h = item % 6, bc = item / 6, cidx = bc % 34, b = bc / 34, g = h / 3, j0 = ssd_chunk_j0(cidx);
  const size_t r0 = (size_t)b * TPB + j0;
#pragma unroll 2
  for (int i = 0; i < 6; ++i) { const int task = tid + NT * i, t = task / 24, cg = task % 24, kind = cg >> 3, q = cg & 7, j = j0 + t;
    const int c0 = kind == 0 ? h * 64 + 8 * q : (kind == 1 ? 384 + g * 64 + 8 * q : 512 + g * 64 + 8 * q);
    float o[8]; ssd_conv8(XBC, r0 + t, c0, j != 0 && j != CTXL, j != CTXL - 1 && j != TPB - 1, cw, cb, o);
    if (kind == 0) {
#pragma unroll
      for (int e = 0; e < 8; ++e) Xt[8 * q + e][t] = (bf16_t)f2bf(o[e]);
    } else { const u32x4 pk = (u32x4){pk2bf(o[0], o[1]), pk2bf(o[2], o[3]), pk2bf(o[4], o[5]), pk2bf(o[6], o[7])};
      if (kind == 1) { *(u32x4*)&Bm[t][8 * q] = pk;
#pragma unroll
        for (int e = 0; e < 8; ++e) BT[8 * q + e][t] = (bf16_t)f2bf(o[e]); }
      else *(u32x4*)&Cm[t][8 * q] = pk; } }
  if (w < 2) { const int dir = w; const float a = -expf(a_log[dir * 6 + h]), bias = dt_bias[dir * 6 + h];
    const int t0 = dir == 0 ? 2 * lane : 127 - 2 * lane, t1 = dir == 0 ? 2 * lane + 1 : 126 - 2 * lane;
    const float d0 = softplusf(DT[(r0 + t0) * 12 + dir * 6 + h] + bias), d1 = softplusf(DT[(r0 + t1) * 12 + dir * 6 + h] + bias);
    float c0, c1; wave_scan128(d0 * a, d1 * a, lane, c0, c1);
    const float tot = __shfl(c1, 63);
    float* dtt = dir == 0 ? dtf : dtb; float* ac = dir == 0 ? acf : acb; float* ww = dir == 0 ? wf : wb;
    dtt[t0] = d0; dtt[t1] = d1; ac[t0] = c0; ac[t1] = c1; ww[t0] = __expf(tot - c0) * d0; ww[t1] = __expf(tot - c1) * d1;
    if (lane == 0) DEC[(((size_t)b * 34 + cidx) * 2 + dir) * 6 + h] = __expf(tot); }
  __syncthreads();
  {
    f32x4 accG[8];
#pragma unroll
    for (int ni = 0; ni < 8; ++ni) accG[ni] = (f32x4){0.f, 0.f, 0.f, 0.f};
#pragma unroll
    for (int kk = 0; kk < 2; ++kk) { const bf16x8 a = *(const bf16x8*)&Cm[16 * w + l15][32 * kk + 8 * l4];
#pragma unroll
      for (int ni = 0; ni < 8; ++ni) { const bf16x8 bb = *(const bf16x8*)&Bm[16 * ni + l15][32 * kk + 8 * l4]; accG[ni] = __builtin_amdgcn_mfma_f32_16x16x32_bf16(a, bb, accG[ni], 0, 0, 0); } }
    float aft[4], abt[4];
#pragma unroll
    for (int rg = 0; rg < 4; ++rg) { aft[rg] = acf[16 * w + 4 * l4 + rg]; abt[rg] = acb[16 * w + 4 * l4 + rg]; }
#pragma unroll
    for (int ni = 0; ni < 8; ++ni) { const int sidx = 16 * ni + l15; const float afs = acf[sidx], abs_ = acb[sidx], dfs = dtf[sidx], dbs = dtb[sidx];
#pragma unroll
      for (int rg = 0; rg < 4; ++rg) { const int t = 16 * w + 4 * l4 + rg;
        const float f = sidx <= t ? __expf(aft[rg] - afs) * dfs : 0.f, bk = sidx >= t ? __expf(abt[rg] - abs_) * dbs : 0.f;
        Mm[t][sidx] = (bf16_t)f2bf(accG[ni][rg] * (f + bk)); } }
  }
  __syncthreads();
  {
    f32x4 acc[4];
#pragma unroll
    for (int ni = 0; ni < 4; ++ni) acc[ni] = (f32x4){0.f, 0.f, 0.f, 0.f};
#pragma unroll
    for (int kk = 0; kk < 4; ++kk) { const bf16x8 a = *(const bf16x8*)&Mm[16 * w + l15][32 * kk + 8 * l4];
#pragma unroll
      for (int ni = 0; ni < 4; ++ni) { const bf16x8 bb = *(const bf16x8*)&Xt[16 * ni + l15][32 * kk + 8 * l4]; acc[ni] = __builtin_amdgcn_mfma_f32_16x16x32_bf16(a, bb, acc[ni], 0, 0, 0); } }
#pragma unroll
    for (int rg = 0; rg < 4; ++rg)
#pragma unroll
      for (int ni = 0; ni < 4; ++ni) YIN[(r0 + 16 * w + 4 * l4 + rg) * 384 + h * 64 + 16 * ni + l15] = acc[ni][rg];
  }
  {
    const int dir = w >> 2, mt = w & 3; const float* ww = dir == 0 ? wf : wb;
    f32x4 acc[4];
#pragma unroll
    for (int ni = 0; ni < 4; ++ni) acc[ni] = (f32x4){0.f, 0.f, 0.f, 0.f};
#pragma unroll
    for (int kk = 0; kk < 4; ++kk) { const bf16x8 raw = *(const bf16x8*)&Xt[16 * mt + l15][32 * kk + 8 * l4];
      const f32x4 w0 = *(const f32x4*)(ww + 32 * kk + 8 * l4), w1 = *(const f32x4*)(ww + 32 * kk + 8 * l4 + 4);
      u32x4 pk; pk.x = pk2bf(bf2f((bf16_t)raw[0]) * w0.x, bf2f((bf16_t)raw[1]) * w0.y); pk.y = pk2bf(bf2f((bf16_t)raw[2]) * w0.z, bf2f((bf16_t)raw[3]) * w0.w);
      pk.z = pk2bf(bf2f((bf16_t)raw[4]) * w1.x, bf2f((bf16_t)raw[5]) * w1.y); pk.w = pk2bf(bf2f((bf16_t)raw[6]) * w1.z, bf2f((bf16_t)raw[7]) * w1.w);
      const bf16x8 a = __builtin_bit_cast(bf16x8, pk);
#pragma unroll
      for (int ni = 0; ni < 4; ++ni) { const bf16x8 bb = *(const bf16x8*)&BT[16 * ni + l15][32 * kk + 8 * l4]; acc[ni] = __builtin_amdgcn_mfma_f32_16x16x32_bf16(a, bb, acc[ni], 0, 0, 0); } }
    float* sp = ST + ((((size_t)b * 34 + cidx) * 2 + dir) * 6 + h) * 4096;
#pragma unroll
    for (int rg = 0; rg < 4; ++rg)
#pragma unroll
      for (int ni = 0; ni < 4; ++ni) sp[(16 * mt + 4 * l4 + rg) * 64 + 16 * ni + l15] = acc[ni][rg];
  }
  __syncthreads();
}

__device__ __forceinline__ void st_ssd_scan2(float* ST, const float* DEC) {
  for (int idx = BIDX * NT + TIDX; idx < 4 * 2 * 6 * 4096; idx += GDIM * NT) {
    const int e = idx & 4095, bdh = idx >> 12, h = bdh % 6, dir = (bdh / 6) & 1, b = bdh / 12;
    float v[34], d[34];
#pragma unroll
    for (int st = 0; st < 34; ++st) { const int cidx = dir == 0 ? st : (st < 2 ? 1 - st : 35 - st); const size_t o = (((size_t)b * 34 + cidx) * 2 + dir) * 6 + h; v[st] = ST[o * 4096 + e]; d[st] = DEC[o]; }
    float H = 0.f;
#pragma unroll
    for (int st = 0; st < 34; ++st) { const int cidx = dir == 0 ? st : (st < 2 ? 1 - st : 35 - st); const size_t o = (((size_t)b * 34 + cidx) * 2 + dir) * 6 + h; ST[o * 4096 + e] = H; H = H * d[st] + v[st]; }
  }
}

__device__ __forceinline__ void ssd3_item(int b, int cidx, int g, const bf16_t* XBC, const bf16_t* VZ, const float* DT, const float* cw, const float* cb, const float* dt_bias, const float* a_log,
                                          const float* dskip, const float* nw, const float* YIN, const float* ST, bf16_t* MIX, char* lds) {
  bf16_t (*Cm)[72] = (bf16_t (*)[72])lds; bf16_t (*Hm)[72] = (bf16_t (*)[72])(lds + 18432);
  float* ef = (float*)(lds + 18432 + 55296);
  const int tid = TIDX, lane = tid & 63, w = tid >> 6, l15 = lane & 15, l4 = lane >> 4, j0 = ssd_chunk_j0(cidx);
  const size_t r0 = (size_t)b * TPB + j0;
#pragma unroll
  for (int i = 0; i < 2; ++i) { const int task = tid + NT * i, t = task >> 3, q = task & 7, j = j0 + t;
    float o[8]; ssd_conv8(XBC, r0 + t, 512 + g * 64 + 8 * q, j != 0 && j != CTXL, j != CTXL - 1 && j != TPB - 1, cw, cb, o);
    *(u32x4*)&Cm[t][8 * q] = (u32x4){pk2bf(o[0], o[1]), pk2bf(o[2], o[3]), pk2bf(o[4], o[5]), pk2bf(o[6], o[7])}; }
#pragma unroll 4
  for (int i = 0; i < 12; ++i) { const int f4 = tid + NT * i, hd = f4 >> 10, rem = f4 & 1023, p = rem >> 4, n4 = (rem & 15) * 4, hh = hd >> 1, dir = hd & 1;
    const f32x4 v = *(const f32x4*)(ST + ((((size_t)b * 34 + cidx) * 2 + dir) * 6 + 3 * g + hh) * 4096 + p * 64 + n4);
    *(u32x2*)&Hm[hd * 64 + p][n4] = (u32x2){pk2bf(v.x, v.y), pk2bf(v.z, v.w)}; }
  if (w < 6) { const int hh = w >> 1, dir = w & 1, h = 3 * g + hh; const float a = -expf(a_log[dir * 6 + h]), bias = dt_bias[dir * 6 + h];
    const int t0 = dir == 0 ? 2 * lane : 127 - 2 * lane, t1 = dir == 0 ? 2 * lane + 1 : 126 - 2 * lane;
    const float d0 = softplusf(DT[(r0 + t0) * 12 + dir * 6 + h] + bias), d1 = softplusf(DT[(r0 + t1) * 12 + dir * 6 + h] + bias);
    float c0, c1; wave_scan128(d0 * a, d1 * a, lane, c0, c1);
    ef[w * 128 + t0] = __expf(c0); ef[w * 128 + t1] = __expf(c1); }
  __syncthreads();
  bf16x8 ca[2];
#pragma unroll
  for (int kk = 0; kk < 2; ++kk) ca[kk] = *(const bf16x8*)&Cm[16 * w + l15][32 * kk + 8 * l4];
  float ss[4] = {0.f, 0.f, 0.f, 0.f}, rstd[4] = {0.f, 0.f, 0.f, 0.f};
#pragma unroll 1
  for (int pass = 0; pass < 2; ++pass) {
#pragma unroll 1
    for (int hh = 0; hh < 3; ++hh) { const int h = 3 * g + hh; const float dsk = dskip[h];
      f32x4 accF[4], accB[4];
#pragma unroll
      for (int ni = 0; ni < 4; ++ni) { accF[ni] = (f32x4){0.f, 0.f, 0.f, 0.f}; accB[ni] = (f32x4){0.f, 0.f, 0.f, 0.f}; }
      const bf16_t (*HF)[72] = Hm + (hh * 2 + 0) * 64; const bf16_t (*HB)[72] = Hm + (hh * 2 + 1) * 64;
#pragma unroll
      for (int kk = 0; kk < 2; ++kk)
#pragma unroll
        for (int ni = 0; ni < 4; ++ni) {
          accF[ni] = __builtin_amdgcn_mfma_f32_16x16x32_bf16(ca[kk], *(const bf16x8*)&HF[16 * ni + l15][32 * kk + 8 * l4], accF[ni], 0, 0, 0);
          accB[ni] = __builtin_amdgcn_mfma_f32_16x16x32_bf16(ca[kk], *(const bf16x8*)&HB[16 * ni + l15][32 * kk + 8 * l4], accB[ni], 0, 0, 0); }
      const float* efF = ef + (hh * 2 + 0) * 128; const float* efB = ef + (hh * 2 + 1) * 128;
#pragma unroll
      for (int rg = 0; rg < 4; ++rg) { const int t = 16 * w + 4 * l4 + rg, j = j0 + t; const size_t r = r0 + t;
        const float eF = efF[t], eB = efB[t]; const bool hasp = j != 0 && j != CTXL, hasn = j != CTXL - 1 && j != TPB - 1;
        const bf16_t* xp = XBC + r * 768 + h * 64 + l15; const float* yp = YIN + r * 384 + h * 64 + l15; const bf16_t* zp = VZ + r * 512 + 128 + h * 64 + l15;
        bf16_t* op = MIX + r * DM + 384 + h * 64 + l15;
#pragma unroll
        for (int ni = 0; ni < 4; ++ni) { const int col = h * 64 + 16 * ni + l15;
          float xv = cw[640 + col] * bf2f(xp[16 * ni]) + cb[col];
          if (hasp) xv += cw[col] * bf2f(xp[16 * ni - 768]);
          if (hasn) xv += cw[1280 + col] * bf2f(xp[16 * ni + 768]);
          xv = siluf(xv);
          const float y = yp[16 * ni] + eF * accF[ni][rg] + eB * accB[ni][rg] + dsk * xv;
          const float gt = y * siluf(bf2f(zp[16 * ni]));
          if (pass == 0) ss[rg] += gt * gt; else op[16 * ni] = (bf16_t)f2bf(gt * rstd[rg] * nw[col]); } }
    }
    if (pass == 0) {
#pragma unroll
      for (int rg = 0; rg < 4; ++rg) { float sv = ss[rg]; sv += __shfl_xor(sv, 1); sv += __shfl_xor(sv, 2); sv += __shfl_xor(sv, 4); sv += __shfl_xor(sv, 8); rstd[rg] = rsqrtf(sv * (1.0f / 192.0f) + EPS); }
    }
  }
  __syncthreads();
}

__device__ __forceinline__ void st_router(const float* xl, const float* xc, const float* g, const float* modv_layer, const float* w_router, const float* rbias,
                                          bf16_t* H2, int* ctl, int* tok_pair, float* tok_w, int skip_ctx) {
  const int lane = TIDX & 63, gw = BIDX * 8 + (TIDX >> 6), ngw = GDIM * 8;
  for (int r = gw; r < MTOK; r += ngw) {
    if (skip_ctx && (r % TPB) < CTXL) continue;
    const float* xr = xrow(xl, xc, r); const float* mv = modv_layer + (size_t)mrow_of(r) * 6144;
    f32x4 v[4]; float ss = 0.f;
#pragma unroll
    for (int j = 0; j < 4; ++j) { v[j] = *(const f32x4*)(xr + 4 * lane + 256 * j); ss += v[j].x * v[j].x + v[j].y * v[j].y + v[j].z * v[j].z + v[j].w * v[j].w; }
    const float rstd = rsqrtf(wave_sum(ss) * (1.0f / DM) + EPS);
    float lg[16];
#pragma unroll
    for (int e = 0; e < 16; ++e) lg[e] = 0.f;
#pragma unroll
    for (int j = 0; j < 4; ++j) { const int k = 4 * lane + 256 * j;
      const f32x4 gg = *(const f32x4*)(g + k), sh = *(const f32x4*)(mv + 3072 + k), sc = *(const f32x4*)(mv + 4096 + k);
      float o[4]; o[0] = v[j].x * rstd * gg.x * (1.f + sc.x) + sh.x; o[1] = v[j].y * rstd * gg.y * (1.f + sc.y) + sh.y;
      o[2] = v[j].z * rstd * gg.z * (1.f + sc.z) + sh.z; o[3] = v[j].w * rstd * gg.w * (1.f + sc.w) + sh.w;
      u32x2 w; w.x = f2bf(o[0]) | (f2bf(o[1]) << 16); w.y = f2bf(o[2]) | (f2bf(o[3]) << 16);
      *(u32x2*)(H2 + (size_t)r * DM + k) = w;
#pragma unroll
      for (int q = 0; q < 4; ++q) {
#pragma unroll
        for (int e4 = 0; e4 < 4; ++e4) { const f32x4 wr = *(const f32x4*)(w_router + (size_t)(k + q) * 16 + 4 * e4);
          lg[4 * e4] += o[q] * wr.x; lg[4 * e4 + 1] += o[q] * wr.y; lg[4 * e4 + 2] += o[q] * wr.z; lg[4 * e4 + 3] += o[q] * wr.w; } } }
#pragma unroll
    for (int e = 0; e < 16; ++e) lg[e] = wave_sum(lg[e]);
    if (lane == 0) {
      int best = 0, bi1 = 0, bi2 = 1; float bestv = -1e30f, bs1 = 0.f, bs2 = 0.f;
#pragma unroll
      for (int gq = 0; gq < 4; ++gq) { float m1 = -1e30f, m2 = -1e30f, s1 = 0.f, s2 = 0.f; int i1 = 0, i2 = 0;
#pragma unroll
        for (int i = 0; i < 4; ++i) { const float scv = 1.0f / (1.0f + expf(-lg[4 * gq + i])); const float s = scv + rbias[4 * gq + i];
          if (s > m1) { m2 = m1; s2 = s1; i2 = i1; m1 = s; s1 = scv; i1 = i; } else if (s > m2) { m2 = s; s2 = scv; i2 = i; } }
        if (m1 + m2 > bestv) { bestv = m1 + m2; best = gq; bi1 = i1; bi2 = i2; bs1 = s1; bs2 = s2; } }
      const int ia = bi1 < bi2 ? bi1 : bi2, ib = bi1 < bi2 ? bi2 : bi1;
      const int tri = ia == 0 ? ib - 1 : (ia == 1 ? ib + 1 : 5);
      const int pidx = best * 6 + tri;
      const float sa = bi1 < bi2 ? bs1 : bs2, sb = bi1 < bi2 ? bs2 : bs1, inv = 1.0f / (sa + sb);
      tok_pair[r] = pidx; tok_w[2 * r] = sa * inv; tok_w[2 * r + 1] = sb * inv;
      atomicAdd(&ctl[CT_CNT + pidx], 1);
    }
  }
}
__device__ __forceinline__ void st_moe_plan(int* ctl, int* sorted_tok) {
  if (BIDX == 0 && TIDX == 0) { int base = 0, nt = 0;
    for (int p = 0; p < 24; ++p) { ctl[CT_BASE + p] = base; const int n = ctl[CT_CNT + p], tl = (n + 255) >> 8; for (int t = 0; t < tl; ++t) ctl[CT_TP + nt + t] = p; nt += tl; base += tl * 256; ctl[CT_FILL + p] = 0; }
    ctl[CT_BASE + 24] = base; ctl[CT_NT] = nt; }
  for (int i = BIDX * NT + TIDX; i < MOE_ROWS; i += GDIM * NT) sorted_tok[i] = -1;
}
__device__ __forceinline__ void st_moe_gather(const bf16_t* H2, bf16_t* H2S, int* ctl, const int* tok_pair, const float* tok_w, int* sorted_tok, float* sorted_w, int skip_ctx) {
  const int lane = TIDX & 63, gw = BIDX * 8 + (TIDX >> 6), ngw = GDIM * 8;
  for (int r = gw; r < MTOK; r += ngw) {
    if (skip_ctx && (r % TPB) < CTXL) continue;
    const int p = tok_pair[r]; int slot = 0;
    if (lane == 0) { slot = ctl[CT_BASE + p] + atomicAdd(&ctl[CT_FILL + p], 1); sorted_tok[slot] = r; sorted_w[2 * slot] = tok_w[2 * r]; sorted_w[2 * slot + 1] = tok_w[2 * r + 1]; }
    slot = __shfl(slot, 0);
    const u32x4* s = (const u32x4*)(H2 + (size_t)r * DM); u32x4* d = (u32x4*)(H2S + (size_t)slot * DM);
    d[lane] = s[lane]; d[lane + 64] = s[lane + 64];
  }
}
__device__ __forceinline__ void st_final(float* xl, const float* g) {
  const int lane = TIDX & 63, gw = BIDX * 8 + (TIDX >> 6), ngw = GDIM * 8;
  for (int r = gw; r < NB * SEQ; r += ngw) {
    float* xr = xl + (size_t)r * DM; f32x4 v[4]; float ss = 0.f;
#pragma unroll
    for (int j = 0; j < 4; ++j) { v[j] = *(const f32x4*)(xr + 4 * lane + 256 * j); ss += v[j].x * v[j].x + v[j].y * v[j].y + v[j].z * v[j].z + v[j].w * v[j].w; }
    const float rstd = rsqrtf(wave_sum(ss) * (1.0f / DM) + EPS);
#pragma unroll
    for (int j = 0; j < 4; ++j) { const int k = 4 * lane + 256 * j; const f32x4 gg = *(const f32x4*)(g + k);
      *(f32x4*)(xr + k) = (f32x4){v[j].x * rstd * gg.x, v[j].y * rstd * gg.y, v[j].z * rstd * gg.z, v[j].w * rstd * gg.w}; }
  }
}

namespace pg8 {
#define PG8_LAS __attribute__((address_space(3)))
typedef unsigned short bf16_t;
typedef short bf16x8 __attribute__((ext_vector_type(8)));
typedef float f32x4 __attribute__((ext_vector_type(4)));
typedef unsigned u32x4 __attribute__((ext_vector_type(4)));
constexpr int BM = 256, BK = 64, HALF = 128, HTB = HALF * BK * 2  , STAGE_BYTES = 8 * HTB, NXCD = 8, WGM = 8;

__host__ __device__ __forceinline__ int lds_byte(int r, int c) { const int st = (r >> 4) * 2 + (c >> 5), rr = r & 15, cc = c & 31, ob = rr * 64 + cc * 2; return st * 1024 + (ob ^ (((ob >> 9) & 1) << 5)); }
__host__ __device__ __forceinline__ void stage_rc(int b, int& R, int& C) { const int st = b / 1024, sb = b % 1024, swz = sb ^ (((sb >> 9) & 1) << 5); R = (st >> 1) * 16 + swz / 64; C = (st & 1) * 32 + (swz % 64) / 2; }
__host__ __device__ __forceinline__ int perm32(int rho) { const int n = rho >> 4, i = rho & 15; return 8 * (i >> 2) + 4 * n + (i & 3); }

struct Unit { int pm, pn, fin; const char* A; const char* B; };
struct Gemm { int K, lda, ldb; };

__device__ __forceinline__ void tile_of(int L, int nM, int nN, int& pm, int& pn) {
    const int nwg = nM * nN; int wgid = L; { const int q = nwg / NXCD, r = nwg % NXCD, xcd = wgid % NXCD, off = wgid / NXCD; wgid = (xcd < r ? xcd * (q + 1) : r * (q + 1) + (xcd - r) * q) + off; }
    const int nig = WGM * nN, gid = wgid / nig, fm = gid * WGM, gsz = (nM - fm) < WGM ? (nM - fm) : WGM;
    pm = fm + ((wgid % nig) % gsz); pn = (wgid % nig) / gsz;
}
__device__ __forceinline__ unsigned cvt_pk_bf16(float lo, float hi) { unsigned r; asm volatile("v_cvt_pk_bf16_f32 %0, %1, %2" : "=v"(r) : "v"(lo), "v"(hi)); return r; }
template <class Epi, class Sched, bool ALIGN_EPI = false, bool SP2 = false>
__device__ __forceinline__ void gemm_phase(PG8_LAS unsigned char* lds, const Gemm g, const Sched& S, const Epi& E) {
    const int tid = opq_v((int)threadIdx.x), wid = __builtin_amdgcn_readfirstlane(tid >> 6), lane = tid & 63, wr = wid >> 2, wc = wid & 3, fr = lane & 15, fq = lane >> 4;
    const int K = g.K, nt = K / BK;
    unsigned voffA[2], voffB[2];
#pragma unroll
    for (int i = 0; i < 2; ++i) { int R, C; stage_rc(tid * 16 + i * 8192, R, C); const int Rb = Epi::PERM ? ((R & ~31) + perm32(R & 31)) : R;
        voffA[i] = (unsigned)(R * g.lda + C) * 2u; voffB[i] = (unsigned)(Rb * g.ldb + C) * 2u; }
    const size_t kstep = (size_t)(BK * 2);
    const size_t hstepA = (size_t)HALF * g.lda * 2, hstepB = (size_t)HALF * g.ldb * 2;
    const unsigned ldsw = (unsigned)wid * 1024u;
    const int aoff = lds_byte(wr * 64 + fr, fq * 8), boff = lds_byte(wc * 32 + fr, fq * 8);
#define PG8_SA(b, h) (((b) * 2 + (h)) * HTB)
#define PG8_SB(b, h) ((4 + (b) * 2 + (h)) * HTB)
#define PG8_STAGE(bufoff, gbase, voff) do { _Pragma("unroll") for (int _i = 0; _i < 2; ++_i) \
        __builtin_amdgcn_global_load_lds((const unsigned*)((const char*)(gbase) + (voff)[_i]), (PG8_LAS unsigned*)(lds + (bufoff) + ldsw + _i * 8192), 16, 0, 0); } while (0)
#define PG8_LDA(dst, b, h) do { _Pragma("unroll") for (int m = 0; m < 4; ++m) _Pragma("unroll") for (int k = 0; k < 2; ++k) dst[m][k] = *(const PG8_LAS bf16x8*)(lds + PG8_SA(b, h) + aoff + m * 2048 + k * 1024); } while (0)
#define PG8_LDB(dst, b, h) do { _Pragma("unroll") for (int n = 0; n < 2; ++n) _Pragma("unroll") for (int k = 0; k < 2; ++k) dst[n][k] = *(const PG8_LAS bf16x8*)(lds + PG8_SB(b, h) + boff + n * 2048 + k * 1024); } while (0)
#define PG8_MMA(ai, bj, At, Bt) do { __builtin_amdgcn_s_setprio(1); _Pragma("unroll") for (int m = 0; m < 4; ++m) _Pragma("unroll") for (int n = 0; n < 2; ++n) _Pragma("unroll") for (int k = 0; k < 2; ++k) \
        acc[ai][bj][m][n] = __builtin_amdgcn_mfma_f32_16x16x32_bf16(Bt[n][k], At[m][k], acc[ai][bj][m][n], 0, 0, 0); __builtin_amdgcn_s_setprio(0); } while (0)
#define PG8_WAIT_V(n) asm volatile("s_waitcnt vmcnt(" #n ")" ::: "memory")
#define PG8_WAIT_L(n) asm volatile("s_waitcnt lgkmcnt(" #n ")" ::: "memory")
#define PG8_BAR __builtin_amdgcn_s_barrier()
#define PG8_SCHED __builtin_amdgcn_sched_barrier(0)
    Unit cur, nxt; int ui = 0;
    if (!S.next(0, cur)) return;
    f32x4 acc[2][2][4][2];
#pragma unroll
    for (int a = 0; a < 2; ++a)
#pragma unroll
        for (int b = 0; b < 2; ++b)
#pragma unroll
            for (int m = 0; m < 4; ++m)
#pragma unroll
                for (int n = 0; n < 2; ++n) acc[a][b][m][n] = (f32x4){0.f, 0.f, 0.f, 0.f};
    bf16x8 At[4][2], B0[2][2], B1[2][2];
    const char* cA = cur.A; const char* cB = cur.B;
    S.a_ready(cur);
    if constexpr (SP2) {
        PG8_STAGE(PG8_SB(0, 0), cB, voffB); PG8_STAGE(PG8_SB(0, 1), cB + hstepB, voffB); PG8_STAGE(PG8_SA(0, 0), cA, voffA); PG8_STAGE(PG8_SA(0, 1), cA + hstepA, voffA);
        if (wr == 1) PG8_BAR;
        PG8_WAIT_V(2); PG8_BAR;
        PG8_STAGE(PG8_SB(1, 0), cB + kstep, voffB); PG8_STAGE(PG8_SA(1, 0), cA + kstep, voffA); PG8_STAGE(PG8_SB(1, 1), cB + hstepB + kstep, voffB);
        PG8_WAIT_V(6); PG8_BAR;
    } else {
        PG8_STAGE(PG8_SB(0, 0), cB, voffB); PG8_STAGE(PG8_SA(0, 0), cA, voffA); PG8_STAGE(PG8_SB(0, 1), cB + hstepB, voffB); PG8_STAGE(PG8_SA(0, 1), cA + hstepA, voffA);
        if (wr == 1) PG8_BAR;
        PG8_WAIT_V(4); PG8_BAR;
        PG8_STAGE(PG8_SB(1, 0), cB + kstep, voffB); PG8_STAGE(PG8_SA(1, 0), cA + kstep, voffA); PG8_STAGE(PG8_SB(1, 1), cB + hstepB + kstep, voffB);
        PG8_WAIT_V(6); PG8_BAR;
    }
    for (;;) {
        const bool has_next = S.next(ui + 1, nxt);
        const char* nA = has_next ? nxt.A : cA; const char* nB = has_next ? nxt.B : cB;
        for (int t = 0; t < nt; t += 2) {
            const bool last = (t == nt - 2);
            const char* a1 = cA + (size_t)(t + 1) * kstep;
            const char* a2 = last ? nA : cA + (size_t)(t + 2) * kstep; const char* b2 = last ? nB : cB + (size_t)(t + 2) * kstep;
            const char* a3 = a2 + kstep; const char* b3 = b2 + kstep;
            if (last && has_next) S.a_ready(nxt);
            if constexpr (SP2) {
            PG8_LDB(B0, 0, 0); PG8_LDB(B1, 0, 1); PG8_SCHED; PG8_LDA(At, 0, 0); PG8_STAGE(PG8_SA(1, 1), a1 + hstepA, voffA);
            PG8_WAIT_V(8); PG8_WAIT_L(0); PG8_BAR; PG8_MMA(0, 0, At, B0); PG8_MMA(0, 1, At, B1); PG8_BAR; PG8_SCHED;
            PG8_LDA(At, 0, 1); PG8_STAGE(PG8_SB(0, 0), b2, voffB); PG8_STAGE(PG8_SB(0, 1), b2 + hstepB, voffB); PG8_STAGE(PG8_SA(0, 0), a2, voffA);
            PG8_WAIT_V(8); PG8_WAIT_L(0); PG8_BAR; PG8_MMA(1, 0, At, B0); PG8_MMA(1, 1, At, B1); PG8_BAR; PG8_SCHED;
            PG8_LDB(B0, 1, 0); PG8_LDB(B1, 1, 1); PG8_SCHED; PG8_LDA(At, 1, 0); PG8_STAGE(PG8_SA(0, 1), a2 + hstepA, voffA);
            PG8_WAIT_V(8); PG8_WAIT_L(0); PG8_BAR; PG8_MMA(0, 0, At, B0); PG8_MMA(0, 1, At, B1); PG8_BAR; PG8_SCHED;
            PG8_LDA(At, 1, 1); PG8_STAGE(PG8_SB(1, 0), b3, voffB); PG8_STAGE(PG8_SB(1, 1), b3 + hstepB, voffB); PG8_STAGE(PG8_SA(1, 0), a3, voffA);
            PG8_WAIT_V(8); PG8_WAIT_L(0); PG8_BAR; PG8_MMA(1, 0, At, B0); PG8_MMA(1, 1, At, B1); PG8_BAR; PG8_SCHED;
            } else {
            PG8_LDB(B0, 0, 0); PG8_SCHED; PG8_LDA(At, 0, 0); PG8_STAGE(PG8_SA(1, 1), a1 + hstepA, voffA);
            PG8_WAIT_L(8); PG8_BAR; PG8_WAIT_L(0); PG8_MMA(0, 0, At, B0); PG8_BAR; PG8_SCHED;
            PG8_LDB(B1, 0, 1); PG8_STAGE(PG8_SB(0, 0), b2, voffB);
            PG8_BAR; PG8_WAIT_L(0); PG8_MMA(0, 1, At, B1); PG8_BAR;
            PG8_LDA(At, 0, 1); PG8_STAGE(PG8_SA(0, 0), a2, voffA);
            PG8_BAR; PG8_WAIT_L(0); PG8_MMA(1, 0, At, B0); PG8_BAR; PG8_SCHED;
            PG8_STAGE(PG8_SB(0, 1), b2 + hstepB, voffB);
            PG8_WAIT_V(6); PG8_BAR; PG8_MMA(1, 1, At, B1); PG8_BAR;
            PG8_LDB(B0, 1, 0); PG8_SCHED; PG8_LDA(At, 1, 0); PG8_STAGE(PG8_SA(0, 1), a2 + hstepA, voffA);
            PG8_WAIT_L(8); PG8_BAR; PG8_WAIT_L(0); PG8_MMA(0, 0, At, B0); PG8_BAR; PG8_SCHED;
            PG8_LDB(B1, 1, 1); PG8_STAGE(PG8_SB(1, 0), b3, voffB);
            PG8_BAR; PG8_WAIT_L(0); PG8_MMA(0, 1, At, B1); PG8_BAR;
            PG8_LDA(At, 1, 1); PG8_STAGE(PG8_SA(1, 0), a3, voffA);
            PG8_BAR; PG8_WAIT_L(0); PG8_MMA(1, 0, At, B0); PG8_BAR; PG8_SCHED;
            PG8_STAGE(PG8_SB(1, 1), b3 + hstepB, voffB);
            PG8_WAIT_V(6); PG8_BAR; PG8_MMA(1, 1, At, B1); PG8_BAR;
            }
        }
        if constexpr (ALIGN_EPI) { if (wr == 0) PG8_BAR; }
        if constexpr (!Epi::AFTER_DRAIN) { if (cur.fin) { E(acc, cur, wr, wc, fr, fq); S.done(cur); } }
        if (!has_next) break;
        if (cur.fin) {
#pragma unroll
        for (int a = 0; a < 2; ++a)
#pragma unroll
            for (int b = 0; b < 2; ++b)
#pragma unroll
                for (int m = 0; m < 4; ++m)
#pragma unroll
                    for (int n = 0; n < 2; ++n) acc[a][b][m][n] = (f32x4){0.f, 0.f, 0.f, 0.f};
        }
        cur = nxt; cA = nA; cB = nB; ++ui;
        if constexpr (ALIGN_EPI) { if (wr == 1) PG8_BAR; }
    }
    PG8_WAIT_V(0);
    if constexpr (!ALIGN_EPI) { if (wr == 0) PG8_BAR; }
    PG8_BAR;
    if constexpr (Epi::AFTER_DRAIN) { E.fused(acc, cur, wr, wc, fr, fq, lds, wid, lane); S.done(cur); }
#undef PG8_SA
#undef PG8_SB
#undef PG8_STAGE
#undef PG8_LDA
#undef PG8_LDB
#undef PG8_MMA
#undef PG8_WAIT_V
#undef PG8_WAIT_L
#undef PG8_BAR
#undef PG8_SCHED
}
}

struct SchedDense {
  int nM, nN, G, c, skip_ctx; const char* A; const char* B; size_t a_tile, b_tile;
  __device__ __forceinline__ bool next(int i, pg8::Unit& u) const {
    const long L = (long)i * G + c; if (L >= (long)nM * nN) return false;
    int pm, pn; pg8::tile_of((int)L, nM, nN, pm, pn); if (skip_ctx) pm = pm + pm / 16 + 1;
    u.pm = pm; u.pn = pn; u.fin = 1; u.A = A + (size_t)pm * a_tile; u.B = B + (size_t)pn * b_tile; return true; }
  __device__ __forceinline__ void a_ready(const pg8::Unit&) const {}
  __device__ __forceinline__ void done(const pg8::Unit&) const {}
};
struct SchedMoe {
  int G, c, mode; const int* ctl; const char* A; size_t a_tile; const char* W;
  __device__ __forceinline__ bool next(int i, pg8::Unit& u) const {
    const int part = mode == 2 ? (i & 1) : 0, iu = mode == 2 ? (i >> 1) : i;
    const long L = (long)iu * G + c; const int ntiles = ctl[CT_NT]; if (L >= (long)ntiles * 4) return false;
    const int pm = (int)(L >> 2), pn = (int)(L & 3); int eA, eB; pair_experts(ctl[CT_TP + pm], eA, eB);
    u.pm = pm; u.pn = pn;
    if (mode == 1) { const int e = pn < 2 ? eA : eB; u.fin = 1; u.A = A + (size_t)pm * a_tile; u.B = W + (size_t)e * (512 * 1024 * 2) + (size_t)(pn & 1) * (256 * 1024 * 2); }
    else { u.fin = part; u.A = A + (size_t)pm * a_tile + part * 512; u.B = W + (size_t)(part ? eB : eA) * (1024 * 256 * 2) + (size_t)pn * (256 * 256 * 2); }
    return true; }
  __device__ __forceinline__ void a_ready(const pg8::Unit&) const {}
  __device__ __forceinline__ void done(const pg8::Unit&) const {}
};
__device__ __forceinline__ unsigned cvt_pk(float lo, float hi) { return pg8::cvt_pk_bf16(lo, hi); }
struct EpiInProj {
  static constexpr bool PERM = true, AFTER_DRAIN = false; bf16_t *QK, *VZ, *XBC, *HY; float* DT;
  __device__ __forceinline__ void operator()(const f32x4 (&acc)[2][2][4][2], const pg8::Unit& u, int wr, int wc, int fr, int fq) const {
    const int pn = u.pn; bf16_t* base; int ldc, coff;
    if (pn < 2) { base = QK; ldc = 512; coff = pn * 256; } else if (pn < 4) { base = VZ; ldc = 512; coff = (pn - 2) * 256; }
    else if (pn < 7) { base = XBC; ldc = 768; coff = (pn - 4) * 256; } else { base = HY; ldc = 768; coff = (pn - 7) * 256; }
    const int row0 = u.pm * 256 + wr * 64 + fr, col0 = coff + wc * 32 + 8 * fq; const bool dtl = (pn == 6 && wc == 0 && fq < 2);
#pragma unroll
    for (int ai = 0; ai < 2; ++ai)
#pragma unroll
      for (int m = 0; m < 4; ++m) { const int row = row0 + ai * 128 + m * 16; bf16_t* rowp = base + (size_t)row * ldc + col0;
#pragma unroll
        for (int bj = 0; bj < 2; ++bj) { const f32x4 v0 = acc[ai][bj][m][0], v1 = acc[ai][bj][m][1];
          u32x4 w; w.x = cvt_pk(v0[0], v0[1]); w.y = cvt_pk(v0[2], v0[3]); w.z = cvt_pk(v1[0], v1[1]); w.w = cvt_pk(v1[2], v1[3]);
          *(u32x4*)(rowp + bj * 128) = w;
          if (bj == 1 && dtl) { float* dp = DT + (size_t)row * 12 + 8 * fq; *(f32x4*)dp = v0; if (fq == 0) *(f32x4*)(dp + 4) = v1; } } }
  }
};
struct EpiOutProj {
  static constexpr bool PERM = false, AFTER_DRAIN = false; const float *xl_src, *xc_src; float *xl_dst, *xc_dst; const float* gate;
  __device__ __forceinline__ void operator()(const f32x4 (&acc)[2][2][4][2], const pg8::Unit& u, int wr, int wc, int fr, int fq) const {
    const int b = u.pm / 17, jt = u.pm - 17 * b; const size_t rbase = jt == 0 ? (size_t)b * CTXL : (size_t)b * SEQ + (jt - 1) * 256;
    const float* xs = (jt == 0 ? xc_src : xl_src) + rbase * DM; float* xd = (jt == 0 ? xc_dst : xl_dst) + rbase * DM; const float* gt = gate + (size_t)(jt == 0 ? 4 : b) * 6144;
    const int col0 = u.pn * 256 + wc * 32 + 4 * fq;
#pragma unroll
    for (int ai = 0; ai < 2; ++ai)
#pragma unroll
      for (int m = 0; m < 4; ++m) { const size_t off = (size_t)(ai * 128 + wr * 64 + m * 16 + fr) * DM + col0;
#pragma unroll
        for (int bj = 0; bj < 2; ++bj)
#pragma unroll
          for (int n = 0; n < 2; ++n) { const int co = bj * 128 + n * 16; const f32x4 g4 = *(const f32x4*)(gt + col0 + co), x4 = *(const f32x4*)(xs + off + co);
            *(f32x4*)(xd + off + co) = x4 + g4 * acc[ai][bj][m][n]; } }
  }
};
struct EpiMoe1 {
  static constexpr bool PERM = true, AFTER_DRAIN = false; bf16_t* ACT; const float* sorted_w;
  __device__ __forceinline__ void operator()(const f32x4 (&acc)[2][2][4][2], const pg8::Unit& u, int wr, int wc, int fr, int fq) const {
    const int half = u.pn >> 1, j0 = (u.pn & 1) * 128 + 16 * wc + 4 * fq;
#pragma unroll
    for (int ai = 0; ai < 2; ++ai)
#pragma unroll
      for (int m = 0; m < 4; ++m) { const int slot = u.pm * 256 + ai * 128 + wr * 64 + m * 16 + fr; const float wt = sorted_w[2 * slot + half];
#pragma unroll
        for (int bj = 0; bj < 2; ++bj) { const f32x4 v0 = acc[ai][bj][m][0], v1 = acc[ai][bj][m][1];
          u32x2 w; w.x = cvt_pk(siluf(v0[0]) * v0[1] * wt, siluf(v0[2]) * v0[3] * wt); w.y = cvt_pk(siluf(v1[0]) * v1[1] * wt, siluf(v1[2]) * v1[3] * wt);
          *(u32x2*)(ACT + (size_t)slot * 512 + half * 256 + j0 + 64 * bj) = w; } }
  }
};
struct EpiMoe2 {
  static constexpr bool PERM = false, AFTER_DRAIN = false; float *xl, *xc; const float* gate; const int* sorted_tok;
  __device__ __forceinline__ void operator()(const f32x4 (&acc)[2][2][4][2], const pg8::Unit& u, int wr, int wc, int fr, int fq) const {
    const int col0 = u.pn * 256 + wc * 32 + 4 * fq;
#pragma unroll
    for (int ai = 0; ai < 2; ++ai)
#pragma unroll
      for (int m = 0; m < 4; ++m) { const int slot = u.pm * 256 + ai * 128 + wr * 64 + m * 16 + fr; const int r = sorted_tok[slot];
        if (r >= 0) { float* xd = xrow(xl, xc, r) + col0; const float* gt = gate + (size_t)mrow_of(r) * 6144 + col0;
#pragma unroll
          for (int bj = 0; bj < 2; ++bj)
#pragma unroll
            for (int n = 0; n < 2; ++n) { const int co = bj * 128 + n * 16; *(f32x4*)(xd + co) = *(const f32x4*)(xd + co) + *(const f32x4*)(gt + co) * acc[ai][bj][m][n]; } }
        asm volatile("" ::: "memory"); }
  }
};

#include <hip/hip_bf16.h>
#include <cmath>
namespace attn_body {
using bf16=__hip_bfloat16;
using bf16x8=__attribute__((ext_vector_type(8)))short;
using s16x4=__attribute__((ext_vector_type(4)))short;
using f32x16=__attribute__((ext_vector_type(16)))float;
using u32x4=__attribute__((ext_vector_type(4)))unsigned;
constexpr int D=64,QP=512,KP=512,VP=512,OP=1024;
constexpr int NW=8,QBLK=32,QB=QBLK*NW,KVBLK=64;
constexpr int ATTN_UNIT_ROWS=QB;
__device__ __forceinline__ int crow(int r,int hi){return (r&3)+8*(r>>2)+4*hi;}
#define SBAR() __builtin_amdgcn_sched_barrier(0)
__device__ __forceinline__ void cmask(f32x16&p0,f32x16&p1,int jb,int qrel,int hi){
  const float NEG=-INFINITY; int kb=64*jb+4*hi;
  #pragma unroll
  for(int r=0;r<16;++r){int kv=kb+(r&3)+8*(r>>2); if(kv>qrel)p0[r]=NEG; if(kv+32>qrel)p1[r]=NEG;}
}

constexpr int NSLOT=3, SLOTB=8192;
constexpr int LDS_K=0, LDS_V=NSLOT*SLOTB, LDS_WS=2*NSLOT*SLOTB, LDS_OST=LDS_WS+NW*64*4, LDS_BYTES=LDS_OST+NW*4096;
constexpr float C2=0.125f*1.4426950408889634f;
__device__ __forceinline__ void glds16(const void*gsrc,unsigned lds_dst){unsigned keep;
  asm volatile("s_mov_b32 %0, m0\n\ts_mov_b32 m0, %2\n\ts_nop 0\n\tglobal_load_lds_dwordx4 %1, off\n\ts_mov_b32 m0, %0":"=&s"(keep):"v"(gsrc),"s"(lds_dst):"memory");}
__device__ __forceinline__ float max3f(float a,float b,float c){float r;asm("v_max3_f32 %0, %1, %2, %3":"=v"(r):"v"(a),"v"(b),"v"(c));return r;}
__device__ __forceinline__ float max2f(float a,float b){float r;asm("v_max_f32_e32 %0, %1, %2":"=v"(r):"v"(a),"v"(b));return r;}
__device__ __forceinline__ float fadd_s(float a,float b){float r;asm("v_add_f32_e32 %0, %1, %2":"=v"(r):"v"(a),"v"(b));return r;}
__device__ __forceinline__ float fsub_s(float a,float b){float r;asm("v_sub_f32_e32 %0, %1, %2":"=v"(r):"v"(a),"v"(b));return r;}
typedef float f32x2_t __attribute__((ext_vector_type(2))); typedef __bf16 bf16x2_t __attribute__((ext_vector_type(2)));
__device__ __forceinline__ unsigned cvtpk_s(float lo,float hi){f32x2_t v={lo,hi};bf16x2_t b=__builtin_convertvector(v,bf16x2_t);return __builtin_bit_cast(unsigned,b);}
#define WAIT_BAR(N) asm volatile("s_waitcnt vmcnt(" #N ") lgkmcnt(0)\n\ts_barrier":::"memory")

__device__ __forceinline__ void qkt(f32x16&p0,f32x16&p1,const char*Kslot,const bf16x8*qr,const f32x16&negm,int r32,int hi){
  const char*kb=Kslot+hi*1024+r32*16;
  #pragma unroll
  for(int d0=0;d0<4;++d0){
    const bf16x8 b0=*reinterpret_cast<const bf16x8*>(kb+d0*2048);
    const bf16x8 b1=*reinterpret_cast<const bf16x8*>(kb+d0*2048+512);
    if(d0==0){p0=__builtin_amdgcn_mfma_f32_32x32x16_bf16(b0,qr[0],negm,0,0,0);p1=__builtin_amdgcn_mfma_f32_32x32x16_bf16(b1,qr[0],negm,0,0,0);}
    else{p0=__builtin_amdgcn_mfma_f32_32x32x16_bf16(b0,qr[d0],p0,0,0,0);p1=__builtin_amdgcn_mfma_f32_32x32x16_bf16(b1,qr[d0],p1,0,0,0);}}
}
typedef __attribute__((address_space(3))) const char* lds_cptr;
typedef short v4i16_t __attribute__((ext_vector_type(4)));
__device__ __forceinline__ void kload8(bf16x8*kf,lds_cptr kp){
  kf[0]=*(const __attribute__((address_space(3))) bf16x8*)(kp);      kf[1]=*(const __attribute__((address_space(3))) bf16x8*)(kp+512);
  kf[2]=*(const __attribute__((address_space(3))) bf16x8*)(kp+2048); kf[3]=*(const __attribute__((address_space(3))) bf16x8*)(kp+2560);
  kf[4]=*(const __attribute__((address_space(3))) bf16x8*)(kp+4096); kf[5]=*(const __attribute__((address_space(3))) bf16x8*)(kp+4608);
  kf[6]=*(const __attribute__((address_space(3))) bf16x8*)(kp+6144); kf[7]=*(const __attribute__((address_space(3))) bf16x8*)(kp+6656);
}
__device__ __forceinline__ void kload2(bf16x8*kf,lds_cptr kp,int j){ kf[2*j]=*(const __attribute__((address_space(3))) bf16x8*)(kp+j*2048); kf[2*j+1]=*(const __attribute__((address_space(3))) bf16x8*)(kp+j*2048+512); }
__device__ __forceinline__ s16x4 vtr(lds_cptr p){ return __builtin_bit_cast(s16x4,__builtin_amdgcn_ds_read_tr16_b64_v4i16((__attribute__((address_space(3))) v4i16_t*)p)); }
__device__ __forceinline__ float rowmax(const f32x16&p0,const f32x16&p1){
  float a=max3f(p0[0],p0[1],p1[0]),b=max3f(p0[2],p0[3],p1[1]);a=max3f(a,p1[2],p1[3]);
  #pragma unroll
  for(int r=4;r<16;r+=4){a=max3f(a,p0[r],p0[r+1]);b=max3f(b,p0[r+2],p0[r+3]);a=max3f(a,p1[r],p1[r+1]);b=max3f(b,p1[r+2],p1[r+3]);}
  const float m=max2f(a,b);
  auto rr=__builtin_amdgcn_permlane32_swap(__float_as_uint(m),__float_as_uint(m),false,false);
  return max2f(__uint_as_float(rr[0]),__uint_as_float(rr[1]));
}
__device__ __forceinline__ void pv(f32x16*o,int vb,bf16x8 pa0,bf16x8 pa1,bf16x8 pa2,bf16x8 pa3){
  #pragma unroll
  for(int d0=0;d0<2;++d0){s16x4 lo[4],hi[4];
    #pragma unroll
    for(int ks=0;ks<4;++ks){
      asm volatile("ds_read_b64_tr_b16 %0,%1 offset:%c2":"=&v"(lo[ks]):"v"(vb),"i"(d0*4096+ks*1024):"memory");
      asm volatile("ds_read_b64_tr_b16 %0,%1 offset:%c2":"=&v"(hi[ks]):"v"(vb),"i"(d0*4096+ks*1024+512):"memory");}
    asm volatile("s_waitcnt lgkmcnt(0)":::"memory");SBAR();
    #define PK(k) (bf16x8){lo[k][0],lo[k][1],lo[k][2],lo[k][3],hi[k][0],hi[k][1],hi[k][2],hi[k][3]}
    o[d0]=__builtin_amdgcn_mfma_f32_32x32x16_bf16(pa0,PK(0),o[d0],0,0,0);
    o[d0]=__builtin_amdgcn_mfma_f32_32x32x16_bf16(pa1,PK(1),o[d0],0,0,0);
    o[d0]=__builtin_amdgcn_mfma_f32_32x32x16_bf16(pa2,PK(2),o[d0],0,0,0);
    o[d0]=__builtin_amdgcn_mfma_f32_32x32x16_bf16(pa3,PK(3),o[d0],0,0,0);
    #undef PK
  }
}

#ifndef ATTN_STORE16
#define ATTN_STORE16(p,v) (*(u32x4*)(p)=(v))
#endif
template<int THRL> __device__ __forceinline__ void attn_unit(const bf16*Qu,const bf16*__restrict__ Kh,const bf16*__restrict__ Vh,bf16*Ou,const int NT,char*shm){
  const int tid=opq_v((int)threadIdx.x),lane=tid&63,r32=lane&31,hi=lane>>5; const int wid=__builtin_amdgcn_readfirstlane(tid>>6);
  const bf16*Qw=Qu+(long)(wid*QBLK)*QP;
  const unsigned lds0=(unsigned)(uintptr_t)shm;
  float*wsf=(float*)(shm+LDS_WS)+wid*64;
  const bf16*ksrc=Kh+(long)lane*KP+wid*8;
  const bf16*vsrc=Vh+(long)(16*(wid&3)+(lane>>2))*VP+(wid>>2)*32+(lane&3)*8;
  const unsigned kdst=lds0+LDS_K+wid*1024, vdst=lds0+LDS_V+wid*1024;
  #define DMA_K(t,slot) glds16(ksrc+(long)(t)*KVBLK*KP,(unsigned)__builtin_amdgcn_readfirstlane(kdst+(slot)))
  #define DMA_V(t,slot) glds16(vsrc+(long)(t)*KVBLK*VP,(unsigned)__builtin_amdgcn_readfirstlane(vdst+(slot)))
  const int vb0=(int)(lds0+LDS_V)+((lane>>4)&1)*32+(lane&3)*8+(4*hi+((lane&15)>>2))*64;
  const char*Kbase=shm+LDS_K; bf16x8 kf[8];
  const lds_cptr shm3=(lds_cptr)shm; const lds_cptr kp0=shm3+LDS_K+hi*1024+r32*16; const lds_cptr vp0=shm3+LDS_V+((lane>>4)&1)*32+(lane&3)*8+(4*hi+((lane&15)>>2))*64;
  DMA_K(0,0);DMA_V(0,0);DMA_K(1,SLOTB);
  bf16x8 qr[4];
  #pragma unroll
  for(int d0=0;d0<4;++d0)qr[d0]=*reinterpret_cast<const bf16x8*>(&Qw[(long)r32*QP+d0*16+hi*8]);
  float mhat=0.f,l_reg=0.f;f32x16 o[2];o[0]=f32x16{};o[1]=f32x16{};f32x16 negm=f32x16{};asm volatile("":"+v"(negm));
  #define CMASK(P0,P1,t) do{}while(0)
  bool resc=false;
  #define START(P0,P1) do{ const float rm=rowmax(P0,P1); resc=false; \
    { const float dl=rm; mhat=fadd_s(mhat,dl); \
      _Pragma("unroll") for(int r=0;r<16;++r){P0[r]=fsub_s(P0[r],dl);P1[r]=fsub_s(P1[r],dl);} \
      _Pragma("unroll") for(int r=0;r<16;++r)negm[r]=-mhat; asm volatile("":"+v"(negm)); } \
    _Pragma("unroll") for(int r=0;r<16;++r)P0[r]=__builtin_amdgcn_exp2f(P0[r]); }while(0)
  #define RESC() do{ if(resc){ asm volatile("s_waitcnt lgkmcnt(0)":::"memory"); \
      _Pragma("unroll") for(int d_=0;d_<2;++d_) _Pragma("unroll") for(int r=0;r<16;++r)o[d_][r]*=wsf[crow(r,hi)]; } }while(0)
  f32x16 pA0,pA1,pB0,pB1;
  int sl_prev=0,sl_cur=0,sl_next=SLOTB;
  #define ROT() do{sl_prev=sl_cur;sl_cur=sl_next;sl_next=(sl_next==(NSLOT-1)*SLOTB)?0:sl_next+SLOTB;}while(0)
  DMA_K(2,2*SLOTB);
  WAIT_BAR(3);
  qkt(pA0,pA1,Kbase,qr,negm,r32,hi);asm volatile("s_nop 15\n\ts_nop 7":"+v"(pA0),"+v"(pA1));CMASK(pA0,pA1,0);
  START(pA0,pA1);
  _Pragma("unroll") for(int r=0;r<16;++r)pA1[r]=__builtin_amdgcn_exp2f(pA1[r]);
  WAIT_BAR(0);
  DMA_K(3,0);DMA_V(1,SLOTB);
  ROT();
  kload8(kf,kp0+sl_cur);
  WAIT_BAR(2);
  s16x4 vlo[8],vhi[8]; u32x4 pw0,pw1,pw2,pw3;
  #define PKW(P,B) cvtpk_s(P[B],P[B+1])
  #define PAF(k) __builtin_bit_cast(bf16x8,pw##k)
  #define VFR(i) (bf16x8){vlo[i][0],vlo[i][1],vlo[i][2],vlo[i][3],vhi[i][0],vhi[i][1],vhi[i][2],vhi[i][3]}
  #define PIN(x) asm volatile("":"+v"(x))
  #define MX3(a,b,c) __builtin_fmaxf(__builtin_fmaxf((a),(b)),(c))
  #define GAPA(MF,A0,A1,A2,A3,W0,W1,PW) do{ MF; sacc+=A0; sacc+=A1; sacc+=A2; sacc+=A3; PIN(sacc); W0; W1; PIN(PW); SBAR(); }while(0)
  #define EX(v) __builtin_amdgcn_exp2f(v)
  #define GAPB(MF,X,B) do{ MF; X[B]=EX(X[B]); X[B+1]=EX(X[B+1]); X[B+2]=EX(X[B+2]); X[B+3]=EX(X[B+3]); PIN(X); SBAR(); }while(0)
  #define VRD(i) do{ vlo[i]=vtr(vp_+(((i)>>2)*4096+((i)&3)*1024)); vhi[i]=vtr(vp_+(((i)>>2)*4096+((i)&3)*1024+512)); }while(0)
  #define KRD(G,j) do{ if(G){ kload2(kf,kp0+sl_next,j); SBAR(); } }while(0)
  #define STEP(C0,C1,P0,P1,t,GK,GV,GL) do{ SBAR(); \
    const lds_cptr vp_=vp0+sl_prev; \
    VRD(0); SBAR(); float sacc=(P0[0]+P0[1]); \
    GAPA(C0=__builtin_amdgcn_mfma_f32_32x32x16_bf16(kf[0],qr[0],negm,0,0,0), P0[2],P0[3],P0[4],P0[5],     pw0[0]=PKW(P0,0), pw0[1]=PKW(P0,2), pw0); \
    VRD(4); SBAR(); GAPA(C1=__builtin_amdgcn_mfma_f32_32x32x16_bf16(kf[1],qr[0],negm,0,0,0), P0[6],P0[7],P0[8],P0[9],     pw0[2]=PKW(P0,4), pw0[3]=PKW(P0,6), pw0); \
    VRD(1); SBAR(); GAPA(C0=__builtin_amdgcn_mfma_f32_32x32x16_bf16(kf[2],qr[1],C0,0,0,0),   P0[10],P0[11],P0[12],P0[13], pw1[0]=PKW(P0,8), pw1[1]=PKW(P0,10), pw1); \
    VRD(5); SBAR(); GAPA(C1=__builtin_amdgcn_mfma_f32_32x32x16_bf16(kf[3],qr[1],C1,0,0,0),   P0[14],P0[15],P1[0],P1[1],   pw1[2]=PKW(P0,12),pw1[3]=PKW(P0,14), pw1); \
    VRD(2); SBAR(); GAPA(C0=__builtin_amdgcn_mfma_f32_32x32x16_bf16(kf[4],qr[2],C0,0,0,0),   P1[2],P1[3],P1[4],P1[5],     pw2[0]=PKW(P1,0), pw2[1]=PKW(P1,2), pw2); \
    VRD(6); SBAR(); GAPA(C1=__builtin_amdgcn_mfma_f32_32x32x16_bf16(kf[5],qr[2],C1,0,0,0),   P1[6],P1[7],P1[8],P1[9],     pw2[2]=PKW(P1,4), pw2[3]=PKW(P1,6), pw2); \
    VRD(3); SBAR(); GAPA(C0=__builtin_amdgcn_mfma_f32_32x32x16_bf16(kf[6],qr[3],C0,0,0,0),   P1[10],P1[11],P1[12],P1[13], pw3[0]=PKW(P1,8), pw3[1]=PKW(P1,10), pw3); \
    VRD(7); SBAR(); GAPA(C1=__builtin_amdgcn_mfma_f32_32x32x16_bf16(kf[7],qr[3],C1,0,0,0),   P1[14],P1[15],0.f,0.f,       pw3[2]=PKW(P1,12),pw3[3]=PKW(P1,14), pw3); \
    l_reg+=sacc; \
    if(GK){DMA_K((t)+3,sl_cur);} if(GV){DMA_V((t)+1,sl_next);} \
    CMASK(C0,C1,t); \
    { float a=MX3(C0[0],C0[1],C1[0]),b=MX3(C0[2],C0[3],C1[1]); a=MX3(a,C1[2],C1[3]); \
      _Pragma("unroll") for(int r=4;r<16;r+=4){a=MX3(a,C0[r],C0[r+1]);b=MX3(b,C0[r+2],C0[r+3]);a=MX3(a,C1[r],C1[r+1]);b=MX3(b,C1[r+2],C1[r+3]);} \
      float rm=__builtin_fmaxf(a,b); { auto rr=__builtin_amdgcn_permlane32_swap(__float_as_uint(rm),__float_as_uint(rm),false,false); rm=__builtin_fmaxf(__uint_as_float(rr[0]),__uint_as_float(rr[1])); } \
      resc=false; \
      if(__builtin_expect(__any(rm>(float)THRL),0)){ const float dl=__builtin_fmaxf(rm,0.f); mhat+=dl; \
        _Pragma("unroll") for(int r=0;r<16;++r){C0[r]-=dl;C1[r]-=dl;} \
        _Pragma("unroll") for(int r=0;r<16;++r)negm[r]=-mhat; asm volatile("":"+v"(negm)); \
        const float f=__builtin_amdgcn_exp2f(-dl); l_reg*=f; if(hi==0)wsf[r32]=f; resc=true; } } \
    SBAR(); \
    GAPB(o[0]=__builtin_amdgcn_mfma_f32_32x32x16_bf16(PAF(0),VFR(0),o[0],0,0,0), C0,0); \
    GAPB(o[1]=__builtin_amdgcn_mfma_f32_32x32x16_bf16(PAF(0),VFR(4),o[1],0,0,0), C0,4); \
    KRD(GL,0); GAPB(o[0]=__builtin_amdgcn_mfma_f32_32x32x16_bf16(PAF(1),VFR(1),o[0],0,0,0), C0,8); \
    KRD(GL,1); GAPB(o[1]=__builtin_amdgcn_mfma_f32_32x32x16_bf16(PAF(1),VFR(5),o[1],0,0,0), C0,12); \
    KRD(GL,2); GAPB(o[0]=__builtin_amdgcn_mfma_f32_32x32x16_bf16(PAF(2),VFR(2),o[0],0,0,0), C1,0); \
    KRD(GL,3); GAPB(o[1]=__builtin_amdgcn_mfma_f32_32x32x16_bf16(PAF(2),VFR(6),o[1],0,0,0), C1,4); \
    GAPB(o[0]=__builtin_amdgcn_mfma_f32_32x32x16_bf16(PAF(3),VFR(3),o[0],0,0,0), C1,8); \
    GAPB(o[1]=__builtin_amdgcn_mfma_f32_32x32x16_bf16(PAF(3),VFR(7),o[1],0,0,0), C1,12); \
    }while(0)
  int t=1;
  for(;t+5<NT;t+=2){
    STEP(pB0,pB1,pA0,pA1,t,true,true,true);     WAIT_BAR(2); RESC(); ROT();
    STEP(pA0,pA1,pB0,pB1,t+1,true,true,true);   WAIT_BAR(2); RESC(); ROT();
  }
  #define ENDW(tt) do{ if((tt)+3<NT){WAIT_BAR(2);} else if((tt)+2<NT){WAIT_BAR(1);} else {WAIT_BAR(0);} }while(0)
  for(;t+1<NT;t+=2){
    STEP(pB0,pB1,pA0,pA1,t,(t+3<NT),(t+1<NT),(t+1<NT));       ENDW(t);   RESC(); ROT();
    STEP(pA0,pA1,pB0,pB1,t+1,(t+4<NT),(t+2<NT),(t+2<NT));     ENDW(t+1); RESC(); ROT();
  }
  STEP(pB0,pB1,pA0,pA1,NT-1,false,false,false); RESC();
  { float sacc=pB0[0]+pB0[1]; _Pragma("unroll") for(int r=2;r<16;++r)sacc+=pB0[r]; _Pragma("unroll") for(int r=0;r<16;++r)sacc+=pB1[r]; l_reg+=sacc;
    pw0=(u32x4){PKW(pB0,0),PKW(pB0,2),PKW(pB0,4),PKW(pB0,6)};pw1=(u32x4){PKW(pB0,8),PKW(pB0,10),PKW(pB0,12),PKW(pB0,14)};pw2=(u32x4){PKW(pB1,0),PKW(pB1,2),PKW(pB1,4),PKW(pB1,6)};pw3=(u32x4){PKW(pB1,8),PKW(pB1,10),PKW(pB1,12),PKW(pB1,14)};
    SBAR(); pv(o,vb0+sl_cur,PAF(0),PAF(1),PAF(2),PAF(3)); }
  #undef PKW
  #undef PAF
  #undef VFR
  #undef PIN
  #undef MX3
  #undef GAPA
  #undef GAPB
  #undef EX
  #undef VRD
  #undef KRD
  #undef STEP
  #undef ENDW
  {auto rr=__builtin_amdgcn_permlane32_swap(__float_as_uint(l_reg),__float_as_uint(l_reg),false,false);l_reg=__uint_as_float(rr[0])+__uint_as_float(rr[1]);}
  if(hi==0)wsf[32+r32]=l_reg;asm volatile("s_waitcnt lgkmcnt(0)":::"memory");
  float rli[16];
  #pragma unroll
  for(int r=0;r<16;++r)rli[r]=__builtin_amdgcn_rcpf(wsf[32+crow(r,hi)]);
  bf16*Ow=Ou+(long)(wid*QBLK)*OP;
  { bf16*stg=(bf16*)(shm+LDS_OST)+wid*2048;
    #pragma unroll
    for(int r=0;r<16;++r){const int orow=crow(r,hi);
      #pragma unroll
      for(int d0=0;d0<2;++d0)stg[orow*64+d0*32+r32]=__float2bfloat16(o[d0][r]*rli[r]);}
    asm volatile("s_waitcnt lgkmcnt(0)":::"memory");
    #pragma unroll
    for(int i=0;i<4;++i){const int row=i*8+(lane>>3),ch=lane&7; const u32x4 v=*(const u32x4*)(stg+row*64+ch*8); ATTN_STORE16(Ow+(long)row*OP+ch*8,v);} }
  asm volatile("s_waitcnt lgkmcnt(0)\n\ts_barrier":::"memory");
  #undef DMA_K
  #undef DMA_V
  #undef CMASK
  #undef START
  #undef RESC
  #undef ROT
}
constexpr int ATTN_LDS_BYTES=LDS_BYTES;
#undef SBAR
#undef WAIT_BAR
}


namespace hyf {
struct c32 { float x, y; };
typedef _Float16 h2 __attribute__((ext_vector_type(2)));
__device__ __forceinline__ c32 operator+(c32 a, c32 b) { return {a.x + b.x, a.y + b.y}; }
__device__ __forceinline__ c32 operator-(c32 a, c32 b) { return {a.x - b.x, a.y - b.y}; }
__device__ __forceinline__ c32 cmul(c32 a, c32 b) { return {a.x * b.x - a.y * b.y, a.x * b.y + a.y * b.x}; }
__device__ __forceinline__ constexpr float C32(int k) {
  switch (k) { case 0: return 1.f; case 1: return 0.98078528f; case 2: return 0.923879533f; case 3: return 0.831469612f; case 4: return 0.707106781f; case 5: return 0.555570233f; case 6: return 0.382683432f;
    case 7: return 0.195090322f; case 8: return 0.f; case 9: return -0.195090322f; case 10: return -0.382683432f; case 11: return -0.555570233f; case 12: return -0.707106781f; case 13: return -0.831469612f;
    case 14: return -0.923879533f; default: return -0.98078528f; } }
__device__ __forceinline__ constexpr float S32(int k) {
  switch (k) { case 0: return 0.f; case 1: return 0.195090322f; case 2: return 0.382683432f; case 3: return 0.555570233f; case 4: return 0.707106781f; case 5: return 0.831469612f; case 6: return 0.923879533f;
    case 7: return 0.98078528f; case 8: return 1.f; case 9: return 0.98078528f; case 10: return 0.923879533f; case 11: return 0.831469612f; case 12: return 0.707106781f; case 13: return 0.555570233f;
    case 14: return 0.382683432f; default: return 0.195090322f; } }
__device__ __forceinline__ constexpr int brev(int q, int bits) {
  return bits == 4 ? (((q & 1) << 3) | ((q & 2) << 1) | ((q & 4) >> 1) | ((q & 8) >> 3))
                   : (((q & 1) << 4) | ((q & 2) << 2) | (q & 4) | ((q & 8) >> 2) | ((q & 16) >> 4)); }
__device__ __forceinline__ int phys(int p) { return p + (p >> 5); }
template <int R, int HALF, bool INV> struct DftStage {
  static __device__ __forceinline__ void run(c32 (&x)[R]) {
#pragma unroll
    for (int blk = 0; blk < R; blk += 2 * HALF) {
#pragma unroll
      for (int j = 0; j < HALF; ++j) {
        const c32 a = x[blk + j], b = x[blk + j + HALF]; x[blk + j] = a + b; const c32 d = a - b;
        const int e = j * (R / (2 * HALF)) * (32 / R);
        if (e == 0) x[blk + j + HALF] = d;
        else if (e == 8) x[blk + j + HALF] = INV ? (c32){-d.y, d.x} : (c32){d.y, -d.x};
        else { const c32 wv = {C32(e), INV ? S32(e) : -S32(e)}; x[blk + j + HALF] = cmul(d, wv); }
      } }
    DftStage<R, HALF / 2, INV>::run(x);
  }
};
template <int R, bool INV> struct DftStage<R, 0, INV> { static __device__ __forceinline__ void run(c32 (&)[R]) {} };
template <int R, bool INV> __device__ __forceinline__ void dft_pow2(c32 (&x)[R]) { DftStage<R, R / 2, INV>::run(x); }
template <int R, int HALF> struct DitStage {
  static __device__ __forceinline__ void run(c32 (&x)[R]) {
#pragma unroll
    for (int blk = 0; blk < R; blk += 2 * HALF) {
#pragma unroll
      for (int j = 0; j < HALF; ++j) {
        const int e = j * (R / (2 * HALF)) * (32 / R);
        const c32 a = x[blk + j], b0 = x[blk + j + HALF];
        c32 b;
        if (e == 0) b = b0; else if (e == 8) b = (c32){-b0.y, b0.x}; else b = cmul(b0, (c32){C32(e), S32(e)});
        x[blk + j] = a + b; x[blk + j + HALF] = a - b;
      } }
    DitStage<R, HALF * 2>::run(x);
  }
};
template <int R> struct DitStage<R, R> { static __device__ __forceinline__ void run(c32 (&)[R]) {} };
template <int R> __device__ __forceinline__ void idft_dit(c32 (&x)[R]) { DitStage<R, 1>::run(x); }
template <int STRIDE, bool INV> __device__ __forceinline__ void pass16(c32* buf, int e0, float rev) {
  float rv = rev; asm volatile("" : "+v"(rv));
  const float cs = __builtin_amdgcn_cosf(rv), sn = __builtin_amdgcn_sinf(rv);
  const c32 w1 = {cs, INV ? sn : -sn};
  c32* p = buf + phys(e0); constexpr int PS = STRIDE + STRIDE / 32;
  c32 x[16];
  if (!INV) {
#pragma unroll
    for (int m = 0; m < 16; ++m) x[m] = p[PS * m];
    dft_pow2<16, false>(x);
    c32 w = w1; p[0] = x[0];
#pragma unroll
    for (int q = 1; q < 16; ++q) { p[PS * q] = cmul(x[brev(q, 4)], w); w = cmul(w, w1); }
  } else {
    c32 w = w1; x[0] = p[0];
#pragma unroll
    for (int q = 1; q < 16; ++q) { x[q] = cmul(p[PS * q], w); w = cmul(w, w1); }
    dft_pow2<16, true>(x);
#pragma unroll
    for (int m = 0; m < 16; ++m) p[PS * m] = x[brev(m, 4)];
  }
}
template <int MODE> __device__ __forceinline__ void mid32(c32* buf, h2* Hs, int j) {
  c32* p = buf + 33 * j; c32 x[32];
#pragma unroll
  for (int m = 0; m < 32; ++m) x[m] = p[m];
  dft_pow2<32, false>(x);
  if (MODE == 0) {
#pragma unroll
    for (int q = 0; q < 32; ++q) { const c32 v = x[brev(q, 5)]; Hs[q * 256 + j] = (h2){(_Float16)v.x, (_Float16)v.y}; }
  } else {
#pragma unroll
    for (int pp = 0; pp < 32; ++pp) { const h2 hv = Hs[brev(pp, 5) * 256 + j]; x[pp] = cmul(x[pp], (c32){(float)hv.x, (float)hv.y}); }
    idft_dit<32>(x);
#pragma unroll
    for (int m = 0; m < 32; ++m) p[m] = x[m];
  }
}
__device__ __forceinline__ void fwd2(c32* buf, int tid) {
  __syncthreads(); pass16<512, false>(buf, tid, (float)tid * (1.0f / 8192.0f));
  __syncthreads(); pass16<32, false>(buf, (tid >> 5) * 512 + (tid & 31), (float)(tid & 31) * (1.0f / 512.0f));
  __syncthreads();
}
__device__ __forceinline__ void conv(c32* buf, h2* Hs, int tid) {
  fwd2(buf, tid);
  if (tid < 256) mid32<1>(buf, Hs, tid);
  __syncthreads(); pass16<32, true>(buf, (tid >> 5) * 512 + (tid & 31), (float)(tid & 31) * (1.0f / 512.0f));
  __syncthreads(); pass16<512, true>(buf, tid, (float)tid * (1.0f / 8192.0f));
  __syncthreads();
}
__device__ __forceinline__ void item(int c, const bf16_t* HYT, const float* HK, const float* hy_bias, bf16_t* HYO, char* lds) {
  c32* buf = (c32*)lds; h2* H0 = (h2*)(lds + 67584); h2* H1 = H0 + 8192;
  const int tid = TIDX;
#pragma unroll 1
  for (int o = 0; o < 2; ++o) {
    const float* kp = HK + ((size_t)o * 256 + c) * 8192;
#pragma unroll
    for (int i = 0; i < 16; ++i) { const int n = tid + 512 * i; buf[phys(n)] = (c32){kp[n], 0.f}; }
    fwd2(buf, tid);
    if (tid < 256) mid32<0>(buf, o ? H1 : H0, tid);
    __syncthreads();
  }
  const float bias0 = hy_bias[c], bias1 = hy_bias[256 + c];
#pragma unroll 1
  for (int pr = 0; pr < 2; ++pr) {
    const bf16_t* v0 = HYT + ((size_t)(2 * pr) * 768 + c) * SEQ; const bf16_t* v1 = v0 + (size_t)768 * SEQ;
    c32 vv[8];
#pragma unroll
    for (int i = 0; i < 8; ++i) { const int t = tid + 512 * i; vv[i] = (c32){bf2f(v0[t]), bf2f(v1[t])}; buf[phys(t)] = vv[i]; buf[phys(t + 4096)] = (c32){0.f, 0.f}; }
    conv(buf, H0, tid);
#pragma unroll
    for (int i = 0; i < 8; ++i) { const int t = tid + 512 * i; const c32 y = buf[phys(t)];
      vv[i] = (c32){bf2f(v0[(size_t)256 * SEQ + t]) * (y.x * (1.0f / 8192.0f) + bias0 * vv[i].x), bf2f(v1[(size_t)256 * SEQ + t]) * (y.y * (1.0f / 8192.0f) + bias0 * vv[i].y)};
      buf[phys(t)] = vv[i]; buf[phys(t + 4096)] = (c32){0.f, 0.f}; }
    conv(buf, H1, tid);
#pragma unroll
    for (int i = 0; i < 8; ++i) { const int t = tid + 512 * i; const c32 y = buf[phys(t)];
      HYO[((size_t)(2 * pr) * 256 + c) * SEQ + t] = (bf16_t)f2bf(bf2f(v0[(size_t)512 * SEQ + t]) * (y.x * (1.0f / 8192.0f) + bias1 * vv[i].x));
      HYO[((size_t)(2 * pr + 1) * 256 + c) * SEQ + t] = (bf16_t)f2bf(bf2f(v1[(size_t)512 * SEQ + t]) * (y.y * (1.0f / 8192.0f) + bias1 * vv[i].y)); }
    __syncthreads();
  }
}
__device__ __forceinline__ void out_item(int it, const bf16_t* HYO, bf16_t* MIX, char* lds) {
  bf16_t (*T)[72] = (bf16_t (*)[72])lds;
  const int tid = TIDX, b = it >> 8, t0 = ((it >> 2) & 63) * 64, c0 = (it & 3) * 64;
  { const int cc = tid >> 3, t8 = (tid & 7) * 8; *(u32x4*)&T[cc][t8] = *(const u32x4*)(HYO + ((size_t)b * 256 + c0 + cc) * SEQ + t0 + t8); }
  __syncthreads();
  { const int tl = tid >> 3, c8 = (tid & 7) * 8; u32x4 o;
    o.x = (unsigned)T[c8][tl] | ((unsigned)T[c8 + 1][tl] << 16); o.y = (unsigned)T[c8 + 2][tl] | ((unsigned)T[c8 + 3][tl] << 16);
    o.z = (unsigned)T[c8 + 4][tl] | ((unsigned)T[c8 + 5][tl] << 16); o.w = (unsigned)T[c8 + 6][tl] | ((unsigned)T[c8 + 7][tl] << 16);
    *(u32x4*)(MIX + ((size_t)b * TPB + CTXL + t0 + tl) * DM + 768 + c0 + c8) = o; }
  __syncthreads();
}
}

#define LAS __attribute__((address_space(3)))
#define XB_TMO      128
#define XB_XCNT(j)  (256  + 64 * (j))
#define XB_XSUB(j)  (1280 + 64 * (j))
#define XB_XGEN(j)  (2304 + 64 * (j))
#define XB_TOP      3328
#define XB_TOPGEN   3392
#define XCD_BAR_WORDS 3456
#define XB_SPIN_CAP (1u << 18)

__device__ __forceinline__ unsigned xb_ld(unsigned* p)              { return __hip_atomic_load(p, __ATOMIC_RELAXED, __HIP_MEMORY_SCOPE_AGENT); }
__device__ __forceinline__ unsigned xb_add(unsigned* p, unsigned v) { return __hip_atomic_fetch_add(p, v, __ATOMIC_RELAXED, __HIP_MEMORY_SCOPE_AGENT); }
__device__ __forceinline__ unsigned xb_xcc_id() { return (unsigned)__builtin_amdgcn_s_getreg((3 << 11) | 20) & 0xFu; }
#define XB_SPIN(cond, bar) do { unsigned _sp = 0; while (cond) { __builtin_amdgcn_s_sleep(1); \
    if ((++_sp & 255u) == 0u) { if (xb_ld(&(bar)[XB_TMO])) break; if (_sp > XB_SPIN_CAP) { atomicAdd(&(bar)[XB_TMO], 1u); break; } } } } while (0)

struct XcdBarrier {
    unsigned* bar; unsigned x;
    volatile LAS unsigned* st;
};

__device__ __forceinline__ XcdBarrier xcd_barrier_post(unsigned* bar, volatile LAS unsigned* st) {
    XcdBarrier b; b.bar = bar; b.x = xb_xcc_id(); b.st = st;
    if (threadIdx.x == 0) (void)xb_add(&bar[XB_XCNT(b.x)], 1u);
    return b;
}
__device__ __forceinline__ void xcd_barrier_complete(unsigned* bar, unsigned x, unsigned& nloc, unsigned& nx) {
    const unsigned G = gridDim.x * gridDim.y * gridDim.z;
    unsigned sum, cnt, mine, sp = 0u;
    for (;;) {
        sum = 0u; cnt = 0u; mine = 0u;
#pragma unroll
        for (unsigned j = 0; j < 16; ++j) { const unsigned c = xb_ld(&bar[XB_XCNT(j)]); sum += c; cnt += (c > 0u) ? 1u : 0u; mine = (j == x) ? c : mine; }
        if (sum == G) break;
        __builtin_amdgcn_s_sleep(1);
        if ((++sp & 255u) == 0u) { if (xb_ld(&bar[XB_TMO])) break; if (sp > XB_SPIN_CAP) { atomicAdd(&bar[XB_TMO], 1u); break; } }
    }
    nloc = mine > 0u ? mine : 1u; nx = cnt > 0u ? cnt : 1u;
}

__device__ __forceinline__ void xcd_barrier(const XcdBarrier& b) {
    asm volatile("s_waitcnt vmcnt(0)" ::: "memory");
    __syncthreads();
    if (threadIdx.x == 0) {
        unsigned* bar = b.bar;
        __builtin_amdgcn_s_waitcnt(0);
        unsigned nloc = b.st[0], nx = b.st[1];
        if (nloc == 0u) { xcd_barrier_complete(bar, b.x, nloc, nx); b.st[0] = nloc; b.st[1] = nx; }
        const unsigned old = xb_add(&bar[XB_XSUB(b.x)], 1u);
        const unsigned gen = old / nloc;
        if (old + 1u == (gen + 1u) * nloc) {
            __builtin_amdgcn_fence(__ATOMIC_RELEASE, "agent");
            asm volatile("s_waitcnt vmcnt(0)" ::: "memory");
            const unsigned og = xb_add(&bar[XB_TOP], 1u);
            const unsigned tg = og / nx;
            if (og + 1u == (tg + 1u) * nx) xb_add(&bar[XB_TOPGEN], 1u);
            else XB_SPIN(xb_ld(&bar[XB_TOPGEN]) == tg, bar);
            __builtin_amdgcn_fence(__ATOMIC_ACQUIRE, "agent");
            xb_add(&bar[XB_XGEN(b.x)], 1u);
            asm volatile("s_waitcnt vmcnt(0)" ::: "memory");
        } else {
            XB_SPIN(xb_ld(&bar[XB_XGEN(b.x)]) == gen, bar);
            __builtin_amdgcn_fence(__ATOMIC_ACQUIRE, "agent");
            asm volatile("s_waitcnt vmcnt(0)" ::: "memory");
        }
    }
    __syncthreads();
}


struct MP { const float* in[33]; float* out; unsigned char* ws; };
typedef const float* const __attribute__((address_space(4))) * kargs_t;
#define KARGS() ({ kargs_t k_ = (kargs_t)__builtin_amdgcn_kernarg_segment_ptr(); asm volatile("" : "+s"(k_)); k_; })
#define WSP(K, off) ((unsigned char*)(K)[34] + (off))

__global__ void __launch_bounds__(NT, 2) mega(MP P) {
  cg::grid_group grid = cg::this_grid();
  extern __shared__ __attribute__((aligned(16))) char lds[];
  volatile LAS unsigned* xst = (volatile LAS unsigned*)(lds + LDS_BYTES - 16);
  if (threadIdx.x < 2) xst[threadIdx.x] = 0u;
  { kargs_t K = KARGS(); unsigned* bw = (unsigned*)WSP(K, WS_CTL) + CT_BAR;
    if (blockIdx.x == 0) for (int i = threadIdx.x; i < XCD_BAR_WORDS; i += NT) bw[i] = 0u; }
  __syncthreads();
#define SEAM() xcd_barrier(xbar)
  {
    kargs_t K = KARGS();
    st_adaln(K[1], K[3], K[4], K[5], (float*)WSP(K, WS_MODV), lds);
    st_rope((float*)WSP(K, WS_ROPE));
  }
  grid.sync();
  XcdBarrier xbar;
  { kargs_t K = KARGS(); xbar = xcd_barrier_post((unsigned*)WSP(K, WS_CTL) + CT_BAR, xst); }
#pragma nounroll
  for (int layer = 0; layer < 2; ++layer) {
    const bool last = layer == 1;
    {
      kargs_t K = KARGS();
      st_weights(K[8], K[26], K[29], K[30], K[31], layer, (bf16_t*)WSP(K, WS_WIN), (bf16_t*)WSP(K, WS_WOUT), (bf16_t*)WSP(K, WS_WGU), (bf16_t*)WSP(K, WS_WD), lds);
    }
    { kargs_t K = KARGS(); const int bid = BIDX, G = GDIM;
      for (int it = bid; it < SEQ / 64; it += G) hyfilt_item<SEQ>(it, K[19] + layer * 33 * 64, K[20] + layer * 64, K[21] + layer * 64, K[22] + layer * 4096, K[23] + layer * 64, K[24] + (size_t)layer * 65536, (float*)WSP(K, WS_HK), lds);
      if (!last) for (int it = bid; it < CTXL / 64; it += G) hyfilt_item<CTXL>(it, K[19] + layer * 33 * 64, K[20] + layer * 64, K[21] + layer * 64, K[22] + layer * 4096, K[23] + layer * 64, K[24] + (size_t)layer * 65536, (float*)WSP(K, WS_HKC), lds);
    }
    { kargs_t K = KARGS();
      const float* xl_src = layer == 0 ? K[0] : K[33]; const float* xc_src = layer == 0 ? K[2] : (const float*)WSP(K, WS_XC);
      st_normmod(xl_src, xc_src, K[6] + layer * 1024, (const float*)WSP(K, WS_MODV) + (size_t)layer * 5 * 6144, 0, 1024, (bf16_t*)WSP(K, WS_H));
    }
    SEAM();
    {
      kargs_t K = KARGS();
      pg8::Gemm g{1024, 1024, 1024}; SchedDense S{MTOK / 256, NPAD / 256, (int)GDIM, BIDX, 0, (const char*)WSP(K, WS_H), (const char*)WSP(K, WS_WIN), (size_t)256 * 1024 * 2, (size_t)256 * 1024 * 2};
      EpiInProj E{(bf16_t*)WSP(K, WS_QK), (bf16_t*)WSP(K, WS_VZ), (bf16_t*)WSP(K, WS_XBC), (bf16_t*)WSP(K, WS_HY), (float*)WSP(K, WS_DT)};
      pg8::gemm_phase<EpiInProj, SchedDense, true, true>((PG8_LAS unsigned char*)lds, g, S, E);
    }
    SEAM();
    {
      kargs_t K = KARGS();
      st_prep_qk((bf16_t*)WSP(K, WS_QK), K[9] + layer * 64, K[10] + layer * 64, (const float*)WSP(K, WS_ROPE));
    }
    { kargs_t K = KARGS();
      st_prep_hy((const bf16_t*)WSP(K, WS_HY), K[17] + layer * 3 * 768, K[18] + layer * 768, (bf16_t*)WSP(K, WS_HYT), last ? 0 : 1, lds);
    }
    { kargs_t K = KARGS(); const int bid = BIDX, G = GDIM;
      for (int it = bid; it < 4 * 34 * 6; it += G)
        ssd1_item(it, (const bf16_t*)WSP(K, WS_XBC), (const float*)WSP(K, WS_DT), K[11] + layer * 3 * 640, K[12] + layer * 640, K[13] + layer * 12, K[14] + layer * 12,
                  (float*)WSP(K, WS_Y), (float*)WSP(K, WS_ST), (float*)WSP(K, WS_DEC), lds);
    }
    SEAM();
    {
      { kargs_t K2 = KARGS(); st_ssd_scan2((float*)WSP(K2, WS_ST), (const float*)WSP(K2, WS_DEC)); }
      const int bid = BIDX, G = GDIM;
      const int n_att = last ? 384 : 408, n_hyl = 256, n_hyc = last ? 0 : 1024;
      const int total = n_att + n_hyl + n_hyc;
      for (int it = bid; it < total; it += G) {
        int i2 = it;
        if (i2 < n_att) {
          kargs_t K = KARGS();
          int b, h, nt; size_t qrow;
          if (i2 < 384) { b = i2 / 96; const int rem = i2 % 96; h = rem >> 4; qrow = (size_t)b * TPB + CTXL + (rem & 15) * 256; nt = TPB / 64; }
          else { const int uc = i2 - 384; b = uc / 6; h = uc % 6; qrow = (size_t)b * TPB; nt = CTXL / 64; }
          const int kvh = h / 3;
          const attn_body::bf16* QKp = (const attn_body::bf16*)WSP(K, WS_QK); const attn_body::bf16* VZp = (const attn_body::bf16*)WSP(K, WS_VZ);
          attn_body::attn_unit<8>(QKp + qrow * 512 + h * 64, QKp + (size_t)b * TPB * 512 + 384 + kvh * 64, VZp + (size_t)b * TPB * 512 + kvh * 64,
                                  (attn_body::bf16*)WSP(K, WS_H) + qrow * 1024 + h * 64, nt, lds);
          continue; } i2 -= n_att;
        if (i2 < n_hyl) { kargs_t K = KARGS(); hyf::item(i2, (const bf16_t*)WSP(K, WS_HYT), (const float*)WSP(K, WS_HK), K[25] + layer * 512, (bf16_t*)WSP(K, WS_HY), lds); continue; } i2 -= n_hyl;
        { kargs_t K = KARGS(); hyconv_item<CTXL>(i2, (const bf16_t*)WSP(K, WS_HYT) + (size_t)4 * 768 * SEQ, (const float*)WSP(K, WS_HKC), K[25] + layer * 512, (bf16_t*)WSP(K, WS_H), 0, lds); }
      }
    }
    SEAM();
    {
      kargs_t K = KARGS();
      { const int bid = BIDX, G = GDIM, nit = last ? 4 * 32 * 2 : 4 * 34 * 2;
        for (int it = bid; it < nit; it += G) { const int g = it & 1, bc = it >> 1; const int b = last ? bc >> 5 : bc / 34, cidx = last ? 2 + (bc & 31) : bc % 34;
          ssd3_item(b, cidx, g, (const bf16_t*)WSP(K, WS_XBC), (const bf16_t*)WSP(K, WS_VZ), (const float*)WSP(K, WS_DT), K[11] + layer * 3 * 640, K[12] + layer * 640, K[13] + layer * 12, K[14] + layer * 12,
                    K[15] + layer * 6, K[16] + layer * 384, (const float*)WSP(K, WS_Y), (const float*)WSP(K, WS_ST), (bf16_t*)WSP(K, WS_H), lds); } }
      { const int bid = BIDX, G = GDIM; for (int it = bid; it < 1024; it += G) hyf::out_item(it, (const bf16_t*)WSP(K, WS_HY), (bf16_t*)WSP(K, WS_H), lds); }
      const int t = TIDX; if (BIDX == 0 && t < 256) ((int*)WSP(K, WS_CTL))[t] = 0;
    }
    SEAM();
    {
      kargs_t K = KARGS();
      const float* xl_src = layer == 0 ? K[0] : K[33]; const float* xc_src = layer == 0 ? K[2] : (const float*)WSP(K, WS_XC);
      pg8::Gemm g{1024, 1024, 1024}; SchedDense S{last ? 64 : 68, 4, (int)GDIM, BIDX, last ? 1 : 0, (const char*)WSP(K, WS_H), (const char*)WSP(K, WS_WOUT), (size_t)256 * 1024 * 2, (size_t)256 * 1024 * 2};
      EpiOutProj E{xl_src, xc_src, (float*)K[33], (float*)WSP(K, WS_XC), (const float*)WSP(K, WS_MODV) + (size_t)layer * 5 * 6144 + 2048};
      pg8::gemm_phase<EpiOutProj, SchedDense, true, true>((PG8_LAS unsigned char*)lds, g, S, E);
    }
    SEAM();
    {
      kargs_t K = KARGS();
      st_router(K[33], (const float*)WSP(K, WS_XC), K[7] + layer * 1024, (const float*)WSP(K, WS_MODV) + (size_t)layer * 5 * 6144, K[27], K[28], (bf16_t*)WSP(K, WS_H), (int*)WSP(K, WS_CTL),
                (int*)WSP(K, WS_MOEM), (float*)WSP(K, WS_MOEM + 128 * 1024), last ? 1 : 0);
    }
    SEAM();
    { kargs_t K = KARGS(); st_moe_plan((int*)WSP(K, WS_CTL), (int*)WSP(K, WS_MOEM + 384 * 1024)); }
    SEAM();
    { kargs_t K = KARGS();
      st_moe_gather((const bf16_t*)WSP(K, WS_H), (bf16_t*)WSP(K, WS_H2S), (int*)WSP(K, WS_CTL), (const int*)WSP(K, WS_MOEM), (const float*)WSP(K, WS_MOEM + 128 * 1024),
                    (int*)WSP(K, WS_MOEM + 384 * 1024), (float*)WSP(K, WS_MOEM + 512 * 1024), last ? 1 : 0);
    }
    SEAM();
    { kargs_t K = KARGS();
      pg8::Gemm g{1024, 1024, 1024}; SchedMoe S{(int)GDIM, BIDX, 1, (const int*)WSP(K, WS_CTL), (const char*)WSP(K, WS_H2S), (size_t)256 * 1024 * 2, (const char*)WSP(K, WS_WGU)};
      EpiMoe1 E{(bf16_t*)WSP(K, WS_ACT), (const float*)WSP(K, WS_MOEM + 512 * 1024)};
      pg8::gemm_phase<EpiMoe1, SchedMoe, true, true>((PG8_LAS unsigned char*)lds, g, S, E);
    }
    SEAM();
    { kargs_t K = KARGS();
      pg8::Gemm g{256, 512, 256}; SchedMoe S{(int)GDIM, BIDX, 2, (const int*)WSP(K, WS_CTL), (const char*)WSP(K, WS_ACT), (size_t)256 * 512 * 2, (const char*)WSP(K, WS_WD)};
      EpiMoe2 E{(float*)K[33], (float*)WSP(K, WS_XC), (const float*)WSP(K, WS_MODV) + (size_t)layer * 5 * 6144 + 5120, (const int*)WSP(K, WS_MOEM + 384 * 1024)};
      pg8::gemm_phase<EpiMoe2, SchedMoe, true, true>((PG8_LAS unsigned char*)lds, g, S, E);
    }
    SEAM();
  }
  { kargs_t K = KARGS(); st_final((float*)K[33], K[32]); }
}

extern "C" void kernel_launch(void* const* d_in, const int* in_sizes, int n_in, void* d_out, int out_size, void* d_ws, size_t ws_size, hipStream_t stream) {
  if (n_in != 33 || ws_size < WS_END) { fprintf(stderr, "kernel_launch: unexpected n_in %d / ws %zu\n", n_in, ws_size); return; }
  static int grid_blocks = 0;
  if (!grid_blocks) {
    int dev = 0, cus = 0, per_cu = 0;
    (void)hipGetDevice(&dev);
    (void)hipDeviceGetAttribute(&cus, hipDeviceAttributeMultiprocessorCount, dev);
    (void)hipFuncSetAttribute((const void*)mega, hipFuncAttributeMaxDynamicSharedMemorySize, LDS_BYTES);
    (void)hipOccupancyMaxActiveBlocksPerMultiprocessor(&per_cu, mega, NT, LDS_BYTES);
    if (per_cu < 1) per_cu = 1;
    if (per_cu > 2) per_cu = 2;
    grid_blocks = cus * per_cu;
  }
  MP p{};
  for (int i = 0; i < 33; ++i) p.in[i] = (const float*)d_in[i];
  p.out = (float*)d_out; p.ws = (unsigned char*)d_ws;
  void* args[] = {&p};
  hipError_t e = hipLaunchCooperativeKernel((const void*)mega, dim3(grid_blocks), dim3(NT), args, LDS_BYTES, stream);
  if (e != hipSuccess) fprintf(stderr, "cooperative launch failed: %s (grid %d)\n", hipGetErrorString(e), grid_blocks);
}
```

```cpp
#include <hip/hip_runtime.h>
#include <hip/hip_cooperative_groups.h>
#include <cstdio>
#include <cstdint>
namespace cg = cooperative_groups;

typedef unsigned short bf16_t;
typedef short bf16x8 __attribute__((ext_vector_type(8)));
typedef float f32x4 __attribute__((ext_vector_type(4)));
typedef unsigned u32x4 __attribute__((ext_vector_type(4)));
typedef unsigned u32x2 __attribute__((ext_vector_type(2)));

constexpr int NB = 4, SEQ = 4096, CTXL = 256, DM = 1024, TPB = 4352, MTOK = NB * TPB;
constexpr int DIN = 2444, NPAD = 2560;
constexpr float EPS = 1e-6f;
constexpr float C2 = 0.125f * 1.4426950408889634f;
constexpr int MOE_ROWS = 23552;
constexpr int NT = 512;
constexpr int LDS_BYTES = 147456;

constexpr size_t MiB = 1u << 20;
constexpr size_t WS_CTL = 0;
constexpr size_t WS_MODV = 1 * MiB;
constexpr size_t WS_ROPE = 2 * MiB;
constexpr size_t WS_MOEM = 3 * MiB;
constexpr size_t WS_DT = 4 * MiB;
constexpr size_t WS_HKC = 5 * MiB;
constexpr size_t WS_XC = 6 * MiB;
constexpr size_t WS_WIN = 10 * MiB;
constexpr size_t WS_WOUT = 15 * MiB;
constexpr size_t WS_WGU = 17 * MiB;
constexpr size_t WS_WD = 33 * MiB;
constexpr size_t WS_HK = 41 * MiB;
constexpr size_t WS_H = 57 * MiB;
constexpr size_t WS_QK = 91 * MiB;
constexpr size_t WS_VZ = 108 * MiB;
constexpr size_t WS_XBC = 125 * MiB;
constexpr size_t WS_HY = WS_XBC + (size_t)MTOK * 768 * 2;
constexpr size_t WS_HYT = WS_HY + (size_t)MTOK * 768 * 2;
constexpr size_t WS_ST = WS_HYT + (size_t)MTOK * 768 * 2;
constexpr size_t WS_Y = WS_ST + (size_t)4 * 34 * 2 * 6 * 4096 * 4;
constexpr size_t WS_END = WS_Y + (size_t)MTOK * 384 * 4;
constexpr size_t WS_DEC = WS_DT + 900 * 1024;
constexpr size_t WS_H2S = WS_QK;
constexpr size_t WS_ACT = WS_H2S + (size_t)MOE_ROWS * 1024 * 2;
static_assert(WS_END <= 256 * MiB, "ws");
static_assert(WS_ACT + (size_t)MOE_ROWS * 512 * 2 <= WS_HYT, "moe alias");

constexpr int CT_CNT = 0, CT_FILL = 32, CT_BASE = 64, CT_NT = 96, CT_TP = 128;
constexpr int CT_BAR = 4096;

__device__ __forceinline__ int opq_v(int v) { asm volatile("" : "+v"(v)); return v; }
__device__ __forceinline__ int opq_s(int v) { asm volatile("" : "+s"(v)); return v; }
#define TIDX opq_v((int)threadIdx.x)
#define BIDX opq_s((int)blockIdx.x)
#define GDIM opq_s((int)gridDim.x)
__device__ __forceinline__ unsigned f2bf(float f) { unsigned u = __float_as_uint(f); return (u + 0x7fffu + ((u >> 16) & 1u)) >> 16; }
__device__ __forceinline__ unsigned pk2bf(float lo, float hi) { return f2bf(lo) | (f2bf(hi) << 16); }
__device__ __forceinline__ float bf2f(bf16_t h) { return __uint_as_float(((unsigned)h) << 16); }
__device__ __forceinline__ float wave_sum(float v) {
#pragma unroll
  for (int o = 1; o < 64; o <<= 1) v += __shfl_xor(v, o);
  return v;
}
__device__ __forceinline__ float siluf(float v) { return v / (1.0f + __expf(-v)); }
__device__ __forceinline__ float* xrow(const float* xl, const float* xc, int r) {
  const int b = r / TPB, j = r - b * TPB;
  return (float*)(j < CTXL ? xc + ((size_t)b * CTXL + j) * DM : xl + ((size_t)b * SEQ + (j - CTXL)) * DM);
}
__device__ __forceinline__ int mrow_of(int r) { const int b = r / TPB, j = r - b * TPB; return j < CTXL ? 4 : b; }

__device__ __forceinline__ void st_adaln(const float* c, const float* c_ctx, const float* w_mod, const float* b_mod, float* modv, char* lds) {
  float (*sc)[1024] = (float (*)[1024])lds;
  float (*red)[5][64] = (float (*)[5][64])(lds + 5 * 1024 * 4);
  const int tid = TIDX;
  for (int it = BIDX; it < 192; it += GDIM) {
    const int layer = it / 96, n0 = (it % 96) * 64;
    for (int i = tid; i < 5 * 1024; i += NT) { const int r = i >> 10, k = i & 1023; const float v = r < 4 ? c[r * 1024 + k] : c_ctx[k]; sc[r][k] = v / (1.0f + expf(-v)); }
    __syncthreads();
    const int kg = tid >> 6, n = tid & 63;
    float acc[5] = {0.f, 0.f, 0.f, 0.f, 0.f};
    for (int k = kg; k < 1024; k += 8) { const float w = w_mod[((size_t)layer * 1024 + k) * 6144 + n0 + n];
#pragma unroll
      for (int r = 0; r < 5; ++r) acc[r] += sc[r][k] * w; }
#pragma unroll
    for (int r = 0; r < 5; ++r) red[kg][r][n] = acc[r];
    __syncthreads();
    if (tid < 320) { const int r = tid >> 6, nn = tid & 63; float s = 0.f;
#pragma unroll
      for (int g = 0; g < 8; ++g) s += red[g][r][nn];
      modv[((size_t)layer * 5 + r) * 6144 + n0 + nn] = s + b_mod[layer * 6144 + n0 + nn]; }
    __syncthreads();
  }
}
__device__ __forceinline__ void st_rope(float* rope) {
  for (int i = BIDX * NT + TIDX; i < 4096 * 32; i += GDIM * NT) {
    const int t = i >> 5, d = i & 31, m = d & 15;
    const float inv = powf(10000.0f, -(float)(2 * m) / 32.0f);
    const float pos = (float)(d < 16 ? (t >> 6) : (t & 63));
    const float ang = pos * inv;
    rope[2 * i] = cosf(ang); rope[2 * i + 1] = sinf(ang);
  }
}

__device__ __forceinline__ void st_normmod(const float* xl, const float* xc, const float* g, const float* modv_layer, int off_sh, int off_sc, bf16_t* H) {
  const int lane = TIDX & 63, gw = BIDX * 8 + (TIDX >> 6), ngw = GDIM * 8;
  for (int r = gw; r < MTOK; r += ngw) {
    const float* xr = xrow(xl, xc, r); const float* mv = modv_layer + (size_t)mrow_of(r) * 6144;
    f32x4 v[4]; float ss = 0.f;
#pragma unroll
    for (int j = 0; j < 4; ++j) { v[j] = *(const f32x4*)(xr + 4 * lane + 256 * j); ss += v[j].x * v[j].x + v[j].y * v[j].y + v[j].z * v[j].z + v[j].w * v[j].w; }
    const float rstd = rsqrtf(wave_sum(ss) * (1.0f / DM) + EPS);
#pragma unroll
    for (int j = 0; j < 4; ++j) { const int k = 4 * lane + 256 * j;
      const f32x4 gg = *(const f32x4*)(g + k), sh = *(const f32x4*)(mv + off_sh + k), sc = *(const f32x4*)(mv + off_sc + k);
      const float o0 = v[j].x * rstd * gg.x * (1.f + sc.x) + sh.x, o1 = v[j].y * rstd * gg.y * (1.f + sc.y) + sh.y;
      const float o2 = v[j].z * rstd * gg.z * (1.f + sc.z) + sh.z, o3 = v[j].w * rstd * gg.w * (1.f + sc.w) + sh.w;
      u32x2 w; w.x = f2bf(o0) | (f2bf(o1) << 16); w.y = f2bf(o2) | (f2bf(o3) << 16);
      *(u32x2*)(H + (size_t)r * DM + k) = w; }
  }
}

template <int MODE> __device__ __forceinline__ void tr_tile(const float* src, const float* src2, int ldsrc, int K, bf16_t* out, int n0, int k0, char* lds) {
  float (*tile)[65] = (float (*)[65])lds;
  const int tid = TIDX;
#pragma unroll
  for (int i = 0; i < 8; ++i) { const int kk = (tid >> 6) + 8 * i, nn = tid & 63, n = n0 + nn; float v = 0.f;
    if (MODE == 0) { const int col = n < 1676 ? n : (n < 1792 ? -1 : n - 116); if (col >= 0) v = src[(size_t)(k0 + kk) * ldsrc + col]; }
    else if (MODE == 1) { v = src[(size_t)(k0 + kk) * ldsrc + n]; }
    else { v = (n & 1) ? src2[(size_t)(k0 + kk) * ldsrc + (n >> 1)] : src[(size_t)(k0 + kk) * ldsrc + (n >> 1)]; }
    tile[kk][nn] = v; }
  __syncthreads();
#pragma unroll
  for (int i = 0; i < 4; ++i) { const int nn = (tid >> 5) + 16 * i, kk = (tid & 31) * 2;
    *(unsigned*)(out + (size_t)(n0 + nn) * K + k0 + kk) = f2bf(tile[kk][nn]) | (f2bf(tile[kk + 1][nn]) << 16); }
  __syncthreads();
}
template <int MODE> __device__ __forceinline__ void tr_wave_item(const float* src, const float* src2, int ldsrc, int K, bf16_t* out, int n0, int k0, float* scr, int lane) {
  const int nn = lane & 31, n = n0 + nn;
#pragma unroll 8
  for (int i = 0; i < 32; ++i) { const int kk = 2 * i + (lane >> 5); float v = 0.f;
    if (MODE == 0) { const int col = n < 1676 ? n : (n < 1792 ? -1 : n - 116); if (col >= 0) v = src[(size_t)(k0 + kk) * ldsrc + col]; }
    else if (MODE == 1) v = src[(size_t)(k0 + kk) * ldsrc + n];
    else v = (n & 1) ? src2[(size_t)(k0 + kk) * ldsrc + (n >> 1)] : src[(size_t)(k0 + kk) * ldsrc + (n >> 1)];
    scr[kk * 33 + nn] = v; }
  asm volatile("s_waitcnt lgkmcnt(0)" ::: "memory");
  const int c = lane & 7;
#pragma unroll
  for (int j = 0; j < 4; ++j) { const int nr = (lane >> 3) + 8 * j; const float* sp = scr + (8 * c) * 33 + nr;
    u32x4 o; o.x = f2bf(sp[0]) | (f2bf(sp[33]) << 16); o.y = f2bf(sp[66]) | (f2bf(sp[99]) << 16); o.z = f2bf(sp[132]) | (f2bf(sp[165]) << 16); o.w = f2bf(sp[198]) | (f2bf(sp[231]) << 16);
    *(u32x4*)(out + (size_t)(n0 + nr) * K + k0 + 8 * c) = o; }
  asm volatile("s_waitcnt lgkmcnt(0)" ::: "memory");
}
__device__ __forceinline__ void st_weights(const float* w_in, const float* w_out, const float* w_gate, const float* w_up, const float* w_down, int layer,
                                           bf16_t* WIN, bf16_t* WOUT, bf16_t* WGU, bf16_t* WD, char* lds) {
  const int tid = TIDX, lane = tid & 63, w = tid >> 6; float* scr = (float*)lds + w * (64 * 33);
  for (int it = BIDX * 8 + w; it < 7936; it += GDIM * 8) {
    if (it < 1280) tr_wave_item<0>(w_in + (size_t)layer * 1024 * DIN, nullptr, DIN, 1024, WIN, (it % 80) * 32, (it / 80) * 64, scr, lane);
    else if (it < 1792) { const int i2 = it - 1280; tr_wave_item<1>(w_out + (size_t)layer * 1024 * 1024, nullptr, 1024, 1024, WOUT, (i2 & 31) * 32, (i2 >> 5) * 64, scr, lane); }
    else if (it < 5888) { const int i2 = it - 1792, e = i2 >> 8, t = i2 & 255;
      tr_wave_item<2>(w_gate + ((size_t)layer * 16 + e) * 1024 * 256, w_up + ((size_t)layer * 16 + e) * 1024 * 256, 256, 1024, WGU + (size_t)e * 512 * 1024, (t & 15) * 32, (t >> 4) * 64, scr, lane); }
    else { const int i2 = it - 5888, e = i2 >> 7, t = i2 & 127;
      tr_wave_item<1>(w_down + ((size_t)layer * 16 + e) * 256 * 1024, nullptr, 1024, 256, WD + (size_t)e * 1024 * 256, (t & 31) * 32, (t >> 5) * 64, scr, lane); }
  }
  __syncthreads();
}

template <class P> __device__ __forceinline__ void st_gemm(const P& p, int ntm, int ntn, char* lds) {
  bf16_t (*As)[72] = (bf16_t (*)[72])lds;
  bf16_t (*Bs)[72] = (bf16_t (*)[72])(lds + 256 * 72 * 2);
  const int tid = TIDX, lane = tid & 63, w = tid >> 6;
  for (int it = BIDX; it < ntm * ntn; it += GDIM) {
    const int mt = it / ntn, nt = it % ntn;
    if (!p.valid(mt)) continue;
    const int m0 = mt * 256, n0 = nt * 128;
    f32x4 acc[2][8];
#pragma unroll
    for (int a = 0; a < 2; ++a)
#pragma unroll
      for (int b = 0; b < 8; ++b) acc[a][b] = (f32x4){0.f, 0.f, 0.f, 0.f};
    const int K = p.K;
    for (int k0 = 0; k0 < K; k0 += 64) {
#pragma unroll
      for (int i = 0; i < 4; ++i) { const int ch = tid + NT * i, r = ch >> 3, kc = (ch & 7) * 8;
        const bf16_t* ap = p.arow(m0 + r); *(u32x4*)&As[r][kc] = *(const u32x4*)(ap + k0 + kc); }
#pragma unroll
      for (int i = 0; i < 2; ++i) { const int ch = tid + NT * i, r = ch >> 3, kc = (ch & 7) * 8;
        const bf16_t* bp = p.brow(mt, n0 + r, k0); *(u32x4*)&Bs[r][kc] = *(const u32x4*)(bp + kc); }
      __syncthreads();
#pragma unroll
      for (int kk = 0; kk < 2; ++kk) {
        bf16x8 a[2], b[8];
#pragma unroll
        for (int mi = 0; mi < 2; ++mi) a[mi] = *(const bf16x8*)&As[32 * w + 16 * mi + (lane & 15)][kk * 32 + 8 * (lane >> 4)];
#pragma unroll
        for (int ni = 0; ni < 8; ++ni) b[ni] = *(const bf16x8*)&Bs[16 * ni + (lane & 15)][kk * 32 + 8 * (lane >> 4)];
#pragma unroll
        for (int mi = 0; mi < 2; ++mi)
#pragma unroll
          for (int ni = 0; ni < 8; ++ni) acc[mi][ni] = __builtin_amdgcn_mfma_f32_16x16x32_bf16(a[mi], b[ni], acc[mi][ni], 0, 0, 0);
      }
      __syncthreads();
    }
    p.epi(acc, mt, m0, n0, w, lane);
  }
}

struct PInProj {
  const bf16_t* H; const bf16_t* W; bf16_t *QK, *VZ, *XBC, *HY; float* DT; int K;
  __device__ bool valid(int) const { return true; }
  __device__ const bf16_t* arow(int m) const { return H + (size_t)m * DM; }
  __device__ const bf16_t* brow(int, int n, int k0) const { return W + (size_t)n * DM + k0; }
  __device__ void epi(const f32x4 (&acc)[2][8], int, int m0, int n0, int w, int lane) const {
#pragma unroll
    for (int mi = 0; mi < 2; ++mi)
#pragma unroll
      for (int ni = 0; ni < 8; ++ni)
#pragma unroll
        for (int rg = 0; rg < 4; ++rg) { const int row = m0 + 32 * w + 16 * mi + 4 * (lane >> 4) + rg, col = n0 + 16 * ni + (lane & 15); const float v = acc[mi][ni][rg];
          if (col < 512) QK[(size_t)row * 512 + col] = (bf16_t)f2bf(v);
          else if (col < 1024) VZ[(size_t)row * 512 + col - 512] = (bf16_t)f2bf(v);
          else if (col < 1792) { XBC[(size_t)row * 768 + col - 1024] = (bf16_t)f2bf(v); if (col >= 1664 && col < 1676) DT[(size_t)row * 12 + col - 1664] = v; }
          else HY[(size_t)row * 768 + col - 1792] = (bf16_t)f2bf(v); }
  }
};
struct POutProj {
  const bf16_t* A; const bf16_t* W; const float *xl_src, *xc_src; float *xl_dst, *xc_dst; const float* gate;   int skip_ctx; int K;
  __device__ bool valid(int mt) const { return !(skip_ctx && ((mt * 256) % TPB) < CTXL); }
  __device__ const bf16_t* arow(int m) const { return A + (size_t)m * DM; }
  __device__ const bf16_t* brow(int, int n, int k0) const { return W + (size_t)n * DM + k0; }
  __device__ void epi(const f32x4 (&acc)[2][8], int, int m0, int n0, int w, int lane) const {
#pragma unroll
    for (int mi = 0; mi < 2; ++mi)
#pragma unroll
      for (int rg = 0; rg < 4; ++rg) { const int row = m0 + 32 * w + 16 * mi + 4 * (lane >> 4) + rg;
        const float* xs = xrow(xl_src, xc_src, row); float* xd = xrow(xl_dst, xc_dst, row); const float* gt = gate + (size_t)mrow_of(row) * 6144;
#pragma unroll
        for (int ni = 0; ni < 8; ++ni) { const int col = n0 + 16 * ni + (lane & 15); xd[col] = xs[col] + gt[col] * acc[mi][ni][rg]; } }
  }
};
__device__ __forceinline__ void pair_experts(int pidx, int& eA, int& eB) {
  const int g = pidx / 6, t = pidx - 6 * g; const int i = t < 3 ? 0 : (t < 5 ? 1 : 2); const int j = t < 3 ? t + 1 : (t < 5 ? t - 1 : 3);
  eA = 4 * g + i; eB = 4 * g + j;
}
struct PMoe1 {
  const bf16_t* H2S; const bf16_t* WGU; bf16_t* ACT; const int* ctl; const float* sorted_w; int K;
  __device__ bool valid(int mt) const { return mt < ctl[CT_NT]; }
  __device__ const bf16_t* arow(int m) const { return H2S + (size_t)m * DM; }
  __device__ const bf16_t* brow(int mt, int n, int k0) const { int eA, eB; pair_experts(ctl[CT_TP + mt], eA, eB); const int e = n < 512 ? eA : eB;
    return WGU + ((size_t)e * 512 + (n & 511)) * DM + k0; }
  __device__ void epi(const f32x4 (&acc)[2][8], int, int m0, int n0, int w, int lane) const {
    const int half = n0 >> 9, tb = (n0 & 511) >> 7;
#pragma unroll
    for (int mi = 0; mi < 2; ++mi)
#pragma unroll
      for (int rg = 0; rg < 4; ++rg) { const int slot = m0 + 32 * w + 16 * mi + 4 * (lane >> 4) + rg; const float wt = sorted_w[2 * slot + half];
#pragma unroll
        for (int ni = 0; ni < 4; ++ni) { const float g = acc[mi][ni][rg], u = acc[mi][ni + 4][rg]; const int j = 64 * tb + 16 * ni + (lane & 15);
          ACT[(size_t)slot * 512 + half * 256 + j] = (bf16_t)f2bf(siluf(g) * u * wt); } }
  }
};
struct PMoe2 {
  const bf16_t* ACT; const bf16_t* WD; float *xl, *xc; const float* gate;   const int* ctl; const int* sorted_tok; int K;
  __device__ bool valid(int mt) const { return mt < ctl[CT_NT]; }
  __device__ const bf16_t* arow(int m) const { return ACT + (size_t)m * 512; }
  __device__ const bf16_t* brow(int mt, int n, int k0) const { int eA, eB; pair_experts(ctl[CT_TP + mt], eA, eB); const int e = k0 < 256 ? eA : eB;
    return WD + ((size_t)e * 1024 + n) * 256 + (k0 & 255); }
  __device__ void epi(const f32x4 (&acc)[2][8], int, int m0, int n0, int w, int lane) const {
#pragma unroll
    for (int mi = 0; mi < 2; ++mi)
#pragma unroll
      for (int rg = 0; rg < 4; ++rg) { const int slot = m0 + 32 * w + 16 * mi + 4 * (lane >> 4) + rg; const int r = sorted_tok[slot];
        if (r >= 0) { float* xd = xrow(xl, xc, r); const float* gt = gate + (size_t)mrow_of(r) * 6144;
#pragma unroll
          for (int ni = 0; ni < 8; ++ni) { const int col = n0 + 16 * ni + (lane & 15); xd[col] += gt[col] * acc[mi][ni][rg]; } } }
  }
};

__device__ __forceinline__ void st_prep_qk(bf16_t* QK, const float* qn, const float* kn, const float* rope) {
  const int lane = TIDX & 63, gw = BIDX * 8 + (TIDX >> 6), ngw = GDIM * 8, hh = lane >> 3, sub = lane & 7;
  for (int r = gw; r < MTOK; r += ngw) {
    const int j = r % TPB; bf16_t* p = QK + (size_t)r * 512 + hh * 64 + sub * 8;
    const bf16x8 raw = *(const bf16x8*)p; float v[8]; float ss = 0.f;
#pragma unroll
    for (int e = 0; e < 8; ++e) { v[e] = bf2f((bf16_t)raw[e]); ss += v[e] * v[e]; }
    ss += __shfl_xor(ss, 1); ss += __shfl_xor(ss, 2); ss += __shfl_xor(ss, 4);
    const float rstd = rsqrtf(ss * (1.0f / 64.0f) + EPS); const float* gn = (hh < 6 ? qn : kn) + sub * 8;
#pragma unroll
    for (int e = 0; e < 8; ++e) v[e] = v[e] * rstd * gn[e];
    if (j >= CTXL) { const float* rp = rope + ((size_t)(j - CTXL) * 32 + (sub & 3) * 8) * 2;
#pragma unroll
      for (int e = 0; e < 8; ++e) { const float other = __shfl_xor(v[e], 4); const float cs = rp[2 * e], sn = rp[2 * e + 1]; v[e] = sub < 4 ? v[e] * cs - other * sn : v[e] * cs + other * sn; } }
    const float sc = hh < 6 ? C2 : 1.0f;
    *(u32x4*)p = (u32x4){pk2bf(v[0] * sc, v[1] * sc), pk2bf(v[2] * sc, v[3] * sc), pk2bf(v[4] * sc, v[5] * sc), pk2bf(v[6] * sc, v[7] * sc)};
  }
}

__device__ __forceinline__ void st_prep_hy(const bf16_t* HY, const float* cw, const float* cb, bf16_t* HYT, int do_ctx, char* lds) {
  float (*tile)[65] = (float (*)[65])lds;
  const int nlat = 4 * 64 * 12, nitem = nlat + (do_ctx ? 4 * 4 * 12 : 0), tid = TIDX;
  for (int it = BIDX; it < nitem; it += GDIM) {
    int b, tt, ct, L, joff; bf16_t* outb;
    if (it < nlat) { b = it / 768; tt = (it % 768) / 12; ct = it % 12; L = SEQ; joff = CTXL; outb = HYT + (size_t)b * 768 * SEQ; }
    else { const int i2 = it - nlat; b = i2 / 48; tt = (i2 % 48) / 12; ct = i2 % 12; L = CTXL; joff = 0; outb = HYT + (size_t)4 * 768 * SEQ + (size_t)b * 768 * CTXL; }
    const int t0 = tt * 64, c0 = ct * 64;
    for (int e = tid; e < 66 * 64; e += NT) { const int rr = e >> 6, cc = e & 63, t = t0 - 1 + rr;
      tile[rr][cc] = (t >= 0 && t < L) ? bf2f(HY[((size_t)b * TPB + joff + t) * 768 + c0 + cc]) : 0.f; }
    __syncthreads();
    for (int e = tid; e < 64 * 64; e += NT) { const int cc = e >> 6, tl = e & 63, c = c0 + cc;
      const float v = cw[c] * tile[tl][cc] + cw[768 + c] * tile[tl + 1][cc] + cw[1536 + c] * tile[tl + 2][cc] + cb[c];
      outb[(size_t)c * L + t0 + tl] = (bf16_t)f2bf(v); }
    __syncthreads();
  }
}

template <int L> __device__ __forceinline__ void hyfilt_item(int item, const float* w1, const float* b1, const float* fr, const float* w2, const float* b2, const float* w3, float* HK, char* lds) {
  float* S0 = (float*)lds; float* S1 = S0 + 64 * 64; float* S2 = S1 + 64 * 64;
  const int tid = TIDX, n0 = (item >> 2) * 64, cq = item & 3, lane = tid & 63, wv = tid >> 6;
  for (int e = tid; e < 64 * 33; e += NT) { const int pp = e / 33, f = e % 33; const int n = n0 + pp; float v;
    if (f == 0) v = (float)n / (float)(L - 1);
    else { const int m = (f - 1) & 15; const float band = 1e-4f + (float)m * ((15.0f - 1e-4f) / 15.0f); const float wpos = (6.283185307179586f / (float)L) * (float)n;
      v = f <= 16 ? cosf(wpos * band) : -sinf(wpos * band); }
    S0[pp * 33 + f] = v; }
  for (int e = tid; e < 33 * 64; e += NT) S1[e] = w1[e];
  __syncthreads();
  for (int e = tid; e < 64 * 64; e += NT) { const int pp = e >> 6, j = e & 63; float a = b1[j];
    for (int f = 0; f < 33; ++f) a += S0[pp * 33 + f] * S1[f * 64 + j];
    S2[pp * 64 + j] = sinf(fr[j] * a); }
  __syncthreads();
  for (int e = tid; e < 64 * 64; e += NT) S0[e] = w2[e];
  __syncthreads();
  for (int e = tid; e < 64 * 64; e += NT) { const int pp = e >> 6, j = e & 63; float a = b2[j];
    for (int f = 0; f < 64; ++f) a += S2[pp * 64 + f] * S0[f * 64 + j];
    S1[pp * 64 + j] = sinf(fr[j] * a); }
  __syncthreads();
  for (int c4 = 0; c4 < 4; ++c4) { const int ch = cq * 4 + c4;
    const int col = ch * 64 + lane; float acc[8];
#pragma unroll
    for (int i = 0; i < 8; ++i) acc[i] = 0.f;
    for (int j = 0; j < 64; ++j) { const float wv3 = w3[j * 1024 + col];
#pragma unroll
      for (int i = 0; i < 8; ++i) acc[i] += S1[(wv * 8 + i) * 64 + j] * wv3; }
    const int c = col & 255; const float delta = 3.0701134573253943f + (float)c * ((15.350567286626972f - 3.0701134573253943f) / 255.0f);
#pragma unroll
    for (int i = 0; i < 8; ++i) { const int pp = wv * 8 + i; const float t = (float)(n0 + pp) / (float)(L - 1); S2[lane * 65 + pp] = acc[i] * expf(-t * delta); }
    __syncthreads();
    const int dir = ch >> 3, order = (ch >> 2) & 1;
#pragma unroll
    for (int i = 0; i < 8; ++i) { const int cl = wv * 8 + i, c2 = (ch * 64 + cl) & 255, n = n0 + lane; const float v = S2[cl * 65 + lane];
      float* dst = HK + ((size_t)order * 256 + c2) * (2 * L);
      if (dir == 0) dst[n] = v; else if (n >= 1) dst[2 * L - n] = v;
      if (dir == 1 && n == 0) dst[L] = 0.f; }
    __syncthreads();
  }
}

template <int L> __device__ __forceinline__ void hyconv_item(int item, const bf16_t* HYT, const float* HK, const float* hy_bias, bf16_t* MIX, int joff, char* lds) {
  float* kern = (float*)lds; float* z = kern + 2 * L;
  const int tid = TIDX, b = item >> 8, c = item & 255;
  const bf16_t* vp = HYT + ((size_t)b * 768 + c) * L; const bf16_t* x1p = vp + (size_t)256 * L; const bf16_t* x2p = vp + (size_t)512 * L;
  const bool act = tid < L / 8; const int tb = 8 * tid;
  for (int o = 0; o < 2; ++o) {
    if (o == 0) for (int t = tid; t < L; t += NT) z[t] = bf2f(vp[t]);
    const float* kp = HK + ((size_t)o * 256 + c) * (2 * L);
    for (int t = tid; t < 2 * L; t += NT) kern[t] = kp[t];
    __syncthreads();
    float acc[8], W[16];
#pragma unroll
    for (int i = 0; i < 8; ++i) acc[i] = 0.f;
    if (act) {
#pragma unroll
      for (int i = 0; i < 8; ++i) W[8 + i] = kern[(tb + i) & (2 * L - 1)];
      for (int s0 = 0; s0 < L; s0 += 8) {
        const int bb = (tb - s0 - 8) & (2 * L - 1);
#pragma unroll
        for (int i = 0; i < 8; ++i) W[i] = kern[bb + i];
        float zs[8];
#pragma unroll
        for (int j = 0; j < 8; ++j) zs[j] = z[s0 + j];
#pragma unroll
        for (int j = 0; j < 8; ++j)
#pragma unroll
          for (int i = 0; i < 8; ++i) acc[i] += W[8 + i - j] * zs[j];
#pragma unroll
        for (int i = 0; i < 8; ++i) W[8 + i] = W[i];
      }
    }
    __syncthreads();
    const float bias = hy_bias[o * 256 + c];
    if (act) {
#pragma unroll
      for (int i = 0; i < 8; ++i) { const int t = tb + i; const float zz = acc[i] + bias * z[t];
        if (o == 0) z[t] = bf2f(x1p[t]) * zz;
        else MIX[((size_t)b * TPB + joff + t) * DM + 768 + c] = (bf16_t)f2bf(bf2f(x2p[t]) * zz); }
    }
    __syncthreads();
  }
}

__device__ __forceinline__ void attn_unit_simple(int u, const bf16_t* QK, const bf16_t* VZ, bf16_t* MIX, char* lds) {
  bf16_t (*Ks)[72] = (bf16_t (*)[72])lds;
  bf16_t (*Vt)[72] = (bf16_t (*)[72])(lds + 64 * 72 * 2);
  bf16_t (*Ps)[16][72] = (bf16_t (*)[16][72])(lds + 2 * 64 * 72 * 2);
  const int tid = TIDX, lane = tid & 63, w = tid >> 6;
  int b, h, qrow0, nk;
  if (u < 768) { b = u / 192; const int rem = u % 192; h = rem >> 5; qrow0 = b * TPB + CTXL + (rem & 31) * 128; nk = TPB; }
  else { const int uc = u - 768; b = uc / 12; h = (uc % 12) >> 1; qrow0 = b * TPB + (uc & 1) * 128; nk = CTXL; }
  const int kvh = h / 3, key0 = b * TPB, l15 = lane & 15, l4 = lane >> 4;
  bf16x8 aq[2];
#pragma unroll
  for (int kk = 0; kk < 2; ++kk) aq[kk] = *(const bf16x8*)(QK + (size_t)(qrow0 + 16 * w + l15) * 512 + h * 64 + kk * 32 + 8 * l4);
  f32x4 O[4]; float m[4], l[4];
#pragma unroll
  for (int i = 0; i < 4; ++i) { O[i] = (f32x4){0.f, 0.f, 0.f, 0.f}; m[i] = -1e30f; l[i] = 0.f; }
  for (int kt = 0; kt < nk / 64; ++kt) {
    __syncthreads();
    { const int r = tid >> 3, c8 = (tid & 7) * 8; const size_t grow = (size_t)(key0 + kt * 64 + r) * 512;
      *(u32x4*)&Ks[r][c8] = *(const u32x4*)(QK + grow + 384 + kvh * 64 + c8);
      const bf16x8 vv = *(const bf16x8*)(VZ + grow + kvh * 64 + c8);
#pragma unroll
      for (int e = 0; e < 8; ++e) Vt[c8 + e][r] = (bf16_t)vv[e]; }
    __syncthreads();
    f32x4 s[4];
#pragma unroll
    for (int ni = 0; ni < 4; ++ni) s[ni] = (f32x4){0.f, 0.f, 0.f, 0.f};
#pragma unroll
    for (int kk = 0; kk < 2; ++kk)
#pragma unroll
      for (int ni = 0; ni < 4; ++ni) { const bf16x8 bk = *(const bf16x8*)&Ks[16 * ni + l15][32 * kk + 8 * l4]; s[ni] = __builtin_amdgcn_mfma_f32_16x16x32_bf16(aq[kk], bk, s[ni], 0, 0, 0); }
#pragma unroll
    for (int rg = 0; rg < 4; ++rg) {
      float mx = fmaxf(fmaxf(s[0][rg], s[1][rg]), fmaxf(s[2][rg], s[3][rg]));
      mx = fmaxf(mx, __shfl_xor(mx, 1)); mx = fmaxf(mx, __shfl_xor(mx, 2)); mx = fmaxf(mx, __shfl_xor(mx, 4)); mx = fmaxf(mx, __shfl_xor(mx, 8));
      const float mn = fmaxf(m[rg], mx), alpha = exp2f(m[rg] - mn); float rs = 0.f;
#pragma unroll
      for (int ni = 0; ni < 4; ++ni) { const float pv = exp2f(s[ni][rg] - mn); rs += pv; Ps[w][4 * l4 + rg][16 * ni + l15] = (bf16_t)f2bf(pv); }
      rs += __shfl_xor(rs, 1); rs += __shfl_xor(rs, 2); rs += __shfl_xor(rs, 4); rs += __shfl_xor(rs, 8);
      l[rg] = l[rg] * alpha + rs; m[rg] = mn;
#pragma unroll
      for (int ni = 0; ni < 4; ++ni) O[ni][rg] *= alpha;
    }
    __syncthreads();
#pragma unroll
    for (int kk = 0; kk < 2; ++kk) { const bf16x8 ap = *(const bf16x8*)&Ps[w][l15][32 * kk + 8 * l4];
#pragma unroll
      for (int ni = 0; ni < 4; ++ni) { const bf16x8 bv = *(const bf16x8*)&Vt[16 * ni + l15][32 * kk + 8 * l4]; O[ni] = __builtin_amdgcn_mfma_f32_16x16x32_bf16(ap, bv, O[ni], 0, 0, 0); } }
  }
#pragma unroll
  for (int rg = 0; rg < 4; ++rg) { const float il = 1.0f / l[rg]; const size_t row = (size_t)(qrow0 + 16 * w + 4 * l4 + rg);
#pragma unroll
    for (int ni = 0; ni < 4; ++ni) MIX[row * DM + h * 64 + 16 * ni + l15] = (bf16_t)f2bf(O[ni][rg] * il); }
  __syncthreads();
}

__device__ __forceinline__ void st_ssd_prep(const bf16_t* XBC, float* DT, const float* cw, const float* cb, const float* dt_bias, bf16_t* XBCC) {
  const size_t total = (size_t)MTOK * 640;
  for (size_t i = (size_t)BIDX * NT + TIDX; i < total; i += (size_t)GDIM * NT) {
    const int r = (int)(i / 640), ch = (int)(i % 640), j = r % TPB;
    const bool hasp = (j != 0 && j != CTXL), hasn = (j != CTXL - 1 && j != TPB - 1);
    float v = cw[640 + ch] * bf2f(XBC[(size_t)r * 768 + ch]) + cb[ch];
    if (hasp) v += cw[ch] * bf2f(XBC[(size_t)(r - 1) * 768 + ch]);
    if (hasn) v += cw[1280 + ch] * bf2f(XBC[(size_t)(r + 1) * 768 + ch]);
    XBCC[i] = (bf16_t)f2bf(siluf(v));
  }
  for (size_t i = (size_t)BIDX * NT + TIDX; i < (size_t)MTOK * 12; i += (size_t)GDIM * NT) {
    const float x = DT[i] + dt_bias[i % 12];
    DT[i] = x > 20.f ? x : log1pf(expf(x));
  }
}
__device__ __forceinline__ void ssd_scan_item(int item, const bf16_t* XBCC, const float* DT, const float* a_log, float* Y, char* lds) {
  const int half = TIDX >> 8, tid = TIDX & 255;
  float* base = (float*)(lds + half * 25088);
  float (*xs)[64] = (float (*)[64])base; float (*Bs)[64] = (float (*)[64])(base + 2048); float (*Cs)[64] = (float (*)[64])(base + 4096);
  float* dAs = base + 6144; float* dts = base + 6176;
  const int bh = 2 * item + half, b = bh / 6, h = bh % 6, g = h / 3, p = tid >> 2, q = tid & 3;
  for (int dir = 0; dir < 2; ++dir) {
    const float a = -expf(a_log[dir * 6 + h]);
    float st[16];
#pragma unroll
    for (int n = 0; n < 16; ++n) st[n] = 0.f;
    for (int ci = 0; ci < TPB / 32; ++ci) {
      for (int e = tid; e < 32 * 64; e += 256) { const int i = e >> 6, cc = e & 63, qi = ci * 32 + i;
        const int j = dir == 0 ? qi : (qi < CTXL ? CTXL - 1 - qi : TPB - 1 - (qi - CTXL)); const size_t r = (size_t)b * TPB + j;
        xs[i][cc] = bf2f(XBCC[r * 640 + h * 64 + cc]); Bs[i][cc] = bf2f(XBCC[r * 640 + 384 + g * 64 + cc]); Cs[i][cc] = bf2f(XBCC[r * 640 + 512 + g * 64 + cc]); }
      if (tid < 32) { const int qi = ci * 32 + tid; const int j = dir == 0 ? qi : (qi < CTXL ? CTXL - 1 - qi : TPB - 1 - (qi - CTXL)); const size_t r = (size_t)b * TPB + j;
        const float dt = DT[r * 12 + dir * 6 + h]; dts[tid] = dt; dAs[tid] = expf(dt * a); }
      __syncthreads();
      for (int i = 0; i < 32; ++i) {
        const float d = dAs[i], dtx = dts[i] * xs[i][p]; float y = 0.f;
#pragma unroll
        for (int n = 0; n < 16; ++n) { st[n] = st[n] * d + dtx * Bs[i][16 * q + n]; y += Cs[i][16 * q + n] * st[n]; }
        y += __shfl_xor(y, 1); y += __shfl_xor(y, 2);
        if (q == 0) { const int qi = ci * 32 + i; const int j = dir == 0 ? qi : (qi < CTXL ? CTXL - 1 - qi : TPB - 1 - (qi - CTXL)); float* yp = Y + ((size_t)b * TPB + j) * 384 + h * 64 + p;
          if (dir == 0) *yp = y; else *yp += y; }
      }
      __syncthreads();
    }
  }
}
__device__ __forceinline__ void st_ssd_out(const float* Y, const bf16_t* XBCC, const bf16_t* VZ, const float* dskip, const float* nw, bf16_t* MIX) {
  const int lane = TIDX & 63, gw = BIDX * 8 + (TIDX >> 6), ngw = GDIM * 8;
  for (int it = gw; it < MTOK * 2; it += ngw) {
    const int r = it >> 1, g = it & 1; float gv[3]; float ss = 0.f;
#pragma unroll
    for (int i = 0; i < 3; ++i) { const int c = g * 192 + lane + 64 * i, hh = c >> 6;
      const float y = Y[(size_t)r * 384 + c] + bf2f(XBCC[(size_t)r * 640 + c]) * dskip[hh]; const float zv = bf2f(VZ[(size_t)r * 512 + 128 + c]);
      gv[i] = y * siluf(zv); ss += gv[i] * gv[i]; }
    const float rstd = rsqrtf(wave_sum(ss) * (1.0f / 192.0f) + EPS);
#pragma unroll
    for (int i = 0; i < 3; ++i) { const int c = g * 192 + lane + 64 * i; MIX[(size_t)r * DM + 384 + c] = (bf16_t)f2bf(gv[i] * rstd * nw[c]); }
  }
}


__device__ __forceinline__ void ssd_conv8(const bf16_t* XBC, size_t r, int c0, bool hasp, bool hasn, const float* cw, const float* cb, float (&o)[8]) {
  const bf16x8 cur = *(const bf16x8*)(XBC + r * 768 + c0);
  bf16x8 prv = (bf16x8){0, 0, 0, 0, 0, 0, 0, 0}, nxt = (bf16x8){0, 0, 0, 0, 0, 0, 0, 0};
  if (hasp) prv = *(const bf16x8*)(XBC + (r - 1) * 768 + c0);
  if (hasn) nxt = *(const bf16x8*)(XBC + (r + 1) * 768 + c0);
#pragma unroll
  for (int e = 0; e < 8; ++e) { const float v = cw[c0 + e] * bf2f((bf16_t)prv[e]) + cw[640 + c0 + e] * bf2f((bf16_t)cur[e]) + cw[1280 + c0 + e] * bf2f((bf16_t)nxt[e]) + cb[c0 + e]; o[e] = siluf(v); }
}
__device__ __forceinline__ float softplusf(float x) { return x > 20.f ? x : log1pf(expf(x)); }
__device__ __forceinline__ void wave_scan128(float e0, float e1, int lane, float& c0, float& c1) {
  float x = e0 + e1;
#pragma unroll
  for (int o = 1; o < 64; o <<= 1) { const float v = __shfl_up(x, o); if (lane >= o) x += v; }
  const float excl = x - (e0 + e1); c0 = excl + e0; c1 = excl + e0 + e1;
}
__device__ __forceinline__ int ssd_chunk_j0(int cidx) { return cidx < 2 ? cidx * 128 : CTXL + (cidx - 2) * 128; }

__device__ __forceinline__ void ssd1_item(int item, const bf16_t* XBC, const float* DT, const float* cw, const float* cb, const float* dt_bias, const float* a_log,
                                          float* YIN, float* ST, float* DEC, char* lds) {
  bf16_t (*Cm)[72] = (bf16_t (*)[72])lds; bf16_t (*Bm)[72] = (bf16_t (*)[72])(lds + 18432);
  bf16_t (*BT)[136] = (bf16_t (*)[136])(lds + 36864); bf16_t (*Xt)[136] = (bf16_t (*)[136])(lds + 54272); bf16_t (*Mm)[136] = (bf16_t (*)[136])(lds + 71680);
  float* tab = (float*)(lds + 106496); float* dtf = tab; float* dtb = tab + 128; float* acf = tab + 256; float* acb = tab + 384; float* wf = tab + 512; float* wb = tab + 640;
  const int tid = TIDX, lane = tid & 63, w = tid >> 6, l15 = lane & 15, l4 = lane >> 4;
  const int h = item % 6, bc = item / 6, cidx = bc % 34, b = bc / 34, g = h / 3, j0 = ssd_chunk_j0(cidx);
  const size_t r0 = (size_t)b * TPB + j0;
#pragma unroll 2
  for (int i = 0; i < 6; ++i) { const int task = tid + NT * i, t = task / 24, cg = task % 24, kind = cg >> 3, q = cg & 7, j = j0 + t;
    const int c0 = kind == 0 ? h * 64 + 8 * q : (kind == 1 ? 384 + g * 64 + 8 * q : 512 + g * 64 + 8 * q);
    float o[8]; ssd_conv8(XBC, r0 + t, c0, j != 0 && j != CTXL, j != CTXL - 1 && j != TPB - 1, cw, cb, o);
    if (kind == 0) {
#pragma unroll
      for (int e = 0; e < 8; ++e) Xt[8 * q + e][t] = (bf16_t)f2bf(o[e]);
    } else { const u32x4 pk = (u32x4){pk2bf(o[0], o[1]), pk2bf(o[2], o[3]), pk2bf(o[4], o[5]), pk2bf(o[6], o[7])};
      if (kind == 1) { *(u32x4*)&Bm[t][8 * q] = pk;
#pragma unroll
        for (int e = 0; e < 8; ++e) BT[8 * q + e][t] = (bf16_t)f2bf(o[e]); }
      else *(u32x4*)&Cm[t][8 * q] = pk; } }
  if (w < 2) { const int dir = w; const float a = -expf(a_log[dir * 6 + h]), bias = dt_bias[dir * 6 + h];
    const int t0 = dir == 0 ? 2 * lane : 127 - 2 * lane, t1 = dir == 0 ? 2 * lane + 1 : 126 - 2 * lane;
    const float d0 = softplusf(DT[(r0 + t0) * 12 + dir * 6 + h] + bias), d1 = softplusf(DT[(r0 + t1) * 12 + dir * 6 + h] + bias);
    float c0, c1; wave_scan128(d0 * a, d1 * a, lane, c0, c1);
    const float tot = __shfl(c1, 63);
    float* dtt = dir == 0 ? dtf : dtb; float* ac = dir == 0 ? acf : acb; float* ww = dir == 0 ? wf : wb;
    dtt[t0] = d0; dtt[t1] = d1; ac[t0] = c0; ac[t1] = c1; ww[t0] = __expf(tot - c0) * d0; ww[t1] = __expf(tot - c1) * d1;
    if (lane == 0) DEC[(((size_t)b * 34 + cidx) * 2 + dir) * 6 + h] = __expf(tot); }
  __syncthreads();
  {
    f32x4 accG[8];
#pragma unroll
    for (int ni = 0; ni < 8; ++ni) accG[ni] = (f32x4){0.f, 0.f, 0.f, 0.f};
#pragma unroll
    for (int kk = 0; kk < 2; ++kk) { const bf16x8 a = *(const bf16x8*)&Cm[16 * w + l15][32 * kk + 8 * l4];
#pragma unroll
      for (int ni = 0; ni < 8; ++ni) { const bf16x8 bb = *(const bf16x8*)&Bm[16 * ni + l15][32 * kk + 8 * l4]; accG[ni] = __builtin_amdgcn_mfma_f32_16x16x32_bf16(a, bb, accG[ni], 0, 0, 0); } }
    float aft[4], abt[4];
#pragma unroll
    for (int rg = 0; rg < 4; ++rg) { aft[rg] = acf[16 * w + 4 * l4 + rg]; abt[rg] = acb[16 * w + 4 * l4 + rg]; }
#pragma unroll
    for (int ni = 0; ni < 8; ++ni) { const int sidx = 16 * ni + l15; const float afs = acf[sidx], abs_ = acb[sidx], dfs = dtf[sidx], dbs = dtb[sidx];
#pragma unroll
      for (int rg = 0; rg < 4; ++rg) { const int t = 16 * w + 4 * l4 + rg;
        const float f = sidx <= t ? __expf(aft[rg] - afs) * dfs : 0.f, bk = sidx >= t ? __expf(abt[rg] - abs_) * dbs : 0.f;
        Mm[t][sidx] = (bf16_t)f2bf(accG[ni][rg] * (f + bk)); } }
  }
  __syncthreads();
  {
    f32x4 acc[4];
#pragma unroll
    for (int ni = 0; ni < 4; ++ni) acc[ni] = (f32x4){0.f, 0.f, 0.f, 0.f};
#pragma unroll
    for (int kk = 0; kk < 4; ++kk) { const bf16x8 a = *(const bf16x8*)&Mm[16 * w + l15][32 * kk + 8 * l4];
#pragma unroll
      for (int ni = 0; ni < 4; ++ni) { const bf16x8 bb = *(const bf16x8*)&Xt[16 * ni + l15][32 * kk + 8 * l4]; acc[ni] = __builtin_amdgcn_mfma_f32_16x16x32_bf16(a, bb, acc[ni], 0, 0, 0); } }
#pragma unroll
    for (int rg = 0; rg < 4; ++rg)
#pragma unroll
      for (int ni = 0; ni < 4; ++ni) YIN[(r0 + 16 * w + 4 * l4 + rg) * 384 + h * 64 + 16 * ni + l15] = acc[ni][rg];
  }
  {
    const int dir = w >> 2, mt = w & 3; const float* ww = dir == 0 ? wf : wb;
    f32x4 acc[4];
#pragma unroll
    for (int ni = 0; ni < 4; ++ni) acc[ni] = (f32x4){0.f, 0.f, 0.f, 0.f};
#pragma unroll
    for (int kk = 0; kk < 4; ++kk) { const bf16x8 raw = *(const bf16x8*)&Xt[16 * mt + l15][32 * kk + 8 * l4];
      const f32x4 w0 = *(const f32x4*)(ww + 32 * kk + 8 * l4), w1 = *(const f32x4*)(ww + 32 * kk + 8 * l4 + 4);
      u32x4 pk; pk.x = pk2bf(bf2f((bf16_t)raw[0]) * w0.x, bf2f((bf16_t)raw[1]) * w0.y); pk.y = pk2bf(bf2f((bf16_t)raw[2]) * w0.z, bf2f((bf16_t)raw[3]) * w0.w);
      pk.z = pk2bf(bf2f((bf16_t)raw[4]) * w1.x, bf2f((bf16_t)raw[5]) * w1.y); pk.w = pk2bf(bf2f((bf16_t)raw[6]) * w1.z, bf2f((bf16_t)raw[7]) * w1.w);
      const bf16x8 a = __builtin_bit_cast(bf16x8, pk);
#pragma unroll
      for (int ni = 0; ni < 4; ++ni) { const bf16x8 bb = *(const bf16x8*)&BT[16 * ni + l15][32 * kk + 8 * l4]; acc[ni] = __builtin_amdgcn_mfma_f32_16x16x32_bf16(a, bb, acc[ni], 0, 0, 0); } }
    float* sp = ST + ((((size_t)b * 34 + cidx) * 2 + dir) * 6 + h) * 4096;
#pragma unroll
    for (int rg = 0; rg < 4; ++rg)
#pragma unroll
      for (int ni = 0; ni < 4; ++ni) sp[(16 * mt + 4 * l4 + rg) * 64 + 16 * ni + l15] = acc[ni][rg];
  }
  __syncthreads();
}

__device__ __forceinline__ void st_ssd_scan2(float* ST, const float* DEC) {
  for (int idx = BIDX * NT + TIDX; idx < 4 * 2 * 6 * 4096; idx += GDIM * NT) {
    const int e = idx & 4095, bdh = idx >> 12, h = bdh % 6, dir = (bdh / 6) & 1, b = bdh / 12;
    float v[34], d[34];
#pragma unroll
    for (int st = 0; st < 34; ++st) { const int cidx = dir == 0 ? st : (st < 2 ? 1 - st : 35 - st); const size_t o = (((size_t)b * 34 + cidx) * 2 + dir) * 6 + h; v[st] = ST[o * 4096 + e]; d[st] = DEC[o]; }
    float H = 0.f;
#pragma unroll
    for (int st = 0; st < 34; ++st) { const int cidx = dir == 0 ? st : (st < 2 ? 1 - st : 35 - st); const size_t o = (((size_t)b * 34 + cidx) * 2 + dir) * 6 + h; ST[o * 4096 + e] = H; H = H * d[st] + v[st]; }
  }
}

__device__ __forceinline__ void ssd3_item(int b, int cidx, int g, const bf16_t* XBC, const bf16_t* VZ, const float* DT, const float* cw, const float* cb, const float* dt_bias, const float* a_log,
                                          const float* dskip, const float* nw, const float* YIN, const float* ST, bf16_t* MIX, char* lds) {
  bf16_t (*Cm)[72] = (bf16_t (*)[72])lds; bf16_t (*Hm)[72] = (bf16_t (*)[72])(lds + 18432);
  float* ef = (float*)(lds + 18432 + 55296);
  float (*Yt)[196] = (float (*)[196])lds;
  const int tid = TIDX, lane = tid & 63, w = tid >> 6, l15 = lane & 15, l4 = lane >> 4, j0 = ssd_chunk_j0(cidx);
  const size_t r0 = (size_t)b * TPB + j0;
#pragma unroll
  for (int i = 0; i < 2; ++i) { const int task = tid + NT * i, t = task >> 3, q = task & 7, j = j0 + t;
    float o[8]; ssd_conv8(XBC, r0 + t, 512 + g * 64 + 8 * q, j != 0 && j != CTXL, j != CTXL - 1 && j != TPB - 1, cw, cb, o);
    *(u32x4*)&Cm[t][8 * q] = (u32x4){pk2bf(o[0], o[1]), pk2bf(o[2], o[3]), pk2bf(o[4], o[5]), pk2bf(o[6], o[7])}; }
#pragma unroll 4
  for (int i = 0; i < 12; ++i) { const int f4 = tid + NT * i, hd = f4 >> 10, rem = f4 & 1023, p = rem >> 4, n4 = (rem & 15) * 4, hh = hd >> 1, dir = hd & 1;
    const f32x4 v = *(const f32x4*)(ST + ((((size_t)b * 34 + cidx) * 2 + dir) * 6 + 3 * g + hh) * 4096 + p * 64 + n4);
    *(u32x2*)&Hm[hd * 64 + p][n4] = (u32x2){pk2bf(v.x, v.y), pk2bf(v.z, v.w)}; }
  if (w < 6) { const int hh = w >> 1, dir = w & 1, h = 3 * g + hh; const float a = -expf(a_log[dir * 6 + h]), bias = dt_bias[dir * 6 + h];
    const int t0 = dir == 0 ? 2 * lane : 127 - 2 * lane, t1 = dir == 0 ? 2 * lane + 1 : 126 - 2 * lane;
    const float d0 = softplusf(DT[(r0 + t0) * 12 + dir * 6 + h] + bias), d1 = softplusf(DT[(r0 + t1) * 12 + dir * 6 + h] + bias);
    float c0, c1; wave_scan128(d0 * a, d1 * a, lane, c0, c1);
    ef[w * 128 + t0] = __expf(c0); ef[w * 128 + t1] = __expf(c1); }
  __syncthreads();
  float yv[3][4][4];
  {
    bf16x8 ca[2];
#pragma unroll
    for (int kk = 0; kk < 2; ++kk) ca[kk] = *(const bf16x8*)&Cm[16 * w + l15][32 * kk + 8 * l4];
#pragma unroll
    for (int hh = 0; hh < 3; ++hh) {
      f32x4 accF[4], accB[4];
#pragma unroll
      for (int ni = 0; ni < 4; ++ni) { accF[ni] = (f32x4){0.f, 0.f, 0.f, 0.f}; accB[ni] = (f32x4){0.f, 0.f, 0.f, 0.f}; }
#pragma unroll
      for (int kk = 0; kk < 2; ++kk)
#pragma unroll
        for (int ni = 0; ni < 4; ++ni) {
          accF[ni] = __builtin_amdgcn_mfma_f32_16x16x32_bf16(ca[kk], *(const bf16x8*)&Hm[(hh * 2 + 0) * 64 + 16 * ni + l15][32 * kk + 8 * l4], accF[ni], 0, 0, 0);
          accB[ni] = __builtin_amdgcn_mfma_f32_16x16x32_bf16(ca[kk], *(const bf16x8*)&Hm[(hh * 2 + 1) * 64 + 16 * ni + l15][32 * kk + 8 * l4], accB[ni], 0, 0, 0); }
#pragma unroll
      for (int rg = 0; rg < 4; ++rg) { const int t = 16 * w + 4 * l4 + rg; const float eF = ef[(hh * 2 + 0) * 128 + t], eB = ef[(hh * 2 + 1) * 128 + t];
#pragma unroll
        for (int ni = 0; ni < 4; ++ni) yv[hh][ni][rg] = eF * accF[ni][rg] + eB * accB[ni][rg]; }
    }
  }
  __syncthreads();
#pragma unroll
  for (int hh = 0; hh < 3; ++hh)
#pragma unroll
    for (int rg = 0; rg < 4; ++rg)
#pragma unroll
      for (int ni = 0; ni < 4; ++ni) Yt[16 * w + 4 * l4 + rg][hh * 64 + 16 * ni + l15] = yv[hh][ni][rg];
  __syncthreads();
  float cw0[3], cw1[3], cw2[3], cbv[3], nwv[3], dsk[3];
#pragma unroll
  for (int k = 0; k < 3; ++k) { const int col = g * 192 + 64 * k + lane; cw0[k] = cw[col]; cw1[k] = cw[640 + col]; cw2[k] = cw[1280 + col]; cbv[k] = cb[col]; nwv[k] = nw[col]; dsk[k] = dskip[3 * g + k]; }
#pragma unroll 2
  for (int rr = 0; rr < 16; ++rr) { const int t = 16 * w + rr, j = j0 + t; const size_t r = r0 + t; const bool hasp = j != 0 && j != CTXL, hasn = j != CTXL - 1 && j != TPB - 1;
    const bf16_t* xp = XBC + r * 768 + g * 192 + lane; const float* yp = YIN + r * 384 + g * 192 + lane; const bf16_t* zp = VZ + r * 512 + 128 + g * 192 + lane;
    float gt[3]; float ss = 0.f;
#pragma unroll
    for (int k = 0; k < 3; ++k) { float xv = cw1[k] * bf2f(xp[64 * k]) + cbv[k];
      if (hasp) xv += cw0[k] * bf2f(xp[64 * k - 768]);
      if (hasn) xv += cw2[k] * bf2f(xp[64 * k + 768]);
      xv = siluf(xv);
      const float y = yp[64 * k] + Yt[t][64 * k + lane] + dsk[k] * xv;
      gt[k] = y * siluf(bf2f(zp[64 * k])); ss += gt[k] * gt[k]; }
    const float rstd = rsqrtf(wave_sum(ss) * (1.0f / 192.0f) + EPS);
    bf16_t* op = MIX + r * DM + 384 + g * 192 + lane;
#pragma unroll
    for (int k = 0; k < 3; ++k) op[64 * k] = (bf16_t)f2bf(gt[k] * rstd * nwv[k]); }
  __syncthreads();
}

__device__ __forceinline__ void st_router(const float* xl, const float* xc, const float* g, const float* modv_layer, const float* w_router, const float* rbias,
                                          bf16_t* H2, int* ctl, int* tok_pair, float* tok_w, int skip_ctx, char* lds) {
  float* wl = (float*)lds;
  const int tid = TIDX, lane = tid & 63, gw = BIDX * 8 + (tid >> 6), ngw = GDIM * 8;
  for (int idx = tid; idx < 4096; idx += NT) { const int k = idx >> 2, e4 = idx & 3, row = ((k & 3) * 4 + (k >> 8)) * 64 + ((k & 255) >> 2);
    *(f32x4*)(wl + row * 20 + 4 * e4) = *(const f32x4*)(w_router + (size_t)k * 16 + 4 * e4); }
  __syncthreads();
  for (int r = gw; r < MTOK; r += ngw) {
    if (skip_ctx && (r % TPB) < CTXL) continue;
    const float* xr = xrow(xl, xc, r); const float* mv = modv_layer + (size_t)mrow_of(r) * 6144;
    f32x4 v[4]; float ss = 0.f;
#pragma unroll
    for (int j = 0; j < 4; ++j) { v[j] = *(const f32x4*)(xr + 4 * lane + 256 * j); ss += v[j].x * v[j].x + v[j].y * v[j].y + v[j].z * v[j].z + v[j].w * v[j].w; }
    const float rstd = rsqrtf(wave_sum(ss) * (1.0f / DM) + EPS);
    float lg[16];
#pragma unroll
    for (int e = 0; e < 16; ++e) lg[e] = 0.f;
#pragma unroll
    for (int j = 0; j < 4; ++j) { const int k = 4 * lane + 256 * j;
      const f32x4 gg = *(const f32x4*)(g + k), sh = *(const f32x4*)(mv + 3072 + k), sc = *(const f32x4*)(mv + 4096 + k);
      float o[4]; o[0] = v[j].x * rstd * gg.x * (1.f + sc.x) + sh.x; o[1] = v[j].y * rstd * gg.y * (1.f + sc.y) + sh.y;
      o[2] = v[j].z * rstd * gg.z * (1.f + sc.z) + sh.z; o[3] = v[j].w * rstd * gg.w * (1.f + sc.w) + sh.w;
      u32x2 wpk; wpk.x = pk2bf(o[0], o[1]); wpk.y = pk2bf(o[2], o[3]);
      *(u32x2*)(H2 + (size_t)r * DM + k) = wpk;
#pragma unroll
      for (int q = 0; q < 4; ++q) { const float* wr_ = wl + ((q * 4 + j) * 64 + lane) * 20;
#pragma unroll
        for (int e4 = 0; e4 < 4; ++e4) { const f32x4 wr = *(const f32x4*)(wr_ + 4 * e4);
          lg[4 * e4] += o[q] * wr.x; lg[4 * e4 + 1] += o[q] * wr.y; lg[4 * e4 + 2] += o[q] * wr.z; lg[4 * e4 + 3] += o[q] * wr.w; } } }
    float h8[8], h4[4], h2[2], h1;
#pragma unroll
    for (int i = 0; i < 8; ++i) { const bool up = (lane & 32) != 0; const float keep = up ? lg[8 + i] : lg[i], give = up ? lg[i] : lg[8 + i]; h8[i] = keep + __shfl_xor(give, 32); }
#pragma unroll
    for (int i = 0; i < 4; ++i) { const bool up = (lane & 16) != 0; const float keep = up ? h8[4 + i] : h8[i], give = up ? h8[i] : h8[4 + i]; h4[i] = keep + __shfl_xor(give, 16); }
#pragma unroll
    for (int i = 0; i < 2; ++i) { const bool up = (lane & 8) != 0; const float keep = up ? h4[2 + i] : h4[i], give = up ? h4[i] : h4[2 + i]; h2[i] = keep + __shfl_xor(give, 8); }
    { const bool up = (lane & 4) != 0; const float keep = up ? h2[1] : h2[0], give = up ? h2[0] : h2[1]; h1 = keep + __shfl_xor(give, 4); }
    h1 += __shfl_xor(h1, 2); h1 += __shfl_xor(h1, 1);
#pragma unroll
    for (int e = 0; e < 16; ++e) lg[e] = __shfl(h1, ((e >> 3) & 1) * 32 + ((e >> 2) & 1) * 16 + ((e >> 1) & 1) * 8 + (e & 1) * 4);
    if (lane == 0) {
      int best = 0, bi1 = 0, bi2 = 1; float bestv = -1e30f, bs1 = 0.f, bs2 = 0.f;
#pragma unroll
      for (int gq = 0; gq < 4; ++gq) { float m1 = -1e30f, m2 = -1e30f, s1 = 0.f, s2 = 0.f; int i1 = 0, i2 = 0;
#pragma unroll
        for (int i = 0; i < 4; ++i) { const float scv = 1.0f / (1.0f + expf(-lg[4 * gq + i])); const float sv = scv + rbias[4 * gq + i];
          if (sv > m1) { m2 = m1; s2 = s1; i2 = i1; m1 = sv; s1 = scv; i1 = i; } else if (sv > m2) { m2 = sv; s2 = scv; i2 = i; } }
        if (m1 + m2 > bestv) { bestv = m1 + m2; best = gq; bi1 = i1; bi2 = i2; bs1 = s1; bs2 = s2; } }
      const int ia = bi1 < bi2 ? bi1 : bi2, ib = bi1 < bi2 ? bi2 : bi1;
      const int tri = ia == 0 ? ib - 1 : (ia == 1 ? ib + 1 : 5);
      const int pidx = best * 6 + tri;
      const float sa = bi1 < bi2 ? bs1 : bs2, sb = bi1 < bi2 ? bs2 : bs1, inv = 1.0f / (sa + sb);
      tok_pair[r] = pidx; tok_w[2 * r] = sa * inv; tok_w[2 * r + 1] = sb * inv;
      atomicAdd(&ctl[CT_CNT + pidx], 1);
    }
  }
  __syncthreads();
}
__device__ __forceinline__ void st_moe_gather(const bf16_t* H2, bf16_t* H2S, int* ctl, const int* tok_pair, const float* tok_w, int* sorted_tok, float* sorted_w, int skip_ctx, char* lds) {
  int* sbase = (int*)lds;
  const int tid = TIDX, bid = BIDX;
  if (tid == 0) { int base = 0, nt = 0;
#pragma unroll 1
    for (int p = 0; p < 24; ++p) { sbase[p] = base; const int n = ctl[CT_CNT + p], tl = (n + 255) >> 8;
      if (bid == 0) { ctl[CT_BASE + p] = base; for (int t = 0; t < tl; ++t) ctl[CT_TP + nt + t] = p; }
      nt += tl; base += tl * 256; }
    if (bid == 0) { ctl[CT_BASE + 24] = base; ctl[CT_NT] = nt; } }
  __syncthreads();
  const int lane = tid & 63, gw = bid * 8 + (tid >> 6), ngw = GDIM * 8;
  for (int r = gw; r < MTOK; r += ngw) {
    if (skip_ctx && (r % TPB) < CTXL) continue;
    const int p = tok_pair[r]; int slot = 0;
    if (lane == 0) { slot = sbase[p] + atomicAdd(&ctl[CT_FILL + p], 1); sorted_tok[slot] = r; sorted_w[2 * slot] = tok_w[2 * r]; sorted_w[2 * slot + 1] = tok_w[2 * r + 1]; }
    slot = __shfl(slot, 0);
    const u32x4* sp = (const u32x4*)(H2 + (size_t)r * DM); u32x4* d = (u32x4*)(H2S + (size_t)slot * DM);
    d[lane] = sp[lane]; d[lane + 64] = sp[lane + 64];
  }
  __syncthreads();
}
__device__ __forceinline__ void st_final(float* xl, const float* g) {
  const int lane = TIDX & 63, gw = BIDX * 8 + (TIDX >> 6), ngw = GDIM * 8;
  for (int r = gw; r < NB * SEQ; r += ngw) {
    float* xr = xl + (size_t)r * DM; f32x4 v[4]; float ss = 0.f;
#pragma unroll
    for (int j = 0; j < 4; ++j) { v[j] = *(const f32x4*)(xr + 4 * lane + 256 * j); ss += v[j].x * v[j].x + v[j].y * v[j].y + v[j].z * v[j].z + v[j].w * v[j].w; }
    const float rstd = rsqrtf(wave_sum(ss) * (1.0f / DM) + EPS);
#pragma unroll
    for (int j = 0; j < 4; ++j) { const int k = 4 * lane + 256 * j; const f32x4 gg = *(const f32x4*)(g + k);
      *(f32x4*)(xr + k) = (f32x4){v[j].x * rstd * gg.x, v[j].y * rstd * gg.y, v[j].z * rstd * gg.z, v[j].w * rstd * gg.w}; }
  }
}

namespace pg8 {
#define PG8_LAS __attribute__((address_space(3)))
typedef unsigned short bf16_t;
typedef short bf16x8 __attribute__((ext_vector_type(8)));
typedef float f32x4 __attribute__((ext_vector_type(4)));
typedef unsigned u32x4 __attribute__((ext_vector_type(4)));
constexpr int BM = 256, BK = 64, HALF = 128, HTB = HALF * BK * 2  , STAGE_BYTES = 8 * HTB, NXCD = 8, WGM = 8;

__host__ __device__ __forceinline__ int lds_byte(int r, int c) { const int st = (r >> 4) * 2 + (c >> 5), rr = r & 15, cc = c & 31, ob = rr * 64 + cc * 2; return st * 1024 + (ob ^ (((ob >> 9) & 1) << 5)); }
__host__ __device__ __forceinline__ void stage_rc(int b, int& R, int& C) { const int st = b / 1024, sb = b % 1024, swz = sb ^ (((sb >> 9) & 1) << 5); R = (st >> 1) * 16 + swz / 64; C = (st & 1) * 32 + (swz % 64) / 2; }
__host__ __device__ __forceinline__ int perm32(int rho) { const int n = rho >> 4, i = rho & 15; return 8 * (i >> 2) + 4 * n + (i & 3); }

struct Unit { int pm, pn, fin; const char* A; const char* B; };
struct Gemm { int K, lda, ldb; };

__device__ __forceinline__ void tile_of(int L, int nM, int nN, int& pm, int& pn) {
    const int nwg = nM * nN; int wgid = L; { const int q = nwg / NXCD, r = nwg % NXCD, xcd = wgid % NXCD, off = wgid / NXCD; wgid = (xcd < r ? xcd * (q + 1) : r * (q + 1) + (xcd - r) * q) + off; }
    const int nig = WGM * nN, gid = wgid / nig, fm = gid * WGM, gsz = (nM - fm) < WGM ? (nM - fm) : WGM;
    pm = fm + ((wgid % nig) % gsz); pn = (wgid % nig) / gsz;
}
__device__ __forceinline__ unsigned cvt_pk_bf16(float lo, float hi) { unsigned r; asm volatile("v_cvt_pk_bf16_f32 %0, %1, %2" : "=v"(r) : "v"(lo), "v"(hi)); return r; }
template <class Epi, class Sched, bool ALIGN_EPI = false, bool SP2 = false>
__device__ __forceinline__ void gemm_phase(PG8_LAS unsigned char* lds, const Gemm g, const Sched& S, const Epi& E) {
    const int tid = opq_v((int)threadIdx.x), wid = __builtin_amdgcn_readfirstlane(tid >> 6), lane = tid & 63, wr = wid >> 2, wc = wid & 3, fr = lane & 15, fq = lane >> 4;
    const int K = g.K, nt = K / BK;
    unsigned voffA[2], voffB[2];
#pragma unroll
    for (int i = 0; i < 2; ++i) { int R, C; stage_rc(tid * 16 + i * 8192, R, C); const int Rb = Epi::PERM ? ((R & ~31) + perm32(R & 31)) : R;
        voffA[i] = (unsigned)(R * g.lda + C) * 2u; voffB[i] = (unsigned)(Rb * g.ldb + C) * 2u; }
    const size_t kstep = (size_t)(BK * 2);
    const size_t hstepA = (size_t)HALF * g.lda * 2, hstepB = (size_t)HALF * g.ldb * 2;
    const unsigned ldsw = (unsigned)wid * 1024u;
    const int aoff = lds_byte(wr * 64 + fr, fq * 8), boff = lds_byte(wc * 32 + fr, fq * 8);
#define PG8_SA(b, h) (((b) * 2 + (h)) * HTB)
#define PG8_SB(b, h) ((4 + (b) * 2 + (h)) * HTB)
#define PG8_STAGE(bufoff, gbase, voff) do { _Pragma("unroll") for (int _i = 0; _i < 2; ++_i) \
        __builtin_amdgcn_global_load_lds((const unsigned*)((const char*)(gbase) + (voff)[_i]), (PG8_LAS unsigned*)(lds + (bufoff) + ldsw + _i * 8192), 16, 0, 0); } while (0)
#define PG8_LDA(dst, b, h) do { _Pragma("unroll") for (int m = 0; m < 4; ++m) _Pragma("unroll") for (int k = 0; k < 2; ++k) dst[m][k] = *(const PG8_LAS bf16x8*)(lds + PG8_SA(b, h) + aoff + m * 2048 + k * 1024); } while (0)
#define PG8_LDB(dst, b, h) do { _Pragma("unroll") for (int n = 0; n < 2; ++n) _Pragma("unroll") for (int k = 0; k < 2; ++k) dst[n][k] = *(const PG8_LAS bf16x8*)(lds + PG8_SB(b, h) + boff + n * 2048 + k * 1024); } while (0)
#define PG8_MMA(ai, bj, At, Bt) do { __builtin_amdgcn_s_setprio(1); _Pragma("unroll") for (int m = 0; m < 4; ++m) _Pragma("unroll") for (int n = 0; n < 2; ++n) _Pragma("unroll") for (int k = 0; k < 2; ++k) \
        acc[ai][bj][m][n] = __builtin_amdgcn_mfma_f32_16x16x32_bf16(Bt[n][k], At[m][k], acc[ai][bj][m][n], 0, 0, 0); __builtin_amdgcn_s_setprio(0); } while (0)
#define PG8_WAIT_V(n) asm volatile("s_waitcnt vmcnt(" #n ")" ::: "memory")
#define PG8_WAIT_L(n) asm volatile("s_waitcnt lgkmcnt(" #n ")" ::: "memory")
#define PG8_BAR __builtin_amdgcn_s_barrier()
#define PG8_SCHED __builtin_amdgcn_sched_barrier(0)
    Unit cur, nxt; int ui = 0;
    if (!S.next(0, cur)) return;
    f32x4 acc[2][2][4][2];
#pragma unroll
    for (int a = 0; a < 2; ++a)
#pragma unroll
        for (int b = 0; b < 2; ++b)
#pragma unroll
            for (int m = 0; m < 4; ++m)
#pragma unroll
                for (int n = 0; n < 2; ++n) acc[a][b][m][n] = (f32x4){0.f, 0.f, 0.f, 0.f};
    bf16x8 At[4][2], B0[2][2], B1[2][2];
    const char* cA = cur.A; const char* cB = cur.B;
    S.a_ready(cur);
    if constexpr (SP2) {
        PG8_STAGE(PG8_SB(0, 0), cB, voffB); PG8_STAGE(PG8_SB(0, 1), cB + hstepB, voffB); PG8_STAGE(PG8_SA(0, 0), cA, voffA); PG8_STAGE(PG8_SA(0, 1), cA + hstepA, voffA);
        if (wr == 1) PG8_BAR;
        PG8_WAIT_V(2); PG8_BAR;
        PG8_STAGE(PG8_SB(1, 0), cB + kstep, voffB); PG8_STAGE(PG8_SA(1, 0), cA + kstep, voffA); PG8_STAGE(PG8_SB(1, 1), cB + hstepB + kstep, voffB);
        PG8_WAIT_V(6); PG8_BAR;
    } else {
        PG8_STAGE(PG8_SB(0, 0), cB, voffB); PG8_STAGE(PG8_SA(0, 0), cA, voffA); PG8_STAGE(PG8_SB(0, 1), cB + hstepB, voffB); PG8_STAGE(PG8_SA(0, 1), cA + hstepA, voffA);
        if (wr == 1) PG8_BAR;
        PG8_WAIT_V(4); PG8_BAR;
        PG8_STAGE(PG8_SB(1, 0), cB + kstep, voffB); PG8_STAGE(PG8_SA(1, 0), cA + kstep, voffA); PG8_STAGE(PG8_SB(1, 1), cB + hstepB + kstep, voffB);
        PG8_WAIT_V(6); PG8_BAR;
    }
    for (;;) {
        const bool has_next = S.next(ui + 1, nxt);
        const char* nA = has_next ? nxt.A : cA; const char* nB = has_next ? nxt.B : cB;
        for (int t = 0; t < nt; t += 2) {
            const bool last = (t == nt - 2);
            const char* a1 = cA + (size_t)(t + 1) * kstep;
            const char* a2 = last ? nA : cA + (size_t)(t + 2) * kstep; const char* b2 = last ? nB : cB + (size_t)(t + 2) * kstep;
            const char* a3 = a2 + kstep; const char* b3 = b2 + kstep;
            if (last && has_next) S.a_ready(nxt);
            if constexpr (SP2) {
            PG8_LDB(B0, 0, 0); PG8_LDB(B1, 0, 1); PG8_SCHED; PG8_LDA(At, 0, 0); PG8_STAGE(PG8_SA(1, 1), a1 + hstepA, voffA);
            PG8_WAIT_V(8); PG8_WAIT_L(0); PG8_BAR; PG8_MMA(0, 0, At, B0); PG8_MMA(0, 1, At, B1); PG8_BAR; PG8_SCHED;
            PG8_LDA(At, 0, 1); PG8_STAGE(PG8_SB(0, 0), b2, voffB); PG8_STAGE(PG8_SB(0, 1), b2 + hstepB, voffB); PG8_STAGE(PG8_SA(0, 0), a2, voffA);
            PG8_WAIT_V(8); PG8_WAIT_L(0); PG8_BAR; PG8_MMA(1, 0, At, B0); PG8_MMA(1, 1, At, B1); PG8_BAR; PG8_SCHED;
            PG8_LDB(B0, 1, 0); PG8_LDB(B1, 1, 1); PG8_SCHED; PG8_LDA(At, 1, 0); PG8_STAGE(PG8_SA(0, 1), a2 + hstepA, voffA);
            PG8_WAIT_V(8); PG8_WAIT_L(0); PG8_BAR; PG8_MMA(0, 0, At, B0); PG8_MMA(0, 1, At, B1); PG8_BAR; PG8_SCHED;
            PG8_LDA(At, 1, 1); PG8_STAGE(PG8_SB(1, 0), b3, voffB); PG8_STAGE(PG8_SB(1, 1), b3 + hstepB, voffB); PG8_STAGE(PG8_SA(1, 0), a3, voffA);
            PG8_WAIT_V(8); PG8_WAIT_L(0); PG8_BAR; PG8_MMA(1, 0, At, B0); PG8_MMA(1, 1, At, B1); PG8_BAR; PG8_SCHED;
            } else {
            PG8_LDB(B0, 0, 0); PG8_SCHED; PG8_LDA(At, 0, 0); PG8_STAGE(PG8_SA(1, 1), a1 + hstepA, voffA);
            PG8_WAIT_L(8); PG8_BAR; PG8_WAIT_L(0); PG8_MMA(0, 0, At, B0); PG8_BAR; PG8_SCHED;
            PG8_LDB(B1, 0, 1); PG8_STAGE(PG8_SB(0, 0), b2, voffB);
            PG8_BAR; PG8_WAIT_L(0); PG8_MMA(0, 1, At, B1); PG8_BAR;
            PG8_LDA(At, 0, 1); PG8_STAGE(PG8_SA(0, 0), a2, voffA);
            PG8_BAR; PG8_WAIT_L(0); PG8_MMA(1, 0, At, B0); PG8_BAR; PG8_SCHED;
            PG8_STAGE(PG8_SB(0, 1), b2 + hstepB, voffB);
            PG8_WAIT_V(6); PG8_BAR; PG8_MMA(1, 1, At, B1); PG8_BAR;
            PG8_LDB(B0, 1, 0); PG8_SCHED; PG8_LDA(At, 1, 0); PG8_STAGE(PG8_SA(0, 1), a2 + hstepA, voffA);
            PG8_WAIT_L(8); PG8_BAR; PG8_WAIT_L(0); PG8_MMA(0, 0, At, B0); PG8_BAR; PG8_SCHED;
            PG8_LDB(B1, 1, 1); PG8_STAGE(PG8_SB(1, 0), b3, voffB);
            PG8_BAR; PG8_WAIT_L(0); PG8_MMA(0, 1, At, B1); PG8_BAR;
            PG8_LDA(At, 1, 1); PG8_STAGE(PG8_SA(1, 0), a3, voffA);
            PG8_BAR; PG8_WAIT_L(0); PG8_MMA(1, 0, At, B0); PG8_BAR; PG8_SCHED;
            PG8_STAGE(PG8_SB(1, 1), b3 + hstepB, voffB);
            PG8_WAIT_V(6); PG8_BAR; PG8_MMA(1, 1, At, B1); PG8_BAR;
            }
        }
        if constexpr (ALIGN_EPI) { if (wr == 0) PG8_BAR; }
        if constexpr (!Epi::AFTER_DRAIN) { if (cur.fin) { E(acc, cur, wr, wc, fr, fq); S.done(cur); } }
        if (!has_next) break;
        if (cur.fin) {
#pragma unroll
        for (int a = 0; a < 2; ++a)
#pragma unroll
            for (int b = 0; b < 2; ++b)
#pragma unroll
                for (int m = 0; m < 4; ++m)
#pragma unroll
                    for (int n = 0; n < 2; ++n) acc[a][b][m][n] = (f32x4){0.f, 0.f, 0.f, 0.f};
        }
        cur = nxt; cA = nA; cB = nB; ++ui;
        if constexpr (ALIGN_EPI) { if (wr == 1) PG8_BAR; }
    }
    PG8_WAIT_V(0);
    if constexpr (!ALIGN_EPI) { if (wr == 0) PG8_BAR; }
    PG8_BAR;
    if constexpr (Epi::AFTER_DRAIN) { E.fused(acc, cur, wr, wc, fr, fq, lds, wid, lane); S.done(cur); }
#undef PG8_SA
#undef PG8_SB
#undef PG8_STAGE
#undef PG8_LDA
#undef PG8_LDB
#undef PG8_MMA
#undef PG8_WAIT_V
#undef PG8_WAIT_L
#undef PG8_BAR
#undef PG8_SCHED
}
}

struct SchedDense {
  int nM, nN, G, c, skip_ctx; const char* A; const char* B; size_t a_tile, b_tile;
  __device__ __forceinline__ bool next(int i, pg8::Unit& u) const {
    const long L = (long)i * G + c; if (L >= (long)nM * nN) return false;
    int pm, pn; pg8::tile_of((int)L, nM, nN, pm, pn); if (skip_ctx) pm = pm + pm / 16 + 1;
    u.pm = pm; u.pn = pn; u.fin = 1; u.A = A + (size_t)pm * a_tile; u.B = B + (size_t)pn * b_tile; return true; }
  __device__ __forceinline__ void a_ready(const pg8::Unit&) const {}
  __device__ __forceinline__ void done(const pg8::Unit&) const {}
};
struct SchedMoe {
  int G, c, mode; const int* ctl; const char* A; size_t a_tile; const char* W;
  __device__ __forceinline__ bool next(int i, pg8::Unit& u) const {
    const int part = mode == 2 ? (i & 1) : 0, iu = mode == 2 ? (i >> 1) : i;
    const long L = (long)iu * G + c; const int ntiles = ctl[CT_NT]; if (L >= (long)ntiles * 4) return false;
    const int pm = (int)(L >> 2), pn = (int)(L & 3); int eA, eB; pair_experts(ctl[CT_TP + pm], eA, eB);
    u.pm = pm; u.pn = pn;
    if (mode == 1) { const int e = pn < 2 ? eA : eB; u.fin = 1; u.A = A + (size_t)pm * a_tile; u.B = W + (size_t)e * (512 * 1024 * 2) + (size_t)(pn & 1) * (256 * 1024 * 2); }
    else { u.fin = part; u.A = A + (size_t)pm * a_tile + part * 512; u.B = W + (size_t)(part ? eB : eA) * (1024 * 256 * 2) + (size_t)pn * (256 * 256 * 2); }
    return true; }
  __device__ __forceinline__ void a_ready(const pg8::Unit&) const {}
  __device__ __forceinline__ void done(const pg8::Unit&) const {}
};
__device__ __forceinline__ unsigned cvt_pk(float lo, float hi) { return pg8::cvt_pk_bf16(lo, hi); }
struct EpiInProj {
  static constexpr bool PERM = true, AFTER_DRAIN = false; bf16_t *QK, *VZ, *XBC, *HY; float* DT;
  __device__ __forceinline__ void operator()(const f32x4 (&acc)[2][2][4][2], const pg8::Unit& u, int wr, int wc, int fr, int fq) const {
    const int pn = u.pn; bf16_t* base; int ldc, coff;
    if (pn < 2) { base = QK; ldc = 512; coff = pn * 256; } else if (pn < 4) { base = VZ; ldc = 512; coff = (pn - 2) * 256; }
    else if (pn < 7) { base = XBC; ldc = 768; coff = (pn - 4) * 256; } else { base = HY; ldc = 768; coff = (pn - 7) * 256; }
    const int row0 = u.pm * 256 + wr * 64 + fr, col0 = coff + wc * 32 + 8 * fq; const bool dtl = (pn == 6 && wc == 0 && fq < 2);
#pragma unroll
    for (int ai = 0; ai < 2; ++ai)
#pragma unroll
      for (int m = 0; m < 4; ++m) { const int row = row0 + ai * 128 + m * 16; bf16_t* rowp = base + (size_t)row * ldc + col0;
#pragma unroll
        for (int bj = 0; bj < 2; ++bj) { const f32x4 v0 = acc[ai][bj][m][0], v1 = acc[ai][bj][m][1];
          u32x4 w; w.x = cvt_pk(v0[0], v0[1]); w.y = cvt_pk(v0[2], v0[3]); w.z = cvt_pk(v1[0], v1[1]); w.w = cvt_pk(v1[2], v1[3]);
          *(u32x4*)(rowp + bj * 128) = w;
          if (bj == 1 && dtl) { float* dp = DT + (size_t)row * 12 + 8 * fq; *(f32x4*)dp = v0; if (fq == 0) *(f32x4*)(dp + 4) = v1; } } }
  }
};
struct EpiOutProj {
  static constexpr bool PERM = false, AFTER_DRAIN = false; const float *xl_src, *xc_src; float *xl_dst, *xc_dst; const float* gate;
  __device__ __forceinline__ void operator()(const f32x4 (&acc)[2][2][4][2], const pg8::Unit& u, int wr, int wc, int fr, int fq) const {
    const int b = u.pm / 17, jt = u.pm - 17 * b; const size_t rbase = jt == 0 ? (size_t)b * CTXL : (size_t)b * SEQ + (jt - 1) * 256;
    const float* xs = (jt == 0 ? xc_src : xl_src) + rbase * DM; float* xd = (jt == 0 ? xc_dst : xl_dst) + rbase * DM; const float* gt = gate + (size_t)(jt == 0 ? 4 : b) * 6144;
    const int col0 = u.pn * 256 + wc * 32 + 4 * fq;
#pragma unroll
    for (int ai = 0; ai < 2; ++ai)
#pragma unroll
      for (int m = 0; m < 4; ++m) { const size_t off = (size_t)(ai * 128 + wr * 64 + m * 16 + fr) * DM + col0;
#pragma unroll
        for (int bj = 0; bj < 2; ++bj)
#pragma unroll
          for (int n = 0; n < 2; ++n) { const int co = bj * 128 + n * 16; const f32x4 g4 = *(const f32x4*)(gt + col0 + co), x4 = *(const f32x4*)(xs + off + co);
            *(f32x4*)(xd + off + co) = x4 + g4 * acc[ai][bj][m][n]; } }
  }
};
struct EpiMoe1 {
  static constexpr bool PERM = true, AFTER_DRAIN = false; bf16_t* ACT; const float* sorted_w;
  __device__ __forceinline__ void operator()(const f32x4 (&acc)[2][2][4][2], const pg8::Unit& u, int wr, int wc, int fr, int fq) const {
    const int half = u.pn >> 1, j0 = (u.pn & 1) * 128 + 16 * wc + 4 * fq;
#pragma unroll
    for (int ai = 0; ai < 2; ++ai)
#pragma unroll
      for (int m = 0; m < 4; ++m) { const int slot = u.pm * 256 + ai * 128 + wr * 64 + m * 16 + fr; const float wt = sorted_w[2 * slot + half];
#pragma unroll
        for (int bj = 0; bj < 2; ++bj) { const f32x4 v0 = acc[ai][bj][m][0], v1 = acc[ai][bj][m][1];
          u32x2 w; w.x = cvt_pk(siluf(v0[0]) * v0[1] * wt, siluf(v0[2]) * v0[3] * wt); w.y = cvt_pk(siluf(v1[0]) * v1[1] * wt, siluf(v1[2]) * v1[3] * wt);
          *(u32x2*)(ACT + (size_t)slot * 512 + half * 256 + j0 + 64 * bj) = w; } }
  }
};
struct EpiMoe2 {
  static constexpr bool PERM = false, AFTER_DRAIN = false; float *xl, *xc; const float* gate; const int* sorted_tok;
  __device__ __forceinline__ void operator()(const f32x4 (&acc)[2][2][4][2], const pg8::Unit& u, int wr, int wc, int fr, int fq) const {
    const int col0 = u.pn * 256 + wc * 32 + 4 * fq;
#pragma unroll
    for (int ai = 0; ai < 2; ++ai)
#pragma unroll
      for (int m = 0; m < 4; ++m) { const int slot = u.pm * 256 + ai * 128 + wr * 64 + m * 16 + fr; const int r = sorted_tok[slot];
        if (r >= 0) { float* xd = xrow(xl, xc, r) + col0; const float* gt = gate + (size_t)mrow_of(r) * 6144 + col0;
#pragma unroll
          for (int bj = 0; bj < 2; ++bj)
#pragma unroll
            for (int n = 0; n < 2; ++n) { const int co = bj * 128 + n * 16; *(f32x4*)(xd + co) = *(const f32x4*)(xd + co) + *(const f32x4*)(gt + co) * acc[ai][bj][m][n]; } }
        asm volatile("" ::: "memory"); }
  }
};

#include <hip/hip_bf16.h>
#include <cmath>
namespace attn_body {
using bf16=__hip_bfloat16;
using bf16x8=__attribute__((ext_vector_type(8)))short;
using s16x4=__attribute__((ext_vector_type(4)))short;
using f32x16=__attribute__((ext_vector_type(16)))float;
using u32x4=__attribute__((ext_vector_type(4)))unsigned;
constexpr int D=64,QP=512,KP=512,VP=512,OP=1024;
constexpr int NW=8,QBLK=32,QB=QBLK*NW,KVBLK=64;
constexpr int ATTN_UNIT_ROWS=QB;
__device__ __forceinline__ int crow(int r,int hi){return (r&3)+8*(r>>2)+4*hi;}
#define SBAR() __builtin_amdgcn_sched_barrier(0)
__device__ __forceinline__ void cmask(f32x16&p0,f32x16&p1,int jb,int qrel,int hi){
  const float NEG=-INFINITY; int kb=64*jb+4*hi;
  #pragma unroll
  for(int r=0;r<16;++r){int kv=kb+(r&3)+8*(r>>2); if(kv>qrel)p0[r]=NEG; if(kv+32>qrel)p1[r]=NEG;}
}

constexpr int NSLOT=3, SLOTB=8192;
constexpr int LDS_K=0, LDS_V=NSLOT*SLOTB, LDS_WS=2*NSLOT*SLOTB, LDS_OST=LDS_WS+NW*64*4, LDS_BYTES=LDS_OST+NW*4096;
constexpr float C2=0.125f*1.4426950408889634f;
__device__ __forceinline__ void glds16(const void*gsrc,unsigned lds_dst){unsigned keep;
  asm volatile("s_mov_b32 %0, m0\n\ts_mov_b32 m0, %2\n\ts_nop 0\n\tglobal_load_lds_dwordx4 %1, off\n\ts_mov_b32 m0, %0":"=&s"(keep):"v"(gsrc),"s"(lds_dst):"memory");}
__device__ __forceinline__ float max3f(float a,float b,float c){float r;asm("v_max3_f32 %0, %1, %2, %3":"=v"(r):"v"(a),"v"(b),"v"(c));return r;}
__device__ __forceinline__ float max2f(float a,float b){float r;asm("v_max_f32_e32 %0, %1, %2":"=v"(r):"v"(a),"v"(b));return r;}
__device__ __forceinline__ float fadd_s(float a,float b){float r;asm("v_add_f32_e32 %0, %1, %2":"=v"(r):"v"(a),"v"(b));return r;}
__device__ __forceinline__ float fsub_s(float a,float b){float r;asm("v_sub_f32_e32 %0, %1, %2":"=v"(r):"v"(a),"v"(b));return r;}
typedef float f32x2_t __attribute__((ext_vector_type(2))); typedef __bf16 bf16x2_t __attribute__((ext_vector_type(2)));
__device__ __forceinline__ unsigned cvtpk_s(float lo,float hi){f32x2_t v={lo,hi};bf16x2_t b=__builtin_convertvector(v,bf16x2_t);return __builtin_bit_cast(unsigned,b);}
#define WAIT_BAR(N) asm volatile("s_waitcnt vmcnt(" #N ") lgkmcnt(0)\n\ts_barrier":::"memory")

__device__ __forceinline__ void qkt(f32x16&p0,f32x16&p1,const char*Kslot,const bf16x8*qr,const f32x16&negm,int r32,int hi){
  const char*kb=Kslot+hi*1024+r32*16;
  #pragma unroll
  for(int d0=0;d0<4;++d0){
    const bf16x8 b0=*reinterpret_cast<const bf16x8*>(kb+d0*2048);
    const bf16x8 b1=*reinterpret_cast<const bf16x8*>(kb+d0*2048+512);
    if(d0==0){p0=__builtin_amdgcn_mfma_f32_32x32x16_bf16(b0,qr[0],negm,0,0,0);p1=__builtin_amdgcn_mfma_f32_32x32x16_bf16(b1,qr[0],negm,0,0,0);}
    else{p0=__builtin_amdgcn_mfma_f32_32x32x16_bf16(b0,qr[d0],p0,0,0,0);p1=__builtin_amdgcn_mfma_f32_32x32x16_bf16(b1,qr[d0],p1,0,0,0);}}
}
typedef __attribute__((address_space(3))) const char* lds_cptr;
typedef short v4i16_t __attribute__((ext_vector_type(4)));
__device__ __forceinline__ void kload8(bf16x8*kf,lds_cptr kp){
  kf[0]=*(const __attribute__((address_space(3))) bf16x8*)(kp);      kf[1]=*(const __attribute__((address_space(3))) bf16x8*)(kp+512);
  kf[2]=*(const __attribute__((address_space(3))) bf16x8*)(kp+2048); kf[3]=*(const __attribute__((address_space(3))) bf16x8*)(kp+2560);
  kf[4]=*(const __attribute__((address_space(3))) bf16x8*)(kp+4096); kf[5]=*(const __attribute__((address_space(3))) bf16x8*)(kp+4608);
  kf[6]=*(const __attribute__((address_space(3))) bf16x8*)(kp+6144); kf[7]=*(const __attribute__((address_space(3))) bf16x8*)(kp+6656);
}
__device__ __forceinline__ void kload2(bf16x8*kf,lds_cptr kp,int j){ kf[2*j]=*(const __attribute__((address_space(3))) bf16x8*)(kp+j*2048); kf[2*j+1]=*(const __attribute__((address_space(3))) bf16x8*)(kp+j*2048+512); }
__device__ __forceinline__ s16x4 vtr(lds_cptr p){ return __builtin_bit_cast(s16x4,__builtin_amdgcn_ds_read_tr16_b64_v4i16((__attribute__((address_space(3))) v4i16_t*)p)); }
__device__ __forceinline__ float rowmax(const f32x16&p0,const f32x16&p1){
  float a=max3f(p0[0],p0[1],p1[0]),b=max3f(p0[2],p0[3],p1[1]);a=max3f(a,p1[2],p1[3]);
  #pragma unroll
  for(int r=4;r<16;r+=4){a=max3f(a,p0[r],p0[r+1]);b=max3f(b,p0[r+2],p0[r+3]);a=max3f(a,p1[r],p1[r+1]);b=max3f(b,p1[r+2],p1[r+3]);}
  const float m=max2f(a,b);
  auto rr=__builtin_amdgcn_permlane32_swap(__float_as_uint(m),__float_as_uint(m),false,false);
  return max2f(__uint_as_float(rr[0]),__uint_as_float(rr[1]));
}
__device__ __forceinline__ void pv(f32x16*o,int vb,bf16x8 pa0,bf16x8 pa1,bf16x8 pa2,bf16x8 pa3){
  #pragma unroll
  for(int d0=0;d0<2;++d0){s16x4 lo[4],hi[4];
    #pragma unroll
    for(int ks=0;ks<4;++ks){
      asm volatile("ds_read_b64_tr_b16 %0,%1 offset:%c2":"=&v"(lo[ks]):"v"(vb),"i"(d0*4096+ks*1024):"memory");
      asm volatile("ds_read_b64_tr_b16 %0,%1 offset:%c2":"=&v"(hi[ks]):"v"(vb),"i"(d0*4096+ks*1024+512):"memory");}
    asm volatile("s_waitcnt lgkmcnt(0)":::"memory");SBAR();
    #define PK(k) (bf16x8){lo[k][0],lo[k][1],lo[k][2],lo[k][3],hi[k][0],hi[k][1],hi[k][2],hi[k][3]}
    o[d0]=__builtin_amdgcn_mfma_f32_32x32x16_bf16(pa0,PK(0),o[d0],0,0,0);
    o[d0]=__builtin_amdgcn_mfma_f32_32x32x16_bf16(pa1,PK(1),o[d0],0,0,0);
    o[d0]=__builtin_amdgcn_mfma_f32_32x32x16_bf16(pa2,PK(2),o[d0],0,0,0);
    o[d0]=__builtin_amdgcn_mfma_f32_32x32x16_bf16(pa3,PK(3),o[d0],0,0,0);
    #undef PK
  }
}

#ifndef ATTN_STORE16
#define ATTN_STORE16(p,v) (*(u32x4*)(p)=(v))
#endif
template<int THRL> __device__ __forceinline__ void attn_unit(const bf16*Qu,const bf16*__restrict__ Kh,const bf16*__restrict__ Vh,bf16*Ou,const int NT,char*shm){
  const int tid=opq_v((int)threadIdx.x),lane=tid&63,r32=lane&31,hi=lane>>5; const int wid=__builtin_amdgcn_readfirstlane(tid>>6);
  const bf16*Qw=Qu+(long)(wid*QBLK)*QP;
  const unsigned lds0=(unsigned)(uintptr_t)shm;
  float*wsf=(float*)(shm+LDS_WS)+wid*64;
  const bf16*ksrc=Kh+(long)lane*KP+wid*8;
  const bf16*vsrc=Vh+(long)(16*(wid&3)+(lane>>2))*VP+(wid>>2)*32+(lane&3)*8;
  const unsigned kdst=lds0+LDS_K+wid*1024, vdst=lds0+LDS_V+wid*1024;
  #define DMA_K(t,slot) glds16(ksrc+(long)(t)*KVBLK*KP,(unsigned)__builtin_amdgcn_readfirstlane(kdst+(slot)))
  #define DMA_V(t,slot) glds16(vsrc+(long)(t)*KVBLK*VP,(unsigned)__builtin_amdgcn_readfirstlane(vdst+(slot)))
  const int vb0=(int)(lds0+LDS_V)+((lane>>4)&1)*32+(lane&3)*8+(4*hi+((lane&15)>>2))*64;
  const char*Kbase=shm+LDS_K; bf16x8 kf[8];
  const lds_cptr shm3=(lds_cptr)shm; const lds_cptr kp0=shm3+LDS_K+hi*1024+r32*16; const lds_cptr vp0=shm3+LDS_V+((lane>>4)&1)*32+(lane&3)*8+(4*hi+((lane&15)>>2))*64;
  DMA_K(0,0);DMA_V(0,0);DMA_K(1,SLOTB);
  bf16x8 qr[4];
  #pragma unroll
  for(int d0=0;d0<4;++d0)qr[d0]=*reinterpret_cast<const bf16x8*>(&Qw[(long)r32*QP+d0*16+hi*8]);
  float mhat=0.f,l_reg=0.f;f32x16 o[2];o[0]=f32x16{};o[1]=f32x16{};f32x16 negm=f32x16{};asm volatile("":"+v"(negm));
  #define CMASK(P0,P1,t) do{}while(0)
  bool resc=false;
  #define START(P0,P1) do{ const float rm=rowmax(P0,P1); resc=false; \
    { const float dl=rm; mhat=fadd_s(mhat,dl); \
      _Pragma("unroll") for(int r=0;r<16;++r){P0[r]=fsub_s(P0[r],dl);P1[r]=fsub_s(P1[r],dl);} \
      _Pragma("unroll") for(int r=0;r<16;++r)negm[r]=-mhat; asm volatile("":"+v"(negm)); } \
    _Pragma("unroll") for(int r=0;r<16;++r)P0[r]=__builtin_amdgcn_exp2f(P0[r]); }while(0)
  #define RESC() do{ if(resc){ asm volatile("s_waitcnt lgkmcnt(0)":::"memory"); \
      _Pragma("unroll") for(int d_=0;d_<2;++d_) _Pragma("unroll") for(int r=0;r<16;++r)o[d_][r]*=wsf[crow(r,hi)]; } }while(0)
  f32x16 pA0,pA1,pB0,pB1;
  int sl_prev=0,sl_cur=0,sl_next=SLOTB;
  #define ROT() do{sl_prev=sl_cur;sl_cur=sl_next;sl_next=(sl_next==(NSLOT-1)*SLOTB)?0:sl_next+SLOTB;}while(0)
  DMA_K(2,2*SLOTB);
  WAIT_BAR(3);
  qkt(pA0,pA1,Kbase,qr,negm,r32,hi);asm volatile("s_nop 15\n\ts_nop 7":"+v"(pA0),"+v"(pA1));CMASK(pA0,pA1,0);
  START(pA0,pA1);
  _Pragma("unroll") for(int r=0;r<16;++r)pA1[r]=__builtin_amdgcn_exp2f(pA1[r]);
  WAIT_BAR(0);
  DMA_K(3,0);DMA_V(1,SLOTB);
  ROT();
  kload8(kf,kp0+sl_cur);
  WAIT_BAR(2);
  s16x4 vlo[8],vhi[8]; u32x4 pw0,pw1,pw2,pw3;
  #define PKW(P,B) cvtpk_s(P[B],P[B+1])
  #define PAF(k) __builtin_bit_cast(bf16x8,pw##k)
  #define VFR(i) (bf16x8){vlo[i][0],vlo[i][1],vlo[i][2],vlo[i][3],vhi[i][0],vhi[i][1],vhi[i][2],vhi[i][3]}
  #define PIN(x) asm volatile("":"+v"(x))
  #define MX3(a,b,c) __builtin_fmaxf(__builtin_fmaxf((a),(b)),(c))
  #define GAPA(MF,A0,A1,A2,A3,W0,W1,PW) do{ MF; sacc+=A0; sacc+=A1; sacc+=A2; sacc+=A3; PIN(sacc); W0; W1; PIN(PW); SBAR(); }while(0)
  #define EX(v) __builtin_amdgcn_exp2f(v)
  #define GAPB(MF,X,B) do{ MF; X[B]=EX(X[B]); X[B+1]=EX(X[B+1]); X[B+2]=EX(X[B+2]); X[B+3]=EX(X[B+3]); PIN(X); SBAR(); }while(0)
  #define VRD(i) do{ vlo[i]=vtr(vp_+(((i)>>2)*4096+((i)&3)*1024)); vhi[i]=vtr(vp_+(((i)>>2)*4096+((i)&3)*1024+512)); }while(0)
  #define KRD(G,j) do{ if(G){ kload2(kf,kp0+sl_next,j); SBAR(); } }while(0)
  #define STEP(C0,C1,P0,P1,t,GK,GV,GL) do{ SBAR(); \
    const lds_cptr vp_=vp0+sl_prev; \
    VRD(0); SBAR(); float sacc=(P0[0]+P0[1]); \
    GAPA(C0=__builtin_amdgcn_mfma_f32_32x32x16_bf16(kf[0],qr[0],negm,0,0,0), P0[2],P0[3],P0[4],P0[5],     pw0[0]=PKW(P0,0), pw0[1]=PKW(P0,2), pw0); \
    VRD(4); SBAR(); GAPA(C1=__builtin_amdgcn_mfma_f32_32x32x16_bf16(kf[1],qr[0],negm,0,0,0), P0[6],P0[7],P0[8],P0[9],     pw0[2]=PKW(P0,4), pw0[3]=PKW(P0,6), pw0); \
    VRD(1); SBAR(); GAPA(C0=__builtin_amdgcn_mfma_f32_32x32x16_bf16(kf[2],qr[1],C0,0,0,0),   P0[10],P0[11],P0[12],P0[13], pw1[0]=PKW(P0,8), pw1[1]=PKW(P0,10), pw1); \
    VRD(5); SBAR(); GAPA(C1=__builtin_amdgcn_mfma_f32_32x32x16_bf16(kf[3],qr[1],C1,0,0,0),   P0[14],P0[15],P1[0],P1[1],   pw1[2]=PKW(P0,12),pw1[3]=PKW(P0,14), pw1); \
    VRD(2); SBAR(); GAPA(C0=__builtin_amdgcn_mfma_f32_32x32x16_bf16(kf[4],qr[2],C0,0,0,0),   P1[2],P1[3],P1[4],P1[5],     pw2[0]=PKW(P1,0), pw2[1]=PKW(P1,2), pw2); \
    VRD(6); SBAR(); GAPA(C1=__builtin_amdgcn_mfma_f32_32x32x16_bf16(kf[5],qr[2],C1,0,0,0),   P1[6],P1[7],P1[8],P1[9],     pw2[2]=PKW(P1,4), pw2[3]=PKW(P1,6), pw2); \
    VRD(3); SBAR(); GAPA(C0=__builtin_amdgcn_mfma_f32_32x32x16_bf16(kf[6],qr[3],C0,0,0,0),   P1[10],P1[11],P1[12],P1[13], pw3[0]=PKW(P1,8), pw3[1]=PKW(P1,10), pw3); \
    VRD(7); SBAR(); GAPA(C1=__builtin_amdgcn_mfma_f32_32x32x16_bf16(kf[7],qr[3],C1,0,0,0),   P1[14],P1[15],0.f,0.f,       pw3[2]=PKW(P1,12),pw3[3]=PKW(P1,14), pw3); \
    l_reg+=sacc; \
    if(GK){DMA_K((t)+3,sl_cur);} if(GV){DMA_V((t)+1,sl_next);} \
    CMASK(C0,C1,t); \
    { float a=MX3(C0[0],C0[1],C1[0]),b=MX3(C0[2],C0[3],C1[1]); a=MX3(a,C1[2],C1[3]); \
      _Pragma("unroll") for(int r=4;r<16;r+=4){a=MX3(a,C0[r],C0[r+1]);b=MX3(b,C0[r+2],C0[r+3]);a=MX3(a,C1[r],C1[r+1]);b=MX3(b,C1[r+2],C1[r+3]);} \
      float rm=__builtin_fmaxf(a,b); { auto rr=__builtin_amdgcn_permlane32_swap(__float_as_uint(rm),__float_as_uint(rm),false,false); rm=__builtin_fmaxf(__uint_as_float(rr[0]),__uint_as_float(rr[1])); } \
      resc=false; \
      if(__builtin_expect(__any(rm>(float)THRL),0)){ const float dl=__builtin_fmaxf(rm,0.f); mhat+=dl; \
        _Pragma("unroll") for(int r=0;r<16;++r){C0[r]-=dl;C1[r]-=dl;} \
        _Pragma("unroll") for(int r=0;r<16;++r)negm[r]=-mhat; asm volatile("":"+v"(negm)); \
        const float f=__builtin_amdgcn_exp2f(-dl); l_reg*=f; if(hi==0)wsf[r32]=f; resc=true; } } \
    SBAR(); \
    GAPB(o[0]=__builtin_amdgcn_mfma_f32_32x32x16_bf16(PAF(0),VFR(0),o[0],0,0,0), C0,0); \
    GAPB(o[1]=__builtin_amdgcn_mfma_f32_32x32x16_bf16(PAF(0),VFR(4),o[1],0,0,0), C0,4); \
    KRD(GL,0); GAPB(o[0]=__builtin_amdgcn_mfma_f32_32x32x16_bf16(PAF(1),VFR(1),o[0],0,0,0), C0,8); \
    KRD(GL,1); GAPB(o[1]=__builtin_amdgcn_mfma_f32_32x32x16_bf16(PAF(1),VFR(5),o[1],0,0,0), C0,12); \
    KRD(GL,2); GAPB(o[0]=__builtin_amdgcn_mfma_f32_32x32x16_bf16(PAF(2),VFR(2),o[0],0,0,0), C1,0); \
    KRD(GL,3); GAPB(o[1]=__builtin_amdgcn_mfma_f32_32x32x16_bf16(PAF(2),VFR(6),o[1],0,0,0), C1,4); \
    GAPB(o[0]=__builtin_amdgcn_mfma_f32_32x32x16_bf16(PAF(3),VFR(3),o[0],0,0,0), C1,8); \
    GAPB(o[1]=__builtin_amdgcn_mfma_f32_32x32x16_bf16(PAF(3),VFR(7),o[1],0,0,0), C1,12); \
    }while(0)
  int t=1;
  for(;t+5<NT;t+=2){
    STEP(pB0,pB1,pA0,pA1,t,true,true,true);     WAIT_BAR(2); RESC(); ROT();
    STEP(pA0,pA1,pB0,pB1,t+1,true,true,true);   WAIT_BAR(2); RESC(); ROT();
  }
  #define ENDW(tt) do{ if((tt)+3<NT){WAIT_BAR(2);} else if((tt)+2<NT){WAIT_BAR(1);} else {WAIT_BAR(0);} }while(0)
  for(;t+1<NT;t+=2){
    STEP(pB0,pB1,pA0,pA1,t,(t+3<NT),(t+1<NT),(t+1<NT));       ENDW(t);   RESC(); ROT();
    STEP(pA0,pA1,pB0,pB1,t+1,(t+4<NT),(t+2<NT),(t+2<NT));     ENDW(t+1); RESC(); ROT();
  }
  STEP(pB0,pB1,pA0,pA1,NT-1,false,false,false); RESC();
  { float sacc=pB0[0]+pB0[1]; _Pragma("unroll") for(int r=2;r<16;++r)sacc+=pB0[r]; _Pragma("unroll") for(int r=0;r<16;++r)sacc+=pB1[r]; l_reg+=sacc;
    pw0=(u32x4){PKW(pB0,0),PKW(pB0,2),PKW(pB0,4),PKW(pB0,6)};pw1=(u32x4){PKW(pB0,8),PKW(pB0,10),PKW(pB0,12),PKW(pB0,14)};pw2=(u32x4){PKW(pB1,0),PKW(pB1,2),PKW(pB1,4),PKW(pB1,6)};pw3=(u32x4){PKW(pB1,8),PKW(pB1,10),PKW(pB1,12),PKW(pB1,14)};
    SBAR(); pv(o,vb0+sl_cur,PAF(0),PAF(1),PAF(2),PAF(3)); }
  #undef PKW
  #undef PAF
  #undef VFR
  #undef PIN
  #undef MX3
  #undef GAPA
  #undef GAPB
  #undef EX
  #undef VRD
  #undef KRD
  #undef STEP
  #undef ENDW
  {auto rr=__builtin_amdgcn_permlane32_swap(__float_as_uint(l_reg),__float_as_uint(l_reg),false,false);l_reg=__uint_as_float(rr[0])+__uint_as_float(rr[1]);}
  if(hi==0)wsf[32+r32]=l_reg;asm volatile("s_waitcnt lgkmcnt(0)":::"memory");
  float rli[16];
  #pragma unroll
  for(int r=0;r<16;++r)rli[r]=__builtin_amdgcn_rcpf(wsf[32+crow(r,hi)]);
  bf16*Ow=Ou+(long)(wid*QBLK)*OP;
  { bf16*stg=(bf16*)(shm+LDS_OST)+wid*2048;
    #pragma unroll
    for(int r=0;r<16;++r){const int orow=crow(r,hi);
      #pragma unroll
      for(int d0=0;d0<2;++d0)stg[orow*64+d0*32+r32]=__float2bfloat16(o[d0][r]*rli[r]);}
    asm volatile("s_waitcnt lgkmcnt(0)":::"memory");
    #pragma unroll
    for(int i=0;i<4;++i){const int row=i*8+(lane>>3),ch=lane&7; const u32x4 v=*(const u32x4*)(stg+row*64+ch*8); ATTN_STORE16(Ow+(long)row*OP+ch*8,v);} }
  asm volatile("s_waitcnt lgkmcnt(0)\n\ts_barrier":::"memory");
  #undef DMA_K
  #undef DMA_V
  #undef CMASK
  #undef START
  #undef RESC
  #undef ROT
}
constexpr int ATTN_LDS_BYTES=LDS_BYTES;
#undef SBAR
#undef WAIT_BAR
}


namespace hyf {
struct c32 { float x, y; };
typedef _Float16 h2 __attribute__((ext_vector_type(2)));
__device__ __forceinline__ c32 operator+(c32 a, c32 b) { return {a.x + b.x, a.y + b.y}; }
__device__ __forceinline__ c32 operator-(c32 a, c32 b) { return {a.x - b.x, a.y - b.y}; }
__device__ __forceinline__ c32 cmul(c32 a, c32 b) { return {a.x * b.x - a.y * b.y, a.x * b.y + a.y * b.x}; }
__device__ __forceinline__ constexpr float C32(int k) {
  switch (k) { case 0: return 1.f; case 1: return 0.98078528f; case 2: return 0.923879533f; case 3: return 0.831469612f; case 4: return 0.707106781f; case 5: return 0.555570233f; case 6: return 0.382683432f;
    case 7: return 0.195090322f; case 8: return 0.f; case 9: return -0.195090322f; case 10: return -0.382683432f; case 11: return -0.555570233f; case 12: return -0.707106781f; case 13: return -0.831469612f;
    case 14: return -0.923879533f; default: return -0.98078528f; } }
__device__ __forceinline__ constexpr float S32(int k) {
  switch (k) { case 0: return 0.f; case 1: return 0.195090322f; case 2: return 0.382683432f; case 3: return 0.555570233f; case 4: return 0.707106781f; case 5: return 0.831469612f; case 6: return 0.923879533f;
    case 7: return 0.98078528f; case 8: return 1.f; case 9: return 0.98078528f; case 10: return 0.923879533f; case 11: return 0.831469612f; case 12: return 0.707106781f; case 13: return 0.555570233f;
    case 14: return 0.382683432f; default: return 0.195090322f; } }
__device__ __forceinline__ constexpr int brev(int q, int bits) {
  return bits == 4 ? (((q & 1) << 3) | ((q & 2) << 1) | ((q & 4) >> 1) | ((q & 8) >> 3))
                   : (((q & 1) << 4) | ((q & 2) << 2) | (q & 4) | ((q & 8) >> 2) | ((q & 16) >> 4)); }
__device__ __forceinline__ int phys(int p) { return p + (p >> 5); }
template <int R, int HALF, bool INV> struct DftStage {
  static __device__ __forceinline__ void run(c32 (&x)[R]) {
#pragma unroll
    for (int blk = 0; blk < R; blk += 2 * HALF) {
#pragma unroll
      for (int j = 0; j < HALF; ++j) {
        const c32 a = x[blk + j], b = x[blk + j + HALF]; x[blk + j] = a + b; const c32 d = a - b;
        const int e = j * (R / (2 * HALF)) * (32 / R);
        if (e == 0) x[blk + j + HALF] = d;
        else if (e == 8) x[blk + j + HALF] = INV ? (c32){-d.y, d.x} : (c32){d.y, -d.x};
        else { const c32 wv = {C32(e), INV ? S32(e) : -S32(e)}; x[blk + j + HALF] = cmul(d, wv); }
      } }
    DftStage<R, HALF / 2, INV>::run(x);
  }
};
template <int R, bool INV> struct DftStage<R, 0, INV> { static __device__ __forceinline__ void run(c32 (&)[R]) {} };
template <int R, bool INV> __device__ __forceinline__ void dft_pow2(c32 (&x)[R]) { DftStage<R, R / 2, INV>::run(x); }
template <int R, int HALF> struct DitStage {
  static __device__ __forceinline__ void run(c32 (&x)[R]) {
#pragma unroll
    for (int blk = 0; blk < R; blk += 2 * HALF) {
#pragma unroll
      for (int j = 0; j < HALF; ++j) {
        const int e = j * (R / (2 * HALF)) * (32 / R);
        const c32 a = x[blk + j], b0 = x[blk + j + HALF];
        c32 b;
        if (e == 0) b = b0; else if (e == 8) b = (c32){-b0.y, b0.x}; else b = cmul(b0, (c32){C32(e), S32(e)});
        x[blk + j] = a + b; x[blk + j + HALF] = a - b;
      } }
    DitStage<R, HALF * 2>::run(x);
  }
};
template <int R> struct DitStage<R, R> { static __device__ __forceinline__ void run(c32 (&)[R]) {} };
template <int R> __device__ __forceinline__ void idft_dit(c32 (&x)[R]) { DitStage<R, 1>::run(x); }
template <int STRIDE, bool INV> __device__ __forceinline__ void pass16(c32* buf, int e0, float rev) {
  float rv = rev; asm volatile("" : "+v"(rv));
  const float cs = __builtin_amdgcn_cosf(rv), sn = __builtin_amdgcn_sinf(rv);
  const c32 w1 = {cs, INV ? sn : -sn};
  c32* p = buf + phys(e0); constexpr int PS = STRIDE + STRIDE / 32;
  c32 x[16];
  if (!INV) {
#pragma unroll
    for (int m = 0; m < 16; ++m) x[m] = p[PS * m];
    dft_pow2<16, false>(x);
    c32 w = w1; p[0] = x[0];
#pragma unroll
    for (int q = 1; q < 16; ++q) { p[PS * q] = cmul(x[brev(q, 4)], w); w = cmul(w, w1); }
  } else {
    c32 w = w1; x[0] = p[0];
#pragma unroll
    for (int q = 1; q < 16; ++q) { x[q] = cmul(p[PS * q], w); w = cmul(w, w1); }
    dft_pow2<16, true>(x);
#pragma unroll
    for (int m = 0; m < 16; ++m) p[PS * m] = x[brev(m, 4)];
  }
}
template <int MODE> __device__ __forceinline__ void mid32(c32* buf, h2* Hs, int j) {
  c32* p = buf + 33 * j; c32 x[32];
#pragma unroll
  for (int m = 0; m < 32; ++m) x[m] = p[m];
  dft_pow2<32, false>(x);
  if (MODE == 0) {
#pragma unroll
    for (int q = 0; q < 32; ++q) { const c32 v = x[brev(q, 5)]; Hs[q * 256 + j] = (h2){(_Float16)v.x, (_Float16)v.y}; }
  } else {
#pragma unroll
    for (int pp = 0; pp < 32; ++pp) { const h2 hv = Hs[brev(pp, 5) * 256 + j]; x[pp] = cmul(x[pp], (c32){(float)hv.x, (float)hv.y}); }
    idft_dit<32>(x);
#pragma unroll
    for (int m = 0; m < 32; ++m) p[m] = x[m];
  }
}
__device__ __forceinline__ void fwd2(c32* buf, int tid) {
  __syncthreads(); pass16<512, false>(buf, tid, (float)tid * (1.0f / 8192.0f));
  __syncthreads(); pass16<32, false>(buf, (tid >> 5) * 512 + (tid & 31), (float)(tid & 31) * (1.0f / 512.0f));
  __syncthreads();
}
__device__ __forceinline__ void conv(c32* buf, h2* Hs, int tid) {
  fwd2(buf, tid);
  if (tid < 256) mid32<1>(buf, Hs, tid);
  __syncthreads(); pass16<32, true>(buf, (tid >> 5) * 512 + (tid & 31), (float)(tid & 31) * (1.0f / 512.0f));
  __syncthreads(); pass16<512, true>(buf, tid, (float)tid * (1.0f / 8192.0f));
  __syncthreads();
}
__device__ __forceinline__ void item(int c, const bf16_t* HYT, const float* HK, const float* hy_bias, bf16_t* HYO, char* lds) {
  c32* buf = (c32*)lds; h2* H0 = (h2*)(lds + 67584); h2* H1 = H0 + 8192;
  const int tid = TIDX;
#pragma unroll 1
  for (int o = 0; o < 2; ++o) {
    const float* kp = HK + ((size_t)o * 256 + c) * 8192;
#pragma unroll
    for (int i = 0; i < 16; ++i) { const int n = tid + 512 * i; buf[phys(n)] = (c32){kp[n], 0.f}; }
    fwd2(buf, tid);
    if (tid < 256) mid32<0>(buf, o ? H1 : H0, tid);
    __syncthreads();
  }
  const float bias0 = hy_bias[c], bias1 = hy_bias[256 + c];
#pragma unroll 1
  for (int pr = 0; pr < 2; ++pr) {
    const bf16_t* v0 = HYT + ((size_t)(2 * pr) * 768 + c) * SEQ; const bf16_t* v1 = v0 + (size_t)768 * SEQ;
    c32 vv[8];
#pragma unroll
    for (int i = 0; i < 8; ++i) { const int t = tid + 512 * i; vv[i] = (c32){bf2f(v0[t]), bf2f(v1[t])}; buf[phys(t)] = vv[i]; buf[phys(t + 4096)] = (c32){0.f, 0.f}; }
    conv(buf, H0, tid);
#pragma unroll
    for (int i = 0; i < 8; ++i) { const int t = tid + 512 * i; const c32 y = buf[phys(t)];
      vv[i] = (c32){bf2f(v0[(size_t)256 * SEQ + t]) * (y.x * (1.0f / 8192.0f) + bias0 * vv[i].x), bf2f(v1[(size_t)256 * SEQ + t]) * (y.y * (1.0f / 8192.0f) + bias0 * vv[i].y)};
      buf[phys(t)] = vv[i]; buf[phys(t + 4096)] = (c32){0.f, 0.f}; }
    conv(buf, H1, tid);
#pragma unroll
    for (int i = 0; i < 8; ++i) { const int t = tid + 512 * i; const c32 y = buf[phys(t)];
      HYO[((size_t)(2 * pr) * 256 + c) * SEQ + t] = (bf16_t)f2bf(bf2f(v0[(size_t)512 * SEQ + t]) * (y.x * (1.0f / 8192.0f) + bias1 * vv[i].x));
      HYO[((size_t)(2 * pr + 1) * 256 + c) * SEQ + t] = (bf16_t)f2bf(bf2f(v1[(size_t)512 * SEQ + t]) * (y.y * (1.0f / 8192.0f) + bias1 * vv[i].y)); }
    __syncthreads();
  }
}
__device__ __forceinline__ void out_item(int it, const bf16_t* HYO, bf16_t* MIX, char* lds) {
  bf16_t (*T)[72] = (bf16_t (*)[72])lds;
  const int tid = TIDX, b = it >> 8, t0 = ((it >> 2) & 63) * 64, c0 = (it & 3) * 64;
  { const int cc = tid >> 3, t8 = (tid & 7) * 8; *(u32x4*)&T[cc][t8] = *(const u32x4*)(HYO + ((size_t)b * 256 + c0 + cc) * SEQ + t0 + t8); }
  __syncthreads();
  { const int tl = tid >> 3, c8 = (tid & 7) * 8; u32x4 o;
    o.x = (unsigned)T[c8][tl] | ((unsigned)T[c8 + 1][tl] << 16); o.y = (unsigned)T[c8 + 2][tl] | ((unsigned)T[c8 + 3][tl] << 16);
    o.z = (unsigned)T[c8 + 4][tl] | ((unsigned)T[c8 + 5][tl] << 16); o.w = (unsigned)T[c8 + 6][tl] | ((unsigned)T[c8 + 7][tl] << 16);
    *(u32x4*)(MIX + ((size_t)b * TPB + CTXL + t0 + tl) * DM + 768 + c0 + c8) = o; }
  __syncthreads();
}
}

#define LAS __attribute__((address_space(3)))
#define XB_TMO      128
#define XB_XCNT(j)  (256  + 64 * (j))
#define XB_XSUB(j)  (1280 + 64 * (j))
#define XB_XGEN(j)  (2304 + 64 * (j))
#define XB_TOP      3328
#define XB_TOPGEN   3392
#define XCD_BAR_WORDS 3456
#define XB_SPIN_CAP (1u << 18)

__device__ __forceinline__ unsigned xb_ld(unsigned* p)              { return __hip_atomic_load(p, __ATOMIC_RELAXED, __HIP_MEMORY_SCOPE_AGENT); }
__device__ __forceinline__ unsigned xb_add(unsigned* p, unsigned v) { return __hip_atomic_fetch_add(p, v, __ATOMIC_RELAXED, __HIP_MEMORY_SCOPE_AGENT); }
__device__ __forceinline__ unsigned xb_xcc_id() { return (unsigned)__builtin_amdgcn_s_getreg((3 << 11) | 20) & 0xFu; }
#define XB_SPIN(cond, bar) do { unsigned _sp = 0; while (cond) { __builtin_amdgcn_s_sleep(1); \
    if ((++_sp & 255u) == 0u) { if (xb_ld(&(bar)[XB_TMO])) break; if (_sp > XB_SPIN_CAP) { atomicAdd(&(bar)[XB_TMO], 1u); break; } } } } while (0)

struct XcdBarrier {
    unsigned* bar; unsigned x;
    volatile LAS unsigned* st;
};

__device__ __forceinline__ XcdBarrier xcd_barrier_post(unsigned* bar, volatile LAS unsigned* st) {
    XcdBarrier b; b.bar = bar; b.x = xb_xcc_id(); b.st = st;
    if (threadIdx.x == 0) (void)xb_add(&bar[XB_XCNT(b.x)], 1u);
    return b;
}
__device__ __forceinline__ void xcd_barrier_complete(unsigned* bar, unsigned x, unsigned& nloc, unsigned& nx) {
    const unsigned G = gridDim.x * gridDim.y * gridDim.z;
    unsigned sum, cnt, mine, sp = 0u;
    for (;;) {
        sum = 0u; cnt = 0u; mine = 0u;
#pragma unroll
        for (unsigned j = 0; j < 16; ++j) { const unsigned c = xb_ld(&bar[XB_XCNT(j)]); sum += c; cnt += (c > 0u) ? 1u : 0u; mine = (j == x) ? c : mine; }
        if (sum == G) break;
        __builtin_amdgcn_s_sleep(1);
        if ((++sp & 255u) == 0u) { if (xb_ld(&bar[XB_TMO])) break; if (sp > XB_SPIN_CAP) { atomicAdd(&bar[XB_TMO], 1u); break; } }
    }
    nloc = mine > 0u ? mine : 1u; nx = cnt > 0u ? cnt : 1u;
}

__device__ __forceinline__ void xcd_barrier(const XcdBarrier& b) {
    asm volatile("s_waitcnt vmcnt(0)" ::: "memory");
    __syncthreads();
    if (threadIdx.x == 0) {
        unsigned* bar = b.bar;
        __builtin_amdgcn_s_waitcnt(0);
        unsigned nloc = b.st[0], nx = b.st[1];
        if (nloc == 0u) { xcd_barrier_complete(bar, b.x, nloc, nx); b.st[0] = nloc; b.st[1] = nx; }
        const unsigned old = xb_add(&bar[XB_XSUB(b.x)], 1u);
        const unsigned gen = old / nloc;
        if (old + 1u == (gen + 1u) * nloc) {
            __builtin_amdgcn_fence(__ATOMIC_RELEASE, "agent");
            asm volatile("s_waitcnt vmcnt(0)" ::: "memory");
            const unsigned og = xb_add(&bar[XB_TOP], 1u);
            const unsigned tg = og / nx;
            if (og + 1u == (tg + 1u) * nx) xb_add(&bar[XB_TOPGEN], 1u);
            else XB_SPIN(xb_ld(&bar[XB_TOPGEN]) == tg, bar);
            __builtin_amdgcn_fence(__ATOMIC_ACQUIRE, "agent");
            xb_add(&bar[XB_XGEN(b.x)], 1u);
            asm volatile("s_waitcnt vmcnt(0)" ::: "memory");
        } else {
            XB_SPIN(xb_ld(&bar[XB_XGEN(b.x)]) == gen, bar);
            __builtin_amdgcn_fence(__ATOMIC_ACQUIRE, "agent");
            asm volatile("s_waitcnt vmcnt(0)" ::: "memory");
        }
    }
    __syncthreads();
}


struct MP { const float* in[33]; float* out; unsigned char* ws; };
typedef const float* const __attribute__((address_space(4))) * kargs_t;
#define KARGS() ({ kargs_t k_ = (kargs_t)__builtin_amdgcn_kernarg_segment_ptr(); asm volatile("" : "+s"(k_)); k_; })
#define WSP(K, off) ((unsigned char*)(K)[34] + (off))

__global__ void __launch_bounds__(NT, 2) mega(MP P) {
  cg::grid_group grid = cg::this_grid();
  extern __shared__ __attribute__((aligned(16))) char lds[];
  volatile LAS unsigned* xst = (volatile LAS unsigned*)(lds + LDS_BYTES - 16);
  if (threadIdx.x < 2) xst[threadIdx.x] = 0u;
  { kargs_t K = KARGS(); unsigned* bw = (unsigned*)WSP(K, WS_CTL) + CT_BAR;
    if (blockIdx.x == 0) for (int i = threadIdx.x; i < XCD_BAR_WORDS; i += NT) bw[i] = 0u; }
  __syncthreads();
#define SEAM() xcd_barrier(xbar)
  {
    kargs_t K = KARGS();
    st_adaln(K[1], K[3], K[4], K[5], (float*)WSP(K, WS_MODV), lds);
    st_rope((float*)WSP(K, WS_ROPE));
  }
  grid.sync();
  XcdBarrier xbar;
  { kargs_t K = KARGS(); xbar = xcd_barrier_post((unsigned*)WSP(K, WS_CTL) + CT_BAR, xst); }
#pragma nounroll
  for (int layer = 0; layer < 2; ++layer) {
    const bool last = layer == 1;
    {
      kargs_t K = KARGS();
      st_weights(K[8], K[26], K[29], K[30], K[31], layer, (bf16_t*)WSP(K, WS_WIN), (bf16_t*)WSP(K, WS_WOUT), (bf16_t*)WSP(K, WS_WGU), (bf16_t*)WSP(K, WS_WD), lds);
    }
    { kargs_t K = KARGS(); const int bid = BIDX, G = GDIM;
      for (int it = bid; it < SEQ / 16; it += G) hyfilt_item<SEQ>(it, K[19] + layer * 33 * 64, K[20] + layer * 64, K[21] + layer * 64, K[22] + layer * 4096, K[23] + layer * 64, K[24] + (size_t)layer * 65536, (float*)WSP(K, WS_HK), lds);
      if (!last) for (int it = bid; it < CTXL / 16; it += G) hyfilt_item<CTXL>(it, K[19] + layer * 33 * 64, K[20] + layer * 64, K[21] + layer * 64, K[22] + layer * 4096, K[23] + layer * 64, K[24] + (size_t)layer * 65536, (float*)WSP(K, WS_HKC), lds);
    }
    { kargs_t K = KARGS();
      const float* xl_src = layer == 0 ? K[0] : K[33]; const float* xc_src = layer == 0 ? K[2] : (const float*)WSP(K, WS_XC);
      st_normmod(xl_src, xc_src, K[6] + layer * 1024, (const float*)WSP(K, WS_MODV) + (size_t)layer * 5 * 6144, 0, 1024, (bf16_t*)WSP(K, WS_H));
    }
    SEAM();
    {
      kargs_t K = KARGS();
      pg8::Gemm g{1024, 1024, 1024}; SchedDense S{MTOK / 256, NPAD / 256, (int)GDIM, BIDX, 0, (const char*)WSP(K, WS_H), (const char*)WSP(K, WS_WIN), (size_t)256 * 1024 * 2, (size_t)256 * 1024 * 2};
      EpiInProj E{(bf16_t*)WSP(K, WS_QK), (bf16_t*)WSP(K, WS_VZ), (bf16_t*)WSP(K, WS_XBC), (bf16_t*)WSP(K, WS_HY), (float*)WSP(K, WS_DT)};
      pg8::gemm_phase<EpiInProj, SchedDense, true, true>((PG8_LAS unsigned char*)lds, g, S, E);
    }
    SEAM();
    {
      kargs_t K = KARGS();
      st_prep_qk((bf16_t*)WSP(K, WS_QK), K[9] + layer * 64, K[10] + layer * 64, (const float*)WSP(K, WS_ROPE));
    }
    { kargs_t K = KARGS();
      st_prep_hy((const bf16_t*)WSP(K, WS_HY), K[17] + layer * 3 * 768, K[18] + layer * 768, (bf16_t*)WSP(K, WS_HYT), last ? 0 : 1, lds);
    }
    { kargs_t K = KARGS(); const int bid = BIDX, G = GDIM;
      for (int it = bid; it < 4 * 34 * 6; it += G)
        ssd1_item(it, (const bf16_t*)WSP(K, WS_XBC), (const float*)WSP(K, WS_DT), K[11] + layer * 3 * 640, K[12] + layer * 640, K[13] + layer * 12, K[14] + layer * 12,
                  (float*)WSP(K, WS_Y), (float*)WSP(K, WS_ST), (float*)WSP(K, WS_DEC), lds);
    }
    SEAM();
    {
      { kargs_t K2 = KARGS(); st_ssd_scan2((float*)WSP(K2, WS_ST), (const float*)WSP(K2, WS_DEC)); }
      const int bid = BIDX, G = GDIM;
      const int n_att = last ? 384 : 408, n_hyl = 256, n_hyc = last ? 0 : 1024;
      const int total = n_att + n_hyl + n_hyc;
      for (int it = bid; it < total; it += G) {
        int i2 = it;
        if (i2 < n_att) {
          kargs_t K = KARGS();
          int b, h, nt; size_t qrow;
          if (i2 < 384) { b = i2 / 96; const int rem = i2 % 96; h = rem >> 4; qrow = (size_t)b * TPB + CTXL + (rem & 15) * 256; nt = TPB / 64; }
          else { const int uc = i2 - 384; b = uc / 6; h = uc % 6; qrow = (size_t)b * TPB; nt = CTXL / 64; }
          const int kvh = h / 3;
          const attn_body::bf16* QKp = (const attn_body::bf16*)WSP(K, WS_QK); const attn_body::bf16* VZp = (const attn_body::bf16*)WSP(K, WS_VZ);
          attn_body::attn_unit<8>(QKp + qrow * 512 + h * 64, QKp + (size_t)b * TPB * 512 + 384 + kvh * 64, VZp + (size_t)b * TPB * 512 + kvh * 64,
                                  (attn_body::bf16*)WSP(K, WS_H) + qrow * 1024 + h * 64, nt, lds);
          continue; } i2 -= n_att;
        if (i2 < n_hyl) { kargs_t K = KARGS(); hyf::item(i2, (const bf16_t*)WSP(K, WS_HYT), (const float*)WSP(K, WS_HK), K[25] + layer * 512, (bf16_t*)WSP(K, WS_HY), lds); continue; } i2 -= n_hyl;
        { kargs_t K = KARGS(); hyconv_item<CTXL>(i2, (const bf16_t*)WSP(K, WS_HYT) + (size_t)4 * 768 * SEQ, (const float*)WSP(K, WS_HKC), K[25] + layer * 512, (bf16_t*)WSP(K, WS_H), 0, lds); }
      }
    }
    SEAM();
    {
      kargs_t K = KARGS();
      { const int bid = BIDX, G = GDIM, nit = last ? 4 * 32 * 2 : 4 * 34 * 2;
        for (int it = bid; it < nit; it += G) { const int g = it & 1, bc = it >> 1; const int b = last ? bc >> 5 : bc / 34, cidx = last ? 2 + (bc & 31) : bc % 34;
          ssd3_item(b, cidx, g, (const bf16_t*)WSP(K, WS_XBC), (const bf16_t*)WSP(K, WS_VZ), (const float*)WSP(K, WS_DT), K[11] + layer * 3 * 640, K[12] + layer * 640, K[13] + layer * 12, K[14] + layer * 12,
                    K[15] + layer * 6, K[16] + layer * 384, (const float*)WSP(K, WS_Y), (const float*)WSP(K, WS_ST), (bf16_t*)WSP(K, WS_H), lds); } }
      { const int bid = BIDX, G = GDIM; for (int it = bid; it < 1024; it += G) hyf::out_item(it, (const bf16_t*)WSP(K, WS_HY), (bf16_t*)WSP(K, WS_H), lds); }
      const int t = TIDX; if (BIDX == 0 && t < 256) ((int*)WSP(K, WS_CTL))[t] = 0;
      { int* stok = (int*)WSP(K, WS_MOEM + 384 * 1024); for (int i = BIDX * NT + t; i < MOE_ROWS; i += GDIM * NT) stok[i] = -1; }
    }
    SEAM();
    {
      kargs_t K = KARGS();
      const float* xl_src = layer == 0 ? K[0] : K[33]; const float* xc_src = layer == 0 ? K[2] : (const float*)WSP(K, WS_XC);
      pg8::Gemm g{1024, 1024, 1024}; SchedDense S{last ? 64 : 68, 4, (int)GDIM, BIDX, last ? 1 : 0, (const char*)WSP(K, WS_H), (const char*)WSP(K, WS_WOUT), (size_t)256 * 1024 * 2, (size_t)256 * 1024 * 2};
      EpiOutProj E{xl_src, xc_src, (float*)K[33], (float*)WSP(K, WS_XC), (const float*)WSP(K, WS_MODV) + (size_t)layer * 5 * 6144 + 2048};
      pg8::gemm_phase<EpiOutProj, SchedDense, true, true>((PG8_LAS unsigned char*)lds, g, S, E);
    }
    SEAM();
    {
      kargs_t K = KARGS();
      st_router(K[33], (const float*)WSP(K, WS_XC), K[7] + layer * 1024, (const float*)WSP(K, WS_MODV) + (size_t)layer * 5 * 6144, K[27], K[28], (bf16_t*)WSP(K, WS_H), (int*)WSP(K, WS_CTL),
                (int*)WSP(K, WS_MOEM), (float*)WSP(K, WS_MOEM + 128 * 1024), last ? 1 : 0, lds);
    }
    SEAM();
    { kargs_t K = KARGS();
      st_moe_gather((const bf16_t*)WSP(K, WS_H), (bf16_t*)WSP(K, WS_H2S), (int*)WSP(K, WS_CTL), (const int*)WSP(K, WS_MOEM), (const float*)WSP(K, WS_MOEM + 128 * 1024),
                    (int*)WSP(K, WS_MOEM + 384 * 1024), (float*)WSP(K, WS_MOEM + 512 * 1024), last ? 1 : 0, lds);
    }
    SEAM();
    { kargs_t K = KARGS();
      pg8::Gemm g{1024, 1024, 1024}; SchedMoe S{(int)GDIM, BIDX, 1, (const int*)WSP(K, WS_CTL), (const char*)WSP(K, WS_H2S), (size_t)256 * 1024 * 2, (const char*)WSP(K, WS_WGU)};
      EpiMoe1 E{(bf16_t*)WSP(K, WS_ACT), (const float*)WSP(K, WS_MOEM + 512 * 1024)};
      pg8::gemm_phase<EpiMoe1, SchedMoe, true, true>((PG8_LAS unsigned char*)lds, g, S, E);
    }
    SEAM();
    { kargs_t K = KARGS();
      pg8::Gemm g{256, 512, 256}; SchedMoe S{(int)GDIM, BIDX, 2, (const int*)WSP(K, WS_CTL), (const char*)WSP(K, WS_ACT), (size_t)256 * 512 * 2, (const char*)WSP(K, WS_WD)};
      EpiMoe2 E{(float*)K[33], (float*)WSP(K, WS_XC), (const float*)WSP(K, WS_MODV) + (size_t)layer * 5 * 6144 + 5120, (const int*)WSP(K, WS_MOEM + 384 * 1024)};
      pg8::gemm_phase<EpiMoe2, SchedMoe, true, true>((PG8_LAS unsigned char*)lds, g, S, E);
    }
    SEAM();
  }
  { kargs_t K = KARGS(); st_final((float*)K[33], K[32]); }
}

extern "C" void kernel_launch(void* const* d_in, const int* in_sizes, int n_in, void* d_out, int out_size, void* d_ws, size_t ws_size, hipStream_t stream) {
  if (n_in != 33 || ws_size < WS_END) { fprintf(stderr, "kernel_launch: unexpected n_in %d / ws %zu\n", n_in, ws_size); return; }
  static int grid_blocks = 0;
  if (!grid_blocks) {
    int dev = 0, cus = 0, per_cu = 0;
    (void)hipGetDevice(&dev);
    (void)hipDeviceGetAttribute(&cus, hipDeviceAttributeMultiprocessorCount, dev);
    (void)hipFuncSetAttribute((const void*)mega, hipFuncAttributeMaxDynamicSharedMemorySize, LDS_BYTES);
    (void)hipOccupancyMaxActiveBlocksPerMultiprocessor(&per_cu, mega, NT, LDS_BYTES);
    if (per_cu < 1) per_cu = 1;
    if (per_cu > 2) per_cu = 2;
    grid_blocks = cus * per_cu;
  }
  MP p{};
  for (int i = 0; i < 33; ++i) p.in[i] = (const float*)d_in[i];
  p.out = (float*)d_out; p.ws = (unsigned char*)d_ws;
  void* args[] = {&p};
  hipError_t e = hipLaunchCooperativeKernel((const void*)mega, dim3(grid_blocks), dim3(NT), args, LDS_BYTES, stream);
  if (e != hipSuccess) fprintf(stderr, "cooperative launch failed: %s (grid %d)\n", hipGetErrorString(e), grid_blocks);
}
```

```cpp
#include <hip/hip_runtime.h>
#include <hip/hip_cooperative_groups.h>
#include <cstdio>
#include <cstdint>
namespace cg = cooperative_groups;

typedef unsigned short bf16_t;
typedef short bf16x8 __attribute__((ext_vector_type(8)));
typedef float f32x4 __attribute__((ext_vector_type(4)));
typedef unsigned u32x4 __attribute__((ext_vector_type(4)));
typedef unsigned u32x2 __attribute__((ext_vector_type(2)));

constexpr int NB = 4, SEQ = 4096, CTXL = 256, DM = 1024, TPB = 4352, MTOK = NB * TPB;
constexpr int DIN = 2444, NPAD = 2560;
constexpr float EPS = 1e-6f;
constexpr float C2 = 0.125f * 1.4426950408889634f;
constexpr int MOE_ROWS = 23552;
constexpr int NT = 512;
constexpr int LDS_BYTES = 147456;

constexpr size_t MiB = 1u << 20;
constexpr size_t WS_CTL = 0;
constexpr size_t WS_MODV = 1 * MiB;
constexpr size_t WS_ROPE = 2 * MiB;
constexpr size_t WS_MOEM = 3 * MiB;
constexpr size_t WS_DT = 4 * MiB;
constexpr size_t WS_HKC = 5 * MiB;
constexpr size_t WS_XC = 6 * MiB;
constexpr size_t WS_WIN = 10 * MiB;
constexpr size_t WS_WOUT = 15 * MiB;
constexpr size_t WS_WGU = 17 * MiB;
constexpr size_t WS_WD = 33 * MiB;
constexpr size_t WS_HK = 41 * MiB;
constexpr size_t WS_H = 57 * MiB;
constexpr size_t WS_QK = 91 * MiB;
constexpr size_t WS_VZ = 108 * MiB;
constexpr size_t WS_XBC = 125 * MiB;
constexpr size_t WS_HY = WS_XBC + (size_t)MTOK * 768 * 2;
constexpr size_t WS_HYT = WS_HY + (size_t)MTOK * 768 * 2;
constexpr size_t WS_ST = WS_HYT + (size_t)MTOK * 768 * 2;
constexpr size_t WS_Y = WS_ST + (size_t)4 * 34 * 2 * 6 * 4096 * 4;
constexpr size_t WS_END = WS_Y + (size_t)MTOK * 384 * 4;
constexpr size_t WS_DEC = WS_DT + 900 * 1024;
constexpr size_t WS_H2S = WS_QK;
constexpr size_t WS_ACT = WS_H2S + (size_t)MOE_ROWS * 1024 * 2;
static_assert(WS_END <= 256 * MiB, "ws");
static_assert(WS_ACT + (size_t)MOE_ROWS * 512 * 2 <= WS_HYT, "moe alias");

constexpr int CT_CNT = 0, CT_FILL = 32, CT_BASE = 64, CT_NT = 96, CT_TP = 128;
constexpr int CT_BAR = 4096;
constexpr int CT_CNTB = 8192;

__device__ __forceinline__ int opq_v(int v) { asm volatile("" : "+v"(v)); return v; }
__device__ __forceinline__ int opq_s(int v) { asm volatile("" : "+s"(v)); return v; }
#define TIDX opq_v((int)threadIdx.x)
#define BIDX opq_s((int)blockIdx.x)
#define GDIM opq_s((int)gridDim.x)
__device__ __forceinline__ unsigned f2bf(float f) { unsigned u = __float_as_uint(f); return (u + 0x7fffu + ((u >> 16) & 1u)) >> 16; }
__device__ __forceinline__ unsigned pk2bf(float lo, float hi) { return f2bf(lo) | (f2bf(hi) << 16); }
__device__ __forceinline__ float bf2f(bf16_t h) { return __uint_as_float(((unsigned)h) << 16); }
__device__ __forceinline__ float wave_sum(float v) {
#pragma unroll
  for (int o = 1; o < 64; o <<= 1) v += __shfl_xor(v, o);
  return v;
}
__device__ __forceinline__ float siluf(float v) { return v / (1.0f + __expf(-v)); }
__device__ __forceinline__ float* xrow(const float* xl, const float* xc, int r) {
  const int b = r / TPB, j = r - b * TPB;
  return (float*)(j < CTXL ? xc + ((size_t)b * CTXL + j) * DM : xl + ((size_t)b * SEQ + (j - CTXL)) * DM);
}
__device__ __forceinline__ int mrow_of(int r) { const int b = r / TPB, j = r - b * TPB; return j < CTXL ? 4 : b; }

__device__ __forceinline__ void st_adaln(const float* c, const float* c_ctx, const float* w_mod, const float* b_mod, float* modv, char* lds) {
  float (*sc)[1024] = (float (*)[1024])lds;
  float (*red)[5][64] = (float (*)[5][64])(lds + 5 * 1024 * 4);
  const int tid = TIDX;
  for (int it = BIDX; it < 192; it += GDIM) {
    const int layer = it / 96, n0 = (it % 96) * 64;
    for (int i = tid; i < 5 * 1024; i += NT) { const int r = i >> 10, k = i & 1023; const float v = r < 4 ? c[r * 1024 + k] : c_ctx[k]; sc[r][k] = v / (1.0f + expf(-v)); }
    __syncthreads();
    const int kg = tid >> 6, n = tid & 63;
    float acc[5] = {0.f, 0.f, 0.f, 0.f, 0.f};
#pragma unroll 16
    for (int k = kg; k < 1024; k += 8) { const float w = w_mod[((size_t)layer * 1024 + k) * 6144 + n0 + n];
#pragma unroll
      for (int r = 0; r < 5; ++r) acc[r] += sc[r][k] * w; }
#pragma unroll
    for (int r = 0; r < 5; ++r) red[kg][r][n] = acc[r];
    __syncthreads();
    if (tid < 320) { const int r = tid >> 6, nn = tid & 63; float s = 0.f;
#pragma unroll
      for (int g = 0; g < 8; ++g) s += red[g][r][nn];
      modv[((size_t)layer * 5 + r) * 6144 + n0 + nn] = s + b_mod[layer * 6144 + n0 + nn]; }
    __syncthreads();
  }
}
__device__ __forceinline__ void st_rope(float* rope) {
  for (int i = BIDX * NT + TIDX; i < 4096 * 32; i += GDIM * NT) {
    const int t = i >> 5, d = i & 31, m = d & 15;
    const float inv = powf(10000.0f, -(float)(2 * m) / 32.0f);
    const float pos = (float)(d < 16 ? (t >> 6) : (t & 63));
    const float ang = pos * inv;
    rope[2 * i] = cosf(ang); rope[2 * i + 1] = sinf(ang);
  }
}

__device__ __forceinline__ void st_normmod(const float* xl, const float* xc, const float* g, const float* modv_layer, int off_sh, int off_sc, bf16_t* H) {
  const int lane = TIDX & 63, gw = BIDX * 8 + (TIDX >> 6), ngw = GDIM * 8;
  for (int r = gw; r < MTOK; r += ngw) {
    const float* xr = xrow(xl, xc, r); const float* mv = modv_layer + (size_t)mrow_of(r) * 6144;
    f32x4 v[4]; float ss = 0.f;
#pragma unroll
    for (int j = 0; j < 4; ++j) { v[j] = *(const f32x4*)(xr + 4 * lane + 256 * j); ss += v[j].x * v[j].x + v[j].y * v[j].y + v[j].z * v[j].z + v[j].w * v[j].w; }
    const float rstd = rsqrtf(wave_sum(ss) * (1.0f / DM) + EPS);
#pragma unroll
    for (int j = 0; j < 4; ++j) { const int k = 4 * lane + 256 * j;
      const f32x4 gg = *(const f32x4*)(g + k), sh = *(const f32x4*)(mv + off_sh + k), sc = *(const f32x4*)(mv + off_sc + k);
      const float o0 = v[j].x * rstd * gg.x * (1.f + sc.x) + sh.x, o1 = v[j].y * rstd * gg.y * (1.f + sc.y) + sh.y;
      const float o2 = v[j].z * rstd * gg.z * (1.f + sc.z) + sh.z, o3 = v[j].w * rstd * gg.w * (1.f + sc.w) + sh.w;
      u32x2 w; w.x = f2bf(o0) | (f2bf(o1) << 16); w.y = f2bf(o2) | (f2bf(o3) << 16);
      *(u32x2*)(H + (size_t)r * DM + k) = w; }
  }
}

template <int MODE> __device__ __forceinline__ void tr_tile(const float* src, const float* src2, int ldsrc, int K, bf16_t* out, int n0, int k0, char* lds) {
  float (*tile)[65] = (float (*)[65])lds;
  const int tid = TIDX;
#pragma unroll
  for (int i = 0; i < 8; ++i) { const int kk = (tid >> 6) + 8 * i, nn = tid & 63, n = n0 + nn; float v = 0.f;
    if (MODE == 0) { const int col = n < 1676 ? n : (n < 1792 ? -1 : n - 116); if (col >= 0) v = src[(size_t)(k0 + kk) * ldsrc + col]; }
    else if (MODE == 1) { v = src[(size_t)(k0 + kk) * ldsrc + n]; }
    else { v = (n & 1) ? src2[(size_t)(k0 + kk) * ldsrc + (n >> 1)] : src[(size_t)(k0 + kk) * ldsrc + (n >> 1)]; }
    tile[kk][nn] = v; }
  __syncthreads();
#pragma unroll
  for (int i = 0; i < 4; ++i) { const int nn = (tid >> 5) + 16 * i, kk = (tid & 31) * 2;
    *(unsigned*)(out + (size_t)(n0 + nn) * K + k0 + kk) = f2bf(tile[kk][nn]) | (f2bf(tile[kk + 1][nn]) << 16); }
  __syncthreads();
}
template <int MODE> __device__ __forceinline__ void tr_wave_item(const float* src, const float* src2, int ldsrc, int K, bf16_t* out, int n0, int k0, float* scr, int lane) {
  const int nn = lane & 31, n = n0 + nn;
#pragma unroll 8
  for (int i = 0; i < 32; ++i) { const int kk = 2 * i + (lane >> 5); float v = 0.f;
    if (MODE == 0) { const int col = n < 1676 ? n : (n < 1792 ? -1 : n - 116); if (col >= 0) v = src[(size_t)(k0 + kk) * ldsrc + col]; }
    else if (MODE == 1) v = src[(size_t)(k0 + kk) * ldsrc + n];
    else v = (n & 1) ? src2[(size_t)(k0 + kk) * ldsrc + (n >> 1)] : src[(size_t)(k0 + kk) * ldsrc + (n >> 1)];
    scr[kk * 33 + nn] = v; }
  asm volatile("s_waitcnt lgkmcnt(0)" ::: "memory");
  const int c = lane & 7;
#pragma unroll
  for (int j = 0; j < 4; ++j) { const int nr = (lane >> 3) + 8 * j; const float* sp = scr + (8 * c) * 33 + nr;
    u32x4 o; o.x = f2bf(sp[0]) | (f2bf(sp[33]) << 16); o.y = f2bf(sp[66]) | (f2bf(sp[99]) << 16); o.z = f2bf(sp[132]) | (f2bf(sp[165]) << 16); o.w = f2bf(sp[198]) | (f2bf(sp[231]) << 16);
    *(u32x4*)(out + (size_t)(n0 + nr) * K + k0 + 8 * c) = o; }
  asm volatile("s_waitcnt lgkmcnt(0)" ::: "memory");
}
__device__ __forceinline__ void st_weights(const float* w_in, const float* w_out, const float* w_gate, const float* w_up, const float* w_down, int layer,
                                           bf16_t* WIN, bf16_t* WOUT, bf16_t* WGU, bf16_t* WD, char* lds) {
  const int tid = TIDX, lane = tid & 63, w = tid >> 6; float* scr = (float*)lds + w * (64 * 33);
  for (int it = BIDX * 8 + w; it < 7936; it += GDIM * 8) {
    if (it < 1280) tr_wave_item<0>(w_in + (size_t)layer * 1024 * DIN, nullptr, DIN, 1024, WIN, (it % 80) * 32, (it / 80) * 64, scr, lane);
    else if (it < 1792) { const int i2 = it - 1280; tr_wave_item<1>(w_out + (size_t)layer * 1024 * 1024, nullptr, 1024, 1024, WOUT, (i2 & 31) * 32, (i2 >> 5) * 64, scr, lane); }
    else if (it < 5888) { const int i2 = it - 1792, e = i2 >> 8, t = i2 & 255;
      tr_wave_item<2>(w_gate + ((size_t)layer * 16 + e) * 1024 * 256, w_up + ((size_t)layer * 16 + e) * 1024 * 256, 256, 1024, WGU + (size_t)e * 512 * 1024, (t & 15) * 32, (t >> 4) * 64, scr, lane); }
    else { const int i2 = it - 5888, e = i2 >> 7, t = i2 & 127;
      tr_wave_item<1>(w_down + ((size_t)layer * 16 + e) * 256 * 1024, nullptr, 1024, 256, WD + (size_t)e * 1024 * 256, (t & 31) * 32, (t >> 5) * 64, scr, lane); }
  }
  __syncthreads();
}

template <class P> __device__ __forceinline__ void st_gemm(const P& p, int ntm, int ntn, char* lds) {
  bf16_t (*As)[72] = (bf16_t (*)[72])lds;
  bf16_t (*Bs)[72] = (bf16_t (*)[72])(lds + 256 * 72 * 2);
  const int tid = TIDX, lane = tid & 63, w = tid >> 6;
  for (int it = BIDX; it < ntm * ntn; it += GDIM) {
    const int mt = it / ntn, nt = it % ntn;
    if (!p.valid(mt)) continue;
    const int m0 = mt * 256, n0 = nt * 128;
    f32x4 acc[2][8];
#pragma unroll
    for (int a = 0; a < 2; ++a)
#pragma unroll
      for (int b = 0; b < 8; ++b) acc[a][b] = (f32x4){0.f, 0.f, 0.f, 0.f};
    const int K = p.K;
    for (int k0 = 0; k0 < K; k0 += 64) {
#pragma unroll
      for (int i = 0; i < 4; ++i) { const int ch = tid + NT * i, r = ch >> 3, kc = (ch & 7) * 8;
        const bf16_t* ap = p.arow(m0 + r); *(u32x4*)&As[r][kc] = *(const u32x4*)(ap + k0 + kc); }
#pragma unroll
      for (int i = 0; i < 2; ++i) { const int ch = tid + NT * i, r = ch >> 3, kc = (ch & 7) * 8;
        const bf16_t* bp = p.brow(mt, n0 + r, k0); *(u32x4*)&Bs[r][kc] = *(const u32x4*)(bp + kc); }
      __syncthreads();
#pragma unroll
      for (int kk = 0; kk < 2; ++kk) {
        bf16x8 a[2], b[8];
#pragma unroll
        for (int mi = 0; mi < 2; ++mi) a[mi] = *(const bf16x8*)&As[32 * w + 16 * mi + (lane & 15)][kk * 32 + 8 * (lane >> 4)];
#pragma unroll
        for (int ni = 0; ni < 8; ++ni) b[ni] = *(const bf16x8*)&Bs[16 * ni + (lane & 15)][kk * 32 + 8 * (lane >> 4)];
#pragma unroll
        for (int mi = 0; mi < 2; ++mi)
#pragma unroll
          for (int ni = 0; ni < 8; ++ni) acc[mi][ni] = __builtin_amdgcn_mfma_f32_16x16x32_bf16(a[mi], b[ni], acc[mi][ni], 0, 0, 0);
      }
      __syncthreads();
    }
    p.epi(acc, mt, m0, n0, w, lane);
  }
}

struct PInProj {
  const bf16_t* H; const bf16_t* W; bf16_t *QK, *VZ, *XBC, *HY; float* DT; int K;
  __device__ bool valid(int) const { return true; }
  __device__ const bf16_t* arow(int m) const { return H + (size_t)m * DM; }
  __device__ const bf16_t* brow(int, int n, int k0) const { return W + (size_t)n * DM + k0; }
  __device__ void epi(const f32x4 (&acc)[2][8], int, int m0, int n0, int w, int lane) const {
#pragma unroll
    for (int mi = 0; mi < 2; ++mi)
#pragma unroll
      for (int ni = 0; ni < 8; ++ni)
#pragma unroll
        for (int rg = 0; rg < 4; ++rg) { const int row = m0 + 32 * w + 16 * mi + 4 * (lane >> 4) + rg, col = n0 + 16 * ni + (lane & 15); const float v = acc[mi][ni][rg];
          if (col < 512) QK[(size_t)row * 512 + col] = (bf16_t)f2bf(v);
          else if (col < 1024) VZ[(size_t)row * 512 + col - 512] = (bf16_t)f2bf(v);
          else if (col < 1792) { XBC[(size_t)row * 768 + col - 1024] = (bf16_t)f2bf(v); if (col >= 1664 && col < 1676) DT[(size_t)row * 12 + col - 1664] = v; }
          else HY[(size_t)row * 768 + col - 1792] = (bf16_t)f2bf(v); }
  }
};
struct POutProj {
  const bf16_t* A; const bf16_t* W; const float *xl_src, *xc_src; float *xl_dst, *xc_dst; const float* gate;   int skip_ctx; int K;
  __device__ bool valid(int mt) const { return !(skip_ctx && ((mt * 256) % TPB) < CTXL); }
  __device__ const bf16_t* arow(int m) const { return A + (size_t)m * DM; }
  __device__ const bf16_t* brow(int, int n, int k0) const { return W + (size_t)n * DM + k0; }
  __device__ void epi(const f32x4 (&acc)[2][8], int, int m0, int n0, int w, int lane) const {
#pragma unroll
    for (int mi = 0; mi < 2; ++mi)
#pragma unroll
      for (int rg = 0; rg < 4; ++rg) { const int row = m0 + 32 * w + 16 * mi + 4 * (lane >> 4) + rg;
        const float* xs = xrow(xl_src, xc_src, row); float* xd = xrow(xl_dst, xc_dst, row); const float* gt = gate + (size_t)mrow_of(row) * 6144;
#pragma unroll
        for (int ni = 0; ni < 8; ++ni) { const int col = n0 + 16 * ni + (lane & 15); xd[col] = xs[col] + gt[col] * acc[mi][ni][rg]; } }
  }
};
__device__ __forceinline__ void pair_experts(int pidx, int& eA, int& eB) {
  const int g = pidx / 6, t = pidx - 6 * g; const int i = t < 3 ? 0 : (t < 5 ? 1 : 2); const int j = t < 3 ? t + 1 : (t < 5 ? t - 1 : 3);
  eA = 4 * g + i; eB = 4 * g + j;
}
struct PMoe1 {
  const bf16_t* H2S; const bf16_t* WGU; bf16_t* ACT; const int* ctl; const float* sorted_w; int K;
  __device__ bool valid(int mt) const { return mt < ctl[CT_NT]; }
  __device__ const bf16_t* arow(int m) const { return H2S + (size_t)m * DM; }
  __device__ const bf16_t* brow(int mt, int n, int k0) const { int eA, eB; pair_experts(ctl[CT_TP + mt], eA, eB); const int e = n < 512 ? eA : eB;
    return WGU + ((size_t)e * 512 + (n & 511)) * DM + k0; }
  __device__ void epi(const f32x4 (&acc)[2][8], int, int m0, int n0, int w, int lane) const {
    const int half = n0 >> 9, tb = (n0 & 511) >> 7;
#pragma unroll
    for (int mi = 0; mi < 2; ++mi)
#pragma unroll
      for (int rg = 0; rg < 4; ++rg) { const int slot = m0 + 32 * w + 16 * mi + 4 * (lane >> 4) + rg; const float wt = sorted_w[2 * slot + half];
#pragma unroll
        for (int ni = 0; ni < 4; ++ni) { const float g = acc[mi][ni][rg], u = acc[mi][ni + 4][rg]; const int j = 64 * tb + 16 * ni + (lane & 15);
          ACT[(size_t)slot * 512 + half * 256 + j] = (bf16_t)f2bf(siluf(g) * u * wt); } }
  }
};
struct PMoe2 {
  const bf16_t* ACT; const bf16_t* WD; float *xl, *xc; const float* gate;   const int* ctl; const int* sorted_tok; int K;
  __device__ bool valid(int mt) const { return mt < ctl[CT_NT]; }
  __device__ const bf16_t* arow(int m) const { return ACT + (size_t)m * 512; }
  __device__ const bf16_t* brow(int mt, int n, int k0) const { int eA, eB; pair_experts(ctl[CT_TP + mt], eA, eB); const int e = k0 < 256 ? eA : eB;
    return WD + ((size_t)e * 1024 + n) * 256 + (k0 & 255); }
  __device__ void epi(const f32x4 (&acc)[2][8], int, int m0, int n0, int w, int lane) const {
#pragma unroll
    for (int mi = 0; mi < 2; ++mi)
#pragma unroll
      for (int rg = 0; rg < 4; ++rg) { const int slot = m0 + 32 * w + 16 * mi + 4 * (lane >> 4) + rg; const int r = sorted_tok[slot];
        if (r >= 0) { float* xd = xrow(xl, xc, r); const float* gt = gate + (size_t)mrow_of(r) * 6144;
#pragma unroll
          for (int ni = 0; ni < 8; ++ni) { const int col = n0 + 16 * ni + (lane & 15); xd[col] += gt[col] * acc[mi][ni][rg]; } } }
  }
};

__device__ __forceinline__ void st_prep_qk(bf16_t* QK, const float* qn, const float* kn, const float* rope) {
  const int lane = TIDX & 63, gw = BIDX * 8 + (TIDX >> 6), ngw = GDIM * 8, hh = lane >> 3, sub = lane & 7;
  for (int r = gw; r < MTOK; r += ngw) {
    const int j = r % TPB; bf16_t* p = QK + (size_t)r * 512 + hh * 64 + sub * 8;
    const bf16x8 raw = *(const bf16x8*)p; float v[8]; float ss = 0.f;
#pragma unroll
    for (int e = 0; e < 8; ++e) { v[e] = bf2f((bf16_t)raw[e]); ss += v[e] * v[e]; }
    ss += __shfl_xor(ss, 1); ss += __shfl_xor(ss, 2); ss += __shfl_xor(ss, 4);
    const float rstd = rsqrtf(ss * (1.0f / 64.0f) + EPS); const float* gn = (hh < 6 ? qn : kn) + sub * 8;
#pragma unroll
    for (int e = 0; e < 8; ++e) v[e] = v[e] * rstd * gn[e];
    if (j >= CTXL) { const float* rp = rope + ((size_t)(j - CTXL) * 32 + (sub & 3) * 8) * 2;
#pragma unroll
      for (int e = 0; e < 8; ++e) { const float other = __shfl_xor(v[e], 4); const float cs = rp[2 * e], sn = rp[2 * e + 1]; v[e] = sub < 4 ? v[e] * cs - other * sn : v[e] * cs + other * sn; } }
    const float sc = hh < 6 ? C2 : 1.0f;
    *(u32x4*)p = (u32x4){pk2bf(v[0] * sc, v[1] * sc), pk2bf(v[2] * sc, v[3] * sc), pk2bf(v[4] * sc, v[5] * sc), pk2bf(v[6] * sc, v[7] * sc)};
  }
}

__device__ __forceinline__ void st_prep_hy(const bf16_t* HY, const float* cw, const float* cb, bf16_t* HYT, int do_ctx, char* lds) {
  const int tid = TIDX, lane = tid & 63, w = tid >> 6; float* tile = (float*)lds + w * (66 * 33);
  const int nlat = 4 * 64 * 24, nitem = nlat + (do_ctx ? 4 * 4 * 24 : 0);
  for (int it = BIDX * 8 + w; it < nitem; it += GDIM * 8) {
    int b, tt, ct, L, joff; bf16_t* outb;
    if (it < nlat) { b = it / 1536; tt = (it % 1536) / 24; ct = it % 24; L = SEQ; joff = CTXL; outb = HYT + (size_t)b * 768 * SEQ; }
    else { const int i2 = it - nlat; b = i2 / 96; tt = (i2 % 96) / 24; ct = i2 % 24; L = CTXL; joff = 0; outb = HYT + (size_t)4 * 768 * SEQ + (size_t)b * 768 * CTXL; }
    const int t0 = tt * 64, c0 = ct * 32;
#pragma unroll
    for (int i = 0; i < 5; ++i) { const int rr = (lane >> 2) + 16 * i, c8 = (lane & 3) * 8, t = t0 - 1 + rr;
      if (rr < 66) { bf16x8 v = (bf16x8){0, 0, 0, 0, 0, 0, 0, 0};
        if (t >= 0 && t < L) v = *(const bf16x8*)(HY + ((size_t)b * TPB + joff + t) * 768 + c0 + c8);
#pragma unroll
        for (int e = 0; e < 8; ++e) tile[rr * 33 + c8 + e] = bf2f((bf16_t)v[e]); } }
    asm volatile("s_waitcnt lgkmcnt(0)" ::: "memory");
#pragma unroll 4
    for (int cc = 0; cc < 32; ++cc) { const int c = c0 + cc;
      const float v = cw[c] * tile[lane * 33 + cc] + cw[768 + c] * tile[(lane + 1) * 33 + cc] + cw[1536 + c] * tile[(lane + 2) * 33 + cc] + cb[c];
      outb[(size_t)c * L + t0 + lane] = (bf16_t)f2bf(v); }
    asm volatile("s_waitcnt lgkmcnt(0)" ::: "memory");
  }
  __syncthreads();
}

template <int L> __device__ __forceinline__ void hyfilt_item(int item, const float* w1, const float* b1, const float* fr, const float* w2, const float* b2, const float* w3, float* HK, char* lds) {
  float* S0 = (float*)lds; float* S1 = S0 + 64 * 64; float* S2 = S1 + 64 * 64;
  const int tid = TIDX, n0 = (item >> 2) * 64, cq = item & 3, lane = tid & 63, wv = tid >> 6;
  for (int e = tid; e < 64 * 33; e += NT) { const int pp = e / 33, f = e % 33; const int n = n0 + pp; float v;
    if (f == 0) v = (float)n / (float)(L - 1);
    else { const int m = (f - 1) & 15; const float band = 1e-4f + (float)m * ((15.0f - 1e-4f) / 15.0f); const float wpos = (6.283185307179586f / (float)L) * (float)n;
      v = f <= 16 ? cosf(wpos * band) : -sinf(wpos * band); }
    S0[pp * 33 + f] = v; }
  for (int e = tid; e < 33 * 64; e += NT) S1[e] = w1[e];
  __syncthreads();
  for (int e = tid; e < 64 * 64; e += NT) { const int pp = e >> 6, j = e & 63; float a = b1[j];
    for (int f = 0; f < 33; ++f) a += S0[pp * 33 + f] * S1[f * 64 + j];
    S2[pp * 64 + j] = sinf(fr[j] * a); }
  __syncthreads();
  for (int e = tid; e < 64 * 64; e += NT) S0[e] = w2[e];
  __syncthreads();
  for (int e = tid; e < 64 * 64; e += NT) { const int pp = e >> 6, j = e & 63; float a = b2[j];
    for (int f = 0; f < 64; ++f) a += S2[pp * 64 + f] * S0[f * 64 + j];
    S1[pp * 64 + j] = sinf(fr[j] * a); }
  __syncthreads();
  for (int c4 = 0; c4 < 4; ++c4) { const int ch = cq * 4 + c4;
    const int col = ch * 64 + lane; float acc[8];
#pragma unroll
    for (int i = 0; i < 8; ++i) acc[i] = 0.f;
    for (int j = 0; j < 64; ++j) { const float wv3 = w3[j * 1024 + col];
#pragma unroll
      for (int i = 0; i < 8; ++i) acc[i] += S1[(wv * 8 + i) * 64 + j] * wv3; }
    const int c = col & 255; const float delta = 3.0701134573253943f + (float)c * ((15.350567286626972f - 3.0701134573253943f) / 255.0f);
#pragma unroll
    for (int i = 0; i < 8; ++i) { const int pp = wv * 8 + i; const float t = (float)(n0 + pp) / (float)(L - 1); S2[lane * 65 + pp] = acc[i] * expf(-t * delta); }
    __syncthreads();
    const int dir = ch >> 3, order = (ch >> 2) & 1;
#pragma unroll
    for (int i = 0; i < 8; ++i) { const int cl = wv * 8 + i, c2 = (ch * 64 + cl) & 255, n = n0 + lane; const float v = S2[cl * 65 + lane];
      float* dst = HK + ((size_t)order * 256 + c2) * (2 * L);
      if (dir == 0) dst[n] = v; else if (n >= 1) dst[2 * L - n] = v;
      if (dir == 1 && n == 0) dst[L] = 0.f; }
    __syncthreads();
  }
}

template <int L> __device__ __forceinline__ void hyconv_item(int item, const bf16_t* HYT, const float* HK, const float* hy_bias, bf16_t* MIX, int joff, char* lds) {
  float* kern = (float*)lds; float* z = kern + 2 * L;
  const int tid = TIDX, b = item >> 8, c = item & 255;
  const bf16_t* vp = HYT + ((size_t)b * 768 + c) * L; const bf16_t* x1p = vp + (size_t)256 * L; const bf16_t* x2p = vp + (size_t)512 * L;
  const bool act = tid < L / 8; const int tb = 8 * tid;
  for (int o = 0; o < 2; ++o) {
    if (o == 0) for (int t = tid; t < L; t += NT) z[t] = bf2f(vp[t]);
    const float* kp = HK + ((size_t)o * 256 + c) * (2 * L);
    for (int t = tid; t < 2 * L; t += NT) kern[t] = kp[t];
    __syncthreads();
    float acc[8], W[16];
#pragma unroll
    for (int i = 0; i < 8; ++i) acc[i] = 0.f;
    if (act) {
#pragma unroll
      for (int i = 0; i < 8; ++i) W[8 + i] = kern[(tb + i) & (2 * L - 1)];
      for (int s0 = 0; s0 < L; s0 += 8) {
        const int bb = (tb - s0 - 8) & (2 * L - 1);
#pragma unroll
        for (int i = 0; i < 8; ++i) W[i] = kern[bb + i];
        float zs[8];
#pragma unroll
        for (int j = 0; j < 8; ++j) zs[j] = z[s0 + j];
#pragma unroll
        for (int j = 0; j < 8; ++j)
#pragma unroll
          for (int i = 0; i < 8; ++i) acc[i] += W[8 + i - j] * zs[j];
#pragma unroll
        for (int i = 0; i < 8; ++i) W[8 + i] = W[i];
      }
    }
    __syncthreads();
    const float bias = hy_bias[o * 256 + c];
    if (act) {
#pragma unroll
      for (int i = 0; i < 8; ++i) { const int t = tb + i; const float zz = acc[i] + bias * z[t];
        if (o == 0) z[t] = bf2f(x1p[t]) * zz;
        else MIX[((size_t)b * TPB + joff + t) * DM + 768 + c] = (bf16_t)f2bf(bf2f(x2p[t]) * zz); }
    }
    __syncthreads();
  }
}

__device__ __forceinline__ void hyconv_ctx_item(int item, const bf16_t* HYTC, const float* HKC, const float* hy_bias, bf16_t* MIX, char* lds) {
  constexpr int L = CTXL;
  const int tid = TIDX, b = item >> 4, cc = tid >> 5, c = (item & 15) * 16 + cc, sub = tid & 31, tb = 8 * sub;
  float* kern = (float*)lds + cc * (2 * L); float* z = (float*)lds + 16 * 2 * L + cc * L;
  const bf16_t* vp = HYTC + ((size_t)b * 768 + c) * L; const bf16_t* x1p = vp + (size_t)256 * L; const bf16_t* x2p = vp + (size_t)512 * L;
#pragma unroll 1
  for (int o = 0; o < 2; ++o) {
    if (o == 0) for (int t = sub; t < L; t += 32) z[t] = bf2f(vp[t]);
    const float* kp = HKC + ((size_t)o * 256 + c) * (2 * L);
    for (int t = sub; t < 2 * L; t += 32) kern[t] = kp[t];
    __syncthreads();
    float acc[8], W[16];
#pragma unroll
    for (int i = 0; i < 8; ++i) { acc[i] = 0.f; W[8 + i] = kern[(tb + i) & (2 * L - 1)]; }
    for (int s0 = 0; s0 < L; s0 += 8) {
      const int bb = (tb - s0 - 8) & (2 * L - 1);
#pragma unroll
      for (int i = 0; i < 8; ++i) W[i] = kern[bb + i];
      float zs[8];
#pragma unroll
      for (int j = 0; j < 8; ++j) zs[j] = z[s0 + j];
#pragma unroll
      for (int j = 0; j < 8; ++j)
#pragma unroll
        for (int i = 0; i < 8; ++i) acc[i] += W[8 + i - j] * zs[j];
#pragma unroll
      for (int i = 0; i < 8; ++i) W[8 + i] = W[i];
    }
    __syncthreads();
    const float bias = hy_bias[o * 256 + c];
#pragma unroll
    for (int i = 0; i < 8; ++i) { const int t = tb + i; const float zz = acc[i] + bias * z[t];
      if (o == 0) z[t] = bf2f(x1p[t]) * zz;
      else MIX[((size_t)b * TPB + t) * DM + 768 + c] = (bf16_t)f2bf(bf2f(x2p[t]) * zz); }
    __syncthreads();
  }
}

__device__ __forceinline__ void attn_unit_simple(int u, const bf16_t* QK, const bf16_t* VZ, bf16_t* MIX, char* lds) {
  bf16_t (*Ks)[72] = (bf16_t (*)[72])lds;
  bf16_t (*Vt)[72] = (bf16_t (*)[72])(lds + 64 * 72 * 2);
  bf16_t (*Ps)[16][72] = (bf16_t (*)[16][72])(lds + 2 * 64 * 72 * 2);
  const int tid = TIDX, lane = tid & 63, w = tid >> 6;
  int b, h, qrow0, nk;
  if (u < 768) { b = u / 192; const int rem = u % 192; h = rem >> 5; qrow0 = b * TPB + CTXL + (rem & 31) * 128; nk = TPB; }
  else { const int uc = u - 768; b = uc / 12; h = (uc % 12) >> 1; qrow0 = b * TPB + (uc & 1) * 128; nk = CTXL; }
  const int kvh = h / 3, key0 = b * TPB, l15 = lane & 15, l4 = lane >> 4;
  bf16x8 aq[2];
#pragma unroll
  for (int kk = 0; kk < 2; ++kk) aq[kk] = *(const bf16x8*)(QK + (size_t)(qrow0 + 16 * w + l15) * 512 + h * 64 + kk * 32 + 8 * l4);
  f32x4 O[4]; float m[4], l[4];
#pragma unroll
  for (int i = 0; i < 4; ++i) { O[i] = (f32x4){0.f, 0.f, 0.f, 0.f}; m[i] = -1e30f; l[i] = 0.f; }
  for (int kt = 0; kt < nk / 64; ++kt) {
    __syncthreads();
    { const int r = tid >> 3, c8 = (tid & 7) * 8; const size_t grow = (size_t)(key0 + kt * 64 + r) * 512;
      *(u32x4*)&Ks[r][c8] = *(const u32x4*)(QK + grow + 384 + kvh * 64 + c8);
      const bf16x8 vv = *(const bf16x8*)(VZ + grow + kvh * 64 + c8);
#pragma unroll
      for (int e = 0; e < 8; ++e) Vt[c8 + e][r] = (bf16_t)vv[e]; }
    __syncthreads();
    f32x4 s[4];
#pragma unroll
    for (int ni = 0; ni < 4; ++ni) s[ni] = (f32x4){0.f, 0.f, 0.f, 0.f};
#pragma unroll
    for (int kk = 0; kk < 2; ++kk)
#pragma unroll
      for (int ni = 0; ni < 4; ++ni) { const bf16x8 bk = *(const bf16x8*)&Ks[16 * ni + l15][32 * kk + 8 * l4]; s[ni] = __builtin_amdgcn_mfma_f32_16x16x32_bf16(aq[kk], bk, s[ni], 0, 0, 0); }
#pragma unroll
    for (int rg = 0; rg < 4; ++rg) {
      float mx = fmaxf(fmaxf(s[0][rg], s[1][rg]), fmaxf(s[2][rg], s[3][rg]));
      mx = fmaxf(mx, __shfl_xor(mx, 1)); mx = fmaxf(mx, __shfl_xor(mx, 2)); mx = fmaxf(mx, __shfl_xor(mx, 4)); mx = fmaxf(mx, __shfl_xor(mx, 8));
      const float mn = fmaxf(m[rg], mx), alpha = exp2f(m[rg] - mn); float rs = 0.f;
#pragma unroll
      for (int ni = 0; ni < 4; ++ni) { const float pv = exp2f(s[ni][rg] - mn); rs += pv; Ps[w][4 * l4 + rg][16 * ni + l15] = (bf16_t)f2bf(pv); }
      rs += __shfl_xor(rs, 1); rs += __shfl_xor(rs, 2); rs += __shfl_xor(rs, 4); rs += __shfl_xor(rs, 8);
      l[rg] = l[rg] * alpha + rs; m[rg] = mn;
#pragma unroll
      for (int ni = 0; ni < 4; ++ni) O[ni][rg] *= alpha;
    }
    __syncthreads();
#pragma unroll
    for (int kk = 0; kk < 2; ++kk) { const bf16x8 ap = *(const bf16x8*)&Ps[w][l15][32 * kk + 8 * l4];
#pragma unroll
      for (int ni = 0; ni < 4; ++ni) { const bf16x8 bv = *(const bf16x8*)&Vt[16 * ni + l15][32 * kk + 8 * l4]; O[ni] = __builtin_amdgcn_mfma_f32_16x16x32_bf16(ap, bv, O[ni], 0, 0, 0); } }
  }
#pragma unroll
  for (int rg = 0; rg < 4; ++rg) { const float il = 1.0f / l[rg]; const size_t row = (size_t)(qrow0 + 16 * w + 4 * l4 + rg);
#pragma unroll
    for (int ni = 0; ni < 4; ++ni) MIX[row * DM + h * 64 + 16 * ni + l15] = (bf16_t)f2bf(O[ni][rg] * il); }
  __syncthreads();
}

__device__ __forceinline__ void st_ssd_prep(const bf16_t* XBC, float* DT, const float* cw, const float* cb, const float* dt_bias, bf16_t* XBCC) {
  const size_t total = (size_t)MTOK * 640;
  for (size_t i = (size_t)BIDX * NT + TIDX; i < total; i += (size_t)GDIM * NT) {
    const int r = (int)(i / 640), ch = (int)(i % 640), j = r % TPB;
    const bool hasp = (j != 0 && j != CTXL), hasn = (j != CTXL - 1 && j != TPB - 1);
    float v = cw[640 + ch] * bf2f(XBC[(size_t)r * 768 + ch]) + cb[ch];
    if (hasp) v += cw[ch] * bf2f(XBC[(size_t)(r - 1) * 768 + ch]);
    if (hasn) v += cw[1280 + ch] * bf2f(XBC[(size_t)(r + 1) * 768 + ch]);
    XBCC[i] = (bf16_t)f2bf(siluf(v));
  }
  for (size_t i = (size_t)BIDX * NT + TIDX; i < (size_t)MTOK * 12; i += (size_t)GDIM * NT) {
    const float x = DT[i] + dt_bias[i % 12];
    DT[i] = x > 20.f ? x : log1pf(expf(x));
  }
}
__device__ __forceinline__ void ssd_scan_item(int item, const bf16_t* XBCC, const float* DT, const float* a_log, float* Y, char* lds) {
  const int half = TIDX >> 8, tid = TIDX & 255;
  float* base = (float*)(lds + half * 25088);
  float (*xs)[64] = (float (*)[64])base; float (*Bs)[64] = (float (*)[64])(base + 2048); float (*Cs)[64] = (float (*)[64])(base + 4096);
  float* dAs = base + 6144; float* dts = base + 6176;
  const int bh = 2 * item + half, b = bh / 6, h = bh % 6, g = h / 3, p = tid >> 2, q = tid & 3;
  for (int dir = 0; dir < 2; ++dir) {
    const float a = -expf(a_log[dir * 6 + h]);
    float st[16];
#pragma unroll
    for (int n = 0; n < 16; ++n) st[n] = 0.f;
    for (int ci = 0; ci < TPB / 32; ++ci) {
      for (int e = tid; e < 32 * 64; e += 256) { const int i = e >> 6, cc = e & 63, qi = ci * 32 + i;
        const int j = dir == 0 ? qi : (qi < CTXL ? CTXL - 1 - qi : TPB - 1 - (qi - CTXL)); const size_t r = (size_t)b * TPB + j;
        xs[i][cc] = bf2f(XBCC[r * 640 + h * 64 + cc]); Bs[i][cc] = bf2f(XBCC[r * 640 + 384 + g * 64 + cc]); Cs[i][cc] = bf2f(XBCC[r * 640 + 512 + g * 64 + cc]); }
      if (tid < 32) { const int qi = ci * 32 + tid; const int j = dir == 0 ? qi : (qi < CTXL ? CTXL - 1 - qi : TPB - 1 - (qi - CTXL)); const size_t r = (size_t)b * TPB + j;
        const float dt = DT[r * 12 + dir * 6 + h]; dts[tid] = dt; dAs[tid] = expf(dt * a); }
      __syncthreads();
      for (int i = 0; i < 32; ++i) {
        const float d = dAs[i], dtx = dts[i] * xs[i][p]; float y = 0.f;
#pragma unroll
        for (int n = 0; n < 16; ++n) { st[n] = st[n] * d + dtx * Bs[i][16 * q + n]; y += Cs[i][16 * q + n] * st[n]; }
        y += __shfl_xor(y, 1); y += __shfl_xor(y, 2);
        if (q == 0) { const int qi = ci * 32 + i; const int j = dir == 0 ? qi : (qi < CTXL ? CTXL - 1 - qi : TPB - 1 - (qi - CTXL)); float* yp = Y + ((size_t)b * TPB + j) * 384 + h * 64 + p;
          if (dir == 0) *yp = y; else *yp += y; }
      }
      __syncthreads();
    }
  }
}
__device__ __forceinline__ void st_ssd_out(const float* Y, const bf16_t* XBCC, const bf16_t* VZ, const float* dskip, const float* nw, bf16_t* MIX) {
  const int lane = TIDX & 63, gw = BIDX * 8 + (TIDX >> 6), ngw = GDIM * 8;
  for (int it = gw; it < MTOK * 2; it += ngw) {
    const int r = it >> 1, g = it & 1; float gv[3]; float ss = 0.f;
#pragma unroll
    for (int i = 0; i < 3; ++i) { const int c = g * 192 + lane + 64 * i, hh = c >> 6;
      const float y = Y[(size_t)r * 384 + c] + bf2f(XBCC[(size_t)r * 640 + c]) * dskip[hh]; const float zv = bf2f(VZ[(size_t)r * 512 + 128 + c]);
      gv[i] = y * siluf(zv); ss += gv[i] * gv[i]; }
    const float rstd = rsqrtf(wave_sum(ss) * (1.0f / 192.0f) + EPS);
#pragma unroll
    for (int i = 0; i < 3; ++i) { const int c = g * 192 + lane + 64 * i; MIX[(size_t)r * DM + 384 + c] = (bf16_t)f2bf(gv[i] * rstd * nw[c]); }
  }
}


__device__ __forceinline__ void ssd_conv8(const bf16_t* XBC, size_t r, int c0, bool hasp, bool hasn, const float* cw, const float* cb, float (&o)[8]) {
  const bf16x8 cur = *(const bf16x8*)(XBC + r * 768 + c0);
  bf16x8 prv = (bf16x8){0, 0, 0, 0, 0, 0, 0, 0}, nxt = (bf16x8){0, 0, 0, 0, 0, 0, 0, 0};
  if (hasp) prv = *(const bf16x8*)(XBC + (r - 1) * 768 + c0);
  if (hasn) nxt = *(const bf16x8*)(XBC + (r + 1) * 768 + c0);
#pragma unroll
  for (int e = 0; e < 8; ++e) { const float v = cw[c0 + e] * bf2f((bf16_t)prv[e]) + cw[640 + c0 + e] * bf2f((bf16_t)cur[e]) + cw[1280 + c0 + e] * bf2f((bf16_t)nxt[e]) + cb[c0 + e]; o[e] = siluf(v); }
}
__device__ __forceinline__ float softplusf(float x) { return x > 20.f ? x : log1pf(expf(x)); }
__device__ __forceinline__ void wave_scan128(float e0, float e1, int lane, float& c0, float& c1) {
  float x = e0 + e1;
#pragma unroll
  for (int o = 1; o < 64; o <<= 1) { const float v = __shfl_up(x, o); if (lane >= o) x += v; }
  const float excl = x - (e0 + e1); c0 = excl + e0; c1 = excl + e0 + e1;
}
__device__ __forceinline__ int ssd_chunk_j0(int cidx) { return cidx < 2 ? cidx * 128 : CTXL + (cidx - 2) * 128; }

__device__ __forceinline__ void ssd1_item(int item, const bf16_t* XBC, const float* DT, const float* cw, const float* cb, const float* dt_bias, const float* a_log,
                                          float* YIN, float* ST, float* DEC, char* lds) {
  bf16_t (*Cm)[72] = (bf16_t (*)[72])lds; bf16_t (*Bm)[72] = (bf16_t (*)[72])(lds + 18432);
  bf16_t (*BT)[136] = (bf16_t (*)[136])(lds + 36864); bf16_t (*Xt)[136] = (bf16_t (*)[136])(lds + 54272); bf16_t (*Mm)[136] = (bf16_t (*)[136])(lds + 71680);
  float* tab = (float*)(lds + 106496); float* dtf = tab; float* dtb = tab + 128; float* acf = tab + 256; float* acb = tab + 384; float* wf = tab + 512; float* wb = tab + 640;
  const int tid = TIDX, lane = tid & 63, w = tid >> 6, l15 = lane & 15, l4 = lane >> 4;
  const int h = item % 6, bc = item / 6, cidx = bc % 34, b = bc / 34, g = h / 3, j0 = ssd_chunk_j0(cidx);
  const size_t r0 = (size_t)b * TPB + j0;
#pragma unroll 2
  for (int i = 0; i < 6; ++i) { const int task = tid + NT * i, t = task / 24, cg = task % 24, kind = cg >> 3, q = cg & 7, j = j0 + t;
    const int c0 = kind == 0 ? h * 64 + 8 * q : (kind == 1 ? 384 + g * 64 + 8 * q : 512 + g * 64 + 8 * q);
    float o[8]; ssd_conv8(XBC, r0 + t, c0, j != 0 && j != CTXL, j != CTXL - 1 && j != TPB - 1, cw, cb, o);
    if (kind == 0) {
#pragma unroll
      for (int e = 0; e < 8; ++e) Xt[8 * q + e][t] = (bf16_t)f2bf(o[e]);
    } else { const u32x4 pk = (u32x4){pk2bf(o[0], o[1]), pk2bf(o[2], o[3]), pk2bf(o[4], o[5]), pk2bf(o[6], o[7])};
      if (kind == 1) { *(u32x4*)&Bm[t][8 * q] = pk;
#pragma unroll
        for (int e = 0; e < 8; ++e) BT[8 * q + e][t] = (bf16_t)f2bf(o[e]); }
      else *(u32x4*)&Cm[t][8 * q] = pk; } }
  if (w < 2) { const int dir = w; const float a = -expf(a_log[dir * 6 + h]), bias = dt_bias[dir * 6 + h];
    const int t0 = dir == 0 ? 2 * lane : 127 - 2 * lane, t1 = dir == 0 ? 2 * lane + 1 : 126 - 2 * lane;
    const float d0 = softplusf(DT[(r0 + t0) * 12 + dir * 6 + h] + bias), d1 = softplusf(DT[(r0 + t1) * 12 + dir * 6 + h] + bias);
    float c0, c1; wave_scan128(d0 * a, d1 * a, lane, c0, c1);
    const float tot = __shfl(c1, 63);
    float* dtt = dir == 0 ? dtf : dtb; float* ac = dir == 0 ? acf : acb; float* ww = dir == 0 ? wf : wb;
    dtt[t0] = d0; dtt[t1] = d1; ac[t0] = c0; ac[t1] = c1; ww[t0] = __expf(tot - c0) * d0; ww[t1] = __expf(tot - c1) * d1;
    if (lane == 0) DEC[(((size_t)b * 34 + cidx) * 2 + dir) * 6 + h] = __expf(tot); }
  __syncthreads();
  {
    f32x4 accG[8];
#pragma unroll
    for (int ni = 0; ni < 8; ++ni) accG[ni] = (f32x4){0.f, 0.f, 0.f, 0.f};
#pragma unroll
    for (int kk = 0; kk < 2; ++kk) { const bf16x8 a = *(const bf16x8*)&Cm[16 * w + l15][32 * kk + 8 * l4];
#pragma unroll
      for (int ni = 0; ni < 8; ++ni) { const bf16x8 bb = *(const bf16x8*)&Bm[16 * ni + l15][32 * kk + 8 * l4]; accG[ni] = __builtin_amdgcn_mfma_f32_16x16x32_bf16(a, bb, accG[ni], 0, 0, 0); } }
    float aft[4], abt[4];
#pragma unroll
    for (int rg = 0; rg < 4; ++rg) { aft[rg] = acf[16 * w + 4 * l4 + rg]; abt[rg] = acb[16 * w + 4 * l4 + rg]; }
#pragma unroll
    for (int ni = 0; ni < 8; ++ni) { const int sidx = 16 * ni + l15; const float afs = acf[sidx], abs_ = acb[sidx], dfs = dtf[sidx], dbs = dtb[sidx];
#pragma unroll
      for (int rg = 0; rg < 4; ++rg) { const int t = 16 * w + 4 * l4 + rg;
        const float f = sidx <= t ? __expf(aft[rg] - afs) * dfs : 0.f, bk = sidx >= t ? __expf(abt[rg] - abs_) * dbs : 0.f;
        Mm[t][sidx] = (bf16_t)f2bf(accG[ni][rg] * (f + bk)); } }
  }
  __syncthreads();
  {
    f32x4 acc[4];
#pragma unroll
    for (int ni = 0; ni < 4; ++ni) acc[ni] = (f32x4){0.f, 0.f, 0.f, 0.f};
#pragma unroll
    for (int kk = 0; kk < 4; ++kk) { const bf16x8 a = *(const bf16x8*)&Mm[16 * w + l15][32 * kk + 8 * l4];
#pragma unroll
      for (int ni = 0; ni < 4; ++ni) { const bf16x8 bb = *(const bf16x8*)&Xt[16 * ni + l15][32 * kk + 8 * l4]; acc[ni] = __builtin_amdgcn_mfma_f32_16x16x32_bf16(a, bb, acc[ni], 0, 0, 0); } }
#pragma unroll
    for (int rg = 0; rg < 4; ++rg)
#pragma unroll
      for (int ni = 0; ni < 4; ++ni) YIN[(r0 + 16 * w + 4 * l4 + rg) * 384 + h * 64 + 16 * ni + l15] = acc[ni][rg];
  }
  {
    const int dir = w >> 2, mt = w & 3; const float* ww = dir == 0 ? wf : wb;
    f32x4 acc[4];
#pragma unroll
    for (int ni = 0; ni < 4; ++ni) acc[ni] = (f32x4){0.f, 0.f, 0.f, 0.f};
#pragma unroll
    for (int kk = 0; kk < 4; ++kk) { const bf16x8 raw = *(const bf16x8*)&Xt[16 * mt + l15][32 * kk + 8 * l4];
      const f32x4 w0 = *(const f32x4*)(ww + 32 * kk + 8 * l4), w1 = *(const f32x4*)(ww + 32 * kk + 8 * l4 + 4);
      u32x4 pk; pk.x = pk2bf(bf2f((bf16_t)raw[0]) * w0.x, bf2f((bf16_t)raw[1]) * w0.y); pk.y = pk2bf(bf2f((bf16_t)raw[2]) * w0.z, bf2f((bf16_t)raw[3]) * w0.w);
      pk.z = pk2bf(bf2f((bf16_t)raw[4]) * w1.x, bf2f((bf16_t)raw[5]) * w1.y); pk.w = pk2bf(bf2f((bf16_t)raw[6]) * w1.z, bf2f((bf16_t)raw[7]) * w1.w);
      const bf16x8 a = __builtin_bit_cast(bf16x8, pk);
#pragma unroll
      for (int ni = 0; ni < 4; ++ni) { const bf16x8 bb = *(const bf16x8*)&BT[16 * ni + l15][32 * kk + 8 * l4]; acc[ni] = __builtin_amdgcn_mfma_f32_16x16x32_bf16(a, bb, acc[ni], 0, 0, 0); } }
    float* sp = ST + ((((size_t)b * 34 + cidx) * 2 + dir) * 6 + h) * 4096;
#pragma unroll
    for (int rg = 0; rg < 4; ++rg)
#pragma unroll
      for (int ni = 0; ni < 4; ++ni) sp[(16 * mt + 4 * l4 + rg) * 64 + 16 * ni + l15] = acc[ni][rg];
  }
  __syncthreads();
}

__device__ __forceinline__ void st_ssd_scan2(float* ST, const float* DEC) {
  for (int idx = BIDX * NT + TIDX; idx < 4 * 2 * 6 * 4096; idx += GDIM * NT) {
    const int e = idx & 4095, bdh = idx >> 12, h = bdh % 6, dir = (bdh / 6) & 1, b = bdh / 12;
    float v[34], d[34];
#pragma unroll
    for (int st = 0; st < 34; ++st) { const int cidx = dir == 0 ? st : (st < 2 ? 1 - st : 35 - st); const size_t o = (((size_t)b * 34 + cidx) * 2 + dir) * 6 + h; v[st] = ST[o * 4096 + e]; d[st] = DEC[o]; }
    float H = 0.f;
#pragma unroll
    for (int st = 0; st < 34; ++st) { const int cidx = dir == 0 ? st : (st < 2 ? 1 - st : 35 - st); const size_t o = (((size_t)b * 34 + cidx) * 2 + dir) * 6 + h; ST[o * 4096 + e] = H; H = H * d[st] + v[st]; }
  }
}

__device__ __forceinline__ void ssd3_item(int b, int cidx, int g, const bf16_t* XBC, const bf16_t* VZ, const float* DT, const float* cw, const float* cb, const float* dt_bias, const float* a_log,
                                          const float* dskip, const float* nw, const float* YIN, const float* ST, bf16_t* MIX, char* lds) {
  bf16_t (*Cm)[72] = (bf16_t (*)[72])lds; bf16_t (*Hm)[72] = (bf16_t (*)[72])(lds + 18432);
  float* ef = (float*)(lds + 18432 + 55296);
  float (*Yt)[196] = (float (*)[196])lds;
  const int tid = TIDX, lane = tid & 63, w = tid >> 6, l15 = lane & 15, l4 = lane >> 4, j0 = ssd_chunk_j0(cidx);
  const size_t r0 = (size_t)b * TPB + j0;
#pragma unroll
  for (int i = 0; i < 2; ++i) { const int task = tid + NT * i, t = task >> 3, q = task & 7, j = j0 + t;
    float o[8]; ssd_conv8(XBC, r0 + t, 512 + g * 64 + 8 * q, j != 0 && j != CTXL, j != CTXL - 1 && j != TPB - 1, cw, cb, o);
    *(u32x4*)&Cm[t][8 * q] = (u32x4){pk2bf(o[0], o[1]), pk2bf(o[2], o[3]), pk2bf(o[4], o[5]), pk2bf(o[6], o[7])}; }
#pragma unroll 4
  for (int i = 0; i < 12; ++i) { const int f4 = tid + NT * i, hd = f4 >> 10, rem = f4 & 1023, p = rem >> 4, n4 = (rem & 15) * 4, hh = hd >> 1, dir = hd & 1;
    const f32x4 v = *(const f32x4*)(ST + ((((size_t)b * 34 + cidx) * 2 + dir) * 6 + 3 * g + hh) * 4096 + p * 64 + n4);
    *(u32x2*)&Hm[hd * 64 + p][n4] = (u32x2){pk2bf(v.x, v.y), pk2bf(v.z, v.w)}; }
  if (w < 6) { const int hh = w >> 1, dir = w & 1, h = 3 * g + hh; const float a = -expf(a_log[dir * 6 + h]), bias = dt_bias[dir * 6 + h];
    const int t0 = dir == 0 ? 2 * lane : 127 - 2 * lane, t1 = dir == 0 ? 2 * lane + 1 : 126 - 2 * lane;
    const float d0 = softplusf(DT[(r0 + t0) * 12 + dir * 6 + h] + bias), d1 = softplusf(DT[(r0 + t1) * 12 + dir * 6 + h] + bias);
    float c0, c1; wave_scan128(d0 * a, d1 * a, lane, c0, c1);
    ef[w * 128 + t0] = __expf(c0); ef[w * 128 + t1] = __expf(c1); }
  __syncthreads();
  float yv[3][4][4];
  {
    bf16x8 ca[2];
#pragma unroll
    for (int kk = 0; kk < 2; ++kk) ca[kk] = *(const bf16x8*)&Cm[16 * w + l15][32 * kk + 8 * l4];
#pragma unroll
    for (int hh = 0; hh < 3; ++hh) {
      f32x4 accF[4], accB[4];
#pragma unroll
      for (int ni = 0; ni < 4; ++ni) { accF[ni] = (f32x4){0.f, 0.f, 0.f, 0.f}; accB[ni] = (f32x4){0.f, 0.f, 0.f, 0.f}; }
#pragma unroll
      for (int kk = 0; kk < 2; ++kk)
#pragma unroll
        for (int ni = 0; ni < 4; ++ni) {
          accF[ni] = __builtin_amdgcn_mfma_f32_16x16x32_bf16(ca[kk], *(const bf16x8*)&Hm[(hh * 2 + 0) * 64 + 16 * ni + l15][32 * kk + 8 * l4], accF[ni], 0, 0, 0);
          accB[ni] = __builtin_amdgcn_mfma_f32_16x16x32_bf16(ca[kk], *(const bf16x8*)&Hm[(hh * 2 + 1) * 64 + 16 * ni + l15][32 * kk + 8 * l4], accB[ni], 0, 0, 0); }
#pragma unroll
      for (int rg = 0; rg < 4; ++rg) { const int t = 16 * w + 4 * l4 + rg; const float eF = ef[(hh * 2 + 0) * 128 + t], eB = ef[(hh * 2 + 1) * 128 + t];
#pragma unroll
        for (int ni = 0; ni < 4; ++ni) yv[hh][ni][rg] = eF * accF[ni][rg] + eB * accB[ni][rg]; }
    }
  }
  __syncthreads();
#pragma unroll
  for (int hh = 0; hh < 3; ++hh)
#pragma unroll
    for (int rg = 0; rg < 4; ++rg)
#pragma unroll
      for (int ni = 0; ni < 4; ++ni) Yt[16 * w + 4 * l4 + rg][hh * 64 + 16 * ni + l15] = yv[hh][ni][rg];
  __syncthreads();
  float cw0[3], cw1[3], cw2[3], cbv[3], nwv[3], dsk[3];
#pragma unroll
  for (int k = 0; k < 3; ++k) { const int col = g * 192 + 64 * k + lane; cw0[k] = cw[col]; cw1[k] = cw[640 + col]; cw2[k] = cw[1280 + col]; cbv[k] = cb[col]; nwv[k] = nw[col]; dsk[k] = dskip[3 * g + k]; }
#pragma unroll 2
  for (int rr = 0; rr < 16; ++rr) { const int t = 16 * w + rr, j = j0 + t; const size_t r = r0 + t; const bool hasp = j != 0 && j != CTXL, hasn = j != CTXL - 1 && j != TPB - 1;
    const bf16_t* xp = XBC + r * 768 + g * 192 + lane; const float* yp = YIN + r * 384 + g * 192 + lane; const bf16_t* zp = VZ + r * 512 + 128 + g * 192 + lane;
    float gt[3]; float ss = 0.f;
#pragma unroll
    for (int k = 0; k < 3; ++k) { float xv = cw1[k] * bf2f(xp[64 * k]) + cbv[k];
      if (hasp) xv += cw0[k] * bf2f(xp[64 * k - 768]);
      if (hasn) xv += cw2[k] * bf2f(xp[64 * k + 768]);
      xv = siluf(xv);
      const float y = yp[64 * k] + Yt[t][64 * k + lane] + dsk[k] * xv;
      gt[k] = y * siluf(bf2f(zp[64 * k])); ss += gt[k] * gt[k]; }
    const float rstd = rsqrtf(wave_sum(ss) * (1.0f / 192.0f) + EPS);
    bf16_t* op = MIX + r * DM + 384 + g * 192 + lane;
#pragma unroll
    for (int k = 0; k < 3; ++k) op[64 * k] = (bf16_t)f2bf(gt[k] * rstd * nwv[k]); }
  __syncthreads();
}

__device__ __forceinline__ void st_router(const float* xl, const float* xc, const float* g, const float* modv_layer, const float* w_router, const float* rbias,
                                          bf16_t* H2, int* ctl, int* tok_pair, float* tok_w, int skip_ctx, char* lds) {
  float* wl = (float*)lds;
  const int tid = TIDX, lane = tid & 63, gw = BIDX * 8 + (tid >> 6), ngw = GDIM * 8;
  int* hist = (int*)(lds + 81920);
  if (tid < 32) hist[tid] = 0;
  for (int idx = tid; idx < 4096; idx += NT) { const int k = idx >> 2, e4 = idx & 3, row = ((k & 3) * 4 + (k >> 8)) * 64 + ((k & 255) >> 2);
    *(f32x4*)(wl + row * 20 + 4 * e4) = *(const f32x4*)(w_router + (size_t)k * 16 + 4 * e4); }
  __syncthreads();
  for (int r = gw; r < MTOK; r += ngw) {
    if (skip_ctx && (r % TPB) < CTXL) continue;
    const float* xr = xrow(xl, xc, r); const float* mv = modv_layer + (size_t)mrow_of(r) * 6144;
    f32x4 v[4]; float ss = 0.f;
#pragma unroll
    for (int j = 0; j < 4; ++j) { v[j] = *(const f32x4*)(xr + 4 * lane + 256 * j); ss += v[j].x * v[j].x + v[j].y * v[j].y + v[j].z * v[j].z + v[j].w * v[j].w; }
    const float rstd = rsqrtf(wave_sum(ss) * (1.0f / DM) + EPS);
    float lg[16];
#pragma unroll
    for (int e = 0; e < 16; ++e) lg[e] = 0.f;
#pragma unroll
    for (int j = 0; j < 4; ++j) { const int k = 4 * lane + 256 * j;
      const f32x4 gg = *(const f32x4*)(g + k), sh = *(const f32x4*)(mv + 3072 + k), sc = *(const f32x4*)(mv + 4096 + k);
      float o[4]; o[0] = v[j].x * rstd * gg.x * (1.f + sc.x) + sh.x; o[1] = v[j].y * rstd * gg.y * (1.f + sc.y) + sh.y;
      o[2] = v[j].z * rstd * gg.z * (1.f + sc.z) + sh.z; o[3] = v[j].w * rstd * gg.w * (1.f + sc.w) + sh.w;
      u32x2 wpk; wpk.x = pk2bf(o[0], o[1]); wpk.y = pk2bf(o[2], o[3]);
      *(u32x2*)(H2 + (size_t)r * DM + k) = wpk;
#pragma unroll
      for (int q = 0; q < 4; ++q) { const float* wr_ = wl + ((q * 4 + j) * 64 + lane) * 20;
#pragma unroll
        for (int e4 = 0; e4 < 4; ++e4) { const f32x4 wr = *(const f32x4*)(wr_ + 4 * e4);
          lg[4 * e4] += o[q] * wr.x; lg[4 * e4 + 1] += o[q] * wr.y; lg[4 * e4 + 2] += o[q] * wr.z; lg[4 * e4 + 3] += o[q] * wr.w; } } }
    float h8[8], h4[4], h2[2], h1;
#pragma unroll
    for (int i = 0; i < 8; ++i) { const bool up = (lane & 32) != 0; const float keep = up ? lg[8 + i] : lg[i], give = up ? lg[i] : lg[8 + i]; h8[i] = keep + __shfl_xor(give, 32); }
#pragma unroll
    for (int i = 0; i < 4; ++i) { const bool up = (lane & 16) != 0; const float keep = up ? h8[4 + i] : h8[i], give = up ? h8[i] : h8[4 + i]; h4[i] = keep + __shfl_xor(give, 16); }
#pragma unroll
    for (int i = 0; i < 2; ++i) { const bool up = (lane & 8) != 0; const float keep = up ? h4[2 + i] : h4[i], give = up ? h4[i] : h4[2 + i]; h2[i] = keep + __shfl_xor(give, 8); }
    { const bool up = (lane & 4) != 0; const float keep = up ? h2[1] : h2[0], give = up ? h2[0] : h2[1]; h1 = keep + __shfl_xor(give, 4); }
    h1 += __shfl_xor(h1, 2); h1 += __shfl_xor(h1, 1);
#pragma unroll
    for (int e = 0; e < 16; ++e) lg[e] = __shfl(h1, ((e >> 3) & 1) * 32 + ((e >> 2) & 1) * 16 + ((e >> 1) & 1) * 8 + (e & 1) * 4);
    if (lane == 0) {
      int best = 0, bi1 = 0, bi2 = 1; float bestv = -1e30f, bs1 = 0.f, bs2 = 0.f;
#pragma unroll
      for (int gq = 0; gq < 4; ++gq) { float m1 = -1e30f, m2 = -1e30f, s1 = 0.f, s2 = 0.f; int i1 = 0, i2 = 0;
#pragma unroll
        for (int i = 0; i < 4; ++i) { const float scv = 1.0f / (1.0f + expf(-lg[4 * gq + i])); const float sv = scv + rbias[4 * gq + i];
          if (sv > m1) { m2 = m1; s2 = s1; i2 = i1; m1 = sv; s1 = scv; i1 = i; } else if (sv > m2) { m2 = sv; s2 = scv; i2 = i; } }
        if (m1 + m2 > bestv) { bestv = m1 + m2; best = gq; bi1 = i1; bi2 = i2; bs1 = s1; bs2 = s2; } }
      const int ia = bi1 < bi2 ? bi1 : bi2, ib = bi1 < bi2 ? bi2 : bi1;
      const int tri = ia == 0 ? ib - 1 : (ia == 1 ? ib + 1 : 5);
      const int pidx = best * 6 + tri;
      const float sa = bi1 < bi2 ? bs1 : bs2, sb = bi1 < bi2 ? bs2 : bs1, inv = 1.0f / (sa + sb);
      const int rank = atomicAdd(&hist[pidx], 1);
      tok_pair[r] = pidx | (rank << 5); tok_w[2 * r] = sa * inv; tok_w[2 * r + 1] = sb * inv;
    }
  }
  __syncthreads();
  if (tid < 32) ctl[CT_CNTB + BIDX * 32 + tid] = tid < 24 ? hist[tid] : 0;
}
__device__ __forceinline__ void st_moe_gather(const bf16_t* H2, bf16_t* H2S, int* ctl, const int* tok_pair, const float* tok_w, int* sorted_tok, float* sorted_w, int skip_ctx, char* lds) {
  int* sbase = (int*)lds; int* rtot = sbase + 32; int* rpre = rtot + 512;
  const int tid = TIDX, bid = BIDX;
  { const int p = tid & 31, seg = tid >> 5; int tot = 0, pre = 0;
#pragma unroll 4
    for (int i = 0; i < 16; ++i) { const int bb = seg * 16 + i; const int cv = ctl[CT_CNTB + bb * 32 + p]; tot += cv; pre += bb < bid ? cv : 0; }
    rtot[seg * 32 + p] = tot; rpre[seg * 32 + p] = pre; }
  __syncthreads();
  if (tid < 32) { int tot = 0, pre = 0;
#pragma unroll
    for (int sg = 0; sg < 16; ++sg) { tot += rtot[sg * 32 + tid]; pre += rpre[sg * 32 + tid]; }
    rtot[tid] = tot; rpre[tid] = pre; }
  __syncthreads();
  if (tid == 0) { int base = 0, nt = 0;
#pragma unroll 1
    for (int p = 0; p < 24; ++p) { sbase[p] = base + rpre[p]; const int n = rtot[p], tl = (n + 255) >> 8;
      if (bid == 0) { ctl[CT_BASE + p] = base; for (int t = 0; t < tl; ++t) ctl[CT_TP + nt + t] = p; }
      nt += tl; base += tl * 256; }
    if (bid == 0) { ctl[CT_BASE + 24] = base; ctl[CT_NT] = nt; } }
  __syncthreads();
  const int lane = tid & 63, gw = bid * 8 + (tid >> 6), ngw = GDIM * 8;
  for (int r = gw; r < MTOK; r += ngw) {
    if (skip_ctx && (r % TPB) < CTXL) continue;
    const int pk = tok_pair[r]; const int slot = sbase[pk & 31] + (pk >> 5);
    if (lane == 0) { sorted_tok[slot] = r; sorted_w[2 * slot] = tok_w[2 * r]; sorted_w[2 * slot + 1] = tok_w[2 * r + 1]; }
    const u32x4* sp = (const u32x4*)(H2 + (size_t)r * DM); u32x4* d = (u32x4*)(H2S + (size_t)slot * DM);
    d[lane] = sp[lane]; d[lane + 64] = sp[lane + 64];
  }
  __syncthreads();
}
__device__ __forceinline__ void st_final(float* xl, const float* g) {
  const int lane = TIDX & 63, gw = BIDX * 8 + (TIDX >> 6), ngw = GDIM * 8;
  for (int r = gw; r < NB * SEQ; r += ngw) {
    float* xr = xl + (size_t)r * DM; f32x4 v[4]; float ss = 0.f;
#pragma unroll
    for (int j = 0; j < 4; ++j) { v[j] = *(const f32x4*)(xr + 4 * lane + 256 * j); ss += v[j].x * v[j].x + v[j].y * v[j].y + v[j].z * v[j].z + v[j].w * v[j].w; }
    const float rstd = rsqrtf(wave_sum(ss) * (1.0f / DM) + EPS);
#pragma unroll
    for (int j = 0; j < 4; ++j) { const int k = 4 * lane + 256 * j; const f32x4 gg = *(const f32x4*)(g + k);
      *(f32x4*)(xr + k) = (f32x4){v[j].x * rstd * gg.x, v[j].y * rstd * gg.y, v[j].z * rstd * gg.z, v[j].w * rstd * gg.w}; }
  }
}

namespace pg8 {
#define PG8_LAS __attribute__((address_space(3)))
typedef unsigned short bf16_t;
typedef short bf16x8 __attribute__((ext_vector_type(8)));
typedef float f32x4 __attribute__((ext_vector_type(4)));
typedef unsigned u32x4 __attribute__((ext_vector_type(4)));
constexpr int BM = 256, BK = 64, HALF = 128, HTB = HALF * BK * 2  , STAGE_BYTES = 8 * HTB, NXCD = 8, WGM = 8;

__host__ __device__ __forceinline__ int lds_byte(int r, int c) { const int st = (r >> 4) * 2 + (c >> 5), rr = r & 15, cc = c & 31, ob = rr * 64 + cc * 2; return st * 1024 + (ob ^ (((ob >> 9) & 1) << 5)); }
__host__ __device__ __forceinline__ void stage_rc(int b, int& R, int& C) { const int st = b / 1024, sb = b % 1024, swz = sb ^ (((sb >> 9) & 1) << 5); R = (st >> 1) * 16 + swz / 64; C = (st & 1) * 32 + (swz % 64) / 2; }
__host__ __device__ __forceinline__ int perm32(int rho) { const int n = rho >> 4, i = rho & 15; return 8 * (i >> 2) + 4 * n + (i & 3); }

struct Unit { int pm, pn, fin; const char* A; const char* B; };
struct Gemm { int K, lda, ldb; };

__device__ __forceinline__ void tile_of(int L, int nM, int nN, int& pm, int& pn) {
    const int nwg = nM * nN; int wgid = L; { const int q = nwg / NXCD, r = nwg % NXCD, xcd = wgid % NXCD, off = wgid / NXCD; wgid = (xcd < r ? xcd * (q + 1) : r * (q + 1) + (xcd - r) * q) + off; }
    const int nig = WGM * nN, gid = wgid / nig, fm = gid * WGM, gsz = (nM - fm) < WGM ? (nM - fm) : WGM;
    pm = fm + ((wgid % nig) % gsz); pn = (wgid % nig) / gsz;
}
__device__ __forceinline__ unsigned cvt_pk_bf16(float lo, float hi) { unsigned r; asm volatile("v_cvt_pk_bf16_f32 %0, %1, %2" : "=v"(r) : "v"(lo), "v"(hi)); return r; }
template <class Epi, class Sched, bool ALIGN_EPI = false, bool SP2 = false>
__device__ __forceinline__ void gemm_phase(PG8_LAS unsigned char* lds, const Gemm g, const Sched& S, const Epi& E) {
    const int tid = opq_v((int)threadIdx.x), wid = __builtin_amdgcn_readfirstlane(tid >> 6), lane = tid & 63, wr = wid >> 2, wc = wid & 3, fr = lane & 15, fq = lane >> 4;
    const int K = g.K, nt = K / BK;
    unsigned voffA[2], voffB[2];
#pragma unroll
    for (int i = 0; i < 2; ++i) { int R, C; stage_rc(tid * 16 + i * 8192, R, C); const int Rb = Epi::PERM ? ((R & ~31) + perm32(R & 31)) : R;
        voffA[i] = (unsigned)(R * g.lda + C) * 2u; voffB[i] = (unsigned)(Rb * g.ldb + C) * 2u; }
    const size_t kstep = (size_t)(BK * 2);
    const size_t hstepA = (size_t)HALF * g.lda * 2, hstepB = (size_t)HALF * g.ldb * 2;
    const unsigned ldsw = (unsigned)wid * 1024u;
    const int aoff = lds_byte(wr * 64 + fr, fq * 8), boff = lds_byte(wc * 32 + fr, fq * 8);
#define PG8_SA(b, h) (((b) * 2 + (h)) * HTB)
#define PG8_SB(b, h) ((4 + (b) * 2 + (h)) * HTB)
#define PG8_STAGE(bufoff, gbase, voff) do { _Pragma("unroll") for (int _i = 0; _i < 2; ++_i) \
        __builtin_amdgcn_global_load_lds((const unsigned*)((const char*)(gbase) + (voff)[_i]), (PG8_LAS unsigned*)(lds + (bufoff) + ldsw + _i * 8192), 16, 0, 0); } while (0)
#define PG8_LDA(dst, b, h) do { _Pragma("unroll") for (int m = 0; m < 4; ++m) _Pragma("unroll") for (int k = 0; k < 2; ++k) dst[m][k] = *(const PG8_LAS bf16x8*)(lds + PG8_SA(b, h) + aoff + m * 2048 + k * 1024); } while (0)
#define PG8_LDB(dst, b, h) do { _Pragma("unroll") for (int n = 0; n < 2; ++n) _Pragma("unroll") for (int k = 0; k < 2; ++k) dst[n][k] = *(const PG8_LAS bf16x8*)(lds + PG8_SB(b, h) + boff + n * 2048 + k * 1024); } while (0)
#define PG8_MMA(ai, bj, At, Bt) do { __builtin_amdgcn_s_setprio(1); _Pragma("unroll") for (int m = 0; m < 4; ++m) _Pragma("unroll") for (int n = 0; n < 2; ++n) _Pragma("unroll") for (int k = 0; k < 2; ++k) \
        acc[ai][bj][m][n] = __builtin_amdgcn_mfma_f32_16x16x32_bf16(Bt[n][k], At[m][k], acc[ai][bj][m][n], 0, 0, 0); __builtin_amdgcn_s_setprio(0); } while (0)
#define PG8_WAIT_V(n) asm volatile("s_waitcnt vmcnt(" #n ")" ::: "memory")
#define PG8_WAIT_L(n) asm volatile("s_waitcnt lgkmcnt(" #n ")" ::: "memory")
#define PG8_BAR __builtin_amdgcn_s_barrier()
#define PG8_SCHED __builtin_amdgcn_sched_barrier(0)
    Unit cur, nxt; int ui = 0;
    if (!S.next(0, cur)) return;
    f32x4 acc[2][2][4][2];
#pragma unroll
    for (int a = 0; a < 2; ++a)
#pragma unroll
        for (int b = 0; b < 2; ++b)
#pragma unroll
            for (int m = 0; m < 4; ++m)
#pragma unroll
                for (int n = 0; n < 2; ++n) acc[a][b][m][n] = (f32x4){0.f, 0.f, 0.f, 0.f};
    bf16x8 At[4][2], B0[2][2], B1[2][2];
    const char* cA = cur.A; const char* cB = cur.B;
    S.a_ready(cur);
    if constexpr (SP2) {
        PG8_STAGE(PG8_SB(0, 0), cB, voffB); PG8_STAGE(PG8_SB(0, 1), cB + hstepB, voffB); PG8_STAGE(PG8_SA(0, 0), cA, voffA); PG8_STAGE(PG8_SA(0, 1), cA + hstepA, voffA);
        if (wr == 1) PG8_BAR;
        PG8_WAIT_V(2); PG8_BAR;
        PG8_STAGE(PG8_SB(1, 0), cB + kstep, voffB); PG8_STAGE(PG8_SA(1, 0), cA + kstep, voffA); PG8_STAGE(PG8_SB(1, 1), cB + hstepB + kstep, voffB);
        PG8_WAIT_V(6); PG8_BAR;
    } else {
        PG8_STAGE(PG8_SB(0, 0), cB, voffB); PG8_STAGE(PG8_SA(0, 0), cA, voffA); PG8_STAGE(PG8_SB(0, 1), cB + hstepB, voffB); PG8_STAGE(PG8_SA(0, 1), cA + hstepA, voffA);
        if (wr == 1) PG8_BAR;
        PG8_WAIT_V(4); PG8_BAR;
        PG8_STAGE(PG8_SB(1, 0), cB + kstep, voffB); PG8_STAGE(PG8_SA(1, 0), cA + kstep, voffA); PG8_STAGE(PG8_SB(1, 1), cB + hstepB + kstep, voffB);
        PG8_WAIT_V(6); PG8_BAR;
    }
    for (;;) {
        const bool has_next = S.next(ui + 1, nxt);
        const char* nA = has_next ? nxt.A : cA; const char* nB = has_next ? nxt.B : cB;
        for (int t = 0; t < nt; t += 2) {
            const bool last = (t == nt - 2);
            const char* a1 = cA + (size_t)(t + 1) * kstep;
            const char* a2 = last ? nA : cA + (size_t)(t + 2) * kstep; const char* b2 = last ? nB : cB + (size_t)(t + 2) * kstep;
            const char* a3 = a2 + kstep; const char* b3 = b2 + kstep;
            if (last && has_next) S.a_ready(nxt);
            if constexpr (SP2) {
            PG8_LDB(B0, 0, 0); PG8_LDB(B1, 0, 1); PG8_SCHED; PG8_LDA(At, 0, 0); PG8_STAGE(PG8_SA(1, 1), a1 + hstepA, voffA);
            PG8_WAIT_V(8); PG8_WAIT_L(0); PG8_BAR; PG8_MMA(0, 0, At, B0); PG8_MMA(0, 1, At, B1); PG8_BAR; PG8_SCHED;
            PG8_LDA(At, 0, 1); PG8_STAGE(PG8_SB(0, 0), b2, voffB); PG8_STAGE(PG8_SB(0, 1), b2 + hstepB, voffB); PG8_STAGE(PG8_SA(0, 0), a2, voffA);
            PG8_WAIT_V(8); PG8_WAIT_L(0); PG8_BAR; PG8_MMA(1, 0, At, B0); PG8_MMA(1, 1, At, B1); PG8_BAR; PG8_SCHED;
            PG8_LDB(B0, 1, 0); PG8_LDB(B1, 1, 1); PG8_SCHED; PG8_LDA(At, 1, 0); PG8_STAGE(PG8_SA(0, 1), a2 + hstepA, voffA);
            PG8_WAIT_V(8); PG8_WAIT_L(0); PG8_BAR; PG8_MMA(0, 0, At, B0); PG8_MMA(0, 1, At, B1); PG8_BAR; PG8_SCHED;
            PG8_LDA(At, 1, 1); PG8_STAGE(PG8_SB(1, 0), b3, voffB); PG8_STAGE(PG8_SB(1, 1), b3 + hstepB, voffB); PG8_STAGE(PG8_SA(1, 0), a3, voffA);
            PG8_WAIT_V(8); PG8_WAIT_L(0); PG8_BAR; PG8_MMA(1, 0, At, B0); PG8_MMA(1, 1, At, B1); PG8_BAR; PG8_SCHED;
            } else {
            PG8_LDB(B0, 0, 0); PG8_SCHED; PG8_LDA(At, 0, 0); PG8_STAGE(PG8_SA(1, 1), a1 + hstepA, voffA);
            PG8_WAIT_L(8); PG8_BAR; PG8_WAIT_L(0); PG8_MMA(0, 0, At, B0); PG8_BAR; PG8_SCHED;
            PG8_LDB(B1, 0, 1); PG8_STAGE(PG8_SB(0, 0), b2, voffB);
            PG8_BAR; PG8_WAIT_L(0); PG8_MMA(0, 1, At, B1); PG8_BAR;
            PG8_LDA(At, 0, 1); PG8_STAGE(PG8_SA(0, 0), a2, voffA);
            PG8_BAR; PG8_WAIT_L(0); PG8_MMA(1, 0, At, B0); PG8_BAR; PG8_SCHED;
            PG8_STAGE(PG8_SB(0, 1), b2 + hstepB, voffB);
            PG8_WAIT_V(6); PG8_BAR; PG8_MMA(1, 1, At, B1); PG8_BAR;
            PG8_LDB(B0, 1, 0); PG8_SCHED; PG8_LDA(At, 1, 0); PG8_STAGE(PG8_SA(0, 1), a2 + hstepA, voffA);
            PG8_WAIT_L(8); PG8_BAR; PG8_WAIT_L(0); PG8_MMA(0, 0, At, B0); PG8_BAR; PG8_SCHED;
            PG8_LDB(B1, 1, 1); PG8_STAGE(PG8_SB(1, 0), b3, voffB);
            PG8_BAR; PG8_WAIT_L(0); PG8_MMA(0, 1, At, B1); PG8_BAR;
            PG8_LDA(At, 1, 1); PG8_STAGE(PG8_SA(1, 0), a3, voffA);
            PG8_BAR; PG8_WAIT_L(0); PG8_MMA(1, 0, At, B0); PG8_BAR; PG8_SCHED;
            PG8_STAGE(PG8_SB(1, 1), b3 + hstepB, voffB);
            PG8_WAIT_V(6); PG8_BAR; PG8_MMA(1, 1, At, B1); PG8_BAR;
            }
        }
        if constexpr (ALIGN_EPI) { if (wr == 0) PG8_BAR; }
        if constexpr (!Epi::AFTER_DRAIN) { if (cur.fin) { E(acc, cur, wr, wc, fr, fq); S.done(cur); } }
        if (!has_next) break;
        if (cur.fin) {
#pragma unroll
        for (int a = 0; a < 2; ++a)
#pragma unroll
            for (int b = 0; b < 2; ++b)
#pragma unroll
                for (int m = 0; m < 4; ++m)
#pragma unroll
                    for (int n = 0; n < 2; ++n) acc[a][b][m][n] = (f32x4){0.f, 0.f, 0.f, 0.f};
        }
        cur = nxt; cA = nA; cB = nB; ++ui;
        if constexpr (ALIGN_EPI) { if (wr == 1) PG8_BAR; }
    }
    PG8_WAIT_V(0);
    if constexpr (!ALIGN_EPI) { if (wr == 0) PG8_BAR; }
    PG8_BAR;
    if constexpr (Epi::AFTER_DRAIN) { E.fused(acc, cur, wr, wc, fr, fq, lds, wid, lane); S.done(cur); }
#undef PG8_SA
#undef PG8_SB
#undef PG8_STAGE
#undef PG8_LDA
#undef PG8_LDB
#undef PG8_MMA
#undef PG8_WAIT_V
#undef PG8_WAIT_L
#undef PG8_BAR
#undef PG8_SCHED
}
}

struct SchedDense {
  int nM, nN, G, c, skip_ctx; const char* A; const char* B; size_t a_tile, b_tile;
  __device__ __forceinline__ bool next(int i, pg8::Unit& u) const {
    const long L = (long)i * G + c; if (L >= (long)nM * nN) return false;
    int pm, pn; pg8::tile_of((int)L, nM, nN, pm, pn); if (skip_ctx) pm = pm + pm / 16 + 1;
    u.pm = pm; u.pn = pn; u.fin = 1; u.A = A + (size_t)pm * a_tile; u.B = B + (size_t)pn * b_tile; return true; }
  __device__ __forceinline__ void a_ready(const pg8::Unit&) const {}
  __device__ __forceinline__ void done(const pg8::Unit&) const {}
};
struct SchedMoe {
  int G, c, mode; const int* ctl; const char* A; size_t a_tile; const char* W;
  __device__ __forceinline__ bool next(int i, pg8::Unit& u) const {
    const int part = mode == 2 ? (i & 1) : 0, iu = mode == 2 ? (i >> 1) : i;
    const long L = (long)iu * G + c; const int ntiles = ctl[CT_NT]; if (L >= (long)ntiles * 4) return false;
    const int pm = (int)(L >> 2), pn = (int)(L & 3); int eA, eB; pair_experts(ctl[CT_TP + pm], eA, eB);
    u.pm = pm; u.pn = pn;
    if (mode == 1) { const int e = pn < 2 ? eA : eB; u.fin = 1; u.A = A + (size_t)pm * a_tile; u.B = W + (size_t)e * (512 * 1024 * 2) + (size_t)(pn & 1) * (256 * 1024 * 2); }
    else { u.fin = part; u.A = A + (size_t)pm * a_tile + part * 512; u.B = W + (size_t)(part ? eB : eA) * (1024 * 256 * 2) + (size_t)pn * (256 * 256 * 2); }
    return true; }
  __device__ __forceinline__ void a_ready(const pg8::Unit&) const {}
  __device__ __forceinline__ void done(const pg8::Unit&) const {}
};
__device__ __forceinline__ unsigned cvt_pk(float lo, float hi) { return pg8::cvt_pk_bf16(lo, hi); }
struct EpiInProj {
  static constexpr bool PERM = true, AFTER_DRAIN = false; bf16_t *QK, *VZ, *XBC, *HY; float* DT;
  __device__ __forceinline__ void operator()(const f32x4 (&acc)[2][2][4][2], const pg8::Unit& u, int wr, int wc, int fr, int fq) const {
    const int pn = u.pn; bf16_t* base; int ldc, coff;
    if (pn < 2) { base = QK; ldc = 512; coff = pn * 256; } else if (pn < 4) { base = VZ; ldc = 512; coff = (pn - 2) * 256; }
    else if (pn < 7) { base = XBC; ldc = 768; coff = (pn - 4) * 256; } else { base = HY; ldc = 768; coff = (pn - 7) * 256; }
    const int row0 = u.pm * 256 + wr * 64 + fr, col0 = coff + wc * 32 + 8 * fq; const bool dtl = (pn == 6 && wc == 0 && fq < 2);
#pragma unroll
    for (int ai = 0; ai < 2; ++ai)
#pragma unroll
      for (int m = 0; m < 4; ++m) { const int row = row0 + ai * 128 + m * 16; bf16_t* rowp = base + (size_t)row * ldc + col0;
#pragma unroll
        for (int bj = 0; bj < 2; ++bj) { const f32x4 v0 = acc[ai][bj][m][0], v1 = acc[ai][bj][m][1];
          u32x4 w; w.x = cvt_pk(v0[0], v0[1]); w.y = cvt_pk(v0[2], v0[3]); w.z = cvt_pk(v1[0], v1[1]); w.w = cvt_pk(v1[2], v1[3]);
          *(u32x4*)(rowp + bj * 128) = w;
          if (bj == 1 && dtl) { float* dp = DT + (size_t)row * 12 + 8 * fq; *(f32x4*)dp = v0; if (fq == 0) *(f32x4*)(dp + 4) = v1; } } }
  }
};
struct EpiOutProj {
  static constexpr bool PERM = false, AFTER_DRAIN = false; const float *xl_src, *xc_src; float *xl_dst, *xc_dst; const float* gate;
  __device__ __forceinline__ void operator()(const f32x4 (&acc)[2][2][4][2], const pg8::Unit& u, int wr, int wc, int fr, int fq) const {
    const int b = u.pm / 17, jt = u.pm - 17 * b; const size_t rbase = jt == 0 ? (size_t)b * CTXL : (size_t)b * SEQ + (jt - 1) * 256;
    const float* xs = (jt == 0 ? xc_src : xl_src) + rbase * DM; float* xd = (jt == 0 ? xc_dst : xl_dst) + rbase * DM; const float* gt = gate + (size_t)(jt == 0 ? 4 : b) * 6144;
    const int col0 = u.pn * 256 + wc * 32 + 4 * fq;
#pragma unroll
    for (int ai = 0; ai < 2; ++ai)
#pragma unroll
      for (int m = 0; m < 4; ++m) { const size_t off = (size_t)(ai * 128 + wr * 64 + m * 16 + fr) * DM + col0;
#pragma unroll
        for (int bj = 0; bj < 2; ++bj)
#pragma unroll
          for (int n = 0; n < 2; ++n) { const int co = bj * 128 + n * 16; const f32x4 g4 = *(const f32x4*)(gt + col0 + co), x4 = *(const f32x4*)(xs + off + co);
            *(f32x4*)(xd + off + co) = x4 + g4 * acc[ai][bj][m][n]; } }
  }
};
struct EpiMoe1 {
  static constexpr bool PERM = true, AFTER_DRAIN = false; bf16_t* ACT; const float* sorted_w;
  __device__ __forceinline__ void operator()(const f32x4 (&acc)[2][2][4][2], const pg8::Unit& u, int wr, int wc, int fr, int fq) const {
    const int half = u.pn >> 1, j0 = (u.pn & 1) * 128 + 16 * wc + 4 * fq;
#pragma unroll
    for (int ai = 0; ai < 2; ++ai)
#pragma unroll
      for (int m = 0; m < 4; ++m) { const int slot = u.pm * 256 + ai * 128 + wr * 64 + m * 16 + fr; const float wt = sorted_w[2 * slot + half];
#pragma unroll
        for (int bj = 0; bj < 2; ++bj) { const f32x4 v0 = acc[ai][bj][m][0], v1 = acc[ai][bj][m][1];
          u32x2 w; w.x = cvt_pk(siluf(v0[0]) * v0[1] * wt, siluf(v0[2]) * v0[3] * wt); w.y = cvt_pk(siluf(v1[0]) * v1[1] * wt, siluf(v1[2]) * v1[3] * wt);
          *(u32x2*)(ACT + (size_t)slot * 512 + half * 256 + j0 + 64 * bj) = w; } }
  }
};
struct EpiMoe2 {
  static constexpr bool PERM = false, AFTER_DRAIN = false; float *xl, *xc; const float* gate; const int* sorted_tok;
  __device__ __forceinline__ void operator()(const f32x4 (&acc)[2][2][4][2], const pg8::Unit& u, int wr, int wc, int fr, int fq) const {
    const int col0 = u.pn * 256 + wc * 32 + 4 * fq;
#pragma unroll
    for (int ai = 0; ai < 2; ++ai)
#pragma unroll
      for (int m = 0; m < 4; ++m) { const int slot = u.pm * 256 + ai * 128 + wr * 64 + m * 16 + fr; const int r = sorted_tok[slot];
        if (r >= 0) { float* xd = xrow(xl, xc, r) + col0; const float* gt = gate + (size_t)mrow_of(r) * 6144 + col0;
#pragma unroll
          for (int bj = 0; bj < 2; ++bj)
#pragma unroll
            for (int n = 0; n < 2; ++n) { const int co = bj * 128 + n * 16; *(f32x4*)(xd + co) = *(const f32x4*)(xd + co) + *(const f32x4*)(gt + co) * acc[ai][bj][m][n]; } }
        asm volatile("" ::: "memory"); }
  }
};

#include <hip/hip_bf16.h>
#include <cmath>
namespace attn_body {
using bf16=__hip_bfloat16;
using bf16x8=__attribute__((ext_vector_type(8)))short;
using s16x4=__attribute__((ext_vector_type(4)))short;
using f32x16=__attribute__((ext_vector_type(16)))float;
using u32x4=__attribute__((ext_vector_type(4)))unsigned;
constexpr int D=64,QP=512,KP=512,VP=512,OP=1024;
constexpr int NW=8,QBLK=32,QB=QBLK*NW,KVBLK=64;
constexpr int ATTN_UNIT_ROWS=QB;
__device__ __forceinline__ int crow(int r,int hi){return (r&3)+8*(r>>2)+4*hi;}
#define SBAR() __builtin_amdgcn_sched_barrier(0)
__device__ __forceinline__ void cmask(f32x16&p0,f32x16&p1,int jb,int qrel,int hi){
  const float NEG=-INFINITY; int kb=64*jb+4*hi;
  #pragma unroll
  for(int r=0;r<16;++r){int kv=kb+(r&3)+8*(r>>2); if(kv>qrel)p0[r]=NEG; if(kv+32>qrel)p1[r]=NEG;}
}

constexpr int NSLOT=3, SLOTB=8192;
constexpr int LDS_K=0, LDS_V=NSLOT*SLOTB, LDS_WS=2*NSLOT*SLOTB, LDS_OST=LDS_WS+NW*64*4, LDS_BYTES=LDS_OST+NW*4096;
constexpr float C2=0.125f*1.4426950408889634f;
__device__ __forceinline__ void glds16(const void*gsrc,unsigned lds_dst){unsigned keep;
  asm volatile("s_mov_b32 %0, m0\n\ts_mov_b32 m0, %2\n\ts_nop 0\n\tglobal_load_lds_dwordx4 %1, off\n\ts_mov_b32 m0, %0":"=&s"(keep):"v"(gsrc),"s"(lds_dst):"memory");}
__device__ __forceinline__ float max3f(float a,float b,float c){float r;asm("v_max3_f32 %0, %1, %2, %3":"=v"(r):"v"(a),"v"(b),"v"(c));return r;}
__device__ __forceinline__ float max2f(float a,float b){float r;asm("v_max_f32_e32 %0, %1, %2":"=v"(r):"v"(a),"v"(b));return r;}
__device__ __forceinline__ float fadd_s(float a,float b){float r;asm("v_add_f32_e32 %0, %1, %2":"=v"(r):"v"(a),"v"(b));return r;}
__device__ __forceinline__ float fsub_s(float a,float b){float r;asm("v_sub_f32_e32 %0, %1, %2":"=v"(r):"v"(a),"v"(b));return r;}
typedef float f32x2_t __attribute__((ext_vector_type(2))); typedef __bf16 bf16x2_t __attribute__((ext_vector_type(2)));
__device__ __forceinline__ unsigned cvtpk_s(float lo,float hi){f32x2_t v={lo,hi};bf16x2_t b=__builtin_convertvector(v,bf16x2_t);return __builtin_bit_cast(unsigned,b);}
#define WAIT_BAR(N) asm volatile("s_waitcnt vmcnt(" #N ") lgkmcnt(0)\n\ts_barrier":::"memory")

__device__ __forceinline__ void qkt(f32x16&p0,f32x16&p1,const char*Kslot,const bf16x8*qr,const f32x16&negm,int r32,int hi){
  const char*kb=Kslot+hi*1024+r32*16;
  #pragma unroll
  for(int d0=0;d0<4;++d0){
    const bf16x8 b0=*reinterpret_cast<const bf16x8*>(kb+d0*2048);
    const bf16x8 b1=*reinterpret_cast<const bf16x8*>(kb+d0*2048+512);
    if(d0==0){p0=__builtin_amdgcn_mfma_f32_32x32x16_bf16(b0,qr[0],negm,0,0,0);p1=__builtin_amdgcn_mfma_f32_32x32x16_bf16(b1,qr[0],negm,0,0,0);}
    else{p0=__builtin_amdgcn_mfma_f32_32x32x16_bf16(b0,qr[d0],p0,0,0,0);p1=__builtin_amdgcn_mfma_f32_32x32x16_bf16(b1,qr[d0],p1,0,0,0);}}
}
typedef __attribute__((address_space(3))) const char* lds_cptr;
typedef short v4i16_t __attribute__((ext_vector_type(4)));
__device__ __forceinline__ void kload8(bf16x8*kf,lds_cptr kp){
  kf[0]=*(const __attribute__((address_space(3))) bf16x8*)(kp);      kf[1]=*(const __attribute__((address_space(3))) bf16x8*)(kp+512);
  kf[2]=*(const __attribute__((address_space(3))) bf16x8*)(kp+2048); kf[3]=*(const __attribute__((address_space(3))) bf16x8*)(kp+2560);
  kf[4]=*(const __attribute__((address_space(3))) bf16x8*)(kp+4096); kf[5]=*(const __attribute__((address_space(3))) bf16x8*)(kp+4608);
  kf[6]=*(const __attribute__((address_space(3))) bf16x8*)(kp+6144); kf[7]=*(const __attribute__((address_space(3))) bf16x8*)(kp+6656);
}
__device__ __forceinline__ void kload2(bf16x8*kf,lds_cptr kp,int j){ kf[2*j]=*(const __attribute__((address_space(3))) bf16x8*)(kp+j*2048); kf[2*j+1]=*(const __attribute__((address_space(3))) bf16x8*)(kp+j*2048+512); }
__device__ __forceinline__ s16x4 vtr(lds_cptr p){ return __builtin_bit_cast(s16x4,__builtin_amdgcn_ds_read_tr16_b64_v4i16((__attribute__((address_space(3))) v4i16_t*)p)); }
__device__ __forceinline__ float rowmax(const f32x16&p0,const f32x16&p1){
  float a=max3f(p0[0],p0[1],p1[0]),b=max3f(p0[2],p0[3],p1[1]);a=max3f(a,p1[2],p1[3]);
  #pragma unroll
  for(int r=4;r<16;r+=4){a=max3f(a,p0[r],p0[r+1]);b=max3f(b,p0[r+2],p0[r+3]);a=max3f(a,p1[r],p1[r+1]);b=max3f(b,p1[r+2],p1[r+3]);}
  const float m=max2f(a,b);
  auto rr=__builtin_amdgcn_permlane32_swap(__float_as_uint(m),__float_as_uint(m),false,false);
  return max2f(__uint_as_float(rr[0]),__uint_as_float(rr[1]));
}
__device__ __forceinline__ void pv(f32x16*o,int vb,bf16x8 pa0,bf16x8 pa1,bf16x8 pa2,bf16x8 pa3){
  #pragma unroll
  for(int d0=0;d0<2;++d0){s16x4 lo[4],hi[4];
    #pragma unroll
    for(int ks=0;ks<4;++ks){
      asm volatile("ds_read_b64_tr_b16 %0,%1 offset:%c2":"=&v"(lo[ks]):"v"(vb),"i"(d0*4096+ks*1024):"memory");
      asm volatile("ds_read_b64_tr_b16 %0,%1 offset:%c2":"=&v"(hi[ks]):"v"(vb),"i"(d0*4096+ks*1024+512):"memory");}
    asm volatile("s_waitcnt lgkmcnt(0)":::"memory");SBAR();
    #define PK(k) (bf16x8){lo[k][0],lo[k][1],lo[k][2],lo[k][3],hi[k][0],hi[k][1],hi[k][2],hi[k][3]}
    o[d0]=__builtin_amdgcn_mfma_f32_32x32x16_bf16(pa0,PK(0),o[d0],0,0,0);
    o[d0]=__builtin_amdgcn_mfma_f32_32x32x16_bf16(pa1,PK(1),o[d0],0,0,0);
    o[d0]=__builtin_amdgcn_mfma_f32_32x32x16_bf16(pa2,PK(2),o[d0],0,0,0);
    o[d0]=__builtin_amdgcn_mfma_f32_32x32x16_bf16(pa3,PK(3),o[d0],0,0,0);
    #undef PK
  }
}

#ifndef ATTN_STORE16
#define ATTN_STORE16(p,v) (*(u32x4*)(p)=(v))
#endif
template<int THRL> __device__ __forceinline__ void attn_unit(const bf16*Qu,const bf16*__restrict__ Kh,const bf16*__restrict__ Vh,bf16*Ou,const int NT,char*shm){
  const int tid=opq_v((int)threadIdx.x),lane=tid&63,r32=lane&31,hi=lane>>5; const int wid=__builtin_amdgcn_readfirstlane(tid>>6);
  const bf16*Qw=Qu+(long)(wid*QBLK)*QP;
  const unsigned lds0=(unsigned)(uintptr_t)shm;
  float*wsf=(float*)(shm+LDS_WS)+wid*64;
  const bf16*ksrc=Kh+(long)lane*KP+wid*8;
  const bf16*vsrc=Vh+(long)(16*(wid&3)+(lane>>2))*VP+(wid>>2)*32+(lane&3)*8;
  const unsigned kdst=lds0+LDS_K+wid*1024, vdst=lds0+LDS_V+wid*1024;
  #define DMA_K(t,slot) glds16(ksrc+(long)(t)*KVBLK*KP,(unsigned)__builtin_amdgcn_readfirstlane(kdst+(slot)))
  #define DMA_V(t,slot) glds16(vsrc+(long)(t)*KVBLK*VP,(unsigned)__builtin_amdgcn_readfirstlane(vdst+(slot)))
  const int vb0=(int)(lds0+LDS_V)+((lane>>4)&1)*32+(lane&3)*8+(4*hi+((lane&15)>>2))*64;
  const char*Kbase=shm+LDS_K; bf16x8 kf[8];
  const lds_cptr shm3=(lds_cptr)shm; const lds_cptr kp0=shm3+LDS_K+hi*1024+r32*16; const lds_cptr vp0=shm3+LDS_V+((lane>>4)&1)*32+(lane&3)*8+(4*hi+((lane&15)>>2))*64;
  DMA_K(0,0);DMA_V(0,0);DMA_K(1,SLOTB);
  bf16x8 qr[4];
  #pragma unroll
  for(int d0=0;d0<4;++d0)qr[d0]=*reinterpret_cast<const bf16x8*>(&Qw[(long)r32*QP+d0*16+hi*8]);
  float mhat=0.f,l_reg=0.f;float z0_=0.f;asm volatile("":"+v"(z0_));f32x16 o[2];f32x16 negm;
  _Pragma("unroll") for(int r=0;r<16;++r){o[0][r]=z0_;o[1][r]=z0_;negm[r]=z0_;} asm volatile("":"+v"(negm));
  #define CMASK(P0,P1,t) do{}while(0)
  bool resc=false;
  #define START(P0,P1) do{ const float rm=rowmax(P0,P1); resc=false; \
    { const float dl=rm; mhat=fadd_s(mhat,dl); \
      _Pragma("unroll") for(int r=0;r<16;++r){P0[r]=fsub_s(P0[r],dl);P1[r]=fsub_s(P1[r],dl);} \
      _Pragma("unroll") for(int r=0;r<16;++r)negm[r]=-mhat; asm volatile("":"+v"(negm)); } \
    _Pragma("unroll") for(int r=0;r<16;++r)P0[r]=__builtin_amdgcn_exp2f(P0[r]); }while(0)
  #define RESC() do{ if(resc){ asm volatile("s_waitcnt lgkmcnt(0)":::"memory"); \
      _Pragma("unroll") for(int d_=0;d_<2;++d_) _Pragma("unroll") for(int r=0;r<16;++r)o[d_][r]*=wsf[crow(r,hi)]; } }while(0)
  f32x16 pA0,pA1,pB0,pB1;
  int sl_prev=0,sl_cur=0,sl_next=SLOTB;
  #define ROT() do{sl_prev=sl_cur;sl_cur=sl_next;sl_next=(sl_next==(NSLOT-1)*SLOTB)?0:sl_next+SLOTB;}while(0)
  DMA_K(2,2*SLOTB);
  WAIT_BAR(3);
  qkt(pA0,pA1,Kbase,qr,negm,r32,hi);asm volatile("s_nop 15\n\ts_nop 7":"+v"(pA0),"+v"(pA1));CMASK(pA0,pA1,0);
  START(pA0,pA1);
  _Pragma("unroll") for(int r=0;r<16;++r)pA1[r]=__builtin_amdgcn_exp2f(pA1[r]);
  WAIT_BAR(0);
  DMA_K(3,0);DMA_V(1,SLOTB);
  ROT();
  kload8(kf,kp0+sl_cur);
  WAIT_BAR(2);
  s16x4 vlo[8],vhi[8]; u32x4 pw0,pw1,pw2,pw3;
  #define PKW(P,B) cvtpk_s(P[B],P[B+1])
  #define PAF(k) __builtin_bit_cast(bf16x8,pw##k)
  #define VFR(i) (bf16x8){vlo[i][0],vlo[i][1],vlo[i][2],vlo[i][3],vhi[i][0],vhi[i][1],vhi[i][2],vhi[i][3]}
  #define PIN(x) asm volatile("":"+v"(x))
  #define MX3(a,b,c) __builtin_fmaxf(__builtin_fmaxf((a),(b)),(c))
  #define GAPA(MF,A0,A1,A2,A3,W0,W1,PW) do{ MF; sacc+=A0; sacc+=A1; sacc+=A2; sacc+=A3; PIN(sacc); W0; W1; PIN(PW); SBAR(); }while(0)
  #define EX(v) __builtin_amdgcn_exp2f(v)
  #define GAPB(MF,X,B) do{ MF; X[B]=EX(X[B]); X[B+1]=EX(X[B+1]); X[B+2]=EX(X[B+2]); X[B+3]=EX(X[B+3]); PIN(X); SBAR(); }while(0)
  #define VRD(i) do{ vlo[i]=vtr(vp_+(((i)>>2)*4096+((i)&3)*1024)); vhi[i]=vtr(vp_+(((i)>>2)*4096+((i)&3)*1024+512)); }while(0)
  #define KRD(G,j) do{ if(G){ kload2(kf,kp0+sl_next,j); SBAR(); } }while(0)
  #define STEP(C0,C1,P0,P1,t,GK,GV,GL) do{ SBAR(); \
    const lds_cptr vp_=vp0+sl_prev; \
    VRD(0); SBAR(); float sacc=(P0[0]+P0[1]); \
    GAPA(C0=__builtin_amdgcn_mfma_f32_32x32x16_bf16(kf[0],qr[0],negm,0,0,0), P0[2],P0[3],P0[4],P0[5],     pw0[0]=PKW(P0,0), pw0[1]=PKW(P0,2), pw0); \
    VRD(4); SBAR(); GAPA(C1=__builtin_amdgcn_mfma_f32_32x32x16_bf16(kf[1],qr[0],negm,0,0,0), P0[6],P0[7],P0[8],P0[9],     pw0[2]=PKW(P0,4), pw0[3]=PKW(P0,6), pw0); \
    VRD(1); SBAR(); GAPA(C0=__builtin_amdgcn_mfma_f32_32x32x16_bf16(kf[2],qr[1],C0,0,0,0),   P0[10],P0[11],P0[12],P0[13], pw1[0]=PKW(P0,8), pw1[1]=PKW(P0,10), pw1); \
    VRD(5); SBAR(); GAPA(C1=__builtin_amdgcn_mfma_f32_32x32x16_bf16(kf[3],qr[1],C1,0,0,0),   P0[14],P0[15],P1[0],P1[1],   pw1[2]=PKW(P0,12),pw1[3]=PKW(P0,14), pw1); \
    VRD(2); SBAR(); GAPA(C0=__builtin_amdgcn_mfma_f32_32x32x16_bf16(kf[4],qr[2],C0,0,0,0),   P1[2],P1[3],P1[4],P1[5],     pw2[0]=PKW(P1,0), pw2[1]=PKW(P1,2), pw2); \
    VRD(6); SBAR(); GAPA(C1=__builtin_amdgcn_mfma_f32_32x32x16_bf16(kf[5],qr[2],C1,0,0,0),   P1[6],P1[7],P1[8],P1[9],     pw2[2]=PKW(P1,4), pw2[3]=PKW(P1,6), pw2); \
    VRD(3); SBAR(); GAPA(C0=__builtin_amdgcn_mfma_f32_32x32x16_bf16(kf[6],qr[3],C0,0,0,0),   P1[10],P1[11],P1[12],P1[13], pw3[0]=PKW(P1,8), pw3[1]=PKW(P1,10), pw3); \
    VRD(7); SBAR(); GAPA(C1=__builtin_amdgcn_mfma_f32_32x32x16_bf16(kf[7],qr[3],C1,0,0,0),   P1[14],P1[15],0.f,0.f,       pw3[2]=PKW(P1,12),pw3[3]=PKW(P1,14), pw3); \
    l_reg+=sacc; \
    if(GK){DMA_K((t)+3,sl_cur);} if(GV){DMA_V((t)+1,sl_next);} \
    CMASK(C0,C1,t); \
    { float a=MX3(C0[0],C0[1],C1[0]),b=MX3(C0[2],C0[3],C1[1]); a=MX3(a,C1[2],C1[3]); \
      _Pragma("unroll") for(int r=4;r<16;r+=4){a=MX3(a,C0[r],C0[r+1]);b=MX3(b,C0[r+2],C0[r+3]);a=MX3(a,C1[r],C1[r+1]);b=MX3(b,C1[r+2],C1[r+3]);} \
      float rm=__builtin_fmaxf(a,b); { auto rr=__builtin_amdgcn_permlane32_swap(__float_as_uint(rm),__float_as_uint(rm),false,false); rm=__builtin_fmaxf(__uint_as_float(rr[0]),__uint_as_float(rr[1])); } \
      resc=false; \
      if(__builtin_expect(__any(rm>(float)THRL),0)){ const float dl=__builtin_fmaxf(rm,0.f); mhat+=dl; \
        _Pragma("unroll") for(int r=0;r<16;++r){C0[r]-=dl;C1[r]-=dl;} \
        _Pragma("unroll") for(int r=0;r<16;++r)negm[r]=-mhat; asm volatile("":"+v"(negm)); \
        const float f=__builtin_amdgcn_exp2f(-dl); l_reg*=f; if(hi==0)wsf[r32]=f; resc=true; } } \
    SBAR(); \
    GAPB(o[0]=__builtin_amdgcn_mfma_f32_32x32x16_bf16(PAF(0),VFR(0),o[0],0,0,0), C0,0); \
    GAPB(o[1]=__builtin_amdgcn_mfma_f32_32x32x16_bf16(PAF(0),VFR(4),o[1],0,0,0), C0,4); \
    KRD(GL,0); GAPB(o[0]=__builtin_amdgcn_mfma_f32_32x32x16_bf16(PAF(1),VFR(1),o[0],0,0,0), C0,8); \
    KRD(GL,1); GAPB(o[1]=__builtin_amdgcn_mfma_f32_32x32x16_bf16(PAF(1),VFR(5),o[1],0,0,0), C0,12); \
    KRD(GL,2); GAPB(o[0]=__builtin_amdgcn_mfma_f32_32x32x16_bf16(PAF(2),VFR(2),o[0],0,0,0), C1,0); \
    KRD(GL,3); GAPB(o[1]=__builtin_amdgcn_mfma_f32_32x32x16_bf16(PAF(2),VFR(6),o[1],0,0,0), C1,4); \
    GAPB(o[0]=__builtin_amdgcn_mfma_f32_32x32x16_bf16(PAF(3),VFR(3),o[0],0,0,0), C1,8); \
    GAPB(o[1]=__builtin_amdgcn_mfma_f32_32x32x16_bf16(PAF(3),VFR(7),o[1],0,0,0), C1,12); \
    }while(0)
  int t=1;
  for(;t+5<NT;t+=2){
    STEP(pB0,pB1,pA0,pA1,t,true,true,true);     WAIT_BAR(2); RESC(); ROT();
    STEP(pA0,pA1,pB0,pB1,t+1,true,true,true);   WAIT_BAR(2); RESC(); ROT();
  }
  #define ENDW(tt) do{ if((tt)+3<NT){WAIT_BAR(2);} else if((tt)+2<NT){WAIT_BAR(1);} else {WAIT_BAR(0);} }while(0)
  for(;t+1<NT;t+=2){
    STEP(pB0,pB1,pA0,pA1,t,(t+3<NT),(t+1<NT),(t+1<NT));       ENDW(t);   RESC(); ROT();
    STEP(pA0,pA1,pB0,pB1,t+1,(t+4<NT),(t+2<NT),(t+2<NT));     ENDW(t+1); RESC(); ROT();
  }
  STEP(pB0,pB1,pA0,pA1,NT-1,false,false,false); RESC();
  { float sacc=pB0[0]+pB0[1]; _Pragma("unroll") for(int r=2;r<16;++r)sacc+=pB0[r]; _Pragma("unroll") for(int r=0;r<16;++r)sacc+=pB1[r]; l_reg+=sacc;
    pw0=(u32x4){PKW(pB0,0),PKW(pB0,2),PKW(pB0,4),PKW(pB0,6)};pw1=(u32x4){PKW(pB0,8),PKW(pB0,10),PKW(pB0,12),PKW(pB0,14)};pw2=(u32x4){PKW(pB1,0),PKW(pB1,2),PKW(pB1,4),PKW(pB1,6)};pw3=(u32x4){PKW(pB1,8),PKW(pB1,10),PKW(pB1,12),PKW(pB1,14)};
    SBAR(); pv(o,vb0+sl_cur,PAF(0),PAF(1),PAF(2),PAF(3)); }
  #undef PKW
  #undef PAF
  #undef VFR
  #undef PIN
  #undef MX3
  #undef GAPA
  #undef GAPB
  #undef EX
  #undef VRD
  #undef KRD
  #undef STEP
  #undef ENDW
  {auto rr=__builtin_amdgcn_permlane32_swap(__float_as_uint(l_reg),__float_as_uint(l_reg),false,false);l_reg=__uint_as_float(rr[0])+__uint_as_float(rr[1]);}
  if(hi==0)wsf[32+r32]=l_reg;asm volatile("s_waitcnt lgkmcnt(0)":::"memory");
  float rli[16];
  #pragma unroll
  for(int r=0;r<16;++r)rli[r]=__builtin_amdgcn_rcpf(wsf[32+crow(r,hi)]);
  bf16*Ow=Ou+(long)(wid*QBLK)*OP;
  { bf16*stg=(bf16*)(shm+LDS_OST)+wid*2048;
    #pragma unroll
    for(int r=0;r<16;++r){const int orow=crow(r,hi);
      #pragma unroll
      for(int d0=0;d0<2;++d0)stg[orow*64+d0*32+r32]=__float2bfloat16(o[d0][r]*rli[r]);}
    asm volatile("s_waitcnt lgkmcnt(0)":::"memory");
    #pragma unroll
    for(int i=0;i<4;++i){const int row=i*8+(lane>>3),ch=lane&7; const u32x4 v=*(const u32x4*)(stg+row*64+ch*8); ATTN_STORE16(Ow+(long)row*OP+ch*8,v);} }
  asm volatile("s_waitcnt lgkmcnt(0)\n\ts_barrier":::"memory");
  #undef DMA_K
  #undef DMA_V
  #undef CMASK
  #undef START
  #undef RESC
  #undef ROT
}
constexpr int ATTN_LDS_BYTES=LDS_BYTES;
#undef SBAR
#undef WAIT_BAR
}


namespace hyf {
struct c32 { float x, y; };
typedef _Float16 h2 __attribute__((ext_vector_type(2)));
__device__ __forceinline__ c32 operator+(c32 a, c32 b) { return {a.x + b.x, a.y + b.y}; }
__device__ __forceinline__ c32 operator-(c32 a, c32 b) { return {a.x - b.x, a.y - b.y}; }
__device__ __forceinline__ c32 cmul(c32 a, c32 b) { return {a.x * b.x - a.y * b.y, a.x * b.y + a.y * b.x}; }
__device__ __forceinline__ constexpr float C32(int k) {
  switch (k) { case 0: return 1.f; case 1: return 0.98078528f; case 2: return 0.923879533f; case 3: return 0.831469612f; case 4: return 0.707106781f; case 5: return 0.555570233f; case 6: return 0.382683432f;
    case 7: return 0.195090322f; case 8: return 0.f; case 9: return -0.195090322f; case 10: return -0.382683432f; case 11: return -0.555570233f; case 12: return -0.707106781f; case 13: return -0.831469612f;
    case 14: return -0.923879533f; default: return -0.98078528f; } }
__device__ __forceinline__ constexpr float S32(int k) {
  switch (k) { case 0: return 0.f; case 1: return 0.195090322f; case 2: return 0.382683432f; case 3: return 0.555570233f; case 4: return 0.707106781f; case 5: return 0.831469612f; case 6: return 0.923879533f;
    case 7: return 0.98078528f; case 8: return 1.f; case 9: return 0.98078528f; case 10: return 0.923879533f; case 11: return 0.831469612f; case 12: return 0.707106781f; case 13: return 0.555570233f;
    case 14: return 0.382683432f; default: return 0.195090322f; } }
__device__ __forceinline__ constexpr int brev(int q, int bits) {
  return bits == 4 ? (((q & 1) << 3) | ((q & 2) << 1) | ((q & 4) >> 1) | ((q & 8) >> 3))
                   : (((q & 1) << 4) | ((q & 2) << 2) | (q & 4) | ((q & 8) >> 2) | ((q & 16) >> 4)); }
__device__ __forceinline__ int phys(int p) { return p + (p >> 5); }
template <int R, int HALF, bool INV> struct DftStage {
  static __device__ __forceinline__ void run(c32 (&x)[R]) {
#pragma unroll
    for (int blk = 0; blk < R; blk += 2 * HALF) {
#pragma unroll
      for (int j = 0; j < HALF; ++j) {
        const c32 a = x[blk + j], b = x[blk + j + HALF]; x[blk + j] = a + b; const c32 d = a - b;
        const int e = j * (R / (2 * HALF)) * (32 / R);
        if (e == 0) x[blk + j + HALF] = d;
        else if (e == 8) x[blk + j + HALF] = INV ? (c32){-d.y, d.x} : (c32){d.y, -d.x};
        else { const c32 wv = {C32(e), INV ? S32(e) : -S32(e)}; x[blk + j + HALF] = cmul(d, wv); }
      } }
    DftStage<R, HALF / 2, INV>::run(x);
  }
};
template <int R, bool INV> struct DftStage<R, 0, INV> { static __device__ __forceinline__ void run(c32 (&)[R]) {} };
template <int R, bool INV> __device__ __forceinline__ void dft_pow2(c32 (&x)[R]) { DftStage<R, R / 2, INV>::run(x); }
template <int R, int HALF> struct DitStage {
  static __device__ __forceinline__ void run(c32 (&x)[R]) {
#pragma unroll
    for (int blk = 0; blk < R; blk += 2 * HALF) {
#pragma unroll
      for (int j = 0; j < HALF; ++j) {
        const int e = j * (R / (2 * HALF)) * (32 / R);
        const c32 a = x[blk + j], b0 = x[blk + j + HALF];
        c32 b;
        if (e == 0) b = b0; else if (e == 8) b = (c32){-b0.y, b0.x}; else b = cmul(b0, (c32){C32(e), S32(e)});
        x[blk + j] = a + b; x[blk + j + HALF] = a - b;
      } }
    DitStage<R, HALF * 2>::run(x);
  }
};
template <int R> struct DitStage<R, R> { static __device__ __forceinline__ void run(c32 (&)[R]) {} };
template <int R> __device__ __forceinline__ void idft_dit(c32 (&x)[R]) { DitStage<R, 1>::run(x); }
template <int STRIDE, bool INV> __device__ __forceinline__ void pass16(c32* buf, int e0, float rev) {
  float rv = rev; asm volatile("" : "+v"(rv));
  const float cs = __builtin_amdgcn_cosf(rv), sn = __builtin_amdgcn_sinf(rv);
  const c32 w1 = {cs, INV ? sn : -sn};
  c32* p = buf + phys(e0); constexpr int PS = STRIDE + STRIDE / 32;
  c32 x[16];
  if (!INV) {
#pragma unroll
    for (int m = 0; m < 16; ++m) x[m] = p[PS * m];
    dft_pow2<16, false>(x);
    c32 w = w1; p[0] = x[0];
#pragma unroll
    for (int q = 1; q < 16; ++q) { p[PS * q] = cmul(x[brev(q, 4)], w); w = cmul(w, w1); }
  } else {
    c32 w = w1; x[0] = p[0];
#pragma unroll
    for (int q = 1; q < 16; ++q) { x[q] = cmul(p[PS * q], w); w = cmul(w, w1); }
    dft_pow2<16, true>(x);
#pragma unroll
    for (int m = 0; m < 16; ++m) p[PS * m] = x[brev(m, 4)];
  }
}
template <int MODE> __device__ __forceinline__ void mid32(c32* buf, h2* Hs, int j) {
  c32* p = buf + 33 * j; c32 x[32];
#pragma unroll
  for (int m = 0; m < 32; ++m) x[m] = p[m];
  dft_pow2<32, false>(x);
  if (MODE == 0) {
#pragma unroll
    for (int q = 0; q < 32; ++q) { const c32 v = x[brev(q, 5)]; Hs[q * 256 + j] = (h2){(_Float16)v.x, (_Float16)v.y}; }
  } else {
#pragma unroll
    for (int pp = 0; pp < 32; ++pp) { const h2 hv = Hs[brev(pp, 5) * 256 + j]; x[pp] = cmul(x[pp], (c32){(float)hv.x, (float)hv.y}); }
    idft_dit<32>(x);
#pragma unroll
    for (int m = 0; m < 32; ++m) p[m] = x[m];
  }
}
__device__ __forceinline__ void fwd2(c32* buf, int tid) {
  __syncthreads(); pass16<512, false>(buf, tid, (float)tid * (1.0f / 8192.0f));
  __syncthreads(); pass16<32, false>(buf, (tid >> 5) * 512 + (tid & 31), (float)(tid & 31) * (1.0f / 512.0f));
  __syncthreads();
}
__device__ __forceinline__ void conv(c32* buf, h2* Hs, int tid) {
  fwd2(buf, tid);
  if (tid < 256) mid32<1>(buf, Hs, tid);
  __syncthreads(); pass16<32, true>(buf, (tid >> 5) * 512 + (tid & 31), (float)(tid & 31) * (1.0f / 512.0f));
  __syncthreads(); pass16<512, true>(buf, tid, (float)tid * (1.0f / 8192.0f));
  __syncthreads();
}
__device__ __forceinline__ void item(int c, const bf16_t* HYT, const float* HK, const float* hy_bias, bf16_t* HYO, char* lds) {
  c32* buf = (c32*)lds; h2* H0 = (h2*)(lds + 67584); h2* H1 = H0 + 8192;
  const int tid = TIDX;
#pragma unroll 1
  for (int o = 0; o < 2; ++o) {
    const float* kp = HK + ((size_t)o * 256 + c) * 8192;
#pragma unroll
    for (int i = 0; i < 16; ++i) { const int n = tid + 512 * i; buf[phys(n)] = (c32){kp[n], 0.f}; }
    fwd2(buf, tid);
    if (tid < 256) mid32<0>(buf, o ? H1 : H0, tid);
    __syncthreads();
  }
  const float bias0 = hy_bias[c], bias1 = hy_bias[256 + c];
#pragma unroll 1
  for (int pr = 0; pr < 2; ++pr) {
    const bf16_t* v0 = HYT + ((size_t)(2 * pr) * 768 + c) * SEQ; const bf16_t* v1 = v0 + (size_t)768 * SEQ;
    c32 vv[8];
#pragma unroll
    for (int i = 0; i < 8; ++i) { const int t = tid + 512 * i; vv[i] = (c32){bf2f(v0[t]), bf2f(v1[t])}; buf[phys(t)] = vv[i]; buf[phys(t + 4096)] = (c32){0.f, 0.f}; }
    conv(buf, H0, tid);
#pragma unroll
    for (int i = 0; i < 8; ++i) { const int t = tid + 512 * i; const c32 y = buf[phys(t)];
      vv[i] = (c32){bf2f(v0[(size_t)256 * SEQ + t]) * (y.x * (1.0f / 8192.0f) + bias0 * vv[i].x), bf2f(v1[(size_t)256 * SEQ + t]) * (y.y * (1.0f / 8192.0f) + bias0 * vv[i].y)};
      buf[phys(t)] = vv[i]; buf[phys(t + 4096)] = (c32){0.f, 0.f}; }
    conv(buf, H1, tid);
#pragma unroll
    for (int i = 0; i < 8; ++i) { const int t = tid + 512 * i; const c32 y = buf[phys(t)];
      HYO[((size_t)(2 * pr) * 256 + c) * SEQ + t] = (bf16_t)f2bf(bf2f(v0[(size_t)512 * SEQ + t]) * (y.x * (1.0f / 8192.0f) + bias1 * vv[i].x));
      HYO[((size_t)(2 * pr + 1) * 256 + c) * SEQ + t] = (bf16_t)f2bf(bf2f(v1[(size_t)512 * SEQ + t]) * (y.y * (1.0f / 8192.0f) + bias1 * vv[i].y)); }
    __syncthreads();
  }
}
__device__ __forceinline__ void out_item(int it, const bf16_t* HYO, bf16_t* MIX, char* lds) {
  bf16_t (*T)[72] = (bf16_t (*)[72])lds;
  const int tid = TIDX, b = it >> 8, t0 = ((it >> 2) & 63) * 64, c0 = (it & 3) * 64;
  { const int cc = tid >> 3, t8 = (tid & 7) * 8; *(u32x4*)&T[cc][t8] = *(const u32x4*)(HYO + ((size_t)b * 256 + c0 + cc) * SEQ + t0 + t8); }
  __syncthreads();
  { const int tl = tid >> 3, c8 = (tid & 7) * 8; u32x4 o;
    o.x = (unsigned)T[c8][tl] | ((unsigned)T[c8 + 1][tl] << 16); o.y = (unsigned)T[c8 + 2][tl] | ((unsigned)T[c8 + 3][tl] << 16);
    o.z = (unsigned)T[c8 + 4][tl] | ((unsigned)T[c8 + 5][tl] << 16); o.w = (unsigned)T[c8 + 6][tl] | ((unsigned)T[c8 + 7][tl] << 16);
    *(u32x4*)(MIX + ((size_t)b * TPB + CTXL + t0 + tl) * DM + 768 + c0 + c8) = o; }
  __syncthreads();
}
}

#define LAS __attribute__((address_space(3)))
#define XB_TMO      128
#define XB_XCNT(j)  (256  + 64 * (j))
#define XB_XSUB(j)  (1280 + 64 * (j))
#define XB_XGEN(j)  (2304 + 64 * (j))
#define XB_TOP      3328
#define XB_TOPGEN   3392
#define XCD_BAR_WORDS 3456
#define XB_SPIN_CAP (1u << 18)

__device__ __forceinline__ unsigned xb_ld(unsigned* p)              { return __hip_atomic_load(p, __ATOMIC_RELAXED, __HIP_MEMORY_SCOPE_AGENT); }
__device__ __forceinline__ unsigned xb_add(unsigned* p, unsigned v) { return __hip_atomic_fetch_add(p, v, __ATOMIC_RELAXED, __HIP_MEMORY_SCOPE_AGENT); }
__device__ __forceinline__ unsigned xb_xcc_id() { return (unsigned)__builtin_amdgcn_s_getreg((3 << 11) | 20) & 0xFu; }
#define XB_SPIN(cond, bar) do { unsigned _sp = 0; while (cond) { __builtin_amdgcn_s_sleep(1); \
    if ((++_sp & 255u) == 0u) { if (xb_ld(&(bar)[XB_TMO])) break; if (_sp > XB_SPIN_CAP) { atomicAdd(&(bar)[XB_TMO], 1u); break; } } } } while (0)

struct XcdBarrier {
    unsigned* bar; unsigned x;
    volatile LAS unsigned* st;
};

__device__ __forceinline__ XcdBarrier xcd_barrier_post(unsigned* bar, volatile LAS unsigned* st) {
    XcdBarrier b; b.bar = bar; b.x = xb_xcc_id(); b.st = st;
    if (threadIdx.x == 0) (void)xb_add(&bar[XB_XCNT(b.x)], 1u);
    return b;
}
__device__ __forceinline__ void xcd_barrier_complete(unsigned* bar, unsigned x, unsigned& nloc, unsigned& nx) {
    const unsigned G = gridDim.x * gridDim.y * gridDim.z;
    unsigned sum, cnt, mine, sp = 0u;
    for (;;) {
        sum = 0u; cnt = 0u; mine = 0u;
#pragma unroll
        for (unsigned j = 0; j < 16; ++j) { const unsigned c = xb_ld(&bar[XB_XCNT(j)]); sum += c; cnt += (c > 0u) ? 1u : 0u; mine = (j == x) ? c : mine; }
        if (sum == G) break;
        __builtin_amdgcn_s_sleep(1);
        if ((++sp & 255u) == 0u) { if (xb_ld(&bar[XB_TMO])) break; if (sp > XB_SPIN_CAP) { atomicAdd(&bar[XB_TMO], 1u); break; } }
    }
    nloc = mine > 0u ? mine : 1u; nx = cnt > 0u ? cnt : 1u;
}

__device__ __forceinline__ void xcd_barrier(const XcdBarrier& b) {
    asm volatile("s_waitcnt vmcnt(0)" ::: "memory");
    __syncthreads();
    if (threadIdx.x == 0) {
        unsigned* bar = b.bar;
        __builtin_amdgcn_s_waitcnt(0);
        unsigned nloc = b.st[0], nx = b.st[1];
        if (nloc == 0u) { xcd_barrier_complete(bar, b.x, nloc, nx); b.st[0] = nloc; b.st[1] = nx; }
        const unsigned old = xb_add(&bar[XB_XSUB(b.x)], 1u);
        const unsigned gen = old / nloc;
        if (old + 1u == (gen + 1u) * nloc) {
            __builtin_amdgcn_fence(__ATOMIC_RELEASE, "agent");
            asm volatile("s_waitcnt vmcnt(0)" ::: "memory");
            const unsigned og = xb_add(&bar[XB_TOP], 1u);
            const unsigned tg = og / nx;
            if (og + 1u == (tg + 1u) * nx) xb_add(&bar[XB_TOPGEN], 1u);
            else XB_SPIN(xb_ld(&bar[XB_TOPGEN]) == tg, bar);
            __builtin_amdgcn_fence(__ATOMIC_ACQUIRE, "agent");
            xb_add(&bar[XB_XGEN(b.x)], 1u);
            asm volatile("s_waitcnt vmcnt(0)" ::: "memory");
        } else {
            XB_SPIN(xb_ld(&bar[XB_XGEN(b.x)]) == gen, bar);
            __builtin_amdgcn_fence(__ATOMIC_ACQUIRE, "agent");
            asm volatile("s_waitcnt vmcnt(0)" ::: "memory");
        }
    }
    __syncthreads();
}


struct MP { const float* in[33]; float* out; unsigned char* ws; };
typedef const float* const __attribute__((address_space(4))) * kargs_t;
#define KARGS() ({ kargs_t k_ = (kargs_t)__builtin_amdgcn_kernarg_segment_ptr(); asm volatile("" : "+s"(k_)); k_; })
#define WSP(K, off) ((unsigned char*)(K)[34] + (off))

__global__ void __launch_bounds__(NT, 2) mega(MP P) {
  cg::grid_group grid = cg::this_grid();
  extern __shared__ __attribute__((aligned(16))) char lds[];
  volatile LAS unsigned* xst = (volatile LAS unsigned*)(lds + LDS_BYTES - 16);
  if (threadIdx.x < 2) xst[threadIdx.x] = 0u;
  { kargs_t K = KARGS(); unsigned* bw = (unsigned*)WSP(K, WS_CTL) + CT_BAR;
    if (blockIdx.x == 0) for (int i = threadIdx.x; i < XCD_BAR_WORDS; i += NT) bw[i] = 0u; }
  __syncthreads();
constexpr int CUT = 0;
#define SEAM() do { xcd_barrier(xbar); if (CUT > 0 && pass_ == 0 && ++nph_ == CUT) { pass_ = 1; goto again_; } } while (0)
  {
    kargs_t K = KARGS();
    st_adaln(K[1], K[3], K[4], K[5], (float*)WSP(K, WS_MODV), lds);
    st_rope((float*)WSP(K, WS_ROPE));
  }
  {
      kargs_t K = KARGS();
      st_weights(K[8], K[26], K[29], K[30], K[31], 0, (bf16_t*)WSP(K, WS_WIN), (bf16_t*)WSP(K, WS_WOUT), (bf16_t*)WSP(K, WS_WGU), (bf16_t*)WSP(K, WS_WD), lds);
    }
    { kargs_t K = KARGS(); const int bid = BIDX, G = GDIM;
      for (int it = bid; it < SEQ / 16; it += G) hyfilt_item<SEQ>(it, K[19] + 0 * 33 * 64, K[20] + 0 * 64, K[21] + 0 * 64, K[22] + 0 * 4096, K[23] + 0 * 64, K[24] + (size_t)0 * 65536, (float*)WSP(K, WS_HK), lds);
      if (true) for (int it = bid; it < CTXL / 16; it += G) hyfilt_item<CTXL>(it, K[19] + 0 * 33 * 64, K[20] + 0 * 64, K[21] + 0 * 64, K[22] + 0 * 4096, K[23] + 0 * 64, K[24] + (size_t)0 * 65536, (float*)WSP(K, WS_HKC), lds);
    }
  grid.sync();
  XcdBarrier xbar;
  { kargs_t K = KARGS(); xbar = xcd_barrier_post((unsigned*)WSP(K, WS_CTL) + CT_BAR, xst); }
  int pass_ = 0, nph_ = 0;
again_:
#pragma nounroll
  for (int layer = 0; layer < 2; ++layer) {
    const bool last = layer == 1;
    if (layer == 1) {
    {
      kargs_t K = KARGS();
      st_weights(K[8], K[26], K[29], K[30], K[31], layer, (bf16_t*)WSP(K, WS_WIN), (bf16_t*)WSP(K, WS_WOUT), (bf16_t*)WSP(K, WS_WGU), (bf16_t*)WSP(K, WS_WD), lds);
    }
    { kargs_t K = KARGS(); const int bid = BIDX, G = GDIM;
      for (int it = bid; it < SEQ / 16; it += G) hyfilt_item<SEQ>(it, K[19] + layer * 33 * 64, K[20] + layer * 64, K[21] + layer * 64, K[22] + layer * 4096, K[23] + layer * 64, K[24] + (size_t)layer * 65536, (float*)WSP(K, WS_HK), lds);
      if (!last) for (int it = bid; it < CTXL / 16; it += G) hyfilt_item<CTXL>(it, K[19] + layer * 33 * 64, K[20] + layer * 64, K[21] + layer * 64, K[22] + layer * 4096, K[23] + layer * 64, K[24] + (size_t)layer * 65536, (float*)WSP(K, WS_HKC), lds);
    }
    }
    { kargs_t K = KARGS();
      const float* xl_src = layer == 0 ? K[0] : K[33]; const float* xc_src = layer == 0 ? K[2] : (const float*)WSP(K, WS_XC);
      st_normmod(xl_src, xc_src, K[6] + layer * 1024, (const float*)WSP(K, WS_MODV) + (size_t)layer * 5 * 6144, 0, 1024, (bf16_t*)WSP(K, WS_H));
    }
    SEAM();
    {
      kargs_t K = KARGS();
      pg8::Gemm g{1024, 1024, 1024}; SchedDense S{MTOK / 256, NPAD / 256, (int)GDIM, BIDX, 0, (const char*)WSP(K, WS_H), (const char*)WSP(K, WS_WIN), (size_t)256 * 1024 * 2, (size_t)256 * 1024 * 2};
      EpiInProj E{(bf16_t*)WSP(K, WS_QK), (bf16_t*)WSP(K, WS_VZ), (bf16_t*)WSP(K, WS_XBC), (bf16_t*)WSP(K, WS_HY), (float*)WSP(K, WS_DT)};
      pg8::gemm_phase<EpiInProj, SchedDense, true, true>((PG8_LAS unsigned char*)lds, g, S, E);
    }
    SEAM();
    {
      kargs_t K = KARGS();
      st_prep_qk((bf16_t*)WSP(K, WS_QK), K[9] + layer * 64, K[10] + layer * 64, (const float*)WSP(K, WS_ROPE));
    }
    { kargs_t K = KARGS();
      st_prep_hy((const bf16_t*)WSP(K, WS_HY), K[17] + layer * 3 * 768, K[18] + layer * 768, (bf16_t*)WSP(K, WS_HYT), last ? 0 : 1, lds);
    }
    { kargs_t K = KARGS(); const int bid = BIDX, G = GDIM;
      for (int it = bid; it < 4 * 34 * 6; it += G)
        ssd1_item(it, (const bf16_t*)WSP(K, WS_XBC), (const float*)WSP(K, WS_DT), K[11] + layer * 3 * 640, K[12] + layer * 640, K[13] + layer * 12, K[14] + layer * 12,
                  (float*)WSP(K, WS_Y), (float*)WSP(K, WS_ST), (float*)WSP(K, WS_DEC), lds);
    }
    SEAM();
    {
      { kargs_t K2 = KARGS(); st_ssd_scan2((float*)WSP(K2, WS_ST), (const float*)WSP(K2, WS_DEC)); }
      const int bid = BIDX, G = GDIM;
#define P4_ATT(bb, hq, qrow_, nt_) do { kargs_t K = KARGS(); const int kvh_ = (hq) / 3; \
          const attn_body::bf16* QKp = (const attn_body::bf16*)WSP(K, WS_QK); const attn_body::bf16* VZp = (const attn_body::bf16*)WSP(K, WS_VZ); \
          attn_body::attn_unit<8>(QKp + (size_t)(qrow_) * 512 + (hq) * 64, QKp + (size_t)(bb) * TPB * 512 + 384 + kvh_ * 64, VZp + (size_t)(bb) * TPB * 512 + kvh_ * 64, \
                                  (attn_body::bf16*)WSP(K, WS_H) + (size_t)(qrow_) * 1024 + (hq) * 64, (nt_), lds); } while (0)
#define P4_FFT(cch) do { kargs_t K = KARGS(); hyf::item((cch), (const bf16_t*)WSP(K, WS_HYT), (const float*)WSP(K, WS_HK), K[25] + layer * 512, (bf16_t*)WSP(K, WS_HY), lds); } while (0)
#define P4_CHY(itm) do { kargs_t K = KARGS(); hyconv_ctx_item((itm), (const bf16_t*)WSP(K, WS_HYT) + (size_t)4 * 768 * SEQ, (const float*)WSP(K, WS_HKC), K[25] + layer * 512, (bf16_t*)WSP(K, WS_H), lds); } while (0)
      {
        const int x = bid & 7, y = bid >> 3, bb = x >> 1, kvh = x & 1;
        const int nun = y < 16 ? 2 : 1, natt = nun + ((!last && y < 3) ? 1 : 0);
#pragma unroll 1
        for (int k = 0; k < natt; ++k) { int hq, qrow, nt;
          if (k < nun) { const int v = y < 16 ? y + 16 * k : 16 + y; hq = 3 * kvh + (v >> 4); qrow = bb * TPB + CTXL + (v & 15) * 256; nt = TPB / 64; }
          else { hq = 3 * kvh + y; qrow = bb * TPB; nt = CTXL / 64; }
          P4_ATT(bb, hq, qrow, nt); }
        if (y >= 16) {
#pragma unroll 1
          for (int k = 0; k < 2; ++k) { const int cch = ((y - 16) * 8 + x) * 2 + k; P4_FFT(cch); } }
        if (!last && y >= 3 && y < 11) { P4_CHY((y - 3) * 8 + x); }
      }
      (void)G;
#undef P4_ATT
#undef P4_FFT
#undef P4_CHY
    }
    SEAM();
    {
      kargs_t K = KARGS();
      { const int bid = BIDX, G = GDIM, nit = last ? 4 * 32 * 2 : 4 * 34 * 2;
        for (int it = bid; it < nit; it += G) { const int g = it & 1, bc = it >> 1; const int b = last ? bc >> 5 : bc / 34, cidx = last ? 2 + (bc & 31) : bc % 34;
          ssd3_item(b, cidx, g, (const bf16_t*)WSP(K, WS_XBC), (const bf16_t*)WSP(K, WS_VZ), (const float*)WSP(K, WS_DT), K[11] + layer * 3 * 640, K[12] + layer * 640, K[13] + layer * 12, K[14] + layer * 12,
                    K[15] + layer * 6, K[16] + layer * 384, (const float*)WSP(K, WS_Y), (const float*)WSP(K, WS_ST), (bf16_t*)WSP(K, WS_H), lds); } }
      { const int bid = BIDX, G = GDIM; for (int it = bid; it < 1024; it += G) hyf::out_item(it, (const bf16_t*)WSP(K, WS_HY), (bf16_t*)WSP(K, WS_H), lds); }
      const int t = TIDX; if (BIDX == 0 && t < 256) ((int*)WSP(K, WS_CTL))[t] = 0;
      { int* stok = (int*)WSP(K, WS_MOEM + 384 * 1024); for (int i = BIDX * NT + t; i < MOE_ROWS; i += GDIM * NT) stok[i] = -1; }
    }
    SEAM();
    {
      kargs_t K = KARGS();
      const float* xl_src = layer == 0 ? K[0] : K[33]; const float* xc_src = layer == 0 ? K[2] : (const float*)WSP(K, WS_XC);
      pg8::Gemm g{1024, 1024, 1024}; SchedDense S{last ? 64 : 68, 4, (int)GDIM, BIDX, last ? 1 : 0, (const char*)WSP(K, WS_H), (const char*)WSP(K, WS_WOUT), (size_t)256 * 1024 * 2, (size_t)256 * 1024 * 2};
      EpiOutProj E{xl_src, xc_src, (float*)K[33], (float*)WSP(K, WS_XC), (const float*)WSP(K, WS_MODV) + (size_t)layer * 5 * 6144 + 2048};
      pg8::gemm_phase<EpiOutProj, SchedDense, true, true>((PG8_LAS unsigned char*)lds, g, S, E);
    }
    SEAM();
    {
      kargs_t K = KARGS();
      st_router(K[33], (const float*)WSP(K, WS_XC), K[7] + layer * 1024, (const float*)WSP(K, WS_MODV) + (size_t)layer * 5 * 6144, K[27], K[28], (bf16_t*)WSP(K, WS_H), (int*)WSP(K, WS_CTL),
                (int*)WSP(K, WS_MOEM), (float*)WSP(K, WS_MOEM + 128 * 1024), last ? 1 : 0, lds);
    }
    SEAM();
    { kargs_t K = KARGS();
      st_moe_gather((const bf16_t*)WSP(K, WS_H), (bf16_t*)WSP(K, WS_H2S), (int*)WSP(K, WS_CTL), (const int*)WSP(K, WS_MOEM), (const float*)WSP(K, WS_MOEM + 128 * 1024),
                    (int*)WSP(K, WS_MOEM + 384 * 1024), (float*)WSP(K, WS_MOEM + 512 * 1024), last ? 1 : 0, lds);
    }
    SEAM();
    { kargs_t K = KARGS();
      pg8::Gemm g{1024, 1024, 1024}; SchedMoe S{(int)GDIM, BIDX, 1, (const int*)WSP(K, WS_CTL), (const char*)WSP(K, WS_H2S), (size_t)256 * 1024 * 2, (const char*)WSP(K, WS_WGU)};
      EpiMoe1 E{(bf16_t*)WSP(K, WS_ACT), (const float*)WSP(K, WS_MOEM + 512 * 1024)};
      pg8::gemm_phase<EpiMoe1, SchedMoe, true, true>((PG8_LAS unsigned char*)lds, g, S, E);
    }
    SEAM();
    { kargs_t K = KARGS();
      pg8::Gemm g{256, 512, 256}; SchedMoe S{(int)GDIM, BIDX, 2, (const int*)WSP(K, WS_CTL), (const char*)WSP(K, WS_ACT), (size_t)256 * 512 * 2, (const char*)WSP(K, WS_WD)};
      EpiMoe2 E{(float*)K[33], (float*)WSP(K, WS_XC), (const float*)WSP(K, WS_MODV) + (size_t)layer * 5 * 6144 + 5120, (const int*)WSP(K, WS_MOEM + 384 * 1024)};
      pg8::gemm_phase<EpiMoe2, SchedMoe, true, true>((PG8_LAS unsigned char*)lds, g, S, E);
    }
    SEAM();
  }
  { kargs_t K = KARGS(); st_final((float*)K[33], K[32]); }
}

extern "C" void kernel_launch(void* const* d_in, const int* in_sizes, int n_in, void* d_out, int out_size, void* d_ws, size_t ws_size, hipStream_t stream) {
  if (n_in != 33 || ws_size < WS_END) { fprintf(stderr, "kernel_launch: unexpected n_in %d / ws %zu\n", n_in, ws_size); return; }
  static int grid_blocks = 0;
  if (!grid_blocks) {
    int dev = 0, cus = 0, per_cu = 0;
    (void)hipGetDevice(&dev);
    (void)hipDeviceGetAttribute(&cus, hipDeviceAttributeMultiprocessorCount, dev);
    (void)hipFuncSetAttribute((const void*)mega, hipFuncAttributeMaxDynamicSharedMemorySize, LDS_BYTES);
    (void)hipOccupancyMaxActiveBlocksPerMultiprocessor(&per_cu, mega, NT, LDS_BYTES);
    if (per_cu < 1) per_cu = 1;
    if (per_cu > 2) per_cu = 2;
    grid_blocks = 256;
    if (cus != 256 || per_cu < 1) fprintf(stderr, "kernel_launch: expected 256 CUs with >= 1 workgroup each (got %d CUs, %d per CU)\n", cus, per_cu);
  }
  MP p{};
  for (int i = 0; i < 33; ++i) p.in[i] = (const float*)d_in[i];
  p.out = (float*)d_out; p.ws = (unsigned char*)d_ws;
  void* args[] = {&p};
  hipError_t e = hipLaunchCooperativeKernel((const void*)mega, dim3(grid_blocks), dim3(NT), args, LDS_BYTES, stream);
  if (e != hipSuccess) fprintf(stderr, "cooperative launch failed: %s (grid %d)\n", hipGetErrorString(e), grid_blocks);
}
```

```cpp
#include <hip/hip_runtime.h>
#include <hip/hip_cooperative_groups.h>
#include <cstdio>
#include <cstdint>
namespace cg = cooperative_groups;

typedef unsigned short bf16_t;
typedef short bf16x8 __attribute__((ext_vector_type(8)));
typedef float f32x4 __attribute__((ext_vector_type(4)));
typedef unsigned u32x4 __attribute__((ext_vector_type(4)));
typedef unsigned u32x2 __attribute__((ext_vector_type(2)));

constexpr int NB = 4, SEQ = 4096, CTXL = 256, DM = 1024, TPB = 4352, MTOK = NB * TPB;
constexpr int DIN = 2444, NPAD = 2560;
constexpr float EPS = 1e-6f;
constexpr float C2 = 0.125f * 1.4426950408889634f;
constexpr int MOE_ROWS = 23552;
constexpr int NT = 512;
constexpr int LDS_BYTES = 147456;

constexpr size_t MiB = 1u << 20;
constexpr size_t WS_CTL = 0;
constexpr size_t WS_MODV = 1 * MiB;
constexpr size_t WS_ROPE = 2 * MiB;
constexpr size_t WS_MOEM = 3 * MiB;
constexpr size_t WS_DT = 4 * MiB;
constexpr size_t WS_HKC = 5 * MiB;
constexpr size_t WS_XC = 6 * MiB;
constexpr size_t WS_WIN = 10 * MiB;
constexpr size_t WS_WOUT = 15 * MiB;
constexpr size_t WS_WGU = 17 * MiB;
constexpr size_t WS_WD = 33 * MiB;
constexpr size_t WS_HK = 41 * MiB;
constexpr size_t WS_H = 57 * MiB;
constexpr size_t WS_QK = 91 * MiB;
constexpr size_t WS_VZ = 108 * MiB;
constexpr size_t WS_XBC = 125 * MiB;
constexpr size_t WS_HY = WS_XBC + (size_t)MTOK * 768 * 2;
constexpr size_t WS_HYT = WS_HY + (size_t)MTOK * 768 * 2;
constexpr size_t WS_ST = WS_HYT + (size_t)MTOK * 768 * 2;
constexpr size_t WS_Y = WS_ST + (size_t)4 * 34 * 2 * 6 * 4096 * 4;
constexpr size_t WS_END = WS_Y + (size_t)MTOK * 384 * 4;
constexpr size_t WS_DEC = WS_DT + 900 * 1024;
constexpr size_t WS_H2S = WS_QK;
constexpr size_t WS_ACT = WS_H2S + (size_t)MOE_ROWS * 1024 * 2;
static_assert(WS_END <= 256 * MiB, "ws");
static_assert(WS_ACT + (size_t)MOE_ROWS * 512 * 2 <= WS_HYT, "moe alias");

constexpr int CT_CNT = 0, CT_FILL = 32, CT_BASE = 64, CT_NT = 96, CT_TP = 128;
constexpr int CT_BAR = 4096;
constexpr int CT_CNTB = 8192;

__device__ __forceinline__ int opq_v(int v) { asm volatile("" : "+v"(v)); return v; }
__device__ __forceinline__ int opq_s(int v) { asm volatile("" : "+s"(v)); return v; }
#define TIDX opq_v((int)threadIdx.x)
#define BIDX opq_s((int)blockIdx.x)
#define GDIM opq_s((int)gridDim.x)
__device__ __forceinline__ unsigned f2bf(float f) { unsigned u = __float_as_uint(f); return (u + 0x7fffu + ((u >> 16) & 1u)) >> 16; }
__device__ __forceinline__ unsigned pk2bf(float lo, float hi) { return f2bf(lo) | (f2bf(hi) << 16); }
__device__ __forceinline__ float bf2f(bf16_t h) { return __uint_as_float(((unsigned)h) << 16); }
__device__ __forceinline__ float wave_sum(float v) {
#pragma unroll
  for (int o = 1; o < 64; o <<= 1) v += __shfl_xor(v, o);
  return v;
}
__device__ __forceinline__ float siluf(float v) { return v / (1.0f + __expf(-v)); }
__device__ __forceinline__ float* xrow(const float* xl, const float* xc, int r) {
  const int b = r / TPB, j = r - b * TPB;
  return (float*)(j < CTXL ? xc + ((size_t)b * CTXL + j) * DM : xl + ((size_t)b * SEQ + (j - CTXL)) * DM);
}
__device__ __forceinline__ int mrow_of(int r) { const int b = r / TPB, j = r - b * TPB; return j < CTXL ? 4 : b; }

__device__ __forceinline__ void st_adaln(const float* c, const float* c_ctx, const float* w_mod, const float* b_mod, float* modv, char* lds) {
  float (*sc)[1024] = (float (*)[1024])lds;
  float (*red)[5][64] = (float (*)[5][64])(lds + 5 * 1024 * 4);
  const int tid = TIDX;
  for (int it = BIDX; it < 192; it += GDIM) {
    const int layer = it / 96, n0 = (it % 96) * 64;
    for (int i = tid; i < 5 * 1024; i += NT) { const int r = i >> 10, k = i & 1023; const float v = r < 4 ? c[r * 1024 + k] : c_ctx[k]; sc[r][k] = v / (1.0f + expf(-v)); }
    __syncthreads();
    const int kg = tid >> 6, n = tid & 63;
    float acc[5] = {0.f, 0.f, 0.f, 0.f, 0.f};
#pragma unroll 16
    for (int k = kg; k < 1024; k += 8) { const float w = w_mod[((size_t)layer * 1024 + k) * 6144 + n0 + n];
#pragma unroll
      for (int r = 0; r < 5; ++r) acc[r] += sc[r][k] * w; }
#pragma unroll
    for (int r = 0; r < 5; ++r) red[kg][r][n] = acc[r];
    __syncthreads();
    if (tid < 320) { const int r = tid >> 6, nn = tid & 63; float s = 0.f;
#pragma unroll
      for (int g = 0; g < 8; ++g) s += red[g][r][nn];
      modv[((size_t)layer * 5 + r) * 6144 + n0 + nn] = s + b_mod[layer * 6144 + n0 + nn]; }
    __syncthreads();
  }
}
__device__ __forceinline__ void st_rope(float* rope) {
  for (int i = BIDX * NT + TIDX; i < 4096 * 32; i += GDIM * NT) {
    const int t = i >> 5, d = i & 31, m = d & 15;
    const float inv = powf(10000.0f, -(float)(2 * m) / 32.0f);
    const float pos = (float)(d < 16 ? (t >> 6) : (t & 63));
    const float ang = pos * inv;
    rope[2 * i] = cosf(ang); rope[2 * i + 1] = sinf(ang);
  }
}

__device__ __forceinline__ void st_normmod(const float* xl, const float* xc, const float* g, const float* modv_layer, int off_sh, int off_sc, bf16_t* H, char* lds) {
  float* mA = (float*)lds; float* mB = mA + 5 * 1024;
  const int tid = TIDX, lane = tid & 63, gw = BIDX * 8 + (tid >> 6), ngw = GDIM * 8;
  for (int idx = tid; idx < 5 * 1024; idx += NT) { const int m = idx >> 10, k = idx & 1023; mA[idx] = g[k] * (1.f + modv_layer[(size_t)m * 6144 + off_sc + k]); mB[idx] = modv_layer[(size_t)m * 6144 + off_sh + k]; }
  __syncthreads();
  for (int rb = gw; rb < MTOK; rb += 3 * ngw) {
    f32x4 v[3][4]; float rstd[3];
#pragma unroll
    for (int u = 0; u < 3; ++u) { const int r = rb + u * ngw; const float* xr = xrow(xl, xc, r < MTOK ? r : MTOK - 1);
#pragma unroll
      for (int j = 0; j < 4; ++j) v[u][j] = *(const f32x4*)(xr + 4 * lane + 256 * j); }
#pragma unroll
    for (int u = 0; u < 3; ++u) { float ss = 0.f;
#pragma unroll
      for (int j = 0; j < 4; ++j) ss += v[u][j].x * v[u][j].x + v[u][j].y * v[u][j].y + v[u][j].z * v[u][j].z + v[u][j].w * v[u][j].w;
      rstd[u] = rsqrtf(wave_sum(ss) * (1.0f / DM) + EPS); }
#pragma unroll
    for (int u = 0; u < 3; ++u) { const int r = rb + u * ngw;
      if (r < MTOK) { const int mo = mrow_of(r) * 1024;
#pragma unroll
        for (int j = 0; j < 4; ++j) { const int k = 4 * lane + 256 * j;
          const f32x4 a4 = *(const f32x4*)(mA + mo + k), b4 = *(const f32x4*)(mB + mo + k); const f32x4 o = v[u][j] * rstd[u] * a4 + b4;
          u32x2 w; w.x = pk2bf(o.x, o.y); w.y = pk2bf(o.z, o.w);
          *(u32x2*)(H + (size_t)r * DM + k) = w; } } }
  }
  __syncthreads();
}

template <int MODE> __device__ __forceinline__ void tr_tile(const float* src, const float* src2, int ldsrc, int K, bf16_t* out, int n0, int k0, char* lds) {
  float (*tile)[65] = (float (*)[65])lds;
  const int tid = TIDX;
#pragma unroll
  for (int i = 0; i < 8; ++i) { const int kk = (tid >> 6) + 8 * i, nn = tid & 63, n = n0 + nn; float v = 0.f;
    if (MODE == 0) { const int col = n < 1676 ? n : (n < 1792 ? -1 : n - 116); if (col >= 0) v = src[(size_t)(k0 + kk) * ldsrc + col]; }
    else if (MODE == 1) { v = src[(size_t)(k0 + kk) * ldsrc + n]; }
    else { v = (n & 1) ? src2[(size_t)(k0 + kk) * ldsrc + (n >> 1)] : src[(size_t)(k0 + kk) * ldsrc + (n >> 1)]; }
    tile[kk][nn] = v; }
  __syncthreads();
#pragma unroll
  for (int i = 0; i < 4; ++i) { const int nn = (tid >> 5) + 16 * i, kk = (tid & 31) * 2;
    *(unsigned*)(out + (size_t)(n0 + nn) * K + k0 + kk) = f2bf(tile[kk][nn]) | (f2bf(tile[kk + 1][nn]) << 16); }
  __syncthreads();
}
template <int MODE> __device__ __forceinline__ void tr_wave_item(const float* src, const float* src2, int ldsrc, int K, bf16_t* out, int n0, int k0, float* scr, int lane) {
  const int nn = lane & 31, n = n0 + nn;
#pragma unroll 8
  for (int i = 0; i < 32; ++i) { const int kk = 2 * i + (lane >> 5); float v = 0.f;
    if (MODE == 0) { const int col = n < 1676 ? n : (n < 1792 ? -1 : n - 116); if (col >= 0) v = src[(size_t)(k0 + kk) * ldsrc + col]; }
    else if (MODE == 1) v = src[(size_t)(k0 + kk) * ldsrc + n];
    else v = (n & 1) ? src2[(size_t)(k0 + kk) * ldsrc + (n >> 1)] : src[(size_t)(k0 + kk) * ldsrc + (n >> 1)];
    scr[kk * 33 + nn] = v; }
  asm volatile("s_waitcnt lgkmcnt(0)" ::: "memory");
  const int c = lane & 7;
#pragma unroll
  for (int j = 0; j < 4; ++j) { const int nr = (lane >> 3) + 8 * j; const float* sp = scr + (8 * c) * 33 + nr;
    u32x4 o; o.x = f2bf(sp[0]) | (f2bf(sp[33]) << 16); o.y = f2bf(sp[66]) | (f2bf(sp[99]) << 16); o.z = f2bf(sp[132]) | (f2bf(sp[165]) << 16); o.w = f2bf(sp[198]) | (f2bf(sp[231]) << 16);
    *(u32x4*)(out + (size_t)(n0 + nr) * K + k0 + 8 * c) = o; }
  asm volatile("s_waitcnt lgkmcnt(0)" ::: "memory");
}
__device__ __forceinline__ void st_weights(const float* w_in, const float* w_out, const float* w_gate, const float* w_up, const float* w_down, int layer,
                                           bf16_t* WIN, bf16_t* WOUT, bf16_t* WGU, bf16_t* WD, char* lds) {
  const int tid = TIDX, lane = tid & 63, w = tid >> 6; float* scr = (float*)lds + w * (64 * 33);
  for (int it = BIDX * 8 + w; it < 7936; it += GDIM * 8) {
    if (it < 1280) tr_wave_item<0>(w_in + (size_t)layer * 1024 * DIN, nullptr, DIN, 1024, WIN, (it % 80) * 32, (it / 80) * 64, scr, lane);
    else if (it < 1792) { const int i2 = it - 1280; tr_wave_item<1>(w_out + (size_t)layer * 1024 * 1024, nullptr, 1024, 1024, WOUT, (i2 & 31) * 32, (i2 >> 5) * 64, scr, lane); }
    else if (it < 5888) { const int i2 = it - 1792, e = i2 >> 8, t = i2 & 255;
      tr_wave_item<2>(w_gate + ((size_t)layer * 16 + e) * 1024 * 256, w_up + ((size_t)layer * 16 + e) * 1024 * 256, 256, 1024, WGU + (size_t)e * 512 * 1024, (t & 15) * 32, (t >> 4) * 64, scr, lane); }
    else { const int i2 = it - 5888, e = i2 >> 7, t = i2 & 127;
      tr_wave_item<1>(w_down + ((size_t)layer * 16 + e) * 256 * 1024, nullptr, 1024, 256, WD + (size_t)e * 1024 * 256, (t & 31) * 32, (t >> 5) * 64, scr, lane); }
  }
  __syncthreads();
}

template <class P> __device__ __forceinline__ void st_gemm(const P& p, int ntm, int ntn, char* lds) {
  bf16_t (*As)[72] = (bf16_t (*)[72])lds;
  bf16_t (*Bs)[72] = (bf16_t (*)[72])(lds + 256 * 72 * 2);
  const int tid = TIDX, lane = tid & 63, w = tid >> 6;
  for (int it = BIDX; it < ntm * ntn; it += GDIM) {
    const int mt = it / ntn, nt = it % ntn;
    if (!p.valid(mt)) continue;
    const int m0 = mt * 256, n0 = nt * 128;
    f32x4 acc[2][8];
#pragma unroll
    for (int a = 0; a < 2; ++a)
#pragma unroll
      for (int b = 0; b < 8; ++b) acc[a][b] = (f32x4){0.f, 0.f, 0.f, 0.f};
    const int K = p.K;
    for (int k0 = 0; k0 < K; k0 += 64) {
#pragma unroll
      for (int i = 0; i < 4; ++i) { const int ch = tid + NT * i, r = ch >> 3, kc = (ch & 7) * 8;
        const bf16_t* ap = p.arow(m0 + r); *(u32x4*)&As[r][kc] = *(const u32x4*)(ap + k0 + kc); }
#pragma unroll
      for (int i = 0; i < 2; ++i) { const int ch = tid + NT * i, r = ch >> 3, kc = (ch & 7) * 8;
        const bf16_t* bp = p.brow(mt, n0 + r, k0); *(u32x4*)&Bs[r][kc] = *(const u32x4*)(bp + kc); }
      __syncthreads();
#pragma unroll
      for (int kk = 0; kk < 2; ++kk) {
        bf16x8 a[2], b[8];
#pragma unroll
        for (int mi = 0; mi < 2; ++mi) a[mi] = *(const bf16x8*)&As[32 * w + 16 * mi + (lane & 15)][kk * 32 + 8 * (lane >> 4)];
#pragma unroll
        for (int ni = 0; ni < 8; ++ni) b[ni] = *(const bf16x8*)&Bs[16 * ni + (lane & 15)][kk * 32 + 8 * (lane >> 4)];
#pragma unroll
        for (int mi = 0; mi < 2; ++mi)
#pragma unroll
          for (int ni = 0; ni < 8; ++ni) acc[mi][ni] = __builtin_amdgcn_mfma_f32_16x16x32_bf16(a[mi], b[ni], acc[mi][ni], 0, 0, 0);
      }
      __syncthreads();
    }
    p.epi(acc, mt, m0, n0, w, lane);
  }
}

struct PInProj {
  const bf16_t* H; const bf16_t* W; bf16_t *QK, *VZ, *XBC, *HY; float* DT; int K;
  __device__ bool valid(int) const { return true; }
  __device__ const bf16_t* arow(int m) const { return H + (size_t)m * DM; }
  __device__ const bf16_t* brow(int, int n, int k0) const { return W + (size_t)n * DM + k0; }
  __device__ void epi(const f32x4 (&acc)[2][8], int, int m0, int n0, int w, int lane) const {
#pragma unroll
    for (int mi = 0; mi < 2; ++mi)
#pragma unroll
      for (int ni = 0; ni < 8; ++ni)
#pragma unroll
        for (int rg = 0; rg < 4; ++rg) { const int row = m0 + 32 * w + 16 * mi + 4 * (lane >> 4) + rg, col = n0 + 16 * ni + (lane & 15); const float v = acc[mi][ni][rg];
          if (col < 512) QK[(size_t)row * 512 + col] = (bf16_t)f2bf(v);
          else if (col < 1024) VZ[(size_t)row * 512 + col - 512] = (bf16_t)f2bf(v);
          else if (col < 1792) { XBC[(size_t)row * 768 + col - 1024] = (bf16_t)f2bf(v); if (col >= 1664 && col < 1676) DT[(size_t)row * 12 + col - 1664] = v; }
          else HY[(size_t)row * 768 + col - 1792] = (bf16_t)f2bf(v); }
  }
};
struct POutProj {
  const bf16_t* A; const bf16_t* W; const float *xl_src, *xc_src; float *xl_dst, *xc_dst; const float* gate;   int skip_ctx; int K;
  __device__ bool valid(int mt) const { return !(skip_ctx && ((mt * 256) % TPB) < CTXL); }
  __device__ const bf16_t* arow(int m) const { return A + (size_t)m * DM; }
  __device__ const bf16_t* brow(int, int n, int k0) const { return W + (size_t)n * DM + k0; }
  __device__ void epi(const f32x4 (&acc)[2][8], int, int m0, int n0, int w, int lane) const {
#pragma unroll
    for (int mi = 0; mi < 2; ++mi)
#pragma unroll
      for (int rg = 0; rg < 4; ++rg) { const int row = m0 + 32 * w + 16 * mi + 4 * (lane >> 4) + rg;
        const float* xs = xrow(xl_src, xc_src, row); float* xd = xrow(xl_dst, xc_dst, row); const float* gt = gate + (size_t)mrow_of(row) * 6144;
#pragma unroll
        for (int ni = 0; ni < 8; ++ni) { const int col = n0 + 16 * ni + (lane & 15); xd[col] = xs[col] + gt[col] * acc[mi][ni][rg]; } }
  }
};
__device__ __forceinline__ void pair_experts(int pidx, int& eA, int& eB) {
  const int g = pidx / 6, t = pidx - 6 * g; const int i = t < 3 ? 0 : (t < 5 ? 1 : 2); const int j = t < 3 ? t + 1 : (t < 5 ? t - 1 : 3);
  eA = 4 * g + i; eB = 4 * g + j;
}
struct PMoe1 {
  const bf16_t* H2S; const bf16_t* WGU; bf16_t* ACT; const int* ctl; const float* sorted_w; int K;
  __device__ bool valid(int mt) const { return mt < ctl[CT_NT]; }
  __device__ const bf16_t* arow(int m) const { return H2S + (size_t)m * DM; }
  __device__ const bf16_t* brow(int mt, int n, int k0) const { int eA, eB; pair_experts(ctl[CT_TP + mt], eA, eB); const int e = n < 512 ? eA : eB;
    return WGU + ((size_t)e * 512 + (n & 511)) * DM + k0; }
  __device__ void epi(const f32x4 (&acc)[2][8], int, int m0, int n0, int w, int lane) const {
    const int half = n0 >> 9, tb = (n0 & 511) >> 7;
#pragma unroll
    for (int mi = 0; mi < 2; ++mi)
#pragma unroll
      for (int rg = 0; rg < 4; ++rg) { const int slot = m0 + 32 * w + 16 * mi + 4 * (lane >> 4) + rg; const float wt = sorted_w[2 * slot + half];
#pragma unroll
        for (int ni = 0; ni < 4; ++ni) { const float g = acc[mi][ni][rg], u = acc[mi][ni + 4][rg]; const int j = 64 * tb + 16 * ni + (lane & 15);
          ACT[(size_t)slot * 512 + half * 256 + j] = (bf16_t)f2bf(siluf(g) * u * wt); } }
  }
};
struct PMoe2 {
  const bf16_t* ACT; const bf16_t* WD; float *xl, *xc; const float* gate;   const int* ctl; const int* sorted_tok; int K;
  __device__ bool valid(int mt) const { return mt < ctl[CT_NT]; }
  __device__ const bf16_t* arow(int m) const { return ACT + (size_t)m * 512; }
  __device__ const bf16_t* brow(int mt, int n, int k0) const { int eA, eB; pair_experts(ctl[CT_TP + mt], eA, eB); const int e = k0 < 256 ? eA : eB;
    return WD + ((size_t)e * 1024 + n) * 256 + (k0 & 255); }
  __device__ void epi(const f32x4 (&acc)[2][8], int, int m0, int n0, int w, int lane) const {
#pragma unroll
    for (int mi = 0; mi < 2; ++mi)
#pragma unroll
      for (int rg = 0; rg < 4; ++rg) { const int slot = m0 + 32 * w + 16 * mi + 4 * (lane >> 4) + rg; const int r = sorted_tok[slot];
        if (r >= 0) { float* xd = xrow(xl, xc, r); const float* gt = gate + (size_t)mrow_of(r) * 6144;
#pragma unroll
          for (int ni = 0; ni < 8; ++ni) { const int col = n0 + 16 * ni + (lane & 15); xd[col] += gt[col] * acc[mi][ni][rg]; } } }
  }
};

__device__ __forceinline__ void st_prep_qk(bf16_t* QK, const float* qn, const float* kn, const float* rope) {
  const int lane = TIDX & 63, gw = BIDX * 8 + (TIDX >> 6), ngw = GDIM * 8, hh = lane >> 3, sub = lane & 7;
  for (int r = gw; r < MTOK; r += ngw) {
    const int j = r % TPB; bf16_t* p = QK + (size_t)r * 512 + hh * 64 + sub * 8;
    const bf16x8 raw = *(const bf16x8*)p; float v[8]; float ss = 0.f;
#pragma unroll
    for (int e = 0; e < 8; ++e) { v[e] = bf2f((bf16_t)raw[e]); ss += v[e] * v[e]; }
    ss += __shfl_xor(ss, 1); ss += __shfl_xor(ss, 2); ss += __shfl_xor(ss, 4);
    const float rstd = rsqrtf(ss * (1.0f / 64.0f) + EPS); const float* gn = (hh < 6 ? qn : kn) + sub * 8;
#pragma unroll
    for (int e = 0; e < 8; ++e) v[e] = v[e] * rstd * gn[e];
    if (j >= CTXL) { const float* rp = rope + ((size_t)(j - CTXL) * 32 + (sub & 3) * 8) * 2;
#pragma unroll
      for (int e = 0; e < 8; ++e) { const float other = __shfl_xor(v[e], 4); const float cs = rp[2 * e], sn = rp[2 * e + 1]; v[e] = sub < 4 ? v[e] * cs - other * sn : v[e] * cs + other * sn; } }
    const float sc = hh < 6 ? C2 : 1.0f;
    *(u32x4*)p = (u32x4){pk2bf(v[0] * sc, v[1] * sc), pk2bf(v[2] * sc, v[3] * sc), pk2bf(v[4] * sc, v[5] * sc), pk2bf(v[6] * sc, v[7] * sc)};
  }
}

__device__ __forceinline__ void st_prep_hy(const bf16_t* HY, const float* cw, const float* cb, bf16_t* HYT, int do_ctx, char* lds) {
  const int tid = TIDX, lane = tid & 63, w = tid >> 6; float* tile = (float*)lds + w * (66 * 33);
  const int nlat = 4 * 64 * 24, nitem = nlat + (do_ctx ? 4 * 4 * 24 : 0);
  for (int it = BIDX * 8 + w; it < nitem; it += GDIM * 8) {
    int b, tt, ct, L, joff; bf16_t* outb;
    if (it < nlat) { b = it / 1536; tt = (it % 1536) / 24; ct = it % 24; L = SEQ; joff = CTXL; outb = HYT + (size_t)b * 768 * SEQ; }
    else { const int i2 = it - nlat; b = i2 / 96; tt = (i2 % 96) / 24; ct = i2 % 24; L = CTXL; joff = 0; outb = HYT + (size_t)4 * 768 * SEQ + (size_t)b * 768 * CTXL; }
    const int t0 = tt * 64, c0 = ct * 32;
#pragma unroll
    for (int i = 0; i < 5; ++i) { const int rr = (lane >> 2) + 16 * i, c8 = (lane & 3) * 8, t = t0 - 1 + rr;
      if (rr < 66) { bf16x8 v = (bf16x8){0, 0, 0, 0, 0, 0, 0, 0};
        if (t >= 0 && t < L) v = *(const bf16x8*)(HY + ((size_t)b * TPB + joff + t) * 768 + c0 + c8);
#pragma unroll
        for (int e = 0; e < 8; ++e) tile[rr * 33 + c8 + e] = bf2f((bf16_t)v[e]); } }
    asm volatile("s_waitcnt lgkmcnt(0)" ::: "memory");
#pragma unroll 4
    for (int cc = 0; cc < 32; ++cc) { const int c = c0 + cc;
      const float v = cw[c] * tile[lane * 33 + cc] + cw[768 + c] * tile[(lane + 1) * 33 + cc] + cw[1536 + c] * tile[(lane + 2) * 33 + cc] + cb[c];
      outb[(size_t)c * L + t0 + lane] = (bf16_t)f2bf(v); }
    asm volatile("s_waitcnt lgkmcnt(0)" ::: "memory");
  }
  __syncthreads();
}

template <int L> __device__ __forceinline__ void hyfilt_item(int item, const float* w1, const float* b1, const float* fr, const float* w2, const float* b2, const float* w3, float* HK, char* lds) {
  float* S0 = (float*)lds; float* S1 = S0 + 64 * 64; float* S2 = S1 + 64 * 68;
  const int tid = TIDX, n0 = (item >> 2) * 64, cq = item & 3, lane = tid & 63, wv = tid >> 6;
  for (int e = tid; e < 64 * 33; e += NT) { const int pp = e / 33, f = e % 33; const int n = n0 + pp; float v;
    if (f == 0) v = (float)n / (float)(L - 1);
    else { const int m = (f - 1) & 15; const float band = 1e-4f + (float)m * ((15.0f - 1e-4f) / 15.0f); const float wpos = (6.283185307179586f / (float)L) * (float)n;
      v = f <= 16 ? cosf(wpos * band) : -sinf(wpos * band); }
    S0[pp * 33 + f] = v; }
  for (int e = tid; e < 33 * 64; e += NT) S1[e] = w1[e];
  __syncthreads();
  for (int e = tid; e < 64 * 64; e += NT) { const int pp = e >> 6, j = e & 63; float a = b1[j];
    for (int f = 0; f < 33; ++f) a += S0[pp * 33 + f] * S1[f * 64 + j];
    S2[pp * 64 + j] = sinf(fr[j] * a); }
  __syncthreads();
  for (int e = tid; e < 64 * 64; e += NT) S0[e] = w2[e];
  __syncthreads();
  for (int e = tid; e < 64 * 64; e += NT) { const int pp = e >> 6, j = e & 63; float a = b2[j];
    for (int f = 0; f < 64; ++f) a += S2[pp * 64 + f] * S0[f * 64 + j];
    S1[pp * 68 + j] = sinf(fr[j] * a); }
  __syncthreads();
  {
    const int l15 = lane & 15, l4 = lane >> 4, colb = cq * 256 + 32 * wv;
    f32x4 acc[4][2];
#pragma unroll
    for (int pt = 0; pt < 4; ++pt) { acc[pt][0] = (f32x4){0.f, 0.f, 0.f, 0.f}; acc[pt][1] = (f32x4){0.f, 0.f, 0.f, 0.f}; }
#pragma unroll 4
    for (int kk = 0; kk < 16; ++kk) { const int k = 4 * kk + l4;
      const float bv0 = w3[k * 1024 + colb + l15], bv1 = w3[k * 1024 + colb + 16 + l15];
#pragma unroll
      for (int pt = 0; pt < 4; ++pt) { const float av = S1[(pt * 16 + l15) * 68 + k];
        acc[pt][0] = __builtin_amdgcn_mfma_f32_16x16x4f32(av, bv0, acc[pt][0], 0, 0, 0);
        acc[pt][1] = __builtin_amdgcn_mfma_f32_16x16x4f32(av, bv1, acc[pt][1], 0, 0, 0); } }
#pragma unroll
    for (int ct = 0; ct < 2; ++ct) { const int col = colb + 16 * ct + l15, dir = col >> 9, order = (col >> 8) & 1, c = col & 255;
      const float delta = 3.0701134573253943f + (float)c * ((15.350567286626972f - 3.0701134573253943f) / 255.0f);
      float* dst = HK + ((size_t)order * 256 + c) * (2 * L);
#pragma unroll
      for (int pt = 0; pt < 4; ++pt) { const int nb = n0 + pt * 16 + 4 * l4; f32x4 o;
#pragma unroll
        for (int rg = 0; rg < 4; ++rg) o[rg] = acc[pt][ct][rg] * __expf(-((float)(nb + rg) / (float)(L - 1)) * delta);
        if (dir == 0) *(f32x4*)(dst + nb) = o;
        else {
#pragma unroll
          for (int rg = 0; rg < 4; ++rg) { const int n = nb + rg; if (n >= 1) dst[2 * L - n] = o[rg]; else dst[L] = 0.f; } } } }
  }
  __syncthreads();
}

template <int L> __device__ __forceinline__ void hyconv_item(int item, const bf16_t* HYT, const float* HK, const float* hy_bias, bf16_t* MIX, int joff, char* lds) {
  float* kern = (float*)lds; float* z = kern + 2 * L;
  const int tid = TIDX, b = item >> 8, c = item & 255;
  const bf16_t* vp = HYT + ((size_t)b * 768 + c) * L; const bf16_t* x1p = vp + (size_t)256 * L; const bf16_t* x2p = vp + (size_t)512 * L;
  const bool act = tid < L / 8; const int tb = 8 * tid;
  for (int o = 0; o < 2; ++o) {
    if (o == 0) for (int t = tid; t < L; t += NT) z[t] = bf2f(vp[t]);
    const float* kp = HK + ((size_t)o * 256 + c) * (2 * L);
    for (int t = tid; t < 2 * L; t += NT) kern[t] = kp[t];
    __syncthreads();
    float acc[8], W[16];
#pragma unroll
    for (int i = 0; i < 8; ++i) acc[i] = 0.f;
    if (act) {
#pragma unroll
      for (int i = 0; i < 8; ++i) W[8 + i] = kern[(tb + i) & (2 * L - 1)];
      for (int s0 = 0; s0 < L; s0 += 8) {
        const int bb = (tb - s0 - 8) & (2 * L - 1);
#pragma unroll
        for (int i = 0; i < 8; ++i) W[i] = kern[bb + i];
        float zs[8];
#pragma unroll
        for (int j = 0; j < 8; ++j) zs[j] = z[s0 + j];
#pragma unroll
        for (int j = 0; j < 8; ++j)
#pragma unroll
          for (int i = 0; i < 8; ++i) acc[i] += W[8 + i - j] * zs[j];
#pragma unroll
        for (int i = 0; i < 8; ++i) W[8 + i] = W[i];
      }
    }
    __syncthreads();
    const float bias = hy_bias[o * 256 + c];
    if (act) {
#pragma unroll
      for (int i = 0; i < 8; ++i) { const int t = tb + i; const float zz = acc[i] + bias * z[t];
        if (o == 0) z[t] = bf2f(x1p[t]) * zz;
        else MIX[((size_t)b * TPB + joff + t) * DM + 768 + c] = (bf16_t)f2bf(bf2f(x2p[t]) * zz); }
    }
    __syncthreads();
  }
}

__device__ __forceinline__ void hyconv_ctx_item(int item, const bf16_t* HYTC, const float* HKC, const float* hy_bias, bf16_t* MIX, char* lds) {
  constexpr int L = CTXL;
  const int tid = TIDX, b = item >> 4, cc = tid >> 5, c = (item & 15) * 16 + cc, sub = tid & 31, tb = 8 * sub;
  float* kern = (float*)lds + cc * (2 * L); float* z = (float*)lds + 16 * 2 * L + cc * L;
  const bf16_t* vp = HYTC + ((size_t)b * 768 + c) * L; const bf16_t* x1p = vp + (size_t)256 * L; const bf16_t* x2p = vp + (size_t)512 * L;
#pragma unroll 1
  for (int o = 0; o < 2; ++o) {
    if (o == 0) for (int t = sub; t < L; t += 32) z[t] = bf2f(vp[t]);
    const float* kp = HKC + ((size_t)o * 256 + c) * (2 * L);
    for (int t = sub; t < 2 * L; t += 32) kern[t] = kp[t];
    __syncthreads();
    float acc[8], W[16];
#pragma unroll
    for (int i = 0; i < 8; ++i) { acc[i] = 0.f; W[8 + i] = kern[(tb + i) & (2 * L - 1)]; }
    for (int s0 = 0; s0 < L; s0 += 8) {
      const int bb = (tb - s0 - 8) & (2 * L - 1);
#pragma unroll
      for (int i = 0; i < 8; ++i) W[i] = kern[bb + i];
      float zs[8];
#pragma unroll
      for (int j = 0; j < 8; ++j) zs[j] = z[s0 + j];
#pragma unroll
      for (int j = 0; j < 8; ++j)
#pragma unroll
        for (int i = 0; i < 8; ++i) acc[i] += W[8 + i - j] * zs[j];
#pragma unroll
      for (int i = 0; i < 8; ++i) W[8 + i] = W[i];
    }
    __syncthreads();
    const float bias = hy_bias[o * 256 + c];
#pragma unroll
    for (int i = 0; i < 8; ++i) { const int t = tb + i; const float zz = acc[i] + bias * z[t];
      if (o == 0) z[t] = bf2f(x1p[t]) * zz;
      else MIX[((size_t)b * TPB + t) * DM + 768 + c] = (bf16_t)f2bf(bf2f(x2p[t]) * zz); }
    __syncthreads();
  }
}

__device__ __forceinline__ void attn_unit_simple(int u, const bf16_t* QK, const bf16_t* VZ, bf16_t* MIX, char* lds) {
  bf16_t (*Ks)[72] = (bf16_t (*)[72])lds;
  bf16_t (*Vt)[72] = (bf16_t (*)[72])(lds + 64 * 72 * 2);
  bf16_t (*Ps)[16][72] = (bf16_t (*)[16][72])(lds + 2 * 64 * 72 * 2);
  const int tid = TIDX, lane = tid & 63, w = tid >> 6;
  int b, h, qrow0, nk;
  if (u < 768) { b = u / 192; const int rem = u % 192; h = rem >> 5; qrow0 = b * TPB + CTXL + (rem & 31) * 128; nk = TPB; }
  else { const int uc = u - 768; b = uc / 12; h = (uc % 12) >> 1; qrow0 = b * TPB + (uc & 1) * 128; nk = CTXL; }
  const int kvh = h / 3, key0 = b * TPB, l15 = lane & 15, l4 = lane >> 4;
  bf16x8 aq[2];
#pragma unroll
  for (int kk = 0; kk < 2; ++kk) aq[kk] = *(const bf16x8*)(QK + (size_t)(qrow0 + 16 * w + l15) * 512 + h * 64 + kk * 32 + 8 * l4);
  f32x4 O[4]; float m[4], l[4];
#pragma unroll
  for (int i = 0; i < 4; ++i) { O[i] = (f32x4){0.f, 0.f, 0.f, 0.f}; m[i] = -1e30f; l[i] = 0.f; }
  for (int kt = 0; kt < nk / 64; ++kt) {
    __syncthreads();
    { const int r = tid >> 3, c8 = (tid & 7) * 8; const size_t grow = (size_t)(key0 + kt * 64 + r) * 512;
      *(u32x4*)&Ks[r][c8] = *(const u32x4*)(QK + grow + 384 + kvh * 64 + c8);
      const bf16x8 vv = *(const bf16x8*)(VZ + grow + kvh * 64 + c8);
#pragma unroll
      for (int e = 0; e < 8; ++e) Vt[c8 + e][r] = (bf16_t)vv[e]; }
    __syncthreads();
    f32x4 s[4];
#pragma unroll
    for (int ni = 0; ni < 4; ++ni) s[ni] = (f32x4){0.f, 0.f, 0.f, 0.f};
#pragma unroll
    for (int kk = 0; kk < 2; ++kk)
#pragma unroll
      for (int ni = 0; ni < 4; ++ni) { const bf16x8 bk = *(const bf16x8*)&Ks[16 * ni + l15][32 * kk + 8 * l4]; s[ni] = __builtin_amdgcn_mfma_f32_16x16x32_bf16(aq[kk], bk, s[ni], 0, 0, 0); }
#pragma unroll
    for (int rg = 0; rg < 4; ++rg) {
      float mx = fmaxf(fmaxf(s[0][rg], s[1][rg]), fmaxf(s[2][rg], s[3][rg]));
      mx = fmaxf(mx, __shfl_xor(mx, 1)); mx = fmaxf(mx, __shfl_xor(mx, 2)); mx = fmaxf(mx, __shfl_xor(mx, 4)); mx = fmaxf(mx, __shfl_xor(mx, 8));
      const float mn = fmaxf(m[rg], mx), alpha = exp2f(m[rg] - mn); float rs = 0.f;
#pragma unroll
      for (int ni = 0; ni < 4; ++ni) { const float pv = exp2f(s[ni][rg] - mn); rs += pv; Ps[w][4 * l4 + rg][16 * ni + l15] = (bf16_t)f2bf(pv); }
      rs += __shfl_xor(rs, 1); rs += __shfl_xor(rs, 2); rs += __shfl_xor(rs, 4); rs += __shfl_xor(rs, 8);
      l[rg] = l[rg] * alpha + rs; m[rg] = mn;
#pragma unroll
      for (int ni = 0; ni < 4; ++ni) O[ni][rg] *= alpha;
    }
    __syncthreads();
#pragma unroll
    for (int kk = 0; kk < 2; ++kk) { const bf16x8 ap = *(const bf16x8*)&Ps[w][l15][32 * kk + 8 * l4];
#pragma unroll
      for (int ni = 0; ni < 4; ++ni) { const bf16x8 bv = *(const bf16x8*)&Vt[16 * ni + l15][32 * kk + 8 * l4]; O[ni] = __builtin_amdgcn_mfma_f32_16x16x32_bf16(ap, bv, O[ni], 0, 0, 0); } }
  }
#pragma unroll
  for (int rg = 0; rg < 4; ++rg) { const float il = 1.0f / l[rg]; const size_t row = (size_t)(qrow0 + 16 * w + 4 * l4 + rg);
#pragma unroll
    for (int ni = 0; ni < 4; ++ni) MIX[row * DM + h * 64 + 16 * ni + l15] = (bf16_t)f2bf(O[ni][rg] * il); }
  __syncthreads();
}

__device__ __forceinline__ void st_ssd_prep(const bf16_t* XBC, float* DT, const float* cw, const float* cb, const float* dt_bias, bf16_t* XBCC) {
  const size_t total = (size_t)MTOK * 640;
  for (size_t i = (size_t)BIDX * NT + TIDX; i < total; i += (size_t)GDIM * NT) {
    const int r = (int)(i / 640), ch = (int)(i % 640), j = r % TPB;
    const bool hasp = (j != 0 && j != CTXL), hasn = (j != CTXL - 1 && j != TPB - 1);
    float v = cw[640 + ch] * bf2f(XBC[(size_t)r * 768 + ch]) + cb[ch];
    if (hasp) v += cw[ch] * bf2f(XBC[(size_t)(r - 1) * 768 + ch]);
    if (hasn) v += cw[1280 + ch] * bf2f(XBC[(size_t)(r + 1) * 768 + ch]);
    XBCC[i] = (bf16_t)f2bf(siluf(v));
  }
  for (size_t i = (size_t)BIDX * NT + TIDX; i < (size_t)MTOK * 12; i += (size_t)GDIM * NT) {
    const float x = DT[i] + dt_bias[i % 12];
    DT[i] = x > 20.f ? x : log1pf(expf(x));
  }
}
__device__ __forceinline__ void ssd_scan_item(int item, const bf16_t* XBCC, const float* DT, const float* a_log, float* Y, char* lds) {
  const int half = TIDX >> 8, tid = TIDX & 255;
  float* base = (float*)(lds + half * 25088);
  float (*xs)[64] = (float (*)[64])base; float (*Bs)[64] = (float (*)[64])(base + 2048); float (*Cs)[64] = (float (*)[64])(base + 4096);
  float* dAs = base + 6144; float* dts = base + 6176;
  const int bh = 2 * item + half, b = bh / 6, h = bh % 6, g = h / 3, p = tid >> 2, q = tid & 3;
  for (int dir = 0; dir < 2; ++dir) {
    const float a = -expf(a_log[dir * 6 + h]);
    float st[16];
#pragma unroll
    for (int n = 0; n < 16; ++n) st[n] = 0.f;
    for (int ci = 0; ci < TPB / 32; ++ci) {
      for (int e = tid; e < 32 * 64; e += 256) { const int i = e >> 6, cc = e & 63, qi = ci * 32 + i;
        const int j = dir == 0 ? qi : (qi < CTXL ? CTXL - 1 - qi : TPB - 1 - (qi - CTXL)); const size_t r = (size_t)b * TPB + j;
        xs[i][cc] = bf2f(XBCC[r * 640 + h * 64 + cc]); Bs[i][cc] = bf2f(XBCC[r * 640 + 384 + g * 64 + cc]); Cs[i][cc] = bf2f(XBCC[r * 640 + 512 + g * 64 + cc]); }
      if (tid < 32) { const int qi = ci * 32 + tid; const int j = dir == 0 ? qi : (qi < CTXL ? CTXL - 1 - qi : TPB - 1 - (qi - CTXL)); const size_t r = (size_t)b * TPB + j;
        const float dt = DT[r * 12 + dir * 6 + h]; dts[tid] = dt; dAs[tid] = expf(dt * a); }
      __syncthreads();
      for (int i = 0; i < 32; ++i) {
        const float d = dAs[i], dtx = dts[i] * xs[i][p]; float y = 0.f;
#pragma unroll
        for (int n = 0; n < 16; ++n) { st[n] = st[n] * d + dtx * Bs[i][16 * q + n]; y += Cs[i][16 * q + n] * st[n]; }
        y += __shfl_xor(y, 1); y += __shfl_xor(y, 2);
        if (q == 0) { const int qi = ci * 32 + i; const int j = dir == 0 ? qi : (qi < CTXL ? CTXL - 1 - qi : TPB - 1 - (qi - CTXL)); float* yp = Y + ((size_t)b * TPB + j) * 384 + h * 64 + p;
          if (dir == 0) *yp = y; else *yp += y; }
      }
      __syncthreads();
    }
  }
}
__device__ __forceinline__ void st_ssd_out(const float* Y, const bf16_t* XBCC, const bf16_t* VZ, const float* dskip, const float* nw, bf16_t* MIX) {
  const int lane = TIDX & 63, gw = BIDX * 8 + (TIDX >> 6), ngw = GDIM * 8;
  for (int it = gw; it < MTOK * 2; it += ngw) {
    const int r = it >> 1, g = it & 1; float gv[3]; float ss = 0.f;
#pragma unroll
    for (int i = 0; i < 3; ++i) { const int c = g * 192 + lane + 64 * i, hh = c >> 6;
      const float y = Y[(size_t)r * 384 + c] + bf2f(XBCC[(size_t)r * 640 + c]) * dskip[hh]; const float zv = bf2f(VZ[(size_t)r * 512 + 128 + c]);
      gv[i] = y * siluf(zv); ss += gv[i] * gv[i]; }
    const float rstd = rsqrtf(wave_sum(ss) * (1.0f / 192.0f) + EPS);
#pragma unroll
    for (int i = 0; i < 3; ++i) { const int c = g * 192 + lane + 64 * i; MIX[(size_t)r * DM + 384 + c] = (bf16_t)f2bf(gv[i] * rstd * nw[c]); }
  }
}


__device__ __forceinline__ void ssd_conv8(const bf16_t* XBC, size_t r, int c0, bool hasp, bool hasn, const float* cw, const float* cb, float (&o)[8]) {
  const bf16x8 cur = *(const bf16x8*)(XBC + r * 768 + c0);
  bf16x8 prv = (bf16x8){0, 0, 0, 0, 0, 0, 0, 0}, nxt = (bf16x8){0, 0, 0, 0, 0, 0, 0, 0};
  if (hasp) prv = *(const bf16x8*)(XBC + (r - 1) * 768 + c0);
  if (hasn) nxt = *(const bf16x8*)(XBC + (r + 1) * 768 + c0);
#pragma unroll
  for (int e = 0; e < 8; ++e) { const float v = cw[c0 + e] * bf2f((bf16_t)prv[e]) + cw[640 + c0 + e] * bf2f((bf16_t)cur[e]) + cw[1280 + c0 + e] * bf2f((bf16_t)nxt[e]) + cb[c0 + e]; o[e] = siluf(v); }
}
__device__ __forceinline__ float softplusf(float x) { return x > 20.f ? x : log1pf(expf(x)); }
__device__ __forceinline__ void wave_scan128(float e0, float e1, int lane, float& c0, float& c1) {
  float x = e0 + e1;
#pragma unroll
  for (int o = 1; o < 64; o <<= 1) { const float v = __shfl_up(x, o); if (lane >= o) x += v; }
  const float excl = x - (e0 + e1); c0 = excl + e0; c1 = excl + e0 + e1;
}
__device__ __forceinline__ int ssd_chunk_j0(int cidx) { return cidx < 2 ? cidx * 128 : CTXL + (cidx - 2) * 128; }

__device__ __forceinline__ void ssd1_item(int item, const bf16_t* XBC, const float* DT, const float* cw, const float* cb, const float* dt_bias, const float* a_log,
                                          float* YIN, float* ST, float* DEC, char* lds) {
  bf16_t (*Cm)[72] = (bf16_t (*)[72])lds; bf16_t (*Bm)[72] = (bf16_t (*)[72])(lds + 18432);
  bf16_t (*BT)[136] = (bf16_t (*)[136])(lds + 36864); bf16_t (*Xt)[136] = (bf16_t (*)[136])(lds + 54272); bf16_t (*Mm)[136] = (bf16_t (*)[136])(lds + 71680);
  float* tab = (float*)(lds + 106496); float* dtf = tab; float* dtb = tab + 128; float* acf = tab + 256; float* acb = tab + 384; float* wf = tab + 512; float* wb = tab + 640;
  const int tid = TIDX, lane = tid & 63, w = tid >> 6, l15 = lane & 15, l4 = lane >> 4;
  const int h = item % 6, bc = item / 6, cidx = bc % 34, b = bc / 34, g = h / 3, j0 = ssd_chunk_j0(cidx);
  const size_t r0 = (size_t)b * TPB + j0;
#pragma unroll 2
  for (int i = 0; i < 6; ++i) { const int task = tid + NT * i, t = task / 24, cg = task % 24, kind = cg >> 3, q = cg & 7, j = j0 + t;
    const int c0 = kind == 0 ? h * 64 + 8 * q : (kind == 1 ? 384 + g * 64 + 8 * q : 512 + g * 64 + 8 * q);
    float o[8]; ssd_conv8(XBC, r0 + t, c0, j != 0 && j != CTXL, j != CTXL - 1 && j != TPB - 1, cw, cb, o);
    if (kind == 0) {
#pragma unroll
      for (int e = 0; e < 8; ++e) Xt[8 * q + e][t] = (bf16_t)f2bf(o[e]);
    } else { const u32x4 pk = (u32x4){pk2bf(o[0], o[1]), pk2bf(o[2], o[3]), pk2bf(o[4], o[5]), pk2bf(o[6], o[7])};
      if (kind == 1) { *(u32x4*)&Bm[t][8 * q] = pk;
#pragma unroll
        for (int e = 0; e < 8; ++e) BT[8 * q + e][t] = (bf16_t)f2bf(o[e]); }
      else *(u32x4*)&Cm[t][8 * q] = pk; } }
  if (w < 2) { const int dir = w; const float a = -expf(a_log[dir * 6 + h]), bias = dt_bias[dir * 6 + h];
    const int t0 = dir == 0 ? 2 * lane : 127 - 2 * lane, t1 = dir == 0 ? 2 * lane + 1 : 126 - 2 * lane;
    const float d0 = softplusf(DT[(r0 + t0) * 12 + dir * 6 + h] + bias), d1 = softplusf(DT[(r0 + t1) * 12 + dir * 6 + h] + bias);
    float c0, c1; wave_scan128(d0 * a, d1 * a, lane, c0, c1);
    const float tot = __shfl(c1, 63);
    float* dtt = dir == 0 ? dtf : dtb; float* ac = dir == 0 ? acf : acb; float* ww = dir == 0 ? wf : wb;
    dtt[t0] = d0; dtt[t1] = d1; ac[t0] = c0; ac[t1] = c1; ww[t0] = __expf(tot - c0) * d0; ww[t1] = __expf(tot - c1) * d1;
    if (lane == 0) DEC[(((size_t)b * 34 + cidx) * 2 + dir) * 6 + h] = __expf(tot); }
  __syncthreads();
  {
    f32x4 accG[8];
#pragma unroll
    for (int ni = 0; ni < 8; ++ni) accG[ni] = (f32x4){0.f, 0.f, 0.f, 0.f};
#pragma unroll
    for (int kk = 0; kk < 2; ++kk) { const bf16x8 a = *(const bf16x8*)&Cm[16 * w + l15][32 * kk + 8 * l4];
#pragma unroll
      for (int ni = 0; ni < 8; ++ni) { const bf16x8 bb = *(const bf16x8*)&Bm[16 * ni + l15][32 * kk + 8 * l4]; accG[ni] = __builtin_amdgcn_mfma_f32_16x16x32_bf16(a, bb, accG[ni], 0, 0, 0); } }
    float aft[4], abt[4];
#pragma unroll
    for (int rg = 0; rg < 4; ++rg) { aft[rg] = acf[16 * w + 4 * l4 + rg]; abt[rg] = acb[16 * w + 4 * l4 + rg]; }
#pragma unroll
    for (int ni = 0; ni < 8; ++ni) { const int sidx = 16 * ni + l15; const float afs = acf[sidx], abs_ = acb[sidx], dfs = dtf[sidx], dbs = dtb[sidx];
#pragma unroll
      for (int rg = 0; rg < 4; ++rg) { const int t = 16 * w + 4 * l4 + rg;
        const float f = sidx <= t ? __expf(aft[rg] - afs) * dfs : 0.f, bk = sidx >= t ? __expf(abt[rg] - abs_) * dbs : 0.f;
        Mm[t][sidx] = (bf16_t)f2bf(accG[ni][rg] * (f + bk)); } }
  }
  __syncthreads();
  {
    f32x4 acc[4];
#pragma unroll
    for (int ni = 0; ni < 4; ++ni) acc[ni] = (f32x4){0.f, 0.f, 0.f, 0.f};
#pragma unroll
    for (int kk = 0; kk < 4; ++kk) { const bf16x8 a = *(const bf16x8*)&Mm[16 * w + l15][32 * kk + 8 * l4];
#pragma unroll
      for (int ni = 0; ni < 4; ++ni) { const bf16x8 bb = *(const bf16x8*)&Xt[16 * ni + l15][32 * kk + 8 * l4]; acc[ni] = __builtin_amdgcn_mfma_f32_16x16x32_bf16(a, bb, acc[ni], 0, 0, 0); } }
#pragma unroll
    for (int rg = 0; rg < 4; ++rg)
#pragma unroll
      for (int ni = 0; ni < 4; ++ni) YIN[(r0 + 16 * w + 4 * l4 + rg) * 384 + h * 64 + 16 * ni + l15] = acc[ni][rg];
  }
  {
    const int dir = w >> 2, mt = w & 3; const float* ww = dir == 0 ? wf : wb;
    f32x4 acc[4];
#pragma unroll
    for (int ni = 0; ni < 4; ++ni) acc[ni] = (f32x4){0.f, 0.f, 0.f, 0.f};
#pragma unroll
    for (int kk = 0; kk < 4; ++kk) { const bf16x8 raw = *(const bf16x8*)&Xt[16 * mt + l15][32 * kk + 8 * l4];
      const f32x4 w0 = *(const f32x4*)(ww + 32 * kk + 8 * l4), w1 = *(const f32x4*)(ww + 32 * kk + 8 * l4 + 4);
      u32x4 pk; pk.x = pk2bf(bf2f((bf16_t)raw[0]) * w0.x, bf2f((bf16_t)raw[1]) * w0.y); pk.y = pk2bf(bf2f((bf16_t)raw[2]) * w0.z, bf2f((bf16_t)raw[3]) * w0.w);
      pk.z = pk2bf(bf2f((bf16_t)raw[4]) * w1.x, bf2f((bf16_t)raw[5]) * w1.y); pk.w = pk2bf(bf2f((bf16_t)raw[6]) * w1.z, bf2f((bf16_t)raw[7]) * w1.w);
      const bf16x8 a = __builtin_bit_cast(bf16x8, pk);
#pragma unroll
      for (int ni = 0; ni < 4; ++ni) { const bf16x8 bb = *(const bf16x8*)&BT[16 * ni + l15][32 * kk + 8 * l4]; acc[ni] = __builtin_amdgcn_mfma_f32_16x16x32_bf16(a, bb, acc[ni], 0, 0, 0); } }
    float* sp = ST + ((((size_t)b * 34 + cidx) * 2 + dir) * 6 + h) * 4096;
#pragma unroll
    for (int rg = 0; rg < 4; ++rg)
#pragma unroll
      for (int ni = 0; ni < 4; ++ni) sp[(16 * mt + 4 * l4 + rg) * 64 + 16 * ni + l15] = acc[ni][rg];
  }
  __syncthreads();
}

__device__ __forceinline__ void st_ssd_scan2(float* ST, const float* DEC) {
  for (int idx = BIDX * NT + TIDX; idx < 4 * 2 * 6 * 4096; idx += GDIM * NT) {
    const int e = idx & 4095, bdh = idx >> 12, h = bdh % 6, dir = (bdh / 6) & 1, b = bdh / 12;
    float v[34], d[34];
#pragma unroll
    for (int st = 0; st < 34; ++st) { const int cidx = dir == 0 ? st : (st < 2 ? 1 - st : 35 - st); const size_t o = (((size_t)b * 34 + cidx) * 2 + dir) * 6 + h; v[st] = ST[o * 4096 + e]; d[st] = DEC[o]; }
    float H = 0.f;
#pragma unroll
    for (int st = 0; st < 34; ++st) { const int cidx = dir == 0 ? st : (st < 2 ? 1 - st : 35 - st); const size_t o = (((size_t)b * 34 + cidx) * 2 + dir) * 6 + h; ST[o * 4096 + e] = H; H = H * d[st] + v[st]; }
  }
}

__device__ __forceinline__ void ssd3_item(int b, int cidx, int g, const bf16_t* XBC, const bf16_t* VZ, const float* DT, const float* cw, const float* cb, const float* dt_bias, const float* a_log,
                                          const float* dskip, const float* nw, const float* YIN, const float* ST, bf16_t* MIX, char* lds) {
  bf16_t (*Cm)[72] = (bf16_t (*)[72])lds; bf16_t (*Hm)[72] = (bf16_t (*)[72])(lds + 18432);
  float* ef = (float*)(lds + 18432 + 55296);
  float (*Yt)[196] = (float (*)[196])lds;
  const int tid = TIDX, lane = tid & 63, w = tid >> 6, l15 = lane & 15, l4 = lane >> 4, j0 = ssd_chunk_j0(cidx);
  const size_t r0 = (size_t)b * TPB + j0;
#pragma unroll
  for (int i = 0; i < 2; ++i) { const int task = tid + NT * i, t = task >> 3, q = task & 7, j = j0 + t;
    float o[8]; ssd_conv8(XBC, r0 + t, 512 + g * 64 + 8 * q, j != 0 && j != CTXL, j != CTXL - 1 && j != TPB - 1, cw, cb, o);
    *(u32x4*)&Cm[t][8 * q] = (u32x4){pk2bf(o[0], o[1]), pk2bf(o[2], o[3]), pk2bf(o[4], o[5]), pk2bf(o[6], o[7])}; }
#pragma unroll
  for (int i = 0; i < 12; ++i) { const int f4 = tid + NT * i, hd = f4 >> 10, rem = f4 & 1023, p = rem >> 4, n4 = (rem & 15) * 4, hh = hd >> 1, dir = hd & 1;
    const f32x4 v = *(const f32x4*)(ST + ((((size_t)b * 34 + cidx) * 2 + dir) * 6 + 3 * g + hh) * 4096 + p * 64 + n4);
    *(u32x2*)&Hm[hd * 64 + p][n4] = (u32x2){pk2bf(v.x, v.y), pk2bf(v.z, v.w)}; }
  if (w < 6) { const int hh = w >> 1, dir = w & 1, h = 3 * g + hh; const float a = -expf(a_log[dir * 6 + h]), bias = dt_bias[dir * 6 + h];
    const int t0 = dir == 0 ? 2 * lane : 127 - 2 * lane, t1 = dir == 0 ? 2 * lane + 1 : 126 - 2 * lane;
    const float d0 = softplusf(DT[(r0 + t0) * 12 + dir * 6 + h] + bias), d1 = softplusf(DT[(r0 + t1) * 12 + dir * 6 + h] + bias);
    float c0, c1; wave_scan128(d0 * a, d1 * a, lane, c0, c1);
    ef[w * 128 + t0] = __expf(c0); ef[w * 128 + t1] = __expf(c1); }
  __syncthreads();
  float yv[3][4][4];
  {
    bf16x8 ca[2];
#pragma unroll
    for (int kk = 0; kk < 2; ++kk) ca[kk] = *(const bf16x8*)&Cm[16 * w + l15][32 * kk + 8 * l4];
#pragma unroll
    for (int hh = 0; hh < 3; ++hh) {
      f32x4 accF[4], accB[4];
#pragma unroll
      for (int ni = 0; ni < 4; ++ni) { accF[ni] = (f32x4){0.f, 0.f, 0.f, 0.f}; accB[ni] = (f32x4){0.f, 0.f, 0.f, 0.f}; }
#pragma unroll
      for (int kk = 0; kk < 2; ++kk)
#pragma unroll
        for (int ni = 0; ni < 4; ++ni) {
          accF[ni] = __builtin_amdgcn_mfma_f32_16x16x32_bf16(ca[kk], *(const bf16x8*)&Hm[(hh * 2 + 0) * 64 + 16 * ni + l15][32 * kk + 8 * l4], accF[ni], 0, 0, 0);
          accB[ni] = __builtin_amdgcn_mfma_f32_16x16x32_bf16(ca[kk], *(const bf16x8*)&Hm[(hh * 2 + 1) * 64 + 16 * ni + l15][32 * kk + 8 * l4], accB[ni], 0, 0, 0); }
#pragma unroll
      for (int rg = 0; rg < 4; ++rg) { const int t = 16 * w + 4 * l4 + rg; const float eF = ef[(hh * 2 + 0) * 128 + t], eB = ef[(hh * 2 + 1) * 128 + t];
#pragma unroll
        for (int ni = 0; ni < 4; ++ni) yv[hh][ni][rg] = eF * accF[ni][rg] + eB * accB[ni][rg]; }
    }
  }
  __syncthreads();
#pragma unroll
  for (int hh = 0; hh < 3; ++hh)
#pragma unroll
    for (int rg = 0; rg < 4; ++rg)
#pragma unroll
      for (int ni = 0; ni < 4; ++ni) Yt[16 * w + 4 * l4 + rg][hh * 64 + 16 * ni + l15] = yv[hh][ni][rg];
  __syncthreads();
  float cw0[3], cw1[3], cw2[3], cbv[3], nwv[3], dsk[3];
#pragma unroll
  for (int k = 0; k < 3; ++k) { const int col = g * 192 + 64 * k + lane; cw0[k] = cw[col]; cw1[k] = cw[640 + col]; cw2[k] = cw[1280 + col]; cbv[k] = cb[col]; nwv[k] = nw[col]; dsk[k] = dskip[3 * g + k]; }
#pragma unroll 2
  for (int rr = 0; rr < 16; ++rr) { const int t = 16 * w + rr, j = j0 + t; const size_t r = r0 + t; const bool hasp = j != 0 && j != CTXL, hasn = j != CTXL - 1 && j != TPB - 1;
    const bf16_t* xp = XBC + r * 768 + g * 192 + lane; const float* yp = YIN + r * 384 + g * 192 + lane; const bf16_t* zp = VZ + r * 512 + 128 + g * 192 + lane;
    float gt[3]; float ss = 0.f;
#pragma unroll
    for (int k = 0; k < 3; ++k) { float xv = cw1[k] * bf2f(xp[64 * k]) + cbv[k];
      if (hasp) xv += cw0[k] * bf2f(xp[64 * k - 768]);
      if (hasn) xv += cw2[k] * bf2f(xp[64 * k + 768]);
      xv = siluf(xv);
      const float y = yp[64 * k] + Yt[t][64 * k + lane] + dsk[k] * xv;
      gt[k] = y * siluf(bf2f(zp[64 * k])); ss += gt[k] * gt[k]; }
    const float rstd = rsqrtf(wave_sum(ss) * (1.0f / 192.0f) + EPS);
    bf16_t* op = MIX + r * DM + 384 + g * 192 + lane;
#pragma unroll
    for (int k = 0; k < 3; ++k) op[64 * k] = (bf16_t)f2bf(gt[k] * rstd * nwv[k]); }
  __syncthreads();
}

__device__ __forceinline__ void st_router(const float* xl, const float* xc, const float* g, const float* modv_layer, const float* w_router, const float* rbias,
                                          bf16_t* H2, int* ctl, int* tok_pair, float* tok_w, int skip_ctx, char* lds) {
  float* wl = (float*)lds;
  const int tid = TIDX, lane = tid & 63, gw = BIDX * 8 + (tid >> 6), ngw = GDIM * 8;
  int* hist = (int*)(lds + 81920);
  if (tid < 32) hist[tid] = 0;
  float* mA = (float*)(lds + 82176); float* mB = mA + 5 * 1024;
  for (int idx = tid; idx < 5 * 1024; idx += NT) { const int m = idx >> 10, k = idx & 1023; mA[idx] = g[k] * (1.f + modv_layer[(size_t)m * 6144 + 4096 + k]); mB[idx] = modv_layer[(size_t)m * 6144 + 3072 + k]; }
  for (int idx = tid; idx < 4096; idx += NT) { const int k = idx >> 2, e4 = idx & 3, row = ((k & 3) * 4 + (k >> 8)) * 64 + ((k & 255) >> 2);
    *(f32x4*)(wl + row * 20 + 4 * e4) = *(const f32x4*)(w_router + (size_t)k * 16 + 4 * e4); }
  __syncthreads();
  f32x4 vn[4];
  if (gw < MTOK) { const float* xr = xrow(xl, xc, gw);
#pragma unroll
    for (int j = 0; j < 4; ++j) vn[j] = *(const f32x4*)(xr + 4 * lane + 256 * j); }
  for (int r = gw; r < MTOK; r += ngw) {
    f32x4 v[4]; float ss = 0.f;
#pragma unroll
    for (int j = 0; j < 4; ++j) v[j] = vn[j];
    if (r + ngw < MTOK) { const float* xr = xrow(xl, xc, r + ngw);
#pragma unroll
      for (int j = 0; j < 4; ++j) vn[j] = *(const f32x4*)(xr + 4 * lane + 256 * j); }
    if (skip_ctx && (r % TPB) < CTXL) continue;
    const int mo = mrow_of(r) * 1024;
#pragma unroll
    for (int j = 0; j < 4; ++j) ss += v[j].x * v[j].x + v[j].y * v[j].y + v[j].z * v[j].z + v[j].w * v[j].w;
    const float rstd = rsqrtf(wave_sum(ss) * (1.0f / DM) + EPS);
    float lg[16];
#pragma unroll
    for (int e = 0; e < 16; ++e) lg[e] = 0.f;
#pragma unroll
    for (int j = 0; j < 4; ++j) { const int k = 4 * lane + 256 * j;
      const f32x4 a4 = *(const f32x4*)(mA + mo + k), b4 = *(const f32x4*)(mB + mo + k); const f32x4 o4 = v[j] * rstd * a4 + b4;
      float o[4]; o[0] = o4.x; o[1] = o4.y; o[2] = o4.z; o[3] = o4.w;
      u32x2 wpk; wpk.x = pk2bf(o[0], o[1]); wpk.y = pk2bf(o[2], o[3]);
      *(u32x2*)(H2 + (size_t)r * DM + k) = wpk;
#pragma unroll
      for (int q = 0; q < 4; ++q) { const float* wr_ = wl + ((q * 4 + j) * 64 + lane) * 20;
#pragma unroll
        for (int e4 = 0; e4 < 4; ++e4) { const f32x4 wr = *(const f32x4*)(wr_ + 4 * e4);
          lg[4 * e4] += o[q] * wr.x; lg[4 * e4 + 1] += o[q] * wr.y; lg[4 * e4 + 2] += o[q] * wr.z; lg[4 * e4 + 3] += o[q] * wr.w; } } }
    float h8[8], h4[4], h2[2], h1;
#pragma unroll
    for (int i = 0; i < 8; ++i) { const bool up = (lane & 32) != 0; const float keep = up ? lg[8 + i] : lg[i], give = up ? lg[i] : lg[8 + i]; h8[i] = keep + __shfl_xor(give, 32); }
#pragma unroll
    for (int i = 0; i < 4; ++i) { const bool up = (lane & 16) != 0; const float keep = up ? h8[4 + i] : h8[i], give = up ? h8[i] : h8[4 + i]; h4[i] = keep + __shfl_xor(give, 16); }
#pragma unroll
    for (int i = 0; i < 2; ++i) { const bool up = (lane & 8) != 0; const float keep = up ? h4[2 + i] : h4[i], give = up ? h4[i] : h4[2 + i]; h2[i] = keep + __shfl_xor(give, 8); }
    { const bool up = (lane & 4) != 0; const float keep = up ? h2[1] : h2[0], give = up ? h2[0] : h2[1]; h1 = keep + __shfl_xor(give, 4); }
    h1 += __shfl_xor(h1, 2); h1 += __shfl_xor(h1, 1);
#pragma unroll
    for (int e = 0; e < 16; ++e) lg[e] = __uint_as_float(__builtin_amdgcn_readlane(__float_as_uint(h1), ((e >> 3) & 1) * 32 + ((e >> 2) & 1) * 16 + ((e >> 1) & 1) * 8 + (e & 1) * 4));
    if (lane == 0) {
      int best = 0, bi1 = 0, bi2 = 1; float bestv = -1e30f, bs1 = 0.f, bs2 = 0.f;
#pragma unroll
      for (int gq = 0; gq < 4; ++gq) { float m1 = -1e30f, m2 = -1e30f, s1 = 0.f, s2 = 0.f; int i1 = 0, i2 = 0;
#pragma unroll
        for (int i = 0; i < 4; ++i) { const float scv = 1.0f / (1.0f + __expf(-lg[4 * gq + i])); const float sv = scv + rbias[4 * gq + i];
          if (sv > m1) { m2 = m1; s2 = s1; i2 = i1; m1 = sv; s1 = scv; i1 = i; } else if (sv > m2) { m2 = sv; s2 = scv; i2 = i; } }
        if (m1 + m2 > bestv) { bestv = m1 + m2; best = gq; bi1 = i1; bi2 = i2; bs1 = s1; bs2 = s2; } }
      const int ia = bi1 < bi2 ? bi1 : bi2, ib = bi1 < bi2 ? bi2 : bi1;
      const int tri = ia == 0 ? ib - 1 : (ia == 1 ? ib + 1 : 5);
      const int pidx = best * 6 + tri;
      const float sa = bi1 < bi2 ? bs1 : bs2, sb = bi1 < bi2 ? bs2 : bs1, inv = 1.0f / (sa + sb);
      const int rank = atomicAdd(&hist[pidx], 1);
      tok_pair[r] = pidx | (rank << 5); tok_w[2 * r] = sa * inv; tok_w[2 * r + 1] = sb * inv;
    }
  }
  __syncthreads();
  if (tid < 32) ctl[CT_CNTB + BIDX * 32 + tid] = tid < 24 ? hist[tid] : 0;
}
__device__ __forceinline__ void st_moe_gather(const bf16_t* H2, bf16_t* H2S, int* ctl, const int* tok_pair, const float* tok_w, int* sorted_tok, float* sorted_w, int skip_ctx, char* lds) {
  int* sbase = (int*)lds; int* rtot = sbase + 32; int* rpre = rtot + 512;
  const int tid = TIDX, bid = BIDX;
  { const int p = tid & 31, seg = tid >> 5; int tot = 0, pre = 0;
#pragma unroll 4
    for (int i = 0; i < 16; ++i) { const int bb = seg * 16 + i; const int cv = ctl[CT_CNTB + bb * 32 + p]; tot += cv; pre += bb < bid ? cv : 0; }
    rtot[seg * 32 + p] = tot; rpre[seg * 32 + p] = pre; }
  __syncthreads();
  if (tid < 32) { int tot = 0, pre = 0;
#pragma unroll
    for (int sg = 0; sg < 16; ++sg) { tot += rtot[sg * 32 + tid]; pre += rpre[sg * 32 + tid]; }
    rtot[tid] = tot; rpre[tid] = pre; }
  __syncthreads();
  if (tid == 0) { int base = 0, nt = 0;
#pragma unroll 1
    for (int p = 0; p < 24; ++p) { sbase[p] = base + rpre[p]; const int n = rtot[p], tl = (n + 255) >> 8;
      if (bid == 0) { ctl[CT_BASE + p] = base; for (int t = 0; t < tl; ++t) ctl[CT_TP + nt + t] = p; }
      nt += tl; base += tl * 256; }
    if (bid == 0) { ctl[CT_BASE + 24] = base; ctl[CT_NT] = nt; } }
  __syncthreads();
  const int lane = tid & 63, gw = bid * 8 + (tid >> 6), ngw = GDIM * 8;
  for (int r = gw; r < MTOK; r += ngw) {
    if (skip_ctx && (r % TPB) < CTXL) continue;
    const int pk = tok_pair[r]; const int slot = sbase[pk & 31] + (pk >> 5);
    if (lane == 0) { sorted_tok[slot] = r; sorted_w[2 * slot] = tok_w[2 * r]; sorted_w[2 * slot + 1] = tok_w[2 * r + 1]; }
    const u32x4* sp = (const u32x4*)(H2 + (size_t)r * DM); u32x4* d = (u32x4*)(H2S + (size_t)slot * DM);
    d[lane] = sp[lane]; d[lane + 64] = sp[lane + 64];
  }
  __syncthreads();
}
__device__ __forceinline__ void st_final(float* xl, const float* g) {
  const int lane = TIDX & 63, gw = BIDX * 8 + (TIDX >> 6), ngw = GDIM * 8;
  f32x4 gg[4];
#pragma unroll
  for (int j = 0; j < 4; ++j) gg[j] = *(const f32x4*)(g + 4 * lane + 256 * j);
  for (int rb = gw; rb < NB * SEQ; rb += 4 * ngw) {
    f32x4 v[4][4];
#pragma unroll
    for (int u = 0; u < 4; ++u) { const int r = rb + u * ngw; const float* xr = xl + (size_t)(r < NB * SEQ ? r : NB * SEQ - 1) * DM;
#pragma unroll
      for (int j = 0; j < 4; ++j) v[u][j] = *(const f32x4*)(xr + 4 * lane + 256 * j); }
#pragma unroll
    for (int u = 0; u < 4; ++u) { const int r = rb + u * ngw; float ss = 0.f;
#pragma unroll
      for (int j = 0; j < 4; ++j) ss += v[u][j].x * v[u][j].x + v[u][j].y * v[u][j].y + v[u][j].z * v[u][j].z + v[u][j].w * v[u][j].w;
      const float rstd = rsqrtf(wave_sum(ss) * (1.0f / DM) + EPS);
      if (r < NB * SEQ) { float* xr = xl + (size_t)r * DM;
#pragma unroll
        for (int j = 0; j < 4; ++j) *(f32x4*)(xr + 4 * lane + 256 * j) = (f32x4){v[u][j].x * rstd * gg[j].x, v[u][j].y * rstd * gg[j].y, v[u][j].z * rstd * gg[j].z, v[u][j].w * rstd * gg[j].w}; } }
  }
}

namespace pg8 {
#define PG8_LAS __attribute__((address_space(3)))
typedef unsigned short bf16_t;
typedef short bf16x8 __attribute__((ext_vector_type(8)));
typedef float f32x4 __attribute__((ext_vector_type(4)));
typedef unsigned u32x4 __attribute__((ext_vector_type(4)));
constexpr int BM = 256, BK = 64, HALF = 128, HTB = HALF * BK * 2  , STAGE_BYTES = 8 * HTB, NXCD = 8, WGM = 8;

__host__ __device__ __forceinline__ int lds_byte(int r, int c) { const int st = (r >> 4) * 2 + (c >> 5), rr = r & 15, cc = c & 31, ob = rr * 64 + cc * 2; return st * 1024 + (ob ^ (((ob >> 9) & 1) << 5)); }
__host__ __device__ __forceinline__ void stage_rc(int b, int& R, int& C) { const int st = b / 1024, sb = b % 1024, swz = sb ^ (((sb >> 9) & 1) << 5); R = (st >> 1) * 16 + swz / 64; C = (st & 1) * 32 + (swz % 64) / 2; }
__host__ __device__ __forceinline__ int perm32(int rho) { const int n = rho >> 4, i = rho & 15; return 8 * (i >> 2) + 4 * n + (i & 3); }

struct Unit { int pm, pn, fin; const char* A; const char* B; };
struct Gemm { int K, lda, ldb; };

__device__ __forceinline__ void tile_of(int L, int nM, int nN, int& pm, int& pn) {
    const int nwg = nM * nN; int wgid = L; { const int q = nwg / NXCD, r = nwg % NXCD, xcd = wgid % NXCD, off = wgid / NXCD; wgid = (xcd < r ? xcd * (q + 1) : r * (q + 1) + (xcd - r) * q) + off; }
    const int nig = WGM * nN, gid = wgid / nig, fm = gid * WGM, gsz = (nM - fm) < WGM ? (nM - fm) : WGM;
    pm = fm + ((wgid % nig) % gsz); pn = (wgid % nig) / gsz;
}
__device__ __forceinline__ unsigned cvt_pk_bf16(float lo, float hi) { unsigned r; asm volatile("v_cvt_pk_bf16_f32 %0, %1, %2" : "=v"(r) : "v"(lo), "v"(hi)); return r; }
template <class Epi, class Sched, bool ALIGN_EPI = false, bool SP2 = false>
__device__ __forceinline__ void gemm_phase(PG8_LAS unsigned char* lds, const Gemm g, const Sched& S, const Epi& E) {
    const int tid = opq_v((int)threadIdx.x), wid = __builtin_amdgcn_readfirstlane(tid >> 6), lane = tid & 63, wr = wid >> 2, wc = wid & 3, fr = lane & 15, fq = lane >> 4;
    const int K = g.K, nt = K / BK;
    unsigned voffA[2], voffB[2];
#pragma unroll
    for (int i = 0; i < 2; ++i) { int R, C; stage_rc(tid * 16 + i * 8192, R, C); const int Rb = Epi::PERM ? ((R & ~31) + perm32(R & 31)) : R;
        voffA[i] = (unsigned)(R * g.lda + C) * 2u; voffB[i] = (unsigned)(Rb * g.ldb + C) * 2u; }
    const size_t kstep = (size_t)(BK * 2);
    const size_t hstepA = (size_t)HALF * g.lda * 2, hstepB = (size_t)HALF * g.ldb * 2;
    const unsigned ldsw = (unsigned)wid * 1024u;
    const int aoff = lds_byte(wr * 64 + fr, fq * 8), boff = lds_byte(wc * 32 + fr, fq * 8);
#define PG8_SA(b, h) (((b) * 2 + (h)) * HTB)
#define PG8_SB(b, h) ((4 + (b) * 2 + (h)) * HTB)
#define PG8_STAGE(bufoff, gbase, voff) do { _Pragma("unroll") for (int _i = 0; _i < 2; ++_i) \
        __builtin_amdgcn_global_load_lds((const unsigned*)((const char*)(gbase) + (voff)[_i]), (PG8_LAS unsigned*)(lds + (bufoff) + ldsw + _i * 8192), 16, 0, 0); } while (0)
#define PG8_LDA(dst, b, h) do { _Pragma("unroll") for (int m = 0; m < 4; ++m) _Pragma("unroll") for (int k = 0; k < 2; ++k) dst[m][k] = *(const PG8_LAS bf16x8*)(lds + PG8_SA(b, h) + aoff + m * 2048 + k * 1024); } while (0)
#define PG8_LDB(dst, b, h) do { _Pragma("unroll") for (int n = 0; n < 2; ++n) _Pragma("unroll") for (int k = 0; k < 2; ++k) dst[n][k] = *(const PG8_LAS bf16x8*)(lds + PG8_SB(b, h) + boff + n * 2048 + k * 1024); } while (0)
#define PG8_MMA(ai, bj, At, Bt) do { __builtin_amdgcn_s_setprio(1); _Pragma("unroll") for (int m = 0; m < 4; ++m) _Pragma("unroll") for (int n = 0; n < 2; ++n) _Pragma("unroll") for (int k = 0; k < 2; ++k) \
        acc[ai][bj][m][n] = __builtin_amdgcn_mfma_f32_16x16x32_bf16(Bt[n][k], At[m][k], acc[ai][bj][m][n], 0, 0, 0); __builtin_amdgcn_s_setprio(0); } while (0)
#define PG8_WAIT_V(n) asm volatile("s_waitcnt vmcnt(" #n ")" ::: "memory")
#define PG8_WAIT_L(n) asm volatile("s_waitcnt lgkmcnt(" #n ")" ::: "memory")
#define PG8_BAR __builtin_amdgcn_s_barrier()
#define PG8_SCHED __builtin_amdgcn_sched_barrier(0)
    Unit cur, nxt; int ui = 0;
    if (!S.next(0, cur)) return;
    f32x4 acc[2][2][4][2];
#pragma unroll
    for (int a = 0; a < 2; ++a)
#pragma unroll
        for (int b = 0; b < 2; ++b)
#pragma unroll
            for (int m = 0; m < 4; ++m)
#pragma unroll
                for (int n = 0; n < 2; ++n) acc[a][b][m][n] = (f32x4){0.f, 0.f, 0.f, 0.f};
    bf16x8 At[4][2], B0[2][2], B1[2][2];
    const char* cA = cur.A; const char* cB = cur.B;
    S.a_ready(cur);
    if constexpr (SP2) {
        PG8_STAGE(PG8_SB(0, 0), cB, voffB); PG8_STAGE(PG8_SB(0, 1), cB + hstepB, voffB); PG8_STAGE(PG8_SA(0, 0), cA, voffA); PG8_STAGE(PG8_SA(0, 1), cA + hstepA, voffA);
        if (wr == 1) PG8_BAR;
        PG8_WAIT_V(2); PG8_BAR;
        PG8_STAGE(PG8_SB(1, 0), cB + kstep, voffB); PG8_STAGE(PG8_SA(1, 0), cA + kstep, voffA); PG8_STAGE(PG8_SB(1, 1), cB + hstepB + kstep, voffB);
        PG8_WAIT_V(6); PG8_BAR;
    } else {
        PG8_STAGE(PG8_SB(0, 0), cB, voffB); PG8_STAGE(PG8_SA(0, 0), cA, voffA); PG8_STAGE(PG8_SB(0, 1), cB + hstepB, voffB); PG8_STAGE(PG8_SA(0, 1), cA + hstepA, voffA);
        if (wr == 1) PG8_BAR;
        PG8_WAIT_V(4); PG8_BAR;
        PG8_STAGE(PG8_SB(1, 0), cB + kstep, voffB); PG8_STAGE(PG8_SA(1, 0), cA + kstep, voffA); PG8_STAGE(PG8_SB(1, 1), cB + hstepB + kstep, voffB);
        PG8_WAIT_V(6); PG8_BAR;
    }
    for (;;) {
        const bool has_next = S.next(ui + 1, nxt);
        const char* nA = has_next ? nxt.A : cA; const char* nB = has_next ? nxt.B : cB;
        for (int t = 0; t < nt; t += 2) {
            const bool last = (t == nt - 2);
            const char* a1 = cA + (size_t)(t + 1) * kstep;
            const char* a2 = last ? nA : cA + (size_t)(t + 2) * kstep; const char* b2 = last ? nB : cB + (size_t)(t + 2) * kstep;
            const char* a3 = a2 + kstep; const char* b3 = b2 + kstep;
            if (last && has_next) S.a_ready(nxt);
            if constexpr (SP2) {
            PG8_LDB(B0, 0, 0); PG8_LDB(B1, 0, 1); PG8_SCHED; PG8_LDA(At, 0, 0); PG8_STAGE(PG8_SA(1, 1), a1 + hstepA, voffA);
            PG8_WAIT_V(8); PG8_WAIT_L(0); PG8_BAR; PG8_MMA(0, 0, At, B0); PG8_MMA(0, 1, At, B1); PG8_BAR; PG8_SCHED;
            PG8_LDA(At, 0, 1); PG8_STAGE(PG8_SB(0, 0), b2, voffB); PG8_STAGE(PG8_SB(0, 1), b2 + hstepB, voffB); PG8_STAGE(PG8_SA(0, 0), a2, voffA);
            PG8_WAIT_V(8); PG8_WAIT_L(0); PG8_BAR; PG8_MMA(1, 0, At, B0); PG8_MMA(1, 1, At, B1); PG8_BAR; PG8_SCHED;
            PG8_LDB(B0, 1, 0); PG8_LDB(B1, 1, 1); PG8_SCHED; PG8_LDA(At, 1, 0); PG8_STAGE(PG8_SA(0, 1), a2 + hstepA, voffA);
            PG8_WAIT_V(8); PG8_WAIT_L(0); PG8_BAR; PG8_MMA(0, 0, At, B0); PG8_MMA(0, 1, At, B1); PG8_BAR; PG8_SCHED;
            PG8_LDA(At, 1, 1); PG8_STAGE(PG8_SB(1, 0), b3, voffB); PG8_STAGE(PG8_SB(1, 1), b3 + hstepB, voffB); PG8_STAGE(PG8_SA(1, 0), a3, voffA);
            PG8_WAIT_V(8); PG8_WAIT_L(0); PG8_BAR; PG8_MMA(1, 0, At, B0); PG8_MMA(1, 1, At, B1); PG8_BAR; PG8_SCHED;
            } else {
            PG8_LDB(B0, 0, 0); PG8_SCHED; PG8_LDA(At, 0, 0); PG8_STAGE(PG8_SA(1, 1), a1 + hstepA, voffA);
            PG8_WAIT_L(8); PG8_BAR; PG8_WAIT_L(0); PG8_MMA(0, 0, At, B0); PG8_BAR; PG8_SCHED;
            PG8_LDB(B1, 0, 1); PG8_STAGE(PG8_SB(0, 0), b2, voffB);
            PG8_BAR; PG8_WAIT_L(0); PG8_MMA(0, 1, At, B1); PG8_BAR;
            PG8_LDA(At, 0, 1); PG8_STAGE(PG8_SA(0, 0), a2, voffA);
            PG8_BAR; PG8_WAIT_L(0); PG8_MMA(1, 0, At, B0); PG8_BAR; PG8_SCHED;
            PG8_STAGE(PG8_SB(0, 1), b2 + hstepB, voffB);
            PG8_WAIT_V(6); PG8_BAR; PG8_MMA(1, 1, At, B1); PG8_BAR;
            PG8_LDB(B0, 1, 0); PG8_SCHED; PG8_LDA(At, 1, 0); PG8_STAGE(PG8_SA(0, 1), a2 + hstepA, voffA);
            PG8_WAIT_L(8); PG8_BAR; PG8_WAIT_L(0); PG8_MMA(0, 0, At, B0); PG8_BAR; PG8_SCHED;
            PG8_LDB(B1, 1, 1); PG8_STAGE(PG8_SB(1, 0), b3, voffB);
            PG8_BAR; PG8_WAIT_L(0); PG8_MMA(0, 1, At, B1); PG8_BAR;
            PG8_LDA(At, 1, 1); PG8_STAGE(PG8_SA(1, 0), a3, voffA);
            PG8_BAR; PG8_WAIT_L(0); PG8_MMA(1, 0, At, B0); PG8_BAR; PG8_SCHED;
            PG8_STAGE(PG8_SB(1, 1), b3 + hstepB, voffB);
            PG8_WAIT_V(6); PG8_BAR; PG8_MMA(1, 1, At, B1); PG8_BAR;
            }
        }
        if constexpr (ALIGN_EPI) { if (wr == 0) PG8_BAR; }
        if constexpr (!Epi::AFTER_DRAIN) { if (cur.fin) { E(acc, cur, wr, wc, fr, fq); S.done(cur); } }
        if (!has_next) break;
        if (cur.fin) {
#pragma unroll
        for (int a = 0; a < 2; ++a)
#pragma unroll
            for (int b = 0; b < 2; ++b)
#pragma unroll
                for (int m = 0; m < 4; ++m)
#pragma unroll
                    for (int n = 0; n < 2; ++n) acc[a][b][m][n] = (f32x4){0.f, 0.f, 0.f, 0.f};
        }
        cur = nxt; cA = nA; cB = nB; ++ui;
        if constexpr (ALIGN_EPI) { if (wr == 1) PG8_BAR; }
    }
    PG8_WAIT_V(0);
    if constexpr (!ALIGN_EPI) { if (wr == 0) PG8_BAR; }
    PG8_BAR;
    if constexpr (Epi::AFTER_DRAIN) { E.fused(acc, cur, wr, wc, fr, fq, lds, wid, lane); S.done(cur); }
#undef PG8_SA
#undef PG8_SB
#undef PG8_STAGE
#undef PG8_LDA
#undef PG8_LDB
#undef PG8_MMA
#undef PG8_WAIT_V
#undef PG8_WAIT_L
#undef PG8_BAR
#undef PG8_SCHED
}
}

struct SchedDense {
  int nM, nN, G, c, skip_ctx; const char* A; const char* B; size_t a_tile, b_tile;
  __device__ __forceinline__ bool next(int i, pg8::Unit& u) const {
    const long L = (long)i * G + c; if (L >= (long)nM * nN) return false;
    int pm, pn; pg8::tile_of((int)L, nM, nN, pm, pn); if (skip_ctx) pm = pm + pm / 16 + 1;
    u.pm = pm; u.pn = pn; u.fin = 1; u.A = A + (size_t)pm * a_tile; u.B = B + (size_t)pn * b_tile; return true; }
  __device__ __forceinline__ void a_ready(const pg8::Unit&) const {}
  __device__ __forceinline__ void done(const pg8::Unit&) const {}
};
struct SchedMoe {
  int G, c, mode; const int* ctl; const char* A; size_t a_tile; const char* W;
  __device__ __forceinline__ bool next(int i, pg8::Unit& u) const {
    const int part = mode == 2 ? (i & 1) : 0, iu = mode == 2 ? (i >> 1) : i;
    const long L = (long)iu * G + c; const int ntiles = ctl[CT_NT]; if (L >= (long)ntiles * 4) return false;
    const int pm = (int)(L >> 2), pn = (int)(L & 3); int eA, eB; pair_experts(ctl[CT_TP + pm], eA, eB);
    u.pm = pm; u.pn = pn;
    if (mode == 1) { const int e = pn < 2 ? eA : eB; u.fin = 1; u.A = A + (size_t)pm * a_tile; u.B = W + (size_t)e * (512 * 1024 * 2) + (size_t)(pn & 1) * (256 * 1024 * 2); }
    else { u.fin = part; u.A = A + (size_t)pm * a_tile + part * 512; u.B = W + (size_t)(part ? eB : eA) * (1024 * 256 * 2) + (size_t)pn * (256 * 256 * 2); }
    return true; }
  __device__ __forceinline__ void a_ready(const pg8::Unit&) const {}
  __device__ __forceinline__ void done(const pg8::Unit&) const {}
};
__device__ __forceinline__ unsigned cvt_pk(float lo, float hi) { return pg8::cvt_pk_bf16(lo, hi); }
struct EpiInProj {
  static constexpr bool PERM = true, AFTER_DRAIN = false; bf16_t *QK, *VZ, *XBC, *HY; float* DT;
  __device__ __forceinline__ void operator()(const f32x4 (&acc)[2][2][4][2], const pg8::Unit& u, int wr, int wc, int fr, int fq) const {
    const int pn = u.pn; bf16_t* base; int ldc, coff;
    if (pn < 2) { base = QK; ldc = 512; coff = pn * 256; } else if (pn < 4) { base = VZ; ldc = 512; coff = (pn - 2) * 256; }
    else if (pn < 7) { base = XBC; ldc = 768; coff = (pn - 4) * 256; } else { base = HY; ldc = 768; coff = (pn - 7) * 256; }
    const int row0 = u.pm * 256 + wr * 64 + fr, col0 = coff + wc * 32 + 8 * fq; const bool dtl = (pn == 6 && wc == 0 && fq < 2);
#pragma unroll
    for (int ai = 0; ai < 2; ++ai)
#pragma unroll
      for (int m = 0; m < 4; ++m) { const int row = row0 + ai * 128 + m * 16; bf16_t* rowp = base + (size_t)row * ldc + col0;
#pragma unroll
        for (int bj = 0; bj < 2; ++bj) { const f32x4 v0 = acc[ai][bj][m][0], v1 = acc[ai][bj][m][1];
          u32x4 w; w.x = cvt_pk(v0[0], v0[1]); w.y = cvt_pk(v0[2], v0[3]); w.z = cvt_pk(v1[0], v1[1]); w.w = cvt_pk(v1[2], v1[3]);
          *(u32x4*)(rowp + bj * 128) = w;
          if (bj == 1 && dtl) { float* dp = DT + (size_t)row * 12 + 8 * fq; *(f32x4*)dp = v0; if (fq == 0) *(f32x4*)(dp + 4) = v1; } } }
  }
};
struct EpiOutProj {
  static constexpr bool PERM = false, AFTER_DRAIN = false; const float *xl_src, *xc_src; float *xl_dst, *xc_dst; const float* gate;
  __device__ __forceinline__ void operator()(const f32x4 (&acc)[2][2][4][2], const pg8::Unit& u, int wr, int wc, int fr, int fq) const {
    const int b = u.pm / 17, jt = u.pm - 17 * b; const size_t rbase = jt == 0 ? (size_t)b * CTXL : (size_t)b * SEQ + (jt - 1) * 256;
    const float* xs = (jt == 0 ? xc_src : xl_src) + rbase * DM; float* xd = (jt == 0 ? xc_dst : xl_dst) + rbase * DM; const float* gt = gate + (size_t)(jt == 0 ? 4 : b) * 6144;
    const int col0 = u.pn * 256 + wc * 32 + 4 * fq;
#pragma unroll
    for (int ai = 0; ai < 2; ++ai)
#pragma unroll
      for (int m = 0; m < 4; ++m) { const size_t off = (size_t)(ai * 128 + wr * 64 + m * 16 + fr) * DM + col0;
#pragma unroll
        for (int bj = 0; bj < 2; ++bj)
#pragma unroll
          for (int n = 0; n < 2; ++n) { const int co = bj * 128 + n * 16; const f32x4 g4 = *(const f32x4*)(gt + col0 + co), x4 = *(const f32x4*)(xs + off + co);
            *(f32x4*)(xd + off + co) = x4 + g4 * acc[ai][bj][m][n]; } }
  }
};
struct EpiMoe1 {
  static constexpr bool PERM = true, AFTER_DRAIN = false; bf16_t* ACT; const float* sorted_w;
  __device__ __forceinline__ void operator()(const f32x4 (&acc)[2][2][4][2], const pg8::Unit& u, int wr, int wc, int fr, int fq) const {
    const int half = u.pn >> 1, j0 = (u.pn & 1) * 128 + 16 * wc + 4 * fq;
#pragma unroll
    for (int ai = 0; ai < 2; ++ai)
#pragma unroll
      for (int m = 0; m < 4; ++m) { const int slot = u.pm * 256 + ai * 128 + wr * 64 + m * 16 + fr; const float wt = sorted_w[2 * slot + half];
#pragma unroll
        for (int bj = 0; bj < 2; ++bj) { const f32x4 v0 = acc[ai][bj][m][0], v1 = acc[ai][bj][m][1];
          u32x2 w; w.x = cvt_pk(siluf(v0[0]) * v0[1] * wt, siluf(v0[2]) * v0[3] * wt); w.y = cvt_pk(siluf(v1[0]) * v1[1] * wt, siluf(v1[2]) * v1[3] * wt);
          *(u32x2*)(ACT + (size_t)slot * 512 + half * 256 + j0 + 64 * bj) = w; } }
  }
};
struct EpiMoe2 {
  static constexpr bool PERM = false, AFTER_DRAIN = false; float *xl, *xc; const float* gate; const int* sorted_tok;
  __device__ __forceinline__ void operator()(const f32x4 (&acc)[2][2][4][2], const pg8::Unit& u, int wr, int wc, int fr, int fq) const {
    const int col0 = u.pn * 256 + wc * 32 + 4 * fq;
#pragma unroll
    for (int ai = 0; ai < 2; ++ai)
#pragma unroll
      for (int m = 0; m < 4; ++m) { const int slot = u.pm * 256 + ai * 128 + wr * 64 + m * 16 + fr; const int r = sorted_tok[slot];
        if (r >= 0) { float* xd = xrow(xl, xc, r) + col0; const float* gt = gate + (size_t)mrow_of(r) * 6144 + col0;
#pragma unroll
          for (int bj = 0; bj < 2; ++bj)
#pragma unroll
            for (int n = 0; n < 2; ++n) { const int co = bj * 128 + n * 16; *(f32x4*)(xd + co) = *(const f32x4*)(xd + co) + *(const f32x4*)(gt + co) * acc[ai][bj][m][n]; } }
        asm volatile("" ::: "memory"); }
  }
};

#include <hip/hip_bf16.h>
#include <cmath>
namespace attn_body {
using bf16=__hip_bfloat16;
using bf16x8=__attribute__((ext_vector_type(8)))short;
using s16x4=__attribute__((ext_vector_type(4)))short;
using f32x16=__attribute__((ext_vector_type(16)))float;
using u32x4=__attribute__((ext_vector_type(4)))unsigned;
constexpr int D=64,QP=512,KP=512,VP=512,OP=1024;
constexpr int NW=8,QBLK=32,QB=QBLK*NW,KVBLK=64;
constexpr int ATTN_UNIT_ROWS=QB;
__device__ __forceinline__ int crow(int r,int hi){return (r&3)+8*(r>>2)+4*hi;}
#define SBAR() __builtin_amdgcn_sched_barrier(0)
__device__ __forceinline__ void cmask(f32x16&p0,f32x16&p1,int jb,int qrel,int hi){
  const float NEG=-INFINITY; int kb=64*jb+4*hi;
  #pragma unroll
  for(int r=0;r<16;++r){int kv=kb+(r&3)+8*(r>>2); if(kv>qrel)p0[r]=NEG; if(kv+32>qrel)p1[r]=NEG;}
}

constexpr int NSLOT=3, SLOTB=8192;
constexpr int LDS_K=0, LDS_V=NSLOT*SLOTB, LDS_WS=2*NSLOT*SLOTB, LDS_OST=LDS_WS+NW*64*4, LDS_BYTES=LDS_OST+NW*4096;
constexpr float C2=0.125f*1.4426950408889634f;
__device__ __forceinline__ void glds16(const void*gsrc,unsigned lds_dst){unsigned keep;
  asm volatile("s_mov_b32 %0, m0\n\ts_mov_b32 m0, %2\n\ts_nop 0\n\tglobal_load_lds_dwordx4 %1, off\n\ts_mov_b32 m0, %0":"=&s"(keep):"v"(gsrc),"s"(lds_dst):"memory");}
__device__ __forceinline__ float max3f(float a,float b,float c){float r;asm("v_max3_f32 %0, %1, %2, %3":"=v"(r):"v"(a),"v"(b),"v"(c));return r;}
__device__ __forceinline__ float max2f(float a,float b){float r;asm("v_max_f32_e32 %0, %1, %2":"=v"(r):"v"(a),"v"(b));return r;}
__device__ __forceinline__ float fadd_s(float a,float b){float r;asm("v_add_f32_e32 %0, %1, %2":"=v"(r):"v"(a),"v"(b));return r;}
__device__ __forceinline__ float fsub_s(float a,float b){float r;asm("v_sub_f32_e32 %0, %1, %2":"=v"(r):"v"(a),"v"(b));return r;}
typedef float f32x2_t __attribute__((ext_vector_type(2))); typedef __bf16 bf16x2_t __attribute__((ext_vector_type(2)));
__device__ __forceinline__ unsigned cvtpk_s(float lo,float hi){f32x2_t v={lo,hi};bf16x2_t b=__builtin_convertvector(v,bf16x2_t);return __builtin_bit_cast(unsigned,b);}
#define WAIT_BAR(N) asm volatile("s_waitcnt vmcnt(" #N ") lgkmcnt(0)\n\ts_barrier":::"memory")

__device__ __forceinline__ void qkt(f32x16&p0,f32x16&p1,const char*Kslot,const bf16x8*qr,const f32x16&negm,int r32,int hi){
  const char*kb=Kslot+hi*1024+r32*16;
  #pragma unroll
  for(int d0=0;d0<4;++d0){
    const bf16x8 b0=*reinterpret_cast<const bf16x8*>(kb+d0*2048);
    const bf16x8 b1=*reinterpret_cast<const bf16x8*>(kb+d0*2048+512);
    if(d0==0){p0=__builtin_amdgcn_mfma_f32_32x32x16_bf16(b0,qr[0],negm,0,0,0);p1=__builtin_amdgcn_mfma_f32_32x32x16_bf16(b1,qr[0],negm,0,0,0);}
    else{p0=__builtin_amdgcn_mfma_f32_32x32x16_bf16(b0,qr[d0],p0,0,0,0);p1=__builtin_amdgcn_mfma_f32_32x32x16_bf16(b1,qr[d0],p1,0,0,0);}}
}
typedef __attribute__((address_space(3))) const char* lds_cptr;
typedef short v4i16_t __attribute__((ext_vector_type(4)));
__device__ __forceinline__ void kload8(bf16x8*kf,lds_cptr kp){
  kf[0]=*(const __attribute__((address_space(3))) bf16x8*)(kp);      kf[1]=*(const __attribute__((address_space(3))) bf16x8*)(kp+512);
  kf[2]=*(const __attribute__((address_space(3))) bf16x8*)(kp+2048); kf[3]=*(const __attribute__((address_space(3))) bf16x8*)(kp+2560);
  kf[4]=*(const __attribute__((address_space(3))) bf16x8*)(kp+4096); kf[5]=*(const __attribute__((address_space(3))) bf16x8*)(kp+4608);
  kf[6]=*(const __attribute__((address_space(3))) bf16x8*)(kp+6144); kf[7]=*(const __attribute__((address_space(3))) bf16x8*)(kp+6656);
}
__device__ __forceinline__ void kload2(bf16x8*kf,lds_cptr kp,int j){ kf[2*j]=*(const __attribute__((address_space(3))) bf16x8*)(kp+j*2048); kf[2*j+1]=*(const __attribute__((address_space(3))) bf16x8*)(kp+j*2048+512); }
__device__ __forceinline__ s16x4 vtr(lds_cptr p){ return __builtin_bit_cast(s16x4,__builtin_amdgcn_ds_read_tr16_b64_v4i16((__attribute__((address_space(3))) v4i16_t*)p)); }
__device__ __forceinline__ float rowmax(const f32x16&p0,const f32x16&p1){
  float a=max3f(p0[0],p0[1],p1[0]),b=max3f(p0[2],p0[3],p1[1]);a=max3f(a,p1[2],p1[3]);
  #pragma unroll
  for(int r=4;r<16;r+=4){a=max3f(a,p0[r],p0[r+1]);b=max3f(b,p0[r+2],p0[r+3]);a=max3f(a,p1[r],p1[r+1]);b=max3f(b,p1[r+2],p1[r+3]);}
  const float m=max2f(a,b);
  auto rr=__builtin_amdgcn_permlane32_swap(__float_as_uint(m),__float_as_uint(m),false,false);
  return max2f(__uint_as_float(rr[0]),__uint_as_float(rr[1]));
}
__device__ __forceinline__ void pv(f32x16*o,int vb,bf16x8 pa0,bf16x8 pa1,bf16x8 pa2,bf16x8 pa3){
  #pragma unroll
  for(int d0=0;d0<2;++d0){s16x4 lo[4],hi[4];
    #pragma unroll
    for(int ks=0;ks<4;++ks){
      asm volatile("ds_read_b64_tr_b16 %0,%1 offset:%c2":"=&v"(lo[ks]):"v"(vb),"i"(d0*4096+ks*1024):"memory");
      asm volatile("ds_read_b64_tr_b16 %0,%1 offset:%c2":"=&v"(hi[ks]):"v"(vb),"i"(d0*4096+ks*1024+512):"memory");}
    asm volatile("s_waitcnt lgkmcnt(0)":::"memory");SBAR();
    #define PK(k) (bf16x8){lo[k][0],lo[k][1],lo[k][2],lo[k][3],hi[k][0],hi[k][1],hi[k][2],hi[k][3]}
    o[d0]=__builtin_amdgcn_mfma_f32_32x32x16_bf16(pa0,PK(0),o[d0],0,0,0);
    o[d0]=__builtin_amdgcn_mfma_f32_32x32x16_bf16(pa1,PK(1),o[d0],0,0,0);
    o[d0]=__builtin_amdgcn_mfma_f32_32x32x16_bf16(pa2,PK(2),o[d0],0,0,0);
    o[d0]=__builtin_amdgcn_mfma_f32_32x32x16_bf16(pa3,PK(3),o[d0],0,0,0);
    #undef PK
  }
}

#ifndef ATTN_STORE16
#define ATTN_STORE16(p,v) (*(u32x4*)(p)=(v))
#endif
template<int THRL> __device__ __forceinline__ void attn_unit(const bf16*Qu,const bf16*__restrict__ Kh,const bf16*__restrict__ Vh,bf16*Ou,const int NT,char*shm){
  const int tid=opq_v((int)threadIdx.x),lane=tid&63,r32=lane&31,hi=lane>>5; const int wid=__builtin_amdgcn_readfirstlane(tid>>6);
  const bf16*Qw=Qu+(long)(wid*QBLK)*QP;
  const unsigned lds0=(unsigned)(uintptr_t)shm;
  float*wsf=(float*)(shm+LDS_WS)+wid*64;
  const bf16*ksrc=Kh+(long)lane*KP+wid*8;
  const bf16*vsrc=Vh+(long)(16*(wid&3)+(lane>>2))*VP+(wid>>2)*32+(lane&3)*8;
  const unsigned kdst=lds0+LDS_K+wid*1024, vdst=lds0+LDS_V+wid*1024;
  #define DMA_K(t,slot) glds16(ksrc+(long)(t)*KVBLK*KP,(unsigned)__builtin_amdgcn_readfirstlane(kdst+(slot)))
  #define DMA_V(t,slot) glds16(vsrc+(long)(t)*KVBLK*VP,(unsigned)__builtin_amdgcn_readfirstlane(vdst+(slot)))
  const int vb0=(int)(lds0+LDS_V)+((lane>>4)&1)*32+(lane&3)*8+(4*hi+((lane&15)>>2))*64;
  const char*Kbase=shm+LDS_K; bf16x8 kf[8];
  const lds_cptr shm3=(lds_cptr)shm; const lds_cptr kp0=shm3+LDS_K+hi*1024+r32*16; const lds_cptr vp0=shm3+LDS_V+((lane>>4)&1)*32+(lane&3)*8+(4*hi+((lane&15)>>2))*64;
  DMA_K(0,0);DMA_V(0,0);DMA_K(1,SLOTB);
  bf16x8 qr[4];
  #pragma unroll
  for(int d0=0;d0<4;++d0)qr[d0]=*reinterpret_cast<const bf16x8*>(&Qw[(long)r32*QP+d0*16+hi*8]);
  float mhat=0.f,l_reg=0.f;float z0_=0.f;asm volatile("":"+v"(z0_));f32x16 o[2];f32x16 negm;
  _Pragma("unroll") for(int r=0;r<16;++r){o[0][r]=z0_;o[1][r]=z0_;negm[r]=z0_;} asm volatile("":"+v"(negm));
  #define CMASK(P0,P1,t) do{}while(0)
  bool resc=false;
  #define START(P0,P1) do{ const float rm=rowmax(P0,P1); resc=false; \
    { const float dl=rm; mhat=fadd_s(mhat,dl); \
      _Pragma("unroll") for(int r=0;r<16;++r){P0[r]=fsub_s(P0[r],dl);P1[r]=fsub_s(P1[r],dl);} \
      _Pragma("unroll") for(int r=0;r<16;++r)negm[r]=-mhat; asm volatile("":"+v"(negm)); } \
    _Pragma("unroll") for(int r=0;r<16;++r)P0[r]=__builtin_amdgcn_exp2f(P0[r]); }while(0)
  #define RESC() do{ if(resc){ asm volatile("s_waitcnt lgkmcnt(0)":::"memory"); \
      _Pragma("unroll") for(int d_=0;d_<2;++d_) _Pragma("unroll") for(int r=0;r<16;++r)o[d_][r]*=wsf[crow(r,hi)]; } }while(0)
  f32x16 pA0,pA1,pB0,pB1;
  int sl_prev=0,sl_cur=0,sl_next=SLOTB;
  #define ROT() do{sl_prev=sl_cur;sl_cur=sl_next;sl_next=(sl_next==(NSLOT-1)*SLOTB)?0:sl_next+SLOTB;}while(0)
  DMA_K(2,2*SLOTB);
  WAIT_BAR(3);
  qkt(pA0,pA1,Kbase,qr,negm,r32,hi);asm volatile("s_nop 15\n\ts_nop 7":"+v"(pA0),"+v"(pA1));CMASK(pA0,pA1,0);
  START(pA0,pA1);
  _Pragma("unroll") for(int r=0;r<16;++r)pA1[r]=__builtin_amdgcn_exp2f(pA1[r]);
  WAIT_BAR(0);
  DMA_K(3,0);DMA_V(1,SLOTB);
  ROT();
  kload8(kf,kp0+sl_cur);
  WAIT_BAR(2);
  s16x4 vlo[8],vhi[8]; u32x4 pw0,pw1,pw2,pw3;
  #define PKW(P,B) cvtpk_s(P[B],P[B+1])
  #define PAF(k) __builtin_bit_cast(bf16x8,pw##k)
  #define VFR(i) (bf16x8){vlo[i][0],vlo[i][1],vlo[i][2],vlo[i][3],vhi[i][0],vhi[i][1],vhi[i][2],vhi[i][3]}
  #define PIN(x) asm volatile("":"+v"(x))
  #define MX3(a,b,c) __builtin_fmaxf(__builtin_fmaxf((a),(b)),(c))
  #define GAPA(MF,A0,A1,A2,A3,W0,W1,PW) do{ MF; sacc+=A0; sacc+=A1; sacc+=A2; sacc+=A3; PIN(sacc); W0; W1; PIN(PW); SBAR(); }while(0)
  #define EX(v) __builtin_amdgcn_exp2f(v)
  #define GAPB(MF,X,B) do{ MF; X[B]=EX(X[B]); X[B+1]=EX(X[B+1]); X[B+2]=EX(X[B+2]); X[B+3]=EX(X[B+3]); PIN(X); SBAR(); }while(0)
  #define VRD(i) do{ vlo[i]=vtr(vp_+(((i)>>2)*4096+((i)&3)*1024)); vhi[i]=vtr(vp_+(((i)>>2)*4096+((i)&3)*1024+512)); }while(0)
  #define KRD(G,j) do{ if(G){ kload2(kf,kp0+sl_next,j); SBAR(); } }while(0)
  #define STEP(C0,C1,P0,P1,t,GK,GV,GL) do{ SBAR(); \
    const lds_cptr vp_=vp0+sl_prev; \
    VRD(0); SBAR(); float sacc=(P0[0]+P0[1]); \
    GAPA(C0=__builtin_amdgcn_mfma_f32_32x32x16_bf16(kf[0],qr[0],negm,0,0,0), P0[2],P0[3],P0[4],P0[5],     pw0[0]=PKW(P0,0), pw0[1]=PKW(P0,2), pw0); \
    VRD(4); SBAR(); GAPA(C1=__builtin_amdgcn_mfma_f32_32x32x16_bf16(kf[1],qr[0],negm,0,0,0), P0[6],P0[7],P0[8],P0[9],     pw0[2]=PKW(P0,4), pw0[3]=PKW(P0,6), pw0); \
    VRD(1); SBAR(); GAPA(C0=__builtin_amdgcn_mfma_f32_32x32x16_bf16(kf[2],qr[1],C0,0,0,0),   P0[10],P0[11],P0[12],P0[13], pw1[0]=PKW(P0,8), pw1[1]=PKW(P0,10), pw1); \
    VRD(5); SBAR(); GAPA(C1=__builtin_amdgcn_mfma_f32_32x32x16_bf16(kf[3],qr[1],C1,0,0,0),   P0[14],P0[15],P1[0],P1[1],   pw1[2]=PKW(P0,12),pw1[3]=PKW(P0,14), pw1); \
    VRD(2); SBAR(); GAPA(C0=__builtin_amdgcn_mfma_f32_32x32x16_bf16(kf[4],qr[2],C0,0,0,0),   P1[2],P1[3],P1[4],P1[5],     pw2[0]=PKW(P1,0), pw2[1]=PKW(P1,2), pw2); \
    VRD(6); SBAR(); GAPA(C1=__builtin_amdgcn_mfma_f32_32x32x16_bf16(kf[5],qr[2],C1,0,0,0),   P1[6],P1[7],P1[8],P1[9],     pw2[2]=PKW(P1,4), pw2[3]=PKW(P1,6), pw2); \
    VRD(3); SBAR(); GAPA(C0=__builtin_amdgcn_mfma_f32_32x32x16_bf16(kf[6],qr[3],C0,0,0,0),   P1[10],P1[11],P1[12],P1[13], pw3[0]=PKW(P1,8), pw3[1]=PKW(P1,10), pw3); \
    VRD(7); SBAR(); GAPA(C1=__builtin_amdgcn_mfma_f32_32x32x16_bf16(kf[7],qr[3],C1,0,0,0),   P1[14],P1[15],0.f,0.f,       pw3[2]=PKW(P1,12),pw3[3]=PKW(P1,14), pw3); \
    l_reg+=sacc; \
    if(GK){DMA_K((t)+3,sl_cur);} if(GV){DMA_V((t)+1,sl_next);} \
    CMASK(C0,C1,t); \
    { float a=MX3(C0[0],C0[1],C1[0]),b=MX3(C0[2],C0[3],C1[1]); a=MX3(a,C1[2],C1[3]); \
      _Pragma("unroll") for(int r=4;r<16;r+=4){a=MX3(a,C0[r],C0[r+1]);b=MX3(b,C0[r+2],C0[r+3]);a=MX3(a,C1[r],C1[r+1]);b=MX3(b,C1[r+2],C1[r+3]);} \
      float rm=__builtin_fmaxf(a,b); { auto rr=__builtin_amdgcn_permlane32_swap(__float_as_uint(rm),__float_as_uint(rm),false,false); rm=__builtin_fmaxf(__uint_as_float(rr[0]),__uint_as_float(rr[1])); } \
      resc=false; \
      if(__builtin_expect(__any(rm>(float)THRL),0)){ const float dl=__builtin_fmaxf(rm,0.f); mhat+=dl; \
        _Pragma("unroll") for(int r=0;r<16;++r){C0[r]-=dl;C1[r]-=dl;} \
        _Pragma("unroll") for(int r=0;r<16;++r)negm[r]=-mhat; asm volatile("":"+v"(negm)); \
        const float f=__builtin_amdgcn_exp2f(-dl); l_reg*=f; if(hi==0)wsf[r32]=f; resc=true; } } \
    SBAR(); \
    GAPB(o[0]=__builtin_amdgcn_mfma_f32_32x32x16_bf16(PAF(0),VFR(0),o[0],0,0,0), C0,0); \
    GAPB(o[1]=__builtin_amdgcn_mfma_f32_32x32x16_bf16(PAF(0),VFR(4),o[1],0,0,0), C0,4); \
    KRD(GL,0); GAPB(o[0]=__builtin_amdgcn_mfma_f32_32x32x16_bf16(PAF(1),VFR(1),o[0],0,0,0), C0,8); \
    KRD(GL,1); GAPB(o[1]=__builtin_amdgcn_mfma_f32_32x32x16_bf16(PAF(1),VFR(5),o[1],0,0,0), C0,12); \
    KRD(GL,2); GAPB(o[0]=__builtin_amdgcn_mfma_f32_32x32x16_bf16(PAF(2),VFR(2),o[0],0,0,0), C1,0); \
    KRD(GL,3); GAPB(o[1]=__builtin_amdgcn_mfma_f32_32x32x16_bf16(PAF(2),VFR(6),o[1],0,0,0), C1,4); \
    GAPB(o[0]=__builtin_amdgcn_mfma_f32_32x32x16_bf16(PAF(3),VFR(3),o[0],0,0,0), C1,8); \
    GAPB(o[1]=__builtin_amdgcn_mfma_f32_32x32x16_bf16(PAF(3),VFR(7),o[1],0,0,0), C1,12); \
    }while(0)
  int t=1;
  for(;t+5<NT;t+=2){
    STEP(pB0,pB1,pA0,pA1,t,true,true,true);     WAIT_BAR(2); RESC(); ROT();
    STEP(pA0,pA1,pB0,pB1,t+1,true,true,true);   WAIT_BAR(2); RESC(); ROT();
  }
  #define ENDW(tt) do{ if((tt)+3<NT){WAIT_BAR(2);} else if((tt)+2<NT){WAIT_BAR(1);} else {WAIT_BAR(0);} }while(0)
  for(;t+1<NT;t+=2){
    STEP(pB0,pB1,pA0,pA1,t,(t+3<NT),(t+1<NT),(t+1<NT));       ENDW(t);   RESC(); ROT();
    STEP(pA0,pA1,pB0,pB1,t+1,(t+4<NT),(t+2<NT),(t+2<NT));     ENDW(t+1); RESC(); ROT();
  }
  STEP(pB0,pB1,pA0,pA1,NT-1,false,false,false); RESC();
  { float sacc=pB0[0]+pB0[1]; _Pragma("unroll") for(int r=2;r<16;++r)sacc+=pB0[r]; _Pragma("unroll") for(int r=0;r<16;++r)sacc+=pB1[r]; l_reg+=sacc;
    pw0=(u32x4){PKW(pB0,0),PKW(pB0,2),PKW(pB0,4),PKW(pB0,6)};pw1=(u32x4){PKW(pB0,8),PKW(pB0,10),PKW(pB0,12),PKW(pB0,14)};pw2=(u32x4){PKW(pB1,0),PKW(pB1,2),PKW(pB1,4),PKW(pB1,6)};pw3=(u32x4){PKW(pB1,8),PKW(pB1,10),PKW(pB1,12),PKW(pB1,14)};
    SBAR(); pv(o,vb0+sl_cur,PAF(0),PAF(1),PAF(2),PAF(3)); }
  #undef PKW
  #undef PAF
  #undef VFR
  #undef PIN
  #undef MX3
  #undef GAPA
  #undef GAPB
  #undef EX
  #undef VRD
  #undef KRD
  #undef STEP
  #undef ENDW
  {auto rr=__builtin_amdgcn_permlane32_swap(__float_as_uint(l_reg),__float_as_uint(l_reg),false,false);l_reg=__uint_as_float(rr[0])+__uint_as_float(rr[1]);}
  if(hi==0)wsf[32+r32]=l_reg;asm volatile("s_waitcnt lgkmcnt(0)":::"memory");
  float rli[16];
  #pragma unroll
  for(int r=0;r<16;++r)rli[r]=__builtin_amdgcn_rcpf(wsf[32+crow(r,hi)]);
  bf16*Ow=Ou+(long)(wid*QBLK)*OP;
  { bf16*stg=(bf16*)(shm+LDS_OST)+wid*2048;
    #pragma unroll
    for(int r=0;r<16;++r){const int orow=crow(r,hi);
      #pragma unroll
      for(int d0=0;d0<2;++d0)stg[orow*64+d0*32+r32]=__float2bfloat16(o[d0][r]*rli[r]);}
    asm volatile("s_waitcnt lgkmcnt(0)":::"memory");
    #pragma unroll
    for(int i=0;i<4;++i){const int row=i*8+(lane>>3),ch=lane&7; const u32x4 v=*(const u32x4*)(stg+row*64+ch*8); ATTN_STORE16(Ow+(long)row*OP+ch*8,v);} }
  asm volatile("s_waitcnt lgkmcnt(0)\n\ts_barrier":::"memory");
  #undef DMA_K
  #undef DMA_V
  #undef CMASK
  #undef START
  #undef RESC
  #undef ROT
}
constexpr int ATTN_LDS_BYTES=LDS_BYTES;
#undef SBAR
#undef WAIT_BAR
}


namespace hyf {
struct c32 { float x, y; };
typedef _Float16 h2 __attribute__((ext_vector_type(2)));
__device__ __forceinline__ c32 operator+(c32 a, c32 b) { return {a.x + b.x, a.y + b.y}; }
__device__ __forceinline__ c32 operator-(c32 a, c32 b) { return {a.x - b.x, a.y - b.y}; }
__device__ __forceinline__ c32 cmul(c32 a, c32 b) { return {a.x * b.x - a.y * b.y, a.x * b.y + a.y * b.x}; }
__device__ __forceinline__ constexpr float C32(int k) {
  switch (k) { case 0: return 1.f; case 1: return 0.98078528f; case 2: return 0.923879533f; case 3: return 0.831469612f; case 4: return 0.707106781f; case 5: return 0.555570233f; case 6: return 0.382683432f;
    case 7: return 0.195090322f; case 8: return 0.f; case 9: return -0.195090322f; case 10: return -0.382683432f; case 11: return -0.555570233f; case 12: return -0.707106781f; case 13: return -0.831469612f;
    case 14: return -0.923879533f; default: return -0.98078528f; } }
__device__ __forceinline__ constexpr float S32(int k) {
  switch (k) { case 0: return 0.f; case 1: return 0.195090322f; case 2: return 0.382683432f; case 3: return 0.555570233f; case 4: return 0.707106781f; case 5: return 0.831469612f; case 6: return 0.923879533f;
    case 7: return 0.98078528f; case 8: return 1.f; case 9: return 0.98078528f; case 10: return 0.923879533f; case 11: return 0.831469612f; case 12: return 0.707106781f; case 13: return 0.555570233f;
    case 14: return 0.382683432f; default: return 0.195090322f; } }
__device__ __forceinline__ constexpr int brev(int q, int bits) {
  return bits == 4 ? (((q & 1) << 3) | ((q & 2) << 1) | ((q & 4) >> 1) | ((q & 8) >> 3))
                   : (((q & 1) << 4) | ((q & 2) << 2) | (q & 4) | ((q & 8) >> 2) | ((q & 16) >> 4)); }
__device__ __forceinline__ int phys(int p) { return p + (p >> 5); }
template <int R, int HALF, bool INV> struct DftStage {
  static __device__ __forceinline__ void run(c32 (&x)[R]) {
#pragma unroll
    for (int blk = 0; blk < R; blk += 2 * HALF) {
#pragma unroll
      for (int j = 0; j < HALF; ++j) {
        const c32 a = x[blk + j], b = x[blk + j + HALF]; x[blk + j] = a + b; const c32 d = a - b;
        const int e = j * (R / (2 * HALF)) * (32 / R);
        if (e == 0) x[blk + j + HALF] = d;
        else if (e == 8) x[blk + j + HALF] = INV ? (c32){-d.y, d.x} : (c32){d.y, -d.x};
        else { const c32 wv = {C32(e), INV ? S32(e) : -S32(e)}; x[blk + j + HALF] = cmul(d, wv); }
      } }
    DftStage<R, HALF / 2, INV>::run(x);
  }
};
template <int R, bool INV> struct DftStage<R, 0, INV> { static __device__ __forceinline__ void run(c32 (&)[R]) {} };
template <int R, bool INV> __device__ __forceinline__ void dft_pow2(c32 (&x)[R]) { DftStage<R, R / 2, INV>::run(x); }
template <int R, int HALF> struct DitStage {
  static __device__ __forceinline__ void run(c32 (&x)[R]) {
#pragma unroll
    for (int blk = 0; blk < R; blk += 2 * HALF) {
#pragma unroll
      for (int j = 0; j < HALF; ++j) {
        const int e = j * (R / (2 * HALF)) * (32 / R);
        const c32 a = x[blk + j], b0 = x[blk + j + HALF];
        c32 b;
        if (e == 0) b = b0; else if (e == 8) b = (c32){-b0.y, b0.x}; else b = cmul(b0, (c32){C32(e), S32(e)});
        x[blk + j] = a + b; x[blk + j + HALF] = a - b;
      } }
    DitStage<R, HALF * 2>::run(x);
  }
};
template <int R> struct DitStage<R, R> { static __device__ __forceinline__ void run(c32 (&)[R]) {} };
template <int R> __device__ __forceinline__ void idft_dit(c32 (&x)[R]) { DitStage<R, 1>::run(x); }
template <int STRIDE, bool INV> __device__ __forceinline__ void pass16(c32* buf, int e0, float rev) {
  float rv = rev; asm volatile("" : "+v"(rv));
  const float cs = __builtin_amdgcn_cosf(rv), sn = __builtin_amdgcn_sinf(rv);
  const c32 w1 = {cs, INV ? sn : -sn};
  c32* p = buf + phys(e0); constexpr int PS = STRIDE + STRIDE / 32;
  c32 x[16];
  if (!INV) {
#pragma unroll
    for (int m = 0; m < 16; ++m) x[m] = p[PS * m];
    dft_pow2<16, false>(x);
    c32 w = w1; p[0] = x[0];
#pragma unroll
    for (int q = 1; q < 16; ++q) { p[PS * q] = cmul(x[brev(q, 4)], w); w = cmul(w, w1); }
  } else {
    c32 w = w1; x[0] = p[0];
#pragma unroll
    for (int q = 1; q < 16; ++q) { x[q] = cmul(p[PS * q], w); w = cmul(w, w1); }
    dft_pow2<16, true>(x);
#pragma unroll
    for (int m = 0; m < 16; ++m) p[PS * m] = x[brev(m, 4)];
  }
}
template <int MODE> __device__ __forceinline__ void mid32(c32* buf, h2* Hs, int j) {
  c32* p = buf + 33 * j; c32 x[32];
#pragma unroll
  for (int m = 0; m < 32; ++m) x[m] = p[m];
  dft_pow2<32, false>(x);
  if (MODE == 0) {
#pragma unroll
    for (int q = 0; q < 32; ++q) { const c32 v = x[brev(q, 5)]; Hs[q * 256 + j] = (h2){(_Float16)v.x, (_Float16)v.y}; }
  } else {
#pragma unroll
    for (int pp = 0; pp < 32; ++pp) { const h2 hv = Hs[brev(pp, 5) * 256 + j]; x[pp] = cmul(x[pp], (c32){(float)hv.x, (float)hv.y}); }
    idft_dit<32>(x);
#pragma unroll
    for (int m = 0; m < 32; ++m) p[m] = x[m];
  }
}
__device__ __forceinline__ void fwd2(c32* buf, int tid) {
  __syncthreads(); pass16<512, false>(buf, tid, (float)tid * (1.0f / 8192.0f));
  __syncthreads(); pass16<32, false>(buf, (tid >> 5) * 512 + (tid & 31), (float)(tid & 31) * (1.0f / 512.0f));
  __syncthreads();
}
__device__ __forceinline__ void conv(c32* buf, h2* Hs, int tid) {
  fwd2(buf, tid);
  if (tid < 256) mid32<1>(buf, Hs, tid);
  __syncthreads(); pass16<32, true>(buf, (tid >> 5) * 512 + (tid & 31), (float)(tid & 31) * (1.0f / 512.0f));
  __syncthreads(); pass16<512, true>(buf, tid, (float)tid * (1.0f / 8192.0f));
  __syncthreads();
}
__device__ __forceinline__ void item(int c, const bf16_t* HYT, const float* HK, const float* hy_bias, bf16_t* HYO, char* lds) {
  c32* buf = (c32*)lds; h2* H0 = (h2*)(lds + 67584); h2* H1 = H0 + 8192;
  const int tid = TIDX;
#pragma unroll 1
  for (int o = 0; o < 2; ++o) {
    const float* kp = HK + ((size_t)o * 256 + c) * 8192;
#pragma unroll
    for (int i = 0; i < 16; ++i) { const int n = tid + 512 * i; buf[phys(n)] = (c32){kp[n], 0.f}; }
    fwd2(buf, tid);
    if (tid < 256) mid32<0>(buf, o ? H1 : H0, tid);
    __syncthreads();
  }
  const float bias0 = hy_bias[c], bias1 = hy_bias[256 + c];
#pragma unroll 1
  for (int pr = 0; pr < 2; ++pr) {
    const bf16_t* v0 = HYT + ((size_t)(2 * pr) * 768 + c) * SEQ; const bf16_t* v1 = v0 + (size_t)768 * SEQ;
    c32 vv[8];
#pragma unroll
    for (int i = 0; i < 8; ++i) { const int t = tid + 512 * i; vv[i] = (c32){bf2f(v0[t]), bf2f(v1[t])}; buf[phys(t)] = vv[i]; buf[phys(t + 4096)] = (c32){0.f, 0.f}; }
    conv(buf, H0, tid);
#pragma unroll
    for (int i = 0; i < 8; ++i) { const int t = tid + 512 * i; const c32 y = buf[phys(t)];
      vv[i] = (c32){bf2f(v0[(size_t)256 * SEQ + t]) * (y.x * (1.0f / 8192.0f) + bias0 * vv[i].x), bf2f(v1[(size_t)256 * SEQ + t]) * (y.y * (1.0f / 8192.0f) + bias0 * vv[i].y)};
      buf[phys(t)] = vv[i]; buf[phys(t + 4096)] = (c32){0.f, 0.f}; }
    conv(buf, H1, tid);
#pragma unroll
    for (int i = 0; i < 8; ++i) { const int t = tid + 512 * i; const c32 y = buf[phys(t)];
      HYO[((size_t)(2 * pr) * 256 + c) * SEQ + t] = (bf16_t)f2bf(bf2f(v0[(size_t)512 * SEQ + t]) * (y.x * (1.0f / 8192.0f) + bias1 * vv[i].x));
      HYO[((size_t)(2 * pr + 1) * 256 + c) * SEQ + t] = (bf16_t)f2bf(bf2f(v1[(size_t)512 * SEQ + t]) * (y.y * (1.0f / 8192.0f) + bias1 * vv[i].y)); }
    __syncthreads();
  }
}
__device__ __forceinline__ void out_item(int it, const bf16_t* HYO, bf16_t* MIX, char* lds) {
  bf16_t (*T)[72] = (bf16_t (*)[72])lds;
  const int tid = TIDX, b = it >> 8, t0 = ((it >> 2) & 63) * 64, c0 = (it & 3) * 64;
  { const int cc = tid >> 3, t8 = (tid & 7) * 8; *(u32x4*)&T[cc][t8] = *(const u32x4*)(HYO + ((size_t)b * 256 + c0 + cc) * SEQ + t0 + t8); }
  __syncthreads();
  { const int tl = tid >> 3, c8 = (tid & 7) * 8; u32x4 o;
    o.x = (unsigned)T[c8][tl] | ((unsigned)T[c8 + 1][tl] << 16); o.y = (unsigned)T[c8 + 2][tl] | ((unsigned)T[c8 + 3][tl] << 16);
    o.z = (unsigned)T[c8 + 4][tl] | ((unsigned)T[c8 + 5][tl] << 16); o.w = (unsigned)T[c8 + 6][tl] | ((unsigned)T[c8 + 7][tl] << 16);
    *(u32x4*)(MIX + ((size_t)b * TPB + CTXL + t0 + tl) * DM + 768 + c0 + c8) = o; }
  __syncthreads();
}
}

#define LAS __attribute__((address_space(3)))
#define XB_TMO      128
#define XB_XCNT(j)  (256  + 64 * (j))
#define XB_XSUB(j)  (1280 + 64 * (j))
#define XB_XGEN(j)  (2304 + 64 * (j))
#define XB_TOP      3328
#define XB_TOPGEN   3392
#define XCD_BAR_WORDS 3456
#define XB_SPIN_CAP (1u << 18)

__device__ __forceinline__ unsigned xb_ld(unsigned* p)              { return __hip_atomic_load(p, __ATOMIC_RELAXED, __HIP_MEMORY_SCOPE_AGENT); }
__device__ __forceinline__ unsigned xb_add(unsigned* p, unsigned v) { return __hip_atomic_fetch_add(p, v, __ATOMIC_RELAXED, __HIP_MEMORY_SCOPE_AGENT); }
__device__ __forceinline__ unsigned xb_xcc_id() { return (unsigned)__builtin_amdgcn_s_getreg((3 << 11) | 20) & 0xFu; }
#define XB_SPIN(cond, bar) do { unsigned _sp = 0; while (cond) { __builtin_amdgcn_s_sleep(1); \
    if ((++_sp & 255u) == 0u) { if (xb_ld(&(bar)[XB_TMO])) break; if (_sp > XB_SPIN_CAP) { atomicAdd(&(bar)[XB_TMO], 1u); break; } } } } while (0)

struct XcdBarrier {
    unsigned* bar; unsigned x;
    volatile LAS unsigned* st;
};

__device__ __forceinline__ XcdBarrier xcd_barrier_post(unsigned* bar, volatile LAS unsigned* st) {
    XcdBarrier b; b.bar = bar; b.x = xb_xcc_id(); b.st = st;
    if (threadIdx.x == 0) (void)xb_add(&bar[XB_XCNT(b.x)], 1u);
    return b;
}
__device__ __forceinline__ void xcd_barrier_complete(unsigned* bar, unsigned x, unsigned& nloc, unsigned& nx) {
    const unsigned G = gridDim.x * gridDim.y * gridDim.z;
    unsigned sum, cnt, mine, sp = 0u;
    for (;;) {
        sum = 0u; cnt = 0u; mine = 0u;
#pragma unroll
        for (unsigned j = 0; j < 16; ++j) { const unsigned c = xb_ld(&bar[XB_XCNT(j)]); sum += c; cnt += (c > 0u) ? 1u : 0u; mine = (j == x) ? c : mine; }
        if (sum == G) break;
        __builtin_amdgcn_s_sleep(1);
        if ((++sp & 255u) == 0u) { if (xb_ld(&bar[XB_TMO])) break; if (sp > XB_SPIN_CAP) { atomicAdd(&bar[XB_TMO], 1u); break; } }
    }
    nloc = mine > 0u ? mine : 1u; nx = cnt > 0u ? cnt : 1u;
}

__device__ __forceinline__ void xcd_barrier(const XcdBarrier& b) {
    asm volatile("s_waitcnt vmcnt(0)" ::: "memory");
    __syncthreads();
    if (threadIdx.x == 0) {
        unsigned* bar = b.bar;
        __builtin_amdgcn_s_waitcnt(0);
        unsigned nloc = b.st[0], nx = b.st[1];
        if (nloc == 0u) { xcd_barrier_complete(bar, b.x, nloc, nx); b.st[0] = nloc; b.st[1] = nx; }
        const unsigned old = xb_add(&bar[XB_XSUB(b.x)], 1u);
        const unsigned gen = old / nloc;
        if (old + 1u == (gen + 1u) * nloc) {
            __builtin_amdgcn_fence(__ATOMIC_RELEASE, "agent");
            asm volatile("s_waitcnt vmcnt(0)" ::: "memory");
            const unsigned og = xb_add(&bar[XB_TOP], 1u);
            const unsigned tg = og / nx;
            if (og + 1u == (tg + 1u) * nx) xb_add(&bar[XB_TOPGEN], 1u);
            else XB_SPIN(xb_ld(&bar[XB_TOPGEN]) == tg, bar);
            __builtin_amdgcn_fence(__ATOMIC_ACQUIRE, "agent");
            xb_add(&bar[XB_XGEN(b.x)], 1u);
            asm volatile("s_waitcnt vmcnt(0)" ::: "memory");
        } else {
            XB_SPIN(xb_ld(&bar[XB_XGEN(b.x)]) == gen, bar);
            __builtin_amdgcn_fence(__ATOMIC_ACQUIRE, "agent");
            asm volatile("s_waitcnt vmcnt(0)" ::: "memory");
        }
    }
    __syncthreads();
}


struct MP { const float* in[33]; float* out; unsigned char* ws; };
typedef const float* const __attribute__((address_space(4))) * kargs_t;
#define KARGS() ({ kargs_t k_ = (kargs_t)__builtin_amdgcn_kernarg_segment_ptr(); asm volatile("" : "+s"(k_)); k_; })
#define WSP(K, off) ((unsigned char*)(K)[34] + (off))

__global__ void __launch_bounds__(NT, 2) mega(MP P) {
  cg::grid_group grid = cg::this_grid();
  extern __shared__ __attribute__((aligned(16))) char lds[];
  volatile LAS unsigned* xst = (volatile LAS unsigned*)(lds + LDS_BYTES - 16);
  if (threadIdx.x < 2) xst[threadIdx.x] = 0u;
  __syncthreads();
  { kargs_t K = KARGS(); (void)xcd_barrier_post((unsigned*)WSP(K, WS_CTL) + CT_BAR, xst); }
constexpr int CUT = 0;
#define XBAR_HERE() do { kargs_t Kb_ = KARGS(); XcdBarrier xb_; xb_.bar = (unsigned*)WSP(Kb_, WS_CTL) + CT_BAR; xb_.x = xb_xcc_id(); xb_.st = (volatile LAS unsigned*)(lds + LDS_BYTES - 16); xcd_barrier(xb_); } while (0)
#define SEAM() do { XBAR_HERE(); if (CUT > 0 && pass_ == 0 && ++nph_ == CUT) { pass_ = 1; goto again_; } } while (0)
  {
    kargs_t K = KARGS();
    st_adaln(K[1], K[3], K[4], K[5], (float*)WSP(K, WS_MODV), lds);
    st_rope((float*)WSP(K, WS_ROPE));
  }
  {
      kargs_t K = KARGS();
      st_weights(K[8], K[26], K[29], K[30], K[31], 0, (bf16_t*)WSP(K, WS_WIN), (bf16_t*)WSP(K, WS_WOUT), (bf16_t*)WSP(K, WS_WGU), (bf16_t*)WSP(K, WS_WD), lds);
    }
    { kargs_t K = KARGS(); const int bid = BIDX, G = GDIM;
      for (int it = bid; it < SEQ / 16; it += G) hyfilt_item<SEQ>(it, K[19] + 0 * 33 * 64, K[20] + 0 * 64, K[21] + 0 * 64, K[22] + 0 * 4096, K[23] + 0 * 64, K[24] + (size_t)0 * 65536, (float*)WSP(K, WS_HK), lds);
      if (true) for (int it = bid; it < CTXL / 16; it += G) hyfilt_item<CTXL>(it, K[19] + 0 * 33 * 64, K[20] + 0 * 64, K[21] + 0 * 64, K[22] + 0 * 4096, K[23] + 0 * 64, K[24] + (size_t)0 * 65536, (float*)WSP(K, WS_HKC), lds);
    }
  if (gridDim.x == 0x7fffffffu) grid.sync();
  XBAR_HERE();
  int pass_ = 0, nph_ = 0;
again_:
#pragma nounroll
  for (int layer = 0; layer < 2; ++layer) {
    const bool last = layer == 1;
    if (layer == 1) {
    {
      kargs_t K = KARGS();
      st_weights(K[8], K[26], K[29], K[30], K[31], layer, (bf16_t*)WSP(K, WS_WIN), (bf16_t*)WSP(K, WS_WOUT), (bf16_t*)WSP(K, WS_WGU), (bf16_t*)WSP(K, WS_WD), lds);
    }
    { kargs_t K = KARGS(); const int bid = BIDX, G = GDIM;
      for (int it = bid; it < SEQ / 16; it += G) hyfilt_item<SEQ>(it, K[19] + layer * 33 * 64, K[20] + layer * 64, K[21] + layer * 64, K[22] + layer * 4096, K[23] + layer * 64, K[24] + (size_t)layer * 65536, (float*)WSP(K, WS_HK), lds);
      if (!last) for (int it = bid; it < CTXL / 16; it += G) hyfilt_item<CTXL>(it, K[19] + layer * 33 * 64, K[20] + layer * 64, K[21] + layer * 64, K[22] + layer * 4096, K[23] + layer * 64, K[24] + (size_t)layer * 65536, (float*)WSP(K, WS_HKC), lds);
    }
    }
    { kargs_t K = KARGS();
      const float* xl_src = layer == 0 ? K[0] : K[33]; const float* xc_src = layer == 0 ? K[2] : (const float*)WSP(K, WS_XC);
      st_normmod(xl_src, xc_src, K[6] + layer * 1024, (const float*)WSP(K, WS_MODV) + (size_t)layer * 5 * 6144, 0, 1024, (bf16_t*)WSP(K, WS_H), lds);
    }
    SEAM();
    {
      kargs_t K = KARGS();
      pg8::Gemm g{1024, 1024, 1024}; SchedDense S{MTOK / 256, NPAD / 256, (int)GDIM, BIDX, 0, (const char*)WSP(K, WS_H), (const char*)WSP(K, WS_WIN), (size_t)256 * 1024 * 2, (size_t)256 * 1024 * 2};
      EpiInProj E{(bf16_t*)WSP(K, WS_QK), (bf16_t*)WSP(K, WS_VZ), (bf16_t*)WSP(K, WS_XBC), (bf16_t*)WSP(K, WS_HY), (float*)WSP(K, WS_DT)};
      pg8::gemm_phase<EpiInProj, SchedDense, true, true>((PG8_LAS unsigned char*)lds, g, S, E);
    }
    SEAM();
    {
      kargs_t K = KARGS();
      st_prep_qk((bf16_t*)WSP(K, WS_QK), K[9] + layer * 64, K[10] + layer * 64, (const float*)WSP(K, WS_ROPE));
    }
    { kargs_t K = KARGS();
      st_prep_hy((const bf16_t*)WSP(K, WS_HY), K[17] + layer * 3 * 768, K[18] + layer * 768, (bf16_t*)WSP(K, WS_HYT), last ? 0 : 1, lds);
    }
    { kargs_t K = KARGS(); const int bid = BIDX, G = GDIM;
      for (int it = bid; it < 4 * 34 * 6; it += G)
        ssd1_item(it, (const bf16_t*)WSP(K, WS_XBC), (const float*)WSP(K, WS_DT), K[11] + layer * 3 * 640, K[12] + layer * 640, K[13] + layer * 12, K[14] + layer * 12,
                  (float*)WSP(K, WS_Y), (float*)WSP(K, WS_ST), (float*)WSP(K, WS_DEC), lds);
    }
    SEAM();
    {
      { kargs_t K2 = KARGS(); st_ssd_scan2((float*)WSP(K2, WS_ST), (const float*)WSP(K2, WS_DEC)); }
      const int bid = BIDX, G = GDIM;
#define P4_ATT(bb, hq, qrow_, nt_) do { kargs_t K = KARGS(); const int kvh_ = (hq) / 3; \
          const attn_body::bf16* QKp = (const attn_body::bf16*)WSP(K, WS_QK); const attn_body::bf16* VZp = (const attn_body::bf16*)WSP(K, WS_VZ); \
          attn_body::attn_unit<8>(QKp + (size_t)(qrow_) * 512 + (hq) * 64, QKp + (size_t)(bb) * TPB * 512 + 384 + kvh_ * 64, VZp + (size_t)(bb) * TPB * 512 + kvh_ * 64, \
                                  (attn_body::bf16*)WSP(K, WS_H) + (size_t)(qrow_) * 1024 + (hq) * 64, (nt_), lds); } while (0)
#define P4_FFT(cch) do { kargs_t K = KARGS(); hyf::item((cch), (const bf16_t*)WSP(K, WS_HYT), (const float*)WSP(K, WS_HK), K[25] + layer * 512, (bf16_t*)WSP(K, WS_HY), lds); } while (0)
#define P4_CHY(itm) do { kargs_t K = KARGS(); hyconv_ctx_item((itm), (const bf16_t*)WSP(K, WS_HYT) + (size_t)4 * 768 * SEQ, (const float*)WSP(K, WS_HKC), K[25] + layer * 512, (bf16_t*)WSP(K, WS_H), lds); } while (0)
      {
        const int x = bid & 7, y = bid >> 3, bb = x >> 1, kvh = x & 1;
        const int nun = y < 16 ? 2 : 1, natt = nun + ((!last && y < 3) ? 1 : 0);
#pragma unroll 1
        for (int k = 0; k < natt; ++k) { int hq, qrow, nt;
          if (k < nun) { const int v = y < 16 ? y + 16 * k : 16 + y; hq = 3 * kvh + (v >> 4); qrow = bb * TPB + CTXL + (v & 15) * 256; nt = TPB / 64; }
          else { hq = 3 * kvh + y; qrow = bb * TPB; nt = CTXL / 64; }
          P4_ATT(bb, hq, qrow, nt); }
        if (y >= 16) {
#pragma unroll 1
          for (int k = 0; k < 2; ++k) { const int cch = ((y - 16) * 8 + x) * 2 + k; P4_FFT(cch); } }
        if (!last && y >= 3 && y < 11) { P4_CHY((y - 3) * 8 + x); }
      }
      (void)G;
#undef P4_ATT
#undef P4_FFT
#undef P4_CHY
    }
    SEAM();
    {
      kargs_t K = KARGS();
      { const int bid = BIDX, G = GDIM, nit = last ? 4 * 32 * 2 : 4 * 34 * 2;
        for (int it = bid; it < nit; it += G) { const int g = it & 1, bc = it >> 1; const int b = last ? bc >> 5 : bc / 34, cidx = last ? 2 + (bc & 31) : bc % 34;
          ssd3_item(b, cidx, g, (const bf16_t*)WSP(K, WS_XBC), (const bf16_t*)WSP(K, WS_VZ), (const float*)WSP(K, WS_DT), K[11] + layer * 3 * 640, K[12] + layer * 640, K[13] + layer * 12, K[14] + layer * 12,
                    K[15] + layer * 6, K[16] + layer * 384, (const float*)WSP(K, WS_Y), (const float*)WSP(K, WS_ST), (bf16_t*)WSP(K, WS_H), lds); } }
      { const int bid = BIDX, G = GDIM; for (int it = bid; it < 1024; it += G) hyf::out_item(it, (const bf16_t*)WSP(K, WS_HY), (bf16_t*)WSP(K, WS_H), lds); }
      const int t = TIDX; if (BIDX == 0 && t < 256) ((int*)WSP(K, WS_CTL))[t] = 0;
      { int* stok = (int*)WSP(K, WS_MOEM + 384 * 1024); for (int i = BIDX * NT + t; i < MOE_ROWS; i += GDIM * NT) stok[i] = -1; }
    }
    SEAM();
    {
      kargs_t K = KARGS();
      const float* xl_src = layer == 0 ? K[0] : K[33]; const float* xc_src = layer == 0 ? K[2] : (const float*)WSP(K, WS_XC);
      pg8::Gemm g{1024, 1024, 1024}; SchedDense S{last ? 64 : 68, 4, (int)GDIM, BIDX, last ? 1 : 0, (const char*)WSP(K, WS_H), (const char*)WSP(K, WS_WOUT), (size_t)256 * 1024 * 2, (size_t)256 * 1024 * 2};
      EpiOutProj E{xl_src, xc_src, (float*)K[33], (float*)WSP(K, WS_XC), (const float*)WSP(K, WS_MODV) + (size_t)layer * 5 * 6144 + 2048};
      pg8::gemm_phase<EpiOutProj, SchedDense, true, true>((PG8_LAS unsigned char*)lds, g, S, E);
    }
    SEAM();
    {
      kargs_t K = KARGS();
      st_router(K[33], (const float*)WSP(K, WS_XC), K[7] + layer * 1024, (const float*)WSP(K, WS_MODV) + (size_t)layer * 5 * 6144, K[27], K[28], (bf16_t*)WSP(K, WS_H), (int*)WSP(K, WS_CTL),
                (int*)WSP(K, WS_MOEM), (float*)WSP(K, WS_MOEM + 128 * 1024), last ? 1 : 0, lds);
    }
    SEAM();
    { kargs_t K = KARGS();
      st_moe_gather((const bf16_t*)WSP(K, WS_H), (bf16_t*)WSP(K, WS_H2S), (int*)WSP(K, WS_CTL), (const int*)WSP(K, WS_MOEM), (const float*)WSP(K, WS_MOEM + 128 * 1024),
                    (int*)WSP(K, WS_MOEM + 384 * 1024), (float*)WSP(K, WS_MOEM + 512 * 1024), last ? 1 : 0, lds);
    }
    SEAM();
    { kargs_t K = KARGS();
      pg8::Gemm g{1024, 1024, 1024}; SchedMoe S{(int)GDIM, BIDX, 1, (const int*)WSP(K, WS_CTL), (const char*)WSP(K, WS_H2S), (size_t)256 * 1024 * 2, (const char*)WSP(K, WS_WGU)};
      EpiMoe1 E{(bf16_t*)WSP(K, WS_ACT), (const float*)WSP(K, WS_MOEM + 512 * 1024)};
      pg8::gemm_phase<EpiMoe1, SchedMoe, true, true>((PG8_LAS unsigned char*)lds, g, S, E);
    }
    SEAM();
    { kargs_t K = KARGS();
      pg8::Gemm g{256, 512, 256}; SchedMoe S{(int)GDIM, BIDX, 2, (const int*)WSP(K, WS_CTL), (const char*)WSP(K, WS_ACT), (size_t)256 * 512 * 2, (const char*)WSP(K, WS_WD)};
      EpiMoe2 E{(float*)K[33], (float*)WSP(K, WS_XC), (const float*)WSP(K, WS_MODV) + (size_t)layer * 5 * 6144 + 5120, (const int*)WSP(K, WS_MOEM + 384 * 1024)};
      pg8::gemm_phase<EpiMoe2, SchedMoe, true, true>((PG8_LAS unsigned char*)lds, g, S, E);
    }
    SEAM();
  }
  { kargs_t K = KARGS(); st_final((float*)K[33], K[32]); }
}

extern "C" void kernel_launch(void* const* d_in, const int* in_sizes, int n_in, void* d_out, int out_size, void* d_ws, size_t ws_size, hipStream_t stream) {
  if (n_in != 33 || ws_size < WS_END) { fprintf(stderr, "kernel_launch: unexpected n_in %d / ws %zu\n", n_in, ws_size); return; }
  static int grid_blocks = 0;
  if (!grid_blocks) {
    int dev = 0, cus = 0, per_cu = 0;
    (void)hipGetDevice(&dev);
    (void)hipDeviceGetAttribute(&cus, hipDeviceAttributeMultiprocessorCount, dev);
    (void)hipFuncSetAttribute((const void*)mega, hipFuncAttributeMaxDynamicSharedMemorySize, LDS_BYTES);
    (void)hipOccupancyMaxActiveBlocksPerMultiprocessor(&per_cu, mega, NT, LDS_BYTES);
    if (per_cu < 1) per_cu = 1;
    if (per_cu > 2) per_cu = 2;
    grid_blocks = 256;
    if (cus != 256 || per_cu < 1) fprintf(stderr, "kernel_launch: expected 256 CUs with >= 1 workgroup each (got %d CUs, %d per CU)\n", cus, per_cu);
  }
  (void)hipMemsetAsync((char*)d_ws + WS_CTL + (size_t)CT_BAR * 4, 0, (size_t)XCD_BAR_WORDS * 4, stream);
  MP p{};
  for (int i = 0; i < 33; ++i) p.in[i] = (const float*)d_in[i];
  p.out = (float*)d_out; p.ws = (unsigned char*)d_ws;
  void* args[] = {&p};
  hipError_t e = hipLaunchCooperativeKernel((const void*)mega, dim3(grid_blocks), dim3(NT), args, LDS_BYTES, stream);
  if (e != hipSuccess) fprintf(stderr, "cooperative launch failed: %s (grid %d)\n", hipGetErrorString(e), grid_blocks);
}
```

```cpp
#include <hip/hip_runtime.h>
#include <hip/hip_cooperative_groups.h>
#include <cstdio>
#include <cstdint>
namespace cg = cooperative_groups;

typedef unsigned short bf16_t;
typedef short bf16x8 __attribute__((ext_vector_type(8)));
typedef float f32x4 __attribute__((ext_vector_type(4)));
typedef unsigned u32x4 __attribute__((ext_vector_type(4)));
typedef unsigned u32x2 __attribute__((ext_vector_type(2)));

constexpr int NB = 4, SEQ = 4096, CTXL = 256, DM = 1024, TPB = 4352, MTOK = NB * TPB;
constexpr int DIN = 2444, NPAD = 2560;
constexpr float EPS = 1e-6f;
constexpr float C2 = 0.125f * 1.4426950408889634f;
constexpr int MOE_ROWS = 23552;
constexpr int NT = 512;
constexpr int LDS_BYTES = 147456;

constexpr size_t MiB = 1u << 20;
constexpr size_t WS_CTL = 0;
constexpr size_t WS_MODV = 1 * MiB;
constexpr size_t WS_ROPE = 2 * MiB;
constexpr size_t WS_MOEM = 3 * MiB;
constexpr size_t WS_DT = 4 * MiB;
constexpr size_t WS_HKC = 5 * MiB;
constexpr size_t WS_XC = 6 * MiB;
constexpr size_t WS_WIN = 10 * MiB;
constexpr size_t WS_WOUT = 15 * MiB;
constexpr size_t WS_WGU = 17 * MiB;
constexpr size_t WS_WD = 33 * MiB;
constexpr size_t WS_HK = 41 * MiB;
constexpr size_t WS_H = 57 * MiB;
constexpr size_t WS_QK = 91 * MiB;
constexpr size_t WS_VZ = 108 * MiB;
constexpr size_t WS_XBC = 125 * MiB;
constexpr size_t WS_HY = WS_XBC + (size_t)MTOK * 768 * 2;
constexpr size_t WS_HYT = WS_HY + (size_t)MTOK * 768 * 2;
constexpr size_t WS_ST = WS_HYT + (size_t)MTOK * 768 * 2;
constexpr size_t WS_Y = WS_ST + (size_t)4 * 34 * 2 * 6 * 4096 * 4;
constexpr size_t WS_END = WS_Y + (size_t)MTOK * 384 * 4;
constexpr size_t WS_DEC = WS_DT + 900 * 1024;
constexpr size_t WS_H2S = WS_QK;
constexpr size_t WS_ACT = WS_H2S + (size_t)MOE_ROWS * 1024 * 2;
static_assert(WS_END <= 256 * MiB, "ws");
static_assert(WS_ACT + (size_t)MOE_ROWS * 512 * 2 <= WS_HYT, "moe alias");

constexpr int CT_CNT = 0, CT_FILL = 32, CT_BASE = 64, CT_NT = 96, CT_TP = 128;
constexpr int CT_BAR = 4096;
constexpr int CT_CNTB = 8192;

__device__ __forceinline__ int opq_v(int v) { asm volatile("" : "+v"(v)); return v; }
__device__ __forceinline__ int opq_s(int v) { asm volatile("" : "+s"(v)); return v; }
#define TIDX opq_v((int)threadIdx.x)
#define BIDX opq_s((int)blockIdx.x)
#define GDIM opq_s((int)gridDim.x)
__device__ __forceinline__ unsigned f2bf(float f) { unsigned u = __float_as_uint(f); return (u + 0x7fffu + ((u >> 16) & 1u)) >> 16; }
__device__ __forceinline__ unsigned pk2bf(float lo, float hi) { return f2bf(lo) | (f2bf(hi) << 16); }
__device__ __forceinline__ float bf2f(bf16_t h) { return __uint_as_float(((unsigned)h) << 16); }
__device__ __forceinline__ float wave_sum(float v) {
#pragma unroll
  for (int o = 1; o < 64; o <<= 1) v += __shfl_xor(v, o);
  return v;
}
__device__ __forceinline__ float siluf(float v) { return v / (1.0f + __expf(-v)); }
__device__ __forceinline__ float* xrow(const float* xl, const float* xc, int r) {
  const int b = r / TPB, j = r - b * TPB;
  return (float*)(j < CTXL ? xc + ((size_t)b * CTXL + j) * DM : xl + ((size_t)b * SEQ + (j - CTXL)) * DM);
}
__device__ __forceinline__ int mrow_of(int r) { const int b = r / TPB, j = r - b * TPB; return j < CTXL ? 4 : b; }

__device__ __forceinline__ void st_adaln(const float* c, const float* c_ctx, const float* w_mod, const float* b_mod, float* modv, char* lds) {
  float (*sc)[1024] = (float (*)[1024])lds;
  float (*red)[5][64] = (float (*)[5][64])(lds + 5 * 1024 * 4);
  const int tid = TIDX;
  for (int it = BIDX; it < 192; it += GDIM) {
    const int layer = it / 96, n0 = (it % 96) * 64;
    for (int i = tid; i < 5 * 1024; i += NT) { const int r = i >> 10, k = i & 1023; const float v = r < 4 ? c[r * 1024 + k] : c_ctx[k]; sc[r][k] = v / (1.0f + expf(-v)); }
    __syncthreads();
    const int kg = tid >> 6, n = tid & 63;
    float acc[5] = {0.f, 0.f, 0.f, 0.f, 0.f};
#pragma unroll 16
    for (int k = kg; k < 1024; k += 8) { const float w = w_mod[((size_t)layer * 1024 + k) * 6144 + n0 + n];
#pragma unroll
      for (int r = 0; r < 5; ++r) acc[r] += sc[r][k] * w; }
#pragma unroll
    for (int r = 0; r < 5; ++r) red[kg][r][n] = acc[r];
    __syncthreads();
    if (tid < 320) { const int r = tid >> 6, nn = tid & 63; float s = 0.f;
#pragma unroll
      for (int g = 0; g < 8; ++g) s += red[g][r][nn];
      modv[((size_t)layer * 5 + r) * 6144 + n0 + nn] = s + b_mod[layer * 6144 + n0 + nn]; }
    __syncthreads();
  }
}
__device__ __forceinline__ void st_rope(float* rope) {
  for (int i = BIDX * NT + TIDX; i < 4096 * 32; i += GDIM * NT) {
    const int t = i >> 5, d = i & 31, m = d & 15;
    const float inv = powf(10000.0f, -(float)(2 * m) / 32.0f);
    const float pos = (float)(d < 16 ? (t >> 6) : (t & 63));
    const float ang = pos * inv;
    rope[2 * i] = cosf(ang); rope[2 * i + 1] = sinf(ang);
  }
}

__device__ __forceinline__ void st_normmod(const float* xl, const float* xc, const float* g, const float* modv_layer, int off_sh, int off_sc, bf16_t* H, char* lds) {
  float* mA = (float*)lds; float* mB = mA + 5 * 1024;
  const int tid = TIDX, lane = tid & 63, gw = BIDX * 8 + (tid >> 6), ngw = GDIM * 8;
  for (int idx = tid; idx < 5 * 1024; idx += NT) { const int m = idx >> 10, k = idx & 1023; mA[idx] = g[k] * (1.f + modv_layer[(size_t)m * 6144 + off_sc + k]); mB[idx] = modv_layer[(size_t)m * 6144 + off_sh + k]; }
  __syncthreads();
  for (int rb = gw; rb < MTOK; rb += 3 * ngw) {
    f32x4 v[3][4]; float rstd[3];
#pragma unroll
    for (int u = 0; u < 3; ++u) { const int r = rb + u * ngw; const float* xr = xrow(xl, xc, r < MTOK ? r : MTOK - 1);
#pragma unroll
      for (int j = 0; j < 4; ++j) v[u][j] = *(const f32x4*)(xr + 4 * lane + 256 * j); }
#pragma unroll
    for (int u = 0; u < 3; ++u) { float ss = 0.f;
#pragma unroll
      for (int j = 0; j < 4; ++j) ss += v[u][j].x * v[u][j].x + v[u][j].y * v[u][j].y + v[u][j].z * v[u][j].z + v[u][j].w * v[u][j].w;
      rstd[u] = rsqrtf(wave_sum(ss) * (1.0f / DM) + EPS); }
#pragma unroll
    for (int u = 0; u < 3; ++u) { const int r = rb + u * ngw;
      if (r < MTOK) { const int mo = mrow_of(r) * 1024;
#pragma unroll
        for (int j = 0; j < 4; ++j) { const int k = 4 * lane + 256 * j;
          const f32x4 a4 = *(const f32x4*)(mA + mo + k), b4 = *(const f32x4*)(mB + mo + k); const f32x4 o = v[u][j] * rstd[u] * a4 + b4;
          u32x2 w; w.x = pk2bf(o.x, o.y); w.y = pk2bf(o.z, o.w);
          *(u32x2*)(H + (size_t)r * DM + k) = w; } } }
  }
  __syncthreads();
}

template <int MODE> __device__ __forceinline__ void tr_tile(const float* src, const float* src2, int ldsrc, int K, bf16_t* out, int n0, int k0, char* lds) {
  float (*tile)[65] = (float (*)[65])lds;
  const int tid = TIDX;
#pragma unroll
  for (int i = 0; i < 8; ++i) { const int kk = (tid >> 6) + 8 * i, nn = tid & 63, n = n0 + nn; float v = 0.f;
    if (MODE == 0) { const int col = n < 1676 ? n : (n < 1792 ? -1 : n - 116); if (col >= 0) v = src[(size_t)(k0 + kk) * ldsrc + col]; }
    else if (MODE == 1) { v = src[(size_t)(k0 + kk) * ldsrc + n]; }
    else { v = (n & 1) ? src2[(size_t)(k0 + kk) * ldsrc + (n >> 1)] : src[(size_t)(k0 + kk) * ldsrc + (n >> 1)]; }
    tile[kk][nn] = v; }
  __syncthreads();
#pragma unroll
  for (int i = 0; i < 4; ++i) { const int nn = (tid >> 5) + 16 * i, kk = (tid & 31) * 2;
    *(unsigned*)(out + (size_t)(n0 + nn) * K + k0 + kk) = f2bf(tile[kk][nn]) | (f2bf(tile[kk + 1][nn]) << 16); }
  __syncthreads();
}
template <int MODE> __device__ __forceinline__ void tr_wave_item(const float* src, const float* src2, int ldsrc, int K, bf16_t* out, int n0, int k0, float* scr, int lane) {
  const int nn = lane & 31, n = n0 + nn;
#pragma unroll 8
  for (int i = 0; i < 32; ++i) { const int kk = 2 * i + (lane >> 5); float v = 0.f;
    if (MODE == 0) { const int col = n < 1676 ? n : (n < 1792 ? -1 : n - 116); if (col >= 0) v = src[(size_t)(k0 + kk) * ldsrc + col]; }
    else if (MODE == 1) v = src[(size_t)(k0 + kk) * ldsrc + n];
    else v = (n & 1) ? src2[(size_t)(k0 + kk) * ldsrc + (n >> 1)] : src[(size_t)(k0 + kk) * ldsrc + (n >> 1)];
    scr[kk * 33 + nn] = v; }
  asm volatile("s_waitcnt lgkmcnt(0)" ::: "memory");
  const int c = lane & 7;
#pragma unroll
  for (int j = 0; j < 4; ++j) { const int nr = (lane >> 3) + 8 * j; const float* sp = scr + (8 * c) * 33 + nr;
    u32x4 o; o.x = f2bf(sp[0]) | (f2bf(sp[33]) << 16); o.y = f2bf(sp[66]) | (f2bf(sp[99]) << 16); o.z = f2bf(sp[132]) | (f2bf(sp[165]) << 16); o.w = f2bf(sp[198]) | (f2bf(sp[231]) << 16);
    *(u32x4*)(out + (size_t)(n0 + nr) * K + k0 + 8 * c) = o; }
  asm volatile("s_waitcnt lgkmcnt(0)" ::: "memory");
}
__device__ __forceinline__ void st_weights(const float* w_in, const float* w_out, const float* w_gate, const float* w_up, const float* w_down, int layer,
                                           bf16_t* WIN, bf16_t* WOUT, bf16_t* WGU, bf16_t* WD, char* lds) {
  const int tid = TIDX, lane = tid & 63, w = tid >> 6; float* scr = (float*)lds + w * (64 * 33);
  for (int it = BIDX * 8 + w; it < 7936; it += GDIM * 8) {
    if (it < 1280) tr_wave_item<0>(w_in + (size_t)layer * 1024 * DIN, nullptr, DIN, 1024, WIN, (it % 80) * 32, (it / 80) * 64, scr, lane);
    else if (it < 1792) { const int i2 = it - 1280; tr_wave_item<1>(w_out + (size_t)layer * 1024 * 1024, nullptr, 1024, 1024, WOUT, (i2 & 31) * 32, (i2 >> 5) * 64, scr, lane); }
    else if (it < 5888) { const int i2 = it - 1792, e = i2 >> 8, t = i2 & 255;
      tr_wave_item<2>(w_gate + ((size_t)layer * 16 + e) * 1024 * 256, w_up + ((size_t)layer * 16 + e) * 1024 * 256, 256, 1024, WGU + (size_t)e * 512 * 1024, (t & 15) * 32, (t >> 4) * 64, scr, lane); }
    else { const int i2 = it - 5888, e = i2 >> 7, t = i2 & 127;
      tr_wave_item<1>(w_down + ((size_t)layer * 16 + e) * 256 * 1024, nullptr, 1024, 256, WD + (size_t)e * 1024 * 256, (t & 31) * 32, (t >> 5) * 64, scr, lane); }
  }
  __syncthreads();
}

template <class P> __device__ __forceinline__ void st_gemm(const P& p, int ntm, int ntn, char* lds) {
  bf16_t (*As)[72] = (bf16_t (*)[72])lds;
  bf16_t (*Bs)[72] = (bf16_t (*)[72])(lds + 256 * 72 * 2);
  const int tid = TIDX, lane = tid & 63, w = tid >> 6;
  for (int it = BIDX; it < ntm * ntn; it += GDIM) {
    const int mt = it / ntn, nt = it % ntn;
    if (!p.valid(mt)) continue;
    const int m0 = mt * 256, n0 = nt * 128;
    f32x4 acc[2][8];
#pragma unroll
    for (int a = 0; a < 2; ++a)
#pragma unroll
      for (int b = 0; b < 8; ++b) acc[a][b] = (f32x4){0.f, 0.f, 0.f, 0.f};
    const int K = p.K;
    for (int k0 = 0; k0 < K; k0 += 64) {
#pragma unroll
      for (int i = 0; i < 4; ++i) { const int ch = tid + NT * i, r = ch >> 3, kc = (ch & 7) * 8;
        const bf16_t* ap = p.arow(m0 + r); *(u32x4*)&As[r][kc] = *(const u32x4*)(ap + k0 + kc); }
#pragma unroll
      for (int i = 0; i < 2; ++i) { const int ch = tid + NT * i, r = ch >> 3, kc = (ch & 7) * 8;
        const bf16_t* bp = p.brow(mt, n0 + r, k0); *(u32x4*)&Bs[r][kc] = *(const u32x4*)(bp + kc); }
      __syncthreads();
#pragma unroll
      for (int kk = 0; kk < 2; ++kk) {
        bf16x8 a[2], b[8];
#pragma unroll
        for (int mi = 0; mi < 2; ++mi) a[mi] = *(const bf16x8*)&As[32 * w + 16 * mi + (lane & 15)][kk * 32 + 8 * (lane >> 4)];
#pragma unroll
        for (int ni = 0; ni < 8; ++ni) b[ni] = *(const bf16x8*)&Bs[16 * ni + (lane & 15)][kk * 32 + 8 * (lane >> 4)];
#pragma unroll
        for (int mi = 0; mi < 2; ++mi)
#pragma unroll
          for (int ni = 0; ni < 8; ++ni) acc[mi][ni] = __builtin_amdgcn_mfma_f32_16x16x32_bf16(a[mi], b[ni], acc[mi][ni], 0, 0, 0);
      }
      __syncthreads();
    }
    p.epi(acc, mt, m0, n0, w, lane);
  }
}

struct PInProj {
  const bf16_t* H; const bf16_t* W; bf16_t *QK, *VZ, *XBC, *HY; float* DT; int K;
  __device__ bool valid(int) const { return true; }
  __device__ const bf16_t* arow(int m) const { return H + (size_t)m * DM; }
  __device__ const bf16_t* brow(int, int n, int k0) const { return W + (size_t)n * DM + k0; }
  __device__ void epi(const f32x4 (&acc)[2][8], int, int m0, int n0, int w, int lane) const {
#pragma unroll
    for (int mi = 0; mi < 2; ++mi)
#pragma unroll
      for (int ni = 0; ni < 8; ++ni)
#pragma unroll
        for (int rg = 0; rg < 4; ++rg) { const int row = m0 + 32 * w + 16 * mi + 4 * (lane >> 4) + rg, col = n0 + 16 * ni + (lane & 15); const float v = acc[mi][ni][rg];
          if (col < 512) QK[(size_t)row * 512 + col] = (bf16_t)f2bf(v);
          else if (col < 1024) VZ[(size_t)row * 512 + col - 512] = (bf16_t)f2bf(v);
          else if (col < 1792) { XBC[(size_t)row * 768 + col - 1024] = (bf16_t)f2bf(v); if (col >= 1664 && col < 1676) DT[(size_t)row * 12 + col - 1664] = v; }
          else HY[(size_t)row * 768 + col - 1792] = (bf16_t)f2bf(v); }
  }
};
struct POutProj {
  const bf16_t* A; const bf16_t* W; const float *xl_src, *xc_src; float *xl_dst, *xc_dst; const float* gate;   int skip_ctx; int K;
  __device__ bool valid(int mt) const { return !(skip_ctx && ((mt * 256) % TPB) < CTXL); }
  __device__ const bf16_t* arow(int m) const { return A + (size_t)m * DM; }
  __device__ const bf16_t* brow(int, int n, int k0) const { return W + (size_t)n * DM + k0; }
  __device__ void epi(const f32x4 (&acc)[2][8], int, int m0, int n0, int w, int lane) const {
#pragma unroll
    for (int mi = 0; mi < 2; ++mi)
#pragma unroll
      for (int rg = 0; rg < 4; ++rg) { const int row = m0 + 32 * w + 16 * mi + 4 * (lane >> 4) + rg;
        const float* xs = xrow(xl_src, xc_src, row); float* xd = xrow(xl_dst, xc_dst, row); const float* gt = gate + (size_t)mrow_of(row) * 6144;
#pragma unroll
        for (int ni = 0; ni < 8; ++ni) { const int col = n0 + 16 * ni + (lane & 15); xd[col] = xs[col] + gt[col] * acc[mi][ni][rg]; } }
  }
};
__device__ __forceinline__ void pair_experts(int pidx, int& eA, int& eB) {
  const int g = pidx / 6, t = pidx - 6 * g; const int i = t < 3 ? 0 : (t < 5 ? 1 : 2); const int j = t < 3 ? t + 1 : (t < 5 ? t - 1 : 3);
  eA = 4 * g + i; eB = 4 * g + j;
}
struct PMoe1 {
  const bf16_t* H2S; const bf16_t* WGU; bf16_t* ACT; const int* ctl; const float* sorted_w; int K;
  __device__ bool valid(int mt) const { return mt < ctl[CT_NT]; }
  __device__ const bf16_t* arow(int m) const { return H2S + (size_t)m * DM; }
  __device__ const bf16_t* brow(int mt, int n, int k0) const { int eA, eB; pair_experts(ctl[CT_TP + mt], eA, eB); const int e = n < 512 ? eA : eB;
    return WGU + ((size_t)e * 512 + (n & 511)) * DM + k0; }
  __device__ void epi(const f32x4 (&acc)[2][8], int, int m0, int n0, int w, int lane) const {
    const int half = n0 >> 9, tb = (n0 & 511) >> 7;
#pragma unroll
    for (int mi = 0; mi < 2; ++mi)
#pragma unroll
      for (int rg = 0; rg < 4; ++rg) { const int slot = m0 + 32 * w + 16 * mi + 4 * (lane >> 4) + rg; const float wt = sorted_w[2 * slot + half];
#pragma unroll
        for (int ni = 0; ni < 4; ++ni) { const float g = acc[mi][ni][rg], u = acc[mi][ni + 4][rg]; const int j = 64 * tb + 16 * ni + (lane & 15);
          ACT[(size_t)slot * 512 + half * 256 + j] = (bf16_t)f2bf(siluf(g) * u * wt); } }
  }
};
struct PMoe2 {
  const bf16_t* ACT; const bf16_t* WD; float *xl, *xc; const float* gate;   const int* ctl; const int* sorted_tok; int K;
  __device__ bool valid(int mt) const { return mt < ctl[CT_NT]; }
  __device__ const bf16_t* arow(int m) const { return ACT + (size_t)m * 512; }
  __device__ const bf16_t* brow(int mt, int n, int k0) const { int eA, eB; pair_experts(ctl[CT_TP + mt], eA, eB); const int e = k0 < 256 ? eA : eB;
    return WD + ((size_t)e * 1024 + n) * 256 + (k0 & 255); }
  __device__ void epi(const f32x4 (&acc)[2][8], int, int m0, int n0, int w, int lane) const {
#pragma unroll
    for (int mi = 0; mi < 2; ++mi)
#pragma unroll
      for (int rg = 0; rg < 4; ++rg) { const int slot = m0 + 32 * w + 16 * mi + 4 * (lane >> 4) + rg; const int r = sorted_tok[slot];
        if (r >= 0) { float* xd = xrow(xl, xc, r); const float* gt = gate + (size_t)mrow_of(r) * 6144;
#pragma unroll
          for (int ni = 0; ni < 8; ++ni) { const int col = n0 + 16 * ni + (lane & 15); xd[col] += gt[col] * acc[mi][ni][rg]; } } }
  }
};

__device__ __forceinline__ void st_prep_qk(bf16_t* QK, const float* qn, const float* kn, const float* rope) {
  const int lane = TIDX & 63, gw = BIDX * 8 + (TIDX >> 6), ngw = GDIM * 8, hh = lane >> 3, sub = lane & 7;
  float gn[8];
#pragma unroll
  for (int e = 0; e < 8; ++e) gn[e] = ((hh < 6 ? qn : kn) + sub * 8)[e] * (hh < 6 ? C2 : 1.0f);
  for (int rb = gw; rb < MTOK; rb += 3 * ngw) {
    bf16x8 raw[3]; f32x4 rp4[3][4];
#pragma unroll
    for (int u = 0; u < 3; ++u) { const int r = rb + u * ngw < MTOK ? rb + u * ngw : MTOK - 1; const int j = r % TPB, t = j >= CTXL ? j - CTXL : 0;
      raw[u] = *(const bf16x8*)(QK + (size_t)r * 512 + hh * 64 + sub * 8);
      const float* rp = rope + ((size_t)t * 32 + (sub & 3) * 8) * 2;
#pragma unroll
      for (int q = 0; q < 4; ++q) rp4[u][q] = *(const f32x4*)(rp + 4 * q); }
#pragma unroll
    for (int u = 0; u < 3; ++u) { const int r = rb + u * ngw; const int j = (r < MTOK ? r : MTOK - 1) % TPB;
      float v[8]; float ss = 0.f;
#pragma unroll
      for (int e = 0; e < 8; ++e) { v[e] = bf2f((bf16_t)raw[u][e]); ss += v[e] * v[e]; }
      ss += __shfl_xor(ss, 1); ss += __shfl_xor(ss, 2); ss += __shfl_xor(ss, 4);
      const float rstd = rsqrtf(ss * (1.0f / 64.0f) + EPS);
#pragma unroll
      for (int e = 0; e < 8; ++e) v[e] = v[e] * rstd * gn[e];
      if (j >= CTXL) {
#pragma unroll
        for (int e = 0; e < 8; ++e) { const float other = __shfl_xor(v[e], 4); const float cs = rp4[u][e >> 1][(e & 1) * 2], sn = rp4[u][e >> 1][(e & 1) * 2 + 1]; v[e] = sub < 4 ? v[e] * cs - other * sn : v[e] * cs + other * sn; } }
      if (r < MTOK) *(u32x4*)(QK + (size_t)r * 512 + hh * 64 + sub * 8) = (u32x4){pk2bf(v[0], v[1]), pk2bf(v[2], v[3]), pk2bf(v[4], v[5]), pk2bf(v[6], v[7])}; }
  }
}

__device__ __forceinline__ void st_prep_hy(const bf16_t* HY, const float* cw, const float* cb, bf16_t* HYT, int do_ctx, char* lds) {
  const int tid = TIDX, lane = tid & 63, w = tid >> 6; float* tile = (float*)lds + w * (66 * 33);
  const int nlat = 4 * 64 * 24, nitem = nlat + (do_ctx ? 4 * 4 * 24 : 0);
  for (int it = BIDX * 8 + w; it < nitem; it += GDIM * 8) {
    int b, tt, ct, L, joff; bf16_t* outb;
    if (it < nlat) { b = it / 1536; tt = (it % 1536) / 24; ct = it % 24; L = SEQ; joff = CTXL; outb = HYT + (size_t)b * 768 * SEQ; }
    else { const int i2 = it - nlat; b = i2 / 96; tt = (i2 % 96) / 24; ct = i2 % 24; L = CTXL; joff = 0; outb = HYT + (size_t)4 * 768 * SEQ + (size_t)b * 768 * CTXL; }
    const int t0 = tt * 64, c0 = ct * 32;
#pragma unroll
    for (int i = 0; i < 5; ++i) { const int rr = (lane >> 2) + 16 * i, c8 = (lane & 3) * 8, t = t0 - 1 + rr;
      if (rr < 66) { bf16x8 v = (bf16x8){0, 0, 0, 0, 0, 0, 0, 0};
        if (t >= 0 && t < L) v = *(const bf16x8*)(HY + ((size_t)b * TPB + joff + t) * 768 + c0 + c8);
#pragma unroll
        for (int e = 0; e < 8; ++e) tile[rr * 33 + c8 + e] = bf2f((bf16_t)v[e]); } }
    asm volatile("s_waitcnt lgkmcnt(0)" ::: "memory");
#pragma unroll 4
    for (int cc = 0; cc < 32; ++cc) { const int c = c0 + cc;
      const float v = cw[c] * tile[lane * 33 + cc] + cw[768 + c] * tile[(lane + 1) * 33 + cc] + cw[1536 + c] * tile[(lane + 2) * 33 + cc] + cb[c];
      outb[(size_t)c * L + t0 + lane] = (bf16_t)f2bf(v); }
    asm volatile("s_waitcnt lgkmcnt(0)" ::: "memory");
  }
  __syncthreads();
}

template <int L> __device__ __forceinline__ void hyfilt_item(int item, const float* w1, const float* b1, const float* fr, const float* w2, const float* b2, const float* w3, float* HK, char* lds) {
  float* S0 = (float*)lds; float* S1 = S0 + 64 * 64; float* S2 = S1 + 64 * 68;
  const int tid = TIDX, n0 = (item >> 2) * 64, cq = item & 3, lane = tid & 63, wv = tid >> 6;
  for (int e = tid; e < 64 * 33; e += NT) { const int pp = e / 33, f = e % 33; const int n = n0 + pp; float v;
    if (f == 0) v = (float)n / (float)(L - 1);
    else { const int m = (f - 1) & 15; const float band = 1e-4f + (float)m * ((15.0f - 1e-4f) / 15.0f); const float wpos = (6.283185307179586f / (float)L) * (float)n;
      v = f <= 16 ? cosf(wpos * band) : -sinf(wpos * band); }
    S0[pp * 33 + f] = v; }
  for (int e = tid; e < 33 * 64; e += NT) S1[e] = w1[e];
  __syncthreads();
  for (int e = tid; e < 64 * 64; e += NT) { const int pp = e >> 6, j = e & 63; float a = b1[j];
    for (int f = 0; f < 33; ++f) a += S0[pp * 33 + f] * S1[f * 64 + j];
    S2[pp * 64 + j] = sinf(fr[j] * a); }
  __syncthreads();
  for (int e = tid; e < 64 * 64; e += NT) S0[e] = w2[e];
  __syncthreads();
  for (int e = tid; e < 64 * 64; e += NT) { const int pp = e >> 6, j = e & 63; float a = b2[j];
    for (int f = 0; f < 64; ++f) a += S2[pp * 64 + f] * S0[f * 64 + j];
    S1[pp * 68 + j] = sinf(fr[j] * a); }
  __syncthreads();
  {
    const int l15 = lane & 15, l4 = lane >> 4, colb = cq * 256 + 32 * wv;
    f32x4 acc[4][2];
#pragma unroll
    for (int pt = 0; pt < 4; ++pt) { acc[pt][0] = (f32x4){0.f, 0.f, 0.f, 0.f}; acc[pt][1] = (f32x4){0.f, 0.f, 0.f, 0.f}; }
#pragma unroll 4
    for (int kk = 0; kk < 16; ++kk) { const int k = 4 * kk + l4;
      const float bv0 = w3[k * 1024 + colb + l15], bv1 = w3[k * 1024 + colb + 16 + l15];
#pragma unroll
      for (int pt = 0; pt < 4; ++pt) { const float av = S1[(pt * 16 + l15) * 68 + k];
        acc[pt][0] = __builtin_amdgcn_mfma_f32_16x16x4f32(av, bv0, acc[pt][0], 0, 0, 0);
        acc[pt][1] = __builtin_amdgcn_mfma_f32_16x16x4f32(av, bv1, acc[pt][1], 0, 0, 0); } }
#pragma unroll
    for (int ct = 0; ct < 2; ++ct) { const int col = colb + 16 * ct + l15, dir = col >> 9, order = (col >> 8) & 1, c = col & 255;
      const float delta = 3.0701134573253943f + (float)c * ((15.350567286626972f - 3.0701134573253943f) / 255.0f);
      float* dst = HK + ((size_t)order * 256 + c) * (2 * L);
#pragma unroll
      for (int pt = 0; pt < 4; ++pt) { const int nb = n0 + pt * 16 + 4 * l4; f32x4 o;
#pragma unroll
        for (int rg = 0; rg < 4; ++rg) o[rg] = acc[pt][ct][rg] * __expf(-((float)(nb + rg) / (float)(L - 1)) * delta);
        if (dir == 0) *(f32x4*)(dst + nb) = o;
        else {
#pragma unroll
          for (int rg = 0; rg < 4; ++rg) { const int n = nb + rg; if (n >= 1) dst[2 * L - n] = o[rg]; else dst[L] = 0.f; } } } }
  }
  __syncthreads();
}

template <int L> __device__ __forceinline__ void hyconv_item(int item, const bf16_t* HYT, const float* HK, const float* hy_bias, bf16_t* MIX, int joff, char* lds) {
  float* kern = (float*)lds; float* z = kern + 2 * L;
  const int tid = TIDX, b = item >> 8, c = item & 255;
  const bf16_t* vp = HYT + ((size_t)b * 768 + c) * L; const bf16_t* x1p = vp + (size_t)256 * L; const bf16_t* x2p = vp + (size_t)512 * L;
  const bool act = tid < L / 8; const int tb = 8 * tid;
  for (int o = 0; o < 2; ++o) {
    if (o == 0) for (int t = tid; t < L; t += NT) z[t] = bf2f(vp[t]);
    const float* kp = HK + ((size_t)o * 256 + c) * (2 * L);
    for (int t = tid; t < 2 * L; t += NT) kern[t] = kp[t];
    __syncthreads();
    float acc[8], W[16];
#pragma unroll
    for (int i = 0; i < 8; ++i) acc[i] = 0.f;
    if (act) {
#pragma unroll
      for (int i = 0; i < 8; ++i) W[8 + i] = kern[(tb + i) & (2 * L - 1)];
      for (int s0 = 0; s0 < L; s0 += 8) {
        const int bb = (tb - s0 - 8) & (2 * L - 1);
#pragma unroll
        for (int i = 0; i < 8; ++i) W[i] = kern[bb + i];
        float zs[8];
#pragma unroll
        for (int j = 0; j < 8; ++j) zs[j] = z[s0 + j];
#pragma unroll
        for (int j = 0; j < 8; ++j)
#pragma unroll
          for (int i = 0; i < 8; ++i) acc[i] += W[8 + i - j] * zs[j];
#pragma unroll
        for (int i = 0; i < 8; ++i) W[8 + i] = W[i];
      }
    }
    __syncthreads();
    const float bias = hy_bias[o * 256 + c];
    if (act) {
#pragma unroll
      for (int i = 0; i < 8; ++i) { const int t = tb + i; const float zz = acc[i] + bias * z[t];
        if (o == 0) z[t] = bf2f(x1p[t]) * zz;
        else MIX[((size_t)b * TPB + joff + t) * DM + 768 + c] = (bf16_t)f2bf(bf2f(x2p[t]) * zz); }
    }
    __syncthreads();
  }
}

__device__ __forceinline__ void hyconv_ctx_item(int item, const bf16_t* HYTC, const float* HKC, const float* hy_bias, bf16_t* MIX, char* lds) {
  constexpr int L = CTXL;
  const int tid = TIDX, b = item >> 4, cc = tid >> 5, c = (item & 15) * 16 + cc, sub = tid & 31, tb = 8 * sub;
  float* kern = (float*)lds + cc * (2 * L); float* z = (float*)lds + 16 * 2 * L + cc * L;
  const bf16_t* vp = HYTC + ((size_t)b * 768 + c) * L; const bf16_t* x1p = vp + (size_t)256 * L; const bf16_t* x2p = vp + (size_t)512 * L;
#pragma unroll 1
  for (int o = 0; o < 2; ++o) {
    if (o == 0) for (int t = sub; t < L; t += 32) z[t] = bf2f(vp[t]);
    const float* kp = HKC + ((size_t)o * 256 + c) * (2 * L);
    for (int t = sub; t < 2 * L; t += 32) kern[t] = kp[t];
    __syncthreads();
    float acc[8], W[16];
#pragma unroll
    for (int i = 0; i < 8; ++i) { acc[i] = 0.f; W[8 + i] = kern[(tb + i) & (2 * L - 1)]; }
    for (int s0 = 0; s0 < L; s0 += 8) {
      const int bb = (tb - s0 - 8) & (2 * L - 1);
#pragma unroll
      for (int i = 0; i < 8; ++i) W[i] = kern[bb + i];
      float zs[8];
#pragma unroll
      for (int j = 0; j < 8; ++j) zs[j] = z[s0 + j];
#pragma unroll
      for (int j = 0; j < 8; ++j)
#pragma unroll
        for (int i = 0; i < 8; ++i) acc[i] += W[8 + i - j] * zs[j];
#pragma unroll
      for (int i = 0; i < 8; ++i) W[8 + i] = W[i];
    }
    __syncthreads();
    const float bias = hy_bias[o * 256 + c];
#pragma unroll
    for (int i = 0; i < 8; ++i) { const int t = tb + i; const float zz = acc[i] + bias * z[t];
      if (o == 0) z[t] = bf2f(x1p[t]) * zz;
      else MIX[((size_t)b * TPB + t) * DM + 768 + c] = (bf16_t)f2bf(bf2f(x2p[t]) * zz); }
    __syncthreads();
  }
}

__device__ __forceinline__ void attn_unit_simple(int u, const bf16_t* QK, const bf16_t* VZ, bf16_t* MIX, char* lds) {
  bf16_t (*Ks)[72] = (bf16_t (*)[72])lds;
  bf16_t (*Vt)[72] = (bf16_t (*)[72])(lds + 64 * 72 * 2);
  bf16_t (*Ps)[16][72] = (bf16_t (*)[16][72])(lds + 2 * 64 * 72 * 2);
  const int tid = TIDX, lane = tid & 63, w = tid >> 6;
  int b, h, qrow0, nk;
  if (u < 768) { b = u / 192; const int rem = u % 192; h = rem >> 5; qrow0 = b * TPB + CTXL + (rem & 31) * 128; nk = TPB; }
  else { const int uc = u - 768; b = uc / 12; h = (uc % 12) >> 1; qrow0 = b * TPB + (uc & 1) * 128; nk = CTXL; }
  const int kvh = h / 3, key0 = b * TPB, l15 = lane & 15, l4 = lane >> 4;
  bf16x8 aq[2];
#pragma unroll
  for (int kk = 0; kk < 2; ++kk) aq[kk] = *(const bf16x8*)(QK + (size_t)(qrow0 + 16 * w + l15) * 512 + h * 64 + kk * 32 + 8 * l4);
  f32x4 O[4]; float m[4], l[4];
#pragma unroll
  for (int i = 0; i < 4; ++i) { O[i] = (f32x4){0.f, 0.f, 0.f, 0.f}; m[i] = -1e30f; l[i] = 0.f; }
  for (int kt = 0; kt < nk / 64; ++kt) {
    __syncthreads();
    { const int r = tid >> 3, c8 = (tid & 7) * 8; const size_t grow = (size_t)(key0 + kt * 64 + r) * 512;
      *(u32x4*)&Ks[r][c8] = *(const u32x4*)(QK + grow + 384 + kvh * 64 + c8);
      const bf16x8 vv = *(const bf16x8*)(VZ + grow + kvh * 64 + c8);
#pragma unroll
      for (int e = 0; e < 8; ++e) Vt[c8 + e][r] = (bf16_t)vv[e]; }
    __syncthreads();
    f32x4 s[4];
#pragma unroll
    for (int ni = 0; ni < 4; ++ni) s[ni] = (f32x4){0.f, 0.f, 0.f, 0.f};
#pragma unroll
    for (int kk = 0; kk < 2; ++kk)
#pragma unroll
      for (int ni = 0; ni < 4; ++ni) { const bf16x8 bk = *(const bf16x8*)&Ks[16 * ni + l15][32 * kk + 8 * l4]; s[ni] = __builtin_amdgcn_mfma_f32_16x16x32_bf16(aq[kk], bk, s[ni], 0, 0, 0); }
#pragma unroll
    for (int rg = 0; rg < 4; ++rg) {
      float mx = fmaxf(fmaxf(s[0][rg], s[1][rg]), fmaxf(s[2][rg], s[3][rg]));
      mx = fmaxf(mx, __shfl_xor(mx, 1)); mx = fmaxf(mx, __shfl_xor(mx, 2)); mx = fmaxf(mx, __shfl_xor(mx, 4)); mx = fmaxf(mx, __shfl_xor(mx, 8));
      const float mn = fmaxf(m[rg], mx), alpha = exp2f(m[rg] - mn); float rs = 0.f;
#pragma unroll
      for (int ni = 0; ni < 4; ++ni) { const float pv = exp2f(s[ni][rg] - mn); rs += pv; Ps[w][4 * l4 + rg][16 * ni + l15] = (bf16_t)f2bf(pv); }
      rs += __shfl_xor(rs, 1); rs += __shfl_xor(rs, 2); rs += __shfl_xor(rs, 4); rs += __shfl_xor(rs, 8);
      l[rg] = l[rg] * alpha + rs; m[rg] = mn;
#pragma unroll
      for (int ni = 0; ni < 4; ++ni) O[ni][rg] *= alpha;
    }
    __syncthreads();
#pragma unroll
    for (int kk = 0; kk < 2; ++kk) { const bf16x8 ap = *(const bf16x8*)&Ps[w][l15][32 * kk + 8 * l4];
#pragma unroll
      for (int ni = 0; ni < 4; ++ni) { const bf16x8 bv = *(const bf16x8*)&Vt[16 * ni + l15][32 * kk + 8 * l4]; O[ni] = __builtin_amdgcn_mfma_f32_16x16x32_bf16(ap, bv, O[ni], 0, 0, 0); } }
  }
#pragma unroll
  for (int rg = 0; rg < 4; ++rg) { const float il = 1.0f / l[rg]; const size_t row = (size_t)(qrow0 + 16 * w + 4 * l4 + rg);
#pragma unroll
    for (int ni = 0; ni < 4; ++ni) MIX[row * DM + h * 64 + 16 * ni + l15] = (bf16_t)f2bf(O[ni][rg] * il); }
  __syncthreads();
}

__device__ __forceinline__ void st_ssd_prep(const bf16_t* XBC, float* DT, const float* cw, const float* cb, const float* dt_bias, bf16_t* XBCC) {
  const size_t total = (size_t)MTOK * 640;
  for (size_t i = (size_t)BIDX * NT + TIDX; i < total; i += (size_t)GDIM * NT) {
    const int r = (int)(i / 640), ch = (int)(i % 640), j = r % TPB;
    const bool hasp = (j != 0 && j != CTXL), hasn = (j != CTXL - 1 && j != TPB - 1);
    float v = cw[640 + ch] * bf2f(XBC[(size_t)r * 768 + ch]) + cb[ch];
    if (hasp) v += cw[ch] * bf2f(XBC[(size_t)(r - 1) * 768 + ch]);
    if (hasn) v += cw[1280 + ch] * bf2f(XBC[(size_t)(r + 1) * 768 + ch]);
    XBCC[i] = (bf16_t)f2bf(siluf(v));
  }
  for (size_t i = (size_t)BIDX * NT + TIDX; i < (size_t)MTOK * 12; i += (size_t)GDIM * NT) {
    const float x = DT[i] + dt_bias[i % 12];
    DT[i] = x > 20.f ? x : log1pf(expf(x));
  }
}
__device__ __forceinline__ void ssd_scan_item(int item, const bf16_t* XBCC, const float* DT, const float* a_log, float* Y, char* lds) {
  const int half = TIDX >> 8, tid = TIDX & 255;
  float* base = (float*)(lds + half * 25088);
  float (*xs)[64] = (float (*)[64])base; float (*Bs)[64] = (float (*)[64])(base + 2048); float (*Cs)[64] = (float (*)[64])(base + 4096);
  float* dAs = base + 6144; float* dts = base + 6176;
  const int bh = 2 * item + half, b = bh / 6, h = bh % 6, g = h / 3, p = tid >> 2, q = tid & 3;
  for (int dir = 0; dir < 2; ++dir) {
    const float a = -expf(a_log[dir * 6 + h]);
    float st[16];
#pragma unroll
    for (int n = 0; n < 16; ++n) st[n] = 0.f;
    for (int ci = 0; ci < TPB / 32; ++ci) {
      for (int e = tid; e < 32 * 64; e += 256) { const int i = e >> 6, cc = e & 63, qi = ci * 32 + i;
        const int j = dir == 0 ? qi : (qi < CTXL ? CTXL - 1 - qi : TPB - 1 - (qi - CTXL)); const size_t r = (size_t)b * TPB + j;
        xs[i][cc] = bf2f(XBCC[r * 640 + h * 64 + cc]); Bs[i][cc] = bf2f(XBCC[r * 640 + 384 + g * 64 + cc]); Cs[i][cc] = bf2f(XBCC[r * 640 + 512 + g * 64 + cc]); }
      if (tid < 32) { const int qi = ci * 32 + tid; const int j = dir == 0 ? qi : (qi < CTXL ? CTXL - 1 - qi : TPB - 1 - (qi - CTXL)); const size_t r = (size_t)b * TPB + j;
        const float dt = DT[r * 12 + dir * 6 + h]; dts[tid] = dt; dAs[tid] = expf(dt * a); }
      __syncthreads();
      for (int i = 0; i < 32; ++i) {
        const float d = dAs[i], dtx = dts[i] * xs[i][p]; float y = 0.f;
#pragma unroll
        for (int n = 0; n < 16; ++n) { st[n] = st[n] * d + dtx * Bs[i][16 * q + n]; y += Cs[i][16 * q + n] * st[n]; }
        y += __shfl_xor(y, 1); y += __shfl_xor(y, 2);
        if (q == 0) { const int qi = ci * 32 + i; const int j = dir == 0 ? qi : (qi < CTXL ? CTXL - 1 - qi : TPB - 1 - (qi - CTXL)); float* yp = Y + ((size_t)b * TPB + j) * 384 + h * 64 + p;
          if (dir == 0) *yp = y; else *yp += y; }
      }
      __syncthreads();
    }
  }
}
__device__ __forceinline__ void st_ssd_out(const float* Y, const bf16_t* XBCC, const bf16_t* VZ, const float* dskip, const float* nw, bf16_t* MIX) {
  const int lane = TIDX & 63, gw = BIDX * 8 + (TIDX >> 6), ngw = GDIM * 8;
  for (int it = gw; it < MTOK * 2; it += ngw) {
    const int r = it >> 1, g = it & 1; float gv[3]; float ss = 0.f;
#pragma unroll
    for (int i = 0; i < 3; ++i) { const int c = g * 192 + lane + 64 * i, hh = c >> 6;
      const float y = Y[(size_t)r * 384 + c] + bf2f(XBCC[(size_t)r * 640 + c]) * dskip[hh]; const float zv = bf2f(VZ[(size_t)r * 512 + 128 + c]);
      gv[i] = y * siluf(zv); ss += gv[i] * gv[i]; }
    const float rstd = rsqrtf(wave_sum(ss) * (1.0f / 192.0f) + EPS);
#pragma unroll
    for (int i = 0; i < 3; ++i) { const int c = g * 192 + lane + 64 * i; MIX[(size_t)r * DM + 384 + c] = (bf16_t)f2bf(gv[i] * rstd * nw[c]); }
  }
}


__device__ __forceinline__ void ssd_conv8(const bf16_t* XBC, size_t r, int c0, bool hasp, bool hasn, const float* cw, const float* cb, float (&o)[8]) {
  const bf16x8 cur = *(const bf16x8*)(XBC + r * 768 + c0);
  const bf16x8 prv = *(const bf16x8*)(XBC + (hasp ? r - 1 : r) * 768 + c0), nxt = *(const bf16x8*)(XBC + (hasn ? r + 1 : r) * 768 + c0);
  const float wp = hasp ? 1.f : 0.f, wn = hasn ? 1.f : 0.f;
#pragma unroll
  for (int e = 0; e < 8; ++e) { const float v = wp * cw[c0 + e] * bf2f((bf16_t)prv[e]) + cw[640 + c0 + e] * bf2f((bf16_t)cur[e]) + wn * cw[1280 + c0 + e] * bf2f((bf16_t)nxt[e]) + cb[c0 + e]; o[e] = siluf(v); }
}
__device__ __forceinline__ float softplusf(float x) { return x > 20.f ? x : log1pf(expf(x)); }
__device__ __forceinline__ void wave_scan128(float e0, float e1, int lane, float& c0, float& c1) {
  float x = e0 + e1;
#pragma unroll
  for (int o = 1; o < 64; o <<= 1) { const float v = __shfl_up(x, o); if (lane >= o) x += v; }
  const float excl = x - (e0 + e1); c0 = excl + e0; c1 = excl + e0 + e1;
}
__device__ __forceinline__ int ssd_chunk_j0(int cidx) { return cidx < 2 ? cidx * 128 : CTXL + (cidx - 2) * 128; }

__device__ __forceinline__ void ssd1_item(int item, const bf16_t* XBC, const float* DT, const float* cw, const float* cb, const float* dt_bias, const float* a_log,
                                          float* YIN, float* ST, float* DEC, char* lds) {
  bf16_t (*Cm)[72] = (bf16_t (*)[72])lds; bf16_t (*Bm)[72] = (bf16_t (*)[72])(lds + 18432);
  bf16_t (*BT)[136] = (bf16_t (*)[136])(lds + 36864); bf16_t (*Xt)[136] = (bf16_t (*)[136])(lds + 54272); bf16_t (*Mm)[136] = (bf16_t (*)[136])(lds + 71680);
  float* tab = (float*)(lds + 106496); float* dtf = tab; float* dtb = tab + 128; float* acf = tab + 256; float* acb = tab + 384; float* wf = tab + 512; float* wb = tab + 640;
  const int tid = TIDX, lane = tid & 63, w = tid >> 6, l15 = lane & 15, l4 = lane >> 4;
  const int h = item % 6, bc = item / 6, cidx = bc % 34, b = bc / 34, g = h / 3, j0 = ssd_chunk_j0(cidx);
  const size_t r0 = (size_t)b * TPB + j0;
#pragma unroll 3
  for (int i = 0; i < 6; ++i) { const int task = tid + NT * i, t = task / 24, cg = task % 24, kind = cg >> 3, q = cg & 7, j = j0 + t;
    const int c0 = kind == 0 ? h * 64 + 8 * q : (kind == 1 ? 384 + g * 64 + 8 * q : 512 + g * 64 + 8 * q);
    float o[8]; ssd_conv8(XBC, r0 + t, c0, j != 0 && j != CTXL, j != CTXL - 1 && j != TPB - 1, cw, cb, o);
    if (kind == 0) {
#pragma unroll
      for (int e = 0; e < 8; ++e) Xt[8 * q + e][t] = (bf16_t)f2bf(o[e]);
    } else { const u32x4 pk = (u32x4){pk2bf(o[0], o[1]), pk2bf(o[2], o[3]), pk2bf(o[4], o[5]), pk2bf(o[6], o[7])};
      if (kind == 1) { *(u32x4*)&Bm[t][8 * q] = pk;
#pragma unroll
        for (int e = 0; e < 8; ++e) BT[8 * q + e][t] = (bf16_t)f2bf(o[e]); }
      else *(u32x4*)&Cm[t][8 * q] = pk; } }
  if (w < 2) { const int dir = w; const float a = -expf(a_log[dir * 6 + h]), bias = dt_bias[dir * 6 + h];
    const int t0 = dir == 0 ? 2 * lane : 127 - 2 * lane, t1 = dir == 0 ? 2 * lane + 1 : 126 - 2 * lane;
    const float d0 = softplusf(DT[(r0 + t0) * 12 + dir * 6 + h] + bias), d1 = softplusf(DT[(r0 + t1) * 12 + dir * 6 + h] + bias);
    float c0, c1; wave_scan128(d0 * a, d1 * a, lane, c0, c1);
    const float tot = __shfl(c1, 63);
    float* dtt = dir == 0 ? dtf : dtb; float* ac = dir == 0 ? acf : acb; float* ww = dir == 0 ? wf : wb;
    dtt[t0] = d0; dtt[t1] = d1; ac[t0] = c0; ac[t1] = c1; ww[t0] = __expf(tot - c0) * d0; ww[t1] = __expf(tot - c1) * d1;
    if (lane == 0) DEC[(((size_t)b * 34 + cidx) * 2 + dir) * 6 + h] = __expf(tot); }
  __syncthreads();
  {
    f32x4 accG[8];
#pragma unroll
    for (int ni = 0; ni < 8; ++ni) accG[ni] = (f32x4){0.f, 0.f, 0.f, 0.f};
#pragma unroll
    for (int kk = 0; kk < 2; ++kk) { const bf16x8 a = *(const bf16x8*)&Cm[16 * w + l15][32 * kk + 8 * l4];
#pragma unroll
      for (int ni = 0; ni < 8; ++ni) { const bf16x8 bb = *(const bf16x8*)&Bm[16 * ni + l15][32 * kk + 8 * l4]; accG[ni] = __builtin_amdgcn_mfma_f32_16x16x32_bf16(a, bb, accG[ni], 0, 0, 0); } }
    float aft[4], abt[4];
#pragma unroll
    for (int rg = 0; rg < 4; ++rg) { aft[rg] = acf[16 * w + 4 * l4 + rg]; abt[rg] = acb[16 * w + 4 * l4 + rg]; }
#pragma unroll
    for (int ni = 0; ni < 8; ++ni) { const int sidx = 16 * ni + l15; const float afs = acf[sidx], abs_ = acb[sidx], dfs = dtf[sidx], dbs = dtb[sidx];
#pragma unroll
      for (int rg = 0; rg < 4; ++rg) { const int t = 16 * w + 4 * l4 + rg;
        const float f = sidx <= t ? __expf(aft[rg] - afs) * dfs : 0.f, bk = sidx >= t ? __expf(abt[rg] - abs_) * dbs : 0.f;
        Mm[t][sidx] = (bf16_t)f2bf(accG[ni][rg] * (f + bk)); } }
  }
  __syncthreads();
  {
    f32x4 acc[4];
#pragma unroll
    for (int ni = 0; ni < 4; ++ni) acc[ni] = (f32x4){0.f, 0.f, 0.f, 0.f};
#pragma unroll
    for (int kk = 0; kk < 4; ++kk) { const bf16x8 a = *(const bf16x8*)&Mm[16 * w + l15][32 * kk + 8 * l4];
#pragma unroll
      for (int ni = 0; ni < 4; ++ni) { const bf16x8 bb = *(const bf16x8*)&Xt[16 * ni + l15][32 * kk + 8 * l4]; acc[ni] = __builtin_amdgcn_mfma_f32_16x16x32_bf16(a, bb, acc[ni], 0, 0, 0); } }
#pragma unroll
    for (int rg = 0; rg < 4; ++rg)
#pragma unroll
      for (int ni = 0; ni < 4; ++ni) YIN[(r0 + 16 * w + 4 * l4 + rg) * 384 + h * 64 + 16 * ni + l15] = acc[ni][rg];
  }
  {
    const int dir = w >> 2, mt = w & 3; const float* ww = dir == 0 ? wf : wb;
    f32x4 acc[4];
#pragma unroll
    for (int ni = 0; ni < 4; ++ni) acc[ni] = (f32x4){0.f, 0.f, 0.f, 0.f};
#pragma unroll
    for (int kk = 0; kk < 4; ++kk) { const bf16x8 raw = *(const bf16x8*)&Xt[16 * mt + l15][32 * kk + 8 * l4];
      const f32x4 w0 = *(const f32x4*)(ww + 32 * kk + 8 * l4), w1 = *(const f32x4*)(ww + 32 * kk + 8 * l4 + 4);
      u32x4 pk; pk.x = pk2bf(bf2f((bf16_t)raw[0]) * w0.x, bf2f((bf16_t)raw[1]) * w0.y); pk.y = pk2bf(bf2f((bf16_t)raw[2]) * w0.z, bf2f((bf16_t)raw[3]) * w0.w);
      pk.z = pk2bf(bf2f((bf16_t)raw[4]) * w1.x, bf2f((bf16_t)raw[5]) * w1.y); pk.w = pk2bf(bf2f((bf16_t)raw[6]) * w1.z, bf2f((bf16_t)raw[7]) * w1.w);
      const bf16x8 a = __builtin_bit_cast(bf16x8, pk);
#pragma unroll
      for (int ni = 0; ni < 4; ++ni) { const bf16x8 bb = *(const bf16x8*)&BT[16 * ni + l15][32 * kk + 8 * l4]; acc[ni] = __builtin_amdgcn_mfma_f32_16x16x32_bf16(a, bb, acc[ni], 0, 0, 0); } }
    float* sp = ST + ((((size_t)b * 34 + cidx) * 2 + dir) * 6 + h) * 4096;
#pragma unroll
    for (int rg = 0; rg < 4; ++rg)
#pragma unroll
      for (int ni = 0; ni < 4; ++ni) sp[(16 * mt + 4 * l4 + rg) * 64 + 16 * ni + l15] = acc[ni][rg];
  }
  __syncthreads();
}

__device__ __forceinline__ void st_ssd_scan2(float* ST, const float* DEC) {
  for (int idx = BIDX * NT + TIDX; idx < 4 * 2 * 6 * 4096; idx += GDIM * NT) {
    const int e = idx & 4095, bdh = idx >> 12, h = bdh % 6, dir = (bdh / 6) & 1, b = bdh / 12;
    float v[34], d[34];
#pragma unroll
    for (int st = 0; st < 34; ++st) { const int cidx = dir == 0 ? st : (st < 2 ? 1 - st : 35 - st); const size_t o = (((size_t)b * 34 + cidx) * 2 + dir) * 6 + h; v[st] = ST[o * 4096 + e]; d[st] = DEC[o]; }
    float H = 0.f;
#pragma unroll
    for (int st = 0; st < 34; ++st) { const int cidx = dir == 0 ? st : (st < 2 ? 1 - st : 35 - st); const size_t o = (((size_t)b * 34 + cidx) * 2 + dir) * 6 + h; ST[o * 4096 + e] = H; H = H * d[st] + v[st]; }
  }
}

__device__ __forceinline__ void ssd3_item(int b, int cidx, int g, const bf16_t* XBC, const bf16_t* VZ, const float* DT, const float* cw, const float* cb, const float* dt_bias, const float* a_log,
                                          const float* dskip, const float* nw, const float* YIN, const float* ST, bf16_t* MIX, char* lds) {
  bf16_t (*Cm)[72] = (bf16_t (*)[72])lds; bf16_t (*Hm)[72] = (bf16_t (*)[72])(lds + 18432);
  float* ef = (float*)(lds + 18432 + 55296);
  float (*Yt)[196] = (float (*)[196])lds;
  const int tid = TIDX, lane = tid & 63, w = tid >> 6, l15 = lane & 15, l4 = lane >> 4, j0 = ssd_chunk_j0(cidx);
  const size_t r0 = (size_t)b * TPB + j0;
#pragma unroll
  for (int i = 0; i < 2; ++i) { const int task = tid + NT * i, t = task >> 3, q = task & 7, j = j0 + t;
    float o[8]; ssd_conv8(XBC, r0 + t, 512 + g * 64 + 8 * q, j != 0 && j != CTXL, j != CTXL - 1 && j != TPB - 1, cw, cb, o);
    *(u32x4*)&Cm[t][8 * q] = (u32x4){pk2bf(o[0], o[1]), pk2bf(o[2], o[3]), pk2bf(o[4], o[5]), pk2bf(o[6], o[7])}; }
#pragma unroll
  for (int i = 0; i < 12; ++i) { const int f4 = tid + NT * i, hd = f4 >> 10, rem = f4 & 1023, p = rem >> 4, n4 = (rem & 15) * 4, hh = hd >> 1, dir = hd & 1;
    const f32x4 v = *(const f32x4*)(ST + ((((size_t)b * 34 + cidx) * 2 + dir) * 6 + 3 * g + hh) * 4096 + p * 64 + n4);
    *(u32x2*)&Hm[hd * 64 + p][n4] = (u32x2){pk2bf(v.x, v.y), pk2bf(v.z, v.w)}; }
  if (w < 6) { const int hh = w >> 1, dir = w & 1, h = 3 * g + hh; const float a = -expf(a_log[dir * 6 + h]), bias = dt_bias[dir * 6 + h];
    const int t0 = dir == 0 ? 2 * lane : 127 - 2 * lane, t1 = dir == 0 ? 2 * lane + 1 : 126 - 2 * lane;
    const float d0 = softplusf(DT[(r0 + t0) * 12 + dir * 6 + h] + bias), d1 = softplusf(DT[(r0 + t1) * 12 + dir * 6 + h] + bias);
    float c0, c1; wave_scan128(d0 * a, d1 * a, lane, c0, c1);
    ef[w * 128 + t0] = __expf(c0); ef[w * 128 + t1] = __expf(c1); }
  __syncthreads();
  float yv[3][4][4];
  {
    bf16x8 ca[2];
#pragma unroll
    for (int kk = 0; kk < 2; ++kk) ca[kk] = *(const bf16x8*)&Cm[16 * w + l15][32 * kk + 8 * l4];
#pragma unroll
    for (int hh = 0; hh < 3; ++hh) {
      f32x4 accF[4], accB[4];
#pragma unroll
      for (int ni = 0; ni < 4; ++ni) { accF[ni] = (f32x4){0.f, 0.f, 0.f, 0.f}; accB[ni] = (f32x4){0.f, 0.f, 0.f, 0.f}; }
#pragma unroll
      for (int kk = 0; kk < 2; ++kk)
#pragma unroll
        for (int ni = 0; ni < 4; ++ni) {
          accF[ni] = __builtin_amdgcn_mfma_f32_16x16x32_bf16(ca[kk], *(const bf16x8*)&Hm[(hh * 2 + 0) * 64 + 16 * ni + l15][32 * kk + 8 * l4], accF[ni], 0, 0, 0);
          accB[ni] = __builtin_amdgcn_mfma_f32_16x16x32_bf16(ca[kk], *(const bf16x8*)&Hm[(hh * 2 + 1) * 64 + 16 * ni + l15][32 * kk + 8 * l4], accB[ni], 0, 0, 0); }
#pragma unroll
      for (int rg = 0; rg < 4; ++rg) { const int t = 16 * w + 4 * l4 + rg; const float eF = ef[(hh * 2 + 0) * 128 + t], eB = ef[(hh * 2 + 1) * 128 + t];
#pragma unroll
        for (int ni = 0; ni < 4; ++ni) yv[hh][ni][rg] = eF * accF[ni][rg] + eB * accB[ni][rg]; }
    }
  }
  __syncthreads();
#pragma unroll
  for (int hh = 0; hh < 3; ++hh)
#pragma unroll
    for (int rg = 0; rg < 4; ++rg)
#pragma unroll
      for (int ni = 0; ni < 4; ++ni) Yt[16 * w + 4 * l4 + rg][hh * 64 + 16 * ni + l15] = yv[hh][ni][rg];
  __syncthreads();
  {
    const int c4 = 4 * (lane < 48 ? lane : 47), hk = c4 >> 6; const bool lact = lane < 48;
    float cw0[4], cw1[4], cw2[4], cbv[4], nwv[4];
#pragma unroll
    for (int e = 0; e < 4; ++e) { const int col = g * 192 + c4 + e; cw0[e] = cw[col]; cw1[e] = cw[640 + col]; cw2[e] = cw[1280 + col]; cbv[e] = cb[col]; nwv[e] = nw[col]; }
    const float dsk = dskip[3 * g + hk];
#pragma unroll 1
    for (int rb = 0; rb < 16; rb += 4) {
      u32x2 xc_[4], xp_[4], xn_[4], zz_[4]; f32x4 yy_[4];
#pragma unroll
      for (int u = 0; u < 4; ++u) { const int t = 16 * w + rb + u, j = j0 + t; const size_t r = r0 + t; const bool hasp = j != 0 && j != CTXL, hasn = j != CTXL - 1 && j != TPB - 1;
        const bf16_t* xq = XBC + r * 768 + g * 192 + c4;
        xc_[u] = *(const u32x2*)xq; xp_[u] = *(const u32x2*)(xq + (hasp ? -768 : 0)); xn_[u] = *(const u32x2*)(xq + (hasn ? 768 : 0));
        yy_[u] = *(const f32x4*)(YIN + r * 384 + g * 192 + c4); zz_[u] = *(const u32x2*)(VZ + r * 512 + 128 + g * 192 + c4); }
#pragma unroll
      for (int u = 0; u < 4; ++u) { const int t = 16 * w + rb + u, j = j0 + t; const size_t r = r0 + t; const float wp = (j != 0 && j != CTXL) ? 1.f : 0.f, wn = (j != CTXL - 1 && j != TPB - 1) ? 1.f : 0.f;
        const f32x4 yt = *(const f32x4*)&Yt[t][c4];
        float gt[4]; float ss = 0.f;
#pragma unroll
        for (int e = 0; e < 4; ++e) { const unsigned sh = (e & 1) * 16; const unsigned wc_ = e < 2 ? xc_[u].x : xc_[u].y, wq_ = e < 2 ? xp_[u].x : xp_[u].y, wn_ = e < 2 ? xn_[u].x : xn_[u].y, wz_ = e < 2 ? zz_[u].x : zz_[u].y;
          float xv = cw1[e] * bf2f((bf16_t)(wc_ >> sh)) + cbv[e] + wp * cw0[e] * bf2f((bf16_t)(wq_ >> sh)) + wn * cw2[e] * bf2f((bf16_t)(wn_ >> sh));
          xv = siluf(xv);
          const float y = yy_[u][e] + yt[e] + dsk * xv;
          gt[e] = lact ? y * siluf(bf2f((bf16_t)(wz_ >> sh))) : 0.f; ss += gt[e] * gt[e]; }
        const float rstd = rsqrtf(wave_sum(ss) * (1.0f / 192.0f) + EPS);
        if (lact) { u32x2 o; o.x = pk2bf(gt[0] * rstd * nwv[0], gt[1] * rstd * nwv[1]); o.y = pk2bf(gt[2] * rstd * nwv[2], gt[3] * rstd * nwv[3]);
          *(u32x2*)(MIX + r * DM + 384 + g * 192 + c4) = o; } }
    }
  }
  __syncthreads();
}

__device__ __forceinline__ void st_router(const float* xl, const float* xc, const float* g, const float* modv_layer, const float* w_router, const float* rbias,
                                          bf16_t* H2, int* ctl, int* tok_pair, float* tok_w, int skip_ctx, char* lds) {
  float* wl = (float*)lds;
  const int tid = TIDX, lane = tid & 63, gw = BIDX * 8 + (tid >> 6), ngw = GDIM * 8;
  int* hist = (int*)(lds + 81920);
  if (tid < 32) hist[tid] = 0;
  float* mA = (float*)(lds + 82176); float* mB = mA + 5 * 1024;
  for (int idx = tid; idx < 5 * 1024; idx += NT) { const int m = idx >> 10, k = idx & 1023; mA[idx] = g[k] * (1.f + modv_layer[(size_t)m * 6144 + 4096 + k]); mB[idx] = modv_layer[(size_t)m * 6144 + 3072 + k]; }
  for (int idx = tid; idx < 4096; idx += NT) { const int k = idx >> 2, e4 = idx & 3, row = ((k & 3) * 4 + (k >> 8)) * 64 + ((k & 255) >> 2);
    *(f32x4*)(wl + row * 20 + 4 * e4) = *(const f32x4*)(w_router + (size_t)k * 16 + 4 * e4); }
  __syncthreads();
  for (int rb = gw; rb < MTOK; rb += 2 * ngw) {
    int rr[2]; bool act[2]; f32x4 v[2][4]; float rstd[2]; int mo[2];
#pragma unroll
    for (int u = 0; u < 2; ++u) { const int r = rb + u * ngw; rr[u] = r < MTOK ? r : MTOK - 1; act[u] = r < MTOK && !(skip_ctx && (rr[u] % TPB) < CTXL); mo[u] = mrow_of(rr[u]) * 1024;
      const float* xr = xrow(xl, xc, rr[u]);
#pragma unroll
      for (int j = 0; j < 4; ++j) v[u][j] = *(const f32x4*)(xr + 4 * lane + 256 * j); }
    if (!act[0] && !act[1]) continue;
#pragma unroll
    for (int u = 0; u < 2; ++u) { float ss = 0.f;
#pragma unroll
      for (int j = 0; j < 4; ++j) ss += v[u][j].x * v[u][j].x + v[u][j].y * v[u][j].y + v[u][j].z * v[u][j].z + v[u][j].w * v[u][j].w;
      rstd[u] = rsqrtf(wave_sum(ss) * (1.0f / DM) + EPS); }
    float lg[2][16];
#pragma unroll
    for (int u = 0; u < 2; ++u)
#pragma unroll
      for (int e = 0; e < 16; ++e) lg[u][e] = 0.f;
#pragma unroll 1
    for (int j = 0; j < 4; ++j) { const int k = 4 * lane + 256 * j; float o[2][4];
#pragma unroll
      for (int u = 0; u < 2; ++u) { const f32x4 a4 = *(const f32x4*)(mA + mo[u] + k), b4 = *(const f32x4*)(mB + mo[u] + k); const f32x4 o4 = v[u][j] * rstd[u] * a4 + b4;
        o[u][0] = o4.x; o[u][1] = o4.y; o[u][2] = o4.z; o[u][3] = o4.w;
        if (act[u]) { u32x2 wpk; wpk.x = pk2bf(o4.x, o4.y); wpk.y = pk2bf(o4.z, o4.w); *(u32x2*)(H2 + (size_t)rr[u] * DM + k) = wpk; } }
#pragma unroll
      for (int q = 0; q < 4; ++q) { const float* wr_ = wl + ((q * 4 + j) * 64 + lane) * 20;
#pragma unroll
        for (int e4 = 0; e4 < 4; ++e4) { const f32x4 wr = *(const f32x4*)(wr_ + 4 * e4);
#pragma unroll
          for (int u = 0; u < 2; ++u) { lg[u][4 * e4] += o[u][q] * wr.x; lg[u][4 * e4 + 1] += o[u][q] * wr.y; lg[u][4 * e4 + 2] += o[u][q] * wr.z; lg[u][4 * e4 + 3] += o[u][q] * wr.w; } } } }
    float h1[2];
#pragma unroll
    for (int u = 0; u < 2; ++u) { float h8[8], h4[4], h2[2];
#pragma unroll
      for (int i = 0; i < 8; ++i) { const bool up = (lane & 32) != 0; const float keep = up ? lg[u][8 + i] : lg[u][i], give = up ? lg[u][i] : lg[u][8 + i]; h8[i] = keep + __shfl_xor(give, 32); }
#pragma unroll
      for (int i = 0; i < 4; ++i) { const bool up = (lane & 16) != 0; const float keep = up ? h8[4 + i] : h8[i], give = up ? h8[i] : h8[4 + i]; h4[i] = keep + __shfl_xor(give, 16); }
#pragma unroll
      for (int i = 0; i < 2; ++i) { const bool up = (lane & 8) != 0; const float keep = up ? h4[2 + i] : h4[i], give = up ? h4[i] : h4[2 + i]; h2[i] = keep + __shfl_xor(give, 8); }
      { const bool up = (lane & 4) != 0; const float keep = up ? h2[1] : h2[0], give = up ? h2[0] : h2[1]; h1[u] = keep + __shfl_xor(give, 4); }
      h1[u] += __shfl_xor(h1[u], 2); h1[u] += __shfl_xor(h1[u], 1); }
    float lx[16];
#pragma unroll
    for (int e = 0; e < 16; ++e) { const int src = ((e >> 3) & 1) * 32 + ((e >> 2) & 1) * 16 + ((e >> 1) & 1) * 8 + (e & 1) * 4;
      const float a0 = __uint_as_float(__builtin_amdgcn_readlane(__float_as_uint(h1[0]), src)), a1 = __uint_as_float(__builtin_amdgcn_readlane(__float_as_uint(h1[1]), src));
      lx[e] = lane < 32 ? a0 : a1; }
    const int us = lane >> 5;
    if ((lane & 31) == 0 && (us == 0 ? act[0] : act[1])) {
      const int r = us == 0 ? rr[0] : rr[1];
      int best = 0, bi1 = 0, bi2 = 1; float bestv = -1e30f, bs1 = 0.f, bs2 = 0.f;
#pragma unroll
      for (int gq = 0; gq < 4; ++gq) { float m1 = -1e30f, m2 = -1e30f, s1 = 0.f, s2 = 0.f; int i1 = 0, i2 = 0;
#pragma unroll
        for (int i = 0; i < 4; ++i) { const float scv = 1.0f / (1.0f + __expf(-lx[4 * gq + i])); const float sv = scv + rbias[4 * gq + i];
          if (sv > m1) { m2 = m1; s2 = s1; i2 = i1; m1 = sv; s1 = scv; i1 = i; } else if (sv > m2) { m2 = sv; s2 = scv; i2 = i; } }
        if (m1 + m2 > bestv) { bestv = m1 + m2; best = gq; bi1 = i1; bi2 = i2; bs1 = s1; bs2 = s2; } }
      const int ia = bi1 < bi2 ? bi1 : bi2, ib = bi1 < bi2 ? bi2 : bi1;
      const int tri = ia == 0 ? ib - 1 : (ia == 1 ? ib + 1 : 5);
      const int pidx = best * 6 + tri;
      const float sa = bi1 < bi2 ? bs1 : bs2, sb = bi1 < bi2 ? bs2 : bs1, inv = 1.0f / (sa + sb);
      const int rank = atomicAdd(&hist[pidx], 1);
      tok_pair[r] = pidx | (rank << 5); tok_w[2 * r] = sa * inv; tok_w[2 * r + 1] = sb * inv;
    }
  }
  __syncthreads();
  if (tid < 32) ctl[CT_CNTB + BIDX * 32 + tid] = tid < 24 ? hist[tid] : 0;
}
__device__ __forceinline__ void st_moe_gather(const bf16_t* H2, bf16_t* H2S, int* ctl, const int* tok_pair, const float* tok_w, int* sorted_tok, float* sorted_w, int skip_ctx, char* lds) {
  int* sbase = (int*)lds; int* rtot = sbase + 32; int* rpre = rtot + 512;
  const int tid = TIDX, bid = BIDX;
  { const int p = tid & 31, seg = tid >> 5; int tot = 0, pre = 0;
#pragma unroll 4
    for (int i = 0; i < 16; ++i) { const int bb = seg * 16 + i; const int cv = ctl[CT_CNTB + bb * 32 + p]; tot += cv; pre += bb < bid ? cv : 0; }
    rtot[seg * 32 + p] = tot; rpre[seg * 32 + p] = pre; }
  __syncthreads();
  if (tid < 32) { int tot = 0, pre = 0;
#pragma unroll
    for (int sg = 0; sg < 16; ++sg) { tot += rtot[sg * 32 + tid]; pre += rpre[sg * 32 + tid]; }
    rtot[tid] = tot; rpre[tid] = pre; }
  __syncthreads();
  if (tid == 0) { int base = 0, nt = 0;
#pragma unroll 1
    for (int p = 0; p < 24; ++p) { sbase[p] = base + rpre[p]; const int n = rtot[p], tl = (n + 255) >> 8;
      if (bid == 0) { ctl[CT_BASE + p] = base; for (int t = 0; t < tl; ++t) ctl[CT_TP + nt + t] = p; }
      nt += tl; base += tl * 256; }
    if (bid == 0) { ctl[CT_BASE + 24] = base; ctl[CT_NT] = nt; } }
  __syncthreads();
  const int lane = tid & 63, gw = bid * 8 + (tid >> 6), ngw = GDIM * 8;
  for (int rb = gw; rb < MTOK; rb += 3 * ngw) {
    u32x4 a0[3], a1[3]; int pk[3]; float w0[3], w1[3]; bool act[3];
#pragma unroll
    for (int u = 0; u < 3; ++u) { const int r = rb + u * ngw; act[u] = r < MTOK && !(skip_ctx && (r % TPB) < CTXL); const int rc = act[u] ? r : 0;
      pk[u] = tok_pair[rc]; w0[u] = tok_w[2 * rc]; w1[u] = tok_w[2 * rc + 1];
      const u32x4* sp = (const u32x4*)(H2 + (size_t)rc * DM); a0[u] = sp[lane]; a1[u] = sp[lane + 64]; }
#pragma unroll
    for (int u = 0; u < 3; ++u) if (act[u]) { const int r = rb + u * ngw; const int slot = sbase[pk[u] & 31] + (pk[u] >> 5);
      if (lane == 0) { sorted_tok[slot] = r; sorted_w[2 * slot] = w0[u]; sorted_w[2 * slot + 1] = w1[u]; }
      u32x4* d = (u32x4*)(H2S + (size_t)slot * DM); d[lane] = a0[u]; d[lane + 64] = a1[u]; }
  }
  __syncthreads();
}
__device__ __forceinline__ void st_final(float* xl, const float* g) {
  const int lane = TIDX & 63, gw = BIDX * 8 + (TIDX >> 6), ngw = GDIM * 8;
  f32x4 gg[4];
#pragma unroll
  for (int j = 0; j < 4; ++j) gg[j] = *(const f32x4*)(g + 4 * lane + 256 * j);
  for (int rb = gw; rb < NB * SEQ; rb += 4 * ngw) {
    f32x4 v[4][4];
#pragma unroll
    for (int u = 0; u < 4; ++u) { const int r = rb + u * ngw; const float* xr = xl + (size_t)(r < NB * SEQ ? r : NB * SEQ - 1) * DM;
#pragma unroll
      for (int j = 0; j < 4; ++j) v[u][j] = *(const f32x4*)(xr + 4 * lane + 256 * j); }
#pragma unroll
    for (int u = 0; u < 4; ++u) { const int r = rb + u * ngw; float ss = 0.f;
#pragma unroll
      for (int j = 0; j < 4; ++j) ss += v[u][j].x * v[u][j].x + v[u][j].y * v[u][j].y + v[u][j].z * v[u][j].z + v[u][j].w * v[u][j].w;
      const float rstd = rsqrtf(wave_sum(ss) * (1.0f / DM) + EPS);
      if (r < NB * SEQ) { float* xr = xl + (size_t)r * DM;
#pragma unroll
        for (int j = 0; j < 4; ++j) *(f32x4*)(xr + 4 * lane + 256 * j) = (f32x4){v[u][j].x * rstd * gg[j].x, v[u][j].y * rstd * gg[j].y, v[u][j].z * rstd * gg[j].z, v[u][j].w * rstd * gg[j].w}; } }
  }
}

namespace pg8 {
#define PG8_LAS __attribute__((address_space(3)))
typedef unsigned short bf16_t;
typedef short bf16x8 __attribute__((ext_vector_type(8)));
typedef float f32x4 __attribute__((ext_vector_type(4)));
typedef unsigned u32x4 __attribute__((ext_vector_type(4)));
constexpr int BM = 256, BK = 64, HALF = 128, HTB = HALF * BK * 2  , STAGE_BYTES = 8 * HTB, NXCD = 8, WGM = 8;

__host__ __device__ __forceinline__ int lds_byte(int r, int c) { const int st = (r >> 4) * 2 + (c >> 5), rr = r & 15, cc = c & 31, ob = rr * 64 + cc * 2; return st * 1024 + (ob ^ (((ob >> 9) & 1) << 5)); }
__host__ __device__ __forceinline__ void stage_rc(int b, int& R, int& C) { const int st = b / 1024, sb = b % 1024, swz = sb ^ (((sb >> 9) & 1) << 5); R = (st >> 1) * 16 + swz / 64; C = (st & 1) * 32 + (swz % 64) / 2; }
__host__ __device__ __forceinline__ int perm32(int rho) { const int n = rho >> 4, i = rho & 15; return 8 * (i >> 2) + 4 * n + (i & 3); }

struct Unit { int pm, pn, fin; const char* A; const char* B; };
struct Gemm { int K, lda, ldb; };

__device__ __forceinline__ void tile_of(int L, int nM, int nN, int& pm, int& pn) {
    const int nwg = nM * nN; int wgid = L; { const int q = nwg / NXCD, r = nwg % NXCD, xcd = wgid % NXCD, off = wgid / NXCD; wgid = (xcd < r ? xcd * (q + 1) : r * (q + 1) + (xcd - r) * q) + off; }
    const int nig = WGM * nN, gid = wgid / nig, fm = gid * WGM, gsz = (nM - fm) < WGM ? (nM - fm) : WGM;
    pm = fm + ((wgid % nig) % gsz); pn = (wgid % nig) / gsz;
}
__device__ __forceinline__ unsigned cvt_pk_bf16(float lo, float hi) { unsigned r; asm volatile("v_cvt_pk_bf16_f32 %0, %1, %2" : "=v"(r) : "v"(lo), "v"(hi)); return r; }
template <class Epi, class Sched, bool ALIGN_EPI = false, bool SP2 = false>
__device__ __forceinline__ void gemm_phase(PG8_LAS unsigned char* lds, const Gemm g, const Sched& S, const Epi& E) {
    const int tid = opq_v((int)threadIdx.x), wid = __builtin_amdgcn_readfirstlane(tid >> 6), lane = tid & 63, wr = wid >> 2, wc = wid & 3, fr = lane & 15, fq = lane >> 4;
    const int K = g.K, nt = K / BK;
    unsigned voffA[2], voffB[2];
#pragma unroll
    for (int i = 0; i < 2; ++i) { int R, C; stage_rc(tid * 16 + i * 8192, R, C); const int Rb = Epi::PERM ? ((R & ~31) + perm32(R & 31)) : R;
        voffA[i] = (unsigned)(R * g.lda + C) * 2u; voffB[i] = (unsigned)(Rb * g.ldb + C) * 2u; }
    const size_t kstep = (size_t)(BK * 2);
    const size_t hstepA = (size_t)HALF * g.lda * 2, hstepB = (size_t)HALF * g.ldb * 2;
    const unsigned ldsw = (unsigned)wid * 1024u;
    const int aoff = lds_byte(wr * 64 + fr, fq * 8), boff = lds_byte(wc * 32 + fr, fq * 8);
#define PG8_SA(b, h) (((b) * 2 + (h)) * HTB)
#define PG8_SB(b, h) ((4 + (b) * 2 + (h)) * HTB)
#define PG8_STAGE(bufoff, gbase, voff) do { _Pragma("unroll") for (int _i = 0; _i < 2; ++_i) \
        __builtin_amdgcn_global_load_lds((const unsigned*)((const char*)(gbase) + (voff)[_i]), (PG8_LAS unsigned*)(lds + (bufoff) + ldsw + _i * 8192), 16, 0, 0); } while (0)
#define PG8_LDA(dst, b, h) do { _Pragma("unroll") for (int m = 0; m < 4; ++m) _Pragma("unroll") for (int k = 0; k < 2; ++k) dst[m][k] = *(const PG8_LAS bf16x8*)(lds + PG8_SA(b, h) + aoff + m * 2048 + k * 1024); } while (0)
#define PG8_LDB(dst, b, h) do { _Pragma("unroll") for (int n = 0; n < 2; ++n) _Pragma("unroll") for (int k = 0; k < 2; ++k) dst[n][k] = *(const PG8_LAS bf16x8*)(lds + PG8_SB(b, h) + boff + n * 2048 + k * 1024); } while (0)
#define PG8_MMA(ai, bj, At, Bt) do { __builtin_amdgcn_s_setprio(1); _Pragma("unroll") for (int m = 0; m < 4; ++m) _Pragma("unroll") for (int n = 0; n < 2; ++n) _Pragma("unroll") for (int k = 0; k < 2; ++k) \
        acc[ai][bj][m][n] = __builtin_amdgcn_mfma_f32_16x16x32_bf16(Bt[n][k], At[m][k], acc[ai][bj][m][n], 0, 0, 0); __builtin_amdgcn_s_setprio(0); } while (0)
#define PG8_WAIT_V(n) asm volatile("s_waitcnt vmcnt(" #n ")" ::: "memory")
#define PG8_WAIT_L(n) asm volatile("s_waitcnt lgkmcnt(" #n ")" ::: "memory")
#define PG8_BAR __builtin_amdgcn_s_barrier()
#define PG8_SCHED __builtin_amdgcn_sched_barrier(0)
    Unit cur, nxt; int ui = 0;
    if (!S.next(0, cur)) return;
    f32x4 acc[2][2][4][2];
#pragma unroll
    for (int a = 0; a < 2; ++a)
#pragma unroll
        for (int b = 0; b < 2; ++b)
#pragma unroll
            for (int m = 0; m < 4; ++m)
#pragma unroll
                for (int n = 0; n < 2; ++n) acc[a][b][m][n] = (f32x4){0.f, 0.f, 0.f, 0.f};
    bf16x8 At[4][2], B0[2][2], B1[2][2];
    const char* cA = cur.A; const char* cB = cur.B;
    S.a_ready(cur);
    if constexpr (SP2) {
        PG8_STAGE(PG8_SB(0, 0), cB, voffB); PG8_STAGE(PG8_SB(0, 1), cB + hstepB, voffB); PG8_STAGE(PG8_SA(0, 0), cA, voffA); PG8_STAGE(PG8_SA(0, 1), cA + hstepA, voffA);
        if (wr == 1) PG8_BAR;
        PG8_WAIT_V(2); PG8_BAR;
        PG8_STAGE(PG8_SB(1, 0), cB + kstep, voffB); PG8_STAGE(PG8_SA(1, 0), cA + kstep, voffA); PG8_STAGE(PG8_SB(1, 1), cB + hstepB + kstep, voffB);
        PG8_WAIT_V(6); PG8_BAR;
    } else {
        PG8_STAGE(PG8_SB(0, 0), cB, voffB); PG8_STAGE(PG8_SA(0, 0), cA, voffA); PG8_STAGE(PG8_SB(0, 1), cB + hstepB, voffB); PG8_STAGE(PG8_SA(0, 1), cA + hstepA, voffA);
        if (wr == 1) PG8_BAR;
        PG8_WAIT_V(4); PG8_BAR;
        PG8_STAGE(PG8_SB(1, 0), cB + kstep, voffB); PG8_STAGE(PG8_SA(1, 0), cA + kstep, voffA); PG8_STAGE(PG8_SB(1, 1), cB + hstepB + kstep, voffB);
        PG8_WAIT_V(6); PG8_BAR;
    }
    for (;;) {
        const bool has_next = S.next(ui + 1, nxt);
        const char* nA = has_next ? nxt.A : cA; const char* nB = has_next ? nxt.B : cB;
        for (int t = 0; t < nt; t += 2) {
            const bool last = (t == nt - 2);
            const char* a1 = cA + (size_t)(t + 1) * kstep;
            const char* a2 = last ? nA : cA + (size_t)(t + 2) * kstep; const char* b2 = last ? nB : cB + (size_t)(t + 2) * kstep;
            const char* a3 = a2 + kstep; const char* b3 = b2 + kstep;
            if (last && has_next) S.a_ready(nxt);
            if constexpr (SP2) {
            PG8_LDB(B0, 0, 0); PG8_LDB(B1, 0, 1); PG8_SCHED; PG8_LDA(At, 0, 0); PG8_STAGE(PG8_SA(1, 1), a1 + hstepA, voffA);
            PG8_WAIT_V(8); PG8_WAIT_L(0); PG8_BAR; PG8_MMA(0, 0, At, B0); PG8_MMA(0, 1, At, B1); PG8_BAR; PG8_SCHED;
            PG8_LDA(At, 0, 1); PG8_STAGE(PG8_SB(0, 0), b2, voffB); PG8_STAGE(PG8_SB(0, 1), b2 + hstepB, voffB); PG8_STAGE(PG8_SA(0, 0), a2, voffA);
            PG8_WAIT_V(8); PG8_WAIT_L(0); PG8_BAR; PG8_MMA(1, 0, At, B0); PG8_MMA(1, 1, At, B1); PG8_BAR; PG8_SCHED;
            PG8_LDB(B0, 1, 0); PG8_LDB(B1, 1, 1); PG8_SCHED; PG8_LDA(At, 1, 0); PG8_STAGE(PG8_SA(0, 1), a2 + hstepA, voffA);
            PG8_WAIT_V(8); PG8_WAIT_L(0); PG8_BAR; PG8_MMA(0, 0, At, B0); PG8_MMA(0, 1, At, B1); PG8_BAR; PG8_SCHED;
            PG8_LDA(At, 1, 1); PG8_STAGE(PG8_SB(1, 0), b3, voffB); PG8_STAGE(PG8_SB(1, 1), b3 + hstepB, voffB); PG8_STAGE(PG8_SA(1, 0), a3, voffA);
            PG8_WAIT_V(8); PG8_WAIT_L(0); PG8_BAR; PG8_MMA(1, 0, At, B0); PG8_MMA(1, 1, At, B1); PG8_BAR; PG8_SCHED;
            } else {
            PG8_LDB(B0, 0, 0); PG8_SCHED; PG8_LDA(At, 0, 0); PG8_STAGE(PG8_SA(1, 1), a1 + hstepA, voffA);
            PG8_WAIT_L(8); PG8_BAR; PG8_WAIT_L(0); PG8_MMA(0, 0, At, B0); PG8_BAR; PG8_SCHED;
            PG8_LDB(B1, 0, 1); PG8_STAGE(PG8_SB(0, 0), b2, voffB);
            PG8_BAR; PG8_WAIT_L(0); PG8_MMA(0, 1, At, B1); PG8_BAR;
            PG8_LDA(At, 0, 1); PG8_STAGE(PG8_SA(0, 0), a2, voffA);
            PG8_BAR; PG8_WAIT_L(0); PG8_MMA(1, 0, At, B0); PG8_BAR; PG8_SCHED;
            PG8_STAGE(PG8_SB(0, 1), b2 + hstepB, voffB);
            PG8_WAIT_V(6); PG8_BAR; PG8_MMA(1, 1, At, B1); PG8_BAR;
            PG8_LDB(B0, 1, 0); PG8_SCHED; PG8_LDA(At, 1, 0); PG8_STAGE(PG8_SA(0, 1), a2 + hstepA, voffA);
            PG8_WAIT_L(8); PG8_BAR; PG8_WAIT_L(0); PG8_MMA(0, 0, At, B0); PG8_BAR; PG8_SCHED;
            PG8_LDB(B1, 1, 1); PG8_STAGE(PG8_SB(1, 0), b3, voffB);
            PG8_BAR; PG8_WAIT_L(0); PG8_MMA(0, 1, At, B1); PG8_BAR;
            PG8_LDA(At, 1, 1); PG8_STAGE(PG8_SA(1, 0), a3, voffA);
            PG8_BAR; PG8_WAIT_L(0); PG8_MMA(1, 0, At, B0); PG8_BAR; PG8_SCHED;
            PG8_STAGE(PG8_SB(1, 1), b3 + hstepB, voffB);
            PG8_WAIT_V(6); PG8_BAR; PG8_MMA(1, 1, At, B1); PG8_BAR;
            }
        }
        if constexpr (ALIGN_EPI) { if (wr == 0) PG8_BAR; }
        if constexpr (!Epi::AFTER_DRAIN) { if (cur.fin) { E(acc, cur, wr, wc, fr, fq); S.done(cur); } }
        if (!has_next) break;
        if (cur.fin) {
#pragma unroll
        for (int a = 0; a < 2; ++a)
#pragma unroll
            for (int b = 0; b < 2; ++b)
#pragma unroll
                for (int m = 0; m < 4; ++m)
#pragma unroll
                    for (int n = 0; n < 2; ++n) acc[a][b][m][n] = (f32x4){0.f, 0.f, 0.f, 0.f};
        }
        cur = nxt; cA = nA; cB = nB; ++ui;
        if constexpr (ALIGN_EPI) { if (wr == 1) PG8_BAR; }
    }
    PG8_WAIT_V(0);
    if constexpr (!ALIGN_EPI) { if (wr == 0) PG8_BAR; }
    PG8_BAR;
    if constexpr (Epi::AFTER_DRAIN) { E.fused(acc, cur, wr, wc, fr, fq, lds, wid, lane); S.done(cur); }
#undef PG8_SA
#undef PG8_SB
#undef PG8_STAGE
#undef PG8_LDA
#undef PG8_LDB
#undef PG8_MMA
#undef PG8_WAIT_V
#undef PG8_WAIT_L
#undef PG8_BAR
#undef PG8_SCHED
}
}

struct SchedDense {
  int nM, nN, G, c, skip_ctx; const char* A; const char* B; size_t a_tile, b_tile;
  __device__ __forceinline__ bool next(int i, pg8::Unit& u) const {
    const long L = (long)i * G + c; if (L >= (long)nM * nN) return false;
    int pm, pn; pg8::tile_of((int)L, nM, nN, pm, pn); if (skip_ctx) pm = pm + pm / 16 + 1;
    u.pm = pm; u.pn = pn; u.fin = 1; u.A = A + (size_t)pm * a_tile; u.B = B + (size_t)pn * b_tile; return true; }
  __device__ __forceinline__ void a_ready(const pg8::Unit&) const {}
  __device__ __forceinline__ void done(const pg8::Unit&) const {}
};
struct SchedMoe {
  int G, c, mode; const int* ctl; const char* A; size_t a_tile; const char* W;
  __device__ __forceinline__ bool next(int i, pg8::Unit& u) const {
    const int part = mode == 2 ? (i & 1) : 0, iu = mode == 2 ? (i >> 1) : i;
    const long L = (long)iu * G + c; const int ntiles = ctl[CT_NT]; if (L >= (long)ntiles * 4) return false;
    const int pm = (int)(L >> 2), pn = (int)(L & 3); int eA, eB; pair_experts(ctl[CT_TP + pm], eA, eB);
    u.pm = pm; u.pn = pn;
    if (mode == 1) { const int e = pn < 2 ? eA : eB; u.fin = 1; u.A = A + (size_t)pm * a_tile; u.B = W + (size_t)e * (512 * 1024 * 2) + (size_t)(pn & 1) * (256 * 1024 * 2); }
    else { u.fin = part; u.A = A + (size_t)pm * a_tile + part * 512; u.B = W + (size_t)(part ? eB : eA) * (1024 * 256 * 2) + (size_t)pn * (256 * 256 * 2); }
    return true; }
  __device__ __forceinline__ void a_ready(const pg8::Unit&) const {}
  __device__ __forceinline__ void done(const pg8::Unit&) const {}
};
__device__ __forceinline__ unsigned cvt_pk(float lo, float hi) { return pg8::cvt_pk_bf16(lo, hi); }
struct EpiInProj {
  static constexpr bool PERM = true, AFTER_DRAIN = false; bf16_t *QK, *VZ, *XBC, *HY; float* DT;
  __device__ __forceinline__ void operator()(const f32x4 (&acc)[2][2][4][2], const pg8::Unit& u, int wr, int wc, int fr, int fq) const {
    const int pn = u.pn; bf16_t* base; int ldc, coff;
    if (pn < 2) { base = QK; ldc = 512; coff = pn * 256; } else if (pn < 4) { base = VZ; ldc = 512; coff = (pn - 2) * 256; }
    else if (pn < 7) { base = XBC; ldc = 768; coff = (pn - 4) * 256; } else { base = HY; ldc = 768; coff = (pn - 7) * 256; }
    const int row0 = u.pm * 256 + wr * 64 + fr, col0 = coff + wc * 32 + 8 * fq; const bool dtl = (pn == 6 && wc == 0 && fq < 2);
#pragma unroll
    for (int ai = 0; ai < 2; ++ai)
#pragma unroll
      for (int m = 0; m < 4; ++m) { const int row = row0 + ai * 128 + m * 16; bf16_t* rowp = base + (size_t)row * ldc + col0;
#pragma unroll
        for (int bj = 0; bj < 2; ++bj) { const f32x4 v0 = acc[ai][bj][m][0], v1 = acc[ai][bj][m][1];
          u32x4 w; w.x = cvt_pk(v0[0], v0[1]); w.y = cvt_pk(v0[2], v0[3]); w.z = cvt_pk(v1[0], v1[1]); w.w = cvt_pk(v1[2], v1[3]);
          *(u32x4*)(rowp + bj * 128) = w;
          if (bj == 1 && dtl) { float* dp = DT + (size_t)row * 12 + 8 * fq; *(f32x4*)dp = v0; if (fq == 0) *(f32x4*)(dp + 4) = v1; } } }
  }
};
struct EpiOutProj {
  static constexpr bool PERM = false, AFTER_DRAIN = false; const float *xl_src, *xc_src; float *xl_dst, *xc_dst; const float* gate;
  __device__ __forceinline__ void operator()(const f32x4 (&acc)[2][2][4][2], const pg8::Unit& u, int wr, int wc, int fr, int fq) const {
    const int b = u.pm / 17, jt = u.pm - 17 * b; const size_t rbase = jt == 0 ? (size_t)b * CTXL : (size_t)b * SEQ + (jt - 1) * 256;
    const float* xs = (jt == 0 ? xc_src : xl_src) + rbase * DM; float* xd = (jt == 0 ? xc_dst : xl_dst) + rbase * DM; const float* gt = gate + (size_t)(jt == 0 ? 4 : b) * 6144;
    const int col0 = u.pn * 256 + wc * 32 + 4 * fq;
#pragma unroll
    for (int ai = 0; ai < 2; ++ai)
#pragma unroll
      for (int m = 0; m < 4; ++m) { const size_t off = (size_t)(ai * 128 + wr * 64 + m * 16 + fr) * DM + col0;
#pragma unroll
        for (int bj = 0; bj < 2; ++bj)
#pragma unroll
          for (int n = 0; n < 2; ++n) { const int co = bj * 128 + n * 16; const f32x4 g4 = *(const f32x4*)(gt + col0 + co), x4 = *(const f32x4*)(xs + off + co);
            *(f32x4*)(xd + off + co) = x4 + g4 * acc[ai][bj][m][n]; } }
  }
};
struct EpiMoe1 {
  static constexpr bool PERM = true, AFTER_DRAIN = false; bf16_t* ACT; const float* sorted_w;
  __device__ __forceinline__ void operator()(const f32x4 (&acc)[2][2][4][2], const pg8::Unit& u, int wr, int wc, int fr, int fq) const {
    const int half = u.pn >> 1, j0 = (u.pn & 1) * 128 + 16 * wc + 4 * fq;
#pragma unroll
    for (int ai = 0; ai < 2; ++ai)
#pragma unroll
      for (int m = 0; m < 4; ++m) { const int slot = u.pm * 256 + ai * 128 + wr * 64 + m * 16 + fr; const float wt = sorted_w[2 * slot + half];
#pragma unroll
        for (int bj = 0; bj < 2; ++bj) { const f32x4 v0 = acc[ai][bj][m][0], v1 = acc[ai][bj][m][1];
          u32x2 w; w.x = cvt_pk(siluf(v0[0]) * v0[1] * wt, siluf(v0[2]) * v0[3] * wt); w.y = cvt_pk(siluf(v1[0]) * v1[1] * wt, siluf(v1[2]) * v1[3] * wt);
          *(u32x2*)(ACT + (size_t)slot * 512 + half * 256 + j0 + 64 * bj) = w; } }
  }
};
struct EpiMoe2 {
  static constexpr bool PERM = false, AFTER_DRAIN = false; float *xl, *xc; const float* gate; const int* sorted_tok;
  __device__ __forceinline__ void operator()(const f32x4 (&acc)[2][2][4][2], const pg8::Unit& u, int wr, int wc, int fr, int fq) const {
    const int col0 = u.pn * 256 + wc * 32 + 4 * fq;
#pragma unroll
    for (int ai = 0; ai < 2; ++ai)
#pragma unroll
      for (int m = 0; m < 4; ++m) { const int slot = u.pm * 256 + ai * 128 + wr * 64 + m * 16 + fr; const int r = sorted_tok[slot];
        if (r >= 0) { float* xd = xrow(xl, xc, r) + col0; const float* gt = gate + (size_t)mrow_of(r) * 6144 + col0;
#pragma unroll
          for (int bj = 0; bj < 2; ++bj)
#pragma unroll
            for (int n = 0; n < 2; ++n) { const int co = bj * 128 + n * 16; *(f32x4*)(xd + co) = *(const f32x4*)(xd + co) + *(const f32x4*)(gt + co) * acc[ai][bj][m][n]; } }
        asm volatile("" ::: "memory"); }
  }
};

#include <hip/hip_bf16.h>
#include <cmath>
namespace attn_body {
using bf16=__hip_bfloat16;
using bf16x8=__attribute__((ext_vector_type(8)))short;
using s16x4=__attribute__((ext_vector_type(4)))short;
using f32x16=__attribute__((ext_vector_type(16)))float;
using u32x4=__attribute__((ext_vector_type(4)))unsigned;
constexpr int D=64,QP=512,KP=512,VP=512,OP=1024;
constexpr int NW=8,QBLK=32,QB=QBLK*NW,KVBLK=64;
constexpr int ATTN_UNIT_ROWS=QB;
__device__ __forceinline__ int crow(int r,int hi){return (r&3)+8*(r>>2)+4*hi;}
#define SBAR() __builtin_amdgcn_sched_barrier(0)
__device__ __forceinline__ void cmask(f32x16&p0,f32x16&p1,int jb,int qrel,int hi){
  const float NEG=-INFINITY; int kb=64*jb+4*hi;
  #pragma unroll
  for(int r=0;r<16;++r){int kv=kb+(r&3)+8*(r>>2); if(kv>qrel)p0[r]=NEG; if(kv+32>qrel)p1[r]=NEG;}
}

constexpr int NSLOT=3, SLOTB=8192;
constexpr int LDS_K=0, LDS_V=NSLOT*SLOTB, LDS_WS=2*NSLOT*SLOTB, LDS_OST=LDS_WS+NW*64*4, LDS_BYTES=LDS_OST+NW*4096;
constexpr float C2=0.125f*1.4426950408889634f;
__device__ __forceinline__ void glds16(const void*gsrc,unsigned lds_dst){unsigned keep;
  asm volatile("s_mov_b32 %0, m0\n\ts_mov_b32 m0, %2\n\ts_nop 0\n\tglobal_load_lds_dwordx4 %1, off\n\ts_mov_b32 m0, %0":"=&s"(keep):"v"(gsrc),"s"(lds_dst):"memory");}
__device__ __forceinline__ float max3f(float a,float b,float c){float r;asm("v_max3_f32 %0, %1, %2, %3":"=v"(r):"v"(a),"v"(b),"v"(c));return r;}
__device__ __forceinline__ float max2f(float a,float b){float r;asm("v_max_f32_e32 %0, %1, %2":"=v"(r):"v"(a),"v"(b));return r;}
__device__ __forceinline__ float fadd_s(float a,float b){float r;asm("v_add_f32_e32 %0, %1, %2":"=v"(r):"v"(a),"v"(b));return r;}
__device__ __forceinline__ float fsub_s(float a,float b){float r;asm("v_sub_f32_e32 %0, %1, %2":"=v"(r):"v"(a),"v"(b));return r;}
typedef float f32x2_t __attribute__((ext_vector_type(2))); typedef __bf16 bf16x2_t __attribute__((ext_vector_type(2)));
__device__ __forceinline__ unsigned cvtpk_s(float lo,float hi){f32x2_t v={lo,hi};bf16x2_t b=__builtin_convertvector(v,bf16x2_t);return __builtin_bit_cast(unsigned,b);}
#define WAIT_BAR(N) asm volatile("s_waitcnt vmcnt(" #N ") lgkmcnt(0)\n\ts_barrier":::"memory")

__device__ __forceinline__ void qkt(f32x16&p0,f32x16&p1,const char*Kslot,const bf16x8*qr,const f32x16&negm,int r32,int hi){
  const char*kb=Kslot+hi*1024+r32*16;
  #pragma unroll
  for(int d0=0;d0<4;++d0){
    const bf16x8 b0=*reinterpret_cast<const bf16x8*>(kb+d0*2048);
    const bf16x8 b1=*reinterpret_cast<const bf16x8*>(kb+d0*2048+512);
    if(d0==0){p0=__builtin_amdgcn_mfma_f32_32x32x16_bf16(b0,qr[0],negm,0,0,0);p1=__builtin_amdgcn_mfma_f32_32x32x16_bf16(b1,qr[0],negm,0,0,0);}
    else{p0=__builtin_amdgcn_mfma_f32_32x32x16_bf16(b0,qr[d0],p0,0,0,0);p1=__builtin_amdgcn_mfma_f32_32x32x16_bf16(b1,qr[d0],p1,0,0,0);}}
}
typedef __attribute__((address_space(3))) const char* lds_cptr;
typedef short v4i16_t __attribute__((ext_vector_type(4)));
__device__ __forceinline__ void kload8(bf16x8*kf,lds_cptr kp){
  kf[0]=*(const __attribute__((address_space(3))) bf16x8*)(kp);      kf[1]=*(const __attribute__((address_space(3))) bf16x8*)(kp+512);
  kf[2]=*(const __attribute__((address_space(3))) bf16x8*)(kp+2048); kf[3]=*(const __attribute__((address_space(3))) bf16x8*)(kp+2560);
  kf[4]=*(const __attribute__((address_space(3))) bf16x8*)(kp+4096); kf[5]=*(const __attribute__((address_space(3))) bf16x8*)(kp+4608);
  kf[6]=*(const __attribute__((address_space(3))) bf16x8*)(kp+6144); kf[7]=*(const __attribute__((address_space(3))) bf16x8*)(kp+6656);
}
__device__ __forceinline__ void kload2(bf16x8*kf,lds_cptr kp,int j){ kf[2*j]=*(const __attribute__((address_space(3))) bf16x8*)(kp+j*2048); kf[2*j+1]=*(const __attribute__((address_space(3))) bf16x8*)(kp+j*2048+512); }
__device__ __forceinline__ s16x4 vtr(lds_cptr p){ return __builtin_bit_cast(s16x4,__builtin_amdgcn_ds_read_tr16_b64_v4i16((__attribute__((address_space(3))) v4i16_t*)p)); }
__device__ __forceinline__ float rowmax(const f32x16&p0,const f32x16&p1){
  float a=max3f(p0[0],p0[1],p1[0]),b=max3f(p0[2],p0[3],p1[1]);a=max3f(a,p1[2],p1[3]);
  #pragma unroll
  for(int r=4;r<16;r+=4){a=max3f(a,p0[r],p0[r+1]);b=max3f(b,p0[r+2],p0[r+3]);a=max3f(a,p1[r],p1[r+1]);b=max3f(b,p1[r+2],p1[r+3]);}
  const float m=max2f(a,b);
  auto rr=__builtin_amdgcn_permlane32_swap(__float_as_uint(m),__float_as_uint(m),false,false);
  return max2f(__uint_as_float(rr[0]),__uint_as_float(rr[1]));
}
__device__ __forceinline__ void pv(f32x16*o,int vb,bf16x8 pa0,bf16x8 pa1,bf16x8 pa2,bf16x8 pa3){
  #pragma unroll
  for(int d0=0;d0<2;++d0){s16x4 lo[4],hi[4];
    #pragma unroll
    for(int ks=0;ks<4;++ks){
      asm volatile("ds_read_b64_tr_b16 %0,%1 offset:%c2":"=&v"(lo[ks]):"v"(vb),"i"(d0*4096+ks*1024):"memory");
      asm volatile("ds_read_b64_tr_b16 %0,%1 offset:%c2":"=&v"(hi[ks]):"v"(vb),"i"(d0*4096+ks*1024+512):"memory");}
    asm volatile("s_waitcnt lgkmcnt(0)":::"memory");SBAR();
    #define PK(k) (bf16x8){lo[k][0],lo[k][1],lo[k][2],lo[k][3],hi[k][0],hi[k][1],hi[k][2],hi[k][3]}
    o[d0]=__builtin_amdgcn_mfma_f32_32x32x16_bf16(pa0,PK(0),o[d0],0,0,0);
    o[d0]=__builtin_amdgcn_mfma_f32_32x32x16_bf16(pa1,PK(1),o[d0],0,0,0);
    o[d0]=__builtin_amdgcn_mfma_f32_32x32x16_bf16(pa2,PK(2),o[d0],0,0,0);
    o[d0]=__builtin_amdgcn_mfma_f32_32x32x16_bf16(pa3,PK(3),o[d0],0,0,0);
    #undef PK
  }
}

#ifndef ATTN_STORE16
#define ATTN_STORE16(p,v) (*(u32x4*)(p)=(v))
#endif
template<int THRL> __device__ __forceinline__ void attn_unit(const bf16*Qu,const bf16*__restrict__ Kh,const bf16*__restrict__ Vh,bf16*Ou,const int NT,char*shm){
  const int tid=opq_v((int)threadIdx.x),lane=tid&63,r32=lane&31,hi=lane>>5; const int wid=__builtin_amdgcn_readfirstlane(tid>>6);
  const bf16*Qw=Qu+(long)(wid*QBLK)*QP;
  const unsigned lds0=(unsigned)(uintptr_t)shm;
  float*wsf=(float*)(shm+LDS_WS)+wid*64;
  const bf16*ksrc=Kh+(long)lane*KP+wid*8;
  const bf16*vsrc=Vh+(long)(16*(wid&3)+(lane>>2))*VP+(wid>>2)*32+(lane&3)*8;
  const unsigned kdst=lds0+LDS_K+wid*1024, vdst=lds0+LDS_V+wid*1024;
  #define DMA_K(t,slot) glds16(ksrc+(long)(t)*KVBLK*KP,(unsigned)__builtin_amdgcn_readfirstlane(kdst+(slot)))
  #define DMA_V(t,slot) glds16(vsrc+(long)(t)*KVBLK*VP,(unsigned)__builtin_amdgcn_readfirstlane(vdst+(slot)))
  const int vb0=(int)(lds0+LDS_V)+((lane>>4)&1)*32+(lane&3)*8+(4*hi+((lane&15)>>2))*64;
  const char*Kbase=shm+LDS_K; bf16x8 kf[8];
  const lds_cptr shm3=(lds_cptr)shm; const lds_cptr kp0=shm3+LDS_K+hi*1024+r32*16; const lds_cptr vp0=shm3+LDS_V+((lane>>4)&1)*32+(lane&3)*8+(4*hi+((lane&15)>>2))*64;
  DMA_K(0,0);DMA_V(0,0);DMA_K(1,SLOTB);
  bf16x8 qr[4];
  #pragma unroll
  for(int d0=0;d0<4;++d0)qr[d0]=*reinterpret_cast<const bf16x8*>(&Qw[(long)r32*QP+d0*16+hi*8]);
  float mhat=0.f,l_reg=0.f;float z0_=0.f;asm volatile("":"+v"(z0_));f32x16 o[2];f32x16 negm;
  _Pragma("unroll") for(int r=0;r<16;++r){o[0][r]=z0_;o[1][r]=z0_;negm[r]=z0_;} asm volatile("":"+v"(negm));
  #define CMASK(P0,P1,t) do{}while(0)
  bool resc=false;
  #define START(P0,P1) do{ const float rm=rowmax(P0,P1); resc=false; \
    { const float dl=rm; mhat=fadd_s(mhat,dl); \
      _Pragma("unroll") for(int r=0;r<16;++r){P0[r]=fsub_s(P0[r],dl);P1[r]=fsub_s(P1[r],dl);} \
      _Pragma("unroll") for(int r=0;r<16;++r)negm[r]=-mhat; asm volatile("":"+v"(negm)); } \
    _Pragma("unroll") for(int r=0;r<16;++r)P0[r]=__builtin_amdgcn_exp2f(P0[r]); }while(0)
  #define RESC() do{ if(resc){ asm volatile("s_waitcnt lgkmcnt(0)":::"memory"); \
      _Pragma("unroll") for(int d_=0;d_<2;++d_) _Pragma("unroll") for(int r=0;r<16;++r)o[d_][r]*=wsf[crow(r,hi)]; } }while(0)
  f32x16 pA0,pA1,pB0,pB1;
  int sl_prev=0,sl_cur=0,sl_next=SLOTB;
  #define ROT() do{sl_prev=sl_cur;sl_cur=sl_next;sl_next=(sl_next==(NSLOT-1)*SLOTB)?0:sl_next+SLOTB;}while(0)
  DMA_K(2,2*SLOTB);
  WAIT_BAR(3);
  qkt(pA0,pA1,Kbase,qr,negm,r32,hi);asm volatile("s_nop 15\n\ts_nop 7":"+v"(pA0),"+v"(pA1));CMASK(pA0,pA1,0);
  START(pA0,pA1);
  _Pragma("unroll") for(int r=0;r<16;++r)pA1[r]=__builtin_amdgcn_exp2f(pA1[r]);
  WAIT_BAR(0);
  DMA_K(3,0);DMA_V(1,SLOTB);
  ROT();
  kload8(kf,kp0+sl_cur);
  WAIT_BAR(2);
  s16x4 vlo[8],vhi[8]; u32x4 pw0,pw1,pw2,pw3;
  #define PKW(P,B) cvtpk_s(P[B],P[B+1])
  #define PAF(k) __builtin_bit_cast(bf16x8,pw##k)
  #define VFR(i) (bf16x8){vlo[i][0],vlo[i][1],vlo[i][2],vlo[i][3],vhi[i][0],vhi[i][1],vhi[i][2],vhi[i][3]}
  #define PIN(x) asm volatile("":"+v"(x))
  #define MX3(a,b,c) __builtin_fmaxf(__builtin_fmaxf((a),(b)),(c))
  #define GAPA(MF,A0,A1,A2,A3,W0,W1,PW) do{ MF; sacc+=A0; sacc+=A1; sacc+=A2; sacc+=A3; PIN(sacc); W0; W1; PIN(PW); SBAR(); }while(0)
  #define EX(v) __builtin_amdgcn_exp2f(v)
  #define GAPB(MF,X,B) do{ MF; X[B]=EX(X[B]); X[B+1]=EX(X[B+1]); X[B+2]=EX(X[B+2]); X[B+3]=EX(X[B+3]); PIN(X); SBAR(); }while(0)
  #define VRD(i) do{ vlo[i]=vtr(vp_+(((i)>>2)*4096+((i)&3)*1024)); vhi[i]=vtr(vp_+(((i)>>2)*4096+((i)&3)*1024+512)); }while(0)
  #define KRD(G,j) do{ if(G){ kload2(kf,kp0+sl_next,j); SBAR(); } }while(0)
  #define STEP(C0,C1,P0,P1,t,GK,GV,GL) do{ SBAR(); \
    const lds_cptr vp_=vp0+sl_prev; \
    VRD(0); SBAR(); float sacc=(P0[0]+P0[1]); \
    GAPA(C0=__builtin_amdgcn_mfma_f32_32x32x16_bf16(kf[0],qr[0],negm,0,0,0), P0[2],P0[3],P0[4],P0[5],     pw0[0]=PKW(P0,0), pw0[1]=PKW(P0,2), pw0); \
    VRD(4); SBAR(); GAPA(C1=__builtin_amdgcn_mfma_f32_32x32x16_bf16(kf[1],qr[0],negm,0,0,0), P0[6],P0[7],P0[8],P0[9],     pw0[2]=PKW(P0,4), pw0[3]=PKW(P0,6), pw0); \
    VRD(1); SBAR(); GAPA(C0=__builtin_amdgcn_mfma_f32_32x32x16_bf16(kf[2],qr[1],C0,0,0,0),   P0[10],P0[11],P0[12],P0[13], pw1[0]=PKW(P0,8), pw1[1]=PKW(P0,10), pw1); \
    VRD(5); SBAR(); GAPA(C1=__builtin_amdgcn_mfma_f32_32x32x16_bf16(kf[3],qr[1],C1,0,0,0),   P0[14],P0[15],P1[0],P1[1],   pw1[2]=PKW(P0,12),pw1[3]=PKW(P0,14), pw1); \
    VRD(2); SBAR(); GAPA(C0=__builtin_amdgcn_mfma_f32_32x32x16_bf16(kf[4],qr[2],C0,0,0,0),   P1[2],P1[3],P1[4],P1[5],     pw2[0]=PKW(P1,0), pw2[1]=PKW(P1,2), pw2); \
    VRD(6); SBAR(); GAPA(C1=__builtin_amdgcn_mfma_f32_32x32x16_bf16(kf[5],qr[2],C1,0,0,0),   P1[6],P1[7],P1[8],P1[9],     pw2[2]=PKW(P1,4), pw2[3]=PKW(P1,6), pw2); \
    VRD(3); SBAR(); GAPA(C0=__builtin_amdgcn_mfma_f32_32x32x16_bf16(kf[6],qr[3],C0,0,0,0),   P1[10],P1[11],P1[12],P1[13], pw3[0]=PKW(P1,8), pw3[1]=PKW(P1,10), pw3); \
    VRD(7); SBAR(); GAPA(C1=__builtin_amdgcn_mfma_f32_32x32x16_bf16(kf[7],qr[3],C1,0,0,0),   P1[14],P1[15],0.f,0.f,       pw3[2]=PKW(P1,12),pw3[3]=PKW(P1,14), pw3); \
    l_reg+=sacc; \
    if(GK){DMA_K((t)+3,sl_cur);} if(GV){DMA_V((t)+1,sl_next);} \
    CMASK(C0,C1,t); \
    { float a=MX3(C0[0],C0[1],C1[0]),b=MX3(C0[2],C0[3],C1[1]); a=MX3(a,C1[2],C1[3]); \
      _Pragma("unroll") for(int r=4;r<16;r+=4){a=MX3(a,C0[r],C0[r+1]);b=MX3(b,C0[r+2],C0[r+3]);a=MX3(a,C1[r],C1[r+1]);b=MX3(b,C1[r+2],C1[r+3]);} \
      float rm=__builtin_fmaxf(a,b); { auto rr=__builtin_amdgcn_permlane32_swap(__float_as_uint(rm),__float_as_uint(rm),false,false); rm=__builtin_fmaxf(__uint_as_float(rr[0]),__uint_as_float(rr[1])); } \
      resc=false; \
      if(__builtin_expect(__any(rm>(float)THRL),0)){ const float dl=__builtin_fmaxf(rm,0.f); mhat+=dl; \
        _Pragma("unroll") for(int r=0;r<16;++r){C0[r]-=dl;C1[r]-=dl;} \
        _Pragma("unroll") for(int r=0;r<16;++r)negm[r]=-mhat; asm volatile("":"+v"(negm)); \
        const float f=__builtin_amdgcn_exp2f(-dl); l_reg*=f; if(hi==0)wsf[r32]=f; resc=true; } } \
    SBAR(); \
    GAPB(o[0]=__builtin_amdgcn_mfma_f32_32x32x16_bf16(PAF(0),VFR(0),o[0],0,0,0), C0,0); \
    GAPB(o[1]=__builtin_amdgcn_mfma_f32_32x32x16_bf16(PAF(0),VFR(4),o[1],0,0,0), C0,4); \
    KRD(GL,0); GAPB(o[0]=__builtin_amdgcn_mfma_f32_32x32x16_bf16(PAF(1),VFR(1),o[0],0,0,0), C0,8); \
    KRD(GL,1); GAPB(o[1]=__builtin_amdgcn_mfma_f32_32x32x16_bf16(PAF(1),VFR(5),o[1],0,0,0), C0,12); \
    KRD(GL,2); GAPB(o[0]=__builtin_amdgcn_mfma_f32_32x32x16_bf16(PAF(2),VFR(2),o[0],0,0,0), C1,0); \
    KRD(GL,3); GAPB(o[1]=__builtin_amdgcn_mfma_f32_32x32x16_bf16(PAF(2),VFR(6),o[1],0,0,0), C1,4); \
    GAPB(o[0]=__builtin_amdgcn_mfma_f32_32x32x16_bf16(PAF(3),VFR(3),o[0],0,0,0), C1,8); \
    GAPB(o[1]=__builtin_amdgcn_mfma_f32_32x32x16_bf16(PAF(3),VFR(7),o[1],0,0,0), C1,12); \
    }while(0)
  int t=1;
  for(;t+5<NT;t+=2){
    STEP(pB0,pB1,pA0,pA1,t,true,true,true);     WAIT_BAR(2); RESC(); ROT();
    STEP(pA0,pA1,pB0,pB1,t+1,true,true,true);   WAIT_BAR(2); RESC(); ROT();
  }
  #define ENDW(tt) do{ if((tt)+3<NT){WAIT_BAR(2);} else if((tt)+2<NT){WAIT_BAR(1);} else {WAIT_BAR(0);} }while(0)
  for(;t+1<NT;t+=2){
    STEP(pB0,pB1,pA0,pA1,t,(t+3<NT),(t+1<NT),(t+1<NT));       ENDW(t);   RESC(); ROT();
    STEP(pA0,pA1,pB0,pB1,t+1,(t+4<NT),(t+2<NT),(t+2<NT));     ENDW(t+1); RESC(); ROT();
  }
  STEP(pB0,pB1,pA0,pA1,NT-1,false,false,false); RESC();
  { float sacc=pB0[0]+pB0[1]; _Pragma("unroll") for(int r=2;r<16;++r)sacc+=pB0[r]; _Pragma("unroll") for(int r=0;r<16;++r)sacc+=pB1[r]; l_reg+=sacc;
    pw0=(u32x4){PKW(pB0,0),PKW(pB0,2),PKW(pB0,4),PKW(pB0,6)};pw1=(u32x4){PKW(pB0,8),PKW(pB0,10),PKW(pB0,12),PKW(pB0,14)};pw2=(u32x4){PKW(pB1,0),PKW(pB1,2),PKW(pB1,4),PKW(pB1,6)};pw3=(u32x4){PKW(pB1,8),PKW(pB1,10),PKW(pB1,12),PKW(pB1,14)};
    SBAR(); pv(o,vb0+sl_cur,PAF(0),PAF(1),PAF(2),PAF(3)); }
  #undef PKW
  #undef PAF
  #undef VFR
  #undef PIN
  #undef MX3
  #undef GAPA
  #undef GAPB
  #undef EX
  #undef VRD
  #undef KRD
  #undef STEP
  #undef ENDW
  {auto rr=__builtin_amdgcn_permlane32_swap(__float_as_uint(l_reg),__float_as_uint(l_reg),false,false);l_reg=__uint_as_float(rr[0])+__uint_as_float(rr[1]);}
  if(hi==0)wsf[32+r32]=l_reg;asm volatile("s_waitcnt lgkmcnt(0)":::"memory");
  float rli[16];
  #pragma unroll
  for(int r=0;r<16;++r)rli[r]=__builtin_amdgcn_rcpf(wsf[32+crow(r,hi)]);
  bf16*Ow=Ou+(long)(wid*QBLK)*OP;
  { bf16*stg=(bf16*)(shm+LDS_OST)+wid*2048;
    #pragma unroll
    for(int r=0;r<16;++r){const int orow=crow(r,hi);
      #pragma unroll
      for(int d0=0;d0<2;++d0)stg[orow*64+d0*32+r32]=__float2bfloat16(o[d0][r]*rli[r]);}
    asm volatile("s_waitcnt lgkmcnt(0)":::"memory");
    #pragma unroll
    for(int i=0;i<4;++i){const int row=i*8+(lane>>3),ch=lane&7; const u32x4 v=*(const u32x4*)(stg+row*64+ch*8); ATTN_STORE16(Ow+(long)row*OP+ch*8,v);} }
  asm volatile("s_waitcnt lgkmcnt(0)\n\ts_barrier":::"memory");
  #undef DMA_K
  #undef DMA_V
  #undef CMASK
  #undef START
  #undef RESC
  #undef ROT
}
constexpr int ATTN_LDS_BYTES=LDS_BYTES;
#undef SBAR
#undef WAIT_BAR
}


namespace hyf {
struct c32 { float x, y; };
typedef _Float16 h2 __attribute__((ext_vector_type(2)));
__device__ __forceinline__ c32 operator+(c32 a, c32 b) { return {a.x + b.x, a.y + b.y}; }
__device__ __forceinline__ c32 operator-(c32 a, c32 b) { return {a.x - b.x, a.y - b.y}; }
__device__ __forceinline__ c32 cmul(c32 a, c32 b) { return {a.x * b.x - a.y * b.y, a.x * b.y + a.y * b.x}; }
__device__ __forceinline__ constexpr float C32(int k) {
  switch (k) { case 0: return 1.f; case 1: return 0.98078528f; case 2: return 0.923879533f; case 3: return 0.831469612f; case 4: return 0.707106781f; case 5: return 0.555570233f; case 6: return 0.382683432f;
    case 7: return 0.195090322f; case 8: return 0.f; case 9: return -0.195090322f; case 10: return -0.382683432f; case 11: return -0.555570233f; case 12: return -0.707106781f; case 13: return -0.831469612f;
    case 14: return -0.923879533f; default: return -0.98078528f; } }
__device__ __forceinline__ constexpr float S32(int k) {
  switch (k) { case 0: return 0.f; case 1: return 0.195090322f; case 2: return 0.382683432f; case 3: return 0.555570233f; case 4: return 0.707106781f; case 5: return 0.831469612f; case 6: return 0.923879533f;
    case 7: return 0.98078528f; case 8: return 1.f; case 9: return 0.98078528f; case 10: return 0.923879533f; case 11: return 0.831469612f; case 12: return 0.707106781f; case 13: return 0.555570233f;
    case 14: return 0.382683432f; default: return 0.195090322f; } }
__device__ __forceinline__ constexpr int brev(int q, int bits) {
  return bits == 4 ? (((q & 1) << 3) | ((q & 2) << 1) | ((q & 4) >> 1) | ((q & 8) >> 3))
                   : (((q & 1) << 4) | ((q & 2) << 2) | (q & 4) | ((q & 8) >> 2) | ((q & 16) >> 4)); }
__device__ __forceinline__ int phys(int p) { return p + (p >> 5); }
template <int R, int HALF, bool INV> struct DftStage {
  static __device__ __forceinline__ void run(c32 (&x)[R]) {
#pragma unroll
    for (int blk = 0; blk < R; blk += 2 * HALF) {
#pragma unroll
      for (int j = 0; j < HALF; ++j) {
        const c32 a = x[blk + j], b = x[blk + j + HALF]; x[blk + j] = a + b; const c32 d = a - b;
        const int e = j * (R / (2 * HALF)) * (32 / R);
        if (e == 0) x[blk + j + HALF] = d;
        else if (e == 8) x[blk + j + HALF] = INV ? (c32){-d.y, d.x} : (c32){d.y, -d.x};
        else { const c32 wv = {C32(e), INV ? S32(e) : -S32(e)}; x[blk + j + HALF] = cmul(d, wv); }
      } }
    DftStage<R, HALF / 2, INV>::run(x);
  }
};
template <int R, bool INV> struct DftStage<R, 0, INV> { static __device__ __forceinline__ void run(c32 (&)[R]) {} };
template <int R, bool INV> __device__ __forceinline__ void dft_pow2(c32 (&x)[R]) { DftStage<R, R / 2, INV>::run(x); }
template <int R, int HALF> struct DitStage {
  static __device__ __forceinline__ void run(c32 (&x)[R]) {
#pragma unroll
    for (int blk = 0; blk < R; blk += 2 * HALF) {
#pragma unroll
      for (int j = 0; j < HALF; ++j) {
        const int e = j * (R / (2 * HALF)) * (32 / R);
        const c32 a = x[blk + j], b0 = x[blk + j + HALF];
        c32 b;
        if (e == 0) b = b0; else if (e == 8) b = (c32){-b0.y, b0.x}; else b = cmul(b0, (c32){C32(e), S32(e)});
        x[blk + j] = a + b; x[blk + j + HALF] = a - b;
      } }
    DitStage<R, HALF * 2>::run(x);
  }
};
template <int R> struct DitStage<R, R> { static __device__ __forceinline__ void run(c32 (&)[R]) {} };
template <int R> __device__ __forceinline__ void idft_dit(c32 (&x)[R]) { DitStage<R, 1>::run(x); }
template <int STRIDE, bool INV> __device__ __forceinline__ void pass16(c32* buf, int e0, float rev) {
  float rv = rev; asm volatile("" : "+v"(rv));
  const float cs = __builtin_amdgcn_cosf(rv), sn = __builtin_amdgcn_sinf(rv);
  const c32 w1 = {cs, INV ? sn : -sn};
  c32* p = buf + phys(e0); constexpr int PS = STRIDE + STRIDE / 32;
  c32 x[16];
  if (!INV) {
#pragma unroll
    for (int m = 0; m < 16; ++m) x[m] = p[PS * m];
    dft_pow2<16, false>(x);
    c32 w = w1; p[0] = x[0];
#pragma unroll
    for (int q = 1; q < 16; ++q) { p[PS * q] = cmul(x[brev(q, 4)], w); w = cmul(w, w1); }
  } else {
    c32 w = w1; x[0] = p[0];
#pragma unroll
    for (int q = 1; q < 16; ++q) { x[q] = cmul(p[PS * q], w); w = cmul(w, w1); }
    dft_pow2<16, true>(x);
#pragma unroll
    for (int m = 0; m < 16; ++m) p[PS * m] = x[brev(m, 4)];
  }
}
template <int MODE> __device__ __forceinline__ void mid32(c32* buf, h2* Hs, int j) {
  c32* p = buf + 33 * j; c32 x[32];
#pragma unroll
  for (int m = 0; m < 32; ++m) x[m] = p[m];
  dft_pow2<32, false>(x);
  if (MODE == 0) {
#pragma unroll
    for (int q = 0; q < 32; ++q) { const c32 v = x[brev(q, 5)]; Hs[q * 256 + j] = (h2){(_Float16)v.x, (_Float16)v.y}; }
  } else {
#pragma unroll
    for (int pp = 0; pp < 32; ++pp) { const h2 hv = Hs[brev(pp, 5) * 256 + j]; x[pp] = cmul(x[pp], (c32){(float)hv.x, (float)hv.y}); }
    idft_dit<32>(x);
#pragma unroll
    for (int m = 0; m < 32; ++m) p[m] = x[m];
  }
}
__device__ __forceinline__ void fwd2(c32* buf, int tid) {
  __syncthreads(); pass16<512, false>(buf, tid, (float)tid * (1.0f / 8192.0f));
  __syncthreads(); pass16<32, false>(buf, (tid >> 5) * 512 + (tid & 31), (float)(tid & 31) * (1.0f / 512.0f));
  __syncthreads();
}
__device__ __forceinline__ void conv(c32* buf, h2* Hs, int tid) {
  fwd2(buf, tid);
  if (tid < 256) mid32<1>(buf, Hs, tid);
  __syncthreads(); pass16<32, true>(buf, (tid >> 5) * 512 + (tid & 31), (float)(tid & 31) * (1.0f / 512.0f));
  __syncthreads(); pass16<512, true>(buf, tid, (float)tid * (1.0f / 8192.0f));
  __syncthreads();
}
__device__ __forceinline__ void item(int c, const bf16_t* HYT, const float* HK, const float* hy_bias, bf16_t* HYO, char* lds) {
  c32* buf = (c32*)lds; h2* H0 = (h2*)(lds + 67584); h2* H1 = H0 + 8192;
  const int tid = TIDX;
#pragma unroll 1
  for (int o = 0; o < 2; ++o) {
    const float* kp = HK + ((size_t)o * 256 + c) * 8192;
#pragma unroll
    for (int i = 0; i < 16; ++i) { const int n = tid + 512 * i; buf[phys(n)] = (c32){kp[n], 0.f}; }
    fwd2(buf, tid);
    if (tid < 256) mid32<0>(buf, o ? H1 : H0, tid);
    __syncthreads();
  }
  const float bias0 = hy_bias[c], bias1 = hy_bias[256 + c];
#pragma unroll 1
  for (int pr = 0; pr < 2; ++pr) {
    const bf16_t* v0 = HYT + ((size_t)(2 * pr) * 768 + c) * SEQ; const bf16_t* v1 = v0 + (size_t)768 * SEQ;
    c32 vv[8];
#pragma unroll
    for (int i = 0; i < 8; ++i) { const int t = tid + 512 * i; vv[i] = (c32){bf2f(v0[t]), bf2f(v1[t])}; buf[phys(t)] = vv[i]; buf[phys(t + 4096)] = (c32){0.f, 0.f}; }
    conv(buf, H0, tid);
#pragma unroll
    for (int i = 0; i < 8; ++i) { const int t = tid + 512 * i; const c32 y = buf[phys(t)];
      vv[i] = (c32){bf2f(v0[(size_t)256 * SEQ + t]) * (y.x * (1.0f / 8192.0f) + bias0 * vv[i].x), bf2f(v1[(size_t)256 * SEQ + t]) * (y.y * (1.0f / 8192.0f) + bias0 * vv[i].y)};
      buf[phys(t)] = vv[i]; buf[phys(t + 4096)] = (c32){0.f, 0.f}; }
    conv(buf, H1, tid);
#pragma unroll
    for (int i = 0; i < 8; ++i) { const int t = tid + 512 * i; const c32 y = buf[phys(t)];
      HYO[((size_t)(2 * pr) * 256 + c) * SEQ + t] = (bf16_t)f2bf(bf2f(v0[(size_t)512 * SEQ + t]) * (y.x * (1.0f / 8192.0f) + bias1 * vv[i].x));
      HYO[((size_t)(2 * pr + 1) * 256 + c) * SEQ + t] = (bf16_t)f2bf(bf2f(v1[(size_t)512 * SEQ + t]) * (y.y * (1.0f / 8192.0f) + bias1 * vv[i].y)); }
    __syncthreads();
  }
}
__device__ __forceinline__ void out_item(int it, const bf16_t* HYO, bf16_t* MIX, char* lds) {
  bf16_t (*T)[72] = (bf16_t (*)[72])lds;
  const int tid = TIDX, b = it >> 8, t0 = ((it >> 2) & 63) * 64, c0 = (it & 3) * 64;
  { const int cc = tid >> 3, t8 = (tid & 7) * 8; *(u32x4*)&T[cc][t8] = *(const u32x4*)(HYO + ((size_t)b * 256 + c0 + cc) * SEQ + t0 + t8); }
  __syncthreads();
  { const int tl = tid >> 3, c8 = (tid & 7) * 8; u32x4 o;
    o.x = (unsigned)T[c8][tl] | ((unsigned)T[c8 + 1][tl] << 16); o.y = (unsigned)T[c8 + 2][tl] | ((unsigned)T[c8 + 3][tl] << 16);
    o.z = (unsigned)T[c8 + 4][tl] | ((unsigned)T[c8 + 5][tl] << 16); o.w = (unsigned)T[c8 + 6][tl] | ((unsigned)T[c8 + 7][tl] << 16);
    *(u32x4*)(MIX + ((size_t)b * TPB + CTXL + t0 + tl) * DM + 768 + c0 + c8) = o; }
  __syncthreads();
}
}

#define LAS __attribute__((address_space(3)))
#define XB_TMO      128
#define XB_XCNT(j)  (256  + 64 * (j))
#define XB_XSUB(j)  (1280 + 64 * (j))
#define XB_XGEN(j)  (2304 + 64 * (j))
#define XB_TOP      3328
#define XB_TOPGEN   3392
#define XCD_BAR_WORDS 3456
#define XB_SPIN_CAP (1u << 18)

__device__ __forceinline__ unsigned xb_ld(unsigned* p)              { return __hip_atomic_load(p, __ATOMIC_RELAXED, __HIP_MEMORY_SCOPE_AGENT); }
__device__ __forceinline__ unsigned xb_add(unsigned* p, unsigned v) { return __hip_atomic_fetch_add(p, v, __ATOMIC_RELAXED, __HIP_MEMORY_SCOPE_AGENT); }
__device__ __forceinline__ unsigned xb_xcc_id() { return (unsigned)__builtin_amdgcn_s_getreg((3 << 11) | 20) & 0xFu; }
#define XB_SPIN(cond, bar) do { unsigned _sp = 0; while (cond) { __builtin_amdgcn_s_sleep(1); \
    if ((++_sp & 255u) == 0u) { if (xb_ld(&(bar)[XB_TMO])) break; if (_sp > XB_SPIN_CAP) { atomicAdd(&(bar)[XB_TMO], 1u); break; } } } } while (0)

struct XcdBarrier {
    unsigned* bar; unsigned x;
    volatile LAS unsigned* st;
};

__device__ __forceinline__ XcdBarrier xcd_barrier_post(unsigned* bar, volatile LAS unsigned* st) {
    XcdBarrier b; b.bar = bar; b.x = xb_xcc_id(); b.st = st;
    if (threadIdx.x == 0) (void)xb_add(&bar[XB_XCNT(b.x)], 1u);
    return b;
}
__device__ __forceinline__ void xcd_barrier_complete(unsigned* bar, unsigned x, unsigned& nloc, unsigned& nx) {
    const unsigned G = gridDim.x * gridDim.y * gridDim.z;
    unsigned sum, cnt, mine, sp = 0u;
    for (;;) {
        sum = 0u; cnt = 0u; mine = 0u;
#pragma unroll
        for (unsigned j = 0; j < 16; ++j) { const unsigned c = xb_ld(&bar[XB_XCNT(j)]); sum += c; cnt += (c > 0u) ? 1u : 0u; mine = (j == x) ? c : mine; }
        if (sum == G) break;
        __builtin_amdgcn_s_sleep(1);
        if ((++sp & 255u) == 0u) { if (xb_ld(&bar[XB_TMO])) break; if (sp > XB_SPIN_CAP) { atomicAdd(&bar[XB_TMO], 1u); break; } }
    }
    nloc = mine > 0u ? mine : 1u; nx = cnt > 0u ? cnt : 1u;
}

__device__ __forceinline__ void xcd_barrier(const XcdBarrier& b) {
    asm volatile("s_waitcnt vmcnt(0)" ::: "memory");
    __syncthreads();
    if (threadIdx.x == 0) {
        unsigned* bar = b.bar;
        __builtin_amdgcn_s_waitcnt(0);
        unsigned nloc = b.st[0], nx = b.st[1];
        if (nloc == 0u) { xcd_barrier_complete(bar, b.x, nloc, nx); b.st[0] = nloc; b.st[1] = nx; }
        const unsigned old = xb_add(&bar[XB_XSUB(b.x)], 1u);
        const unsigned gen = old / nloc;
        if (old + 1u == (gen + 1u) * nloc) {
            __builtin_amdgcn_fence(__ATOMIC_RELEASE, "agent");
            asm volatile("s_waitcnt vmcnt(0)" ::: "memory");
            const unsigned og = xb_add(&bar[XB_TOP], 1u);
            const unsigned tg = og / nx;
            if (og + 1u == (tg + 1u) * nx) xb_add(&bar[XB_TOPGEN], 1u);
            else XB_SPIN(xb_ld(&bar[XB_TOPGEN]) == tg, bar);
            __builtin_amdgcn_fence(__ATOMIC_ACQUIRE, "agent");
            xb_add(&bar[XB_XGEN(b.x)], 1u);
            asm volatile("s_waitcnt vmcnt(0)" ::: "memory");
        } else {
            XB_SPIN(xb_ld(&bar[XB_XGEN(b.x)]) == gen, bar);
            __builtin_amdgcn_fence(__ATOMIC_ACQUIRE, "agent");
            asm volatile("s_waitcnt vmcnt(0)" ::: "memory");
        }
    }
    __syncthreads();
}


struct MP { const float* in[33]; float* out; unsigned char* ws; };
typedef const float* const __attribute__((address_space(4))) * kargs_t;
#define KARGS() ({ kargs_t k_ = (kargs_t)__builtin_amdgcn_kernarg_segment_ptr(); asm volatile("" : "+s"(k_)); k_; })
#define WSP(K, off) ((unsigned char*)(K)[34] + (off))

__global__ void __launch_bounds__(NT, 2) mega(MP P) {
  cg::grid_group grid = cg::this_grid();
  extern __shared__ __attribute__((aligned(16))) char lds[];
  volatile LAS unsigned* xst = (volatile LAS unsigned*)(lds + LDS_BYTES - 16);
  if (threadIdx.x < 2) xst[threadIdx.x] = 0u;
  __syncthreads();
  { kargs_t K = KARGS(); (void)xcd_barrier_post((unsigned*)WSP(K, WS_CTL) + CT_BAR, xst); }
constexpr int CUT = 0;
#define XBAR_HERE() do { kargs_t Kb_ = KARGS(); XcdBarrier xb_; xb_.bar = (unsigned*)WSP(Kb_, WS_CTL) + CT_BAR; xb_.x = xb_xcc_id(); xb_.st = (volatile LAS unsigned*)(lds + LDS_BYTES - 16); xcd_barrier(xb_); } while (0)
#define SEAM() do { XBAR_HERE(); if (CUT > 0 && pass_ == 0 && ++nph_ == CUT) { pass_ = 1; goto again_; } } while (0)
  {
    kargs_t K = KARGS();
    st_adaln(K[1], K[3], K[4], K[5], (float*)WSP(K, WS_MODV), lds);
    st_rope((float*)WSP(K, WS_ROPE));
  }
  {
      kargs_t K = KARGS();
      st_weights(K[8], K[26], K[29], K[30], K[31], 0, (bf16_t*)WSP(K, WS_WIN), (bf16_t*)WSP(K, WS_WOUT), (bf16_t*)WSP(K, WS_WGU), (bf16_t*)WSP(K, WS_WD), lds);
    }
    { kargs_t K = KARGS(); const int bid = BIDX, G = GDIM;
      for (int it = bid; it < SEQ / 16; it += G) hyfilt_item<SEQ>(it, K[19] + 0 * 33 * 64, K[20] + 0 * 64, K[21] + 0 * 64, K[22] + 0 * 4096, K[23] + 0 * 64, K[24] + (size_t)0 * 65536, (float*)WSP(K, WS_HK), lds);
      if (true) for (int it = bid; it < CTXL / 16; it += G) hyfilt_item<CTXL>(it, K[19] + 0 * 33 * 64, K[20] + 0 * 64, K[21] + 0 * 64, K[22] + 0 * 4096, K[23] + 0 * 64, K[24] + (size_t)0 * 65536, (float*)WSP(K, WS_HKC), lds);
    }
  if (gridDim.x == 0x7fffffffu) grid.sync();
  XBAR_HERE();
  int pass_ = 0, nph_ = 0;
again_:
#pragma nounroll
  for (int layer = 0; layer < 2; ++layer) {
    const bool last = layer == 1;
    if (layer == 1) {
    {
      kargs_t K = KARGS();
      st_weights(K[8], K[26], K[29], K[30], K[31], layer, (bf16_t*)WSP(K, WS_WIN), (bf16_t*)WSP(K, WS_WOUT), (bf16_t*)WSP(K, WS_WGU), (bf16_t*)WSP(K, WS_WD), lds);
    }
    { kargs_t K = KARGS(); const int bid = BIDX, G = GDIM;
      for (int it = bid; it < SEQ / 16; it += G) hyfilt_item<SEQ>(it, K[19] + layer * 33 * 64, K[20] + layer * 64, K[21] + layer * 64, K[22] + layer * 4096, K[23] + layer * 64, K[24] + (size_t)layer * 65536, (float*)WSP(K, WS_HK), lds);
      if (!last) for (int it = bid; it < CTXL / 16; it += G) hyfilt_item<CTXL>(it, K[19] + layer * 33 * 64, K[20] + layer * 64, K[21] + layer * 64, K[22] + layer * 4096, K[23] + layer * 64, K[24] + (size_t)layer * 65536, (float*)WSP(K, WS_HKC), lds);
    }
    }
    { kargs_t K = KARGS();
      const float* xl_src = layer == 0 ? K[0] : K[33]; const float* xc_src = layer == 0 ? K[2] : (const float*)WSP(K, WS_XC);
      st_normmod(xl_src, xc_src, K[6] + layer * 1024, (const float*)WSP(K, WS_MODV) + (size_t)layer * 5 * 6144, 0, 1024, (bf16_t*)WSP(K, WS_H), lds);
    }
    SEAM();
    {
      kargs_t K = KARGS();
      pg8::Gemm g{1024, 1024, 1024}; SchedDense S{MTOK / 256, NPAD / 256, (int)GDIM, BIDX, 0, (const char*)WSP(K, WS_H), (const char*)WSP(K, WS_WIN), (size_t)256 * 1024 * 2, (size_t)256 * 1024 * 2};
      EpiInProj E{(bf16_t*)WSP(K, WS_QK), (bf16_t*)WSP(K, WS_VZ), (bf16_t*)WSP(K, WS_XBC), (bf16_t*)WSP(K, WS_HY), (float*)WSP(K, WS_DT)};
      pg8::gemm_phase<EpiInProj, SchedDense, true, true>((PG8_LAS unsigned char*)lds, g, S, E);
    }
    SEAM();
    {
      kargs_t K = KARGS();
      st_prep_qk((bf16_t*)WSP(K, WS_QK), K[9] + layer * 64, K[10] + layer * 64, (const float*)WSP(K, WS_ROPE));
    }
    { kargs_t K = KARGS();
      st_prep_hy((const bf16_t*)WSP(K, WS_HY), K[17] + layer * 3 * 768, K[18] + layer * 768, (bf16_t*)WSP(K, WS_HYT), last ? 0 : 1, lds);
    }
    { kargs_t K = KARGS(); const int bid = BIDX, G = GDIM;
      for (int it = bid; it < 4 * 34 * 6; it += G)
        ssd1_item(it, (const bf16_t*)WSP(K, WS_XBC), (const float*)WSP(K, WS_DT), K[11] + layer * 3 * 640, K[12] + layer * 640, K[13] + layer * 12, K[14] + layer * 12,
                  (float*)WSP(K, WS_Y), (float*)WSP(K, WS_ST), (float*)WSP(K, WS_DEC), lds);
    }
    SEAM();
    {
      { kargs_t K2 = KARGS(); st_ssd_scan2((float*)WSP(K2, WS_ST), (const float*)WSP(K2, WS_DEC)); }
      const int bid = BIDX, G = GDIM;
#define P4_ATT(bb, hq, qrow_, nt_) do { kargs_t K = KARGS(); const int kvh_ = (hq) / 3; \
          const attn_body::bf16* QKp = (const attn_body::bf16*)WSP(K, WS_QK); const attn_body::bf16* VZp = (const attn_body::bf16*)WSP(K, WS_VZ); \
          attn_body::attn_unit<8>(QKp + (size_t)(qrow_) * 512 + (hq) * 64, QKp + (size_t)(bb) * TPB * 512 + 384 + kvh_ * 64, VZp + (size_t)(bb) * TPB * 512 + kvh_ * 64, \
                                  (attn_body::bf16*)WSP(K, WS_H) + (size_t)(qrow_) * 1024 + (hq) * 64, (nt_), lds); } while (0)
#define P4_FFT(cch) do { kargs_t K = KARGS(); hyf::item((cch), (const bf16_t*)WSP(K, WS_HYT), (const float*)WSP(K, WS_HK), K[25] + layer * 512, (bf16_t*)WSP(K, WS_HY), lds); } while (0)
#define P4_CHY(itm) do { kargs_t K = KARGS(); hyconv_ctx_item((itm), (const bf16_t*)WSP(K, WS_HYT) + (size_t)4 * 768 * SEQ, (const float*)WSP(K, WS_HKC), K[25] + layer * 512, (bf16_t*)WSP(K, WS_H), lds); } while (0)
      {
        const int x = bid & 7, y = bid >> 3, bb = x >> 1, kvh = x & 1;
        const int nun = y < 16 ? 2 : 1, natt = nun + ((!last && y < 3) ? 1 : 0);
#pragma unroll 1
        for (int k = 0; k < natt; ++k) { int hq, qrow, nt;
          if (k < nun) { const int v = y < 16 ? y + 16 * k : 16 + y; hq = 3 * kvh + (v >> 4); qrow = bb * TPB + CTXL + (v & 15) * 256; nt = TPB / 64; }
          else { hq = 3 * kvh + y; qrow = bb * TPB; nt = CTXL / 64; }
          P4_ATT(bb, hq, qrow, nt); }
        if (y >= 16) {
#pragma unroll 1
          for (int k = 0; k < 2; ++k) { const int cch = ((y - 16) * 8 + x) * 2 + k; P4_FFT(cch); } }
        if (!last && y >= 3 && y < 11) { P4_CHY((y - 3) * 8 + x); }
      }
      (void)G;
#undef P4_ATT
#undef P4_FFT
#undef P4_CHY
    }
    SEAM();
    {
      kargs_t K = KARGS();
      { const int bid = BIDX, G = GDIM, nit = last ? 4 * 32 * 2 : 4 * 34 * 2;
        for (int it = bid; it < nit; it += G) { const int g = it & 1, bc = it >> 1; const int b = last ? bc >> 5 : bc / 34, cidx = last ? 2 + (bc & 31) : bc % 34;
          ssd3_item(b, cidx, g, (const bf16_t*)WSP(K, WS_XBC), (const bf16_t*)WSP(K, WS_VZ), (const float*)WSP(K, WS_DT), K[11] + layer * 3 * 640, K[12] + layer * 640, K[13] + layer * 12, K[14] + layer * 12,
                    K[15] + layer * 6, K[16] + layer * 384, (const float*)WSP(K, WS_Y), (const float*)WSP(K, WS_ST), (bf16_t*)WSP(K, WS_H), lds); } }
      { const int bid = BIDX, G = GDIM; for (int it = bid; it < 1024; it += G) hyf::out_item(it, (const bf16_t*)WSP(K, WS_HY), (bf16_t*)WSP(K, WS_H), lds); }
      const int t = TIDX; if (BIDX == 0 && t < 256) ((int*)WSP(K, WS_CTL))[t] = 0;
      { int* stok = (int*)WSP(K, WS_MOEM + 384 * 1024); for (int i = BIDX * NT + t; i < MOE_ROWS; i += GDIM * NT) stok[i] = -1; }
    }
    SEAM();
    {
      kargs_t K = KARGS();
      const float* xl_src = layer == 0 ? K[0] : K[33]; const float* xc_src = layer == 0 ? K[2] : (const float*)WSP(K, WS_XC);
      pg8::Gemm g{1024, 1024, 1024}; SchedDense S{last ? 64 : 68, 4, (int)GDIM, BIDX, last ? 1 : 0, (const char*)WSP(K, WS_H), (const char*)WSP(K, WS_WOUT), (size_t)256 * 1024 * 2, (size_t)256 * 1024 * 2};
      EpiOutProj E{xl_src, xc_src, (float*)K[33], (float*)WSP(K, WS_XC), (const float*)WSP(K, WS_MODV) + (size_t)layer * 5 * 6144 + 2048};
      pg8::gemm_phase<EpiOutProj, SchedDense, true, true>((PG8_LAS unsigned char*)lds, g, S, E);
    }
    SEAM();
    {
      kargs_t K = KARGS();
      st_router(K[33], (const float*)WSP(K, WS_XC), K[7] + layer * 1024, (const float*)WSP(K, WS_MODV) + (size_t)layer * 5 * 6144, K[27], K[28], (bf16_t*)WSP(K, WS_H), (int*)WSP(K, WS_CTL),
                (int*)WSP(K, WS_MOEM), (float*)WSP(K, WS_MOEM + 128 * 1024), last ? 1 : 0, lds);
    }
    SEAM();
    { kargs_t K = KARGS();
      st_moe_gather((const bf16_t*)WSP(K, WS_H), (bf16_t*)WSP(K, WS_H2S), (int*)WSP(K, WS_CTL), (const int*)WSP(K, WS_MOEM), (const float*)WSP(K, WS_MOEM + 128 * 1024),
                    (int*)WSP(K, WS_MOEM + 384 * 1024), (float*)WSP(K, WS_MOEM + 512 * 1024), last ? 1 : 0, lds);
    }
    SEAM();
    { kargs_t K = KARGS();
      pg8::Gemm g{1024, 1024, 1024}; SchedMoe S{(int)GDIM, BIDX, 1, (const int*)WSP(K, WS_CTL), (const char*)WSP(K, WS_H2S), (size_t)256 * 1024 * 2, (const char*)WSP(K, WS_WGU)};
      EpiMoe1 E{(bf16_t*)WSP(K, WS_ACT), (const float*)WSP(K, WS_MOEM + 512 * 1024)};
      pg8::gemm_phase<EpiMoe1, SchedMoe, true, true>((PG8_LAS unsigned char*)lds, g, S, E);
    }
    SEAM();
    { kargs_t K = KARGS();
      pg8::Gemm g{256, 512, 256}; SchedMoe S{(int)GDIM, BIDX, 2, (const int*)WSP(K, WS_CTL), (const char*)WSP(K, WS_ACT), (size_t)256 * 512 * 2, (const char*)WSP(K, WS_WD)};
      EpiMoe2 E{(float*)K[33], (float*)WSP(K, WS_XC), (const float*)WSP(K, WS_MODV) + (size_t)layer * 5 * 6144 + 5120, (const int*)WSP(K, WS_MOEM + 384 * 1024)};
      pg8::gemm_phase<EpiMoe2, SchedMoe, true, true>((PG8_LAS unsigned char*)lds, g, S, E);
    }
    SEAM();
  }
  { kargs_t K = KARGS(); st_final((float*)K[33], K[32]); }
}

extern "C" void kernel_launch(void* const* d_in, const int* in_sizes, int n_in, void* d_out, int out_size, void* d_ws, size_t ws_size, hipStream_t stream) {
  if (n_in != 33 || ws_size < WS_END) { fprintf(stderr, "kernel_launch: unexpected n_in %d / ws %zu\n", n_in, ws_size); return; }
  static int grid_blocks = 0;
  if (!grid_blocks) {
    int dev = 0, cus = 0, per_cu = 0;
    (void)hipGetDevice(&dev);
    (void)hipDeviceGetAttribute(&cus, hipDeviceAttributeMultiprocessorCount, dev);
    (void)hipFuncSetAttribute((const void*)mega, hipFuncAttributeMaxDynamicSharedMemorySize, LDS_BYTES);
    (void)hipOccupancyMaxActiveBlocksPerMultiprocessor(&per_cu, mega, NT, LDS_BYTES);
    if (per_cu < 1) per_cu = 1;
    if (per_cu > 2) per_cu = 2;
    grid_blocks = 256;
    if (cus != 256 || per_cu < 1) fprintf(stderr, "kernel_launch: expected 256 CUs with >= 1 workgroup each (got %d CUs, %d per CU)\n", cus, per_cu);
  }
  (void)hipMemsetAsync((char*)d_ws + WS_CTL + (size_t)CT_BAR * 4, 0, (size_t)XCD_BAR_WORDS * 4, stream);
  MP p{};
  for (int i = 0; i < 33; ++i) p.in[i] = (const float*)d_in[i];
  p.out = (float*)d_out; p.ws = (unsigned char*)d_ws;
  void* args[] = {&p};
  hipError_t e = hipLaunchCooperativeKernel((const void*)mega, dim3(grid_blocks), dim3(NT), args, LDS_BYTES, stream);
  if (e != hipSuccess) fprintf(stderr, "cooperative launch failed: %s (grid %d)\n", hipGetErrorString(e), grid_blocks);
}
```

```cpp
#include <hip/hip_runtime.h>
#include <hip/hip_cooperative_groups.h>
#include <cstdio>
#include <cstdint>
namespace cg = cooperative_groups;

typedef unsigned short bf16_t;
typedef short bf16x8 __attribute__((ext_vector_type(8)));
typedef float f32x4 __attribute__((ext_vector_type(4)));
typedef unsigned u32x4 __attribute__((ext_vector_type(4)));
typedef unsigned u32x2 __attribute__((ext_vector_type(2)));

constexpr int NB = 4, SEQ = 4096, CTXL = 256, DM = 1024, TPB = 4352, MTOK = NB * TPB;
constexpr int DIN = 2444, NPAD = 2560;
constexpr float EPS = 1e-6f;
constexpr float C2 = 0.125f * 1.4426950408889634f;
constexpr int MOE_ROWS = 23552;
constexpr int NT = 512;
constexpr int LDS_BYTES = 147456;

constexpr size_t MiB = 1u << 20;
constexpr size_t WS_CTL = 0;
constexpr size_t WS_MODV = 1 * MiB;
constexpr size_t WS_ROPE = 2 * MiB;
constexpr size_t WS_MOEM = 3 * MiB;
constexpr size_t WS_DT = 4 * MiB;
constexpr size_t WS_HKC = 5 * MiB;
constexpr size_t WS_XC = 6 * MiB;
constexpr size_t WS_WIN = 10 * MiB;
constexpr size_t WS_WOUT = 15 * MiB;
constexpr size_t WS_WGU = 17 * MiB;
constexpr size_t WS_WD = 33 * MiB;
constexpr size_t WS_HK = 41 * MiB;
constexpr size_t WS_H = 57 * MiB;
constexpr size_t WS_QK = 91 * MiB;
constexpr size_t WS_VZ = 108 * MiB;
constexpr size_t WS_XBC = 125 * MiB;
constexpr size_t WS_HY = WS_XBC + (size_t)MTOK * 768 * 2;
constexpr size_t WS_HYT = WS_HY + (size_t)MTOK * 768 * 2;
constexpr size_t WS_ST = WS_HYT + (size_t)MTOK * 768 * 2;
constexpr size_t WS_Y = WS_ST + (size_t)4 * 34 * 2 * 6 * 4096 * 4;
constexpr size_t WS_END = WS_Y + (size_t)MTOK * 384 * 4;
constexpr size_t WS_DEC = WS_DT + 900 * 1024;
constexpr size_t WS_H2S = WS_QK;
constexpr size_t WS_ACT = WS_H2S + (size_t)MOE_ROWS * 1024 * 2;
static_assert(WS_END <= 256 * MiB, "ws");
static_assert(WS_ACT + (size_t)MOE_ROWS * 512 * 2 <= WS_HYT, "moe alias");

constexpr int CT_CNT = 0, CT_FILL = 32, CT_BASE = 64, CT_NT = 96, CT_TP = 128;
constexpr int CT_BAR = 4096;
constexpr int CT_CNTB = 8192;

__device__ __forceinline__ int opq_v(int v) { asm volatile("" : "+v"(v)); return v; }
__device__ __forceinline__ int opq_s(int v) { asm volatile("" : "+s"(v)); return v; }
#define TIDX opq_v((int)threadIdx.x)
#define BIDX opq_s((int)blockIdx.x)
#define GDIM opq_s((int)gridDim.x)
__device__ __forceinline__ unsigned f2bf(float f) { unsigned u = __float_as_uint(f); return (u + 0x7fffu + ((u >> 16) & 1u)) >> 16; }
__device__ __forceinline__ unsigned pk2bf(float lo, float hi) { return f2bf(lo) | (f2bf(hi) << 16); }
__device__ __forceinline__ float bf2f(bf16_t h) { return __uint_as_float(((unsigned)h) << 16); }
__device__ __forceinline__ float wave_sum(float v) {
#pragma unroll
  for (int o = 1; o < 64; o <<= 1) v += __shfl_xor(v, o);
  return v;
}
__device__ __forceinline__ float siluf(float v) { return v / (1.0f + __expf(-v)); }
__device__ __forceinline__ float* xrow(const float* xl, const float* xc, int r) {
  const int b = r / TPB, j = r - b * TPB;
  return (float*)(j < CTXL ? xc + ((size_t)b * CTXL + j) * DM : xl + ((size_t)b * SEQ + (j - CTXL)) * DM);
}
__device__ __forceinline__ int mrow_of(int r) { const int b = r / TPB, j = r - b * TPB; return j < CTXL ? 4 : b; }

__device__ __forceinline__ void st_adaln(const float* c, const float* c_ctx, const float* w_mod, const float* b_mod, float* modv, char* lds) {
  float (*sc)[1024] = (float (*)[1024])lds;
  float (*red)[5][64] = (float (*)[5][64])(lds + 5 * 1024 * 4);
  const int tid = TIDX;
  for (int it = BIDX; it < 192; it += GDIM) {
    const int layer = it / 96, n0 = (it % 96) * 64;
    for (int i = tid; i < 5 * 1024; i += NT) { const int r = i >> 10, k = i & 1023; const float v = r < 4 ? c[r * 1024 + k] : c_ctx[k]; sc[r][k] = v / (1.0f + expf(-v)); }
    __syncthreads();
    const int kg = tid >> 6, n = tid & 63;
    float acc[5] = {0.f, 0.f, 0.f, 0.f, 0.f};
#pragma unroll 16
    for (int k = kg; k < 1024; k += 8) { const float w = w_mod[((size_t)layer * 1024 + k) * 6144 + n0 + n];
#pragma unroll
      for (int r = 0; r < 5; ++r) acc[r] += sc[r][k] * w; }
#pragma unroll
    for (int r = 0; r < 5; ++r) red[kg][r][n] = acc[r];
    __syncthreads();
    if (tid < 320) { const int r = tid >> 6, nn = tid & 63; float s = 0.f;
#pragma unroll
      for (int g = 0; g < 8; ++g) s += red[g][r][nn];
      modv[((size_t)layer * 5 + r) * 6144 + n0 + nn] = s + b_mod[layer * 6144 + n0 + nn]; }
    __syncthreads();
  }
}
__device__ __forceinline__ void st_rope(float* rope) {
  for (int i = BIDX * NT + TIDX; i < 4096 * 32; i += GDIM * NT) {
    const int t = i >> 5, d = i & 31, m = d & 15;
    const float inv = exp2f(-(float)(2 * m) * (13.287712379549449f / 32.0f));
    const float pos = (float)(d < 16 ? (t >> 6) : (t & 63));
    float rev = pos * inv * 0.15915494309189535f; rev -= floorf(rev);
    rope[2 * i] = __builtin_amdgcn_cosf(rev); rope[2 * i + 1] = __builtin_amdgcn_sinf(rev);
  }
}

__device__ __forceinline__ void st_normmod(const float* xl, const float* xc, const float* g, const float* modv_layer, int off_sh, int off_sc, bf16_t* H, char* lds) {
  float* mA = (float*)lds; float* mB = mA + 5 * 1024;
  const int tid = TIDX, lane = tid & 63, gw = BIDX * 8 + (tid >> 6), ngw = GDIM * 8;
  for (int idx = tid; idx < 5 * 1024; idx += NT) { const int m = idx >> 10, k = idx & 1023; mA[idx] = g[k] * (1.f + modv_layer[(size_t)m * 6144 + off_sc + k]); mB[idx] = modv_layer[(size_t)m * 6144 + off_sh + k]; }
  __syncthreads();
  for (int rb = gw; rb < MTOK; rb += 3 * ngw) {
    f32x4 v[3][4]; float rstd[3];
#pragma unroll
    for (int u = 0; u < 3; ++u) { const int r = rb + u * ngw; const float* xr = xrow(xl, xc, r < MTOK ? r : MTOK - 1);
#pragma unroll
      for (int j = 0; j < 4; ++j) v[u][j] = *(const f32x4*)(xr + 4 * lane + 256 * j); }
#pragma unroll
    for (int u = 0; u < 3; ++u) { float ss = 0.f;
#pragma unroll
      for (int j = 0; j < 4; ++j) ss += v[u][j].x * v[u][j].x + v[u][j].y * v[u][j].y + v[u][j].z * v[u][j].z + v[u][j].w * v[u][j].w;
      rstd[u] = rsqrtf(wave_sum(ss) * (1.0f / DM) + EPS); }
#pragma unroll
    for (int u = 0; u < 3; ++u) { const int r = rb + u * ngw;
      if (r < MTOK) { const int mo = mrow_of(r) * 1024;
#pragma unroll
        for (int j = 0; j < 4; ++j) { const int k = 4 * lane + 256 * j;
          const f32x4 a4 = *(const f32x4*)(mA + mo + k), b4 = *(const f32x4*)(mB + mo + k); const f32x4 o = v[u][j] * rstd[u] * a4 + b4;
          u32x2 w; w.x = pk2bf(o.x, o.y); w.y = pk2bf(o.z, o.w);
          *(u32x2*)(H + (size_t)r * DM + k) = w; } } }
  }
  __syncthreads();
}

template <int MODE> __device__ __forceinline__ void tr_tile(const float* src, const float* src2, int ldsrc, int K, bf16_t* out, int n0, int k0, char* lds) {
  float (*tile)[65] = (float (*)[65])lds;
  const int tid = TIDX;
#pragma unroll
  for (int i = 0; i < 8; ++i) { const int kk = (tid >> 6) + 8 * i, nn = tid & 63, n = n0 + nn; float v = 0.f;
    if (MODE == 0) { const int col = n < 1676 ? n : (n < 1792 ? -1 : n - 116); if (col >= 0) v = src[(size_t)(k0 + kk) * ldsrc + col]; }
    else if (MODE == 1) { v = src[(size_t)(k0 + kk) * ldsrc + n]; }
    else { v = (n & 1) ? src2[(size_t)(k0 + kk) * ldsrc + (n >> 1)] : src[(size_t)(k0 + kk) * ldsrc + (n >> 1)]; }
    tile[kk][nn] = v; }
  __syncthreads();
#pragma unroll
  for (int i = 0; i < 4; ++i) { const int nn = (tid >> 5) + 16 * i, kk = (tid & 31) * 2;
    *(unsigned*)(out + (size_t)(n0 + nn) * K + k0 + kk) = f2bf(tile[kk][nn]) | (f2bf(tile[kk + 1][nn]) << 16); }
  __syncthreads();
}
template <int MODE> __device__ __forceinline__ void tr_wave_item(const float* src, const float* src2, int ldsrc, int K, bf16_t* out, int n0, int k0, float* scr, int lane) {
  const int nn = lane & 31, n = n0 + nn;
#pragma unroll 8
  for (int i = 0; i < 32; ++i) { const int kk = 2 * i + (lane >> 5); float v = 0.f;
    if (MODE == 0) { const int col = n < 1676 ? n : (n < 1792 ? -1 : n - 116); if (col >= 0) v = src[(size_t)(k0 + kk) * ldsrc + col]; }
    else if (MODE == 1) v = src[(size_t)(k0 + kk) * ldsrc + n];
    else v = (n & 1) ? src2[(size_t)(k0 + kk) * ldsrc + (n >> 1)] : src[(size_t)(k0 + kk) * ldsrc + (n >> 1)];
    scr[kk * 33 + nn] = v; }
  asm volatile("s_waitcnt lgkmcnt(0)" ::: "memory");
  const int c = lane & 7;
#pragma unroll
  for (int j = 0; j < 4; ++j) { const int nr = (lane >> 3) + 8 * j; const float* sp = scr + (8 * c) * 33 + nr;
    u32x4 o; o.x = f2bf(sp[0]) | (f2bf(sp[33]) << 16); o.y = f2bf(sp[66]) | (f2bf(sp[99]) << 16); o.z = f2bf(sp[132]) | (f2bf(sp[165]) << 16); o.w = f2bf(sp[198]) | (f2bf(sp[231]) << 16);
    *(u32x4*)(out + (size_t)(n0 + nr) * K + k0 + 8 * c) = o; }
  asm volatile("s_waitcnt lgkmcnt(0)" ::: "memory");
}
__device__ __forceinline__ void st_weights(const float* w_in, const float* w_out, const float* w_gate, const float* w_up, const float* w_down, int layer,
                                           bf16_t* WIN, bf16_t* WOUT, bf16_t* WGU, bf16_t* WD, char* lds) {
  const int tid = TIDX, lane = tid & 63, w = tid >> 6; float* scr = (float*)lds + w * (64 * 33);
  for (int it = BIDX * 8 + w; it < 7936; it += GDIM * 8) {
    if (it < 1280) tr_wave_item<0>(w_in + (size_t)layer * 1024 * DIN, nullptr, DIN, 1024, WIN, (it % 80) * 32, (it / 80) * 64, scr, lane);
    else if (it < 1792) { const int i2 = it - 1280; tr_wave_item<1>(w_out + (size_t)layer * 1024 * 1024, nullptr, 1024, 1024, WOUT, (i2 & 31) * 32, (i2 >> 5) * 64, scr, lane); }
    else if (it < 5888) { const int i2 = it - 1792, e = i2 >> 8, t = i2 & 255;
      tr_wave_item<2>(w_gate + ((size_t)layer * 16 + e) * 1024 * 256, w_up + ((size_t)layer * 16 + e) * 1024 * 256, 256, 1024, WGU + (size_t)e * 512 * 1024, (t & 15) * 32, (t >> 4) * 64, scr, lane); }
    else { const int i2 = it - 5888, e = i2 >> 7, t = i2 & 127;
      tr_wave_item<1>(w_down + ((size_t)layer * 16 + e) * 256 * 1024, nullptr, 1024, 256, WD + (size_t)e * 1024 * 256, (t & 31) * 32, (t >> 5) * 64, scr, lane); }
  }
  __syncthreads();
}

template <class P> __device__ __forceinline__ void st_gemm(const P& p, int ntm, int ntn, char* lds) {
  bf16_t (*As)[72] = (bf16_t (*)[72])lds;
  bf16_t (*Bs)[72] = (bf16_t (*)[72])(lds + 256 * 72 * 2);
  const int tid = TIDX, lane = tid & 63, w = tid >> 6;
  for (int it = BIDX; it < ntm * ntn; it += GDIM) {
    const int mt = it / ntn, nt = it % ntn;
    if (!p.valid(mt)) continue;
    const int m0 = mt * 256, n0 = nt * 128;
    f32x4 acc[2][8];
#pragma unroll
    for (int a = 0; a < 2; ++a)
#pragma unroll
      for (int b = 0; b < 8; ++b) acc[a][b] = (f32x4){0.f, 0.f, 0.f, 0.f};
    const int K = p.K;
    for (int k0 = 0; k0 < K; k0 += 64) {
#pragma unroll
      for (int i = 0; i < 4; ++i) { const int ch = tid + NT * i, r = ch >> 3, kc = (ch & 7) * 8;
        const bf16_t* ap = p.arow(m0 + r); *(u32x4*)&As[r][kc] = *(const u32x4*)(ap + k0 + kc); }
#pragma unroll
      for (int i = 0; i < 2; ++i) { const int ch = tid + NT * i, r = ch >> 3, kc = (ch & 7) * 8;
        const bf16_t* bp = p.brow(mt, n0 + r, k0); *(u32x4*)&Bs[r][kc] = *(const u32x4*)(bp + kc); }
      __syncthreads();
#pragma unroll
      for (int kk = 0; kk < 2; ++kk) {
        bf16x8 a[2], b[8];
#pragma unroll
        for (int mi = 0; mi < 2; ++mi) a[mi] = *(const bf16x8*)&As[32 * w + 16 * mi + (lane & 15)][kk * 32 + 8 * (lane >> 4)];
#pragma unroll
        for (int ni = 0; ni < 8; ++ni) b[ni] = *(const bf16x8*)&Bs[16 * ni + (lane & 15)][kk * 32 + 8 * (lane >> 4)];
#pragma unroll
        for (int mi = 0; mi < 2; ++mi)
#pragma unroll
          for (int ni = 0; ni < 8; ++ni) acc[mi][ni] = __builtin_amdgcn_mfma_f32_16x16x32_bf16(a[mi], b[ni], acc[mi][ni], 0, 0, 0);
      }
      __syncthreads();
    }
    p.epi(acc, mt, m0, n0, w, lane);
  }
}

struct PInProj {
  const bf16_t* H; const bf16_t* W; bf16_t *QK, *VZ, *XBC, *HY; float* DT; int K;
  __device__ bool valid(int) const { return true; }
  __device__ const bf16_t* arow(int m) const { return H + (size_t)m * DM; }
  __device__ const bf16_t* brow(int, int n, int k0) const { return W + (size_t)n * DM + k0; }
  __device__ void epi(const f32x4 (&acc)[2][8], int, int m0, int n0, int w, int lane) const {
#pragma unroll
    for (int mi = 0; mi < 2; ++mi)
#pragma unroll
      for (int ni = 0; ni < 8; ++ni)
#pragma unroll
        for (int rg = 0; rg < 4; ++rg) { const int row = m0 + 32 * w + 16 * mi + 4 * (lane >> 4) + rg, col = n0 + 16 * ni + (lane & 15); const float v = acc[mi][ni][rg];
          if (col < 512) QK[(size_t)row * 512 + col] = (bf16_t)f2bf(v);
          else if (col < 1024) VZ[(size_t)row * 512 + col - 512] = (bf16_t)f2bf(v);
          else if (col < 1792) { XBC[(size_t)row * 768 + col - 1024] = (bf16_t)f2bf(v); if (col >= 1664 && col < 1676) DT[(size_t)row * 12 + col - 1664] = v; }
          else HY[(size_t)row * 768 + col - 1792] = (bf16_t)f2bf(v); }
  }
};
struct POutProj {
  const bf16_t* A; const bf16_t* W; const float *xl_src, *xc_src; float *xl_dst, *xc_dst; const float* gate;   int skip_ctx; int K;
  __device__ bool valid(int mt) const { return !(skip_ctx && ((mt * 256) % TPB) < CTXL); }
  __device__ const bf16_t* arow(int m) const { return A + (size_t)m * DM; }
  __device__ const bf16_t* brow(int, int n, int k0) const { return W + (size_t)n * DM + k0; }
  __device__ void epi(const f32x4 (&acc)[2][8], int, int m0, int n0, int w, int lane) const {
#pragma unroll
    for (int mi = 0; mi < 2; ++mi)
#pragma unroll
      for (int rg = 0; rg < 4; ++rg) { const int row = m0 + 32 * w + 16 * mi + 4 * (lane >> 4) + rg;
        const float* xs = xrow(xl_src, xc_src, row); float* xd = xrow(xl_dst, xc_dst, row); const float* gt = gate + (size_t)mrow_of(row) * 6144;
#pragma unroll
        for (int ni = 0; ni < 8; ++ni) { const int col = n0 + 16 * ni + (lane & 15); xd[col] = xs[col] + gt[col] * acc[mi][ni][rg]; } }
  }
};
__device__ __forceinline__ void pair_experts(int pidx, int& eA, int& eB) {
  const int g = pidx / 6, t = pidx - 6 * g; const int i = t < 3 ? 0 : (t < 5 ? 1 : 2); const int j = t < 3 ? t + 1 : (t < 5 ? t - 1 : 3);
  eA = 4 * g + i; eB = 4 * g + j;
}
struct PMoe1 {
  const bf16_t* H2S; const bf16_t* WGU; bf16_t* ACT; const int* ctl; const float* sorted_w; int K;
  __device__ bool valid(int mt) const { return mt < ctl[CT_NT]; }
  __device__ const bf16_t* arow(int m) const { return H2S + (size_t)m * DM; }
  __device__ const bf16_t* brow(int mt, int n, int k0) const { int eA, eB; pair_experts(ctl[CT_TP + mt], eA, eB); const int e = n < 512 ? eA : eB;
    return WGU + ((size_t)e * 512 + (n & 511)) * DM + k0; }
  __device__ void epi(const f32x4 (&acc)[2][8], int, int m0, int n0, int w, int lane) const {
    const int half = n0 >> 9, tb = (n0 & 511) >> 7;
#pragma unroll
    for (int mi = 0; mi < 2; ++mi)
#pragma unroll
      for (int rg = 0; rg < 4; ++rg) { const int slot = m0 + 32 * w + 16 * mi + 4 * (lane >> 4) + rg; const float wt = sorted_w[2 * slot + half];
#pragma unroll
        for (int ni = 0; ni < 4; ++ni) { const float g = acc[mi][ni][rg], u = acc[mi][ni + 4][rg]; const int j = 64 * tb + 16 * ni + (lane & 15);
          ACT[(size_t)slot * 512 + half * 256 + j] = (bf16_t)f2bf(siluf(g) * u * wt); } }
  }
};
struct PMoe2 {
  const bf16_t* ACT; const bf16_t* WD; float *xl, *xc; const float* gate;   const int* ctl; const int* sorted_tok; int K;
  __device__ bool valid(int mt) const { return mt < ctl[CT_NT]; }
  __device__ const bf16_t* arow(int m) const { return ACT + (size_t)m * 512; }
  __device__ const bf16_t* brow(int mt, int n, int k0) const { int eA, eB; pair_experts(ctl[CT_TP + mt], eA, eB); const int e = k0 < 256 ? eA : eB;
    return WD + ((size_t)e * 1024 + n) * 256 + (k0 & 255); }
  __device__ void epi(const f32x4 (&acc)[2][8], int, int m0, int n0, int w, int lane) const {
#pragma unroll
    for (int mi = 0; mi < 2; ++mi)
#pragma unroll
      for (int rg = 0; rg < 4; ++rg) { const int slot = m0 + 32 * w + 16 * mi + 4 * (lane >> 4) + rg; const int r = sorted_tok[slot];
        if (r >= 0) { float* xd = xrow(xl, xc, r); const float* gt = gate + (size_t)mrow_of(r) * 6144;
#pragma unroll
          for (int ni = 0; ni < 8; ++ni) { const int col = n0 + 16 * ni + (lane & 15); xd[col] += gt[col] * acc[mi][ni][rg]; } } }
  }
};

__device__ __forceinline__ void st_prep_qk(bf16_t* QK, const float* qn, const float* kn, const float* rope) {
  const int lane = TIDX & 63, gw = BIDX * 8 + (TIDX >> 6), ngw = GDIM * 8, hh = lane >> 3, sub = lane & 7;
  float gn[8];
#pragma unroll
  for (int e = 0; e < 8; ++e) gn[e] = ((hh < 6 ? qn : kn) + sub * 8)[e] * (hh < 6 ? C2 : 1.0f);
  for (int rb = gw; rb < MTOK; rb += 3 * ngw) {
    bf16x8 raw[3]; f32x4 rp4[3][4];
#pragma unroll
    for (int u = 0; u < 3; ++u) { const int r = rb + u * ngw < MTOK ? rb + u * ngw : MTOK - 1; const int j = r % TPB, t = j >= CTXL ? j - CTXL : 0;
      raw[u] = *(const bf16x8*)(QK + (size_t)r * 512 + hh * 64 + sub * 8);
      const float* rp = rope + ((size_t)t * 32 + (sub & 3) * 8) * 2;
#pragma unroll
      for (int q = 0; q < 4; ++q) rp4[u][q] = *(const f32x4*)(rp + 4 * q); }
#pragma unroll
    for (int u = 0; u < 3; ++u) { const int r = rb + u * ngw; const int j = (r < MTOK ? r : MTOK - 1) % TPB;
      float v[8]; float ss = 0.f;
#pragma unroll
      for (int e = 0; e < 8; ++e) { v[e] = bf2f((bf16_t)raw[u][e]); ss += v[e] * v[e]; }
      ss += __shfl_xor(ss, 1); ss += __shfl_xor(ss, 2); ss += __shfl_xor(ss, 4);
      const float rstd = rsqrtf(ss * (1.0f / 64.0f) + EPS);
#pragma unroll
      for (int e = 0; e < 8; ++e) v[e] = v[e] * rstd * gn[e];
      if (j >= CTXL) {
#pragma unroll
        for (int e = 0; e < 8; ++e) { const float other = __shfl_xor(v[e], 4); const float cs = rp4[u][e >> 1][(e & 1) * 2], sn = rp4[u][e >> 1][(e & 1) * 2 + 1]; v[e] = sub < 4 ? v[e] * cs - other * sn : v[e] * cs + other * sn; } }
      if (r < MTOK) *(u32x4*)(QK + (size_t)r * 512 + hh * 64 + sub * 8) = (u32x4){pk2bf(v[0], v[1]), pk2bf(v[2], v[3]), pk2bf(v[4], v[5]), pk2bf(v[6], v[7])}; }
  }
}

__device__ __forceinline__ void st_prep_hy(const bf16_t* HY, const float* cw, const float* cb, bf16_t* HYT, int do_ctx, char* lds) {
  const int tid = TIDX, lane = tid & 63, w = tid >> 6; float* tile = (float*)lds + w * (66 * 33);
  const int nlat = 4 * 64 * 24, nitem = nlat + (do_ctx ? 4 * 4 * 24 : 0), step = GDIM * 8;
  bf16x8 raw[5];
#define PHY_DECODE(it) int b, tt, ct, L, joff; bf16_t* outb; \
    if ((it) < nlat) { b = (it) / 1536; tt = ((it) % 1536) / 24; ct = (it) % 24; L = SEQ; joff = CTXL; outb = HYT + (size_t)b * 768 * SEQ; } \
    else { const int i2 = (it) - nlat; b = i2 / 96; tt = (i2 % 96) / 24; ct = i2 % 24; L = CTXL; joff = 0; outb = HYT + (size_t)4 * 768 * SEQ + (size_t)b * 768 * CTXL; } \
    const int t0 = tt * 64, c0 = ct * 32; (void)outb;
#define PHY_LOADS(it) do { PHY_DECODE(it) _Pragma("unroll") for (int i = 0; i < 5; ++i) { const int rr = (lane >> 2) + 16 * i, c8 = (lane & 3) * 8; int t = t0 - 1 + rr; const bool ok = rr < 66 && t >= 0 && t < L; t = ok ? t : t0; \
      const bf16x8 v = *(const bf16x8*)(HY + ((size_t)b * TPB + joff + t) * 768 + c0 + c8); raw[i] = ok ? v : (bf16x8){0, 0, 0, 0, 0, 0, 0, 0}; } } while (0)
  int it = BIDX * 8 + w;
  if (it < nitem) PHY_LOADS(it);
  for (; it < nitem; it += step) {
    PHY_DECODE(it)
#pragma unroll
    for (int i = 0; i < 5; ++i) { const int rr = (lane >> 2) + 16 * i, c8 = (lane & 3) * 8;
      if (rr < 66) {
#pragma unroll
        for (int e = 0; e < 8; ++e) tile[rr * 33 + c8 + e] = bf2f((bf16_t)raw[i][e]); } }
    asm volatile("s_waitcnt lgkmcnt(0)" ::: "memory");
    if (it + step < nitem) PHY_LOADS(it + step);
#pragma unroll 4
    for (int cc = 0; cc < 32; ++cc) { const int c = c0 + cc;
      const float v = cw[c] * tile[lane * 33 + cc] + cw[768 + c] * tile[(lane + 1) * 33 + cc] + cw[1536 + c] * tile[(lane + 2) * 33 + cc] + cb[c];
      outb[(size_t)c * L + t0 + lane] = (bf16_t)f2bf(v); }
    asm volatile("s_waitcnt lgkmcnt(0)" ::: "memory");
  }
#undef PHY_LOADS
#undef PHY_DECODE
  __syncthreads();
}

template <int L> __device__ __forceinline__ void hyfilt_item(int item, const float* w1, const float* b1, const float* fr, const float* w2, const float* b2, const float* w3, float* HK, char* lds) {
  float* S0 = (float*)lds; float* S1 = S0 + 64 * 64; float* S2 = S1 + 64 * 68;
  const int tid = TIDX, n0 = (item >> 2) * 64, cq = item & 3, lane = tid & 63, wv = tid >> 6;
  for (int e = tid; e < 64 * 33; e += NT) { const int pp = e / 33, f = e % 33; const int n = n0 + pp; float v;
    if (f == 0) v = (float)n / (float)(L - 1);
    else { const int m = (f - 1) & 15; const float band = 1e-4f + (float)m * ((15.0f - 1e-4f) / 15.0f); const float wpos = (6.283185307179586f / (float)L) * (float)n;
      v = f <= 16 ? cosf(wpos * band) : -sinf(wpos * band); }
    S0[pp * 33 + f] = v; }
  for (int e = tid; e < 33 * 64; e += NT) S1[e] = w1[e];
  __syncthreads();
  for (int e = tid; e < 64 * 64; e += NT) { const int pp = e >> 6, j = e & 63; float a = b1[j];
    for (int f = 0; f < 33; ++f) a += S0[pp * 33 + f] * S1[f * 64 + j];
    S2[pp * 64 + j] = sinf(fr[j] * a); }
  __syncthreads();
  for (int e = tid; e < 64 * 64; e += NT) S0[e] = w2[e];
  __syncthreads();
  for (int e = tid; e < 64 * 64; e += NT) { const int pp = e >> 6, j = e & 63; float a = b2[j];
    for (int f = 0; f < 64; ++f) a += S2[pp * 64 + f] * S0[f * 64 + j];
    S1[pp * 68 + j] = sinf(fr[j] * a); }
  __syncthreads();
  {
    const int l15 = lane & 15, l4 = lane >> 4, colb = cq * 256 + 32 * wv;
    f32x4 acc[4][2];
#pragma unroll
    for (int pt = 0; pt < 4; ++pt) { acc[pt][0] = (f32x4){0.f, 0.f, 0.f, 0.f}; acc[pt][1] = (f32x4){0.f, 0.f, 0.f, 0.f}; }
#pragma unroll 4
    for (int kk = 0; kk < 16; ++kk) { const int k = 4 * kk + l4;
      const float bv0 = w3[k * 1024 + colb + l15], bv1 = w3[k * 1024 + colb + 16 + l15];
#pragma unroll
      for (int pt = 0; pt < 4; ++pt) { const float av = S1[(pt * 16 + l15) * 68 + k];
        acc[pt][0] = __builtin_amdgcn_mfma_f32_16x16x4f32(av, bv0, acc[pt][0], 0, 0, 0);
        acc[pt][1] = __builtin_amdgcn_mfma_f32_16x16x4f32(av, bv1, acc[pt][1], 0, 0, 0); } }
#pragma unroll
    for (int ct = 0; ct < 2; ++ct) { const int col = colb + 16 * ct + l15, dir = col >> 9, order = (col >> 8) & 1, c = col & 255;
      const float delta = 3.0701134573253943f + (float)c * ((15.350567286626972f - 3.0701134573253943f) / 255.0f);
      float* dst = HK + ((size_t)order * 256 + c) * (2 * L);
#pragma unroll
      for (int pt = 0; pt < 4; ++pt) { const int nb = n0 + pt * 16 + 4 * l4; f32x4 o;
#pragma unroll
        for (int rg = 0; rg < 4; ++rg) o[rg] = acc[pt][ct][rg] * __expf(-((float)(nb + rg) / (float)(L - 1)) * delta);
        if (dir == 0) *(f32x4*)(dst + nb) = o;
        else {
#pragma unroll
          for (int rg = 0; rg < 4; ++rg) { const int n = nb + rg; if (n >= 1) dst[2 * L - n] = o[rg]; else dst[L] = 0.f; } } } }
  }
  __syncthreads();
}

template <int L> __device__ __forceinline__ void hyconv_item(int item, const bf16_t* HYT, const float* HK, const float* hy_bias, bf16_t* MIX, int joff, char* lds) {
  float* kern = (float*)lds; float* z = kern + 2 * L;
  const int tid = TIDX, b = item >> 8, c = item & 255;
  const bf16_t* vp = HYT + ((size_t)b * 768 + c) * L; const bf16_t* x1p = vp + (size_t)256 * L; const bf16_t* x2p = vp + (size_t)512 * L;
  const bool act = tid < L / 8; const int tb = 8 * tid;
  for (int o = 0; o < 2; ++o) {
    if (o == 0) for (int t = tid; t < L; t += NT) z[t] = bf2f(vp[t]);
    const float* kp = HK + ((size_t)o * 256 + c) * (2 * L);
    for (int t = tid; t < 2 * L; t += NT) kern[t] = kp[t];
    __syncthreads();
    float acc[8], W[16];
#pragma unroll
    for (int i = 0; i < 8; ++i) acc[i] = 0.f;
    if (act) {
#pragma unroll
      for (int i = 0; i < 8; ++i) W[8 + i] = kern[(tb + i) & (2 * L - 1)];
      for (int s0 = 0; s0 < L; s0 += 8) {
        const int bb = (tb - s0 - 8) & (2 * L - 1);
#pragma unroll
        for (int i = 0; i < 8; ++i) W[i] = kern[bb + i];
        float zs[8];
#pragma unroll
        for (int j = 0; j < 8; ++j) zs[j] = z[s0 + j];
#pragma unroll
        for (int j = 0; j < 8; ++j)
#pragma unroll
          for (int i = 0; i < 8; ++i) acc[i] += W[8 + i - j] * zs[j];
#pragma unroll
        for (int i = 0; i < 8; ++i) W[8 + i] = W[i];
      }
    }
    __syncthreads();
    const float bias = hy_bias[o * 256 + c];
    if (act) {
#pragma unroll
      for (int i = 0; i < 8; ++i) { const int t = tb + i; const float zz = acc[i] + bias * z[t];
        if (o == 0) z[t] = bf2f(x1p[t]) * zz;
        else MIX[((size_t)b * TPB + joff + t) * DM + 768 + c] = (bf16_t)f2bf(bf2f(x2p[t]) * zz); }
    }
    __syncthreads();
  }
}

__device__ __forceinline__ void hyconv_ctx_item(int item, const bf16_t* HYTC, const float* HKC, const float* hy_bias, bf16_t* MIX, char* lds) {
  constexpr int L = CTXL;
  const int tid = TIDX, b = item >> 4, cc = tid >> 5, c = (item & 15) * 16 + cc, sub = tid & 31, tb = 8 * sub;
  float* kern = (float*)lds + cc * (2 * L); float* z = (float*)lds + 16 * 2 * L + cc * L;
  const bf16_t* vp = HYTC + ((size_t)b * 768 + c) * L; const bf16_t* x1p = vp + (size_t)256 * L; const bf16_t* x2p = vp + (size_t)512 * L;
#pragma unroll 1
  for (int o = 0; o < 2; ++o) {
    if (o == 0) for (int t = sub; t < L; t += 32) z[t] = bf2f(vp[t]);
    const float* kp = HKC + ((size_t)o * 256 + c) * (2 * L);
    for (int t = sub; t < 2 * L; t += 32) kern[t] = kp[t];
    __syncthreads();
    float acc[8], W[16];
#pragma unroll
    for (int i = 0; i < 8; ++i) { acc[i] = 0.f; W[8 + i] = kern[(tb + i) & (2 * L - 1)]; }
    for (int s0 = 0; s0 < L; s0 += 8) {
      const int bb = (tb - s0 - 8) & (2 * L - 1);
#pragma unroll
      for (int i = 0; i < 8; ++i) W[i] = kern[bb + i];
      float zs[8];
#pragma unroll
      for (int j = 0; j < 8; ++j) zs[j] = z[s0 + j];
#pragma unroll
      for (int j = 0; j < 8; ++j)
#pragma unroll
        for (int i = 0; i < 8; ++i) acc[i] += W[8 + i - j] * zs[j];
#pragma unroll
      for (int i = 0; i < 8; ++i) W[8 + i] = W[i];
    }
    __syncthreads();
    const float bias = hy_bias[o * 256 + c];
#pragma unroll
    for (int i = 0; i < 8; ++i) { const int t = tb + i; const float zz = acc[i] + bias * z[t];
      if (o == 0) z[t] = bf2f(x1p[t]) * zz;
      else MIX[((size_t)b * TPB + t) * DM + 768 + c] = (bf16_t)f2bf(bf2f(x2p[t]) * zz); }
    __syncthreads();
  }
}

__device__ __forceinline__ void attn_unit_simple(int u, const bf16_t* QK, const bf16_t* VZ, bf16_t* MIX, char* lds) {
  bf16_t (*Ks)[72] = (bf16_t (*)[72])lds;
  bf16_t (*Vt)[72] = (bf16_t (*)[72])(lds + 64 * 72 * 2);
  bf16_t (*Ps)[16][72] = (bf16_t (*)[16][72])(lds + 2 * 64 * 72 * 2);
  const int tid = TIDX, lane = tid & 63, w = tid >> 6;
  int b, h, qrow0, nk;
  if (u < 768) { b = u / 192; const int rem = u % 192; h = rem >> 5; qrow0 = b * TPB + CTXL + (rem & 31) * 128; nk = TPB; }
  else { const int uc = u - 768; b = uc / 12; h = (uc % 12) >> 1; qrow0 = b * TPB + (uc & 1) * 128; nk = CTXL; }
  const int kvh = h / 3, key0 = b * TPB, l15 = lane & 15, l4 = lane >> 4;
  bf16x8 aq[2];
#pragma unroll
  for (int kk = 0; kk < 2; ++kk) aq[kk] = *(const bf16x8*)(QK + (size_t)(qrow0 + 16 * w + l15) * 512 + h * 64 + kk * 32 + 8 * l4);
  f32x4 O[4]; float m[4], l[4];
#pragma unroll
  for (int i = 0; i < 4; ++i) { O[i] = (f32x4){0.f, 0.f, 0.f, 0.f}; m[i] = -1e30f; l[i] = 0.f; }
  for (int kt = 0; kt < nk / 64; ++kt) {
    __syncthreads();
    { const int r = tid >> 3, c8 = (tid & 7) * 8; const size_t grow = (size_t)(key0 + kt * 64 + r) * 512;
      *(u32x4*)&Ks[r][c8] = *(const u32x4*)(QK + grow + 384 + kvh * 64 + c8);
      const bf16x8 vv = *(const bf16x8*)(VZ + grow + kvh * 64 + c8);
#pragma unroll
      for (int e = 0; e < 8; ++e) Vt[c8 + e][r] = (bf16_t)vv[e]; }
    __syncthreads();
    f32x4 s[4];
#pragma unroll
    for (int ni = 0; ni < 4; ++ni) s[ni] = (f32x4){0.f, 0.f, 0.f, 0.f};
#pragma unroll
    for (int kk = 0; kk < 2; ++kk)
#pragma unroll
      for (int ni = 0; ni < 4; ++ni) { const bf16x8 bk = *(const bf16x8*)&Ks[16 * ni + l15][32 * kk + 8 * l4]; s[ni] = __builtin_amdgcn_mfma_f32_16x16x32_bf16(aq[kk], bk, s[ni], 0, 0, 0); }
#pragma unroll
    for (int rg = 0; rg < 4; ++rg) {
      float mx = fmaxf(fmaxf(s[0][rg], s[1][rg]), fmaxf(s[2][rg], s[3][rg]));
      mx = fmaxf(mx, __shfl_xor(mx, 1)); mx = fmaxf(mx, __shfl_xor(mx, 2)); mx = fmaxf(mx, __shfl_xor(mx, 4)); mx = fmaxf(mx, __shfl_xor(mx, 8));
      const float mn = fmaxf(m[rg], mx), alpha = exp2f(m[rg] - mn); float rs = 0.f;
#pragma unroll
      for (int ni = 0; ni < 4; ++ni) { const float pv = exp2f(s[ni][rg] - mn); rs += pv; Ps[w][4 * l4 + rg][16 * ni + l15] = (bf16_t)f2bf(pv); }
      rs += __shfl_xor(rs, 1); rs += __shfl_xor(rs, 2); rs += __shfl_xor(rs, 4); rs += __shfl_xor(rs, 8);
      l[rg] = l[rg] * alpha + rs; m[rg] = mn;
#pragma unroll
      for (int ni = 0; ni < 4; ++ni) O[ni][rg] *= alpha;
    }
    __syncthreads();
#pragma unroll
    for (int kk = 0; kk < 2; ++kk) { const bf16x8 ap = *(const bf16x8*)&Ps[w][l15][32 * kk + 8 * l4];
#pragma unroll
      for (int ni = 0; ni < 4; ++ni) { const bf16x8 bv = *(const bf16x8*)&Vt[16 * ni + l15][32 * kk + 8 * l4]; O[ni] = __builtin_amdgcn_mfma_f32_16x16x32_bf16(ap, bv, O[ni], 0, 0, 0); } }
  }
#pragma unroll
  for (int rg = 0; rg < 4; ++rg) { const float il = 1.0f / l[rg]; const size_t row = (size_t)(qrow0 + 16 * w + 4 * l4 + rg);
#pragma unroll
    for (int ni = 0; ni < 4; ++ni) MIX[row * DM + h * 64 + 16 * ni + l15] = (bf16_t)f2bf(O[ni][rg] * il); }
  __syncthreads();
}

__device__ __forceinline__ void st_ssd_prep(const bf16_t* XBC, float* DT, const float* cw, const float* cb, const float* dt_bias, bf16_t* XBCC) {
  const size_t total = (size_t)MTOK * 640;
  for (size_t i = (size_t)BIDX * NT + TIDX; i < total; i += (size_t)GDIM * NT) {
    const int r = (int)(i / 640), ch = (int)(i % 640), j = r % TPB;
    const bool hasp = (j != 0 && j != CTXL), hasn = (j != CTXL - 1 && j != TPB - 1);
    float v = cw[640 + ch] * bf2f(XBC[(size_t)r * 768 + ch]) + cb[ch];
    if (hasp) v += cw[ch] * bf2f(XBC[(size_t)(r - 1) * 768 + ch]);
    if (hasn) v += cw[1280 + ch] * bf2f(XBC[(size_t)(r + 1) * 768 + ch]);
    XBCC[i] = (bf16_t)f2bf(siluf(v));
  }
  for (size_t i = (size_t)BIDX * NT + TIDX; i < (size_t)MTOK * 12; i += (size_t)GDIM * NT) {
    const float x = DT[i] + dt_bias[i % 12];
    DT[i] = x > 20.f ? x : log1pf(expf(x));
  }
}
__device__ __forceinline__ void ssd_scan_item(int item, const bf16_t* XBCC, const float* DT, const float* a_log, float* Y, char* lds) {
  const int half = TIDX >> 8, tid = TIDX & 255;
  float* base = (float*)(lds + half * 25088);
  float (*xs)[64] = (float (*)[64])base; float (*Bs)[64] = (float (*)[64])(base + 2048); float (*Cs)[64] = (float (*)[64])(base + 4096);
  float* dAs = base + 6144; float* dts = base + 6176;
  const int bh = 2 * item + half, b = bh / 6, h = bh % 6, g = h / 3, p = tid >> 2, q = tid & 3;
  for (int dir = 0; dir < 2; ++dir) {
    const float a = -expf(a_log[dir * 6 + h]);
    float st[16];
#pragma unroll
    for (int n = 0; n < 16; ++n) st[n] = 0.f;
    for (int ci = 0; ci < TPB / 32; ++ci) {
      for (int e = tid; e < 32 * 64; e += 256) { const int i = e >> 6, cc = e & 63, qi = ci * 32 + i;
        const int j = dir == 0 ? qi : (qi < CTXL ? CTXL - 1 - qi : TPB - 1 - (qi - CTXL)); const size_t r = (size_t)b * TPB + j;
        xs[i][cc] = bf2f(XBCC[r * 640 + h * 64 + cc]); Bs[i][cc] = bf2f(XBCC[r * 640 + 384 + g * 64 + cc]); Cs[i][cc] = bf2f(XBCC[r * 640 + 512 + g * 64 + cc]); }
      if (tid < 32) { const int qi = ci * 32 + tid; const int j = dir == 0 ? qi : (qi < CTXL ? CTXL - 1 - qi : TPB - 1 - (qi - CTXL)); const size_t r = (size_t)b * TPB + j;
        const float dt = DT[r * 12 + dir * 6 + h]; dts[tid] = dt; dAs[tid] = expf(dt * a); }
      __syncthreads();
      for (int i = 0; i < 32; ++i) {
        const float d = dAs[i], dtx = dts[i] * xs[i][p]; float y = 0.f;
#pragma unroll
        for (int n = 0; n < 16; ++n) { st[n] = st[n] * d + dtx * Bs[i][16 * q + n]; y += Cs[i][16 * q + n] * st[n]; }
        y += __shfl_xor(y, 1); y += __shfl_xor(y, 2);
        if (q == 0) { const int qi = ci * 32 + i; const int j = dir == 0 ? qi : (qi < CTXL ? CTXL - 1 - qi : TPB - 1 - (qi - CTXL)); float* yp = Y + ((size_t)b * TPB + j) * 384 + h * 64 + p;
          if (dir == 0) *yp = y; else *yp += y; }
      }
      __syncthreads();
    }
  }
}
__device__ __forceinline__ void st_ssd_out(const float* Y, const bf16_t* XBCC, const bf16_t* VZ, const float* dskip, const float* nw, bf16_t* MIX) {
  const int lane = TIDX & 63, gw = BIDX * 8 + (TIDX >> 6), ngw = GDIM * 8;
  for (int it = gw; it < MTOK * 2; it += ngw) {
    const int r = it >> 1, g = it & 1; float gv[3]; float ss = 0.f;
#pragma unroll
    for (int i = 0; i < 3; ++i) { const int c = g * 192 + lane + 64 * i, hh = c >> 6;
      const float y = Y[(size_t)r * 384 + c] + bf2f(XBCC[(size_t)r * 640 + c]) * dskip[hh]; const float zv = bf2f(VZ[(size_t)r * 512 + 128 + c]);
      gv[i] = y * siluf(zv); ss += gv[i] * gv[i]; }
    const float rstd = rsqrtf(wave_sum(ss) * (1.0f / 192.0f) + EPS);
#pragma unroll
    for (int i = 0; i < 3; ++i) { const int c = g * 192 + lane + 64 * i; MIX[(size_t)r * DM + 384 + c] = (bf16_t)f2bf(gv[i] * rstd * nw[c]); }
  }
}


__device__ __forceinline__ void ssd_conv8(const bf16_t* XBC, size_t r, int c0, bool hasp, bool hasn, const float* cw, const float* cb, float (&o)[8]) {
  const bf16x8 cur = *(const bf16x8*)(XBC + r * 768 + c0);
  const bf16x8 prv = *(const bf16x8*)(XBC + (hasp ? r - 1 : r) * 768 + c0), nxt = *(const bf16x8*)(XBC + (hasn ? r + 1 : r) * 768 + c0);
  const float wp = hasp ? 1.f : 0.f, wn = hasn ? 1.f : 0.f;
#pragma unroll
  for (int e = 0; e < 8; ++e) { const float v = wp * cw[c0 + e] * bf2f((bf16_t)prv[e]) + cw[640 + c0 + e] * bf2f((bf16_t)cur[e]) + wn * cw[1280 + c0 + e] * bf2f((bf16_t)nxt[e]) + cb[c0 + e]; o[e] = siluf(v); }
}
__device__ __forceinline__ float softplusf(float x) {
  const float y = __expf(-fabsf(x)); const float l = y < 0.06f ? y * (1.f - y * (0.5f - y * (0.33333334f - 0.25f * y))) : __logf(1.f + y); return fmaxf(x, 0.f) + l; }
__device__ __forceinline__ void wave_scan128(float e0, float e1, int lane, float& c0, float& c1) {
  float x = e0 + e1;
#pragma unroll
  for (int o = 1; o < 64; o <<= 1) { const float v = __shfl_up(x, o); if (lane >= o) x += v; }
  const float excl = x - (e0 + e1); c0 = excl + e0; c1 = excl + e0 + e1;
}
__device__ __forceinline__ int ssd_chunk_j0(int cidx) { return cidx < 2 ? cidx * 128 : CTXL + (cidx - 2) * 128; }

__device__ __forceinline__ void st_ssd1(int it0, int step, int nitems, const bf16_t* XBC, const float* DT, const float* cw, const float* cb, const float* dt_bias, const float* a_log,
                                        float* YIN, float* ST, float* DEC, char* lds) {
  bf16_t (*Cm)[72] = (bf16_t (*)[72])lds; bf16_t (*Bm)[72] = (bf16_t (*)[72])(lds + 18432);
  bf16_t (*BT)[136] = (bf16_t (*)[136])(lds + 36864); bf16_t (*Xt)[136] = (bf16_t (*)[136])(lds + 54272); bf16_t (*Mm)[136] = (bf16_t (*)[136])(lds + 71680);
  float* tab = (float*)(lds + 106496); float* dtf = tab; float* dtb = tab + 128; float* acf = tab + 256; float* acb = tab + 384; float* wf = tab + 512; float* wb = tab + 640;
  const int tid = TIDX;
  bf16x8 cu[6], pv[6], nx[6];
#define SSD1_LOADS(itm, I0, I1) do { const int h_ = (itm) % 6, bc_ = (itm) / 6, cidx_ = bc_ % 34, b_ = bc_ / 34, g_ = h_ / 3, j0_ = ssd_chunk_j0(cidx_); const size_t r0_ = (size_t)b_ * TPB + j0_; \
    _Pragma("unroll") for (int i = (I0); i < (I1); ++i) { const int task = tid + NT * i, t = task / 24, cg = task % 24, kind = cg >> 3, q = cg & 7, j = j0_ + t; \
      const int c0 = kind == 0 ? h_ * 64 + 8 * q : (kind == 1 ? 384 + g_ * 64 + 8 * q : 512 + g_ * 64 + 8 * q); \
      const bool hasp = j != 0 && j != CTXL, hasn = j != CTXL - 1 && j != TPB - 1; const bf16_t* p = XBC + (r0_ + t) * 768 + c0; \
      cu[i] = *(const bf16x8*)p; pv[i] = *(const bf16x8*)(p + (hasp ? -768 : 0)); nx[i] = *(const bf16x8*)(p + (hasn ? 768 : 0)); } } while (0)
  if (it0 < nitems) SSD1_LOADS(it0, 0, 6);
#pragma unroll 1
  for (int item = it0; item < nitems; item += step) {
  const int tid = TIDX, lane = tid & 63, w = tid >> 6, l15 = lane & 15, l4 = lane >> 4;
  const int h = item % 6, bc = item / 6, cidx = bc % 34, b = bc / 34, g = h / 3, j0 = ssd_chunk_j0(cidx);
  const size_t r0 = (size_t)b * TPB + j0;
  float dtr0 = 0.f, dtr1 = 0.f;
  if (w < 2) { const int t0 = w == 0 ? 2 * lane : 127 - 2 * lane, t1 = w == 0 ? 2 * lane + 1 : 126 - 2 * lane; dtr0 = DT[(r0 + t0) * 12 + w * 6 + h]; dtr1 = DT[(r0 + t1) * 12 + w * 6 + h]; }
  SSD1_LOADS(item, 6, 6);
  {
#pragma unroll
    for (int i = 0; i < 6; ++i) { const int task = tid + NT * i, t = task / 24, cg = task % 24, kind = cg >> 3, q = cg & 7, j = j0 + t;
      const int c0 = kind == 0 ? h * 64 + 8 * q : (kind == 1 ? 384 + g * 64 + 8 * q : 512 + g * 64 + 8 * q);
      const float wp = (j != 0 && j != CTXL) ? 1.f : 0.f, wn = (j != CTXL - 1 && j != TPB - 1) ? 1.f : 0.f;
      float o[8];
#pragma unroll
      for (int e = 0; e < 8; ++e) o[e] = siluf(wp * cw[c0 + e] * bf2f((bf16_t)pv[i][e]) + cw[640 + c0 + e] * bf2f((bf16_t)cu[i][e]) + wn * cw[1280 + c0 + e] * bf2f((bf16_t)nx[i][e]) + cb[c0 + e]);
      if (kind == 0) {
#pragma unroll
        for (int e = 0; e < 8; ++e) Xt[8 * q + e][t] = (bf16_t)f2bf(o[e]);
      } else { const u32x4 pk = (u32x4){pk2bf(o[0], o[1]), pk2bf(o[2], o[3]), pk2bf(o[4], o[5]), pk2bf(o[6], o[7])};
        if (kind == 1) { *(u32x4*)&Bm[t][8 * q] = pk;
#pragma unroll
          for (int e = 0; e < 8; ++e) BT[8 * q + e][t] = (bf16_t)f2bf(o[e]); }
        else *(u32x4*)&Cm[t][8 * q] = pk; } }
  }
  if (w < 2) { const int dir = w; const float a = -expf(a_log[dir * 6 + h]), bias = dt_bias[dir * 6 + h];
    const int t0 = dir == 0 ? 2 * lane : 127 - 2 * lane, t1 = dir == 0 ? 2 * lane + 1 : 126 - 2 * lane;
    const float d0 = softplusf(dtr0 + bias), d1 = softplusf(dtr1 + bias);
    float c0, c1; wave_scan128(d0 * a, d1 * a, lane, c0, c1);
    const float tot = __shfl(c1, 63);
    float* dtt = dir == 0 ? dtf : dtb; float* ac = dir == 0 ? acf : acb; float* ww = dir == 0 ? wf : wb;
    dtt[t0] = d0; dtt[t1] = d1; ac[t0] = c0; ac[t1] = c1; ww[t0] = __expf(tot - c0) * d0; ww[t1] = __expf(tot - c1) * d1;
    if (lane == 0) DEC[(((size_t)b * 34 + cidx) * 2 + dir) * 6 + h] = __expf(tot); }
  __syncthreads();
  if (item + step < nitems) SSD1_LOADS(item + step, 0, 6);
  {
    f32x4 accG[8];
#pragma unroll
    for (int ni = 0; ni < 8; ++ni) accG[ni] = (f32x4){0.f, 0.f, 0.f, 0.f};
#pragma unroll
    for (int kk = 0; kk < 2; ++kk) { const bf16x8 a = *(const bf16x8*)&Cm[16 * w + l15][32 * kk + 8 * l4];
#pragma unroll
      for (int ni = 0; ni < 8; ++ni) { const bf16x8 bb = *(const bf16x8*)&Bm[16 * ni + l15][32 * kk + 8 * l4]; accG[ni] = __builtin_amdgcn_mfma_f32_16x16x32_bf16(a, bb, accG[ni], 0, 0, 0); } }
    float aft[4], abt[4];
#pragma unroll
    for (int rg = 0; rg < 4; ++rg) { aft[rg] = acf[16 * w + 4 * l4 + rg]; abt[rg] = acb[16 * w + 4 * l4 + rg]; }
#pragma unroll
    for (int ni = 0; ni < 8; ++ni) { const int sidx = 16 * ni + l15; const float afs = acf[sidx], abs_ = acb[sidx], dfs = dtf[sidx], dbs = dtb[sidx];
#pragma unroll
      for (int rg = 0; rg < 4; ++rg) { const int t = 16 * w + 4 * l4 + rg;
        const float f = sidx <= t ? __expf(aft[rg] - afs) * dfs : 0.f, bk = sidx >= t ? __expf(abt[rg] - abs_) * dbs : 0.f;
        Mm[t][sidx] = (bf16_t)f2bf(accG[ni][rg] * (f + bk)); } }
  }
  __syncthreads();
  {
    f32x4 acc[4];
#pragma unroll
    for (int ni = 0; ni < 4; ++ni) acc[ni] = (f32x4){0.f, 0.f, 0.f, 0.f};
#pragma unroll
    for (int kk = 0; kk < 4; ++kk) { const bf16x8 a = *(const bf16x8*)&Mm[16 * w + l15][32 * kk + 8 * l4];
#pragma unroll
      for (int ni = 0; ni < 4; ++ni) { const bf16x8 bb = *(const bf16x8*)&Xt[16 * ni + l15][32 * kk + 8 * l4]; acc[ni] = __builtin_amdgcn_mfma_f32_16x16x32_bf16(a, bb, acc[ni], 0, 0, 0); } }
#pragma unroll
    for (int rg = 0; rg < 4; ++rg)
#pragma unroll
      for (int ni = 0; ni < 4; ++ni) YIN[(r0 + 16 * w + 4 * l4 + rg) * 384 + h * 64 + 16 * ni + l15] = acc[ni][rg];
  }
  {
    const int dir = w >> 2, mt = w & 3; const float* ww = dir == 0 ? wf : wb;
    f32x4 acc[4];
#pragma unroll
    for (int ni = 0; ni < 4; ++ni) acc[ni] = (f32x4){0.f, 0.f, 0.f, 0.f};
#pragma unroll
    for (int kk = 0; kk < 4; ++kk) { const bf16x8 raw = *(const bf16x8*)&Xt[16 * mt + l15][32 * kk + 8 * l4];
      const f32x4 w0 = *(const f32x4*)(ww + 32 * kk + 8 * l4), w1 = *(const f32x4*)(ww + 32 * kk + 8 * l4 + 4);
      u32x4 pk; pk.x = pk2bf(bf2f((bf16_t)raw[0]) * w0.x, bf2f((bf16_t)raw[1]) * w0.y); pk.y = pk2bf(bf2f((bf16_t)raw[2]) * w0.z, bf2f((bf16_t)raw[3]) * w0.w);
      pk.z = pk2bf(bf2f((bf16_t)raw[4]) * w1.x, bf2f((bf16_t)raw[5]) * w1.y); pk.w = pk2bf(bf2f((bf16_t)raw[6]) * w1.z, bf2f((bf16_t)raw[7]) * w1.w);
      const bf16x8 a = __builtin_bit_cast(bf16x8, pk);
#pragma unroll
      for (int ni = 0; ni < 4; ++ni) { const bf16x8 bb = *(const bf16x8*)&BT[16 * ni + l15][32 * kk + 8 * l4]; acc[ni] = __builtin_amdgcn_mfma_f32_16x16x32_bf16(a, bb, acc[ni], 0, 0, 0); } }
    float* sp = ST + ((((size_t)b * 34 + cidx) * 2 + dir) * 6 + h) * 4096;
#pragma unroll
    for (int rg = 0; rg < 4; ++rg)
#pragma unroll
      for (int ni = 0; ni < 4; ++ni) sp[(16 * mt + 4 * l4 + rg) * 64 + 16 * ni + l15] = acc[ni][rg];
  }
  __syncthreads();
  }
#undef SSD1_LOADS
}

__device__ __forceinline__ void st_ssd_scan2(float* ST, const float* DEC) {
  for (int idx = BIDX * NT + TIDX; idx < 4 * 2 * 6 * 4096; idx += GDIM * NT) {
    const int e = idx & 4095, bdh = idx >> 12, h = bdh % 6, dir = (bdh / 6) & 1, b = bdh / 12;
    float v[34], d[34];
#pragma unroll
    for (int st = 0; st < 34; ++st) { const int cidx = dir == 0 ? st : (st < 2 ? 1 - st : 35 - st); const size_t o = (((size_t)b * 34 + cidx) * 2 + dir) * 6 + h; v[st] = ST[o * 4096 + e]; d[st] = DEC[o]; }
    float H = 0.f;
#pragma unroll
    for (int st = 0; st < 34; ++st) { const int cidx = dir == 0 ? st : (st < 2 ? 1 - st : 35 - st); const size_t o = (((size_t)b * 34 + cidx) * 2 + dir) * 6 + h; ST[o * 4096 + e] = H; H = H * d[st] + v[st]; }
  }
}

__device__ __forceinline__ void ssd3_item(int b, int cidx, int g, const bf16_t* XBC, const bf16_t* VZ, const float* DT, const float* cw, const float* cb, const float* dt_bias, const float* a_log,
                                          const float* dskip, const float* nw, const float* YIN, const float* ST, bf16_t* MIX, char* lds) {
  bf16_t (*Cm)[72] = (bf16_t (*)[72])lds; bf16_t (*Hm)[72] = (bf16_t (*)[72])(lds + 18432);
  float* ef = (float*)(lds + 18432 + 55296);
  float (*Yt)[196] = (float (*)[196])lds;
  const int tid = TIDX, lane = tid & 63, w = tid >> 6, l15 = lane & 15, l4 = lane >> 4, j0 = ssd_chunk_j0(cidx);
  const size_t r0 = (size_t)b * TPB + j0;
#pragma unroll
  for (int i = 0; i < 2; ++i) { const int task = tid + NT * i, t = task >> 3, q = task & 7, j = j0 + t;
    float o[8]; ssd_conv8(XBC, r0 + t, 512 + g * 64 + 8 * q, j != 0 && j != CTXL, j != CTXL - 1 && j != TPB - 1, cw, cb, o);
    *(u32x4*)&Cm[t][8 * q] = (u32x4){pk2bf(o[0], o[1]), pk2bf(o[2], o[3]), pk2bf(o[4], o[5]), pk2bf(o[6], o[7])}; }
#pragma unroll
  for (int i = 0; i < 12; ++i) { const int f4 = tid + NT * i, hd = f4 >> 10, rem = f4 & 1023, p = rem >> 4, n4 = (rem & 15) * 4, hh = hd >> 1, dir = hd & 1;
    const f32x4 v = *(const f32x4*)(ST + ((((size_t)b * 34 + cidx) * 2 + dir) * 6 + 3 * g + hh) * 4096 + p * 64 + n4);
    *(u32x2*)&Hm[hd * 64 + p][n4] = (u32x2){pk2bf(v.x, v.y), pk2bf(v.z, v.w)}; }
  if (w < 6) { const int hh = w >> 1, dir = w & 1, h = 3 * g + hh; const float a = -expf(a_log[dir * 6 + h]), bias = dt_bias[dir * 6 + h];
    const int t0 = dir == 0 ? 2 * lane : 127 - 2 * lane, t1 = dir == 0 ? 2 * lane + 1 : 126 - 2 * lane;
    const float d0 = softplusf(DT[(r0 + t0) * 12 + dir * 6 + h] + bias), d1 = softplusf(DT[(r0 + t1) * 12 + dir * 6 + h] + bias);
    float c0, c1; wave_scan128(d0 * a, d1 * a, lane, c0, c1);
    ef[w * 128 + t0] = __expf(c0); ef[w * 128 + t1] = __expf(c1); }
  __syncthreads();
  float yv[3][4][4];
  {
    bf16x8 ca[2];
#pragma unroll
    for (int kk = 0; kk < 2; ++kk) ca[kk] = *(const bf16x8*)&Cm[16 * w + l15][32 * kk + 8 * l4];
#pragma unroll
    for (int hh = 0; hh < 3; ++hh) {
      f32x4 accF[4], accB[4];
#pragma unroll
      for (int ni = 0; ni < 4; ++ni) { accF[ni] = (f32x4){0.f, 0.f, 0.f, 0.f}; accB[ni] = (f32x4){0.f, 0.f, 0.f, 0.f}; }
#pragma unroll
      for (int kk = 0; kk < 2; ++kk)
#pragma unroll
        for (int ni = 0; ni < 4; ++ni) {
          accF[ni] = __builtin_amdgcn_mfma_f32_16x16x32_bf16(ca[kk], *(const bf16x8*)&Hm[(hh * 2 + 0) * 64 + 16 * ni + l15][32 * kk + 8 * l4], accF[ni], 0, 0, 0);
          accB[ni] = __builtin_amdgcn_mfma_f32_16x16x32_bf16(ca[kk], *(const bf16x8*)&Hm[(hh * 2 + 1) * 64 + 16 * ni + l15][32 * kk + 8 * l4], accB[ni], 0, 0, 0); }
#pragma unroll
      for (int rg = 0; rg < 4; ++rg) { const int t = 16 * w + 4 * l4 + rg; const float eF = ef[(hh * 2 + 0) * 128 + t], eB = ef[(hh * 2 + 1) * 128 + t];
#pragma unroll
        for (int ni = 0; ni < 4; ++ni) yv[hh][ni][rg] = eF * accF[ni][rg] + eB * accB[ni][rg]; }
    }
  }
  __syncthreads();
#pragma unroll
  for (int hh = 0; hh < 3; ++hh)
#pragma unroll
    for (int rg = 0; rg < 4; ++rg)
#pragma unroll
      for (int ni = 0; ni < 4; ++ni) Yt[16 * w + 4 * l4 + rg][hh * 64 + 16 * ni + l15] = yv[hh][ni][rg];
  __syncthreads();
  {
    const int c4 = 4 * (lane < 48 ? lane : 47), hk = c4 >> 6; const bool lact = lane < 48;
    float cw0[4], cw1[4], cw2[4], cbv[4], nwv[4];
#pragma unroll
    for (int e = 0; e < 4; ++e) { const int col = g * 192 + c4 + e; cw0[e] = cw[col]; cw1[e] = cw[640 + col]; cw2[e] = cw[1280 + col]; cbv[e] = cb[col]; nwv[e] = nw[col]; }
    const float dsk = dskip[3 * g + hk];
#pragma unroll 1
    for (int rb = 0; rb < 16; rb += 4) {
      u32x2 xc_[4], xp_[4], xn_[4], zz_[4]; f32x4 yy_[4];
#pragma unroll
      for (int u = 0; u < 4; ++u) { const int t = 16 * w + rb + u, j = j0 + t; const size_t r = r0 + t; const bool hasp = j != 0 && j != CTXL, hasn = j != CTXL - 1 && j != TPB - 1;
        const bf16_t* xq = XBC + r * 768 + g * 192 + c4;
        xc_[u] = *(const u32x2*)xq; xp_[u] = *(const u32x2*)(xq + (hasp ? -768 : 0)); xn_[u] = *(const u32x2*)(xq + (hasn ? 768 : 0));
        yy_[u] = *(const f32x4*)(YIN + r * 384 + g * 192 + c4); zz_[u] = *(const u32x2*)(VZ + r * 512 + 128 + g * 192 + c4); }
#pragma unroll
      for (int u = 0; u < 4; ++u) { const int t = 16 * w + rb + u, j = j0 + t; const size_t r = r0 + t; const float wp = (j != 0 && j != CTXL) ? 1.f : 0.f, wn = (j != CTXL - 1 && j != TPB - 1) ? 1.f : 0.f;
        const f32x4 yt = *(const f32x4*)&Yt[t][c4];
        float gt[4]; float ss = 0.f;
#pragma unroll
        for (int e = 0; e < 4; ++e) { const unsigned sh = (e & 1) * 16; const unsigned wc_ = e < 2 ? xc_[u].x : xc_[u].y, wq_ = e < 2 ? xp_[u].x : xp_[u].y, wn_ = e < 2 ? xn_[u].x : xn_[u].y, wz_ = e < 2 ? zz_[u].x : zz_[u].y;
          float xv = cw1[e] * bf2f((bf16_t)(wc_ >> sh)) + cbv[e] + wp * cw0[e] * bf2f((bf16_t)(wq_ >> sh)) + wn * cw2[e] * bf2f((bf16_t)(wn_ >> sh));
          xv = siluf(xv);
          const float y = yy_[u][e] + yt[e] + dsk * xv;
          gt[e] = lact ? y * siluf(bf2f((bf16_t)(wz_ >> sh))) : 0.f; ss += gt[e] * gt[e]; }
        const float rstd = rsqrtf(wave_sum(ss) * (1.0f / 192.0f) + EPS);
        if (lact) { u32x2 o; o.x = pk2bf(gt[0] * rstd * nwv[0], gt[1] * rstd * nwv[1]); o.y = pk2bf(gt[2] * rstd * nwv[2], gt[3] * rstd * nwv[3]);
          *(u32x2*)(MIX + r * DM + 384 + g * 192 + c4) = o; } }
    }
  }
  __syncthreads();
}

__device__ __forceinline__ void st_router(const float* xl, const float* xc, float* xl_dst, float* xc_dst, const bf16_t* MO, const float* g, const float* modv_layer, const float* w_router, const float* rbias,
                                          bf16_t* H2, int* ctl, int* tok_pair, float* tok_w, int skip_ctx, char* lds) {
  float* wl = (float*)lds;
  const int tid = TIDX, lane = tid & 63, gw = BIDX * 8 + (tid >> 6), ngw = GDIM * 8;
  int* hist = (int*)(lds + 81920);
  if (tid < 32) hist[tid] = 0;
  float* mA = (float*)(lds + 82176); float* mB = mA + 5 * 1024; float* mG = mB + 5 * 1024;
  for (int idx = tid; idx < 5 * 1024; idx += NT) { const int m = idx >> 10, k = idx & 1023; mA[idx] = g[k] * (1.f + modv_layer[(size_t)m * 6144 + 4096 + k]); mB[idx] = modv_layer[(size_t)m * 6144 + 3072 + k]; mG[idx] = modv_layer[(size_t)m * 6144 + 2048 + k]; }
  for (int idx = tid; idx < 4096; idx += NT) { const int k = idx >> 2, e4 = idx & 3, row = ((k & 3) * 4 + (k >> 8)) * 64 + ((k & 255) >> 2);
    *(f32x4*)(wl + row * 20 + 4 * e4) = *(const f32x4*)(w_router + (size_t)k * 16 + 4 * e4); }
  __syncthreads();
  for (int rb = gw; rb < MTOK; rb += 2 * ngw) {
    int rr[2]; bool act[2]; f32x4 v[2][4]; u32x2 mo[2][4]; float rstd[2]; int mo_[2];
#pragma unroll
    for (int u = 0; u < 2; ++u) { const int r = rb + u * ngw; rr[u] = r < MTOK ? r : MTOK - 1; act[u] = r < MTOK && !(skip_ctx && (rr[u] % TPB) < CTXL); mo_[u] = mrow_of(rr[u]) * 1024;
      const float* xr = xrow(xl, xc, rr[u]); const bf16_t* mr = MO + (size_t)rr[u] * DM;
#pragma unroll
      for (int j = 0; j < 4; ++j) { v[u][j] = *(const f32x4*)(xr + 4 * lane + 256 * j); mo[u][j] = *(const u32x2*)(mr + 4 * lane + 256 * j); } }
    if (!act[0] && !act[1]) continue;
#pragma unroll
    for (int u = 0; u < 2; ++u) if (act[u]) { float* xd = xrow(xl_dst, xc_dst, rr[u]);
#pragma unroll
      for (int j = 0; j < 4; ++j) { const int k = 4 * lane + 256 * j; const f32x4 g4 = *(const f32x4*)(mG + mo_[u] + k);
        const f32x4 m4 = (f32x4){__uint_as_float(mo[u][j].x << 16), __uint_as_float(mo[u][j].x & 0xffff0000u), __uint_as_float(mo[u][j].y << 16), __uint_as_float(mo[u][j].y & 0xffff0000u)};
        v[u][j] = v[u][j] + g4 * m4; *(f32x4*)(xd + k) = v[u][j]; } }
#pragma unroll
    for (int u = 0; u < 2; ++u) { float ss = 0.f;
#pragma unroll
      for (int j = 0; j < 4; ++j) ss += v[u][j].x * v[u][j].x + v[u][j].y * v[u][j].y + v[u][j].z * v[u][j].z + v[u][j].w * v[u][j].w;
      rstd[u] = rsqrtf(wave_sum(ss) * (1.0f / DM) + EPS); }
    float lg[2][16];
#pragma unroll
    for (int u = 0; u < 2; ++u)
#pragma unroll
      for (int e = 0; e < 16; ++e) lg[u][e] = 0.f;
#pragma unroll 1
    for (int j = 0; j < 4; ++j) { const int k = 4 * lane + 256 * j; float o[2][4];
#pragma unroll
      for (int u = 0; u < 2; ++u) { const f32x4 a4 = *(const f32x4*)(mA + mo_[u] + k), b4 = *(const f32x4*)(mB + mo_[u] + k); const f32x4 o4 = v[u][j] * rstd[u] * a4 + b4;
        o[u][0] = o4.x; o[u][1] = o4.y; o[u][2] = o4.z; o[u][3] = o4.w;
        if (act[u]) { u32x2 wpk; wpk.x = pk2bf(o4.x, o4.y); wpk.y = pk2bf(o4.z, o4.w); *(u32x2*)(H2 + (size_t)rr[u] * DM + k) = wpk; } }
#pragma unroll
      for (int q = 0; q < 4; ++q) { const float* wr_ = wl + ((q * 4 + j) * 64 + lane) * 20;
#pragma unroll
        for (int e4 = 0; e4 < 4; ++e4) { const f32x4 wr = *(const f32x4*)(wr_ + 4 * e4);
#pragma unroll
          for (int u = 0; u < 2; ++u) { lg[u][4 * e4] += o[u][q] * wr.x; lg[u][4 * e4 + 1] += o[u][q] * wr.y; lg[u][4 * e4 + 2] += o[u][q] * wr.z; lg[u][4 * e4 + 3] += o[u][q] * wr.w; } } } }
    float h1[2];
#pragma unroll
    for (int u = 0; u < 2; ++u) { float h8[8], h4[4], h2[2];
#pragma unroll
      for (int i = 0; i < 8; ++i) { const bool up = (lane & 32) != 0; const float keep = up ? lg[u][8 + i] : lg[u][i], give = up ? lg[u][i] : lg[u][8 + i]; h8[i] = keep + __shfl_xor(give, 32); }
#pragma unroll
      for (int i = 0; i < 4; ++i) { const bool up = (lane & 16) != 0; const float keep = up ? h8[4 + i] : h8[i], give = up ? h8[i] : h8[4 + i]; h4[i] = keep + __shfl_xor(give, 16); }
#pragma unroll
      for (int i = 0; i < 2; ++i) { const bool up = (lane & 8) != 0; const float keep = up ? h4[2 + i] : h4[i], give = up ? h4[i] : h4[2 + i]; h2[i] = keep + __shfl_xor(give, 8); }
      { const bool up = (lane & 4) != 0; const float keep = up ? h2[1] : h2[0], give = up ? h2[0] : h2[1]; h1[u] = keep + __shfl_xor(give, 4); }
      h1[u] += __shfl_xor(h1[u], 2); h1[u] += __shfl_xor(h1[u], 1); }
    float lx[16];
#pragma unroll
    for (int e = 0; e < 16; ++e) { const int src = ((e >> 3) & 1) * 32 + ((e >> 2) & 1) * 16 + ((e >> 1) & 1) * 8 + (e & 1) * 4;
      const float a0 = __uint_as_float(__builtin_amdgcn_readlane(__float_as_uint(h1[0]), src)), a1 = __uint_as_float(__builtin_amdgcn_readlane(__float_as_uint(h1[1]), src));
      lx[e] = lane < 32 ? a0 : a1; }
    const int us = lane >> 5;
    if ((lane & 31) == 0 && (us == 0 ? act[0] : act[1])) {
      const int r = us == 0 ? rr[0] : rr[1];
      int best = 0, bi1 = 0, bi2 = 1; float bestv = -1e30f, bs1 = 0.f, bs2 = 0.f;
#pragma unroll
      for (int gq = 0; gq < 4; ++gq) { float m1 = -1e30f, m2 = -1e30f, s1 = 0.f, s2 = 0.f; int i1 = 0, i2 = 0;
#pragma unroll
        for (int i = 0; i < 4; ++i) { const float scv = 1.0f / (1.0f + __expf(-lx[4 * gq + i])); const float sv = scv + rbias[4 * gq + i];
          if (sv > m1) { m2 = m1; s2 = s1; i2 = i1; m1 = sv; s1 = scv; i1 = i; } else if (sv > m2) { m2 = sv; s2 = scv; i2 = i; } }
        if (m1 + m2 > bestv) { bestv = m1 + m2; best = gq; bi1 = i1; bi2 = i2; bs1 = s1; bs2 = s2; } }
      const int ia = bi1 < bi2 ? bi1 : bi2, ib = bi1 < bi2 ? bi2 : bi1;
      const int tri = ia == 0 ? ib - 1 : (ia == 1 ? ib + 1 : 5);
      const int pidx = best * 6 + tri;
      const float sa = bi1 < bi2 ? bs1 : bs2, sb = bi1 < bi2 ? bs2 : bs1, inv = 1.0f / (sa + sb);
      const int rank = atomicAdd(&hist[pidx], 1);
      tok_pair[r] = pidx | (rank << 5); tok_w[2 * r] = sa * inv; tok_w[2 * r + 1] = sb * inv;
    }
  }
  __syncthreads();
  if (tid < 32) ctl[CT_CNTB + BIDX * 32 + tid] = tid < 24 ? hist[tid] : 0;
}
__device__ __forceinline__ void st_moe_gather(const bf16_t* H2, bf16_t* H2S, int* ctl, const int* tok_pair, const float* tok_w, int* sorted_tok, float* sorted_w, int skip_ctx, char* lds) {
  int* sbase = (int*)lds; int* rtot = sbase + 32; int* rpre = rtot + 512;
  const int tid = TIDX, bid = BIDX;
  { const int p = tid & 31, seg = tid >> 5; int tot = 0, pre = 0;
#pragma unroll 4
    for (int i = 0; i < 16; ++i) { const int bb = seg * 16 + i; const int cv = ctl[CT_CNTB + bb * 32 + p]; tot += cv; pre += bb < bid ? cv : 0; }
    rtot[seg * 32 + p] = tot; rpre[seg * 32 + p] = pre; }
  __syncthreads();
  if (tid < 32) { int tot = 0, pre = 0;
#pragma unroll
    for (int sg = 0; sg < 16; ++sg) { tot += rtot[sg * 32 + tid]; pre += rpre[sg * 32 + tid]; }
    rtot[tid] = tot; rpre[tid] = pre; }
  __syncthreads();
  if (tid == 0) { int base = 0, nt = 0;
#pragma unroll 1
    for (int p = 0; p < 24; ++p) { sbase[p] = base + rpre[p]; const int n = rtot[p], tl = (n + 255) >> 8;
      if (bid == 0) { ctl[CT_BASE + p] = base; for (int t = 0; t < tl; ++t) ctl[CT_TP + nt + t] = p; }
      nt += tl; base += tl * 256; }
    if (bid == 0) { ctl[CT_BASE + 24] = base; ctl[CT_NT] = nt; } }
  __syncthreads();
  const int lane = tid & 63, gw = bid * 8 + (tid >> 6), ngw = GDIM * 8;
  for (int rb = gw; rb < MTOK; rb += 3 * ngw) {
    u32x4 a0[3], a1[3]; int pk[3]; float w0[3], w1[3]; bool act[3];
#pragma unroll
    for (int u = 0; u < 3; ++u) { const int r = rb + u * ngw; act[u] = r < MTOK && !(skip_ctx && (r % TPB) < CTXL); const int rc = act[u] ? r : 0;
      pk[u] = tok_pair[rc]; w0[u] = tok_w[2 * rc]; w1[u] = tok_w[2 * rc + 1];
      const u32x4* sp = (const u32x4*)(H2 + (size_t)rc * DM); a0[u] = sp[lane]; a1[u] = sp[lane + 64]; }
#pragma unroll
    for (int u = 0; u < 3; ++u) if (act[u]) { const int r = rb + u * ngw; const int slot = sbase[pk[u] & 31] + (pk[u] >> 5);
      if (lane == 0) { sorted_tok[slot] = r; sorted_w[2 * slot] = w0[u]; sorted_w[2 * slot + 1] = w1[u]; }
      u32x4* d = (u32x4*)(H2S + (size_t)slot * DM); d[lane] = a0[u]; d[lane + 64] = a1[u]; }
  }
  __syncthreads();
}
__device__ __forceinline__ void st_final(float* xl, const float* g) {
  const int lane = TIDX & 63, gw = BIDX * 8 + (TIDX >> 6), ngw = GDIM * 8;
  f32x4 gg[4];
#pragma unroll
  for (int j = 0; j < 4; ++j) gg[j] = *(const f32x4*)(g + 4 * lane + 256 * j);
  for (int rb = gw; rb < NB * SEQ; rb += 4 * ngw) {
    f32x4 v[4][4];
#pragma unroll
    for (int u = 0; u < 4; ++u) { const int r = rb + u * ngw; const float* xr = xl + (size_t)(r < NB * SEQ ? r : NB * SEQ - 1) * DM;
#pragma unroll
      for (int j = 0; j < 4; ++j) v[u][j] = *(const f32x4*)(xr + 4 * lane + 256 * j); }
#pragma unroll
    for (int u = 0; u < 4; ++u) { const int r = rb + u * ngw; float ss = 0.f;
#pragma unroll
      for (int j = 0; j < 4; ++j) ss += v[u][j].x * v[u][j].x + v[u][j].y * v[u][j].y + v[u][j].z * v[u][j].z + v[u][j].w * v[u][j].w;
      const float rstd = rsqrtf(wave_sum(ss) * (1.0f / DM) + EPS);
      if (r < NB * SEQ) { float* xr = xl + (size_t)r * DM;
#pragma unroll
        for (int j = 0; j < 4; ++j) *(f32x4*)(xr + 4 * lane + 256 * j) = (f32x4){v[u][j].x * rstd * gg[j].x, v[u][j].y * rstd * gg[j].y, v[u][j].z * rstd * gg[j].z, v[u][j].w * rstd * gg[j].w}; } }
  }
}

namespace pg8 {
#define PG8_LAS __attribute__((address_space(3)))
typedef unsigned short bf16_t;
typedef short bf16x8 __attribute__((ext_vector_type(8)));
typedef float f32x4 __attribute__((ext_vector_type(4)));
typedef unsigned u32x4 __attribute__((ext_vector_type(4)));
constexpr int BM = 256, BK = 64, HALF = 128, HTB = HALF * BK * 2  , STAGE_BYTES = 8 * HTB, NXCD = 8, WGM = 8;

__host__ __device__ __forceinline__ int lds_byte(int r, int c) { const int st = (r >> 4) * 2 + (c >> 5), rr = r & 15, cc = c & 31, ob = rr * 64 + cc * 2; return st * 1024 + (ob ^ (((ob >> 9) & 1) << 5)); }
__host__ __device__ __forceinline__ void stage_rc(int b, int& R, int& C) { const int st = b / 1024, sb = b % 1024, swz = sb ^ (((sb >> 9) & 1) << 5); R = (st >> 1) * 16 + swz / 64; C = (st & 1) * 32 + (swz % 64) / 2; }
__host__ __device__ __forceinline__ int perm32(int rho) { const int n = rho >> 4, i = rho & 15; return 8 * (i >> 2) + 4 * n + (i & 3); }

struct Unit { int pm, pn, fin; const char* A; const char* B; };
struct Gemm { int K, lda, ldb; };

__device__ __forceinline__ void tile_of(int L, int nM, int nN, int& pm, int& pn) {
    const int nwg = nM * nN; int wgid = L; { const int q = nwg / NXCD, r = nwg % NXCD, xcd = wgid % NXCD, off = wgid / NXCD; wgid = (xcd < r ? xcd * (q + 1) : r * (q + 1) + (xcd - r) * q) + off; }
    const int nig = WGM * nN, gid = wgid / nig, fm = gid * WGM, gsz = (nM - fm) < WGM ? (nM - fm) : WGM;
    pm = fm + ((wgid % nig) % gsz); pn = (wgid % nig) / gsz;
}
__device__ __forceinline__ unsigned cvt_pk_bf16(float lo, float hi) { unsigned r; asm volatile("v_cvt_pk_bf16_f32 %0, %1, %2" : "=v"(r) : "v"(lo), "v"(hi)); return r; }
template <class Epi, class Sched, bool ALIGN_EPI = false, bool SP2 = false>
__device__ __forceinline__ void gemm_phase(PG8_LAS unsigned char* lds, const Gemm g, const Sched& S, const Epi& E) {
    const int tid = opq_v((int)threadIdx.x), wid = __builtin_amdgcn_readfirstlane(tid >> 6), lane = tid & 63, wr = wid >> 2, wc = wid & 3, fr = lane & 15, fq = lane >> 4;
    const int K = g.K, nt = K / BK;
    unsigned voffA[2], voffB[2];
#pragma unroll
    for (int i = 0; i < 2; ++i) { int R, C; stage_rc(tid * 16 + i * 8192, R, C); const int Rb = Epi::PERM ? ((R & ~31) + perm32(R & 31)) : R;
        voffA[i] = (unsigned)(R * g.lda + C) * 2u; voffB[i] = (unsigned)(Rb * g.ldb + C) * 2u; }
    const size_t kstep = (size_t)(BK * 2);
    const size_t hstepA = (size_t)HALF * g.lda * 2, hstepB = (size_t)HALF * g.ldb * 2;
    const unsigned ldsw = (unsigned)wid * 1024u;
    const int aoff = lds_byte(wr * 64 + fr, fq * 8), boff = lds_byte(wc * 32 + fr, fq * 8);
#define PG8_SA(b, h) (((b) * 2 + (h)) * HTB)
#define PG8_SB(b, h) ((4 + (b) * 2 + (h)) * HTB)
#define PG8_STAGE(bufoff, gbase, voff) do { _Pragma("unroll") for (int _i = 0; _i < 2; ++_i) \
        __builtin_amdgcn_global_load_lds((const unsigned*)((const char*)(gbase) + (voff)[_i]), (PG8_LAS unsigned*)(lds + (bufoff) + ldsw + _i * 8192), 16, 0, 0); } while (0)
#define PG8_LDA(dst, b, h) do { _Pragma("unroll") for (int m = 0; m < 4; ++m) _Pragma("unroll") for (int k = 0; k < 2; ++k) dst[m][k] = *(const PG8_LAS bf16x8*)(lds + PG8_SA(b, h) + aoff + m * 2048 + k * 1024); } while (0)
#define PG8_LDB(dst, b, h) do { _Pragma("unroll") for (int n = 0; n < 2; ++n) _Pragma("unroll") for (int k = 0; k < 2; ++k) dst[n][k] = *(const PG8_LAS bf16x8*)(lds + PG8_SB(b, h) + boff + n * 2048 + k * 1024); } while (0)
#define PG8_MMA(ai, bj, At, Bt) do { __builtin_amdgcn_s_setprio(1); _Pragma("unroll") for (int m = 0; m < 4; ++m) _Pragma("unroll") for (int n = 0; n < 2; ++n) _Pragma("unroll") for (int k = 0; k < 2; ++k) \
        acc[ai][bj][m][n] = __builtin_amdgcn_mfma_f32_16x16x32_bf16(Bt[n][k], At[m][k], acc[ai][bj][m][n], 0, 0, 0); __builtin_amdgcn_s_setprio(0); } while (0)
#define PG8_WAIT_V(n) asm volatile("s_waitcnt vmcnt(" #n ")" ::: "memory")
#define PG8_WAIT_L(n) asm volatile("s_waitcnt lgkmcnt(" #n ")" ::: "memory")
#define PG8_BAR __builtin_amdgcn_s_barrier()
#define PG8_SCHED __builtin_amdgcn_sched_barrier(0)
    Unit cur, nxt; int ui = 0;
    if (!S.next(0, cur)) return;
    f32x4 acc[2][2][4][2];
#pragma unroll
    for (int a = 0; a < 2; ++a)
#pragma unroll
        for (int b = 0; b < 2; ++b)
#pragma unroll
            for (int m = 0; m < 4; ++m)
#pragma unroll
                for (int n = 0; n < 2; ++n) acc[a][b][m][n] = (f32x4){0.f, 0.f, 0.f, 0.f};
    bf16x8 At[4][2], B0[2][2], B1[2][2];
    const char* cA = cur.A; const char* cB = cur.B;
    S.a_ready(cur);
    if constexpr (SP2) {
        PG8_STAGE(PG8_SB(0, 0), cB, voffB); PG8_STAGE(PG8_SB(0, 1), cB + hstepB, voffB); PG8_STAGE(PG8_SA(0, 0), cA, voffA); PG8_STAGE(PG8_SA(0, 1), cA + hstepA, voffA);
        if (wr == 1) PG8_BAR;
        PG8_WAIT_V(2); PG8_BAR;
        PG8_STAGE(PG8_SB(1, 0), cB + kstep, voffB); PG8_STAGE(PG8_SA(1, 0), cA + kstep, voffA); PG8_STAGE(PG8_SB(1, 1), cB + hstepB + kstep, voffB);
        PG8_WAIT_V(6); PG8_BAR;
    } else {
        PG8_STAGE(PG8_SB(0, 0), cB, voffB); PG8_STAGE(PG8_SA(0, 0), cA, voffA); PG8_STAGE(PG8_SB(0, 1), cB + hstepB, voffB); PG8_STAGE(PG8_SA(0, 1), cA + hstepA, voffA);
        if (wr == 1) PG8_BAR;
        PG8_WAIT_V(4); PG8_BAR;
        PG8_STAGE(PG8_SB(1, 0), cB + kstep, voffB); PG8_STAGE(PG8_SA(1, 0), cA + kstep, voffA); PG8_STAGE(PG8_SB(1, 1), cB + hstepB + kstep, voffB);
        PG8_WAIT_V(6); PG8_BAR;
    }
    for (;;) {
        const bool has_next = S.next(ui + 1, nxt);
        const char* nA = has_next ? nxt.A : cA; const char* nB = has_next ? nxt.B : cB;
        for (int t = 0; t < nt; t += 2) {
            const bool last = (t == nt - 2);
            const char* a1 = cA + (size_t)(t + 1) * kstep;
            const char* a2 = last ? nA : cA + (size_t)(t + 2) * kstep; const char* b2 = last ? nB : cB + (size_t)(t + 2) * kstep;
            const char* a3 = a2 + kstep; const char* b3 = b2 + kstep;
            if (last && has_next) S.a_ready(nxt);
            if constexpr (SP2) {
            PG8_LDB(B0, 0, 0); PG8_LDB(B1, 0, 1); PG8_SCHED; PG8_LDA(At, 0, 0); PG8_STAGE(PG8_SA(1, 1), a1 + hstepA, voffA);
            PG8_WAIT_V(8); PG8_WAIT_L(0); PG8_BAR; PG8_MMA(0, 0, At, B0); PG8_MMA(0, 1, At, B1); PG8_BAR; PG8_SCHED;
            PG8_LDA(At, 0, 1); PG8_STAGE(PG8_SB(0, 0), b2, voffB); PG8_STAGE(PG8_SB(0, 1), b2 + hstepB, voffB); PG8_STAGE(PG8_SA(0, 0), a2, voffA);
            PG8_WAIT_V(8); PG8_WAIT_L(0); PG8_BAR; PG8_MMA(1, 0, At, B0); PG8_MMA(1, 1, At, B1); PG8_BAR; PG8_SCHED;
            PG8_LDB(B0, 1, 0); PG8_LDB(B1, 1, 1); PG8_SCHED; PG8_LDA(At, 1, 0); PG8_STAGE(PG8_SA(0, 1), a2 + hstepA, voffA);
            PG8_WAIT_V(8); PG8_WAIT_L(0); PG8_BAR; PG8_MMA(0, 0, At, B0); PG8_MMA(0, 1, At, B1); PG8_BAR; PG8_SCHED;
            PG8_LDA(At, 1, 1); PG8_STAGE(PG8_SB(1, 0), b3, voffB); PG8_STAGE(PG8_SB(1, 1), b3 + hstepB, voffB); PG8_STAGE(PG8_SA(1, 0), a3, voffA);
            PG8_WAIT_V(8); PG8_WAIT_L(0); PG8_BAR; PG8_MMA(1, 0, At, B0); PG8_MMA(1, 1, At, B1); PG8_BAR; PG8_SCHED;
            } else {
            PG8_LDB(B0, 0, 0); PG8_SCHED; PG8_LDA(At, 0, 0); PG8_STAGE(PG8_SA(1, 1), a1 + hstepA, voffA);
            PG8_WAIT_L(8); PG8_BAR; PG8_WAIT_L(0); PG8_MMA(0, 0, At, B0); PG8_BAR; PG8_SCHED;
            PG8_LDB(B1, 0, 1); PG8_STAGE(PG8_SB(0, 0), b2, voffB);
            PG8_BAR; PG8_WAIT_L(0); PG8_MMA(0, 1, At, B1); PG8_BAR;
            PG8_LDA(At, 0, 1); PG8_STAGE(PG8_SA(0, 0), a2, voffA);
            PG8_BAR; PG8_WAIT_L(0); PG8_MMA(1, 0, At, B0); PG8_BAR; PG8_SCHED;
            PG8_STAGE(PG8_SB(0, 1), b2 + hstepB, voffB);
            PG8_WAIT_V(6); PG8_BAR; PG8_MMA(1, 1, At, B1); PG8_BAR;
            PG8_LDB(B0, 1, 0); PG8_SCHED; PG8_LDA(At, 1, 0); PG8_STAGE(PG8_SA(0, 1), a2 + hstepA, voffA);
            PG8_WAIT_L(8); PG8_BAR; PG8_WAIT_L(0); PG8_MMA(0, 0, At, B0); PG8_BAR; PG8_SCHED;
            PG8_LDB(B1, 1, 1); PG8_STAGE(PG8_SB(1, 0), b3, voffB);
            PG8_BAR; PG8_WAIT_L(0); PG8_MMA(0, 1, At, B1); PG8_BAR;
            PG8_LDA(At, 1, 1); PG8_STAGE(PG8_SA(1, 0), a3, voffA);
            PG8_BAR; PG8_WAIT_L(0); PG8_MMA(1, 0, At, B0); PG8_BAR; PG8_SCHED;
            PG8_STAGE(PG8_SB(1, 1), b3 + hstepB, voffB);
            PG8_WAIT_V(6); PG8_BAR; PG8_MMA(1, 1, At, B1); PG8_BAR;
            }
        }
        if constexpr (ALIGN_EPI) { if (wr == 0) PG8_BAR; }
        if constexpr (!Epi::AFTER_DRAIN) { if (cur.fin) { E(acc, cur, wr, wc, fr, fq); S.done(cur); } }
        if (!has_next) break;
        if (cur.fin) {
#pragma unroll
        for (int a = 0; a < 2; ++a)
#pragma unroll
            for (int b = 0; b < 2; ++b)
#pragma unroll
                for (int m = 0; m < 4; ++m)
#pragma unroll
                    for (int n = 0; n < 2; ++n) acc[a][b][m][n] = (f32x4){0.f, 0.f, 0.f, 0.f};
        }
        cur = nxt; cA = nA; cB = nB; ++ui;
        if constexpr (ALIGN_EPI) { if (wr == 1) PG8_BAR; }
    }
    PG8_WAIT_V(0);
    if constexpr (!ALIGN_EPI) { if (wr == 0) PG8_BAR; }
    PG8_BAR;
    if constexpr (Epi::AFTER_DRAIN) { E.fused(acc, cur, wr, wc, fr, fq, lds, wid, lane); S.done(cur); }
#undef PG8_SA
#undef PG8_SB
#undef PG8_STAGE
#undef PG8_LDA
#undef PG8_LDB
#undef PG8_MMA
#undef PG8_WAIT_V
#undef PG8_WAIT_L
#undef PG8_BAR
#undef PG8_SCHED
}
}

struct SchedDense {
  int nM, nN, G, c, skip_ctx; const char* A; const char* B; size_t a_tile, b_tile;
  __device__ __forceinline__ bool next(int i, pg8::Unit& u) const {
    const long L = (long)i * G + c; if (L >= (long)nM * nN) return false;
    int pm, pn; pg8::tile_of((int)L, nM, nN, pm, pn); if (skip_ctx) pm = pm + pm / 16 + 1;
    u.pm = pm; u.pn = pn; u.fin = 1; u.A = A + (size_t)pm * a_tile; u.B = B + (size_t)pn * b_tile; return true; }
  __device__ __forceinline__ void a_ready(const pg8::Unit&) const {}
  __device__ __forceinline__ void done(const pg8::Unit&) const {}
};
struct SchedMoe {
  int G, c, mode; const int* ctl; const char* A; size_t a_tile; const char* W;
  __device__ __forceinline__ bool next(int i, pg8::Unit& u) const {
    const int part = mode == 2 ? (i & 1) : 0, iu = mode == 2 ? (i >> 1) : i;
    const long L = (long)iu * G + c; const int ntiles = ctl[CT_NT]; if (L >= (long)ntiles * 4) return false;
    const int pm = (int)(L >> 2), pn = (int)(L & 3); int eA, eB; pair_experts(ctl[CT_TP + pm], eA, eB);
    u.pm = pm; u.pn = pn;
    if (mode == 1) { const int e = pn < 2 ? eA : eB; u.fin = 1; u.A = A + (size_t)pm * a_tile; u.B = W + (size_t)e * (512 * 1024 * 2) + (size_t)(pn & 1) * (256 * 1024 * 2); }
    else { u.fin = part; u.A = A + (size_t)pm * a_tile + part * 512; u.B = W + (size_t)(part ? eB : eA) * (1024 * 256 * 2) + (size_t)pn * (256 * 256 * 2); }
    return true; }
  __device__ __forceinline__ void a_ready(const pg8::Unit&) const {}
  __device__ __forceinline__ void done(const pg8::Unit&) const {}
};
__device__ __forceinline__ unsigned cvt_pk(float lo, float hi) { return pg8::cvt_pk_bf16(lo, hi); }
struct EpiInProj {
  static constexpr bool PERM = true, AFTER_DRAIN = false; bf16_t *QK, *VZ, *XBC, *HY; float* DT;
  __device__ __forceinline__ void operator()(const f32x4 (&acc)[2][2][4][2], const pg8::Unit& u, int wr, int wc, int fr, int fq) const {
    const int pn = u.pn; bf16_t* base; int ldc, coff;
    if (pn < 2) { base = QK; ldc = 512; coff = pn * 256; } else if (pn < 4) { base = VZ; ldc = 512; coff = (pn - 2) * 256; }
    else if (pn < 7) { base = XBC; ldc = 768; coff = (pn - 4) * 256; } else { base = HY; ldc = 768; coff = (pn - 7) * 256; }
    const int row0 = u.pm * 256 + wr * 64 + fr, col0 = coff + wc * 32 + 8 * fq; const bool dtl = (pn == 6 && wc == 0 && fq < 2);
#pragma unroll
    for (int ai = 0; ai < 2; ++ai)
#pragma unroll
      for (int m = 0; m < 4; ++m) { const int row = row0 + ai * 128 + m * 16; bf16_t* rowp = base + (size_t)row * ldc + col0;
#pragma unroll
        for (int bj = 0; bj < 2; ++bj) { const f32x4 v0 = acc[ai][bj][m][0], v1 = acc[ai][bj][m][1];
          u32x4 w; w.x = cvt_pk(v0[0], v0[1]); w.y = cvt_pk(v0[2], v0[3]); w.z = cvt_pk(v1[0], v1[1]); w.w = cvt_pk(v1[2], v1[3]);
          *(u32x4*)(rowp + bj * 128) = w;
          if (bj == 1 && dtl) { float* dp = DT + (size_t)row * 12 + 8 * fq; *(f32x4*)dp = v0; if (fq == 0) *(f32x4*)(dp + 4) = v1; } } }
  }
};
struct EpiOutProj {
  static constexpr bool PERM = true, AFTER_DRAIN = false; bf16_t* MO;
  __device__ __forceinline__ void operator()(const f32x4 (&acc)[2][2][4][2], const pg8::Unit& u, int wr, int wc, int fr, int fq) const {
    const int row0 = u.pm * 256 + wr * 64 + fr, col0 = u.pn * 256 + wc * 32 + 8 * fq;
#pragma unroll
    for (int ai = 0; ai < 2; ++ai)
#pragma unroll
      for (int m = 0; m < 4; ++m) { bf16_t* rowp = MO + (size_t)(row0 + ai * 128 + m * 16) * DM + col0;
#pragma unroll
        for (int bj = 0; bj < 2; ++bj) { const f32x4 v0 = acc[ai][bj][m][0], v1 = acc[ai][bj][m][1];
          u32x4 w; w.x = cvt_pk(v0[0], v0[1]); w.y = cvt_pk(v0[2], v0[3]); w.z = cvt_pk(v1[0], v1[1]); w.w = cvt_pk(v1[2], v1[3]);
          *(u32x4*)(rowp + bj * 128) = w; } }
  }
};
struct EpiMoe1 {
  static constexpr bool PERM = true, AFTER_DRAIN = false; bf16_t* ACT; const float* sorted_w;
  __device__ __forceinline__ void operator()(const f32x4 (&acc)[2][2][4][2], const pg8::Unit& u, int wr, int wc, int fr, int fq) const {
    const int half = u.pn >> 1, j0 = (u.pn & 1) * 128 + 16 * wc + 4 * fq;
#pragma unroll
    for (int ai = 0; ai < 2; ++ai)
#pragma unroll
      for (int m = 0; m < 4; ++m) { const int slot = u.pm * 256 + ai * 128 + wr * 64 + m * 16 + fr; const float wt = sorted_w[2 * slot + half];
#pragma unroll
        for (int bj = 0; bj < 2; ++bj) { const f32x4 v0 = acc[ai][bj][m][0], v1 = acc[ai][bj][m][1];
          u32x2 w; w.x = cvt_pk(siluf(v0[0]) * v0[1] * wt, siluf(v0[2]) * v0[3] * wt); w.y = cvt_pk(siluf(v1[0]) * v1[1] * wt, siluf(v1[2]) * v1[3] * wt);
          *(u32x2*)(ACT + (size_t)slot * 512 + half * 256 + j0 + 64 * bj) = w; } }
  }
};
struct EpiMoe2 {
  static constexpr bool PERM = false, AFTER_DRAIN = false; float *xl, *xc; const float* gate; const int* sorted_tok;
  __device__ __forceinline__ void operator()(const f32x4 (&acc)[2][2][4][2], const pg8::Unit& u, int wr, int wc, int fr, int fq) const {
    const int col0 = u.pn * 256 + wc * 32 + 4 * fq;
#pragma unroll
    for (int ai = 0; ai < 2; ++ai)
#pragma unroll
      for (int m = 0; m < 4; ++m) { const int slot = u.pm * 256 + ai * 128 + wr * 64 + m * 16 + fr; const int r = sorted_tok[slot];
        if (r >= 0) { float* xd = xrow(xl, xc, r) + col0; const float* gt = gate + (size_t)mrow_of(r) * 6144 + col0;
#pragma unroll
          for (int bj = 0; bj < 2; ++bj)
#pragma unroll
            for (int n = 0; n < 2; ++n) { const int co = bj * 128 + n * 16; *(f32x4*)(xd + co) = *(const f32x4*)(xd + co) + *(const f32x4*)(gt + co) * acc[ai][bj][m][n]; } }
        asm volatile("" ::: "memory"); }
  }
};

#include <hip/hip_bf16.h>
#include <cmath>
namespace attn_body {
using bf16=__hip_bfloat16;
using bf16x8=__attribute__((ext_vector_type(8)))short;
using s16x4=__attribute__((ext_vector_type(4)))short;
using f32x16=__attribute__((ext_vector_type(16)))float;
using u32x4=__attribute__((ext_vector_type(4)))unsigned;
constexpr int D=64,QP=512,KP=512,VP=512,OP=1024;
constexpr int NW=8,QBLK=32,QB=QBLK*NW,KVBLK=64;
constexpr int ATTN_UNIT_ROWS=QB;
__device__ __forceinline__ int crow(int r,int hi){return (r&3)+8*(r>>2)+4*hi;}
#define SBAR() __builtin_amdgcn_sched_barrier(0)
__device__ __forceinline__ void cmask(f32x16&p0,f32x16&p1,int jb,int qrel,int hi){
  const float NEG=-INFINITY; int kb=64*jb+4*hi;
  #pragma unroll
  for(int r=0;r<16;++r){int kv=kb+(r&3)+8*(r>>2); if(kv>qrel)p0[r]=NEG; if(kv+32>qrel)p1[r]=NEG;}
}

constexpr int NSLOT=3, SLOTB=8192;
constexpr int LDS_K=0, LDS_V=NSLOT*SLOTB, LDS_WS=2*NSLOT*SLOTB, LDS_OST=LDS_WS+NW*64*4, LDS_BYTES=LDS_OST+NW*4096;
constexpr float C2=0.125f*1.4426950408889634f;
__device__ __forceinline__ void glds16(const void*gsrc,unsigned lds_dst){unsigned keep;
  asm volatile("s_mov_b32 %0, m0\n\ts_mov_b32 m0, %2\n\ts_nop 0\n\tglobal_load_lds_dwordx4 %1, off\n\ts_mov_b32 m0, %0":"=&s"(keep):"v"(gsrc),"s"(lds_dst):"memory");}
__device__ __forceinline__ float max3f(float a,float b,float c){float r;asm("v_max3_f32 %0, %1, %2, %3":"=v"(r):"v"(a),"v"(b),"v"(c));return r;}
__device__ __forceinline__ float max2f(float a,float b){float r;asm("v_max_f32_e32 %0, %1, %2":"=v"(r):"v"(a),"v"(b));return r;}
__device__ __forceinline__ float fadd_s(float a,float b){float r;asm("v_add_f32_e32 %0, %1, %2":"=v"(r):"v"(a),"v"(b));return r;}
__device__ __forceinline__ float fsub_s(float a,float b){float r;asm("v_sub_f32_e32 %0, %1, %2":"=v"(r):"v"(a),"v"(b));return r;}
typedef float f32x2_t __attribute__((ext_vector_type(2))); typedef __bf16 bf16x2_t __attribute__((ext_vector_type(2)));
__device__ __forceinline__ unsigned cvtpk_s(float lo,float hi){f32x2_t v={lo,hi};bf16x2_t b=__builtin_convertvector(v,bf16x2_t);return __builtin_bit_cast(unsigned,b);}
#define WAIT_BAR(N) asm volatile("s_waitcnt vmcnt(" #N ") lgkmcnt(0)\n\ts_barrier":::"memory")

__device__ __forceinline__ void qkt(f32x16&p0,f32x16&p1,const char*Kslot,const bf16x8*qr,const f32x16&negm,int r32,int hi){
  const char*kb=Kslot+hi*1024+r32*16;
  #pragma unroll
  for(int d0=0;d0<4;++d0){
    const bf16x8 b0=*reinterpret_cast<const bf16x8*>(kb+d0*2048);
    const bf16x8 b1=*reinterpret_cast<const bf16x8*>(kb+d0*2048+512);
    if(d0==0){p0=__builtin_amdgcn_mfma_f32_32x32x16_bf16(b0,qr[0],negm,0,0,0);p1=__builtin_amdgcn_mfma_f32_32x32x16_bf16(b1,qr[0],negm,0,0,0);}
    else{p0=__builtin_amdgcn_mfma_f32_32x32x16_bf16(b0,qr[d0],p0,0,0,0);p1=__builtin_amdgcn_mfma_f32_32x32x16_bf16(b1,qr[d0],p1,0,0,0);}}
}
typedef __attribute__((address_space(3))) const char* lds_cptr;
typedef short v4i16_t __attribute__((ext_vector_type(4)));
__device__ __forceinline__ void kload8(bf16x8*kf,lds_cptr kp){
  kf[0]=*(const __attribute__((address_space(3))) bf16x8*)(kp);      kf[1]=*(const __attribute__((address_space(3))) bf16x8*)(kp+512);
  kf[2]=*(const __attribute__((address_space(3))) bf16x8*)(kp+2048); kf[3]=*(const __attribute__((address_space(3))) bf16x8*)(kp+2560);
  kf[4]=*(const __attribute__((address_space(3))) bf16x8*)(kp+4096); kf[5]=*(const __attribute__((address_space(3))) bf16x8*)(kp+4608);
  kf[6]=*(const __attribute__((address_space(3))) bf16x8*)(kp+6144); kf[7]=*(const __attribute__((address_space(3))) bf16x8*)(kp+6656);
}
__device__ __forceinline__ void kload2(bf16x8*kf,lds_cptr kp,int j){ kf[2*j]=*(const __attribute__((address_space(3))) bf16x8*)(kp+j*2048); kf[2*j+1]=*(const __attribute__((address_space(3))) bf16x8*)(kp+j*2048+512); }
__device__ __forceinline__ s16x4 vtr(lds_cptr p){ return __builtin_bit_cast(s16x4,__builtin_amdgcn_ds_read_tr16_b64_v4i16((__attribute__((address_space(3))) v4i16_t*)p)); }
__device__ __forceinline__ float rowmax(const f32x16&p0,const f32x16&p1){
  float a=max3f(p0[0],p0[1],p1[0]),b=max3f(p0[2],p0[3],p1[1]);a=max3f(a,p1[2],p1[3]);
  #pragma unroll
  for(int r=4;r<16;r+=4){a=max3f(a,p0[r],p0[r+1]);b=max3f(b,p0[r+2],p0[r+3]);a=max3f(a,p1[r],p1[r+1]);b=max3f(b,p1[r+2],p1[r+3]);}
  const float m=max2f(a,b);
  auto rr=__builtin_amdgcn_permlane32_swap(__float_as_uint(m),__float_as_uint(m),false,false);
  return max2f(__uint_as_float(rr[0]),__uint_as_float(rr[1]));
}
__device__ __forceinline__ void pv(f32x16*o,int vb,bf16x8 pa0,bf16x8 pa1,bf16x8 pa2,bf16x8 pa3){
  #pragma unroll
  for(int d0=0;d0<2;++d0){s16x4 lo[4],hi[4];
    #pragma unroll
    for(int ks=0;ks<4;++ks){
      asm volatile("ds_read_b64_tr_b16 %0,%1 offset:%c2":"=&v"(lo[ks]):"v"(vb),"i"(d0*4096+ks*1024):"memory");
      asm volatile("ds_read_b64_tr_b16 %0,%1 offset:%c2":"=&v"(hi[ks]):"v"(vb),"i"(d0*4096+ks*1024+512):"memory");}
    asm volatile("s_waitcnt lgkmcnt(0)":::"memory");SBAR();
    #define PK(k) (bf16x8){lo[k][0],lo[k][1],lo[k][2],lo[k][3],hi[k][0],hi[k][1],hi[k][2],hi[k][3]}
    o[d0]=__builtin_amdgcn_mfma_f32_32x32x16_bf16(pa0,PK(0),o[d0],0,0,0);
    o[d0]=__builtin_amdgcn_mfma_f32_32x32x16_bf16(pa1,PK(1),o[d0],0,0,0);
    o[d0]=__builtin_amdgcn_mfma_f32_32x32x16_bf16(pa2,PK(2),o[d0],0,0,0);
    o[d0]=__builtin_amdgcn_mfma_f32_32x32x16_bf16(pa3,PK(3),o[d0],0,0,0);
    #undef PK
  }
}

#ifndef ATTN_STORE16
#define ATTN_STORE16(p,v) (*(u32x4*)(p)=(v))
#endif
template<int THRL> __device__ __forceinline__ void attn_unit(const bf16*Qu,const bf16*__restrict__ Kh,const bf16*__restrict__ Vh,bf16*Ou,const int NT,char*shm){
  const int tid=opq_v((int)threadIdx.x),lane=tid&63,r32=lane&31,hi=lane>>5; const int wid=__builtin_amdgcn_readfirstlane(tid>>6);
  const bf16*Qw=Qu+(long)(wid*QBLK)*QP;
  const unsigned lds0=(unsigned)(uintptr_t)shm;
  float*wsf=(float*)(shm+LDS_WS)+wid*64;
  const bf16*ksrc=Kh+(long)lane*KP+wid*8;
  const bf16*vsrc=Vh+(long)(16*(wid&3)+(lane>>2))*VP+(wid>>2)*32+(lane&3)*8;
  const unsigned kdst=lds0+LDS_K+wid*1024, vdst=lds0+LDS_V+wid*1024;
  #define DMA_K(t,slot) glds16(ksrc+(long)(t)*KVBLK*KP,(unsigned)__builtin_amdgcn_readfirstlane(kdst+(slot)))
  #define DMA_V(t,slot) glds16(vsrc+(long)(t)*KVBLK*VP,(unsigned)__builtin_amdgcn_readfirstlane(vdst+(slot)))
  const int vb0=(int)(lds0+LDS_V)+((lane>>4)&1)*32+(lane&3)*8+(4*hi+((lane&15)>>2))*64;
  const char*Kbase=shm+LDS_K; bf16x8 kf[8];
  const lds_cptr shm3=(lds_cptr)shm; const lds_cptr kp0=shm3+LDS_K+hi*1024+r32*16; const lds_cptr vp0=shm3+LDS_V+((lane>>4)&1)*32+(lane&3)*8+(4*hi+((lane&15)>>2))*64;
  DMA_K(0,0);DMA_V(0,0);DMA_K(1,SLOTB);
  bf16x8 qr[4];
  #pragma unroll
  for(int d0=0;d0<4;++d0)qr[d0]=*reinterpret_cast<const bf16x8*>(&Qw[(long)r32*QP+d0*16+hi*8]);
  float mhat=0.f,l_reg=0.f;float z0_=0.f;asm volatile("":"+v"(z0_));f32x16 o[2];f32x16 negm;
  _Pragma("unroll") for(int r=0;r<16;++r){o[0][r]=z0_;o[1][r]=z0_;negm[r]=z0_;} asm volatile("":"+v"(negm));
  #define CMASK(P0,P1,t) do{}while(0)
  bool resc=false;
  #define START(P0,P1) do{ const float rm=rowmax(P0,P1); resc=false; \
    { const float dl=rm; mhat=fadd_s(mhat,dl); \
      _Pragma("unroll") for(int r=0;r<16;++r){P0[r]=fsub_s(P0[r],dl);P1[r]=fsub_s(P1[r],dl);} \
      _Pragma("unroll") for(int r=0;r<16;++r)negm[r]=-mhat; asm volatile("":"+v"(negm)); } \
    _Pragma("unroll") for(int r=0;r<16;++r)P0[r]=__builtin_amdgcn_exp2f(P0[r]); }while(0)
  #define RESC() do{ if(resc){ asm volatile("s_waitcnt lgkmcnt(0)":::"memory"); \
      _Pragma("unroll") for(int d_=0;d_<2;++d_) _Pragma("unroll") for(int r=0;r<16;++r)o[d_][r]*=wsf[crow(r,hi)]; } }while(0)
  f32x16 pA0,pA1,pB0,pB1;
  int sl_prev=0,sl_cur=0,sl_next=SLOTB;
  #define ROT() do{sl_prev=sl_cur;sl_cur=sl_next;sl_next=(sl_next==(NSLOT-1)*SLOTB)?0:sl_next+SLOTB;}while(0)
  DMA_K(2,2*SLOTB);
  WAIT_BAR(3);
  qkt(pA0,pA1,Kbase,qr,negm,r32,hi);asm volatile("s_nop 15\n\ts_nop 7":"+v"(pA0),"+v"(pA1));CMASK(pA0,pA1,0);
  START(pA0,pA1);
  _Pragma("unroll") for(int r=0;r<16;++r)pA1[r]=__builtin_amdgcn_exp2f(pA1[r]);
  WAIT_BAR(0);
  DMA_K(3,0);DMA_V(1,SLOTB);
  ROT();
  kload8(kf,kp0+sl_cur);
  WAIT_BAR(2);
  s16x4 vlo[8],vhi[8]; u32x4 pw0,pw1,pw2,pw3;
  #define PKW(P,B) cvtpk_s(P[B],P[B+1])
  #define PAF(k) __builtin_bit_cast(bf16x8,pw##k)
  #define VFR(i) (bf16x8){vlo[i][0],vlo[i][1],vlo[i][2],vlo[i][3],vhi[i][0],vhi[i][1],vhi[i][2],vhi[i][3]}
  #define PIN(x) asm volatile("":"+v"(x))
  #define MX3(a,b,c) __builtin_fmaxf(__builtin_fmaxf((a),(b)),(c))
  #define GAPA(MF,A0,A1,A2,A3,W0,W1,PW) do{ MF; sacc+=A0; sacc+=A1; sacc+=A2; sacc+=A3; PIN(sacc); W0; W1; PIN(PW); SBAR(); }while(0)
  #define EX(v) __builtin_amdgcn_exp2f(v)
  #define GAPB(MF,X,B) do{ MF; X[B]=EX(X[B]); X[B+1]=EX(X[B+1]); X[B+2]=EX(X[B+2]); X[B+3]=EX(X[B+3]); PIN(X); SBAR(); }while(0)
  #define VRD(i) do{ vlo[i]=vtr(vp_+(((i)>>2)*4096+((i)&3)*1024)); vhi[i]=vtr(vp_+(((i)>>2)*4096+((i)&3)*1024+512)); }while(0)
  #define KRD(G,j) do{ if(G){ kload2(kf,kp0+sl_next,j); SBAR(); } }while(0)
  #define STEP(C0,C1,P0,P1,t,GK,GV,GL) do{ SBAR(); \
    const lds_cptr vp_=vp0+sl_prev; \
    VRD(0); SBAR(); float sacc=(P0[0]+P0[1]); \
    GAPA(C0=__builtin_amdgcn_mfma_f32_32x32x16_bf16(kf[0],qr[0],negm,0,0,0), P0[2],P0[3],P0[4],P0[5],     pw0[0]=PKW(P0,0), pw0[1]=PKW(P0,2), pw0); \
    VRD(4); SBAR(); GAPA(C1=__builtin_amdgcn_mfma_f32_32x32x16_bf16(kf[1],qr[0],negm,0,0,0), P0[6],P0[7],P0[8],P0[9],     pw0[2]=PKW(P0,4), pw0[3]=PKW(P0,6), pw0); \
    VRD(1); SBAR(); GAPA(C0=__builtin_amdgcn_mfma_f32_32x32x16_bf16(kf[2],qr[1],C0,0,0,0),   P0[10],P0[11],P0[12],P0[13], pw1[0]=PKW(P0,8), pw1[1]=PKW(P0,10), pw1); \
    VRD(5); SBAR(); GAPA(C1=__builtin_amdgcn_mfma_f32_32x32x16_bf16(kf[3],qr[1],C1,0,0,0),   P0[14],P0[15],P1[0],P1[1],   pw1[2]=PKW(P0,12),pw1[3]=PKW(P0,14), pw1); \
    VRD(2); SBAR(); GAPA(C0=__builtin_amdgcn_mfma_f32_32x32x16_bf16(kf[4],qr[2],C0,0,0,0),   P1[2],P1[3],P1[4],P1[5],     pw2[0]=PKW(P1,0), pw2[1]=PKW(P1,2), pw2); \
    VRD(6); SBAR(); GAPA(C1=__builtin_amdgcn_mfma_f32_32x32x16_bf16(kf[5],qr[2],C1,0,0,0),   P1[6],P1[7],P1[8],P1[9],     pw2[2]=PKW(P1,4), pw2[3]=PKW(P1,6), pw2); \
    VRD(3); SBAR(); GAPA(C0=__builtin_amdgcn_mfma_f32_32x32x16_bf16(kf[6],qr[3],C0,0,0,0),   P1[10],P1[11],P1[12],P1[13], pw3[0]=PKW(P1,8), pw3[1]=PKW(P1,10), pw3); \
    VRD(7); SBAR(); GAPA(C1=__builtin_amdgcn_mfma_f32_32x32x16_bf16(kf[7],qr[3],C1,0,0,0),   P1[14],P1[15],0.f,0.f,       pw3[2]=PKW(P1,12),pw3[3]=PKW(P1,14), pw3); \
    l_reg+=sacc; \
    if(GK){DMA_K((t)+3,sl_cur);} if(GV){DMA_V((t)+1,sl_next);} \
    CMASK(C0,C1,t); \
    { float a=MX3(C0[0],C0[1],C1[0]),b=MX3(C0[2],C0[3],C1[1]); a=MX3(a,C1[2],C1[3]); \
      _Pragma("unroll") for(int r=4;r<16;r+=4){a=MX3(a,C0[r],C0[r+1]);b=MX3(b,C0[r+2],C0[r+3]);a=MX3(a,C1[r],C1[r+1]);b=MX3(b,C1[r+2],C1[r+3]);} \
      float rm=__builtin_fmaxf(a,b); { auto rr=__builtin_amdgcn_permlane32_swap(__float_as_uint(rm),__float_as_uint(rm),false,false); rm=__builtin_fmaxf(__uint_as_float(rr[0]),__uint_as_float(rr[1])); } \
      resc=false; \
      if(__builtin_expect(__any(rm>(float)THRL),0)){ const float dl=__builtin_fmaxf(rm,0.f); mhat+=dl; \
        _Pragma("unroll") for(int r=0;r<16;++r){C0[r]-=dl;C1[r]-=dl;} \
        _Pragma("unroll") for(int r=0;r<16;++r)negm[r]=-mhat; asm volatile("":"+v"(negm)); \
        const float f=__builtin_amdgcn_exp2f(-dl); l_reg*=f; if(hi==0)wsf[r32]=f; resc=true; } } \
    SBAR(); \
    GAPB(o[0]=__builtin_amdgcn_mfma_f32_32x32x16_bf16(PAF(0),VFR(0),o[0],0,0,0), C0,0); \
    GAPB(o[1]=__builtin_amdgcn_mfma_f32_32x32x16_bf16(PAF(0),VFR(4),o[1],0,0,0), C0,4); \
    KRD(GL,0); GAPB(o[0]=__builtin_amdgcn_mfma_f32_32x32x16_bf16(PAF(1),VFR(1),o[0],0,0,0), C0,8); \
    KRD(GL,1); GAPB(o[1]=__builtin_amdgcn_mfma_f32_32x32x16_bf16(PAF(1),VFR(5),o[1],0,0,0), C0,12); \
    KRD(GL,2); GAPB(o[0]=__builtin_amdgcn_mfma_f32_32x32x16_bf16(PAF(2),VFR(2),o[0],0,0,0), C1,0); \
    KRD(GL,3); GAPB(o[1]=__builtin_amdgcn_mfma_f32_32x32x16_bf16(PAF(2),VFR(6),o[1],0,0,0), C1,4); \
    GAPB(o[0]=__builtin_amdgcn_mfma_f32_32x32x16_bf16(PAF(3),VFR(3),o[0],0,0,0), C1,8); \
    GAPB(o[1]=__builtin_amdgcn_mfma_f32_32x32x16_bf16(PAF(3),VFR(7),o[1],0,0,0), C1,12); \
    }while(0)
  int t=1;
  for(;t+5<NT;t+=2){
    STEP(pB0,pB1,pA0,pA1,t,true,true,true);     WAIT_BAR(2); RESC(); ROT();
    STEP(pA0,pA1,pB0,pB1,t+1,true,true,true);   WAIT_BAR(2); RESC(); ROT();
  }
  #define ENDW(tt) do{ if((tt)+3<NT){WAIT_BAR(2);} else if((tt)+2<NT){WAIT_BAR(1);} else {WAIT_BAR(0);} }while(0)
  for(;t+1<NT;t+=2){
    STEP(pB0,pB1,pA0,pA1,t,(t+3<NT),(t+1<NT),(t+1<NT));       ENDW(t);   RESC(); ROT();
    STEP(pA0,pA1,pB0,pB1,t+1,(t+4<NT),(t+2<NT),(t+2<NT));     ENDW(t+1); RESC(); ROT();
  }
  STEP(pB0,pB1,pA0,pA1,NT-1,false,false,false); RESC();
  { float sacc=pB0[0]+pB0[1]; _Pragma("unroll") for(int r=2;r<16;++r)sacc+=pB0[r]; _Pragma("unroll") for(int r=0;r<16;++r)sacc+=pB1[r]; l_reg+=sacc;
    pw0=(u32x4){PKW(pB0,0),PKW(pB0,2),PKW(pB0,4),PKW(pB0,6)};pw1=(u32x4){PKW(pB0,8),PKW(pB0,10),PKW(pB0,12),PKW(pB0,14)};pw2=(u32x4){PKW(pB1,0),PKW(pB1,2),PKW(pB1,4),PKW(pB1,6)};pw3=(u32x4){PKW(pB1,8),PKW(pB1,10),PKW(pB1,12),PKW(pB1,14)};
    SBAR(); pv(o,vb0+sl_cur,PAF(0),PAF(1),PAF(2),PAF(3)); }
  #undef PKW
  #undef PAF
  #undef VFR
  #undef PIN
  #undef MX3
  #undef GAPA
  #undef GAPB
  #undef EX
  #undef VRD
  #undef KRD
  #undef STEP
  #undef ENDW
  {auto rr=__builtin_amdgcn_permlane32_swap(__float_as_uint(l_reg),__float_as_uint(l_reg),false,false);l_reg=__uint_as_float(rr[0])+__uint_as_float(rr[1]);}
  if(hi==0)wsf[32+r32]=l_reg;asm volatile("s_waitcnt lgkmcnt(0)":::"memory");
  float rli[16];
  #pragma unroll
  for(int r=0;r<16;++r)rli[r]=__builtin_amdgcn_rcpf(wsf[32+crow(r,hi)]);
  bf16*Ow=Ou+(long)(wid*QBLK)*OP;
  { bf16*stg=(bf16*)(shm+LDS_OST)+wid*2048;
    #pragma unroll
    for(int r=0;r<16;++r){const int orow=crow(r,hi);
      #pragma unroll
      for(int d0=0;d0<2;++d0)stg[orow*64+d0*32+r32]=__float2bfloat16(o[d0][r]*rli[r]);}
    asm volatile("s_waitcnt lgkmcnt(0)":::"memory");
    #pragma unroll
    for(int i=0;i<4;++i){const int row=i*8+(lane>>3),ch=lane&7; const u32x4 v=*(const u32x4*)(stg+row*64+ch*8); ATTN_STORE16(Ow+(long)row*OP+ch*8,v);} }
  asm volatile("s_waitcnt lgkmcnt(0)\n\ts_barrier":::"memory");
  #undef DMA_K
  #undef DMA_V
  #undef CMASK
  #undef START
  #undef RESC
  #undef ROT
}
constexpr int ATTN_LDS_BYTES=LDS_BYTES;
#undef SBAR
#undef WAIT_BAR
}


namespace hyf {
struct c32 { float x, y; };
typedef _Float16 h2 __attribute__((ext_vector_type(2)));
__device__ __forceinline__ c32 operator+(c32 a, c32 b) { return {a.x + b.x, a.y + b.y}; }
__device__ __forceinline__ c32 operator-(c32 a, c32 b) { return {a.x - b.x, a.y - b.y}; }
__device__ __forceinline__ c32 cmul(c32 a, c32 b) { return {a.x * b.x - a.y * b.y, a.x * b.y + a.y * b.x}; }
__device__ __forceinline__ constexpr float C32(int k) {
  switch (k) { case 0: return 1.f; case 1: return 0.98078528f; case 2: return 0.923879533f; case 3: return 0.831469612f; case 4: return 0.707106781f; case 5: return 0.555570233f; case 6: return 0.382683432f;
    case 7: return 0.195090322f; case 8: return 0.f; case 9: return -0.195090322f; case 10: return -0.382683432f; case 11: return -0.555570233f; case 12: return -0.707106781f; case 13: return -0.831469612f;
    case 14: return -0.923879533f; default: return -0.98078528f; } }
__device__ __forceinline__ constexpr float S32(int k) {
  switch (k) { case 0: return 0.f; case 1: return 0.195090322f; case 2: return 0.382683432f; case 3: return 0.555570233f; case 4: return 0.707106781f; case 5: return 0.831469612f; case 6: return 0.923879533f;
    case 7: return 0.98078528f; case 8: return 1.f; case 9: return 0.98078528f; case 10: return 0.923879533f; case 11: return 0.831469612f; case 12: return 0.707106781f; case 13: return 0.555570233f;
    case 14: return 0.382683432f; default: return 0.195090322f; } }
__device__ __forceinline__ constexpr int brev(int q, int bits) {
  return bits == 4 ? (((q & 1) << 3) | ((q & 2) << 1) | ((q & 4) >> 1) | ((q & 8) >> 3))
                   : (((q & 1) << 4) | ((q & 2) << 2) | (q & 4) | ((q & 8) >> 2) | ((q & 16) >> 4)); }
__device__ __forceinline__ int phys(int p) { return p + (p >> 5); }
template <int R, int HALF, bool INV> struct DftStage {
  static __device__ __forceinline__ void run(c32 (&x)[R]) {
#pragma unroll
    for (int blk = 0; blk < R; blk += 2 * HALF) {
#pragma unroll
      for (int j = 0; j < HALF; ++j) {
        const c32 a = x[blk + j], b = x[blk + j + HALF]; x[blk + j] = a + b; const c32 d = a - b;
        const int e = j * (R / (2 * HALF)) * (32 / R);
        if (e == 0) x[blk + j + HALF] = d;
        else if (e == 8) x[blk + j + HALF] = INV ? (c32){-d.y, d.x} : (c32){d.y, -d.x};
        else { const c32 wv = {C32(e), INV ? S32(e) : -S32(e)}; x[blk + j + HALF] = cmul(d, wv); }
      } }
    DftStage<R, HALF / 2, INV>::run(x);
  }
};
template <int R, bool INV> struct DftStage<R, 0, INV> { static __device__ __forceinline__ void run(c32 (&)[R]) {} };
template <int R, bool INV> __device__ __forceinline__ void dft_pow2(c32 (&x)[R]) { DftStage<R, R / 2, INV>::run(x); }
template <int R, int HALF> struct DitStage {
  static __device__ __forceinline__ void run(c32 (&x)[R]) {
#pragma unroll
    for (int blk = 0; blk < R; blk += 2 * HALF) {
#pragma unroll
      for (int j = 0; j < HALF; ++j) {
        const int e = j * (R / (2 * HALF)) * (32 / R);
        const c32 a = x[blk + j], b0 = x[blk + j + HALF];
        c32 b;
        if (e == 0) b = b0; else if (e == 8) b = (c32){-b0.y, b0.x}; else b = cmul(b0, (c32){C32(e), S32(e)});
        x[blk + j] = a + b; x[blk + j + HALF] = a - b;
      } }
    DitStage<R, HALF * 2>::run(x);
  }
};
template <int R> struct DitStage<R, R> { static __device__ __forceinline__ void run(c32 (&)[R]) {} };
template <int R> __device__ __forceinline__ void idft_dit(c32 (&x)[R]) { DitStage<R, 1>::run(x); }
template <int STRIDE, bool INV> __device__ __forceinline__ void pass16(c32* buf, int e0, float rev) {
  float rv = rev; asm volatile("" : "+v"(rv));
  const float cs = __builtin_amdgcn_cosf(rv), sn = __builtin_amdgcn_sinf(rv);
  const c32 w1 = {cs, INV ? sn : -sn};
  c32* p = buf + phys(e0); constexpr int PS = STRIDE + STRIDE / 32;
  c32 x[16];
  if (!INV) {
#pragma unroll
    for (int m = 0; m < 16; ++m) x[m] = p[PS * m];
    dft_pow2<16, false>(x);
    c32 w = w1; p[0] = x[0];
#pragma unroll
    for (int q = 1; q < 16; ++q) { p[PS * q] = cmul(x[brev(q, 4)], w); w = cmul(w, w1); }
  } else {
    c32 w = w1; x[0] = p[0];
#pragma unroll
    for (int q = 1; q < 16; ++q) { x[q] = cmul(p[PS * q], w); w = cmul(w, w1); }
    dft_pow2<16, true>(x);
#pragma unroll
    for (int m = 0; m < 16; ++m) p[PS * m] = x[brev(m, 4)];
  }
}
template <int MODE> __device__ __forceinline__ void mid32(c32* buf, h2* Hs, int j) {
  c32* p = buf + 33 * j; c32 x[32];
#pragma unroll
  for (int m = 0; m < 32; ++m) x[m] = p[m];
  dft_pow2<32, false>(x);
  if (MODE == 0) {
#pragma unroll
    for (int q = 0; q < 32; ++q) { const c32 v = x[brev(q, 5)]; Hs[q * 256 + j] = (h2){(_Float16)v.x, (_Float16)v.y}; }
  } else {
#pragma unroll
    for (int pp = 0; pp < 32; ++pp) { const h2 hv = Hs[brev(pp, 5) * 256 + j]; x[pp] = cmul(x[pp], (c32){(float)hv.x, (float)hv.y}); }
    idft_dit<32>(x);
#pragma unroll
    for (int m = 0; m < 32; ++m) p[m] = x[m];
  }
}
__device__ __forceinline__ void fwd2(c32* buf, int tid) {
  __syncthreads(); pass16<512, false>(buf, tid, (float)tid * (1.0f / 8192.0f));
  __syncthreads(); pass16<32, false>(buf, (tid >> 5) * 512 + (tid & 31), (float)(tid & 31) * (1.0f / 512.0f));
  __syncthreads();
}
__device__ __forceinline__ void conv(c32* buf, h2* Hs, int tid) {
  fwd2(buf, tid);
  if (tid < 256) mid32<1>(buf, Hs, tid);
  __syncthreads(); pass16<32, true>(buf, (tid >> 5) * 512 + (tid & 31), (float)(tid & 31) * (1.0f / 512.0f));
  __syncthreads(); pass16<512, true>(buf, tid, (float)tid * (1.0f / 8192.0f));
  __syncthreads();
}
__device__ __forceinline__ void item(int c, const bf16_t* HYT, const float* HK, const float* hy_bias, bf16_t* HYO, char* lds) {
  c32* buf = (c32*)lds; h2* H0 = (h2*)(lds + 67584); h2* H1 = H0 + 8192;
  const int tid = TIDX;
#pragma unroll 1
  for (int o = 0; o < 2; ++o) {
    const float* kp = HK + ((size_t)o * 256 + c) * 8192;
#pragma unroll
    for (int i = 0; i < 16; ++i) { const int n = tid + 512 * i; buf[phys(n)] = (c32){kp[n], 0.f}; }
    fwd2(buf, tid);
    if (tid < 256) mid32<0>(buf, o ? H1 : H0, tid);
    __syncthreads();
  }
  const float bias0 = hy_bias[c], bias1 = hy_bias[256 + c];
#pragma unroll 1
  for (int pr = 0; pr < 2; ++pr) {
    const bf16_t* v0 = HYT + ((size_t)(2 * pr) * 768 + c) * SEQ; const bf16_t* v1 = v0 + (size_t)768 * SEQ;
    c32 vv[8];
#pragma unroll
    for (int i = 0; i < 8; ++i) { const int t = tid + 512 * i; vv[i] = (c32){bf2f(v0[t]), bf2f(v1[t])}; buf[phys(t)] = vv[i]; buf[phys(t + 4096)] = (c32){0.f, 0.f}; }
    conv(buf, H0, tid);
#pragma unroll
    for (int i = 0; i < 8; ++i) { const int t = tid + 512 * i; const c32 y = buf[phys(t)];
      vv[i] = (c32){bf2f(v0[(size_t)256 * SEQ + t]) * (y.x * (1.0f / 8192.0f) + bias0 * vv[i].x), bf2f(v1[(size_t)256 * SEQ + t]) * (y.y * (1.0f / 8192.0f) + bias0 * vv[i].y)};
      buf[phys(t)] = vv[i]; buf[phys(t + 4096)] = (c32){0.f, 0.f}; }
    conv(buf, H1, tid);
#pragma unroll
    for (int i = 0; i < 8; ++i) { const int t = tid + 512 * i; const c32 y = buf[phys(t)];
      HYO[((size_t)(2 * pr) * 256 + c) * SEQ + t] = (bf16_t)f2bf(bf2f(v0[(size_t)512 * SEQ + t]) * (y.x * (1.0f / 8192.0f) + bias1 * vv[i].x));
      HYO[((size_t)(2 * pr + 1) * 256 + c) * SEQ + t] = (bf16_t)f2bf(bf2f(v1[(size_t)512 * SEQ + t]) * (y.y * (1.0f / 8192.0f) + bias1 * vv[i].y)); }
    __syncthreads();
  }
}
__device__ __forceinline__ void out_item(int it, const bf16_t* HYO, bf16_t* MIX, char* lds) {
  bf16_t (*T)[72] = (bf16_t (*)[72])lds;
  const int tid = TIDX, b = it >> 8, t0 = ((it >> 2) & 63) * 64, c0 = (it & 3) * 64;
  { const int cc = tid >> 3, t8 = (tid & 7) * 8; *(u32x4*)&T[cc][t8] = *(const u32x4*)(HYO + ((size_t)b * 256 + c0 + cc) * SEQ + t0 + t8); }
  __syncthreads();
  { const int tl = tid >> 3, c8 = (tid & 7) * 8; u32x4 o;
    o.x = (unsigned)T[c8][tl] | ((unsigned)T[c8 + 1][tl] << 16); o.y = (unsigned)T[c8 + 2][tl] | ((unsigned)T[c8 + 3][tl] << 16);
    o.z = (unsigned)T[c8 + 4][tl] | ((unsigned)T[c8 + 5][tl] << 16); o.w = (unsigned)T[c8 + 6][tl] | ((unsigned)T[c8 + 7][tl] << 16);
    *(u32x4*)(MIX + ((size_t)b * TPB + CTXL + t0 + tl) * DM + 768 + c0 + c8) = o; }
  __syncthreads();
}
}

#define LAS __attribute__((address_space(3)))
#define XB_TMO      128
#define XB_XCNT(j)  (256  + 64 * (j))
#define XB_XSUB(j)  (1280 + 64 * (j))
#define XB_XGEN(j)  (2304 + 64 * (j))
#define XB_TOP      3328
#define XB_TOPGEN   3392
#define XCD_BAR_WORDS 3456
#define XB_SPIN_CAP (1u << 18)

__device__ __forceinline__ unsigned xb_ld(unsigned* p)              { return __hip_atomic_load(p, __ATOMIC_RELAXED, __HIP_MEMORY_SCOPE_AGENT); }
__device__ __forceinline__ unsigned xb_add(unsigned* p, unsigned v) { return __hip_atomic_fetch_add(p, v, __ATOMIC_RELAXED, __HIP_MEMORY_SCOPE_AGENT); }
__device__ __forceinline__ unsigned xb_xcc_id() { return (unsigned)__builtin_amdgcn_s_getreg((3 << 11) | 20) & 0xFu; }
#define XB_SPIN(cond, bar) do { unsigned _sp = 0; while (cond) { __builtin_amdgcn_s_sleep(1); \
    if ((++_sp & 255u) == 0u) { if (xb_ld(&(bar)[XB_TMO])) break; if (_sp > XB_SPIN_CAP) { atomicAdd(&(bar)[XB_TMO], 1u); break; } } } } while (0)

struct XcdBarrier {
    unsigned* bar; unsigned x;
    volatile LAS unsigned* st;
};

__device__ __forceinline__ XcdBarrier xcd_barrier_post(unsigned* bar, volatile LAS unsigned* st) {
    XcdBarrier b; b.bar = bar; b.x = xb_xcc_id(); b.st = st;
    if (threadIdx.x == 0) (void)xb_add(&bar[XB_XCNT(b.x)], 1u);
    return b;
}
__device__ __forceinline__ void xcd_barrier_complete(unsigned* bar, unsigned x, unsigned& nloc, unsigned& nx) {
    const unsigned G = gridDim.x * gridDim.y * gridDim.z;
    unsigned sum, cnt, mine, sp = 0u;
    for (;;) {
        sum = 0u; cnt = 0u; mine = 0u;
#pragma unroll
        for (unsigned j = 0; j < 16; ++j) { const unsigned c = xb_ld(&bar[XB_XCNT(j)]); sum += c; cnt += (c > 0u) ? 1u : 0u; mine = (j == x) ? c : mine; }
        if (sum == G) break;
        __builtin_amdgcn_s_sleep(1);
        if ((++sp & 255u) == 0u) { if (xb_ld(&bar[XB_TMO])) break; if (sp > XB_SPIN_CAP) { atomicAdd(&bar[XB_TMO], 1u); break; } }
    }
    nloc = mine > 0u ? mine : 1u; nx = cnt > 0u ? cnt : 1u;
}

__device__ __forceinline__ void xcd_barrier(const XcdBarrier& b) {
    asm volatile("s_waitcnt vmcnt(0)" ::: "memory");
    __syncthreads();
    if (threadIdx.x == 0) {
        unsigned* bar = b.bar;
        __builtin_amdgcn_s_waitcnt(0);
        unsigned nloc = b.st[0], nx = b.st[1];
        if (nloc == 0u) { xcd_barrier_complete(bar, b.x, nloc, nx); b.st[0] = nloc; b.st[1] = nx; }
        const unsigned old = xb_add(&bar[XB_XSUB(b.x)], 1u);
        const unsigned gen = old / nloc;
        if (old + 1u == (gen + 1u) * nloc) {
            __builtin_amdgcn_fence(__ATOMIC_RELEASE, "agent");
            asm volatile("s_waitcnt vmcnt(0)" ::: "memory");
            const unsigned og = xb_add(&bar[XB_TOP], 1u);
            const unsigned tg = og / nx;
            if (og + 1u == (tg + 1u) * nx) xb_add(&bar[XB_TOPGEN], 1u);
            else XB_SPIN(xb_ld(&bar[XB_TOPGEN]) == tg, bar);
            __builtin_amdgcn_fence(__ATOMIC_ACQUIRE, "agent");
            xb_add(&bar[XB_XGEN(b.x)], 1u);
            asm volatile("s_waitcnt vmcnt(0)" ::: "memory");
        } else {
            XB_SPIN(xb_ld(&bar[XB_XGEN(b.x)]) == gen, bar);
            __builtin_amdgcn_fence(__ATOMIC_ACQUIRE, "agent");
            asm volatile("s_waitcnt vmcnt(0)" ::: "memory");
        }
    }
    __syncthreads();
}


struct MP { const float* in[33]; float* out; unsigned char* ws; };
typedef const float* const __attribute__((address_space(4))) * kargs_t;
#define KARGS() ({ kargs_t k_ = (kargs_t)__builtin_amdgcn_kernarg_segment_ptr(); asm volatile("" : "+s"(k_)); k_; })
#define WSP(K, off) ((unsigned char*)(K)[34] + (off))

__global__ void __launch_bounds__(NT, 2) mega(MP P) {
  cg::grid_group grid = cg::this_grid();
  extern __shared__ __attribute__((aligned(16))) char lds[];
  volatile LAS unsigned* xst = (volatile LAS unsigned*)(lds + LDS_BYTES - 16);
  if (threadIdx.x < 2) xst[threadIdx.x] = 0u;
  __syncthreads();
  { kargs_t K = KARGS(); (void)xcd_barrier_post((unsigned*)WSP(K, WS_CTL) + CT_BAR, xst); }
constexpr int CUT = 0;
#define XBAR_HERE() do { kargs_t Kb_ = KARGS(); XcdBarrier xb_; xb_.bar = (unsigned*)WSP(Kb_, WS_CTL) + CT_BAR; xb_.x = xb_xcc_id(); xb_.st = (volatile LAS unsigned*)(lds + LDS_BYTES - 16); xcd_barrier(xb_); } while (0)
#define SEAM() do { XBAR_HERE(); if (CUT > 0 && pass_ == 0 && ++nph_ == CUT) { pass_ = 1; goto again_; } } while (0)
  {
    kargs_t K = KARGS();
    st_adaln(K[1], K[3], K[4], K[5], (float*)WSP(K, WS_MODV), lds);
    st_rope((float*)WSP(K, WS_ROPE));
  }
  {
      kargs_t K = KARGS();
      st_weights(K[8], K[26], K[29], K[30], K[31], 0, (bf16_t*)WSP(K, WS_WIN), (bf16_t*)WSP(K, WS_WOUT), (bf16_t*)WSP(K, WS_WGU), (bf16_t*)WSP(K, WS_WD), lds);
    }
    { kargs_t K = KARGS(); const int bid = BIDX, G = GDIM;
      for (int it = bid; it < SEQ / 16; it += G) hyfilt_item<SEQ>(it, K[19] + 0 * 33 * 64, K[20] + 0 * 64, K[21] + 0 * 64, K[22] + 0 * 4096, K[23] + 0 * 64, K[24] + (size_t)0 * 65536, (float*)WSP(K, WS_HK), lds);
      if (true) for (int it = bid; it < CTXL / 16; it += G) hyfilt_item<CTXL>(it, K[19] + 0 * 33 * 64, K[20] + 0 * 64, K[21] + 0 * 64, K[22] + 0 * 4096, K[23] + 0 * 64, K[24] + (size_t)0 * 65536, (float*)WSP(K, WS_HKC), lds);
    }
  if (gridDim.x == 0x7fffffffu) grid.sync();
  XBAR_HERE();
  int pass_ = 0, nph_ = 0;
again_:
#pragma nounroll
  for (int layer = 0; layer < 2; ++layer) {
    const bool last = layer == 1;
    if (layer == 1) {
    {
      kargs_t K = KARGS();
      st_weights(K[8], K[26], K[29], K[30], K[31], layer, (bf16_t*)WSP(K, WS_WIN), (bf16_t*)WSP(K, WS_WOUT), (bf16_t*)WSP(K, WS_WGU), (bf16_t*)WSP(K, WS_WD), lds);
    }
    { kargs_t K = KARGS(); const int bid = BIDX, G = GDIM;
      for (int it = bid; it < SEQ / 16; it += G) hyfilt_item<SEQ>(it, K[19] + layer * 33 * 64, K[20] + layer * 64, K[21] + layer * 64, K[22] + layer * 4096, K[23] + layer * 64, K[24] + (size_t)layer * 65536, (float*)WSP(K, WS_HK), lds);
      if (!last) for (int it = bid; it < CTXL / 16; it += G) hyfilt_item<CTXL>(it, K[19] + layer * 33 * 64, K[20] + layer * 64, K[21] + layer * 64, K[22] + layer * 4096, K[23] + layer * 64, K[24] + (size_t)layer * 65536, (float*)WSP(K, WS_HKC), lds);
    }
    }
    { kargs_t K = KARGS();
      const float* xl_src = layer == 0 ? K[0] : K[33]; const float* xc_src = layer == 0 ? K[2] : (const float*)WSP(K, WS_XC);
      st_normmod(xl_src, xc_src, K[6] + layer * 1024, (const float*)WSP(K, WS_MODV) + (size_t)layer * 5 * 6144, 0, 1024, (bf16_t*)WSP(K, WS_H), lds);
    }
    SEAM();
    {
      kargs_t K = KARGS();
      pg8::Gemm g{1024, 1024, 1024}; SchedDense S{MTOK / 256, NPAD / 256, (int)GDIM, BIDX, 0, (const char*)WSP(K, WS_H), (const char*)WSP(K, WS_WIN), (size_t)256 * 1024 * 2, (size_t)256 * 1024 * 2};
      EpiInProj E{(bf16_t*)WSP(K, WS_QK), (bf16_t*)WSP(K, WS_VZ), (bf16_t*)WSP(K, WS_XBC), (bf16_t*)WSP(K, WS_HY), (float*)WSP(K, WS_DT)};
      pg8::gemm_phase<EpiInProj, SchedDense, true, true>((PG8_LAS unsigned char*)lds, g, S, E);
    }
    SEAM();
    {
      kargs_t K = KARGS();
      st_prep_qk((bf16_t*)WSP(K, WS_QK), K[9] + layer * 64, K[10] + layer * 64, (const float*)WSP(K, WS_ROPE));
    }
    { kargs_t K = KARGS();
      st_prep_hy((const bf16_t*)WSP(K, WS_HY), K[17] + layer * 3 * 768, K[18] + layer * 768, (bf16_t*)WSP(K, WS_HYT), last ? 0 : 1, lds);
    }
    { kargs_t K = KARGS();
      st_ssd1(BIDX, GDIM, 4 * 34 * 6, (const bf16_t*)WSP(K, WS_XBC), (const float*)WSP(K, WS_DT), K[11] + layer * 3 * 640, K[12] + layer * 640, K[13] + layer * 12, K[14] + layer * 12,
              (float*)WSP(K, WS_Y), (float*)WSP(K, WS_ST), (float*)WSP(K, WS_DEC), lds);
    }
    SEAM();
    {
      { kargs_t K2 = KARGS(); st_ssd_scan2((float*)WSP(K2, WS_ST), (const float*)WSP(K2, WS_DEC)); }
      const int bid = BIDX, G = GDIM;
#define P4_ATT(bb, hq, qrow_, nt_) do { kargs_t K = KARGS(); const int kvh_ = (hq) / 3; \
          const attn_body::bf16* QKp = (const attn_body::bf16*)WSP(K, WS_QK); const attn_body::bf16* VZp = (const attn_body::bf16*)WSP(K, WS_VZ); \
          attn_body::attn_unit<8>(QKp + (size_t)(qrow_) * 512 + (hq) * 64, QKp + (size_t)(bb) * TPB * 512 + 384 + kvh_ * 64, VZp + (size_t)(bb) * TPB * 512 + kvh_ * 64, \
                                  (attn_body::bf16*)WSP(K, WS_H) + (size_t)(qrow_) * 1024 + (hq) * 64, (nt_), lds); } while (0)
#define P4_FFT(cch) do { kargs_t K = KARGS(); hyf::item((cch), (const bf16_t*)WSP(K, WS_HYT), (const float*)WSP(K, WS_HK), K[25] + layer * 512, (bf16_t*)WSP(K, WS_HY), lds); } while (0)
#define P4_CHY(itm) do { kargs_t K = KARGS(); hyconv_ctx_item((itm), (const bf16_t*)WSP(K, WS_HYT) + (size_t)4 * 768 * SEQ, (const float*)WSP(K, WS_HKC), K[25] + layer * 512, (bf16_t*)WSP(K, WS_H), lds); } while (0)
      {
        const int x = bid & 7, y = bid >> 3, bb = x >> 1, kvh = x & 1;
        const int nun = y < 16 ? 2 : 1, natt = nun + ((!last && y < 3) ? 1 : 0);
#pragma unroll 1
        for (int k = 0; k < natt; ++k) { int hq, qrow, nt;
          if (k < nun) { const int v = y < 16 ? y + 16 * k : 16 + y; hq = 3 * kvh + (v >> 4); qrow = bb * TPB + CTXL + (v & 15) * 256; nt = TPB / 64; }
          else { hq = 3 * kvh + y; qrow = bb * TPB; nt = CTXL / 64; }
          P4_ATT(bb, hq, qrow, nt); }
        if (y >= 16) {
#pragma unroll 1
          for (int k = 0; k < 2; ++k) { const int cch = ((y - 16) * 8 + x) * 2 + k; P4_FFT(cch); } }
        if (!last && y >= 3 && y < 11) { P4_CHY((y - 3) * 8 + x); }
      }
      (void)G;
#undef P4_ATT
#undef P4_FFT
#undef P4_CHY
    }
    SEAM();
    {
      kargs_t K = KARGS();
      { const int bid = BIDX, G = GDIM, nit = last ? 4 * 32 * 2 : 4 * 34 * 2;
        for (int it = bid; it < nit; it += G) { const int g = it & 1, bc = it >> 1; const int b = last ? bc >> 5 : bc / 34, cidx = last ? 2 + (bc & 31) : bc % 34;
          ssd3_item(b, cidx, g, (const bf16_t*)WSP(K, WS_XBC), (const bf16_t*)WSP(K, WS_VZ), (const float*)WSP(K, WS_DT), K[11] + layer * 3 * 640, K[12] + layer * 640, K[13] + layer * 12, K[14] + layer * 12,
                    K[15] + layer * 6, K[16] + layer * 384, (const float*)WSP(K, WS_Y), (const float*)WSP(K, WS_ST), (bf16_t*)WSP(K, WS_H), lds); } }
      { const int bid = BIDX, G = GDIM; for (int it = bid; it < 1024; it += G) hyf::out_item(it, (const bf16_t*)WSP(K, WS_HY), (bf16_t*)WSP(K, WS_H), lds); }
      const int t = TIDX; if (BIDX == 0 && t < 256) ((int*)WSP(K, WS_CTL))[t] = 0;
      { int* stok = (int*)WSP(K, WS_MOEM + 384 * 1024); for (int i = BIDX * NT + t; i < MOE_ROWS; i += GDIM * NT) stok[i] = -1; }
    }
    SEAM();
    {
      kargs_t K = KARGS();
      const float* xl_src = layer == 0 ? K[0] : K[33]; const float* xc_src = layer == 0 ? K[2] : (const float*)WSP(K, WS_XC);
      pg8::Gemm g{1024, 1024, 1024}; SchedDense S{last ? 64 : 68, 4, (int)GDIM, BIDX, last ? 1 : 0, (const char*)WSP(K, WS_H), (const char*)WSP(K, WS_WOUT), (size_t)256 * 1024 * 2, (size_t)256 * 1024 * 2};
      EpiOutProj E{(bf16_t*)WSP(K, WS_QK)};
      pg8::gemm_phase<EpiOutProj, SchedDense, true, true>((PG8_LAS unsigned char*)lds, g, S, E);
    }
    SEAM();
    {
      kargs_t K = KARGS();
      st_router(layer == 0 ? K[0] : K[33], layer == 0 ? K[2] : (const float*)WSP(K, WS_XC), (float*)K[33], (float*)WSP(K, WS_XC), (const bf16_t*)WSP(K, WS_QK), K[7] + layer * 1024, (const float*)WSP(K, WS_MODV) + (size_t)layer * 5 * 6144, K[27], K[28], (bf16_t*)WSP(K, WS_H), (int*)WSP(K, WS_CTL),
                (int*)WSP(K, WS_MOEM), (float*)WSP(K, WS_MOEM + 128 * 1024), last ? 1 : 0, lds);
    }
    SEAM();
    { kargs_t K = KARGS();
      st_moe_gather((const bf16_t*)WSP(K, WS_H), (bf16_t*)WSP(K, WS_H2S), (int*)WSP(K, WS_CTL), (const int*)WSP(K, WS_MOEM), (const float*)WSP(K, WS_MOEM + 128 * 1024),
                    (int*)WSP(K, WS_MOEM + 384 * 1024), (float*)WSP(K, WS_MOEM + 512 * 1024), last ? 1 : 0, lds);
    }
    SEAM();
    { kargs_t K = KARGS();
      pg8::Gemm g{1024, 1024, 1024}; SchedMoe S{(int)GDIM, BIDX, 1, (const int*)WSP(K, WS_CTL), (const char*)WSP(K, WS_H2S), (size_t)256 * 1024 * 2, (const char*)WSP(K, WS_WGU)};
      EpiMoe1 E{(bf16_t*)WSP(K, WS_ACT), (const float*)WSP(K, WS_MOEM + 512 * 1024)};
      pg8::gemm_phase<EpiMoe1, SchedMoe, true, true>((PG8_LAS unsigned char*)lds, g, S, E);
    }
    SEAM();
    { kargs_t K = KARGS();
      pg8::Gemm g{256, 512, 256}; SchedMoe S{(int)GDIM, BIDX, 2, (const int*)WSP(K, WS_CTL), (const char*)WSP(K, WS_ACT), (size_t)256 * 512 * 2, (const char*)WSP(K, WS_WD)};
      EpiMoe2 E{(float*)K[33], (float*)WSP(K, WS_XC), (const float*)WSP(K, WS_MODV) + (size_t)layer * 5 * 6144 + 5120, (const int*)WSP(K, WS_MOEM + 384 * 1024)};
      pg8::gemm_phase<EpiMoe2, SchedMoe, true, true>((PG8_LAS unsigned char*)lds, g, S, E);
    }
    SEAM();
  }
  { kargs_t K = KARGS(); st_final((float*)K[33], K[32]); }
}

extern "C" void kernel_launch(void* const* d_in, const int* in_sizes, int n_in, void* d_out, int out_size, void* d_ws, size_t ws_size, hipStream_t stream) {
  if (n_in != 33 || ws_size < WS_END) { fprintf(stderr, "kernel_launch: unexpected n_in %d / ws %zu\n", n_in, ws_size); return; }
  static int grid_blocks = 0;
  if (!grid_blocks) {
    int dev = 0, cus = 0, per_cu = 0;
    (void)hipGetDevice(&dev);
    (void)hipDeviceGetAttribute(&cus, hipDeviceAttributeMultiprocessorCount, dev);
    (void)hipFuncSetAttribute((const void*)mega, hipFuncAttributeMaxDynamicSharedMemorySize, LDS_BYTES);
    (void)hipOccupancyMaxActiveBlocksPerMultiprocessor(&per_cu, mega, NT, LDS_BYTES);
    if (per_cu < 1) per_cu = 1;
    if (per_cu > 2) per_cu = 2;
    grid_blocks = 256;
    if (cus != 256 || per_cu < 1) fprintf(stderr, "kernel_launch: expected 256 CUs with >= 1 workgroup each (got %d CUs, %d per CU)\n", cus, per_cu);
  }
  (void)hipMemsetAsync((char*)d_ws + WS_CTL + (size_t)CT_BAR * 4, 0, (size_t)XCD_BAR_WORDS * 4, stream);
  MP p{};
  for (int i = 0; i < 33; ++i) p.in[i] = (const float*)d_in[i];
  p.out = (float*)d_out; p.ws = (unsigned char*)d_ws;
  void* args[] = {&p};
  hipError_t e = hipLaunchCooperativeKernel((const void*)mega, dim3(grid_blocks), dim3(NT), args, LDS_BYTES, stream);
  if (e != hipSuccess) fprintf(stderr, "cooperative launch failed: %s (grid %d)\n", hipGetErrorString(e), grid_blocks);
}
```

```cpp
#include <hip/hip_runtime.h>
#include <hip/hip_cooperative_groups.h>
#include <cstdio>
#include <cstdint>
namespace cg = cooperative_groups;

typedef unsigned short bf16_t;
typedef short bf16x8 __attribute__((ext_vector_type(8)));
typedef float f32x4 __attribute__((ext_vector_type(4)));
typedef unsigned u32x4 __attribute__((ext_vector_type(4)));
typedef unsigned u32x2 __attribute__((ext_vector_type(2)));

constexpr int NB = 4, SEQ = 4096, CTXL = 256, DM = 1024, TPB = 4352, MTOK = NB * TPB;
constexpr int DIN = 2444, NPAD = 2560;
constexpr float EPS = 1e-6f;
constexpr float C2 = 0.125f * 1.4426950408889634f;
constexpr int MOE_ROWS = 23552;
constexpr int NT = 512;
constexpr int LDS_BYTES = 147456;

constexpr size_t MiB = 1u << 20;
constexpr size_t WS_CTL = 0;
constexpr size_t WS_MODV = 1 * MiB;
constexpr size_t WS_ROPE = 2 * MiB;
constexpr size_t WS_MOEM = 3 * MiB;
constexpr size_t WS_DT = 4 * MiB;
constexpr size_t WS_HKC = 5 * MiB;
constexpr size_t WS_XC = 6 * MiB;
constexpr size_t WS_WIN = 10 * MiB;
constexpr size_t WS_WOUT = 15 * MiB;
constexpr size_t WS_WGU = 17 * MiB;
constexpr size_t WS_WD = 33 * MiB;
constexpr size_t WS_HK = 41 * MiB;
constexpr size_t WS_H = 57 * MiB;
constexpr size_t WS_QK = 91 * MiB;
constexpr size_t WS_VZ = 108 * MiB;
constexpr size_t WS_XBC = 125 * MiB;
constexpr size_t WS_HY = WS_XBC + (size_t)MTOK * 768 * 2;
constexpr size_t WS_HYT = WS_HY + (size_t)MTOK * 768 * 2;
constexpr size_t WS_ST = WS_HYT + (size_t)MTOK * 768 * 2;
constexpr size_t WS_Y = WS_ST + (size_t)4 * 34 * 2 * 6 * 4096 * 4;
constexpr size_t WS_END = WS_Y + (size_t)MTOK * 384 * 4;
constexpr size_t WS_DEC = WS_DT + 900 * 1024;
constexpr size_t WS_H2S = WS_QK;
constexpr size_t WS_ACT = WS_H2S + (size_t)MOE_ROWS * 1024 * 2;
static_assert(WS_END <= 256 * MiB, "ws");
static_assert(WS_ACT + (size_t)MOE_ROWS * 512 * 2 <= WS_HYT, "moe alias");

constexpr int CT_CNT = 0, CT_FILL = 32, CT_BASE = 64, CT_NT = 96, CT_TP = 128;
constexpr int CT_BAR = 4096;
constexpr int CT_CNTB = 8192;

__device__ __forceinline__ int opq_v(int v) { asm volatile("" : "+v"(v)); return v; }
__device__ __forceinline__ int opq_s(int v) { asm volatile("" : "+s"(v)); return v; }
#define TIDX opq_v((int)threadIdx.x)
#define BIDX opq_s((int)blockIdx.x)
#define GDIM opq_s((int)gridDim.x)
__device__ __forceinline__ unsigned f2bf(float f) { unsigned u = __float_as_uint(f); return (u + 0x7fffu + ((u >> 16) & 1u)) >> 16; }
__device__ __forceinline__ unsigned pk2bf(float lo, float hi) { return f2bf(lo) | (f2bf(hi) << 16); }
__device__ __forceinline__ float bf2f(bf16_t h) { return __uint_as_float(((unsigned)h) << 16); }
__device__ __forceinline__ float wave_sum(float v) {
#pragma unroll
  for (int o = 1; o < 64; o <<= 1) v += __shfl_xor(v, o);
  return v;
}
__device__ __forceinline__ float siluf(float v) { return v / (1.0f + __expf(-v)); }
__device__ __forceinline__ float* xrow(const float* xl, const float* xc, int r) {
  const int b = r / TPB, j = r - b * TPB;
  return (float*)(j < CTXL ? xc + ((size_t)b * CTXL + j) * DM : xl + ((size_t)b * SEQ + (j - CTXL)) * DM);
}
__device__ __forceinline__ int mrow_of(int r) { const int b = r / TPB, j = r - b * TPB; return j < CTXL ? 4 : b; }

__device__ __forceinline__ void st_adaln(const float* c, const float* c_ctx, const float* w_mod, const float* b_mod, float* modv, char* lds) {
  float (*sc)[1024] = (float (*)[1024])lds;
  float (*red)[5][64] = (float (*)[5][64])(lds + 5 * 1024 * 4);
  const int tid = TIDX;
  for (int it = BIDX; it < 192; it += GDIM) {
    const int layer = it / 96, n0 = (it % 96) * 64;
    for (int i = tid; i < 5 * 1024; i += NT) { const int r = i >> 10, k = i & 1023; const float v = r < 4 ? c[r * 1024 + k] : c_ctx[k]; sc[r][k] = v / (1.0f + expf(-v)); }
    __syncthreads();
    const int kg = tid >> 6, n = tid & 63;
    float acc[5] = {0.f, 0.f, 0.f, 0.f, 0.f};
#pragma unroll 16
    for (int k = kg; k < 1024; k += 8) { const float w = w_mod[((size_t)layer * 1024 + k) * 6144 + n0 + n];
#pragma unroll
      for (int r = 0; r < 5; ++r) acc[r] += sc[r][k] * w; }
#pragma unroll
    for (int r = 0; r < 5; ++r) red[kg][r][n] = acc[r];
    __syncthreads();
    if (tid < 320) { const int r = tid >> 6, nn = tid & 63; float s = 0.f;
#pragma unroll
      for (int g = 0; g < 8; ++g) s += red[g][r][nn];
      modv[((size_t)layer * 5 + r) * 6144 + n0 + nn] = s + b_mod[layer * 6144 + n0 + nn]; }
    __syncthreads();
  }
}
__device__ __forceinline__ void st_rope(float* rope) {
  for (int i = BIDX * NT + TIDX; i < 4096 * 32; i += GDIM * NT) {
    const int t = i >> 5, d = i & 31, m = d & 15;
    const float inv = exp2f(-(float)(2 * m) * (13.287712379549449f / 32.0f));
    const float pos = (float)(d < 16 ? (t >> 6) : (t & 63));
    float rev = pos * inv * 0.15915494309189535f; rev -= floorf(rev);
    rope[2 * i] = __builtin_amdgcn_cosf(rev); rope[2 * i + 1] = __builtin_amdgcn_sinf(rev);
  }
}

__device__ __forceinline__ void st_normmod(const float* xl, const float* xc, const float* g, const float* modv_layer, int off_sh, int off_sc, bf16_t* H, char* lds) {
  float* mA = (float*)lds; float* mB = mA + 5 * 1024;
  const int tid = TIDX, lane = tid & 63, gw = BIDX * 8 + (tid >> 6), ngw = GDIM * 8;
  for (int idx = tid; idx < 5 * 1024; idx += NT) { const int m = idx >> 10, k = idx & 1023; mA[idx] = g[k] * (1.f + modv_layer[(size_t)m * 6144 + off_sc + k]); mB[idx] = modv_layer[(size_t)m * 6144 + off_sh + k]; }
  __syncthreads();
  for (int rb = gw; rb < MTOK; rb += 3 * ngw) {
    f32x4 v[3][4]; float rstd[3];
#pragma unroll
    for (int u = 0; u < 3; ++u) { const int r = rb + u * ngw; const float* xr = xrow(xl, xc, r < MTOK ? r : MTOK - 1);
#pragma unroll
      for (int j = 0; j < 4; ++j) v[u][j] = *(const f32x4*)(xr + 4 * lane + 256 * j); }
#pragma unroll
    for (int u = 0; u < 3; ++u) { float ss = 0.f;
#pragma unroll
      for (int j = 0; j < 4; ++j) ss += v[u][j].x * v[u][j].x + v[u][j].y * v[u][j].y + v[u][j].z * v[u][j].z + v[u][j].w * v[u][j].w;
      rstd[u] = rsqrtf(wave_sum(ss) * (1.0f / DM) + EPS); }
#pragma unroll
    for (int u = 0; u < 3; ++u) { const int r = rb + u * ngw;
      if (r < MTOK) { const int mo = mrow_of(r) * 1024;
#pragma unroll
        for (int j = 0; j < 4; ++j) { const int k = 4 * lane + 256 * j;
          const f32x4 a4 = *(const f32x4*)(mA + mo + k), b4 = *(const f32x4*)(mB + mo + k); const f32x4 o = v[u][j] * rstd[u] * a4 + b4;
          u32x2 w; w.x = pk2bf(o.x, o.y); w.y = pk2bf(o.z, o.w);
          *(u32x2*)(H + (size_t)r * DM + k) = w; } } }
  }
  __syncthreads();
}

template <int MODE> __device__ __forceinline__ void tr_wave_item(const float* src, const float* src2, int ldsrc, int K, bf16_t* out, int n0, int k0, float* scr, int lane) {
  const int nn = lane & 31, n = n0 + nn;
#pragma unroll 8
  for (int i = 0; i < 32; ++i) { const int kk = 2 * i + (lane >> 5); float v = 0.f;
    if (MODE == 0) { const int col = n < 1676 ? n : (n < 1792 ? -1 : n - 116); if (col >= 0) v = src[(size_t)(k0 + kk) * ldsrc + col]; }
    else if (MODE == 1) v = src[(size_t)(k0 + kk) * ldsrc + n];
    else v = (n & 1) ? src2[(size_t)(k0 + kk) * ldsrc + (n >> 1)] : src[(size_t)(k0 + kk) * ldsrc + (n >> 1)];
    scr[kk * 33 + nn] = v; }
  asm volatile("s_waitcnt lgkmcnt(0)" ::: "memory");
  const int c = lane & 7;
#pragma unroll
  for (int j = 0; j < 4; ++j) { const int nr = (lane >> 3) + 8 * j; const float* sp = scr + (8 * c) * 33 + nr;
    u32x4 o; o.x = f2bf(sp[0]) | (f2bf(sp[33]) << 16); o.y = f2bf(sp[66]) | (f2bf(sp[99]) << 16); o.z = f2bf(sp[132]) | (f2bf(sp[165]) << 16); o.w = f2bf(sp[198]) | (f2bf(sp[231]) << 16);
    *(u32x4*)(out + (size_t)(n0 + nr) * K + k0 + 8 * c) = o; }
  asm volatile("s_waitcnt lgkmcnt(0)" ::: "memory");
}
__device__ __forceinline__ void st_weights(const float* w_in, const float* w_out, const float* w_gate, const float* w_up, const float* w_down, int layer,
                                           bf16_t* WIN, bf16_t* WOUT, bf16_t* WGU, bf16_t* WD, char* lds) {
  const int tid = TIDX, lane = tid & 63, w = tid >> 6; float* scr = (float*)lds + w * (64 * 33);
  for (int it = BIDX * 8 + w; it < 7936; it += GDIM * 8) {
    if (it < 1280) tr_wave_item<0>(w_in + (size_t)layer * 1024 * DIN, nullptr, DIN, 1024, WIN, (it % 80) * 32, (it / 80) * 64, scr, lane);
    else if (it < 1792) { const int i2 = it - 1280; tr_wave_item<1>(w_out + (size_t)layer * 1024 * 1024, nullptr, 1024, 1024, WOUT, (i2 & 31) * 32, (i2 >> 5) * 64, scr, lane); }
    else if (it < 5888) { const int i2 = it - 1792, e = i2 >> 8, t = i2 & 255;
      tr_wave_item<2>(w_gate + ((size_t)layer * 16 + e) * 1024 * 256, w_up + ((size_t)layer * 16 + e) * 1024 * 256, 256, 1024, WGU + (size_t)e * 512 * 1024, (t & 15) * 32, (t >> 4) * 64, scr, lane); }
    else { const int i2 = it - 5888, e = i2 >> 7, t = i2 & 127;
      tr_wave_item<1>(w_down + ((size_t)layer * 16 + e) * 256 * 1024, nullptr, 1024, 256, WD + (size_t)e * 1024 * 256, (t & 31) * 32, (t >> 5) * 64, scr, lane); }
  }
  __syncthreads();
}

__device__ __forceinline__ void pair_experts(int pidx, int& eA, int& eB) {
  const int g = pidx / 6, t = pidx - 6 * g; const int i = t < 3 ? 0 : (t < 5 ? 1 : 2); const int j = t < 3 ? t + 1 : (t < 5 ? t - 1 : 3);
  eA = 4 * g + i; eB = 4 * g + j;
}
__device__ __forceinline__ void st_prep_qk(bf16_t* QK, const float* qn, const float* kn, const float* rope) {
  const int lane = TIDX & 63, gw = BIDX * 8 + (TIDX >> 6), ngw = GDIM * 8, hh = lane >> 3, sub = lane & 7;
  float gn[8];
#pragma unroll
  for (int e = 0; e < 8; ++e) gn[e] = ((hh < 6 ? qn : kn) + sub * 8)[e] * (hh < 6 ? C2 : 1.0f);
  for (int rb = gw; rb < MTOK; rb += 3 * ngw) {
    bf16x8 raw[3]; f32x4 rp4[3][4];
#pragma unroll
    for (int u = 0; u < 3; ++u) { const int r = rb + u * ngw < MTOK ? rb + u * ngw : MTOK - 1; const int j = r % TPB, t = j >= CTXL ? j - CTXL : 0;
      raw[u] = *(const bf16x8*)(QK + (size_t)r * 512 + hh * 64 + sub * 8);
      const float* rp = rope + ((size_t)t * 32 + (sub & 3) * 8) * 2;
#pragma unroll
      for (int q = 0; q < 4; ++q) rp4[u][q] = *(const f32x4*)(rp + 4 * q); }
#pragma unroll
    for (int u = 0; u < 3; ++u) { const int r = rb + u * ngw; const int j = (r < MTOK ? r : MTOK - 1) % TPB;
      float v[8]; float ss = 0.f;
#pragma unroll
      for (int e = 0; e < 8; ++e) { v[e] = bf2f((bf16_t)raw[u][e]); ss += v[e] * v[e]; }
      ss += __shfl_xor(ss, 1); ss += __shfl_xor(ss, 2); ss += __shfl_xor(ss, 4);
      const float rstd = rsqrtf(ss * (1.0f / 64.0f) + EPS);
#pragma unroll
      for (int e = 0; e < 8; ++e) v[e] = v[e] * rstd * gn[e];
      if (j >= CTXL) {
#pragma unroll
        for (int e = 0; e < 8; ++e) { const float other = __shfl_xor(v[e], 4); const float cs = rp4[u][e >> 1][(e & 1) * 2], sn = rp4[u][e >> 1][(e & 1) * 2 + 1]; v[e] = sub < 4 ? v[e] * cs - other * sn : v[e] * cs + other * sn; } }
      if (r < MTOK) *(u32x4*)(QK + (size_t)r * 512 + hh * 64 + sub * 8) = (u32x4){pk2bf(v[0], v[1]), pk2bf(v[2], v[3]), pk2bf(v[4], v[5]), pk2bf(v[6], v[7])}; }
  }
}

__device__ __forceinline__ void st_prep_hy(const bf16_t* HY, const float* cw, const float* cb, bf16_t* HYT, int do_ctx, char* lds) {
  const int tid = TIDX, lane = tid & 63, w = tid >> 6; float* tile = (float*)lds + w * (66 * 33);
  const int nlat = 4 * 64 * 24, nitem = nlat + (do_ctx ? 4 * 4 * 24 : 0), step = GDIM * 8;
  bf16x8 raw[5];
#define PHY_DECODE(it) int b, tt, ct, L, joff; bf16_t* outb; \
    if ((it) < nlat) { b = (it) / 1536; tt = ((it) % 1536) / 24; ct = (it) % 24; L = SEQ; joff = CTXL; outb = HYT + (size_t)b * 768 * SEQ; } \
    else { const int i2 = (it) - nlat; b = i2 / 96; tt = (i2 % 96) / 24; ct = i2 % 24; L = CTXL; joff = 0; outb = HYT + (size_t)4 * 768 * SEQ + (size_t)b * 768 * CTXL; } \
    const int t0 = tt * 64, c0 = ct * 32; (void)outb;
#define PHY_LOADS(it) do { PHY_DECODE(it) _Pragma("unroll") for (int i = 0; i < 5; ++i) { const int rr = (lane >> 2) + 16 * i, c8 = (lane & 3) * 8; int t = t0 - 1 + rr; const bool ok = rr < 66 && t >= 0 && t < L; t = ok ? t : t0; \
      const bf16x8 v = *(const bf16x8*)(HY + ((size_t)b * TPB + joff + t) * 768 + c0 + c8); raw[i] = ok ? v : (bf16x8){0, 0, 0, 0, 0, 0, 0, 0}; } } while (0)
  int it = BIDX * 8 + w;
  if (it < nitem) PHY_LOADS(it);
  for (; it < nitem; it += step) {
    PHY_DECODE(it)
#pragma unroll
    for (int i = 0; i < 5; ++i) { const int rr = (lane >> 2) + 16 * i, c8 = (lane & 3) * 8;
      if (rr < 66) {
#pragma unroll
        for (int e = 0; e < 8; ++e) tile[rr * 33 + c8 + e] = bf2f((bf16_t)raw[i][e]); } }
    asm volatile("s_waitcnt lgkmcnt(0)" ::: "memory");
    if (it + step < nitem) PHY_LOADS(it + step);
#pragma unroll 4
    for (int cc = 0; cc < 32; ++cc) { const int c = c0 + cc;
      const float v = cw[c] * tile[lane * 33 + cc] + cw[768 + c] * tile[(lane + 1) * 33 + cc] + cw[1536 + c] * tile[(lane + 2) * 33 + cc] + cb[c];
      outb[(size_t)c * L + t0 + lane] = (bf16_t)f2bf(v); }
    asm volatile("s_waitcnt lgkmcnt(0)" ::: "memory");
  }
#undef PHY_LOADS
#undef PHY_DECODE
  __syncthreads();
}

template <int L> __device__ __forceinline__ void hyfilt_item(int item, const float* w1, const float* b1, const float* fr, const float* w2, const float* b2, const float* w3, float* HK, char* lds) {
  float* S0 = (float*)lds; float* S1 = S0 + 64 * 64; float* S2 = S1 + 64 * 68;
  const int tid = TIDX, n0 = (item >> 2) * 64, cq = item & 3, lane = tid & 63, wv = tid >> 6;
  for (int e = tid; e < 64 * 33; e += NT) { const int pp = e / 33, f = e % 33; const int n = n0 + pp; float v;
    if (f == 0) v = (float)n / (float)(L - 1);
    else { const int m = (f - 1) & 15; const float band = 1e-4f + (float)m * ((15.0f - 1e-4f) / 15.0f); const float wpos = (6.283185307179586f / (float)L) * (float)n;
      v = f <= 16 ? cosf(wpos * band) : -sinf(wpos * band); }
    S0[pp * 33 + f] = v; }
  for (int e = tid; e < 33 * 64; e += NT) S1[e] = w1[e];
  __syncthreads();
  for (int e = tid; e < 64 * 64; e += NT) { const int pp = e >> 6, j = e & 63; float a = b1[j];
    for (int f = 0; f < 33; ++f) a += S0[pp * 33 + f] * S1[f * 64 + j];
    S2[pp * 64 + j] = sinf(fr[j] * a); }
  __syncthreads();
  for (int e = tid; e < 64 * 64; e += NT) S0[e] = w2[e];
  __syncthreads();
  for (int e = tid; e < 64 * 64; e += NT) { const int pp = e >> 6, j = e & 63; float a = b2[j];
    for (int f = 0; f < 64; ++f) a += S2[pp * 64 + f] * S0[f * 64 + j];
    S1[pp * 68 + j] = sinf(fr[j] * a); }
  __syncthreads();
  {
    const int l15 = lane & 15, l4 = lane >> 4, colb = cq * 256 + 32 * wv;
    f32x4 acc[4][2];
#pragma unroll
    for (int pt = 0; pt < 4; ++pt) { acc[pt][0] = (f32x4){0.f, 0.f, 0.f, 0.f}; acc[pt][1] = (f32x4){0.f, 0.f, 0.f, 0.f}; }
#pragma unroll 4
    for (int kk = 0; kk < 16; ++kk) { const int k = 4 * kk + l4;
      const float bv0 = w3[k * 1024 + colb + l15], bv1 = w3[k * 1024 + colb + 16 + l15];
#pragma unroll
      for (int pt = 0; pt < 4; ++pt) { const float av = S1[(pt * 16 + l15) * 68 + k];
        acc[pt][0] = __builtin_amdgcn_mfma_f32_16x16x4f32(av, bv0, acc[pt][0], 0, 0, 0);
        acc[pt][1] = __builtin_amdgcn_mfma_f32_16x16x4f32(av, bv1, acc[pt][1], 0, 0, 0); } }
#pragma unroll
    for (int ct = 0; ct < 2; ++ct) { const int col = colb + 16 * ct + l15, dir = col >> 9, order = (col >> 8) & 1, c = col & 255;
      const float delta = 3.0701134573253943f + (float)c * ((15.350567286626972f - 3.0701134573253943f) / 255.0f);
      float* dst = HK + ((size_t)order * 256 + c) * (2 * L);
#pragma unroll
      for (int pt = 0; pt < 4; ++pt) { const int nb = n0 + pt * 16 + 4 * l4; f32x4 o;
#pragma unroll
        for (int rg = 0; rg < 4; ++rg) o[rg] = acc[pt][ct][rg] * __expf(-((float)(nb + rg) / (float)(L - 1)) * delta);
        if (dir == 0) *(f32x4*)(dst + nb) = o;
        else {
#pragma unroll
          for (int rg = 0; rg < 4; ++rg) { const int n = nb + rg; if (n >= 1) dst[2 * L - n] = o[rg]; else dst[L] = 0.f; } } } }
  }
  __syncthreads();
}

__device__ __forceinline__ void hyconv_ctx_item(int item, const bf16_t* HYTC, const float* HKC, const float* hy_bias, bf16_t* MIX, char* lds) {
  constexpr int L = CTXL;
  const int tid = TIDX, b = item >> 4, cc = tid >> 5, c = (item & 15) * 16 + cc, sub = tid & 31, tb = 8 * sub;
  float* kern = (float*)lds + cc * (2 * L); float* z = (float*)lds + 16 * 2 * L + cc * L;
  const bf16_t* vp = HYTC + ((size_t)b * 768 + c) * L; const bf16_t* x1p = vp + (size_t)256 * L; const bf16_t* x2p = vp + (size_t)512 * L;
#pragma unroll 1
  for (int o = 0; o < 2; ++o) {
    if (o == 0) for (int t = sub; t < L; t += 32) z[t] = bf2f(vp[t]);
    const float* kp = HKC + ((size_t)o * 256 + c) * (2 * L);
    for (int t = sub; t < 2 * L; t += 32) kern[t] = kp[t];
    __syncthreads();
    float acc[8], W[16];
#pragma unroll
    for (int i = 0; i < 8; ++i) { acc[i] = 0.f; W[8 + i] = kern[(tb + i) & (2 * L - 1)]; }
    for (int s0 = 0; s0 < L; s0 += 8) {
      const int bb = (tb - s0 - 8) & (2 * L - 1);
#pragma unroll
      for (int i = 0; i < 8; ++i) W[i] = kern[bb + i];
      float zs[8];
#pragma unroll
      for (int j = 0; j < 8; ++j) zs[j] = z[s0 + j];
#pragma unroll
      for (int j = 0; j < 8; ++j)
#pragma unroll
        for (int i = 0; i < 8; ++i) acc[i] += W[8 + i - j] * zs[j];
#pragma unroll
      for (int i = 0; i < 8; ++i) W[8 + i] = W[i];
    }
    __syncthreads();
    const float bias = hy_bias[o * 256 + c];
#pragma unroll
    for (int i = 0; i < 8; ++i) { const int t = tb + i; const float zz = acc[i] + bias * z[t];
      if (o == 0) z[t] = bf2f(x1p[t]) * zz;
      else MIX[((size_t)b * TPB + t) * DM + 768 + c] = (bf16_t)f2bf(bf2f(x2p[t]) * zz); }
    __syncthreads();
  }
}

__device__ __forceinline__ void ssd_conv8(const bf16_t* XBC, size_t r, int c0, bool hasp, bool hasn, const float* cw, const float* cb, float (&o)[8]) {
  const bf16x8 cur = *(const bf16x8*)(XBC + r * 768 + c0);
  const bf16x8 prv = *(const bf16x8*)(XBC + (hasp ? r - 1 : r) * 768 + c0), nxt = *(const bf16x8*)(XBC + (hasn ? r + 1 : r) * 768 + c0);
  const float wp = hasp ? 1.f : 0.f, wn = hasn ? 1.f : 0.f;
#pragma unroll
  for (int e = 0; e < 8; ++e) { const float v = wp * cw[c0 + e] * bf2f((bf16_t)prv[e]) + cw[640 + c0 + e] * bf2f((bf16_t)cur[e]) + wn * cw[1280 + c0 + e] * bf2f((bf16_t)nxt[e]) + cb[c0 + e]; o[e] = siluf(v); }
}
__device__ __forceinline__ float softplusf(float x) {
  const float y = __expf(-fabsf(x)); const float l = y < 0.06f ? y * (1.f - y * (0.5f - y * (0.33333334f - 0.25f * y))) : __logf(1.f + y); return fmaxf(x, 0.f) + l; }
__device__ __forceinline__ void wave_scan128(float e0, float e1, int lane, float& c0, float& c1) {
  float x = e0 + e1;
#pragma unroll
  for (int o = 1; o < 64; o <<= 1) { const float v = __shfl_up(x, o); if (lane >= o) x += v; }
  const float excl = x - (e0 + e1); c0 = excl + e0; c1 = excl + e0 + e1;
}
__device__ __forceinline__ int ssd_chunk_j0(int cidx) { return cidx < 2 ? cidx * 128 : CTXL + (cidx - 2) * 128; }

__device__ __forceinline__ void st_ssd1(int it0, int step, int nitems, const bf16_t* XBC, const float* DT, const float* cw, const float* cb, const float* dt_bias, const float* a_log,
                                        float* YIN, float* ST, float* DEC, char* lds) {
  bf16_t (*Cm)[72] = (bf16_t (*)[72])lds; bf16_t (*Bm)[72] = (bf16_t (*)[72])(lds + 18432);
  bf16_t (*BT)[136] = (bf16_t (*)[136])(lds + 36864); bf16_t (*Xt)[136] = (bf16_t (*)[136])(lds + 54272); bf16_t (*Mm)[136] = (bf16_t (*)[136])(lds + 71680);
  float* tab = (float*)(lds + 106496); float* dtf = tab; float* dtb = tab + 128; float* acf = tab + 256; float* acb = tab + 384; float* wf = tab + 512; float* wb = tab + 640;
  const int tid = TIDX;
  bf16x8 cu[6], pv[6], nx[6];
#define SSD1_LOADS(itm, I0, I1) do { const int h_ = (itm) % 6, bc_ = (itm) / 6, cidx_ = bc_ % 34, b_ = bc_ / 34, g_ = h_ / 3, j0_ = ssd_chunk_j0(cidx_); const size_t r0_ = (size_t)b_ * TPB + j0_; \
    _Pragma("unroll") for (int i = (I0); i < (I1); ++i) { const int task = tid + NT * i, t = task / 24, cg = task % 24, kind = cg >> 3, q = cg & 7, j = j0_ + t; \
      const int c0 = kind == 0 ? h_ * 64 + 8 * q : (kind == 1 ? 384 + g_ * 64 + 8 * q : 512 + g_ * 64 + 8 * q); \
      const bool hasp = j != 0 && j != CTXL, hasn = j != CTXL - 1 && j != TPB - 1; const bf16_t* p = XBC + (r0_ + t) * 768 + c0; \
      cu[i] = *(const bf16x8*)p; pv[i] = *(const bf16x8*)(p + (hasp ? -768 : 0)); nx[i] = *(const bf16x8*)(p + (hasn ? 768 : 0)); } } while (0)
  if (it0 < nitems) SSD1_LOADS(it0, 0, 6);
#pragma unroll 1
  for (int item = it0; item < nitems; item += step) {
  const int tid = TIDX, lane = tid & 63, w = tid >> 6, l15 = lane & 15, l4 = lane >> 4;
  const int h = item % 6, bc = item / 6, cidx = bc % 34, b = bc / 34, g = h / 3, j0 = ssd_chunk_j0(cidx);
  const size_t r0 = (size_t)b * TPB + j0;
  float dtr0 = 0.f, dtr1 = 0.f;
  if (w < 2) { const int t0 = w == 0 ? 2 * lane : 127 - 2 * lane, t1 = w == 0 ? 2 * lane + 1 : 126 - 2 * lane; dtr0 = DT[(r0 + t0) * 12 + w * 6 + h]; dtr1 = DT[(r0 + t1) * 12 + w * 6 + h]; }
  SSD1_LOADS(item, 6, 6);
  {
#pragma unroll
    for (int i = 0; i < 6; ++i) { const int task = tid + NT * i, t = task / 24, cg = task % 24, kind = cg >> 3, q = cg & 7, j = j0 + t;
      const int c0 = kind == 0 ? h * 64 + 8 * q : (kind == 1 ? 384 + g * 64 + 8 * q : 512 + g * 64 + 8 * q);
      const float wp = (j != 0 && j != CTXL) ? 1.f : 0.f, wn = (j != CTXL - 1 && j != TPB - 1) ? 1.f : 0.f;
      float o[8];
#pragma unroll
      for (int e = 0; e < 8; ++e) o[e] = siluf(wp * cw[c0 + e] * bf2f((bf16_t)pv[i][e]) + cw[640 + c0 + e] * bf2f((bf16_t)cu[i][e]) + wn * cw[1280 + c0 + e] * bf2f((bf16_t)nx[i][e]) + cb[c0 + e]);
      if (kind == 0) {
#pragma unroll
        for (int e = 0; e < 8; ++e) Xt[8 * q + e][t] = (bf16_t)f2bf(o[e]);
      } else { const u32x4 pk = (u32x4){pk2bf(o[0], o[1]), pk2bf(o[2], o[3]), pk2bf(o[4], o[5]), pk2bf(o[6], o[7])};
        if (kind == 1) { *(u32x4*)&Bm[t][8 * q] = pk;
#pragma unroll
          for (int e = 0; e < 8; ++e) BT[8 * q + e][t] = (bf16_t)f2bf(o[e]); }
        else *(u32x4*)&Cm[t][8 * q] = pk; } }
  }
  if (w < 2) { const int dir = w; const float a = -expf(a_log[dir * 6 + h]), bias = dt_bias[dir * 6 + h];
    const int t0 = dir == 0 ? 2 * lane : 127 - 2 * lane, t1 = dir == 0 ? 2 * lane + 1 : 126 - 2 * lane;
    const float d0 = softplusf(dtr0 + bias), d1 = softplusf(dtr1 + bias);
    float c0, c1; wave_scan128(d0 * a, d1 * a, lane, c0, c1);
    const float tot = __shfl(c1, 63);
    float* dtt = dir == 0 ? dtf : dtb; float* ac = dir == 0 ? acf : acb; float* ww = dir == 0 ? wf : wb;
    dtt[t0] = d0; dtt[t1] = d1; ac[t0] = c0; ac[t1] = c1; ww[t0] = __expf(tot - c0) * d0; ww[t1] = __expf(tot - c1) * d1;
    if (lane == 0) DEC[(((size_t)b * 34 + cidx) * 2 + dir) * 6 + h] = __expf(tot); }
  __syncthreads();
  if (item + step < nitems) SSD1_LOADS(item + step, 0, 6);
  {
    f32x4 accG[8];
#pragma unroll
    for (int ni = 0; ni < 8; ++ni) accG[ni] = (f32x4){0.f, 0.f, 0.f, 0.f};
#pragma unroll
    for (int kk = 0; kk < 2; ++kk) { const bf16x8 a = *(const bf16x8*)&Cm[16 * w + l15][32 * kk + 8 * l4];
#pragma unroll
      for (int ni = 0; ni < 8; ++ni) { const bf16x8 bb = *(const bf16x8*)&Bm[16 * ni + l15][32 * kk + 8 * l4]; accG[ni] = __builtin_amdgcn_mfma_f32_16x16x32_bf16(a, bb, accG[ni], 0, 0, 0); } }
    float aft[4], abt[4];
#pragma unroll
    for (int rg = 0; rg < 4; ++rg) { aft[rg] = acf[16 * w + 4 * l4 + rg]; abt[rg] = acb[16 * w + 4 * l4 + rg]; }
#pragma unroll
    for (int ni = 0; ni < 8; ++ni) { const int sidx = 16 * ni + l15; const float afs = acf[sidx], abs_ = acb[sidx], dfs = dtf[sidx], dbs = dtb[sidx];
#pragma unroll
      for (int rg = 0; rg < 4; ++rg) { const int t = 16 * w + 4 * l4 + rg;
        const float f = sidx <= t ? __expf(aft[rg] - afs) * dfs : 0.f, bk = sidx >= t ? __expf(abt[rg] - abs_) * dbs : 0.f;
        Mm[t][sidx] = (bf16_t)f2bf(accG[ni][rg] * (f + bk)); } }
  }
  __syncthreads();
  {
    f32x4 acc[4];
#pragma unroll
    for (int ni = 0; ni < 4; ++ni) acc[ni] = (f32x4){0.f, 0.f, 0.f, 0.f};
#pragma unroll
    for (int kk = 0; kk < 4; ++kk) { const bf16x8 a = *(const bf16x8*)&Mm[16 * w + l15][32 * kk + 8 * l4];
#pragma unroll
      for (int ni = 0; ni < 4; ++ni) { const bf16x8 bb = *(const bf16x8*)&Xt[16 * ni + l15][32 * kk + 8 * l4]; acc[ni] = __builtin_amdgcn_mfma_f32_16x16x32_bf16(a, bb, acc[ni], 0, 0, 0); } }
#pragma unroll
    for (int rg = 0; rg < 4; ++rg)
#pragma unroll
      for (int ni = 0; ni < 4; ++ni) YIN[(r0 + 16 * w + 4 * l4 + rg) * 384 + h * 64 + 16 * ni + l15] = acc[ni][rg];
  }
  {
    const int dir = w >> 2, mt = w & 3; const float* ww = dir == 0 ? wf : wb;
    f32x4 acc[4];
#pragma unroll
    for (int ni = 0; ni < 4; ++ni) acc[ni] = (f32x4){0.f, 0.f, 0.f, 0.f};
#pragma unroll
    for (int kk = 0; kk < 4; ++kk) { const bf16x8 raw = *(const bf16x8*)&Xt[16 * mt + l15][32 * kk + 8 * l4];
      const f32x4 w0 = *(const f32x4*)(ww + 32 * kk + 8 * l4), w1 = *(const f32x4*)(ww + 32 * kk + 8 * l4 + 4);
      u32x4 pk; pk.x = pk2bf(bf2f((bf16_t)raw[0]) * w0.x, bf2f((bf16_t)raw[1]) * w0.y); pk.y = pk2bf(bf2f((bf16_t)raw[2]) * w0.z, bf2f((bf16_t)raw[3]) * w0.w);
      pk.z = pk2bf(bf2f((bf16_t)raw[4]) * w1.x, bf2f((bf16_t)raw[5]) * w1.y); pk.w = pk2bf(bf2f((bf16_t)raw[6]) * w1.z, bf2f((bf16_t)raw[7]) * w1.w);
      const bf16x8 a = __builtin_bit_cast(bf16x8, pk);
#pragma unroll
      for (int ni = 0; ni < 4; ++ni) { const bf16x8 bb = *(const bf16x8*)&BT[16 * ni + l15][32 * kk + 8 * l4]; acc[ni] = __builtin_amdgcn_mfma_f32_16x16x32_bf16(a, bb, acc[ni], 0, 0, 0); } }
    float* sp = ST + ((((size_t)b * 34 + cidx) * 2 + dir) * 6 + h) * 4096;
#pragma unroll
    for (int rg = 0; rg < 4; ++rg)
#pragma unroll
      for (int ni = 0; ni < 4; ++ni) sp[(16 * mt + 4 * l4 + rg) * 64 + 16 * ni + l15] = acc[ni][rg];
  }
  __syncthreads();
  }
#undef SSD1_LOADS
}

__device__ __forceinline__ void st_ssd_scan2(float* ST, const float* DEC) {
  for (int idx = BIDX * NT + TIDX; idx < 4 * 2 * 6 * 4096; idx += GDIM * NT) {
    const int e = idx & 4095, bdh = idx >> 12, h = bdh % 6, dir = (bdh / 6) & 1, b = bdh / 12;
    float v[34], d[34];
#pragma unroll
    for (int st = 0; st < 34; ++st) { const int cidx = dir == 0 ? st : (st < 2 ? 1 - st : 35 - st); const size_t o = (((size_t)b * 34 + cidx) * 2 + dir) * 6 + h; v[st] = ST[o * 4096 + e]; d[st] = DEC[o]; }
    float H = 0.f;
#pragma unroll
    for (int st = 0; st < 34; ++st) { const int cidx = dir == 0 ? st : (st < 2 ? 1 - st : 35 - st); const size_t o = (((size_t)b * 34 + cidx) * 2 + dir) * 6 + h; ST[o * 4096 + e] = H; H = H * d[st] + v[st]; }
  }
}

__device__ __forceinline__ void ssd3_item(int b, int cidx, int g, const bf16_t* XBC, const bf16_t* VZ, const float* DT, const float* cw, const float* cb, const float* dt_bias, const float* a_log,
                                          const float* dskip, const float* nw, const float* YIN, const float* ST, bf16_t* MIX, char* lds) {
  bf16_t (*Cm)[72] = (bf16_t (*)[72])lds; bf16_t (*Hm)[72] = (bf16_t (*)[72])(lds + 18432);
  float* ef = (float*)(lds + 18432 + 55296);
  float (*Yt)[196] = (float (*)[196])lds;
  const int tid = TIDX, lane = tid & 63, w = tid >> 6, l15 = lane & 15, l4 = lane >> 4, j0 = ssd_chunk_j0(cidx);
  const size_t r0 = (size_t)b * TPB + j0;
#pragma unroll
  for (int i = 0; i < 2; ++i) { const int task = tid + NT * i, t = task >> 3, q = task & 7, j = j0 + t;
    float o[8]; ssd_conv8(XBC, r0 + t, 512 + g * 64 + 8 * q, j != 0 && j != CTXL, j != CTXL - 1 && j != TPB - 1, cw, cb, o);
    *(u32x4*)&Cm[t][8 * q] = (u32x4){pk2bf(o[0], o[1]), pk2bf(o[2], o[3]), pk2bf(o[4], o[5]), pk2bf(o[6], o[7])}; }
#pragma unroll
  for (int i = 0; i < 12; ++i) { const int f4 = tid + NT * i, hd = f4 >> 10, rem = f4 & 1023, p = rem >> 4, n4 = (rem & 15) * 4, hh = hd >> 1, dir = hd & 1;
    const f32x4 v = *(const f32x4*)(ST + ((((size_t)b * 34 + cidx) * 2 + dir) * 6 + 3 * g + hh) * 4096 + p * 64 + n4);
    *(u32x2*)&Hm[hd * 64 + p][n4] = (u32x2){pk2bf(v.x, v.y), pk2bf(v.z, v.w)}; }
  if (w < 6) { const int hh = w >> 1, dir = w & 1, h = 3 * g + hh; const float a = -expf(a_log[dir * 6 + h]), bias = dt_bias[dir * 6 + h];
    const int t0 = dir == 0 ? 2 * lane : 127 - 2 * lane, t1 = dir == 0 ? 2 * lane + 1 : 126 - 2 * lane;
    const float d0 = softplusf(DT[(r0 + t0) * 12 + dir * 6 + h] + bias), d1 = softplusf(DT[(r0 + t1) * 12 + dir * 6 + h] + bias);
    float c0, c1; wave_scan128(d0 * a, d1 * a, lane, c0, c1);
    ef[w * 128 + t0] = __expf(c0); ef[w * 128 + t1] = __expf(c1); }
  __syncthreads();
  float yv[3][4][4];
  {
    bf16x8 ca[2];
#pragma unroll
    for (int kk = 0; kk < 2; ++kk) ca[kk] = *(const bf16x8*)&Cm[16 * w + l15][32 * kk + 8 * l4];
#pragma unroll
    for (int hh = 0; hh < 3; ++hh) {
      f32x4 accF[4], accB[4];
#pragma unroll
      for (int ni = 0; ni < 4; ++ni) { accF[ni] = (f32x4){0.f, 0.f, 0.f, 0.f}; accB[ni] = (f32x4){0.f, 0.f, 0.f, 0.f}; }
#pragma unroll
      for (int kk = 0; kk < 2; ++kk)
#pragma unroll
        for (int ni = 0; ni < 4; ++ni) {
          accF[ni] = __builtin_amdgcn_mfma_f32_16x16x32_bf16(ca[kk], *(const bf16x8*)&Hm[(hh * 2 + 0) * 64 + 16 * ni + l15][32 * kk + 8 * l4], accF[ni], 0, 0, 0);
          accB[ni] = __builtin_amdgcn_mfma_f32_16x16x32_bf16(ca[kk], *(const bf16x8*)&Hm[(hh * 2 + 1) * 64 + 16 * ni + l15][32 * kk + 8 * l4], accB[ni], 0, 0, 0); }
#pragma unroll
      for (int rg = 0; rg < 4; ++rg) { const int t = 16 * w + 4 * l4 + rg; const float eF = ef[(hh * 2 + 0) * 128 + t], eB = ef[(hh * 2 + 1) * 128 + t];
#pragma unroll
        for (int ni = 0; ni < 4; ++ni) yv[hh][ni][rg] = eF * accF[ni][rg] + eB * accB[ni][rg]; }
    }
  }
  __syncthreads();
#pragma unroll
  for (int hh = 0; hh < 3; ++hh)
#pragma unroll
    for (int rg = 0; rg < 4; ++rg)
#pragma unroll
      for (int ni = 0; ni < 4; ++ni) Yt[16 * w + 4 * l4 + rg][hh * 64 + 16 * ni + l15] = yv[hh][ni][rg];
  __syncthreads();
  {
    const int c4 = 4 * (lane < 48 ? lane : 47), hk = c4 >> 6; const bool lact = lane < 48;
    float cw0[4], cw1[4], cw2[4], cbv[4], nwv[4];
#pragma unroll
    for (int e = 0; e < 4; ++e) { const int col = g * 192 + c4 + e; cw0[e] = cw[col]; cw1[e] = cw[640 + col]; cw2[e] = cw[1280 + col]; cbv[e] = cb[col]; nwv[e] = nw[col]; }
    const float dsk = dskip[3 * g + hk];
#pragma unroll 1
    for (int rb = 0; rb < 16; rb += 4) {
      u32x2 xc_[4], xp_[4], xn_[4], zz_[4]; f32x4 yy_[4];
#pragma unroll
      for (int u = 0; u < 4; ++u) { const int t = 16 * w + rb + u, j = j0 + t; const size_t r = r0 + t; const bool hasp = j != 0 && j != CTXL, hasn = j != CTXL - 1 && j != TPB - 1;
        const bf16_t* xq = XBC + r * 768 + g * 192 + c4;
        xc_[u] = *(const u32x2*)xq; xp_[u] = *(const u32x2*)(xq + (hasp ? -768 : 0)); xn_[u] = *(const u32x2*)(xq + (hasn ? 768 : 0));
        yy_[u] = *(const f32x4*)(YIN + r * 384 + g * 192 + c4); zz_[u] = *(const u32x2*)(VZ + r * 512 + 128 + g * 192 + c4); }
#pragma unroll
      for (int u = 0; u < 4; ++u) { const int t = 16 * w + rb + u, j = j0 + t; const size_t r = r0 + t; const float wp = (j != 0 && j != CTXL) ? 1.f : 0.f, wn = (j != CTXL - 1 && j != TPB - 1) ? 1.f : 0.f;
        const f32x4 yt = *(const f32x4*)&Yt[t][c4];
        float gt[4]; float ss = 0.f;
#pragma unroll
        for (int e = 0; e < 4; ++e) { const unsigned sh = (e & 1) * 16; const unsigned wc_ = e < 2 ? xc_[u].x : xc_[u].y, wq_ = e < 2 ? xp_[u].x : xp_[u].y, wn_ = e < 2 ? xn_[u].x : xn_[u].y, wz_ = e < 2 ? zz_[u].x : zz_[u].y;
          float xv = cw1[e] * bf2f((bf16_t)(wc_ >> sh)) + cbv[e] + wp * cw0[e] * bf2f((bf16_t)(wq_ >> sh)) + wn * cw2[e] * bf2f((bf16_t)(wn_ >> sh));
          xv = siluf(xv);
          const float y = yy_[u][e] + yt[e] + dsk * xv;
          gt[e] = lact ? y * siluf(bf2f((bf16_t)(wz_ >> sh))) : 0.f; ss += gt[e] * gt[e]; }
        const float rstd = rsqrtf(wave_sum(ss) * (1.0f / 192.0f) + EPS);
        if (lact) { u32x2 o; o.x = pk2bf(gt[0] * rstd * nwv[0], gt[1] * rstd * nwv[1]); o.y = pk2bf(gt[2] * rstd * nwv[2], gt[3] * rstd * nwv[3]);
          *(u32x2*)(MIX + r * DM + 384 + g * 192 + c4) = o; } }
    }
  }
  __syncthreads();
}

__device__ __forceinline__ void st_router(const float* xl, const float* xc, float* xl_dst, float* xc_dst, const bf16_t* MO, const float* g, const float* modv_layer, const float* w_router, const float* rbias,
                                          bf16_t* H2, int* ctl, int* tok_pair, float* tok_w, int skip_ctx, char* lds) {
  float* wl = (float*)lds;
  const int tid = TIDX, lane = tid & 63, gw = BIDX * 8 + (tid >> 6), ngw = GDIM * 8;
  int* hist = (int*)(lds + 81920);
  if (tid < 32) hist[tid] = 0;
  float* mA = (float*)(lds + 82176); float* mB = mA + 5 * 1024; float* mG = mB + 5 * 1024;
  for (int idx = tid; idx < 5 * 1024; idx += NT) { const int m = idx >> 10, k = idx & 1023; mA[idx] = g[k] * (1.f + modv_layer[(size_t)m * 6144 + 4096 + k]); mB[idx] = modv_layer[(size_t)m * 6144 + 3072 + k]; mG[idx] = modv_layer[(size_t)m * 6144 + 2048 + k]; }
  for (int idx = tid; idx < 4096; idx += NT) { const int k = idx >> 2, e4 = idx & 3, row = ((k & 3) * 4 + (k >> 8)) * 64 + ((k & 255) >> 2);
    *(f32x4*)(wl + row * 20 + 4 * e4) = *(const f32x4*)(w_router + (size_t)k * 16 + 4 * e4); }
  __syncthreads();
  for (int rb = gw; rb < MTOK; rb += 2 * ngw) {
    int rr[2]; bool act[2]; f32x4 v[2][4]; u32x2 mo[2][4]; float rstd[2]; int mo_[2];
#pragma unroll
    for (int u = 0; u < 2; ++u) { const int r = rb + u * ngw; rr[u] = r < MTOK ? r : MTOK - 1; act[u] = r < MTOK && !(skip_ctx && (rr[u] % TPB) < CTXL); mo_[u] = mrow_of(rr[u]) * 1024;
      const float* xr = xrow(xl, xc, rr[u]); const bf16_t* mr = MO + (size_t)rr[u] * DM;
#pragma unroll
      for (int j = 0; j < 4; ++j) { v[u][j] = *(const f32x4*)(xr + 4 * lane + 256 * j); mo[u][j] = *(const u32x2*)(mr + 4 * lane + 256 * j); } }
    if (!act[0] && !act[1]) continue;
#pragma unroll
    for (int u = 0; u < 2; ++u) if (act[u]) { float* xd = xrow(xl_dst, xc_dst, rr[u]);
#pragma unroll
      for (int j = 0; j < 4; ++j) { const int k = 4 * lane + 256 * j; const f32x4 g4 = *(const f32x4*)(mG + mo_[u] + k);
        const f32x4 m4 = (f32x4){__uint_as_float(mo[u][j].x << 16), __uint_as_float(mo[u][j].x & 0xffff0000u), __uint_as_float(mo[u][j].y << 16), __uint_as_float(mo[u][j].y & 0xffff0000u)};
        v[u][j] = v[u][j] + g4 * m4; *(f32x4*)(xd + k) = v[u][j]; } }
#pragma unroll
    for (int u = 0; u < 2; ++u) { float ss = 0.f;
#pragma unroll
      for (int j = 0; j < 4; ++j) ss += v[u][j].x * v[u][j].x + v[u][j].y * v[u][j].y + v[u][j].z * v[u][j].z + v[u][j].w * v[u][j].w;
      rstd[u] = rsqrtf(wave_sum(ss) * (1.0f / DM) + EPS); }
    float lg[2][16];
#pragma unroll
    for (int u = 0; u < 2; ++u)
#pragma unroll
      for (int e = 0; e < 16; ++e) lg[u][e] = 0.f;
#pragma unroll 1
    for (int j = 0; j < 4; ++j) { const int k = 4 * lane + 256 * j; float o[2][4];
#pragma unroll
      for (int u = 0; u < 2; ++u) { const f32x4 a4 = *(const f32x4*)(mA + mo_[u] + k), b4 = *(const f32x4*)(mB + mo_[u] + k); const f32x4 o4 = v[u][j] * rstd[u] * a4 + b4;
        o[u][0] = o4.x; o[u][1] = o4.y; o[u][2] = o4.z; o[u][3] = o4.w;
        if (act[u]) { u32x2 wpk; wpk.x = pk2bf(o4.x, o4.y); wpk.y = pk2bf(o4.z, o4.w); *(u32x2*)(H2 + (size_t)rr[u] * DM + k) = wpk; } }
#pragma unroll
      for (int q = 0; q < 4; ++q) { const float* wr_ = wl + ((q * 4 + j) * 64 + lane) * 20;
#pragma unroll
        for (int e4 = 0; e4 < 4; ++e4) { const f32x4 wr = *(const f32x4*)(wr_ + 4 * e4);
#pragma unroll
          for (int u = 0; u < 2; ++u) { lg[u][4 * e4] += o[u][q] * wr.x; lg[u][4 * e4 + 1] += o[u][q] * wr.y; lg[u][4 * e4 + 2] += o[u][q] * wr.z; lg[u][4 * e4 + 3] += o[u][q] * wr.w; } } } }
    float h1[2];
#pragma unroll
    for (int u = 0; u < 2; ++u) { float h8[8], h4[4], h2[2];
#pragma unroll
      for (int i = 0; i < 8; ++i) { const bool up = (lane & 32) != 0; const float keep = up ? lg[u][8 + i] : lg[u][i], give = up ? lg[u][i] : lg[u][8 + i]; h8[i] = keep + __shfl_xor(give, 32); }
#pragma unroll
      for (int i = 0; i < 4; ++i) { const bool up = (lane & 16) != 0; const float keep = up ? h8[4 + i] : h8[i], give = up ? h8[i] : h8[4 + i]; h4[i] = keep + __shfl_xor(give, 16); }
#pragma unroll
      for (int i = 0; i < 2; ++i) { const bool up = (lane & 8) != 0; const float keep = up ? h4[2 + i] : h4[i], give = up ? h4[i] : h4[2 + i]; h2[i] = keep + __shfl_xor(give, 8); }
      { const bool up = (lane & 4) != 0; const float keep = up ? h2[1] : h2[0], give = up ? h2[0] : h2[1]; h1[u] = keep + __shfl_xor(give, 4); }
      h1[u] += __shfl_xor(h1[u], 2); h1[u] += __shfl_xor(h1[u], 1); }
    float lx[16];
#pragma unroll
    for (int e = 0; e < 16; ++e) { const int src = ((e >> 3) & 1) * 32 + ((e >> 2) & 1) * 16 + ((e >> 1) & 1) * 8 + (e & 1) * 4;
      const float a0 = __uint_as_float(__builtin_amdgcn_readlane(__float_as_uint(h1[0]), src)), a1 = __uint_as_float(__builtin_amdgcn_readlane(__float_as_uint(h1[1]), src));
      lx[e] = lane < 32 ? a0 : a1; }
    const int us = lane >> 5;
    if ((lane & 31) == 0 && (us == 0 ? act[0] : act[1])) {
      const int r = us == 0 ? rr[0] : rr[1];
      int best = 0, bi1 = 0, bi2 = 1; float bestv = -1e30f, bs1 = 0.f, bs2 = 0.f;
#pragma unroll
      for (int gq = 0; gq < 4; ++gq) { float m1 = -1e30f, m2 = -1e30f, s1 = 0.f, s2 = 0.f; int i1 = 0, i2 = 0;
#pragma unroll
        for (int i = 0; i < 4; ++i) { const float scv = 1.0f / (1.0f + __expf(-lx[4 * gq + i])); const float sv = scv + rbias[4 * gq + i];
          if (sv > m1) { m2 = m1; s2 = s1; i2 = i1; m1 = sv; s1 = scv; i1 = i; } else if (sv > m2) { m2 = sv; s2 = scv; i2 = i; } }
        if (m1 + m2 > bestv) { bestv = m1 + m2; best = gq; bi1 = i1; bi2 = i2; bs1 = s1; bs2 = s2; } }
      const int ia = bi1 < bi2 ? bi1 : bi2, ib = bi1 < bi2 ? bi2 : bi1;
      const int tri = ia == 0 ? ib - 1 : (ia == 1 ? ib + 1 : 5);
      const int pidx = best * 6 + tri;
      const float sa = bi1 < bi2 ? bs1 : bs2, sb = bi1 < bi2 ? bs2 : bs1, inv = 1.0f / (sa + sb);
      const int rank = atomicAdd(&hist[pidx], 1);
      tok_pair[r] = pidx | (rank << 5); tok_w[2 * r] = sa * inv; tok_w[2 * r + 1] = sb * inv;
    }
  }
  __syncthreads();
  if (tid < 32) ctl[CT_CNTB + BIDX * 32 + tid] = tid < 24 ? hist[tid] : 0;
}
__device__ __forceinline__ void st_moe_gather(const bf16_t* H2, bf16_t* H2S, int* ctl, const int* tok_pair, const float* tok_w, int* sorted_tok, float* sorted_w, int skip_ctx, char* lds) {
  int* sbase = (int*)lds; int* rtot = sbase + 32; int* rpre = rtot + 512;
  const int tid = TIDX, bid = BIDX;
  { const int p = tid & 31, seg = tid >> 5; int tot = 0, pre = 0;
#pragma unroll 4
    for (int i = 0; i < 16; ++i) { const int bb = seg * 16 + i; const int cv = ctl[CT_CNTB + bb * 32 + p]; tot += cv; pre += bb < bid ? cv : 0; }
    rtot[seg * 32 + p] = tot; rpre[seg * 32 + p] = pre; }
  __syncthreads();
  if (tid < 32) { int tot = 0, pre = 0;
#pragma unroll
    for (int sg = 0; sg < 16; ++sg) { tot += rtot[sg * 32 + tid]; pre += rpre[sg * 32 + tid]; }
    rtot[tid] = tot; rpre[tid] = pre; }
  __syncthreads();
  if (tid == 0) { int base = 0, nt = 0;
#pragma unroll 1
    for (int p = 0; p < 24; ++p) { sbase[p] = base + rpre[p]; const int n = rtot[p], tl = (n + 255) >> 8;
      if (bid == 0) { ctl[CT_BASE + p] = base; for (int t = 0; t < tl; ++t) ctl[CT_TP + nt + t] = p; }
      nt += tl; base += tl * 256; }
    if (bid == 0) { ctl[CT_BASE + 24] = base; ctl[CT_NT] = nt; } }
  __syncthreads();
  const int lane = tid & 63, gw = bid * 8 + (tid >> 6), ngw = GDIM * 8;
  for (int rb = gw; rb < MTOK; rb += 3 * ngw) {
    u32x4 a0[3], a1[3]; int pk[3]; float w0[3], w1[3]; bool act[3];
#pragma unroll
    for (int u = 0; u < 3; ++u) { const int r = rb + u * ngw; act[u] = r < MTOK && !(skip_ctx && (r % TPB) < CTXL); const int rc = act[u] ? r : 0;
      pk[u] = tok_pair[rc]; w0[u] = tok_w[2 * rc]; w1[u] = tok_w[2 * rc + 1];
      const u32x4* sp = (const u32x4*)(H2 + (size_t)rc * DM); a0[u] = sp[lane]; a1[u] = sp[lane + 64]; }
#pragma unroll
    for (int u = 0; u < 3; ++u) if (act[u]) { const int r = rb + u * ngw; const int slot = sbase[pk[u] & 31] + (pk[u] >> 5);
      if (lane == 0) { sorted_tok[slot] = r; sorted_w[2 * slot] = w0[u]; sorted_w[2 * slot + 1] = w1[u]; }
      u32x4* d = (u32x4*)(H2S + (size_t)slot * DM); d[lane] = a0[u]; d[lane + 64] = a1[u]; }
  }
  __syncthreads();
}
__device__ __forceinline__ void st_final(float* xl, const float* g) {
  const int lane = TIDX & 63, gw = BIDX * 8 + (TIDX >> 6), ngw = GDIM * 8;
  f32x4 gg[4];
#pragma unroll
  for (int j = 0; j < 4; ++j) gg[j] = *(const f32x4*)(g + 4 * lane + 256 * j);
  for (int rb = gw; rb < NB * SEQ; rb += 4 * ngw) {
    f32x4 v[4][4];
#pragma unroll
    for (int u = 0; u < 4; ++u) { const int r = rb + u * ngw; const float* xr = xl + (size_t)(r < NB * SEQ ? r : NB * SEQ - 1) * DM;
#pragma unroll
      for (int j = 0; j < 4; ++j) v[u][j] = *(const f32x4*)(xr + 4 * lane + 256 * j); }
#pragma unroll
    for (int u = 0; u < 4; ++u) { const int r = rb + u * ngw; float ss = 0.f;
#pragma unroll
      for (int j = 0; j < 4; ++j) ss += v[u][j].x * v[u][j].x + v[u][j].y * v[u][j].y + v[u][j].z * v[u][j].z + v[u][j].w * v[u][j].w;
      const float rstd = rsqrtf(wave_sum(ss) * (1.0f / DM) + EPS);
      if (r < NB * SEQ) { float* xr = xl + (size_t)r * DM;
#pragma unroll
        for (int j = 0; j < 4; ++j) *(f32x4*)(xr + 4 * lane + 256 * j) = (f32x4){v[u][j].x * rstd * gg[j].x, v[u][j].y * rstd * gg[j].y, v[u][j].z * rstd * gg[j].z, v[u][j].w * rstd * gg[j].w}; } }
  }
}

namespace pg8 {
#define PG8_LAS __attribute__((address_space(3)))
typedef unsigned short bf16_t;
typedef short bf16x8 __attribute__((ext_vector_type(8)));
typedef float f32x4 __attribute__((ext_vector_type(4)));
typedef unsigned u32x4 __attribute__((ext_vector_type(4)));
constexpr int BM = 256, BK = 64, HALF = 128, HTB = HALF * BK * 2  , STAGE_BYTES = 8 * HTB, NXCD = 8, WGM = 8;

__host__ __device__ __forceinline__ int lds_byte(int r, int c) { const int st = (r >> 4) * 2 + (c >> 5), rr = r & 15, cc = c & 31, ob = rr * 64 + cc * 2; return st * 1024 + (ob ^ (((ob >> 9) & 1) << 5)); }
__host__ __device__ __forceinline__ void stage_rc(int b, int& R, int& C) { const int st = b / 1024, sb = b % 1024, swz = sb ^ (((sb >> 9) & 1) << 5); R = (st >> 1) * 16 + swz / 64; C = (st & 1) * 32 + (swz % 64) / 2; }
__host__ __device__ __forceinline__ int perm32(int rho) { const int n = rho >> 4, i = rho & 15; return 8 * (i >> 2) + 4 * n + (i & 3); }

struct Unit { int pm, pn, fin; const char* A; const char* B; };
struct Gemm { int K, lda, ldb; };

__device__ __forceinline__ void tile_of(int L, int nM, int nN, int& pm, int& pn) {
    const int nwg = nM * nN; int wgid = L; { const int q = nwg / NXCD, r = nwg % NXCD, xcd = wgid % NXCD, off = wgid / NXCD; wgid = (xcd < r ? xcd * (q + 1) : r * (q + 1) + (xcd - r) * q) + off; }
    const int nig = WGM * nN, gid = wgid / nig, fm = gid * WGM, gsz = (nM - fm) < WGM ? (nM - fm) : WGM;
    pm = fm + ((wgid % nig) % gsz); pn = (wgid % nig) / gsz;
}
__device__ __forceinline__ unsigned cvt_pk_bf16(float lo, float hi) { unsigned r; asm volatile("v_cvt_pk_bf16_f32 %0, %1, %2" : "=v"(r) : "v"(lo), "v"(hi)); return r; }
template <class Epi, class Sched, bool ALIGN_EPI = false, bool SP2 = false>
__device__ __forceinline__ void gemm_phase(PG8_LAS unsigned char* lds, const Gemm g, const Sched& S, const Epi& E) {
    const int tid = opq_v((int)threadIdx.x), wid = __builtin_amdgcn_readfirstlane(tid >> 6), lane = tid & 63, wr = wid >> 2, wc = wid & 3, fr = lane & 15, fq = lane >> 4;
    const int K = g.K, nt = K / BK;
    unsigned voffA[2], voffB[2];
#pragma unroll
    for (int i = 0; i < 2; ++i) { int R, C; stage_rc(tid * 16 + i * 8192, R, C); const int Rb = Epi::PERM ? ((R & ~31) + perm32(R & 31)) : R;
        voffA[i] = (unsigned)(R * g.lda + C) * 2u; voffB[i] = (unsigned)(Rb * g.ldb + C) * 2u; }
    const size_t kstep = (size_t)(BK * 2);
    const size_t hstepA = (size_t)HALF * g.lda * 2, hstepB = (size_t)HALF * g.ldb * 2;
    const unsigned ldsw = (unsigned)wid * 1024u;
    const int aoff = lds_byte(wr * 64 + fr, fq * 8), boff = lds_byte(wc * 32 + fr, fq * 8);
#define PG8_SA(b, h) (((b) * 2 + (h)) * HTB)
#define PG8_SB(b, h) ((4 + (b) * 2 + (h)) * HTB)
#define PG8_STAGE(bufoff, gbase, voff) do { _Pragma("unroll") for (int _i = 0; _i < 2; ++_i) \
        __builtin_amdgcn_global_load_lds((const unsigned*)((const char*)(gbase) + (voff)[_i]), (PG8_LAS unsigned*)(lds + (bufoff) + ldsw + _i * 8192), 16, 0, 0); } while (0)
#define PG8_LDA(dst, b, h) do { _Pragma("unroll") for (int m = 0; m < 4; ++m) _Pragma("unroll") for (int k = 0; k < 2; ++k) dst[m][k] = *(const PG8_LAS bf16x8*)(lds + PG8_SA(b, h) + aoff + m * 2048 + k * 1024); } while (0)
#define PG8_LDB(dst, b, h) do { _Pragma("unroll") for (int n = 0; n < 2; ++n) _Pragma("unroll") for (int k = 0; k < 2; ++k) dst[n][k] = *(const PG8_LAS bf16x8*)(lds + PG8_SB(b, h) + boff + n * 2048 + k * 1024); } while (0)
#define PG8_MMA(ai, bj, At, Bt) do { __builtin_amdgcn_s_setprio(1); _Pragma("unroll") for (int m = 0; m < 4; ++m) _Pragma("unroll") for (int n = 0; n < 2; ++n) _Pragma("unroll") for (int k = 0; k < 2; ++k) \
        acc[ai][bj][m][n] = __builtin_amdgcn_mfma_f32_16x16x32_bf16(Bt[n][k], At[m][k], acc[ai][bj][m][n], 0, 0, 0); __builtin_amdgcn_s_setprio(0); } while (0)
#define PG8_WAIT_V(n) asm volatile("s_waitcnt vmcnt(" #n ")" ::: "memory")
#define PG8_WAIT_L(n) asm volatile("s_waitcnt lgkmcnt(" #n ")" ::: "memory")
#define PG8_BAR __builtin_amdgcn_s_barrier()
#define PG8_SCHED __builtin_amdgcn_sched_barrier(0)
    Unit cur, nxt; int ui = 0;
    if (!S.next(0, cur)) return;
    f32x4 acc[2][2][4][2];
#pragma unroll
    for (int a = 0; a < 2; ++a)
#pragma unroll
        for (int b = 0; b < 2; ++b)
#pragma unroll
            for (int m = 0; m < 4; ++m)
#pragma unroll
                for (int n = 0; n < 2; ++n) acc[a][b][m][n] = (f32x4){0.f, 0.f, 0.f, 0.f};
    bf16x8 At[4][2], B0[2][2], B1[2][2];
    const char* cA = cur.A; const char* cB = cur.B;
    S.a_ready(cur);
    if constexpr (SP2) {
        PG8_STAGE(PG8_SB(0, 0), cB, voffB); PG8_STAGE(PG8_SB(0, 1), cB + hstepB, voffB); PG8_STAGE(PG8_SA(0, 0), cA, voffA); PG8_STAGE(PG8_SA(0, 1), cA + hstepA, voffA);
        if (wr == 1) PG8_BAR;
        PG8_WAIT_V(2); PG8_BAR;
        PG8_STAGE(PG8_SB(1, 0), cB + kstep, voffB); PG8_STAGE(PG8_SA(1, 0), cA + kstep, voffA); PG8_STAGE(PG8_SB(1, 1), cB + hstepB + kstep, voffB);
        PG8_WAIT_V(6); PG8_BAR;
    } else {
        PG8_STAGE(PG8_SB(0, 0), cB, voffB); PG8_STAGE(PG8_SA(0, 0), cA, voffA); PG8_STAGE(PG8_SB(0, 1), cB + hstepB, voffB); PG8_STAGE(PG8_SA(0, 1), cA + hstepA, voffA);
        if (wr == 1) PG8_BAR;
        PG8_WAIT_V(4); PG8_BAR;
        PG8_STAGE(PG8_SB(1, 0), cB + kstep, voffB); PG8_STAGE(PG8_SA(1, 0), cA + kstep, voffA); PG8_STAGE(PG8_SB(1, 1), cB + hstepB + kstep, voffB);
        PG8_WAIT_V(6); PG8_BAR;
    }
    for (;;) {
        const bool has_next = S.next(ui + 1, nxt);
        const char* nA = has_next ? nxt.A : cA; const char* nB = has_next ? nxt.B : cB;
        for (int t = 0; t < nt; t += 2) {
            const bool last = (t == nt - 2);
            const char* a1 = cA + (size_t)(t + 1) * kstep;
            const char* a2 = last ? nA : cA + (size_t)(t + 2) * kstep; const char* b2 = last ? nB : cB + (size_t)(t + 2) * kstep;
            const char* a3 = a2 + kstep; const char* b3 = b2 + kstep;
            if (last && has_next) S.a_ready(nxt);
            if constexpr (SP2) {
            PG8_LDB(B0, 0, 0); PG8_LDB(B1, 0, 1); PG8_SCHED; PG8_LDA(At, 0, 0); PG8_STAGE(PG8_SA(1, 1), a1 + hstepA, voffA);
            PG8_WAIT_V(8); PG8_WAIT_L(0); PG8_BAR; PG8_MMA(0, 0, At, B0); PG8_MMA(0, 1, At, B1); PG8_BAR; PG8_SCHED;
            PG8_LDA(At, 0, 1); PG8_STAGE(PG8_SB(0, 0), b2, voffB); PG8_STAGE(PG8_SB(0, 1), b2 + hstepB, voffB); PG8_STAGE(PG8_SA(0, 0), a2, voffA);
            PG8_WAIT_V(8); PG8_WAIT_L(0); PG8_BAR; PG8_MMA(1, 0, At, B0); PG8_MMA(1, 1, At, B1); PG8_BAR; PG8_SCHED;
            PG8_LDB(B0, 1, 0); PG8_LDB(B1, 1, 1); PG8_SCHED; PG8_LDA(At, 1, 0); PG8_STAGE(PG8_SA(0, 1), a2 + hstepA, voffA);
            PG8_WAIT_V(8); PG8_WAIT_L(0); PG8_BAR; PG8_MMA(0, 0, At, B0); PG8_MMA(0, 1, At, B1); PG8_BAR; PG8_SCHED;
            PG8_LDA(At, 1, 1); PG8_STAGE(PG8_SB(1, 0), b3, voffB); PG8_STAGE(PG8_SB(1, 1), b3 + hstepB, voffB); PG8_STAGE(PG8_SA(1, 0), a3, voffA);
            PG8_WAIT_V(8); PG8_WAIT_L(0); PG8_BAR; PG8_MMA(1, 0, At, B0); PG8_MMA(1, 1, At, B1); PG8_BAR; PG8_SCHED;
            } else {
            PG8_LDB(B0, 0, 0); PG8_SCHED; PG8_LDA(At, 0, 0); PG8_STAGE(PG8_SA(1, 1), a1 + hstepA, voffA);
            PG8_WAIT_L(8); PG8_BAR; PG8_WAIT_L(0); PG8_MMA(0, 0, At, B0); PG8_BAR; PG8_SCHED;
            PG8_LDB(B1, 0, 1); PG8_STAGE(PG8_SB(0, 0), b2, voffB);
            PG8_BAR; PG8_WAIT_L(0); PG8_MMA(0, 1, At, B1); PG8_BAR;
            PG8_LDA(At, 0, 1); PG8_STAGE(PG8_SA(0, 0), a2, voffA);
            PG8_BAR; PG8_WAIT_L(0); PG8_MMA(1, 0, At, B0); PG8_BAR; PG8_SCHED;
            PG8_STAGE(PG8_SB(0, 1), b2 + hstepB, voffB);
            PG8_WAIT_V(6); PG8_BAR; PG8_MMA(1, 1, At, B1); PG8_BAR;
            PG8_LDB(B0, 1, 0); PG8_SCHED; PG8_LDA(At, 1, 0); PG8_STAGE(PG8_SA(0, 1), a2 + hstepA, voffA);
            PG8_WAIT_L(8); PG8_BAR; PG8_WAIT_L(0); PG8_MMA(0, 0, At, B0); PG8_BAR; PG8_SCHED;
            PG8_LDB(B1, 1, 1); PG8_STAGE(PG8_SB(1, 0), b3, voffB);
            PG8_BAR; PG8_WAIT_L(0); PG8_MMA(0, 1, At, B1); PG8_BAR;
            PG8_LDA(At, 1, 1); PG8_STAGE(PG8_SA(1, 0), a3, voffA);
            PG8_BAR; PG8_WAIT_L(0); PG8_MMA(1, 0, At, B0); PG8_BAR; PG8_SCHED;
            PG8_STAGE(PG8_SB(1, 1), b3 + hstepB, voffB);
            PG8_WAIT_V(6); PG8_BAR; PG8_MMA(1, 1, At, B1); PG8_BAR;
            }
        }
        if constexpr (ALIGN_EPI) { if (wr == 0) PG8_BAR; }
        if constexpr (!Epi::AFTER_DRAIN) { if (cur.fin) { E(acc, cur, wr, wc, fr, fq); S.done(cur); } }
        if (!has_next) break;
        if (cur.fin) {
#pragma unroll
        for (int a = 0; a < 2; ++a)
#pragma unroll
            for (int b = 0; b < 2; ++b)
#pragma unroll
                for (int m = 0; m < 4; ++m)
#pragma unroll
                    for (int n = 0; n < 2; ++n) acc[a][b][m][n] = (f32x4){0.f, 0.f, 0.f, 0.f};
        }
        cur = nxt; cA = nA; cB = nB; ++ui;
        if constexpr (ALIGN_EPI) { if (wr == 1) PG8_BAR; }
    }
    PG8_WAIT_V(0);
    if constexpr (!ALIGN_EPI) { if (wr == 0) PG8_BAR; }
    PG8_BAR;
    if constexpr (Epi::AFTER_DRAIN) { E.fused(acc, cur, wr, wc, fr, fq, lds, wid, lane); S.done(cur); }
#undef PG8_SA
#undef PG8_SB
#undef PG8_STAGE
#undef PG8_LDA
#undef PG8_LDB
#undef PG8_MMA
#undef PG8_WAIT_V
#undef PG8_WAIT_L
#undef PG8_BAR
#undef PG8_SCHED
}
}

struct SchedDense {
  int nM, nN, G, c, skip_ctx; const char* A; const char* B; size_t a_tile, b_tile;
  __device__ __forceinline__ bool next(int i, pg8::Unit& u) const {
    const long L = (long)i * G + c; if (L >= (long)nM * nN) return false;
    int pm, pn; pg8::tile_of((int)L, nM, nN, pm, pn); if (skip_ctx) pm = pm + pm / 16 + 1;
    u.pm = pm; u.pn = pn; u.fin = 1; u.A = A + (size_t)pm * a_tile; u.B = B + (size_t)pn * b_tile; return true; }
  __device__ __forceinline__ void a_ready(const pg8::Unit&) const {}
  __device__ __forceinline__ void done(const pg8::Unit&) const {}
};
struct SchedMoe {
  int G, c, mode; const int* ctl; const char* A; size_t a_tile; const char* W;
  __device__ __forceinline__ bool next(int i, pg8::Unit& u) const {
    const int part = mode == 2 ? (i & 1) : 0, iu = mode == 2 ? (i >> 1) : i;
    const long L = (long)iu * G + c; const int ntiles = ctl[CT_NT]; if (L >= (long)ntiles * 4) return false;
    const int pm = (int)(L >> 2), pn = (int)(L & 3); int eA, eB; pair_experts(ctl[CT_TP + pm], eA, eB);
    u.pm = pm; u.pn = pn;
    if (mode == 1) { const int e = pn < 2 ? eA : eB; u.fin = 1; u.A = A + (size_t)pm * a_tile; u.B = W + (size_t)e * (512 * 1024 * 2) + (size_t)(pn & 1) * (256 * 1024 * 2); }
    else { u.fin = part; u.A = A + (size_t)pm * a_tile + part * 512; u.B = W + (size_t)(part ? eB : eA) * (1024 * 256 * 2) + (size_t)pn * (256 * 256 * 2); }
    return true; }
  __device__ __forceinline__ void a_ready(const pg8::Unit&) const {}
  __device__ __forceinline__ void done(const pg8::Unit&) const {}
};
__device__ __forceinline__ unsigned cvt_pk(float lo, float hi) { return pg8::cvt_pk_bf16(lo, hi); }
struct EpiInProj {
  static constexpr bool PERM = true, AFTER_DRAIN = false; bf16_t *QK, *VZ, *XBC, *HY; float* DT;
  __device__ __forceinline__ void operator()(const f32x4 (&acc)[2][2][4][2], const pg8::Unit& u, int wr, int wc, int fr, int fq) const {
    const int pn = u.pn; bf16_t* base; int ldc, coff;
    if (pn < 2) { base = QK; ldc = 512; coff = pn * 256; } else if (pn < 4) { base = VZ; ldc = 512; coff = (pn - 2) * 256; }
    else if (pn < 7) { base = XBC; ldc = 768; coff = (pn - 4) * 256; } else { base = HY; ldc = 768; coff = (pn - 7) * 256; }
    const int row0 = u.pm * 256 + wr * 64 + fr, col0 = coff + wc * 32 + 8 * fq; const bool dtl = (pn == 6 && wc == 0 && fq < 2);
#pragma unroll
    for (int ai = 0; ai < 2; ++ai)
#pragma unroll
      for (int m = 0; m < 4; ++m) { const int row = row0 + ai * 128 + m * 16; bf16_t* rowp = base + (size_t)row * ldc + col0;
#pragma unroll
        for (int bj = 0; bj < 2; ++bj) { const f32x4 v0 = acc[ai][bj][m][0], v1 = acc[ai][bj][m][1];
          u32x4 w; w.x = cvt_pk(v0[0], v0[1]); w.y = cvt_pk(v0[2], v0[3]); w.z = cvt_pk(v1[0], v1[1]); w.w = cvt_pk(v1[2], v1[3]);
          *(u32x4*)(rowp + bj * 128) = w;
          if (bj == 1 && dtl) { float* dp = DT + (size_t)row * 12 + 8 * fq; *(f32x4*)dp = v0; if (fq == 0) *(f32x4*)(dp + 4) = v1; } } }
  }
};
struct EpiOutProj {
  static constexpr bool PERM = true, AFTER_DRAIN = false; bf16_t* MO;
  __device__ __forceinline__ void operator()(const f32x4 (&acc)[2][2][4][2], const pg8::Unit& u, int wr, int wc, int fr, int fq) const {
    const int row0 = u.pm * 256 + wr * 64 + fr, col0 = u.pn * 256 + wc * 32 + 8 * fq;
#pragma unroll
    for (int ai = 0; ai < 2; ++ai)
#pragma unroll
      for (int m = 0; m < 4; ++m) { bf16_t* rowp = MO + (size_t)(row0 + ai * 128 + m * 16) * DM + col0;
#pragma unroll
        for (int bj = 0; bj < 2; ++bj) { const f32x4 v0 = acc[ai][bj][m][0], v1 = acc[ai][bj][m][1];
          u32x4 w; w.x = cvt_pk(v0[0], v0[1]); w.y = cvt_pk(v0[2], v0[3]); w.z = cvt_pk(v1[0], v1[1]); w.w = cvt_pk(v1[2], v1[3]);
          *(u32x4*)(rowp + bj * 128) = w; } }
  }
};
struct EpiMoe1 {
  static constexpr bool PERM = true, AFTER_DRAIN = false; bf16_t* ACT; const float* sorted_w;
  __device__ __forceinline__ void operator()(const f32x4 (&acc)[2][2][4][2], const pg8::Unit& u, int wr, int wc, int fr, int fq) const {
    const int half = u.pn >> 1, j0 = (u.pn & 1) * 128 + 16 * wc + 4 * fq;
#pragma unroll
    for (int ai = 0; ai < 2; ++ai)
#pragma unroll
      for (int m = 0; m < 4; ++m) { const int slot = u.pm * 256 + ai * 128 + wr * 64 + m * 16 + fr; const float wt = sorted_w[2 * slot + half];
#pragma unroll
        for (int bj = 0; bj < 2; ++bj) { const f32x4 v0 = acc[ai][bj][m][0], v1 = acc[ai][bj][m][1];
          u32x2 w; w.x = cvt_pk(siluf(v0[0]) * v0[1] * wt, siluf(v0[2]) * v0[3] * wt); w.y = cvt_pk(siluf(v1[0]) * v1[1] * wt, siluf(v1[2]) * v1[3] * wt);
          *(u32x2*)(ACT + (size_t)slot * 512 + half * 256 + j0 + 64 * bj) = w; } }
  }
};
struct EpiMoe2 {
  static constexpr bool PERM = false, AFTER_DRAIN = false; float *xl, *xc; const float* gate; const int* sorted_tok;
  __device__ __forceinline__ void operator()(const f32x4 (&acc)[2][2][4][2], const pg8::Unit& u, int wr, int wc, int fr, int fq) const {
    const int col0 = u.pn * 256 + wc * 32 + 4 * fq;
#pragma unroll
    for (int ai = 0; ai < 2; ++ai)
#pragma unroll
      for (int m = 0; m < 4; ++m) { const int slot = u.pm * 256 + ai * 128 + wr * 64 + m * 16 + fr; const int r = sorted_tok[slot];
        if (r >= 0) { float* xd = xrow(xl, xc, r) + col0; const float* gt = gate + (size_t)mrow_of(r) * 6144 + col0;
#pragma unroll
          for (int bj = 0; bj < 2; ++bj)
#pragma unroll
            for (int n = 0; n < 2; ++n) { const int co = bj * 128 + n * 16; *(f32x4*)(xd + co) = *(const f32x4*)(xd + co) + *(const f32x4*)(gt + co) * acc[ai][bj][m][n]; } }
        asm volatile("" ::: "memory"); }
  }
};

#include <hip/hip_bf16.h>
#include <cmath>
namespace attn_body {
using bf16=__hip_bfloat16;
using bf16x8=__attribute__((ext_vector_type(8)))short;
using s16x4=__attribute__((ext_vector_type(4)))short;
using f32x16=__attribute__((ext_vector_type(16)))float;
using u32x4=__attribute__((ext_vector_type(4)))unsigned;
constexpr int D=64,QP=512,KP=512,VP=512,OP=1024;
constexpr int NW=8,QBLK=32,QB=QBLK*NW,KVBLK=64;
constexpr int ATTN_UNIT_ROWS=QB;
__device__ __forceinline__ int crow(int r,int hi){return (r&3)+8*(r>>2)+4*hi;}
#define SBAR() __builtin_amdgcn_sched_barrier(0)
__device__ __forceinline__ void cmask(f32x16&p0,f32x16&p1,int jb,int qrel,int hi){
  const float NEG=-INFINITY; int kb=64*jb+4*hi;
  #pragma unroll
  for(int r=0;r<16;++r){int kv=kb+(r&3)+8*(r>>2); if(kv>qrel)p0[r]=NEG; if(kv+32>qrel)p1[r]=NEG;}
}

constexpr int NSLOT=3, SLOTB=8192;
constexpr int LDS_K=0, LDS_V=NSLOT*SLOTB, LDS_WS=2*NSLOT*SLOTB, LDS_OST=LDS_WS+NW*64*4, LDS_BYTES=LDS_OST+NW*4096;
constexpr float C2=0.125f*1.4426950408889634f;
__device__ __forceinline__ void glds16(const void*gsrc,unsigned lds_dst){unsigned keep;
  asm volatile("s_mov_b32 %0, m0\n\ts_mov_b32 m0, %2\n\ts_nop 0\n\tglobal_load_lds_dwordx4 %1, off\n\ts_mov_b32 m0, %0":"=&s"(keep):"v"(gsrc),"s"(lds_dst):"memory");}
__device__ __forceinline__ float max3f(float a,float b,float c){float r;asm("v_max3_f32 %0, %1, %2, %3":"=v"(r):"v"(a),"v"(b),"v"(c));return r;}
__device__ __forceinline__ float max2f(float a,float b){float r;asm("v_max_f32_e32 %0, %1, %2":"=v"(r):"v"(a),"v"(b));return r;}
__device__ __forceinline__ float fadd_s(float a,float b){float r;asm("v_add_f32_e32 %0, %1, %2":"=v"(r):"v"(a),"v"(b));return r;}
__device__ __forceinline__ float fsub_s(float a,float b){float r;asm("v_sub_f32_e32 %0, %1, %2":"=v"(r):"v"(a),"v"(b));return r;}
typedef float f32x2_t __attribute__((ext_vector_type(2))); typedef __bf16 bf16x2_t __attribute__((ext_vector_type(2)));
__device__ __forceinline__ unsigned cvtpk_s(float lo,float hi){f32x2_t v={lo,hi};bf16x2_t b=__builtin_convertvector(v,bf16x2_t);return __builtin_bit_cast(unsigned,b);}
#define WAIT_BAR(N) asm volatile("s_waitcnt vmcnt(" #N ") lgkmcnt(0)\n\ts_barrier":::"memory")

__device__ __forceinline__ void qkt(f32x16&p0,f32x16&p1,const char*Kslot,const bf16x8*qr,const f32x16&negm,int r32,int hi){
  const char*kb=Kslot+hi*1024+r32*16;
  #pragma unroll
  for(int d0=0;d0<4;++d0){
    const bf16x8 b0=*reinterpret_cast<const bf16x8*>(kb+d0*2048);
    const bf16x8 b1=*reinterpret_cast<const bf16x8*>(kb+d0*2048+512);
    if(d0==0){p0=__builtin_amdgcn_mfma_f32_32x32x16_bf16(b0,qr[0],negm,0,0,0);p1=__builtin_amdgcn_mfma_f32_32x32x16_bf16(b1,qr[0],negm,0,0,0);}
    else{p0=__builtin_amdgcn_mfma_f32_32x32x16_bf16(b0,qr[d0],p0,0,0,0);p1=__builtin_amdgcn_mfma_f32_32x32x16_bf16(b1,qr[d0],p1,0,0,0);}}
}
typedef __attribute__((address_space(3))) const char* lds_cptr;
typedef short v4i16_t __attribute__((ext_vector_type(4)));
__device__ __forceinline__ void kload8(bf16x8*kf,lds_cptr kp){
  kf[0]=*(const __attribute__((address_space(3))) bf16x8*)(kp);      kf[1]=*(const __attribute__((address_space(3))) bf16x8*)(kp+512);
  kf[2]=*(const __attribute__((address_space(3))) bf16x8*)(kp+2048); kf[3]=*(const __attribute__((address_space(3))) bf16x8*)(kp+2560);
  kf[4]=*(const __attribute__((address_space(3))) bf16x8*)(kp+4096); kf[5]=*(const __attribute__((address_space(3))) bf16x8*)(kp+4608);
  kf[6]=*(const __attribute__((address_space(3))) bf16x8*)(kp+6144); kf[7]=*(const __attribute__((address_space(3))) bf16x8*)(kp+6656);
}
__device__ __forceinline__ void kload2(bf16x8*kf,lds_cptr kp,int j){ kf[2*j]=*(const __attribute__((address_space(3))) bf16x8*)(kp+j*2048); kf[2*j+1]=*(const __attribute__((address_space(3))) bf16x8*)(kp+j*2048+512); }
__device__ __forceinline__ s16x4 vtr(lds_cptr p){ return __builtin_bit_cast(s16x4,__builtin_amdgcn_ds_read_tr16_b64_v4i16((__attribute__((address_space(3))) v4i16_t*)p)); }
__device__ __forceinline__ float rowmax(const f32x16&p0,const f32x16&p1){
  float a=max3f(p0[0],p0[1],p1[0]),b=max3f(p0[2],p0[3],p1[1]);a=max3f(a,p1[2],p1[3]);
  #pragma unroll
  for(int r=4;r<16;r+=4){a=max3f(a,p0[r],p0[r+1]);b=max3f(b,p0[r+2],p0[r+3]);a=max3f(a,p1[r],p1[r+1]);b=max3f(b,p1[r+2],p1[r+3]);}
  const float m=max2f(a,b);
  auto rr=__builtin_amdgcn_permlane32_swap(__float_as_uint(m),__float_as_uint(m),false,false);
  return max2f(__uint_as_float(rr[0]),__uint_as_float(rr[1]));
}
__device__ __forceinline__ void pv(f32x16*o,int vb,bf16x8 pa0,bf16x8 pa1,bf16x8 pa2,bf16x8 pa3){
  #pragma unroll
  for(int d0=0;d0<2;++d0){s16x4 lo[4],hi[4];
    #pragma unroll
    for(int ks=0;ks<4;++ks){
      asm volatile("ds_read_b64_tr_b16 %0,%1 offset:%c2":"=&v"(lo[ks]):"v"(vb),"i"(d0*4096+ks*1024):"memory");
      asm volatile("ds_read_b64_tr_b16 %0,%1 offset:%c2":"=&v"(hi[ks]):"v"(vb),"i"(d0*4096+ks*1024+512):"memory");}
    asm volatile("s_waitcnt lgkmcnt(0)":::"memory");SBAR();
    #define PK(k) (bf16x8){lo[k][0],lo[k][1],lo[k][2],lo[k][3],hi[k][0],hi[k][1],hi[k][2],hi[k][3]}
    o[d0]=__builtin_amdgcn_mfma_f32_32x32x16_bf16(pa0,PK(0),o[d0],0,0,0);
    o[d0]=__builtin_amdgcn_mfma_f32_32x32x16_bf16(pa1,PK(1),o[d0],0,0,0);
    o[d0]=__builtin_amdgcn_mfma_f32_32x32x16_bf16(pa2,PK(2),o[d0],0,0,0);
    o[d0]=__builtin_amdgcn_mfma_f32_32x32x16_bf16(pa3,PK(3),o[d0],0,0,0);
    #undef PK
  }
}

#ifndef ATTN_STORE16
#define ATTN_STORE16(p,v) (*(u32x4*)(p)=(v))
#endif
template<int THRL> __device__ __forceinline__ void attn_unit(const bf16*Qu,const bf16*__restrict__ Kh,const bf16*__restrict__ Vh,bf16*Ou,const int NT,char*shm){
  const int tid=opq_v((int)threadIdx.x),lane=tid&63,r32=lane&31,hi=lane>>5; const int wid=__builtin_amdgcn_readfirstlane(tid>>6);
  const bf16*Qw=Qu+(long)(wid*QBLK)*QP;
  const unsigned lds0=(unsigned)(uintptr_t)shm;
  float*wsf=(float*)(shm+LDS_WS)+wid*64;
  const bf16*ksrc=Kh+(long)lane*KP+wid*8;
  const bf16*vsrc=Vh+(long)(16*(wid&3)+(lane>>2))*VP+(wid>>2)*32+(lane&3)*8;
  const unsigned kdst=lds0+LDS_K+wid*1024, vdst=lds0+LDS_V+wid*1024;
  #define DMA_K(t,slot) glds16(ksrc+(long)(t)*KVBLK*KP,(unsigned)__builtin_amdgcn_readfirstlane(kdst+(slot)))
  #define DMA_V(t,slot) glds16(vsrc+(long)(t)*KVBLK*VP,(unsigned)__builtin_amdgcn_readfirstlane(vdst+(slot)))
  const int vb0=(int)(lds0+LDS_V)+((lane>>4)&1)*32+(lane&3)*8+(4*hi+((lane&15)>>2))*64;
  const char*Kbase=shm+LDS_K; bf16x8 kf[8];
  const lds_cptr shm3=(lds_cptr)shm; const lds_cptr kp0=shm3+LDS_K+hi*1024+r32*16; const lds_cptr vp0=shm3+LDS_V+((lane>>4)&1)*32+(lane&3)*8+(4*hi+((lane&15)>>2))*64;
  DMA_K(0,0);DMA_V(0,0);DMA_K(1,SLOTB);
  bf16x8 qr[4];
  #pragma unroll
  for(int d0=0;d0<4;++d0)qr[d0]=*reinterpret_cast<const bf16x8*>(&Qw[(long)r32*QP+d0*16+hi*8]);
  float mhat=0.f,l_reg=0.f;float z0_=0.f;asm volatile("":"+v"(z0_));f32x16 o[2];f32x16 negm;
  _Pragma("unroll") for(int r=0;r<16;++r){o[0][r]=z0_;o[1][r]=z0_;negm[r]=z0_;} asm volatile("":"+v"(negm));
  #define CMASK(P0,P1,t) do{}while(0)
  bool resc=false;
  #define START(P0,P1) do{ const float rm=rowmax(P0,P1); resc=false; \
    { const float dl=rm; mhat=fadd_s(mhat,dl); \
      _Pragma("unroll") for(int r=0;r<16;++r){P0[r]=fsub_s(P0[r],dl);P1[r]=fsub_s(P1[r],dl);} \
      _Pragma("unroll") for(int r=0;r<16;++r)negm[r]=-mhat; asm volatile("":"+v"(negm)); } \
    _Pragma("unroll") for(int r=0;r<16;++r)P0[r]=__builtin_amdgcn_exp2f(P0[r]); }while(0)
  #define RESC() do{ if(resc){ asm volatile("s_waitcnt lgkmcnt(0)":::"memory"); \
      _Pragma("unroll") for(int d_=0;d_<2;++d_) _Pragma("unroll") for(int r=0;r<16;++r)o[d_][r]*=wsf[crow(r,hi)]; } }while(0)
  f32x16 pA0,pA1,pB0,pB1;
  int sl_prev=0,sl_cur=0,sl_next=SLOTB;
  #define ROT() do{sl_prev=sl_cur;sl_cur=sl_next;sl_next=(sl_next==(NSLOT-1)*SLOTB)?0:sl_next+SLOTB;}while(0)
  DMA_K(2,2*SLOTB);
  WAIT_BAR(3);
  qkt(pA0,pA1,Kbase,qr,negm,r32,hi);asm volatile("s_nop 15\n\ts_nop 7":"+v"(pA0),"+v"(pA1));CMASK(pA0,pA1,0);
  START(pA0,pA1);
  _Pragma("unroll") for(int r=0;r<16;++r)pA1[r]=__builtin_amdgcn_exp2f(pA1[r]);
  WAIT_BAR(0);
  DMA_K(3,0);DMA_V(1,SLOTB);
  ROT();
  kload8(kf,kp0+sl_cur);
  WAIT_BAR(2);
  s16x4 vlo[8],vhi[8]; u32x4 pw0,pw1,pw2,pw3;
  #define PKW(P,B) cvtpk_s(P[B],P[B+1])
  #define PAF(k) __builtin_bit_cast(bf16x8,pw##k)
  #define VFR(i) (bf16x8){vlo[i][0],vlo[i][1],vlo[i][2],vlo[i][3],vhi[i][0],vhi[i][1],vhi[i][2],vhi[i][3]}
  #define PIN(x) asm volatile("":"+v"(x))
  #define MX3(a,b,c) __builtin_fmaxf(__builtin_fmaxf((a),(b)),(c))
  #define GAPA(MF,A0,A1,A2,A3,W0,W1,PW) do{ MF; sacc+=A0; sacc+=A1; sacc+=A2; sacc+=A3; PIN(sacc); W0; W1; PIN(PW); SBAR(); }while(0)
  #define EX(v) __builtin_amdgcn_exp2f(v)
  #define GAPB(MF,X,B) do{ MF; X[B]=EX(X[B]); X[B+1]=EX(X[B+1]); X[B+2]=EX(X[B+2]); X[B+3]=EX(X[B+3]); PIN(X); SBAR(); }while(0)
  #define VRD(i) do{ vlo[i]=vtr(vp_+(((i)>>2)*4096+((i)&3)*1024)); vhi[i]=vtr(vp_+(((i)>>2)*4096+((i)&3)*1024+512)); }while(0)
  #define KRD(G,j) do{ if(G){ kload2(kf,kp0+sl_next,j); SBAR(); } }while(0)
  #define STEP(C0,C1,P0,P1,t,GK,GV,GL) do{ SBAR(); \
    const lds_cptr vp_=vp0+sl_prev; \
    VRD(0); SBAR(); float sacc=(P0[0]+P0[1]); \
    GAPA(C0=__builtin_amdgcn_mfma_f32_32x32x16_bf16(kf[0],qr[0],negm,0,0,0), P0[2],P0[3],P0[4],P0[5],     pw0[0]=PKW(P0,0), pw0[1]=PKW(P0,2), pw0); \
    VRD(4); SBAR(); GAPA(C1=__builtin_amdgcn_mfma_f32_32x32x16_bf16(kf[1],qr[0],negm,0,0,0), P0[6],P0[7],P0[8],P0[9],     pw0[2]=PKW(P0,4), pw0[3]=PKW(P0,6), pw0); \
    VRD(1); SBAR(); GAPA(C0=__builtin_amdgcn_mfma_f32_32x32x16_bf16(kf[2],qr[1],C0,0,0,0),   P0[10],P0[11],P0[12],P0[13], pw1[0]=PKW(P0,8), pw1[1]=PKW(P0,10), pw1); \
    VRD(5); SBAR(); GAPA(C1=__builtin_amdgcn_mfma_f32_32x32x16_bf16(kf[3],qr[1],C1,0,0,0),   P0[14],P0[15],P1[0],P1[1],   pw1[2]=PKW(P0,12),pw1[3]=PKW(P0,14), pw1); \
    VRD(2); SBAR(); GAPA(C0=__builtin_amdgcn_mfma_f32_32x32x16_bf16(kf[4],qr[2],C0,0,0,0),   P1[2],P1[3],P1[4],P1[5],     pw2[0]=PKW(P1,0), pw2[1]=PKW(P1,2), pw2); \
    VRD(6); SBAR(); GAPA(C1=__builtin_amdgcn_mfma_f32_32x32x16_bf16(kf[5],qr[2],C1,0,0,0),   P1[6],P1[7],P1[8],P1[9],     pw2[2]=PKW(P1,4), pw2[3]=PKW(P1,6), pw2); \
    VRD(3); SBAR(); GAPA(C0=__builtin_amdgcn_mfma_f32_32x32x16_bf16(kf[6],qr[3],C0,0,0,0),   P1[10],P1[11],P1[12],P1[13], pw3[0]=PKW(P1,8), pw3[1]=PKW(P1,10), pw3); \
    VRD(7); SBAR(); GAPA(C1=__builtin_amdgcn_mfma_f32_32x32x16_bf16(kf[7],qr[3],C1,0,0,0),   P1[14],P1[15],0.f,0.f,       pw3[2]=PKW(P1,12),pw3[3]=PKW(P1,14), pw3); \
    l_reg+=sacc; \
    if(GK){DMA_K((t)+3,sl_cur);} if(GV){DMA_V((t)+1,sl_next);} \
    CMASK(C0,C1,t); \
    { float a=MX3(C0[0],C0[1],C1[0]),b=MX3(C0[2],C0[3],C1[1]); a=MX3(a,C1[2],C1[3]); \
      _Pragma("unroll") for(int r=4;r<16;r+=4){a=MX3(a,C0[r],C0[r+1]);b=MX3(b,C0[r+2],C0[r+3]);a=MX3(a,C1[r],C1[r+1]);b=MX3(b,C1[r+2],C1[r+3]);} \
      float rm=__builtin_fmaxf(a,b); { auto rr=__builtin_amdgcn_permlane32_swap(__float_as_uint(rm),__float_as_uint(rm),false,false); rm=__builtin_fmaxf(__uint_as_float(rr[0]),__uint_as_float(rr[1])); } \
      resc=false; \
      if(__builtin_expect(__any(rm>(float)THRL),0)){ const float dl=__builtin_fmaxf(rm,0.f); mhat+=dl; \
        _Pragma("unroll") for(int r=0;r<16;++r){C0[r]-=dl;C1[r]-=dl;} \
        _Pragma("unroll") for(int r=0;r<16;++r)negm[r]=-mhat; asm volatile("":"+v"(negm)); \
        const float f=__builtin_amdgcn_exp2f(-dl); l_reg*=f; if(hi==0)wsf[r32]=f; resc=true; } } \
    SBAR(); \
    GAPB(o[0]=__builtin_amdgcn_mfma_f32_32x32x16_bf16(PAF(0),VFR(0),o[0],0,0,0), C0,0); \
    GAPB(o[1]=__builtin_amdgcn_mfma_f32_32x32x16_bf16(PAF(0),VFR(4),o[1],0,0,0), C0,4); \
    KRD(GL,0); GAPB(o[0]=__builtin_amdgcn_mfma_f32_32x32x16_bf16(PAF(1),VFR(1),o[0],0,0,0), C0,8); \
    KRD(GL,1); GAPB(o[1]=__builtin_amdgcn_mfma_f32_32x32x16_bf16(PAF(1),VFR(5),o[1],0,0,0), C0,12); \
    KRD(GL,2); GAPB(o[0]=__builtin_amdgcn_mfma_f32_32x32x16_bf16(PAF(2),VFR(2),o[0],0,0,0), C1,0); \
    KRD(GL,3); GAPB(o[1]=__builtin_amdgcn_mfma_f32_32x32x16_bf16(PAF(2),VFR(6),o[1],0,0,0), C1,4); \
    GAPB(o[0]=__builtin_amdgcn_mfma_f32_32x32x16_bf16(PAF(3),VFR(3),o[0],0,0,0), C1,8); \
    GAPB(o[1]=__builtin_amdgcn_mfma_f32_32x32x16_bf16(PAF(3),VFR(7),o[1],0,0,0), C1,12); \
    }while(0)
  int t=1;
  for(;t+5<NT;t+=2){
    STEP(pB0,pB1,pA0,pA1,t,true,true,true);     WAIT_BAR(2); RESC(); ROT();
    STEP(pA0,pA1,pB0,pB1,t+1,true,true,true);   WAIT_BAR(2); RESC(); ROT();
  }
  #define ENDW(tt) do{ if((tt)+3<NT){WAIT_BAR(2);} else if((tt)+2<NT){WAIT_BAR(1);} else {WAIT_BAR(0);} }while(0)
  for(;t+1<NT;t+=2){
    STEP(pB0,pB1,pA0,pA1,t,(t+3<NT),(t+1<NT),(t+1<NT));       ENDW(t);   RESC(); ROT();
    STEP(pA0,pA1,pB0,pB1,t+1,(t+4<NT),(t+2<NT),(t+2<NT));     ENDW(t+1); RESC(); ROT();
  }
  STEP(pB0,pB1,pA0,pA1,NT-1,false,false,false); RESC();
  { float sacc=pB0[0]+pB0[1]; _Pragma("unroll") for(int r=2;r<16;++r)sacc+=pB0[r]; _Pragma("unroll") for(int r=0;r<16;++r)sacc+=pB1[r]; l_reg+=sacc;
    pw0=(u32x4){PKW(pB0,0),PKW(pB0,2),PKW(pB0,4),PKW(pB0,6)};pw1=(u32x4){PKW(pB0,8),PKW(pB0,10),PKW(pB0,12),PKW(pB0,14)};pw2=(u32x4){PKW(pB1,0),PKW(pB1,2),PKW(pB1,4),PKW(pB1,6)};pw3=(u32x4){PKW(pB1,8),PKW(pB1,10),PKW(pB1,12),PKW(pB1,14)};
    SBAR(); pv(o,vb0+sl_cur,PAF(0),PAF(1),PAF(2),PAF(3)); }
  #undef PKW
  #undef PAF
  #undef VFR
  #undef PIN
  #undef MX3
  #undef GAPA
  #undef GAPB
  #undef EX
  #undef VRD
  #undef KRD
  #undef STEP
  #undef ENDW
  {auto rr=__builtin_amdgcn_permlane32_swap(__float_as_uint(l_reg),__float_as_uint(l_reg),false,false);l_reg=__uint_as_float(rr[0])+__uint_as_float(rr[1]);}
  if(hi==0)wsf[32+r32]=l_reg;asm volatile("s_waitcnt lgkmcnt(0)":::"memory");
  float rli[16];
  #pragma unroll
  for(int r=0;r<16;++r)rli[r]=__builtin_amdgcn_rcpf(wsf[32+crow(r,hi)]);
  bf16*Ow=Ou+(long)(wid*QBLK)*OP;
  { bf16*stg=(bf16*)(shm+LDS_OST)+wid*2048;
    #pragma unroll
    for(int r=0;r<16;++r){const int orow=crow(r,hi);
      #pragma unroll
      for(int d0=0;d0<2;++d0)stg[orow*64+d0*32+r32]=__float2bfloat16(o[d0][r]*rli[r]);}
    asm volatile("s_waitcnt lgkmcnt(0)":::"memory");
    #pragma unroll
    for(int i=0;i<4;++i){const int row=i*8+(lane>>3),ch=lane&7; const u32x4 v=*(const u32x4*)(stg+row*64+ch*8); ATTN_STORE16(Ow+(long)row*OP+ch*8,v);} }
  asm volatile("s_waitcnt lgkmcnt(0)\n\ts_barrier":::"memory");
  #undef DMA_K
  #undef DMA_V
  #undef CMASK
  #undef START
  #undef RESC
  #undef ROT
}
constexpr int ATTN_LDS_BYTES=LDS_BYTES;
#undef SBAR
#undef WAIT_BAR
}


namespace hyf {
struct c32 { float x, y; };
typedef _Float16 h2 __attribute__((ext_vector_type(2)));
__device__ __forceinline__ c32 operator+(c32 a, c32 b) { return {a.x + b.x, a.y + b.y}; }
__device__ __forceinline__ c32 operator-(c32 a, c32 b) { return {a.x - b.x, a.y - b.y}; }
__device__ __forceinline__ c32 cmul(c32 a, c32 b) { return {a.x * b.x - a.y * b.y, a.x * b.y + a.y * b.x}; }
__device__ __forceinline__ constexpr float C32(int k) {
  switch (k) { case 0: return 1.f; case 1: return 0.98078528f; case 2: return 0.923879533f; case 3: return 0.831469612f; case 4: return 0.707106781f; case 5: return 0.555570233f; case 6: return 0.382683432f;
    case 7: return 0.195090322f; case 8: return 0.f; case 9: return -0.195090322f; case 10: return -0.382683432f; case 11: return -0.555570233f; case 12: return -0.707106781f; case 13: return -0.831469612f;
    case 14: return -0.923879533f; default: return -0.98078528f; } }
__device__ __forceinline__ constexpr float S32(int k) {
  switch (k) { case 0: return 0.f; case 1: return 0.195090322f; case 2: return 0.382683432f; case 3: return 0.555570233f; case 4: return 0.707106781f; case 5: return 0.831469612f; case 6: return 0.923879533f;
    case 7: return 0.98078528f; case 8: return 1.f; case 9: return 0.98078528f; case 10: return 0.923879533f; case 11: return 0.831469612f; case 12: return 0.707106781f; case 13: return 0.555570233f;
    case 14: return 0.382683432f; default: return 0.195090322f; } }
__device__ __forceinline__ constexpr int brev(int q, int bits) {
  return bits == 4 ? (((q & 1) << 3) | ((q & 2) << 1) | ((q & 4) >> 1) | ((q & 8) >> 3))
                   : (((q & 1) << 4) | ((q & 2) << 2) | (q & 4) | ((q & 8) >> 2) | ((q & 16) >> 4)); }
__device__ __forceinline__ int phys(int p) { return p + (p >> 5); }
template <int R, int HALF, bool INV> struct DftStage {
  static __device__ __forceinline__ void run(c32 (&x)[R]) {
#pragma unroll
    for (int blk = 0; blk < R; blk += 2 * HALF) {
#pragma unroll
      for (int j = 0; j < HALF; ++j) {
        const c32 a = x[blk + j], b = x[blk + j + HALF]; x[blk + j] = a + b; const c32 d = a - b;
        const int e = j * (R / (2 * HALF)) * (32 / R);
        if (e == 0) x[blk + j + HALF] = d;
        else if (e == 8) x[blk + j + HALF] = INV ? (c32){-d.y, d.x} : (c32){d.y, -d.x};
        else { const c32 wv = {C32(e), INV ? S32(e) : -S32(e)}; x[blk + j + HALF] = cmul(d, wv); }
      } }
    DftStage<R, HALF / 2, INV>::run(x);
  }
};
template <int R, bool INV> struct DftStage<R, 0, INV> { static __device__ __forceinline__ void run(c32 (&)[R]) {} };
template <int R, bool INV> __device__ __forceinline__ void dft_pow2(c32 (&x)[R]) { DftStage<R, R / 2, INV>::run(x); }
template <int R, int HALF> struct DitStage {
  static __device__ __forceinline__ void run(c32 (&x)[R]) {
#pragma unroll
    for (int blk = 0; blk < R; blk += 2 * HALF) {
#pragma unroll
      for (int j = 0; j < HALF; ++j) {
        const int e = j * (R / (2 * HALF)) * (32 / R);
        const c32 a = x[blk + j], b0 = x[blk + j + HALF];
        c32 b;
        if (e == 0) b = b0; else if (e == 8) b = (c32){-b0.y, b0.x}; else b = cmul(b0, (c32){C32(e), S32(e)});
        x[blk + j] = a + b; x[blk + j + HALF] = a - b;
      } }
    DitStage<R, HALF * 2>::run(x);
  }
};
template <int R> struct DitStage<R, R> { static __device__ __forceinline__ void run(c32 (&)[R]) {} };
template <int R> __device__ __forceinline__ void idft_dit(c32 (&x)[R]) { DitStage<R, 1>::run(x); }
template <int STRIDE, bool INV> __device__ __forceinline__ void pass16(c32* buf, int e0, float rev) {
  float rv = rev; asm volatile("" : "+v"(rv));
  const float cs = __builtin_amdgcn_cosf(rv), sn = __builtin_amdgcn_sinf(rv);
  const c32 w1 = {cs, INV ? sn : -sn};
  c32* p = buf + phys(e0); constexpr int PS = STRIDE + STRIDE / 32;
  c32 x[16];
  if (!INV) {
#pragma unroll
    for (int m = 0; m < 16; ++m) x[m] = p[PS * m];
    dft_pow2<16, false>(x);
    c32 w = w1; p[0] = x[0];
#pragma unroll
    for (int q = 1; q < 16; ++q) { p[PS * q] = cmul(x[brev(q, 4)], w); w = cmul(w, w1); }
  } else {
    c32 w = w1; x[0] = p[0];
#pragma unroll
    for (int q = 1; q < 16; ++q) { x[q] = cmul(p[PS * q], w); w = cmul(w, w1); }
    dft_pow2<16, true>(x);
#pragma unroll
    for (int m = 0; m < 16; ++m) p[PS * m] = x[brev(m, 4)];
  }
}
template <int MODE> __device__ __forceinline__ void mid32(c32* buf, h2* Hs, int j) {
  c32* p = buf + 33 * j; c32 x[32];
#pragma unroll
  for (int m = 0; m < 32; ++m) x[m] = p[m];
  dft_pow2<32, false>(x);
  if (MODE == 0) {
#pragma unroll
    for (int q = 0; q < 32; ++q) { const c32 v = x[brev(q, 5)]; Hs[q * 256 + j] = (h2){(_Float16)v.x, (_Float16)v.y}; }
  } else {
#pragma unroll
    for (int pp = 0; pp < 32; ++pp) { const h2 hv = Hs[brev(pp, 5) * 256 + j]; x[pp] = cmul(x[pp], (c32){(float)hv.x, (float)hv.y}); }
    idft_dit<32>(x);
#pragma unroll
    for (int m = 0; m < 32; ++m) p[m] = x[m];
  }
}
__device__ __forceinline__ void fwd2(c32* buf, int tid) {
  __syncthreads(); pass16<512, false>(buf, tid, (float)tid * (1.0f / 8192.0f));
  __syncthreads(); pass16<32, false>(buf, (tid >> 5) * 512 + (tid & 31), (float)(tid & 31) * (1.0f / 512.0f));
  __syncthreads();
}
__device__ __forceinline__ void conv(c32* buf, h2* Hs, int tid) {
  fwd2(buf, tid);
  if (tid < 256) mid32<1>(buf, Hs, tid);
  __syncthreads(); pass16<32, true>(buf, (tid >> 5) * 512 + (tid & 31), (float)(tid & 31) * (1.0f / 512.0f));
  __syncthreads(); pass16<512, true>(buf, tid, (float)tid * (1.0f / 8192.0f));
  __syncthreads();
}
__device__ __forceinline__ void item(int c, const bf16_t* HYT, const float* HK, const float* hy_bias, bf16_t* HYO, char* lds) {
  c32* buf = (c32*)lds; h2* H0 = (h2*)(lds + 67584); h2* H1 = H0 + 8192;
  const int tid = TIDX;
#pragma unroll 1
  for (int o = 0; o < 2; ++o) {
    const float* kp = HK + ((size_t)o * 256 + c) * 8192;
#pragma unroll
    for (int i = 0; i < 16; ++i) { const int n = tid + 512 * i; buf[phys(n)] = (c32){kp[n], 0.f}; }
    fwd2(buf, tid);
    if (tid < 256) mid32<0>(buf, o ? H1 : H0, tid);
    __syncthreads();
  }
  const float bias0 = hy_bias[c], bias1 = hy_bias[256 + c];
#pragma unroll 1
  for (int pr = 0; pr < 2; ++pr) {
    const bf16_t* v0 = HYT + ((size_t)(2 * pr) * 768 + c) * SEQ; const bf16_t* v1 = v0 + (size_t)768 * SEQ;
    c32 vv[8];
#pragma unroll
    for (int i = 0; i < 8; ++i) { const int t = tid + 512 * i; vv[i] = (c32){bf2f(v0[t]), bf2f(v1[t])}; buf[phys(t)] = vv[i]; buf[phys(t + 4096)] = (c32){0.f, 0.f}; }
    conv(buf, H0, tid);
#pragma unroll
    for (int i = 0; i < 8; ++i) { const int t = tid + 512 * i; const c32 y = buf[phys(t)];
      vv[i] = (c32){bf2f(v0[(size_t)256 * SEQ + t]) * (y.x * (1.0f / 8192.0f) + bias0 * vv[i].x), bf2f(v1[(size_t)256 * SEQ + t]) * (y.y * (1.0f / 8192.0f) + bias0 * vv[i].y)};
      buf[phys(t)] = vv[i]; buf[phys(t + 4096)] = (c32){0.f, 0.f}; }
    conv(buf, H1, tid);
#pragma unroll
    for (int i = 0; i < 8; ++i) { const int t = tid + 512 * i; const c32 y = buf[phys(t)];
      HYO[((size_t)(2 * pr) * 256 + c) * SEQ + t] = (bf16_t)f2bf(bf2f(v0[(size_t)512 * SEQ + t]) * (y.x * (1.0f / 8192.0f) + bias1 * vv[i].x));
      HYO[((size_t)(2 * pr + 1) * 256 + c) * SEQ + t] = (bf16_t)f2bf(bf2f(v1[(size_t)512 * SEQ + t]) * (y.y * (1.0f / 8192.0f) + bias1 * vv[i].y)); }
    __syncthreads();
  }
}
__device__ __forceinline__ void out_item(int it, const bf16_t* HYO, bf16_t* MIX, char* lds) {
  bf16_t (*T)[72] = (bf16_t (*)[72])lds;
  const int tid = TIDX, b = it >> 8, t0 = ((it >> 2) & 63) * 64, c0 = (it & 3) * 64;
  { const int cc = tid >> 3, t8 = (tid & 7) * 8; *(u32x4*)&T[cc][t8] = *(const u32x4*)(HYO + ((size_t)b * 256 + c0 + cc) * SEQ + t0 + t8); }
  __syncthreads();
  { const int tl = tid >> 3, c8 = (tid & 7) * 8; u32x4 o;
    o.x = (unsigned)T[c8][tl] | ((unsigned)T[c8 + 1][tl] << 16); o.y = (unsigned)T[c8 + 2][tl] | ((unsigned)T[c8 + 3][tl] << 16);
    o.z = (unsigned)T[c8 + 4][tl] | ((unsigned)T[c8 + 5][tl] << 16); o.w = (unsigned)T[c8 + 6][tl] | ((unsigned)T[c8 + 7][tl] << 16);
    *(u32x4*)(MIX + ((size_t)b * TPB + CTXL + t0 + tl) * DM + 768 + c0 + c8) = o; }
  __syncthreads();
}
}

#define LAS __attribute__((address_space(3)))
#define XB_TMO      128
#define XB_XCNT(j)  (256  + 64 * (j))
#define XB_XSUB(j)  (1280 + 64 * (j))
#define XB_XGEN(j)  (2304 + 64 * (j))
#define XB_TOP      3328
#define XB_TOPGEN   3392
#define XCD_BAR_WORDS 3456
#define XB_SPIN_CAP (1u << 18)

__device__ __forceinline__ unsigned xb_ld(unsigned* p)              { return __hip_atomic_load(p, __ATOMIC_RELAXED, __HIP_MEMORY_SCOPE_AGENT); }
__device__ __forceinline__ unsigned xb_add(unsigned* p, unsigned v) { return __hip_atomic_fetch_add(p, v, __ATOMIC_RELAXED, __HIP_MEMORY_SCOPE_AGENT); }
__device__ __forceinline__ unsigned xb_xcc_id() { return (unsigned)__builtin_amdgcn_s_getreg((3 << 11) | 20) & 0xFu; }
#define XB_SPIN(cond, bar) do { unsigned _sp = 0; while (cond) { __builtin_amdgcn_s_sleep(1); \
    if ((++_sp & 255u) == 0u) { if (xb_ld(&(bar)[XB_TMO])) break; if (_sp > XB_SPIN_CAP) { atomicAdd(&(bar)[XB_TMO], 1u); break; } } } } while (0)

struct XcdBarrier {
    unsigned* bar; unsigned x;
    volatile LAS unsigned* st;
};

__device__ __forceinline__ XcdBarrier xcd_barrier_post(unsigned* bar, volatile LAS unsigned* st) {
    XcdBarrier b; b.bar = bar; b.x = xb_xcc_id(); b.st = st;
    if (threadIdx.x == 0) (void)xb_add(&bar[XB_XCNT(b.x)], 1u);
    return b;
}
__device__ __forceinline__ void xcd_barrier_complete(unsigned* bar, unsigned x, unsigned& nloc, unsigned& nx) {
    const unsigned G = gridDim.x * gridDim.y * gridDim.z;
    unsigned sum, cnt, mine, sp = 0u;
    for (;;) {
        sum = 0u; cnt = 0u; mine = 0u;
#pragma unroll
        for (unsigned j = 0; j < 16; ++j) { const unsigned c = xb_ld(&bar[XB_XCNT(j)]); sum += c; cnt += (c > 0u) ? 1u : 0u; mine = (j == x) ? c : mine; }
        if (sum == G) break;
        __builtin_amdgcn_s_sleep(1);
        if ((++sp & 255u) == 0u) { if (xb_ld(&bar[XB_TMO])) break; if (sp > XB_SPIN_CAP) { atomicAdd(&bar[XB_TMO], 1u); break; } }
    }
    nloc = mine > 0u ? mine : 1u; nx = cnt > 0u ? cnt : 1u;
}

__device__ __forceinline__ void xcd_barrier(const XcdBarrier& b) {
    asm volatile("s_waitcnt vmcnt(0)" ::: "memory");
    __syncthreads();
    if (threadIdx.x == 0) {
        unsigned* bar = b.bar;
        __builtin_amdgcn_s_waitcnt(0);
        unsigned nloc = b.st[0], nx = b.st[1];
        if (nloc == 0u) { xcd_barrier_complete(bar, b.x, nloc, nx); b.st[0] = nloc; b.st[1] = nx; }
        const unsigned old = xb_add(&bar[XB_XSUB(b.x)], 1u);
        const unsigned gen = old / nloc;
        if (old + 1u == (gen + 1u) * nloc) {
            __builtin_amdgcn_fence(__ATOMIC_RELEASE, "agent");
            asm volatile("s_waitcnt vmcnt(0)" ::: "memory");
            const unsigned og = xb_add(&bar[XB_TOP], 1u);
            const unsigned tg = og / nx;
            if (og + 1u == (tg + 1u) * nx) xb_add(&bar[XB_TOPGEN], 1u);
            else XB_SPIN(xb_ld(&bar[XB_TOPGEN]) == tg, bar);
            __builtin_amdgcn_fence(__ATOMIC_ACQUIRE, "agent");
            xb_add(&bar[XB_XGEN(b.x)], 1u);
            asm volatile("s_waitcnt vmcnt(0)" ::: "memory");
        } else {
            XB_SPIN(xb_ld(&bar[XB_XGEN(b.x)]) == gen, bar);
            __builtin_amdgcn_fence(__ATOMIC_ACQUIRE, "agent");
            asm volatile("s_waitcnt vmcnt(0)" ::: "memory");
        }
    }
    __syncthreads();
}


struct MP { const float* in[33]; float* out; unsigned char* ws; };
typedef const float* const __attribute__((address_space(4))) * kargs_t;
#define KARGS() ({ kargs_t k_ = (kargs_t)__builtin_amdgcn_kernarg_segment_ptr(); asm volatile("" : "+s"(k_)); k_; })
#define WSP(K, off) ((unsigned char*)(K)[34] + (off))

__global__ void __launch_bounds__(NT, 2) mega(MP P) {
  cg::grid_group grid = cg::this_grid();
  extern __shared__ __attribute__((aligned(16))) char lds[];
  volatile LAS unsigned* xst = (volatile LAS unsigned*)(lds + LDS_BYTES - 16);
  if (threadIdx.x < 2) xst[threadIdx.x] = 0u;
  __syncthreads();
  { kargs_t K = KARGS(); (void)xcd_barrier_post((unsigned*)WSP(K, WS_CTL) + CT_BAR, xst); }
#define XBAR_HERE() do { kargs_t Kb_ = KARGS(); XcdBarrier xb_; xb_.bar = (unsigned*)WSP(Kb_, WS_CTL) + CT_BAR; xb_.x = xb_xcc_id(); xb_.st = (volatile LAS unsigned*)(lds + LDS_BYTES - 16); xcd_barrier(xb_); } while (0)
#define SEAM() XBAR_HERE()
  {
    kargs_t K = KARGS();
    st_adaln(K[1], K[3], K[4], K[5], (float*)WSP(K, WS_MODV), lds);
    st_rope((float*)WSP(K, WS_ROPE));
  }
  {
      kargs_t K = KARGS();
      st_weights(K[8], K[26], K[29], K[30], K[31], 0, (bf16_t*)WSP(K, WS_WIN), (bf16_t*)WSP(K, WS_WOUT), (bf16_t*)WSP(K, WS_WGU), (bf16_t*)WSP(K, WS_WD), lds);
    }
    { kargs_t K = KARGS(); const int bid = BIDX, G = GDIM;
      for (int it = bid; it < SEQ / 16; it += G) hyfilt_item<SEQ>(it, K[19] + 0 * 33 * 64, K[20] + 0 * 64, K[21] + 0 * 64, K[22] + 0 * 4096, K[23] + 0 * 64, K[24] + (size_t)0 * 65536, (float*)WSP(K, WS_HK), lds);
      if (true) for (int it = bid; it < CTXL / 16; it += G) hyfilt_item<CTXL>(it, K[19] + 0 * 33 * 64, K[20] + 0 * 64, K[21] + 0 * 64, K[22] + 0 * 4096, K[23] + 0 * 64, K[24] + (size_t)0 * 65536, (float*)WSP(K, WS_HKC), lds);
    }
  if (gridDim.x == 0x7fffffffu) grid.sync();
  XBAR_HERE();
#pragma nounroll
  for (int layer = 0; layer < 2; ++layer) {
    const bool last = layer == 1;
    if (layer == 1) {
    {
      kargs_t K = KARGS();
      st_weights(K[8], K[26], K[29], K[30], K[31], layer, (bf16_t*)WSP(K, WS_WIN), (bf16_t*)WSP(K, WS_WOUT), (bf16_t*)WSP(K, WS_WGU), (bf16_t*)WSP(K, WS_WD), lds);
    }
    { kargs_t K = KARGS(); const int bid = BIDX, G = GDIM;
      for (int it = bid; it < SEQ / 16; it += G) hyfilt_item<SEQ>(it, K[19] + layer * 33 * 64, K[20] + layer * 64, K[21] + layer * 64, K[22] + layer * 4096, K[23] + layer * 64, K[24] + (size_t)layer * 65536, (float*)WSP(K, WS_HK), lds);
      if (!last) for (int it = bid; it < CTXL / 16; it += G) hyfilt_item<CTXL>(it, K[19] + layer * 33 * 64, K[20] + layer * 64, K[21] + layer * 64, K[22] + layer * 4096, K[23] + layer * 64, K[24] + (size_t)layer * 65536, (float*)WSP(K, WS_HKC), lds);
    }
    }
    { kargs_t K = KARGS();
      const float* xl_src = layer == 0 ? K[0] : K[33]; const float* xc_src = layer == 0 ? K[2] : (const float*)WSP(K, WS_XC);
      st_normmod(xl_src, xc_src, K[6] + layer * 1024, (const float*)WSP(K, WS_MODV) + (size_t)layer * 5 * 6144, 0, 1024, (bf16_t*)WSP(K, WS_H), lds);
    }
    SEAM();
    {
      kargs_t K = KARGS();
      pg8::Gemm g{1024, 1024, 1024}; SchedDense S{MTOK / 256, NPAD / 256, (int)GDIM, BIDX, 0, (const char*)WSP(K, WS_H), (const char*)WSP(K, WS_WIN), (size_t)256 * 1024 * 2, (size_t)256 * 1024 * 2};
      EpiInProj E{(bf16_t*)WSP(K, WS_QK), (bf16_t*)WSP(K, WS_VZ), (bf16_t*)WSP(K, WS_XBC), (bf16_t*)WSP(K, WS_HY), (float*)WSP(K, WS_DT)};
      pg8::gemm_phase<EpiInProj, SchedDense, true, true>((PG8_LAS unsigned char*)lds, g, S, E);
    }
    SEAM();
    {
      kargs_t K = KARGS();
      st_prep_qk((bf16_t*)WSP(K, WS_QK), K[9] + layer * 64, K[10] + layer * 64, (const float*)WSP(K, WS_ROPE));
    }
    { kargs_t K = KARGS();
      st_prep_hy((const bf16_t*)WSP(K, WS_HY), K[17] + layer * 3 * 768, K[18] + layer * 768, (bf16_t*)WSP(K, WS_HYT), last ? 0 : 1, lds);
    }
    { kargs_t K = KARGS();
      st_ssd1(BIDX, GDIM, 4 * 34 * 6, (const bf16_t*)WSP(K, WS_XBC), (const float*)WSP(K, WS_DT), K[11] + layer * 3 * 640, K[12] + layer * 640, K[13] + layer * 12, K[14] + layer * 12,
              (float*)WSP(K, WS_Y), (float*)WSP(K, WS_ST), (float*)WSP(K, WS_DEC), lds);
    }
    SEAM();
    {
      { kargs_t K2 = KARGS(); st_ssd_scan2((float*)WSP(K2, WS_ST), (const float*)WSP(K2, WS_DEC)); }
      const int bid = BIDX, G = GDIM;
#define P4_ATT(bb, hq, qrow_, nt_) do { kargs_t K = KARGS(); const int kvh_ = (hq) / 3; \
          const attn_body::bf16* QKp = (const attn_body::bf16*)WSP(K, WS_QK); const attn_body::bf16* VZp = (const attn_body::bf16*)WSP(K, WS_VZ); \
          attn_body::attn_unit<8>(QKp + (size_t)(qrow_) * 512 + (hq) * 64, QKp + (size_t)(bb) * TPB * 512 + 384 + kvh_ * 64, VZp + (size_t)(bb) * TPB * 512 + kvh_ * 64, \
                                  (attn_body::bf16*)WSP(K, WS_H) + (size_t)(qrow_) * 1024 + (hq) * 64, (nt_), lds); } while (0)
#define P4_FFT(cch) do { kargs_t K = KARGS(); hyf::item((cch), (const bf16_t*)WSP(K, WS_HYT), (const float*)WSP(K, WS_HK), K[25] + layer * 512, (bf16_t*)WSP(K, WS_HY), lds); } while (0)
#define P4_CHY(itm) do { kargs_t K = KARGS(); hyconv_ctx_item((itm), (const bf16_t*)WSP(K, WS_HYT) + (size_t)4 * 768 * SEQ, (const float*)WSP(K, WS_HKC), K[25] + layer * 512, (bf16_t*)WSP(K, WS_H), lds); } while (0)
      {
        const int x = bid & 7, y = bid >> 3, bb = x >> 1, kvh = x & 1;
        const int nun = y < 16 ? 2 : 1, natt = nun + ((!last && y < 3) ? 1 : 0);
#pragma unroll 1
        for (int k = 0; k < natt; ++k) { int hq, qrow, nt;
          if (k < nun) { const int v = y < 16 ? y + 16 * k : 16 + y; hq = 3 * kvh + (v >> 4); qrow = bb * TPB + CTXL + (v & 15) * 256; nt = TPB / 64; }
          else { hq = 3 * kvh + y; qrow = bb * TPB; nt = CTXL / 64; }
          P4_ATT(bb, hq, qrow, nt); }
        if (y >= 16) {
#pragma unroll 1
          for (int k = 0; k < 2; ++k) { const int cch = ((y - 16) * 8 + x) * 2 + k; P4_FFT(cch); } }
        if (!last && y >= 3 && y < 11) { P4_CHY((y - 3) * 8 + x); }
      }
      (void)G;
#undef P4_ATT
#undef P4_FFT
#undef P4_CHY
    }
    SEAM();
    {
      kargs_t K = KARGS();
      { const int bid = BIDX, G = GDIM, nit = last ? 4 * 32 * 2 : 4 * 34 * 2;
        for (int it = bid; it < nit; it += G) { const int g = it & 1, bc = it >> 1; const int b = last ? bc >> 5 : bc / 34, cidx = last ? 2 + (bc & 31) : bc % 34;
          ssd3_item(b, cidx, g, (const bf16_t*)WSP(K, WS_XBC), (const bf16_t*)WSP(K, WS_VZ), (const float*)WSP(K, WS_DT), K[11] + layer * 3 * 640, K[12] + layer * 640, K[13] + layer * 12, K[14] + layer * 12,
                    K[15] + layer * 6, K[16] + layer * 384, (const float*)WSP(K, WS_Y), (const float*)WSP(K, WS_ST), (bf16_t*)WSP(K, WS_H), lds); } }
      { const int bid = BIDX, G = GDIM; for (int it = bid; it < 1024; it += G) hyf::out_item(it, (const bf16_t*)WSP(K, WS_HY), (bf16_t*)WSP(K, WS_H), lds); }
      const int t = TIDX; if (BIDX == 0 && t < 256) ((int*)WSP(K, WS_CTL))[t] = 0;
      { int* stok = (int*)WSP(K, WS_MOEM + 384 * 1024); for (int i = BIDX * NT + t; i < MOE_ROWS; i += GDIM * NT) stok[i] = -1; }
    }
    SEAM();
    {
      kargs_t K = KARGS();
      const float* xl_src = layer == 0 ? K[0] : K[33]; const float* xc_src = layer == 0 ? K[2] : (const float*)WSP(K, WS_XC);
      pg8::Gemm g{1024, 1024, 1024}; SchedDense S{last ? 64 : 68, 4, (int)GDIM, BIDX, last ? 1 : 0, (const char*)WSP(K, WS_H), (const char*)WSP(K, WS_WOUT), (size_t)256 * 1024 * 2, (size_t)256 * 1024 * 2};
      EpiOutProj E{(bf16_t*)WSP(K, WS_QK)};
      pg8::gemm_phase<EpiOutProj, SchedDense, true, true>((PG8_LAS unsigned char*)lds, g, S, E);
    }
    SEAM();
    {
      kargs_t K = KARGS();
      st_router(layer == 0 ? K[0] : K[33], layer == 0 ? K[2] : (const float*)WSP(K, WS_XC), (float*)K[33], (float*)WSP(K, WS_XC), (const bf16_t*)WSP(K, WS_QK), K[7] + layer * 1024, (const float*)WSP(K, WS_MODV) + (size_t)layer * 5 * 6144, K[27], K[28], (bf16_t*)WSP(K, WS_H), (int*)WSP(K, WS_CTL),
                (int*)WSP(K, WS_MOEM), (float*)WSP(K, WS_MOEM + 128 * 1024), last ? 1 : 0, lds);
    }
    SEAM();
    { kargs_t K = KARGS();
      st_moe_gather((const bf16_t*)WSP(K, WS_H), (bf16_t*)WSP(K, WS_H2S), (int*)WSP(K, WS_CTL), (const int*)WSP(K, WS_MOEM), (const float*)WSP(K, WS_MOEM + 128 * 1024),
                    (int*)WSP(K, WS_MOEM + 384 * 1024), (float*)WSP(K, WS_MOEM + 512 * 1024), last ? 1 : 0, lds);
    }
    SEAM();
    { kargs_t K = KARGS();
      pg8::Gemm g{1024, 1024, 1024}; SchedMoe S{(int)GDIM, BIDX, 1, (const int*)WSP(K, WS_CTL), (const char*)WSP(K, WS_H2S), (size_t)256 * 1024 * 2, (const char*)WSP(K, WS_WGU)};
      EpiMoe1 E{(bf16_t*)WSP(K, WS_ACT), (const float*)WSP(K, WS_MOEM + 512 * 1024)};
      pg8::gemm_phase<EpiMoe1, SchedMoe, true, true>((PG8_LAS unsigned char*)lds, g, S, E);
    }
    SEAM();
    { kargs_t K = KARGS();
      pg8::Gemm g{256, 512, 256}; SchedMoe S{(int)GDIM, BIDX, 2, (const int*)WSP(K, WS_CTL), (const char*)WSP(K, WS_ACT), (size_t)256 * 512 * 2, (const char*)WSP(K, WS_WD)};
      EpiMoe2 E{(float*)K[33], (float*)WSP(K, WS_XC), (const float*)WSP(K, WS_MODV) + (size_t)layer * 5 * 6144 + 5120, (const int*)WSP(K, WS_MOEM + 384 * 1024)};
      pg8::gemm_phase<EpiMoe2, SchedMoe, true, true>((PG8_LAS unsigned char*)lds, g, S, E);
    }
    SEAM();
  }
  { kargs_t K = KARGS(); st_final((float*)K[33], K[32]); }
}

extern "C" void kernel_launch(void* const* d_in, const int* in_sizes, int n_in, void* d_out, int out_size, void* d_ws, size_t ws_size, hipStream_t stream) {
  if (n_in != 33 || ws_size < WS_END) { fprintf(stderr, "kernel_launch: unexpected n_in %d / ws %zu\n", n_in, ws_size); return; }
  static int grid_blocks = 0;
  if (!grid_blocks) {
    int dev = 0, cus = 0, per_cu = 0;
    (void)hipGetDevice(&dev);
    (void)hipDeviceGetAttribute(&cus, hipDeviceAttributeMultiprocessorCount, dev);
    (void)hipFuncSetAttribute((const void*)mega, hipFuncAttributeMaxDynamicSharedMemorySize, LDS_BYTES);
    (void)hipOccupancyMaxActiveBlocksPerMultiprocessor(&per_cu, mega, NT, LDS_BYTES);
    if (per_cu < 1) per_cu = 1;
    if (per_cu > 2) per_cu = 2;
    grid_blocks = 256;
    if (cus != 256 || per_cu < 1) fprintf(stderr, "kernel_launch: expected 256 CUs with >= 1 workgroup each (got %d CUs, %d per CU)\n", cus, per_cu);
  }
  (void)hipMemsetAsync((char*)d_ws + WS_CTL + (size_t)CT_BAR * 4, 0, (size_t)XCD_BAR_WORDS * 4, stream);
  MP p{};
  for (int i = 0; i < 33; ++i) p.in[i] = (const float*)d_in[i];
  p.out = (float*)d_out; p.ws = (unsigned char*)d_ws;
  void* args[] = {&p};
  hipError_t e = hipLaunchCooperativeKernel((const void*)mega, dim3(grid_blocks), dim3(NT), args, LDS_BYTES, stream);
  if (e != hipSuccess) fprintf(stderr, "cooperative launch failed: %s (grid %d)\n", hipGetErrorString(e), grid_blocks);
}
```

```cpp
#include <hip/hip_runtime.h>
#include <hip/hip_cooperative_groups.h>
#include <cstdio>
#include <cstdint>
namespace cg = cooperative_groups;

typedef unsigned short bf16_t;
typedef short bf16x8 __attribute__((ext_vector_type(8)));
typedef float f32x4 __attribute__((ext_vector_type(4)));
typedef unsigned u32x4 __attribute__((ext_vector_type(4)));
typedef unsigned u32x2 __attribute__((ext_vector_type(2)));

constexpr int NB = 4, SEQ = 4096, CTXL = 256, DM = 1024, TPB = 4352, MTOK = NB * TPB;
constexpr int DIN = 2444, NPAD = 2560;
constexpr float EPS = 1e-6f;
constexpr float C2 = 0.125f * 1.4426950408889634f;
constexpr int MOE_ROWS = 23552;
constexpr int NT = 512;
constexpr int LDS_BYTES = 147456;

constexpr size_t MiB = 1u << 20;
constexpr size_t WS_CTL = 0;
constexpr size_t WS_MODV = 1 * MiB;
constexpr size_t WS_ROPE = 2 * MiB;
constexpr size_t WS_MOEM = 3 * MiB;
constexpr size_t WS_DT = 4 * MiB;
constexpr size_t WS_HKC = 5 * MiB;
constexpr size_t WS_XC = 6 * MiB;
constexpr size_t WS_WIN = 10 * MiB;
constexpr size_t WS_WOUT = 15 * MiB;
constexpr size_t WS_WGU = 17 * MiB;
constexpr size_t WS_WD = 33 * MiB;
constexpr size_t WS_HK = 41 * MiB;
constexpr size_t WS_H = 57 * MiB;
constexpr size_t WS_QK = 91 * MiB;
constexpr size_t WS_VZ = 108 * MiB;
constexpr size_t WS_XBC = 125 * MiB;
constexpr size_t WS_HY = WS_XBC + (size_t)MTOK * 768 * 2;
constexpr size_t WS_HYT = WS_HY + (size_t)MTOK * 768 * 2;
constexpr size_t WS_ST = WS_HYT + (size_t)MTOK * 768 * 2;
constexpr size_t WS_Y = WS_ST + (size_t)4 * 34 * 2 * 6 * 4096 * 4;
constexpr size_t WS_END = WS_Y + (size_t)MTOK * 384 * 4;
constexpr size_t WS_DEC = WS_DT + 900 * 1024;
constexpr size_t WS_H2S = WS_QK;
constexpr size_t WS_ACT = WS_H2S + (size_t)MOE_ROWS * 1024 * 2;
static_assert(WS_END <= 256 * MiB, "ws");
static_assert(WS_ACT + (size_t)MOE_ROWS * 512 * 2 <= WS_HYT, "moe alias");

constexpr int CT_CNT = 0, CT_FILL = 32, CT_BASE = 64, CT_NT = 96, CT_TP = 128;
constexpr int CT_BAR = 4096;
constexpr int CT_CNTB = 8192;

__device__ __forceinline__ int opq_v(int v) { asm volatile("" : "+v"(v)); return v; }
__device__ __forceinline__ int opq_s(int v) { asm volatile("" : "+s"(v)); return v; }
#define TIDX opq_v((int)threadIdx.x)
#define BIDX opq_s((int)blockIdx.x)
#define GDIM opq_s((int)gridDim.x)
__device__ __forceinline__ unsigned f2bf(float f) { unsigned u = __float_as_uint(f); return (u + 0x7fffu + ((u >> 16) & 1u)) >> 16; }
__device__ __forceinline__ unsigned pk2bf(float lo, float hi) { return f2bf(lo) | (f2bf(hi) << 16); }
__device__ __forceinline__ float bf2f(bf16_t h) { return __uint_as_float(((unsigned)h) << 16); }
__device__ __forceinline__ float wave_sum(float v) {
#pragma unroll
  for (int o = 1; o < 64; o <<= 1) v += __shfl_xor(v, o);
  return v;
}
__device__ __forceinline__ float siluf(float v) { return v / (1.0f + __expf(-v)); }
__device__ __forceinline__ float* xrow(const float* xl, const float* xc, int r) {
  const int b = r / TPB, j = r - b * TPB;
  return (float*)(j < CTXL ? xc + ((size_t)b * CTXL + j) * DM : xl + ((size_t)b * SEQ + (j - CTXL)) * DM);
}
__device__ __forceinline__ int mrow_of(int r) { const int b = r / TPB, j = r - b * TPB; return j < CTXL ? 4 : b; }

__device__ __forceinline__ void st_adaln(const float* c, const float* c_ctx, const float* w_mod, const float* b_mod, float* modv, char* lds) {
  float (*sc)[1024] = (float (*)[1024])lds;
  float (*red)[5][64] = (float (*)[5][64])(lds + 5 * 1024 * 4);
  const int tid = TIDX;
  for (int it = BIDX; it < 192; it += GDIM) {
    const int layer = it / 96, n0 = (it % 96) * 64;
    for (int i = tid; i < 5 * 1024; i += NT) { const int r = i >> 10, k = i & 1023; const float v = r < 4 ? c[r * 1024 + k] : c_ctx[k]; sc[r][k] = v / (1.0f + expf(-v)); }
    __syncthreads();
    const int kg = tid >> 6, n = tid & 63;
    float acc[5] = {0.f, 0.f, 0.f, 0.f, 0.f};
#pragma unroll 16
    for (int k = kg; k < 1024; k += 8) { const float w = w_mod[((size_t)layer * 1024 + k) * 6144 + n0 + n];
#pragma unroll
      for (int r = 0; r < 5; ++r) acc[r] += sc[r][k] * w; }
#pragma unroll
    for (int r = 0; r < 5; ++r) red[kg][r][n] = acc[r];
    __syncthreads();
    if (tid < 320) { const int r = tid >> 6, nn = tid & 63; float s = 0.f;
#pragma unroll
      for (int g = 0; g < 8; ++g) s += red[g][r][nn];
      modv[((size_t)layer * 5 + r) * 6144 + n0 + nn] = s + b_mod[layer * 6144 + n0 + nn]; }
    __syncthreads();
  }
}
__device__ __forceinline__ void st_rope(float* rope) {
  for (int i = BIDX * NT + TIDX; i < 4096 * 32; i += GDIM * NT) {
    const int t = i >> 5, d = i & 31, m = d & 15;
    const float inv = exp2f(-(float)(2 * m) * (13.287712379549449f / 32.0f));
    const float pos = (float)(d < 16 ? (t >> 6) : (t & 63));
    float rev = pos * inv * 0.15915494309189535f; rev -= floorf(rev);
    rope[2 * i] = __builtin_amdgcn_cosf(rev); rope[2 * i + 1] = __builtin_amdgcn_sinf(rev);
  }
}

__device__ __forceinline__ void st_normmod(const float* xl, const float* xc, float* xl_dst, float* xc_dst, const bf16_t* YS, const int* tok_slot, const float* gate_prev,
                                           const float* g, const float* modv_layer, int off_sh, int off_sc, bf16_t* H, char* lds) {
  float* mA = (float*)lds; float* mB = mA + 5 * 1024; float* mG = mB + 5 * 1024;
  const int tid = TIDX, lane = tid & 63, gw = BIDX * 8 + (tid >> 6), ngw = GDIM * 8;
  for (int idx = tid; idx < 5 * 1024; idx += NT) { const int m = idx >> 10, k = idx & 1023; mA[idx] = g[k] * (1.f + modv_layer[(size_t)m * 6144 + off_sc + k]); mB[idx] = modv_layer[(size_t)m * 6144 + off_sh + k];
    mG[idx] = YS ? gate_prev[(size_t)m * 6144 + k] : 0.f; }
  __syncthreads();
  for (int rb = gw; rb < MTOK; rb += 3 * ngw) {
    f32x4 v[3][4]; u32x2 ys[3][4]; float rstd[3];
#pragma unroll
    for (int u = 0; u < 3; ++u) { const int r = rb + u * ngw, rc = r < MTOK ? r : MTOK - 1; const float* xr = xrow(xl, xc, rc);
#pragma unroll
      for (int j = 0; j < 4; ++j) v[u][j] = *(const f32x4*)(xr + 4 * lane + 256 * j);
      if (YS) { const bf16_t* yr = YS + (size_t)tok_slot[rc] * DM;
#pragma unroll
        for (int j = 0; j < 4; ++j) ys[u][j] = *(const u32x2*)(yr + 4 * lane + 256 * j); } }
    if (YS) {
#pragma unroll
      for (int u = 0; u < 3; ++u) { const int r = rb + u * ngw; if (r < MTOK) { const int mo = mrow_of(r) * 1024; float* xd = xrow(xl_dst, xc_dst, r);
#pragma unroll
        for (int j = 0; j < 4; ++j) { const int k = 4 * lane + 256 * j; const f32x4 g4 = *(const f32x4*)(mG + mo + k);
          const f32x4 m4 = (f32x4){__uint_as_float(ys[u][j].x << 16), __uint_as_float(ys[u][j].x & 0xffff0000u), __uint_as_float(ys[u][j].y << 16), __uint_as_float(ys[u][j].y & 0xffff0000u)};
          v[u][j] = v[u][j] + g4 * m4; *(f32x4*)(xd + k) = v[u][j]; } } } }
#pragma unroll
    for (int u = 0; u < 3; ++u) { float ss = 0.f;
#pragma unroll
      for (int j = 0; j < 4; ++j) ss += v[u][j].x * v[u][j].x + v[u][j].y * v[u][j].y + v[u][j].z * v[u][j].z + v[u][j].w * v[u][j].w;
      rstd[u] = rsqrtf(wave_sum(ss) * (1.0f / DM) + EPS); }
#pragma unroll
    for (int u = 0; u < 3; ++u) { const int r = rb + u * ngw;
      if (r < MTOK) { const int mo = mrow_of(r) * 1024;
#pragma unroll
        for (int j = 0; j < 4; ++j) { const int k = 4 * lane + 256 * j;
          const f32x4 a4 = *(const f32x4*)(mA + mo + k), b4 = *(const f32x4*)(mB + mo + k); const f32x4 o = v[u][j] * rstd[u] * a4 + b4;
          u32x2 w; w.x = pk2bf(o.x, o.y); w.y = pk2bf(o.z, o.w);
          *(u32x2*)(H + (size_t)r * DM + k) = w; } } }
  }
  __syncthreads();
}

template <int MODE> __device__ __forceinline__ void tr_wave_item(const float* src, const float* src2, int ldsrc, int K, bf16_t* out, int n0, int k0, float* scr, int lane) {
  const int nn = lane & 31, n = n0 + nn;
#pragma unroll 8
  for (int i = 0; i < 32; ++i) { const int kk = 2 * i + (lane >> 5); float v = 0.f;
    if (MODE == 0) { const int col = n < 1676 ? n : (n < 1792 ? -1 : n - 116); if (col >= 0) v = src[(size_t)(k0 + kk) * ldsrc + col]; }
    else if (MODE == 1) v = src[(size_t)(k0 + kk) * ldsrc + n];
    else v = (n & 1) ? src2[(size_t)(k0 + kk) * ldsrc + (n >> 1)] : src[(size_t)(k0 + kk) * ldsrc + (n >> 1)];
    scr[kk * 33 + nn] = v; }
  asm volatile("s_waitcnt lgkmcnt(0)" ::: "memory");
  const int c = lane & 7;
#pragma unroll
  for (int j = 0; j < 4; ++j) { const int nr = (lane >> 3) + 8 * j; const float* sp = scr + (8 * c) * 33 + nr;
    u32x4 o; o.x = f2bf(sp[0]) | (f2bf(sp[33]) << 16); o.y = f2bf(sp[66]) | (f2bf(sp[99]) << 16); o.z = f2bf(sp[132]) | (f2bf(sp[165]) << 16); o.w = f2bf(sp[198]) | (f2bf(sp[231]) << 16);
    *(u32x4*)(out + (size_t)(n0 + nr) * K + k0 + 8 * c) = o; }
  asm volatile("s_waitcnt lgkmcnt(0)" ::: "memory");
}
__device__ __forceinline__ void st_weights(const float* w_in, const float* w_out, const float* w_gate, const float* w_up, const float* w_down, int layer,
                                           bf16_t* WIN, bf16_t* WOUT, bf16_t* WGU, bf16_t* WD, char* lds) {
  const int tid = TIDX, lane = tid & 63, w = tid >> 6; float* scr = (float*)lds + w * (64 * 33);
  for (int it = BIDX * 8 + w; it < 7936; it += GDIM * 8) {
    if (it < 1280) tr_wave_item<0>(w_in + (size_t)layer * 1024 * DIN, nullptr, DIN, 1024, WIN, (it % 80) * 32, (it / 80) * 64, scr, lane);
    else if (it < 1792) { const int i2 = it - 1280; tr_wave_item<1>(w_out + (size_t)layer * 1024 * 1024, nullptr, 1024, 1024, WOUT, (i2 & 31) * 32, (i2 >> 5) * 64, scr, lane); }
    else if (it < 5888) { const int i2 = it - 1792, e = i2 >> 8, t = i2 & 255;
      tr_wave_item<2>(w_gate + ((size_t)layer * 16 + e) * 1024 * 256, w_up + ((size_t)layer * 16 + e) * 1024 * 256, 256, 1024, WGU + (size_t)e * 512 * 1024, (t & 15) * 32, (t >> 4) * 64, scr, lane); }
    else { const int i2 = it - 5888, e = i2 >> 7, t = i2 & 127;
      tr_wave_item<1>(w_down + ((size_t)layer * 16 + e) * 256 * 1024, nullptr, 1024, 256, WD + (size_t)e * 1024 * 256, (t & 31) * 32, (t >> 5) * 64, scr, lane); }
  }
  __syncthreads();
}

__device__ __forceinline__ void pair_experts(int pidx, int& eA, int& eB) {
  const int g = pidx / 6, t = pidx - 6 * g; const int i = t < 3 ? 0 : (t < 5 ? 1 : 2); const int j = t < 3 ? t + 1 : (t < 5 ? t - 1 : 3);
  eA = 4 * g + i; eB = 4 * g + j;
}
__device__ __forceinline__ void st_prep_qk(bf16_t* QK, const float* qn, const float* kn, const float* rope) {
  const int lane = TIDX & 63, gw = BIDX * 8 + (TIDX >> 6), ngw = GDIM * 8, hh = lane >> 3, sub = lane & 7;
  float gn[8];
#pragma unroll
  for (int e = 0; e < 8; ++e) gn[e] = ((hh < 6 ? qn : kn) + sub * 8)[e] * (hh < 6 ? C2 : 1.0f);
  for (int rb = gw; rb < MTOK; rb += 3 * ngw) {
    bf16x8 raw[3]; f32x4 rp4[3][4];
#pragma unroll
    for (int u = 0; u < 3; ++u) { const int r = rb + u * ngw < MTOK ? rb + u * ngw : MTOK - 1; const int j = r % TPB, t = j >= CTXL ? j - CTXL : 0;
      raw[u] = *(const bf16x8*)(QK + (size_t)r * 512 + hh * 64 + sub * 8);
      const float* rp = rope + ((size_t)t * 32 + (sub & 3) * 8) * 2;
#pragma unroll
      for (int q = 0; q < 4; ++q) rp4[u][q] = *(const f32x4*)(rp + 4 * q); }
#pragma unroll
    for (int u = 0; u < 3; ++u) { const int r = rb + u * ngw; const int j = (r < MTOK ? r : MTOK - 1) % TPB;
      float v[8]; float ss = 0.f;
#pragma unroll
      for (int e = 0; e < 8; ++e) { v[e] = bf2f((bf16_t)raw[u][e]); ss += v[e] * v[e]; }
      ss += __shfl_xor(ss, 1); ss += __shfl_xor(ss, 2); ss += __shfl_xor(ss, 4);
      const float rstd = rsqrtf(ss * (1.0f / 64.0f) + EPS);
#pragma unroll
      for (int e = 0; e < 8; ++e) v[e] = v[e] * rstd * gn[e];
      if (j >= CTXL) {
#pragma unroll
        for (int e = 0; e < 8; ++e) { const float other = __shfl_xor(v[e], 4); const float cs = rp4[u][e >> 1][(e & 1) * 2], sn = rp4[u][e >> 1][(e & 1) * 2 + 1]; v[e] = sub < 4 ? v[e] * cs - other * sn : v[e] * cs + other * sn; } }
      if (r < MTOK) *(u32x4*)(QK + (size_t)r * 512 + hh * 64 + sub * 8) = (u32x4){pk2bf(v[0], v[1]), pk2bf(v[2], v[3]), pk2bf(v[4], v[5]), pk2bf(v[6], v[7])}; }
  }
}

__device__ __forceinline__ void st_prep_hy(const bf16_t* HY, const float* cw, const float* cb, bf16_t* HYT, int do_ctx, char* lds) {
  const int tid = TIDX, lane = tid & 63, w = tid >> 6; float* tile = (float*)lds + w * (66 * 33);
  const int nlat = 4 * 64 * 24, nitem = nlat + (do_ctx ? 4 * 4 * 24 : 0), step = GDIM * 8;
  bf16x8 raw[5];
#define PHY_DECODE(it) int b, tt, ct, L, joff; bf16_t* outb; \
    if ((it) < nlat) { b = (it) / 1536; tt = ((it) % 1536) / 24; ct = (it) % 24; L = SEQ; joff = CTXL; outb = HYT + (size_t)b * 768 * SEQ; } \
    else { const int i2 = (it) - nlat; b = i2 / 96; tt = (i2 % 96) / 24; ct = i2 % 24; L = CTXL; joff = 0; outb = HYT + (size_t)4 * 768 * SEQ + (size_t)b * 768 * CTXL; } \
    const int t0 = tt * 64, c0 = ct * 32; (void)outb;
#define PHY_LOADS(it) do { PHY_DECODE(it) _Pragma("unroll") for (int i = 0; i < 5; ++i) { const int rr = (lane >> 2) + 16 * i, c8 = (lane & 3) * 8; int t = t0 - 1 + rr; const bool ok = rr < 66 && t >= 0 && t < L; t = ok ? t : t0; \
      const bf16x8 v = *(const bf16x8*)(HY + ((size_t)b * TPB + joff + t) * 768 + c0 + c8); raw[i] = ok ? v : (bf16x8){0, 0, 0, 0, 0, 0, 0, 0}; } } while (0)
  int it = BIDX * 8 + w;
  if (it < nitem) PHY_LOADS(it);
  for (; it < nitem; it += step) {
    PHY_DECODE(it)
#pragma unroll
    for (int i = 0; i < 5; ++i) { const int rr = (lane >> 2) + 16 * i, c8 = (lane & 3) * 8;
      if (rr < 66) {
#pragma unroll
        for (int e = 0; e < 8; ++e) tile[rr * 33 + c8 + e] = bf2f((bf16_t)raw[i][e]); } }
    asm volatile("s_waitcnt lgkmcnt(0)" ::: "memory");
    if (it + step < nitem) PHY_LOADS(it + step);
#pragma unroll 4
    for (int cc = 0; cc < 32; ++cc) { const int c = c0 + cc;
      const float v = cw[c] * tile[lane * 33 + cc] + cw[768 + c] * tile[(lane + 1) * 33 + cc] + cw[1536 + c] * tile[(lane + 2) * 33 + cc] + cb[c];
      outb[(size_t)c * L + t0 + lane] = (bf16_t)f2bf(v); }
    asm volatile("s_waitcnt lgkmcnt(0)" ::: "memory");
  }
#undef PHY_LOADS
#undef PHY_DECODE
  __syncthreads();
}

template <int L> __device__ __forceinline__ void hyfilt_item(int item, const float* w1, const float* b1, const float* fr, const float* w2, const float* b2, const float* w3, float* HK, char* lds) {
  float* S0 = (float*)lds; float* S1 = S0 + 64 * 64; float* S2 = S1 + 64 * 68;
  const int tid = TIDX, n0 = (item >> 2) * 64, cq = item & 3, lane = tid & 63, wv = tid >> 6;
  for (int e = tid; e < 64 * 33; e += NT) { const int pp = e / 33, f = e % 33; const int n = n0 + pp; float v;
    if (f == 0) v = (float)n / (float)(L - 1);
    else { const int m = (f - 1) & 15; const float band = 1e-4f + (float)m * ((15.0f - 1e-4f) / 15.0f); const float wpos = (6.283185307179586f / (float)L) * (float)n;
      v = f <= 16 ? cosf(wpos * band) : -sinf(wpos * band); }
    S0[pp * 33 + f] = v; }
  for (int e = tid; e < 33 * 64; e += NT) S1[e] = w1[e];
  __syncthreads();
  for (int e = tid; e < 64 * 64; e += NT) { const int pp = e >> 6, j = e & 63; float a = b1[j];
    for (int f = 0; f < 33; ++f) a += S0[pp * 33 + f] * S1[f * 64 + j];
    S2[pp * 64 + j] = sinf(fr[j] * a); }
  __syncthreads();
  for (int e = tid; e < 64 * 64; e += NT) S0[e] = w2[e];
  __syncthreads();
  for (int e = tid; e < 64 * 64; e += NT) { const int pp = e >> 6, j = e & 63; float a = b2[j];
    for (int f = 0; f < 64; ++f) a += S2[pp * 64 + f] * S0[f * 64 + j];
    S1[pp * 68 + j] = sinf(fr[j] * a); }
  __syncthreads();
  {
    const int l15 = lane & 15, l4 = lane >> 4, colb = cq * 256 + 32 * wv;
    f32x4 acc[4][2];
#pragma unroll
    for (int pt = 0; pt < 4; ++pt) { acc[pt][0] = (f32x4){0.f, 0.f, 0.f, 0.f}; acc[pt][1] = (f32x4){0.f, 0.f, 0.f, 0.f}; }
#pragma unroll 4
    for (int kk = 0; kk < 16; ++kk) { const int k = 4 * kk + l4;
      const float bv0 = w3[k * 1024 + colb + l15], bv1 = w3[k * 1024 + colb + 16 + l15];
#pragma unroll
      for (int pt = 0; pt < 4; ++pt) { const float av = S1[(pt * 16 + l15) * 68 + k];
        acc[pt][0] = __builtin_amdgcn_mfma_f32_16x16x4f32(av, bv0, acc[pt][0], 0, 0, 0);
        acc[pt][1] = __builtin_amdgcn_mfma_f32_16x16x4f32(av, bv1, acc[pt][1], 0, 0, 0); } }
#pragma unroll
    for (int ct = 0; ct < 2; ++ct) { const int col = colb + 16 * ct + l15, dir = col >> 9, order = (col >> 8) & 1, c = col & 255;
      const float delta = 3.0701134573253943f + (float)c * ((15.350567286626972f - 3.0701134573253943f) / 255.0f);
      float* dst = HK + ((size_t)order * 256 + c) * (2 * L);
#pragma unroll
      for (int pt = 0; pt < 4; ++pt) { const int nb = n0 + pt * 16 + 4 * l4; f32x4 o;
#pragma unroll
        for (int rg = 0; rg < 4; ++rg) o[rg] = acc[pt][ct][rg] * __expf(-((float)(nb + rg) / (float)(L - 1)) * delta);
        if (dir == 0) *(f32x4*)(dst + nb) = o;
        else {
#pragma unroll
          for (int rg = 0; rg < 4; ++rg) { const int n = nb + rg; if (n >= 1) dst[2 * L - n] = o[rg]; else dst[L] = 0.f; } } } }
  }
  __syncthreads();
}

__device__ __forceinline__ void hyconv_ctx_item(int item, const bf16_t* HYTC, const float* HKC, const float* hy_bias, bf16_t* MIX, char* lds) {
  constexpr int L = CTXL;
  const int tid = TIDX, b = item >> 4, cc = tid >> 5, c = (item & 15) * 16 + cc, sub = tid & 31, tb = 8 * sub;
  float* kern = (float*)lds + cc * (2 * L); float* z = (float*)lds + 16 * 2 * L + cc * L;
  const bf16_t* vp = HYTC + ((size_t)b * 768 + c) * L; const bf16_t* x1p = vp + (size_t)256 * L; const bf16_t* x2p = vp + (size_t)512 * L;
#pragma unroll 1
  for (int o = 0; o < 2; ++o) {
    if (o == 0) for (int t = sub; t < L; t += 32) z[t] = bf2f(vp[t]);
    const float* kp = HKC + ((size_t)o * 256 + c) * (2 * L);
    for (int t = sub; t < 2 * L; t += 32) kern[t] = kp[t];
    __syncthreads();
    float acc[8], W[16];
#pragma unroll
    for (int i = 0; i < 8; ++i) { acc[i] = 0.f; W[8 + i] = kern[(tb + i) & (2 * L - 1)]; }
    for (int s0 = 0; s0 < L; s0 += 8) {
      const int bb = (tb - s0 - 8) & (2 * L - 1);
#pragma unroll
      for (int i = 0; i < 8; ++i) W[i] = kern[bb + i];
      float zs[8];
#pragma unroll
      for (int j = 0; j < 8; ++j) zs[j] = z[s0 + j];
#pragma unroll
      for (int j = 0; j < 8; ++j)
#pragma unroll
        for (int i = 0; i < 8; ++i) acc[i] += W[8 + i - j] * zs[j];
#pragma unroll
      for (int i = 0; i < 8; ++i) W[8 + i] = W[i];
    }
    __syncthreads();
    const float bias = hy_bias[o * 256 + c];
#pragma unroll
    for (int i = 0; i < 8; ++i) { const int t = tb + i; const float zz = acc[i] + bias * z[t];
      if (o == 0) z[t] = bf2f(x1p[t]) * zz;
      else MIX[((size_t)b * TPB + t) * DM + 768 + c] = (bf16_t)f2bf(bf2f(x2p[t]) * zz); }
    __syncthreads();
  }
}

__device__ __forceinline__ void ssd_conv8(const bf16_t* XBC, size_t r, int c0, bool hasp, bool hasn, const float* cw, const float* cb, float (&o)[8]) {
  const bf16x8 cur = *(const bf16x8*)(XBC + r * 768 + c0);
  const bf16x8 prv = *(const bf16x8*)(XBC + (hasp ? r - 1 : r) * 768 + c0), nxt = *(const bf16x8*)(XBC + (hasn ? r + 1 : r) * 768 + c0);
  const float wp = hasp ? 1.f : 0.f, wn = hasn ? 1.f : 0.f;
#pragma unroll
  for (int e = 0; e < 8; ++e) { const float v = wp * cw[c0 + e] * bf2f((bf16_t)prv[e]) + cw[640 + c0 + e] * bf2f((bf16_t)cur[e]) + wn * cw[1280 + c0 + e] * bf2f((bf16_t)nxt[e]) + cb[c0 + e]; o[e] = siluf(v); }
}
__device__ __forceinline__ float softplusf(float x) {
  const float y = __expf(-fabsf(x)); const float l = y < 0.06f ? y * (1.f - y * (0.5f - y * (0.33333334f - 0.25f * y))) : __logf(1.f + y); return fmaxf(x, 0.f) + l; }
__device__ __forceinline__ void wave_scan128(float e0, float e1, int lane, float& c0, float& c1) {
  float x = e0 + e1;
#pragma unroll
  for (int o = 1; o < 64; o <<= 1) { const float v = __shfl_up(x, o); if (lane >= o) x += v; }
  const float excl = x - (e0 + e1); c0 = excl + e0; c1 = excl + e0 + e1;
}
__device__ __forceinline__ int ssd_chunk_j0(int cidx) { return cidx < 2 ? cidx * 128 : CTXL + (cidx - 2) * 128; }

__device__ __forceinline__ void st_ssd1(int it0, int step, int nitems, const bf16_t* XBC, const float* DT, const float* cw, const float* cb, const float* dt_bias, const float* a_log,
                                        float* YIN, float* ST, float* DEC, char* lds) {
  bf16_t (*Cm)[72] = (bf16_t (*)[72])lds; bf16_t (*Bm)[72] = (bf16_t (*)[72])(lds + 18432);
  bf16_t (*BT)[136] = (bf16_t (*)[136])(lds + 36864); bf16_t (*Xt)[136] = (bf16_t (*)[136])(lds + 54272); bf16_t (*Mm)[136] = (bf16_t (*)[136])(lds + 71680);
  float* tab = (float*)(lds + 106496); float* dtf = tab; float* dtb = tab + 128; float* acf = tab + 256; float* acb = tab + 384; float* wf = tab + 512; float* wb = tab + 640;
  const int tid = TIDX;
  bf16x8 cu[6], pv[6], nx[6];
#define SSD1_LOADS(itm, I0, I1) do { const int h_ = (itm) % 6, bc_ = (itm) / 6, cidx_ = bc_ % 34, b_ = bc_ / 34, g_ = h_ / 3, j0_ = ssd_chunk_j0(cidx_); const size_t r0_ = (size_t)b_ * TPB + j0_; \
    _Pragma("unroll") for (int i = (I0); i < (I1); ++i) { const int task = tid + NT * i, t = task / 24, cg = task % 24, kind = cg >> 3, q = cg & 7, j = j0_ + t; \
      const int c0 = kind == 0 ? h_ * 64 + 8 * q : (kind == 1 ? 384 + g_ * 64 + 8 * q : 512 + g_ * 64 + 8 * q); \
      const bool hasp = j != 0 && j != CTXL, hasn = j != CTXL - 1 && j != TPB - 1; const bf16_t* p = XBC + (r0_ + t) * 768 + c0; \
      cu[i] = *(const bf16x8*)p; pv[i] = *(const bf16x8*)(p + (hasp ? -768 : 0)); nx[i] = *(const bf16x8*)(p + (hasn ? 768 : 0)); } } while (0)
  if (it0 < nitems) SSD1_LOADS(it0, 0, 6);
#pragma unroll 1
  for (int item = it0; item < nitems; item += step) {
  const int tid = TIDX, lane = tid & 63, w = tid >> 6, l15 = lane & 15, l4 = lane >> 4;
  const int h = item % 6, bc = item / 6, cidx = bc % 34, b = bc / 34, g = h / 3, j0 = ssd_chunk_j0(cidx);
  const size_t r0 = (size_t)b * TPB + j0;
  float dtr0 = 0.f, dtr1 = 0.f;
  if (w < 2) { const int t0 = w == 0 ? 2 * lane : 127 - 2 * lane, t1 = w == 0 ? 2 * lane + 1 : 126 - 2 * lane; dtr0 = DT[(r0 + t0) * 12 + w * 6 + h]; dtr1 = DT[(r0 + t1) * 12 + w * 6 + h]; }
  SSD1_LOADS(item, 6, 6);
  {
#pragma unroll
    for (int i = 0; i < 6; ++i) { const int task = tid + NT * i, t = task / 24, cg = task % 24, kind = cg >> 3, q = cg & 7, j = j0 + t;
      const int c0 = kind == 0 ? h * 64 + 8 * q : (kind == 1 ? 384 + g * 64 + 8 * q : 512 + g * 64 + 8 * q);
      const float wp = (j != 0 && j != CTXL) ? 1.f : 0.f, wn = (j != CTXL - 1 && j != TPB - 1) ? 1.f : 0.f;
      float o[8];
#pragma unroll
      for (int e = 0; e < 8; ++e) o[e] = siluf(wp * cw[c0 + e] * bf2f((bf16_t)pv[i][e]) + cw[640 + c0 + e] * bf2f((bf16_t)cu[i][e]) + wn * cw[1280 + c0 + e] * bf2f((bf16_t)nx[i][e]) + cb[c0 + e]);
      if (kind == 0) {
#pragma unroll
        for (int e = 0; e < 8; ++e) Xt[8 * q + e][t] = (bf16_t)f2bf(o[e]);
      } else { const u32x4 pk = (u32x4){pk2bf(o[0], o[1]), pk2bf(o[2], o[3]), pk2bf(o[4], o[5]), pk2bf(o[6], o[7])};
        if (kind == 1) { *(u32x4*)&Bm[t][8 * q] = pk;
#pragma unroll
          for (int e = 0; e < 8; ++e) BT[8 * q + e][t] = (bf16_t)f2bf(o[e]); }
        else *(u32x4*)&Cm[t][8 * q] = pk; } }
  }
  if (w < 2) { const int dir = w; const float a = -expf(a_log[dir * 6 + h]), bias = dt_bias[dir * 6 + h];
    const int t0 = dir == 0 ? 2 * lane : 127 - 2 * lane, t1 = dir == 0 ? 2 * lane + 1 : 126 - 2 * lane;
    const float d0 = softplusf(dtr0 + bias), d1 = softplusf(dtr1 + bias);
    float c0, c1; wave_scan128(d0 * a, d1 * a, lane, c0, c1);
    const float tot = __shfl(c1, 63);
    float* dtt = dir == 0 ? dtf : dtb; float* ac = dir == 0 ? acf : acb; float* ww = dir == 0 ? wf : wb;
    dtt[t0] = d0; dtt[t1] = d1; ac[t0] = c0; ac[t1] = c1; ww[t0] = __expf(tot - c0) * d0; ww[t1] = __expf(tot - c1) * d1;
    if (lane == 0) DEC[(((size_t)b * 34 + cidx) * 2 + dir) * 6 + h] = __expf(tot); }
  __syncthreads();
  if (item + step < nitems) SSD1_LOADS(item + step, 0, 6);
  {
    f32x4 accG[8];
#pragma unroll
    for (int ni = 0; ni < 8; ++ni) accG[ni] = (f32x4){0.f, 0.f, 0.f, 0.f};
#pragma unroll
    for (int kk = 0; kk < 2; ++kk) { const bf16x8 a = *(const bf16x8*)&Cm[16 * w + l15][32 * kk + 8 * l4];
#pragma unroll
      for (int ni = 0; ni < 8; ++ni) { const bf16x8 bb = *(const bf16x8*)&Bm[16 * ni + l15][32 * kk + 8 * l4]; accG[ni] = __builtin_amdgcn_mfma_f32_16x16x32_bf16(a, bb, accG[ni], 0, 0, 0); } }
    float aft[4], abt[4];
#pragma unroll
    for (int rg = 0; rg < 4; ++rg) { aft[rg] = acf[16 * w + 4 * l4 + rg]; abt[rg] = acb[16 * w + 4 * l4 + rg]; }
#pragma unroll
    for (int ni = 0; ni < 8; ++ni) { const int sidx = 16 * ni + l15; const float afs = acf[sidx], abs_ = acb[sidx], dfs = dtf[sidx], dbs = dtb[sidx];
#pragma unroll
      for (int rg = 0; rg < 4; ++rg) { const int t = 16 * w + 4 * l4 + rg;
        const float f = sidx <= t ? __expf(aft[rg] - afs) * dfs : 0.f, bk = sidx >= t ? __expf(abt[rg] - abs_) * dbs : 0.f;
        Mm[t][sidx] = (bf16_t)f2bf(accG[ni][rg] * (f + bk)); } }
  }
  __syncthreads();
  {
    f32x4 acc[4];
#pragma unroll
    for (int ni = 0; ni < 4; ++ni) acc[ni] = (f32x4){0.f, 0.f, 0.f, 0.f};
#pragma unroll
    for (int kk = 0; kk < 4; ++kk) { const bf16x8 a = *(const bf16x8*)&Mm[16 * w + l15][32 * kk + 8 * l4];
#pragma unroll
      for (int ni = 0; ni < 4; ++ni) { const bf16x8 bb = *(const bf16x8*)&Xt[16 * ni + l15][32 * kk + 8 * l4]; acc[ni] = __builtin_amdgcn_mfma_f32_16x16x32_bf16(a, bb, acc[ni], 0, 0, 0); } }
#pragma unroll
    for (int rg = 0; rg < 4; ++rg)
#pragma unroll
      for (int ni = 0; ni < 4; ++ni) YIN[(r0 + 16 * w + 4 * l4 + rg) * 384 + h * 64 + 16 * ni + l15] = acc[ni][rg];
  }
  {
    const int dir = w >> 2, mt = w & 3; const float* ww = dir == 0 ? wf : wb;
    f32x4 acc[4];
#pragma unroll
    for (int ni = 0; ni < 4; ++ni) acc[ni] = (f32x4){0.f, 0.f, 0.f, 0.f};
#pragma unroll
    for (int kk = 0; kk < 4; ++kk) { const bf16x8 raw = *(const bf16x8*)&Xt[16 * mt + l15][32 * kk + 8 * l4];
      const f32x4 w0 = *(const f32x4*)(ww + 32 * kk + 8 * l4), w1 = *(const f32x4*)(ww + 32 * kk + 8 * l4 + 4);
      u32x4 pk; pk.x = pk2bf(bf2f((bf16_t)raw[0]) * w0.x, bf2f((bf16_t)raw[1]) * w0.y); pk.y = pk2bf(bf2f((bf16_t)raw[2]) * w0.z, bf2f((bf16_t)raw[3]) * w0.w);
      pk.z = pk2bf(bf2f((bf16_t)raw[4]) * w1.x, bf2f((bf16_t)raw[5]) * w1.y); pk.w = pk2bf(bf2f((bf16_t)raw[6]) * w1.z, bf2f((bf16_t)raw[7]) * w1.w);
      const bf16x8 a = __builtin_bit_cast(bf16x8, pk);
#pragma unroll
      for (int ni = 0; ni < 4; ++ni) { const bf16x8 bb = *(const bf16x8*)&BT[16 * ni + l15][32 * kk + 8 * l4]; acc[ni] = __builtin_amdgcn_mfma_f32_16x16x32_bf16(a, bb, acc[ni], 0, 0, 0); } }
    float* sp = ST + ((((size_t)b * 34 + cidx) * 2 + dir) * 6 + h) * 4096;
#pragma unroll
    for (int rg = 0; rg < 4; ++rg)
#pragma unroll
      for (int ni = 0; ni < 4; ++ni) sp[(16 * mt + 4 * l4 + rg) * 64 + 16 * ni + l15] = acc[ni][rg];
  }
  __syncthreads();
  }
#undef SSD1_LOADS
}

__device__ __forceinline__ void st_ssd_scan2(float* ST, const float* DEC) {
  for (int idx = BIDX * NT + TIDX; idx < 4 * 2 * 6 * 4096; idx += GDIM * NT) {
    const int e = idx & 4095, bdh = idx >> 12, h = bdh % 6, dir = (bdh / 6) & 1, b = bdh / 12;
    float v[34], d[34];
#pragma unroll
    for (int st = 0; st < 34; ++st) { const int cidx = dir == 0 ? st : (st < 2 ? 1 - st : 35 - st); const size_t o = (((size_t)b * 34 + cidx) * 2 + dir) * 6 + h; v[st] = ST[o * 4096 + e]; d[st] = DEC[o]; }
    float H = 0.f;
#pragma unroll
    for (int st = 0; st < 34; ++st) { const int cidx = dir == 0 ? st : (st < 2 ? 1 - st : 35 - st); const size_t o = (((size_t)b * 34 + cidx) * 2 + dir) * 6 + h; ST[o * 4096 + e] = H; H = H * d[st] + v[st]; }
  }
}

__device__ __forceinline__ void ssd3_item(int b, int cidx, int g, const bf16_t* XBC, const bf16_t* VZ, const float* DT, const float* cw, const float* cb, const float* dt_bias, const float* a_log,
                                          const float* dskip, const float* nw, const float* YIN, const float* ST, bf16_t* MIX, char* lds) {
  bf16_t (*Cm)[72] = (bf16_t (*)[72])lds; bf16_t (*Hm)[72] = (bf16_t (*)[72])(lds + 18432);
  float* ef = (float*)(lds + 18432 + 55296);
  float (*Yt)[196] = (float (*)[196])lds;
  const int tid = TIDX, lane = tid & 63, w = tid >> 6, l15 = lane & 15, l4 = lane >> 4, j0 = ssd_chunk_j0(cidx);
  const size_t r0 = (size_t)b * TPB + j0;
#pragma unroll
  for (int i = 0; i < 2; ++i) { const int task = tid + NT * i, t = task >> 3, q = task & 7, j = j0 + t;
    float o[8]; ssd_conv8(XBC, r0 + t, 512 + g * 64 + 8 * q, j != 0 && j != CTXL, j != CTXL - 1 && j != TPB - 1, cw, cb, o);
    *(u32x4*)&Cm[t][8 * q] = (u32x4){pk2bf(o[0], o[1]), pk2bf(o[2], o[3]), pk2bf(o[4], o[5]), pk2bf(o[6], o[7])}; }
#pragma unroll
  for (int i = 0; i < 12; ++i) { const int f4 = tid + NT * i, hd = f4 >> 10, rem = f4 & 1023, p = rem >> 4, n4 = (rem & 15) * 4, hh = hd >> 1, dir = hd & 1;
    const f32x4 v = *(const f32x4*)(ST + ((((size_t)b * 34 + cidx) * 2 + dir) * 6 + 3 * g + hh) * 4096 + p * 64 + n4);
    *(u32x2*)&Hm[hd * 64 + p][n4] = (u32x2){pk2bf(v.x, v.y), pk2bf(v.z, v.w)}; }
  if (w < 6) { const int hh = w >> 1, dir = w & 1, h = 3 * g + hh; const float a = -expf(a_log[dir * 6 + h]), bias = dt_bias[dir * 6 + h];
    const int t0 = dir == 0 ? 2 * lane : 127 - 2 * lane, t1 = dir == 0 ? 2 * lane + 1 : 126 - 2 * lane;
    const float d0 = softplusf(DT[(r0 + t0) * 12 + dir * 6 + h] + bias), d1 = softplusf(DT[(r0 + t1) * 12 + dir * 6 + h] + bias);
    float c0, c1; wave_scan128(d0 * a, d1 * a, lane, c0, c1);
    ef[w * 128 + t0] = __expf(c0); ef[w * 128 + t1] = __expf(c1); }
  __syncthreads();
  float yv[3][4][4];
  {
    bf16x8 ca[2];
#pragma unroll
    for (int kk = 0; kk < 2; ++kk) ca[kk] = *(const bf16x8*)&Cm[16 * w + l15][32 * kk + 8 * l4];
#pragma unroll
    for (int hh = 0; hh < 3; ++hh) {
      f32x4 accF[4], accB[4];
#pragma unroll
      for (int ni = 0; ni < 4; ++ni) { accF[ni] = (f32x4){0.f, 0.f, 0.f, 0.f}; accB[ni] = (f32x4){0.f, 0.f, 0.f, 0.f}; }
#pragma unroll
      for (int kk = 0; kk < 2; ++kk)
#pragma unroll
        for (int ni = 0; ni < 4; ++ni) {
          accF[ni] = __builtin_amdgcn_mfma_f32_16x16x32_bf16(ca[kk], *(const bf16x8*)&Hm[(hh * 2 + 0) * 64 + 16 * ni + l15][32 * kk + 8 * l4], accF[ni], 0, 0, 0);
          accB[ni] = __builtin_amdgcn_mfma_f32_16x16x32_bf16(ca[kk], *(const bf16x8*)&Hm[(hh * 2 + 1) * 64 + 16 * ni + l15][32 * kk + 8 * l4], accB[ni], 0, 0, 0); }
#pragma unroll
      for (int rg = 0; rg < 4; ++rg) { const int t = 16 * w + 4 * l4 + rg; const float eF = ef[(hh * 2 + 0) * 128 + t], eB = ef[(hh * 2 + 1) * 128 + t];
#pragma unroll
        for (int ni = 0; ni < 4; ++ni) yv[hh][ni][rg] = eF * accF[ni][rg] + eB * accB[ni][rg]; }
    }
  }
  __syncthreads();
#pragma unroll
  for (int hh = 0; hh < 3; ++hh)
#pragma unroll
    for (int rg = 0; rg < 4; ++rg)
#pragma unroll
      for (int ni = 0; ni < 4; ++ni) Yt[16 * w + 4 * l4 + rg][hh * 64 + 16 * ni + l15] = yv[hh][ni][rg];
  __syncthreads();
  {
    const int c4 = 4 * (lane < 48 ? lane : 47), hk = c4 >> 6; const bool lact = lane < 48;
    float cw0[4], cw1[4], cw2[4], cbv[4], nwv[4];
#pragma unroll
    for (int e = 0; e < 4; ++e) { const int col = g * 192 + c4 + e; cw0[e] = cw[col]; cw1[e] = cw[640 + col]; cw2[e] = cw[1280 + col]; cbv[e] = cb[col]; nwv[e] = nw[col]; }
    const float dsk = dskip[3 * g + hk];
#pragma unroll 1
    for (int rb = 0; rb < 16; rb += 4) {
      u32x2 xc_[4], xp_[4], xn_[4], zz_[4]; f32x4 yy_[4];
#pragma unroll
      for (int u = 0; u < 4; ++u) { const int t = 16 * w + rb + u, j = j0 + t; const size_t r = r0 + t; const bool hasp = j != 0 && j != CTXL, hasn = j != CTXL - 1 && j != TPB - 1;
        const bf16_t* xq = XBC + r * 768 + g * 192 + c4;
        xc_[u] = *(const u32x2*)xq; xp_[u] = *(const u32x2*)(xq + (hasp ? -768 : 0)); xn_[u] = *(const u32x2*)(xq + (hasn ? 768 : 0));
        yy_[u] = *(const f32x4*)(YIN + r * 384 + g * 192 + c4); zz_[u] = *(const u32x2*)(VZ + r * 512 + 128 + g * 192 + c4); }
#pragma unroll
      for (int u = 0; u < 4; ++u) { const int t = 16 * w + rb + u, j = j0 + t; const size_t r = r0 + t; const float wp = (j != 0 && j != CTXL) ? 1.f : 0.f, wn = (j != CTXL - 1 && j != TPB - 1) ? 1.f : 0.f;
        const f32x4 yt = *(const f32x4*)&Yt[t][c4];
        float gt[4]; float ss = 0.f;
#pragma unroll
        for (int e = 0; e < 4; ++e) { const unsigned sh = (e & 1) * 16; const unsigned wc_ = e < 2 ? xc_[u].x : xc_[u].y, wq_ = e < 2 ? xp_[u].x : xp_[u].y, wn_ = e < 2 ? xn_[u].x : xn_[u].y, wz_ = e < 2 ? zz_[u].x : zz_[u].y;
          float xv = cw1[e] * bf2f((bf16_t)(wc_ >> sh)) + cbv[e] + wp * cw0[e] * bf2f((bf16_t)(wq_ >> sh)) + wn * cw2[e] * bf2f((bf16_t)(wn_ >> sh));
          xv = siluf(xv);
          const float y = yy_[u][e] + yt[e] + dsk * xv;
          gt[e] = lact ? y * siluf(bf2f((bf16_t)(wz_ >> sh))) : 0.f; ss += gt[e] * gt[e]; }
        const float rstd = rsqrtf(wave_sum(ss) * (1.0f / 192.0f) + EPS);
        if (lact) { u32x2 o; o.x = pk2bf(gt[0] * rstd * nwv[0], gt[1] * rstd * nwv[1]); o.y = pk2bf(gt[2] * rstd * nwv[2], gt[3] * rstd * nwv[3]);
          *(u32x2*)(MIX + r * DM + 384 + g * 192 + c4) = o; } }
    }
  }
  __syncthreads();
}

__device__ __forceinline__ void st_router(const float* xl, const float* xc, float* xl_dst, float* xc_dst, const bf16_t* MO, const float* g, const float* modv_layer, const float* w_router, const float* rbias,
                                          bf16_t* H2, int* ctl, int* tok_pair, float* tok_w, int skip_ctx, char* lds) {
  float* wl = (float*)lds;
  const int tid = TIDX, lane = tid & 63, gw = BIDX * 8 + (tid >> 6), ngw = GDIM * 8;
  int* hist = (int*)(lds + 81920);
  if (tid < 32) hist[tid] = 0;
  float* mA = (float*)(lds + 82176); float* mB = mA + 5 * 1024; float* mG = mB + 5 * 1024;
  for (int idx = tid; idx < 5 * 1024; idx += NT) { const int m = idx >> 10, k = idx & 1023; mA[idx] = g[k] * (1.f + modv_layer[(size_t)m * 6144 + 4096 + k]); mB[idx] = modv_layer[(size_t)m * 6144 + 3072 + k]; mG[idx] = modv_layer[(size_t)m * 6144 + 2048 + k]; }
  for (int idx = tid; idx < 4096; idx += NT) { const int k = idx >> 2, e4 = idx & 3, row = ((k & 3) * 4 + (k >> 8)) * 64 + ((k & 255) >> 2);
    *(f32x4*)(wl + row * 20 + 4 * e4) = *(const f32x4*)(w_router + (size_t)k * 16 + 4 * e4); }
  __syncthreads();
  for (int rb = gw; rb < MTOK; rb += 2 * ngw) {
    int rr[2]; bool act[2]; f32x4 v[2][4]; u32x2 mo[2][4]; float rstd[2]; int mo_[2];
#pragma unroll
    for (int u = 0; u < 2; ++u) { const int r = rb + u * ngw; rr[u] = r < MTOK ? r : MTOK - 1; act[u] = r < MTOK && !(skip_ctx && (rr[u] % TPB) < CTXL); mo_[u] = mrow_of(rr[u]) * 1024;
      const float* xr = xrow(xl, xc, rr[u]); const bf16_t* mr = MO + (size_t)rr[u] * DM;
#pragma unroll
      for (int j = 0; j < 4; ++j) { v[u][j] = *(const f32x4*)(xr + 4 * lane + 256 * j); mo[u][j] = *(const u32x2*)(mr + 4 * lane + 256 * j); } }
    if (!act[0] && !act[1]) continue;
#pragma unroll
    for (int u = 0; u < 2; ++u) if (act[u]) { float* xd = xrow(xl_dst, xc_dst, rr[u]);
#pragma unroll
      for (int j = 0; j < 4; ++j) { const int k = 4 * lane + 256 * j; const f32x4 g4 = *(const f32x4*)(mG + mo_[u] + k);
        const f32x4 m4 = (f32x4){__uint_as_float(mo[u][j].x << 16), __uint_as_float(mo[u][j].x & 0xffff0000u), __uint_as_float(mo[u][j].y << 16), __uint_as_float(mo[u][j].y & 0xffff0000u)};
        v[u][j] = v[u][j] + g4 * m4; *(f32x4*)(xd + k) = v[u][j]; } }
#pragma unroll
    for (int u = 0; u < 2; ++u) { float ss = 0.f;
#pragma unroll
      for (int j = 0; j < 4; ++j) ss += v[u][j].x * v[u][j].x + v[u][j].y * v[u][j].y + v[u][j].z * v[u][j].z + v[u][j].w * v[u][j].w;
      rstd[u] = rsqrtf(wave_sum(ss) * (1.0f / DM) + EPS); }
    float lg[2][16];
#pragma unroll
    for (int u = 0; u < 2; ++u)
#pragma unroll
      for (int e = 0; e < 16; ++e) lg[u][e] = 0.f;
#pragma unroll 1
    for (int j = 0; j < 4; ++j) { const int k = 4 * lane + 256 * j; float o[2][4];
#pragma unroll
      for (int u = 0; u < 2; ++u) { const f32x4 a4 = *(const f32x4*)(mA + mo_[u] + k), b4 = *(const f32x4*)(mB + mo_[u] + k); const f32x4 o4 = v[u][j] * rstd[u] * a4 + b4;
        o[u][0] = o4.x; o[u][1] = o4.y; o[u][2] = o4.z; o[u][3] = o4.w;
        if (act[u]) { u32x2 wpk; wpk.x = pk2bf(o4.x, o4.y); wpk.y = pk2bf(o4.z, o4.w); *(u32x2*)(H2 + (size_t)rr[u] * DM + k) = wpk; } }
#pragma unroll
      for (int q = 0; q < 4; ++q) { const float* wr_ = wl + ((q * 4 + j) * 64 + lane) * 20;
#pragma unroll
        for (int e4 = 0; e4 < 4; ++e4) { const f32x4 wr = *(const f32x4*)(wr_ + 4 * e4);
#pragma unroll
          for (int u = 0; u < 2; ++u) { lg[u][4 * e4] += o[u][q] * wr.x; lg[u][4 * e4 + 1] += o[u][q] * wr.y; lg[u][4 * e4 + 2] += o[u][q] * wr.z; lg[u][4 * e4 + 3] += o[u][q] * wr.w; } } } }
    float h1[2];
#pragma unroll
    for (int u = 0; u < 2; ++u) { float h8[8], h4[4], h2[2];
#pragma unroll
      for (int i = 0; i < 8; ++i) { const bool up = (lane & 32) != 0; const float keep = up ? lg[u][8 + i] : lg[u][i], give = up ? lg[u][i] : lg[u][8 + i]; h8[i] = keep + __shfl_xor(give, 32); }
#pragma unroll
      for (int i = 0; i < 4; ++i) { const bool up = (lane & 16) != 0; const float keep = up ? h8[4 + i] : h8[i], give = up ? h8[i] : h8[4 + i]; h4[i] = keep + __shfl_xor(give, 16); }
#pragma unroll
      for (int i = 0; i < 2; ++i) { const bool up = (lane & 8) != 0; const float keep = up ? h4[2 + i] : h4[i], give = up ? h4[i] : h4[2 + i]; h2[i] = keep + __shfl_xor(give, 8); }
      { const bool up = (lane & 4) != 0; const float keep = up ? h2[1] : h2[0], give = up ? h2[0] : h2[1]; h1[u] = keep + __shfl_xor(give, 4); }
      h1[u] += __shfl_xor(h1[u], 2); h1[u] += __shfl_xor(h1[u], 1); }
    float lx[16];
#pragma unroll
    for (int e = 0; e < 16; ++e) { const int src = ((e >> 3) & 1) * 32 + ((e >> 2) & 1) * 16 + ((e >> 1) & 1) * 8 + (e & 1) * 4;
      const float a0 = __uint_as_float(__builtin_amdgcn_readlane(__float_as_uint(h1[0]), src)), a1 = __uint_as_float(__builtin_amdgcn_readlane(__float_as_uint(h1[1]), src));
      lx[e] = lane < 32 ? a0 : a1; }
    const int us = lane >> 5;
    if ((lane & 31) == 0 && (us == 0 ? act[0] : act[1])) {
      const int r = us == 0 ? rr[0] : rr[1];
      int best = 0, bi1 = 0, bi2 = 1; float bestv = -1e30f, bs1 = 0.f, bs2 = 0.f;
#pragma unroll
      for (int gq = 0; gq < 4; ++gq) { float m1 = -1e30f, m2 = -1e30f, s1 = 0.f, s2 = 0.f; int i1 = 0, i2 = 0;
#pragma unroll
        for (int i = 0; i < 4; ++i) { const float scv = 1.0f / (1.0f + __expf(-lx[4 * gq + i])); const float sv = scv + rbias[4 * gq + i];
          if (sv > m1) { m2 = m1; s2 = s1; i2 = i1; m1 = sv; s1 = scv; i1 = i; } else if (sv > m2) { m2 = sv; s2 = scv; i2 = i; } }
        if (m1 + m2 > bestv) { bestv = m1 + m2; best = gq; bi1 = i1; bi2 = i2; bs1 = s1; bs2 = s2; } }
      const int ia = bi1 < bi2 ? bi1 : bi2, ib = bi1 < bi2 ? bi2 : bi1;
      const int tri = ia == 0 ? ib - 1 : (ia == 1 ? ib + 1 : 5);
      const int pidx = best * 6 + tri;
      const float sa = bi1 < bi2 ? bs1 : bs2, sb = bi1 < bi2 ? bs2 : bs1, inv = 1.0f / (sa + sb);
      const int rank = atomicAdd(&hist[pidx], 1);
      tok_pair[r] = pidx | (rank << 5); tok_w[2 * r] = sa * inv; tok_w[2 * r + 1] = sb * inv;
    }
  }
  __syncthreads();
  if (tid < 32) ctl[CT_CNTB + BIDX * 32 + tid] = tid < 24 ? hist[tid] : 0;
}
__device__ __forceinline__ void st_moe_gather(const bf16_t* H2, bf16_t* H2S, int* ctl, const int* tok_pair, const float* tok_w, int* sorted_tok, float* sorted_w, int* tok_slot, int skip_ctx, char* lds) {
  int* sbase = (int*)lds; int* rtot = sbase + 32; int* rpre = rtot + 512;
  const int tid = TIDX, bid = BIDX;
  { const int p = tid & 31, seg = tid >> 5; int tot = 0, pre = 0;
#pragma unroll 4
    for (int i = 0; i < 16; ++i) { const int bb = seg * 16 + i; const int cv = ctl[CT_CNTB + bb * 32 + p]; tot += cv; pre += bb < bid ? cv : 0; }
    rtot[seg * 32 + p] = tot; rpre[seg * 32 + p] = pre; }
  __syncthreads();
  if (tid < 32) { int tot = 0, pre = 0;
#pragma unroll
    for (int sg = 0; sg < 16; ++sg) { tot += rtot[sg * 32 + tid]; pre += rpre[sg * 32 + tid]; }
    rtot[tid] = tot; rpre[tid] = pre; }
  __syncthreads();
  if (tid == 0) { int base = 0, nt = 0;
#pragma unroll 1
    for (int p = 0; p < 24; ++p) { sbase[p] = base + rpre[p]; const int n = rtot[p], tl = (n + 255) >> 8;
      if (bid == 0) { ctl[CT_BASE + p] = base; for (int t = 0; t < tl; ++t) ctl[CT_TP + nt + t] = p; }
      nt += tl; base += tl * 256; }
    if (bid == 0) { ctl[CT_BASE + 24] = base; ctl[CT_NT] = nt; } }
  __syncthreads();
  const int lane = tid & 63, gw = bid * 8 + (tid >> 6), ngw = GDIM * 8;
  for (int rb = gw; rb < MTOK; rb += 3 * ngw) {
    u32x4 a0[3], a1[3]; int pk[3]; float w0[3], w1[3]; bool act[3];
#pragma unroll
    for (int u = 0; u < 3; ++u) { const int r = rb + u * ngw; act[u] = r < MTOK && !(skip_ctx && (r % TPB) < CTXL); const int rc = act[u] ? r : 0;
      pk[u] = tok_pair[rc]; w0[u] = tok_w[2 * rc]; w1[u] = tok_w[2 * rc + 1];
      const u32x4* sp = (const u32x4*)(H2 + (size_t)rc * DM); a0[u] = sp[lane]; a1[u] = sp[lane + 64]; }
#pragma unroll
    for (int u = 0; u < 3; ++u) if (act[u]) { const int r = rb + u * ngw; const int slot = sbase[pk[u] & 31] + (pk[u] >> 5);
      if (lane == 0) { sorted_tok[slot] = r; tok_slot[r] = slot; sorted_w[2 * slot] = w0[u]; sorted_w[2 * slot + 1] = w1[u]; }
      u32x4* d = (u32x4*)(H2S + (size_t)slot * DM); d[lane] = a0[u]; d[lane + 64] = a1[u]; }
  }
  __syncthreads();
}
__device__ __forceinline__ void st_final(float* xl, const float* g, const bf16_t* YS, const int* tok_slot, const float* gate  ) {
  const int lane = TIDX & 63, gw = BIDX * 8 + (TIDX >> 6), ngw = GDIM * 8;
  f32x4 gg[4];
#pragma unroll
  for (int j = 0; j < 4; ++j) gg[j] = *(const f32x4*)(g + 4 * lane + 256 * j);
  for (int rb = gw; rb < NB * SEQ; rb += 4 * ngw) {
    f32x4 v[4][4]; u32x2 ys[4][4];
#pragma unroll
    for (int u = 0; u < 4; ++u) { const int r = rb + u * ngw, rc = r < NB * SEQ ? r : NB * SEQ - 1; const float* xr = xl + (size_t)rc * DM;
      const int bb = rc >> 12, tr = bb * TPB + CTXL + (rc & 4095); const bf16_t* yr = YS + (size_t)tok_slot[tr] * DM;
#pragma unroll
      for (int j = 0; j < 4; ++j) { v[u][j] = *(const f32x4*)(xr + 4 * lane + 256 * j); ys[u][j] = *(const u32x2*)(yr + 4 * lane + 256 * j); } }
#pragma unroll
    for (int u = 0; u < 4; ++u) { const int r = rb + u * ngw, rc = r < NB * SEQ ? r : NB * SEQ - 1; const float* gt = gate + (size_t)(rc >> 12) * 6144; float ss = 0.f;
#pragma unroll
      for (int j = 0; j < 4; ++j) { const f32x4 g4 = *(const f32x4*)(gt + 4 * lane + 256 * j);
        const f32x4 m4 = (f32x4){__uint_as_float(ys[u][j].x << 16), __uint_as_float(ys[u][j].x & 0xffff0000u), __uint_as_float(ys[u][j].y << 16), __uint_as_float(ys[u][j].y & 0xffff0000u)};
        v[u][j] = v[u][j] + g4 * m4; ss += v[u][j].x * v[u][j].x + v[u][j].y * v[u][j].y + v[u][j].z * v[u][j].z + v[u][j].w * v[u][j].w; }
      const float rstd = rsqrtf(wave_sum(ss) * (1.0f / DM) + EPS);
      if (r < NB * SEQ) { float* xr = xl + (size_t)r * DM;
#pragma unroll
        for (int j = 0; j < 4; ++j) *(f32x4*)(xr + 4 * lane + 256 * j) = (f32x4){v[u][j].x * rstd * gg[j].x, v[u][j].y * rstd * gg[j].y, v[u][j].z * rstd * gg[j].z, v[u][j].w * rstd * gg[j].w}; } }
  }
}

namespace pg8 {
#define PG8_LAS __attribute__((address_space(3)))
typedef unsigned short bf16_t;
typedef short bf16x8 __attribute__((ext_vector_type(8)));
typedef float f32x4 __attribute__((ext_vector_type(4)));
typedef unsigned u32x4 __attribute__((ext_vector_type(4)));
constexpr int BM = 256, BK = 64, HALF = 128, HTB = HALF * BK * 2  , STAGE_BYTES = 8 * HTB, NXCD = 8, WGM = 8;

__host__ __device__ __forceinline__ int lds_byte(int r, int c) { const int st = (r >> 4) * 2 + (c >> 5), rr = r & 15, cc = c & 31, ob = rr * 64 + cc * 2; return st * 1024 + (ob ^ (((ob >> 9) & 1) << 5)); }
__host__ __device__ __forceinline__ void stage_rc(int b, int& R, int& C) { const int st = b / 1024, sb = b % 1024, swz = sb ^ (((sb >> 9) & 1) << 5); R = (st >> 1) * 16 + swz / 64; C = (st & 1) * 32 + (swz % 64) / 2; }
__host__ __device__ __forceinline__ int perm32(int rho) { const int n = rho >> 4, i = rho & 15; return 8 * (i >> 2) + 4 * n + (i & 3); }

struct Unit { int pm, pn, fin; const char* A; const char* B; };
struct Gemm { int K, lda, ldb; };

__device__ __forceinline__ void tile_of(int L, int nM, int nN, int& pm, int& pn) {
    const int nwg = nM * nN; int wgid = L; { const int q = nwg / NXCD, r = nwg % NXCD, xcd = wgid % NXCD, off = wgid / NXCD; wgid = (xcd < r ? xcd * (q + 1) : r * (q + 1) + (xcd - r) * q) + off; }
    const int nig = WGM * nN, gid = wgid / nig, fm = gid * WGM, gsz = (nM - fm) < WGM ? (nM - fm) : WGM;
    pm = fm + ((wgid % nig) % gsz); pn = (wgid % nig) / gsz;
}
__device__ __forceinline__ unsigned cvt_pk_bf16(float lo, float hi) { unsigned r; asm volatile("v_cvt_pk_bf16_f32 %0, %1, %2" : "=v"(r) : "v"(lo), "v"(hi)); return r; }
template <class Epi, class Sched, bool ALIGN_EPI = false, bool SP2 = false>
__device__ __forceinline__ void gemm_phase(PG8_LAS unsigned char* lds, const Gemm g, const Sched& S, const Epi& E) {
    const int tid = opq_v((int)threadIdx.x), wid = __builtin_amdgcn_readfirstlane(tid >> 6), lane = tid & 63, wr = wid >> 2, wc = wid & 3, fr = lane & 15, fq = lane >> 4;
    const int K = g.K, nt = K / BK;
    unsigned voffA[2], voffB[2];
#pragma unroll
    for (int i = 0; i < 2; ++i) { int R, C; stage_rc(tid * 16 + i * 8192, R, C); const int Rb = Epi::PERM ? ((R & ~31) + perm32(R & 31)) : R;
        voffA[i] = (unsigned)(R * g.lda + C) * 2u; voffB[i] = (unsigned)(Rb * g.ldb + C) * 2u; }
    const size_t kstep = (size_t)(BK * 2);
    const size_t hstepA = (size_t)HALF * g.lda * 2, hstepB = (size_t)HALF * g.ldb * 2;
    const unsigned ldsw = (unsigned)wid * 1024u;
    const int aoff = lds_byte(wr * 64 + fr, fq * 8), boff = lds_byte(wc * 32 + fr, fq * 8);
#define PG8_SA(b, h) (((b) * 2 + (h)) * HTB)
#define PG8_SB(b, h) ((4 + (b) * 2 + (h)) * HTB)
#define PG8_STAGE(bufoff, gbase, voff) do { _Pragma("unroll") for (int _i = 0; _i < 2; ++_i) \
        __builtin_amdgcn_global_load_lds((const unsigned*)((const char*)(gbase) + (voff)[_i]), (PG8_LAS unsigned*)(lds + (bufoff) + ldsw + _i * 8192), 16, 0, 0); } while (0)
#define PG8_LDA(dst, b, h) do { _Pragma("unroll") for (int m = 0; m < 4; ++m) _Pragma("unroll") for (int k = 0; k < 2; ++k) dst[m][k] = *(const PG8_LAS bf16x8*)(lds + PG8_SA(b, h) + aoff + m * 2048 + k * 1024); } while (0)
#define PG8_LDB(dst, b, h) do { _Pragma("unroll") for (int n = 0; n < 2; ++n) _Pragma("unroll") for (int k = 0; k < 2; ++k) dst[n][k] = *(const PG8_LAS bf16x8*)(lds + PG8_SB(b, h) + boff + n * 2048 + k * 1024); } while (0)
#define PG8_MMA(ai, bj, At, Bt) do { __builtin_amdgcn_s_setprio(1); _Pragma("unroll") for (int m = 0; m < 4; ++m) _Pragma("unroll") for (int n = 0; n < 2; ++n) _Pragma("unroll") for (int k = 0; k < 2; ++k) \
        acc[ai][bj][m][n] = __builtin_amdgcn_mfma_f32_16x16x32_bf16(Bt[n][k], At[m][k], acc[ai][bj][m][n], 0, 0, 0); __builtin_amdgcn_s_setprio(0); } while (0)
#define PG8_WAIT_V(n) asm volatile("s_waitcnt vmcnt(" #n ")" ::: "memory")
#define PG8_WAIT_L(n) asm volatile("s_waitcnt lgkmcnt(" #n ")" ::: "memory")
#define PG8_BAR __builtin_amdgcn_s_barrier()
#define PG8_SCHED __builtin_amdgcn_sched_barrier(0)
    Unit cur, nxt; int ui = 0;
    if (!S.next(0, cur)) return;
    f32x4 acc[2][2][4][2];
#pragma unroll
    for (int a = 0; a < 2; ++a)
#pragma unroll
        for (int b = 0; b < 2; ++b)
#pragma unroll
            for (int m = 0; m < 4; ++m)
#pragma unroll
                for (int n = 0; n < 2; ++n) acc[a][b][m][n] = (f32x4){0.f, 0.f, 0.f, 0.f};
    bf16x8 At[4][2], B0[2][2], B1[2][2];
    const char* cA = cur.A; const char* cB = cur.B;
    S.a_ready(cur);
    if constexpr (SP2) {
        PG8_STAGE(PG8_SB(0, 0), cB, voffB); PG8_STAGE(PG8_SB(0, 1), cB + hstepB, voffB); PG8_STAGE(PG8_SA(0, 0), cA, voffA); PG8_STAGE(PG8_SA(0, 1), cA + hstepA, voffA);
        if (wr == 1) PG8_BAR;
        PG8_WAIT_V(2); PG8_BAR;
        PG8_STAGE(PG8_SB(1, 0), cB + kstep, voffB); PG8_STAGE(PG8_SA(1, 0), cA + kstep, voffA); PG8_STAGE(PG8_SB(1, 1), cB + hstepB + kstep, voffB);
        PG8_WAIT_V(6); PG8_BAR;
    } else {
        PG8_STAGE(PG8_SB(0, 0), cB, voffB); PG8_STAGE(PG8_SA(0, 0), cA, voffA); PG8_STAGE(PG8_SB(0, 1), cB + hstepB, voffB); PG8_STAGE(PG8_SA(0, 1), cA + hstepA, voffA);
        if (wr == 1) PG8_BAR;
        PG8_WAIT_V(4); PG8_BAR;
        PG8_STAGE(PG8_SB(1, 0), cB + kstep, voffB); PG8_STAGE(PG8_SA(1, 0), cA + kstep, voffA); PG8_STAGE(PG8_SB(1, 1), cB + hstepB + kstep, voffB);
        PG8_WAIT_V(6); PG8_BAR;
    }
    for (;;) {
        const bool has_next = S.next(ui + 1, nxt);
        const char* nA = has_next ? nxt.A : cA; const char* nB = has_next ? nxt.B : cB;
        for (int t = 0; t < nt; t += 2) {
            const bool last = (t == nt - 2);
            const char* a1 = cA + (size_t)(t + 1) * kstep;
            const char* a2 = last ? nA : cA + (size_t)(t + 2) * kstep; const char* b2 = last ? nB : cB + (size_t)(t + 2) * kstep;
            const char* a3 = a2 + kstep; const char* b3 = b2 + kstep;
            if (last && has_next) S.a_ready(nxt);
            if constexpr (SP2) {
            PG8_LDB(B0, 0, 0); PG8_LDB(B1, 0, 1); PG8_SCHED; PG8_LDA(At, 0, 0); PG8_STAGE(PG8_SA(1, 1), a1 + hstepA, voffA);
            PG8_WAIT_V(8); PG8_WAIT_L(0); PG8_BAR; PG8_MMA(0, 0, At, B0); PG8_MMA(0, 1, At, B1); PG8_BAR; PG8_SCHED;
            PG8_LDA(At, 0, 1); PG8_STAGE(PG8_SB(0, 0), b2, voffB); PG8_STAGE(PG8_SB(0, 1), b2 + hstepB, voffB); PG8_STAGE(PG8_SA(0, 0), a2, voffA);
            PG8_WAIT_V(8); PG8_WAIT_L(0); PG8_BAR; PG8_MMA(1, 0, At, B0); PG8_MMA(1, 1, At, B1); PG8_BAR; PG8_SCHED;
            PG8_LDB(B0, 1, 0); PG8_LDB(B1, 1, 1); PG8_SCHED; PG8_LDA(At, 1, 0); PG8_STAGE(PG8_SA(0, 1), a2 + hstepA, voffA);
            PG8_WAIT_V(8); PG8_WAIT_L(0); PG8_BAR; PG8_MMA(0, 0, At, B0); PG8_MMA(0, 1, At, B1); PG8_BAR; PG8_SCHED;
            PG8_LDA(At, 1, 1); PG8_STAGE(PG8_SB(1, 0), b3, voffB); PG8_STAGE(PG8_SB(1, 1), b3 + hstepB, voffB); PG8_STAGE(PG8_SA(1, 0), a3, voffA);
            PG8_WAIT_V(8); PG8_WAIT_L(0); PG8_BAR; PG8_MMA(1, 0, At, B0); PG8_MMA(1, 1, At, B1); PG8_BAR; PG8_SCHED;
            } else {
            PG8_LDB(B0, 0, 0); PG8_SCHED; PG8_LDA(At, 0, 0); PG8_STAGE(PG8_SA(1, 1), a1 + hstepA, voffA);
            PG8_WAIT_L(8); PG8_BAR; PG8_WAIT_L(0); PG8_MMA(0, 0, At, B0); PG8_BAR; PG8_SCHED;
            PG8_LDB(B1, 0, 1); PG8_STAGE(PG8_SB(0, 0), b2, voffB);
            PG8_BAR; PG8_WAIT_L(0); PG8_MMA(0, 1, At, B1); PG8_BAR;
            PG8_LDA(At, 0, 1); PG8_STAGE(PG8_SA(0, 0), a2, voffA);
            PG8_BAR; PG8_WAIT_L(0); PG8_MMA(1, 0, At, B0); PG8_BAR; PG8_SCHED;
            PG8_STAGE(PG8_SB(0, 1), b2 + hstepB, voffB);
            PG8_WAIT_V(6); PG8_BAR; PG8_MMA(1, 1, At, B1); PG8_BAR;
            PG8_LDB(B0, 1, 0); PG8_SCHED; PG8_LDA(At, 1, 0); PG8_STAGE(PG8_SA(0, 1), a2 + hstepA, voffA);
            PG8_WAIT_L(8); PG8_BAR; PG8_WAIT_L(0); PG8_MMA(0, 0, At, B0); PG8_BAR; PG8_SCHED;
            PG8_LDB(B1, 1, 1); PG8_STAGE(PG8_SB(1, 0), b3, voffB);
            PG8_BAR; PG8_WAIT_L(0); PG8_MMA(0, 1, At, B1); PG8_BAR;
            PG8_LDA(At, 1, 1); PG8_STAGE(PG8_SA(1, 0), a3, voffA);
            PG8_BAR; PG8_WAIT_L(0); PG8_MMA(1, 0, At, B0); PG8_BAR; PG8_SCHED;
            PG8_STAGE(PG8_SB(1, 1), b3 + hstepB, voffB);
            PG8_WAIT_V(6); PG8_BAR; PG8_MMA(1, 1, At, B1); PG8_BAR;
            }
        }
        if constexpr (ALIGN_EPI) { if (wr == 0) PG8_BAR; }
        if constexpr (!Epi::AFTER_DRAIN) { if (cur.fin) { E(acc, cur, wr, wc, fr, fq); S.done(cur); } }
        if (!has_next) break;
        if (cur.fin) {
#pragma unroll
        for (int a = 0; a < 2; ++a)
#pragma unroll
            for (int b = 0; b < 2; ++b)
#pragma unroll
                for (int m = 0; m < 4; ++m)
#pragma unroll
                    for (int n = 0; n < 2; ++n) acc[a][b][m][n] = (f32x4){0.f, 0.f, 0.f, 0.f};
        }
        cur = nxt; cA = nA; cB = nB; ++ui;
        if constexpr (ALIGN_EPI) { if (wr == 1) PG8_BAR; }
    }
    PG8_WAIT_V(0);
    if constexpr (!ALIGN_EPI) { if (wr == 0) PG8_BAR; }
    PG8_BAR;
    if constexpr (Epi::AFTER_DRAIN) { E.fused(acc, cur, wr, wc, fr, fq, lds, wid, lane); S.done(cur); }
#undef PG8_SA
#undef PG8_SB
#undef PG8_STAGE
#undef PG8_LDA
#undef PG8_LDB
#undef PG8_MMA
#undef PG8_WAIT_V
#undef PG8_WAIT_L
#undef PG8_BAR
#undef PG8_SCHED
}
}

struct SchedDense {
  int nM, nN, G, c, skip_ctx; const char* A; const char* B; size_t a_tile, b_tile;
  __device__ __forceinline__ bool next(int i, pg8::Unit& u) const {
    const long L = (long)i * G + c; if (L >= (long)nM * nN) return false;
    int pm, pn; pg8::tile_of((int)L, nM, nN, pm, pn); if (skip_ctx) pm = pm + pm / 16 + 1;
    u.pm = pm; u.pn = pn; u.fin = 1; u.A = A + (size_t)pm * a_tile; u.B = B + (size_t)pn * b_tile; return true; }
  __device__ __forceinline__ void a_ready(const pg8::Unit&) const {}
  __device__ __forceinline__ void done(const pg8::Unit&) const {}
};
struct SchedMoe {
  int G, c, mode; const int* ctl; const char* A; size_t a_tile; const char* W;
  __device__ __forceinline__ bool next(int i, pg8::Unit& u) const {
    const int part = mode == 2 ? (i & 1) : 0, iu = mode == 2 ? (i >> 1) : i;
    const long L = (long)iu * G + c; const int ntiles = ctl[CT_NT]; if (L >= (long)ntiles * 4) return false;
    const int pm = (int)(L >> 2), pn = (int)(L & 3); int eA, eB; pair_experts(ctl[CT_TP + pm], eA, eB);
    u.pm = pm; u.pn = pn;
    if (mode == 1) { const int e = pn < 2 ? eA : eB; u.fin = 1; u.A = A + (size_t)pm * a_tile; u.B = W + (size_t)e * (512 * 1024 * 2) + (size_t)(pn & 1) * (256 * 1024 * 2); }
    else { u.fin = part; u.A = A + (size_t)pm * a_tile + part * 512; u.B = W + (size_t)(part ? eB : eA) * (1024 * 256 * 2) + (size_t)pn * (256 * 256 * 2); }
    return true; }
  __device__ __forceinline__ void a_ready(const pg8::Unit&) const {}
  __device__ __forceinline__ void done(const pg8::Unit&) const {}
};
__device__ __forceinline__ unsigned cvt_pk(float lo, float hi) { return pg8::cvt_pk_bf16(lo, hi); }
struct EpiInProj {
  static constexpr bool PERM = true, AFTER_DRAIN = false; bf16_t *QK, *VZ, *XBC, *HY; float* DT;
  __device__ __forceinline__ void operator()(const f32x4 (&acc)[2][2][4][2], const pg8::Unit& u, int wr, int wc, int fr, int fq) const {
    const int pn = u.pn; bf16_t* base; int ldc, coff;
    if (pn < 2) { base = QK; ldc = 512; coff = pn * 256; } else if (pn < 4) { base = VZ; ldc = 512; coff = (pn - 2) * 256; }
    else if (pn < 7) { base = XBC; ldc = 768; coff = (pn - 4) * 256; } else { base = HY; ldc = 768; coff = (pn - 7) * 256; }
    const int row0 = u.pm * 256 + wr * 64 + fr, col0 = coff + wc * 32 + 8 * fq; const bool dtl = (pn == 6 && wc == 0 && fq < 2);
#pragma unroll
    for (int ai = 0; ai < 2; ++ai)
#pragma unroll
      for (int m = 0; m < 4; ++m) { const int row = row0 + ai * 128 + m * 16; bf16_t* rowp = base + (size_t)row * ldc + col0;
#pragma unroll
        for (int bj = 0; bj < 2; ++bj) { const f32x4 v0 = acc[ai][bj][m][0], v1 = acc[ai][bj][m][1];
          u32x4 w; w.x = cvt_pk(v0[0], v0[1]); w.y = cvt_pk(v0[2], v0[3]); w.z = cvt_pk(v1[0], v1[1]); w.w = cvt_pk(v1[2], v1[3]);
          *(u32x4*)(rowp + bj * 128) = w;
          if (bj == 1 && dtl) { float* dp = DT + (size_t)row * 12 + 8 * fq; *(f32x4*)dp = v0; if (fq == 0) *(f32x4*)(dp + 4) = v1; } } }
  }
};
struct EpiOutProj {
  static constexpr bool PERM = true, AFTER_DRAIN = false; bf16_t* MO;
  __device__ __forceinline__ void operator()(const f32x4 (&acc)[2][2][4][2], const pg8::Unit& u, int wr, int wc, int fr, int fq) const {
    const int row0 = u.pm * 256 + wr * 64 + fr, col0 = u.pn * 256 + wc * 32 + 8 * fq;
#pragma unroll
    for (int ai = 0; ai < 2; ++ai)
#pragma unroll
      for (int m = 0; m < 4; ++m) { bf16_t* rowp = MO + (size_t)(row0 + ai * 128 + m * 16) * DM + col0;
#pragma unroll
        for (int bj = 0; bj < 2; ++bj) { const f32x4 v0 = acc[ai][bj][m][0], v1 = acc[ai][bj][m][1];
          u32x4 w; w.x = cvt_pk(v0[0], v0[1]); w.y = cvt_pk(v0[2], v0[3]); w.z = cvt_pk(v1[0], v1[1]); w.w = cvt_pk(v1[2], v1[3]);
          *(u32x4*)(rowp + bj * 128) = w; } }
  }
};
struct EpiMoe1 {
  static constexpr bool PERM = true, AFTER_DRAIN = false; bf16_t* ACT; const float* sorted_w;
  __device__ __forceinline__ void operator()(const f32x4 (&acc)[2][2][4][2], const pg8::Unit& u, int wr, int wc, int fr, int fq) const {
    const int half = u.pn >> 1, j0 = (u.pn & 1) * 128 + 16 * wc + 4 * fq;
#pragma unroll
    for (int ai = 0; ai < 2; ++ai)
#pragma unroll
      for (int m = 0; m < 4; ++m) { const int slot = u.pm * 256 + ai * 128 + wr * 64 + m * 16 + fr; const float wt = sorted_w[2 * slot + half];
#pragma unroll
        for (int bj = 0; bj < 2; ++bj) { const f32x4 v0 = acc[ai][bj][m][0], v1 = acc[ai][bj][m][1];
          u32x2 w; w.x = cvt_pk(siluf(v0[0]) * v0[1] * wt, siluf(v0[2]) * v0[3] * wt); w.y = cvt_pk(siluf(v1[0]) * v1[1] * wt, siluf(v1[2]) * v1[3] * wt);
          *(u32x2*)(ACT + (size_t)slot * 512 + half * 256 + j0 + 64 * bj) = w; } }
  }
};
struct EpiMoe2 {
  static constexpr bool PERM = true, AFTER_DRAIN = false; bf16_t* YS;
  __device__ __forceinline__ void operator()(const f32x4 (&acc)[2][2][4][2], const pg8::Unit& u, int wr, int wc, int fr, int fq) const {
    const int row0 = u.pm * 256 + wr * 64 + fr, col0 = u.pn * 256 + wc * 32 + 8 * fq;
#pragma unroll
    for (int ai = 0; ai < 2; ++ai)
#pragma unroll
      for (int m = 0; m < 4; ++m) { bf16_t* rowp = YS + (size_t)(row0 + ai * 128 + m * 16) * DM + col0;
#pragma unroll
        for (int bj = 0; bj < 2; ++bj) { const f32x4 v0 = acc[ai][bj][m][0], v1 = acc[ai][bj][m][1];
          u32x4 w; w.x = cvt_pk(v0[0], v0[1]); w.y = cvt_pk(v0[2], v0[3]); w.z = cvt_pk(v1[0], v1[1]); w.w = cvt_pk(v1[2], v1[3]);
          *(u32x4*)(rowp + bj * 128) = w; } }
  }
};

#include <hip/hip_bf16.h>
#include <cmath>
namespace attn_body {
using bf16=__hip_bfloat16;
using bf16x8=__attribute__((ext_vector_type(8)))short;
using s16x4=__attribute__((ext_vector_type(4)))short;
using f32x16=__attribute__((ext_vector_type(16)))float;
using u32x4=__attribute__((ext_vector_type(4)))unsigned;
constexpr int D=64,QP=512,KP=512,VP=512,OP=1024;
constexpr int NW=8,QBLK=32,QB=QBLK*NW,KVBLK=64;
constexpr int ATTN_UNIT_ROWS=QB;
__device__ __forceinline__ int crow(int r,int hi){return (r&3)+8*(r>>2)+4*hi;}
#define SBAR() __builtin_amdgcn_sched_barrier(0)
__device__ __forceinline__ void cmask(f32x16&p0,f32x16&p1,int jb,int qrel,int hi){
  const float NEG=-INFINITY; int kb=64*jb+4*hi;
  #pragma unroll
  for(int r=0;r<16;++r){int kv=kb+(r&3)+8*(r>>2); if(kv>qrel)p0[r]=NEG; if(kv+32>qrel)p1[r]=NEG;}
}

constexpr int NSLOT=3, SLOTB=8192;
constexpr int LDS_K=0, LDS_V=NSLOT*SLOTB, LDS_WS=2*NSLOT*SLOTB, LDS_OST=LDS_WS+NW*64*4, LDS_BYTES=LDS_OST+NW*4096;
constexpr float C2=0.125f*1.4426950408889634f;
__device__ __forceinline__ void glds16(const void*gsrc,unsigned lds_dst){unsigned keep;
  asm volatile("s_mov_b32 %0, m0\n\ts_mov_b32 m0, %2\n\ts_nop 0\n\tglobal_load_lds_dwordx4 %1, off\n\ts_mov_b32 m0, %0":"=&s"(keep):"v"(gsrc),"s"(lds_dst):"memory");}
__device__ __forceinline__ float max3f(float a,float b,float c){float r;asm("v_max3_f32 %0, %1, %2, %3":"=v"(r):"v"(a),"v"(b),"v"(c));return r;}
__device__ __forceinline__ float max2f(float a,float b){float r;asm("v_max_f32_e32 %0, %1, %2":"=v"(r):"v"(a),"v"(b));return r;}
__device__ __forceinline__ float fadd_s(float a,float b){float r;asm("v_add_f32_e32 %0, %1, %2":"=v"(r):"v"(a),"v"(b));return r;}
__device__ __forceinline__ float fsub_s(float a,float b){float r;asm("v_sub_f32_e32 %0, %1, %2":"=v"(r):"v"(a),"v"(b));return r;}
typedef float f32x2_t __attribute__((ext_vector_type(2))); typedef __bf16 bf16x2_t __attribute__((ext_vector_type(2)));
__device__ __forceinline__ unsigned cvtpk_s(float lo,float hi){f32x2_t v={lo,hi};bf16x2_t b=__builtin_convertvector(v,bf16x2_t);return __builtin_bit_cast(unsigned,b);}
#define WAIT_BAR(N) asm volatile("s_waitcnt vmcnt(" #N ") lgkmcnt(0)\n\ts_barrier":::"memory")

__device__ __forceinline__ void qkt(f32x16&p0,f32x16&p1,const char*Kslot,const bf16x8*qr,const f32x16&negm,int r32,int hi){
  const char*kb=Kslot+hi*1024+r32*16;
  #pragma unroll
  for(int d0=0;d0<4;++d0){
    const bf16x8 b0=*reinterpret_cast<const bf16x8*>(kb+d0*2048);
    const bf16x8 b1=*reinterpret_cast<const bf16x8*>(kb+d0*2048+512);
    if(d0==0){p0=__builtin_amdgcn_mfma_f32_32x32x16_bf16(b0,qr[0],negm,0,0,0);p1=__builtin_amdgcn_mfma_f32_32x32x16_bf16(b1,qr[0],negm,0,0,0);}
    else{p0=__builtin_amdgcn_mfma_f32_32x32x16_bf16(b0,qr[d0],p0,0,0,0);p1=__builtin_amdgcn_mfma_f32_32x32x16_bf16(b1,qr[d0],p1,0,0,0);}}
}
typedef __attribute__((address_space(3))) const char* lds_cptr;
typedef short v4i16_t __attribute__((ext_vector_type(4)));
__device__ __forceinline__ void kload8(bf16x8*kf,lds_cptr kp){
  kf[0]=*(const __attribute__((address_space(3))) bf16x8*)(kp);      kf[1]=*(const __attribute__((address_space(3))) bf16x8*)(kp+512);
  kf[2]=*(const __attribute__((address_space(3))) bf16x8*)(kp+2048); kf[3]=*(const __attribute__((address_space(3))) bf16x8*)(kp+2560);
  kf[4]=*(const __attribute__((address_space(3))) bf16x8*)(kp+4096); kf[5]=*(const __attribute__((address_space(3))) bf16x8*)(kp+4608);
  kf[6]=*(const __attribute__((address_space(3))) bf16x8*)(kp+6144); kf[7]=*(const __attribute__((address_space(3))) bf16x8*)(kp+6656);
}
__device__ __forceinline__ void kload2(bf16x8*kf,lds_cptr kp,int j){ kf[2*j]=*(const __attribute__((address_space(3))) bf16x8*)(kp+j*2048); kf[2*j+1]=*(const __attribute__((address_space(3))) bf16x8*)(kp+j*2048+512); }
__device__ __forceinline__ s16x4 vtr(lds_cptr p){ return __builtin_bit_cast(s16x4,__builtin_amdgcn_ds_read_tr16_b64_v4i16((__attribute__((address_space(3))) v4i16_t*)p)); }
__device__ __forceinline__ float rowmax(const f32x16&p0,const f32x16&p1){
  float a=max3f(p0[0],p0[1],p1[0]),b=max3f(p0[2],p0[3],p1[1]);a=max3f(a,p1[2],p1[3]);
  #pragma unroll
  for(int r=4;r<16;r+=4){a=max3f(a,p0[r],p0[r+1]);b=max3f(b,p0[r+2],p0[r+3]);a=max3f(a,p1[r],p1[r+1]);b=max3f(b,p1[r+2],p1[r+3]);}
  const float m=max2f(a,b);
  auto rr=__builtin_amdgcn_permlane32_swap(__float_as_uint(m),__float_as_uint(m),false,false);
  return max2f(__uint_as_float(rr[0]),__uint_as_float(rr[1]));
}
__device__ __forceinline__ void pv(f32x16*o,int vb,bf16x8 pa0,bf16x8 pa1,bf16x8 pa2,bf16x8 pa3){
  #pragma unroll
  for(int d0=0;d0<2;++d0){s16x4 lo[4],hi[4];
    #pragma unroll
    for(int ks=0;ks<4;++ks){
      asm volatile("ds_read_b64_tr_b16 %0,%1 offset:%c2":"=&v"(lo[ks]):"v"(vb),"i"(d0*4096+ks*1024):"memory");
      asm volatile("ds_read_b64_tr_b16 %0,%1 offset:%c2":"=&v"(hi[ks]):"v"(vb),"i"(d0*4096+ks*1024+512):"memory");}
    asm volatile("s_waitcnt lgkmcnt(0)":::"memory");SBAR();
    #define PK(k) (bf16x8){lo[k][0],lo[k][1],lo[k][2],lo[k][3],hi[k][0],hi[k][1],hi[k][2],hi[k][3]}
    o[d0]=__builtin_amdgcn_mfma_f32_32x32x16_bf16(pa0,PK(0),o[d0],0,0,0);
    o[d0]=__builtin_amdgcn_mfma_f32_32x32x16_bf16(pa1,PK(1),o[d0],0,0,0);
    o[d0]=__builtin_amdgcn_mfma_f32_32x32x16_bf16(pa2,PK(2),o[d0],0,0,0);
    o[d0]=__builtin_amdgcn_mfma_f32_32x32x16_bf16(pa3,PK(3),o[d0],0,0,0);
    #undef PK
  }
}

#ifndef ATTN_STORE16
#define ATTN_STORE16(p,v) (*(u32x4*)(p)=(v))
#endif
template<int THRL> __device__ __forceinline__ void attn_unit(const bf16*Qu,const bf16*__restrict__ Kh,const bf16*__restrict__ Vh,bf16*Ou,const int NT,char*shm){
  const int tid=opq_v((int)threadIdx.x),lane=tid&63,r32=lane&31,hi=lane>>5; const int wid=__builtin_amdgcn_readfirstlane(tid>>6);
  const bf16*Qw=Qu+(long)(wid*QBLK)*QP;
  const unsigned lds0=(unsigned)(uintptr_t)shm;
  float*wsf=(float*)(shm+LDS_WS)+wid*64;
  const bf16*ksrc=Kh+(long)lane*KP+wid*8;
  const bf16*vsrc=Vh+(long)(16*(wid&3)+(lane>>2))*VP+(wid>>2)*32+(lane&3)*8;
  const unsigned kdst=lds0+LDS_K+wid*1024, vdst=lds0+LDS_V+wid*1024;
  #define DMA_K(t,slot) glds16(ksrc+(long)(t)*KVBLK*KP,(unsigned)__builtin_amdgcn_readfirstlane(kdst+(slot)))
  #define DMA_V(t,slot) glds16(vsrc+(long)(t)*KVBLK*VP,(unsigned)__builtin_amdgcn_readfirstlane(vdst+(slot)))
  const int vb0=(int)(lds0+LDS_V)+((lane>>4)&1)*32+(lane&3)*8+(4*hi+((lane&15)>>2))*64;
  const char*Kbase=shm+LDS_K; bf16x8 kf[8];
  const lds_cptr shm3=(lds_cptr)shm; const lds_cptr kp0=shm3+LDS_K+hi*1024+r32*16; const lds_cptr vp0=shm3+LDS_V+((lane>>4)&1)*32+(lane&3)*8+(4*hi+((lane&15)>>2))*64;
  DMA_K(0,0);DMA_V(0,0);DMA_K(1,SLOTB);
  bf16x8 qr[4];
  #pragma unroll
  for(int d0=0;d0<4;++d0)qr[d0]=*reinterpret_cast<const bf16x8*>(&Qw[(long)r32*QP+d0*16+hi*8]);
  float mhat=0.f,l_reg=0.f;float z0_=0.f;asm volatile("":"+v"(z0_));f32x16 o[2];f32x16 negm;
  _Pragma("unroll") for(int r=0;r<16;++r){o[0][r]=z0_;o[1][r]=z0_;negm[r]=z0_;} asm volatile("":"+v"(negm));
  #define CMASK(P0,P1,t) do{}while(0)
  bool resc=false;
  #define START(P0,P1) do{ const float rm=rowmax(P0,P1); resc=false; \
    { const float dl=rm; mhat=fadd_s(mhat,dl); \
      _Pragma("unroll") for(int r=0;r<16;++r){P0[r]=fsub_s(P0[r],dl);P1[r]=fsub_s(P1[r],dl);} \
      _Pragma("unroll") for(int r=0;r<16;++r)negm[r]=-mhat; asm volatile("":"+v"(negm)); } \
    _Pragma("unroll") for(int r=0;r<16;++r)P0[r]=__builtin_amdgcn_exp2f(P0[r]); }while(0)
  #define RESC() do{ if(resc){ asm volatile("s_waitcnt lgkmcnt(0)":::"memory"); \
      _Pragma("unroll") for(int d_=0;d_<2;++d_) _Pragma("unroll") for(int r=0;r<16;++r)o[d_][r]*=wsf[crow(r,hi)]; } }while(0)
  f32x16 pA0,pA1,pB0,pB1;
  int sl_prev=0,sl_cur=0,sl_next=SLOTB;
  #define ROT() do{sl_prev=sl_cur;sl_cur=sl_next;sl_next=(sl_next==(NSLOT-1)*SLOTB)?0:sl_next+SLOTB;}while(0)
  DMA_K(2,2*SLOTB);
  WAIT_BAR(3);
  qkt(pA0,pA1,Kbase,qr,negm,r32,hi);asm volatile("s_nop 15\n\ts_nop 7":"+v"(pA0),"+v"(pA1));CMASK(pA0,pA1,0);
  START(pA0,pA1);
  _Pragma("unroll") for(int r=0;r<16;++r)pA1[r]=__builtin_amdgcn_exp2f(pA1[r]);
  WAIT_BAR(0);
  DMA_K(3,0);DMA_V(1,SLOTB);
  ROT();
  kload8(kf,kp0+sl_cur);
  WAIT_BAR(2);
  s16x4 vlo[8],vhi[8]; u32x4 pw0,pw1,pw2,pw3;
  #define PKW(P,B) cvtpk_s(P[B],P[B+1])
  #define PAF(k) __builtin_bit_cast(bf16x8,pw##k)
  #define VFR(i) (bf16x8){vlo[i][0],vlo[i][1],vlo[i][2],vlo[i][3],vhi[i][0],vhi[i][1],vhi[i][2],vhi[i][3]}
  #define PIN(x) asm volatile("":"+v"(x))
  #define MX3(a,b,c) __builtin_fmaxf(__builtin_fmaxf((a),(b)),(c))
  #define GAPA(MF,A0,A1,A2,A3,W0,W1,PW) do{ MF; sacc+=A0; sacc+=A1; sacc+=A2; sacc+=A3; PIN(sacc); W0; W1; PIN(PW); SBAR(); }while(0)
  #define EX(v) __builtin_amdgcn_exp2f(v)
  #define GAPB(MF,X,B) do{ MF; X[B]=EX(X[B]); X[B+1]=EX(X[B+1]); X[B+2]=EX(X[B+2]); X[B+3]=EX(X[B+3]); PIN(X); SBAR(); }while(0)
  #define VRD(i) do{ vlo[i]=vtr(vp_+(((i)>>2)*4096+((i)&3)*1024)); vhi[i]=vtr(vp_+(((i)>>2)*4096+((i)&3)*1024+512)); }while(0)
  #define KRD(G,j) do{ if(G){ kload2(kf,kp0+sl_next,j); SBAR(); } }while(0)
  #define STEP(C0,C1,P0,P1,t,GK,GV,GL) do{ SBAR(); \
    const lds_cptr vp_=vp0+sl_prev; \
    VRD(0); SBAR(); float sacc=(P0[0]+P0[1]); \
    GAPA(C0=__builtin_amdgcn_mfma_f32_32x32x16_bf16(kf[0],qr[0],negm,0,0,0), P0[2],P0[3],P0[4],P0[5],     pw0[0]=PKW(P0,0), pw0[1]=PKW(P0,2), pw0); \
    VRD(4); SBAR(); GAPA(C1=__builtin_amdgcn_mfma_f32_32x32x16_bf16(kf[1],qr[0],negm,0,0,0), P0[6],P0[7],P0[8],P0[9],     pw0[2]=PKW(P0,4), pw0[3]=PKW(P0,6), pw0); \
    VRD(1); SBAR(); GAPA(C0=__builtin_amdgcn_mfma_f32_32x32x16_bf16(kf[2],qr[1],C0,0,0,0),   P0[10],P0[11],P0[12],P0[13], pw1[0]=PKW(P0,8), pw1[1]=PKW(P0,10), pw1); \
    VRD(5); SBAR(); GAPA(C1=__builtin_amdgcn_mfma_f32_32x32x16_bf16(kf[3],qr[1],C1,0,0,0),   P0[14],P0[15],P1[0],P1[1],   pw1[2]=PKW(P0,12),pw1[3]=PKW(P0,14), pw1); \
    VRD(2); SBAR(); GAPA(C0=__builtin_amdgcn_mfma_f32_32x32x16_bf16(kf[4],qr[2],C0,0,0,0),   P1[2],P1[3],P1[4],P1[5],     pw2[0]=PKW(P1,0), pw2[1]=PKW(P1,2), pw2); \
    VRD(6); SBAR(); GAPA(C1=__builtin_amdgcn_mfma_f32_32x32x16_bf16(kf[5],qr[2],C1,0,0,0),   P1[6],P1[7],P1[8],P1[9],     pw2[2]=PKW(P1,4), pw2[3]=PKW(P1,6), pw2); \
    VRD(3); SBAR(); GAPA(C0=__builtin_amdgcn_mfma_f32_32x32x16_bf16(kf[6],qr[3],C0,0,0,0),   P1[10],P1[11],P1[12],P1[13], pw3[0]=PKW(P1,8), pw3[1]=PKW(P1,10), pw3); \
    VRD(7); SBAR(); GAPA(C1=__builtin_amdgcn_mfma_f32_32x32x16_bf16(kf[7],qr[3],C1,0,0,0),   P1[14],P1[15],0.f,0.f,       pw3[2]=PKW(P1,12),pw3[3]=PKW(P1,14), pw3); \
    l_reg+=sacc; \
    if(GK){DMA_K((t)+3,sl_cur);} if(GV){DMA_V((t)+1,sl_next);} \
    CMASK(C0,C1,t); \
    { float a=MX3(C0[0],C0[1],C1[0]),b=MX3(C0[2],C0[3],C1[1]); a=MX3(a,C1[2],C1[3]); \
      _Pragma("unroll") for(int r=4;r<16;r+=4){a=MX3(a,C0[r],C0[r+1]);b=MX3(b,C0[r+2],C0[r+3]);a=MX3(a,C1[r],C1[r+1]);b=MX3(b,C1[r+2],C1[r+3]);} \
      float rm=__builtin_fmaxf(a,b); { auto rr=__builtin_amdgcn_permlane32_swap(__float_as_uint(rm),__float_as_uint(rm),false,false); rm=__builtin_fmaxf(__uint_as_float(rr[0]),__uint_as_float(rr[1])); } \
      resc=false; \
      if(__builtin_expect(__any(rm>(float)THRL),0)){ const float dl=__builtin_fmaxf(rm,0.f); mhat+=dl; \
        _Pragma("unroll") for(int r=0;r<16;++r){C0[r]-=dl;C1[r]-=dl;} \
        _Pragma("unroll") for(int r=0;r<16;++r)negm[r]=-mhat; asm volatile("":"+v"(negm)); \
        const float f=__builtin_amdgcn_exp2f(-dl); l_reg*=f; if(hi==0)wsf[r32]=f; resc=true; } } \
    SBAR(); \
    GAPB(o[0]=__builtin_amdgcn_mfma_f32_32x32x16_bf16(PAF(0),VFR(0),o[0],0,0,0), C0,0); \
    GAPB(o[1]=__builtin_amdgcn_mfma_f32_32x32x16_bf16(PAF(0),VFR(4),o[1],0,0,0), C0,4); \
    KRD(GL,0); GAPB(o[0]=__builtin_amdgcn_mfma_f32_32x32x16_bf16(PAF(1),VFR(1),o[0],0,0,0), C0,8); \
    KRD(GL,1); GAPB(o[1]=__builtin_amdgcn_mfma_f32_32x32x16_bf16(PAF(1),VFR(5),o[1],0,0,0), C0,12); \
    KRD(GL,2); GAPB(o[0]=__builtin_amdgcn_mfma_f32_32x32x16_bf16(PAF(2),VFR(2),o[0],0,0,0), C1,0); \
    KRD(GL,3); GAPB(o[1]=__builtin_amdgcn_mfma_f32_32x32x16_bf16(PAF(2),VFR(6),o[1],0,0,0), C1,4); \
    GAPB(o[0]=__builtin_amdgcn_mfma_f32_32x32x16_bf16(PAF(3),VFR(3),o[0],0,0,0), C1,8); \
    GAPB(o[1]=__builtin_amdgcn_mfma_f32_32x32x16_bf16(PAF(3),VFR(7),o[1],0,0,0), C1,12); \
    }while(0)
  int t=1;
  for(;t+5<NT;t+=2){
    STEP(pB0,pB1,pA0,pA1,t,true,true,true);     WAIT_BAR(2); RESC(); ROT();
    STEP(pA0,pA1,pB0,pB1,t+1,true,true,true);   WAIT_BAR(2); RESC(); ROT();
  }
  #define ENDW(tt) do{ if((tt)+3<NT){WAIT_BAR(2);} else if((tt)+2<NT){WAIT_BAR(1);} else {WAIT_BAR(0);} }while(0)
  for(;t+1<NT;t+=2){
    STEP(pB0,pB1,pA0,pA1,t,(t+3<NT),(t+1<NT),(t+1<NT));       ENDW(t);   RESC(); ROT();
    STEP(pA0,pA1,pB0,pB1,t+1,(t+4<NT),(t+2<NT),(t+2<NT));     ENDW(t+1); RESC(); ROT();
  }
  STEP(pB0,pB1,pA0,pA1,NT-1,false,false,false); RESC();
  { float sacc=pB0[0]+pB0[1]; _Pragma("unroll") for(int r=2;r<16;++r)sacc+=pB0[r]; _Pragma("unroll") for(int r=0;r<16;++r)sacc+=pB1[r]; l_reg+=sacc;
    pw0=(u32x4){PKW(pB0,0),PKW(pB0,2),PKW(pB0,4),PKW(pB0,6)};pw1=(u32x4){PKW(pB0,8),PKW(pB0,10),PKW(pB0,12),PKW(pB0,14)};pw2=(u32x4){PKW(pB1,0),PKW(pB1,2),PKW(pB1,4),PKW(pB1,6)};pw3=(u32x4){PKW(pB1,8),PKW(pB1,10),PKW(pB1,12),PKW(pB1,14)};
    SBAR(); pv(o,vb0+sl_cur,PAF(0),PAF(1),PAF(2),PAF(3)); }
  #undef PKW
  #undef PAF
  #undef VFR
  #undef PIN
  #undef MX3
  #undef GAPA
  #undef GAPB
  #undef EX
  #undef VRD
  #undef KRD
  #undef STEP
  #undef ENDW
  {auto rr=__builtin_amdgcn_permlane32_swap(__float_as_uint(l_reg),__float_as_uint(l_reg),false,false);l_reg=__uint_as_float(rr[0])+__uint_as_float(rr[1]);}
  if(hi==0)wsf[32+r32]=l_reg;asm volatile("s_waitcnt lgkmcnt(0)":::"memory");
  float rli[16];
  #pragma unroll
  for(int r=0;r<16;++r)rli[r]=__builtin_amdgcn_rcpf(wsf[32+crow(r,hi)]);
  bf16*Ow=Ou+(long)(wid*QBLK)*OP;
  { bf16*stg=(bf16*)(shm+LDS_OST)+wid*2048;
    #pragma unroll
    for(int r=0;r<16;++r){const int orow=crow(r,hi);
      #pragma unroll
      for(int d0=0;d0<2;++d0)stg[orow*64+d0*32+r32]=__float2bfloat16(o[d0][r]*rli[r]);}
    asm volatile("s_waitcnt lgkmcnt(0)":::"memory");
    #pragma unroll
    for(int i=0;i<4;++i){const int row=i*8+(lane>>3),ch=lane&7; const u32x4 v=*(const u32x4*)(stg+row*64+ch*8); ATTN_STORE16(Ow+(long)row*OP+ch*8,v);} }
  asm volatile("s_waitcnt lgkmcnt(0)\n\ts_barrier":::"memory");
  #undef DMA_K
  #undef DMA_V
  #undef CMASK
  #undef START
  #undef RESC
  #undef ROT
}
constexpr int ATTN_LDS_BYTES=LDS_BYTES;
#undef SBAR
#undef WAIT_BAR
}


namespace hyf {
struct c32 { float x, y; };
typedef _Float16 h2 __attribute__((ext_vector_type(2)));
__device__ __forceinline__ c32 operator+(c32 a, c32 b) { return {a.x + b.x, a.y + b.y}; }
__device__ __forceinline__ c32 operator-(c32 a, c32 b) { return {a.x - b.x, a.y - b.y}; }
__device__ __forceinline__ c32 cmul(c32 a, c32 b) { return {a.x * b.x - a.y * b.y, a.x * b.y + a.y * b.x}; }
__device__ __forceinline__ constexpr float C32(int k) {
  switch (k) { case 0: return 1.f; case 1: return 0.98078528f; case 2: return 0.923879533f; case 3: return 0.831469612f; case 4: return 0.707106781f; case 5: return 0.555570233f; case 6: return 0.382683432f;
    case 7: return 0.195090322f; case 8: return 0.f; case 9: return -0.195090322f; case 10: return -0.382683432f; case 11: return -0.555570233f; case 12: return -0.707106781f; case 13: return -0.831469612f;
    case 14: return -0.923879533f; default: return -0.98078528f; } }
__device__ __forceinline__ constexpr float S32(int k) {
  switch (k) { case 0: return 0.f; case 1: return 0.195090322f; case 2: return 0.382683432f; case 3: return 0.555570233f; case 4: return 0.707106781f; case 5: return 0.831469612f; case 6: return 0.923879533f;
    case 7: return 0.98078528f; case 8: return 1.f; case 9: return 0.98078528f; case 10: return 0.923879533f; case 11: return 0.831469612f; case 12: return 0.707106781f; case 13: return 0.555570233f;
    case 14: return 0.382683432f; default: return 0.195090322f; } }
__device__ __forceinline__ constexpr int brev(int q, int bits) {
  return bits == 4 ? (((q & 1) << 3) | ((q & 2) << 1) | ((q & 4) >> 1) | ((q & 8) >> 3))
                   : (((q & 1) << 4) | ((q & 2) << 2) | (q & 4) | ((q & 8) >> 2) | ((q & 16) >> 4)); }
__device__ __forceinline__ int phys(int p) { return p + (p >> 5); }
template <int R, int HALF, bool INV> struct DftStage {
  static __device__ __forceinline__ void run(c32 (&x)[R]) {
#pragma unroll
    for (int blk = 0; blk < R; blk += 2 * HALF) {
#pragma unroll
      for (int j = 0; j < HALF; ++j) {
        const c32 a = x[blk + j], b = x[blk + j + HALF]; x[blk + j] = a + b; const c32 d = a - b;
        const int e = j * (R / (2 * HALF)) * (32 / R);
        if (e == 0) x[blk + j + HALF] = d;
        else if (e == 8) x[blk + j + HALF] = INV ? (c32){-d.y, d.x} : (c32){d.y, -d.x};
        else { const c32 wv = {C32(e), INV ? S32(e) : -S32(e)}; x[blk + j + HALF] = cmul(d, wv); }
      } }
    DftStage<R, HALF / 2, INV>::run(x);
  }
};
template <int R, bool INV> struct DftStage<R, 0, INV> { static __device__ __forceinline__ void run(c32 (&)[R]) {} };
template <int R, bool INV> __device__ __forceinline__ void dft_pow2(c32 (&x)[R]) { DftStage<R, R / 2, INV>::run(x); }
template <int R, int HALF> struct DitStage {
  static __device__ __forceinline__ void run(c32 (&x)[R]) {
#pragma unroll
    for (int blk = 0; blk < R; blk += 2 * HALF) {
#pragma unroll
      for (int j = 0; j < HALF; ++j) {
        const int e = j * (R / (2 * HALF)) * (32 / R);
        const c32 a = x[blk + j], b0 = x[blk + j + HALF];
        c32 b;
        if (e == 0) b = b0; else if (e == 8) b = (c32){-b0.y, b0.x}; else b = cmul(b0, (c32){C32(e), S32(e)});
        x[blk + j] = a + b; x[blk + j + HALF] = a - b;
      } }
    DitStage<R, HALF * 2>::run(x);
  }
};
template <int R> struct DitStage<R, R> { static __device__ __forceinline__ void run(c32 (&)[R]) {} };
template <int R> __device__ __forceinline__ void idft_dit(c32 (&x)[R]) { DitStage<R, 1>::run(x); }
template <int STRIDE, bool INV> __device__ __forceinline__ void pass16(c32* buf, int e0, float rev) {
  float rv = rev; asm volatile("" : "+v"(rv));
  const float cs = __builtin_amdgcn_cosf(rv), sn = __builtin_amdgcn_sinf(rv);
  const c32 w1 = {cs, INV ? sn : -sn};
  c32* p = buf + phys(e0); constexpr int PS = STRIDE + STRIDE / 32;
  c32 x[16];
  if (!INV) {
#pragma unroll
    for (int m = 0; m < 16; ++m) x[m] = p[PS * m];
    dft_pow2<16, false>(x);
    c32 w = w1; p[0] = x[0];
#pragma unroll
    for (int q = 1; q < 16; ++q) { p[PS * q] = cmul(x[brev(q, 4)], w); w = cmul(w, w1); }
  } else {
    c32 w = w1; x[0] = p[0];
#pragma unroll
    for (int q = 1; q < 16; ++q) { x[q] = cmul(p[PS * q], w); w = cmul(w, w1); }
    dft_pow2<16, true>(x);
#pragma unroll
    for (int m = 0; m < 16; ++m) p[PS * m] = x[brev(m, 4)];
  }
}
template <int MODE> __device__ __forceinline__ void mid32(c32* buf, h2* Hs, int j) {
  c32* p = buf + 33 * j; c32 x[32];
#pragma unroll
  for (int m = 0; m < 32; ++m) x[m] = p[m];
  dft_pow2<32, false>(x);
  if (MODE == 0) {
#pragma unroll
    for (int q = 0; q < 32; ++q) { const c32 v = x[brev(q, 5)]; Hs[q * 256 + j] = (h2){(_Float16)v.x, (_Float16)v.y}; }
  } else {
#pragma unroll
    for (int pp = 0; pp < 32; ++pp) { const h2 hv = Hs[brev(pp, 5) * 256 + j]; x[pp] = cmul(x[pp], (c32){(float)hv.x, (float)hv.y}); }
    idft_dit<32>(x);
#pragma unroll
    for (int m = 0; m < 32; ++m) p[m] = x[m];
  }
}
__device__ __forceinline__ void fwd2(c32* buf, int tid) {
  __syncthreads(); pass16<512, false>(buf, tid, (float)tid * (1.0f / 8192.0f));
  __syncthreads(); pass16<32, false>(buf, (tid >> 5) * 512 + (tid & 31), (float)(tid & 31) * (1.0f / 512.0f));
  __syncthreads();
}
__device__ __forceinline__ void conv(c32* buf, h2* Hs, int tid) {
  fwd2(buf, tid);
  if (tid < 256) mid32<1>(buf, Hs, tid);
  __syncthreads(); pass16<32, true>(buf, (tid >> 5) * 512 + (tid & 31), (float)(tid & 31) * (1.0f / 512.0f));
  __syncthreads(); pass16<512, true>(buf, tid, (float)tid * (1.0f / 8192.0f));
  __syncthreads();
}
__device__ __forceinline__ void item(int c, const bf16_t* HYT, const float* HK, const float* hy_bias, bf16_t* HYO, char* lds) {
  c32* buf = (c32*)lds; h2* H0 = (h2*)(lds + 67584); h2* H1 = H0 + 8192;
  const int tid = TIDX;
#pragma unroll 1
  for (int o = 0; o < 2; ++o) {
    const float* kp = HK + ((size_t)o * 256 + c) * 8192;
#pragma unroll
    for (int i = 0; i < 16; ++i) { const int n = tid + 512 * i; buf[phys(n)] = (c32){kp[n], 0.f}; }
    fwd2(buf, tid);
    if (tid < 256) mid32<0>(buf, o ? H1 : H0, tid);
    __syncthreads();
  }
  const float bias0 = hy_bias[c], bias1 = hy_bias[256 + c];
#pragma unroll 1
  for (int pr = 0; pr < 2; ++pr) {
    const bf16_t* v0 = HYT + ((size_t)(2 * pr) * 768 + c) * SEQ; const bf16_t* v1 = v0 + (size_t)768 * SEQ;
    c32 vv[8];
#pragma unroll
    for (int i = 0; i < 8; ++i) { const int t = tid + 512 * i; vv[i] = (c32){bf2f(v0[t]), bf2f(v1[t])}; buf[phys(t)] = vv[i]; buf[phys(t + 4096)] = (c32){0.f, 0.f}; }
    conv(buf, H0, tid);
#pragma unroll
    for (int i = 0; i < 8; ++i) { const int t = tid + 512 * i; const c32 y = buf[phys(t)];
      vv[i] = (c32){bf2f(v0[(size_t)256 * SEQ + t]) * (y.x * (1.0f / 8192.0f) + bias0 * vv[i].x), bf2f(v1[(size_t)256 * SEQ + t]) * (y.y * (1.0f / 8192.0f) + bias0 * vv[i].y)};
      buf[phys(t)] = vv[i]; buf[phys(t + 4096)] = (c32){0.f, 0.f}; }
    conv(buf, H1, tid);
#pragma unroll
    for (int i = 0; i < 8; ++i) { const int t = tid + 512 * i; const c32 y = buf[phys(t)];
      HYO[((size_t)(2 * pr) * 256 + c) * SEQ + t] = (bf16_t)f2bf(bf2f(v0[(size_t)512 * SEQ + t]) * (y.x * (1.0f / 8192.0f) + bias1 * vv[i].x));
      HYO[((size_t)(2 * pr + 1) * 256 + c) * SEQ + t] = (bf16_t)f2bf(bf2f(v1[(size_t)512 * SEQ + t]) * (y.y * (1.0f / 8192.0f) + bias1 * vv[i].y)); }
    __syncthreads();
  }
}
__device__ __forceinline__ void out_item(int it, const bf16_t* HYO, bf16_t* MIX, char* lds) {
  bf16_t (*T)[72] = (bf16_t (*)[72])lds;
  const int tid = TIDX, b = it >> 8, t0 = ((it >> 2) & 63) * 64, c0 = (it & 3) * 64;
  { const int cc = tid >> 3, t8 = (tid & 7) * 8; *(u32x4*)&T[cc][t8] = *(const u32x4*)(HYO + ((size_t)b * 256 + c0 + cc) * SEQ + t0 + t8); }
  __syncthreads();
  { const int tl = tid >> 3, c8 = (tid & 7) * 8; u32x4 o;
    o.x = (unsigned)T[c8][tl] | ((unsigned)T[c8 + 1][tl] << 16); o.y = (unsigned)T[c8 + 2][tl] | ((unsigned)T[c8 + 3][tl] << 16);
    o.z = (unsigned)T[c8 + 4][tl] | ((unsigned)T[c8 + 5][tl] << 16); o.w = (unsigned)T[c8 + 6][tl] | ((unsigned)T[c8 + 7][tl] << 16);
    *(u32x4*)(MIX + ((size_t)b * TPB + CTXL + t0 + tl) * DM + 768 + c0 + c8) = o; }
  __syncthreads();
}
}

#define LAS __attribute__((address_space(3)))
#define XB_TMO      128
#define XB_XCNT(j)  (256  + 64 * (j))
#define XB_XSUB(j)  (1280 + 64 * (j))
#define XB_XGEN(j)  (2304 + 64 * (j))
#define XB_TOP      3328
#define XB_TOPGEN   3392
#define XCD_BAR_WORDS 3456
#define XB_SPIN_CAP (1u << 18)

__device__ __forceinline__ unsigned xb_ld(unsigned* p)              { return __hip_atomic_load(p, __ATOMIC_RELAXED, __HIP_MEMORY_SCOPE_AGENT); }
__device__ __forceinline__ unsigned xb_add(unsigned* p, unsigned v) { return __hip_atomic_fetch_add(p, v, __ATOMIC_RELAXED, __HIP_MEMORY_SCOPE_AGENT); }
__device__ __forceinline__ unsigned xb_xcc_id() { return (unsigned)__builtin_amdgcn_s_getreg((3 << 11) | 20) & 0xFu; }
#define XB_SPIN(cond, bar) do { unsigned _sp = 0; while (cond) { __builtin_amdgcn_s_sleep(1); \
    if ((++_sp & 255u) == 0u) { if (xb_ld(&(bar)[XB_TMO])) break; if (_sp > XB_SPIN_CAP) { atomicAdd(&(bar)[XB_TMO], 1u); break; } } } } while (0)

struct XcdBarrier {
    unsigned* bar; unsigned x;
    volatile LAS unsigned* st;
};

__device__ __forceinline__ XcdBarrier xcd_barrier_post(unsigned* bar, volatile LAS unsigned* st) {
    XcdBarrier b; b.bar = bar; b.x = xb_xcc_id(); b.st = st;
    if (threadIdx.x == 0) (void)xb_add(&bar[XB_XCNT(b.x)], 1u);
    return b;
}
__device__ __forceinline__ void xcd_barrier_complete(unsigned* bar, unsigned x, unsigned& nloc, unsigned& nx) {
    const unsigned G = gridDim.x * gridDim.y * gridDim.z;
    unsigned sum, cnt, mine, sp = 0u;
    for (;;) {
        sum = 0u; cnt = 0u; mine = 0u;
#pragma unroll
        for (unsigned j = 0; j < 16; ++j) { const unsigned c = xb_ld(&bar[XB_XCNT(j)]); sum += c; cnt += (c > 0u) ? 1u : 0u; mine = (j == x) ? c : mine; }
        if (sum == G) break;
        __builtin_amdgcn_s_sleep(1);
        if ((++sp & 255u) == 0u) { if (xb_ld(&bar[XB_TMO])) break; if (sp > XB_SPIN_CAP) { atomicAdd(&bar[XB_TMO], 1u); break; } }
    }
    nloc = mine > 0u ? mine : 1u; nx = cnt > 0u ? cnt : 1u;
}

__device__ __forceinline__ void xcd_barrier(const XcdBarrier& b) {
    asm volatile("s_waitcnt vmcnt(0)" ::: "memory");
    __syncthreads();
    if (threadIdx.x == 0) {
        unsigned* bar = b.bar;
        __builtin_amdgcn_s_waitcnt(0);
        unsigned nloc = b.st[0], nx = b.st[1];
        if (nloc == 0u) { xcd_barrier_complete(bar, b.x, nloc, nx); b.st[0] = nloc; b.st[1] = nx; }
        const unsigned old = xb_add(&bar[XB_XSUB(b.x)], 1u);
        const unsigned gen = old / nloc;
        if (old + 1u == (gen + 1u) * nloc) {
            __builtin_amdgcn_fence(__ATOMIC_RELEASE, "agent");
            asm volatile("s_waitcnt vmcnt(0)" ::: "memory");
            const unsigned og = xb_add(&bar[XB_TOP], 1u);
            const unsigned tg = og / nx;
            if (og + 1u == (tg + 1u) * nx) xb_add(&bar[XB_TOPGEN], 1u);
            else XB_SPIN(xb_ld(&bar[XB_TOPGEN]) == tg, bar);
            __builtin_amdgcn_fence(__ATOMIC_ACQUIRE, "agent");
            xb_add(&bar[XB_XGEN(b.x)], 1u);
            asm volatile("s_waitcnt vmcnt(0)" ::: "memory");
        } else {
            XB_SPIN(xb_ld(&bar[XB_XGEN(b.x)]) == gen, bar);
            __builtin_amdgcn_fence(__ATOMIC_ACQUIRE, "agent");
            asm volatile("s_waitcnt vmcnt(0)" ::: "memory");
        }
    }
    __syncthreads();
}


struct MP { const float* in[33]; float* out; unsigned char* ws; };
typedef const float* const __attribute__((address_space(4))) * kargs_t;
#define KARGS() ({ kargs_t k_ = (kargs_t)__builtin_amdgcn_kernarg_segment_ptr(); asm volatile("" : "+s"(k_)); k_; })
#define WSP(K, off) ((unsigned char*)(K)[34] + (off))

__global__ void __launch_bounds__(NT, 2) mega(MP P) {
  cg::grid_group grid = cg::this_grid();
  extern __shared__ __attribute__((aligned(16))) char lds[];
  volatile LAS unsigned* xst = (volatile LAS unsigned*)(lds + LDS_BYTES - 16);
  if (threadIdx.x < 2) xst[threadIdx.x] = 0u;
  __syncthreads();
  { kargs_t K = KARGS(); (void)xcd_barrier_post((unsigned*)WSP(K, WS_CTL) + CT_BAR, xst); }
#define XBAR_HERE() do { kargs_t Kb_ = KARGS(); XcdBarrier xb_; xb_.bar = (unsigned*)WSP(Kb_, WS_CTL) + CT_BAR; xb_.x = xb_xcc_id(); xb_.st = (volatile LAS unsigned*)(lds + LDS_BYTES - 16); xcd_barrier(xb_); } while (0)
#define SEAM() XBAR_HERE()
  {
    kargs_t K = KARGS();
    st_adaln(K[1], K[3], K[4], K[5], (float*)WSP(K, WS_MODV), lds);
    st_rope((float*)WSP(K, WS_ROPE));
  }
  {
      kargs_t K = KARGS();
      st_weights(K[8], K[26], K[29], K[30], K[31], 0, (bf16_t*)WSP(K, WS_WIN), (bf16_t*)WSP(K, WS_WOUT), (bf16_t*)WSP(K, WS_WGU), (bf16_t*)WSP(K, WS_WD), lds);
    }
    { kargs_t K = KARGS(); const int bid = BIDX, G = GDIM;
      for (int it = bid; it < SEQ / 16; it += G) hyfilt_item<SEQ>(it, K[19] + 0 * 33 * 64, K[20] + 0 * 64, K[21] + 0 * 64, K[22] + 0 * 4096, K[23] + 0 * 64, K[24] + (size_t)0 * 65536, (float*)WSP(K, WS_HK), lds);
      if (true) for (int it = bid; it < CTXL / 16; it += G) hyfilt_item<CTXL>(it, K[19] + 0 * 33 * 64, K[20] + 0 * 64, K[21] + 0 * 64, K[22] + 0 * 4096, K[23] + 0 * 64, K[24] + (size_t)0 * 65536, (float*)WSP(K, WS_HKC), lds);
    }
  if (gridDim.x == 0x7fffffffu) grid.sync();
  XBAR_HERE();
#pragma nounroll
  for (int layer = 0; layer < 2; ++layer) {
    const bool last = layer == 1;
    if (layer == 1) {
    {
      kargs_t K = KARGS();
      st_weights(K[8], K[26], K[29], K[30], K[31], layer, (bf16_t*)WSP(K, WS_WIN), (bf16_t*)WSP(K, WS_WOUT), (bf16_t*)WSP(K, WS_WGU), (bf16_t*)WSP(K, WS_WD), lds);
    }
    { kargs_t K = KARGS(); const int bid = BIDX, G = GDIM;
      for (int it = bid; it < SEQ / 16; it += G) hyfilt_item<SEQ>(it, K[19] + layer * 33 * 64, K[20] + layer * 64, K[21] + layer * 64, K[22] + layer * 4096, K[23] + layer * 64, K[24] + (size_t)layer * 65536, (float*)WSP(K, WS_HK), lds);
      if (!last) for (int it = bid; it < CTXL / 16; it += G) hyfilt_item<CTXL>(it, K[19] + layer * 33 * 64, K[20] + layer * 64, K[21] + layer * 64, K[22] + layer * 4096, K[23] + layer * 64, K[24] + (size_t)layer * 65536, (float*)WSP(K, WS_HKC), lds);
    }
    }
    { kargs_t K = KARGS();
      const float* xl_src = layer == 0 ? K[0] : K[33]; const float* xc_src = layer == 0 ? K[2] : (const float*)WSP(K, WS_XC);
      st_normmod(xl_src, xc_src, (float*)K[33], (float*)WSP(K, WS_XC), layer == 0 ? (const bf16_t*)nullptr : (const bf16_t*)WSP(K, WS_H2S), (const int*)WSP(K, WS_MOEM + 768 * 1024),
                 (const float*)WSP(K, WS_MODV) + 5120, K[6] + layer * 1024, (const float*)WSP(K, WS_MODV) + (size_t)layer * 5 * 6144, 0, 1024, (bf16_t*)WSP(K, WS_H), lds);
    }
    SEAM();
    {
      kargs_t K = KARGS();
      pg8::Gemm g{1024, 1024, 1024}; SchedDense S{MTOK / 256, NPAD / 256, (int)GDIM, BIDX, 0, (const char*)WSP(K, WS_H), (const char*)WSP(K, WS_WIN), (size_t)256 * 1024 * 2, (size_t)256 * 1024 * 2};
      EpiInProj E{(bf16_t*)WSP(K, WS_QK), (bf16_t*)WSP(K, WS_VZ), (bf16_t*)WSP(K, WS_XBC), (bf16_t*)WSP(K, WS_HY), (float*)WSP(K, WS_DT)};
      pg8::gemm_phase<EpiInProj, SchedDense, true, true>((PG8_LAS unsigned char*)lds, g, S, E);
    }
    SEAM();
    {
      kargs_t K = KARGS();
      st_prep_qk((bf16_t*)WSP(K, WS_QK), K[9] + layer * 64, K[10] + layer * 64, (const float*)WSP(K, WS_ROPE));
    }
    { kargs_t K = KARGS();
      st_prep_hy((const bf16_t*)WSP(K, WS_HY), K[17] + layer * 3 * 768, K[18] + layer * 768, (bf16_t*)WSP(K, WS_HYT), last ? 0 : 1, lds);
    }
    { kargs_t K = KARGS();
      st_ssd1(BIDX, GDIM, 4 * 34 * 6, (const bf16_t*)WSP(K, WS_XBC), (const float*)WSP(K, WS_DT), K[11] + layer * 3 * 640, K[12] + layer * 640, K[13] + layer * 12, K[14] + layer * 12,
              (float*)WSP(K, WS_Y), (float*)WSP(K, WS_ST), (float*)WSP(K, WS_DEC), lds);
    }
    SEAM();
    {
      { kargs_t K2 = KARGS(); st_ssd_scan2((float*)WSP(K2, WS_ST), (const float*)WSP(K2, WS_DEC)); }
      const int bid = BIDX, G = GDIM;
#define P4_ATT(bb, hq, qrow_, nt_) do { kargs_t K = KARGS(); const int kvh_ = (hq) / 3; \
          const attn_body::bf16* QKp = (const attn_body::bf16*)WSP(K, WS_QK); const attn_body::bf16* VZp = (const attn_body::bf16*)WSP(K, WS_VZ); \
          attn_body::attn_unit<8>(QKp + (size_t)(qrow_) * 512 + (hq) * 64, QKp + (size_t)(bb) * TPB * 512 + 384 + kvh_ * 64, VZp + (size_t)(bb) * TPB * 512 + kvh_ * 64, \
                                  (attn_body::bf16*)WSP(K, WS_H) + (size_t)(qrow_) * 1024 + (hq) * 64, (nt_), lds); } while (0)
#define P4_FFT(cch) do { kargs_t K = KARGS(); hyf::item((cch), (const bf16_t*)WSP(K, WS_HYT), (const float*)WSP(K, WS_HK), K[25] + layer * 512, (bf16_t*)WSP(K, WS_HY), lds); } while (0)
#define P4_CHY(itm) do { kargs_t K = KARGS(); hyconv_ctx_item((itm), (const bf16_t*)WSP(K, WS_HYT) + (size_t)4 * 768 * SEQ, (const float*)WSP(K, WS_HKC), K[25] + layer * 512, (bf16_t*)WSP(K, WS_H), lds); } while (0)
      {
        const int x = bid & 7, y = bid >> 3, bb = x >> 1, kvh = x & 1;
        const int nun = y < 16 ? 2 : 1, natt = nun + ((!last && y < 3) ? 1 : 0);
#pragma unroll 1
        for (int k = 0; k < natt; ++k) { int hq, qrow, nt;
          if (k < nun) { const int v = y < 16 ? y + 16 * k : 16 + y; hq = 3 * kvh + (v >> 4); qrow = bb * TPB + CTXL + (v & 15) * 256; nt = TPB / 64; }
          else { hq = 3 * kvh + y; qrow = bb * TPB; nt = CTXL / 64; }
          P4_ATT(bb, hq, qrow, nt); }
        if (y >= 16) {
#pragma unroll 1
          for (int k = 0; k < 2; ++k) { const int cch = ((y - 16) * 8 + x) * 2 + k; P4_FFT(cch); } }
        if (!last && y >= 3 && y < 11) { P4_CHY((y - 3) * 8 + x); }
      }
      (void)G;
#undef P4_ATT
#undef P4_FFT
#undef P4_CHY
    }
    SEAM();
    {
      kargs_t K = KARGS();
      { const int bid = BIDX, G = GDIM, nit = last ? 4 * 32 * 2 : 4 * 34 * 2;
        for (int it = bid; it < nit; it += G) { const int g = it & 1, bc = it >> 1; const int b = last ? bc >> 5 : bc / 34, cidx = last ? 2 + (bc & 31) : bc % 34;
          ssd3_item(b, cidx, g, (const bf16_t*)WSP(K, WS_XBC), (const bf16_t*)WSP(K, WS_VZ), (const float*)WSP(K, WS_DT), K[11] + layer * 3 * 640, K[12] + layer * 640, K[13] + layer * 12, K[14] + layer * 12,
                    K[15] + layer * 6, K[16] + layer * 384, (const float*)WSP(K, WS_Y), (const float*)WSP(K, WS_ST), (bf16_t*)WSP(K, WS_H), lds); } }
      { const int bid = BIDX, G = GDIM; for (int it = bid; it < 1024; it += G) hyf::out_item(it, (const bf16_t*)WSP(K, WS_HY), (bf16_t*)WSP(K, WS_H), lds); }
      const int t = TIDX; if (BIDX == 0 && t < 256) ((int*)WSP(K, WS_CTL))[t] = 0;
      { int* stok = (int*)WSP(K, WS_MOEM + 384 * 1024); for (int i = BIDX * NT + t; i < MOE_ROWS; i += GDIM * NT) stok[i] = -1; }
    }
    SEAM();
    {
      kargs_t K = KARGS();
      const float* xl_src = layer == 0 ? K[0] : K[33]; const float* xc_src = layer == 0 ? K[2] : (const float*)WSP(K, WS_XC);
      pg8::Gemm g{1024, 1024, 1024}; SchedDense S{last ? 64 : 68, 4, (int)GDIM, BIDX, last ? 1 : 0, (const char*)WSP(K, WS_H), (const char*)WSP(K, WS_WOUT), (size_t)256 * 1024 * 2, (size_t)256 * 1024 * 2};
      EpiOutProj E{(bf16_t*)WSP(K, WS_QK)};
      pg8::gemm_phase<EpiOutProj, SchedDense, true, true>((PG8_LAS unsigned char*)lds, g, S, E);
    }
    SEAM();
    {
      kargs_t K = KARGS();
      st_router(layer == 0 ? K[0] : K[33], layer == 0 ? K[2] : (const float*)WSP(K, WS_XC), (float*)K[33], (float*)WSP(K, WS_XC), (const bf16_t*)WSP(K, WS_QK), K[7] + layer * 1024, (const float*)WSP(K, WS_MODV) + (size_t)layer * 5 * 6144, K[27], K[28], (bf16_t*)WSP(K, WS_H), (int*)WSP(K, WS_CTL),
                (int*)WSP(K, WS_MOEM), (float*)WSP(K, WS_MOEM + 128 * 1024), last ? 1 : 0, lds);
    }
    SEAM();
    { kargs_t K = KARGS();
      st_moe_gather((const bf16_t*)WSP(K, WS_H), (bf16_t*)WSP(K, WS_H2S), (int*)WSP(K, WS_CTL), (const int*)WSP(K, WS_MOEM), (const float*)WSP(K, WS_MOEM + 128 * 1024),
                    (int*)WSP(K, WS_MOEM + 384 * 1024), (float*)WSP(K, WS_MOEM + 512 * 1024), (int*)WSP(K, WS_MOEM + 768 * 1024), last ? 1 : 0, lds);
    }
    SEAM();
    { kargs_t K = KARGS();
      pg8::Gemm g{1024, 1024, 1024}; SchedMoe S{(int)GDIM, BIDX, 1, (const int*)WSP(K, WS_CTL), (const char*)WSP(K, WS_H2S), (size_t)256 * 1024 * 2, (const char*)WSP(K, WS_WGU)};
      EpiMoe1 E{(bf16_t*)WSP(K, WS_ACT), (const float*)WSP(K, WS_MOEM + 512 * 1024)};
      pg8::gemm_phase<EpiMoe1, SchedMoe, true, true>((PG8_LAS unsigned char*)lds, g, S, E);
    }
    SEAM();
    { kargs_t K = KARGS();
      pg8::Gemm g{256, 512, 256}; SchedMoe S{(int)GDIM, BIDX, 2, (const int*)WSP(K, WS_CTL), (const char*)WSP(K, WS_ACT), (size_t)256 * 512 * 2, (const char*)WSP(K, WS_WD)};
      EpiMoe2 E{(bf16_t*)WSP(K, WS_H2S)};
      pg8::gemm_phase<EpiMoe2, SchedMoe, true, true>((PG8_LAS unsigned char*)lds, g, S, E);
    }
    SEAM();
  }
  { kargs_t K = KARGS(); st_final((float*)K[33], K[32], (const bf16_t*)WSP(K, WS_H2S), (const int*)WSP(K, WS_MOEM + 768 * 1024), (const float*)WSP(K, WS_MODV) + (size_t)5 * 6144 + 5120); }
}

extern "C" void kernel_launch(void* const* d_in, const int* in_sizes, int n_in, void* d_out, int out_size, void* d_ws, size_t ws_size, hipStream_t stream) {
  if (n_in != 33 || ws_size < WS_END) { fprintf(stderr, "kernel_launch: unexpected n_in %d / ws %zu\n", n_in, ws_size); return; }
  static int grid_blocks = 0;
  if (!grid_blocks) {
    int dev = 0, cus = 0, per_cu = 0;
    (void)hipGetDevice(&dev);
    (void)hipDeviceGetAttribute(&cus, hipDeviceAttributeMultiprocessorCount, dev);
    (void)hipFuncSetAttribute((const void*)mega, hipFuncAttributeMaxDynamicSharedMemorySize, LDS_BYTES);
    (void)hipOccupancyMaxActiveBlocksPerMultiprocessor(&per_cu, mega, NT, LDS_BYTES);
    if (per_cu < 1) per_cu = 1;
    if (per_cu > 2) per_cu = 2;
    grid_blocks = 256;
    if (cus != 256 || per_cu < 1) fprintf(stderr, "kernel_launch: expected 256 CUs with >= 1 workgroup each (got %d CUs, %d per CU)\n", cus, per_cu);
  }
  (void)hipMemsetAsync((char*)d_ws + WS_CTL + (size_t)CT_BAR * 4, 0, (size_t)XCD_BAR_WORDS * 4, stream);
  MP p{};
  for (int i = 0; i < 33; ++i) p.in[i] = (const float*)d_in[i];
  p.out = (float*)d_out; p.ws = (unsigned char*)d_ws;
  void* args[] = {&p};
  hipError_t e = hipLaunchCooperativeKernel((const void*)mega, dim3(grid_blocks), dim3(NT), args, LDS_BYTES, stream);
  if (e != hipSuccess) fprintf(stderr, "cooperative launch failed: %s (grid %d)\n", hipGetErrorString(e), grid_blocks);
}
```

```cpp
#include <hip/hip_runtime.h>
#include <hip/hip_cooperative_groups.h>
#include <cstdio>
#include <cstdint>
namespace cg = cooperative_groups;

typedef unsigned short bf16_t;
typedef short bf16x8 __attribute__((ext_vector_type(8)));
typedef float f32x4 __attribute__((ext_vector_type(4)));
typedef unsigned u32x4 __attribute__((ext_vector_type(4)));
typedef unsigned u32x2 __attribute__((ext_vector_type(2)));

constexpr int NB = 4, SEQ = 4096, CTXL = 256, DM = 1024, TPB = 4352, MTOK = NB * TPB;
constexpr int DIN = 2444, NPAD = 2560;
constexpr float EPS = 1e-6f;
constexpr float C2 = 0.125f * 1.4426950408889634f;
constexpr int MOE_ROWS = 23552;
constexpr int NT = 512;
constexpr int LDS_BYTES = 147456;

constexpr size_t MiB = 1u << 20;
constexpr size_t WS_CTL = 0;
constexpr size_t WS_MODV = 1 * MiB;
constexpr size_t WS_ROPE = 2 * MiB;
constexpr size_t WS_MOEM = 3 * MiB;
constexpr size_t WS_DT = 4 * MiB;
constexpr size_t WS_HKC = 5 * MiB;
constexpr size_t WS_XC = 6 * MiB;
constexpr size_t WS_WIN = 10 * MiB;
constexpr size_t WS_WOUT = 15 * MiB;
constexpr size_t WS_WGU = 17 * MiB;
constexpr size_t WS_WD = 33 * MiB;
constexpr size_t WS_HK = 41 * MiB;
constexpr size_t WS_H = 57 * MiB;
constexpr size_t WS_QK = 91 * MiB;
constexpr size_t WS_VZ = 108 * MiB;
constexpr size_t WS_XBC = 125 * MiB;
constexpr size_t WS_HY = WS_XBC + (size_t)MTOK * 768 * 2;
constexpr size_t WS_HYT = WS_HY + (size_t)MTOK * 768 * 2;
constexpr size_t WS_ST = WS_HYT + (size_t)MTOK * 768 * 2;
constexpr size_t WS_Y = WS_ST + (size_t)4 * 34 * 2 * 6 * 4096 * 4;
constexpr size_t WS_END = WS_Y + (size_t)MTOK * 384 * 4;
constexpr size_t WS_DEC = WS_DT + 900 * 1024;
constexpr size_t WS_H2S = WS_QK;
constexpr size_t WS_ACT = WS_H2S + (size_t)MOE_ROWS * 1024 * 2;
static_assert(WS_END <= 256 * MiB, "ws");
static_assert(WS_ACT + (size_t)MOE_ROWS * 512 * 2 <= WS_HYT, "moe alias");

constexpr int CT_CNT = 0, CT_FILL = 32, CT_BASE = 64, CT_NT = 96, CT_TP = 128;
constexpr int CT_BAR = 4096;
constexpr int CT_CNTB = 8192;

__device__ __forceinline__ int opq_v(int v) { asm volatile("" : "+v"(v)); return v; }
__device__ __forceinline__ int opq_s(int v) { asm volatile("" : "+s"(v)); return v; }
#define TIDX opq_v((int)threadIdx.x)
#define BIDX opq_s((int)blockIdx.x)
#define GDIM opq_s((int)gridDim.x)
__device__ __forceinline__ unsigned f2bf(float f) { unsigned u = __float_as_uint(f); return (u + 0x7fffu + ((u >> 16) & 1u)) >> 16; }
__device__ __forceinline__ unsigned pk2bf(float lo, float hi) { return f2bf(lo) | (f2bf(hi) << 16); }
__device__ __forceinline__ float bf2f(bf16_t h) { return __uint_as_float(((unsigned)h) << 16); }
__device__ __forceinline__ float wave_sum(float v) {
#pragma unroll
  for (int o = 1; o < 64; o <<= 1) v += __shfl_xor(v, o);
  return v;
}
__device__ __forceinline__ float siluf(float v) { return v / (1.0f + __expf(-v)); }
__device__ __forceinline__ float* xrow(const float* xl, const float* xc, int r) {
  const int b = r / TPB, j = r - b * TPB;
  return (float*)(j < CTXL ? xc + ((size_t)b * CTXL + j) * DM : xl + ((size_t)b * SEQ + (j - CTXL)) * DM);
}
__device__ __forceinline__ int mrow_of(int r) { const int b = r / TPB, j = r - b * TPB; return j < CTXL ? 4 : b; }

__device__ __forceinline__ void st_adaln(const float* c, const float* c_ctx, const float* w_mod, const float* b_mod, float* modv, char* lds) {
  float (*sc)[1024] = (float (*)[1024])lds;
  float (*red)[5][64] = (float (*)[5][64])(lds + 5 * 1024 * 4);
  const int tid = TIDX;
  for (int it = BIDX; it < 192; it += GDIM) {
    const int layer = it / 96, n0 = (it % 96) * 64;
    for (int i = tid; i < 5 * 1024; i += NT) { const int r = i >> 10, k = i & 1023; const float v = r < 4 ? c[r * 1024 + k] : c_ctx[k]; sc[r][k] = v / (1.0f + expf(-v)); }
    __syncthreads();
    const int kg = tid >> 6, n = tid & 63;
    float acc[5] = {0.f, 0.f, 0.f, 0.f, 0.f};
#pragma unroll 16
    for (int k = kg; k < 1024; k += 8) { const float w = w_mod[((size_t)layer * 1024 + k) * 6144 + n0 + n];
#pragma unroll
      for (int r = 0; r < 5; ++r) acc[r] += sc[r][k] * w; }
#pragma unroll
    for (int r = 0; r < 5; ++r) red[kg][r][n] = acc[r];
    __syncthreads();
    if (tid < 320) { const int r = tid >> 6, nn = tid & 63; float s = 0.f;
#pragma unroll
      for (int g = 0; g < 8; ++g) s += red[g][r][nn];
      modv[((size_t)layer * 5 + r) * 6144 + n0 + nn] = s + b_mod[layer * 6144 + n0 + nn]; }
    __syncthreads();
  }
}
__device__ __forceinline__ void st_rope(float* rope) {
  for (int i = BIDX * NT + TIDX; i < 4096 * 32; i += GDIM * NT) {
    const int t = i >> 5, d = i & 31, m = d & 15;
    const float inv = exp2f(-(float)(2 * m) * (13.287712379549449f / 32.0f));
    const float pos = (float)(d < 16 ? (t >> 6) : (t & 63));
    float rev = pos * inv * 0.15915494309189535f; rev -= floorf(rev);
    rope[2 * i] = __builtin_amdgcn_cosf(rev); rope[2 * i + 1] = __builtin_amdgcn_sinf(rev);
  }
}

__device__ __forceinline__ void st_normmod(const float* xl, const float* xc, float* xl_dst, float* xc_dst, const bf16_t* YS, const int* tok_slot, const float* gate_prev,
                                           const float* g, const float* modv_layer, int off_sh, int off_sc, bf16_t* H, char* lds) {
  float* mA = (float*)lds; float* mB = mA + 5 * 1024; float* mG = mB + 5 * 1024;
  const int tid = TIDX, lane = tid & 63, gw = BIDX * 8 + (tid >> 6), ngw = GDIM * 8;
  for (int idx = tid; idx < 5 * 1024; idx += NT) { const int m = idx >> 10, k = idx & 1023; mA[idx] = g[k] * (1.f + modv_layer[(size_t)m * 6144 + off_sc + k]); mB[idx] = modv_layer[(size_t)m * 6144 + off_sh + k];
    mG[idx] = YS ? gate_prev[(size_t)m * 6144 + k] : 0.f; }
  __syncthreads();
  for (int rb = gw; rb < MTOK; rb += 3 * ngw) {
    f32x4 v[3][4]; u32x2 ys[3][4]; float rstd[3];
#pragma unroll
    for (int u = 0; u < 3; ++u) { const int r = rb + u * ngw, rc = r < MTOK ? r : MTOK - 1; const float* xr = xrow(xl, xc, rc);
#pragma unroll
      for (int j = 0; j < 4; ++j) v[u][j] = *(const f32x4*)(xr + 4 * lane + 256 * j);
      if (YS) { const bf16_t* yr = YS + (size_t)tok_slot[rc] * DM;
#pragma unroll
        for (int j = 0; j < 4; ++j) ys[u][j] = *(const u32x2*)(yr + 4 * lane + 256 * j); } }
    if (YS) {
#pragma unroll
      for (int u = 0; u < 3; ++u) { const int r = rb + u * ngw; if (r < MTOK) { const int mo = mrow_of(r) * 1024; float* xd = xrow(xl_dst, xc_dst, r);
#pragma unroll
        for (int j = 0; j < 4; ++j) { const int k = 4 * lane + 256 * j; const f32x4 g4 = *(const f32x4*)(mG + mo + k);
          const f32x4 m4 = (f32x4){__uint_as_float(ys[u][j].x << 16), __uint_as_float(ys[u][j].x & 0xffff0000u), __uint_as_float(ys[u][j].y << 16), __uint_as_float(ys[u][j].y & 0xffff0000u)};
          v[u][j] = v[u][j] + g4 * m4; *(f32x4*)(xd + k) = v[u][j]; } } } }
#pragma unroll
    for (int u = 0; u < 3; ++u) { float ss = 0.f;
#pragma unroll
      for (int j = 0; j < 4; ++j) ss += v[u][j].x * v[u][j].x + v[u][j].y * v[u][j].y + v[u][j].z * v[u][j].z + v[u][j].w * v[u][j].w;
      rstd[u] = rsqrtf(wave_sum(ss) * (1.0f / DM) + EPS); }
#pragma unroll
    for (int u = 0; u < 3; ++u) { const int r = rb + u * ngw;
      if (r < MTOK) { const int mo = mrow_of(r) * 1024;
#pragma unroll
        for (int j = 0; j < 4; ++j) { const int k = 4 * lane + 256 * j;
          const f32x4 a4 = *(const f32x4*)(mA + mo + k), b4 = *(const f32x4*)(mB + mo + k); const f32x4 o = v[u][j] * rstd[u] * a4 + b4;
          u32x2 w; w.x = pk2bf(o.x, o.y); w.y = pk2bf(o.z, o.w);
          *(u32x2*)(H + (size_t)r * DM + k) = w; } } }
  }
  __syncthreads();
}

template <int MODE> __device__ __forceinline__ void tr_wave_item(const float* src, const float* src2, int ldsrc, int K, bf16_t* out, int n0, int k0, float* scr, int lane) {
  const int nn = lane & 31, n = n0 + nn;
#pragma unroll 8
  for (int i = 0; i < 32; ++i) { const int kk = 2 * i + (lane >> 5); float v = 0.f;
    if (MODE == 0) { const int col = n < 1676 ? n : (n < 1792 ? -1 : n - 116); if (col >= 0) v = src[(size_t)(k0 + kk) * ldsrc + col]; }
    else if (MODE == 1) v = src[(size_t)(k0 + kk) * ldsrc + n];
    else v = (n & 1) ? src2[(size_t)(k0 + kk) * ldsrc + (n >> 1)] : src[(size_t)(k0 + kk) * ldsrc + (n >> 1)];
    scr[kk * 33 + nn] = v; }
  asm volatile("s_waitcnt lgkmcnt(0)" ::: "memory");
  const int c = lane & 7;
#pragma unroll
  for (int j = 0; j < 4; ++j) { const int nr = (lane >> 3) + 8 * j; const float* sp = scr + (8 * c) * 33 + nr;
    u32x4 o; o.x = f2bf(sp[0]) | (f2bf(sp[33]) << 16); o.y = f2bf(sp[66]) | (f2bf(sp[99]) << 16); o.z = f2bf(sp[132]) | (f2bf(sp[165]) << 16); o.w = f2bf(sp[198]) | (f2bf(sp[231]) << 16);
    *(u32x4*)(out + (size_t)(n0 + nr) * K + k0 + 8 * c) = o; }
  asm volatile("s_waitcnt lgkmcnt(0)" ::: "memory");
}
__device__ __forceinline__ void st_weights(const float* w_in, const float* w_out, const float* w_gate, const float* w_up, const float* w_down, int layer,
                                           bf16_t* WIN, bf16_t* WOUT, bf16_t* WGU, bf16_t* WD, char* lds) {
  const int tid = TIDX, lane = tid & 63, w = tid >> 6; float* scr = (float*)lds + w * (64 * 33);
  for (int it = BIDX * 8 + w; it < 7936; it += GDIM * 8) {
    if (it < 1280) tr_wave_item<0>(w_in + (size_t)layer * 1024 * DIN, nullptr, DIN, 1024, WIN, (it % 80) * 32, (it / 80) * 64, scr, lane);
    else if (it < 1792) { const int i2 = it - 1280; tr_wave_item<1>(w_out + (size_t)layer * 1024 * 1024, nullptr, 1024, 1024, WOUT, (i2 & 31) * 32, (i2 >> 5) * 64, scr, lane); }
    else if (it < 5888) { const int i2 = it - 1792, e = i2 >> 8, t = i2 & 255;
      tr_wave_item<2>(w_gate + ((size_t)layer * 16 + e) * 1024 * 256, w_up + ((size_t)layer * 16 + e) * 1024 * 256, 256, 1024, WGU + (size_t)e * 512 * 1024, (t & 15) * 32, (t >> 4) * 64, scr, lane); }
    else { const int i2 = it - 5888, e = i2 >> 7, t = i2 & 127;
      tr_wave_item<1>(w_down + ((size_t)layer * 16 + e) * 256 * 1024, nullptr, 1024, 256, WD + (size_t)e * 1024 * 256, (t & 31) * 32, (t >> 5) * 64, scr, lane); }
  }
  __syncthreads();
}

__device__ __forceinline__ void pair_experts(int pidx, int& eA, int& eB) {
  const int g = pidx / 6, t = pidx - 6 * g; const int i = t < 3 ? 0 : (t < 5 ? 1 : 2); const int j = t < 3 ? t + 1 : (t < 5 ? t - 1 : 3);
  eA = 4 * g + i; eB = 4 * g + j;
}
__device__ __forceinline__ void st_prep_qk(bf16_t* QK, const float* qn, const float* kn, const float* rope) {
  const int lane = TIDX & 63, gw = BIDX * 8 + (TIDX >> 6), ngw = GDIM * 8, hh = lane >> 3, sub = lane & 7;
  float gn[8];
#pragma unroll
  for (int e = 0; e < 8; ++e) gn[e] = ((hh < 6 ? qn : kn) + sub * 8)[e] * (hh < 6 ? C2 : 1.0f);
  for (int rb = gw; rb < MTOK; rb += 3 * ngw) {
    bf16x8 raw[3]; f32x4 rp4[3][4];
#pragma unroll
    for (int u = 0; u < 3; ++u) { const int r = rb + u * ngw < MTOK ? rb + u * ngw : MTOK - 1; const int j = r % TPB, t = j >= CTXL ? j - CTXL : 0;
      raw[u] = *(const bf16x8*)(QK + (size_t)r * 512 + hh * 64 + sub * 8);
      const float* rp = rope + ((size_t)t * 32 + (sub & 3) * 8) * 2;
#pragma unroll
      for (int q = 0; q < 4; ++q) rp4[u][q] = *(const f32x4*)(rp + 4 * q); }
#pragma unroll
    for (int u = 0; u < 3; ++u) { const int r = rb + u * ngw; const int j = (r < MTOK ? r : MTOK - 1) % TPB;
      float v[8]; float ss = 0.f;
#pragma unroll
      for (int e = 0; e < 8; ++e) { v[e] = bf2f((bf16_t)raw[u][e]); ss += v[e] * v[e]; }
      ss += __shfl_xor(ss, 1); ss += __shfl_xor(ss, 2); ss += __shfl_xor(ss, 4);
      const float rstd = rsqrtf(ss * (1.0f / 64.0f) + EPS);
#pragma unroll
      for (int e = 0; e < 8; ++e) v[e] = v[e] * rstd * gn[e];
      if (j >= CTXL) {
#pragma unroll
        for (int e = 0; e < 8; ++e) { const float other = __shfl_xor(v[e], 4); const float cs = rp4[u][e >> 1][(e & 1) * 2], sn = rp4[u][e >> 1][(e & 1) * 2 + 1]; v[e] = sub < 4 ? v[e] * cs - other * sn : v[e] * cs + other * sn; } }
      if (r < MTOK) *(u32x4*)(QK + (size_t)r * 512 + hh * 64 + sub * 8) = (u32x4){pk2bf(v[0], v[1]), pk2bf(v[2], v[3]), pk2bf(v[4], v[5]), pk2bf(v[6], v[7])}; }
  }
}

__device__ __forceinline__ void st_prep_hy(const bf16_t* HY, const float* cw, const float* cb, bf16_t* HYT, int do_ctx, char* lds) {
  const int tid = TIDX, lane = tid & 63, w = tid >> 6; float* tile = (float*)lds + w * (66 * 33);
  const int nlat = 4 * 64 * 24, nitem = nlat + (do_ctx ? 4 * 4 * 24 : 0), step = GDIM * 8;
  bf16x8 raw[5];
#define PHY_DECODE(it) int b, tt, ct, L, joff; bf16_t* outb; \
    if ((it) < nlat) { b = (it) / 1536; tt = ((it) % 1536) / 24; ct = (it) % 24; L = SEQ; joff = CTXL; outb = HYT + (size_t)b * 768 * SEQ; } \
    else { const int i2 = (it) - nlat; b = i2 / 96; tt = (i2 % 96) / 24; ct = i2 % 24; L = CTXL; joff = 0; outb = HYT + (size_t)4 * 768 * SEQ + (size_t)b * 768 * CTXL; } \
    const int t0 = tt * 64, c0 = ct * 32; (void)outb;
#define PHY_LOADS(it) do { PHY_DECODE(it) _Pragma("unroll") for (int i = 0; i < 5; ++i) { const int rr = (lane >> 2) + 16 * i, c8 = (lane & 3) * 8; int t = t0 - 1 + rr; const bool ok = rr < 66 && t >= 0 && t < L; t = ok ? t : t0; \
      const bf16x8 v = *(const bf16x8*)(HY + ((size_t)b * TPB + joff + t) * 768 + c0 + c8); raw[i] = ok ? v : (bf16x8){0, 0, 0, 0, 0, 0, 0, 0}; } } while (0)
  int it = BIDX * 8 + w;
  if (it < nitem) PHY_LOADS(it);
  for (; it < nitem; it += step) {
    PHY_DECODE(it)
#pragma unroll
    for (int i = 0; i < 5; ++i) { const int rr = (lane >> 2) + 16 * i, c8 = (lane & 3) * 8;
      if (rr < 66) {
#pragma unroll
        for (int e = 0; e < 8; ++e) tile[rr * 33 + c8 + e] = bf2f((bf16_t)raw[i][e]); } }
    asm volatile("s_waitcnt lgkmcnt(0)" ::: "memory");
    if (it + step < nitem) PHY_LOADS(it + step);
#pragma unroll 4
    for (int cc = 0; cc < 32; ++cc) { const int c = c0 + cc;
      const float v = cw[c] * tile[lane * 33 + cc] + cw[768 + c] * tile[(lane + 1) * 33 + cc] + cw[1536 + c] * tile[(lane + 2) * 33 + cc] + cb[c];
      outb[(size_t)c * L + t0 + lane] = (bf16_t)f2bf(v); }
    asm volatile("s_waitcnt lgkmcnt(0)" ::: "memory");
  }
#undef PHY_LOADS
#undef PHY_DECODE
  __syncthreads();
}

template <int L> __device__ __forceinline__ void hyfilt_item(int item, const float* w1, const float* b1, const float* fr, const float* w2, const float* b2, const float* w3, float* HK, char* lds) {
  float* F = (float*)lds; float* W1 = F + 64 * 37; float* H1 = W1 + 36 * 68; float* W2 = H1 + 64 * 68; float* S1 = W2 + 64 * 68;
  const int tid = TIDX, n0 = (item >> 2) * 64, cq = item & 3, lane = tid & 63, wv = tid >> 6, l15 = lane & 15, l4 = lane >> 4;
  for (int e = tid; e < 64 * 36; e += NT) { const int pp = e / 36, f = e % 36; const int n = n0 + pp; float v = 0.f;
    if (f == 0) v = (float)n / (float)(L - 1);
    else if (f < 33) { const int m = (f - 1) & 15; const float band = 1e-4f + (float)m * ((15.0f - 1e-4f) / 15.0f); float rev = ((float)n * (1.0f / (float)L)) * band; rev -= floorf(rev);
      v = f <= 16 ? __builtin_amdgcn_cosf(rev) : -__builtin_amdgcn_sinf(rev); }
    F[pp * 37 + f] = v; }
  for (int e = tid; e < 36 * 64; e += NT) { const int k = e >> 6, j = e & 63; W1[k * 68 + j] = k < 33 ? w1[k * 64 + j] : 0.f; }
  for (int e = tid; e < 64 * 64; e += NT) { const int k = e >> 6, j = e & 63; W2[k * 68 + j] = w2[e]; }
  __syncthreads();
  { const int pt = wv >> 1, c0 = 32 * (wv & 1);
    f32x4 acc[2] = {(f32x4){0.f, 0.f, 0.f, 0.f}, (f32x4){0.f, 0.f, 0.f, 0.f}};
#pragma unroll
    for (int kk = 0; kk < 9; ++kk) { const float av = F[(pt * 16 + l15) * 37 + 4 * kk + l4];
      acc[0] = __builtin_amdgcn_mfma_f32_16x16x4f32(av, W1[(4 * kk + l4) * 68 + c0 + l15], acc[0], 0, 0, 0);
      acc[1] = __builtin_amdgcn_mfma_f32_16x16x4f32(av, W1[(4 * kk + l4) * 68 + c0 + 16 + l15], acc[1], 0, 0, 0); }
#pragma unroll
    for (int ct = 0; ct < 2; ++ct) { const int j = c0 + 16 * ct + l15; const float bj = b1[j], fj = fr[j] * 0.15915494309189535f;
#pragma unroll
      for (int rg = 0; rg < 4; ++rg) { float rev = fj * (acc[ct][rg] + bj); rev -= floorf(rev); H1[(pt * 16 + 4 * l4 + rg) * 68 + j] = __builtin_amdgcn_sinf(rev); } } }
  __syncthreads();
  { const int pt = wv >> 1, c0 = 32 * (wv & 1);
    f32x4 acc[2] = {(f32x4){0.f, 0.f, 0.f, 0.f}, (f32x4){0.f, 0.f, 0.f, 0.f}};
#pragma unroll
    for (int kk = 0; kk < 16; ++kk) { const float av = H1[(pt * 16 + l15) * 68 + 4 * kk + l4];
      acc[0] = __builtin_amdgcn_mfma_f32_16x16x4f32(av, W2[(4 * kk + l4) * 68 + c0 + l15], acc[0], 0, 0, 0);
      acc[1] = __builtin_amdgcn_mfma_f32_16x16x4f32(av, W2[(4 * kk + l4) * 68 + c0 + 16 + l15], acc[1], 0, 0, 0); }
#pragma unroll
    for (int ct = 0; ct < 2; ++ct) { const int j = c0 + 16 * ct + l15; const float bj = b2[j], fj = fr[j] * 0.15915494309189535f;
#pragma unroll
      for (int rg = 0; rg < 4; ++rg) { float rev = fj * (acc[ct][rg] + bj); rev -= floorf(rev); S1[(pt * 16 + 4 * l4 + rg) * 68 + j] = __builtin_amdgcn_sinf(rev); } } }
  __syncthreads();
  {
    const int colb = cq * 256 + 32 * wv;
    f32x4 acc[4][2];
#pragma unroll
    for (int pt = 0; pt < 4; ++pt) { acc[pt][0] = (f32x4){0.f, 0.f, 0.f, 0.f}; acc[pt][1] = (f32x4){0.f, 0.f, 0.f, 0.f}; }
#pragma unroll 4
    for (int kk = 0; kk < 16; ++kk) { const int k = 4 * kk + l4;
      const float bv0 = w3[k * 1024 + colb + l15], bv1 = w3[k * 1024 + colb + 16 + l15];
#pragma unroll
      for (int pt = 0; pt < 4; ++pt) { const float av = S1[(pt * 16 + l15) * 68 + k];
        acc[pt][0] = __builtin_amdgcn_mfma_f32_16x16x4f32(av, bv0, acc[pt][0], 0, 0, 0);
        acc[pt][1] = __builtin_amdgcn_mfma_f32_16x16x4f32(av, bv1, acc[pt][1], 0, 0, 0); } }
#pragma unroll
    for (int ct = 0; ct < 2; ++ct) { const int col = colb + 16 * ct + l15, dir = col >> 9, order = (col >> 8) & 1, c = col & 255;
      const float delta = 3.0701134573253943f + (float)c * ((15.350567286626972f - 3.0701134573253943f) / 255.0f);
      float* dst = HK + ((size_t)order * 256 + c) * (2 * L);
#pragma unroll
      for (int pt = 0; pt < 4; ++pt) { const int nb = n0 + pt * 16 + 4 * l4; f32x4 o;
#pragma unroll
        for (int rg = 0; rg < 4; ++rg) o[rg] = acc[pt][ct][rg] * __expf(-((float)(nb + rg) / (float)(L - 1)) * delta);
        if (dir == 0) *(f32x4*)(dst + nb) = o;
        else {
#pragma unroll
          for (int rg = 0; rg < 4; ++rg) { const int n = nb + rg; if (n >= 1) dst[2 * L - n] = o[rg]; else dst[L] = 0.f; } } } }
  }
  __syncthreads();
}

__device__ __forceinline__ void hyconv_ctx_item(int item, const bf16_t* HYTC, const float* HKC, const float* hy_bias, bf16_t* MIX, char* lds) {
  constexpr int L = CTXL;
  const int tid = TIDX, b = item >> 4, cc = tid >> 5, c = (item & 15) * 16 + cc, sub = tid & 31, tb = 8 * sub;
  float* kern = (float*)lds + cc * (2 * L); float* z = (float*)lds + 16 * 2 * L + cc * L;
  const bf16_t* vp = HYTC + ((size_t)b * 768 + c) * L; const bf16_t* x1p = vp + (size_t)256 * L; const bf16_t* x2p = vp + (size_t)512 * L;
#pragma unroll 1
  for (int o = 0; o < 2; ++o) {
    if (o == 0) for (int t = sub; t < L; t += 32) z[t] = bf2f(vp[t]);
    const float* kp = HKC + ((size_t)o * 256 + c) * (2 * L);
    for (int t = sub; t < 2 * L; t += 32) kern[t] = kp[t];
    __syncthreads();
    float acc[8], W[16];
#pragma unroll
    for (int i = 0; i < 8; ++i) { acc[i] = 0.f; W[8 + i] = kern[(tb + i) & (2 * L - 1)]; }
    for (int s0 = 0; s0 < L; s0 += 8) {
      const int bb = (tb - s0 - 8) & (2 * L - 1);
#pragma unroll
      for (int i = 0; i < 8; ++i) W[i] = kern[bb + i];
      float zs[8];
#pragma unroll
      for (int j = 0; j < 8; ++j) zs[j] = z[s0 + j];
#pragma unroll
      for (int j = 0; j < 8; ++j)
#pragma unroll
        for (int i = 0; i < 8; ++i) acc[i] += W[8 + i - j] * zs[j];
#pragma unroll
      for (int i = 0; i < 8; ++i) W[8 + i] = W[i];
    }
    __syncthreads();
    const float bias = hy_bias[o * 256 + c];
#pragma unroll
    for (int i = 0; i < 8; ++i) { const int t = tb + i; const float zz = acc[i] + bias * z[t];
      if (o == 0) z[t] = bf2f(x1p[t]) * zz;
      else MIX[((size_t)b * TPB + t) * DM + 768 + c] = (bf16_t)f2bf(bf2f(x2p[t]) * zz); }
    __syncthreads();
  }
}

__device__ __forceinline__ void ssd_conv8(const bf16_t* XBC, size_t r, int c0, bool hasp, bool hasn, const float* cw, const float* cb, float (&o)[8]) {
  const bf16x8 cur = *(const bf16x8*)(XBC + r * 768 + c0);
  const bf16x8 prv = *(const bf16x8*)(XBC + (hasp ? r - 1 : r) * 768 + c0), nxt = *(const bf16x8*)(XBC + (hasn ? r + 1 : r) * 768 + c0);
  const float wp = hasp ? 1.f : 0.f, wn = hasn ? 1.f : 0.f;
#pragma unroll
  for (int e = 0; e < 8; ++e) { const float v = wp * cw[c0 + e] * bf2f((bf16_t)prv[e]) + cw[640 + c0 + e] * bf2f((bf16_t)cur[e]) + wn * cw[1280 + c0 + e] * bf2f((bf16_t)nxt[e]) + cb[c0 + e]; o[e] = siluf(v); }
}
__device__ __forceinline__ float softplusf(float x) {
  const float y = __expf(-fabsf(x)); const float l = y < 0.06f ? y * (1.f - y * (0.5f - y * (0.33333334f - 0.25f * y))) : __logf(1.f + y); return fmaxf(x, 0.f) + l; }
__device__ __forceinline__ void wave_scan128(float e0, float e1, int lane, float& c0, float& c1) {
  float x = e0 + e1;
#pragma unroll
  for (int o = 1; o < 64; o <<= 1) { const float v = __shfl_up(x, o); if (lane >= o) x += v; }
  const float excl = x - (e0 + e1); c0 = excl + e0; c1 = excl + e0 + e1;
}
__device__ __forceinline__ int ssd_chunk_j0(int cidx) { return cidx < 2 ? cidx * 128 : CTXL + (cidx - 2) * 128; }

__device__ __forceinline__ void st_ssd1(int it0, int step, int nitems, const bf16_t* XBC, const float* DT, const float* cw, const float* cb, const float* dt_bias, const float* a_log,
                                        float* YIN, float* ST, float* DEC, char* lds) {
  bf16_t (*Cm)[72] = (bf16_t (*)[72])lds; bf16_t (*Bm)[72] = (bf16_t (*)[72])(lds + 18432);
  bf16_t (*BT)[136] = (bf16_t (*)[136])(lds + 36864); bf16_t (*Xt)[136] = (bf16_t (*)[136])(lds + 54272); bf16_t (*Mm)[136] = (bf16_t (*)[136])(lds + 71680);
  float* tab = (float*)(lds + 106496); float* dtf = tab; float* dtb = tab + 128; float* acf = tab + 256; float* acb = tab + 384; float* wf = tab + 512; float* wb = tab + 640;
  const int tid = TIDX;
  bf16x8 cu[6], pv[6], nx[6];
#define SSD1_LOADS(itm, I0, I1) do { const int h_ = (itm) % 6, bc_ = (itm) / 6, cidx_ = bc_ % 34, b_ = bc_ / 34, g_ = h_ / 3, j0_ = ssd_chunk_j0(cidx_); const size_t r0_ = (size_t)b_ * TPB + j0_; \
    _Pragma("unroll") for (int i = (I0); i < (I1); ++i) { const int task = tid + NT * i, t = task / 24, cg = task % 24, kind = cg >> 3, q = cg & 7, j = j0_ + t; \
      const int c0 = kind == 0 ? h_ * 64 + 8 * q : (kind == 1 ? 384 + g_ * 64 + 8 * q : 512 + g_ * 64 + 8 * q); \
      const bool hasp = j != 0 && j != CTXL, hasn = j != CTXL - 1 && j != TPB - 1; const bf16_t* p = XBC + (r0_ + t) * 768 + c0; \
      cu[i] = *(const bf16x8*)p; pv[i] = *(const bf16x8*)(p + (hasp ? -768 : 0)); nx[i] = *(const bf16x8*)(p + (hasn ? 768 : 0)); } } while (0)
  if (it0 < nitems) SSD1_LOADS(it0, 0, 6);
#pragma unroll 1
  for (int item = it0; item < nitems; item += step) {
  const int tid = TIDX, lane = tid & 63, w = tid >> 6, l15 = lane & 15, l4 = lane >> 4;
  const int h = item % 6, bc = item / 6, cidx = bc % 34, b = bc / 34, g = h / 3, j0 = ssd_chunk_j0(cidx);
  const size_t r0 = (size_t)b * TPB + j0;
  float dtr0 = 0.f, dtr1 = 0.f;
  if (w < 2) { const int t0 = w == 0 ? 2 * lane : 127 - 2 * lane, t1 = w == 0 ? 2 * lane + 1 : 126 - 2 * lane; dtr0 = DT[(r0 + t0) * 12 + w * 6 + h]; dtr1 = DT[(r0 + t1) * 12 + w * 6 + h]; }
  SSD1_LOADS(item, 6, 6);
  {
#pragma unroll
    for (int i = 0; i < 6; ++i) { const int task = tid + NT * i, t = task / 24, cg = task % 24, kind = cg >> 3, q = cg & 7, j = j0 + t;
      const int c0 = kind == 0 ? h * 64 + 8 * q : (kind == 1 ? 384 + g * 64 + 8 * q : 512 + g * 64 + 8 * q);
      const float wp = (j != 0 && j != CTXL) ? 1.f : 0.f, wn = (j != CTXL - 1 && j != TPB - 1) ? 1.f : 0.f;
      float o[8];
#pragma unroll
      for (int e = 0; e < 8; ++e) o[e] = siluf(wp * cw[c0 + e] * bf2f((bf16_t)pv[i][e]) + cw[640 + c0 + e] * bf2f((bf16_t)cu[i][e]) + wn * cw[1280 + c0 + e] * bf2f((bf16_t)nx[i][e]) + cb[c0 + e]);
      if (kind == 0) {
#pragma unroll
        for (int e = 0; e < 8; ++e) Xt[8 * q + e][t] = (bf16_t)f2bf(o[e]);
      } else { const u32x4 pk = (u32x4){pk2bf(o[0], o[1]), pk2bf(o[2], o[3]), pk2bf(o[4], o[5]), pk2bf(o[6], o[7])};
        if (kind == 1) { *(u32x4*)&Bm[t][8 * q] = pk;
#pragma unroll
          for (int e = 0; e < 8; ++e) BT[8 * q + e][t] = (bf16_t)f2bf(o[e]); }
        else *(u32x4*)&Cm[t][8 * q] = pk; } }
  }
  if (w < 2) { const int dir = w; const float a = -expf(a_log[dir * 6 + h]), bias = dt_bias[dir * 6 + h];
    const int t0 = dir == 0 ? 2 * lane : 127 - 2 * lane, t1 = dir == 0 ? 2 * lane + 1 : 126 - 2 * lane;
    const float d0 = softplusf(dtr0 + bias), d1 = softplusf(dtr1 + bias);
    float c0, c1; wave_scan128(d0 * a, d1 * a, lane, c0, c1);
    const float tot = __shfl(c1, 63);
    float* dtt = dir == 0 ? dtf : dtb; float* ac = dir == 0 ? acf : acb; float* ww = dir == 0 ? wf : wb;
    dtt[t0] = d0; dtt[t1] = d1; ac[t0] = c0; ac[t1] = c1; ww[t0] = __expf(tot - c0) * d0; ww[t1] = __expf(tot - c1) * d1;
    if (lane == 0) DEC[(((size_t)b * 34 + cidx) * 2 + dir) * 6 + h] = __expf(tot); }
  __syncthreads();
  if (item + step < nitems) SSD1_LOADS(item + step, 0, 6);
  {
    f32x4 accG[8];
#pragma unroll
    for (int ni = 0; ni < 8; ++ni) accG[ni] = (f32x4){0.f, 0.f, 0.f, 0.f};
#pragma unroll
    for (int kk = 0; kk < 2; ++kk) { const bf16x8 a = *(const bf16x8*)&Cm[16 * w + l15][32 * kk + 8 * l4];
#pragma unroll
      for (int ni = 0; ni < 8; ++ni) { const bf16x8 bb = *(const bf16x8*)&Bm[16 * ni + l15][32 * kk + 8 * l4]; accG[ni] = __builtin_amdgcn_mfma_f32_16x16x32_bf16(a, bb, accG[ni], 0, 0, 0); } }
    float aft[4], abt[4];
#pragma unroll
    for (int rg = 0; rg < 4; ++rg) { aft[rg] = acf[16 * w + 4 * l4 + rg]; abt[rg] = acb[16 * w + 4 * l4 + rg]; }
#pragma unroll
    for (int ni = 0; ni < 8; ++ni) { const int sidx = 16 * ni + l15; const float afs = acf[sidx], abs_ = acb[sidx], dfs = dtf[sidx], dbs = dtb[sidx];
#pragma unroll
      for (int rg = 0; rg < 4; ++rg) { const int t = 16 * w + 4 * l4 + rg;
        const float f = sidx <= t ? __expf(aft[rg] - afs) * dfs : 0.f, bk = sidx >= t ? __expf(abt[rg] - abs_) * dbs : 0.f;
        Mm[t][sidx] = (bf16_t)f2bf(accG[ni][rg] * (f + bk)); } }
  }
  __syncthreads();
  {
    f32x4 acc[4];
#pragma unroll
    for (int ni = 0; ni < 4; ++ni) acc[ni] = (f32x4){0.f, 0.f, 0.f, 0.f};
#pragma unroll
    for (int kk = 0; kk < 4; ++kk) { const bf16x8 a = *(const bf16x8*)&Mm[16 * w + l15][32 * kk + 8 * l4];
#pragma unroll
      for (int ni = 0; ni < 4; ++ni) { const bf16x8 bb = *(const bf16x8*)&Xt[16 * ni + l15][32 * kk + 8 * l4]; acc[ni] = __builtin_amdgcn_mfma_f32_16x16x32_bf16(a, bb, acc[ni], 0, 0, 0); } }
#pragma unroll
    for (int rg = 0; rg < 4; ++rg)
#pragma unroll
      for (int ni = 0; ni < 4; ++ni) YIN[(r0 + 16 * w + 4 * l4 + rg) * 384 + h * 64 + 16 * ni + l15] = acc[ni][rg];
  }
  {
    const int dir = w >> 2, mt = w & 3; const float* ww = dir == 0 ? wf : wb;
    f32x4 acc[4];
#pragma unroll
    for (int ni = 0; ni < 4; ++ni) acc[ni] = (f32x4){0.f, 0.f, 0.f, 0.f};
#pragma unroll
    for (int kk = 0; kk < 4; ++kk) { const bf16x8 raw = *(const bf16x8*)&Xt[16 * mt + l15][32 * kk + 8 * l4];
      const f32x4 w0 = *(const f32x4*)(ww + 32 * kk + 8 * l4), w1 = *(const f32x4*)(ww + 32 * kk + 8 * l4 + 4);
      u32x4 pk; pk.x = pk2bf(bf2f((bf16_t)raw[0]) * w0.x, bf2f((bf16_t)raw[1]) * w0.y); pk.y = pk2bf(bf2f((bf16_t)raw[2]) * w0.z, bf2f((bf16_t)raw[3]) * w0.w);
      pk.z = pk2bf(bf2f((bf16_t)raw[4]) * w1.x, bf2f((bf16_t)raw[5]) * w1.y); pk.w = pk2bf(bf2f((bf16_t)raw[6]) * w1.z, bf2f((bf16_t)raw[7]) * w1.w);
      const bf16x8 a = __builtin_bit_cast(bf16x8, pk);
#pragma unroll
      for (int ni = 0; ni < 4; ++ni) { const bf16x8 bb = *(const bf16x8*)&BT[16 * ni + l15][32 * kk + 8 * l4]; acc[ni] = __builtin_amdgcn_mfma_f32_16x16x32_bf16(a, bb, acc[ni], 0, 0, 0); } }
    float* sp = ST + ((((size_t)b * 34 + cidx) * 2 + dir) * 6 + h) * 4096;
#pragma unroll
    for (int rg = 0; rg < 4; ++rg)
#pragma unroll
      for (int ni = 0; ni < 4; ++ni) sp[(16 * mt + 4 * l4 + rg) * 64 + 16 * ni + l15] = acc[ni][rg];
  }
  __syncthreads();
  }
#undef SSD1_LOADS
}

__device__ __forceinline__ void st_ssd_scan2(float* ST, const float* DEC) {
  for (int idx = BIDX * NT + TIDX; idx < 4 * 2 * 6 * 4096; idx += GDIM * NT) {
    const int e = idx & 4095, bdh = idx >> 12, h = bdh % 6, dir = (bdh / 6) & 1, b = bdh / 12;
    float v[34], d[34];
#pragma unroll
    for (int st = 0; st < 34; ++st) { const int cidx = dir == 0 ? st : (st < 2 ? 1 - st : 35 - st); const size_t o = (((size_t)b * 34 + cidx) * 2 + dir) * 6 + h; v[st] = ST[o * 4096 + e]; d[st] = DEC[o]; }
    float H = 0.f;
#pragma unroll
    for (int st = 0; st < 34; ++st) { const int cidx = dir == 0 ? st : (st < 2 ? 1 - st : 35 - st); const size_t o = (((size_t)b * 34 + cidx) * 2 + dir) * 6 + h; ST[o * 4096 + e] = H; H = H * d[st] + v[st]; }
  }
}

__device__ __forceinline__ void ssd3_item(int b, int cidx, int g, const bf16_t* XBC, const bf16_t* VZ, const float* DT, const float* cw, const float* cb, const float* dt_bias, const float* a_log,
                                          const float* dskip, const float* nw, const float* YIN, const float* ST, bf16_t* MIX, char* lds) {
  bf16_t (*Cm)[72] = (bf16_t (*)[72])lds; bf16_t (*Hm)[72] = (bf16_t (*)[72])(lds + 18432);
  float* ef = (float*)(lds + 18432 + 55296);
  float (*Yt)[196] = (float (*)[196])lds;
  const int tid = TIDX, lane = tid & 63, w = tid >> 6, l15 = lane & 15, l4 = lane >> 4, j0 = ssd_chunk_j0(cidx);
  const size_t r0 = (size_t)b * TPB + j0;
#pragma unroll
  for (int i = 0; i < 2; ++i) { const int task = tid + NT * i, t = task >> 3, q = task & 7, j = j0 + t;
    float o[8]; ssd_conv8(XBC, r0 + t, 512 + g * 64 + 8 * q, j != 0 && j != CTXL, j != CTXL - 1 && j != TPB - 1, cw, cb, o);
    *(u32x4*)&Cm[t][8 * q] = (u32x4){pk2bf(o[0], o[1]), pk2bf(o[2], o[3]), pk2bf(o[4], o[5]), pk2bf(o[6], o[7])}; }
#pragma unroll
  for (int i = 0; i < 12; ++i) { const int f4 = tid + NT * i, hd = f4 >> 10, rem = f4 & 1023, p = rem >> 4, n4 = (rem & 15) * 4, hh = hd >> 1, dir = hd & 1;
    const f32x4 v = *(const f32x4*)(ST + ((((size_t)b * 34 + cidx) * 2 + dir) * 6 + 3 * g + hh) * 4096 + p * 64 + n4);
    *(u32x2*)&Hm[hd * 64 + p][n4] = (u32x2){pk2bf(v.x, v.y), pk2bf(v.z, v.w)}; }
  if (w < 6) { const int hh = w >> 1, dir = w & 1, h = 3 * g + hh; const float a = -expf(a_log[dir * 6 + h]), bias = dt_bias[dir * 6 + h];
    const int t0 = dir == 0 ? 2 * lane : 127 - 2 * lane, t1 = dir == 0 ? 2 * lane + 1 : 126 - 2 * lane;
    const float d0 = softplusf(DT[(r0 + t0) * 12 + dir * 6 + h] + bias), d1 = softplusf(DT[(r0 + t1) * 12 + dir * 6 + h] + bias);
    float c0, c1; wave_scan128(d0 * a, d1 * a, lane, c0, c1);
    ef[w * 128 + t0] = __expf(c0); ef[w * 128 + t1] = __expf(c1); }
  __syncthreads();
  float yv[3][4][4];
  {
    bf16x8 ca[2];
#pragma unroll
    for (int kk = 0; kk < 2; ++kk) ca[kk] = *(const bf16x8*)&Cm[16 * w + l15][32 * kk + 8 * l4];
#pragma unroll
    for (int hh = 0; hh < 3; ++hh) {
      f32x4 accF[4], accB[4];
#pragma unroll
      for (int ni = 0; ni < 4; ++ni) { accF[ni] = (f32x4){0.f, 0.f, 0.f, 0.f}; accB[ni] = (f32x4){0.f, 0.f, 0.f, 0.f}; }
#pragma unroll
      for (int kk = 0; kk < 2; ++kk)
#pragma unroll
        for (int ni = 0; ni < 4; ++ni) {
          accF[ni] = __builtin_amdgcn_mfma_f32_16x16x32_bf16(ca[kk], *(const bf16x8*)&Hm[(hh * 2 + 0) * 64 + 16 * ni + l15][32 * kk + 8 * l4], accF[ni], 0, 0, 0);
          accB[ni] = __builtin_amdgcn_mfma_f32_16x16x32_bf16(ca[kk], *(const bf16x8*)&Hm[(hh * 2 + 1) * 64 + 16 * ni + l15][32 * kk + 8 * l4], accB[ni], 0, 0, 0); }
#pragma unroll
      for (int rg = 0; rg < 4; ++rg) { const int t = 16 * w + 4 * l4 + rg; const float eF = ef[(hh * 2 + 0) * 128 + t], eB = ef[(hh * 2 + 1) * 128 + t];
#pragma unroll
        for (int ni = 0; ni < 4; ++ni) yv[hh][ni][rg] = eF * accF[ni][rg] + eB * accB[ni][rg]; }
    }
  }
  __syncthreads();
#pragma unroll
  for (int hh = 0; hh < 3; ++hh)
#pragma unroll
    for (int rg = 0; rg < 4; ++rg)
#pragma unroll
      for (int ni = 0; ni < 4; ++ni) Yt[16 * w + 4 * l4 + rg][hh * 64 + 16 * ni + l15] = yv[hh][ni][rg];
  __syncthreads();
  {
    const int c4 = 4 * (lane < 48 ? lane : 47), hk = c4 >> 6; const bool lact = lane < 48;
    float cw0[4], cw1[4], cw2[4], cbv[4], nwv[4];
#pragma unroll
    for (int e = 0; e < 4; ++e) { const int col = g * 192 + c4 + e; cw0[e] = cw[col]; cw1[e] = cw[640 + col]; cw2[e] = cw[1280 + col]; cbv[e] = cb[col]; nwv[e] = nw[col]; }
    const float dsk = dskip[3 * g + hk];
#pragma unroll 1
    for (int rb = 0; rb < 16; rb += 4) {
      u32x2 xc_[4], xp_[4], xn_[4], zz_[4]; f32x4 yy_[4];
#pragma unroll
      for (int u = 0; u < 4; ++u) { const int t = 16 * w + rb + u, j = j0 + t; const size_t r = r0 + t; const bool hasp = j != 0 && j != CTXL, hasn = j != CTXL - 1 && j != TPB - 1;
        const bf16_t* xq = XBC + r * 768 + g * 192 + c4;
        xc_[u] = *(const u32x2*)xq; xp_[u] = *(const u32x2*)(xq + (hasp ? -768 : 0)); xn_[u] = *(const u32x2*)(xq + (hasn ? 768 : 0));
        yy_[u] = *(const f32x4*)(YIN + r * 384 + g * 192 + c4); zz_[u] = *(const u32x2*)(VZ + r * 512 + 128 + g * 192 + c4); }
#pragma unroll
      for (int u = 0; u < 4; ++u) { const int t = 16 * w + rb + u, j = j0 + t; const size_t r = r0 + t; const float wp = (j != 0 && j != CTXL) ? 1.f : 0.f, wn = (j != CTXL - 1 && j != TPB - 1) ? 1.f : 0.f;
        const f32x4 yt = *(const f32x4*)&Yt[t][c4];
        float gt[4]; float ss = 0.f;
#pragma unroll
        for (int e = 0; e < 4; ++e) { const unsigned sh = (e & 1) * 16; const unsigned wc_ = e < 2 ? xc_[u].x : xc_[u].y, wq_ = e < 2 ? xp_[u].x : xp_[u].y, wn_ = e < 2 ? xn_[u].x : xn_[u].y, wz_ = e < 2 ? zz_[u].x : zz_[u].y;
          float xv = cw1[e] * bf2f((bf16_t)(wc_ >> sh)) + cbv[e] + wp * cw0[e] * bf2f((bf16_t)(wq_ >> sh)) + wn * cw2[e] * bf2f((bf16_t)(wn_ >> sh));
          xv = siluf(xv);
          const float y = yy_[u][e] + yt[e] + dsk * xv;
          gt[e] = lact ? y * siluf(bf2f((bf16_t)(wz_ >> sh))) : 0.f; ss += gt[e] * gt[e]; }
        const float rstd = rsqrtf(wave_sum(ss) * (1.0f / 192.0f) + EPS);
        if (lact) { u32x2 o; o.x = pk2bf(gt[0] * rstd * nwv[0], gt[1] * rstd * nwv[1]); o.y = pk2bf(gt[2] * rstd * nwv[2], gt[3] * rstd * nwv[3]);
          *(u32x2*)(MIX + r * DM + 384 + g * 192 + c4) = o; } }
    }
  }
  __syncthreads();
}

__device__ __forceinline__ void st_router(const float* xl, const float* xc, float* xl_dst, float* xc_dst, const bf16_t* MO, const float* g, const float* modv_layer, const float* w_router, const float* rbias,
                                          bf16_t* H2, int* ctl, int* tok_pair, float* tok_w, int skip_ctx, char* lds) {
  float* wl = (float*)lds;
  const int tid = TIDX, lane = tid & 63, gw = BIDX * 8 + (tid >> 6), ngw = GDIM * 8;
  int* hist = (int*)(lds + 81920);
  if (tid < 32) hist[tid] = 0;
  float* mA = (float*)(lds + 82176); float* mB = mA + 5 * 1024; float* mG = mB + 5 * 1024;
  for (int idx = tid; idx < 5 * 1024; idx += NT) { const int m = idx >> 10, k = idx & 1023; mA[idx] = g[k] * (1.f + modv_layer[(size_t)m * 6144 + 4096 + k]); mB[idx] = modv_layer[(size_t)m * 6144 + 3072 + k]; mG[idx] = modv_layer[(size_t)m * 6144 + 2048 + k]; }
  for (int idx = tid; idx < 4096; idx += NT) { const int k = idx >> 2, e4 = idx & 3, row = ((k & 3) * 4 + (k >> 8)) * 64 + ((k & 255) >> 2);
    *(f32x4*)(wl + row * 20 + 4 * e4) = *(const f32x4*)(w_router + (size_t)k * 16 + 4 * e4); }
  __syncthreads();
  for (int rb = gw; rb < MTOK; rb += 2 * ngw) {
    int rr[2]; bool act[2]; f32x4 v[2][4]; u32x2 mo[2][4]; float rstd[2]; int mo_[2];
#pragma unroll
    for (int u = 0; u < 2; ++u) { const int r = rb + u * ngw; rr[u] = r < MTOK ? r : MTOK - 1; act[u] = r < MTOK && !(skip_ctx && (rr[u] % TPB) < CTXL); mo_[u] = mrow_of(rr[u]) * 1024;
      const float* xr = xrow(xl, xc, rr[u]); const bf16_t* mr = MO + (size_t)rr[u] * DM;
#pragma unroll
      for (int j = 0; j < 4; ++j) { v[u][j] = *(const f32x4*)(xr + 4 * lane + 256 * j); mo[u][j] = *(const u32x2*)(mr + 4 * lane + 256 * j); } }
    if (!act[0] && !act[1]) continue;
#pragma unroll
    for (int u = 0; u < 2; ++u) if (act[u]) { float* xd = xrow(xl_dst, xc_dst, rr[u]);
#pragma unroll
      for (int j = 0; j < 4; ++j) { const int k = 4 * lane + 256 * j; const f32x4 g4 = *(const f32x4*)(mG + mo_[u] + k);
        const f32x4 m4 = (f32x4){__uint_as_float(mo[u][j].x << 16), __uint_as_float(mo[u][j].x & 0xffff0000u), __uint_as_float(mo[u][j].y << 16), __uint_as_float(mo[u][j].y & 0xffff0000u)};
        v[u][j] = v[u][j] + g4 * m4; *(f32x4*)(xd + k) = v[u][j]; } }
#pragma unroll
    for (int u = 0; u < 2; ++u) { float ss = 0.f;
#pragma unroll
      for (int j = 0; j < 4; ++j) ss += v[u][j].x * v[u][j].x + v[u][j].y * v[u][j].y + v[u][j].z * v[u][j].z + v[u][j].w * v[u][j].w;
      rstd[u] = rsqrtf(wave_sum(ss) * (1.0f / DM) + EPS); }
    float lg[2][16];
#pragma unroll
    for (int u = 0; u < 2; ++u)
#pragma unroll
      for (int e = 0; e < 16; ++e) lg[u][e] = 0.f;
#pragma unroll 1
    for (int j = 0; j < 4; ++j) { const int k = 4 * lane + 256 * j; float o[2][4];
#pragma unroll
      for (int u = 0; u < 2; ++u) { const f32x4 a4 = *(const f32x4*)(mA + mo_[u] + k), b4 = *(const f32x4*)(mB + mo_[u] + k); const f32x4 o4 = v[u][j] * rstd[u] * a4 + b4;
        o[u][0] = o4.x; o[u][1] = o4.y; o[u][2] = o4.z; o[u][3] = o4.w;
        if (act[u]) { u32x2 wpk; wpk.x = pk2bf(o4.x, o4.y); wpk.y = pk2bf(o4.z, o4.w); *(u32x2*)(H2 + (size_t)rr[u] * DM + k) = wpk; } }
#pragma unroll
      for (int q = 0; q < 4; ++q) { const float* wr_ = wl + ((q * 4 + j) * 64 + lane) * 20;
#pragma unroll
        for (int e4 = 0; e4 < 4; ++e4) { const f32x4 wr = *(const f32x4*)(wr_ + 4 * e4);
#pragma unroll
          for (int u = 0; u < 2; ++u) { lg[u][4 * e4] += o[u][q] * wr.x; lg[u][4 * e4 + 1] += o[u][q] * wr.y; lg[u][4 * e4 + 2] += o[u][q] * wr.z; lg[u][4 * e4 + 3] += o[u][q] * wr.w; } } } }
    float h1[2];
#pragma unroll
    for (int u = 0; u < 2; ++u) { float h8[8], h4[4], h2[2];
#pragma unroll
      for (int i = 0; i < 8; ++i) { const bool up = (lane & 32) != 0; const float keep = up ? lg[u][8 + i] : lg[u][i], give = up ? lg[u][i] : lg[u][8 + i]; h8[i] = keep + __shfl_xor(give, 32); }
#pragma unroll
      for (int i = 0; i < 4; ++i) { const bool up = (lane & 16) != 0; const float keep = up ? h8[4 + i] : h8[i], give = up ? h8[i] : h8[4 + i]; h4[i] = keep + __shfl_xor(give, 16); }
#pragma unroll
      for (int i = 0; i < 2; ++i) { const bool up = (lane & 8) != 0; const float keep = up ? h4[2 + i] : h4[i], give = up ? h4[i] : h4[2 + i]; h2[i] = keep + __shfl_xor(give, 8); }
      { const bool up = (lane & 4) != 0; const float keep = up ? h2[1] : h2[0], give = up ? h2[0] : h2[1]; h1[u] = keep + __shfl_xor(give, 4); }
      h1[u] += __shfl_xor(h1[u], 2); h1[u] += __shfl_xor(h1[u], 1); }
    float lx[16];
#pragma unroll
    for (int e = 0; e < 16; ++e) { const int src = ((e >> 3) & 1) * 32 + ((e >> 2) & 1) * 16 + ((e >> 1) & 1) * 8 + (e & 1) * 4;
      const float a0 = __uint_as_float(__builtin_amdgcn_readlane(__float_as_uint(h1[0]), src)), a1 = __uint_as_float(__builtin_amdgcn_readlane(__float_as_uint(h1[1]), src));
      lx[e] = lane < 32 ? a0 : a1; }
    const int us = lane >> 5;
    if ((lane & 31) == 0 && (us == 0 ? act[0] : act[1])) {
      const int r = us == 0 ? rr[0] : rr[1];
      int best = 0, bi1 = 0, bi2 = 1; float bestv = -1e30f, bs1 = 0.f, bs2 = 0.f;
#pragma unroll
      for (int gq = 0; gq < 4; ++gq) { float m1 = -1e30f, m2 = -1e30f, s1 = 0.f, s2 = 0.f; int i1 = 0, i2 = 0;
#pragma unroll
        for (int i = 0; i < 4; ++i) { const float scv = 1.0f / (1.0f + __expf(-lx[4 * gq + i])); const float sv = scv + rbias[4 * gq + i];
          if (sv > m1) { m2 = m1; s2 = s1; i2 = i1; m1 = sv; s1 = scv; i1 = i; } else if (sv > m2) { m2 = sv; s2 = scv; i2 = i; } }
        if (m1 + m2 > bestv) { bestv = m1 + m2; best = gq; bi1 = i1; bi2 = i2; bs1 = s1; bs2 = s2; } }
      const int ia = bi1 < bi2 ? bi1 : bi2, ib = bi1 < bi2 ? bi2 : bi1;
      const int tri = ia == 0 ? ib - 1 : (ia == 1 ? ib + 1 : 5);
      const int pidx = best * 6 + tri;
      const float sa = bi1 < bi2 ? bs1 : bs2, sb = bi1 < bi2 ? bs2 : bs1, inv = 1.0f / (sa + sb);
      const int rank = atomicAdd(&hist[pidx], 1);
      tok_pair[r] = pidx | (rank << 5); tok_w[2 * r] = sa * inv; tok_w[2 * r + 1] = sb * inv;
    }
  }
  __syncthreads();
  if (tid < 32) ctl[CT_CNTB + BIDX * 32 + tid] = tid < 24 ? hist[tid] : 0;
}
__device__ __forceinline__ void st_moe_gather(const bf16_t* H2, bf16_t* H2S, int* ctl, const int* tok_pair, const float* tok_w, int* sorted_tok, float* sorted_w, int* tok_slot, int skip_ctx, char* lds) {
  int* sbase = (int*)lds; int* rtot = sbase + 32; int* rpre = rtot + 512;
  const int tid = TIDX, bid = BIDX;
  { const int p = tid & 31, seg = tid >> 5; int tot = 0, pre = 0;
#pragma unroll 4
    for (int i = 0; i < 16; ++i) { const int bb = seg * 16 + i; const int cv = ctl[CT_CNTB + bb * 32 + p]; tot += cv; pre += bb < bid ? cv : 0; }
    rtot[seg * 32 + p] = tot; rpre[seg * 32 + p] = pre; }
  __syncthreads();
  if (tid < 32) { int tot = 0, pre = 0;
#pragma unroll
    for (int sg = 0; sg < 16; ++sg) { tot += rtot[sg * 32 + tid]; pre += rpre[sg * 32 + tid]; }
    rtot[tid] = tot; rpre[tid] = pre; }
  __syncthreads();
  if (tid == 0) { int base = 0, nt = 0;
#pragma unroll 1
    for (int p = 0; p < 24; ++p) { sbase[p] = base + rpre[p]; const int n = rtot[p], tl = (n + 255) >> 8;
      if (bid == 0) { ctl[CT_BASE + p] = base; for (int t = 0; t < tl; ++t) ctl[CT_TP + nt + t] = p; }
      nt += tl; base += tl * 256; }
    if (bid == 0) { ctl[CT_BASE + 24] = base; ctl[CT_NT] = nt; } }
  __syncthreads();
  const int lane = tid & 63, gw = bid * 8 + (tid >> 6), ngw = GDIM * 8;
  for (int rb = gw; rb < MTOK; rb += 3 * ngw) {
    u32x4 a0[3], a1[3]; int pk[3]; float w0[3], w1[3]; bool act[3];
#pragma unroll
    for (int u = 0; u < 3; ++u) { const int r = rb + u * ngw; act[u] = r < MTOK && !(skip_ctx && (r % TPB) < CTXL); const int rc = act[u] ? r : 0;
      pk[u] = tok_pair[rc]; w0[u] = tok_w[2 * rc]; w1[u] = tok_w[2 * rc + 1];
      const u32x4* sp = (const u32x4*)(H2 + (size_t)rc * DM); a0[u] = sp[lane]; a1[u] = sp[lane + 64]; }
#pragma unroll
    for (int u = 0; u < 3; ++u) if (act[u]) { const int r = rb + u * ngw; const int slot = sbase[pk[u] & 31] + (pk[u] >> 5);
      if (lane == 0) { sorted_tok[slot] = r; tok_slot[r] = slot; sorted_w[2 * slot] = w0[u]; sorted_w[2 * slot + 1] = w1[u]; }
      u32x4* d = (u32x4*)(H2S + (size_t)slot * DM); d[lane] = a0[u]; d[lane + 64] = a1[u]; }
  }
  __syncthreads();
}
__device__ __forceinline__ void st_final(float* xl, const float* g, const bf16_t* YS, const int* tok_slot, const float* gate  ) {
  const int lane = TIDX & 63, gw = BIDX * 8 + (TIDX >> 6), ngw = GDIM * 8;
  f32x4 gg[4];
#pragma unroll
  for (int j = 0; j < 4; ++j) gg[j] = *(const f32x4*)(g + 4 * lane + 256 * j);
  for (int rb = gw; rb < NB * SEQ; rb += 4 * ngw) {
    f32x4 v[4][4]; u32x2 ys[4][4];
#pragma unroll
    for (int u = 0; u < 4; ++u) { const int r = rb + u * ngw, rc = r < NB * SEQ ? r : NB * SEQ - 1; const float* xr = xl + (size_t)rc * DM;
      const int bb = rc >> 12, tr = bb * TPB + CTXL + (rc & 4095); const bf16_t* yr = YS + (size_t)tok_slot[tr] * DM;
#pragma unroll
      for (int j = 0; j < 4; ++j) { v[u][j] = *(const f32x4*)(xr + 4 * lane + 256 * j); ys[u][j] = *(const u32x2*)(yr + 4 * lane + 256 * j); } }
#pragma unroll
    for (int u = 0; u < 4; ++u) { const int r = rb + u * ngw, rc = r < NB * SEQ ? r : NB * SEQ - 1; const float* gt = gate + (size_t)(rc >> 12) * 6144; float ss = 0.f;
#pragma unroll
      for (int j = 0; j < 4; ++j) { const f32x4 g4 = *(const f32x4*)(gt + 4 * lane + 256 * j);
        const f32x4 m4 = (f32x4){__uint_as_float(ys[u][j].x << 16), __uint_as_float(ys[u][j].x & 0xffff0000u), __uint_as_float(ys[u][j].y << 16), __uint_as_float(ys[u][j].y & 0xffff0000u)};
        v[u][j] = v[u][j] + g4 * m4; ss += v[u][j].x * v[u][j].x + v[u][j].y * v[u][j].y + v[u][j].z * v[u][j].z + v[u][j].w * v[u][j].w; }
      const float rstd = rsqrtf(wave_sum(ss) * (1.0f / DM) + EPS);
      if (r < NB * SEQ) { float* xr = xl + (size_t)r * DM;
#pragma unroll
        for (int j = 0; j < 4; ++j) *(f32x4*)(xr + 4 * lane + 256 * j) = (f32x4){v[u][j].x * rstd * gg[j].x, v[u][j].y * rstd * gg[j].y, v[u][j].z * rstd * gg[j].z, v[u][j].w * rstd * gg[j].w}; } }
  }
}

namespace pg8 {
#define PG8_LAS __attribute__((address_space(3)))
typedef unsigned short bf16_t;
typedef short bf16x8 __attribute__((ext_vector_type(8)));
typedef float f32x4 __attribute__((ext_vector_type(4)));
typedef unsigned u32x4 __attribute__((ext_vector_type(4)));
constexpr int BM = 256, BK = 64, HALF = 128, HTB = HALF * BK * 2  , STAGE_BYTES = 8 * HTB, NXCD = 8, WGM = 8;

__host__ __device__ __forceinline__ int lds_byte(int r, int c) { const int st = (r >> 4) * 2 + (c >> 5), rr = r & 15, cc = c & 31, ob = rr * 64 + cc * 2; return st * 1024 + (ob ^ (((ob >> 9) & 1) << 5)); }
__host__ __device__ __forceinline__ void stage_rc(int b, int& R, int& C) { const int st = b / 1024, sb = b % 1024, swz = sb ^ (((sb >> 9) & 1) << 5); R = (st >> 1) * 16 + swz / 64; C = (st & 1) * 32 + (swz % 64) / 2; }
__host__ __device__ __forceinline__ int perm32(int rho) { const int n = rho >> 4, i = rho & 15; return 8 * (i >> 2) + 4 * n + (i & 3); }

struct Unit { int pm, pn, fin; const char* A; const char* B; };
struct Gemm { int K, lda, ldb; };

__device__ __forceinline__ void tile_of(int L, int nM, int nN, int& pm, int& pn) {
    const int nwg = nM * nN; int wgid = L; { const int q = nwg / NXCD, r = nwg % NXCD, xcd = wgid % NXCD, off = wgid / NXCD; wgid = (xcd < r ? xcd * (q + 1) : r * (q + 1) + (xcd - r) * q) + off; }
    const int nig = WGM * nN, gid = wgid / nig, fm = gid * WGM, gsz = (nM - fm) < WGM ? (nM - fm) : WGM;
    pm = fm + ((wgid % nig) % gsz); pn = (wgid % nig) / gsz;
}
__device__ __forceinline__ unsigned cvt_pk_bf16(float lo, float hi) { unsigned r; asm volatile("v_cvt_pk_bf16_f32 %0, %1, %2" : "=v"(r) : "v"(lo), "v"(hi)); return r; }
template <class Epi, class Sched, bool ALIGN_EPI = false, bool SP2 = false>
__device__ __forceinline__ void gemm_phase(PG8_LAS unsigned char* lds, const Gemm g, const Sched& S, const Epi& E) {
    const int tid = opq_v((int)threadIdx.x), wid = __builtin_amdgcn_readfirstlane(tid >> 6), lane = tid & 63, wr = wid >> 2, wc = wid & 3, fr = lane & 15, fq = lane >> 4;
    const int K = g.K, nt = K / BK;
    unsigned voffA[2], voffB[2];
#pragma unroll
    for (int i = 0; i < 2; ++i) { int R, C; stage_rc(tid * 16 + i * 8192, R, C); const int Rb = Epi::PERM ? ((R & ~31) + perm32(R & 31)) : R;
        voffA[i] = (unsigned)(R * g.lda + C) * 2u; voffB[i] = (unsigned)(Rb * g.ldb + C) * 2u; }
    const size_t kstep = (size_t)(BK * 2);
    const size_t hstepA = (size_t)HALF * g.lda * 2, hstepB = (size_t)HALF * g.ldb * 2;
    const unsigned ldsw = (unsigned)wid * 1024u;
    const int aoff = lds_byte(wr * 64 + fr, fq * 8), boff = lds_byte(wc * 32 + fr, fq * 8);
#define PG8_SA(b, h) (((b) * 2 + (h)) * HTB)
#define PG8_SB(b, h) ((4 + (b) * 2 + (h)) * HTB)
#define PG8_STAGE(bufoff, gbase, voff) do { _Pragma("unroll") for (int _i = 0; _i < 2; ++_i) \
        __builtin_amdgcn_global_load_lds((const unsigned*)((const char*)(gbase) + (voff)[_i]), (PG8_LAS unsigned*)(lds + (bufoff) + ldsw + _i * 8192), 16, 0, 0); } while (0)
#define PG8_LDA(dst, b, h) do { _Pragma("unroll") for (int m = 0; m < 4; ++m) _Pragma("unroll") for (int k = 0; k < 2; ++k) dst[m][k] = *(const PG8_LAS bf16x8*)(lds + PG8_SA(b, h) + aoff + m * 2048 + k * 1024); } while (0)
#define PG8_LDB(dst, b, h) do { _Pragma("unroll") for (int n = 0; n < 2; ++n) _Pragma("unroll") for (int k = 0; k < 2; ++k) dst[n][k] = *(const PG8_LAS bf16x8*)(lds + PG8_SB(b, h) + boff + n * 2048 + k * 1024); } while (0)
#define PG8_MMA(ai, bj, At, Bt) do { __builtin_amdgcn_s_setprio(1); _Pragma("unroll") for (int m = 0; m < 4; ++m) _Pragma("unroll") for (int n = 0; n < 2; ++n) _Pragma("unroll") for (int k = 0; k < 2; ++k) \
        acc[ai][bj][m][n] = __builtin_amdgcn_mfma_f32_16x16x32_bf16(Bt[n][k], At[m][k], acc[ai][bj][m][n], 0, 0, 0); __builtin_amdgcn_s_setprio(0); } while (0)
#define PG8_WAIT_V(n) asm volatile("s_waitcnt vmcnt(" #n ")" ::: "memory")
#define PG8_WAIT_L(n) asm volatile("s_waitcnt lgkmcnt(" #n ")" ::: "memory")
#define PG8_BAR __builtin_amdgcn_s_barrier()
#define PG8_SCHED __builtin_amdgcn_sched_barrier(0)
    Unit cur, nxt; int ui = 0;
    if (!S.next(0, cur)) return;
    f32x4 acc[2][2][4][2];
#pragma unroll
    for (int a = 0; a < 2; ++a)
#pragma unroll
        for (int b = 0; b < 2; ++b)
#pragma unroll
            for (int m = 0; m < 4; ++m)
#pragma unroll
                for (int n = 0; n < 2; ++n) acc[a][b][m][n] = (f32x4){0.f, 0.f, 0.f, 0.f};
    bf16x8 At[4][2], B0[2][2], B1[2][2];
    const char* cA = cur.A; const char* cB = cur.B;
    S.a_ready(cur);
    if constexpr (SP2) {
        PG8_STAGE(PG8_SB(0, 0), cB, voffB); PG8_STAGE(PG8_SB(0, 1), cB + hstepB, voffB); PG8_STAGE(PG8_SA(0, 0), cA, voffA); PG8_STAGE(PG8_SA(0, 1), cA + hstepA, voffA);
        if (wr == 1) PG8_BAR;
        PG8_WAIT_V(2); PG8_BAR;
        PG8_STAGE(PG8_SB(1, 0), cB + kstep, voffB); PG8_STAGE(PG8_SA(1, 0), cA + kstep, voffA); PG8_STAGE(PG8_SB(1, 1), cB + hstepB + kstep, voffB);
        PG8_WAIT_V(6); PG8_BAR;
    } else {
        PG8_STAGE(PG8_SB(0, 0), cB, voffB); PG8_STAGE(PG8_SA(0, 0), cA, voffA); PG8_STAGE(PG8_SB(0, 1), cB + hstepB, voffB); PG8_STAGE(PG8_SA(0, 1), cA + hstepA, voffA);
        if (wr == 1) PG8_BAR;
        PG8_WAIT_V(4); PG8_BAR;
        PG8_STAGE(PG8_SB(1, 0), cB + kstep, voffB); PG8_STAGE(PG8_SA(1, 0), cA + kstep, voffA); PG8_STAGE(PG8_SB(1, 1), cB + hstepB + kstep, voffB);
        PG8_WAIT_V(6); PG8_BAR;
    }
    for (;;) {
        const bool has_next = S.next(ui + 1, nxt);
        const char* nA = has_next ? nxt.A : cA; const char* nB = has_next ? nxt.B : cB;
        for (int t = 0; t < nt; t += 2) {
            const bool last = (t == nt - 2);
            const char* a1 = cA + (size_t)(t + 1) * kstep;
            const char* a2 = last ? nA : cA + (size_t)(t + 2) * kstep; const char* b2 = last ? nB : cB + (size_t)(t + 2) * kstep;
            const char* a3 = a2 + kstep; const char* b3 = b2 + kstep;
            if (last && has_next) S.a_ready(nxt);
            if constexpr (SP2) {
            PG8_LDB(B0, 0, 0); PG8_LDB(B1, 0, 1); PG8_SCHED; PG8_LDA(At, 0, 0); PG8_STAGE(PG8_SA(1, 1), a1 + hstepA, voffA);
            PG8_WAIT_V(8); PG8_WAIT_L(0); PG8_BAR; PG8_MMA(0, 0, At, B0); PG8_MMA(0, 1, At, B1); PG8_BAR; PG8_SCHED;
            PG8_LDA(At, 0, 1); PG8_STAGE(PG8_SB(0, 0), b2, voffB); PG8_STAGE(PG8_SB(0, 1), b2 + hstepB, voffB); PG8_STAGE(PG8_SA(0, 0), a2, voffA);
            PG8_WAIT_V(8); PG8_WAIT_L(0); PG8_BAR; PG8_MMA(1, 0, At, B0); PG8_MMA(1, 1, At, B1); PG8_BAR; PG8_SCHED;
            PG8_LDB(B0, 1, 0); PG8_LDB(B1, 1, 1); PG8_SCHED; PG8_LDA(At, 1, 0); PG8_STAGE(PG8_SA(0, 1), a2 + hstepA, voffA);
            PG8_WAIT_V(8); PG8_WAIT_L(0); PG8_BAR; PG8_MMA(0, 0, At, B0); PG8_MMA(0, 1, At, B1); PG8_BAR; PG8_SCHED;
            PG8_LDA(At, 1, 1); PG8_STAGE(PG8_SB(1, 0), b3, voffB); PG8_STAGE(PG8_SB(1, 1), b3 + hstepB, voffB); PG8_STAGE(PG8_SA(1, 0), a3, voffA);
            PG8_WAIT_V(8); PG8_WAIT_L(0); PG8_BAR; PG8_MMA(1, 0, At, B0); PG8_MMA(1, 1, At, B1); PG8_BAR; PG8_SCHED;
            } else {
            PG8_LDB(B0, 0, 0); PG8_SCHED; PG8_LDA(At, 0, 0); PG8_STAGE(PG8_SA(1, 1), a1 + hstepA, voffA);
            PG8_WAIT_L(8); PG8_BAR; PG8_WAIT_L(0); PG8_MMA(0, 0, At, B0); PG8_BAR; PG8_SCHED;
            PG8_LDB(B1, 0, 1); PG8_STAGE(PG8_SB(0, 0), b2, voffB);
            PG8_BAR; PG8_WAIT_L(0); PG8_MMA(0, 1, At, B1); PG8_BAR;
            PG8_LDA(At, 0, 1); PG8_STAGE(PG8_SA(0, 0), a2, voffA);
            PG8_BAR; PG8_WAIT_L(0); PG8_MMA(1, 0, At, B0); PG8_BAR; PG8_SCHED;
            PG8_STAGE(PG8_SB(0, 1), b2 + hstepB, voffB);
            PG8_WAIT_V(6); PG8_BAR; PG8_MMA(1, 1, At, B1); PG8_BAR;
            PG8_LDB(B0, 1, 0); PG8_SCHED; PG8_LDA(At, 1, 0); PG8_STAGE(PG8_SA(0, 1), a2 + hstepA, voffA);
            PG8_WAIT_L(8); PG8_BAR; PG8_WAIT_L(0); PG8_MMA(0, 0, At, B0); PG8_BAR; PG8_SCHED;
            PG8_LDB(B1, 1, 1); PG8_STAGE(PG8_SB(1, 0), b3, voffB);
            PG8_BAR; PG8_WAIT_L(0); PG8_MMA(0, 1, At, B1); PG8_BAR;
            PG8_LDA(At, 1, 1); PG8_STAGE(PG8_SA(1, 0), a3, voffA);
            PG8_BAR; PG8_WAIT_L(0); PG8_MMA(1, 0, At, B0); PG8_BAR; PG8_SCHED;
            PG8_STAGE(PG8_SB(1, 1), b3 + hstepB, voffB);
            PG8_WAIT_V(6); PG8_BAR; PG8_MMA(1, 1, At, B1); PG8_BAR;
            }
        }
        if constexpr (ALIGN_EPI) { if (wr == 0) PG8_BAR; }
        if constexpr (!Epi::AFTER_DRAIN) { if (cur.fin) { E(acc, cur, wr, wc, fr, fq); S.done(cur); } }
        if (!has_next) break;
        if (cur.fin) {
#pragma unroll
        for (int a = 0; a < 2; ++a)
#pragma unroll
            for (int b = 0; b < 2; ++b)
#pragma unroll
                for (int m = 0; m < 4; ++m)
#pragma unroll
                    for (int n = 0; n < 2; ++n) acc[a][b][m][n] = (f32x4){0.f, 0.f, 0.f, 0.f};
        }
        cur = nxt; cA = nA; cB = nB; ++ui;
        if constexpr (ALIGN_EPI) { if (wr == 1) PG8_BAR; }
    }
    PG8_WAIT_V(0);
    if constexpr (!ALIGN_EPI) { if (wr == 0) PG8_BAR; }
    PG8_BAR;
    if constexpr (Epi::AFTER_DRAIN) { E.fused(acc, cur, wr, wc, fr, fq, lds, wid, lane); S.done(cur); }
#undef PG8_SA
#undef PG8_SB
#undef PG8_STAGE
#undef PG8_LDA
#undef PG8_LDB
#undef PG8_MMA
#undef PG8_WAIT_V
#undef PG8_WAIT_L
#undef PG8_BAR
#undef PG8_SCHED
}
}

struct SchedDense {
  int nM, nN, G, c, skip_ctx; const char* A; const char* B; size_t a_tile, b_tile;
  __device__ __forceinline__ bool next(int i, pg8::Unit& u) const {
    const long L = (long)i * G + c; if (L >= (long)nM * nN) return false;
    int pm, pn; pg8::tile_of((int)L, nM, nN, pm, pn); if (skip_ctx) pm = pm + pm / 16 + 1;
    u.pm = pm; u.pn = pn; u.fin = 1; u.A = A + (size_t)pm * a_tile; u.B = B + (size_t)pn * b_tile; return true; }
  __device__ __forceinline__ void a_ready(const pg8::Unit&) const {}
  __device__ __forceinline__ void done(const pg8::Unit&) const {}
};
struct SchedMoe {
  int G, c, mode; const int* ctl; const char* A; size_t a_tile; const char* W;
  __device__ __forceinline__ bool next(int i, pg8::Unit& u) const {
    const int part = mode == 2 ? (i & 1) : 0, iu = mode == 2 ? (i >> 1) : i;
    const long L = (long)iu * G + c; const int ntiles = ctl[CT_NT]; if (L >= (long)ntiles * 4) return false;
    const int pm = (int)(L >> 2), pn = (int)(L & 3); int eA, eB; pair_experts(ctl[CT_TP + pm], eA, eB);
    u.pm = pm; u.pn = pn;
    if (mode == 1) { const int e = pn < 2 ? eA : eB; u.fin = 1; u.A = A + (size_t)pm * a_tile; u.B = W + (size_t)e * (512 * 1024 * 2) + (size_t)(pn & 1) * (256 * 1024 * 2); }
    else { u.fin = part; u.A = A + (size_t)pm * a_tile + part * 512; u.B = W + (size_t)(part ? eB : eA) * (1024 * 256 * 2) + (size_t)pn * (256 * 256 * 2); }
    return true; }
  __device__ __forceinline__ void a_ready(const pg8::Unit&) const {}
  __device__ __forceinline__ void done(const pg8::Unit&) const {}
};
__device__ __forceinline__ unsigned cvt_pk(float lo, float hi) { return pg8::cvt_pk_bf16(lo, hi); }
struct EpiInProj {
  static constexpr bool PERM = true, AFTER_DRAIN = false; bf16_t *QK, *VZ, *XBC, *HY; float* DT;
  __device__ __forceinline__ void operator()(const f32x4 (&acc)[2][2][4][2], const pg8::Unit& u, int wr, int wc, int fr, int fq) const {
    const int pn = u.pn; bf16_t* base; int ldc, coff;
    if (pn < 2) { base = QK; ldc = 512; coff = pn * 256; } else if (pn < 4) { base = VZ; ldc = 512; coff = (pn - 2) * 256; }
    else if (pn < 7) { base = XBC; ldc = 768; coff = (pn - 4) * 256; } else { base = HY; ldc = 768; coff = (pn - 7) * 256; }
    const int row0 = u.pm * 256 + wr * 64 + fr, col0 = coff + wc * 32 + 8 * fq; const bool dtl = (pn == 6 && wc == 0 && fq < 2);
#pragma unroll
    for (int ai = 0; ai < 2; ++ai)
#pragma unroll
      for (int m = 0; m < 4; ++m) { const int row = row0 + ai * 128 + m * 16; bf16_t* rowp = base + (size_t)row * ldc + col0;
#pragma unroll
        for (int bj = 0; bj < 2; ++bj) { const f32x4 v0 = acc[ai][bj][m][0], v1 = acc[ai][bj][m][1];
          u32x4 w; w.x = cvt_pk(v0[0], v0[1]); w.y = cvt_pk(v0[2], v0[3]); w.z = cvt_pk(v1[0], v1[1]); w.w = cvt_pk(v1[2], v1[3]);
          *(u32x4*)(rowp + bj * 128) = w;
          if (bj == 1 && dtl) { float* dp = DT + (size_t)row * 12 + 8 * fq; *(f32x4*)dp = v0; if (fq == 0) *(f32x4*)(dp + 4) = v1; } } }
  }
};
struct EpiOutProj {
  static constexpr bool PERM = true, AFTER_DRAIN = false; bf16_t* MO;
  __device__ __forceinline__ void operator()(const f32x4 (&acc)[2][2][4][2], const pg8::Unit& u, int wr, int wc, int fr, int fq) const {
    const int row0 = u.pm * 256 + wr * 64 + fr, col0 = u.pn * 256 + wc * 32 + 8 * fq;
#pragma unroll
    for (int ai = 0; ai < 2; ++ai)
#pragma unroll
      for (int m = 0; m < 4; ++m) { bf16_t* rowp = MO + (size_t)(row0 + ai * 128 + m * 16) * DM + col0;
#pragma unroll
        for (int bj = 0; bj < 2; ++bj) { const f32x4 v0 = acc[ai][bj][m][0], v1 = acc[ai][bj][m][1];
          u32x4 w; w.x = cvt_pk(v0[0], v0[1]); w.y = cvt_pk(v0[2], v0[3]); w.z = cvt_pk(v1[0], v1[1]); w.w = cvt_pk(v1[2], v1[3]);
          *(u32x4*)(rowp + bj * 128) = w; } }
  }
};
struct EpiMoe1 {
  static constexpr bool PERM = true, AFTER_DRAIN = false; bf16_t* ACT; const float* sorted_w;
  __device__ __forceinline__ void operator()(const f32x4 (&acc)[2][2][4][2], const pg8::Unit& u, int wr, int wc, int fr, int fq) const {
    const int half = u.pn >> 1, j0 = (u.pn & 1) * 128 + 16 * wc + 4 * fq;
#pragma unroll
    for (int ai = 0; ai < 2; ++ai)
#pragma unroll
      for (int m = 0; m < 4; ++m) { const int slot = u.pm * 256 + ai * 128 + wr * 64 + m * 16 + fr; const float wt = sorted_w[2 * slot + half];
#pragma unroll
        for (int bj = 0; bj < 2; ++bj) { const f32x4 v0 = acc[ai][bj][m][0], v1 = acc[ai][bj][m][1];
          u32x2 w; w.x = cvt_pk(siluf(v0[0]) * v0[1] * wt, siluf(v0[2]) * v0[3] * wt); w.y = cvt_pk(siluf(v1[0]) * v1[1] * wt, siluf(v1[2]) * v1[3] * wt);
          *(u32x2*)(ACT + (size_t)slot * 512 + half * 256 + j0 + 64 * bj) = w; } }
  }
};
struct EpiMoe2 {
  static constexpr bool PERM = true, AFTER_DRAIN = false; bf16_t* YS;
  __device__ __forceinline__ void operator()(const f32x4 (&acc)[2][2][4][2], const pg8::Unit& u, int wr, int wc, int fr, int fq) const {
    const int row0 = u.pm * 256 + wr * 64 + fr, col0 = u.pn * 256 + wc * 32 + 8 * fq;
#pragma unroll
    for (int ai = 0; ai < 2; ++ai)
#pragma unroll
      for (int m = 0; m < 4; ++m) { bf16_t* rowp = YS + (size_t)(row0 + ai * 128 + m * 16) * DM + col0;
#pragma unroll
        for (int bj = 0; bj < 2; ++bj) { const f32x4 v0 = acc[ai][bj][m][0], v1 = acc[ai][bj][m][1];
          u32x4 w; w.x = cvt_pk(v0[0], v0[1]); w.y = cvt_pk(v0[2], v0[3]); w.z = cvt_pk(v1[0], v1[1]); w.w = cvt_pk(v1[2], v1[3]);
          *(u32x4*)(rowp + bj * 128) = w; } }
  }
};

#include <hip/hip_bf16.h>
#include <cmath>
namespace attn_body {
using bf16=__hip_bfloat16;
using bf16x8=__attribute__((ext_vector_type(8)))short;
using s16x4=__attribute__((ext_vector_type(4)))short;
using f32x16=__attribute__((ext_vector_type(16)))float;
using u32x4=__attribute__((ext_vector_type(4)))unsigned;
constexpr int D=64,QP=512,KP=512,VP=512,OP=1024;
constexpr int NW=8,QBLK=32,QB=QBLK*NW,KVBLK=64;
constexpr int ATTN_UNIT_ROWS=QB;
__device__ __forceinline__ int crow(int r,int hi){return (r&3)+8*(r>>2)+4*hi;}
#define SBAR() __builtin_amdgcn_sched_barrier(0)
__device__ __forceinline__ void cmask(f32x16&p0,f32x16&p1,int jb,int qrel,int hi){
  const float NEG=-INFINITY; int kb=64*jb+4*hi;
  #pragma unroll
  for(int r=0;r<16;++r){int kv=kb+(r&3)+8*(r>>2); if(kv>qrel)p0[r]=NEG; if(kv+32>qrel)p1[r]=NEG;}
}

constexpr int NSLOT=3, SLOTB=8192;
constexpr int LDS_K=0, LDS_V=NSLOT*SLOTB, LDS_WS=2*NSLOT*SLOTB, LDS_OST=LDS_WS+NW*64*4, LDS_BYTES=LDS_OST+NW*4096;
constexpr float C2=0.125f*1.4426950408889634f;
__device__ __forceinline__ void glds16(const void*gsrc,unsigned lds_dst){unsigned keep;
  asm volatile("s_mov_b32 %0, m0\n\ts_mov_b32 m0, %2\n\ts_nop 0\n\tglobal_load_lds_dwordx4 %1, off\n\ts_mov_b32 m0, %0":"=&s"(keep):"v"(gsrc),"s"(lds_dst):"memory");}
__device__ __forceinline__ float max3f(float a,float b,float c){float r;asm("v_max3_f32 %0, %1, %2, %3":"=v"(r):"v"(a),"v"(b),"v"(c));return r;}
__device__ __forceinline__ float max2f(float a,float b){float r;asm("v_max_f32_e32 %0, %1, %2":"=v"(r):"v"(a),"v"(b));return r;}
__device__ __forceinline__ float fadd_s(float a,float b){float r;asm("v_add_f32_e32 %0, %1, %2":"=v"(r):"v"(a),"v"(b));return r;}
__device__ __forceinline__ float fsub_s(float a,float b){float r;asm("v_sub_f32_e32 %0, %1, %2":"=v"(r):"v"(a),"v"(b));return r;}
typedef float f32x2_t __attribute__((ext_vector_type(2))); typedef __bf16 bf16x2_t __attribute__((ext_vector_type(2)));
__device__ __forceinline__ unsigned cvtpk_s(float lo,float hi){f32x2_t v={lo,hi};bf16x2_t b=__builtin_convertvector(v,bf16x2_t);return __builtin_bit_cast(unsigned,b);}
#define WAIT_BAR(N) asm volatile("s_waitcnt vmcnt(" #N ") lgkmcnt(0)\n\ts_barrier":::"memory")

__device__ __forceinline__ void qkt(f32x16&p0,f32x16&p1,const char*Kslot,const bf16x8*qr,const f32x16&negm,int r32,int hi){
  const char*kb=Kslot+hi*1024+r32*16;
  #pragma unroll
  for(int d0=0;d0<4;++d0){
    const bf16x8 b0=*reinterpret_cast<const bf16x8*>(kb+d0*2048);
    const bf16x8 b1=*reinterpret_cast<const bf16x8*>(kb+d0*2048+512);
    if(d0==0){p0=__builtin_amdgcn_mfma_f32_32x32x16_bf16(b0,qr[0],negm,0,0,0);p1=__builtin_amdgcn_mfma_f32_32x32x16_bf16(b1,qr[0],negm,0,0,0);}
    else{p0=__builtin_amdgcn_mfma_f32_32x32x16_bf16(b0,qr[d0],p0,0,0,0);p1=__builtin_amdgcn_mfma_f32_32x32x16_bf16(b1,qr[d0],p1,0,0,0);}}
}
typedef __attribute__((address_space(3))) const char* lds_cptr;
typedef short v4i16_t __attribute__((ext_vector_type(4)));
__device__ __forceinline__ void kload8(bf16x8*kf,lds_cptr kp){
  kf[0]=*(const __attribute__((address_space(3))) bf16x8*)(kp);      kf[1]=*(const __attribute__((address_space(3))) bf16x8*)(kp+512);
  kf[2]=*(const __attribute__((address_space(3))) bf16x8*)(kp+2048); kf[3]=*(const __attribute__((address_space(3))) bf16x8*)(kp+2560);
  kf[4]=*(const __attribute__((address_space(3))) bf16x8*)(kp+4096); kf[5]=*(const __attribute__((address_space(3))) bf16x8*)(kp+4608);
  kf[6]=*(const __attribute__((address_space(3))) bf16x8*)(kp+6144); kf[7]=*(const __attribute__((address_space(3))) bf16x8*)(kp+6656);
}
__device__ __forceinline__ void kload2(bf16x8*kf,lds_cptr kp,int j){ kf[2*j]=*(const __attribute__((address_space(3))) bf16x8*)(kp+j*2048); kf[2*j+1]=*(const __attribute__((address_space(3))) bf16x8*)(kp+j*2048+512); }
__device__ __forceinline__ s16x4 vtr(lds_cptr p){ return __builtin_bit_cast(s16x4,__builtin_amdgcn_ds_read_tr16_b64_v4i16((__attribute__((address_space(3))) v4i16_t*)p)); }
__device__ __forceinline__ float rowmax(const f32x16&p0,const f32x16&p1){
  float a=max3f(p0[0],p0[1],p1[0]),b=max3f(p0[2],p0[3],p1[1]);a=max3f(a,p1[2],p1[3]);
  #pragma unroll
  for(int r=4;r<16;r+=4){a=max3f(a,p0[r],p0[r+1]);b=max3f(b,p0[r+2],p0[r+3]);a=max3f(a,p1[r],p1[r+1]);b=max3f(b,p1[r+2],p1[r+3]);}
  const float m=max2f(a,b);
  auto rr=__builtin_amdgcn_permlane32_swap(__float_as_uint(m),__float_as_uint(m),false,false);
  return max2f(__uint_as_float(rr[0]),__uint_as_float(rr[1]));
}
__device__ __forceinline__ void pv(f32x16*o,int vb,bf16x8 pa0,bf16x8 pa1,bf16x8 pa2,bf16x8 pa3){
  #pragma unroll
  for(int d0=0;d0<2;++d0){s16x4 lo[4],hi[4];
    #pragma unroll
    for(int ks=0;ks<4;++ks){
      asm volatile("ds_read_b64_tr_b16 %0,%1 offset:%c2":"=&v"(lo[ks]):"v"(vb),"i"(d0*4096+ks*1024):"memory");
      asm volatile("ds_read_b64_tr_b16 %0,%1 offset:%c2":"=&v"(hi[ks]):"v"(vb),"i"(d0*4096+ks*1024+512):"memory");}
    asm volatile("s_waitcnt lgkmcnt(0)":::"memory");SBAR();
    #define PK(k) (bf16x8){lo[k][0],lo[k][1],lo[k][2],lo[k][3],hi[k][0],hi[k][1],hi[k][2],hi[k][3]}
    o[d0]=__builtin_amdgcn_mfma_f32_32x32x16_bf16(pa0,PK(0),o[d0],0,0,0);
    o[d0]=__builtin_amdgcn_mfma_f32_32x32x16_bf16(pa1,PK(1),o[d0],0,0,0);
    o[d0]=__builtin_amdgcn_mfma_f32_32x32x16_bf16(pa2,PK(2),o[d0],0,0,0);
    o[d0]=__builtin_amdgcn_mfma_f32_32x32x16_bf16(pa3,PK(3),o[d0],0,0,0);
    #undef PK
  }
}

#ifndef ATTN_STORE16
#define ATTN_STORE16(p,v) (*(u32x4*)(p)=(v))
#endif
template<int THRL> __device__ __forceinline__ void attn_unit(const bf16*Qu,const bf16*__restrict__ Kh,const bf16*__restrict__ Vh,bf16*Ou,const int NT,char*shm){
  const int tid=opq_v((int)threadIdx.x),lane=tid&63,r32=lane&31,hi=lane>>5; const int wid=__builtin_amdgcn_readfirstlane(tid>>6);
  const bf16*Qw=Qu+(long)(wid*QBLK)*QP;
  const unsigned lds0=(unsigned)(uintptr_t)shm;
  float*wsf=(float*)(shm+LDS_WS)+wid*64;
  const bf16*ksrc=Kh+(long)lane*KP+wid*8;
  const bf16*vsrc=Vh+(long)(16*(wid&3)+(lane>>2))*VP+(wid>>2)*32+(lane&3)*8;
  const unsigned kdst=lds0+LDS_K+wid*1024, vdst=lds0+LDS_V+wid*1024;
  #define DMA_K(t,slot) glds16(ksrc+(long)(t)*KVBLK*KP,(unsigned)__builtin_amdgcn_readfirstlane(kdst+(slot)))
  #define DMA_V(t,slot) glds16(vsrc+(long)(t)*KVBLK*VP,(unsigned)__builtin_amdgcn_readfirstlane(vdst+(slot)))
  const int vb0=(int)(lds0+LDS_V)+((lane>>4)&1)*32+(lane&3)*8+(4*hi+((lane&15)>>2))*64;
  const char*Kbase=shm+LDS_K; bf16x8 kf[8];
  const lds_cptr shm3=(lds_cptr)shm; const lds_cptr kp0=shm3+LDS_K+hi*1024+r32*16; const lds_cptr vp0=shm3+LDS_V+((lane>>4)&1)*32+(lane&3)*8+(4*hi+((lane&15)>>2))*64;
  DMA_K(0,0);DMA_V(0,0);DMA_K(1,SLOTB);
  bf16x8 qr[4];
  #pragma unroll
  for(int d0=0;d0<4;++d0)qr[d0]=*reinterpret_cast<const bf16x8*>(&Qw[(long)r32*QP+d0*16+hi*8]);
  float mhat=0.f,l_reg=0.f;float z0_=0.f;asm volatile("":"+v"(z0_));f32x16 o[2];f32x16 negm;
  _Pragma("unroll") for(int r=0;r<16;++r){o[0][r]=z0_;o[1][r]=z0_;negm[r]=z0_;} asm volatile("":"+v"(negm));
  #define CMASK(P0,P1,t) do{}while(0)
  bool resc=false;
  #define START(P0,P1) do{ const float rm=rowmax(P0,P1); resc=false; \
    { const float dl=rm; mhat=fadd_s(mhat,dl); \
      _Pragma("unroll") for(int r=0;r<16;++r){P0[r]=fsub_s(P0[r],dl);P1[r]=fsub_s(P1[r],dl);} \
      _Pragma("unroll") for(int r=0;r<16;++r)negm[r]=-mhat; asm volatile("":"+v"(negm)); } \
    _Pragma("unroll") for(int r=0;r<16;++r)P0[r]=__builtin_amdgcn_exp2f(P0[r]); }while(0)
  #define RESC() do{ if(resc){ asm volatile("s_waitcnt lgkmcnt(0)":::"memory"); \
      _Pragma("unroll") for(int d_=0;d_<2;++d_) _Pragma("unroll") for(int r=0;r<16;++r)o[d_][r]*=wsf[crow(r,hi)]; } }while(0)
  f32x16 pA0,pA1,pB0,pB1;
  int sl_prev=0,sl_cur=0,sl_next=SLOTB;
  #define ROT() do{sl_prev=sl_cur;sl_cur=sl_next;sl_next=(sl_next==(NSLOT-1)*SLOTB)?0:sl_next+SLOTB;}while(0)
  DMA_K(2,2*SLOTB);
  WAIT_BAR(3);
  qkt(pA0,pA1,Kbase,qr,negm,r32,hi);asm volatile("s_nop 15\n\ts_nop 7":"+v"(pA0),"+v"(pA1));CMASK(pA0,pA1,0);
  START(pA0,pA1);
  _Pragma("unroll") for(int r=0;r<16;++r)pA1[r]=__builtin_amdgcn_exp2f(pA1[r]);
  WAIT_BAR(0);
  DMA_K(3,0);DMA_V(1,SLOTB);
  ROT();
  kload8(kf,kp0+sl_cur);
  WAIT_BAR(2);
  s16x4 vlo[8],vhi[8]; u32x4 pw0,pw1,pw2,pw3;
  #define PKW(P,B) cvtpk_s(P[B],P[B+1])
  #define PAF(k) __builtin_bit_cast(bf16x8,pw##k)
  #define VFR(i) (bf16x8){vlo[i][0],vlo[i][1],vlo[i][2],vlo[i][3],vhi[i][0],vhi[i][1],vhi[i][2],vhi[i][3]}
  #define PIN(x) asm volatile("":"+v"(x))
  #define MX3(a,b,c) __builtin_fmaxf(__builtin_fmaxf((a),(b)),(c))
  #define GAPA(MF,A0,A1,A2,A3,W0,W1,PW) do{ MF; sacc+=A0; sacc+=A1; sacc+=A2; sacc+=A3; PIN(sacc); W0; W1; PIN(PW); SBAR(); }while(0)
  #define EX(v) __builtin_amdgcn_exp2f(v)
  #define GAPB(MF,X,B) do{ MF; X[B]=EX(X[B]); X[B+1]=EX(X[B+1]); X[B+2]=EX(X[B+2]); X[B+3]=EX(X[B+3]); PIN(X); SBAR(); }while(0)
  #define VRD(i) do{ vlo[i]=vtr(vp_+(((i)>>2)*4096+((i)&3)*1024)); vhi[i]=vtr(vp_+(((i)>>2)*4096+((i)&3)*1024+512)); }while(0)
  #define KRD(G,j) do{ if(G){ kload2(kf,kp0+sl_next,j); SBAR(); } }while(0)
  #define STEP(C0,C1,P0,P1,t,GK,GV,GL) do{ SBAR(); \
    const lds_cptr vp_=vp0+sl_prev; \
    VRD(0); SBAR(); float sacc=(P0[0]+P0[1]); \
    GAPA(C0=__builtin_amdgcn_mfma_f32_32x32x16_bf16(kf[0],qr[0],negm,0,0,0), P0[2],P0[3],P0[4],P0[5],     pw0[0]=PKW(P0,0), pw0[1]=PKW(P0,2), pw0); \
    VRD(4); SBAR(); GAPA(C1=__builtin_amdgcn_mfma_f32_32x32x16_bf16(kf[1],qr[0],negm,0,0,0), P0[6],P0[7],P0[8],P0[9],     pw0[2]=PKW(P0,4), pw0[3]=PKW(P0,6), pw0); \
    VRD(1); SBAR(); GAPA(C0=__builtin_amdgcn_mfma_f32_32x32x16_bf16(kf[2],qr[1],C0,0,0,0),   P0[10],P0[11],P0[12],P0[13], pw1[0]=PKW(P0,8), pw1[1]=PKW(P0,10), pw1); \
    VRD(5); SBAR(); GAPA(C1=__builtin_amdgcn_mfma_f32_32x32x16_bf16(kf[3],qr[1],C1,0,0,0),   P0[14],P0[15],P1[0],P1[1],   pw1[2]=PKW(P0,12),pw1[3]=PKW(P0,14), pw1); \
    VRD(2); SBAR(); GAPA(C0=__builtin_amdgcn_mfma_f32_32x32x16_bf16(kf[4],qr[2],C0,0,0,0),   P1[2],P1[3],P1[4],P1[5],     pw2[0]=PKW(P1,0), pw2[1]=PKW(P1,2), pw2); \
    VRD(6); SBAR(); GAPA(C1=__builtin_amdgcn_mfma_f32_32x32x16_bf16(kf[5],qr[2],C1,0,0,0),   P1[6],P1[7],P1[8],P1[9],     pw2[2]=PKW(P1,4), pw2[3]=PKW(P1,6), pw2); \
    VRD(3); SBAR(); GAPA(C0=__builtin_amdgcn_mfma_f32_32x32x16_bf16(kf[6],qr[3],C0,0,0,0),   P1[10],P1[11],P1[12],P1[13], pw3[0]=PKW(P1,8), pw3[1]=PKW(P1,10), pw3); \
    VRD(7); SBAR(); GAPA(C1=__builtin_amdgcn_mfma_f32_32x32x16_bf16(kf[7],qr[3],C1,0,0,0),   P1[14],P1[15],0.f,0.f,       pw3[2]=PKW(P1,12),pw3[3]=PKW(P1,14), pw3); \
    l_reg+=sacc; \
    if(GK){DMA_K((t)+3,sl_cur);} if(GV){DMA_V((t)+1,sl_next);} \
    CMASK(C0,C1,t); \
    { float a=MX3(C0[0],C0[1],C1[0]),b=MX3(C0[2],C0[3],C1[1]); a=MX3(a,C1[2],C1[3]); \
      _Pragma("unroll") for(int r=4;r<16;r+=4){a=MX3(a,C0[r],C0[r+1]);b=MX3(b,C0[r+2],C0[r+3]);a=MX3(a,C1[r],C1[r+1]);b=MX3(b,C1[r+2],C1[r+3]);} \
      float rm=__builtin_fmaxf(a,b); { auto rr=__builtin_amdgcn_permlane32_swap(__float_as_uint(rm),__float_as_uint(rm),false,false); rm=__builtin_fmaxf(__uint_as_float(rr[0]),__uint_as_float(rr[1])); } \
      resc=false; \
      if(__builtin_expect(__any(rm>(float)THRL),0)){ const float dl=__builtin_fmaxf(rm,0.f); mhat+=dl; \
        _Pragma("unroll") for(int r=0;r<16;++r){C0[r]-=dl;C1[r]-=dl;} \
        _Pragma("unroll") for(int r=0;r<16;++r)negm[r]=-mhat; asm volatile("":"+v"(negm)); \
        const float f=__builtin_amdgcn_exp2f(-dl); l_reg*=f; if(hi==0)wsf[r32]=f; resc=true; } } \
    SBAR(); \
    GAPB(o[0]=__builtin_amdgcn_mfma_f32_32x32x16_bf16(PAF(0),VFR(0),o[0],0,0,0), C0,0); \
    GAPB(o[1]=__builtin_amdgcn_mfma_f32_32x32x16_bf16(PAF(0),VFR(4),o[1],0,0,0), C0,4); \
    KRD(GL,0); GAPB(o[0]=__builtin_amdgcn_mfma_f32_32x32x16_bf16(PAF(1),VFR(1),o[0],0,0,0), C0,8); \
    KRD(GL,1); GAPB(o[1]=__builtin_amdgcn_mfma_f32_32x32x16_bf16(PAF(1),VFR(5),o[1],0,0,0), C0,12); \
    KRD(GL,2); GAPB(o[0]=__builtin_amdgcn_mfma_f32_32x32x16_bf16(PAF(2),VFR(2),o[0],0,0,0), C1,0); \
    KRD(GL,3); GAPB(o[1]=__builtin_amdgcn_mfma_f32_32x32x16_bf16(PAF(2),VFR(6),o[1],0,0,0), C1,4); \
    GAPB(o[0]=__builtin_amdgcn_mfma_f32_32x32x16_bf16(PAF(3),VFR(3),o[0],0,0,0), C1,8); \
    GAPB(o[1]=__builtin_amdgcn_mfma_f32_32x32x16_bf16(PAF(3),VFR(7),o[1],0,0,0), C1,12); \
    }while(0)
  int t=1;
  for(;t+5<NT;t+=2){
    STEP(pB0,pB1,pA0,pA1,t,true,true,true);     WAIT_BAR(2); RESC(); ROT();
    STEP(pA0,pA1,pB0,pB1,t+1,true,true,true);   WAIT_BAR(2); RESC(); ROT();
  }
  #define ENDW(tt) do{ if((tt)+3<NT){WAIT_BAR(2);} else if((tt)+2<NT){WAIT_BAR(1);} else {WAIT_BAR(0);} }while(0)
  for(;t+1<NT;t+=2){
    STEP(pB0,pB1,pA0,pA1,t,(t+3<NT),(t+1<NT),(t+1<NT));       ENDW(t);   RESC(); ROT();
    STEP(pA0,pA1,pB0,pB1,t+1,(t+4<NT),(t+2<NT),(t+2<NT));     ENDW(t+1); RESC(); ROT();
  }
  STEP(pB0,pB1,pA0,pA1,NT-1,false,false,false); RESC();
  { float sacc=pB0[0]+pB0[1]; _Pragma("unroll") for(int r=2;r<16;++r)sacc+=pB0[r]; _Pragma("unroll") for(int r=0;r<16;++r)sacc+=pB1[r]; l_reg+=sacc;
    pw0=(u32x4){PKW(pB0,0),PKW(pB0,2),PKW(pB0,4),PKW(pB0,6)};pw1=(u32x4){PKW(pB0,8),PKW(pB0,10),PKW(pB0,12),PKW(pB0,14)};pw2=(u32x4){PKW(pB1,0),PKW(pB1,2),PKW(pB1,4),PKW(pB1,6)};pw3=(u32x4){PKW(pB1,8),PKW(pB1,10),PKW(pB1,12),PKW(pB1,14)};
    SBAR(); pv(o,vb0+sl_cur,PAF(0),PAF(1),PAF(2),PAF(3)); }
  #undef PKW
  #undef PAF
  #undef VFR
  #undef PIN
  #undef MX3
  #undef GAPA
  #undef GAPB
  #undef EX
  #undef VRD
  #undef KRD
  #undef STEP
  #undef ENDW
  {auto rr=__builtin_amdgcn_permlane32_swap(__float_as_uint(l_reg),__float_as_uint(l_reg),false,false);l_reg=__uint_as_float(rr[0])+__uint_as_float(rr[1]);}
  if(hi==0)wsf[32+r32]=l_reg;asm volatile("s_waitcnt lgkmcnt(0)":::"memory");
  float rli[16];
  #pragma unroll
  for(int r=0;r<16;++r)rli[r]=__builtin_amdgcn_rcpf(wsf[32+crow(r,hi)]);
  bf16*Ow=Ou+(long)(wid*QBLK)*OP;
  { bf16*stg=(bf16*)(shm+LDS_OST)+wid*2048;
    #pragma unroll
    for(int r=0;r<16;++r){const int orow=crow(r,hi);
      #pragma unroll
      for(int d0=0;d0<2;++d0)stg[orow*64+d0*32+r32]=__float2bfloat16(o[d0][r]*rli[r]);}
    asm volatile("s_waitcnt lgkmcnt(0)":::"memory");
    #pragma unroll
    for(int i=0;i<4;++i){const int row=i*8+(lane>>3),ch=lane&7; const u32x4 v=*(const u32x4*)(stg+row*64+ch*8); ATTN_STORE16(Ow+(long)row*OP+ch*8,v);} }
  asm volatile("s_waitcnt lgkmcnt(0)\n\ts_barrier":::"memory");
  #undef DMA_K
  #undef DMA_V
  #undef CMASK
  #undef START
  #undef RESC
  #undef ROT
}
constexpr int ATTN_LDS_BYTES=LDS_BYTES;
#undef SBAR
#undef WAIT_BAR
}


namespace hyf {
struct c32 { float x, y; };
typedef _Float16 h2 __attribute__((ext_vector_type(2)));
__device__ __forceinline__ c32 operator+(c32 a, c32 b) { return {a.x + b.x, a.y + b.y}; }
__device__ __forceinline__ c32 operator-(c32 a, c32 b) { return {a.x - b.x, a.y - b.y}; }
__device__ __forceinline__ c32 cmul(c32 a, c32 b) { return {a.x * b.x - a.y * b.y, a.x * b.y + a.y * b.x}; }
__device__ __forceinline__ constexpr float C32(int k) {
  switch (k) { case 0: return 1.f; case 1: return 0.98078528f; case 2: return 0.923879533f; case 3: return 0.831469612f; case 4: return 0.707106781f; case 5: return 0.555570233f; case 6: return 0.382683432f;
    case 7: return 0.195090322f; case 8: return 0.f; case 9: return -0.195090322f; case 10: return -0.382683432f; case 11: return -0.555570233f; case 12: return -0.707106781f; case 13: return -0.831469612f;
    case 14: return -0.923879533f; default: return -0.98078528f; } }
__device__ __forceinline__ constexpr float S32(int k) {
  switch (k) { case 0: return 0.f; case 1: return 0.195090322f; case 2: return 0.382683432f; case 3: return 0.555570233f; case 4: return 0.707106781f; case 5: return 0.831469612f; case 6: return 0.923879533f;
    case 7: return 0.98078528f; case 8: return 1.f; case 9: return 0.98078528f; case 10: return 0.923879533f; case 11: return 0.831469612f; case 12: return 0.707106781f; case 13: return 0.555570233f;
    case 14: return 0.382683432f; default: return 0.195090322f; } }
__device__ __forceinline__ constexpr int brev(int q, int bits) {
  return bits == 4 ? (((q & 1) << 3) | ((q & 2) << 1) | ((q & 4) >> 1) | ((q & 8) >> 3))
                   : (((q & 1) << 4) | ((q & 2) << 2) | (q & 4) | ((q & 8) >> 2) | ((q & 16) >> 4)); }
__device__ __forceinline__ int phys(int p) { return p + (p >> 5); }
template <int R, int HALF, bool INV> struct DftStage {
  static __device__ __forceinline__ void run(c32 (&x)[R]) {
#pragma unroll
    for (int blk = 0; blk < R; blk += 2 * HALF) {
#pragma unroll
      for (int j = 0; j < HALF; ++j) {
        const c32 a = x[blk + j], b = x[blk + j + HALF]; x[blk + j] = a + b; const c32 d = a - b;
        const int e = j * (R / (2 * HALF)) * (32 / R);
        if (e == 0) x[blk + j + HALF] = d;
        else if (e == 8) x[blk + j + HALF] = INV ? (c32){-d.y, d.x} : (c32){d.y, -d.x};
        else { const c32 wv = {C32(e), INV ? S32(e) : -S32(e)}; x[blk + j + HALF] = cmul(d, wv); }
      } }
    DftStage<R, HALF / 2, INV>::run(x);
  }
};
template <int R, bool INV> struct DftStage<R, 0, INV> { static __device__ __forceinline__ void run(c32 (&)[R]) {} };
template <int R, bool INV> __device__ __forceinline__ void dft_pow2(c32 (&x)[R]) { DftStage<R, R / 2, INV>::run(x); }
template <int R, int HALF> struct DitStage {
  static __device__ __forceinline__ void run(c32 (&x)[R]) {
#pragma unroll
    for (int blk = 0; blk < R; blk += 2 * HALF) {
#pragma unroll
      for (int j = 0; j < HALF; ++j) {
        const int e = j * (R / (2 * HALF)) * (32 / R);
        const c32 a = x[blk + j], b0 = x[blk + j + HALF];
        c32 b;
        if (e == 0) b = b0; else if (e == 8) b = (c32){-b0.y, b0.x}; else b = cmul(b0, (c32){C32(e), S32(e)});
        x[blk + j] = a + b; x[blk + j + HALF] = a - b;
      } }
    DitStage<R, HALF * 2>::run(x);
  }
};
template <int R> struct DitStage<R, R> { static __device__ __forceinline__ void run(c32 (&)[R]) {} };
template <int R> __device__ __forceinline__ void idft_dit(c32 (&x)[R]) { DitStage<R, 1>::run(x); }
template <int STRIDE, bool INV> __device__ __forceinline__ void pass16(c32* buf, int e0, float rev) {
  float rv = rev; asm volatile("" : "+v"(rv));
  const float cs = __builtin_amdgcn_cosf(rv), sn = __builtin_amdgcn_sinf(rv);
  const c32 w1 = {cs, INV ? sn : -sn};
  c32* p = buf + phys(e0); constexpr int PS = STRIDE + STRIDE / 32;
  c32 x[16];
  if (!INV) {
#pragma unroll
    for (int m = 0; m < 16; ++m) x[m] = p[PS * m];
    dft_pow2<16, false>(x);
    c32 w = w1; p[0] = x[0];
#pragma unroll
    for (int q = 1; q < 16; ++q) { p[PS * q] = cmul(x[brev(q, 4)], w); w = cmul(w, w1); }
  } else {
    c32 w = w1; x[0] = p[0];
#pragma unroll
    for (int q = 1; q < 16; ++q) { x[q] = cmul(p[PS * q], w); w = cmul(w, w1); }
    dft_pow2<16, true>(x);
#pragma unroll
    for (int m = 0; m < 16; ++m) p[PS * m] = x[brev(m, 4)];
  }
}
template <int MODE> __device__ __forceinline__ void mid32(c32* buf, h2* Hs, int j) {
  c32* p = buf + 33 * j; c32 x[32];
#pragma unroll
  for (int m = 0; m < 32; ++m) x[m] = p[m];
  dft_pow2<32, false>(x);
  if (MODE == 0) {
#pragma unroll
    for (int q = 0; q < 32; ++q) { const c32 v = x[brev(q, 5)]; Hs[q * 256 + j] = (h2){(_Float16)v.x, (_Float16)v.y}; }
  } else {
#pragma unroll
    for (int pp = 0; pp < 32; ++pp) { const h2 hv = Hs[brev(pp, 5) * 256 + j]; x[pp] = cmul(x[pp], (c32){(float)hv.x, (float)hv.y}); }
    idft_dit<32>(x);
#pragma unroll
    for (int m = 0; m < 32; ++m) p[m] = x[m];
  }
}
__device__ __forceinline__ void fwd2(c32* buf, int tid) {
  __syncthreads(); pass16<512, false>(buf, tid, (float)tid * (1.0f / 8192.0f));
  __syncthreads(); pass16<32, false>(buf, (tid >> 5) * 512 + (tid & 31), (float)(tid & 31) * (1.0f / 512.0f));
  __syncthreads();
}
__device__ __forceinline__ void conv(c32* buf, h2* Hs, int tid) {
  fwd2(buf, tid);
  if (tid < 256) mid32<1>(buf, Hs, tid);
  __syncthreads(); pass16<32, true>(buf, (tid >> 5) * 512 + (tid & 31), (float)(tid & 31) * (1.0f / 512.0f));
  __syncthreads(); pass16<512, true>(buf, tid, (float)tid * (1.0f / 8192.0f));
  __syncthreads();
}
__device__ __forceinline__ void item(int c, const bf16_t* HYT, const float* HK, const float* hy_bias, bf16_t* HYO, char* lds) {
  c32* buf = (c32*)lds; h2* H0 = (h2*)(lds + 67584); h2* H1 = H0 + 8192;
  const int tid = TIDX;
#pragma unroll 1
  for (int o = 0; o < 2; ++o) {
    const float* kp = HK + ((size_t)o * 256 + c) * 8192;
#pragma unroll
    for (int i = 0; i < 16; ++i) { const int n = tid + 512 * i; buf[phys(n)] = (c32){kp[n], 0.f}; }
    fwd2(buf, tid);
    if (tid < 256) mid32<0>(buf, o ? H1 : H0, tid);
    __syncthreads();
  }
  const float bias0 = hy_bias[c], bias1 = hy_bias[256 + c];
#pragma unroll 1
  for (int pr = 0; pr < 2; ++pr) {
    const bf16_t* v0 = HYT + ((size_t)(2 * pr) * 768 + c) * SEQ; const bf16_t* v1 = v0 + (size_t)768 * SEQ;
    c32 vv[8];
#pragma unroll
    for (int i = 0; i < 8; ++i) { const int t = tid + 512 * i; vv[i] = (c32){bf2f(v0[t]), bf2f(v1[t])}; buf[phys(t)] = vv[i]; buf[phys(t + 4096)] = (c32){0.f, 0.f}; }
    conv(buf, H0, tid);
#pragma unroll
    for (int i = 0; i < 8; ++i) { const int t = tid + 512 * i; const c32 y = buf[phys(t)];
      vv[i] = (c32){bf2f(v0[(size_t)256 * SEQ + t]) * (y.x * (1.0f / 8192.0f) + bias0 * vv[i].x), bf2f(v1[(size_t)256 * SEQ + t]) * (y.y * (1.0f / 8192.0f) + bias0 * vv[i].y)};
      buf[phys(t)] = vv[i]; buf[phys(t + 4096)] = (c32){0.f, 0.f}; }
    conv(buf, H1, tid);
#pragma unroll
    for (int i = 0; i < 8; ++i) { const int t = tid + 512 * i; const c32 y = buf[phys(t)];
      HYO[((size_t)(2 * pr) * 256 + c) * SEQ + t] = (bf16_t)f2bf(bf2f(v0[(size_t)512 * SEQ + t]) * (y.x * (1.0f / 8192.0f) + bias1 * vv[i].x));
      HYO[((size_t)(2 * pr + 1) * 256 + c) * SEQ + t] = (bf16_t)f2bf(bf2f(v1[(size_t)512 * SEQ + t]) * (y.y * (1.0f / 8192.0f) + bias1 * vv[i].y)); }
    __syncthreads();
  }
}
__device__ __forceinline__ void out_item(int it, const bf16_t* HYO, bf16_t* MIX, char* lds) {
  bf16_t (*T)[72] = (bf16_t (*)[72])lds;
  const int tid = TIDX, b = it >> 8, t0 = ((it >> 2) & 63) * 64, c0 = (it & 3) * 64;
  { const int cc = tid >> 3, t8 = (tid & 7) * 8; *(u32x4*)&T[cc][t8] = *(const u32x4*)(HYO + ((size_t)b * 256 + c0 + cc) * SEQ + t0 + t8); }
  __syncthreads();
  { const int tl = tid >> 3, c8 = (tid & 7) * 8; u32x4 o;
    o.x = (unsigned)T[c8][tl] | ((unsigned)T[c8 + 1][tl] << 16); o.y = (unsigned)T[c8 + 2][tl] | ((unsigned)T[c8 + 3][tl] << 16);
    o.z = (unsigned)T[c8 + 4][tl] | ((unsigned)T[c8 + 5][tl] << 16); o.w = (unsigned)T[c8 + 6][tl] | ((unsigned)T[c8 + 7][tl] << 16);
    *(u32x4*)(MIX + ((size_t)b * TPB + CTXL + t0 + tl) * DM + 768 + c0 + c8) = o; }
  __syncthreads();
}
}

#define LAS __attribute__((address_space(3)))
#define XB_TMO      128
#define XB_XCNT(j)  (256  + 64 * (j))
#define XB_XSUB(j)  (1280 + 64 * (j))
#define XB_XGEN(j)  (2304 + 64 * (j))
#define XB_TOP      3328
#define XB_TOPGEN   3392
#define XCD_BAR_WORDS 3456
#define XB_SPIN_CAP (1u << 18)

__device__ __forceinline__ unsigned xb_ld(unsigned* p)              { return __hip_atomic_load(p, __ATOMIC_RELAXED, __HIP_MEMORY_SCOPE_AGENT); }
__device__ __forceinline__ unsigned xb_add(unsigned* p, unsigned v) { return __hip_atomic_fetch_add(p, v, __ATOMIC_RELAXED, __HIP_MEMORY_SCOPE_AGENT); }
__device__ __forceinline__ unsigned xb_xcc_id() { return (unsigned)__builtin_amdgcn_s_getreg((3 << 11) | 20) & 0xFu; }
#define XB_SPIN(cond, bar) do { unsigned _sp = 0; while (cond) { __builtin_amdgcn_s_sleep(1); \
    if ((++_sp & 255u) == 0u) { if (xb_ld(&(bar)[XB_TMO])) break; if (_sp > XB_SPIN_CAP) { atomicAdd(&(bar)[XB_TMO], 1u); break; } } } } while (0)

struct XcdBarrier {
    unsigned* bar; unsigned x;
    volatile LAS unsigned* st;
};

__device__ __forceinline__ XcdBarrier xcd_barrier_post(unsigned* bar, volatile LAS unsigned* st) {
    XcdBarrier b; b.bar = bar; b.x = xb_xcc_id(); b.st = st;
    if (threadIdx.x == 0) (void)xb_add(&bar[XB_XCNT(b.x)], 1u);
    return b;
}
__device__ __forceinline__ void xcd_barrier_complete(unsigned* bar, unsigned x, unsigned& nloc, unsigned& nx) {
    const unsigned G = gridDim.x * gridDim.y * gridDim.z;
    unsigned sum, cnt, mine, sp = 0u;
    for (;;) {
        sum = 0u; cnt = 0u; mine = 0u;
#pragma unroll
        for (unsigned j = 0; j < 16; ++j) { const unsigned c = xb_ld(&bar[XB_XCNT(j)]); sum += c; cnt += (c > 0u) ? 1u : 0u; mine = (j == x) ? c : mine; }
        if (sum == G) break;
        __builtin_amdgcn_s_sleep(1);
        if ((++sp & 255u) == 0u) { if (xb_ld(&bar[XB_TMO])) break; if (sp > XB_SPIN_CAP) { atomicAdd(&bar[XB_TMO], 1u); break; } }
    }
    nloc = mine > 0u ? mine : 1u; nx = cnt > 0u ? cnt : 1u;
}

__device__ __forceinline__ void xcd_barrier(const XcdBarrier& b) {
    asm volatile("s_waitcnt vmcnt(0)" ::: "memory");
    __syncthreads();
    if (threadIdx.x == 0) {
        unsigned* bar = b.bar;
        __builtin_amdgcn_s_waitcnt(0);
        unsigned nloc = b.st[0], nx = b.st[1];
        if (nloc == 0u) { xcd_barrier_complete(bar, b.x, nloc, nx); b.st[0] = nloc; b.st[1] = nx; }
        const unsigned old = xb_add(&bar[XB_XSUB(b.x)], 1u);
        const unsigned gen = old / nloc;
        if (old + 1u == (gen + 1u) * nloc) {
            __builtin_amdgcn_fence(__ATOMIC_RELEASE, "agent");
            asm volatile("s_waitcnt vmcnt(0)" ::: "memory");
            const unsigned og = xb_add(&bar[XB_TOP], 1u);
            const unsigned tg = og / nx;
            if (og + 1u == (tg + 1u) * nx) xb_add(&bar[XB_TOPGEN], 1u);
            else XB_SPIN(xb_ld(&bar[XB_TOPGEN]) == tg, bar);
            __builtin_amdgcn_fence(__ATOMIC_ACQUIRE, "agent");
            xb_add(&bar[XB_XGEN(b.x)], 1u);
            asm volatile("s_waitcnt vmcnt(0)" ::: "memory");
        } else {
            XB_SPIN(xb_ld(&bar[XB_XGEN(b.x)]) == gen, bar);
            __builtin_amdgcn_fence(__ATOMIC_ACQUIRE, "agent");
            asm volatile("s_waitcnt vmcnt(0)" ::: "memory");
        }
    }
    __syncthreads();
}


struct MP { const float* in[33]; float* out; unsigned char* ws; };
typedef const float* const __attribute__((address_space(4))) * kargs_t;
#define KARGS() ({ kargs_t k_ = (kargs_t)__builtin_amdgcn_kernarg_segment_ptr(); asm volatile("" : "+s"(k_)); k_; })
#define WSP(K, off) ((unsigned char*)(K)[34] + (off))

__global__ void __launch_bounds__(NT, 2) mega(MP P) {
  cg::grid_group grid = cg::this_grid();
  extern __shared__ __attribute__((aligned(16))) char lds[];
  volatile LAS unsigned* xst = (volatile LAS unsigned*)(lds + LDS_BYTES - 16);
  if (threadIdx.x < 2) xst[threadIdx.x] = 0u;
  __syncthreads();
  { kargs_t K = KARGS(); (void)xcd_barrier_post((unsigned*)WSP(K, WS_CTL) + CT_BAR, xst); }
#define XBAR_HERE() do { kargs_t Kb_ = KARGS(); XcdBarrier xb_; xb_.bar = (unsigned*)WSP(Kb_, WS_CTL) + CT_BAR; xb_.x = xb_xcc_id(); xb_.st = (volatile LAS unsigned*)(lds + LDS_BYTES - 16); xcd_barrier(xb_); } while (0)
#define SEAM() XBAR_HERE()
  {
    kargs_t K = KARGS();
    st_adaln(K[1], K[3], K[4], K[5], (float*)WSP(K, WS_MODV), lds);
    st_rope((float*)WSP(K, WS_ROPE));
  }
  {
      kargs_t K = KARGS();
      st_weights(K[8], K[26], K[29], K[30], K[31], 0, (bf16_t*)WSP(K, WS_WIN), (bf16_t*)WSP(K, WS_WOUT), (bf16_t*)WSP(K, WS_WGU), (bf16_t*)WSP(K, WS_WD), lds);
    }
    { kargs_t K = KARGS(); const int bid = BIDX, G = GDIM;
      for (int it = bid; it < SEQ / 16; it += G) hyfilt_item<SEQ>(it, K[19] + 0 * 33 * 64, K[20] + 0 * 64, K[21] + 0 * 64, K[22] + 0 * 4096, K[23] + 0 * 64, K[24] + (size_t)0 * 65536, (float*)WSP(K, WS_HK), lds);
      if (true) for (int it = bid; it < CTXL / 16; it += G) hyfilt_item<CTXL>(it, K[19] + 0 * 33 * 64, K[20] + 0 * 64, K[21] + 0 * 64, K[22] + 0 * 4096, K[23] + 0 * 64, K[24] + (size_t)0 * 65536, (float*)WSP(K, WS_HKC), lds);
    }
  if (gridDim.x == 0x7fffffffu) grid.sync();
  XBAR_HERE();
#pragma nounroll
  for (int layer = 0; layer < 2; ++layer) {
    const bool last = layer == 1;
    if (layer == 1) {
    {
      kargs_t K = KARGS();
      st_weights(K[8], K[26], K[29], K[30], K[31], layer, (bf16_t*)WSP(K, WS_WIN), (bf16_t*)WSP(K, WS_WOUT), (bf16_t*)WSP(K, WS_WGU), (bf16_t*)WSP(K, WS_WD), lds);
    }
    { kargs_t K = KARGS(); const int bid = BIDX, G = GDIM;
      for (int it = bid; it < SEQ / 16; it += G) hyfilt_item<SEQ>(it, K[19] + layer * 33 * 64, K[20] + layer * 64, K[21] + layer * 64, K[22] + layer * 4096, K[23] + layer * 64, K[24] + (size_t)layer * 65536, (float*)WSP(K, WS_HK), lds);
      if (!last) for (int it = bid; it < CTXL / 16; it += G) hyfilt_item<CTXL>(it, K[19] + layer * 33 * 64, K[20] + layer * 64, K[21] + layer * 64, K[22] + layer * 4096, K[23] + layer * 64, K[24] + (size_t)layer * 65536, (float*)WSP(K, WS_HKC), lds);
    }
    }
    { kargs_t K = KARGS();
      const float* xl_src = layer == 0 ? K[0] : K[33]; const float* xc_src = layer == 0 ? K[2] : (const float*)WSP(K, WS_XC);
      st_normmod(xl_src, xc_src, (float*)K[33], (float*)WSP(K, WS_XC), layer == 0 ? (const bf16_t*)nullptr : (const bf16_t*)WSP(K, WS_H2S), (const int*)WSP(K, WS_MOEM + 768 * 1024),
                 (const float*)WSP(K, WS_MODV) + 5120, K[6] + layer * 1024, (const float*)WSP(K, WS_MODV) + (size_t)layer * 5 * 6144, 0, 1024, (bf16_t*)WSP(K, WS_H), lds);
    }
    SEAM();
    {
      kargs_t K = KARGS();
      pg8::Gemm g{1024, 1024, 1024}; SchedDense S{MTOK / 256, NPAD / 256, (int)GDIM, BIDX, 0, (const char*)WSP(K, WS_H), (const char*)WSP(K, WS_WIN), (size_t)256 * 1024 * 2, (size_t)256 * 1024 * 2};
      EpiInProj E{(bf16_t*)WSP(K, WS_QK), (bf16_t*)WSP(K, WS_VZ), (bf16_t*)WSP(K, WS_XBC), (bf16_t*)WSP(K, WS_HY), (float*)WSP(K, WS_DT)};
      pg8::gemm_phase<EpiInProj, SchedDense, true, true>((PG8_LAS unsigned char*)lds, g, S, E);
    }
    SEAM();
    {
      kargs_t K = KARGS();
      st_prep_qk((bf16_t*)WSP(K, WS_QK), K[9] + layer * 64, K[10] + layer * 64, (const float*)WSP(K, WS_ROPE));
    }
    { kargs_t K = KARGS();
      st_prep_hy((const bf16_t*)WSP(K, WS_HY), K[17] + layer * 3 * 768, K[18] + layer * 768, (bf16_t*)WSP(K, WS_HYT), last ? 0 : 1, lds);
    }
    { kargs_t K = KARGS();
      st_ssd1(BIDX, GDIM, 4 * 34 * 6, (const bf16_t*)WSP(K, WS_XBC), (const float*)WSP(K, WS_DT), K[11] + layer * 3 * 640, K[12] + layer * 640, K[13] + layer * 12, K[14] + layer * 12,
              (float*)WSP(K, WS_Y), (float*)WSP(K, WS_ST), (float*)WSP(K, WS_DEC), lds);
    }
    SEAM();
    {
      { kargs_t K2 = KARGS(); st_ssd_scan2((float*)WSP(K2, WS_ST), (const float*)WSP(K2, WS_DEC)); }
      const int bid = BIDX, G = GDIM;
#define P4_ATT(bb, hq, qrow_, nt_) do { kargs_t K = KARGS(); const int kvh_ = (hq) / 3; \
          const attn_body::bf16* QKp = (const attn_body::bf16*)WSP(K, WS_QK); const attn_body::bf16* VZp = (const attn_body::bf16*)WSP(K, WS_VZ); \
          attn_body::attn_unit<8>(QKp + (size_t)(qrow_) * 512 + (hq) * 64, QKp + (size_t)(bb) * TPB * 512 + 384 + kvh_ * 64, VZp + (size_t)(bb) * TPB * 512 + kvh_ * 64, \
                                  (attn_body::bf16*)WSP(K, WS_H) + (size_t)(qrow_) * 1024 + (hq) * 64, (nt_), lds); } while (0)
#define P4_FFT(cch) do { kargs_t K = KARGS(); hyf::item((cch), (const bf16_t*)WSP(K, WS_HYT), (const float*)WSP(K, WS_HK), K[25] + layer * 512, (bf16_t*)WSP(K, WS_HY), lds); } while (0)
#define P4_CHY(itm) do { kargs_t K = KARGS(); hyconv_ctx_item((itm), (const bf16_t*)WSP(K, WS_HYT) + (size_t)4 * 768 * SEQ, (const float*)WSP(K, WS_HKC), K[25] + layer * 512, (bf16_t*)WSP(K, WS_H), lds); } while (0)
      {
        const int x = bid & 7, y = bid >> 3, bb = x >> 1, kvh = x & 1;
        const int nun = y < 16 ? 2 : 1, natt = nun + ((!last && y < 3) ? 1 : 0);
#pragma unroll 1
        for (int k = 0; k < natt; ++k) { int hq, qrow, nt;
          if (k < nun) { const int v = y < 16 ? y + 16 * k : 16 + y; hq = 3 * kvh + (v >> 4); qrow = bb * TPB + CTXL + (v & 15) * 256; nt = TPB / 64; }
          else { hq = 3 * kvh + y; qrow = bb * TPB; nt = CTXL / 64; }
          P4_ATT(bb, hq, qrow, nt); }
        if (y >= 16) {
#pragma unroll 1
          for (int k = 0; k < 2; ++k) { const int cch = ((y - 16) * 8 + x) * 2 + k; P4_FFT(cch); } }
        if (!last && y >= 3 && y < 11) { P4_CHY((y - 3) * 8 + x); }
      }
      (void)G;
#undef P4_ATT
#undef P4_FFT
#undef P4_CHY
    }
    SEAM();
    {
      kargs_t K = KARGS();
      { const int bid = BIDX, G = GDIM, nit = last ? 4 * 32 * 2 : 4 * 34 * 2;
        for (int it = bid; it < nit; it += G) { const int g = it & 1, bc = it >> 1; const int b = last ? bc >> 5 : bc / 34, cidx = last ? 2 + (bc & 31) : bc % 34;
          ssd3_item(b, cidx, g, (const bf16_t*)WSP(K, WS_XBC), (const bf16_t*)WSP(K, WS_VZ), (const float*)WSP(K, WS_DT), K[11] + layer * 3 * 640, K[12] + layer * 640, K[13] + layer * 12, K[14] + layer * 12,
                    K[15] + layer * 6, K[16] + layer * 384, (const float*)WSP(K, WS_Y), (const float*)WSP(K, WS_ST), (bf16_t*)WSP(K, WS_H), lds); } }
      { const int bid = BIDX, G = GDIM; for (int it = bid; it < 1024; it += G) hyf::out_item(it, (const bf16_t*)WSP(K, WS_HY), (bf16_t*)WSP(K, WS_H), lds); }
      const int t = TIDX; if (BIDX == 0 && t < 256) ((int*)WSP(K, WS_CTL))[t] = 0;
      { int* stok = (int*)WSP(K, WS_MOEM + 384 * 1024); for (int i = BIDX * NT + t; i < MOE_ROWS; i += GDIM * NT) stok[i] = -1; }
    }
    SEAM();
    {
      kargs_t K = KARGS();
      const float* xl_src = layer == 0 ? K[0] : K[33]; const float* xc_src = layer == 0 ? K[2] : (const float*)WSP(K, WS_XC);
      pg8::Gemm g{1024, 1024, 1024}; SchedDense S{last ? 64 : 68, 4, (int)GDIM, BIDX, last ? 1 : 0, (const char*)WSP(K, WS_H), (const char*)WSP(K, WS_WOUT), (size_t)256 * 1024 * 2, (size_t)256 * 1024 * 2};
      EpiOutProj E{(bf16_t*)WSP(K, WS_QK)};
      pg8::gemm_phase<EpiOutProj, SchedDense, true, true>((PG8_LAS unsigned char*)lds, g, S, E);
    }
    SEAM();
    {
      kargs_t K = KARGS();
      st_router(layer == 0 ? K[0] : K[33], layer == 0 ? K[2] : (const float*)WSP(K, WS_XC), (float*)K[33], (float*)WSP(K, WS_XC), (const bf16_t*)WSP(K, WS_QK), K[7] + layer * 1024, (const float*)WSP(K, WS_MODV) + (size_t)layer * 5 * 6144, K[27], K[28], (bf16_t*)WSP(K, WS_H), (int*)WSP(K, WS_CTL),
                (int*)WSP(K, WS_MOEM), (float*)WSP(K, WS_MOEM + 128 * 1024), last ? 1 : 0, lds);
    }
    SEAM();
    { kargs_t K = KARGS();
      st_moe_gather((const bf16_t*)WSP(K, WS_H), (bf16_t*)WSP(K, WS_H2S), (int*)WSP(K, WS_CTL), (const int*)WSP(K, WS_MOEM), (const float*)WSP(K, WS_MOEM + 128 * 1024),
                    (int*)WSP(K, WS_MOEM + 384 * 1024), (float*)WSP(K, WS_MOEM + 512 * 1024), (int*)WSP(K, WS_MOEM + 768 * 1024), last ? 1 : 0, lds);
    }
    SEAM();
    { kargs_t K = KARGS();
      pg8::Gemm g{1024, 1024, 1024}; SchedMoe S{(int)GDIM, BIDX, 1, (const int*)WSP(K, WS_CTL), (const char*)WSP(K, WS_H2S), (size_t)256 * 1024 * 2, (const char*)WSP(K, WS_WGU)};
      EpiMoe1 E{(bf16_t*)WSP(K, WS_ACT), (const float*)WSP(K, WS_MOEM + 512 * 1024)};
      pg8::gemm_phase<EpiMoe1, SchedMoe, true, true>((PG8_LAS unsigned char*)lds, g, S, E);
    }
    SEAM();
    { kargs_t K = KARGS();
      pg8::Gemm g{256, 512, 256}; SchedMoe S{(int)GDIM, BIDX, 2, (const int*)WSP(K, WS_CTL), (const char*)WSP(K, WS_ACT), (size_t)256 * 512 * 2, (const char*)WSP(K, WS_WD)};
      EpiMoe2 E{(bf16_t*)WSP(K, WS_H2S)};
      pg8::gemm_phase<EpiMoe2, SchedMoe, true, true>((PG8_LAS unsigned char*)lds, g, S, E);
    }
    SEAM();
  }
  { kargs_t K = KARGS(); st_final((float*)K[33], K[32], (const bf16_t*)WSP(K, WS_H2S), (const int*)WSP(K, WS_MOEM + 768 * 1024), (const float*)WSP(K, WS_MODV) + (size_t)5 * 6144 + 5120); }
}

extern "C" void kernel_launch(void* const* d_in, const int* in_sizes, int n_in, void* d_out, int out_size, void* d_ws, size_t ws_size, hipStream_t stream) {
  if (n_in != 33 || ws_size < WS_END) { fprintf(stderr, "kernel_launch: unexpected n_in %d / ws %zu\n", n_in, ws_size); return; }
  static int grid_blocks = 0;
  if (!grid_blocks) {
    int dev = 0, cus = 0, per_cu = 0;
    (void)hipGetDevice(&dev);
    (void)hipDeviceGetAttribute(&cus, hipDeviceAttributeMultiprocessorCount, dev);
    (void)hipFuncSetAttribute((const void*)mega, hipFuncAttributeMaxDynamicSharedMemorySize, LDS_BYTES);
    (void)hipOccupancyMaxActiveBlocksPerMultiprocessor(&per_cu, mega, NT, LDS_BYTES);
    if (per_cu < 1) per_cu = 1;
    if (per_cu > 2) per_cu = 2;
    grid_blocks = 256;
    if (cus != 256 || per_cu < 1) fprintf(stderr, "kernel_launch: expected 256 CUs with >= 1 workgroup each (got %d CUs, %d per CU)\n", cus, per_cu);
  }
  (void)hipMemsetAsync((char*)d_ws + WS_CTL + (size_t)CT_BAR * 4, 0, (size_t)XCD_BAR_WORDS * 4, stream);
  MP p{};
  for (int i = 0; i < 33; ++i) p.in[i] = (const float*)d_in[i];
  p.out = (float*)d_out; p.ws = (unsigned char*)d_ws;
  void* args[] = {&p};
  hipError_t e = hipLaunchCooperativeKernel((const void*)mega, dim3(grid_blocks), dim3(NT), args, LDS_BYTES, stream);
  if (e != hipSuccess) fprintf(stderr, "cooperative launch failed: %s (grid %d)\n", hipGetErrorString(e), grid_blocks);
}
```

```cpp
#include <hip/hip_runtime.h>
#include <hip/hip_cooperative_groups.h>
#include <cstdio>
#include <cstdint>
namespace cg = cooperative_groups;

typedef unsigned short bf16_t;
typedef short bf16x8 __attribute__((ext_vector_type(8)));
typedef float f32x4 __attribute__((ext_vector_type(4)));
typedef unsigned u32x4 __attribute__((ext_vector_type(4)));
typedef unsigned u32x2 __attribute__((ext_vector_type(2)));

constexpr int NB = 4, SEQ = 4096, CTXL = 256, DM = 1024, TPB = 4352, MTOK = NB * TPB;
constexpr int DIN = 2444, NPAD = 2560;
constexpr float EPS = 1e-6f;
constexpr float C2 = 0.125f * 1.4426950408889634f;
constexpr int MOE_ROWS = 23552;
constexpr int NT = 512;
constexpr int LDS_BYTES = 147456;

constexpr size_t MiB = 1u << 20;
constexpr size_t WS_CTL = 0;
constexpr size_t WS_MODV = 1 * MiB;
constexpr size_t WS_ROPE = 2 * MiB;
constexpr size_t WS_MOEM = 3 * MiB;
constexpr size_t WS_DT = 4 * MiB;
constexpr size_t WS_HKC = 5 * MiB;
constexpr size_t WS_XC = 6 * MiB;
constexpr size_t WS_WIN = 10 * MiB;
constexpr size_t WS_WOUT = 15 * MiB;
constexpr size_t WS_WGU = 17 * MiB;
constexpr size_t WS_WD = 33 * MiB;
constexpr size_t WS_HK = 41 * MiB;
constexpr size_t WS_H = 57 * MiB;
constexpr size_t WS_QK = 91 * MiB;
constexpr size_t WS_VZ = 108 * MiB;
constexpr size_t WS_XBC = 125 * MiB;
constexpr size_t WS_HY = WS_XBC + (size_t)MTOK * 768 * 2;
constexpr size_t WS_HYT = WS_HY + (size_t)MTOK * 768 * 2;
constexpr size_t WS_ST = WS_HYT + (size_t)MTOK * 768 * 2;
constexpr size_t WS_Y = WS_ST + (size_t)4 * 34 * 2 * 6 * 4096 * 4;
constexpr size_t WS_END = WS_Y + (size_t)MTOK * 384 * 4;
constexpr size_t WS_DEC = WS_DT + 900 * 1024;
constexpr size_t WS_H2S = WS_QK;
constexpr size_t WS_ACT = WS_H2S + (size_t)MOE_ROWS * 1024 * 2;
static_assert(WS_END <= 256 * MiB, "ws");
static_assert(WS_ACT + (size_t)MOE_ROWS * 512 * 2 <= WS_HYT, "moe alias");

constexpr int CT_CNT = 0, CT_FILL = 32, CT_BASE = 64, CT_NT = 96, CT_TP = 128;
constexpr int CT_BAR = 4096;
constexpr int CT_CNTB = 8192;

__device__ __forceinline__ int opq_v(int v) { asm volatile("" : "+v"(v)); return v; }
__device__ __forceinline__ int opq_s(int v) { asm volatile("" : "+s"(v)); return v; }
#define TIDX opq_v((int)threadIdx.x)
#define BIDX opq_s((int)blockIdx.x)
#define GDIM opq_s((int)gridDim.x)
__device__ __forceinline__ unsigned f2bf(float f) { unsigned u = __float_as_uint(f); return (u + 0x7fffu + ((u >> 16) & 1u)) >> 16; }
__device__ __forceinline__ unsigned pk2bf(float lo, float hi) { return f2bf(lo) | (f2bf(hi) << 16); }
__device__ __forceinline__ float bf2f(bf16_t h) { return __uint_as_float(((unsigned)h) << 16); }
__device__ __forceinline__ float wave_sum(float v) {
#pragma unroll
  for (int o = 1; o < 64; o <<= 1) v += __shfl_xor(v, o);
  return v;
}
__device__ __forceinline__ float siluf(float v) { return v / (1.0f + __expf(-v)); }
__device__ __forceinline__ float* xrow(const float* xl, const float* xc, int r) {
  const int b = r / TPB, j = r - b * TPB;
  return (float*)(j < CTXL ? xc + ((size_t)b * CTXL + j) * DM : xl + ((size_t)b * SEQ + (j - CTXL)) * DM);
}
__device__ __forceinline__ int mrow_of(int r) { const int b = r / TPB, j = r - b * TPB; return j < CTXL ? 4 : b; }

__device__ __forceinline__ void st_adaln(const float* c, const float* c_ctx, const float* w_mod, const float* b_mod, float* modv, char* lds) {
  float (*sc)[1024] = (float (*)[1024])lds;
  float (*red)[5][64] = (float (*)[5][64])(lds + 5 * 1024 * 4);
  const int tid = TIDX;
  for (int it = BIDX; it < 192; it += GDIM) {
    const int layer = it / 96, n0 = (it % 96) * 64;
    for (int i = tid; i < 5 * 1024; i += NT) { const int r = i >> 10, k = i & 1023; const float v = r < 4 ? c[r * 1024 + k] : c_ctx[k]; sc[r][k] = v / (1.0f + expf(-v)); }
    __syncthreads();
    const int kg = tid >> 6, n = tid & 63;
    float acc[5] = {0.f, 0.f, 0.f, 0.f, 0.f};
#pragma unroll 16
    for (int k = kg; k < 1024; k += 8) { const float w = w_mod[((size_t)layer * 1024 + k) * 6144 + n0 + n];
#pragma unroll
      for (int r = 0; r < 5; ++r) acc[r] += sc[r][k] * w; }
#pragma unroll
    for (int r = 0; r < 5; ++r) red[kg][r][n] = acc[r];
    __syncthreads();
    if (tid < 320) { const int r = tid >> 6, nn = tid & 63; float s = 0.f;
#pragma unroll
      for (int g = 0; g < 8; ++g) s += red[g][r][nn];
      modv[((size_t)layer * 5 + r) * 6144 + n0 + nn] = s + b_mod[layer * 6144 + n0 + nn]; }
    __syncthreads();
  }
}
__device__ __forceinline__ void st_rope(float* rope) {
  for (int i = BIDX * NT + TIDX; i < 4096 * 32; i += GDIM * NT) {
    const int t = i >> 5, d = i & 31, m = d & 15;
    const float inv = exp2f(-(float)(2 * m) * (13.287712379549449f / 32.0f));
    const float pos = (float)(d < 16 ? (t >> 6) : (t & 63));
    float rev = pos * inv * 0.15915494309189535f; rev -= floorf(rev);
    rope[2 * i] = __builtin_amdgcn_cosf(rev); rope[2 * i + 1] = __builtin_amdgcn_sinf(rev);
  }
}

__device__ __forceinline__ void st_normmod(const float* xl, const float* xc, float* xl_dst, float* xc_dst, const bf16_t* YS, const int* tok_slot, const float* gate_prev,
                                           const float* g, const float* modv_layer, int off_sh, int off_sc, bf16_t* H, char* lds) {
  float* mA = (float*)lds; float* mB = mA + 5 * 1024; float* mG = mB + 5 * 1024;
  const int tid = TIDX, lane = tid & 63, gw = BIDX * 8 + (tid >> 6), ngw = GDIM * 8;
  for (int idx = tid; idx < 5 * 1024; idx += NT) { const int m = idx >> 10, k = idx & 1023; mA[idx] = g[k] * (1.f + modv_layer[(size_t)m * 6144 + off_sc + k]); mB[idx] = modv_layer[(size_t)m * 6144 + off_sh + k];
    mG[idx] = YS ? gate_prev[(size_t)m * 6144 + k] : 0.f; }
  __syncthreads();
  for (int rb = gw; rb < MTOK; rb += 3 * ngw) {
    f32x4 v[3][4]; u32x2 ys[3][4]; float rstd[3];
#pragma unroll
    for (int u = 0; u < 3; ++u) { const int r = rb + u * ngw, rc = r < MTOK ? r : MTOK - 1; const float* xr = xrow(xl, xc, rc);
#pragma unroll
      for (int j = 0; j < 4; ++j) v[u][j] = *(const f32x4*)(xr + 4 * lane + 256 * j);
      if (YS) { const bf16_t* yr = YS + (size_t)tok_slot[rc] * DM;
#pragma unroll
        for (int j = 0; j < 4; ++j) ys[u][j] = *(const u32x2*)(yr + 4 * lane + 256 * j); } }
    if (YS) {
#pragma unroll
      for (int u = 0; u < 3; ++u) { const int r = rb + u * ngw; if (r < MTOK) { const int mo = mrow_of(r) * 1024; float* xd = xrow(xl_dst, xc_dst, r);
#pragma unroll
        for (int j = 0; j < 4; ++j) { const int k = 4 * lane + 256 * j; const f32x4 g4 = *(const f32x4*)(mG + mo + k);
          const f32x4 m4 = (f32x4){__uint_as_float(ys[u][j].x << 16), __uint_as_float(ys[u][j].x & 0xffff0000u), __uint_as_float(ys[u][j].y << 16), __uint_as_float(ys[u][j].y & 0xffff0000u)};
          v[u][j] = v[u][j] + g4 * m4; *(f32x4*)(xd + k) = v[u][j]; } } } }
#pragma unroll
    for (int u = 0; u < 3; ++u) { float ss = 0.f;
#pragma unroll
      for (int j = 0; j < 4; ++j) ss += v[u][j].x * v[u][j].x + v[u][j].y * v[u][j].y + v[u][j].z * v[u][j].z + v[u][j].w * v[u][j].w;
      rstd[u] = rsqrtf(wave_sum(ss) * (1.0f / DM) + EPS); }
#pragma unroll
    for (int u = 0; u < 3; ++u) { const int r = rb + u * ngw;
      if (r < MTOK) { const int mo = mrow_of(r) * 1024;
#pragma unroll
        for (int j = 0; j < 4; ++j) { const int k = 4 * lane + 256 * j;
          const f32x4 a4 = *(const f32x4*)(mA + mo + k), b4 = *(const f32x4*)(mB + mo + k); const f32x4 o = v[u][j] * rstd[u] * a4 + b4;
          u32x2 w; w.x = pk2bf(o.x, o.y); w.y = pk2bf(o.z, o.w);
          *(u32x2*)(H + (size_t)r * DM + k) = w; } } }
  }
  __syncthreads();
}

template <int MODE> __device__ __forceinline__ void tr_wave_item(const float* src, const float* src2, int ldsrc, int K, bf16_t* out, int n0, int k0, float* scr, int lane) {
  const int nn = lane & 31, n = n0 + nn;
#pragma unroll 8
  for (int i = 0; i < 32; ++i) { const int kk = 2 * i + (lane >> 5); float v = 0.f;
    if (MODE == 0) { const int col = n < 1676 ? n : (n < 1792 ? -1 : n - 116); if (col >= 0) v = src[(size_t)(k0 + kk) * ldsrc + col]; }
    else if (MODE == 1) v = src[(size_t)(k0 + kk) * ldsrc + n];
    else v = (n & 1) ? src2[(size_t)(k0 + kk) * ldsrc + (n >> 1)] : src[(size_t)(k0 + kk) * ldsrc + (n >> 1)];
    scr[kk * 33 + nn] = v; }
  asm volatile("s_waitcnt lgkmcnt(0)" ::: "memory");
  const int c = lane & 7;
#pragma unroll
  for (int j = 0; j < 4; ++j) { const int nr = (lane >> 3) + 8 * j; const float* sp = scr + (8 * c) * 33 + nr;
    u32x4 o; o.x = f2bf(sp[0]) | (f2bf(sp[33]) << 16); o.y = f2bf(sp[66]) | (f2bf(sp[99]) << 16); o.z = f2bf(sp[132]) | (f2bf(sp[165]) << 16); o.w = f2bf(sp[198]) | (f2bf(sp[231]) << 16);
    *(u32x4*)(out + (size_t)(n0 + nr) * K + k0 + 8 * c) = o; }
  asm volatile("s_waitcnt lgkmcnt(0)" ::: "memory");
}
__device__ __forceinline__ void st_weights(const float* w_in, const float* w_out, const float* w_gate, const float* w_up, const float* w_down, int layer,
                                           bf16_t* WIN, bf16_t* WOUT, bf16_t* WGU, bf16_t* WD, char* lds) {
  const int tid = TIDX, lane = tid & 63, w = tid >> 6; float* scr = (float*)lds + w * (64 * 33);
  for (int it = BIDX * 8 + w; it < 7936; it += GDIM * 8) {
    if (it < 1280) tr_wave_item<0>(w_in + (size_t)layer * 1024 * DIN, nullptr, DIN, 1024, WIN, (it % 80) * 32, (it / 80) * 64, scr, lane);
    else if (it < 1792) { const int i2 = it - 1280; tr_wave_item<1>(w_out + (size_t)layer * 1024 * 1024, nullptr, 1024, 1024, WOUT, (i2 & 31) * 32, (i2 >> 5) * 64, scr, lane); }
    else if (it < 5888) { const int i2 = it - 1792, e = i2 >> 8, t = i2 & 255;
      tr_wave_item<2>(w_gate + ((size_t)layer * 16 + e) * 1024 * 256, w_up + ((size_t)layer * 16 + e) * 1024 * 256, 256, 1024, WGU + (size_t)e * 512 * 1024, (t & 15) * 32, (t >> 4) * 64, scr, lane); }
    else { const int i2 = it - 5888, e = i2 >> 7, t = i2 & 127;
      tr_wave_item<1>(w_down + ((size_t)layer * 16 + e) * 256 * 1024, nullptr, 1024, 256, WD + (size_t)e * 1024 * 256, (t & 31) * 32, (t >> 5) * 64, scr, lane); }
  }
  __syncthreads();
}

__device__ __forceinline__ void pair_experts(int pidx, int& eA, int& eB) {
  const int g = pidx / 6, t = pidx - 6 * g; const int i = t < 3 ? 0 : (t < 5 ? 1 : 2); const int j = t < 3 ? t + 1 : (t < 5 ? t - 1 : 3);
  eA = 4 * g + i; eB = 4 * g + j;
}
__device__ __forceinline__ void st_prep_qk(bf16_t* QK, const float* qn, const float* kn, const float* rope) {
  const int lane = TIDX & 63, gw = BIDX * 8 + (TIDX >> 6), ngw = GDIM * 8, hh = lane >> 3, sub = lane & 7;
  float gn[8];
#pragma unroll
  for (int e = 0; e < 8; ++e) gn[e] = ((hh < 6 ? qn : kn) + sub * 8)[e] * (hh < 6 ? C2 : 1.0f);
  for (int rb = gw; rb < MTOK; rb += 3 * ngw) {
    bf16x8 raw[3]; f32x4 rp4[3][4];
#pragma unroll
    for (int u = 0; u < 3; ++u) { const int r = rb + u * ngw < MTOK ? rb + u * ngw : MTOK - 1; const int j = r % TPB, t = j >= CTXL ? j - CTXL : 0;
      raw[u] = *(const bf16x8*)(QK + (size_t)r * 512 + hh * 64 + sub * 8);
      const float* rp = rope + ((size_t)t * 32 + (sub & 3) * 8) * 2;
#pragma unroll
      for (int q = 0; q < 4; ++q) rp4[u][q] = *(const f32x4*)(rp + 4 * q); }
#pragma unroll
    for (int u = 0; u < 3; ++u) { const int r = rb + u * ngw; const int j = (r < MTOK ? r : MTOK - 1) % TPB;
      float v[8]; float ss = 0.f;
#pragma unroll
      for (int e = 0; e < 8; ++e) { v[e] = bf2f((bf16_t)raw[u][e]); ss += v[e] * v[e]; }
      ss += __shfl_xor(ss, 1); ss += __shfl_xor(ss, 2); ss += __shfl_xor(ss, 4);
      const float rstd = rsqrtf(ss * (1.0f / 64.0f) + EPS);
#pragma unroll
      for (int e = 0; e < 8; ++e) v[e] = v[e] * rstd * gn[e];
      if (j >= CTXL) {
#pragma unroll
        for (int e = 0; e < 8; ++e) { const float other = __shfl_xor(v[e], 4); const float cs = rp4[u][e >> 1][(e & 1) * 2], sn = rp4[u][e >> 1][(e & 1) * 2 + 1]; v[e] = sub < 4 ? v[e] * cs - other * sn : v[e] * cs + other * sn; } }
      if (r < MTOK) *(u32x4*)(QK + (size_t)r * 512 + hh * 64 + sub * 8) = (u32x4){pk2bf(v[0], v[1]), pk2bf(v[2], v[3]), pk2bf(v[4], v[5]), pk2bf(v[6], v[7])}; }
  }
}

__device__ __forceinline__ void st_prep_hy(const bf16_t* HY, const float* cw, const float* cb, bf16_t* HYT, int do_ctx, char* lds) {
  const int tid = TIDX, lane = tid & 63, w = tid >> 6; float* tile = (float*)lds + w * (66 * 33);
  const int nlat = 4 * 64 * 24, nitem = nlat + (do_ctx ? 4 * 4 * 24 : 0), step = (GDIM - 48) * 8;
  bf16x8 raw[5];
#define PHY_DECODE(it) int b, tt, ct, L, joff; bf16_t* outb; \
    if ((it) < nlat) { b = (it) / 1536; tt = ((it) % 1536) / 24; ct = (it) % 24; L = SEQ; joff = CTXL; outb = HYT + (size_t)b * 768 * SEQ; } \
    else { const int i2 = (it) - nlat; b = i2 / 96; tt = (i2 % 96) / 24; ct = i2 % 24; L = CTXL; joff = 0; outb = HYT + (size_t)4 * 768 * SEQ + (size_t)b * 768 * CTXL; } \
    const int t0 = tt * 64, c0 = ct * 32; (void)outb;
#define PHY_LOADS(it) do { PHY_DECODE(it) _Pragma("unroll") for (int i = 0; i < 5; ++i) { const int rr = (lane >> 2) + 16 * i, c8 = (lane & 3) * 8; int t = t0 - 1 + rr; const bool ok = rr < 66 && t >= 0 && t < L; t = ok ? t : t0; \
      const bf16x8 v = *(const bf16x8*)(HY + ((size_t)b * TPB + joff + t) * 768 + c0 + c8); raw[i] = ok ? v : (bf16x8){0, 0, 0, 0, 0, 0, 0, 0}; } } while (0)
  int it = BIDX >= 48 ? (BIDX - 48) * 8 + w : nitem;
  if (it < nitem) PHY_LOADS(it);
  for (; it < nitem; it += step) {
    PHY_DECODE(it)
#pragma unroll
    for (int i = 0; i < 5; ++i) { const int rr = (lane >> 2) + 16 * i, c8 = (lane & 3) * 8;
      if (rr < 66) {
#pragma unroll
        for (int e = 0; e < 8; ++e) tile[rr * 33 + c8 + e] = bf2f((bf16_t)raw[i][e]); } }
    asm volatile("s_waitcnt lgkmcnt(0)" ::: "memory");
    if (it + step < nitem) PHY_LOADS(it + step);
#pragma unroll 4
    for (int cc = 0; cc < 32; ++cc) { const int c = c0 + cc;
      const float v = cw[c] * tile[lane * 33 + cc] + cw[768 + c] * tile[(lane + 1) * 33 + cc] + cw[1536 + c] * tile[(lane + 2) * 33 + cc] + cb[c];
      outb[(size_t)c * L + t0 + lane] = (bf16_t)f2bf(v); }
    asm volatile("s_waitcnt lgkmcnt(0)" ::: "memory");
  }
#undef PHY_LOADS
#undef PHY_DECODE
  __syncthreads();
}

template <int L> __device__ __forceinline__ void hyfilt_item(int item, const float* w1, const float* b1, const float* fr, const float* w2, const float* b2, const float* w3, float* HK, char* lds) {
  float* F = (float*)lds; float* W1 = F + 64 * 37; float* H1 = W1 + 36 * 68; float* W2 = H1 + 64 * 68; float* S1 = W2 + 64 * 68;
  const int tid = TIDX, n0 = (item >> 2) * 64, cq = item & 3, lane = tid & 63, wv = tid >> 6, l15 = lane & 15, l4 = lane >> 4;
  for (int e = tid; e < 64 * 36; e += NT) { const int pp = e / 36, f = e % 36; const int n = n0 + pp; float v = 0.f;
    if (f == 0) v = (float)n / (float)(L - 1);
    else if (f < 33) { const int m = (f - 1) & 15; const float band = 1e-4f + (float)m * ((15.0f - 1e-4f) / 15.0f); float rev = ((float)n * (1.0f / (float)L)) * band; rev -= floorf(rev);
      v = f <= 16 ? __builtin_amdgcn_cosf(rev) : -__builtin_amdgcn_sinf(rev); }
    F[pp * 37 + f] = v; }
  for (int e = tid; e < 36 * 64; e += NT) { const int k = e >> 6, j = e & 63; W1[k * 68 + j] = k < 33 ? w1[k * 64 + j] : 0.f; }
  for (int e = tid; e < 64 * 64; e += NT) { const int k = e >> 6, j = e & 63; W2[k * 68 + j] = w2[e]; }
  __syncthreads();
  { const int pt = wv >> 1, c0 = 32 * (wv & 1);
    f32x4 acc[2] = {(f32x4){0.f, 0.f, 0.f, 0.f}, (f32x4){0.f, 0.f, 0.f, 0.f}};
#pragma unroll
    for (int kk = 0; kk < 9; ++kk) { const float av = F[(pt * 16 + l15) * 37 + 4 * kk + l4];
      acc[0] = __builtin_amdgcn_mfma_f32_16x16x4f32(av, W1[(4 * kk + l4) * 68 + c0 + l15], acc[0], 0, 0, 0);
      acc[1] = __builtin_amdgcn_mfma_f32_16x16x4f32(av, W1[(4 * kk + l4) * 68 + c0 + 16 + l15], acc[1], 0, 0, 0); }
#pragma unroll
    for (int ct = 0; ct < 2; ++ct) { const int j = c0 + 16 * ct + l15; const float bj = b1[j], fj = fr[j] * 0.15915494309189535f;
#pragma unroll
      for (int rg = 0; rg < 4; ++rg) { float rev = fj * (acc[ct][rg] + bj); rev -= floorf(rev); H1[(pt * 16 + 4 * l4 + rg) * 68 + j] = __builtin_amdgcn_sinf(rev); } } }
  __syncthreads();
  { const int pt = wv >> 1, c0 = 32 * (wv & 1);
    f32x4 acc[2] = {(f32x4){0.f, 0.f, 0.f, 0.f}, (f32x4){0.f, 0.f, 0.f, 0.f}};
#pragma unroll
    for (int kk = 0; kk < 16; ++kk) { const float av = H1[(pt * 16 + l15) * 68 + 4 * kk + l4];
      acc[0] = __builtin_amdgcn_mfma_f32_16x16x4f32(av, W2[(4 * kk + l4) * 68 + c0 + l15], acc[0], 0, 0, 0);
      acc[1] = __builtin_amdgcn_mfma_f32_16x16x4f32(av, W2[(4 * kk + l4) * 68 + c0 + 16 + l15], acc[1], 0, 0, 0); }
#pragma unroll
    for (int ct = 0; ct < 2; ++ct) { const int j = c0 + 16 * ct + l15; const float bj = b2[j], fj = fr[j] * 0.15915494309189535f;
#pragma unroll
      for (int rg = 0; rg < 4; ++rg) { float rev = fj * (acc[ct][rg] + bj); rev -= floorf(rev); S1[(pt * 16 + 4 * l4 + rg) * 68 + j] = __builtin_amdgcn_sinf(rev); } } }
  __syncthreads();
  {
    const int colb = cq * 256 + 32 * wv;
    f32x4 acc[4][2];
#pragma unroll
    for (int pt = 0; pt < 4; ++pt) { acc[pt][0] = (f32x4){0.f, 0.f, 0.f, 0.f}; acc[pt][1] = (f32x4){0.f, 0.f, 0.f, 0.f}; }
#pragma unroll 4
    for (int kk = 0; kk < 16; ++kk) { const int k = 4 * kk + l4;
      const float bv0 = w3[k * 1024 + colb + l15], bv1 = w3[k * 1024 + colb + 16 + l15];
#pragma unroll
      for (int pt = 0; pt < 4; ++pt) { const float av = S1[(pt * 16 + l15) * 68 + k];
        acc[pt][0] = __builtin_amdgcn_mfma_f32_16x16x4f32(av, bv0, acc[pt][0], 0, 0, 0);
        acc[pt][1] = __builtin_amdgcn_mfma_f32_16x16x4f32(av, bv1, acc[pt][1], 0, 0, 0); } }
#pragma unroll
    for (int ct = 0; ct < 2; ++ct) { const int col = colb + 16 * ct + l15, dir = col >> 9, order = (col >> 8) & 1, c = col & 255;
      const float delta = 3.0701134573253943f + (float)c * ((15.350567286626972f - 3.0701134573253943f) / 255.0f);
      float* dst = HK + ((size_t)order * 256 + c) * (2 * L);
#pragma unroll
      for (int pt = 0; pt < 4; ++pt) { const int nb = n0 + pt * 16 + 4 * l4; f32x4 o;
#pragma unroll
        for (int rg = 0; rg < 4; ++rg) o[rg] = acc[pt][ct][rg] * __expf(-((float)(nb + rg) / (float)(L - 1)) * delta);
        if (dir == 0) *(f32x4*)(dst + nb) = o;
        else {
#pragma unroll
          for (int rg = 0; rg < 4; ++rg) { const int n = nb + rg; if (n >= 1) dst[2 * L - n] = o[rg]; else dst[L] = 0.f; } } } }
  }
  __syncthreads();
}

__device__ __forceinline__ void hyconv_ctx_item(int item, const bf16_t* HYTC, const float* HKC, const float* hy_bias, bf16_t* MIX, char* lds) {
  constexpr int L = CTXL;
  const int tid = TIDX, b = item >> 4, cc = tid >> 5, c = (item & 15) * 16 + cc, sub = tid & 31, tb = 8 * sub;
  float* kern = (float*)lds + cc * (2 * L); float* z = (float*)lds + 16 * 2 * L + cc * L;
  const bf16_t* vp = HYTC + ((size_t)b * 768 + c) * L; const bf16_t* x1p = vp + (size_t)256 * L; const bf16_t* x2p = vp + (size_t)512 * L;
#pragma unroll 1
  for (int o = 0; o < 2; ++o) {
    if (o == 0) for (int t = sub; t < L; t += 32) z[t] = bf2f(vp[t]);
    const float* kp = HKC + ((size_t)o * 256 + c) * (2 * L);
    for (int t = sub; t < 2 * L; t += 32) kern[t] = kp[t];
    __syncthreads();
    float acc[8], W[16];
#pragma unroll
    for (int i = 0; i < 8; ++i) { acc[i] = 0.f; W[8 + i] = kern[(tb + i) & (2 * L - 1)]; }
    for (int s0 = 0; s0 < L; s0 += 8) {
      const int bb = (tb - s0 - 8) & (2 * L - 1);
#pragma unroll
      for (int i = 0; i < 8; ++i) W[i] = kern[bb + i];
      float zs[8];
#pragma unroll
      for (int j = 0; j < 8; ++j) zs[j] = z[s0 + j];
#pragma unroll
      for (int j = 0; j < 8; ++j)
#pragma unroll
        for (int i = 0; i < 8; ++i) acc[i] += W[8 + i - j] * zs[j];
#pragma unroll
      for (int i = 0; i < 8; ++i) W[8 + i] = W[i];
    }
    __syncthreads();
    const float bias = hy_bias[o * 256 + c];
#pragma unroll
    for (int i = 0; i < 8; ++i) { const int t = tb + i; const float zz = acc[i] + bias * z[t];
      if (o == 0) z[t] = bf2f(x1p[t]) * zz;
      else MIX[((size_t)b * TPB + t) * DM + 768 + c] = (bf16_t)f2bf(bf2f(x2p[t]) * zz); }
    __syncthreads();
  }
}

__device__ __forceinline__ void ssd_conv8(const bf16_t* XBC, size_t r, int c0, bool hasp, bool hasn, const float* cw, const float* cb, float (&o)[8]) {
  const bf16x8 cur = *(const bf16x8*)(XBC + r * 768 + c0);
  const bf16x8 prv = *(const bf16x8*)(XBC + (hasp ? r - 1 : r) * 768 + c0), nxt = *(const bf16x8*)(XBC + (hasn ? r + 1 : r) * 768 + c0);
  const float wp = hasp ? 1.f : 0.f, wn = hasn ? 1.f : 0.f;
#pragma unroll
  for (int e = 0; e < 8; ++e) { const float v = wp * cw[c0 + e] * bf2f((bf16_t)prv[e]) + cw[640 + c0 + e] * bf2f((bf16_t)cur[e]) + wn * cw[1280 + c0 + e] * bf2f((bf16_t)nxt[e]) + cb[c0 + e]; o[e] = siluf(v); }
}
__device__ __forceinline__ float softplusf(float x) {
  const float y = __expf(-fabsf(x)); const float l = y < 0.06f ? y * (1.f - y * (0.5f - y * (0.33333334f - 0.25f * y))) : __logf(1.f + y); return fmaxf(x, 0.f) + l; }
__device__ __forceinline__ void wave_scan128(float e0, float e1, int lane, float& c0, float& c1) {
  float x = e0 + e1;
#pragma unroll
  for (int o = 1; o < 64; o <<= 1) { const float v = __shfl_up(x, o); if (lane >= o) x += v; }
  const float excl = x - (e0 + e1); c0 = excl + e0; c1 = excl + e0 + e1;
}
__device__ __forceinline__ int ssd_chunk_j0(int cidx) { return cidx < 2 ? cidx * 128 : CTXL + (cidx - 2) * 128; }

__device__ __forceinline__ void st_ssd1(int it0, int step, int nitems, const bf16_t* XBC, const float* DT, const float* cw, const float* cb, const float* dt_bias, const float* a_log,
                                        float* YIN, float* ST, float* DEC, char* lds) {
  bf16_t (*Cm)[72] = (bf16_t (*)[72])lds; bf16_t (*Bm)[72] = (bf16_t (*)[72])(lds + 18432);
  bf16_t (*BT)[136] = (bf16_t (*)[136])(lds + 36864); bf16_t (*Xt)[136] = (bf16_t (*)[136])(lds + 54272); bf16_t (*Mm)[136] = (bf16_t (*)[136])(lds + 71680);
  float* tab = (float*)(lds + 106496); float* dtf = tab; float* dtb = tab + 128; float* acf = tab + 256; float* acb = tab + 384; float* wf = tab + 512; float* wb = tab + 640;
  const int tid = TIDX;
  bf16x8 cu[6], pv[6], nx[6];
#define SSD1_LOADS(itm, I0, I1) do { const int h_ = (itm) % 6, bc_ = (itm) / 6, cidx_ = bc_ % 34, b_ = bc_ / 34, g_ = h_ / 3, j0_ = ssd_chunk_j0(cidx_); const size_t r0_ = (size_t)b_ * TPB + j0_; \
    _Pragma("unroll") for (int i = (I0); i < (I1); ++i) { const int task = tid + NT * i, t = task / 24, cg = task % 24, kind = cg >> 3, q = cg & 7, j = j0_ + t; \
      const int c0 = kind == 0 ? h_ * 64 + 8 * q : (kind == 1 ? 384 + g_ * 64 + 8 * q : 512 + g_ * 64 + 8 * q); \
      const bool hasp = j != 0 && j != CTXL, hasn = j != CTXL - 1 && j != TPB - 1; const bf16_t* p = XBC + (r0_ + t) * 768 + c0; \
      cu[i] = *(const bf16x8*)p; pv[i] = *(const bf16x8*)(p + (hasp ? -768 : 0)); nx[i] = *(const bf16x8*)(p + (hasn ? 768 : 0)); } } while (0)
  if (it0 < nitems) SSD1_LOADS(it0, 0, 6);
#pragma unroll 1
  for (int item = it0; item < nitems; item += step) {
  const int tid = TIDX, lane = tid & 63, w = tid >> 6, l15 = lane & 15, l4 = lane >> 4;
  const int h = item % 6, bc = item / 6, cidx = bc % 34, b = bc / 34, g = h / 3, j0 = ssd_chunk_j0(cidx);
  const size_t r0 = (size_t)b * TPB + j0;
  float dtr0 = 0.f, dtr1 = 0.f;
  if (w < 2) { const int t0 = w == 0 ? 2 * lane : 127 - 2 * lane, t1 = w == 0 ? 2 * lane + 1 : 126 - 2 * lane; dtr0 = DT[(r0 + t0) * 12 + w * 6 + h]; dtr1 = DT[(r0 + t1) * 12 + w * 6 + h]; }
  SSD1_LOADS(item, 6, 6);
  {
#pragma unroll
    for (int i = 0; i < 6; ++i) { const int task = tid + NT * i, t = task / 24, cg = task % 24, kind = cg >> 3, q = cg & 7, j = j0 + t;
      const int c0 = kind == 0 ? h * 64 + 8 * q : (kind == 1 ? 384 + g * 64 + 8 * q : 512 + g * 64 + 8 * q);
      const float wp = (j != 0 && j != CTXL) ? 1.f : 0.f, wn = (j != CTXL - 1 && j != TPB - 1) ? 1.f : 0.f;
      float o[8];
#pragma unroll
      for (int e = 0; e < 8; ++e) o[e] = siluf(wp * cw[c0 + e] * bf2f((bf16_t)pv[i][e]) + cw[640 + c0 + e] * bf2f((bf16_t)cu[i][e]) + wn * cw[1280 + c0 + e] * bf2f((bf16_t)nx[i][e]) + cb[c0 + e]);
      if (kind == 0) {
#pragma unroll
        for (int e = 0; e < 8; ++e) Xt[8 * q + e][t] = (bf16_t)f2bf(o[e]);
      } else { const u32x4 pk = (u32x4){pk2bf(o[0], o[1]), pk2bf(o[2], o[3]), pk2bf(o[4], o[5]), pk2bf(o[6], o[7])};
        if (kind == 1) { *(u32x4*)&Bm[t][8 * q] = pk;
#pragma unroll
          for (int e = 0; e < 8; ++e) BT[8 * q + e][t] = (bf16_t)f2bf(o[e]); }
        else *(u32x4*)&Cm[t][8 * q] = pk; } }
  }
  if (w < 2) { const int dir = w; const float a = -expf(a_log[dir * 6 + h]), bias = dt_bias[dir * 6 + h];
    const int t0 = dir == 0 ? 2 * lane : 127 - 2 * lane, t1 = dir == 0 ? 2 * lane + 1 : 126 - 2 * lane;
    const float d0 = softplusf(dtr0 + bias), d1 = softplusf(dtr1 + bias);
    float c0, c1; wave_scan128(d0 * a, d1 * a, lane, c0, c1);
    const float tot = __shfl(c1, 63);
    float* dtt = dir == 0 ? dtf : dtb; float* ac = dir == 0 ? acf : acb; float* ww = dir == 0 ? wf : wb;
    dtt[t0] = d0; dtt[t1] = d1; ac[t0] = c0; ac[t1] = c1; ww[t0] = __expf(tot - c0) * d0; ww[t1] = __expf(tot - c1) * d1;
    if (lane == 0) DEC[(((size_t)b * 34 + cidx) * 2 + dir) * 6 + h] = __expf(tot); }
  __syncthreads();
  if (item + step < nitems) SSD1_LOADS(item + step, 0, 6);
  {
    f32x4 accG[8];
#pragma unroll
    for (int ni = 0; ni < 8; ++ni) accG[ni] = (f32x4){0.f, 0.f, 0.f, 0.f};
#pragma unroll
    for (int kk = 0; kk < 2; ++kk) { const bf16x8 a = *(const bf16x8*)&Cm[16 * w + l15][32 * kk + 8 * l4];
#pragma unroll
      for (int ni = 0; ni < 8; ++ni) { const bf16x8 bb = *(const bf16x8*)&Bm[16 * ni + l15][32 * kk + 8 * l4]; accG[ni] = __builtin_amdgcn_mfma_f32_16x16x32_bf16(a, bb, accG[ni], 0, 0, 0); } }
    float aft[4], abt[4];
#pragma unroll
    for (int rg = 0; rg < 4; ++rg) { aft[rg] = acf[16 * w + 4 * l4 + rg]; abt[rg] = acb[16 * w + 4 * l4 + rg]; }
#pragma unroll
    for (int ni = 0; ni < 8; ++ni) { const int sidx = 16 * ni + l15; const float afs = acf[sidx], abs_ = acb[sidx], dfs = dtf[sidx], dbs = dtb[sidx];
#pragma unroll
      for (int rg = 0; rg < 4; ++rg) { const int t = 16 * w + 4 * l4 + rg;
        const float f = sidx <= t ? __expf(aft[rg] - afs) * dfs : 0.f, bk = sidx >= t ? __expf(abt[rg] - abs_) * dbs : 0.f;
        Mm[t][sidx] = (bf16_t)f2bf(accG[ni][rg] * (f + bk)); } }
  }
  __syncthreads();
  {
    f32x4 acc[4];
#pragma unroll
    for (int ni = 0; ni < 4; ++ni) acc[ni] = (f32x4){0.f, 0.f, 0.f, 0.f};
#pragma unroll
    for (int kk = 0; kk < 4; ++kk) { const bf16x8 a = *(const bf16x8*)&Mm[16 * w + l15][32 * kk + 8 * l4];
#pragma unroll
      for (int ni = 0; ni < 4; ++ni) { const bf16x8 bb = *(const bf16x8*)&Xt[16 * ni + l15][32 * kk + 8 * l4]; acc[ni] = __builtin_amdgcn_mfma_f32_16x16x32_bf16(a, bb, acc[ni], 0, 0, 0); } }
#pragma unroll
    for (int rg = 0; rg < 4; ++rg)
#pragma unroll
      for (int ni = 0; ni < 4; ++ni) YIN[(r0 + 16 * w + 4 * l4 + rg) * 384 + h * 64 + 16 * ni + l15] = acc[ni][rg];
  }
  {
    const int dir = w >> 2, mt = w & 3; const float* ww = dir == 0 ? wf : wb;
    f32x4 acc[4];
#pragma unroll
    for (int ni = 0; ni < 4; ++ni) acc[ni] = (f32x4){0.f, 0.f, 0.f, 0.f};
#pragma unroll
    for (int kk = 0; kk < 4; ++kk) { const bf16x8 raw = *(const bf16x8*)&Xt[16 * mt + l15][32 * kk + 8 * l4];
      const f32x4 w0 = *(const f32x4*)(ww + 32 * kk + 8 * l4), w1 = *(const f32x4*)(ww + 32 * kk + 8 * l4 + 4);
      u32x4 pk; pk.x = pk2bf(bf2f((bf16_t)raw[0]) * w0.x, bf2f((bf16_t)raw[1]) * w0.y); pk.y = pk2bf(bf2f((bf16_t)raw[2]) * w0.z, bf2f((bf16_t)raw[3]) * w0.w);
      pk.z = pk2bf(bf2f((bf16_t)raw[4]) * w1.x, bf2f((bf16_t)raw[5]) * w1.y); pk.w = pk2bf(bf2f((bf16_t)raw[6]) * w1.z, bf2f((bf16_t)raw[7]) * w1.w);
      const bf16x8 a = __builtin_bit_cast(bf16x8, pk);
#pragma unroll
      for (int ni = 0; ni < 4; ++ni) { const bf16x8 bb = *(const bf16x8*)&BT[16 * ni + l15][32 * kk + 8 * l4]; acc[ni] = __builtin_amdgcn_mfma_f32_16x16x32_bf16(a, bb, acc[ni], 0, 0, 0); } }
    float* sp = ST + ((((size_t)b * 34 + cidx) * 2 + dir) * 6 + h) * 4096;
#pragma unroll
    for (int rg = 0; rg < 4; ++rg)
#pragma unroll
      for (int ni = 0; ni < 4; ++ni) sp[(16 * mt + 4 * l4 + rg) * 64 + 16 * ni + l15] = acc[ni][rg];
  }
  __syncthreads();
  }
#undef SSD1_LOADS
}

__device__ __forceinline__ void st_ssd_scan2(float* ST, const float* DEC) {
  for (int idx = BIDX * NT + TIDX; idx < 4 * 2 * 6 * 4096; idx += GDIM * NT) {
    const int e = idx & 4095, bdh = idx >> 12, h = bdh % 6, dir = (bdh / 6) & 1, b = bdh / 12;
    float v[34], d[34];
#pragma unroll
    for (int st = 0; st < 34; ++st) { const int cidx = dir == 0 ? st : (st < 2 ? 1 - st : 35 - st); const size_t o = (((size_t)b * 34 + cidx) * 2 + dir) * 6 + h; v[st] = ST[o * 4096 + e]; d[st] = DEC[o]; }
    float H = 0.f;
#pragma unroll
    for (int st = 0; st < 34; ++st) { const int cidx = dir == 0 ? st : (st < 2 ? 1 - st : 35 - st); const size_t o = (((size_t)b * 34 + cidx) * 2 + dir) * 6 + h; ST[o * 4096 + e] = H; H = H * d[st] + v[st]; }
  }
}

__device__ __forceinline__ void ssd3_item(int b, int cidx, int g, const bf16_t* XBC, const bf16_t* VZ, const float* DT, const float* cw, const float* cb, const float* dt_bias, const float* a_log,
                                          const float* dskip, const float* nw, const float* YIN, const float* ST, bf16_t* MIX, char* lds) {
  bf16_t (*Cm)[72] = (bf16_t (*)[72])lds; bf16_t (*Hm)[72] = (bf16_t (*)[72])(lds + 18432);
  float* ef = (float*)(lds + 18432 + 55296);
  float (*Yt)[196] = (float (*)[196])lds;
  const int tid = TIDX, lane = tid & 63, w = tid >> 6, l15 = lane & 15, l4 = lane >> 4, j0 = ssd_chunk_j0(cidx);
  const size_t r0 = (size_t)b * TPB + j0;
#pragma unroll
  for (int i = 0; i < 2; ++i) { const int task = tid + NT * i, t = task >> 3, q = task & 7, j = j0 + t;
    float o[8]; ssd_conv8(XBC, r0 + t, 512 + g * 64 + 8 * q, j != 0 && j != CTXL, j != CTXL - 1 && j != TPB - 1, cw, cb, o);
    *(u32x4*)&Cm[t][8 * q] = (u32x4){pk2bf(o[0], o[1]), pk2bf(o[2], o[3]), pk2bf(o[4], o[5]), pk2bf(o[6], o[7])}; }
#pragma unroll
  for (int i = 0; i < 12; ++i) { const int f4 = tid + NT * i, hd = f4 >> 10, rem = f4 & 1023, p = rem >> 4, n4 = (rem & 15) * 4, hh = hd >> 1, dir = hd & 1;
    const f32x4 v = *(const f32x4*)(ST + ((((size_t)b * 34 + cidx) * 2 + dir) * 6 + 3 * g + hh) * 4096 + p * 64 + n4);
    *(u32x2*)&Hm[hd * 64 + p][n4] = (u32x2){pk2bf(v.x, v.y), pk2bf(v.z, v.w)}; }
  if (w < 6) { const int hh = w >> 1, dir = w & 1, h = 3 * g + hh; const float a = -expf(a_log[dir * 6 + h]), bias = dt_bias[dir * 6 + h];
    const int t0 = dir == 0 ? 2 * lane : 127 - 2 * lane, t1 = dir == 0 ? 2 * lane + 1 : 126 - 2 * lane;
    const float d0 = softplusf(DT[(r0 + t0) * 12 + dir * 6 + h] + bias), d1 = softplusf(DT[(r0 + t1) * 12 + dir * 6 + h] + bias);
    float c0, c1; wave_scan128(d0 * a, d1 * a, lane, c0, c1);
    ef[w * 128 + t0] = __expf(c0); ef[w * 128 + t1] = __expf(c1); }
  __syncthreads();
  float yv[3][4][4];
  {
    bf16x8 ca[2];
#pragma unroll
    for (int kk = 0; kk < 2; ++kk) ca[kk] = *(const bf16x8*)&Cm[16 * w + l15][32 * kk + 8 * l4];
#pragma unroll
    for (int hh = 0; hh < 3; ++hh) {
      f32x4 accF[4], accB[4];
#pragma unroll
      for (int ni = 0; ni < 4; ++ni) { accF[ni] = (f32x4){0.f, 0.f, 0.f, 0.f}; accB[ni] = (f32x4){0.f, 0.f, 0.f, 0.f}; }
#pragma unroll
      for (int kk = 0; kk < 2; ++kk)
#pragma unroll
        for (int ni = 0; ni < 4; ++ni) {
          accF[ni] = __builtin_amdgcn_mfma_f32_16x16x32_bf16(ca[kk], *(const bf16x8*)&Hm[(hh * 2 + 0) * 64 + 16 * ni + l15][32 * kk + 8 * l4], accF[ni], 0, 0, 0);
          accB[ni] = __builtin_amdgcn_mfma_f32_16x16x32_bf16(ca[kk], *(const bf16x8*)&Hm[(hh * 2 + 1) * 64 + 16 * ni + l15][32 * kk + 8 * l4], accB[ni], 0, 0, 0); }
#pragma unroll
      for (int rg = 0; rg < 4; ++rg) { const int t = 16 * w + 4 * l4 + rg; const float eF = ef[(hh * 2 + 0) * 128 + t], eB = ef[(hh * 2 + 1) * 128 + t];
#pragma unroll
        for (int ni = 0; ni < 4; ++ni) yv[hh][ni][rg] = eF * accF[ni][rg] + eB * accB[ni][rg]; }
    }
  }
  __syncthreads();
#pragma unroll
  for (int hh = 0; hh < 3; ++hh)
#pragma unroll
    for (int rg = 0; rg < 4; ++rg)
#pragma unroll
      for (int ni = 0; ni < 4; ++ni) Yt[16 * w + 4 * l4 + rg][hh * 64 + 16 * ni + l15] = yv[hh][ni][rg];
  __syncthreads();
  {
    const int c4 = 4 * (lane < 48 ? lane : 47), hk = c4 >> 6; const bool lact = lane < 48;
    float cw0[4], cw1[4], cw2[4], cbv[4], nwv[4];
#pragma unroll
    for (int e = 0; e < 4; ++e) { const int col = g * 192 + c4 + e; cw0[e] = cw[col]; cw1[e] = cw[640 + col]; cw2[e] = cw[1280 + col]; cbv[e] = cb[col]; nwv[e] = nw[col]; }
    const float dsk = dskip[3 * g + hk];
#pragma unroll 1
    for (int rb = 0; rb < 16; rb += 4) {
      u32x2 xc_[4], xp_[4], xn_[4], zz_[4]; f32x4 yy_[4];
#pragma unroll
      for (int u = 0; u < 4; ++u) { const int t = 16 * w + rb + u, j = j0 + t; const size_t r = r0 + t; const bool hasp = j != 0 && j != CTXL, hasn = j != CTXL - 1 && j != TPB - 1;
        const bf16_t* xq = XBC + r * 768 + g * 192 + c4;
        xc_[u] = *(const u32x2*)xq; xp_[u] = *(const u32x2*)(xq + (hasp ? -768 : 0)); xn_[u] = *(const u32x2*)(xq + (hasn ? 768 : 0));
        yy_[u] = *(const f32x4*)(YIN + r * 384 + g * 192 + c4); zz_[u] = *(const u32x2*)(VZ + r * 512 + 128 + g * 192 + c4); }
#pragma unroll
      for (int u = 0; u < 4; ++u) { const int t = 16 * w + rb + u, j = j0 + t; const size_t r = r0 + t; const float wp = (j != 0 && j != CTXL) ? 1.f : 0.f, wn = (j != CTXL - 1 && j != TPB - 1) ? 1.f : 0.f;
        const f32x4 yt = *(const f32x4*)&Yt[t][c4];
        float gt[4]; float ss = 0.f;
#pragma unroll
        for (int e = 0; e < 4; ++e) { const unsigned sh = (e & 1) * 16; const unsigned wc_ = e < 2 ? xc_[u].x : xc_[u].y, wq_ = e < 2 ? xp_[u].x : xp_[u].y, wn_ = e < 2 ? xn_[u].x : xn_[u].y, wz_ = e < 2 ? zz_[u].x : zz_[u].y;
          float xv = cw1[e] * bf2f((bf16_t)(wc_ >> sh)) + cbv[e] + wp * cw0[e] * bf2f((bf16_t)(wq_ >> sh)) + wn * cw2[e] * bf2f((bf16_t)(wn_ >> sh));
          xv = siluf(xv);
          const float y = yy_[u][e] + yt[e] + dsk * xv;
          gt[e] = lact ? y * siluf(bf2f((bf16_t)(wz_ >> sh))) : 0.f; ss += gt[e] * gt[e]; }
        const float rstd = rsqrtf(wave_sum(ss) * (1.0f / 192.0f) + EPS);
        if (lact) { u32x2 o; o.x = pk2bf(gt[0] * rstd * nwv[0], gt[1] * rstd * nwv[1]); o.y = pk2bf(gt[2] * rstd * nwv[2], gt[3] * rstd * nwv[3]);
          *(u32x2*)(MIX + r * DM + 384 + g * 192 + c4) = o; } }
    }
  }
  __syncthreads();
}

__device__ __forceinline__ void st_router(const float* xl, const float* xc, float* xl_dst, float* xc_dst, const bf16_t* MO, const float* g, const float* modv_layer, const float* w_router, const float* rbias,
                                          bf16_t* H2, int* ctl, int* tok_pair, float* tok_w, int skip_ctx, char* lds) {
  float* wl = (float*)lds;
  const int tid = TIDX, lane = tid & 63, gw = BIDX * 8 + (tid >> 6), ngw = GDIM * 8;
  int* hist = (int*)(lds + 81920);
  if (tid < 32) hist[tid] = 0;
  float* mA = (float*)(lds + 82176); float* mB = mA + 5 * 1024; float* mG = mB + 5 * 1024;
  for (int idx = tid; idx < 5 * 1024; idx += NT) { const int m = idx >> 10, k = idx & 1023; mA[idx] = g[k] * (1.f + modv_layer[(size_t)m * 6144 + 4096 + k]); mB[idx] = modv_layer[(size_t)m * 6144 + 3072 + k]; mG[idx] = modv_layer[(size_t)m * 6144 + 2048 + k]; }
  for (int idx = tid; idx < 4096; idx += NT) { const int k = idx >> 2, e4 = idx & 3, row = ((k & 3) * 4 + (k >> 8)) * 64 + ((k & 255) >> 2);
    *(f32x4*)(wl + row * 20 + 4 * e4) = *(const f32x4*)(w_router + (size_t)k * 16 + 4 * e4); }
  __syncthreads();
  for (int rb = gw; rb < MTOK; rb += 2 * ngw) {
    int rr[2]; bool act[2]; f32x4 v[2][4]; u32x2 mo[2][4]; float rstd[2]; int mo_[2];
#pragma unroll
    for (int u = 0; u < 2; ++u) { const int r = rb + u * ngw; rr[u] = r < MTOK ? r : MTOK - 1; act[u] = r < MTOK && !(skip_ctx && (rr[u] % TPB) < CTXL); mo_[u] = mrow_of(rr[u]) * 1024;
      const float* xr = xrow(xl, xc, rr[u]); const bf16_t* mr = MO + (size_t)rr[u] * DM;
#pragma unroll
      for (int j = 0; j < 4; ++j) { v[u][j] = *(const f32x4*)(xr + 4 * lane + 256 * j); mo[u][j] = *(const u32x2*)(mr + 4 * lane + 256 * j); } }
    if (!act[0] && !act[1]) continue;
#pragma unroll
    for (int u = 0; u < 2; ++u) if (act[u]) { float* xd = xrow(xl_dst, xc_dst, rr[u]);
#pragma unroll
      for (int j = 0; j < 4; ++j) { const int k = 4 * lane + 256 * j; const f32x4 g4 = *(const f32x4*)(mG + mo_[u] + k);
        const f32x4 m4 = (f32x4){__uint_as_float(mo[u][j].x << 16), __uint_as_float(mo[u][j].x & 0xffff0000u), __uint_as_float(mo[u][j].y << 16), __uint_as_float(mo[u][j].y & 0xffff0000u)};
        v[u][j] = v[u][j] + g4 * m4; *(f32x4*)(xd + k) = v[u][j]; } }
#pragma unroll
    for (int u = 0; u < 2; ++u) { float ss = 0.f;
#pragma unroll
      for (int j = 0; j < 4; ++j) ss += v[u][j].x * v[u][j].x + v[u][j].y * v[u][j].y + v[u][j].z * v[u][j].z + v[u][j].w * v[u][j].w;
      rstd[u] = rsqrtf(wave_sum(ss) * (1.0f / DM) + EPS); }
    float lg[2][16];
#pragma unroll
    for (int u = 0; u < 2; ++u)
#pragma unroll
      for (int e = 0; e < 16; ++e) lg[u][e] = 0.f;
#pragma unroll 1
    for (int j = 0; j < 4; ++j) { const int k = 4 * lane + 256 * j; float o[2][4];
#pragma unroll
      for (int u = 0; u < 2; ++u) { const f32x4 a4 = *(const f32x4*)(mA + mo_[u] + k), b4 = *(const f32x4*)(mB + mo_[u] + k); const f32x4 o4 = v[u][j] * rstd[u] * a4 + b4;
        o[u][0] = o4.x; o[u][1] = o4.y; o[u][2] = o4.z; o[u][3] = o4.w;
        if (act[u]) { u32x2 wpk; wpk.x = pk2bf(o4.x, o4.y); wpk.y = pk2bf(o4.z, o4.w); *(u32x2*)(H2 + (size_t)rr[u] * DM + k) = wpk; } }
#pragma unroll
      for (int q = 0; q < 4; ++q) { const float* wr_ = wl + ((q * 4 + j) * 64 + lane) * 20;
#pragma unroll
        for (int e4 = 0; e4 < 4; ++e4) { const f32x4 wr = *(const f32x4*)(wr_ + 4 * e4);
#pragma unroll
          for (int u = 0; u < 2; ++u) { lg[u][4 * e4] += o[u][q] * wr.x; lg[u][4 * e4 + 1] += o[u][q] * wr.y; lg[u][4 * e4 + 2] += o[u][q] * wr.z; lg[u][4 * e4 + 3] += o[u][q] * wr.w; } } } }
    float h1[2];
#pragma unroll
    for (int u = 0; u < 2; ++u) { float h8[8], h4[4], h2[2];
#pragma unroll
      for (int i = 0; i < 8; ++i) { const bool up = (lane & 32) != 0; const float keep = up ? lg[u][8 + i] : lg[u][i], give = up ? lg[u][i] : lg[u][8 + i]; h8[i] = keep + __shfl_xor(give, 32); }
#pragma unroll
      for (int i = 0; i < 4; ++i) { const bool up = (lane & 16) != 0; const float keep = up ? h8[4 + i] : h8[i], give = up ? h8[i] : h8[4 + i]; h4[i] = keep + __shfl_xor(give, 16); }
#pragma unroll
      for (int i = 0; i < 2; ++i) { const bool up = (lane & 8) != 0; const float keep = up ? h4[2 + i] : h4[i], give = up ? h4[i] : h4[2 + i]; h2[i] = keep + __shfl_xor(give, 8); }
      { const bool up = (lane & 4) != 0; const float keep = up ? h2[1] : h2[0], give = up ? h2[0] : h2[1]; h1[u] = keep + __shfl_xor(give, 4); }
      h1[u] += __shfl_xor(h1[u], 2); h1[u] += __shfl_xor(h1[u], 1); }
    float lx[16];
#pragma unroll
    for (int e = 0; e < 16; ++e) { const int src = ((e >> 3) & 1) * 32 + ((e >> 2) & 1) * 16 + ((e >> 1) & 1) * 8 + (e & 1) * 4;
      const float a0 = __uint_as_float(__builtin_amdgcn_readlane(__float_as_uint(h1[0]), src)), a1 = __uint_as_float(__builtin_amdgcn_readlane(__float_as_uint(h1[1]), src));
      lx[e] = lane < 32 ? a0 : a1; }
    const int us = lane >> 5;
    if ((lane & 31) == 0 && (us == 0 ? act[0] : act[1])) {
      const int r = us == 0 ? rr[0] : rr[1];
      int best = 0, bi1 = 0, bi2 = 1; float bestv = -1e30f, bs1 = 0.f, bs2 = 0.f;
#pragma unroll
      for (int gq = 0; gq < 4; ++gq) { float m1 = -1e30f, m2 = -1e30f, s1 = 0.f, s2 = 0.f; int i1 = 0, i2 = 0;
#pragma unroll
        for (int i = 0; i < 4; ++i) { const float scv = 1.0f / (1.0f + __expf(-lx[4 * gq + i])); const float sv = scv + rbias[4 * gq + i];
          if (sv > m1) { m2 = m1; s2 = s1; i2 = i1; m1 = sv; s1 = scv; i1 = i; } else if (sv > m2) { m2 = sv; s2 = scv; i2 = i; } }
        if (m1 + m2 > bestv) { bestv = m1 + m2; best = gq; bi1 = i1; bi2 = i2; bs1 = s1; bs2 = s2; } }
      const int ia = bi1 < bi2 ? bi1 : bi2, ib = bi1 < bi2 ? bi2 : bi1;
      const int tri = ia == 0 ? ib - 1 : (ia == 1 ? ib + 1 : 5);
      const int pidx = best * 6 + tri;
      const float sa = bi1 < bi2 ? bs1 : bs2, sb = bi1 < bi2 ? bs2 : bs1, inv = 1.0f / (sa + sb);
      const int rank = atomicAdd(&hist[pidx], 1);
      tok_pair[r] = pidx | (rank << 5); tok_w[2 * r] = sa * inv; tok_w[2 * r + 1] = sb * inv;
    }
  }
  __syncthreads();
  if (tid < 32) ctl[CT_CNTB + BIDX * 32 + tid] = tid < 24 ? hist[tid] : 0;
}
__device__ __forceinline__ void st_moe_gather(const bf16_t* H2, bf16_t* H2S, int* ctl, const int* tok_pair, const float* tok_w, int* sorted_tok, float* sorted_w, int* tok_slot, int skip_ctx, char* lds) {
  int* sbase = (int*)lds; int* rtot = sbase + 32; int* rpre = rtot + 512;
  const int tid = TIDX, bid = BIDX;
  { const int p = tid & 31, seg = tid >> 5; int tot = 0, pre = 0;
#pragma unroll 4
    for (int i = 0; i < 16; ++i) { const int bb = seg * 16 + i; const int cv = ctl[CT_CNTB + bb * 32 + p]; tot += cv; pre += bb < bid ? cv : 0; }
    rtot[seg * 32 + p] = tot; rpre[seg * 32 + p] = pre; }
  __syncthreads();
  if (tid < 32) { int tot = 0, pre = 0;
#pragma unroll
    for (int sg = 0; sg < 16; ++sg) { tot += rtot[sg * 32 + tid]; pre += rpre[sg * 32 + tid]; }
    rtot[tid] = tot; rpre[tid] = pre; }
  __syncthreads();
  if (tid == 0) { int base = 0, nt = 0;
#pragma unroll 1
    for (int p = 0; p < 24; ++p) { sbase[p] = base + rpre[p]; const int n = rtot[p], tl = (n + 255) >> 8;
      if (bid == 0) { ctl[CT_BASE + p] = base; for (int t = 0; t < tl; ++t) ctl[CT_TP + nt + t] = p; }
      nt += tl; base += tl * 256; }
    if (bid == 0) { ctl[CT_BASE + 24] = base; ctl[CT_NT] = nt; } }
  __syncthreads();
  const int lane = tid & 63, gw = bid * 8 + (tid >> 6), ngw = GDIM * 8;
  for (int rb = gw; rb < MTOK; rb += 3 * ngw) {
    u32x4 a0[3], a1[3]; int pk[3]; float w0[3], w1[3]; bool act[3];
#pragma unroll
    for (int u = 0; u < 3; ++u) { const int r = rb + u * ngw; act[u] = r < MTOK && !(skip_ctx && (r % TPB) < CTXL); const int rc = act[u] ? r : 0;
      pk[u] = tok_pair[rc]; w0[u] = tok_w[2 * rc]; w1[u] = tok_w[2 * rc + 1];
      const u32x4* sp = (const u32x4*)(H2 + (size_t)rc * DM); a0[u] = sp[lane]; a1[u] = sp[lane + 64]; }
#pragma unroll
    for (int u = 0; u < 3; ++u) if (act[u]) { const int r = rb + u * ngw; const int slot = sbase[pk[u] & 31] + (pk[u] >> 5);
      if (lane == 0) { sorted_tok[slot] = r; tok_slot[r] = slot; sorted_w[2 * slot] = w0[u]; sorted_w[2 * slot + 1] = w1[u]; }
      u32x4* d = (u32x4*)(H2S + (size_t)slot * DM); d[lane] = a0[u]; d[lane + 64] = a1[u]; }
  }
  __syncthreads();
}
__device__ __forceinline__ void st_final(float* xl, const float* g, const bf16_t* YS, const int* tok_slot, const float* gate  ) {
  const int lane = TIDX & 63, gw = BIDX * 8 + (TIDX >> 6), ngw = GDIM * 8;
  f32x4 gg[4];
#pragma unroll
  for (int j = 0; j < 4; ++j) gg[j] = *(const f32x4*)(g + 4 * lane + 256 * j);
  for (int rb = gw; rb < NB * SEQ; rb += 4 * ngw) {
    f32x4 v[4][4]; u32x2 ys[4][4];
#pragma unroll
    for (int u = 0; u < 4; ++u) { const int r = rb + u * ngw, rc = r < NB * SEQ ? r : NB * SEQ - 1; const float* xr = xl + (size_t)rc * DM;
      const int bb = rc >> 12, tr = bb * TPB + CTXL + (rc & 4095); const bf16_t* yr = YS + (size_t)tok_slot[tr] * DM;
#pragma unroll
      for (int j = 0; j < 4; ++j) { v[u][j] = *(const f32x4*)(xr + 4 * lane + 256 * j); ys[u][j] = *(const u32x2*)(yr + 4 * lane + 256 * j); } }
#pragma unroll
    for (int u = 0; u < 4; ++u) { const int r = rb + u * ngw, rc = r < NB * SEQ ? r : NB * SEQ - 1; const float* gt = gate + (size_t)(rc >> 12) * 6144; float ss = 0.f;
#pragma unroll
      for (int j = 0; j < 4; ++j) { const f32x4 g4 = *(const f32x4*)(gt + 4 * lane + 256 * j);
        const f32x4 m4 = (f32x4){__uint_as_float(ys[u][j].x << 16), __uint_as_float(ys[u][j].x & 0xffff0000u), __uint_as_float(ys[u][j].y << 16), __uint_as_float(ys[u][j].y & 0xffff0000u)};
        v[u][j] = v[u][j] + g4 * m4; ss += v[u][j].x * v[u][j].x + v[u][j].y * v[u][j].y + v[u][j].z * v[u][j].z + v[u][j].w * v[u][j].w; }
      const float rstd = rsqrtf(wave_sum(ss) * (1.0f / DM) + EPS);
      if (r < NB * SEQ) { float* xr = xl + (size_t)r * DM;
#pragma unroll
        for (int j = 0; j < 4; ++j) *(f32x4*)(xr + 4 * lane + 256 * j) = (f32x4){v[u][j].x * rstd * gg[j].x, v[u][j].y * rstd * gg[j].y, v[u][j].z * rstd * gg[j].z, v[u][j].w * rstd * gg[j].w}; } }
  }
}

namespace pg8 {
#define PG8_LAS __attribute__((address_space(3)))
typedef unsigned short bf16_t;
typedef short bf16x8 __attribute__((ext_vector_type(8)));
typedef float f32x4 __attribute__((ext_vector_type(4)));
typedef unsigned u32x4 __attribute__((ext_vector_type(4)));
constexpr int BM = 256, BK = 64, HALF = 128, HTB = HALF * BK * 2  , STAGE_BYTES = 8 * HTB, NXCD = 8, WGM = 8;

__host__ __device__ __forceinline__ int lds_byte(int r, int c) { const int st = (r >> 4) * 2 + (c >> 5), rr = r & 15, cc = c & 31, ob = rr * 64 + cc * 2; return st * 1024 + (ob ^ (((ob >> 9) & 1) << 5)); }
__host__ __device__ __forceinline__ void stage_rc(int b, int& R, int& C) { const int st = b / 1024, sb = b % 1024, swz = sb ^ (((sb >> 9) & 1) << 5); R = (st >> 1) * 16 + swz / 64; C = (st & 1) * 32 + (swz % 64) / 2; }
__host__ __device__ __forceinline__ int perm32(int rho) { const int n = rho >> 4, i = rho & 15; return 8 * (i >> 2) + 4 * n + (i & 3); }

struct Unit { int pm, pn, fin; const char* A; const char* B; };
struct Gemm { int K, lda, ldb; };

__device__ __forceinline__ void tile_of(int L, int nM, int nN, int& pm, int& pn) {
    const int nwg = nM * nN; int wgid = L; { const int q = nwg / NXCD, r = nwg % NXCD, xcd = wgid % NXCD, off = wgid / NXCD; wgid = (xcd < r ? xcd * (q + 1) : r * (q + 1) + (xcd - r) * q) + off; }
    const int nig = WGM * nN, gid = wgid / nig, fm = gid * WGM, gsz = (nM - fm) < WGM ? (nM - fm) : WGM;
    pm = fm + ((wgid % nig) % gsz); pn = (wgid % nig) / gsz;
}
__device__ __forceinline__ unsigned cvt_pk_bf16(float lo, float hi) { unsigned r; asm volatile("v_cvt_pk_bf16_f32 %0, %1, %2" : "=v"(r) : "v"(lo), "v"(hi)); return r; }
template <class Epi, class Sched, bool ALIGN_EPI = false, bool SP2 = false>
__device__ __forceinline__ void gemm_phase(PG8_LAS unsigned char* lds, const Gemm g, const Sched& S, const Epi& E) {
    const int tid = opq_v((int)threadIdx.x), wid = __builtin_amdgcn_readfirstlane(tid >> 6), lane = tid & 63, wr = wid >> 2, wc = wid & 3, fr = lane & 15, fq = lane >> 4;
    const int K = g.K, nt = K / BK;
    unsigned voffA[2], voffB[2];
#pragma unroll
    for (int i = 0; i < 2; ++i) { int R, C; stage_rc(tid * 16 + i * 8192, R, C); const int Rb = Epi::PERM ? ((R & ~31) + perm32(R & 31)) : R;
        voffA[i] = (unsigned)(R * g.lda + C) * 2u; voffB[i] = (unsigned)(Rb * g.ldb + C) * 2u; }
    const size_t kstep = (size_t)(BK * 2);
    const size_t hstepA = (size_t)HALF * g.lda * 2, hstepB = (size_t)HALF * g.ldb * 2;
    const unsigned ldsw = (unsigned)wid * 1024u;
    const int aoff = lds_byte(wr * 64 + fr, fq * 8), boff = lds_byte(wc * 32 + fr, fq * 8);
#define PG8_SA(b, h) (((b) * 2 + (h)) * HTB)
#define PG8_SB(b, h) ((4 + (b) * 2 + (h)) * HTB)
#define PG8_STAGE(bufoff, gbase, voff) do { _Pragma("unroll") for (int _i = 0; _i < 2; ++_i) \
        __builtin_amdgcn_global_load_lds((const unsigned*)((const char*)(gbase) + (voff)[_i]), (PG8_LAS unsigned*)(lds + (bufoff) + ldsw + _i * 8192), 16, 0, 0); } while (0)
#define PG8_LDA(dst, b, h) do { _Pragma("unroll") for (int m = 0; m < 4; ++m) _Pragma("unroll") for (int k = 0; k < 2; ++k) dst[m][k] = *(const PG8_LAS bf16x8*)(lds + PG8_SA(b, h) + aoff + m * 2048 + k * 1024); } while (0)
#define PG8_LDB(dst, b, h) do { _Pragma("unroll") for (int n = 0; n < 2; ++n) _Pragma("unroll") for (int k = 0; k < 2; ++k) dst[n][k] = *(const PG8_LAS bf16x8*)(lds + PG8_SB(b, h) + boff + n * 2048 + k * 1024); } while (0)
#define PG8_MMA(ai, bj, At, Bt) do { __builtin_amdgcn_s_setprio(1); _Pragma("unroll") for (int m = 0; m < 4; ++m) _Pragma("unroll") for (int n = 0; n < 2; ++n) _Pragma("unroll") for (int k = 0; k < 2; ++k) \
        acc[ai][bj][m][n] = __builtin_amdgcn_mfma_f32_16x16x32_bf16(Bt[n][k], At[m][k], acc[ai][bj][m][n], 0, 0, 0); __builtin_amdgcn_s_setprio(0); } while (0)
#define PG8_WAIT_V(n) asm volatile("s_waitcnt vmcnt(" #n ")" ::: "memory")
#define PG8_WAIT_L(n) asm volatile("s_waitcnt lgkmcnt(" #n ")" ::: "memory")
#define PG8_BAR __builtin_amdgcn_s_barrier()
#define PG8_SCHED __builtin_amdgcn_sched_barrier(0)
    Unit cur, nxt; int ui = 0;
    if (!S.next(0, cur)) return;
    f32x4 acc[2][2][4][2];
#pragma unroll
    for (int a = 0; a < 2; ++a)
#pragma unroll
        for (int b = 0; b < 2; ++b)
#pragma unroll
            for (int m = 0; m < 4; ++m)
#pragma unroll
                for (int n = 0; n < 2; ++n) acc[a][b][m][n] = (f32x4){0.f, 0.f, 0.f, 0.f};
    bf16x8 At[4][2], B0[2][2], B1[2][2];
    const char* cA = cur.A; const char* cB = cur.B;
    S.a_ready(cur);
    if constexpr (SP2) {
        PG8_STAGE(PG8_SB(0, 0), cB, voffB); PG8_STAGE(PG8_SB(0, 1), cB + hstepB, voffB); PG8_STAGE(PG8_SA(0, 0), cA, voffA); PG8_STAGE(PG8_SA(0, 1), cA + hstepA, voffA);
        if (wr == 1) PG8_BAR;
        PG8_WAIT_V(2); PG8_BAR;
        PG8_STAGE(PG8_SB(1, 0), cB + kstep, voffB); PG8_STAGE(PG8_SA(1, 0), cA + kstep, voffA); PG8_STAGE(PG8_SB(1, 1), cB + hstepB + kstep, voffB);
        PG8_WAIT_V(6); PG8_BAR;
    } else {
        PG8_STAGE(PG8_SB(0, 0), cB, voffB); PG8_STAGE(PG8_SA(0, 0), cA, voffA); PG8_STAGE(PG8_SB(0, 1), cB + hstepB, voffB); PG8_STAGE(PG8_SA(0, 1), cA + hstepA, voffA);
        if (wr == 1) PG8_BAR;
        PG8_WAIT_V(4); PG8_BAR;
        PG8_STAGE(PG8_SB(1, 0), cB + kstep, voffB); PG8_STAGE(PG8_SA(1, 0), cA + kstep, voffA); PG8_STAGE(PG8_SB(1, 1), cB + hstepB + kstep, voffB);
        PG8_WAIT_V(6); PG8_BAR;
    }
    for (;;) {
        const bool has_next = S.next(ui + 1, nxt);
        const char* nA = has_next ? nxt.A : cA; const char* nB = has_next ? nxt.B : cB;
        for (int t = 0; t < nt; t += 2) {
            const bool last = (t == nt - 2);
            const char* a1 = cA + (size_t)(t + 1) * kstep;
            const char* a2 = last ? nA : cA + (size_t)(t + 2) * kstep; const char* b2 = last ? nB : cB + (size_t)(t + 2) * kstep;
            const char* a3 = a2 + kstep; const char* b3 = b2 + kstep;
            if (last && has_next) S.a_ready(nxt);
            if constexpr (SP2) {
            PG8_LDB(B0, 0, 0); PG8_LDB(B1, 0, 1); PG8_SCHED; PG8_LDA(At, 0, 0); PG8_STAGE(PG8_SA(1, 1), a1 + hstepA, voffA);
            PG8_WAIT_V(8); PG8_WAIT_L(0); PG8_BAR; PG8_MMA(0, 0, At, B0); PG8_MMA(0, 1, At, B1); PG8_BAR; PG8_SCHED;
            PG8_LDA(At, 0, 1); PG8_STAGE(PG8_SB(0, 0), b2, voffB); PG8_STAGE(PG8_SB(0, 1), b2 + hstepB, voffB); PG8_STAGE(PG8_SA(0, 0), a2, voffA);
            PG8_WAIT_V(8); PG8_WAIT_L(0); PG8_BAR; PG8_MMA(1, 0, At, B0); PG8_MMA(1, 1, At, B1); PG8_BAR; PG8_SCHED;
            PG8_LDB(B0, 1, 0); PG8_LDB(B1, 1, 1); PG8_SCHED; PG8_LDA(At, 1, 0); PG8_STAGE(PG8_SA(0, 1), a2 + hstepA, voffA);
            PG8_WAIT_V(8); PG8_WAIT_L(0); PG8_BAR; PG8_MMA(0, 0, At, B0); PG8_MMA(0, 1, At, B1); PG8_BAR; PG8_SCHED;
            PG8_LDA(At, 1, 1); PG8_STAGE(PG8_SB(1, 0), b3, voffB); PG8_STAGE(PG8_SB(1, 1), b3 + hstepB, voffB); PG8_STAGE(PG8_SA(1, 0), a3, voffA);
            PG8_WAIT_V(8); PG8_WAIT_L(0); PG8_BAR; PG8_MMA(1, 0, At, B0); PG8_MMA(1, 1, At, B1); PG8_BAR; PG8_SCHED;
            } else {
            PG8_LDB(B0, 0, 0); PG8_SCHED; PG8_LDA(At, 0, 0); PG8_STAGE(PG8_SA(1, 1), a1 + hstepA, voffA);
            PG8_WAIT_L(8); PG8_BAR; PG8_WAIT_L(0); PG8_MMA(0, 0, At, B0); PG8_BAR; PG8_SCHED;
            PG8_LDB(B1, 0, 1); PG8_STAGE(PG8_SB(0, 0), b2, voffB);
            PG8_BAR; PG8_WAIT_L(0); PG8_MMA(0, 1, At, B1); PG8_BAR;
            PG8_LDA(At, 0, 1); PG8_STAGE(PG8_SA(0, 0), a2, voffA);
            PG8_BAR; PG8_WAIT_L(0); PG8_MMA(1, 0, At, B0); PG8_BAR; PG8_SCHED;
            PG8_STAGE(PG8_SB(0, 1), b2 + hstepB, voffB);
            PG8_WAIT_V(6); PG8_BAR; PG8_MMA(1, 1, At, B1); PG8_BAR;
            PG8_LDB(B0, 1, 0); PG8_SCHED; PG8_LDA(At, 1, 0); PG8_STAGE(PG8_SA(0, 1), a2 + hstepA, voffA);
            PG8_WAIT_L(8); PG8_BAR; PG8_WAIT_L(0); PG8_MMA(0, 0, At, B0); PG8_BAR; PG8_SCHED;
            PG8_LDB(B1, 1, 1); PG8_STAGE(PG8_SB(1, 0), b3, voffB);
            PG8_BAR; PG8_WAIT_L(0); PG8_MMA(0, 1, At, B1); PG8_BAR;
            PG8_LDA(At, 1, 1); PG8_STAGE(PG8_SA(1, 0), a3, voffA);
            PG8_BAR; PG8_WAIT_L(0); PG8_MMA(1, 0, At, B0); PG8_BAR; PG8_SCHED;
            PG8_STAGE(PG8_SB(1, 1), b3 + hstepB, voffB);
            PG8_WAIT_V(6); PG8_BAR; PG8_MMA(1, 1, At, B1); PG8_BAR;
            }
        }
        if constexpr (ALIGN_EPI) { if (wr == 0) PG8_BAR; }
        if constexpr (!Epi::AFTER_DRAIN) { if (cur.fin) { E(acc, cur, wr, wc, fr, fq); S.done(cur); } }
        if (!has_next) break;
        if (cur.fin) {
#pragma unroll
        for (int a = 0; a < 2; ++a)
#pragma unroll
            for (int b = 0; b < 2; ++b)
#pragma unroll
                for (int m = 0; m < 4; ++m)
#pragma unroll
                    for (int n = 0; n < 2; ++n) acc[a][b][m][n] = (f32x4){0.f, 0.f, 0.f, 0.f};
        }
        cur = nxt; cA = nA; cB = nB; ++ui;
        if constexpr (ALIGN_EPI) { if (wr == 1) PG8_BAR; }
    }
    PG8_WAIT_V(0);
    if constexpr (!ALIGN_EPI) { if (wr == 0) PG8_BAR; }
    PG8_BAR;
    if constexpr (Epi::AFTER_DRAIN) { E.fused(acc, cur, wr, wc, fr, fq, lds, wid, lane); S.done(cur); }
#undef PG8_SA
#undef PG8_SB
#undef PG8_STAGE
#undef PG8_LDA
#undef PG8_LDB
#undef PG8_MMA
#undef PG8_WAIT_V
#undef PG8_WAIT_L
#undef PG8_BAR
#undef PG8_SCHED
}
}

struct SchedDense {
  int nM, nN, G, c, skip_ctx; const char* A; const char* B; size_t a_tile, b_tile;
  __device__ __forceinline__ bool next(int i, pg8::Unit& u) const {
    const long L = (long)i * G + c; if (L >= (long)nM * nN) return false;
    int pm, pn; pg8::tile_of((int)L, nM, nN, pm, pn); if (skip_ctx) pm = pm + pm / 16 + 1;
    u.pm = pm; u.pn = pn; u.fin = 1; u.A = A + (size_t)pm * a_tile; u.B = B + (size_t)pn * b_tile; return true; }
  __device__ __forceinline__ void a_ready(const pg8::Unit&) const {}
  __device__ __forceinline__ void done(const pg8::Unit&) const {}
};
struct SchedMoe {
  int G, c, mode; const int* ctl; const char* A; size_t a_tile; const char* W;
  __device__ __forceinline__ bool next(int i, pg8::Unit& u) const {
    const int part = mode == 2 ? (i & 1) : 0, iu = mode == 2 ? (i >> 1) : i;
    const long L = (long)iu * G + c; const int ntiles = ctl[CT_NT]; if (L >= (long)ntiles * 4) return false;
    const int pm = (int)(L >> 2), pn = (int)(L & 3); int eA, eB; pair_experts(ctl[CT_TP + pm], eA, eB);
    u.pm = pm; u.pn = pn;
    if (mode == 1) { const int e = pn < 2 ? eA : eB; u.fin = 1; u.A = A + (size_t)pm * a_tile; u.B = W + (size_t)e * (512 * 1024 * 2) + (size_t)(pn & 1) * (256 * 1024 * 2); }
    else { u.fin = part; u.A = A + (size_t)pm * a_tile + part * 512; u.B = W + (size_t)(part ? eB : eA) * (1024 * 256 * 2) + (size_t)pn * (256 * 256 * 2); }
    return true; }
  __device__ __forceinline__ void a_ready(const pg8::Unit&) const {}
  __device__ __forceinline__ void done(const pg8::Unit&) const {}
};
__device__ __forceinline__ unsigned cvt_pk(float lo, float hi) { return pg8::cvt_pk_bf16(lo, hi); }
struct EpiInProj {
  static constexpr bool PERM = true, AFTER_DRAIN = false; bf16_t *QK, *VZ, *XBC, *HY; float* DT;
  __device__ __forceinline__ void operator()(const f32x4 (&acc)[2][2][4][2], const pg8::Unit& u, int wr, int wc, int fr, int fq) const {
    const int pn = u.pn; bf16_t* base; int ldc, coff;
    if (pn < 2) { base = QK; ldc = 512; coff = pn * 256; } else if (pn < 4) { base = VZ; ldc = 512; coff = (pn - 2) * 256; }
    else if (pn < 7) { base = XBC; ldc = 768; coff = (pn - 4) * 256; } else { base = HY; ldc = 768; coff = (pn - 7) * 256; }
    const int row0 = u.pm * 256 + wr * 64 + fr, col0 = coff + wc * 32 + 8 * fq; const bool dtl = (pn == 6 && wc == 0 && fq < 2);
#pragma unroll
    for (int ai = 0; ai < 2; ++ai)
#pragma unroll
      for (int m = 0; m < 4; ++m) { const int row = row0 + ai * 128 + m * 16; bf16_t* rowp = base + (size_t)row * ldc + col0;
#pragma unroll
        for (int bj = 0; bj < 2; ++bj) { const f32x4 v0 = acc[ai][bj][m][0], v1 = acc[ai][bj][m][1];
          u32x4 w; w.x = cvt_pk(v0[0], v0[1]); w.y = cvt_pk(v0[2], v0[3]); w.z = cvt_pk(v1[0], v1[1]); w.w = cvt_pk(v1[2], v1[3]);
          *(u32x4*)(rowp + bj * 128) = w;
          if (bj == 1 && dtl) { float* dp = DT + (size_t)row * 12 + 8 * fq; *(f32x4*)dp = v0; if (fq == 0) *(f32x4*)(dp + 4) = v1; } } }
  }
};
struct EpiOutProj {
  static constexpr bool PERM = true, AFTER_DRAIN = false; bf16_t* MO;
  __device__ __forceinline__ void operator()(const f32x4 (&acc)[2][2][4][2], const pg8::Unit& u, int wr, int wc, int fr, int fq) const {
    const int row0 = u.pm * 256 + wr * 64 + fr, col0 = u.pn * 256 + wc * 32 + 8 * fq;
#pragma unroll
    for (int ai = 0; ai < 2; ++ai)
#pragma unroll
      for (int m = 0; m < 4; ++m) { bf16_t* rowp = MO + (size_t)(row0 + ai * 128 + m * 16) * DM + col0;
#pragma unroll
        for (int bj = 0; bj < 2; ++bj) { const f32x4 v0 = acc[ai][bj][m][0], v1 = acc[ai][bj][m][1];
          u32x4 w; w.x = cvt_pk(v0[0], v0[1]); w.y = cvt_pk(v0[2], v0[3]); w.z = cvt_pk(v1[0], v1[1]); w.w = cvt_pk(v1[2], v1[3]);
          *(u32x4*)(rowp + bj * 128) = w; } }
  }
};
struct EpiMoe1 {
  static constexpr bool PERM = true, AFTER_DRAIN = false; bf16_t* ACT; const float* sorted_w;
  __device__ __forceinline__ void operator()(const f32x4 (&acc)[2][2][4][2], const pg8::Unit& u, int wr, int wc, int fr, int fq) const {
    const int half = u.pn >> 1, j0 = (u.pn & 1) * 128 + 16 * wc + 4 * fq;
#pragma unroll
    for (int ai = 0; ai < 2; ++ai)
#pragma unroll
      for (int m = 0; m < 4; ++m) { const int slot = u.pm * 256 + ai * 128 + wr * 64 + m * 16 + fr; const float wt = sorted_w[2 * slot + half];
#pragma unroll
        for (int bj = 0; bj < 2; ++bj) { const f32x4 v0 = acc[ai][bj][m][0], v1 = acc[ai][bj][m][1];
          u32x2 w; w.x = cvt_pk(siluf(v0[0]) * v0[1] * wt, siluf(v0[2]) * v0[3] * wt); w.y = cvt_pk(siluf(v1[0]) * v1[1] * wt, siluf(v1[2]) * v1[3] * wt);
          *(u32x2*)(ACT + (size_t)slot * 512 + half * 256 + j0 + 64 * bj) = w; } }
  }
};
struct EpiMoe2 {
  static constexpr bool PERM = true, AFTER_DRAIN = false; bf16_t* YS;
  __device__ __forceinline__ void operator()(const f32x4 (&acc)[2][2][4][2], const pg8::Unit& u, int wr, int wc, int fr, int fq) const {
    const int row0 = u.pm * 256 + wr * 64 + fr, col0 = u.pn * 256 + wc * 32 + 8 * fq;
#pragma unroll
    for (int ai = 0; ai < 2; ++ai)
#pragma unroll
      for (int m = 0; m < 4; ++m) { bf16_t* rowp = YS + (size_t)(row0 + ai * 128 + m * 16) * DM + col0;
#pragma unroll
        for (int bj = 0; bj < 2; ++bj) { const f32x4 v0 = acc[ai][bj][m][0], v1 = acc[ai][bj][m][1];
          u32x4 w; w.x = cvt_pk(v0[0], v0[1]); w.y = cvt_pk(v0[2], v0[3]); w.z = cvt_pk(v1[0], v1[1]); w.w = cvt_pk(v1[2], v1[3]);
          *(u32x4*)(rowp + bj * 128) = w; } }
  }
};

#include <hip/hip_bf16.h>
#include <cmath>
namespace attn_body {
using bf16=__hip_bfloat16;
using bf16x8=__attribute__((ext_vector_type(8)))short;
using s16x4=__attribute__((ext_vector_type(4)))short;
using f32x16=__attribute__((ext_vector_type(16)))float;
using u32x4=__attribute__((ext_vector_type(4)))unsigned;
constexpr int D=64,QP=512,KP=512,VP=512,OP=1024;
constexpr int NW=8,QBLK=32,QB=QBLK*NW,KVBLK=64;
constexpr int ATTN_UNIT_ROWS=QB;
__device__ __forceinline__ int crow(int r,int hi){return (r&3)+8*(r>>2)+4*hi;}
#define SBAR() __builtin_amdgcn_sched_barrier(0)
__device__ __forceinline__ void cmask(f32x16&p0,f32x16&p1,int jb,int qrel,int hi){
  const float NEG=-INFINITY; int kb=64*jb+4*hi;
  #pragma unroll
  for(int r=0;r<16;++r){int kv=kb+(r&3)+8*(r>>2); if(kv>qrel)p0[r]=NEG; if(kv+32>qrel)p1[r]=NEG;}
}

constexpr int NSLOT=3, SLOTB=8192;
constexpr int LDS_K=0, LDS_V=NSLOT*SLOTB, LDS_WS=2*NSLOT*SLOTB, LDS_OST=LDS_WS+NW*64*4, LDS_BYTES=LDS_OST+NW*4096;
constexpr float C2=0.125f*1.4426950408889634f;
__device__ __forceinline__ void glds16(const void*gsrc,unsigned lds_dst){unsigned keep;
  asm volatile("s_mov_b32 %0, m0\n\ts_mov_b32 m0, %2\n\ts_nop 0\n\tglobal_load_lds_dwordx4 %1, off\n\ts_mov_b32 m0, %0":"=&s"(keep):"v"(gsrc),"s"(lds_dst):"memory");}
__device__ __forceinline__ float max3f(float a,float b,float c){float r;asm("v_max3_f32 %0, %1, %2, %3":"=v"(r):"v"(a),"v"(b),"v"(c));return r;}
__device__ __forceinline__ float max2f(float a,float b){float r;asm("v_max_f32_e32 %0, %1, %2":"=v"(r):"v"(a),"v"(b));return r;}
__device__ __forceinline__ float fadd_s(float a,float b){float r;asm("v_add_f32_e32 %0, %1, %2":"=v"(r):"v"(a),"v"(b));return r;}
__device__ __forceinline__ float fsub_s(float a,float b){float r;asm("v_sub_f32_e32 %0, %1, %2":"=v"(r):"v"(a),"v"(b));return r;}
typedef float f32x2_t __attribute__((ext_vector_type(2))); typedef __bf16 bf16x2_t __attribute__((ext_vector_type(2)));
__device__ __forceinline__ unsigned cvtpk_s(float lo,float hi){f32x2_t v={lo,hi};bf16x2_t b=__builtin_convertvector(v,bf16x2_t);return __builtin_bit_cast(unsigned,b);}
#define WAIT_BAR(N) asm volatile("s_waitcnt vmcnt(" #N ") lgkmcnt(0)\n\ts_barrier":::"memory")

__device__ __forceinline__ void qkt(f32x16&p0,f32x16&p1,const char*Kslot,const bf16x8*qr,const f32x16&negm,int r32,int hi){
  const char*kb=Kslot+hi*1024+r32*16;
  #pragma unroll
  for(int d0=0;d0<4;++d0){
    const bf16x8 b0=*reinterpret_cast<const bf16x8*>(kb+d0*2048);
    const bf16x8 b1=*reinterpret_cast<const bf16x8*>(kb+d0*2048+512);
    if(d0==0){p0=__builtin_amdgcn_mfma_f32_32x32x16_bf16(b0,qr[0],negm,0,0,0);p1=__builtin_amdgcn_mfma_f32_32x32x16_bf16(b1,qr[0],negm,0,0,0);}
    else{p0=__builtin_amdgcn_mfma_f32_32x32x16_bf16(b0,qr[d0],p0,0,0,0);p1=__builtin_amdgcn_mfma_f32_32x32x16_bf16(b1,qr[d0],p1,0,0,0);}}
}
typedef __attribute__((address_space(3))) const char* lds_cptr;
typedef short v4i16_t __attribute__((ext_vector_type(4)));
__device__ __forceinline__ void kload8(bf16x8*kf,lds_cptr kp){
  kf[0]=*(const __attribute__((address_space(3))) bf16x8*)(kp);      kf[1]=*(const __attribute__((address_space(3))) bf16x8*)(kp+512);
  kf[2]=*(const __attribute__((address_space(3))) bf16x8*)(kp+2048); kf[3]=*(const __attribute__((address_space(3))) bf16x8*)(kp+2560);
  kf[4]=*(const __attribute__((address_space(3))) bf16x8*)(kp+4096); kf[5]=*(const __attribute__((address_space(3))) bf16x8*)(kp+4608);
  kf[6]=*(const __attribute__((address_space(3))) bf16x8*)(kp+6144); kf[7]=*(const __attribute__((address_space(3))) bf16x8*)(kp+6656);
}
__device__ __forceinline__ void kload2(bf16x8*kf,lds_cptr kp,int j){ kf[2*j]=*(const __attribute__((address_space(3))) bf16x8*)(kp+j*2048); kf[2*j+1]=*(const __attribute__((address_space(3))) bf16x8*)(kp+j*2048+512); }
__device__ __forceinline__ s16x4 vtr(lds_cptr p){ return __builtin_bit_cast(s16x4,__builtin_amdgcn_ds_read_tr16_b64_v4i16((__attribute__((address_space(3))) v4i16_t*)p)); }
__device__ __forceinline__ float rowmax(const f32x16&p0,const f32x16&p1){
  float a=max3f(p0[0],p0[1],p1[0]),b=max3f(p0[2],p0[3],p1[1]);a=max3f(a,p1[2],p1[3]);
  #pragma unroll
  for(int r=4;r<16;r+=4){a=max3f(a,p0[r],p0[r+1]);b=max3f(b,p0[r+2],p0[r+3]);a=max3f(a,p1[r],p1[r+1]);b=max3f(b,p1[r+2],p1[r+3]);}
  const float m=max2f(a,b);
  auto rr=__builtin_amdgcn_permlane32_swap(__float_as_uint(m),__float_as_uint(m),false,false);
  return max2f(__uint_as_float(rr[0]),__uint_as_float(rr[1]));
}
__device__ __forceinline__ void pv(f32x16*o,int vb,bf16x8 pa0,bf16x8 pa1,bf16x8 pa2,bf16x8 pa3){
  #pragma unroll
  for(int d0=0;d0<2;++d0){s16x4 lo[4],hi[4];
    #pragma unroll
    for(int ks=0;ks<4;++ks){
      asm volatile("ds_read_b64_tr_b16 %0,%1 offset:%c2":"=&v"(lo[ks]):"v"(vb),"i"(d0*4096+ks*1024):"memory");
      asm volatile("ds_read_b64_tr_b16 %0,%1 offset:%c2":"=&v"(hi[ks]):"v"(vb),"i"(d0*4096+ks*1024+512):"memory");}
    asm volatile("s_waitcnt lgkmcnt(0)":::"memory");SBAR();
    #define PK(k) (bf16x8){lo[k][0],lo[k][1],lo[k][2],lo[k][3],hi[k][0],hi[k][1],hi[k][2],hi[k][3]}
    o[d0]=__builtin_amdgcn_mfma_f32_32x32x16_bf16(pa0,PK(0),o[d0],0,0,0);
    o[d0]=__builtin_amdgcn_mfma_f32_32x32x16_bf16(pa1,PK(1),o[d0],0,0,0);
    o[d0]=__builtin_amdgcn_mfma_f32_32x32x16_bf16(pa2,PK(2),o[d0],0,0,0);
    o[d0]=__builtin_amdgcn_mfma_f32_32x32x16_bf16(pa3,PK(3),o[d0],0,0,0);
    #undef PK
  }
}

#ifndef ATTN_STORE16
#define ATTN_STORE16(p,v) (*(u32x4*)(p)=(v))
#endif
template<int THRL> __device__ __forceinline__ void attn_unit(const bf16*Qu,const bf16*__restrict__ Kh,const bf16*__restrict__ Vh,bf16*Ou,const int NT,char*shm){
  const int tid=opq_v((int)threadIdx.x),lane=tid&63,r32=lane&31,hi=lane>>5; const int wid=__builtin_amdgcn_readfirstlane(tid>>6);
  const bf16*Qw=Qu+(long)(wid*QBLK)*QP;
  const unsigned lds0=(unsigned)(uintptr_t)shm;
  float*wsf=(float*)(shm+LDS_WS)+wid*64;
  const bf16*ksrc=Kh+(long)lane*KP+wid*8;
  const bf16*vsrc=Vh+(long)(16*(wid&3)+(lane>>2))*VP+(wid>>2)*32+(lane&3)*8;
  const unsigned kdst=lds0+LDS_K+wid*1024, vdst=lds0+LDS_V+wid*1024;
  #define DMA_K(t,slot) glds16(ksrc+(long)(t)*KVBLK*KP,(unsigned)__builtin_amdgcn_readfirstlane(kdst+(slot)))
  #define DMA_V(t,slot) glds16(vsrc+(long)(t)*KVBLK*VP,(unsigned)__builtin_amdgcn_readfirstlane(vdst+(slot)))
  const int vb0=(int)(lds0+LDS_V)+((lane>>4)&1)*32+(lane&3)*8+(4*hi+((lane&15)>>2))*64;
  const char*Kbase=shm+LDS_K; bf16x8 kf[8];
  const lds_cptr shm3=(lds_cptr)shm; const lds_cptr kp0=shm3+LDS_K+hi*1024+r32*16; const lds_cptr vp0=shm3+LDS_V+((lane>>4)&1)*32+(lane&3)*8+(4*hi+((lane&15)>>2))*64;
  DMA_K(0,0);DMA_V(0,0);DMA_K(1,SLOTB);
  bf16x8 qr[4];
  #pragma unroll
  for(int d0=0;d0<4;++d0)qr[d0]=*reinterpret_cast<const bf16x8*>(&Qw[(long)r32*QP+d0*16+hi*8]);
  float mhat=0.f,l_reg=0.f;float z0_=0.f;asm volatile("":"+v"(z0_));f32x16 o[2];f32x16 negm;
  _Pragma("unroll") for(int r=0;r<16;++r){o[0][r]=z0_;o[1][r]=z0_;negm[r]=z0_;} asm volatile("":"+v"(negm));
  #define CMASK(P0,P1,t) do{}while(0)
  bool resc=false;
  #define START(P0,P1) do{ const float rm=rowmax(P0,P1); resc=false; \
    { const float dl=rm; mhat=fadd_s(mhat,dl); \
      _Pragma("unroll") for(int r=0;r<16;++r){P0[r]=fsub_s(P0[r],dl);P1[r]=fsub_s(P1[r],dl);} \
      _Pragma("unroll") for(int r=0;r<16;++r)negm[r]=-mhat; asm volatile("":"+v"(negm)); } \
    _Pragma("unroll") for(int r=0;r<16;++r)P0[r]=__builtin_amdgcn_exp2f(P0[r]); }while(0)
  #define RESC() do{ if(resc){ asm volatile("s_waitcnt lgkmcnt(0)":::"memory"); \
      _Pragma("unroll") for(int d_=0;d_<2;++d_) _Pragma("unroll") for(int r=0;r<16;++r)o[d_][r]*=wsf[crow(r,hi)]; } }while(0)
  f32x16 pA0,pA1,pB0,pB1;
  int sl_prev=0,sl_cur=0,sl_next=SLOTB;
  #define ROT() do{sl_prev=sl_cur;sl_cur=sl_next;sl_next=(sl_next==(NSLOT-1)*SLOTB)?0:sl_next+SLOTB;}while(0)
  DMA_K(2,2*SLOTB);
  WAIT_BAR(3);
  qkt(pA0,pA1,Kbase,qr,negm,r32,hi);asm volatile("s_nop 15\n\ts_nop 7":"+v"(pA0),"+v"(pA1));CMASK(pA0,pA1,0);
  START(pA0,pA1);
  _Pragma("unroll") for(int r=0;r<16;++r)pA1[r]=__builtin_amdgcn_exp2f(pA1[r]);
  WAIT_BAR(0);
  DMA_K(3,0);DMA_V(1,SLOTB);
  ROT();
  kload8(kf,kp0+sl_cur);
  WAIT_BAR(2);
  s16x4 vlo[8],vhi[8]; u32x4 pw0,pw1,pw2,pw3;
  #define PKW(P,B) cvtpk_s(P[B],P[B+1])
  #define PAF(k) __builtin_bit_cast(bf16x8,pw##k)
  #define VFR(i) (bf16x8){vlo[i][0],vlo[i][1],vlo[i][2],vlo[i][3],vhi[i][0],vhi[i][1],vhi[i][2],vhi[i][3]}
  #define PIN(x) asm volatile("":"+v"(x))
  #define MX3(a,b,c) __builtin_fmaxf(__builtin_fmaxf((a),(b)),(c))
  #define GAPA(MF,A0,A1,A2,A3,W0,W1,PW) do{ MF; sacc+=A0; sacc+=A1; sacc+=A2; sacc+=A3; PIN(sacc); W0; W1; PIN(PW); SBAR(); }while(0)
  #define EX(v) __builtin_amdgcn_exp2f(v)
  #define GAPB(MF,X,B) do{ MF; X[B]=EX(X[B]); X[B+1]=EX(X[B+1]); X[B+2]=EX(X[B+2]); X[B+3]=EX(X[B+3]); PIN(X); SBAR(); }while(0)
  #define VRD(i) do{ vlo[i]=vtr(vp_+(((i)>>2)*4096+((i)&3)*1024)); vhi[i]=vtr(vp_+(((i)>>2)*4096+((i)&3)*1024+512)); }while(0)
  #define KRD(G,j) do{ if(G){ kload2(kf,kp0+sl_next,j); SBAR(); } }while(0)
  #define STEP(C0,C1,P0,P1,t,GK,GV,GL) do{ SBAR(); \
    const lds_cptr vp_=vp0+sl_prev; \
    VRD(0); SBAR(); float sacc=(P0[0]+P0[1]); \
    GAPA(C0=__builtin_amdgcn_mfma_f32_32x32x16_bf16(kf[0],qr[0],negm,0,0,0), P0[2],P0[3],P0[4],P0[5],     pw0[0]=PKW(P0,0), pw0[1]=PKW(P0,2), pw0); \
    VRD(4); SBAR(); GAPA(C1=__builtin_amdgcn_mfma_f32_32x32x16_bf16(kf[1],qr[0],negm,0,0,0), P0[6],P0[7],P0[8],P0[9],     pw0[2]=PKW(P0,4), pw0[3]=PKW(P0,6), pw0); \
    VRD(1); SBAR(); GAPA(C0=__builtin_amdgcn_mfma_f32_32x32x16_bf16(kf[2],qr[1],C0,0,0,0),   P0[10],P0[11],P0[12],P0[13], pw1[0]=PKW(P0,8), pw1[1]=PKW(P0,10), pw1); \
    VRD(5); SBAR(); GAPA(C1=__builtin_amdgcn_mfma_f32_32x32x16_bf16(kf[3],qr[1],C1,0,0,0),   P0[14],P0[15],P1[0],P1[1],   pw1[2]=PKW(P0,12),pw1[3]=PKW(P0,14), pw1); \
    VRD(2); SBAR(); GAPA(C0=__builtin_amdgcn_mfma_f32_32x32x16_bf16(kf[4],qr[2],C0,0,0,0),   P1[2],P1[3],P1[4],P1[5],     pw2[0]=PKW(P1,0), pw2[1]=PKW(P1,2), pw2); \
    VRD(6); SBAR(); GAPA(C1=__builtin_amdgcn_mfma_f32_32x32x16_bf16(kf[5],qr[2],C1,0,0,0),   P1[6],P1[7],P1[8],P1[9],     pw2[2]=PKW(P1,4), pw2[3]=PKW(P1,6), pw2); \
    VRD(3); SBAR(); GAPA(C0=__builtin_amdgcn_mfma_f32_32x32x16_bf16(kf[6],qr[3],C0,0,0,0),   P1[10],P1[11],P1[12],P1[13], pw3[0]=PKW(P1,8), pw3[1]=PKW(P1,10), pw3); \
    VRD(7); SBAR(); GAPA(C1=__builtin_amdgcn_mfma_f32_32x32x16_bf16(kf[7],qr[3],C1,0,0,0),   P1[14],P1[15],0.f,0.f,       pw3[2]=PKW(P1,12),pw3[3]=PKW(P1,14), pw3); \
    l_reg+=sacc; \
    if(GK){DMA_K((t)+3,sl_cur);} if(GV){DMA_V((t)+1,sl_next);} \
    CMASK(C0,C1,t); \
    { float a=MX3(C0[0],C0[1],C1[0]),b=MX3(C0[2],C0[3],C1[1]); a=MX3(a,C1[2],C1[3]); \
      _Pragma("unroll") for(int r=4;r<16;r+=4){a=MX3(a,C0[r],C0[r+1]);b=MX3(b,C0[r+2],C0[r+3]);a=MX3(a,C1[r],C1[r+1]);b=MX3(b,C1[r+2],C1[r+3]);} \
      float rm=__builtin_fmaxf(a,b); { auto rr=__builtin_amdgcn_permlane32_swap(__float_as_uint(rm),__float_as_uint(rm),false,false); rm=__builtin_fmaxf(__uint_as_float(rr[0]),__uint_as_float(rr[1])); } \
      resc=false; \
      if(__builtin_expect(__any(rm>(float)THRL),0)){ const float dl=__builtin_fmaxf(rm,0.f); mhat+=dl; \
        _Pragma("unroll") for(int r=0;r<16;++r){C0[r]-=dl;C1[r]-=dl;} \
        _Pragma("unroll") for(int r=0;r<16;++r)negm[r]=-mhat; asm volatile("":"+v"(negm)); \
        const float f=__builtin_amdgcn_exp2f(-dl); l_reg*=f; if(hi==0)wsf[r32]=f; resc=true; } } \
    SBAR(); \
    GAPB(o[0]=__builtin_amdgcn_mfma_f32_32x32x16_bf16(PAF(0),VFR(0),o[0],0,0,0), C0,0); \
    GAPB(o[1]=__builtin_amdgcn_mfma_f32_32x32x16_bf16(PAF(0),VFR(4),o[1],0,0,0), C0,4); \
    KRD(GL,0); GAPB(o[0]=__builtin_amdgcn_mfma_f32_32x32x16_bf16(PAF(1),VFR(1),o[0],0,0,0), C0,8); \
    KRD(GL,1); GAPB(o[1]=__builtin_amdgcn_mfma_f32_32x32x16_bf16(PAF(1),VFR(5),o[1],0,0,0), C0,12); \
    KRD(GL,2); GAPB(o[0]=__builtin_amdgcn_mfma_f32_32x32x16_bf16(PAF(2),VFR(2),o[0],0,0,0), C1,0); \
    KRD(GL,3); GAPB(o[1]=__builtin_amdgcn_mfma_f32_32x32x16_bf16(PAF(2),VFR(6),o[1],0,0,0), C1,4); \
    GAPB(o[0]=__builtin_amdgcn_mfma_f32_32x32x16_bf16(PAF(3),VFR(3),o[0],0,0,0), C1,8); \
    GAPB(o[1]=__builtin_amdgcn_mfma_f32_32x32x16_bf16(PAF(3),VFR(7),o[1],0,0,0), C1,12); \
    }while(0)
  int t=1;
  for(;t+5<NT;t+=2){
    STEP(pB0,pB1,pA0,pA1,t,true,true,true);     WAIT_BAR(2); RESC(); ROT();
    STEP(pA0,pA1,pB0,pB1,t+1,true,true,true);   WAIT_BAR(2); RESC(); ROT();
  }
  #define ENDW(tt) do{ if((tt)+3<NT){WAIT_BAR(2);} else if((tt)+2<NT){WAIT_BAR(1);} else {WAIT_BAR(0);} }while(0)
  for(;t+1<NT;t+=2){
    STEP(pB0,pB1,pA0,pA1,t,(t+3<NT),(t+1<NT),(t+1<NT));       ENDW(t);   RESC(); ROT();
    STEP(pA0,pA1,pB0,pB1,t+1,(t+4<NT),(t+2<NT),(t+2<NT));     ENDW(t+1); RESC(); ROT();
  }
  STEP(pB0,pB1,pA0,pA1,NT-1,false,false,false); RESC();
  { float sacc=pB0[0]+pB0[1]; _Pragma("unroll") for(int r=2;r<16;++r)sacc+=pB0[r]; _Pragma("unroll") for(int r=0;r<16;++r)sacc+=pB1[r]; l_reg+=sacc;
    pw0=(u32x4){PKW(pB0,0),PKW(pB0,2),PKW(pB0,4),PKW(pB0,6)};pw1=(u32x4){PKW(pB0,8),PKW(pB0,10),PKW(pB0,12),PKW(pB0,14)};pw2=(u32x4){PKW(pB1,0),PKW(pB1,2),PKW(pB1,4),PKW(pB1,6)};pw3=(u32x4){PKW(pB1,8),PKW(pB1,10),PKW(pB1,12),PKW(pB1,14)};
    SBAR(); pv(o,vb0+sl_cur,PAF(0),PAF(1),PAF(2),PAF(3)); }
  #undef PKW
  #undef PAF
  #undef VFR
  #undef PIN
  #undef MX3
  #undef GAPA
  #undef GAPB
  #undef EX
  #undef VRD
  #undef KRD
  #undef STEP
  #undef ENDW
  {auto rr=__builtin_amdgcn_permlane32_swap(__float_as_uint(l_reg),__float_as_uint(l_reg),false,false);l_reg=__uint_as_float(rr[0])+__uint_as_float(rr[1]);}
  if(hi==0)wsf[32+r32]=l_reg;asm volatile("s_waitcnt lgkmcnt(0)":::"memory");
  float rli[16];
  #pragma unroll
  for(int r=0;r<16;++r)rli[r]=__builtin_amdgcn_rcpf(wsf[32+crow(r,hi)]);
  bf16*Ow=Ou+(long)(wid*QBLK)*OP;
  { bf16*stg=(bf16*)(shm+LDS_OST)+wid*2048;
    #pragma unroll
    for(int r=0;r<16;++r){const int orow=crow(r,hi);
      #pragma unroll
      for(int d0=0;d0<2;++d0)stg[orow*64+d0*32+r32]=__float2bfloat16(o[d0][r]*rli[r]);}
    asm volatile("s_waitcnt lgkmcnt(0)":::"memory");
    #pragma unroll
    for(int i=0;i<4;++i){const int row=i*8+(lane>>3),ch=lane&7; const u32x4 v=*(const u32x4*)(stg+row*64+ch*8); ATTN_STORE16(Ow+(long)row*OP+ch*8,v);} }
  asm volatile("s_waitcnt lgkmcnt(0)\n\ts_barrier":::"memory");
  #undef DMA_K
  #undef DMA_V
  #undef CMASK
  #undef START
  #undef RESC
  #undef ROT
}
constexpr int ATTN_LDS_BYTES=LDS_BYTES;
#undef SBAR
#undef WAIT_BAR
}


namespace hyf {
struct c32 { float x, y; };
typedef _Float16 h2 __attribute__((ext_vector_type(2)));
__device__ __forceinline__ c32 operator+(c32 a, c32 b) { return {a.x + b.x, a.y + b.y}; }
__device__ __forceinline__ c32 operator-(c32 a, c32 b) { return {a.x - b.x, a.y - b.y}; }
__device__ __forceinline__ c32 cmul(c32 a, c32 b) { return {a.x * b.x - a.y * b.y, a.x * b.y + a.y * b.x}; }
__device__ __forceinline__ constexpr float C32(int k) {
  switch (k) { case 0: return 1.f; case 1: return 0.98078528f; case 2: return 0.923879533f; case 3: return 0.831469612f; case 4: return 0.707106781f; case 5: return 0.555570233f; case 6: return 0.382683432f;
    case 7: return 0.195090322f; case 8: return 0.f; case 9: return -0.195090322f; case 10: return -0.382683432f; case 11: return -0.555570233f; case 12: return -0.707106781f; case 13: return -0.831469612f;
    case 14: return -0.923879533f; default: return -0.98078528f; } }
__device__ __forceinline__ constexpr float S32(int k) {
  switch (k) { case 0: return 0.f; case 1: return 0.195090322f; case 2: return 0.382683432f; case 3: return 0.555570233f; case 4: return 0.707106781f; case 5: return 0.831469612f; case 6: return 0.923879533f;
    case 7: return 0.98078528f; case 8: return 1.f; case 9: return 0.98078528f; case 10: return 0.923879533f; case 11: return 0.831469612f; case 12: return 0.707106781f; case 13: return 0.555570233f;
    case 14: return 0.382683432f; default: return 0.195090322f; } }
__device__ __forceinline__ constexpr int brev(int q, int bits) {
  return bits == 4 ? (((q & 1) << 3) | ((q & 2) << 1) | ((q & 4) >> 1) | ((q & 8) >> 3))
                   : (((q & 1) << 4) | ((q & 2) << 2) | (q & 4) | ((q & 8) >> 2) | ((q & 16) >> 4)); }
__device__ __forceinline__ int phys(int p) { return p + (p >> 5); }
template <int R, int HALF, bool INV> struct DftStage {
  static __device__ __forceinline__ void run(c32 (&x)[R]) {
#pragma unroll
    for (int blk = 0; blk < R; blk += 2 * HALF) {
#pragma unroll
      for (int j = 0; j < HALF; ++j) {
        const c32 a = x[blk + j], b = x[blk + j + HALF]; x[blk + j] = a + b; const c32 d = a - b;
        const int e = j * (R / (2 * HALF)) * (32 / R);
        if (e == 0) x[blk + j + HALF] = d;
        else if (e == 8) x[blk + j + HALF] = INV ? (c32){-d.y, d.x} : (c32){d.y, -d.x};
        else { const c32 wv = {C32(e), INV ? S32(e) : -S32(e)}; x[blk + j + HALF] = cmul(d, wv); }
      } }
    DftStage<R, HALF / 2, INV>::run(x);
  }
};
template <int R, bool INV> struct DftStage<R, 0, INV> { static __device__ __forceinline__ void run(c32 (&)[R]) {} };
template <int R, bool INV> __device__ __forceinline__ void dft_pow2(c32 (&x)[R]) { DftStage<R, R / 2, INV>::run(x); }
template <int R, int HALF> struct DitStage {
  static __device__ __forceinline__ void run(c32 (&x)[R]) {
#pragma unroll
    for (int blk = 0; blk < R; blk += 2 * HALF) {
#pragma unroll
      for (int j = 0; j < HALF; ++j) {
        const int e = j * (R / (2 * HALF)) * (32 / R);
        const c32 a = x[blk + j], b0 = x[blk + j + HALF];
        c32 b;
        if (e == 0) b = b0; else if (e == 8) b = (c32){-b0.y, b0.x}; else b = cmul(b0, (c32){C32(e), S32(e)});
        x[blk + j] = a + b; x[blk + j + HALF] = a - b;
      } }
    DitStage<R, HALF * 2>::run(x);
  }
};
template <int R> struct DitStage<R, R> { static __device__ __forceinline__ void run(c32 (&)[R]) {} };
template <int R> __device__ __forceinline__ void idft_dit(c32 (&x)[R]) { DitStage<R, 1>::run(x); }
template <int STRIDE, bool INV> __device__ __forceinline__ void pass16(c32* buf, int e0, float rev) {
  float rv = rev; asm volatile("" : "+v"(rv));
  const float cs = __builtin_amdgcn_cosf(rv), sn = __builtin_amdgcn_sinf(rv);
  const c32 w1 = {cs, INV ? sn : -sn};
  c32* p = buf + phys(e0); constexpr int PS = STRIDE + STRIDE / 32;
  c32 x[16];
  if (!INV) {
#pragma unroll
    for (int m = 0; m < 16; ++m) x[m] = p[PS * m];
    dft_pow2<16, false>(x);
    c32 w = w1; p[0] = x[0];
#pragma unroll
    for (int q = 1; q < 16; ++q) { p[PS * q] = cmul(x[brev(q, 4)], w); w = cmul(w, w1); }
  } else {
    c32 w = w1; x[0] = p[0];
#pragma unroll
    for (int q = 1; q < 16; ++q) { x[q] = cmul(p[PS * q], w); w = cmul(w, w1); }
    dft_pow2<16, true>(x);
#pragma unroll
    for (int m = 0; m < 16; ++m) p[PS * m] = x[brev(m, 4)];
  }
}
template <int MODE> __device__ __forceinline__ void mid32(c32* buf, h2* Hs, int j) {
  c32* p = buf + 33 * j; c32 x[32];
#pragma unroll
  for (int m = 0; m < 32; ++m) x[m] = p[m];
  dft_pow2<32, false>(x);
  if (MODE == 0) {
#pragma unroll
    for (int q = 0; q < 32; ++q) { const c32 v = x[brev(q, 5)]; Hs[q * 256 + j] = (h2){(_Float16)v.x, (_Float16)v.y}; }
  } else {
#pragma unroll
    for (int pp = 0; pp < 32; ++pp) { const h2 hv = Hs[brev(pp, 5) * 256 + j]; x[pp] = cmul(x[pp], (c32){(float)hv.x, (float)hv.y}); }
    idft_dit<32>(x);
#pragma unroll
    for (int m = 0; m < 32; ++m) p[m] = x[m];
  }
}
__device__ __forceinline__ void fwd2(c32* buf, int tid) {
  __syncthreads(); pass16<512, false>(buf, tid, (float)tid * (1.0f / 8192.0f));
  __syncthreads(); pass16<32, false>(buf, (tid >> 5) * 512 + (tid & 31), (float)(tid & 31) * (1.0f / 512.0f));
  __syncthreads();
}
__device__ __forceinline__ void conv(c32* buf, h2* Hs, int tid) {
  fwd2(buf, tid);
  if (tid < 256) mid32<1>(buf, Hs, tid);
  __syncthreads(); pass16<32, true>(buf, (tid >> 5) * 512 + (tid & 31), (float)(tid & 31) * (1.0f / 512.0f));
  __syncthreads(); pass16<512, true>(buf, tid, (float)tid * (1.0f / 8192.0f));
  __syncthreads();
}
__device__ __forceinline__ void item(int c, const bf16_t* HYT, const float* HK, const float* hy_bias, bf16_t* HYO, char* lds) {
  c32* buf = (c32*)lds; h2* H0 = (h2*)(lds + 67584); h2* H1 = H0 + 8192;
  const int tid = TIDX;
#pragma unroll 1
  for (int o = 0; o < 2; ++o) {
    const float* kp = HK + ((size_t)o * 256 + c) * 8192;
#pragma unroll
    for (int i = 0; i < 16; ++i) { const int n = tid + 512 * i; buf[phys(n)] = (c32){kp[n], 0.f}; }
    fwd2(buf, tid);
    if (tid < 256) mid32<0>(buf, o ? H1 : H0, tid);
    __syncthreads();
  }
  const float bias0 = hy_bias[c], bias1 = hy_bias[256 + c];
#pragma unroll 1
  for (int pr = 0; pr < 2; ++pr) {
    const bf16_t* v0 = HYT + ((size_t)(2 * pr) * 768 + c) * SEQ; const bf16_t* v1 = v0 + (size_t)768 * SEQ;
    c32 vv[8];
#pragma unroll
    for (int i = 0; i < 8; ++i) { const int t = tid + 512 * i; vv[i] = (c32){bf2f(v0[t]), bf2f(v1[t])}; buf[phys(t)] = vv[i]; buf[phys(t + 4096)] = (c32){0.f, 0.f}; }
    conv(buf, H0, tid);
#pragma unroll
    for (int i = 0; i < 8; ++i) { const int t = tid + 512 * i; const c32 y = buf[phys(t)];
      vv[i] = (c32){bf2f(v0[(size_t)256 * SEQ + t]) * (y.x * (1.0f / 8192.0f) + bias0 * vv[i].x), bf2f(v1[(size_t)256 * SEQ + t]) * (y.y * (1.0f / 8192.0f) + bias0 * vv[i].y)};
      buf[phys(t)] = vv[i]; buf[phys(t + 4096)] = (c32){0.f, 0.f}; }
    conv(buf, H1, tid);
#pragma unroll
    for (int i = 0; i < 8; ++i) { const int t = tid + 512 * i; const c32 y = buf[phys(t)];
      HYO[((size_t)(2 * pr) * 256 + c) * SEQ + t] = (bf16_t)f2bf(bf2f(v0[(size_t)512 * SEQ + t]) * (y.x * (1.0f / 8192.0f) + bias1 * vv[i].x));
      HYO[((size_t)(2 * pr + 1) * 256 + c) * SEQ + t] = (bf16_t)f2bf(bf2f(v1[(size_t)512 * SEQ + t]) * (y.y * (1.0f / 8192.0f) + bias1 * vv[i].y)); }
    __syncthreads();
  }
}
__device__ __forceinline__ void out_item(int it, const bf16_t* HYO, bf16_t* MIX, char* lds) {
  bf16_t (*T)[72] = (bf16_t (*)[72])lds;
  const int tid = TIDX, b = it >> 8, t0 = ((it >> 2) & 63) * 64, c0 = (it & 3) * 64;
  { const int cc = tid >> 3, t8 = (tid & 7) * 8; *(u32x4*)&T[cc][t8] = *(const u32x4*)(HYO + ((size_t)b * 256 + c0 + cc) * SEQ + t0 + t8); }
  __syncthreads();
  { const int tl = tid >> 3, c8 = (tid & 7) * 8; u32x4 o;
    o.x = (unsigned)T[c8][tl] | ((unsigned)T[c8 + 1][tl] << 16); o.y = (unsigned)T[c8 + 2][tl] | ((unsigned)T[c8 + 3][tl] << 16);
    o.z = (unsigned)T[c8 + 4][tl] | ((unsigned)T[c8 + 5][tl] << 16); o.w = (unsigned)T[c8 + 6][tl] | ((unsigned)T[c8 + 7][tl] << 16);
    *(u32x4*)(MIX + ((size_t)b * TPB + CTXL + t0 + tl) * DM + 768 + c0 + c8) = o; }
  __syncthreads();
}
}

#define LAS __attribute__((address_space(3)))
#define XB_TMO      128
#define XB_XCNT(j)  (256  + 64 * (j))
#define XB_XSUB(j)  (1280 + 64 * (j))
#define XB_XGEN(j)  (2304 + 64 * (j))
#define XB_TOP      3328
#define XB_TOPGEN   3392
#define XCD_BAR_WORDS 3456
#define XB_SPIN_CAP (1u << 18)

__device__ __forceinline__ unsigned xb_ld(unsigned* p)              { return __hip_atomic_load(p, __ATOMIC_RELAXED, __HIP_MEMORY_SCOPE_AGENT); }
__device__ __forceinline__ unsigned xb_add(unsigned* p, unsigned v) { return __hip_atomic_fetch_add(p, v, __ATOMIC_RELAXED, __HIP_MEMORY_SCOPE_AGENT); }
__device__ __forceinline__ unsigned xb_xcc_id() { return (unsigned)__builtin_amdgcn_s_getreg((3 << 11) | 20) & 0xFu; }
#define XB_SPIN(cond, bar) do { unsigned _sp = 0; while (cond) { __builtin_amdgcn_s_sleep(1); \
    if ((++_sp & 255u) == 0u) { if (xb_ld(&(bar)[XB_TMO])) break; if (_sp > XB_SPIN_CAP) { atomicAdd(&(bar)[XB_TMO], 1u); break; } } } } while (0)

struct XcdBarrier {
    unsigned* bar; unsigned x;
    volatile LAS unsigned* st;
};

__device__ __forceinline__ XcdBarrier xcd_barrier_post(unsigned* bar, volatile LAS unsigned* st) {
    XcdBarrier b; b.bar = bar; b.x = xb_xcc_id(); b.st = st;
    if (threadIdx.x == 0) (void)xb_add(&bar[XB_XCNT(b.x)], 1u);
    return b;
}
__device__ __forceinline__ void xcd_barrier_complete(unsigned* bar, unsigned x, unsigned& nloc, unsigned& nx) {
    const unsigned G = gridDim.x * gridDim.y * gridDim.z;
    unsigned sum, cnt, mine, sp = 0u;
    for (;;) {
        sum = 0u; cnt = 0u; mine = 0u;
#pragma unroll
        for (unsigned j = 0; j < 16; ++j) { const unsigned c = xb_ld(&bar[XB_XCNT(j)]); sum += c; cnt += (c > 0u) ? 1u : 0u; mine = (j == x) ? c : mine; }
        if (sum == G) break;
        __builtin_amdgcn_s_sleep(1);
        if ((++sp & 255u) == 0u) { if (xb_ld(&bar[XB_TMO])) break; if (sp > XB_SPIN_CAP) { atomicAdd(&bar[XB_TMO], 1u); break; } }
    }
    nloc = mine > 0u ? mine : 1u; nx = cnt > 0u ? cnt : 1u;
}

__device__ __forceinline__ void xcd_barrier(const XcdBarrier& b) {
    asm volatile("s_waitcnt vmcnt(0)" ::: "memory");
    __syncthreads();
    if (threadIdx.x == 0) {
        unsigned* bar = b.bar;
        __builtin_amdgcn_s_waitcnt(0);
        unsigned nloc = b.st[0], nx = b.st[1];
        if (nloc == 0u) { xcd_barrier_complete(bar, b.x, nloc, nx); b.st[0] = nloc; b.st[1] = nx; }
        const unsigned old = xb_add(&bar[XB_XSUB(b.x)], 1u);
        const unsigned gen = old / nloc;
        if (old + 1u == (gen + 1u) * nloc) {
            __builtin_amdgcn_fence(__ATOMIC_RELEASE, "agent");
            asm volatile("s_waitcnt vmcnt(0)" ::: "memory");
            const unsigned og = xb_add(&bar[XB_TOP], 1u);
            const unsigned tg = og / nx;
            if (og + 1u == (tg + 1u) * nx) xb_add(&bar[XB_TOPGEN], 1u);
            else XB_SPIN(xb_ld(&bar[XB_TOPGEN]) == tg, bar);
            __builtin_amdgcn_fence(__ATOMIC_ACQUIRE, "agent");
            xb_add(&bar[XB_XGEN(b.x)], 1u);
            asm volatile("s_waitcnt vmcnt(0)" ::: "memory");
        } else {
            XB_SPIN(xb_ld(&bar[XB_XGEN(b.x)]) == gen, bar);
            __builtin_amdgcn_fence(__ATOMIC_ACQUIRE, "agent");
            asm volatile("s_waitcnt vmcnt(0)" ::: "memory");
        }
    }
    __syncthreads();
}


struct MP { const float* in[33]; float* out; unsigned char* ws; };
typedef const float* const __attribute__((address_space(4))) * kargs_t;
#define KARGS() ({ kargs_t k_ = (kargs_t)__builtin_amdgcn_kernarg_segment_ptr(); asm volatile("" : "+s"(k_)); k_; })
#define WSP(K, off) ((unsigned char*)(K)[34] + (off))

__global__ void __launch_bounds__(NT, 2) mega(MP P) {
  cg::grid_group grid = cg::this_grid();
  extern __shared__ __attribute__((aligned(16))) char lds[];
  volatile LAS unsigned* xst = (volatile LAS unsigned*)(lds + LDS_BYTES - 16);
  if (threadIdx.x < 2) xst[threadIdx.x] = 0u;
  __syncthreads();
  { kargs_t K = KARGS(); (void)xcd_barrier_post((unsigned*)WSP(K, WS_CTL) + CT_BAR, xst); }
#define XBAR_HERE() do { kargs_t Kb_ = KARGS(); XcdBarrier xb_; xb_.bar = (unsigned*)WSP(Kb_, WS_CTL) + CT_BAR; xb_.x = xb_xcc_id(); xb_.st = (volatile LAS unsigned*)(lds + LDS_BYTES - 16); xcd_barrier(xb_); } while (0)
#define SEAM() XBAR_HERE()
  {
    kargs_t K = KARGS();
    st_adaln(K[1], K[3], K[4], K[5], (float*)WSP(K, WS_MODV), lds);
    st_rope((float*)WSP(K, WS_ROPE));
  }
  {
      kargs_t K = KARGS();
      st_weights(K[8], K[26], K[29], K[30], K[31], 0, (bf16_t*)WSP(K, WS_WIN), (bf16_t*)WSP(K, WS_WOUT), (bf16_t*)WSP(K, WS_WGU), (bf16_t*)WSP(K, WS_WD), lds);
    }
    { kargs_t K = KARGS(); const int bid = BIDX, G = GDIM;
      for (int it = bid; it < SEQ / 16; it += G) hyfilt_item<SEQ>(it, K[19] + 0 * 33 * 64, K[20] + 0 * 64, K[21] + 0 * 64, K[22] + 0 * 4096, K[23] + 0 * 64, K[24] + (size_t)0 * 65536, (float*)WSP(K, WS_HK), lds);
      if (true) for (int it = bid; it < CTXL / 16; it += G) hyfilt_item<CTXL>(it, K[19] + 0 * 33 * 64, K[20] + 0 * 64, K[21] + 0 * 64, K[22] + 0 * 4096, K[23] + 0 * 64, K[24] + (size_t)0 * 65536, (float*)WSP(K, WS_HKC), lds);
    }
  if (gridDim.x == 0x7fffffffu) grid.sync();
  XBAR_HERE();
#pragma nounroll
  for (int layer = 0; layer < 2; ++layer) {
    const bool last = layer == 1;
    if (layer == 1) {
    {
      kargs_t K = KARGS();
      st_weights(K[8], K[26], K[29], K[30], K[31], layer, (bf16_t*)WSP(K, WS_WIN), (bf16_t*)WSP(K, WS_WOUT), (bf16_t*)WSP(K, WS_WGU), (bf16_t*)WSP(K, WS_WD), lds);
    }
    { kargs_t K = KARGS(); const int bid = BIDX, G = GDIM;
      for (int it = bid; it < SEQ / 16; it += G) hyfilt_item<SEQ>(it, K[19] + layer * 33 * 64, K[20] + layer * 64, K[21] + layer * 64, K[22] + layer * 4096, K[23] + layer * 64, K[24] + (size_t)layer * 65536, (float*)WSP(K, WS_HK), lds);
      if (!last) for (int it = bid; it < CTXL / 16; it += G) hyfilt_item<CTXL>(it, K[19] + layer * 33 * 64, K[20] + layer * 64, K[21] + layer * 64, K[22] + layer * 4096, K[23] + layer * 64, K[24] + (size_t)layer * 65536, (float*)WSP(K, WS_HKC), lds);
    }
    }
    { kargs_t K = KARGS();
      const float* xl_src = layer == 0 ? K[0] : K[33]; const float* xc_src = layer == 0 ? K[2] : (const float*)WSP(K, WS_XC);
      st_normmod(xl_src, xc_src, (float*)K[33], (float*)WSP(K, WS_XC), layer == 0 ? (const bf16_t*)nullptr : (const bf16_t*)WSP(K, WS_H2S), (const int*)WSP(K, WS_MOEM + 768 * 1024),
                 (const float*)WSP(K, WS_MODV) + 5120, K[6] + layer * 1024, (const float*)WSP(K, WS_MODV) + (size_t)layer * 5 * 6144, 0, 1024, (bf16_t*)WSP(K, WS_H), lds);
    }
    SEAM();
    {
      kargs_t K = KARGS();
      pg8::Gemm g{1024, 1024, 1024}; SchedDense S{MTOK / 256, NPAD / 256, (int)GDIM, BIDX, 0, (const char*)WSP(K, WS_H), (const char*)WSP(K, WS_WIN), (size_t)256 * 1024 * 2, (size_t)256 * 1024 * 2};
      EpiInProj E{(bf16_t*)WSP(K, WS_QK), (bf16_t*)WSP(K, WS_VZ), (bf16_t*)WSP(K, WS_XBC), (bf16_t*)WSP(K, WS_HY), (float*)WSP(K, WS_DT)};
      pg8::gemm_phase<EpiInProj, SchedDense, true, true>((PG8_LAS unsigned char*)lds, g, S, E);
    }
    SEAM();
    {
      kargs_t K = KARGS();
      st_prep_qk((bf16_t*)WSP(K, WS_QK), K[9] + layer * 64, K[10] + layer * 64, (const float*)WSP(K, WS_ROPE));
    }
    { kargs_t K = KARGS();
      st_prep_hy((const bf16_t*)WSP(K, WS_HY), K[17] + layer * 3 * 768, K[18] + layer * 768, (bf16_t*)WSP(K, WS_HYT), last ? 0 : 1, lds);
    }
    { kargs_t K = KARGS();
      st_ssd1(BIDX, GDIM, 4 * 34 * 6, (const bf16_t*)WSP(K, WS_XBC), (const float*)WSP(K, WS_DT), K[11] + layer * 3 * 640, K[12] + layer * 640, K[13] + layer * 12, K[14] + layer * 12,
              (float*)WSP(K, WS_Y), (float*)WSP(K, WS_ST), (float*)WSP(K, WS_DEC), lds);
    }
    SEAM();
    {
      { kargs_t K2 = KARGS(); st_ssd_scan2((float*)WSP(K2, WS_ST), (const float*)WSP(K2, WS_DEC)); }
      const int bid = BIDX, G = GDIM;
#define P4_ATT(bb, hq, qrow_, nt_) do { kargs_t K = KARGS(); const int kvh_ = (hq) / 3; \
          const attn_body::bf16* QKp = (const attn_body::bf16*)WSP(K, WS_QK); const attn_body::bf16* VZp = (const attn_body::bf16*)WSP(K, WS_VZ); \
          attn_body::attn_unit<8>(QKp + (size_t)(qrow_) * 512 + (hq) * 64, QKp + (size_t)(bb) * TPB * 512 + 384 + kvh_ * 64, VZp + (size_t)(bb) * TPB * 512 + kvh_ * 64, \
                                  (attn_body::bf16*)WSP(K, WS_H) + (size_t)(qrow_) * 1024 + (hq) * 64, (nt_), lds); } while (0)
#define P4_FFT(cch) do { kargs_t K = KARGS(); hyf::item((cch), (const bf16_t*)WSP(K, WS_HYT), (const float*)WSP(K, WS_HK), K[25] + layer * 512, (bf16_t*)WSP(K, WS_HY), lds); } while (0)
#define P4_CHY(itm) do { kargs_t K = KARGS(); hyconv_ctx_item((itm), (const bf16_t*)WSP(K, WS_HYT) + (size_t)4 * 768 * SEQ, (const float*)WSP(K, WS_HKC), K[25] + layer * 512, (bf16_t*)WSP(K, WS_H), lds); } while (0)
      {
        const int x = bid & 7, y = bid >> 3, bb = x >> 1, kvh = x & 1;
        const int nun = y < 16 ? 2 : 1, natt = nun + ((!last && y < 3) ? 1 : 0);
#pragma unroll 1
        for (int k = 0; k < natt; ++k) { int hq, qrow, nt;
          if (k < nun) { const int v = y < 16 ? y + 16 * k : 16 + y; hq = 3 * kvh + (v >> 4); qrow = bb * TPB + CTXL + (v & 15) * 256; nt = TPB / 64; }
          else { hq = 3 * kvh + y; qrow = bb * TPB; nt = CTXL / 64; }
          P4_ATT(bb, hq, qrow, nt); }
        if (y >= 16) {
#pragma unroll 1
          for (int k = 0; k < 2; ++k) { const int cch = ((y - 16) * 8 + x) * 2 + k; P4_FFT(cch); } }
        if (!last && y >= 3 && y < 11) { P4_CHY((y - 3) * 8 + x); }
      }
      (void)G;
#undef P4_ATT
#undef P4_FFT
#undef P4_CHY
    }
    SEAM();
    {
      kargs_t K = KARGS();
      { const int bid = BIDX, G = GDIM, nit = last ? 4 * 32 * 2 : 4 * 34 * 2;
        for (int it = bid; it < nit; it += G) { const int g = it & 1, bc = it >> 1; const int b = last ? bc >> 5 : bc / 34, cidx = last ? 2 + (bc & 31) : bc % 34;
          ssd3_item(b, cidx, g, (const bf16_t*)WSP(K, WS_XBC), (const bf16_t*)WSP(K, WS_VZ), (const float*)WSP(K, WS_DT), K[11] + layer * 3 * 640, K[12] + layer * 640, K[13] + layer * 12, K[14] + layer * 12,
                    K[15] + layer * 6, K[16] + layer * 384, (const float*)WSP(K, WS_Y), (const float*)WSP(K, WS_ST), (bf16_t*)WSP(K, WS_H), lds); } }
      { const int bid = BIDX, G = GDIM; for (int it = bid; it < 1024; it += G) hyf::out_item(it, (const bf16_t*)WSP(K, WS_HY), (bf16_t*)WSP(K, WS_H), lds); }
      const int t = TIDX; if (BIDX == 0 && t < 256) ((int*)WSP(K, WS_CTL))[t] = 0;
      { int* stok = (int*)WSP(K, WS_MOEM + 384 * 1024); for (int i = BIDX * NT + t; i < MOE_ROWS; i += GDIM * NT) stok[i] = -1; }
    }
    SEAM();
    {
      kargs_t K = KARGS();
      const float* xl_src = layer == 0 ? K[0] : K[33]; const float* xc_src = layer == 0 ? K[2] : (const float*)WSP(K, WS_XC);
      pg8::Gemm g{1024, 1024, 1024}; SchedDense S{last ? 64 : 68, 4, (int)GDIM, BIDX, last ? 1 : 0, (const char*)WSP(K, WS_H), (const char*)WSP(K, WS_WOUT), (size_t)256 * 1024 * 2, (size_t)256 * 1024 * 2};
      EpiOutProj E{(bf16_t*)WSP(K, WS_QK)};
      pg8::gemm_phase<EpiOutProj, SchedDense, true, true>((PG8_LAS unsigned char*)lds, g, S, E);
    }
    SEAM();
    {
      kargs_t K = KARGS();
      st_router(layer == 0 ? K[0] : K[33], layer == 0 ? K[2] : (const float*)WSP(K, WS_XC), (float*)K[33], (float*)WSP(K, WS_XC), (const bf16_t*)WSP(K, WS_QK), K[7] + layer * 1024, (const float*)WSP(K, WS_MODV) + (size_t)layer * 5 * 6144, K[27], K[28], (bf16_t*)WSP(K, WS_H), (int*)WSP(K, WS_CTL),
                (int*)WSP(K, WS_MOEM), (float*)WSP(K, WS_MOEM + 128 * 1024), last ? 1 : 0, lds);
    }
    SEAM();
    { kargs_t K = KARGS();
      st_moe_gather((const bf16_t*)WSP(K, WS_H), (bf16_t*)WSP(K, WS_H2S), (int*)WSP(K, WS_CTL), (const int*)WSP(K, WS_MOEM), (const float*)WSP(K, WS_MOEM + 128 * 1024),
                    (int*)WSP(K, WS_MOEM + 384 * 1024), (float*)WSP(K, WS_MOEM + 512 * 1024), (int*)WSP(K, WS_MOEM + 768 * 1024), last ? 1 : 0, lds);
    }
    SEAM();
    { kargs_t K = KARGS();
      pg8::Gemm g{1024, 1024, 1024}; SchedMoe S{(int)GDIM, BIDX, 1, (const int*)WSP(K, WS_CTL), (const char*)WSP(K, WS_H2S), (size_t)256 * 1024 * 2, (const char*)WSP(K, WS_WGU)};
      EpiMoe1 E{(bf16_t*)WSP(K, WS_ACT), (const float*)WSP(K, WS_MOEM + 512 * 1024)};
      pg8::gemm_phase<EpiMoe1, SchedMoe, true, true>((PG8_LAS unsigned char*)lds, g, S, E);
    }
    SEAM();
    { kargs_t K = KARGS();
      pg8::Gemm g{256, 512, 256}; SchedMoe S{(int)GDIM, BIDX, 2, (const int*)WSP(K, WS_CTL), (const char*)WSP(K, WS_ACT), (size_t)256 * 512 * 2, (const char*)WSP(K, WS_WD)};
      EpiMoe2 E{(bf16_t*)WSP(K, WS_H2S)};
      pg8::gemm_phase<EpiMoe2, SchedMoe, true, true>((PG8_LAS unsigned char*)lds, g, S, E);
    }
    SEAM();
  }
  { kargs_t K = KARGS(); st_final((float*)K[33], K[32], (const bf16_t*)WSP(K, WS_H2S), (const int*)WSP(K, WS_MOEM + 768 * 1024), (const float*)WSP(K, WS_MODV) + (size_t)5 * 6144 + 5120); }
}

extern "C" void kernel_launch(void* const* d_in, const int* in_sizes, int n_in, void* d_out, int out_size, void* d_ws, size_t ws_size, hipStream_t stream) {
  if (n_in != 33 || ws_size < WS_END) { fprintf(stderr, "kernel_launch: unexpected n_in %d / ws %zu\n", n_in, ws_size); return; }
  static int grid_blocks = 0;
  if (!grid_blocks) {
    int dev = 0, cus = 0, per_cu = 0;
    (void)hipGetDevice(&dev);
    (void)hipDeviceGetAttribute(&cus, hipDeviceAttributeMultiprocessorCount, dev);
    (void)hipFuncSetAttribute((const void*)mega, hipFuncAttributeMaxDynamicSharedMemorySize, LDS_BYTES);
    (void)hipOccupancyMaxActiveBlocksPerMultiprocessor(&per_cu, mega, NT, LDS_BYTES);
    if (per_cu < 1) per_cu = 1;
    if (per_cu > 2) per_cu = 2;
    grid_blocks = 256;
    if (cus != 256 || per_cu < 1) fprintf(stderr, "kernel_launch: expected 256 CUs with >= 1 workgroup each (got %d CUs, %d per CU)\n", cus, per_cu);
  }
  (void)hipMemsetAsync((char*)d_ws + WS_CTL + (size_t)CT_BAR * 4, 0, (size_t)XCD_BAR_WORDS * 4, stream);
  MP p{};
  for (int i = 0; i < 33; ++i) p.in[i] = (const float*)d_in[i];
  p.out = (float*)d_out; p.ws = (unsigned char*)d_ws;
  void* args[] = {&p};
  hipError_t e = hipLaunchCooperativeKernel((const void*)mega, dim3(grid_blocks), dim3(NT), args, LDS_BYTES, stream);
  if (e != hipSuccess) fprintf(stderr, "cooperative launch failed: %s (grid %d)\n", hipGetErrorString(e), grid_blocks);
}
```

```cpp
#include <hip/hip_runtime.h>
#include <hip/hip_cooperative_groups.h>
#include <cstdio>
#include <cstdint>
namespace cg = cooperative_groups;

typedef unsigned short bf16_t;
typedef short bf16x8 __attribute__((ext_vector_type(8)));
typedef float f32x4 __attribute__((ext_vector_type(4)));
typedef unsigned u32x4 __attribute__((ext_vector_type(4)));
typedef unsigned u32x2 __attribute__((ext_vector_type(2)));

constexpr int NB = 4, SEQ = 4096, CTXL = 256, DM = 1024, TPB = 4352, MTOK = NB * TPB;
constexpr int DIN = 2444, NPAD = 2560;
constexpr float EPS = 1e-6f;
constexpr float C2 = 0.125f * 1.4426950408889634f;
constexpr int MOE_ROWS = 23552;
constexpr int NT = 512;
constexpr int LDS_BYTES = 147456;

constexpr size_t MiB = 1u << 20;
constexpr size_t WS_CTL = 0;
constexpr size_t WS_MODV = 1 * MiB;
constexpr size_t WS_ROPE = 2 * MiB;
constexpr size_t WS_MOEM = 3 * MiB;
constexpr size_t WS_DT = 4 * MiB;
constexpr size_t WS_HKC = 5 * MiB;
constexpr size_t WS_XC = 6 * MiB;
constexpr size_t WS_WIN = 10 * MiB;
constexpr size_t WS_WOUT = 15 * MiB;
constexpr size_t WS_WGU = 17 * MiB;
constexpr size_t WS_WD = 33 * MiB;
constexpr size_t WS_HK = 41 * MiB;
constexpr size_t WS_H = 57 * MiB;
constexpr size_t WS_QK = 91 * MiB;
constexpr size_t WS_VZ = 108 * MiB;
constexpr size_t WS_XBC = 125 * MiB;
constexpr size_t WS_HY = WS_XBC + (size_t)MTOK * 768 * 2;
constexpr size_t WS_HYT = WS_HY + (size_t)MTOK * 768 * 2;
constexpr size_t WS_ST = WS_HYT + (size_t)MTOK * 768 * 2;
constexpr size_t WS_Y = WS_ST + (size_t)4 * 34 * 2 * 6 * 4096 * 4;
constexpr size_t WS_END = WS_Y + (size_t)MTOK * 384 * 4;
constexpr size_t WS_DEC = WS_DT + 900 * 1024;
constexpr size_t WS_H2S = WS_QK;
constexpr size_t WS_ACT = WS_H2S + (size_t)MOE_ROWS * 1024 * 2;
static_assert(WS_END <= 256 * MiB, "ws");
static_assert(WS_ACT + (size_t)MOE_ROWS * 512 * 2 <= WS_HYT, "moe alias");

constexpr int CT_CNT = 0, CT_FILL = 32, CT_BASE = 64, CT_NT = 96, CT_TP = 128;
constexpr int CT_BAR = 4096;
constexpr int CT_CNTB = 8192;

__device__ __forceinline__ int opq_v(int v) { asm volatile("" : "+v"(v)); return v; }
__device__ __forceinline__ int opq_s(int v) { asm volatile("" : "+s"(v)); return v; }
#define TIDX opq_v((int)threadIdx.x)
#define BIDX opq_s((int)blockIdx.x)
#define GDIM opq_s((int)gridDim.x)
__device__ __forceinline__ unsigned f2bf(float f) { unsigned u = __float_as_uint(f); return (u + 0x7fffu + ((u >> 16) & 1u)) >> 16; }
__device__ __forceinline__ unsigned pk2bf(float lo, float hi) { return f2bf(lo) | (f2bf(hi) << 16); }
__device__ __forceinline__ float bf2f(bf16_t h) { return __uint_as_float(((unsigned)h) << 16); }
__device__ __forceinline__ float wave_sum(float v) {
#pragma unroll
  for (int o = 1; o < 64; o <<= 1) v += __shfl_xor(v, o);
  return v;
}
__device__ __forceinline__ float siluf(float v) { return v / (1.0f + __expf(-v)); }
__device__ __forceinline__ float* xrow(const float* xl, const float* xc, int r) {
  const int b = r / TPB, j = r - b * TPB;
  return (float*)(j < CTXL ? xc + ((size_t)b * CTXL + j) * DM : xl + ((size_t)b * SEQ + (j - CTXL)) * DM);
}
__device__ __forceinline__ int mrow_of(int r) { const int b = r / TPB, j = r - b * TPB; return j < CTXL ? 4 : b; }

__device__ __forceinline__ void st_adaln(const float* c, const float* c_ctx, const float* w_mod, const float* b_mod, float* modv, char* lds) {
  float (*sc)[1024] = (float (*)[1024])lds;
  float (*red)[5][64] = (float (*)[5][64])(lds + 5 * 1024 * 4);
  const int tid = TIDX;
  for (int it = BIDX; it < 192; it += GDIM) {
    const int layer = it / 96, n0 = (it % 96) * 64;
    for (int i = tid; i < 5 * 1024; i += NT) { const int r = i >> 10, k = i & 1023; const float v = r < 4 ? c[r * 1024 + k] : c_ctx[k]; sc[r][k] = v / (1.0f + expf(-v)); }
    __syncthreads();
    const int kg = tid >> 6, n = tid & 63;
    float acc[5] = {0.f, 0.f, 0.f, 0.f, 0.f};
#pragma unroll 16
    for (int k = kg; k < 1024; k += 8) { const float w = w_mod[((size_t)layer * 1024 + k) * 6144 + n0 + n];
#pragma unroll
      for (int r = 0; r < 5; ++r) acc[r] += sc[r][k] * w; }
#pragma unroll
    for (int r = 0; r < 5; ++r) red[kg][r][n] = acc[r];
    __syncthreads();
    if (tid < 320) { const int r = tid >> 6, nn = tid & 63; float s = 0.f;
#pragma unroll
      for (int g = 0; g < 8; ++g) s += red[g][r][nn];
      modv[((size_t)layer * 5 + r) * 6144 + n0 + nn] = s + b_mod[layer * 6144 + n0 + nn]; }
    __syncthreads();
  }
}
__device__ __forceinline__ void st_rope(float* rope) {
  for (int i = BIDX * NT + TIDX; i < 4096 * 32; i += GDIM * NT) {
    const int t = i >> 5, d = i & 31, m = d & 15;
    const float inv = exp2f(-(float)(2 * m) * (13.287712379549449f / 32.0f));
    const float pos = (float)(d < 16 ? (t >> 6) : (t & 63));
    float rev = pos * inv * 0.15915494309189535f; rev -= floorf(rev);
    rope[2 * i] = __builtin_amdgcn_cosf(rev); rope[2 * i + 1] = __builtin_amdgcn_sinf(rev);
  }
}

__device__ __forceinline__ void st_normmod(const float* xl, const float* xc, bf16_t* XB, const bf16_t* YS, const int* tok_slot, const float* gate_prev,
                                           const float* g, const float* modv_layer, int off_sh, int off_sc, bf16_t* H, char* lds) {
  float* mA = (float*)lds; float* mB = mA + 5 * 1024; float* mG = mB + 5 * 1024;
  const int tid = TIDX, lane = tid & 63, gw = BIDX * 8 + (tid >> 6), ngw = GDIM * 8;
  for (int idx = tid; idx < 5 * 1024; idx += NT) { const int m = idx >> 10, k = idx & 1023; mA[idx] = g[k] * (1.f + modv_layer[(size_t)m * 6144 + off_sc + k]); mB[idx] = modv_layer[(size_t)m * 6144 + off_sh + k];
    mG[idx] = YS ? gate_prev[(size_t)m * 6144 + k] : 0.f; }
  __syncthreads();
  for (int rb = gw; rb < MTOK; rb += 3 * ngw) {
    f32x4 v[3][4]; float rstd[3];
    if (!YS) {
#pragma unroll
      for (int u = 0; u < 3; ++u) { const int r = rb + u * ngw, rc = r < MTOK ? r : MTOK - 1; const float* xr = xrow(xl, xc, rc);
#pragma unroll
        for (int j = 0; j < 4; ++j) v[u][j] = *(const f32x4*)(xr + 4 * lane + 256 * j); }
    } else {
      u32x2 xb[3][4], ys[3][4];
#pragma unroll
      for (int u = 0; u < 3; ++u) { const int r = rb + u * ngw, rc = r < MTOK ? r : MTOK - 1; const bf16_t* xr = XB + (size_t)rc * DM; const bf16_t* yr = YS + (size_t)tok_slot[rc] * DM;
#pragma unroll
        for (int j = 0; j < 4; ++j) { xb[u][j] = *(const u32x2*)(xr + 4 * lane + 256 * j); ys[u][j] = *(const u32x2*)(yr + 4 * lane + 256 * j); } }
#pragma unroll
      for (int u = 0; u < 3; ++u) { const int r = rb + u * ngw, rc = r < MTOK ? r : MTOK - 1; const int mo = mrow_of(rc) * 1024;
#pragma unroll
        for (int j = 0; j < 4; ++j) { const int k = 4 * lane + 256 * j; const f32x4 g4 = *(const f32x4*)(mG + mo + k);
          const f32x4 x4 = (f32x4){__uint_as_float(xb[u][j].x << 16), __uint_as_float(xb[u][j].x & 0xffff0000u), __uint_as_float(xb[u][j].y << 16), __uint_as_float(xb[u][j].y & 0xffff0000u)};
          const f32x4 m4 = (f32x4){__uint_as_float(ys[u][j].x << 16), __uint_as_float(ys[u][j].x & 0xffff0000u), __uint_as_float(ys[u][j].y << 16), __uint_as_float(ys[u][j].y & 0xffff0000u)};
          v[u][j] = x4 + g4 * m4;
          if (r < MTOK) { u32x2 w; w.x = pk2bf(v[u][j].x, v[u][j].y); w.y = pk2bf(v[u][j].z, v[u][j].w); *(u32x2*)(XB + (size_t)r * DM + k) = w; } } }
    }
#pragma unroll
    for (int u = 0; u < 3; ++u) { float ss = 0.f;
#pragma unroll
      for (int j = 0; j < 4; ++j) ss += v[u][j].x * v[u][j].x + v[u][j].y * v[u][j].y + v[u][j].z * v[u][j].z + v[u][j].w * v[u][j].w;
      rstd[u] = rsqrtf(wave_sum(ss) * (1.0f / DM) + EPS); }
#pragma unroll
    for (int u = 0; u < 3; ++u) { const int r = rb + u * ngw;
      if (r < MTOK) { const int mo = mrow_of(r) * 1024;
#pragma unroll
        for (int j = 0; j < 4; ++j) { const int k = 4 * lane + 256 * j;
          const f32x4 a4 = *(const f32x4*)(mA + mo + k), b4 = *(const f32x4*)(mB + mo + k); const f32x4 o = v[u][j] * rstd[u] * a4 + b4;
          u32x2 w; w.x = pk2bf(o.x, o.y); w.y = pk2bf(o.z, o.w);
          *(u32x2*)(H + (size_t)r * DM + k) = w; } } }
  }
  __syncthreads();
}

template <int MODE> __device__ __forceinline__ void tr_wave_item(const float* src, const float* src2, int ldsrc, int K, bf16_t* out, int n0, int k0, float* scr, int lane) {
  const int nn = lane & 31, n = n0 + nn;
#pragma unroll 8
  for (int i = 0; i < 32; ++i) { const int kk = 2 * i + (lane >> 5); float v = 0.f;
    if (MODE == 0) { const int col = n < 1676 ? n : (n < 1792 ? -1 : n - 116); if (col >= 0) v = src[(size_t)(k0 + kk) * ldsrc + col]; }
    else if (MODE == 1) v = src[(size_t)(k0 + kk) * ldsrc + n];
    else v = (n & 1) ? src2[(size_t)(k0 + kk) * ldsrc + (n >> 1)] : src[(size_t)(k0 + kk) * ldsrc + (n >> 1)];
    scr[kk * 33 + nn] = v; }
  asm volatile("s_waitcnt lgkmcnt(0)" ::: "memory");
  const int c = lane & 7;
#pragma unroll
  for (int j = 0; j < 4; ++j) { const int nr = (lane >> 3) + 8 * j; const float* sp = scr + (8 * c) * 33 + nr;
    u32x4 o; o.x = f2bf(sp[0]) | (f2bf(sp[33]) << 16); o.y = f2bf(sp[66]) | (f2bf(sp[99]) << 16); o.z = f2bf(sp[132]) | (f2bf(sp[165]) << 16); o.w = f2bf(sp[198]) | (f2bf(sp[231]) << 16);
    *(u32x4*)(out + (size_t)(n0 + nr) * K + k0 + 8 * c) = o; }
  asm volatile("s_waitcnt lgkmcnt(0)" ::: "memory");
}
__device__ __forceinline__ void st_weights(const float* w_in, const float* w_out, const float* w_gate, const float* w_up, const float* w_down, int layer,
                                           bf16_t* WIN, bf16_t* WOUT, bf16_t* WGU, bf16_t* WD, char* lds) {
  const int tid = TIDX, lane = tid & 63, w = tid >> 6; float* scr = (float*)lds + w * (64 * 33);
  for (int it = BIDX * 8 + w; it < 7936; it += GDIM * 8) {
    if (it < 1280) tr_wave_item<0>(w_in + (size_t)layer * 1024 * DIN, nullptr, DIN, 1024, WIN, (it % 80) * 32, (it / 80) * 64, scr, lane);
    else if (it < 1792) { const int i2 = it - 1280; tr_wave_item<1>(w_out + (size_t)layer * 1024 * 1024, nullptr, 1024, 1024, WOUT, (i2 & 31) * 32, (i2 >> 5) * 64, scr, lane); }
    else if (it < 5888) { const int i2 = it - 1792, e = i2 >> 8, t = i2 & 255;
      tr_wave_item<2>(w_gate + ((size_t)layer * 16 + e) * 1024 * 256, w_up + ((size_t)layer * 16 + e) * 1024 * 256, 256, 1024, WGU + (size_t)e * 512 * 1024, (t & 15) * 32, (t >> 4) * 64, scr, lane); }
    else { const int i2 = it - 5888, e = i2 >> 7, t = i2 & 127;
      tr_wave_item<1>(w_down + ((size_t)layer * 16 + e) * 256 * 1024, nullptr, 1024, 256, WD + (size_t)e * 1024 * 256, (t & 31) * 32, (t >> 5) * 64, scr, lane); }
  }
  __syncthreads();
}

__device__ __forceinline__ void pair_experts(int pidx, int& eA, int& eB) {
  const int g = pidx / 6, t = pidx - 6 * g; const int i = t < 3 ? 0 : (t < 5 ? 1 : 2); const int j = t < 3 ? t + 1 : (t < 5 ? t - 1 : 3);
  eA = 4 * g + i; eB = 4 * g + j;
}
__device__ __forceinline__ void st_prep_qk(bf16_t* QK, const float* qn, const float* kn, const float* rope) {
  const int lane = TIDX & 63, gw = BIDX * 8 + (TIDX >> 6), ngw = GDIM * 8, hh = lane >> 3, sub = lane & 7;
  float gn[8];
#pragma unroll
  for (int e = 0; e < 8; ++e) gn[e] = ((hh < 6 ? qn : kn) + sub * 8)[e] * (hh < 6 ? C2 : 1.0f);
  for (int rb = gw; rb < MTOK; rb += 3 * ngw) {
    bf16x8 raw[3]; f32x4 rp4[3][4];
#pragma unroll
    for (int u = 0; u < 3; ++u) { const int r = rb + u * ngw < MTOK ? rb + u * ngw : MTOK - 1; const int j = r % TPB, t = j >= CTXL ? j - CTXL : 0;
      raw[u] = *(const bf16x8*)(QK + (size_t)r * 512 + hh * 64 + sub * 8);
      const float* rp = rope + ((size_t)t * 32 + (sub & 3) * 8) * 2;
#pragma unroll
      for (int q = 0; q < 4; ++q) rp4[u][q] = *(const f32x4*)(rp + 4 * q); }
#pragma unroll
    for (int u = 0; u < 3; ++u) { const int r = rb + u * ngw; const int j = (r < MTOK ? r : MTOK - 1) % TPB;
      float v[8]; float ss = 0.f;
#pragma unroll
      for (int e = 0; e < 8; ++e) { v[e] = bf2f((bf16_t)raw[u][e]); ss += v[e] * v[e]; }
      ss += __shfl_xor(ss, 1); ss += __shfl_xor(ss, 2); ss += __shfl_xor(ss, 4);
      const float rstd = rsqrtf(ss * (1.0f / 64.0f) + EPS);
#pragma unroll
      for (int e = 0; e < 8; ++e) v[e] = v[e] * rstd * gn[e];
      if (j >= CTXL) {
#pragma unroll
        for (int e = 0; e < 8; ++e) { const float other = __shfl_xor(v[e], 4); const float cs = rp4[u][e >> 1][(e & 1) * 2], sn = rp4[u][e >> 1][(e & 1) * 2 + 1]; v[e] = sub < 4 ? v[e] * cs - other * sn : v[e] * cs + other * sn; } }
      if (r < MTOK) *(u32x4*)(QK + (size_t)r * 512 + hh * 64 + sub * 8) = (u32x4){pk2bf(v[0], v[1]), pk2bf(v[2], v[3]), pk2bf(v[4], v[5]), pk2bf(v[6], v[7])}; }
  }
}

__device__ __forceinline__ void st_prep_hy(const bf16_t* HY, const float* cw, const float* cb, bf16_t* HYT, int do_ctx, char* lds) {
  const int tid = TIDX, lane = tid & 63, w = tid >> 6; float* tile = (float*)lds + w * (66 * 33);
  const int nlat = 4 * 64 * 24, nitem = nlat + (do_ctx ? 4 * 4 * 24 : 0), step = (GDIM - 48) * 8;
  bf16x8 raw[5];
#define PHY_DECODE(it) int b, tt, ct, L, joff; bf16_t* outb; \
    if ((it) < nlat) { b = (it) / 1536; tt = ((it) % 1536) / 24; ct = (it) % 24; L = SEQ; joff = CTXL; outb = HYT + (size_t)b * 768 * SEQ; } \
    else { const int i2 = (it) - nlat; b = i2 / 96; tt = (i2 % 96) / 24; ct = i2 % 24; L = CTXL; joff = 0; outb = HYT + (size_t)4 * 768 * SEQ + (size_t)b * 768 * CTXL; } \
    const int t0 = tt * 64, c0 = ct * 32; (void)outb;
#define PHY_LOADS(it) do { PHY_DECODE(it) _Pragma("unroll") for (int i = 0; i < 5; ++i) { const int rr = (lane >> 2) + 16 * i, c8 = (lane & 3) * 8; int t = t0 - 1 + rr; const bool ok = rr < 66 && t >= 0 && t < L; t = ok ? t : t0; \
      const bf16x8 v = *(const bf16x8*)(HY + ((size_t)b * TPB + joff + t) * 768 + c0 + c8); raw[i] = ok ? v : (bf16x8){0, 0, 0, 0, 0, 0, 0, 0}; } } while (0)
  int it = BIDX >= 48 ? (BIDX - 48) * 8 + w : nitem;
  if (it < nitem) PHY_LOADS(it);
  for (; it < nitem; it += step) {
    PHY_DECODE(it)
#pragma unroll
    for (int i = 0; i < 5; ++i) { const int rr = (lane >> 2) + 16 * i, c8 = (lane & 3) * 8;
      if (rr < 66) {
#pragma unroll
        for (int e = 0; e < 8; ++e) tile[rr * 33 + c8 + e] = bf2f((bf16_t)raw[i][e]); } }
    asm volatile("s_waitcnt lgkmcnt(0)" ::: "memory");
    if (it + step < nitem) PHY_LOADS(it + step);
#pragma unroll 4
    for (int cc = 0; cc < 32; ++cc) { const int c = c0 + cc;
      const float v = cw[c] * tile[lane * 33 + cc] + cw[768 + c] * tile[(lane + 1) * 33 + cc] + cw[1536 + c] * tile[(lane + 2) * 33 + cc] + cb[c];
      outb[(size_t)c * L + t0 + lane] = (bf16_t)f2bf(v); }
    asm volatile("s_waitcnt lgkmcnt(0)" ::: "memory");
  }
#undef PHY_LOADS
#undef PHY_DECODE
  __syncthreads();
}

template <int L> __device__ __forceinline__ void hyfilt_item(int item, const float* w1, const float* b1, const float* fr, const float* w2, const float* b2, const float* w3, float* HK, char* lds) {
  float* F = (float*)lds; float* W1 = F + 64 * 37; float* H1 = W1 + 36 * 68; float* W2 = H1 + 64 * 68; float* S1 = W2 + 64 * 68;
  const int tid = TIDX, n0 = (item >> 2) * 64, cq = item & 3, lane = tid & 63, wv = tid >> 6, l15 = lane & 15, l4 = lane >> 4;
  for (int e = tid; e < 64 * 36; e += NT) { const int pp = e / 36, f = e % 36; const int n = n0 + pp; float v = 0.f;
    if (f == 0) v = (float)n / (float)(L - 1);
    else if (f < 33) { const int m = (f - 1) & 15; const float band = 1e-4f + (float)m * ((15.0f - 1e-4f) / 15.0f); float rev = ((float)n * (1.0f / (float)L)) * band; rev -= floorf(rev);
      v = f <= 16 ? __builtin_amdgcn_cosf(rev) : -__builtin_amdgcn_sinf(rev); }
    F[pp * 37 + f] = v; }
  for (int e = tid; e < 36 * 64; e += NT) { const int k = e >> 6, j = e & 63; W1[k * 68 + j] = k < 33 ? w1[k * 64 + j] : 0.f; }
  for (int e = tid; e < 64 * 64; e += NT) { const int k = e >> 6, j = e & 63; W2[k * 68 + j] = w2[e]; }
  __syncthreads();
  { const int pt = wv >> 1, c0 = 32 * (wv & 1);
    f32x4 acc[2] = {(f32x4){0.f, 0.f, 0.f, 0.f}, (f32x4){0.f, 0.f, 0.f, 0.f}};
#pragma unroll
    for (int kk = 0; kk < 9; ++kk) { const float av = F[(pt * 16 + l15) * 37 + 4 * kk + l4];
      acc[0] = __builtin_amdgcn_mfma_f32_16x16x4f32(av, W1[(4 * kk + l4) * 68 + c0 + l15], acc[0], 0, 0, 0);
      acc[1] = __builtin_amdgcn_mfma_f32_16x16x4f32(av, W1[(4 * kk + l4) * 68 + c0 + 16 + l15], acc[1], 0, 0, 0); }
#pragma unroll
    for (int ct = 0; ct < 2; ++ct) { const int j = c0 + 16 * ct + l15; const float bj = b1[j], fj = fr[j] * 0.15915494309189535f;
#pragma unroll
      for (int rg = 0; rg < 4; ++rg) { float rev = fj * (acc[ct][rg] + bj); rev -= floorf(rev); H1[(pt * 16 + 4 * l4 + rg) * 68 + j] = __builtin_amdgcn_sinf(rev); } } }
  __syncthreads();
  { const int pt = wv >> 1, c0 = 32 * (wv & 1);
    f32x4 acc[2] = {(f32x4){0.f, 0.f, 0.f, 0.f}, (f32x4){0.f, 0.f, 0.f, 0.f}};
#pragma unroll
    for (int kk = 0; kk < 16; ++kk) { const float av = H1[(pt * 16 + l15) * 68 + 4 * kk + l4];
      acc[0] = __builtin_amdgcn_mfma_f32_16x16x4f32(av, W2[(4 * kk + l4) * 68 + c0 + l15], acc[0], 0, 0, 0);
      acc[1] = __builtin_amdgcn_mfma_f32_16x16x4f32(av, W2[(4 * kk + l4) * 68 + c0 + 16 + l15], acc[1], 0, 0, 0); }
#pragma unroll
    for (int ct = 0; ct < 2; ++ct) { const int j = c0 + 16 * ct + l15; const float bj = b2[j], fj = fr[j] * 0.15915494309189535f;
#pragma unroll
      for (int rg = 0; rg < 4; ++rg) { float rev = fj * (acc[ct][rg] + bj); rev -= floorf(rev); S1[(pt * 16 + 4 * l4 + rg) * 68 + j] = __builtin_amdgcn_sinf(rev); } } }
  __syncthreads();
  {
    const int colb = cq * 256 + 32 * wv;
    f32x4 acc[4][2];
#pragma unroll
    for (int pt = 0; pt < 4; ++pt) { acc[pt][0] = (f32x4){0.f, 0.f, 0.f, 0.f}; acc[pt][1] = (f32x4){0.f, 0.f, 0.f, 0.f}; }
#pragma unroll 4
    for (int kk = 0; kk < 16; ++kk) { const int k = 4 * kk + l4;
      const float bv0 = w3[k * 1024 + colb + l15], bv1 = w3[k * 1024 + colb + 16 + l15];
#pragma unroll
      for (int pt = 0; pt < 4; ++pt) { const float av = S1[(pt * 16 + l15) * 68 + k];
        acc[pt][0] = __builtin_amdgcn_mfma_f32_16x16x4f32(av, bv0, acc[pt][0], 0, 0, 0);
        acc[pt][1] = __builtin_amdgcn_mfma_f32_16x16x4f32(av, bv1, acc[pt][1], 0, 0, 0); } }
#pragma unroll
    for (int ct = 0; ct < 2; ++ct) { const int col = colb + 16 * ct + l15, dir = col >> 9, order = (col >> 8) & 1, c = col & 255;
      const float delta = 3.0701134573253943f + (float)c * ((15.350567286626972f - 3.0701134573253943f) / 255.0f);
      float* dst = HK + ((size_t)order * 256 + c) * (2 * L);
#pragma unroll
      for (int pt = 0; pt < 4; ++pt) { const int nb = n0 + pt * 16 + 4 * l4; f32x4 o;
#pragma unroll
        for (int rg = 0; rg < 4; ++rg) o[rg] = acc[pt][ct][rg] * __expf(-((float)(nb + rg) / (float)(L - 1)) * delta);
        if (dir == 0) *(f32x4*)(dst + nb) = o;
        else {
#pragma unroll
          for (int rg = 0; rg < 4; ++rg) { const int n = nb + rg; if (n >= 1) dst[2 * L - n] = o[rg]; else dst[L] = 0.f; } } } }
  }
  __syncthreads();
}

__device__ __forceinline__ void hyconv_ctx_item(int item, const bf16_t* HYTC, const float* HKC, const float* hy_bias, bf16_t* MIX, char* lds) {
  constexpr int L = CTXL;
  const int tid = TIDX, b = item >> 4, cc = tid >> 5, c = (item & 15) * 16 + cc, sub = tid & 31, tb = 8 * sub;
  float* kern = (float*)lds + cc * (2 * L); float* z = (float*)lds + 16 * 2 * L + cc * L;
  const bf16_t* vp = HYTC + ((size_t)b * 768 + c) * L; const bf16_t* x1p = vp + (size_t)256 * L; const bf16_t* x2p = vp + (size_t)512 * L;
#pragma unroll 1
  for (int o = 0; o < 2; ++o) {
    if (o == 0) for (int t = sub; t < L; t += 32) z[t] = bf2f(vp[t]);
    const float* kp = HKC + ((size_t)o * 256 + c) * (2 * L);
    for (int t = sub; t < 2 * L; t += 32) kern[t] = kp[t];
    __syncthreads();
    float acc[8], W[16];
#pragma unroll
    for (int i = 0; i < 8; ++i) { acc[i] = 0.f; W[8 + i] = kern[(tb + i) & (2 * L - 1)]; }
    for (int s0 = 0; s0 < L; s0 += 8) {
      const int bb = (tb - s0 - 8) & (2 * L - 1);
#pragma unroll
      for (int i = 0; i < 8; ++i) W[i] = kern[bb + i];
      float zs[8];
#pragma unroll
      for (int j = 0; j < 8; ++j) zs[j] = z[s0 + j];
#pragma unroll
      for (int j = 0; j < 8; ++j)
#pragma unroll
        for (int i = 0; i < 8; ++i) acc[i] += W[8 + i - j] * zs[j];
#pragma unroll
      for (int i = 0; i < 8; ++i) W[8 + i] = W[i];
    }
    __syncthreads();
    const float bias = hy_bias[o * 256 + c];
#pragma unroll
    for (int i = 0; i < 8; ++i) { const int t = tb + i; const float zz = acc[i] + bias * z[t];
      if (o == 0) z[t] = bf2f(x1p[t]) * zz;
      else MIX[((size_t)b * TPB + t) * DM + 768 + c] = (bf16_t)f2bf(bf2f(x2p[t]) * zz); }
    __syncthreads();
  }
}

__device__ __forceinline__ void ssd_conv8(const bf16_t* XBC, size_t r, int c0, bool hasp, bool hasn, const float* cw, const float* cb, float (&o)[8]) {
  const bf16x8 cur = *(const bf16x8*)(XBC + r * 768 + c0);
  const bf16x8 prv = *(const bf16x8*)(XBC + (hasp ? r - 1 : r) * 768 + c0), nxt = *(const bf16x8*)(XBC + (hasn ? r + 1 : r) * 768 + c0);
  const float wp = hasp ? 1.f : 0.f, wn = hasn ? 1.f : 0.f;
#pragma unroll
  for (int e = 0; e < 8; ++e) { const float v = wp * cw[c0 + e] * bf2f((bf16_t)prv[e]) + cw[640 + c0 + e] * bf2f((bf16_t)cur[e]) + wn * cw[1280 + c0 + e] * bf2f((bf16_t)nxt[e]) + cb[c0 + e]; o[e] = siluf(v); }
}
__device__ __forceinline__ float softplusf(float x) {
  const float y = __expf(-fabsf(x)); const float l = y < 0.06f ? y * (1.f - y * (0.5f - y * (0.33333334f - 0.25f * y))) : __logf(1.f + y); return fmaxf(x, 0.f) + l; }
__device__ __forceinline__ void wave_scan128(float e0, float e1, int lane, float& c0, float& c1) {
  float x = e0 + e1;
#pragma unroll
  for (int o = 1; o < 64; o <<= 1) { const float v = __shfl_up(x, o); if (lane >= o) x += v; }
  const float excl = x - (e0 + e1); c0 = excl + e0; c1 = excl + e0 + e1;
}
__device__ __forceinline__ int ssd_chunk_j0(int cidx) { return cidx < 2 ? cidx * 128 : CTXL + (cidx - 2) * 128; }

__device__ __forceinline__ void st_ssd1(int it0, int step, int nitems, const bf16_t* XBC, const float* DT, const float* cw, const float* cb, const float* dt_bias, const float* a_log,
                                        float* YIN, float* ST, float* DEC, char* lds) {
  bf16_t (*Cm)[72] = (bf16_t (*)[72])lds; bf16_t (*Bm)[72] = (bf16_t (*)[72])(lds + 18432);
  bf16_t (*BT)[136] = (bf16_t (*)[136])(lds + 36864); bf16_t (*Xt)[136] = (bf16_t (*)[136])(lds + 54272); bf16_t (*Mm)[136] = (bf16_t (*)[136])(lds + 71680);
  float* tab = (float*)(lds + 106496); float* dtf = tab; float* dtb = tab + 128; float* acf = tab + 256; float* acb = tab + 384; float* wf = tab + 512; float* wb = tab + 640;
  const int tid = TIDX;
  bf16x8 cu[6], pv[6], nx[6];
#define SSD1_LOADS(itm, I0, I1) do { const int h_ = (itm) % 6, bc_ = (itm) / 6, cidx_ = bc_ % 34, b_ = bc_ / 34, g_ = h_ / 3, j0_ = ssd_chunk_j0(cidx_); const size_t r0_ = (size_t)b_ * TPB + j0_; \
    _Pragma("unroll") for (int i = (I0); i < (I1); ++i) { const int task = tid + NT * i, t = task / 24, cg = task % 24, kind = cg >> 3, q = cg & 7, j = j0_ + t; \
      const int c0 = kind == 0 ? h_ * 64 + 8 * q : (kind == 1 ? 384 + g_ * 64 + 8 * q : 512 + g_ * 64 + 8 * q); \
      const bool hasp = j != 0 && j != CTXL, hasn = j != CTXL - 1 && j != TPB - 1; const bf16_t* p = XBC + (r0_ + t) * 768 + c0; \
      cu[i] = *(const bf16x8*)p; pv[i] = *(const bf16x8*)(p + (hasp ? -768 : 0)); nx[i] = *(const bf16x8*)(p + (hasn ? 768 : 0)); } } while (0)
  if (it0 < nitems) SSD1_LOADS(it0, 0, 6);
#pragma unroll 1
  for (int item = it0; item < nitems; item += step) {
  const int tid = TIDX, lane = tid & 63, w = tid >> 6, l15 = lane & 15, l4 = lane >> 4;
  const int h = item % 6, bc = item / 6, cidx = bc % 34, b = bc / 34, g = h / 3, j0 = ssd_chunk_j0(cidx);
  const size_t r0 = (size_t)b * TPB + j0;
  float dtr0 = 0.f, dtr1 = 0.f;
  if (w < 2) { const int t0 = w == 0 ? 2 * lane : 127 - 2 * lane, t1 = w == 0 ? 2 * lane + 1 : 126 - 2 * lane; dtr0 = DT[(r0 + t0) * 12 + w * 6 + h]; dtr1 = DT[(r0 + t1) * 12 + w * 6 + h]; }
  SSD1_LOADS(item, 6, 6);
  {
#pragma unroll
    for (int i = 0; i < 6; ++i) { const int task = tid + NT * i, t = task / 24, cg = task % 24, kind = cg >> 3, q = cg & 7, j = j0 + t;
      const int c0 = kind == 0 ? h * 64 + 8 * q : (kind == 1 ? 384 + g * 64 + 8 * q : 512 + g * 64 + 8 * q);
      const float wp = (j != 0 && j != CTXL) ? 1.f : 0.f, wn = (j != CTXL - 1 && j != TPB - 1) ? 1.f : 0.f;
      float o[8];
#pragma unroll
      for (int e = 0; e < 8; ++e) o[e] = siluf(wp * cw[c0 + e] * bf2f((bf16_t)pv[i][e]) + cw[640 + c0 + e] * bf2f((bf16_t)cu[i][e]) + wn * cw[1280 + c0 + e] * bf2f((bf16_t)nx[i][e]) + cb[c0 + e]);
      if (kind == 0) {
#pragma unroll
        for (int e = 0; e < 8; ++e) Xt[8 * q + e][t] = (bf16_t)f2bf(o[e]);
      } else { const u32x4 pk = (u32x4){pk2bf(o[0], o[1]), pk2bf(o[2], o[3]), pk2bf(o[4], o[5]), pk2bf(o[6], o[7])};
        if (kind == 1) { *(u32x4*)&Bm[t][8 * q] = pk;
#pragma unroll
          for (int e = 0; e < 8; ++e) BT[8 * q + e][t] = (bf16_t)f2bf(o[e]); }
        else *(u32x4*)&Cm[t][8 * q] = pk; } }
  }
  if (w < 2) { const int dir = w; const float a = -expf(a_log[dir * 6 + h]), bias = dt_bias[dir * 6 + h];
    const int t0 = dir == 0 ? 2 * lane : 127 - 2 * lane, t1 = dir == 0 ? 2 * lane + 1 : 126 - 2 * lane;
    const float d0 = softplusf(dtr0 + bias), d1 = softplusf(dtr1 + bias);
    float c0, c1; wave_scan128(d0 * a, d1 * a, lane, c0, c1);
    const float tot = __shfl(c1, 63);
    float* dtt = dir == 0 ? dtf : dtb; float* ac = dir == 0 ? acf : acb; float* ww = dir == 0 ? wf : wb;
    dtt[t0] = d0; dtt[t1] = d1; ac[t0] = c0; ac[t1] = c1; ww[t0] = __expf(tot - c0) * d0; ww[t1] = __expf(tot - c1) * d1;
    if (lane == 0) DEC[(((size_t)b * 34 + cidx) * 2 + dir) * 6 + h] = __expf(tot); }
  __syncthreads();
  if (item + step < nitems) SSD1_LOADS(item + step, 0, 6);
  {
    f32x4 accG[8];
#pragma unroll
    for (int ni = 0; ni < 8; ++ni) accG[ni] = (f32x4){0.f, 0.f, 0.f, 0.f};
#pragma unroll
    for (int kk = 0; kk < 2; ++kk) { const bf16x8 a = *(const bf16x8*)&Cm[16 * w + l15][32 * kk + 8 * l4];
#pragma unroll
      for (int ni = 0; ni < 8; ++ni) { const bf16x8 bb = *(const bf16x8*)&Bm[16 * ni + l15][32 * kk + 8 * l4]; accG[ni] = __builtin_amdgcn_mfma_f32_16x16x32_bf16(a, bb, accG[ni], 0, 0, 0); } }
    float aft[4], abt[4];
#pragma unroll
    for (int rg = 0; rg < 4; ++rg) { aft[rg] = acf[16 * w + 4 * l4 + rg]; abt[rg] = acb[16 * w + 4 * l4 + rg]; }
#pragma unroll
    for (int ni = 0; ni < 8; ++ni) { const int sidx = 16 * ni + l15; const float afs = acf[sidx], abs_ = acb[sidx], dfs = dtf[sidx], dbs = dtb[sidx];
#pragma unroll
      for (int rg = 0; rg < 4; ++rg) { const int t = 16 * w + 4 * l4 + rg;
        const float f = sidx <= t ? __expf(aft[rg] - afs) * dfs : 0.f, bk = sidx >= t ? __expf(abt[rg] - abs_) * dbs : 0.f;
        Mm[t][sidx] = (bf16_t)f2bf(accG[ni][rg] * (f + bk)); } }
  }
  __syncthreads();
  {
    f32x4 acc[4];
#pragma unroll
    for (int ni = 0; ni < 4; ++ni) acc[ni] = (f32x4){0.f, 0.f, 0.f, 0.f};
#pragma unroll
    for (int kk = 0; kk < 4; ++kk) { const bf16x8 a = *(const bf16x8*)&Mm[16 * w + l15][32 * kk + 8 * l4];
#pragma unroll
      for (int ni = 0; ni < 4; ++ni) { const bf16x8 bb = *(const bf16x8*)&Xt[16 * ni + l15][32 * kk + 8 * l4]; acc[ni] = __builtin_amdgcn_mfma_f32_16x16x32_bf16(a, bb, acc[ni], 0, 0, 0); } }
#pragma unroll
    for (int rg = 0; rg < 4; ++rg)
#pragma unroll
      for (int ni = 0; ni < 4; ++ni) YIN[(r0 + 16 * w + 4 * l4 + rg) * 384 + h * 64 + 16 * ni + l15] = acc[ni][rg];
  }
  {
    const int dir = w >> 2, mt = w & 3; const float* ww = dir == 0 ? wf : wb;
    f32x4 acc[4];
#pragma unroll
    for (int ni = 0; ni < 4; ++ni) acc[ni] = (f32x4){0.f, 0.f, 0.f, 0.f};
#pragma unroll
    for (int kk = 0; kk < 4; ++kk) { const bf16x8 raw = *(const bf16x8*)&Xt[16 * mt + l15][32 * kk + 8 * l4];
      const f32x4 w0 = *(const f32x4*)(ww + 32 * kk + 8 * l4), w1 = *(const f32x4*)(ww + 32 * kk + 8 * l4 + 4);
      u32x4 pk; pk.x = pk2bf(bf2f((bf16_t)raw[0]) * w0.x, bf2f((bf16_t)raw[1]) * w0.y); pk.y = pk2bf(bf2f((bf16_t)raw[2]) * w0.z, bf2f((bf16_t)raw[3]) * w0.w);
      pk.z = pk2bf(bf2f((bf16_t)raw[4]) * w1.x, bf2f((bf16_t)raw[5]) * w1.y); pk.w = pk2bf(bf2f((bf16_t)raw[6]) * w1.z, bf2f((bf16_t)raw[7]) * w1.w);
      const bf16x8 a = __builtin_bit_cast(bf16x8, pk);
#pragma unroll
      for (int ni = 0; ni < 4; ++ni) { const bf16x8 bb = *(const bf16x8*)&BT[16 * ni + l15][32 * kk + 8 * l4]; acc[ni] = __builtin_amdgcn_mfma_f32_16x16x32_bf16(a, bb, acc[ni], 0, 0, 0); } }
    float* sp = ST + ((((size_t)b * 34 + cidx) * 2 + dir) * 6 + h) * 4096;
#pragma unroll
    for (int rg = 0; rg < 4; ++rg)
#pragma unroll
      for (int ni = 0; ni < 4; ++ni) sp[(16 * mt + 4 * l4 + rg) * 64 + 16 * ni + l15] = acc[ni][rg];
  }
  __syncthreads();
  }
#undef SSD1_LOADS
}

__device__ __forceinline__ void st_ssd_scan2(float* ST, const float* DEC) {
  for (int idx = BIDX * NT + TIDX; idx < 4 * 2 * 6 * 4096; idx += GDIM * NT) {
    const int e = idx & 4095, bdh = idx >> 12, h = bdh % 6, dir = (bdh / 6) & 1, b = bdh / 12;
    float v[34], d[34];
#pragma unroll
    for (int st = 0; st < 34; ++st) { const int cidx = dir == 0 ? st : (st < 2 ? 1 - st : 35 - st); const size_t o = (((size_t)b * 34 + cidx) * 2 + dir) * 6 + h; v[st] = ST[o * 4096 + e]; d[st] = DEC[o]; }
    float H = 0.f;
#pragma unroll
    for (int st = 0; st < 34; ++st) { const int cidx = dir == 0 ? st : (st < 2 ? 1 - st : 35 - st); const size_t o = (((size_t)b * 34 + cidx) * 2 + dir) * 6 + h; ST[o * 4096 + e] = H; H = H * d[st] + v[st]; }
  }
}

__device__ __forceinline__ void ssd3_item(int b, int cidx, int g, const bf16_t* XBC, const bf16_t* VZ, const float* DT, const float* cw, const float* cb, const float* dt_bias, const float* a_log,
                                          const float* dskip, const float* nw, const float* YIN, const float* ST, bf16_t* MIX, char* lds) {
  bf16_t (*Cm)[72] = (bf16_t (*)[72])lds; bf16_t (*Hm)[72] = (bf16_t (*)[72])(lds + 18432);
  float* ef = (float*)(lds + 18432 + 55296);
  float (*Yt)[196] = (float (*)[196])lds;
  const int tid = TIDX, lane = tid & 63, w = tid >> 6, l15 = lane & 15, l4 = lane >> 4, j0 = ssd_chunk_j0(cidx);
  const size_t r0 = (size_t)b * TPB + j0;
#pragma unroll
  for (int i = 0; i < 2; ++i) { const int task = tid + NT * i, t = task >> 3, q = task & 7, j = j0 + t;
    float o[8]; ssd_conv8(XBC, r0 + t, 512 + g * 64 + 8 * q, j != 0 && j != CTXL, j != CTXL - 1 && j != TPB - 1, cw, cb, o);
    *(u32x4*)&Cm[t][8 * q] = (u32x4){pk2bf(o[0], o[1]), pk2bf(o[2], o[3]), pk2bf(o[4], o[5]), pk2bf(o[6], o[7])}; }
#pragma unroll
  for (int i = 0; i < 12; ++i) { const int f4 = tid + NT * i, hd = f4 >> 10, rem = f4 & 1023, p = rem >> 4, n4 = (rem & 15) * 4, hh = hd >> 1, dir = hd & 1;
    const f32x4 v = *(const f32x4*)(ST + ((((size_t)b * 34 + cidx) * 2 + dir) * 6 + 3 * g + hh) * 4096 + p * 64 + n4);
    *(u32x2*)&Hm[hd * 64 + p][n4] = (u32x2){pk2bf(v.x, v.y), pk2bf(v.z, v.w)}; }
  if (w < 6) { const int hh = w >> 1, dir = w & 1, h = 3 * g + hh; const float a = -expf(a_log[dir * 6 + h]), bias = dt_bias[dir * 6 + h];
    const int t0 = dir == 0 ? 2 * lane : 127 - 2 * lane, t1 = dir == 0 ? 2 * lane + 1 : 126 - 2 * lane;
    const float d0 = softplusf(DT[(r0 + t0) * 12 + dir * 6 + h] + bias), d1 = softplusf(DT[(r0 + t1) * 12 + dir * 6 + h] + bias);
    float c0, c1; wave_scan128(d0 * a, d1 * a, lane, c0, c1);
    ef[w * 128 + t0] = __expf(c0); ef[w * 128 + t1] = __expf(c1); }
  __syncthreads();
  float yv[3][4][4];
  {
    bf16x8 ca[2];
#pragma unroll
    for (int kk = 0; kk < 2; ++kk) ca[kk] = *(const bf16x8*)&Cm[16 * w + l15][32 * kk + 8 * l4];
#pragma unroll
    for (int hh = 0; hh < 3; ++hh) {
      f32x4 accF[4], accB[4];
#pragma unroll
      for (int ni = 0; ni < 4; ++ni) { accF[ni] = (f32x4){0.f, 0.f, 0.f, 0.f}; accB[ni] = (f32x4){0.f, 0.f, 0.f, 0.f}; }
#pragma unroll
      for (int kk = 0; kk < 2; ++kk)
#pragma unroll
        for (int ni = 0; ni < 4; ++ni) {
          accF[ni] = __builtin_amdgcn_mfma_f32_16x16x32_bf16(ca[kk], *(const bf16x8*)&Hm[(hh * 2 + 0) * 64 + 16 * ni + l15][32 * kk + 8 * l4], accF[ni], 0, 0, 0);
          accB[ni] = __builtin_amdgcn_mfma_f32_16x16x32_bf16(ca[kk], *(const bf16x8*)&Hm[(hh * 2 + 1) * 64 + 16 * ni + l15][32 * kk + 8 * l4], accB[ni], 0, 0, 0); }
#pragma unroll
      for (int rg = 0; rg < 4; ++rg) { const int t = 16 * w + 4 * l4 + rg; const float eF = ef[(hh * 2 + 0) * 128 + t], eB = ef[(hh * 2 + 1) * 128 + t];
#pragma unroll
        for (int ni = 0; ni < 4; ++ni) yv[hh][ni][rg] = eF * accF[ni][rg] + eB * accB[ni][rg]; }
    }
  }
  __syncthreads();
#pragma unroll
  for (int hh = 0; hh < 3; ++hh)
#pragma unroll
    for (int rg = 0; rg < 4; ++rg)
#pragma unroll
      for (int ni = 0; ni < 4; ++ni) Yt[16 * w + 4 * l4 + rg][hh * 64 + 16 * ni + l15] = yv[hh][ni][rg];
  __syncthreads();
  {
    const int c4 = 4 * (lane < 48 ? lane : 47), hk = c4 >> 6; const bool lact = lane < 48;
    float cw0[4], cw1[4], cw2[4], cbv[4], nwv[4];
#pragma unroll
    for (int e = 0; e < 4; ++e) { const int col = g * 192 + c4 + e; cw0[e] = cw[col]; cw1[e] = cw[640 + col]; cw2[e] = cw[1280 + col]; cbv[e] = cb[col]; nwv[e] = nw[col]; }
    const float dsk = dskip[3 * g + hk];
#pragma unroll 1
    for (int rb = 0; rb < 16; rb += 4) {
      u32x2 xc_[4], xp_[4], xn_[4], zz_[4]; f32x4 yy_[4];
#pragma unroll
      for (int u = 0; u < 4; ++u) { const int t = 16 * w + rb + u, j = j0 + t; const size_t r = r0 + t; const bool hasp = j != 0 && j != CTXL, hasn = j != CTXL - 1 && j != TPB - 1;
        const bf16_t* xq = XBC + r * 768 + g * 192 + c4;
        xc_[u] = *(const u32x2*)xq; xp_[u] = *(const u32x2*)(xq + (hasp ? -768 : 0)); xn_[u] = *(const u32x2*)(xq + (hasn ? 768 : 0));
        yy_[u] = *(const f32x4*)(YIN + r * 384 + g * 192 + c4); zz_[u] = *(const u32x2*)(VZ + r * 512 + 128 + g * 192 + c4); }
#pragma unroll
      for (int u = 0; u < 4; ++u) { const int t = 16 * w + rb + u, j = j0 + t; const size_t r = r0 + t; const float wp = (j != 0 && j != CTXL) ? 1.f : 0.f, wn = (j != CTXL - 1 && j != TPB - 1) ? 1.f : 0.f;
        const f32x4 yt = *(const f32x4*)&Yt[t][c4];
        float gt[4]; float ss = 0.f;
#pragma unroll
        for (int e = 0; e < 4; ++e) { const unsigned sh = (e & 1) * 16; const unsigned wc_ = e < 2 ? xc_[u].x : xc_[u].y, wq_ = e < 2 ? xp_[u].x : xp_[u].y, wn_ = e < 2 ? xn_[u].x : xn_[u].y, wz_ = e < 2 ? zz_[u].x : zz_[u].y;
          float xv = cw1[e] * bf2f((bf16_t)(wc_ >> sh)) + cbv[e] + wp * cw0[e] * bf2f((bf16_t)(wq_ >> sh)) + wn * cw2[e] * bf2f((bf16_t)(wn_ >> sh));
          xv = siluf(xv);
          const float y = yy_[u][e] + yt[e] + dsk * xv;
          gt[e] = lact ? y * siluf(bf2f((bf16_t)(wz_ >> sh))) : 0.f; ss += gt[e] * gt[e]; }
        const float rstd = rsqrtf(wave_sum(ss) * (1.0f / 192.0f) + EPS);
        if (lact) { u32x2 o; o.x = pk2bf(gt[0] * rstd * nwv[0], gt[1] * rstd * nwv[1]); o.y = pk2bf(gt[2] * rstd * nwv[2], gt[3] * rstd * nwv[3]);
          *(u32x2*)(MIX + r * DM + 384 + g * 192 + c4) = o; } }
    }
  }
  __syncthreads();
}

__device__ __forceinline__ void st_router(const float* xl, const float* xc, int from_inputs, bf16_t* XB, const bf16_t* MO, const float* g, const float* modv_layer, const float* w_router, const float* rbias,
                                          bf16_t* H2, int* ctl, int* tok_pair, float* tok_w, int skip_ctx, char* lds) {
  float* wl = (float*)lds;
  const int tid = TIDX, lane = tid & 63, gw = BIDX * 8 + (tid >> 6), ngw = GDIM * 8;
  int* hist = (int*)(lds + 81920);
  if (tid < 32) hist[tid] = 0;
  float* mA = (float*)(lds + 82176); float* mB = mA + 5 * 1024; float* mG = mB + 5 * 1024;
  for (int idx = tid; idx < 5 * 1024; idx += NT) { const int m = idx >> 10, k = idx & 1023; mA[idx] = g[k] * (1.f + modv_layer[(size_t)m * 6144 + 4096 + k]); mB[idx] = modv_layer[(size_t)m * 6144 + 3072 + k]; mG[idx] = modv_layer[(size_t)m * 6144 + 2048 + k]; }
  for (int idx = tid; idx < 4096; idx += NT) { const int k = idx >> 2, e4 = idx & 3, row = ((k & 3) * 4 + (k >> 8)) * 64 + ((k & 255) >> 2);
    *(f32x4*)(wl + row * 20 + 4 * e4) = *(const f32x4*)(w_router + (size_t)k * 16 + 4 * e4); }
  __syncthreads();
  for (int rb = gw; rb < MTOK; rb += 2 * ngw) {
    int rr[2]; bool act[2]; f32x4 v[2][4]; u32x2 mo[2][4]; float rstd[2]; int mo_[2];
#pragma unroll
    for (int u = 0; u < 2; ++u) { const int r = rb + u * ngw; rr[u] = r < MTOK ? r : MTOK - 1; act[u] = r < MTOK && !(skip_ctx && (rr[u] % TPB) < CTXL); mo_[u] = mrow_of(rr[u]) * 1024;
      const bf16_t* mr = MO + (size_t)rr[u] * DM;
      if (from_inputs) { const float* xr = xrow(xl, xc, rr[u]);
#pragma unroll
        for (int j = 0; j < 4; ++j) v[u][j] = *(const f32x4*)(xr + 4 * lane + 256 * j); }
      else { const bf16_t* xr = XB + (size_t)rr[u] * DM;
#pragma unroll
        for (int j = 0; j < 4; ++j) { const u32x2 t2 = *(const u32x2*)(xr + 4 * lane + 256 * j);
          v[u][j] = (f32x4){__uint_as_float(t2.x << 16), __uint_as_float(t2.x & 0xffff0000u), __uint_as_float(t2.y << 16), __uint_as_float(t2.y & 0xffff0000u)}; } }
#pragma unroll
      for (int j = 0; j < 4; ++j) mo[u][j] = *(const u32x2*)(mr + 4 * lane + 256 * j); }
    if (!act[0] && !act[1]) continue;
#pragma unroll
    for (int u = 0; u < 2; ++u) if (act[u]) { bf16_t* xd = XB + (size_t)rr[u] * DM;
#pragma unroll
      for (int j = 0; j < 4; ++j) { const int k = 4 * lane + 256 * j; const f32x4 g4 = *(const f32x4*)(mG + mo_[u] + k);
        const f32x4 m4 = (f32x4){__uint_as_float(mo[u][j].x << 16), __uint_as_float(mo[u][j].x & 0xffff0000u), __uint_as_float(mo[u][j].y << 16), __uint_as_float(mo[u][j].y & 0xffff0000u)};
        v[u][j] = v[u][j] + g4 * m4; u32x2 w2; w2.x = pk2bf(v[u][j].x, v[u][j].y); w2.y = pk2bf(v[u][j].z, v[u][j].w); *(u32x2*)(xd + k) = w2; } }
#pragma unroll
    for (int u = 0; u < 2; ++u) { float ss = 0.f;
#pragma unroll
      for (int j = 0; j < 4; ++j) ss += v[u][j].x * v[u][j].x + v[u][j].y * v[u][j].y + v[u][j].z * v[u][j].z + v[u][j].w * v[u][j].w;
      rstd[u] = rsqrtf(wave_sum(ss) * (1.0f / DM) + EPS); }
    float lg[2][16];
#pragma unroll
    for (int u = 0; u < 2; ++u)
#pragma unroll
      for (int e = 0; e < 16; ++e) lg[u][e] = 0.f;
#pragma unroll 1
    for (int j = 0; j < 4; ++j) { const int k = 4 * lane + 256 * j; float o[2][4];
#pragma unroll
      for (int u = 0; u < 2; ++u) { const f32x4 a4 = *(const f32x4*)(mA + mo_[u] + k), b4 = *(const f32x4*)(mB + mo_[u] + k); const f32x4 o4 = v[u][j] * rstd[u] * a4 + b4;
        o[u][0] = o4.x; o[u][1] = o4.y; o[u][2] = o4.z; o[u][3] = o4.w;
        if (act[u]) { u32x2 wpk; wpk.x = pk2bf(o4.x, o4.y); wpk.y = pk2bf(o4.z, o4.w); *(u32x2*)(H2 + (size_t)rr[u] * DM + k) = wpk; } }
#pragma unroll
      for (int q = 0; q < 4; ++q) { const float* wr_ = wl + ((q * 4 + j) * 64 + lane) * 20;
#pragma unroll
        for (int e4 = 0; e4 < 4; ++e4) { const f32x4 wr = *(const f32x4*)(wr_ + 4 * e4);
#pragma unroll
          for (int u = 0; u < 2; ++u) { lg[u][4 * e4] += o[u][q] * wr.x; lg[u][4 * e4 + 1] += o[u][q] * wr.y; lg[u][4 * e4 + 2] += o[u][q] * wr.z; lg[u][4 * e4 + 3] += o[u][q] * wr.w; } } } }
    float h1[2];
#pragma unroll
    for (int u = 0; u < 2; ++u) { float h8[8], h4[4], h2[2];
#pragma unroll
      for (int i = 0; i < 8; ++i) { const bool up = (lane & 32) != 0; const float keep = up ? lg[u][8 + i] : lg[u][i], give = up ? lg[u][i] : lg[u][8 + i]; h8[i] = keep + __shfl_xor(give, 32); }
#pragma unroll
      for (int i = 0; i < 4; ++i) { const bool up = (lane & 16) != 0; const float keep = up ? h8[4 + i] : h8[i], give = up ? h8[i] : h8[4 + i]; h4[i] = keep + __shfl_xor(give, 16); }
#pragma unroll
      for (int i = 0; i < 2; ++i) { const bool up = (lane & 8) != 0; const float keep = up ? h4[2 + i] : h4[i], give = up ? h4[i] : h4[2 + i]; h2[i] = keep + __shfl_xor(give, 8); }
      { const bool up = (lane & 4) != 0; const float keep = up ? h2[1] : h2[0], give = up ? h2[0] : h2[1]; h1[u] = keep + __shfl_xor(give, 4); }
      h1[u] += __shfl_xor(h1[u], 2); h1[u] += __shfl_xor(h1[u], 1); }
    float lx[16];
#pragma unroll
    for (int e = 0; e < 16; ++e) { const int src = ((e >> 3) & 1) * 32 + ((e >> 2) & 1) * 16 + ((e >> 1) & 1) * 8 + (e & 1) * 4;
      const float a0 = __uint_as_float(__builtin_amdgcn_readlane(__float_as_uint(h1[0]), src)), a1 = __uint_as_float(__builtin_amdgcn_readlane(__float_as_uint(h1[1]), src));
      lx[e] = lane < 32 ? a0 : a1; }
    const int us = lane >> 5;
    if ((lane & 31) == 0 && (us == 0 ? act[0] : act[1])) {
      const int r = us == 0 ? rr[0] : rr[1];
      int best = 0, bi1 = 0, bi2 = 1; float bestv = -1e30f, bs1 = 0.f, bs2 = 0.f;
#pragma unroll
      for (int gq = 0; gq < 4; ++gq) { float m1 = -1e30f, m2 = -1e30f, s1 = 0.f, s2 = 0.f; int i1 = 0, i2 = 0;
#pragma unroll
        for (int i = 0; i < 4; ++i) { const float scv = 1.0f / (1.0f + __expf(-lx[4 * gq + i])); const float sv = scv + rbias[4 * gq + i];
          if (sv > m1) { m2 = m1; s2 = s1; i2 = i1; m1 = sv; s1 = scv; i1 = i; } else if (sv > m2) { m2 = sv; s2 = scv; i2 = i; } }
        if (m1 + m2 > bestv) { bestv = m1 + m2; best = gq; bi1 = i1; bi2 = i2; bs1 = s1; bs2 = s2; } }
      const int ia = bi1 < bi2 ? bi1 : bi2, ib = bi1 < bi2 ? bi2 : bi1;
      const int tri = ia == 0 ? ib - 1 : (ia == 1 ? ib + 1 : 5);
      const int pidx = best * 6 + tri;
      const float sa = bi1 < bi2 ? bs1 : bs2, sb = bi1 < bi2 ? bs2 : bs1, inv = 1.0f / (sa + sb);
      const int rank = atomicAdd(&hist[pidx], 1);
      tok_pair[r] = pidx | (rank << 5); tok_w[2 * r] = sa * inv; tok_w[2 * r + 1] = sb * inv;
    }
  }
  __syncthreads();
  if (tid < 32) ctl[CT_CNTB + BIDX * 32 + tid] = tid < 24 ? hist[tid] : 0;
}
__device__ __forceinline__ void st_moe_gather(const bf16_t* H2, bf16_t* H2S, int* ctl, const int* tok_pair, const float* tok_w, int* sorted_tok, float* sorted_w, int* tok_slot, int skip_ctx, char* lds) {
  int* sbase = (int*)lds; int* rtot = sbase + 32; int* rpre = rtot + 512;
  const int tid = TIDX, bid = BIDX;
  { const int p = tid & 31, seg = tid >> 5; int tot = 0, pre = 0;
#pragma unroll 4
    for (int i = 0; i < 16; ++i) { const int bb = seg * 16 + i; const int cv = ctl[CT_CNTB + bb * 32 + p]; tot += cv; pre += bb < bid ? cv : 0; }
    rtot[seg * 32 + p] = tot; rpre[seg * 32 + p] = pre; }
  __syncthreads();
  if (tid < 32) { int tot = 0, pre = 0;
#pragma unroll
    for (int sg = 0; sg < 16; ++sg) { tot += rtot[sg * 32 + tid]; pre += rpre[sg * 32 + tid]; }
    rtot[tid] = tot; rpre[tid] = pre; }
  __syncthreads();
  if (tid == 0) { int base = 0, nt = 0;
#pragma unroll 1
    for (int p = 0; p < 24; ++p) { sbase[p] = base + rpre[p]; const int n = rtot[p], tl = (n + 255) >> 8;
      if (bid == 0) { ctl[CT_BASE + p] = base; for (int t = 0; t < tl; ++t) ctl[CT_TP + nt + t] = p; }
      nt += tl; base += tl * 256; }
    if (bid == 0) { ctl[CT_BASE + 24] = base; ctl[CT_NT] = nt; } }
  __syncthreads();
  const int lane = tid & 63, gw = bid * 8 + (tid >> 6), ngw = GDIM * 8;
  for (int rb = gw; rb < MTOK; rb += 3 * ngw) {
    u32x4 a0[3], a1[3]; int pk[3]; float w0[3], w1[3]; bool act[3];
#pragma unroll
    for (int u = 0; u < 3; ++u) { const int r = rb + u * ngw; act[u] = r < MTOK && !(skip_ctx && (r % TPB) < CTXL); const int rc = act[u] ? r : 0;
      pk[u] = tok_pair[rc]; w0[u] = tok_w[2 * rc]; w1[u] = tok_w[2 * rc + 1];
      const u32x4* sp = (const u32x4*)(H2 + (size_t)rc * DM); a0[u] = sp[lane]; a1[u] = sp[lane + 64]; }
#pragma unroll
    for (int u = 0; u < 3; ++u) if (act[u]) { const int r = rb + u * ngw; const int slot = sbase[pk[u] & 31] + (pk[u] >> 5);
      if (lane == 0) { sorted_tok[slot] = r; tok_slot[r] = slot; sorted_w[2 * slot] = w0[u]; sorted_w[2 * slot + 1] = w1[u]; }
      u32x4* d = (u32x4*)(H2S + (size_t)slot * DM); d[lane] = a0[u]; d[lane + 64] = a1[u]; }
  }
  __syncthreads();
}
__device__ __forceinline__ void st_final(float* out, const float* g, const bf16_t* XB, const bf16_t* YS, const int* tok_slot, const float* gate  ) {
  const int lane = TIDX & 63, gw = BIDX * 8 + (TIDX >> 6), ngw = GDIM * 8;
  f32x4 gg[4];
#pragma unroll
  for (int j = 0; j < 4; ++j) gg[j] = *(const f32x4*)(g + 4 * lane + 256 * j);
  for (int rb = gw; rb < NB * SEQ; rb += 4 * ngw) {
    u32x2 xb[4][4], ys[4][4];
#pragma unroll
    for (int u = 0; u < 4; ++u) { const int r = rb + u * ngw, rc = r < NB * SEQ ? r : NB * SEQ - 1;
      const int bb = rc >> 12, tr = bb * TPB + CTXL + (rc & 4095); const bf16_t* xr = XB + (size_t)tr * DM; const bf16_t* yr = YS + (size_t)tok_slot[tr] * DM;
#pragma unroll
      for (int j = 0; j < 4; ++j) { xb[u][j] = *(const u32x2*)(xr + 4 * lane + 256 * j); ys[u][j] = *(const u32x2*)(yr + 4 * lane + 256 * j); } }
#pragma unroll
    for (int u = 0; u < 4; ++u) { const int r = rb + u * ngw, rc = r < NB * SEQ ? r : NB * SEQ - 1; const float* gt = gate + (size_t)(rc >> 12) * 6144; float ss = 0.f; f32x4 v[4];
#pragma unroll
      for (int j = 0; j < 4; ++j) { const f32x4 g4 = *(const f32x4*)(gt + 4 * lane + 256 * j);
        const f32x4 x4 = (f32x4){__uint_as_float(xb[u][j].x << 16), __uint_as_float(xb[u][j].x & 0xffff0000u), __uint_as_float(xb[u][j].y << 16), __uint_as_float(xb[u][j].y & 0xffff0000u)};
        const f32x4 m4 = (f32x4){__uint_as_float(ys[u][j].x << 16), __uint_as_float(ys[u][j].x & 0xffff0000u), __uint_as_float(ys[u][j].y << 16), __uint_as_float(ys[u][j].y & 0xffff0000u)};
        v[j] = x4 + g4 * m4; ss += v[j].x * v[j].x + v[j].y * v[j].y + v[j].z * v[j].z + v[j].w * v[j].w; }
      const float rstd = rsqrtf(wave_sum(ss) * (1.0f / DM) + EPS);
      if (r < NB * SEQ) { float* orow = out + (size_t)r * DM;
#pragma unroll
        for (int j = 0; j < 4; ++j) *(f32x4*)(orow + 4 * lane + 256 * j) = (f32x4){v[j].x * rstd * gg[j].x, v[j].y * rstd * gg[j].y, v[j].z * rstd * gg[j].z, v[j].w * rstd * gg[j].w}; } }
  }
}

namespace pg8 {
#define PG8_LAS __attribute__((address_space(3)))
typedef unsigned short bf16_t;
typedef short bf16x8 __attribute__((ext_vector_type(8)));
typedef float f32x4 __attribute__((ext_vector_type(4)));
typedef unsigned u32x4 __attribute__((ext_vector_type(4)));
constexpr int BM = 256, BK = 64, HALF = 128, HTB = HALF * BK * 2  , STAGE_BYTES = 8 * HTB, NXCD = 8, WGM = 8;

__host__ __device__ __forceinline__ int lds_byte(int r, int c) { const int st = (r >> 4) * 2 + (c >> 5), rr = r & 15, cc = c & 31, ob = rr * 64 + cc * 2; return st * 1024 + (ob ^ (((ob >> 9) & 1) << 5)); }
__host__ __device__ __forceinline__ void stage_rc(int b, int& R, int& C) { const int st = b / 1024, sb = b % 1024, swz = sb ^ (((sb >> 9) & 1) << 5); R = (st >> 1) * 16 + swz / 64; C = (st & 1) * 32 + (swz % 64) / 2; }
__host__ __device__ __forceinline__ int perm32(int rho) { const int n = rho >> 4, i = rho & 15; return 8 * (i >> 2) + 4 * n + (i & 3); }

struct Unit { int pm, pn, fin; const char* A; const char* B; };
struct Gemm { int K, lda, ldb; };

__device__ __forceinline__ void tile_of(int L, int nM, int nN, int& pm, int& pn) {
    const int nwg = nM * nN; int wgid = L; { const int q = nwg / NXCD, r = nwg % NXCD, xcd = wgid % NXCD, off = wgid / NXCD; wgid = (xcd < r ? xcd * (q + 1) : r * (q + 1) + (xcd - r) * q) + off; }
    const int nig = WGM * nN, gid = wgid / nig, fm = gid * WGM, gsz = (nM - fm) < WGM ? (nM - fm) : WGM;
    pm = fm + ((wgid % nig) % gsz); pn = (wgid % nig) / gsz;
}
__device__ __forceinline__ unsigned cvt_pk_bf16(float lo, float hi) { unsigned r; asm volatile("v_cvt_pk_bf16_f32 %0, %1, %2" : "=v"(r) : "v"(lo), "v"(hi)); return r; }
template <class Epi, class Sched, bool ALIGN_EPI = false, bool SP2 = false>
__device__ __forceinline__ void gemm_phase(PG8_LAS unsigned char* lds, const Gemm g, const Sched& S, const Epi& E) {
    const int tid = opq_v((int)threadIdx.x), wid = __builtin_amdgcn_readfirstlane(tid >> 6), lane = tid & 63, wr = wid >> 2, wc = wid & 3, fr = lane & 15, fq = lane >> 4;
    const int K = g.K, nt = K / BK;
    unsigned voffA[2], voffB[2];
#pragma unroll
    for (int i = 0; i < 2; ++i) { int R, C; stage_rc(tid * 16 + i * 8192, R, C); const int Rb = Epi::PERM ? ((R & ~31) + perm32(R & 31)) : R;
        voffA[i] = (unsigned)(R * g.lda + C) * 2u; voffB[i] = (unsigned)(Rb * g.ldb + C) * 2u; }
    const size_t kstep = (size_t)(BK * 2);
    const size_t hstepA = (size_t)HALF * g.lda * 2, hstepB = (size_t)HALF * g.ldb * 2;
    const unsigned ldsw = (unsigned)wid * 1024u;
    const int aoff = lds_byte(wr * 64 + fr, fq * 8), boff = lds_byte(wc * 32 + fr, fq * 8);
#define PG8_SA(b, h) (((b) * 2 + (h)) * HTB)
#define PG8_SB(b, h) ((4 + (b) * 2 + (h)) * HTB)
#define PG8_STAGE(bufoff, gbase, voff) do { _Pragma("unroll") for (int _i = 0; _i < 2; ++_i) \
        __builtin_amdgcn_global_load_lds((const unsigned*)((const char*)(gbase) + (voff)[_i]), (PG8_LAS unsigned*)(lds + (bufoff) + ldsw + _i * 8192), 16, 0, 0); } while (0)
#define PG8_LDA(dst, b, h) do { _Pragma("unroll") for (int m = 0; m < 4; ++m) _Pragma("unroll") for (int k = 0; k < 2; ++k) dst[m][k] = *(const PG8_LAS bf16x8*)(lds + PG8_SA(b, h) + aoff + m * 2048 + k * 1024); } while (0)
#define PG8_LDB(dst, b, h) do { _Pragma("unroll") for (int n = 0; n < 2; ++n) _Pragma("unroll") for (int k = 0; k < 2; ++k) dst[n][k] = *(const PG8_LAS bf16x8*)(lds + PG8_SB(b, h) + boff + n * 2048 + k * 1024); } while (0)
#define PG8_MMA(ai, bj, At, Bt) do { __builtin_amdgcn_s_setprio(1); _Pragma("unroll") for (int m = 0; m < 4; ++m) _Pragma("unroll") for (int n = 0; n < 2; ++n) _Pragma("unroll") for (int k = 0; k < 2; ++k) \
        acc[ai][bj][m][n] = __builtin_amdgcn_mfma_f32_16x16x32_bf16(Bt[n][k], At[m][k], acc[ai][bj][m][n], 0, 0, 0); __builtin_amdgcn_s_setprio(0); } while (0)
#define PG8_WAIT_V(n) asm volatile("s_waitcnt vmcnt(" #n ")" ::: "memory")
#define PG8_WAIT_L(n) asm volatile("s_waitcnt lgkmcnt(" #n ")" ::: "memory")
#define PG8_BAR __builtin_amdgcn_s_barrier()
#define PG8_SCHED __builtin_amdgcn_sched_barrier(0)
    Unit cur, nxt; int ui = 0;
    if (!S.next(0, cur)) return;
    f32x4 acc[2][2][4][2];
#pragma unroll
    for (int a = 0; a < 2; ++a)
#pragma unroll
        for (int b = 0; b < 2; ++b)
#pragma unroll
            for (int m = 0; m < 4; ++m)
#pragma unroll
                for (int n = 0; n < 2; ++n) acc[a][b][m][n] = (f32x4){0.f, 0.f, 0.f, 0.f};
    bf16x8 At[4][2], B0[2][2], B1[2][2];
    const char* cA = cur.A; const char* cB = cur.B;
    S.a_ready(cur);
    if constexpr (SP2) {
        PG8_STAGE(PG8_SB(0, 0), cB, voffB); PG8_STAGE(PG8_SB(0, 1), cB + hstepB, voffB); PG8_STAGE(PG8_SA(0, 0), cA, voffA); PG8_STAGE(PG8_SA(0, 1), cA + hstepA, voffA);
        if (wr == 1) PG8_BAR;
        PG8_WAIT_V(2); PG8_BAR;
        PG8_STAGE(PG8_SB(1, 0), cB + kstep, voffB); PG8_STAGE(PG8_SA(1, 0), cA + kstep, voffA); PG8_STAGE(PG8_SB(1, 1), cB + hstepB + kstep, voffB);
        PG8_WAIT_V(6); PG8_BAR;
    } else {
        PG8_STAGE(PG8_SB(0, 0), cB, voffB); PG8_STAGE(PG8_SA(0, 0), cA, voffA); PG8_STAGE(PG8_SB(0, 1), cB + hstepB, voffB); PG8_STAGE(PG8_SA(0, 1), cA + hstepA, voffA);
        if (wr == 1) PG8_BAR;
        PG8_WAIT_V(4); PG8_BAR;
        PG8_STAGE(PG8_SB(1, 0), cB + kstep, voffB); PG8_STAGE(PG8_SA(1, 0), cA + kstep, voffA); PG8_STAGE(PG8_SB(1, 1), cB + hstepB + kstep, voffB);
        PG8_WAIT_V(6); PG8_BAR;
    }
    for (;;) {
        const bool has_next = S.next(ui + 1, nxt);
        const char* nA = has_next ? nxt.A : cA; const char* nB = has_next ? nxt.B : cB;
        for (int t = 0; t < nt; t += 2) {
            const bool last = (t == nt - 2);
            const char* a1 = cA + (size_t)(t + 1) * kstep;
            const char* a2 = last ? nA : cA + (size_t)(t + 2) * kstep; const char* b2 = last ? nB : cB + (size_t)(t + 2) * kstep;
            const char* a3 = a2 + kstep; const char* b3 = b2 + kstep;
            if (last && has_next) S.a_ready(nxt);
            if constexpr (SP2) {
            PG8_LDB(B0, 0, 0); PG8_LDB(B1, 0, 1); PG8_SCHED; PG8_LDA(At, 0, 0); PG8_STAGE(PG8_SA(1, 1), a1 + hstepA, voffA);
            PG8_WAIT_V(8); PG8_WAIT_L(0); PG8_BAR; PG8_MMA(0, 0, At, B0); PG8_MMA(0, 1, At, B1); PG8_BAR; PG8_SCHED;
            PG8_LDA(At, 0, 1); PG8_STAGE(PG8_SB(0, 0), b2, voffB); PG8_STAGE(PG8_SB(0, 1), b2 + hstepB, voffB); PG8_STAGE(PG8_SA(0, 0), a2, voffA);
            PG8_WAIT_V(8); PG8_WAIT_L(0); PG8_BAR; PG8_MMA(1, 0, At, B0); PG8_MMA(1, 1, At, B1); PG8_BAR; PG8_SCHED;
            PG8_LDB(B0, 1, 0); PG8_LDB(B1, 1, 1); PG8_SCHED; PG8_LDA(At, 1, 0); PG8_STAGE(PG8_SA(0, 1), a2 + hstepA, voffA);
            PG8_WAIT_V(8); PG8_WAIT_L(0); PG8_BAR; PG8_MMA(0, 0, At, B0); PG8_MMA(0, 1, At, B1); PG8_BAR; PG8_SCHED;
            PG8_LDA(At, 1, 1); PG8_STAGE(PG8_SB(1, 0), b3, voffB); PG8_STAGE(PG8_SB(1, 1), b3 + hstepB, voffB); PG8_STAGE(PG8_SA(1, 0), a3, voffA);
            PG8_WAIT_V(8); PG8_WAIT_L(0); PG8_BAR; PG8_MMA(1, 0, At, B0); PG8_MMA(1, 1, At, B1); PG8_BAR; PG8_SCHED;
            } else {
            PG8_LDB(B0, 0, 0); PG8_SCHED; PG8_LDA(At, 0, 0); PG8_STAGE(PG8_SA(1, 1), a1 + hstepA, voffA);
            PG8_WAIT_L(8); PG8_BAR; PG8_WAIT_L(0); PG8_MMA(0, 0, At, B0); PG8_BAR; PG8_SCHED;
            PG8_LDB(B1, 0, 1); PG8_STAGE(PG8_SB(0, 0), b2, voffB);
            PG8_BAR; PG8_WAIT_L(0); PG8_MMA(0, 1, At, B1); PG8_BAR;
            PG8_LDA(At, 0, 1); PG8_STAGE(PG8_SA(0, 0), a2, voffA);
            PG8_BAR; PG8_WAIT_L(0); PG8_MMA(1, 0, At, B0); PG8_BAR; PG8_SCHED;
            PG8_STAGE(PG8_SB(0, 1), b2 + hstepB, voffB);
            PG8_WAIT_V(6); PG8_BAR; PG8_MMA(1, 1, At, B1); PG8_BAR;
            PG8_LDB(B0, 1, 0); PG8_SCHED; PG8_LDA(At, 1, 0); PG8_STAGE(PG8_SA(0, 1), a2 + hstepA, voffA);
            PG8_WAIT_L(8); PG8_BAR; PG8_WAIT_L(0); PG8_MMA(0, 0, At, B0); PG8_BAR; PG8_SCHED;
            PG8_LDB(B1, 1, 1); PG8_STAGE(PG8_SB(1, 0), b3, voffB);
            PG8_BAR; PG8_WAIT_L(0); PG8_MMA(0, 1, At, B1); PG8_BAR;
            PG8_LDA(At, 1, 1); PG8_STAGE(PG8_SA(1, 0), a3, voffA);
            PG8_BAR; PG8_WAIT_L(0); PG8_MMA(1, 0, At, B0); PG8_BAR; PG8_SCHED;
            PG8_STAGE(PG8_SB(1, 1), b3 + hstepB, voffB);
            PG8_WAIT_V(6); PG8_BAR; PG8_MMA(1, 1, At, B1); PG8_BAR;
            }
        }
        if constexpr (ALIGN_EPI) { if (wr == 0) PG8_BAR; }
        if constexpr (!Epi::AFTER_DRAIN) { if (cur.fin) { E(acc, cur, wr, wc, fr, fq); S.done(cur); } }
        if (!has_next) break;
        if (cur.fin) {
#pragma unroll
        for (int a = 0; a < 2; ++a)
#pragma unroll
            for (int b = 0; b < 2; ++b)
#pragma unroll
                for (int m = 0; m < 4; ++m)
#pragma unroll
                    for (int n = 0; n < 2; ++n) acc[a][b][m][n] = (f32x4){0.f, 0.f, 0.f, 0.f};
        }
        cur = nxt; cA = nA; cB = nB; ++ui;
        if constexpr (ALIGN_EPI) { if (wr == 1) PG8_BAR; }
    }
    PG8_WAIT_V(0);
    if constexpr (!ALIGN_EPI) { if (wr == 0) PG8_BAR; }
    PG8_BAR;
    if constexpr (Epi::AFTER_DRAIN) { E.fused(acc, cur, wr, wc, fr, fq, lds, wid, lane); S.done(cur); }
#undef PG8_SA
#undef PG8_SB
#undef PG8_STAGE
#undef PG8_LDA
#undef PG8_LDB
#undef PG8_MMA
#undef PG8_WAIT_V
#undef PG8_WAIT_L
#undef PG8_BAR
#undef PG8_SCHED
}
}

struct SchedDense {
  int nM, nN, G, c, skip_ctx; const char* A; const char* B; size_t a_tile, b_tile;
  __device__ __forceinline__ bool next(int i, pg8::Unit& u) const {
    const long L = (long)i * G + c; if (L >= (long)nM * nN) return false;
    int pm, pn; pg8::tile_of((int)L, nM, nN, pm, pn); if (skip_ctx) pm = pm + pm / 16 + 1;
    u.pm = pm; u.pn = pn; u.fin = 1; u.A = A + (size_t)pm * a_tile; u.B = B + (size_t)pn * b_tile; return true; }
  __device__ __forceinline__ void a_ready(const pg8::Unit&) const {}
  __device__ __forceinline__ void done(const pg8::Unit&) const {}
};
struct SchedMoe {
  int G, c, mode; const int* ctl; const char* A; size_t a_tile; const char* W;
  __device__ __forceinline__ bool next(int i, pg8::Unit& u) const {
    const int part = mode == 2 ? (i & 1) : 0, iu = mode == 2 ? (i >> 1) : i;
    const long L = (long)iu * G + c; const int ntiles = ctl[CT_NT]; if (L >= (long)ntiles * 4) return false;
    const int pm = (int)(L >> 2), pn = (int)(L & 3); int eA, eB; pair_experts(ctl[CT_TP + pm], eA, eB);
    u.pm = pm; u.pn = pn;
    if (mode == 1) { const int e = pn < 2 ? eA : eB; u.fin = 1; u.A = A + (size_t)pm * a_tile; u.B = W + (size_t)e * (512 * 1024 * 2) + (size_t)(pn & 1) * (256 * 1024 * 2); }
    else { u.fin = part; u.A = A + (size_t)pm * a_tile + part * 512; u.B = W + (size_t)(part ? eB : eA) * (1024 * 256 * 2) + (size_t)pn * (256 * 256 * 2); }
    return true; }
  __device__ __forceinline__ void a_ready(const pg8::Unit&) const {}
  __device__ __forceinline__ void done(const pg8::Unit&) const {}
};
__device__ __forceinline__ unsigned cvt_pk(float lo, float hi) { return pg8::cvt_pk_bf16(lo, hi); }
struct EpiInProj {
  static constexpr bool PERM = true, AFTER_DRAIN = false; bf16_t *QK, *VZ, *XBC, *HY; float* DT;
  __device__ __forceinline__ void operator()(const f32x4 (&acc)[2][2][4][2], const pg8::Unit& u, int wr, int wc, int fr, int fq) const {
    const int pn = u.pn; bf16_t* base; int ldc, coff;
    if (pn < 2) { base = QK; ldc = 512; coff = pn * 256; } else if (pn < 4) { base = VZ; ldc = 512; coff = (pn - 2) * 256; }
    else if (pn < 7) { base = XBC; ldc = 768; coff = (pn - 4) * 256; } else { base = HY; ldc = 768; coff = (pn - 7) * 256; }
    const int row0 = u.pm * 256 + wr * 64 + fr, col0 = coff + wc * 32 + 8 * fq; const bool dtl = (pn == 6 && wc == 0 && fq < 2);
#pragma unroll
    for (int ai = 0; ai < 2; ++ai)
#pragma unroll
      for (int m = 0; m < 4; ++m) { const int row = row0 + ai * 128 + m * 16; bf16_t* rowp = base + (size_t)row * ldc + col0;
#pragma unroll
        for (int bj = 0; bj < 2; ++bj) { const f32x4 v0 = acc[ai][bj][m][0], v1 = acc[ai][bj][m][1];
          u32x4 w; w.x = cvt_pk(v0[0], v0[1]); w.y = cvt_pk(v0[2], v0[3]); w.z = cvt_pk(v1[0], v1[1]); w.w = cvt_pk(v1[2], v1[3]);
          *(u32x4*)(rowp + bj * 128) = w;
          if (bj == 1 && dtl) { float* dp = DT + (size_t)row * 12 + 8 * fq; *(f32x4*)dp = v0; if (fq == 0) *(f32x4*)(dp + 4) = v1; } } }
  }
};
struct EpiOutProj {
  static constexpr bool PERM = true, AFTER_DRAIN = false; bf16_t* MO;
  __device__ __forceinline__ void operator()(const f32x4 (&acc)[2][2][4][2], const pg8::Unit& u, int wr, int wc, int fr, int fq) const {
    const int row0 = u.pm * 256 + wr * 64 + fr, col0 = u.pn * 256 + wc * 32 + 8 * fq;
#pragma unroll
    for (int ai = 0; ai < 2; ++ai)
#pragma unroll
      for (int m = 0; m < 4; ++m) { bf16_t* rowp = MO + (size_t)(row0 + ai * 128 + m * 16) * DM + col0;
#pragma unroll
        for (int bj = 0; bj < 2; ++bj) { const f32x4 v0 = acc[ai][bj][m][0], v1 = acc[ai][bj][m][1];
          u32x4 w; w.x = cvt_pk(v0[0], v0[1]); w.y = cvt_pk(v0[2], v0[3]); w.z = cvt_pk(v1[0], v1[1]); w.w = cvt_pk(v1[2], v1[3]);
          *(u32x4*)(rowp + bj * 128) = w; } }
  }
};
struct EpiMoe1 {
  static constexpr bool PERM = true, AFTER_DRAIN = false; bf16_t* ACT; const float* sorted_w;
  __device__ __forceinline__ void operator()(const f32x4 (&acc)[2][2][4][2], const pg8::Unit& u, int wr, int wc, int fr, int fq) const {
    const int half = u.pn >> 1, j0 = (u.pn & 1) * 128 + 16 * wc + 4 * fq;
#pragma unroll
    for (int ai = 0; ai < 2; ++ai)
#pragma unroll
      for (int m = 0; m < 4; ++m) { const int slot = u.pm * 256 + ai * 128 + wr * 64 + m * 16 + fr; const float wt = sorted_w[2 * slot + half];
#pragma unroll
        for (int bj = 0; bj < 2; ++bj) { const f32x4 v0 = acc[ai][bj][m][0], v1 = acc[ai][bj][m][1];
          u32x2 w; w.x = cvt_pk(siluf(v0[0]) * v0[1] * wt, siluf(v0[2]) * v0[3] * wt); w.y = cvt_pk(siluf(v1[0]) * v1[1] * wt, siluf(v1[2]) * v1[3] * wt);
          *(u32x2*)(ACT + (size_t)slot * 512 + half * 256 + j0 + 64 * bj) = w; } }
  }
};
struct EpiMoe2 {
  static constexpr bool PERM = true, AFTER_DRAIN = false; bf16_t* YS;
  __device__ __forceinline__ void operator()(const f32x4 (&acc)[2][2][4][2], const pg8::Unit& u, int wr, int wc, int fr, int fq) const {
    const int row0 = u.pm * 256 + wr * 64 + fr, col0 = u.pn * 256 + wc * 32 + 8 * fq;
#pragma unroll
    for (int ai = 0; ai < 2; ++ai)
#pragma unroll
      for (int m = 0; m < 4; ++m) { bf16_t* rowp = YS + (size_t)(row0 + ai * 128 + m * 16) * DM + col0;
#pragma unroll
        for (int bj = 0; bj < 2; ++bj) { const f32x4 v0 = acc[ai][bj][m][0], v1 = acc[ai][bj][m][1];
          u32x4 w; w.x = cvt_pk(v0[0], v0[1]); w.y = cvt_pk(v0[2], v0[3]); w.z = cvt_pk(v1[0], v1[1]); w.w = cvt_pk(v1[2], v1[3]);
          *(u32x4*)(rowp + bj * 128) = w; } }
  }
};

#include <hip/hip_bf16.h>
#include <cmath>
namespace attn_body {
using bf16=__hip_bfloat16;
using bf16x8=__attribute__((ext_vector_type(8)))short;
using s16x4=__attribute__((ext_vector_type(4)))short;
using f32x16=__attribute__((ext_vector_type(16)))float;
using u32x4=__attribute__((ext_vector_type(4)))unsigned;
constexpr int D=64,QP=512,KP=512,VP=512,OP=1024;
constexpr int NW=8,QBLK=32,QB=QBLK*NW,KVBLK=64;
constexpr int ATTN_UNIT_ROWS=QB;
__device__ __forceinline__ int crow(int r,int hi){return (r&3)+8*(r>>2)+4*hi;}
#define SBAR() __builtin_amdgcn_sched_barrier(0)
__device__ __forceinline__ void cmask(f32x16&p0,f32x16&p1,int jb,int qrel,int hi){
  const float NEG=-INFINITY; int kb=64*jb+4*hi;
  #pragma unroll
  for(int r=0;r<16;++r){int kv=kb+(r&3)+8*(r>>2); if(kv>qrel)p0[r]=NEG; if(kv+32>qrel)p1[r]=NEG;}
}

constexpr int NSLOT=3, SLOTB=8192;
constexpr int LDS_K=0, LDS_V=NSLOT*SLOTB, LDS_WS=2*NSLOT*SLOTB, LDS_OST=LDS_WS+NW*64*4, LDS_BYTES=LDS_OST+NW*4096;
constexpr float C2=0.125f*1.4426950408889634f;
__device__ __forceinline__ void glds16(const void*gsrc,unsigned lds_dst){unsigned keep;
  asm volatile("s_mov_b32 %0, m0\n\ts_mov_b32 m0, %2\n\ts_nop 0\n\tglobal_load_lds_dwordx4 %1, off\n\ts_mov_b32 m0, %0":"=&s"(keep):"v"(gsrc),"s"(lds_dst):"memory");}
__device__ __forceinline__ float max3f(float a,float b,float c){float r;asm("v_max3_f32 %0, %1, %2, %3":"=v"(r):"v"(a),"v"(b),"v"(c));return r;}
__device__ __forceinline__ float max2f(float a,float b){float r;asm("v_max_f32_e32 %0, %1, %2":"=v"(r):"v"(a),"v"(b));return r;}
__device__ __forceinline__ float fadd_s(float a,float b){float r;asm("v_add_f32_e32 %0, %1, %2":"=v"(r):"v"(a),"v"(b));return r;}
__device__ __forceinline__ float fsub_s(float a,float b){float r;asm("v_sub_f32_e32 %0, %1, %2":"=v"(r):"v"(a),"v"(b));return r;}
typedef float f32x2_t __attribute__((ext_vector_type(2))); typedef __bf16 bf16x2_t __attribute__((ext_vector_type(2)));
__device__ __forceinline__ unsigned cvtpk_s(float lo,float hi){f32x2_t v={lo,hi};bf16x2_t b=__builtin_convertvector(v,bf16x2_t);return __builtin_bit_cast(unsigned,b);}
#define WAIT_BAR(N) asm volatile("s_waitcnt vmcnt(" #N ") lgkmcnt(0)\n\ts_barrier":::"memory")

__device__ __forceinline__ void qkt(f32x16&p0,f32x16&p1,const char*Kslot,const bf16x8*qr,const f32x16&negm,int r32,int hi){
  const char*kb=Kslot+hi*1024+r32*16;
  #pragma unroll
  for(int d0=0;d0<4;++d0){
    const bf16x8 b0=*reinterpret_cast<const bf16x8*>(kb+d0*2048);
    const bf16x8 b1=*reinterpret_cast<const bf16x8*>(kb+d0*2048+512);
    if(d0==0){p0=__builtin_amdgcn_mfma_f32_32x32x16_bf16(b0,qr[0],negm,0,0,0);p1=__builtin_amdgcn_mfma_f32_32x32x16_bf16(b1,qr[0],negm,0,0,0);}
    else{p0=__builtin_amdgcn_mfma_f32_32x32x16_bf16(b0,qr[d0],p0,0,0,0);p1=__builtin_amdgcn_mfma_f32_32x32x16_bf16(b1,qr[d0],p1,0,0,0);}}
}
typedef __attribute__((address_space(3))) const char* lds_cptr;
typedef short v4i16_t __attribute__((ext_vector_type(4)));
__device__ __forceinline__ void kload8(bf16x8*kf,lds_cptr kp){
  kf[0]=*(const __attribute__((address_space(3))) bf16x8*)(kp);      kf[1]=*(const __attribute__((address_space(3))) bf16x8*)(kp+512);
  kf[2]=*(const __attribute__((address_space(3))) bf16x8*)(kp+2048); kf[3]=*(const __attribute__((address_space(3))) bf16x8*)(kp+2560);
  kf[4]=*(const __attribute__((address_space(3))) bf16x8*)(kp+4096); kf[5]=*(const __attribute__((address_space(3))) bf16x8*)(kp+4608);
  kf[6]=*(const __attribute__((address_space(3))) bf16x8*)(kp+6144); kf[7]=*(const __attribute__((address_space(3))) bf16x8*)(kp+6656);
}
__device__ __forceinline__ void kload2(bf16x8*kf,lds_cptr kp,int j){ kf[2*j]=*(const __attribute__((address_space(3))) bf16x8*)(kp+j*2048); kf[2*j+1]=*(const __attribute__((address_space(3))) bf16x8*)(kp+j*2048+512); }
__device__ __forceinline__ s16x4 vtr(lds_cptr p){ return __builtin_bit_cast(s16x4,__builtin_amdgcn_ds_read_tr16_b64_v4i16((__attribute__((address_space(3))) v4i16_t*)p)); }
__device__ __forceinline__ float rowmax(const f32x16&p0,const f32x16&p1){
  float a=max3f(p0[0],p0[1],p1[0]),b=max3f(p0[2],p0[3],p1[1]);a=max3f(a,p1[2],p1[3]);
  #pragma unroll
  for(int r=4;r<16;r+=4){a=max3f(a,p0[r],p0[r+1]);b=max3f(b,p0[r+2],p0[r+3]);a=max3f(a,p1[r],p1[r+1]);b=max3f(b,p1[r+2],p1[r+3]);}
  const float m=max2f(a,b);
  auto rr=__builtin_amdgcn_permlane32_swap(__float_as_uint(m),__float_as_uint(m),false,false);
  return max2f(__uint_as_float(rr[0]),__uint_as_float(rr[1]));
}
__device__ __forceinline__ void pv(f32x16*o,int vb,bf16x8 pa0,bf16x8 pa1,bf16x8 pa2,bf16x8 pa3){
  #pragma unroll
  for(int d0=0;d0<2;++d0){s16x4 lo[4],hi[4];
    #pragma unroll
    for(int ks=0;ks<4;++ks){
      asm volatile("ds_read_b64_tr_b16 %0,%1 offset:%c2":"=&v"(lo[ks]):"v"(vb),"i"(d0*4096+ks*1024):"memory");
      asm volatile("ds_read_b64_tr_b16 %0,%1 offset:%c2":"=&v"(hi[ks]):"v"(vb),"i"(d0*4096+ks*1024+512):"memory");}
    asm volatile("s_waitcnt lgkmcnt(0)":::"memory");SBAR();
    #define PK(k) (bf16x8){lo[k][0],lo[k][1],lo[k][2],lo[k][3],hi[k][0],hi[k][1],hi[k][2],hi[k][3]}
    o[d0]=__builtin_amdgcn_mfma_f32_32x32x16_bf16(pa0,PK(0),o[d0],0,0,0);
    o[d0]=__builtin_amdgcn_mfma_f32_32x32x16_bf16(pa1,PK(1),o[d0],0,0,0);
    o[d0]=__builtin_amdgcn_mfma_f32_32x32x16_bf16(pa2,PK(2),o[d0],0,0,0);
    o[d0]=__builtin_amdgcn_mfma_f32_32x32x16_bf16(pa3,PK(3),o[d0],0,0,0);
    #undef PK
  }
}

#ifndef ATTN_STORE16
#define ATTN_STORE16(p,v) (*(u32x4*)(p)=(v))
#endif
template<int THRL> __device__ __forceinline__ void attn_unit(const bf16*Qu,const bf16*__restrict__ Kh,const bf16*__restrict__ Vh,bf16*Ou,const int NT,char*shm){
  const int tid=opq_v((int)threadIdx.x),lane=tid&63,r32=lane&31,hi=lane>>5; const int wid=__builtin_amdgcn_readfirstlane(tid>>6);
  const bf16*Qw=Qu+(long)(wid*QBLK)*QP;
  const unsigned lds0=(unsigned)(uintptr_t)shm;
  float*wsf=(float*)(shm+LDS_WS)+wid*64;
  const bf16*ksrc=Kh+(long)lane*KP+wid*8;
  const bf16*vsrc=Vh+(long)(16*(wid&3)+(lane>>2))*VP+(wid>>2)*32+(lane&3)*8;
  const unsigned kdst=lds0+LDS_K+wid*1024, vdst=lds0+LDS_V+wid*1024;
  #define DMA_K(t,slot) glds16(ksrc+(long)(t)*KVBLK*KP,(unsigned)__builtin_amdgcn_readfirstlane(kdst+(slot)))
  #define DMA_V(t,slot) glds16(vsrc+(long)(t)*KVBLK*VP,(unsigned)__builtin_amdgcn_readfirstlane(vdst+(slot)))
  const int vb0=(int)(lds0+LDS_V)+((lane>>4)&1)*32+(lane&3)*8+(4*hi+((lane&15)>>2))*64;
  const char*Kbase=shm+LDS_K; bf16x8 kf[8];
  const lds_cptr shm3=(lds_cptr)shm; const lds_cptr kp0=shm3+LDS_K+hi*1024+r32*16; const lds_cptr vp0=shm3+LDS_V+((lane>>4)&1)*32+(lane&3)*8+(4*hi+((lane&15)>>2))*64;
  DMA_K(0,0);DMA_V(0,0);DMA_K(1,SLOTB);
  bf16x8 qr[4];
  #pragma unroll
  for(int d0=0;d0<4;++d0)qr[d0]=*reinterpret_cast<const bf16x8*>(&Qw[(long)r32*QP+d0*16+hi*8]);
  float mhat=0.f,l_reg=0.f;float z0_=0.f;asm volatile("":"+v"(z0_));f32x16 o[2];f32x16 negm;
  _Pragma("unroll") for(int r=0;r<16;++r){o[0][r]=z0_;o[1][r]=z0_;negm[r]=z0_;} asm volatile("":"+v"(negm));
  #define CMASK(P0,P1,t) do{}while(0)
  bool resc=false;
  #define START(P0,P1) do{ const float rm=rowmax(P0,P1); resc=false; \
    { const float dl=rm; mhat=fadd_s(mhat,dl); \
      _Pragma("unroll") for(int r=0;r<16;++r){P0[r]=fsub_s(P0[r],dl);P1[r]=fsub_s(P1[r],dl);} \
      _Pragma("unroll") for(int r=0;r<16;++r)negm[r]=-mhat; asm volatile("":"+v"(negm)); } \
    _Pragma("unroll") for(int r=0;r<16;++r)P0[r]=__builtin_amdgcn_exp2f(P0[r]); }while(0)
  #define RESC() do{ if(resc){ asm volatile("s_waitcnt lgkmcnt(0)":::"memory"); \
      _Pragma("unroll") for(int d_=0;d_<2;++d_) _Pragma("unroll") for(int r=0;r<16;++r)o[d_][r]*=wsf[crow(r,hi)]; } }while(0)
  f32x16 pA0,pA1,pB0,pB1;
  int sl_prev=0,sl_cur=0,sl_next=SLOTB;
  #define ROT() do{sl_prev=sl_cur;sl_cur=sl_next;sl_next=(sl_next==(NSLOT-1)*SLOTB)?0:sl_next+SLOTB;}while(0)
  DMA_K(2,2*SLOTB);
  WAIT_BAR(3);
  qkt(pA0,pA1,Kbase,qr,negm,r32,hi);asm volatile("s_nop 15\n\ts_nop 7":"+v"(pA0),"+v"(pA1));CMASK(pA0,pA1,0);
  START(pA0,pA1);
  _Pragma("unroll") for(int r=0;r<16;++r)pA1[r]=__builtin_amdgcn_exp2f(pA1[r]);
  WAIT_BAR(0);
  DMA_K(3,0);DMA_V(1,SLOTB);
  ROT();
  kload8(kf,kp0+sl_cur);
  WAIT_BAR(2);
  s16x4 vlo[8],vhi[8]; u32x4 pw0,pw1,pw2,pw3;
  #define PKW(P,B) cvtpk_s(P[B],P[B+1])
  #define PAF(k) __builtin_bit_cast(bf16x8,pw##k)
  #define VFR(i) (bf16x8){vlo[i][0],vlo[i][1],vlo[i][2],vlo[i][3],vhi[i][0],vhi[i][1],vhi[i][2],vhi[i][3]}
  #define PIN(x) asm volatile("":"+v"(x))
  #define MX3(a,b,c) __builtin_fmaxf(__builtin_fmaxf((a),(b)),(c))
  #define GAPA(MF,A0,A1,A2,A3,W0,W1,PW) do{ MF; sacc+=A0; sacc+=A1; sacc+=A2; sacc+=A3; PIN(sacc); W0; W1; PIN(PW); SBAR(); }while(0)
  #define EX(v) __builtin_amdgcn_exp2f(v)
  #define GAPB(MF,X,B) do{ MF; X[B]=EX(X[B]); X[B+1]=EX(X[B+1]); X[B+2]=EX(X[B+2]); X[B+3]=EX(X[B+3]); PIN(X); SBAR(); }while(0)
  #define VRD(i) do{ vlo[i]=vtr(vp_+(((i)>>2)*4096+((i)&3)*1024)); vhi[i]=vtr(vp_+(((i)>>2)*4096+((i)&3)*1024+512)); }while(0)
  #define KRD(G,j) do{ if(G){ kload2(kf,kp0+sl_next,j); SBAR(); } }while(0)
  #define STEP(C0,C1,P0,P1,t,GK,GV,GL) do{ SBAR(); \
    const lds_cptr vp_=vp0+sl_prev; \
    VRD(0); SBAR(); float sacc=(P0[0]+P0[1]); \
    GAPA(C0=__builtin_amdgcn_mfma_f32_32x32x16_bf16(kf[0],qr[0],negm,0,0,0), P0[2],P0[3],P0[4],P0[5],     pw0[0]=PKW(P0,0), pw0[1]=PKW(P0,2), pw0); \
    VRD(4); SBAR(); GAPA(C1=__builtin_amdgcn_mfma_f32_32x32x16_bf16(kf[1],qr[0],negm,0,0,0), P0[6],P0[7],P0[8],P0[9],     pw0[2]=PKW(P0,4), pw0[3]=PKW(P0,6), pw0); \
    VRD(1); SBAR(); GAPA(C0=__builtin_amdgcn_mfma_f32_32x32x16_bf16(kf[2],qr[1],C0,0,0,0),   P0[10],P0[11],P0[12],P0[13], pw1[0]=PKW(P0,8), pw1[1]=PKW(P0,10), pw1); \
    VRD(5); SBAR(); GAPA(C1=__builtin_amdgcn_mfma_f32_32x32x16_bf16(kf[3],qr[1],C1,0,0,0),   P0[14],P0[15],P1[0],P1[1],   pw1[2]=PKW(P0,12),pw1[3]=PKW(P0,14), pw1); \
    VRD(2); SBAR(); GAPA(C0=__builtin_amdgcn_mfma_f32_32x32x16_bf16(kf[4],qr[2],C0,0,0,0),   P1[2],P1[3],P1[4],P1[5],     pw2[0]=PKW(P1,0), pw2[1]=PKW(P1,2), pw2); \
    VRD(6); SBAR(); GAPA(C1=__builtin_amdgcn_mfma_f32_32x32x16_bf16(kf[5],qr[2],C1,0,0,0),   P1[6],P1[7],P1[8],P1[9],     pw2[2]=PKW(P1,4), pw2[3]=PKW(P1,6), pw2); \
    VRD(3); SBAR(); GAPA(C0=__builtin_amdgcn_mfma_f32_32x32x16_bf16(kf[6],qr[3],C0,0,0,0),   P1[10],P1[11],P1[12],P1[13], pw3[0]=PKW(P1,8), pw3[1]=PKW(P1,10), pw3); \
    VRD(7); SBAR(); GAPA(C1=__builtin_amdgcn_mfma_f32_32x32x16_bf16(kf[7],qr[3],C1,0,0,0),   P1[14],P1[15],0.f,0.f,       pw3[2]=PKW(P1,12),pw3[3]=PKW(P1,14), pw3); \
    l_reg+=sacc; \
    if(GK){DMA_K((t)+3,sl_cur);} if(GV){DMA_V((t)+1,sl_next);} \
    CMASK(C0,C1,t); \
    { float a=MX3(C0[0],C0[1],C1[0]),b=MX3(C0[2],C0[3],C1[1]); a=MX3(a,C1[2],C1[3]); \
      _Pragma("unroll") for(int r=4;r<16;r+=4){a=MX3(a,C0[r],C0[r+1]);b=MX3(b,C0[r+2],C0[r+3]);a=MX3(a,C1[r],C1[r+1]);b=MX3(b,C1[r+2],C1[r+3]);} \
      float rm=__builtin_fmaxf(a,b); { auto rr=__builtin_amdgcn_permlane32_swap(__float_as_uint(rm),__float_as_uint(rm),false,false); rm=__builtin_fmaxf(__uint_as_float(rr[0]),__uint_as_float(rr[1])); } \
      resc=false; \
      if(__builtin_expect(__any(rm>(float)THRL),0)){ const float dl=__builtin_fmaxf(rm,0.f); mhat+=dl; \
        _Pragma("unroll") for(int r=0;r<16;++r){C0[r]-=dl;C1[r]-=dl;} \
        _Pragma("unroll") for(int r=0;r<16;++r)negm[r]=-mhat; asm volatile("":"+v"(negm)); \
        const float f=__builtin_amdgcn_exp2f(-dl); l_reg*=f; if(hi==0)wsf[r32]=f; resc=true; } } \
    SBAR(); \
    GAPB(o[0]=__builtin_amdgcn_mfma_f32_32x32x16_bf16(PAF(0),VFR(0),o[0],0,0,0), C0,0); \
    GAPB(o[1]=__builtin_amdgcn_mfma_f32_32x32x16_bf16(PAF(0),VFR(4),o[1],0,0,0), C0,4); \
    KRD(GL,0); GAPB(o[0]=__builtin_amdgcn_mfma_f32_32x32x16_bf16(PAF(1),VFR(1),o[0],0,0,0), C0,8); \
    KRD(GL,1); GAPB(o[1]=__builtin_amdgcn_mfma_f32_32x32x16_bf16(PAF(1),VFR(5),o[1],0,0,0), C0,12); \
    KRD(GL,2); GAPB(o[0]=__builtin_amdgcn_mfma_f32_32x32x16_bf16(PAF(2),VFR(2),o[0],0,0,0), C1,0); \
    KRD(GL,3); GAPB(o[1]=__builtin_amdgcn_mfma_f32_32x32x16_bf16(PAF(2),VFR(6),o[1],0,0,0), C1,4); \
    GAPB(o[0]=__builtin_amdgcn_mfma_f32_32x32x16_bf16(PAF(3),VFR(3),o[0],0,0,0), C1,8); \
    GAPB(o[1]=__builtin_amdgcn_mfma_f32_32x32x16_bf16(PAF(3),VFR(7),o[1],0,0,0), C1,12); \
    }while(0)
  int t=1;
  for(;t+5<NT;t+=2){
    STEP(pB0,pB1,pA0,pA1,t,true,true,true);     WAIT_BAR(2); RESC(); ROT();
    STEP(pA0,pA1,pB0,pB1,t+1,true,true,true);   WAIT_BAR(2); RESC(); ROT();
  }
  #define ENDW(tt) do{ if((tt)+3<NT){WAIT_BAR(2);} else if((tt)+2<NT){WAIT_BAR(1);} else {WAIT_BAR(0);} }while(0)
  for(;t+1<NT;t+=2){
    STEP(pB0,pB1,pA0,pA1,t,(t+3<NT),(t+1<NT),(t+1<NT));       ENDW(t);   RESC(); ROT();
    STEP(pA0,pA1,pB0,pB1,t+1,(t+4<NT),(t+2<NT),(t+2<NT));     ENDW(t+1); RESC(); ROT();
  }
  STEP(pB0,pB1,pA0,pA1,NT-1,false,false,false); RESC();
  { float sacc=pB0[0]+pB0[1]; _Pragma("unroll") for(int r=2;r<16;++r)sacc+=pB0[r]; _Pragma("unroll") for(int r=0;r<16;++r)sacc+=pB1[r]; l_reg+=sacc;
    pw0=(u32x4){PKW(pB0,0),PKW(pB0,2),PKW(pB0,4),PKW(pB0,6)};pw1=(u32x4){PKW(pB0,8),PKW(pB0,10),PKW(pB0,12),PKW(pB0,14)};pw2=(u32x4){PKW(pB1,0),PKW(pB1,2),PKW(pB1,4),PKW(pB1,6)};pw3=(u32x4){PKW(pB1,8),PKW(pB1,10),PKW(pB1,12),PKW(pB1,14)};
    SBAR(); pv(o,vb0+sl_cur,PAF(0),PAF(1),PAF(2),PAF(3)); }
  #undef PKW
  #undef PAF
  #undef VFR
  #undef PIN
  #undef MX3
  #undef GAPA
  #undef GAPB
  #undef EX
  #undef VRD
  #undef KRD
  #undef STEP
  #undef ENDW
  {auto rr=__builtin_amdgcn_permlane32_swap(__float_as_uint(l_reg),__float_as_uint(l_reg),false,false);l_reg=__uint_as_float(rr[0])+__uint_as_float(rr[1]);}
  if(hi==0)wsf[32+r32]=l_reg;asm volatile("s_waitcnt lgkmcnt(0)":::"memory");
  float rli[16];
  #pragma unroll
  for(int r=0;r<16;++r)rli[r]=__builtin_amdgcn_rcpf(wsf[32+crow(r,hi)]);
  bf16*Ow=Ou+(long)(wid*QBLK)*OP;
  { bf16*stg=(bf16*)(shm+LDS_OST)+wid*2048;
    #pragma unroll
    for(int r=0;r<16;++r){const int orow=crow(r,hi);
      #pragma unroll
      for(int d0=0;d0<2;++d0)stg[orow*64+d0*32+r32]=__float2bfloat16(o[d0][r]*rli[r]);}
    asm volatile("s_waitcnt lgkmcnt(0)":::"memory");
    #pragma unroll
    for(int i=0;i<4;++i){const int row=i*8+(lane>>3),ch=lane&7; const u32x4 v=*(const u32x4*)(stg+row*64+ch*8); ATTN_STORE16(Ow+(long)row*OP+ch*8,v);} }
  asm volatile("s_waitcnt lgkmcnt(0)\n\ts_barrier":::"memory");
  #undef DMA_K
  #undef DMA_V
  #undef CMASK
  #undef START
  #undef RESC
  #undef ROT
}
constexpr int ATTN_LDS_BYTES=LDS_BYTES;
#undef SBAR
#undef WAIT_BAR
}


namespace hyf {
struct c32 { float x, y; };
typedef _Float16 h2 __attribute__((ext_vector_type(2)));
__device__ __forceinline__ c32 operator+(c32 a, c32 b) { return {a.x + b.x, a.y + b.y}; }
__device__ __forceinline__ c32 operator-(c32 a, c32 b) { return {a.x - b.x, a.y - b.y}; }
__device__ __forceinline__ c32 cmul(c32 a, c32 b) { return {a.x * b.x - a.y * b.y, a.x * b.y + a.y * b.x}; }
__device__ __forceinline__ constexpr float C32(int k) {
  switch (k) { case 0: return 1.f; case 1: return 0.98078528f; case 2: return 0.923879533f; case 3: return 0.831469612f; case 4: return 0.707106781f; case 5: return 0.555570233f; case 6: return 0.382683432f;
    case 7: return 0.195090322f; case 8: return 0.f; case 9: return -0.195090322f; case 10: return -0.382683432f; case 11: return -0.555570233f; case 12: return -0.707106781f; case 13: return -0.831469612f;
    case 14: return -0.923879533f; default: return -0.98078528f; } }
__device__ __forceinline__ constexpr float S32(int k) {
  switch (k) { case 0: return 0.f; case 1: return 0.195090322f; case 2: return 0.382683432f; case 3: return 0.555570233f; case 4: return 0.707106781f; case 5: return 0.831469612f; case 6: return 0.923879533f;
    case 7: return 0.98078528f; case 8: return 1.f; case 9: return 0.98078528f; case 10: return 0.923879533f; case 11: return 0.831469612f; case 12: return 0.707106781f; case 13: return 0.555570233f;
    case 14: return 0.382683432f; default: return 0.195090322f; } }
__device__ __forceinline__ constexpr int brev(int q, int bits) {
  return bits == 4 ? (((q & 1) << 3) | ((q & 2) << 1) | ((q & 4) >> 1) | ((q & 8) >> 3))
                   : (((q & 1) << 4) | ((q & 2) << 2) | (q & 4) | ((q & 8) >> 2) | ((q & 16) >> 4)); }
__device__ __forceinline__ int phys(int p) { return p + (p >> 5); }
template <int R, int HALF, bool INV> struct DftStage {
  static __device__ __forceinline__ void run(c32 (&x)[R]) {
#pragma unroll
    for (int blk = 0; blk < R; blk += 2 * HALF) {
#pragma unroll
      for (int j = 0; j < HALF; ++j) {
        const c32 a = x[blk + j], b = x[blk + j + HALF]; x[blk + j] = a + b; const c32 d = a - b;
        const int e = j * (R / (2 * HALF)) * (32 / R);
        if (e == 0) x[blk + j + HALF] = d;
        else if (e == 8) x[blk + j + HALF] = INV ? (c32){-d.y, d.x} : (c32){d.y, -d.x};
        else { const c32 wv = {C32(e), INV ? S32(e) : -S32(e)}; x[blk + j + HALF] = cmul(d, wv); }
      } }
    DftStage<R, HALF / 2, INV>::run(x);
  }
};
template <int R, bool INV> struct DftStage<R, 0, INV> { static __device__ __forceinline__ void run(c32 (&)[R]) {} };
template <int R, bool INV> __device__ __forceinline__ void dft_pow2(c32 (&x)[R]) { DftStage<R, R / 2, INV>::run(x); }
template <int R, int HALF> struct DitStage {
  static __device__ __forceinline__ void run(c32 (&x)[R]) {
#pragma unroll
    for (int blk = 0; blk < R; blk += 2 * HALF) {
#pragma unroll
      for (int j = 0; j < HALF; ++j) {
        const int e = j * (R / (2 * HALF)) * (32 / R);
        const c32 a = x[blk + j], b0 = x[blk + j + HALF];
        c32 b;
        if (e == 0) b = b0; else if (e == 8) b = (c32){-b0.y, b0.x}; else b = cmul(b0, (c32){C32(e), S32(e)});
        x[blk + j] = a + b; x[blk + j + HALF] = a - b;
      } }
    DitStage<R, HALF * 2>::run(x);
  }
};
template <int R> struct DitStage<R, R> { static __device__ __forceinline__ void run(c32 (&)[R]) {} };
template <int R> __device__ __forceinline__ void idft_dit(c32 (&x)[R]) { DitStage<R, 1>::run(x); }
template <int STRIDE, bool INV> __device__ __forceinline__ void pass16(c32* buf, int e0, float rev) {
  float rv = rev; asm volatile("" : "+v"(rv));
  const float cs = __builtin_amdgcn_cosf(rv), sn = __builtin_amdgcn_sinf(rv);
  const c32 w1 = {cs, INV ? sn : -sn};
  c32* p = buf + phys(e0); constexpr int PS = STRIDE + STRIDE / 32;
  c32 x[16];
  if (!INV) {
#pragma unroll
    for (int m = 0; m < 16; ++m) x[m] = p[PS * m];
    dft_pow2<16, false>(x);
    c32 w = w1; p[0] = x[0];
#pragma unroll
    for (int q = 1; q < 16; ++q) { p[PS * q] = cmul(x[brev(q, 4)], w); w = cmul(w, w1); }
  } else {
    c32 w = w1; x[0] = p[0];
#pragma unroll
    for (int q = 1; q < 16; ++q) { x[q] = cmul(p[PS * q], w); w = cmul(w, w1); }
    dft_pow2<16, true>(x);
#pragma unroll
    for (int m = 0; m < 16; ++m) p[PS * m] = x[brev(m, 4)];
  }
}
template <int MODE> __device__ __forceinline__ void mid32(c32* buf, h2* Hs, int j) {
  c32* p = buf + 33 * j; c32 x[32];
#pragma unroll
  for (int m = 0; m < 32; ++m) x[m] = p[m];
  dft_pow2<32, false>(x);
  if (MODE == 0) {
#pragma unroll
    for (int q = 0; q < 32; ++q) { const c32 v = x[brev(q, 5)]; Hs[q * 256 + j] = (h2){(_Float16)v.x, (_Float16)v.y}; }
  } else {
#pragma unroll
    for (int pp = 0; pp < 32; ++pp) { const h2 hv = Hs[brev(pp, 5) * 256 + j]; x[pp] = cmul(x[pp], (c32){(float)hv.x, (float)hv.y}); }
    idft_dit<32>(x);
#pragma unroll
    for (int m = 0; m < 32; ++m) p[m] = x[m];
  }
}
__device__ __forceinline__ void fwd2(c32* buf, int tid) {
  __syncthreads(); pass16<512, false>(buf, tid, (float)tid * (1.0f / 8192.0f));
  __syncthreads(); pass16<32, false>(buf, (tid >> 5) * 512 + (tid & 31), (float)(tid & 31) * (1.0f / 512.0f));
  __syncthreads();
}
__device__ __forceinline__ void conv(c32* buf, h2* Hs, int tid) {
  fwd2(buf, tid);
  if (tid < 256) mid32<1>(buf, Hs, tid);
  __syncthreads(); pass16<32, true>(buf, (tid >> 5) * 512 + (tid & 31), (float)(tid & 31) * (1.0f / 512.0f));
  __syncthreads(); pass16<512, true>(buf, tid, (float)tid * (1.0f / 8192.0f));
  __syncthreads();
}
__device__ __forceinline__ void item(int c, const bf16_t* HYT, const float* HK, const float* hy_bias, bf16_t* HYO, char* lds) {
  c32* buf = (c32*)lds; h2* H0 = (h2*)(lds + 67584); h2* H1 = H0 + 8192;
  const int tid = TIDX;
#pragma unroll 1
  for (int o = 0; o < 2; ++o) {
    const float* kp = HK + ((size_t)o * 256 + c) * 8192;
#pragma unroll
    for (int i = 0; i < 16; ++i) { const int n = tid + 512 * i; buf[phys(n)] = (c32){kp[n], 0.f}; }
    fwd2(buf, tid);
    if (tid < 256) mid32<0>(buf, o ? H1 : H0, tid);
    __syncthreads();
  }
  const float bias0 = hy_bias[c], bias1 = hy_bias[256 + c];
#pragma unroll 1
  for (int pr = 0; pr < 2; ++pr) {
    const bf16_t* v0 = HYT + ((size_t)(2 * pr) * 768 + c) * SEQ; const bf16_t* v1 = v0 + (size_t)768 * SEQ;
    c32 vv[8];
#pragma unroll
    for (int i = 0; i < 8; ++i) { const int t = tid + 512 * i; vv[i] = (c32){bf2f(v0[t]), bf2f(v1[t])}; buf[phys(t)] = vv[i]; buf[phys(t + 4096)] = (c32){0.f, 0.f}; }
    conv(buf, H0, tid);
#pragma unroll
    for (int i = 0; i < 8; ++i) { const int t = tid + 512 * i; const c32 y = buf[phys(t)];
      vv[i] = (c32){bf2f(v0[(size_t)256 * SEQ + t]) * (y.x * (1.0f / 8192.0f) + bias0 * vv[i].x), bf2f(v1[(size_t)256 * SEQ + t]) * (y.y * (1.0f / 8192.0f) + bias0 * vv[i].y)};
      buf[phys(t)] = vv[i]; buf[phys(t + 4096)] = (c32){0.f, 0.f}; }
    conv(buf, H1, tid);
#pragma unroll
    for (int i = 0; i < 8; ++i) { const int t = tid + 512 * i; const c32 y = buf[phys(t)];
      HYO[((size_t)(2 * pr) * 256 + c) * SEQ + t] = (bf16_t)f2bf(bf2f(v0[(size_t)512 * SEQ + t]) * (y.x * (1.0f / 8192.0f) + bias1 * vv[i].x));
      HYO[((size_t)(2 * pr + 1) * 256 + c) * SEQ + t] = (bf16_t)f2bf(bf2f(v1[(size_t)512 * SEQ + t]) * (y.y * (1.0f / 8192.0f) + bias1 * vv[i].y)); }
    __syncthreads();
  }
}
__device__ __forceinline__ void out_item(int it, const bf16_t* HYO, bf16_t* MIX, char* lds) {
  bf16_t (*T)[72] = (bf16_t (*)[72])lds;
  const int tid = TIDX, b = it >> 8, t0 = ((it >> 2) & 63) * 64, c0 = (it & 3) * 64;
  { const int cc = tid >> 3, t8 = (tid & 7) * 8; *(u32x4*)&T[cc][t8] = *(const u32x4*)(HYO + ((size_t)b * 256 + c0 + cc) * SEQ + t0 + t8); }
  __syncthreads();
  { const int tl = tid >> 3, c8 = (tid & 7) * 8; u32x4 o;
    o.x = (unsigned)T[c8][tl] | ((unsigned)T[c8 + 1][tl] << 16); o.y = (unsigned)T[c8 + 2][tl] | ((unsigned)T[c8 + 3][tl] << 16);
    o.z = (unsigned)T[c8 + 4][tl] | ((unsigned)T[c8 + 5][tl] << 16); o.w = (unsigned)T[c8 + 6][tl] | ((unsigned)T[c8 + 7][tl] << 16);
    *(u32x4*)(MIX + ((size_t)b * TPB + CTXL + t0 + tl) * DM + 768 + c0 + c8) = o; }
  __syncthreads();
}
}

#define LAS __attribute__((address_space(3)))
#define XB_TMO      128
#define XB_XCNT(j)  (256  + 64 * (j))
#define XB_XSUB(j)  (1280 + 64 * (j))
#define XB_XGEN(j)  (2304 + 64 * (j))
#define XB_TOP      3328
#define XB_TOPGEN   3392
#define XCD_BAR_WORDS 3456
#define XB_SPIN_CAP (1u << 18)

__device__ __forceinline__ unsigned xb_ld(unsigned* p)              { return __hip_atomic_load(p, __ATOMIC_RELAXED, __HIP_MEMORY_SCOPE_AGENT); }
__device__ __forceinline__ unsigned xb_add(unsigned* p, unsigned v) { return __hip_atomic_fetch_add(p, v, __ATOMIC_RELAXED, __HIP_MEMORY_SCOPE_AGENT); }
__device__ __forceinline__ unsigned xb_xcc_id() { return (unsigned)__builtin_amdgcn_s_getreg((3 << 11) | 20) & 0xFu; }
#define XB_SPIN(cond, bar) do { unsigned _sp = 0; while (cond) { __builtin_amdgcn_s_sleep(1); \
    if ((++_sp & 255u) == 0u) { if (xb_ld(&(bar)[XB_TMO])) break; if (_sp > XB_SPIN_CAP) { atomicAdd(&(bar)[XB_TMO], 1u); break; } } } } while (0)

struct XcdBarrier {
    unsigned* bar; unsigned x;
    volatile LAS unsigned* st;
};

__device__ __forceinline__ XcdBarrier xcd_barrier_post(unsigned* bar, volatile LAS unsigned* st) {
    XcdBarrier b; b.bar = bar; b.x = xb_xcc_id(); b.st = st;
    if (threadIdx.x == 0) (void)xb_add(&bar[XB_XCNT(b.x)], 1u);
    return b;
}
__device__ __forceinline__ void xcd_barrier_complete(unsigned* bar, unsigned x, unsigned& nloc, unsigned& nx) {
    const unsigned G = gridDim.x * gridDim.y * gridDim.z;
    unsigned sum, cnt, mine, sp = 0u;
    for (;;) {
        sum = 0u; cnt = 0u; mine = 0u;
#pragma unroll
        for (unsigned j = 0; j < 16; ++j) { const unsigned c = xb_ld(&bar[XB_XCNT(j)]); sum += c; cnt += (c > 0u) ? 1u : 0u; mine = (j == x) ? c : mine; }
        if (sum == G) break;
        __builtin_amdgcn_s_sleep(1);
        if ((++sp & 255u) == 0u) { if (xb_ld(&bar[XB_TMO])) break; if (sp > XB_SPIN_CAP) { atomicAdd(&bar[XB_TMO], 1u); break; } }
    }
    nloc = mine > 0u ? mine : 1u; nx = cnt > 0u ? cnt : 1u;
}

__device__ __forceinline__ void xcd_barrier(const XcdBarrier& b) {
    asm volatile("s_waitcnt vmcnt(0)" ::: "memory");
    __syncthreads();
    if (threadIdx.x == 0) {
        unsigned* bar = b.bar;
        __builtin_amdgcn_s_waitcnt(0);
        unsigned nloc = b.st[0], nx = b.st[1];
        if (nloc == 0u) { xcd_barrier_complete(bar, b.x, nloc, nx); b.st[0] = nloc; b.st[1] = nx; }
        const unsigned old = xb_add(&bar[XB_XSUB(b.x)], 1u);
        const unsigned gen = old / nloc;
        if (old + 1u == (gen + 1u) * nloc) {
            __builtin_amdgcn_fence(__ATOMIC_RELEASE, "agent");
            asm volatile("s_waitcnt vmcnt(0)" ::: "memory");
            const unsigned og = xb_add(&bar[XB_TOP], 1u);
            const unsigned tg = og / nx;
            if (og + 1u == (tg + 1u) * nx) xb_add(&bar[XB_TOPGEN], 1u);
            else XB_SPIN(xb_ld(&bar[XB_TOPGEN]) == tg, bar);
            __builtin_amdgcn_fence(__ATOMIC_ACQUIRE, "agent");
            xb_add(&bar[XB_XGEN(b.x)], 1u);
            asm volatile("s_waitcnt vmcnt(0)" ::: "memory");
        } else {
            XB_SPIN(xb_ld(&bar[XB_XGEN(b.x)]) == gen, bar);
            __builtin_amdgcn_fence(__ATOMIC_ACQUIRE, "agent");
            asm volatile("s_waitcnt vmcnt(0)" ::: "memory");
        }
    }
    __syncthreads();
}


struct MP { const float* in[33]; float* out; unsigned char* ws; };
typedef const float* const __attribute__((address_space(4))) * kargs_t;
#define KARGS() ({ kargs_t k_ = (kargs_t)__builtin_amdgcn_kernarg_segment_ptr(); asm volatile("" : "+s"(k_)); k_; })
#define WSP(K, off) ((unsigned char*)(K)[34] + (off))

__global__ void __launch_bounds__(NT, 2) mega(MP P) {
  cg::grid_group grid = cg::this_grid();
  extern __shared__ __attribute__((aligned(16))) char lds[];
  volatile LAS unsigned* xst = (volatile LAS unsigned*)(lds + LDS_BYTES - 16);
  if (threadIdx.x < 2) xst[threadIdx.x] = 0u;
  __syncthreads();
  { kargs_t K = KARGS(); (void)xcd_barrier_post((unsigned*)WSP(K, WS_CTL) + CT_BAR, xst); }
#define XBAR_HERE() do { kargs_t Kb_ = KARGS(); XcdBarrier xb_; xb_.bar = (unsigned*)WSP(Kb_, WS_CTL) + CT_BAR; xb_.x = xb_xcc_id(); xb_.st = (volatile LAS unsigned*)(lds + LDS_BYTES - 16); xcd_barrier(xb_); } while (0)
#define SEAM() XBAR_HERE()
  {
    kargs_t K = KARGS();
    st_adaln(K[1], K[3], K[4], K[5], (float*)WSP(K, WS_MODV), lds);
    st_rope((float*)WSP(K, WS_ROPE));
  }
  {
      kargs_t K = KARGS();
      st_weights(K[8], K[26], K[29], K[30], K[31], 0, (bf16_t*)WSP(K, WS_WIN), (bf16_t*)WSP(K, WS_WOUT), (bf16_t*)WSP(K, WS_WGU), (bf16_t*)WSP(K, WS_WD), lds);
    }
    { kargs_t K = KARGS(); const int bid = BIDX, G = GDIM;
      for (int it = bid; it < SEQ / 16; it += G) hyfilt_item<SEQ>(it, K[19] + 0 * 33 * 64, K[20] + 0 * 64, K[21] + 0 * 64, K[22] + 0 * 4096, K[23] + 0 * 64, K[24] + (size_t)0 * 65536, (float*)WSP(K, WS_HK), lds);
      if (true) for (int it = bid; it < CTXL / 16; it += G) hyfilt_item<CTXL>(it, K[19] + 0 * 33 * 64, K[20] + 0 * 64, K[21] + 0 * 64, K[22] + 0 * 4096, K[23] + 0 * 64, K[24] + (size_t)0 * 65536, (float*)WSP(K, WS_HKC), lds);
    }
  if (gridDim.x == 0x7fffffffu) grid.sync();
  XBAR_HERE();
#pragma nounroll
  for (int layer = 0; layer < 2; ++layer) {
    const bool last = layer == 1;
    if (layer == 1) {
    {
      kargs_t K = KARGS();
      st_weights(K[8], K[26], K[29], K[30], K[31], layer, (bf16_t*)WSP(K, WS_WIN), (bf16_t*)WSP(K, WS_WOUT), (bf16_t*)WSP(K, WS_WGU), (bf16_t*)WSP(K, WS_WD), lds);
    }
    { kargs_t K = KARGS(); const int bid = BIDX, G = GDIM;
      for (int it = bid; it < SEQ / 16; it += G) hyfilt_item<SEQ>(it, K[19] + layer * 33 * 64, K[20] + layer * 64, K[21] + layer * 64, K[22] + layer * 4096, K[23] + layer * 64, K[24] + (size_t)layer * 65536, (float*)WSP(K, WS_HK), lds);
      if (!last) for (int it = bid; it < CTXL / 16; it += G) hyfilt_item<CTXL>(it, K[19] + layer * 33 * 64, K[20] + layer * 64, K[21] + layer * 64, K[22] + layer * 4096, K[23] + layer * 64, K[24] + (size_t)layer * 65536, (float*)WSP(K, WS_HKC), lds);
    }
    }
    { kargs_t K = KARGS();
      st_normmod(K[0], K[2], (bf16_t*)WSP(K, WS_H), layer == 0 ? (const bf16_t*)nullptr : (const bf16_t*)WSP(K, WS_H2S), (const int*)WSP(K, WS_MOEM + 768 * 1024),
                 (const float*)WSP(K, WS_MODV) + 5120, K[6] + layer * 1024, (const float*)WSP(K, WS_MODV) + (size_t)layer * 5 * 6144, 0, 1024, (bf16_t*)K[33], lds);
    }
    SEAM();
    {
      kargs_t K = KARGS();
      pg8::Gemm g{1024, 1024, 1024}; SchedDense S{MTOK / 256, NPAD / 256, (int)GDIM, BIDX, 0, (const char*)K[33], (const char*)WSP(K, WS_WIN), (size_t)256 * 1024 * 2, (size_t)256 * 1024 * 2};
      EpiInProj E{(bf16_t*)WSP(K, WS_QK), (bf16_t*)WSP(K, WS_VZ), (bf16_t*)WSP(K, WS_XBC), (bf16_t*)WSP(K, WS_HY), (float*)WSP(K, WS_DT)};
      pg8::gemm_phase<EpiInProj, SchedDense, true, true>((PG8_LAS unsigned char*)lds, g, S, E);
    }
    SEAM();
    {
      kargs_t K = KARGS();
      st_prep_qk((bf16_t*)WSP(K, WS_QK), K[9] + layer * 64, K[10] + layer * 64, (const float*)WSP(K, WS_ROPE));
    }
    { kargs_t K = KARGS();
      st_prep_hy((const bf16_t*)WSP(K, WS_HY), K[17] + layer * 3 * 768, K[18] + layer * 768, (bf16_t*)WSP(K, WS_HYT), last ? 0 : 1, lds);
    }
    { kargs_t K = KARGS();
      st_ssd1(BIDX, GDIM, 4 * 34 * 6, (const bf16_t*)WSP(K, WS_XBC), (const float*)WSP(K, WS_DT), K[11] + layer * 3 * 640, K[12] + layer * 640, K[13] + layer * 12, K[14] + layer * 12,
              (float*)WSP(K, WS_Y), (float*)WSP(K, WS_ST), (float*)WSP(K, WS_DEC), lds);
    }
    SEAM();
    {
      { kargs_t K2 = KARGS(); st_ssd_scan2((float*)WSP(K2, WS_ST), (const float*)WSP(K2, WS_DEC)); }
      const int bid = BIDX, G = GDIM;
#define P4_ATT(bb, hq, qrow_, nt_) do { kargs_t K = KARGS(); const int kvh_ = (hq) / 3; \
          const attn_body::bf16* QKp = (const attn_body::bf16*)WSP(K, WS_QK); const attn_body::bf16* VZp = (const attn_body::bf16*)WSP(K, WS_VZ); \
          attn_body::attn_unit<8>(QKp + (size_t)(qrow_) * 512 + (hq) * 64, QKp + (size_t)(bb) * TPB * 512 + 384 + kvh_ * 64, VZp + (size_t)(bb) * TPB * 512 + kvh_ * 64, \
                                  (attn_body::bf16*)K[33] + (size_t)(qrow_) * 1024 + (hq) * 64, (nt_), lds); } while (0)
#define P4_FFT(cch) do { kargs_t K = KARGS(); hyf::item((cch), (const bf16_t*)WSP(K, WS_HYT), (const float*)WSP(K, WS_HK), K[25] + layer * 512, (bf16_t*)WSP(K, WS_HY), lds); } while (0)
#define P4_CHY(itm) do { kargs_t K = KARGS(); hyconv_ctx_item((itm), (const bf16_t*)WSP(K, WS_HYT) + (size_t)4 * 768 * SEQ, (const float*)WSP(K, WS_HKC), K[25] + layer * 512, (bf16_t*)K[33], lds); } while (0)
      {
        const int x = bid & 7, y = bid >> 3, bb = x >> 1, kvh = x & 1;
        const int nun = y < 16 ? 2 : 1, natt = nun + ((!last && y < 3) ? 1 : 0);
#pragma unroll 1
        for (int k = 0; k < natt; ++k) { int hq, qrow, nt;
          if (k < nun) { const int v = y < 16 ? y + 16 * k : 16 + y; hq = 3 * kvh + (v >> 4); qrow = bb * TPB + CTXL + (v & 15) * 256; nt = TPB / 64; }
          else { hq = 3 * kvh + y; qrow = bb * TPB; nt = CTXL / 64; }
          P4_ATT(bb, hq, qrow, nt); }
        if (y >= 16) {
#pragma unroll 1
          for (int k = 0; k < 2; ++k) { const int cch = ((y - 16) * 8 + x) * 2 + k; P4_FFT(cch); } }
        if (!last && y >= 3 && y < 11) { P4_CHY((y - 3) * 8 + x); }
      }
      (void)G;
#undef P4_ATT
#undef P4_FFT
#undef P4_CHY
    }
    SEAM();
    {
      kargs_t K = KARGS();
      { const int bid = BIDX, G = GDIM, nit = last ? 4 * 32 * 2 : 4 * 34 * 2;
        for (int it = bid; it < nit; it += G) { const int g = it & 1, bc = it >> 1; const int b = last ? bc >> 5 : bc / 34, cidx = last ? 2 + (bc & 31) : bc % 34;
          ssd3_item(b, cidx, g, (const bf16_t*)WSP(K, WS_XBC), (const bf16_t*)WSP(K, WS_VZ), (const float*)WSP(K, WS_DT), K[11] + layer * 3 * 640, K[12] + layer * 640, K[13] + layer * 12, K[14] + layer * 12,
                    K[15] + layer * 6, K[16] + layer * 384, (const float*)WSP(K, WS_Y), (const float*)WSP(K, WS_ST), (bf16_t*)K[33], lds); } }
      { const int bid = BIDX, G = GDIM; for (int it = bid; it < 1024; it += G) hyf::out_item(it, (const bf16_t*)WSP(K, WS_HY), (bf16_t*)K[33], lds); }
      const int t = TIDX; if (BIDX == 0 && t < 256) ((int*)WSP(K, WS_CTL))[t] = 0;
      { int* stok = (int*)WSP(K, WS_MOEM + 384 * 1024); for (int i = BIDX * NT + t; i < MOE_ROWS; i += GDIM * NT) stok[i] = -1; }
    }
    SEAM();
    {
      kargs_t K = KARGS();
      pg8::Gemm g{1024, 1024, 1024}; SchedDense S{last ? 64 : 68, 4, (int)GDIM, BIDX, last ? 1 : 0, (const char*)K[33], (const char*)WSP(K, WS_WOUT), (size_t)256 * 1024 * 2, (size_t)256 * 1024 * 2};
      EpiOutProj E{(bf16_t*)WSP(K, WS_QK)};
      pg8::gemm_phase<EpiOutProj, SchedDense, true, true>((PG8_LAS unsigned char*)lds, g, S, E);
    }
    SEAM();
    {
      kargs_t K = KARGS();
      st_router(K[0], K[2], layer == 0 ? 1 : 0, (bf16_t*)WSP(K, WS_H), (const bf16_t*)WSP(K, WS_QK), K[7] + layer * 1024, (const float*)WSP(K, WS_MODV) + (size_t)layer * 5 * 6144, K[27], K[28], (bf16_t*)K[33], (int*)WSP(K, WS_CTL),
                (int*)WSP(K, WS_MOEM), (float*)WSP(K, WS_MOEM + 128 * 1024), last ? 1 : 0, lds);
    }
    SEAM();
    { kargs_t K = KARGS();
      st_moe_gather((const bf16_t*)K[33], (bf16_t*)WSP(K, WS_H2S), (int*)WSP(K, WS_CTL), (const int*)WSP(K, WS_MOEM), (const float*)WSP(K, WS_MOEM + 128 * 1024),
                    (int*)WSP(K, WS_MOEM + 384 * 1024), (float*)WSP(K, WS_MOEM + 512 * 1024), (int*)WSP(K, WS_MOEM + 768 * 1024), last ? 1 : 0, lds);
    }
    SEAM();
    { kargs_t K = KARGS();
      pg8::Gemm g{1024, 1024, 1024}; SchedMoe S{(int)GDIM, BIDX, 1, (const int*)WSP(K, WS_CTL), (const char*)WSP(K, WS_H2S), (size_t)256 * 1024 * 2, (const char*)WSP(K, WS_WGU)};
      EpiMoe1 E{(bf16_t*)WSP(K, WS_ACT), (const float*)WSP(K, WS_MOEM + 512 * 1024)};
      pg8::gemm_phase<EpiMoe1, SchedMoe, true, true>((PG8_LAS unsigned char*)lds, g, S, E);
    }
    SEAM();
    { kargs_t K = KARGS();
      pg8::Gemm g{256, 512, 256}; SchedMoe S{(int)GDIM, BIDX, 2, (const int*)WSP(K, WS_CTL), (const char*)WSP(K, WS_ACT), (size_t)256 * 512 * 2, (const char*)WSP(K, WS_WD)};
      EpiMoe2 E{(bf16_t*)WSP(K, WS_H2S)};
      pg8::gemm_phase<EpiMoe2, SchedMoe, true, true>((PG8_LAS unsigned char*)lds, g, S, E);
    }
    SEAM();
  }
  { kargs_t K = KARGS(); st_final((float*)K[33], K[32], (const bf16_t*)WSP(K, WS_H), (const bf16_t*)WSP(K, WS_H2S), (const int*)WSP(K, WS_MOEM + 768 * 1024), (const float*)WSP(K, WS_MODV) + (size_t)5 * 6144 + 5120); }
}

extern "C" void kernel_launch(void* const* d_in, const int* in_sizes, int n_in, void* d_out, int out_size, void* d_ws, size_t ws_size, hipStream_t stream) {
  if (n_in != 33 || ws_size < WS_END) { fprintf(stderr, "kernel_launch: unexpected n_in %d / ws %zu\n", n_in, ws_size); return; }
  static int grid_blocks = 0;
  if (!grid_blocks) {
    int dev = 0, cus = 0, per_cu = 0;
    (void)hipGetDevice(&dev);
    (void)hipDeviceGetAttribute(&cus, hipDeviceAttributeMultiprocessorCount, dev);
    (void)hipFuncSetAttribute((const void*)mega, hipFuncAttributeMaxDynamicSharedMemorySize, LDS_BYTES);
    (void)hipOccupancyMaxActiveBlocksPerMultiprocessor(&per_cu, mega, NT, LDS_BYTES);
    if (per_cu < 1) per_cu = 1;
    if (per_cu > 2) per_cu = 2;
    grid_blocks = 256;
    if (cus != 256 || per_cu < 1) fprintf(stderr, "kernel_launch: expected 256 CUs with >= 1 workgroup each (got %d CUs, %d per CU)\n", cus, per_cu);
  }
  (void)hipMemsetAsync((char*)d_ws + WS_CTL + (size_t)CT_BAR * 4, 0, (size_t)XCD_BAR_WORDS * 4, stream);
  MP p{};
  for (int i = 0; i < 33; ++i) p.in[i] = (const float*)d_in[i];
  p.out = (float*)d_out; p.ws = (unsigned char*)d_ws;
  void* args[] = {&p};
  hipError_t e = hipLaunchCooperativeKernel((const void*)mega, dim3(grid_blocks), dim3(NT), args, LDS_BYTES, stream);
  if (e != hipSuccess) fprintf(stderr, "cooperative launch failed: %s (grid %d)\n", hipGetErrorString(e), grid_blocks);
}
```

```cpp
#include <hip/hip_runtime.h>
#include <hip/hip_cooperative_groups.h>
#include <cstdio>
#include <cstdint>
namespace cg = cooperative_groups;

typedef unsigned short bf16_t;
typedef short bf16x8 __attribute__((ext_vector_type(8)));
typedef float f32x4 __attribute__((ext_vector_type(4)));
typedef unsigned u32x4 __attribute__((ext_vector_type(4)));
typedef unsigned u32x2 __attribute__((ext_vector_type(2)));

constexpr int NB = 4, SEQ = 4096, CTXL = 256, DM = 1024, TPB = 4352, MTOK = NB * TPB;
constexpr int DIN = 2444, NPAD = 2560;
constexpr float EPS = 1e-6f;
constexpr float C2 = 0.125f * 1.4426950408889634f;
constexpr int MOE_ROWS = 23552;
constexpr int NT = 512;
constexpr int LDS_BYTES = 147456;

constexpr size_t MiB = 1u << 20;
constexpr size_t WS_CTL = 0;
constexpr size_t WS_MODV = 1 * MiB;
constexpr size_t WS_ROPE = 2 * MiB;
constexpr size_t WS_MOEM = 3 * MiB;
constexpr size_t WS_DT = 4 * MiB;
constexpr size_t WS_HKC = 5 * MiB;
constexpr size_t WS_XC = 6 * MiB;
constexpr size_t WS_WIN = 10 * MiB;
constexpr size_t WS_WOUT = 15 * MiB;
constexpr size_t WS_WGU = 17 * MiB;
constexpr size_t WS_WD = 33 * MiB;
constexpr size_t WS_HK = 41 * MiB;
constexpr size_t WS_H = 57 * MiB;
constexpr size_t WS_QK = 91 * MiB;
constexpr size_t WS_VZ = 108 * MiB;
constexpr size_t WS_XBC = 125 * MiB;
constexpr size_t WS_HY = WS_XBC + (size_t)MTOK * 768 * 2;
constexpr size_t WS_HYT = WS_HY + (size_t)MTOK * 768 * 2;
constexpr size_t WS_ST = WS_HYT + (size_t)MTOK * 768 * 2;
constexpr size_t WS_Y = WS_ST + (size_t)4 * 34 * 2 * 6 * 4096 * 4;
constexpr size_t WS_END = WS_Y + (size_t)MTOK * 384 * 4;
constexpr size_t WS_DEC = WS_DT + 900 * 1024;
constexpr size_t WS_H2S = WS_QK;
constexpr size_t WS_ACT = WS_H2S + (size_t)MOE_ROWS * 1024 * 2;
static_assert(WS_END <= 256 * MiB, "ws");
static_assert(WS_ACT + (size_t)MOE_ROWS * 512 * 2 <= WS_HYT, "moe alias");

constexpr int CT_CNT = 0, CT_FILL = 32, CT_BASE = 64, CT_NT = 96, CT_TP = 128;
constexpr int CT_BAR = 4096;
constexpr int CT_CNTB = 8192;

__device__ __forceinline__ int opq_v(int v) { asm volatile("" : "+v"(v)); return v; }
__device__ __forceinline__ int opq_s(int v) { asm volatile("" : "+s"(v)); return v; }
#define TIDX opq_v((int)threadIdx.x)
#define BIDX opq_s((int)blockIdx.x)
#define GDIM opq_s((int)gridDim.x)
__device__ __forceinline__ unsigned f2bf(float f) { unsigned u = __float_as_uint(f); return (u + 0x7fffu + ((u >> 16) & 1u)) >> 16; }
__device__ __forceinline__ unsigned pk2bf(float lo, float hi) { return f2bf(lo) | (f2bf(hi) << 16); }
__device__ __forceinline__ float bf2f(bf16_t h) { return __uint_as_float(((unsigned)h) << 16); }
__device__ __forceinline__ float wave_sum(float v) {
#pragma unroll
  for (int o = 1; o < 64; o <<= 1) v += __shfl_xor(v, o);
  return v;
}
__device__ __forceinline__ float siluf(float v) { return v / (1.0f + __expf(-v)); }
__device__ __forceinline__ float* xrow(const float* xl, const float* xc, int r) {
  const int b = r / TPB, j = r - b * TPB;
  return (float*)(j < CTXL ? xc + ((size_t)b * CTXL + j) * DM : xl + ((size_t)b * SEQ + (j - CTXL)) * DM);
}
__device__ __forceinline__ int mrow_of(int r) { const int b = r / TPB, j = r - b * TPB; return j < CTXL ? 4 : b; }

__device__ __forceinline__ void st_adaln(const float* c, const float* c_ctx, const float* w_mod, const float* b_mod, float* modv, char* lds) {
  float (*sc)[1024] = (float (*)[1024])lds;
  float (*red)[5][64] = (float (*)[5][64])(lds + 5 * 1024 * 4);
  const int tid = TIDX;
  for (int it = BIDX; it < 192; it += GDIM) {
    const int layer = it / 96, n0 = (it % 96) * 64;
    for (int i = tid; i < 5 * 1024; i += NT) { const int r = i >> 10, k = i & 1023; const float v = r < 4 ? c[r * 1024 + k] : c_ctx[k]; sc[r][k] = v / (1.0f + expf(-v)); }
    __syncthreads();
    const int kg = tid >> 6, n = tid & 63;
    float acc[5] = {0.f, 0.f, 0.f, 0.f, 0.f};
#pragma unroll 16
    for (int k = kg; k < 1024; k += 8) { const float w = w_mod[((size_t)layer * 1024 + k) * 6144 + n0 + n];
#pragma unroll
      for (int r = 0; r < 5; ++r) acc[r] += sc[r][k] * w; }
#pragma unroll
    for (int r = 0; r < 5; ++r) red[kg][r][n] = acc[r];
    __syncthreads();
    if (tid < 320) { const int r = tid >> 6, nn = tid & 63; float s = 0.f;
#pragma unroll
      for (int g = 0; g < 8; ++g) s += red[g][r][nn];
      modv[((size_t)layer * 5 + r) * 6144 + n0 + nn] = s + b_mod[layer * 6144 + n0 + nn]; }
    __syncthreads();
  }
}
__device__ __forceinline__ void st_rope(float* rope) {
  for (int i = BIDX * NT + TIDX; i < 4096 * 32; i += GDIM * NT) {
    const int t = i >> 5, d = i & 31, m = d & 15;
    const float inv = exp2f(-(float)(2 * m) * (13.287712379549449f / 32.0f));
    const float pos = (float)(d < 16 ? (t >> 6) : (t & 63));
    float rev = pos * inv * 0.15915494309189535f; rev -= floorf(rev);
    rope[2 * i] = __builtin_amdgcn_cosf(rev); rope[2 * i + 1] = __builtin_amdgcn_sinf(rev);
  }
}

__device__ __forceinline__ void st_normmod(const float* xl, const float* xc, bf16_t* XB, const bf16_t* YS, const int* tok_slot, const float* gate_prev,
                                           const float* g, const float* modv_layer, int off_sh, int off_sc, bf16_t* H, char* lds) {
  float* mA = (float*)lds; float* mB = mA + 5 * 1024; float* mG = mB + 5 * 1024;
  const int tid = TIDX, lane = tid & 63, gw = BIDX * 8 + (tid >> 6), ngw = GDIM * 8;
  for (int idx = tid; idx < 5 * 1024; idx += NT) { const int m = idx >> 10, k = idx & 1023; mA[idx] = g[k] * (1.f + modv_layer[(size_t)m * 6144 + off_sc + k]); mB[idx] = modv_layer[(size_t)m * 6144 + off_sh + k];
    mG[idx] = YS ? gate_prev[(size_t)m * 6144 + k] : 0.f; }
  __syncthreads();
  for (int rb = gw; rb < MTOK; rb += 3 * ngw) {
    f32x4 v[3][4]; float rstd[3];
    if (!YS) {
#pragma unroll
      for (int u = 0; u < 3; ++u) { const int r = rb + u * ngw, rc = r < MTOK ? r : MTOK - 1; const float* xr = xrow(xl, xc, rc);
#pragma unroll
        for (int j = 0; j < 4; ++j) v[u][j] = *(const f32x4*)(xr + 4 * lane + 256 * j); }
    } else {
      u32x2 xb[3][4], ys[3][4];
#pragma unroll
      for (int u = 0; u < 3; ++u) { const int r = rb + u * ngw, rc = r < MTOK ? r : MTOK - 1; const bf16_t* xr = XB + (size_t)rc * DM; const bf16_t* yr = YS + (size_t)tok_slot[rc] * DM;
#pragma unroll
        for (int j = 0; j < 4; ++j) { xb[u][j] = *(const u32x2*)(xr + 4 * lane + 256 * j); ys[u][j] = *(const u32x2*)(yr + 4 * lane + 256 * j); } }
#pragma unroll
      for (int u = 0; u < 3; ++u) { const int r = rb + u * ngw, rc = r < MTOK ? r : MTOK - 1; const int mo = mrow_of(rc) * 1024;
#pragma unroll
        for (int j = 0; j < 4; ++j) { const int k = 4 * lane + 256 * j; const f32x4 g4 = *(const f32x4*)(mG + mo + k);
          const f32x4 x4 = (f32x4){__uint_as_float(xb[u][j].x << 16), __uint_as_float(xb[u][j].x & 0xffff0000u), __uint_as_float(xb[u][j].y << 16), __uint_as_float(xb[u][j].y & 0xffff0000u)};
          const f32x4 m4 = (f32x4){__uint_as_float(ys[u][j].x << 16), __uint_as_float(ys[u][j].x & 0xffff0000u), __uint_as_float(ys[u][j].y << 16), __uint_as_float(ys[u][j].y & 0xffff0000u)};
          v[u][j] = x4 + g4 * m4;
          if (r < MTOK) { u32x2 w; w.x = pk2bf(v[u][j].x, v[u][j].y); w.y = pk2bf(v[u][j].z, v[u][j].w); *(u32x2*)(XB + (size_t)r * DM + k) = w; } } }
    }
#pragma unroll
    for (int u = 0; u < 3; ++u) { float ss = 0.f;
#pragma unroll
      for (int j = 0; j < 4; ++j) ss += v[u][j].x * v[u][j].x + v[u][j].y * v[u][j].y + v[u][j].z * v[u][j].z + v[u][j].w * v[u][j].w;
      rstd[u] = rsqrtf(wave_sum(ss) * (1.0f / DM) + EPS); }
#pragma unroll
    for (int u = 0; u < 3; ++u) { const int r = rb + u * ngw;
      if (r < MTOK) { const int mo = mrow_of(r) * 1024;
#pragma unroll
        for (int j = 0; j < 4; ++j) { const int k = 4 * lane + 256 * j;
          const f32x4 a4 = *(const f32x4*)(mA + mo + k), b4 = *(const f32x4*)(mB + mo + k); const f32x4 o = v[u][j] * rstd[u] * a4 + b4;
          u32x2 w; w.x = pk2bf(o.x, o.y); w.y = pk2bf(o.z, o.w);
          *(u32x2*)(H + (size_t)r * DM + k) = w; } } }
  }
  __syncthreads();
}

template <int MODE> __device__ __forceinline__ void tr_wave_item(const float* src, const float* src2, int ldsrc, int K, bf16_t* out, int n0, int k0, float* scr, int lane) {
  const int nn = lane & 31, n = n0 + nn;
#pragma unroll 8
  for (int i = 0; i < 32; ++i) { const int kk = 2 * i + (lane >> 5); float v = 0.f;
    if (MODE == 0) { const int col = n < 1676 ? n : (n < 1792 ? -1 : n - 116); if (col >= 0) v = src[(size_t)(k0 + kk) * ldsrc + col]; }
    else if (MODE == 1) v = src[(size_t)(k0 + kk) * ldsrc + n];
    else v = (n & 1) ? src2[(size_t)(k0 + kk) * ldsrc + (n >> 1)] : src[(size_t)(k0 + kk) * ldsrc + (n >> 1)];
    scr[kk * 33 + nn] = v; }
  asm volatile("s_waitcnt lgkmcnt(0)" ::: "memory");
  const int c = lane & 7;
#pragma unroll
  for (int j = 0; j < 4; ++j) { const int nr = (lane >> 3) + 8 * j; const float* sp = scr + (8 * c) * 33 + nr;
    u32x4 o; o.x = f2bf(sp[0]) | (f2bf(sp[33]) << 16); o.y = f2bf(sp[66]) | (f2bf(sp[99]) << 16); o.z = f2bf(sp[132]) | (f2bf(sp[165]) << 16); o.w = f2bf(sp[198]) | (f2bf(sp[231]) << 16);
    *(u32x4*)(out + (size_t)(n0 + nr) * K + k0 + 8 * c) = o; }
  asm volatile("s_waitcnt lgkmcnt(0)" ::: "memory");
}
__device__ __forceinline__ void st_weights(const float* w_in, const float* w_out, const float* w_gate, const float* w_up, const float* w_down, int layer,
                                           bf16_t* WIN, bf16_t* WOUT, bf16_t* WGU, bf16_t* WD, char* lds) {
  const int tid = TIDX, lane = tid & 63, w = tid >> 6; float* scr = (float*)lds + w * (64 * 33);
  for (int it = BIDX * 8 + w; it < 7936; it += GDIM * 8) {
    if (it < 1280) tr_wave_item<0>(w_in + (size_t)layer * 1024 * DIN, nullptr, DIN, 1024, WIN, (it % 80) * 32, (it / 80) * 64, scr, lane);
    else if (it < 1792) { const int i2 = it - 1280; tr_wave_item<1>(w_out + (size_t)layer * 1024 * 1024, nullptr, 1024, 1024, WOUT, (i2 & 31) * 32, (i2 >> 5) * 64, scr, lane); }
    else if (it < 5888) { const int i2 = it - 1792, e = i2 >> 8, t = i2 & 255;
      tr_wave_item<2>(w_gate + ((size_t)layer * 16 + e) * 1024 * 256, w_up + ((size_t)layer * 16 + e) * 1024 * 256, 256, 1024, WGU + (size_t)e * 512 * 1024, (t & 15) * 32, (t >> 4) * 64, scr, lane); }
    else { const int i2 = it - 5888, e = i2 >> 7, t = i2 & 127;
      tr_wave_item<1>(w_down + ((size_t)layer * 16 + e) * 256 * 1024, nullptr, 1024, 256, WD + (size_t)e * 1024 * 256, (t & 31) * 32, (t >> 5) * 64, scr, lane); }
  }
  __syncthreads();
}

__device__ __forceinline__ void pair_experts(int pidx, int& eA, int& eB) {
  const int g = pidx / 6, t = pidx - 6 * g; const int i = t < 3 ? 0 : (t < 5 ? 1 : 2); const int j = t < 3 ? t + 1 : (t < 5 ? t - 1 : 3);
  eA = 4 * g + i; eB = 4 * g + j;
}
__device__ __forceinline__ void st_prep_qk(bf16_t* QK, const float* qn, const float* kn, const float* rope) {
  const int lane = TIDX & 63, gw = BIDX * 8 + (TIDX >> 6), ngw = GDIM * 8, hh = lane >> 3, sub = lane & 7;
  float gn[8];
#pragma unroll
  for (int e = 0; e < 8; ++e) gn[e] = ((hh < 6 ? qn : kn) + sub * 8)[e] * (hh < 6 ? C2 : 1.0f);
  for (int rb = gw; rb < MTOK; rb += 3 * ngw) {
    bf16x8 raw[3]; f32x4 rp4[3][4];
#pragma unroll
    for (int u = 0; u < 3; ++u) { const int r = rb + u * ngw < MTOK ? rb + u * ngw : MTOK - 1; const int j = r % TPB, t = j >= CTXL ? j - CTXL : 0;
      raw[u] = *(const bf16x8*)(QK + (size_t)r * 512 + hh * 64 + sub * 8);
      const float* rp = rope + ((size_t)t * 32 + (sub & 3) * 8) * 2;
#pragma unroll
      for (int q = 0; q < 4; ++q) rp4[u][q] = *(const f32x4*)(rp + 4 * q); }
#pragma unroll
    for (int u = 0; u < 3; ++u) { const int r = rb + u * ngw; const int j = (r < MTOK ? r : MTOK - 1) % TPB;
      float v[8]; float ss = 0.f;
#pragma unroll
      for (int e = 0; e < 8; ++e) { v[e] = bf2f((bf16_t)raw[u][e]); ss += v[e] * v[e]; }
      ss += __shfl_xor(ss, 1); ss += __shfl_xor(ss, 2); ss += __shfl_xor(ss, 4);
      const float rstd = rsqrtf(ss * (1.0f / 64.0f) + EPS);
#pragma unroll
      for (int e = 0; e < 8; ++e) v[e] = v[e] * rstd * gn[e];
      if (j >= CTXL) {
#pragma unroll
        for (int e = 0; e < 8; ++e) { const float other = __shfl_xor(v[e], 4); const float cs = rp4[u][e >> 1][(e & 1) * 2], sn = rp4[u][e >> 1][(e & 1) * 2 + 1]; v[e] = sub < 4 ? v[e] * cs - other * sn : v[e] * cs + other * sn; } }
      if (r < MTOK) *(u32x4*)(QK + (size_t)r * 512 + hh * 64 + sub * 8) = (u32x4){pk2bf(v[0], v[1]), pk2bf(v[2], v[3]), pk2bf(v[4], v[5]), pk2bf(v[6], v[7])}; }
  }
}

__device__ __forceinline__ void st_prep_hy(const bf16_t* HY, const float* cw, const float* cb, bf16_t* HYT, int do_ctx, char* lds) {
  const int tid = TIDX, lane = tid & 63, w = tid >> 6; float* tile = (float*)lds + w * (66 * 33);
  const int nlat = 4 * 64 * 24, nitem = nlat + (do_ctx ? 4 * 4 * 24 : 0), step = (GDIM - 48) * 8;
  bf16x8 raw[5];
#define PHY_DECODE(it) int b, tt, ct, L, joff; bf16_t* outb; \
    if ((it) < nlat) { b = (it) / 1536; tt = ((it) % 1536) / 24; ct = (it) % 24; L = SEQ; joff = CTXL; outb = HYT + (size_t)b * 768 * SEQ; } \
    else { const int i2 = (it) - nlat; b = i2 / 96; tt = (i2 % 96) / 24; ct = i2 % 24; L = CTXL; joff = 0; outb = HYT + (size_t)4 * 768 * SEQ + (size_t)b * 768 * CTXL; } \
    const int t0 = tt * 64, c0 = ct * 32; (void)outb;
#define PHY_LOADS(it) do { PHY_DECODE(it) _Pragma("unroll") for (int i = 0; i < 5; ++i) { const int rr = (lane >> 2) + 16 * i, c8 = (lane & 3) * 8; int t = t0 - 1 + rr; const bool ok = rr < 66 && t >= 0 && t < L; t = ok ? t : t0; \
      const bf16x8 v = *(const bf16x8*)(HY + ((size_t)b * TPB + joff + t) * 768 + c0 + c8); raw[i] = ok ? v : (bf16x8){0, 0, 0, 0, 0, 0, 0, 0}; } } while (0)
  int it = BIDX >= 48 ? (BIDX - 48) * 8 + w : nitem;
  if (it < nitem) PHY_LOADS(it);
  for (; it < nitem; it += step) {
    PHY_DECODE(it)
#pragma unroll
    for (int i = 0; i < 5; ++i) { const int rr = (lane >> 2) + 16 * i, c8 = (lane & 3) * 8;
      if (rr < 66) {
#pragma unroll
        for (int e = 0; e < 8; ++e) tile[rr * 33 + c8 + e] = bf2f((bf16_t)raw[i][e]); } }
    asm volatile("s_waitcnt lgkmcnt(0)" ::: "memory");
    if (it + step < nitem) PHY_LOADS(it + step);
#pragma unroll 4
    for (int cc = 0; cc < 32; ++cc) { const int c = c0 + cc;
      const float v = cw[c] * tile[lane * 33 + cc] + cw[768 + c] * tile[(lane + 1) * 33 + cc] + cw[1536 + c] * tile[(lane + 2) * 33 + cc] + cb[c];
      outb[(size_t)c * L + t0 + lane] = (bf16_t)f2bf(v); }
    asm volatile("s_waitcnt lgkmcnt(0)" ::: "memory");
  }
#undef PHY_LOADS
#undef PHY_DECODE
  __syncthreads();
}

template <int L> __device__ __forceinline__ void hyfilt_item(int item, const float* w1, const float* b1, const float* fr, const float* w2, const float* b2, const float* w3, float* HK, char* lds) {
  float* F = (float*)lds; float* W1 = F + 64 * 37; float* H1 = W1 + 36 * 68; float* W2 = H1 + 64 * 68; float* S1 = W2 + 64 * 68;
  const int tid = TIDX, n0 = (item >> 2) * 64, cq = item & 3, lane = tid & 63, wv = tid >> 6, l15 = lane & 15, l4 = lane >> 4;
  for (int e = tid; e < 64 * 36; e += NT) { const int pp = e / 36, f = e % 36; const int n = n0 + pp; float v = 0.f;
    if (f == 0) v = (float)n / (float)(L - 1);
    else if (f < 33) { const int m = (f - 1) & 15; const float band = 1e-4f + (float)m * ((15.0f - 1e-4f) / 15.0f); float rev = ((float)n * (1.0f / (float)L)) * band; rev -= floorf(rev);
      v = f <= 16 ? __builtin_amdgcn_cosf(rev) : -__builtin_amdgcn_sinf(rev); }
    F[pp * 37 + f] = v; }
  for (int e = tid; e < 36 * 64; e += NT) { const int k = e >> 6, j = e & 63; W1[k * 68 + j] = k < 33 ? w1[k * 64 + j] : 0.f; }
  for (int e = tid; e < 64 * 64; e += NT) { const int k = e >> 6, j = e & 63; W2[k * 68 + j] = w2[e]; }
  __syncthreads();
  { const int pt = wv >> 1, c0 = 32 * (wv & 1);
    f32x4 acc[2] = {(f32x4){0.f, 0.f, 0.f, 0.f}, (f32x4){0.f, 0.f, 0.f, 0.f}};
#pragma unroll
    for (int kk = 0; kk < 9; ++kk) { const float av = F[(pt * 16 + l15) * 37 + 4 * kk + l4];
      acc[0] = __builtin_amdgcn_mfma_f32_16x16x4f32(av, W1[(4 * kk + l4) * 68 + c0 + l15], acc[0], 0, 0, 0);
      acc[1] = __builtin_amdgcn_mfma_f32_16x16x4f32(av, W1[(4 * kk + l4) * 68 + c0 + 16 + l15], acc[1], 0, 0, 0); }
#pragma unroll
    for (int ct = 0; ct < 2; ++ct) { const int j = c0 + 16 * ct + l15; const float bj = b1[j], fj = fr[j] * 0.15915494309189535f;
#pragma unroll
      for (int rg = 0; rg < 4; ++rg) { float rev = fj * (acc[ct][rg] + bj); rev -= floorf(rev); H1[(pt * 16 + 4 * l4 + rg) * 68 + j] = __builtin_amdgcn_sinf(rev); } } }
  __syncthreads();
  { const int pt = wv >> 1, c0 = 32 * (wv & 1);
    f32x4 acc[2] = {(f32x4){0.f, 0.f, 0.f, 0.f}, (f32x4){0.f, 0.f, 0.f, 0.f}};
#pragma unroll
    for (int kk = 0; kk < 16; ++kk) { const float av = H1[(pt * 16 + l15) * 68 + 4 * kk + l4];
      acc[0] = __builtin_amdgcn_mfma_f32_16x16x4f32(av, W2[(4 * kk + l4) * 68 + c0 + l15], acc[0], 0, 0, 0);
      acc[1] = __builtin_amdgcn_mfma_f32_16x16x4f32(av, W2[(4 * kk + l4) * 68 + c0 + 16 + l15], acc[1], 0, 0, 0); }
#pragma unroll
    for (int ct = 0; ct < 2; ++ct) { const int j = c0 + 16 * ct + l15; const float bj = b2[j], fj = fr[j] * 0.15915494309189535f;
#pragma unroll
      for (int rg = 0; rg < 4; ++rg) { float rev = fj * (acc[ct][rg] + bj); rev -= floorf(rev); S1[(pt * 16 + 4 * l4 + rg) * 68 + j] = __builtin_amdgcn_sinf(rev); } } }
  __syncthreads();
  {
    const int colb = cq * 256 + 32 * wv;
    f32x4 acc[4][2];
#pragma unroll
    for (int pt = 0; pt < 4; ++pt) { acc[pt][0] = (f32x4){0.f, 0.f, 0.f, 0.f}; acc[pt][1] = (f32x4){0.f, 0.f, 0.f, 0.f}; }
#pragma unroll 4
    for (int kk = 0; kk < 16; ++kk) { const int k = 4 * kk + l4;
      const float bv0 = w3[k * 1024 + colb + l15], bv1 = w3[k * 1024 + colb + 16 + l15];
#pragma unroll
      for (int pt = 0; pt < 4; ++pt) { const float av = S1[(pt * 16 + l15) * 68 + k];
        acc[pt][0] = __builtin_amdgcn_mfma_f32_16x16x4f32(av, bv0, acc[pt][0], 0, 0, 0);
        acc[pt][1] = __builtin_amdgcn_mfma_f32_16x16x4f32(av, bv1, acc[pt][1], 0, 0, 0); } }
#pragma unroll
    for (int ct = 0; ct < 2; ++ct) { const int col = colb + 16 * ct + l15, dir = col >> 9, order = (col >> 8) & 1, c = col & 255;
      const float delta = 3.0701134573253943f + (float)c * ((15.350567286626972f - 3.0701134573253943f) / 255.0f);
      float* dst = HK + ((size_t)order * 256 + c) * (2 * L);
#pragma unroll
      for (int pt = 0; pt < 4; ++pt) { const int nb = n0 + pt * 16 + 4 * l4; f32x4 o;
#pragma unroll
        for (int rg = 0; rg < 4; ++rg) o[rg] = acc[pt][ct][rg] * __expf(-((float)(nb + rg) / (float)(L - 1)) * delta);
        if (dir == 0) *(f32x4*)(dst + nb) = o;
        else {
#pragma unroll
          for (int rg = 0; rg < 4; ++rg) { const int n = nb + rg; if (n >= 1) dst[2 * L - n] = o[rg]; else dst[L] = 0.f; } } } }
  }
  __syncthreads();
}

__device__ __forceinline__ void hyconv_ctx_item(int item, const bf16_t* HYTC, const float* HKC, const float* hy_bias, bf16_t* MIX, char* lds) {
  constexpr int L = CTXL;
  const int tid = TIDX, b = item >> 4, cc = tid >> 5, c = (item & 15) * 16 + cc, sub = tid & 31, tb = 8 * sub;
  float* kern = (float*)lds + cc * (2 * L); float* z = (float*)lds + 16 * 2 * L + cc * L;
  const bf16_t* vp = HYTC + ((size_t)b * 768 + c) * L; const bf16_t* x1p = vp + (size_t)256 * L; const bf16_t* x2p = vp + (size_t)512 * L;
#pragma unroll 1
  for (int o = 0; o < 2; ++o) {
    if (o == 0) for (int t = sub; t < L; t += 32) z[t] = bf2f(vp[t]);
    const float* kp = HKC + ((size_t)o * 256 + c) * (2 * L);
    for (int t = sub; t < 2 * L; t += 32) kern[t] = kp[t];
    __syncthreads();
    float acc[8], W[16];
#pragma unroll
    for (int i = 0; i < 8; ++i) { acc[i] = 0.f; W[8 + i] = kern[(tb + i) & (2 * L - 1)]; }
    for (int s0 = 0; s0 < L; s0 += 8) {
      const int bb = (tb - s0 - 8) & (2 * L - 1);
#pragma unroll
      for (int i = 0; i < 8; ++i) W[i] = kern[bb + i];
      float zs[8];
#pragma unroll
      for (int j = 0; j < 8; ++j) zs[j] = z[s0 + j];
#pragma unroll
      for (int j = 0; j < 8; ++j)
#pragma unroll
        for (int i = 0; i < 8; ++i) acc[i] += W[8 + i - j] * zs[j];
#pragma unroll
      for (int i = 0; i < 8; ++i) W[8 + i] = W[i];
    }
    __syncthreads();
    const float bias = hy_bias[o * 256 + c];
#pragma unroll
    for (int i = 0; i < 8; ++i) { const int t = tb + i; const float zz = acc[i] + bias * z[t];
      if (o == 0) z[t] = bf2f(x1p[t]) * zz;
      else MIX[((size_t)b * TPB + t) * DM + 768 + c] = (bf16_t)f2bf(bf2f(x2p[t]) * zz); }
    __syncthreads();
  }
}

__device__ __forceinline__ void ssd_conv8(const bf16_t* XBC, size_t r, int c0, bool hasp, bool hasn, const float* cw, const float* cb, float (&o)[8]) {
  const bf16x8 cur = *(const bf16x8*)(XBC + r * 768 + c0);
  const bf16x8 prv = *(const bf16x8*)(XBC + (hasp ? r - 1 : r) * 768 + c0), nxt = *(const bf16x8*)(XBC + (hasn ? r + 1 : r) * 768 + c0);
  const float wp = hasp ? 1.f : 0.f, wn = hasn ? 1.f : 0.f;
#pragma unroll
  for (int e = 0; e < 8; ++e) { const float v = wp * cw[c0 + e] * bf2f((bf16_t)prv[e]) + cw[640 + c0 + e] * bf2f((bf16_t)cur[e]) + wn * cw[1280 + c0 + e] * bf2f((bf16_t)nxt[e]) + cb[c0 + e]; o[e] = siluf(v); }
}
__device__ __forceinline__ float softplusf(float x) {
  const float y = __expf(-fabsf(x)); const float l = y < 0.06f ? y * (1.f - y * (0.5f - y * (0.33333334f - 0.25f * y))) : __logf(1.f + y); return fmaxf(x, 0.f) + l; }
__device__ __forceinline__ void wave_scan128(float e0, float e1, int lane, float& c0, float& c1) {
  float x = e0 + e1;
#pragma unroll
  for (int o = 1; o < 64; o <<= 1) { const float v = __shfl_up(x, o); if (lane >= o) x += v; }
  const float excl = x - (e0 + e1); c0 = excl + e0; c1 = excl + e0 + e1;
}
__device__ __forceinline__ int ssd_chunk_j0(int cidx) { return cidx < 2 ? cidx * 128 : CTXL + (cidx - 2) * 128; }

__device__ __forceinline__ void st_ssd1(int it0, int step, int nitems, const bf16_t* XBC, const float* DT, const float* cw, const float* cb, const float* dt_bias, const float* a_log,
                                        bf16_t* YIN, bf16_t* ST, float* DEC, char* lds) {
  bf16_t (*Cm)[72] = (bf16_t (*)[72])lds; bf16_t (*Bm)[72] = (bf16_t (*)[72])(lds + 18432);
  bf16_t (*BT)[136] = (bf16_t (*)[136])(lds + 36864); bf16_t (*Xt)[136] = (bf16_t (*)[136])(lds + 54272); bf16_t (*Mm)[136] = (bf16_t (*)[136])(lds + 71680);
  float* tab = (float*)(lds + 106496); float* dtf = tab; float* dtb = tab + 128; float* acf = tab + 256; float* acb = tab + 384; float* wf = tab + 512; float* wb = tab + 640;
  const int tid = TIDX;
  bf16x8 cu[6], pv[6], nx[6];
#define SSD1_LOADS(itm, I0, I1) do { const int h_ = (itm) % 6, bc_ = (itm) / 6, cidx_ = bc_ % 34, b_ = bc_ / 34, g_ = h_ / 3, j0_ = ssd_chunk_j0(cidx_); const size_t r0_ = (size_t)b_ * TPB + j0_; \
    _Pragma("unroll") for (int i = (I0); i < (I1); ++i) { const int task = tid + NT * i, t = task / 24, cg = task % 24, kind = cg >> 3, q = cg & 7, j = j0_ + t; \
      const int c0 = kind == 0 ? h_ * 64 + 8 * q : (kind == 1 ? 384 + g_ * 64 + 8 * q : 512 + g_ * 64 + 8 * q); \
      const bool hasp = j != 0 && j != CTXL, hasn = j != CTXL - 1 && j != TPB - 1; const bf16_t* p = XBC + (r0_ + t) * 768 + c0; \
      cu[i] = *(const bf16x8*)p; pv[i] = *(const bf16x8*)(p + (hasp ? -768 : 0)); nx[i] = *(const bf16x8*)(p + (hasn ? 768 : 0)); } } while (0)
  if (it0 < nitems) SSD1_LOADS(it0, 0, 6);
#pragma unroll 1
  for (int item = it0; item < nitems; item += step) {
  const int tid = TIDX, lane = tid & 63, w = tid >> 6, l15 = lane & 15, l4 = lane >> 4;
  const int h = item % 6, bc = item / 6, cidx = bc % 34, b = bc / 34, g = h / 3, j0 = ssd_chunk_j0(cidx);
  const size_t r0 = (size_t)b * TPB + j0;
  float dtr0 = 0.f, dtr1 = 0.f;
  if (w < 2) { const int t0 = w == 0 ? 2 * lane : 127 - 2 * lane, t1 = w == 0 ? 2 * lane + 1 : 126 - 2 * lane; dtr0 = DT[(r0 + t0) * 12 + w * 6 + h]; dtr1 = DT[(r0 + t1) * 12 + w * 6 + h]; }
  SSD1_LOADS(item, 6, 6);
  {
#pragma unroll
    for (int i = 0; i < 6; ++i) { const int task = tid + NT * i, t = task / 24, cg = task % 24, kind = cg >> 3, q = cg & 7, j = j0 + t;
      const int c0 = kind == 0 ? h * 64 + 8 * q : (kind == 1 ? 384 + g * 64 + 8 * q : 512 + g * 64 + 8 * q);
      const float wp = (j != 0 && j != CTXL) ? 1.f : 0.f, wn = (j != CTXL - 1 && j != TPB - 1) ? 1.f : 0.f;
      float o[8];
#pragma unroll
      for (int e = 0; e < 8; ++e) o[e] = siluf(wp * cw[c0 + e] * bf2f((bf16_t)pv[i][e]) + cw[640 + c0 + e] * bf2f((bf16_t)cu[i][e]) + wn * cw[1280 + c0 + e] * bf2f((bf16_t)nx[i][e]) + cb[c0 + e]);
      if (kind == 0) {
#pragma unroll
        for (int e = 0; e < 8; ++e) Xt[8 * q + e][t] = (bf16_t)f2bf(o[e]);
      } else { const u32x4 pk = (u32x4){pk2bf(o[0], o[1]), pk2bf(o[2], o[3]), pk2bf(o[4], o[5]), pk2bf(o[6], o[7])};
        if (kind == 1) { *(u32x4*)&Bm[t][8 * q] = pk;
#pragma unroll
          for (int e = 0; e < 8; ++e) BT[8 * q + e][t] = (bf16_t)f2bf(o[e]); }
        else *(u32x4*)&Cm[t][8 * q] = pk; } }
  }
  if (w < 2) { const int dir = w; const float a = -expf(a_log[dir * 6 + h]), bias = dt_bias[dir * 6 + h];
    const int t0 = dir == 0 ? 2 * lane : 127 - 2 * lane, t1 = dir == 0 ? 2 * lane + 1 : 126 - 2 * lane;
    const float d0 = softplusf(dtr0 + bias), d1 = softplusf(dtr1 + bias);
    float c0, c1; wave_scan128(d0 * a, d1 * a, lane, c0, c1);
    const float tot = __shfl(c1, 63);
    float* dtt = dir == 0 ? dtf : dtb; float* ac = dir == 0 ? acf : acb; float* ww = dir == 0 ? wf : wb;
    dtt[t0] = d0; dtt[t1] = d1; ac[t0] = c0; ac[t1] = c1; ww[t0] = __expf(tot - c0) * d0; ww[t1] = __expf(tot - c1) * d1;
    if (lane == 0) DEC[(((size_t)b * 34 + cidx) * 2 + dir) * 6 + h] = __expf(tot); }
  __syncthreads();
  if (item + step < nitems) SSD1_LOADS(item + step, 0, 6);
  {
    f32x4 accG[8];
#pragma unroll
    for (int ni = 0; ni < 8; ++ni) accG[ni] = (f32x4){0.f, 0.f, 0.f, 0.f};
#pragma unroll
    for (int kk = 0; kk < 2; ++kk) { const bf16x8 a = *(const bf16x8*)&Cm[16 * w + l15][32 * kk + 8 * l4];
#pragma unroll
      for (int ni = 0; ni < 8; ++ni) { const bf16x8 bb = *(const bf16x8*)&Bm[16 * ni + l15][32 * kk + 8 * l4]; accG[ni] = __builtin_amdgcn_mfma_f32_16x16x32_bf16(a, bb, accG[ni], 0, 0, 0); } }
    float aft[4], abt[4];
#pragma unroll
    for (int rg = 0; rg < 4; ++rg) { aft[rg] = acf[16 * w + 4 * l4 + rg]; abt[rg] = acb[16 * w + 4 * l4 + rg]; }
#pragma unroll
    for (int ni = 0; ni < 8; ++ni) { const int sidx = 16 * ni + l15; const float afs = acf[sidx], abs_ = acb[sidx], dfs = dtf[sidx], dbs = dtb[sidx];
#pragma unroll
      for (int rg = 0; rg < 4; ++rg) { const int t = 16 * w + 4 * l4 + rg;
        const float f = sidx <= t ? __expf(aft[rg] - afs) * dfs : 0.f, bk = sidx >= t ? __expf(abt[rg] - abs_) * dbs : 0.f;
        Mm[t][sidx] = (bf16_t)f2bf(accG[ni][rg] * (f + bk)); } }
  }
  __syncthreads();
  {
    f32x4 acc[4];
#pragma unroll
    for (int ni = 0; ni < 4; ++ni) acc[ni] = (f32x4){0.f, 0.f, 0.f, 0.f};
#pragma unroll
    for (int kk = 0; kk < 4; ++kk) { const bf16x8 a = *(const bf16x8*)&Mm[16 * w + l15][32 * kk + 8 * l4];
#pragma unroll
      for (int ni = 0; ni < 4; ++ni) { const bf16x8 bb = *(const bf16x8*)&Xt[16 * ni + l15][32 * kk + 8 * l4]; acc[ni] = __builtin_amdgcn_mfma_f32_16x16x32_bf16(a, bb, acc[ni], 0, 0, 0); } }
#pragma unroll
    for (int rg = 0; rg < 4; ++rg)
#pragma unroll
      for (int ni = 0; ni < 4; ++ni) YIN[(r0 + 16 * w + 4 * l4 + rg) * 384 + h * 64 + 16 * ni + l15] = (bf16_t)f2bf(acc[ni][rg]);
  }
  {
    const int dir = w >> 2, mt = w & 3; const float* ww = dir == 0 ? wf : wb;
    f32x4 acc[4];
#pragma unroll
    for (int ni = 0; ni < 4; ++ni) acc[ni] = (f32x4){0.f, 0.f, 0.f, 0.f};
#pragma unroll
    for (int kk = 0; kk < 4; ++kk) { const bf16x8 raw = *(const bf16x8*)&Xt[16 * mt + l15][32 * kk + 8 * l4];
      const f32x4 w0 = *(const f32x4*)(ww + 32 * kk + 8 * l4), w1 = *(const f32x4*)(ww + 32 * kk + 8 * l4 + 4);
      u32x4 pk; pk.x = pk2bf(bf2f((bf16_t)raw[0]) * w0.x, bf2f((bf16_t)raw[1]) * w0.y); pk.y = pk2bf(bf2f((bf16_t)raw[2]) * w0.z, bf2f((bf16_t)raw[3]) * w0.w);
      pk.z = pk2bf(bf2f((bf16_t)raw[4]) * w1.x, bf2f((bf16_t)raw[5]) * w1.y); pk.w = pk2bf(bf2f((bf16_t)raw[6]) * w1.z, bf2f((bf16_t)raw[7]) * w1.w);
      const bf16x8 a = __builtin_bit_cast(bf16x8, pk);
#pragma unroll
      for (int ni = 0; ni < 4; ++ni) { const bf16x8 bb = *(const bf16x8*)&BT[16 * ni + l15][32 * kk + 8 * l4]; acc[ni] = __builtin_amdgcn_mfma_f32_16x16x32_bf16(a, bb, acc[ni], 0, 0, 0); } }
    bf16_t* sp = ST + ((((size_t)b * 34 + cidx) * 2 + dir) * 6 + h) * 4096;
#pragma unroll
    for (int rg = 0; rg < 4; ++rg)
#pragma unroll
      for (int ni = 0; ni < 4; ++ni) sp[(16 * mt + 4 * l4 + rg) * 64 + 16 * ni + l15] = (bf16_t)f2bf(acc[ni][rg]);
  }
  __syncthreads();
  }
#undef SSD1_LOADS
}

__device__ __forceinline__ void st_ssd_scan2(bf16_t* ST, const float* DEC) {
  for (int idx = BIDX * NT + TIDX; idx < 4 * 2 * 6 * 2048; idx += GDIM * NT) {
    const int e = (idx & 2047) * 2, bdh = idx >> 11, h = bdh % 6, dir = (bdh / 6) & 1, b = bdh / 12;
    unsigned v[34]; float d[34];
#pragma unroll
    for (int st = 0; st < 34; ++st) { const int cidx = dir == 0 ? st : (st < 2 ? 1 - st : 35 - st); const size_t o = (((size_t)b * 34 + cidx) * 2 + dir) * 6 + h; v[st] = *(const unsigned*)(ST + o * 4096 + e); d[st] = DEC[o]; }
    float H0 = 0.f, H1 = 0.f;
#pragma unroll
    for (int st = 0; st < 34; ++st) { const int cidx = dir == 0 ? st : (st < 2 ? 1 - st : 35 - st); const size_t o = (((size_t)b * 34 + cidx) * 2 + dir) * 6 + h;
      *(unsigned*)(ST + o * 4096 + e) = pk2bf(H0, H1); H0 = H0 * d[st] + __uint_as_float(v[st] << 16); H1 = H1 * d[st] + __uint_as_float(v[st] & 0xffff0000u); }
  }
}

__device__ __forceinline__ void ssd3_item(int b, int cidx, int g, const bf16_t* XBC, const bf16_t* VZ, const float* DT, const float* cw, const float* cb, const float* dt_bias, const float* a_log,
                                          const float* dskip, const float* nw, const bf16_t* YIN, const bf16_t* ST, bf16_t* MIX, char* lds) {
  bf16_t (*Cm)[72] = (bf16_t (*)[72])lds; bf16_t (*Hm)[72] = (bf16_t (*)[72])(lds + 18432);
  float* ef = (float*)(lds + 18432 + 55296);
  float (*Yt)[196] = (float (*)[196])lds;
  const int tid = TIDX, lane = tid & 63, w = tid >> 6, l15 = lane & 15, l4 = lane >> 4, j0 = ssd_chunk_j0(cidx);
  const size_t r0 = (size_t)b * TPB + j0;
#pragma unroll
  for (int i = 0; i < 2; ++i) { const int task = tid + NT * i, t = task >> 3, q = task & 7, j = j0 + t;
    float o[8]; ssd_conv8(XBC, r0 + t, 512 + g * 64 + 8 * q, j != 0 && j != CTXL, j != CTXL - 1 && j != TPB - 1, cw, cb, o);
    *(u32x4*)&Cm[t][8 * q] = (u32x4){pk2bf(o[0], o[1]), pk2bf(o[2], o[3]), pk2bf(o[4], o[5]), pk2bf(o[6], o[7])}; }
#pragma unroll
  for (int i = 0; i < 6; ++i) { const int f8 = tid + NT * i, hd = f8 >> 9, rem = f8 & 511, p = rem >> 3, n8 = (rem & 7) * 8, hh = hd >> 1, dir = hd & 1;
    *(u32x4*)&Hm[hd * 64 + p][n8] = *(const u32x4*)(ST + ((((size_t)b * 34 + cidx) * 2 + dir) * 6 + 3 * g + hh) * 4096 + p * 64 + n8); }
  if (w < 6) { const int hh = w >> 1, dir = w & 1, h = 3 * g + hh; const float a = -expf(a_log[dir * 6 + h]), bias = dt_bias[dir * 6 + h];
    const int t0 = dir == 0 ? 2 * lane : 127 - 2 * lane, t1 = dir == 0 ? 2 * lane + 1 : 126 - 2 * lane;
    const float d0 = softplusf(DT[(r0 + t0) * 12 + dir * 6 + h] + bias), d1 = softplusf(DT[(r0 + t1) * 12 + dir * 6 + h] + bias);
    float c0, c1; wave_scan128(d0 * a, d1 * a, lane, c0, c1);
    ef[w * 128 + t0] = __expf(c0); ef[w * 128 + t1] = __expf(c1); }
  __syncthreads();
  float yv[3][4][4];
  {
    bf16x8 ca[2];
#pragma unroll
    for (int kk = 0; kk < 2; ++kk) ca[kk] = *(const bf16x8*)&Cm[16 * w + l15][32 * kk + 8 * l4];
#pragma unroll
    for (int hh = 0; hh < 3; ++hh) {
      f32x4 accF[4], accB[4];
#pragma unroll
      for (int ni = 0; ni < 4; ++ni) { accF[ni] = (f32x4){0.f, 0.f, 0.f, 0.f}; accB[ni] = (f32x4){0.f, 0.f, 0.f, 0.f}; }
#pragma unroll
      for (int kk = 0; kk < 2; ++kk)
#pragma unroll
        for (int ni = 0; ni < 4; ++ni) {
          accF[ni] = __builtin_amdgcn_mfma_f32_16x16x32_bf16(ca[kk], *(const bf16x8*)&Hm[(hh * 2 + 0) * 64 + 16 * ni + l15][32 * kk + 8 * l4], accF[ni], 0, 0, 0);
          accB[ni] = __builtin_amdgcn_mfma_f32_16x16x32_bf16(ca[kk], *(const bf16x8*)&Hm[(hh * 2 + 1) * 64 + 16 * ni + l15][32 * kk + 8 * l4], accB[ni], 0, 0, 0); }
#pragma unroll
      for (int rg = 0; rg < 4; ++rg) { const int t = 16 * w + 4 * l4 + rg; const float eF = ef[(hh * 2 + 0) * 128 + t], eB = ef[(hh * 2 + 1) * 128 + t];
#pragma unroll
        for (int ni = 0; ni < 4; ++ni) yv[hh][ni][rg] = eF * accF[ni][rg] + eB * accB[ni][rg]; }
    }
  }
  __syncthreads();
#pragma unroll
  for (int hh = 0; hh < 3; ++hh)
#pragma unroll
    for (int rg = 0; rg < 4; ++rg)
#pragma unroll
      for (int ni = 0; ni < 4; ++ni) Yt[16 * w + 4 * l4 + rg][hh * 64 + 16 * ni + l15] = yv[hh][ni][rg];
  __syncthreads();
  {
    const int c4 = 4 * (lane < 48 ? lane : 47), hk = c4 >> 6; const bool lact = lane < 48;
    float cw0[4], cw1[4], cw2[4], cbv[4], nwv[4];
#pragma unroll
    for (int e = 0; e < 4; ++e) { const int col = g * 192 + c4 + e; cw0[e] = cw[col]; cw1[e] = cw[640 + col]; cw2[e] = cw[1280 + col]; cbv[e] = cb[col]; nwv[e] = nw[col]; }
    const float dsk = dskip[3 * g + hk];
#pragma unroll 1
    for (int rb = 0; rb < 16; rb += 4) {
      u32x2 xc_[4], xp_[4], xn_[4], zz_[4], yy_[4];
#pragma unroll
      for (int u = 0; u < 4; ++u) { const int t = 16 * w + rb + u, j = j0 + t; const size_t r = r0 + t; const bool hasp = j != 0 && j != CTXL, hasn = j != CTXL - 1 && j != TPB - 1;
        const bf16_t* xq = XBC + r * 768 + g * 192 + c4;
        xc_[u] = *(const u32x2*)xq; xp_[u] = *(const u32x2*)(xq + (hasp ? -768 : 0)); xn_[u] = *(const u32x2*)(xq + (hasn ? 768 : 0));
        yy_[u] = *(const u32x2*)(YIN + r * 384 + g * 192 + c4); zz_[u] = *(const u32x2*)(VZ + r * 512 + 128 + g * 192 + c4); }
#pragma unroll
      for (int u = 0; u < 4; ++u) { const int t = 16 * w + rb + u, j = j0 + t; const size_t r = r0 + t; const float wp = (j != 0 && j != CTXL) ? 1.f : 0.f, wn = (j != CTXL - 1 && j != TPB - 1) ? 1.f : 0.f;
        const f32x4 yt = *(const f32x4*)&Yt[t][c4];
        float gt[4]; float ss = 0.f;
#pragma unroll
        for (int e = 0; e < 4; ++e) { const unsigned sh = (e & 1) * 16; const unsigned wc_ = e < 2 ? xc_[u].x : xc_[u].y, wq_ = e < 2 ? xp_[u].x : xp_[u].y, wn_ = e < 2 ? xn_[u].x : xn_[u].y, wz_ = e < 2 ? zz_[u].x : zz_[u].y;
          float xv = cw1[e] * bf2f((bf16_t)(wc_ >> sh)) + cbv[e] + wp * cw0[e] * bf2f((bf16_t)(wq_ >> sh)) + wn * cw2[e] * bf2f((bf16_t)(wn_ >> sh));
          xv = siluf(xv);
          const float y = bf2f((bf16_t)((e < 2 ? yy_[u].x : yy_[u].y) >> sh)) + yt[e] + dsk * xv;
          gt[e] = lact ? y * siluf(bf2f((bf16_t)(wz_ >> sh))) : 0.f; ss += gt[e] * gt[e]; }
        const float rstd = rsqrtf(wave_sum(ss) * (1.0f / 192.0f) + EPS);
        if (lact) { u32x2 o; o.x = pk2bf(gt[0] * rstd * nwv[0], gt[1] * rstd * nwv[1]); o.y = pk2bf(gt[2] * rstd * nwv[2], gt[3] * rstd * nwv[3]);
          *(u32x2*)(MIX + r * DM + 384 + g * 192 + c4) = o; } }
    }
  }
  __syncthreads();
}

__device__ __forceinline__ void st_router(const float* xl, const float* xc, int from_inputs, bf16_t* XB, const bf16_t* MO, const float* g, const float* modv_layer, const float* w_router, const float* rbias,
                                          bf16_t* H2, int* ctl, int* tok_pair, float* tok_w, int skip_ctx, char* lds) {
  float* wl = (float*)lds;
  const int tid = TIDX, lane = tid & 63, gw = BIDX * 8 + (tid >> 6), ngw = GDIM * 8;
  int* hist = (int*)(lds + 81920);
  if (tid < 32) hist[tid] = 0;
  float* mA = (float*)(lds + 82176); float* mB = mA + 5 * 1024; float* mG = mB + 5 * 1024;
  for (int idx = tid; idx < 5 * 1024; idx += NT) { const int m = idx >> 10, k = idx & 1023; mA[idx] = g[k] * (1.f + modv_layer[(size_t)m * 6144 + 4096 + k]); mB[idx] = modv_layer[(size_t)m * 6144 + 3072 + k]; mG[idx] = modv_layer[(size_t)m * 6144 + 2048 + k]; }
  for (int idx = tid; idx < 4096; idx += NT) { const int k = idx >> 2, e4 = idx & 3, row = ((k & 3) * 4 + (k >> 8)) * 64 + ((k & 255) >> 2);
    *(f32x4*)(wl + row * 20 + 4 * e4) = *(const f32x4*)(w_router + (size_t)k * 16 + 4 * e4); }
  __syncthreads();
  for (int rb = gw; rb < MTOK; rb += 2 * ngw) {
    int rr[2]; bool act[2]; f32x4 v[2][4]; u32x2 mo[2][4]; float rstd[2]; int mo_[2];
#pragma unroll
    for (int u = 0; u < 2; ++u) { const int r = rb + u * ngw; rr[u] = r < MTOK ? r : MTOK - 1; act[u] = r < MTOK && !(skip_ctx && (rr[u] % TPB) < CTXL); mo_[u] = mrow_of(rr[u]) * 1024;
      const bf16_t* mr = MO + (size_t)rr[u] * DM;
      if (from_inputs) { const float* xr = xrow(xl, xc, rr[u]);
#pragma unroll
        for (int j = 0; j < 4; ++j) v[u][j] = *(const f32x4*)(xr + 4 * lane + 256 * j); }
      else { const bf16_t* xr = XB + (size_t)rr[u] * DM;
#pragma unroll
        for (int j = 0; j < 4; ++j) { const u32x2 t2 = *(const u32x2*)(xr + 4 * lane + 256 * j);
          v[u][j] = (f32x4){__uint_as_float(t2.x << 16), __uint_as_float(t2.x & 0xffff0000u), __uint_as_float(t2.y << 16), __uint_as_float(t2.y & 0xffff0000u)}; } }
#pragma unroll
      for (int j = 0; j < 4; ++j) mo[u][j] = *(const u32x2*)(mr + 4 * lane + 256 * j); }
    if (!act[0] && !act[1]) continue;
#pragma unroll
    for (int u = 0; u < 2; ++u) if (act[u]) { bf16_t* xd = XB + (size_t)rr[u] * DM;
#pragma unroll
      for (int j = 0; j < 4; ++j) { const int k = 4 * lane + 256 * j; const f32x4 g4 = *(const f32x4*)(mG + mo_[u] + k);
        const f32x4 m4 = (f32x4){__uint_as_float(mo[u][j].x << 16), __uint_as_float(mo[u][j].x & 0xffff0000u), __uint_as_float(mo[u][j].y << 16), __uint_as_float(mo[u][j].y & 0xffff0000u)};
        v[u][j] = v[u][j] + g4 * m4; u32x2 w2; w2.x = pk2bf(v[u][j].x, v[u][j].y); w2.y = pk2bf(v[u][j].z, v[u][j].w); *(u32x2*)(xd + k) = w2; } }
#pragma unroll
    for (int u = 0; u < 2; ++u) { float ss = 0.f;
#pragma unroll
      for (int j = 0; j < 4; ++j) ss += v[u][j].x * v[u][j].x + v[u][j].y * v[u][j].y + v[u][j].z * v[u][j].z + v[u][j].w * v[u][j].w;
      rstd[u] = rsqrtf(wave_sum(ss) * (1.0f / DM) + EPS); }
    float lg[2][16];
#pragma unroll
    for (int u = 0; u < 2; ++u)
#pragma unroll
      for (int e = 0; e < 16; ++e) lg[u][e] = 0.f;
#pragma unroll 1
    for (int j = 0; j < 4; ++j) { const int k = 4 * lane + 256 * j; float o[2][4];
#pragma unroll
      for (int u = 0; u < 2; ++u) { const f32x4 a4 = *(const f32x4*)(mA + mo_[u] + k), b4 = *(const f32x4*)(mB + mo_[u] + k); const f32x4 o4 = v[u][j] * rstd[u] * a4 + b4;
        o[u][0] = o4.x; o[u][1] = o4.y; o[u][2] = o4.z; o[u][3] = o4.w;
        if (act[u]) { u32x2 wpk; wpk.x = pk2bf(o4.x, o4.y); wpk.y = pk2bf(o4.z, o4.w); *(u32x2*)(H2 + (size_t)rr[u] * DM + k) = wpk; } }
#pragma unroll
      for (int q = 0; q < 4; ++q) { const float* wr_ = wl + ((q * 4 + j) * 64 + lane) * 20;
#pragma unroll
        for (int e4 = 0; e4 < 4; ++e4) { const f32x4 wr = *(const f32x4*)(wr_ + 4 * e4);
#pragma unroll
          for (int u = 0; u < 2; ++u) { lg[u][4 * e4] += o[u][q] * wr.x; lg[u][4 * e4 + 1] += o[u][q] * wr.y; lg[u][4 * e4 + 2] += o[u][q] * wr.z; lg[u][4 * e4 + 3] += o[u][q] * wr.w; } } } }
    float h1[2];
#pragma unroll
    for (int u = 0; u < 2; ++u) { float h8[8], h4[4], h2[2];
#pragma unroll
      for (int i = 0; i < 8; ++i) { const bool up = (lane & 32) != 0; const float keep = up ? lg[u][8 + i] : lg[u][i], give = up ? lg[u][i] : lg[u][8 + i]; h8[i] = keep + __shfl_xor(give, 32); }
#pragma unroll
      for (int i = 0; i < 4; ++i) { const bool up = (lane & 16) != 0; const float keep = up ? h8[4 + i] : h8[i], give = up ? h8[i] : h8[4 + i]; h4[i] = keep + __shfl_xor(give, 16); }
#pragma unroll
      for (int i = 0; i < 2; ++i) { const bool up = (lane & 8) != 0; const float keep = up ? h4[2 + i] : h4[i], give = up ? h4[i] : h4[2 + i]; h2[i] = keep + __shfl_xor(give, 8); }
      { const bool up = (lane & 4) != 0; const float keep = up ? h2[1] : h2[0], give = up ? h2[0] : h2[1]; h1[u] = keep + __shfl_xor(give, 4); }
      h1[u] += __shfl_xor(h1[u], 2); h1[u] += __shfl_xor(h1[u], 1); }
    float lx[16];
#pragma unroll
    for (int e = 0; e < 16; ++e) { const int src = ((e >> 3) & 1) * 32 + ((e >> 2) & 1) * 16 + ((e >> 1) & 1) * 8 + (e & 1) * 4;
      const float a0 = __uint_as_float(__builtin_amdgcn_readlane(__float_as_uint(h1[0]), src)), a1 = __uint_as_float(__builtin_amdgcn_readlane(__float_as_uint(h1[1]), src));
      lx[e] = lane < 32 ? a0 : a1; }
    const int us = lane >> 5;
    if ((lane & 31) == 0 && (us == 0 ? act[0] : act[1])) {
      const int r = us == 0 ? rr[0] : rr[1];
      int best = 0, bi1 = 0, bi2 = 1; float bestv = -1e30f, bs1 = 0.f, bs2 = 0.f;
#pragma unroll
      for (int gq = 0; gq < 4; ++gq) { float m1 = -1e30f, m2 = -1e30f, s1 = 0.f, s2 = 0.f; int i1 = 0, i2 = 0;
#pragma unroll
        for (int i = 0; i < 4; ++i) { const float scv = 1.0f / (1.0f + __expf(-lx[4 * gq + i])); const float sv = scv + rbias[4 * gq + i];
          if (sv > m1) { m2 = m1; s2 = s1; i2 = i1; m1 = sv; s1 = scv; i1 = i; } else if (sv > m2) { m2 = sv; s2 = scv; i2 = i; } }
        if (m1 + m2 > bestv) { bestv = m1 + m2; best = gq; bi1 = i1; bi2 = i2; bs1 = s1; bs2 = s2; } }
      const int ia = bi1 < bi2 ? bi1 : bi2, ib = bi1 < bi2 ? bi2 : bi1;
      const int tri = ia == 0 ? ib - 1 : (ia == 1 ? ib + 1 : 5);
      const int pidx = best * 6 + tri;
      const float sa = bi1 < bi2 ? bs1 : bs2, sb = bi1 < bi2 ? bs2 : bs1, inv = 1.0f / (sa + sb);
      const int rank = atomicAdd(&hist[pidx], 1);
      tok_pair[r] = pidx | (rank << 5); tok_w[2 * r] = sa * inv; tok_w[2 * r + 1] = sb * inv;
    }
  }
  __syncthreads();
  if (tid < 32) ctl[CT_CNTB + BIDX * 32 + tid] = tid < 24 ? hist[tid] : 0;
}
__device__ __forceinline__ void st_moe_gather(const bf16_t* H2, bf16_t* H2S, int* ctl, const int* tok_pair, const float* tok_w, int* sorted_tok, float* sorted_w, int* tok_slot, int skip_ctx, char* lds) {
  int* sbase = (int*)lds; int* rtot = sbase + 32; int* rpre = rtot + 512;
  const int tid = TIDX, bid = BIDX;
  { const int p = tid & 31, seg = tid >> 5; int tot = 0, pre = 0;
#pragma unroll 4
    for (int i = 0; i < 16; ++i) { const int bb = seg * 16 + i; const int cv = ctl[CT_CNTB + bb * 32 + p]; tot += cv; pre += bb < bid ? cv : 0; }
    rtot[seg * 32 + p] = tot; rpre[seg * 32 + p] = pre; }
  __syncthreads();
  if (tid < 32) { int tot = 0, pre = 0;
#pragma unroll
    for (int sg = 0; sg < 16; ++sg) { tot += rtot[sg * 32 + tid]; pre += rpre[sg * 32 + tid]; }
    rtot[tid] = tot; rpre[tid] = pre; }
  __syncthreads();
  if (tid == 0) { int base = 0, nt = 0;
#pragma unroll 1
    for (int p = 0; p < 24; ++p) { sbase[p] = base + rpre[p]; const int n = rtot[p], tl = (n + 255) >> 8;
      if (bid == 0) { ctl[CT_BASE + p] = base; for (int t = 0; t < tl; ++t) ctl[CT_TP + nt + t] = p; }
      nt += tl; base += tl * 256; }
    if (bid == 0) { ctl[CT_BASE + 24] = base; ctl[CT_NT] = nt; } }
  __syncthreads();
  const int lane = tid & 63, gw = bid * 8 + (tid >> 6), ngw = GDIM * 8;
  for (int rb = gw; rb < MTOK; rb += 3 * ngw) {
    u32x4 a0[3], a1[3]; int pk[3]; float w0[3], w1[3]; bool act[3];
#pragma unroll
    for (int u = 0; u < 3; ++u) { const int r = rb + u * ngw; act[u] = r < MTOK && !(skip_ctx && (r % TPB) < CTXL); const int rc = act[u] ? r : 0;
      pk[u] = tok_pair[rc]; w0[u] = tok_w[2 * rc]; w1[u] = tok_w[2 * rc + 1];
      const u32x4* sp = (const u32x4*)(H2 + (size_t)rc * DM); a0[u] = sp[lane]; a1[u] = sp[lane + 64]; }
#pragma unroll
    for (int u = 0; u < 3; ++u) if (act[u]) { const int r = rb + u * ngw; const int slot = sbase[pk[u] & 31] + (pk[u] >> 5);
      if (lane == 0) { sorted_tok[slot] = r; tok_slot[r] = slot; sorted_w[2 * slot] = w0[u]; sorted_w[2 * slot + 1] = w1[u]; }
      u32x4* d = (u32x4*)(H2S + (size_t)slot * DM); d[lane] = a0[u]; d[lane + 64] = a1[u]; }
  }
  __syncthreads();
}
__device__ __forceinline__ void st_final(float* out, const float* g, const bf16_t* XB, const bf16_t* YS, const int* tok_slot, const float* gate  ) {
  const int lane = TIDX & 63, gw = BIDX * 8 + (TIDX >> 6), ngw = GDIM * 8;
  f32x4 gg[4];
#pragma unroll
  for (int j = 0; j < 4; ++j) gg[j] = *(const f32x4*)(g + 4 * lane + 256 * j);
  for (int rb = gw; rb < NB * SEQ; rb += 4 * ngw) {
    u32x2 xb[4][4], ys[4][4];
#pragma unroll
    for (int u = 0; u < 4; ++u) { const int r = rb + u * ngw, rc = r < NB * SEQ ? r : NB * SEQ - 1;
      const int bb = rc >> 12, tr = bb * TPB + CTXL + (rc & 4095); const bf16_t* xr = XB + (size_t)tr * DM; const bf16_t* yr = YS + (size_t)tok_slot[tr] * DM;
#pragma unroll
      for (int j = 0; j < 4; ++j) { xb[u][j] = *(const u32x2*)(xr + 4 * lane + 256 * j); ys[u][j] = *(const u32x2*)(yr + 4 * lane + 256 * j); } }
#pragma unroll
    for (int u = 0; u < 4; ++u) { const int r = rb + u * ngw, rc = r < NB * SEQ ? r : NB * SEQ - 1; const float* gt = gate + (size_t)(rc >> 12) * 6144; float ss = 0.f; f32x4 v[4];
#pragma unroll
      for (int j = 0; j < 4; ++j) { const f32x4 g4 = *(const f32x4*)(gt + 4 * lane + 256 * j);
        const f32x4 x4 = (f32x4){__uint_as_float(xb[u][j].x << 16), __uint_as_float(xb[u][j].x & 0xffff0000u), __uint_as_float(xb[u][j].y << 16), __uint_as_float(xb[u][j].y & 0xffff0000u)};
        const f32x4 m4 = (f32x4){__uint_as_float(ys[u][j].x << 16), __uint_as_float(ys[u][j].x & 0xffff0000u), __uint_as_float(ys[u][j].y << 16), __uint_as_float(ys[u][j].y & 0xffff0000u)};
        v[j] = x4 + g4 * m4; ss += v[j].x * v[j].x + v[j].y * v[j].y + v[j].z * v[j].z + v[j].w * v[j].w; }
      const float rstd = rsqrtf(wave_sum(ss) * (1.0f / DM) + EPS);
      if (r < NB * SEQ) { float* orow = out + (size_t)r * DM;
#pragma unroll
        for (int j = 0; j < 4; ++j) *(f32x4*)(orow + 4 * lane + 256 * j) = (f32x4){v[j].x * rstd * gg[j].x, v[j].y * rstd * gg[j].y, v[j].z * rstd * gg[j].z, v[j].w * rstd * gg[j].w}; } }
  }
}

namespace pg8 {
#define PG8_LAS __attribute__((address_space(3)))
typedef unsigned short bf16_t;
typedef short bf16x8 __attribute__((ext_vector_type(8)));
typedef float f32x4 __attribute__((ext_vector_type(4)));
typedef unsigned u32x4 __attribute__((ext_vector_type(4)));
constexpr int BM = 256, BK = 64, HALF = 128, HTB = HALF * BK * 2  , STAGE_BYTES = 8 * HTB, NXCD = 8, WGM = 8;

__host__ __device__ __forceinline__ int lds_byte(int r, int c) { const int st = (r >> 4) * 2 + (c >> 5), rr = r & 15, cc = c & 31, ob = rr * 64 + cc * 2; return st * 1024 + (ob ^ (((ob >> 9) & 1) << 5)); }
__host__ __device__ __forceinline__ void stage_rc(int b, int& R, int& C) { const int st = b / 1024, sb = b % 1024, swz = sb ^ (((sb >> 9) & 1) << 5); R = (st >> 1) * 16 + swz / 64; C = (st & 1) * 32 + (swz % 64) / 2; }
__host__ __device__ __forceinline__ int perm32(int rho) { const int n = rho >> 4, i = rho & 15; return 8 * (i >> 2) + 4 * n + (i & 3); }

struct Unit { int pm, pn, fin; const char* A; const char* B; };
struct Gemm { int K, lda, ldb; };

__device__ __forceinline__ void tile_of(int L, int nM, int nN, int& pm, int& pn) {
    const int nwg = nM * nN; int wgid = L; { const int q = nwg / NXCD, r = nwg % NXCD, xcd = wgid % NXCD, off = wgid / NXCD; wgid = (xcd < r ? xcd * (q + 1) : r * (q + 1) + (xcd - r) * q) + off; }
    const int nig = WGM * nN, gid = wgid / nig, fm = gid * WGM, gsz = (nM - fm) < WGM ? (nM - fm) : WGM;
    pm = fm + ((wgid % nig) % gsz); pn = (wgid % nig) / gsz;
}
__device__ __forceinline__ unsigned cvt_pk_bf16(float lo, float hi) { unsigned r; asm volatile("v_cvt_pk_bf16_f32 %0, %1, %2" : "=v"(r) : "v"(lo), "v"(hi)); return r; }
template <class Epi, class Sched, bool ALIGN_EPI = false, bool SP2 = false>
__device__ __forceinline__ void gemm_phase(PG8_LAS unsigned char* lds, const Gemm g, const Sched& S, const Epi& E) {
    const int tid = opq_v((int)threadIdx.x), wid = __builtin_amdgcn_readfirstlane(tid >> 6), lane = tid & 63, wr = wid >> 2, wc = wid & 3, fr = lane & 15, fq = lane >> 4;
    const int K = g.K, nt = K / BK;
    unsigned voffA[2], voffB[2];
#pragma unroll
    for (int i = 0; i < 2; ++i) { int R, C; stage_rc(tid * 16 + i * 8192, R, C); const int Rb = Epi::PERM ? ((R & ~31) + perm32(R & 31)) : R;
        voffA[i] = (unsigned)(R * g.lda + C) * 2u; voffB[i] = (unsigned)(Rb * g.ldb + C) * 2u; }
    const size_t kstep = (size_t)(BK * 2);
    const size_t hstepA = (size_t)HALF * g.lda * 2, hstepB = (size_t)HALF * g.ldb * 2;
    const unsigned ldsw = (unsigned)wid * 1024u;
    const int aoff = lds_byte(wr * 64 + fr, fq * 8), boff = lds_byte(wc * 32 + fr, fq * 8);
#define PG8_SA(b, h) (((b) * 2 + (h)) * HTB)
#define PG8_SB(b, h) ((4 + (b) * 2 + (h)) * HTB)
#define PG8_STAGE(bufoff, gbase, voff) do { _Pragma("unroll") for (int _i = 0; _i < 2; ++_i) \
        __builtin_amdgcn_global_load_lds((const unsigned*)((const char*)(gbase) + (voff)[_i]), (PG8_LAS unsigned*)(lds + (bufoff) + ldsw + _i * 8192), 16, 0, 0); } while (0)
#define PG8_LDA(dst, b, h) do { _Pragma("unroll") for (int m = 0; m < 4; ++m) _Pragma("unroll") for (int k = 0; k < 2; ++k) dst[m][k] = *(const PG8_LAS bf16x8*)(lds + PG8_SA(b, h) + aoff + m * 2048 + k * 1024); } while (0)
#define PG8_LDB(dst, b, h) do { _Pragma("unroll") for (int n = 0; n < 2; ++n) _Pragma("unroll") for (int k = 0; k < 2; ++k) dst[n][k] = *(const PG8_LAS bf16x8*)(lds + PG8_SB(b, h) + boff + n * 2048 + k * 1024); } while (0)
#define PG8_MMA(ai, bj, At, Bt) do { __builtin_amdgcn_s_setprio(1); _Pragma("unroll") for (int m = 0; m < 4; ++m) _Pragma("unroll") for (int n = 0; n < 2; ++n) _Pragma("unroll") for (int k = 0; k < 2; ++k) \
        acc[ai][bj][m][n] = __builtin_amdgcn_mfma_f32_16x16x32_bf16(Bt[n][k], At[m][k], acc[ai][bj][m][n], 0, 0, 0); __builtin_amdgcn_s_setprio(0); } while (0)
#define PG8_WAIT_V(n) asm volatile("s_waitcnt vmcnt(" #n ")" ::: "memory")
#define PG8_WAIT_L(n) asm volatile("s_waitcnt lgkmcnt(" #n ")" ::: "memory")
#define PG8_BAR __builtin_amdgcn_s_barrier()
#define PG8_SCHED __builtin_amdgcn_sched_barrier(0)
    Unit cur, nxt; int ui = 0;
    if (!S.next(0, cur)) return;
    f32x4 acc[2][2][4][2];
#pragma unroll
    for (int a = 0; a < 2; ++a)
#pragma unroll
        for (int b = 0; b < 2; ++b)
#pragma unroll
            for (int m = 0; m < 4; ++m)
#pragma unroll
                for (int n = 0; n < 2; ++n) acc[a][b][m][n] = (f32x4){0.f, 0.f, 0.f, 0.f};
    bf16x8 At[4][2], B0[2][2], B1[2][2];
    const char* cA = cur.A; const char* cB = cur.B;
    S.a_ready(cur);
    if constexpr (SP2) {
        PG8_STAGE(PG8_SB(0, 0), cB, voffB); PG8_STAGE(PG8_SB(0, 1), cB + hstepB, voffB); PG8_STAGE(PG8_SA(0, 0), cA, voffA); PG8_STAGE(PG8_SA(0, 1), cA + hstepA, voffA);
        if (wr == 1) PG8_BAR;
        PG8_WAIT_V(2); PG8_BAR;
        PG8_STAGE(PG8_SB(1, 0), cB + kstep, voffB); PG8_STAGE(PG8_SA(1, 0), cA + kstep, voffA); PG8_STAGE(PG8_SB(1, 1), cB + hstepB + kstep, voffB);
        PG8_WAIT_V(6); PG8_BAR;
    } else {
        PG8_STAGE(PG8_SB(0, 0), cB, voffB); PG8_STAGE(PG8_SA(0, 0), cA, voffA); PG8_STAGE(PG8_SB(0, 1), cB + hstepB, voffB); PG8_STAGE(PG8_SA(0, 1), cA + hstepA, voffA);
        if (wr == 1) PG8_BAR;
        PG8_WAIT_V(4); PG8_BAR;
        PG8_STAGE(PG8_SB(1, 0), cB + kstep, voffB); PG8_STAGE(PG8_SA(1, 0), cA + kstep, voffA); PG8_STAGE(PG8_SB(1, 1), cB + hstepB + kstep, voffB);
        PG8_WAIT_V(6); PG8_BAR;
    }
    for (;;) {
        const bool has_next = S.next(ui + 1, nxt);
        const char* nA = has_next ? nxt.A : cA; const char* nB = has_next ? nxt.B : cB;
        for (int t = 0; t < nt; t += 2) {
            const bool last = (t == nt - 2);
            const char* a1 = cA + (size_t)(t + 1) * kstep;
            const char* a2 = last ? nA : cA + (size_t)(t + 2) * kstep; const char* b2 = last ? nB : cB + (size_t)(t + 2) * kstep;
            const char* a3 = a2 + kstep; const char* b3 = b2 + kstep;
            if (last && has_next) S.a_ready(nxt);
            if constexpr (SP2) {
            PG8_LDB(B0, 0, 0); PG8_LDB(B1, 0, 1); PG8_SCHED; PG8_LDA(At, 0, 0); PG8_STAGE(PG8_SA(1, 1), a1 + hstepA, voffA);
            PG8_WAIT_V(8); PG8_WAIT_L(0); PG8_BAR; PG8_MMA(0, 0, At, B0); PG8_MMA(0, 1, At, B1); PG8_BAR; PG8_SCHED;
            PG8_LDA(At, 0, 1); PG8_STAGE(PG8_SB(0, 0), b2, voffB); PG8_STAGE(PG8_SB(0, 1), b2 + hstepB, voffB); PG8_STAGE(PG8_SA(0, 0), a2, voffA);
            PG8_WAIT_V(8); PG8_WAIT_L(0); PG8_BAR; PG8_MMA(1, 0, At, B0); PG8_MMA(1, 1, At, B1); PG8_BAR; PG8_SCHED;
            PG8_LDB(B0, 1, 0); PG8_LDB(B1, 1, 1); PG8_SCHED; PG8_LDA(At, 1, 0); PG8_STAGE(PG8_SA(0, 1), a2 + hstepA, voffA);
            PG8_WAIT_V(8); PG8_WAIT_L(0); PG8_BAR; PG8_MMA(0, 0, At, B0); PG8_MMA(0, 1, At, B1); PG8_BAR; PG8_SCHED;
            PG8_LDA(At, 1, 1); PG8_STAGE(PG8_SB(1, 0), b3, voffB); PG8_STAGE(PG8_SB(1, 1), b3 + hstepB, voffB); PG8_STAGE(PG8_SA(1, 0), a3, voffA);
            PG8_WAIT_V(8); PG8_WAIT_L(0); PG8_BAR; PG8_MMA(1, 0, At, B0); PG8_MMA(1, 1, At, B1); PG8_BAR; PG8_SCHED;
            } else {
            PG8_LDB(B0, 0, 0); PG8_SCHED; PG8_LDA(At, 0, 0); PG8_STAGE(PG8_SA(1, 1), a1 + hstepA, voffA);
            PG8_WAIT_L(8); PG8_BAR; PG8_WAIT_L(0); PG8_MMA(0, 0, At, B0); PG8_BAR; PG8_SCHED;
            PG8_LDB(B1, 0, 1); PG8_STAGE(PG8_SB(0, 0), b2, voffB);
            PG8_BAR; PG8_WAIT_L(0); PG8_MMA(0, 1, At, B1); PG8_BAR;
            PG8_LDA(At, 0, 1); PG8_STAGE(PG8_SA(0, 0), a2, voffA);
            PG8_BAR; PG8_WAIT_L(0); PG8_MMA(1, 0, At, B0); PG8_BAR; PG8_SCHED;
            PG8_STAGE(PG8_SB(0, 1), b2 + hstepB, voffB);
            PG8_WAIT_V(6); PG8_BAR; PG8_MMA(1, 1, At, B1); PG8_BAR;
            PG8_LDB(B0, 1, 0); PG8_SCHED; PG8_LDA(At, 1, 0); PG8_STAGE(PG8_SA(0, 1), a2 + hstepA, voffA);
            PG8_WAIT_L(8); PG8_BAR; PG8_WAIT_L(0); PG8_MMA(0, 0, At, B0); PG8_BAR; PG8_SCHED;
            PG8_LDB(B1, 1, 1); PG8_STAGE(PG8_SB(1, 0), b3, voffB);
            PG8_BAR; PG8_WAIT_L(0); PG8_MMA(0, 1, At, B1); PG8_BAR;
            PG8_LDA(At, 1, 1); PG8_STAGE(PG8_SA(1, 0), a3, voffA);
            PG8_BAR; PG8_WAIT_L(0); PG8_MMA(1, 0, At, B0); PG8_BAR; PG8_SCHED;
            PG8_STAGE(PG8_SB(1, 1), b3 + hstepB, voffB);
            PG8_WAIT_V(6); PG8_BAR; PG8_MMA(1, 1, At, B1); PG8_BAR;
            }
        }
        if constexpr (ALIGN_EPI) { if (wr == 0) PG8_BAR; }
        if constexpr (!Epi::AFTER_DRAIN) { if (cur.fin) { E(acc, cur, wr, wc, fr, fq); S.done(cur); } }
        if (!has_next) break;
        if (cur.fin) {
#pragma unroll
        for (int a = 0; a < 2; ++a)
#pragma unroll
            for (int b = 0; b < 2; ++b)
#pragma unroll
                for (int m = 0; m < 4; ++m)
#pragma unroll
                    for (int n = 0; n < 2; ++n) acc[a][b][m][n] = (f32x4){0.f, 0.f, 0.f, 0.f};
        }
        cur = nxt; cA = nA; cB = nB; ++ui;
        if constexpr (ALIGN_EPI) { if (wr == 1) PG8_BAR; }
    }
    PG8_WAIT_V(0);
    if constexpr (!ALIGN_EPI) { if (wr == 0) PG8_BAR; }
    PG8_BAR;
    if constexpr (Epi::AFTER_DRAIN) { E.fused(acc, cur, wr, wc, fr, fq, lds, wid, lane); S.done(cur); }
#undef PG8_SA
#undef PG8_SB
#undef PG8_STAGE
#undef PG8_LDA
#undef PG8_LDB
#undef PG8_MMA
#undef PG8_WAIT_V
#undef PG8_WAIT_L
#undef PG8_BAR
#undef PG8_SCHED
}
}

struct SchedDense {
  int nM, nN, G, c, skip_ctx; const char* A; const char* B; size_t a_tile, b_tile;
  __device__ __forceinline__ bool next(int i, pg8::Unit& u) const {
    const long L = (long)i * G + c; if (L >= (long)nM * nN) return false;
    int pm, pn; pg8::tile_of((int)L, nM, nN, pm, pn); if (skip_ctx) pm = pm + pm / 16 + 1;
    u.pm = pm; u.pn = pn; u.fin = 1; u.A = A + (size_t)pm * a_tile; u.B = B + (size_t)pn * b_tile; return true; }
  __device__ __forceinline__ void a_ready(const pg8::Unit&) const {}
  __device__ __forceinline__ void done(const pg8::Unit&) const {}
};
struct SchedMoe {
  int G, c, mode; const int* ctl; const char* A; size_t a_tile; const char* W;
  __device__ __forceinline__ bool next(int i, pg8::Unit& u) const {
    const int part = mode == 2 ? (i & 1) : 0, iu = mode == 2 ? (i >> 1) : i;
    const long L = (long)iu * G + c; const int ntiles = ctl[CT_NT]; if (L >= (long)ntiles * 4) return false;
    const int pm = (int)(L >> 2), pn = (int)(L & 3); int eA, eB; pair_experts(ctl[CT_TP + pm], eA, eB);
    u.pm = pm; u.pn = pn;
    if (mode == 1) { const int e = pn < 2 ? eA : eB; u.fin = 1; u.A = A + (size_t)pm * a_tile; u.B = W + (size_t)e * (512 * 1024 * 2) + (size_t)(pn & 1) * (256 * 1024 * 2); }
    else { u.fin = part; u.A = A + (size_t)pm * a_tile + part * 512; u.B = W + (size_t)(part ? eB : eA) * (1024 * 256 * 2) + (size_t)pn * (256 * 256 * 2); }
    return true; }
  __device__ __forceinline__ void a_ready(const pg8::Unit&) const {}
  __device__ __forceinline__ void done(const pg8::Unit&) const {}
};
__device__ __forceinline__ unsigned cvt_pk(float lo, float hi) { return pg8::cvt_pk_bf16(lo, hi); }
struct EpiInProj {
  static constexpr bool PERM = true, AFTER_DRAIN = false; bf16_t *QK, *VZ, *XBC, *HY; float* DT;
  __device__ __forceinline__ void operator()(const f32x4 (&acc)[2][2][4][2], const pg8::Unit& u, int wr, int wc, int fr, int fq) const {
    const int pn = u.pn; bf16_t* base; int ldc, coff;
    if (pn < 2) { base = QK; ldc = 512; coff = pn * 256; } else if (pn < 4) { base = VZ; ldc = 512; coff = (pn - 2) * 256; }
    else if (pn < 7) { base = XBC; ldc = 768; coff = (pn - 4) * 256; } else { base = HY; ldc = 768; coff = (pn - 7) * 256; }
    const int row0 = u.pm * 256 + wr * 64 + fr, col0 = coff + wc * 32 + 8 * fq; const bool dtl = (pn == 6 && wc == 0 && fq < 2);
#pragma unroll
    for (int ai = 0; ai < 2; ++ai)
#pragma unroll
      for (int m = 0; m < 4; ++m) { const int row = row0 + ai * 128 + m * 16; bf16_t* rowp = base + (size_t)row * ldc + col0;
#pragma unroll
        for (int bj = 0; bj < 2; ++bj) { const f32x4 v0 = acc[ai][bj][m][0], v1 = acc[ai][bj][m][1];
          u32x4 w; w.x = cvt_pk(v0[0], v0[1]); w.y = cvt_pk(v0[2], v0[3]); w.z = cvt_pk(v1[0], v1[1]); w.w = cvt_pk(v1[2], v1[3]);
          *(u32x4*)(rowp + bj * 128) = w;
          if (bj == 1 && dtl) { float* dp = DT + (size_t)row * 12 + 8 * fq; *(f32x4*)dp = v0; if (fq == 0) *(f32x4*)(dp + 4) = v1; } } }
  }
};
struct EpiOutProj {
  static constexpr bool PERM = true, AFTER_DRAIN = false; bf16_t* MO;
  __device__ __forceinline__ void operator()(const f32x4 (&acc)[2][2][4][2], const pg8::Unit& u, int wr, int wc, int fr, int fq) const {
    const int row0 = u.pm * 256 + wr * 64 + fr, col0 = u.pn * 256 + wc * 32 + 8 * fq;
#pragma unroll
    for (int ai = 0; ai < 2; ++ai)
#pragma unroll
      for (int m = 0; m < 4; ++m) { bf16_t* rowp = MO + (size_t)(row0 + ai * 128 + m * 16) * DM + col0;
#pragma unroll
        for (int bj = 0; bj < 2; ++bj) { const f32x4 v0 = acc[ai][bj][m][0], v1 = acc[ai][bj][m][1];
          u32x4 w; w.x = cvt_pk(v0[0], v0[1]); w.y = cvt_pk(v0[2], v0[3]); w.z = cvt_pk(v1[0], v1[1]); w.w = cvt_pk(v1[2], v1[3]);
          *(u32x4*)(rowp + bj * 128) = w; } }
  }
};
struct EpiMoe1 {
  static constexpr bool PERM = true, AFTER_DRAIN = false; bf16_t* ACT; const float* sorted_w;
  __device__ __forceinline__ void operator()(const f32x4 (&acc)[2][2][4][2], const pg8::Unit& u, int wr, int wc, int fr, int fq) const {
    const int half = u.pn >> 1, j0 = (u.pn & 1) * 128 + 16 * wc + 4 * fq;
#pragma unroll
    for (int ai = 0; ai < 2; ++ai)
#pragma unroll
      for (int m = 0; m < 4; ++m) { const int slot = u.pm * 256 + ai * 128 + wr * 64 + m * 16 + fr; const float wt = sorted_w[2 * slot + half];
#pragma unroll
        for (int bj = 0; bj < 2; ++bj) { const f32x4 v0 = acc[ai][bj][m][0], v1 = acc[ai][bj][m][1];
          u32x2 w; w.x = cvt_pk(siluf(v0[0]) * v0[1] * wt, siluf(v0[2]) * v0[3] * wt); w.y = cvt_pk(siluf(v1[0]) * v1[1] * wt, siluf(v1[2]) * v1[3] * wt);
          *(u32x2*)(ACT + (size_t)slot * 512 + half * 256 + j0 + 64 * bj) = w; } }
  }
};
struct EpiMoe2 {
  static constexpr bool PERM = true, AFTER_DRAIN = false; bf16_t* YS;
  __device__ __forceinline__ void operator()(const f32x4 (&acc)[2][2][4][2], const pg8::Unit& u, int wr, int wc, int fr, int fq) const {
    const int row0 = u.pm * 256 + wr * 64 + fr, col0 = u.pn * 256 + wc * 32 + 8 * fq;
#pragma unroll
    for (int ai = 0; ai < 2; ++ai)
#pragma unroll
      for (int m = 0; m < 4; ++m) { bf16_t* rowp = YS + (size_t)(row0 + ai * 128 + m * 16) * DM + col0;
#pragma unroll
        for (int bj = 0; bj < 2; ++bj) { const f32x4 v0 = acc[ai][bj][m][0], v1 = acc[ai][bj][m][1];
          u32x4 w; w.x = cvt_pk(v0[0], v0[1]); w.y = cvt_pk(v0[2], v0[3]); w.z = cvt_pk(v1[0], v1[1]); w.w = cvt_pk(v1[2], v1[3]);
          *(u32x4*)(rowp + bj * 128) = w; } }
  }
};

#include <hip/hip_bf16.h>
#include <cmath>
namespace attn_body {
using bf16=__hip_bfloat16;
using bf16x8=__attribute__((ext_vector_type(8)))short;
using s16x4=__attribute__((ext_vector_type(4)))short;
using f32x16=__attribute__((ext_vector_type(16)))float;
using u32x4=__attribute__((ext_vector_type(4)))unsigned;
constexpr int D=64,QP=512,KP=512,VP=512,OP=1024;
constexpr int NW=8,QBLK=32,QB=QBLK*NW,KVBLK=64;
constexpr int ATTN_UNIT_ROWS=QB;
__device__ __forceinline__ int crow(int r,int hi){return (r&3)+8*(r>>2)+4*hi;}
#define SBAR() __builtin_amdgcn_sched_barrier(0)
__device__ __forceinline__ void cmask(f32x16&p0,f32x16&p1,int jb,int qrel,int hi){
  const float NEG=-INFINITY; int kb=64*jb+4*hi;
  #pragma unroll
  for(int r=0;r<16;++r){int kv=kb+(r&3)+8*(r>>2); if(kv>qrel)p0[r]=NEG; if(kv+32>qrel)p1[r]=NEG;}
}

constexpr int NSLOT=3, SLOTB=8192;
constexpr int LDS_K=0, LDS_V=NSLOT*SLOTB, LDS_WS=2*NSLOT*SLOTB, LDS_OST=LDS_WS+NW*64*4, LDS_BYTES=LDS_OST+NW*4096;
constexpr float C2=0.125f*1.4426950408889634f;
__device__ __forceinline__ void glds16(const void*gsrc,unsigned lds_dst){unsigned keep;
  asm volatile("s_mov_b32 %0, m0\n\ts_mov_b32 m0, %2\n\ts_nop 0\n\tglobal_load_lds_dwordx4 %1, off\n\ts_mov_b32 m0, %0":"=&s"(keep):"v"(gsrc),"s"(lds_dst):"memory");}
__device__ __forceinline__ float max3f(float a,float b,float c){float r;asm("v_max3_f32 %0, %1, %2, %3":"=v"(r):"v"(a),"v"(b),"v"(c));return r;}
__device__ __forceinline__ float max2f(float a,float b){float r;asm("v_max_f32_e32 %0, %1, %2":"=v"(r):"v"(a),"v"(b));return r;}
__device__ __forceinline__ float fadd_s(float a,float b){float r;asm("v_add_f32_e32 %0, %1, %2":"=v"(r):"v"(a),"v"(b));return r;}
__device__ __forceinline__ float fsub_s(float a,float b){float r;asm("v_sub_f32_e32 %0, %1, %2":"=v"(r):"v"(a),"v"(b));return r;}
typedef float f32x2_t __attribute__((ext_vector_type(2))); typedef __bf16 bf16x2_t __attribute__((ext_vector_type(2)));
__device__ __forceinline__ unsigned cvtpk_s(float lo,float hi){f32x2_t v={lo,hi};bf16x2_t b=__builtin_convertvector(v,bf16x2_t);return __builtin_bit_cast(unsigned,b);}
#define WAIT_BAR(N) asm volatile("s_waitcnt vmcnt(" #N ") lgkmcnt(0)\n\ts_barrier":::"memory")

__device__ __forceinline__ void qkt(f32x16&p0,f32x16&p1,const char*Kslot,const bf16x8*qr,const f32x16&negm,int r32,int hi){
  const char*kb=Kslot+hi*1024+r32*16;
  #pragma unroll
  for(int d0=0;d0<4;++d0){
    const bf16x8 b0=*reinterpret_cast<const bf16x8*>(kb+d0*2048);
    const bf16x8 b1=*reinterpret_cast<const bf16x8*>(kb+d0*2048+512);
    if(d0==0){p0=__builtin_amdgcn_mfma_f32_32x32x16_bf16(b0,qr[0],negm,0,0,0);p1=__builtin_amdgcn_mfma_f32_32x32x16_bf16(b1,qr[0],negm,0,0,0);}
    else{p0=__builtin_amdgcn_mfma_f32_32x32x16_bf16(b0,qr[d0],p0,0,0,0);p1=__builtin_amdgcn_mfma_f32_32x32x16_bf16(b1,qr[d0],p1,0,0,0);}}
}
typedef __attribute__((address_space(3))) const char* lds_cptr;
typedef short v4i16_t __attribute__((ext_vector_type(4)));
__device__ __forceinline__ void kload8(bf16x8*kf,lds_cptr kp){
  kf[0]=*(const __attribute__((address_space(3))) bf16x8*)(kp);      kf[1]=*(const __attribute__((address_space(3))) bf16x8*)(kp+512);
  kf[2]=*(const __attribute__((address_space(3))) bf16x8*)(kp+2048); kf[3]=*(const __attribute__((address_space(3))) bf16x8*)(kp+2560);
  kf[4]=*(const __attribute__((address_space(3))) bf16x8*)(kp+4096); kf[5]=*(const __attribute__((address_space(3))) bf16x8*)(kp+4608);
  kf[6]=*(const __attribute__((address_space(3))) bf16x8*)(kp+6144); kf[7]=*(const __attribute__((address_space(3))) bf16x8*)(kp+6656);
}
__device__ __forceinline__ void kload2(bf16x8*kf,lds_cptr kp,int j){ kf[2*j]=*(const __attribute__((address_space(3))) bf16x8*)(kp+j*2048); kf[2*j+1]=*(const __attribute__((address_space(3))) bf16x8*)(kp+j*2048+512); }
__device__ __forceinline__ s16x4 vtr(lds_cptr p){ return __builtin_bit_cast(s16x4,__builtin_amdgcn_ds_read_tr16_b64_v4i16((__attribute__((address_space(3))) v4i16_t*)p)); }
__device__ __forceinline__ float rowmax(const f32x16&p0,const f32x16&p1){
  float a=max3f(p0[0],p0[1],p1[0]),b=max3f(p0[2],p0[3],p1[1]);a=max3f(a,p1[2],p1[3]);
  #pragma unroll
  for(int r=4;r<16;r+=4){a=max3f(a,p0[r],p0[r+1]);b=max3f(b,p0[r+2],p0[r+3]);a=max3f(a,p1[r],p1[r+1]);b=max3f(b,p1[r+2],p1[r+3]);}
  const float m=max2f(a,b);
  auto rr=__builtin_amdgcn_permlane32_swap(__float_as_uint(m),__float_as_uint(m),false,false);
  return max2f(__uint_as_float(rr[0]),__uint_as_float(rr[1]));
}
__device__ __forceinline__ void pv(f32x16*o,int vb,bf16x8 pa0,bf16x8 pa1,bf16x8 pa2,bf16x8 pa3){
  #pragma unroll
  for(int d0=0;d0<2;++d0){s16x4 lo[4],hi[4];
    #pragma unroll
    for(int ks=0;ks<4;++ks){
      asm volatile("ds_read_b64_tr_b16 %0,%1 offset:%c2":"=&v"(lo[ks]):"v"(vb),"i"(d0*4096+ks*1024):"memory");
      asm volatile("ds_read_b64_tr_b16 %0,%1 offset:%c2":"=&v"(hi[ks]):"v"(vb),"i"(d0*4096+ks*1024+512):"memory");}
    asm volatile("s_waitcnt lgkmcnt(0)":::"memory");SBAR();
    #define PK(k) (bf16x8){lo[k][0],lo[k][1],lo[k][2],lo[k][3],hi[k][0],hi[k][1],hi[k][2],hi[k][3]}
    o[d0]=__builtin_amdgcn_mfma_f32_32x32x16_bf16(pa0,PK(0),o[d0],0,0,0);
    o[d0]=__builtin_amdgcn_mfma_f32_32x32x16_bf16(pa1,PK(1),o[d0],0,0,0);
    o[d0]=__builtin_amdgcn_mfma_f32_32x32x16_bf16(pa2,PK(2),o[d0],0,0,0);
    o[d0]=__builtin_amdgcn_mfma_f32_32x32x16_bf16(pa3,PK(3),o[d0],0,0,0);
    #undef PK
  }
}

#ifndef ATTN_STORE16
#define ATTN_STORE16(p,v) (*(u32x4*)(p)=(v))
#endif
template<int THRL> __device__ __forceinline__ void attn_unit(const bf16*Qu,const bf16*__restrict__ Kh,const bf16*__restrict__ Vh,bf16*Ou,const int NT,char*shm){
  const int tid=opq_v((int)threadIdx.x),lane=tid&63,r32=lane&31,hi=lane>>5; const int wid=__builtin_amdgcn_readfirstlane(tid>>6);
  const bf16*Qw=Qu+(long)(wid*QBLK)*QP;
  const unsigned lds0=(unsigned)(uintptr_t)shm;
  float*wsf=(float*)(shm+LDS_WS)+wid*64;
  const bf16*ksrc=Kh+(long)lane*KP+wid*8;
  const bf16*vsrc=Vh+(long)(16*(wid&3)+(lane>>2))*VP+(wid>>2)*32+(lane&3)*8;
  const unsigned kdst=lds0+LDS_K+wid*1024, vdst=lds0+LDS_V+wid*1024;
  #define DMA_K(t,slot) glds16(ksrc+(long)(t)*KVBLK*KP,(unsigned)__builtin_amdgcn_readfirstlane(kdst+(slot)))
  #define DMA_V(t,slot) glds16(vsrc+(long)(t)*KVBLK*VP,(unsigned)__builtin_amdgcn_readfirstlane(vdst+(slot)))
  const int vb0=(int)(lds0+LDS_V)+((lane>>4)&1)*32+(lane&3)*8+(4*hi+((lane&15)>>2))*64;
  const char*Kbase=shm+LDS_K; bf16x8 kf[8];
  const lds_cptr shm3=(lds_cptr)shm; const lds_cptr kp0=shm3+LDS_K+hi*1024+r32*16; const lds_cptr vp0=shm3+LDS_V+((lane>>4)&1)*32+(lane&3)*8+(4*hi+((lane&15)>>2))*64;
  DMA_K(0,0);DMA_V(0,0);DMA_K(1,SLOTB);
  bf16x8 qr[4];
  #pragma unroll
  for(int d0=0;d0<4;++d0)qr[d0]=*reinterpret_cast<const bf16x8*>(&Qw[(long)r32*QP+d0*16+hi*8]);
  float mhat=0.f,l_reg=0.f;float z0_=0.f;asm volatile("":"+v"(z0_));f32x16 o[2];f32x16 negm;
  _Pragma("unroll") for(int r=0;r<16;++r){o[0][r]=z0_;o[1][r]=z0_;negm[r]=z0_;} asm volatile("":"+v"(negm));
  #define CMASK(P0,P1,t) do{}while(0)
  bool resc=false;
  #define START(P0,P1) do{ const float rm=rowmax(P0,P1); resc=false; \
    { const float dl=rm; mhat=fadd_s(mhat,dl); \
      _Pragma("unroll") for(int r=0;r<16;++r){P0[r]=fsub_s(P0[r],dl);P1[r]=fsub_s(P1[r],dl);} \
      _Pragma("unroll") for(int r=0;r<16;++r)negm[r]=-mhat; asm volatile("":"+v"(negm)); } \
    _Pragma("unroll") for(int r=0;r<16;++r)P0[r]=__builtin_amdgcn_exp2f(P0[r]); }while(0)
  #define RESC() do{ if(resc){ asm volatile("s_waitcnt lgkmcnt(0)":::"memory"); \
      _Pragma("unroll") for(int d_=0;d_<2;++d_) _Pragma("unroll") for(int r=0;r<16;++r)o[d_][r]*=wsf[crow(r,hi)]; } }while(0)
  f32x16 pA0,pA1,pB0,pB1;
  int sl_prev=0,sl_cur=0,sl_next=SLOTB;
  #define ROT() do{sl_prev=sl_cur;sl_cur=sl_next;sl_next=(sl_next==(NSLOT-1)*SLOTB)?0:sl_next+SLOTB;}while(0)
  DMA_K(2,2*SLOTB);
  WAIT_BAR(3);
  qkt(pA0,pA1,Kbase,qr,negm,r32,hi);asm volatile("s_nop 15\n\ts_nop 7":"+v"(pA0),"+v"(pA1));CMASK(pA0,pA1,0);
  START(pA0,pA1);
  _Pragma("unroll") for(int r=0;r<16;++r)pA1[r]=__builtin_amdgcn_exp2f(pA1[r]);
  WAIT_BAR(0);
  DMA_K(3,0);DMA_V(1,SLOTB);
  ROT();
  kload8(kf,kp0+sl_cur);
  WAIT_BAR(2);
  s16x4 vlo[8],vhi[8]; u32x4 pw0,pw1,pw2,pw3;
  #define PKW(P,B) cvtpk_s(P[B],P[B+1])
  #define PAF(k) __builtin_bit_cast(bf16x8,pw##k)
  #define VFR(i) (bf16x8){vlo[i][0],vlo[i][1],vlo[i][2],vlo[i][3],vhi[i][0],vhi[i][1],vhi[i][2],vhi[i][3]}
  #define PIN(x) asm volatile("":"+v"(x))
  #define MX3(a,b,c) __builtin_fmaxf(__builtin_fmaxf((a),(b)),(c))
  #define GAPA(MF,A0,A1,A2,A3,W0,W1,PW) do{ MF; sacc+=A0; sacc+=A1; sacc+=A2; sacc+=A3; PIN(sacc); W0; W1; PIN(PW); SBAR(); }while(0)
  #define EX(v) __builtin_amdgcn_exp2f(v)
  #define GAPB(MF,X,B) do{ MF; X[B]=EX(X[B]); X[B+1]=EX(X[B+1]); X[B+2]=EX(X[B+2]); X[B+3]=EX(X[B+3]); PIN(X); SBAR(); }while(0)
  #define VRD(i) do{ vlo[i]=vtr(vp_+(((i)>>2)*4096+((i)&3)*1024)); vhi[i]=vtr(vp_+(((i)>>2)*4096+((i)&3)*1024+512)); }while(0)
  #define KRD(G,j) do{ if(G){ kload2(kf,kp0+sl_next,j); SBAR(); } }while(0)
  #define STEP(C0,C1,P0,P1,t,GK,GV,GL) do{ SBAR(); \
    const lds_cptr vp_=vp0+sl_prev; \
    VRD(0); SBAR(); float sacc=(P0[0]+P0[1]); \
    GAPA(C0=__builtin_amdgcn_mfma_f32_32x32x16_bf16(kf[0],qr[0],negm,0,0,0), P0[2],P0[3],P0[4],P0[5],     pw0[0]=PKW(P0,0), pw0[1]=PKW(P0,2), pw0); \
    VRD(4); SBAR(); GAPA(C1=__builtin_amdgcn_mfma_f32_32x32x16_bf16(kf[1],qr[0],negm,0,0,0), P0[6],P0[7],P0[8],P0[9],     pw0[2]=PKW(P0,4), pw0[3]=PKW(P0,6), pw0); \
    VRD(1); SBAR(); GAPA(C0=__builtin_amdgcn_mfma_f32_32x32x16_bf16(kf[2],qr[1],C0,0,0,0),   P0[10],P0[11],P0[12],P0[13], pw1[0]=PKW(P0,8), pw1[1]=PKW(P0,10), pw1); \
    VRD(5); SBAR(); GAPA(C1=__builtin_amdgcn_mfma_f32_32x32x16_bf16(kf[3],qr[1],C1,0,0,0),   P0[14],P0[15],P1[0],P1[1],   pw1[2]=PKW(P0,12),pw1[3]=PKW(P0,14), pw1); \
    VRD(2); SBAR(); GAPA(C0=__builtin_amdgcn_mfma_f32_32x32x16_bf16(kf[4],qr[2],C0,0,0,0),   P1[2],P1[3],P1[4],P1[5],     pw2[0]=PKW(P1,0), pw2[1]=PKW(P1,2), pw2); \
    VRD(6); SBAR(); GAPA(C1=__builtin_amdgcn_mfma_f32_32x32x16_bf16(kf[5],qr[2],C1,0,0,0),   P1[6],P1[7],P1[8],P1[9],     pw2[2]=PKW(P1,4), pw2[3]=PKW(P1,6), pw2); \
    VRD(3); SBAR(); GAPA(C0=__builtin_amdgcn_mfma_f32_32x32x16_bf16(kf[6],qr[3],C0,0,0,0),   P1[10],P1[11],P1[12],P1[13], pw3[0]=PKW(P1,8), pw3[1]=PKW(P1,10), pw3); \
    VRD(7); SBAR(); GAPA(C1=__builtin_amdgcn_mfma_f32_32x32x16_bf16(kf[7],qr[3],C1,0,0,0),   P1[14],P1[15],0.f,0.f,       pw3[2]=PKW(P1,12),pw3[3]=PKW(P1,14), pw3); \
    l_reg+=sacc; \
    if(GK){DMA_K((t)+3,sl_cur);} if(GV){DMA_V((t)+1,sl_next);} \
    CMASK(C0,C1,t); \
    { float a=MX3(C0[0],C0[1],C1[0]),b=MX3(C0[2],C0[3],C1[1]); a=MX3(a,C1[2],C1[3]); \
      _Pragma("unroll") for(int r=4;r<16;r+=4){a=MX3(a,C0[r],C0[r+1]);b=MX3(b,C0[r+2],C0[r+3]);a=MX3(a,C1[r],C1[r+1]);b=MX3(b,C1[r+2],C1[r+3]);} \
      float rm=__builtin_fmaxf(a,b); { auto rr=__builtin_amdgcn_permlane32_swap(__float_as_uint(rm),__float_as_uint(rm),false,false); rm=__builtin_fmaxf(__uint_as_float(rr[0]),__uint_as_float(rr[1])); } \
      resc=false; \
      if(__builtin_expect(__any(rm>(float)THRL),0)){ const float dl=__builtin_fmaxf(rm,0.f); mhat+=dl; \
        _Pragma("unroll") for(int r=0;r<16;++r){C0[r]-=dl;C1[r]-=dl;} \
        _Pragma("unroll") for(int r=0;r<16;++r)negm[r]=-mhat; asm volatile("":"+v"(negm)); \
        const float f=__builtin_amdgcn_exp2f(-dl); l_reg*=f; if(hi==0)wsf[r32]=f; resc=true; } } \
    SBAR(); \
    GAPB(o[0]=__builtin_amdgcn_mfma_f32_32x32x16_bf16(PAF(0),VFR(0),o[0],0,0,0), C0,0); \
    GAPB(o[1]=__builtin_amdgcn_mfma_f32_32x32x16_bf16(PAF(0),VFR(4),o[1],0,0,0), C0,4); \
    KRD(GL,0); GAPB(o[0]=__builtin_amdgcn_mfma_f32_32x32x16_bf16(PAF(1),VFR(1),o[0],0,0,0), C0,8); \
    KRD(GL,1); GAPB(o[1]=__builtin_amdgcn_mfma_f32_32x32x16_bf16(PAF(1),VFR(5),o[1],0,0,0), C0,12); \
    KRD(GL,2); GAPB(o[0]=__builtin_amdgcn_mfma_f32_32x32x16_bf16(PAF(2),VFR(2),o[0],0,0,0), C1,0); \
    KRD(GL,3); GAPB(o[1]=__builtin_amdgcn_mfma_f32_32x32x16_bf16(PAF(2),VFR(6),o[1],0,0,0), C1,4); \
    GAPB(o[0]=__builtin_amdgcn_mfma_f32_32x32x16_bf16(PAF(3),VFR(3),o[0],0,0,0), C1,8); \
    GAPB(o[1]=__builtin_amdgcn_mfma_f32_32x32x16_bf16(PAF(3),VFR(7),o[1],0,0,0), C1,12); \
    }while(0)
  int t=1;
  for(;t+5<NT;t+=2){
    STEP(pB0,pB1,pA0,pA1,t,true,true,true);     WAIT_BAR(2); RESC(); ROT();
    STEP(pA0,pA1,pB0,pB1,t+1,true,true,true);   WAIT_BAR(2); RESC(); ROT();
  }
  #define ENDW(tt) do{ if((tt)+3<NT){WAIT_BAR(2);} else if((tt)+2<NT){WAIT_BAR(1);} else {WAIT_BAR(0);} }while(0)
  for(;t+1<NT;t+=2){
    STEP(pB0,pB1,pA0,pA1,t,(t+3<NT),(t+1<NT),(t+1<NT));       ENDW(t);   RESC(); ROT();
    STEP(pA0,pA1,pB0,pB1,t+1,(t+4<NT),(t+2<NT),(t+2<NT));     ENDW(t+1); RESC(); ROT();
  }
  STEP(pB0,pB1,pA0,pA1,NT-1,false,false,false); RESC();
  { float sacc=pB0[0]+pB0[1]; _Pragma("unroll") for(int r=2;r<16;++r)sacc+=pB0[r]; _Pragma("unroll") for(int r=0;r<16;++r)sacc+=pB1[r]; l_reg+=sacc;
    pw0=(u32x4){PKW(pB0,0),PKW(pB0,2),PKW(pB0,4),PKW(pB0,6)};pw1=(u32x4){PKW(pB0,8),PKW(pB0,10),PKW(pB0,12),PKW(pB0,14)};pw2=(u32x4){PKW(pB1,0),PKW(pB1,2),PKW(pB1,4),PKW(pB1,6)};pw3=(u32x4){PKW(pB1,8),PKW(pB1,10),PKW(pB1,12),PKW(pB1,14)};
    SBAR(); pv(o,vb0+sl_cur,PAF(0),PAF(1),PAF(2),PAF(3)); }
  #undef PKW
  #undef PAF
  #undef VFR
  #undef PIN
  #undef MX3
  #undef GAPA
  #undef GAPB
  #undef EX
  #undef VRD
  #undef KRD
  #undef STEP
  #undef ENDW
  {auto rr=__builtin_amdgcn_permlane32_swap(__float_as_uint(l_reg),__float_as_uint(l_reg),false,false);l_reg=__uint_as_float(rr[0])+__uint_as_float(rr[1]);}
  if(hi==0)wsf[32+r32]=l_reg;asm volatile("s_waitcnt lgkmcnt(0)":::"memory");
  float rli[16];
  #pragma unroll
  for(int r=0;r<16;++r)rli[r]=__builtin_amdgcn_rcpf(wsf[32+crow(r,hi)]);
  bf16*Ow=Ou+(long)(wid*QBLK)*OP;
  { bf16*stg=(bf16*)(shm+LDS_OST)+wid*2048;
    #pragma unroll
    for(int r=0;r<16;++r){const int orow=crow(r,hi);
      #pragma unroll
      for(int d0=0;d0<2;++d0)stg[orow*64+d0*32+r32]=__float2bfloat16(o[d0][r]*rli[r]);}
    asm volatile("s_waitcnt lgkmcnt(0)":::"memory");
    #pragma unroll
    for(int i=0;i<4;++i){const int row=i*8+(lane>>3),ch=lane&7; const u32x4 v=*(const u32x4*)(stg+row*64+ch*8); ATTN_STORE16(Ow+(long)row*OP+ch*8,v);} }
  asm volatile("s_waitcnt lgkmcnt(0)\n\ts_barrier":::"memory");
  #undef DMA_K
  #undef DMA_V
  #undef CMASK
  #undef START
  #undef RESC
  #undef ROT
}
constexpr int ATTN_LDS_BYTES=LDS_BYTES;
#undef SBAR
#undef WAIT_BAR
}


namespace hyf {
struct c32 { float x, y; };
typedef _Float16 h2 __attribute__((ext_vector_type(2)));
__device__ __forceinline__ c32 operator+(c32 a, c32 b) { return {a.x + b.x, a.y + b.y}; }
__device__ __forceinline__ c32 operator-(c32 a, c32 b) { return {a.x - b.x, a.y - b.y}; }
__device__ __forceinline__ c32 cmul(c32 a, c32 b) { return {a.x * b.x - a.y * b.y, a.x * b.y + a.y * b.x}; }
__device__ __forceinline__ constexpr float C32(int k) {
  switch (k) { case 0: return 1.f; case 1: return 0.98078528f; case 2: return 0.923879533f; case 3: return 0.831469612f; case 4: return 0.707106781f; case 5: return 0.555570233f; case 6: return 0.382683432f;
    case 7: return 0.195090322f; case 8: return 0.f; case 9: return -0.195090322f; case 10: return -0.382683432f; case 11: return -0.555570233f; case 12: return -0.707106781f; case 13: return -0.831469612f;
    case 14: return -0.923879533f; default: return -0.98078528f; } }
__device__ __forceinline__ constexpr float S32(int k) {
  switch (k) { case 0: return 0.f; case 1: return 0.195090322f; case 2: return 0.382683432f; case 3: return 0.555570233f; case 4: return 0.707106781f; case 5: return 0.831469612f; case 6: return 0.923879533f;
    case 7: return 0.98078528f; case 8: return 1.f; case 9: return 0.98078528f; case 10: return 0.923879533f; case 11: return 0.831469612f; case 12: return 0.707106781f; case 13: return 0.555570233f;
    case 14: return 0.382683432f; default: return 0.195090322f; } }
__device__ __forceinline__ constexpr int brev(int q, int bits) {
  return bits == 4 ? (((q & 1) << 3) | ((q & 2) << 1) | ((q & 4) >> 1) | ((q & 8) >> 3))
                   : (((q & 1) << 4) | ((q & 2) << 2) | (q & 4) | ((q & 8) >> 2) | ((q & 16) >> 4)); }
__device__ __forceinline__ int phys(int p) { return p + (p >> 5); }
template <int R, int HALF, bool INV> struct DftStage {
  static __device__ __forceinline__ void run(c32 (&x)[R]) {
#pragma unroll
    for (int blk = 0; blk < R; blk += 2 * HALF) {
#pragma unroll
      for (int j = 0; j < HALF; ++j) {
        const c32 a = x[blk + j], b = x[blk + j + HALF]; x[blk + j] = a + b; const c32 d = a - b;
        const int e = j * (R / (2 * HALF)) * (32 / R);
        if (e == 0) x[blk + j + HALF] = d;
        else if (e == 8) x[blk + j + HALF] = INV ? (c32){-d.y, d.x} : (c32){d.y, -d.x};
        else { const c32 wv = {C32(e), INV ? S32(e) : -S32(e)}; x[blk + j + HALF] = cmul(d, wv); }
      } }
    DftStage<R, HALF / 2, INV>::run(x);
  }
};
template <int R, bool INV> struct DftStage<R, 0, INV> { static __device__ __forceinline__ void run(c32 (&)[R]) {} };
template <int R, bool INV> __device__ __forceinline__ void dft_pow2(c32 (&x)[R]) { DftStage<R, R / 2, INV>::run(x); }
template <int R, int HALF> struct DitStage {
  static __device__ __forceinline__ void run(c32 (&x)[R]) {
#pragma unroll
    for (int blk = 0; blk < R; blk += 2 * HALF) {
#pragma unroll
      for (int j = 0; j < HALF; ++j) {
        const int e = j * (R / (2 * HALF)) * (32 / R);
        const c32 a = x[blk + j], b0 = x[blk + j + HALF];
        c32 b;
        if (e == 0) b = b0; else if (e == 8) b = (c32){-b0.y, b0.x}; else b = cmul(b0, (c32){C32(e), S32(e)});
        x[blk + j] = a + b; x[blk + j + HALF] = a - b;
      } }
    DitStage<R, HALF * 2>::run(x);
  }
};
template <int R> struct DitStage<R, R> { static __device__ __forceinline__ void run(c32 (&)[R]) {} };
template <int R> __device__ __forceinline__ void idft_dit(c32 (&x)[R]) { DitStage<R, 1>::run(x); }
template <int STRIDE, bool INV> __device__ __forceinline__ void pass16(c32* buf, int e0, float rev) {
  float rv = rev; asm volatile("" : "+v"(rv));
  const float cs = __builtin_amdgcn_cosf(rv), sn = __builtin_amdgcn_sinf(rv);
  const c32 w1 = {cs, INV ? sn : -sn};
  c32* p = buf + phys(e0); constexpr int PS = STRIDE + STRIDE / 32;
  c32 x[16];
  if (!INV) {
#pragma unroll
    for (int m = 0; m < 16; ++m) x[m] = p[PS * m];
    dft_pow2<16, false>(x);
    c32 w = w1; p[0] = x[0];
#pragma unroll
    for (int q = 1; q < 16; ++q) { p[PS * q] = cmul(x[brev(q, 4)], w); w = cmul(w, w1); }
  } else {
    c32 w = w1; x[0] = p[0];
#pragma unroll
    for (int q = 1; q < 16; ++q) { x[q] = cmul(p[PS * q], w); w = cmul(w, w1); }
    dft_pow2<16, true>(x);
#pragma unroll
    for (int m = 0; m < 16; ++m) p[PS * m] = x[brev(m, 4)];
  }
}
template <int MODE> __device__ __forceinline__ void mid32(c32* buf, h2* Hs, int j) {
  c32* p = buf + 33 * j; c32 x[32];
#pragma unroll
  for (int m = 0; m < 32; ++m) x[m] = p[m];
  dft_pow2<32, false>(x);
  if (MODE == 0) {
#pragma unroll
    for (int q = 0; q < 32; ++q) { const c32 v = x[brev(q, 5)]; Hs[q * 256 + j] = (h2){(_Float16)v.x, (_Float16)v.y}; }
  } else {
#pragma unroll
    for (int pp = 0; pp < 32; ++pp) { const h2 hv = Hs[brev(pp, 5) * 256 + j]; x[pp] = cmul(x[pp], (c32){(float)hv.x, (float)hv.y}); }
    idft_dit<32>(x);
#pragma unroll
    for (int m = 0; m < 32; ++m) p[m] = x[m];
  }
}
__device__ __forceinline__ void fwd2(c32* buf, int tid) {
  __syncthreads(); pass16<512, false>(buf, tid, (float)tid * (1.0f / 8192.0f));
  __syncthreads(); pass16<32, false>(buf, (tid >> 5) * 512 + (tid & 31), (float)(tid & 31) * (1.0f / 512.0f));
  __syncthreads();
}
__device__ __forceinline__ void conv(c32* buf, h2* Hs, int tid) {
  fwd2(buf, tid);
  if (tid < 256) mid32<1>(buf, Hs, tid);
  __syncthreads(); pass16<32, true>(buf, (tid >> 5) * 512 + (tid & 31), (float)(tid & 31) * (1.0f / 512.0f));
  __syncthreads(); pass16<512, true>(buf, tid, (float)tid * (1.0f / 8192.0f));
  __syncthreads();
}
__device__ __forceinline__ void item(int c, const bf16_t* HYT, const float* HK, const float* hy_bias, bf16_t* HYO, char* lds) {
  c32* buf = (c32*)lds; h2* H0 = (h2*)(lds + 67584); h2* H1 = H0 + 8192;
  const int tid = TIDX;
#pragma unroll 1
  for (int o = 0; o < 2; ++o) {
    const float* kp = HK + ((size_t)o * 256 + c) * 8192;
#pragma unroll
    for (int i = 0; i < 16; ++i) { const int n = tid + 512 * i; buf[phys(n)] = (c32){kp[n], 0.f}; }
    fwd2(buf, tid);
    if (tid < 256) mid32<0>(buf, o ? H1 : H0, tid);
    __syncthreads();
  }
  const float bias0 = hy_bias[c], bias1 = hy_bias[256 + c];
#pragma unroll 1
  for (int pr = 0; pr < 2; ++pr) {
    const bf16_t* v0 = HYT + ((size_t)(2 * pr) * 768 + c) * SEQ; const bf16_t* v1 = v0 + (size_t)768 * SEQ;
    c32 vv[8];
#pragma unroll
    for (int i = 0; i < 8; ++i) { const int t = tid + 512 * i; vv[i] = (c32){bf2f(v0[t]), bf2f(v1[t])}; buf[phys(t)] = vv[i]; buf[phys(t + 4096)] = (c32){0.f, 0.f}; }
    conv(buf, H0, tid);
#pragma unroll
    for (int i = 0; i < 8; ++i) { const int t = tid + 512 * i; const c32 y = buf[phys(t)];
      vv[i] = (c32){bf2f(v0[(size_t)256 * SEQ + t]) * (y.x * (1.0f / 8192.0f) + bias0 * vv[i].x), bf2f(v1[(size_t)256 * SEQ + t]) * (y.y * (1.0f / 8192.0f) + bias0 * vv[i].y)};
      buf[phys(t)] = vv[i]; buf[phys(t + 4096)] = (c32){0.f, 0.f}; }
    conv(buf, H1, tid);
#pragma unroll
    for (int i = 0; i < 8; ++i) { const int t = tid + 512 * i; const c32 y = buf[phys(t)];
      HYO[((size_t)(2 * pr) * 256 + c) * SEQ + t] = (bf16_t)f2bf(bf2f(v0[(size_t)512 * SEQ + t]) * (y.x * (1.0f / 8192.0f) + bias1 * vv[i].x));
      HYO[((size_t)(2 * pr + 1) * 256 + c) * SEQ + t] = (bf16_t)f2bf(bf2f(v1[(size_t)512 * SEQ + t]) * (y.y * (1.0f / 8192.0f) + bias1 * vv[i].y)); }
    __syncthreads();
  }
}
__device__ __forceinline__ void out_item(int it, const bf16_t* HYO, bf16_t* MIX, char* lds) {
  bf16_t (*T)[72] = (bf16_t (*)[72])lds;
  const int tid = TIDX, b = it >> 8, t0 = ((it >> 2) & 63) * 64, c0 = (it & 3) * 64;
  { const int cc = tid >> 3, t8 = (tid & 7) * 8; *(u32x4*)&T[cc][t8] = *(const u32x4*)(HYO + ((size_t)b * 256 + c0 + cc) * SEQ + t0 + t8); }
  __syncthreads();
  { const int tl = tid >> 3, c8 = (tid & 7) * 8; u32x4 o;
    o.x = (unsigned)T[c8][tl] | ((unsigned)T[c8 + 1][tl] << 16); o.y = (unsigned)T[c8 + 2][tl] | ((unsigned)T[c8 + 3][tl] << 16);
    o.z = (unsigned)T[c8 + 4][tl] | ((unsigned)T[c8 + 5][tl] << 16); o.w = (unsigned)T[c8 + 6][tl] | ((unsigned)T[c8 + 7][tl] << 16);
    *(u32x4*)(MIX + ((size_t)b * TPB + CTXL + t0 + tl) * DM + 768 + c0 + c8) = o; }
  __syncthreads();
}
}

#define LAS __attribute__((address_space(3)))
#define XB_TMO      128
#define XB_XCNT(j)  (256  + 64 * (j))
#define XB_XSUB(j)  (1280 + 64 * (j))
#define XB_XGEN(j)  (2304 + 64 * (j))
#define XB_TOP      3328
#define XB_TOPGEN   3392
#define XCD_BAR_WORDS 3456
#define XB_SPIN_CAP (1u << 18)

__device__ __forceinline__ unsigned xb_ld(unsigned* p)              { return __hip_atomic_load(p, __ATOMIC_RELAXED, __HIP_MEMORY_SCOPE_AGENT); }
__device__ __forceinline__ unsigned xb_add(unsigned* p, unsigned v) { return __hip_atomic_fetch_add(p, v, __ATOMIC_RELAXED, __HIP_MEMORY_SCOPE_AGENT); }
__device__ __forceinline__ unsigned xb_xcc_id() { return (unsigned)__builtin_amdgcn_s_getreg((3 << 11) | 20) & 0xFu; }
#define XB_SPIN(cond, bar) do { unsigned _sp = 0; while (cond) { __builtin_amdgcn_s_sleep(1); \
    if ((++_sp & 255u) == 0u) { if (xb_ld(&(bar)[XB_TMO])) break; if (_sp > XB_SPIN_CAP) { atomicAdd(&(bar)[XB_TMO], 1u); break; } } } } while (0)

struct XcdBarrier {
    unsigned* bar; unsigned x;
    volatile LAS unsigned* st;
};

__device__ __forceinline__ XcdBarrier xcd_barrier_post(unsigned* bar, volatile LAS unsigned* st) {
    XcdBarrier b; b.bar = bar; b.x = xb_xcc_id(); b.st = st;
    if (threadIdx.x == 0) (void)xb_add(&bar[XB_XCNT(b.x)], 1u);
    return b;
}
__device__ __forceinline__ void xcd_barrier_complete(unsigned* bar, unsigned x, unsigned& nloc, unsigned& nx) {
    const unsigned G = gridDim.x * gridDim.y * gridDim.z;
    unsigned sum, cnt, mine, sp = 0u;
    for (;;) {
        sum = 0u; cnt = 0u; mine = 0u;
#pragma unroll
        for (unsigned j = 0; j < 16; ++j) { const unsigned c = xb_ld(&bar[XB_XCNT(j)]); sum += c; cnt += (c > 0u) ? 1u : 0u; mine = (j == x) ? c : mine; }
        if (sum == G) break;
        __builtin_amdgcn_s_sleep(1);
        if ((++sp & 255u) == 0u) { if (xb_ld(&bar[XB_TMO])) break; if (sp > XB_SPIN_CAP) { atomicAdd(&bar[XB_TMO], 1u); break; } }
    }
    nloc = mine > 0u ? mine : 1u; nx = cnt > 0u ? cnt : 1u;
}

__device__ __forceinline__ void xcd_barrier(const XcdBarrier& b) {
    asm volatile("s_waitcnt vmcnt(0)" ::: "memory");
    __syncthreads();
    if (threadIdx.x == 0) {
        unsigned* bar = b.bar;
        __builtin_amdgcn_s_waitcnt(0);
        unsigned nloc = b.st[0], nx = b.st[1];
        if (nloc == 0u) { xcd_barrier_complete(bar, b.x, nloc, nx); b.st[0] = nloc; b.st[1] = nx; }
        const unsigned old = xb_add(&bar[XB_XSUB(b.x)], 1u);
        const unsigned gen = old / nloc;
        if (old + 1u == (gen + 1u) * nloc) {
            __builtin_amdgcn_fence(__ATOMIC_RELEASE, "agent");
            asm volatile("s_waitcnt vmcnt(0)" ::: "memory");
            const unsigned og = xb_add(&bar[XB_TOP], 1u);
            const unsigned tg = og / nx;
            if (og + 1u == (tg + 1u) * nx) xb_add(&bar[XB_TOPGEN], 1u);
            else XB_SPIN(xb_ld(&bar[XB_TOPGEN]) == tg, bar);
            __builtin_amdgcn_fence(__ATOMIC_ACQUIRE, "agent");
            xb_add(&bar[XB_XGEN(b.x)], 1u);
            asm volatile("s_waitcnt vmcnt(0)" ::: "memory");
        } else {
            XB_SPIN(xb_ld(&bar[XB_XGEN(b.x)]) == gen, bar);
            __builtin_amdgcn_fence(__ATOMIC_ACQUIRE, "agent");
            asm volatile("s_waitcnt vmcnt(0)" ::: "memory");
        }
    }
    __syncthreads();
}


struct MP { const float* in[33]; float* out; unsigned char* ws; };
typedef const float* const __attribute__((address_space(4))) * kargs_t;
#define KARGS() ({ kargs_t k_ = (kargs_t)__builtin_amdgcn_kernarg_segment_ptr(); asm volatile("" : "+s"(k_)); k_; })
#define WSP(K, off) ((unsigned char*)(K)[34] + (off))

__global__ void __launch_bounds__(NT, 2) mega(MP P) {
  cg::grid_group grid = cg::this_grid();
  extern __shared__ __attribute__((aligned(16))) char lds[];
  volatile LAS unsigned* xst = (volatile LAS unsigned*)(lds + LDS_BYTES - 16);
  if (threadIdx.x < 2) xst[threadIdx.x] = 0u;
  __syncthreads();
  { kargs_t K = KARGS(); (void)xcd_barrier_post((unsigned*)WSP(K, WS_CTL) + CT_BAR, xst); }
#define XBAR_HERE() do { kargs_t Kb_ = KARGS(); XcdBarrier xb_; xb_.bar = (unsigned*)WSP(Kb_, WS_CTL) + CT_BAR; xb_.x = xb_xcc_id(); xb_.st = (volatile LAS unsigned*)(lds + LDS_BYTES - 16); xcd_barrier(xb_); } while (0)
#define SEAM() XBAR_HERE()
  {
    kargs_t K = KARGS();
    st_adaln(K[1], K[3], K[4], K[5], (float*)WSP(K, WS_MODV), lds);
    st_rope((float*)WSP(K, WS_ROPE));
  }
  {
      kargs_t K = KARGS();
      st_weights(K[8], K[26], K[29], K[30], K[31], 0, (bf16_t*)WSP(K, WS_WIN), (bf16_t*)WSP(K, WS_WOUT), (bf16_t*)WSP(K, WS_WGU), (bf16_t*)WSP(K, WS_WD), lds);
    }
    { kargs_t K = KARGS(); const int bid = BIDX, G = GDIM;
      for (int it = bid; it < SEQ / 16; it += G) hyfilt_item<SEQ>(it, K[19] + 0 * 33 * 64, K[20] + 0 * 64, K[21] + 0 * 64, K[22] + 0 * 4096, K[23] + 0 * 64, K[24] + (size_t)0 * 65536, (float*)WSP(K, WS_HK), lds);
      if (true) for (int it = bid; it < CTXL / 16; it += G) hyfilt_item<CTXL>(it, K[19] + 0 * 33 * 64, K[20] + 0 * 64, K[21] + 0 * 64, K[22] + 0 * 4096, K[23] + 0 * 64, K[24] + (size_t)0 * 65536, (float*)WSP(K, WS_HKC), lds);
    }
  if (gridDim.x == 0x7fffffffu) grid.sync();
  XBAR_HERE();
#pragma nounroll
  for (int layer = 0; layer < 2; ++layer) {
    const bool last = layer == 1;
    if (layer == 1) {
    {
      kargs_t K = KARGS();
      st_weights(K[8], K[26], K[29], K[30], K[31], layer, (bf16_t*)WSP(K, WS_WIN), (bf16_t*)WSP(K, WS_WOUT), (bf16_t*)WSP(K, WS_WGU), (bf16_t*)WSP(K, WS_WD), lds);
    }
    { kargs_t K = KARGS(); const int bid = BIDX, G = GDIM;
      for (int it = bid; it < SEQ / 16; it += G) hyfilt_item<SEQ>(it, K[19] + layer * 33 * 64, K[20] + layer * 64, K[21] + layer * 64, K[22] + layer * 4096, K[23] + layer * 64, K[24] + (size_t)layer * 65536, (float*)WSP(K, WS_HK), lds);
      if (!last) for (int it = bid; it < CTXL / 16; it += G) hyfilt_item<CTXL>(it, K[19] + layer * 33 * 64, K[20] + layer * 64, K[21] + layer * 64, K[22] + layer * 4096, K[23] + layer * 64, K[24] + (size_t)layer * 65536, (float*)WSP(K, WS_HKC), lds);
    }
    }
    { kargs_t K = KARGS();
      st_normmod(K[0], K[2], (bf16_t*)WSP(K, WS_H), layer == 0 ? (const bf16_t*)nullptr : (const bf16_t*)WSP(K, WS_H2S), (const int*)WSP(K, WS_MOEM + 768 * 1024),
                 (const float*)WSP(K, WS_MODV) + 5120, K[6] + layer * 1024, (const float*)WSP(K, WS_MODV) + (size_t)layer * 5 * 6144, 0, 1024, (bf16_t*)K[33], lds);
    }
    SEAM();
    {
      kargs_t K = KARGS();
      pg8::Gemm g{1024, 1024, 1024}; SchedDense S{MTOK / 256, NPAD / 256, (int)GDIM, BIDX, 0, (const char*)K[33], (const char*)WSP(K, WS_WIN), (size_t)256 * 1024 * 2, (size_t)256 * 1024 * 2};
      EpiInProj E{(bf16_t*)WSP(K, WS_QK), (bf16_t*)WSP(K, WS_VZ), (bf16_t*)WSP(K, WS_XBC), (bf16_t*)WSP(K, WS_HY), (float*)WSP(K, WS_DT)};
      pg8::gemm_phase<EpiInProj, SchedDense, true, true>((PG8_LAS unsigned char*)lds, g, S, E);
    }
    SEAM();
    {
      kargs_t K = KARGS();
      st_prep_qk((bf16_t*)WSP(K, WS_QK), K[9] + layer * 64, K[10] + layer * 64, (const float*)WSP(K, WS_ROPE));
    }
    { kargs_t K = KARGS();
      st_prep_hy((const bf16_t*)WSP(K, WS_HY), K[17] + layer * 3 * 768, K[18] + layer * 768, (bf16_t*)WSP(K, WS_HYT), last ? 0 : 1, lds);
    }
    { kargs_t K = KARGS();
      st_ssd1(BIDX, GDIM, 4 * 34 * 6, (const bf16_t*)WSP(K, WS_XBC), (const float*)WSP(K, WS_DT), K[11] + layer * 3 * 640, K[12] + layer * 640, K[13] + layer * 12, K[14] + layer * 12,
              (bf16_t*)WSP(K, WS_Y), (bf16_t*)WSP(K, WS_ST), (float*)WSP(K, WS_DEC), lds);
    }
    SEAM();
    {
      { kargs_t K2 = KARGS(); st_ssd_scan2((bf16_t*)WSP(K2, WS_ST), (const float*)WSP(K2, WS_DEC)); }
      const int bid = BIDX, G = GDIM;
#define P4_ATT(bb, hq, qrow_, nt_) do { kargs_t K = KARGS(); const int kvh_ = (hq) / 3; \
          const attn_body::bf16* QKp = (const attn_body::bf16*)WSP(K, WS_QK); const attn_body::bf16* VZp = (const attn_body::bf16*)WSP(K, WS_VZ); \
          attn_body::attn_unit<8>(QKp + (size_t)(qrow_) * 512 + (hq) * 64, QKp + (size_t)(bb) * TPB * 512 + 384 + kvh_ * 64, VZp + (size_t)(bb) * TPB * 512 + kvh_ * 64, \
                                  (attn_body::bf16*)K[33] + (size_t)(qrow_) * 1024 + (hq) * 64, (nt_), lds); } while (0)
#define P4_FFT(cch) do { kargs_t K = KARGS(); hyf::item((cch), (const bf16_t*)WSP(K, WS_HYT), (const float*)WSP(K, WS_HK), K[25] + layer * 512, (bf16_t*)WSP(K, WS_HY), lds); } while (0)
#define P4_CHY(itm) do { kargs_t K = KARGS(); hyconv_ctx_item((itm), (const bf16_t*)WSP(K, WS_HYT) + (size_t)4 * 768 * SEQ, (const float*)WSP(K, WS_HKC), K[25] + layer * 512, (bf16_t*)K[33], lds); } while (0)
      {
        const int x = bid & 7, y = bid >> 3, bb = x >> 1, kvh = x & 1;
        const int nun = y < 16 ? 2 : 1, natt = nun + ((!last && y < 3) ? 1 : 0);
#pragma unroll 1
        for (int k = 0; k < natt; ++k) { int hq, qrow, nt;
          if (k < nun) { const int v = y < 16 ? y + 16 * k : 16 + y; hq = 3 * kvh + (v >> 4); qrow = bb * TPB + CTXL + (v & 15) * 256; nt = TPB / 64; }
          else { hq = 3 * kvh + y; qrow = bb * TPB; nt = CTXL / 64; }
          P4_ATT(bb, hq, qrow, nt); }
        if (y >= 16) {
#pragma unroll 1
          for (int k = 0; k < 2; ++k) { const int cch = ((y - 16) * 8 + x) * 2 + k; P4_FFT(cch); } }
        if (!last && y >= 3 && y < 11) { P4_CHY((y - 3) * 8 + x); }
      }
      (void)G;
#undef P4_ATT
#undef P4_FFT
#undef P4_CHY
    }
    SEAM();
    {
      kargs_t K = KARGS();
      { const int bid = BIDX, G = GDIM, nit = last ? 4 * 32 * 2 : 4 * 34 * 2;
        for (int it = bid; it < nit; it += G) { const int g = it & 1, bc = it >> 1; const int b = last ? bc >> 5 : bc / 34, cidx = last ? 2 + (bc & 31) : bc % 34;
          ssd3_item(b, cidx, g, (const bf16_t*)WSP(K, WS_XBC), (const bf16_t*)WSP(K, WS_VZ), (const float*)WSP(K, WS_DT), K[11] + layer * 3 * 640, K[12] + layer * 640, K[13] + layer * 12, K[14] + layer * 12,
                    K[15] + layer * 6, K[16] + layer * 384, (const bf16_t*)WSP(K, WS_Y), (const bf16_t*)WSP(K, WS_ST), (bf16_t*)K[33], lds); } }
      { const int bid = BIDX, G = GDIM; for (int it = bid; it < 1024; it += G) hyf::out_item(it, (const bf16_t*)WSP(K, WS_HY), (bf16_t*)K[33], lds); }
      const int t = TIDX; if (BIDX == 0 && t < 256) ((int*)WSP(K, WS_CTL))[t] = 0;
      { int* stok = (int*)WSP(K, WS_MOEM + 384 * 1024); for (int i = BIDX * NT + t; i < MOE_ROWS; i += GDIM * NT) stok[i] = -1; }
    }
    SEAM();
    {
      kargs_t K = KARGS();
      pg8::Gemm g{1024, 1024, 1024}; SchedDense S{last ? 64 : 68, 4, (int)GDIM, BIDX, last ? 1 : 0, (const char*)K[33], (const char*)WSP(K, WS_WOUT), (size_t)256 * 1024 * 2, (size_t)256 * 1024 * 2};
      EpiOutProj E{(bf16_t*)WSP(K, WS_QK)};
      pg8::gemm_phase<EpiOutProj, SchedDense, true, true>((PG8_LAS unsigned char*)lds, g, S, E);
    }
    SEAM();
    {
      kargs_t K = KARGS();
      st_router(K[0], K[2], layer == 0 ? 1 : 0, (bf16_t*)WSP(K, WS_H), (const bf16_t*)WSP(K, WS_QK), K[7] + layer * 1024, (const float*)WSP(K, WS_MODV) + (size_t)layer * 5 * 6144, K[27], K[28], (bf16_t*)K[33], (int*)WSP(K, WS_CTL),
                (int*)WSP(K, WS_MOEM), (float*)WSP(K, WS_MOEM + 128 * 1024), last ? 1 : 0, lds);
    }
    SEAM();
    { kargs_t K = KARGS();
      st_moe_gather((const bf16_t*)K[33], (bf16_t*)WSP(K, WS_H2S), (int*)WSP(K, WS_CTL), (const int*)WSP(K, WS_MOEM), (const float*)WSP(K, WS_MOEM + 128 * 1024),
                    (int*)WSP(K, WS_MOEM + 384 * 1024), (float*)WSP(K, WS_MOEM + 512 * 1024), (int*)WSP(K, WS_MOEM + 768 * 1024), last ? 1 : 0, lds);
    }
    SEAM();
    { kargs_t K = KARGS();
      pg8::Gemm g{1024, 1024, 1024}; SchedMoe S{(int)GDIM, BIDX, 1, (const int*)WSP(K, WS_CTL), (const char*)WSP(K, WS_H2S), (size_t)256 * 1024 * 2, (const char*)WSP(K, WS_WGU)};
      EpiMoe1 E{(bf16_t*)WSP(K, WS_ACT), (const float*)WSP(K, WS_MOEM + 512 * 1024)};
      pg8::gemm_phase<EpiMoe1, SchedMoe, true, true>((PG8_LAS unsigned char*)lds, g, S, E);
    }
    SEAM();
    { kargs_t K = KARGS();
      pg8::Gemm g{256, 512, 256}; SchedMoe S{(int)GDIM, BIDX, 2, (const int*)WSP(K, WS_CTL), (const char*)WSP(K, WS_ACT), (size_t)256 * 512 * 2, (const char*)WSP(K, WS_WD)};
      EpiMoe2 E{(bf16_t*)WSP(K, WS_H2S)};
      pg8::gemm_phase<EpiMoe2, SchedMoe, true, true>((PG8_LAS unsigned char*)lds, g, S, E);
    }
    SEAM();
  }
  { kargs_t K = KARGS(); st_final((float*)K[33], K[32], (const bf16_t*)WSP(K, WS_H), (const bf16_t*)WSP(K, WS_H2S), (const int*)WSP(K, WS_MOEM + 768 * 1024), (const float*)WSP(K, WS_MODV) + (size_t)5 * 6144 + 5120); }
}

extern "C" void kernel_launch(void* const* d_in, const int* in_sizes, int n_in, void* d_out, int out_size, void* d_ws, size_t ws_size, hipStream_t stream) {
  if (n_in != 33 || ws_size < WS_END) { fprintf(stderr, "kernel_launch: unexpected n_in %d / ws %zu\n", n_in, ws_size); return; }
  static int grid_blocks = 0;
  if (!grid_blocks) {
    int dev = 0, cus = 0, per_cu = 0;
    (void)hipGetDevice(&dev);
    (void)hipDeviceGetAttribute(&cus, hipDeviceAttributeMultiprocessorCount, dev);
    (void)hipFuncSetAttribute((const void*)mega, hipFuncAttributeMaxDynamicSharedMemorySize, LDS_BYTES);
    (void)hipOccupancyMaxActiveBlocksPerMultiprocessor(&per_cu, mega, NT, LDS_BYTES);
    if (per_cu < 1) per_cu = 1;
    if (per_cu > 2) per_cu = 2;
    grid_blocks = 256;
    if (cus != 256 || per_cu < 1) fprintf(stderr, "kernel_launch: expected 256 CUs with >= 1 workgroup each (got %d CUs, %d per CU)\n", cus, per_cu);
  }
  (void)hipMemsetAsync((char*)d_ws + WS_CTL + (size_t)CT_BAR * 4, 0, (size_t)XCD_BAR_WORDS * 4, stream);
  MP p{};
  for (int i = 0; i < 33; ++i) p.in[i] = (const float*)d_in[i];
  p.out = (float*)d_out; p.ws = (unsigned char*)d_ws;
  void* args[] = {&p};
  hipError_t e = hipLaunchCooperativeKernel((const void*)mega, dim3(grid_blocks), dim3(NT), args, LDS_BYTES, stream);
  if (e != hipSuccess) fprintf(stderr, "cooperative launch failed: %s (grid %d)\n", hipGetErrorString(e), grid_blocks);
}
```

```cpp
#include <hip/hip_runtime.h>
#include <hip/hip_cooperative_groups.h>
#include <cstdio>
#include <cstdint>
namespace cg = cooperative_groups;

typedef unsigned short bf16_t;
typedef short bf16x8 __attribute__((ext_vector_type(8)));
typedef float f32x4 __attribute__((ext_vector_type(4)));
typedef unsigned u32x4 __attribute__((ext_vector_type(4)));
typedef unsigned u32x2 __attribute__((ext_vector_type(2)));

constexpr int NB = 4, SEQ = 4096, CTXL = 256, DM = 1024, TPB = 4352, MTOK = NB * TPB;
constexpr int DIN = 2444, NPAD = 2560;
constexpr float EPS = 1e-6f;
constexpr float C2 = 0.125f * 1.4426950408889634f;
constexpr int MOE_ROWS = 23552;
constexpr int NT = 512;
constexpr int LDS_BYTES = 147456;

constexpr size_t MiB = 1u << 20;
constexpr size_t WS_CTL = 0;
constexpr size_t WS_MODV = 1 * MiB;
constexpr size_t WS_ROPE = 2 * MiB;
constexpr size_t WS_MOEM = 3 * MiB;
constexpr size_t WS_DT = 4 * MiB;
constexpr size_t WS_HKC = 5 * MiB;
constexpr size_t WS_XC = 6 * MiB;
constexpr size_t WS_WIN = 10 * MiB;
constexpr size_t WS_WOUT = 15 * MiB;
constexpr size_t WS_WGU = 17 * MiB;
constexpr size_t WS_WD = 33 * MiB;
constexpr size_t WS_HK = 41 * MiB;
constexpr size_t WS_H = 57 * MiB;
constexpr size_t WS_QK = 91 * MiB;
constexpr size_t WS_VZ = 108 * MiB;
constexpr size_t WS_XBC = 125 * MiB;
constexpr size_t WS_HY = WS_XBC + (size_t)MTOK * 768 * 2;
constexpr size_t WS_HYT = WS_HY + (size_t)MTOK * 768 * 2;
constexpr size_t WS_ST = WS_HYT + (size_t)MTOK * 768 * 2;
constexpr size_t WS_Y = WS_ST + (size_t)4 * 34 * 2 * 6 * 4096 * 4;
constexpr size_t WS_END = WS_Y + (size_t)MTOK * 384 * 4;
constexpr size_t WS_DEC = WS_DT + 900 * 1024;
constexpr size_t WS_H2S = WS_QK;
constexpr size_t WS_ACT = WS_H2S + (size_t)MOE_ROWS * 1024 * 2;
static_assert(WS_END <= 256 * MiB, "ws");
static_assert(WS_ACT + (size_t)MOE_ROWS * 512 * 2 <= WS_HYT, "moe alias");

constexpr int CT_CNT = 0, CT_FILL = 32, CT_BASE = 64, CT_NT = 96, CT_TP = 128;
constexpr int CT_BAR = 4096;
constexpr bool IN_HALF = false;
constexpr int CT_CNTB = 8192;

__device__ __forceinline__ int opq_v(int v) { asm volatile("" : "+v"(v)); return v; }
__device__ __forceinline__ int opq_s(int v) { asm volatile("" : "+s"(v)); return v; }
#define TIDX opq_v((int)threadIdx.x)
#define BIDX opq_s((int)blockIdx.x)
#define GDIM opq_s((int)gridDim.x)
__device__ __forceinline__ unsigned f2bf(float f) { unsigned u = __float_as_uint(f); return (u + 0x7fffu + ((u >> 16) & 1u)) >> 16; }
__device__ __forceinline__ unsigned pk2bf(float lo, float hi) { return f2bf(lo) | (f2bf(hi) << 16); }
__device__ __forceinline__ float bf2f(bf16_t h) { return __uint_as_float(((unsigned)h) << 16); }
__device__ __forceinline__ float wave_sum(float v) {
#pragma unroll
  for (int o = 1; o < 64; o <<= 1) v += __shfl_xor(v, o);
  return v;
}
__device__ __forceinline__ float siluf(float v) { return v / (1.0f + __expf(-v)); }
__device__ __forceinline__ float* xrow(const float* xl, const float* xc, int r) {
  const int b = r / TPB, j = r - b * TPB;
  return (float*)(j < CTXL ? xc + ((size_t)b * CTXL + j) * DM : xl + ((size_t)b * SEQ + (j - CTXL)) * DM);
}
__device__ __forceinline__ int mrow_of(int r) { const int b = r / TPB, j = r - b * TPB; return j < CTXL ? 4 : b; }

__device__ __forceinline__ void st_adaln(const float* c, const float* c_ctx, const float* w_mod, const float* b_mod, float* modv, char* lds) {
  float (*sc)[1024] = (float (*)[1024])lds;
  float (*red)[5][64] = (float (*)[5][64])(lds + 5 * 1024 * 4);
  const int tid = TIDX;
  for (int it = BIDX; it < 192; it += GDIM) {
    const int layer = it / 96, n0 = (it % 96) * 64;
    for (int i = tid; i < 5 * 1024; i += NT) { const int r = i >> 10, k = i & 1023; const float v = r < 4 ? c[r * 1024 + k] : c_ctx[k]; sc[r][k] = v / (1.0f + expf(-v)); }
    __syncthreads();
    const int kg = tid >> 6, n = tid & 63;
    float acc[5] = {0.f, 0.f, 0.f, 0.f, 0.f};
#pragma unroll 16
    for (int k = kg; k < 1024; k += 8) { const float w = w_mod[((size_t)layer * 1024 + k) * 6144 + n0 + n];
#pragma unroll
      for (int r = 0; r < 5; ++r) acc[r] += sc[r][k] * w; }
#pragma unroll
    for (int r = 0; r < 5; ++r) red[kg][r][n] = acc[r];
    __syncthreads();
    if (tid < 320) { const int r = tid >> 6, nn = tid & 63; float s = 0.f;
#pragma unroll
      for (int g = 0; g < 8; ++g) s += red[g][r][nn];
      modv[((size_t)layer * 5 + r) * 6144 + n0 + nn] = s + b_mod[layer * 6144 + n0 + nn]; }
    __syncthreads();
  }
}
__device__ __forceinline__ void st_rope(float* rope) {
  for (int i = BIDX * NT + TIDX; i < 4096 * 32; i += GDIM * NT) {
    const int t = i >> 5, d = i & 31, m = d & 15;
    const float inv = exp2f(-(float)(2 * m) * (13.287712379549449f / 32.0f));
    const float pos = (float)(d < 16 ? (t >> 6) : (t & 63));
    float rev = pos * inv * 0.15915494309189535f; rev -= floorf(rev);
    rope[2 * i] = __builtin_amdgcn_cosf(rev); rope[2 * i + 1] = __builtin_amdgcn_sinf(rev);
  }
}

__device__ __forceinline__ void st_normmod(const float* xl, const float* xc, bf16_t* XB, const bf16_t* YS, const int* tok_slot, const float* gate_prev,
                                           const float* g, const float* modv_layer, int off_sh, int off_sc, bf16_t* H, char* lds) {
  float* mA = (float*)lds; float* mB = mA + 5 * 1024; float* mG = mB + 5 * 1024;
  const int tid = TIDX, lane = tid & 63, gw = BIDX * 8 + (tid >> 6), ngw = GDIM * 8;
  for (int idx = tid; idx < 5 * 1024; idx += NT) { const int m = idx >> 10, k = idx & 1023; mA[idx] = g[k] * (1.f + modv_layer[(size_t)m * 6144 + off_sc + k]); mB[idx] = modv_layer[(size_t)m * 6144 + off_sh + k];
    mG[idx] = YS ? gate_prev[(size_t)m * 6144 + k] : 0.f; }
  __syncthreads();
  for (int rb = gw; rb < MTOK; rb += 3 * ngw) {
    f32x4 v[3][4]; float rstd[3];
    if (!YS) {
#pragma unroll
      for (int u = 0; u < 3; ++u) { const int r = rb + u * ngw, rc = r < MTOK ? r : MTOK - 1; const float* xr = xrow(xl, xc, rc);
#pragma unroll
        for (int j = 0; j < 4; ++j) v[u][j] = *(const f32x4*)(xr + 4 * lane + 256 * j); }
    } else {
      u32x2 xb[3][4], ys[3][4];
#pragma unroll
      for (int u = 0; u < 3; ++u) { const int r = rb + u * ngw, rc = r < MTOK ? r : MTOK - 1; const bf16_t* xr = XB + (size_t)rc * DM; const bf16_t* yr = YS + (size_t)tok_slot[rc] * DM;
#pragma unroll
        for (int j = 0; j < 4; ++j) { xb[u][j] = *(const u32x2*)(xr + 4 * lane + 256 * j); ys[u][j] = *(const u32x2*)(yr + 4 * lane + 256 * j); } }
#pragma unroll
      for (int u = 0; u < 3; ++u) { const int r = rb + u * ngw, rc = r < MTOK ? r : MTOK - 1; const int mo = mrow_of(rc) * 1024;
#pragma unroll
        for (int j = 0; j < 4; ++j) { const int k = 4 * lane + 256 * j; const f32x4 g4 = *(const f32x4*)(mG + mo + k);
          const f32x4 x4 = (f32x4){__uint_as_float(xb[u][j].x << 16), __uint_as_float(xb[u][j].x & 0xffff0000u), __uint_as_float(xb[u][j].y << 16), __uint_as_float(xb[u][j].y & 0xffff0000u)};
          const f32x4 m4 = (f32x4){__uint_as_float(ys[u][j].x << 16), __uint_as_float(ys[u][j].x & 0xffff0000u), __uint_as_float(ys[u][j].y << 16), __uint_as_float(ys[u][j].y & 0xffff0000u)};
          v[u][j] = x4 + g4 * m4;
          if (r < MTOK) { u32x2 w; w.x = pk2bf(v[u][j].x, v[u][j].y); w.y = pk2bf(v[u][j].z, v[u][j].w); *(u32x2*)(XB + (size_t)r * DM + k) = w; } } }
    }
#pragma unroll
    for (int u = 0; u < 3; ++u) { float ss = 0.f;
#pragma unroll
      for (int j = 0; j < 4; ++j) ss += v[u][j].x * v[u][j].x + v[u][j].y * v[u][j].y + v[u][j].z * v[u][j].z + v[u][j].w * v[u][j].w;
      rstd[u] = rsqrtf(wave_sum(ss) * (1.0f / DM) + EPS); }
#pragma unroll
    for (int u = 0; u < 3; ++u) { const int r = rb + u * ngw;
      if (r < MTOK) { const int mo = mrow_of(r) * 1024;
#pragma unroll
        for (int j = 0; j < 4; ++j) { const int k = 4 * lane + 256 * j;
          const f32x4 a4 = *(const f32x4*)(mA + mo + k), b4 = *(const f32x4*)(mB + mo + k); const f32x4 o = v[u][j] * rstd[u] * a4 + b4;
          u32x2 w; w.x = pk2bf(o.x, o.y); w.y = pk2bf(o.z, o.w);
          *(u32x2*)(H + (size_t)r * DM + k) = w; } } }
  }
  __syncthreads();
}

template <int MODE> __device__ __forceinline__ void tr_wave_item(const float* src, const float* src2, int ldsrc, int K, bf16_t* out, int n0, int k0, float* scr, int lane) {
  const int nn = lane & 31, n = n0 + nn;
#pragma unroll 8
  for (int i = 0; i < 32; ++i) { const int kk = 2 * i + (lane >> 5); float v = 0.f;
    if (MODE == 0) { const int col = n < 1676 ? n : (n < 1792 ? -1 : n - 116); if (col >= 0) v = src[(size_t)(k0 + kk) * ldsrc + col]; }
    else if (MODE == 1) v = src[(size_t)(k0 + kk) * ldsrc + n];
    else v = (n & 1) ? src2[(size_t)(k0 + kk) * ldsrc + (n >> 1)] : src[(size_t)(k0 + kk) * ldsrc + (n >> 1)];
    scr[kk * 33 + nn] = v; }
  asm volatile("s_waitcnt lgkmcnt(0)" ::: "memory");
  const int c = lane & 7;
#pragma unroll
  for (int j = 0; j < 4; ++j) { const int nr = (lane >> 3) + 8 * j; const float* sp = scr + (8 * c) * 33 + nr;
    u32x4 o; o.x = f2bf(sp[0]) | (f2bf(sp[33]) << 16); o.y = f2bf(sp[66]) | (f2bf(sp[99]) << 16); o.z = f2bf(sp[132]) | (f2bf(sp[165]) << 16); o.w = f2bf(sp[198]) | (f2bf(sp[231]) << 16);
    *(u32x4*)(out + (size_t)(n0 + nr) * K + k0 + 8 * c) = o; }
  asm volatile("s_waitcnt lgkmcnt(0)" ::: "memory");
}
__device__ __forceinline__ void st_weights(const float* w_in, const float* w_out, const float* w_gate, const float* w_up, const float* w_down, int layer,
                                           bf16_t* WIN, bf16_t* WOUT, bf16_t* WGU, bf16_t* WD, char* lds) {
  const int tid = TIDX, lane = tid & 63, w = tid >> 6; float* scr = (float*)lds + w * (64 * 33);
  for (int it = BIDX * 8 + w; it < 7936; it += GDIM * 8) {
    if (it < 1280) tr_wave_item<0>(w_in + (size_t)layer * 1024 * DIN, nullptr, DIN, 1024, WIN, (it % 80) * 32, (it / 80) * 64, scr, lane);
    else if (it < 1792) { const int i2 = it - 1280; tr_wave_item<1>(w_out + (size_t)layer * 1024 * 1024, nullptr, 1024, 1024, WOUT, (i2 & 31) * 32, (i2 >> 5) * 64, scr, lane); }
    else if (it < 5888) { const int i2 = it - 1792, e = i2 >> 8, t = i2 & 255;
      tr_wave_item<2>(w_gate + ((size_t)layer * 16 + e) * 1024 * 256, w_up + ((size_t)layer * 16 + e) * 1024 * 256, 256, 1024, WGU + (size_t)e * 512 * 1024, (t & 15) * 32, (t >> 4) * 64, scr, lane); }
    else { const int i2 = it - 5888, e = i2 >> 7, t = i2 & 127;
      tr_wave_item<1>(w_down + ((size_t)layer * 16 + e) * 256 * 1024, nullptr, 1024, 256, WD + (size_t)e * 1024 * 256, (t & 31) * 32, (t >> 5) * 64, scr, lane); }
  }
  __syncthreads();
}

__device__ __forceinline__ void pair_experts(int pidx, int& eA, int& eB) {
  const int g = pidx / 6, t = pidx - 6 * g; const int i = t < 3 ? 0 : (t < 5 ? 1 : 2); const int j = t < 3 ? t + 1 : (t < 5 ? t - 1 : 3);
  eA = 4 * g + i; eB = 4 * g + j;
}
__device__ __forceinline__ void st_prep_qk(bf16_t* QK, const float* qn, const float* kn, const float* rope) {
  const int lane = TIDX & 63, gw = BIDX * 8 + (TIDX >> 6), ngw = GDIM * 8, hh = lane >> 3, sub = lane & 7;
  float gn[8];
#pragma unroll
  for (int e = 0; e < 8; ++e) gn[e] = ((hh < 6 ? qn : kn) + sub * 8)[e] * (hh < 6 ? C2 : 1.0f);
  for (int rb = gw; rb < MTOK; rb += 3 * ngw) {
    bf16x8 raw[3]; f32x4 rp4[3][4];
#pragma unroll
    for (int u = 0; u < 3; ++u) { const int r = rb + u * ngw < MTOK ? rb + u * ngw : MTOK - 1; const int j = r % TPB, t = j >= CTXL ? j - CTXL : 0;
      raw[u] = *(const bf16x8*)(QK + (size_t)r * 512 + hh * 64 + sub * 8);
      const float* rp = rope + ((size_t)t * 32 + (sub & 3) * 8) * 2;
#pragma unroll
      for (int q = 0; q < 4; ++q) rp4[u][q] = *(const f32x4*)(rp + 4 * q); }
#pragma unroll
    for (int u = 0; u < 3; ++u) { const int r = rb + u * ngw; const int j = (r < MTOK ? r : MTOK - 1) % TPB;
      float v[8]; float ss = 0.f;
#pragma unroll
      for (int e = 0; e < 8; ++e) { v[e] = bf2f((bf16_t)raw[u][e]); ss += v[e] * v[e]; }
      ss += __shfl_xor(ss, 1); ss += __shfl_xor(ss, 2); ss += __shfl_xor(ss, 4);
      const float rstd = rsqrtf(ss * (1.0f / 64.0f) + EPS);
#pragma unroll
      for (int e = 0; e < 8; ++e) v[e] = v[e] * rstd * gn[e];
      if (j >= CTXL) {
#pragma unroll
        for (int e = 0; e < 8; ++e) { const float other = __shfl_xor(v[e], 4); const float cs = rp4[u][e >> 1][(e & 1) * 2], sn = rp4[u][e >> 1][(e & 1) * 2 + 1]; v[e] = sub < 4 ? v[e] * cs - other * sn : v[e] * cs + other * sn; } }
      if (r < MTOK) *(u32x4*)(QK + (size_t)r * 512 + hh * 64 + sub * 8) = (u32x4){pk2bf(v[0], v[1]), pk2bf(v[2], v[3]), pk2bf(v[4], v[5]), pk2bf(v[6], v[7])}; }
  }
}

__device__ __forceinline__ void st_prep_hy(const bf16_t* HY, const float* cw, const float* cb, bf16_t* HYT, int do_ctx, char* lds) {
  const int tid = TIDX, lane = tid & 63, w = tid >> 6; float* tile = (float*)lds + w * (66 * 33);
  const int nlat = 4 * 64 * 24, nitem = nlat + (do_ctx ? 4 * 4 * 24 : 0), step = (GDIM - 48) * 8;
  bf16x8 raw[5];
#define PHY_DECODE(it) int b, tt, ct, L, joff; bf16_t* outb; \
    if ((it) < nlat) { b = (it) / 1536; tt = ((it) % 1536) / 24; ct = (it) % 24; L = SEQ; joff = CTXL; outb = HYT + (size_t)b * 768 * SEQ; } \
    else { const int i2 = (it) - nlat; b = i2 / 96; tt = (i2 % 96) / 24; ct = i2 % 24; L = CTXL; joff = 0; outb = HYT + (size_t)4 * 768 * SEQ + (size_t)b * 768 * CTXL; } \
    const int t0 = tt * 64, c0 = ct * 32; (void)outb;
#define PHY_LOADS(it) do { PHY_DECODE(it) _Pragma("unroll") for (int i = 0; i < 5; ++i) { const int rr = (lane >> 2) + 16 * i, c8 = (lane & 3) * 8; int t = t0 - 1 + rr; const bool ok = rr < 66 && t >= 0 && t < L; t = ok ? t : t0; \
      const bf16x8 v = *(const bf16x8*)(HY + ((size_t)b * TPB + joff + t) * 768 + c0 + c8); raw[i] = ok ? v : (bf16x8){0, 0, 0, 0, 0, 0, 0, 0}; } } while (0)
  int it = BIDX >= 48 ? (BIDX - 48) * 8 + w : nitem;
  if (it < nitem) PHY_LOADS(it);
  for (; it < nitem; it += step) {
    PHY_DECODE(it)
#pragma unroll
    for (int i = 0; i < 5; ++i) { const int rr = (lane >> 2) + 16 * i, c8 = (lane & 3) * 8;
      if (rr < 66) {
#pragma unroll
        for (int e = 0; e < 8; ++e) tile[rr * 33 + c8 + e] = bf2f((bf16_t)raw[i][e]); } }
    asm volatile("s_waitcnt lgkmcnt(0)" ::: "memory");
    if (it + step < nitem) PHY_LOADS(it + step);
#pragma unroll 4
    for (int cc = 0; cc < 32; ++cc) { const int c = c0 + cc;
      const float v = cw[c] * tile[lane * 33 + cc] + cw[768 + c] * tile[(lane + 1) * 33 + cc] + cw[1536 + c] * tile[(lane + 2) * 33 + cc] + cb[c];
      outb[(size_t)c * L + t0 + lane] = (bf16_t)f2bf(v); }
    asm volatile("s_waitcnt lgkmcnt(0)" ::: "memory");
  }
#undef PHY_LOADS
#undef PHY_DECODE
  __syncthreads();
}

template <int L> __device__ __forceinline__ void hyfilt_item(int item, const float* w1, const float* b1, const float* fr, const float* w2, const float* b2, const float* w3, float* HK, char* lds) {
  float* F = (float*)lds; float* W1 = F + 64 * 37; float* H1 = W1 + 36 * 68; float* W2 = H1 + 64 * 68; float* S1 = W2 + 64 * 68;
  const int tid = TIDX, n0 = (item >> 2) * 64, cq = item & 3, lane = tid & 63, wv = tid >> 6, l15 = lane & 15, l4 = lane >> 4;
  for (int e = tid; e < 64 * 36; e += NT) { const int pp = e / 36, f = e % 36; const int n = n0 + pp; float v = 0.f;
    if (f == 0) v = (float)n / (float)(L - 1);
    else if (f < 33) { const int m = (f - 1) & 15; const float band = 1e-4f + (float)m * ((15.0f - 1e-4f) / 15.0f); float rev = ((float)n * (1.0f / (float)L)) * band; rev -= floorf(rev);
      v = f <= 16 ? __builtin_amdgcn_cosf(rev) : -__builtin_amdgcn_sinf(rev); }
    F[pp * 37 + f] = v; }
  for (int e = tid; e < 36 * 64; e += NT) { const int k = e >> 6, j = e & 63; W1[k * 68 + j] = k < 33 ? w1[k * 64 + j] : 0.f; }
  for (int e = tid; e < 64 * 64; e += NT) { const int k = e >> 6, j = e & 63; W2[k * 68 + j] = w2[e]; }
  __syncthreads();
  { const int pt = wv >> 1, c0 = 32 * (wv & 1);
    f32x4 acc[2] = {(f32x4){0.f, 0.f, 0.f, 0.f}, (f32x4){0.f, 0.f, 0.f, 0.f}};
#pragma unroll
    for (int kk = 0; kk < 9; ++kk) { const float av = F[(pt * 16 + l15) * 37 + 4 * kk + l4];
      acc[0] = __builtin_amdgcn_mfma_f32_16x16x4f32(av, W1[(4 * kk + l4) * 68 + c0 + l15], acc[0], 0, 0, 0);
      acc[1] = __builtin_amdgcn_mfma_f32_16x16x4f32(av, W1[(4 * kk + l4) * 68 + c0 + 16 + l15], acc[1], 0, 0, 0); }
#pragma unroll
    for (int ct = 0; ct < 2; ++ct) { const int j = c0 + 16 * ct + l15; const float bj = b1[j], fj = fr[j] * 0.15915494309189535f;
#pragma unroll
      for (int rg = 0; rg < 4; ++rg) { float rev = fj * (acc[ct][rg] + bj); rev -= floorf(rev); H1[(pt * 16 + 4 * l4 + rg) * 68 + j] = __builtin_amdgcn_sinf(rev); } } }
  __syncthreads();
  { const int pt = wv >> 1, c0 = 32 * (wv & 1);
    f32x4 acc[2] = {(f32x4){0.f, 0.f, 0.f, 0.f}, (f32x4){0.f, 0.f, 0.f, 0.f}};
#pragma unroll
    for (int kk = 0; kk < 16; ++kk) { const float av = H1[(pt * 16 + l15) * 68 + 4 * kk + l4];
      acc[0] = __builtin_amdgcn_mfma_f32_16x16x4f32(av, W2[(4 * kk + l4) * 68 + c0 + l15], acc[0], 0, 0, 0);
      acc[1] = __builtin_amdgcn_mfma_f32_16x16x4f32(av, W2[(4 * kk + l4) * 68 + c0 + 16 + l15], acc[1], 0, 0, 0); }
#pragma unroll
    for (int ct = 0; ct < 2; ++ct) { const int j = c0 + 16 * ct + l15; const float bj = b2[j], fj = fr[j] * 0.15915494309189535f;
#pragma unroll
      for (int rg = 0; rg < 4; ++rg) { float rev = fj * (acc[ct][rg] + bj); rev -= floorf(rev); S1[(pt * 16 + 4 * l4 + rg) * 68 + j] = __builtin_amdgcn_sinf(rev); } } }
  __syncthreads();
  {
    const int colb = cq * 256 + 32 * wv;
    f32x4 acc[4][2];
#pragma unroll
    for (int pt = 0; pt < 4; ++pt) { acc[pt][0] = (f32x4){0.f, 0.f, 0.f, 0.f}; acc[pt][1] = (f32x4){0.f, 0.f, 0.f, 0.f}; }
#pragma unroll 4
    for (int kk = 0; kk < 16; ++kk) { const int k = 4 * kk + l4;
      const float bv0 = w3[k * 1024 + colb + l15], bv1 = w3[k * 1024 + colb + 16 + l15];
#pragma unroll
      for (int pt = 0; pt < 4; ++pt) { const float av = S1[(pt * 16 + l15) * 68 + k];
        acc[pt][0] = __builtin_amdgcn_mfma_f32_16x16x4f32(av, bv0, acc[pt][0], 0, 0, 0);
        acc[pt][1] = __builtin_amdgcn_mfma_f32_16x16x4f32(av, bv1, acc[pt][1], 0, 0, 0); } }
#pragma unroll
    for (int ct = 0; ct < 2; ++ct) { const int col = colb + 16 * ct + l15, dir = col >> 9, order = (col >> 8) & 1, c = col & 255;
      const float delta = 3.0701134573253943f + (float)c * ((15.350567286626972f - 3.0701134573253943f) / 255.0f);
      float* dst = HK + ((size_t)order * 256 + c) * (2 * L);
#pragma unroll
      for (int pt = 0; pt < 4; ++pt) { const int nb = n0 + pt * 16 + 4 * l4; f32x4 o;
#pragma unroll
        for (int rg = 0; rg < 4; ++rg) o[rg] = acc[pt][ct][rg] * __expf(-((float)(nb + rg) / (float)(L - 1)) * delta);
        if (dir == 0) *(f32x4*)(dst + nb) = o;
        else {
#pragma unroll
          for (int rg = 0; rg < 4; ++rg) { const int n = nb + rg; if (n >= 1) dst[2 * L - n] = o[rg]; else dst[L] = 0.f; } } } }
  }
  __syncthreads();
}

__device__ __forceinline__ void hyconv_ctx_item(int item, const bf16_t* HYTC, const float* HKC, const float* hy_bias, bf16_t* MIX, char* lds) {
  constexpr int L = CTXL;
  const int tid = TIDX, b = item >> 4, cc = tid >> 5, c = (item & 15) * 16 + cc, sub = tid & 31, tb = 8 * sub;
  float* kern = (float*)lds + cc * (2 * L); float* z = (float*)lds + 16 * 2 * L + cc * L;
  const bf16_t* vp = HYTC + ((size_t)b * 768 + c) * L; const bf16_t* x1p = vp + (size_t)256 * L; const bf16_t* x2p = vp + (size_t)512 * L;
#pragma unroll 1
  for (int o = 0; o < 2; ++o) {
    if (o == 0) for (int t = sub; t < L; t += 32) z[t] = bf2f(vp[t]);
    const float* kp = HKC + ((size_t)o * 256 + c) * (2 * L);
    for (int t = sub; t < 2 * L; t += 32) kern[t] = kp[t];
    __syncthreads();
    float acc[8], W[16];
#pragma unroll
    for (int i = 0; i < 8; ++i) { acc[i] = 0.f; W[8 + i] = kern[(tb + i) & (2 * L - 1)]; }
    for (int s0 = 0; s0 < L; s0 += 8) {
      const int bb = (tb - s0 - 8) & (2 * L - 1);
#pragma unroll
      for (int i = 0; i < 8; ++i) W[i] = kern[bb + i];
      float zs[8];
#pragma unroll
      for (int j = 0; j < 8; ++j) zs[j] = z[s0 + j];
#pragma unroll
      for (int j = 0; j < 8; ++j)
#pragma unroll
        for (int i = 0; i < 8; ++i) acc[i] += W[8 + i - j] * zs[j];
#pragma unroll
      for (int i = 0; i < 8; ++i) W[8 + i] = W[i];
    }
    __syncthreads();
    const float bias = hy_bias[o * 256 + c];
#pragma unroll
    for (int i = 0; i < 8; ++i) { const int t = tb + i; const float zz = acc[i] + bias * z[t];
      if (o == 0) z[t] = bf2f(x1p[t]) * zz;
      else MIX[((size_t)b * TPB + t) * DM + 768 + c] = (bf16_t)f2bf(bf2f(x2p[t]) * zz); }
    __syncthreads();
  }
}

__device__ __forceinline__ void ssd_conv8(const bf16_t* XBC, size_t r, int c0, bool hasp, bool hasn, const float* cw, const float* cb, float (&o)[8]) {
  const bf16x8 cur = *(const bf16x8*)(XBC + r * 768 + c0);
  const bf16x8 prv = *(const bf16x8*)(XBC + (hasp ? r - 1 : r) * 768 + c0), nxt = *(const bf16x8*)(XBC + (hasn ? r + 1 : r) * 768 + c0);
  const float wp = hasp ? 1.f : 0.f, wn = hasn ? 1.f : 0.f;
#pragma unroll
  for (int e = 0; e < 8; ++e) { const float v = wp * cw[c0 + e] * bf2f((bf16_t)prv[e]) + cw[640 + c0 + e] * bf2f((bf16_t)cur[e]) + wn * cw[1280 + c0 + e] * bf2f((bf16_t)nxt[e]) + cb[c0 + e]; o[e] = siluf(v); }
}
__device__ __forceinline__ float softplusf(float x) {
  const float y = __expf(-fabsf(x)); const float l = y < 0.06f ? y * (1.f - y * (0.5f - y * (0.33333334f - 0.25f * y))) : __logf(1.f + y); return fmaxf(x, 0.f) + l; }
__device__ __forceinline__ void wave_scan128(float e0, float e1, int lane, float& c0, float& c1) {
  float x = e0 + e1;
#pragma unroll
  for (int o = 1; o < 64; o <<= 1) { const float v = __shfl_up(x, o); if (lane >= o) x += v; }
  const float excl = x - (e0 + e1); c0 = excl + e0; c1 = excl + e0 + e1;
}
__device__ __forceinline__ int ssd_chunk_j0(int cidx) { return cidx < 2 ? cidx * 128 : CTXL + (cidx - 2) * 128; }

__device__ __forceinline__ void st_ssd1(int it0, int step, int nitems, const bf16_t* XBC, const float* DT, const float* cw, const float* cb, const float* dt_bias, const float* a_log,
                                        bf16_t* YIN, bf16_t* ST, float* DEC, char* lds) {
  bf16_t (*Cm)[72] = (bf16_t (*)[72])lds; bf16_t (*Bm)[72] = (bf16_t (*)[72])(lds + 18432);
  bf16_t (*BT)[136] = (bf16_t (*)[136])(lds + 36864); bf16_t (*Xt)[136] = (bf16_t (*)[136])(lds + 54272); bf16_t (*Mm)[136] = (bf16_t (*)[136])(lds + 71680);
  float* tab = (float*)(lds + 106496); float* dtf = tab; float* dtb = tab + 128; float* acf = tab + 256; float* acb = tab + 384; float* wf = tab + 512; float* wb = tab + 640;
  const int tid = TIDX;
  bf16x8 cu[6], pv[6], nx[6];
#define SSD1_LOADS(itm, I0, I1) do { const int h_ = (itm) % 6, bc_ = (itm) / 6, cidx_ = bc_ % 34, b_ = bc_ / 34, g_ = h_ / 3, j0_ = ssd_chunk_j0(cidx_); const size_t r0_ = (size_t)b_ * TPB + j0_; \
    _Pragma("unroll") for (int i = (I0); i < (I1); ++i) { const int task = tid + NT * i, t = task / 24, cg = task % 24, kind = cg >> 3, q = cg & 7, j = j0_ + t; \
      const int c0 = kind == 0 ? h_ * 64 + 8 * q : (kind == 1 ? 384 + g_ * 64 + 8 * q : 512 + g_ * 64 + 8 * q); \
      const bool hasp = j != 0 && j != CTXL, hasn = j != CTXL - 1 && j != TPB - 1; const bf16_t* p = XBC + (r0_ + t) * 768 + c0; \
      cu[i] = *(const bf16x8*)p; pv[i] = *(const bf16x8*)(p + (hasp ? -768 : 0)); nx[i] = *(const bf16x8*)(p + (hasn ? 768 : 0)); } } while (0)
  if (it0 < nitems) SSD1_LOADS(it0, 0, 6);
#pragma unroll 1
  for (int item = it0; item < nitems; item += step) {
  const int tid = TIDX, lane = tid & 63, w = tid >> 6, l15 = lane & 15, l4 = lane >> 4;
  const int h = item % 6, bc = item / 6, cidx = bc % 34, b = bc / 34, g = h / 3, j0 = ssd_chunk_j0(cidx);
  const size_t r0 = (size_t)b * TPB + j0;
  float dtr0 = 0.f, dtr1 = 0.f;
  if (w < 2) { const int t0 = w == 0 ? 2 * lane : 127 - 2 * lane, t1 = w == 0 ? 2 * lane + 1 : 126 - 2 * lane; dtr0 = DT[(r0 + t0) * 12 + w * 6 + h]; dtr1 = DT[(r0 + t1) * 12 + w * 6 + h]; }
  SSD1_LOADS(item, 6, 6);
  {
#pragma unroll
    for (int i = 0; i < 6; ++i) { const int task = tid + NT * i, t = task / 24, cg = task % 24, kind = cg >> 3, q = cg & 7, j = j0 + t;
      const int c0 = kind == 0 ? h * 64 + 8 * q : (kind == 1 ? 384 + g * 64 + 8 * q : 512 + g * 64 + 8 * q);
      const float wp = (j != 0 && j != CTXL) ? 1.f : 0.f, wn = (j != CTXL - 1 && j != TPB - 1) ? 1.f : 0.f;
      float o[8];
#pragma unroll
      for (int e = 0; e < 8; ++e) o[e] = siluf(wp * cw[c0 + e] * bf2f((bf16_t)pv[i][e]) + cw[640 + c0 + e] * bf2f((bf16_t)cu[i][e]) + wn * cw[1280 + c0 + e] * bf2f((bf16_t)nx[i][e]) + cb[c0 + e]);
      if (kind == 0) {
#pragma unroll
        for (int e = 0; e < 8; ++e) Xt[8 * q + e][t] = (bf16_t)f2bf(o[e]);
      } else { const u32x4 pk = (u32x4){pk2bf(o[0], o[1]), pk2bf(o[2], o[3]), pk2bf(o[4], o[5]), pk2bf(o[6], o[7])};
        if (kind == 1) { *(u32x4*)&Bm[t][8 * q] = pk;
#pragma unroll
          for (int e = 0; e < 8; ++e) BT[8 * q + e][t] = (bf16_t)f2bf(o[e]); }
        else *(u32x4*)&Cm[t][8 * q] = pk; } }
  }
  if (w < 2) { const int dir = w; const float a = -expf(a_log[dir * 6 + h]), bias = dt_bias[dir * 6 + h];
    const int t0 = dir == 0 ? 2 * lane : 127 - 2 * lane, t1 = dir == 0 ? 2 * lane + 1 : 126 - 2 * lane;
    const float d0 = softplusf(dtr0 + bias), d1 = softplusf(dtr1 + bias);
    float c0, c1; wave_scan128(d0 * a, d1 * a, lane, c0, c1);
    const float tot = __shfl(c1, 63);
    float* dtt = dir == 0 ? dtf : dtb; float* ac = dir == 0 ? acf : acb; float* ww = dir == 0 ? wf : wb;
    dtt[t0] = d0; dtt[t1] = d1; ac[t0] = c0; ac[t1] = c1; ww[t0] = __expf(tot - c0) * d0; ww[t1] = __expf(tot - c1) * d1;
    if (lane == 0) DEC[(((size_t)b * 34 + cidx) * 2 + dir) * 6 + h] = __expf(tot); }
  __syncthreads();
  if (item + step < nitems) SSD1_LOADS(item + step, 0, 6);
  {
    f32x4 accG[8];
#pragma unroll
    for (int ni = 0; ni < 8; ++ni) accG[ni] = (f32x4){0.f, 0.f, 0.f, 0.f};
#pragma unroll
    for (int kk = 0; kk < 2; ++kk) { const bf16x8 a = *(const bf16x8*)&Cm[16 * w + l15][32 * kk + 8 * l4];
#pragma unroll
      for (int ni = 0; ni < 8; ++ni) { const bf16x8 bb = *(const bf16x8*)&Bm[16 * ni + l15][32 * kk + 8 * l4]; accG[ni] = __builtin_amdgcn_mfma_f32_16x16x32_bf16(a, bb, accG[ni], 0, 0, 0); } }
    float aft[4], abt[4];
#pragma unroll
    for (int rg = 0; rg < 4; ++rg) { aft[rg] = acf[16 * w + 4 * l4 + rg]; abt[rg] = acb[16 * w + 4 * l4 + rg]; }
#pragma unroll
    for (int ni = 0; ni < 8; ++ni) { const int sidx = 16 * ni + l15; const float afs = acf[sidx], abs_ = acb[sidx], dfs = dtf[sidx], dbs = dtb[sidx];
#pragma unroll
      for (int rg = 0; rg < 4; ++rg) { const int t = 16 * w + 4 * l4 + rg;
        const float f = sidx <= t ? __expf(aft[rg] - afs) * dfs : 0.f, bk = sidx >= t ? __expf(abt[rg] - abs_) * dbs : 0.f;
        Mm[t][sidx] = (bf16_t)f2bf(accG[ni][rg] * (f + bk)); } }
  }
  __syncthreads();
  {
    f32x4 acc[4];
#pragma unroll
    for (int ni = 0; ni < 4; ++ni) acc[ni] = (f32x4){0.f, 0.f, 0.f, 0.f};
#pragma unroll
    for (int kk = 0; kk < 4; ++kk) { const bf16x8 a = *(const bf16x8*)&Mm[16 * w + l15][32 * kk + 8 * l4];
#pragma unroll
      for (int ni = 0; ni < 4; ++ni) { const bf16x8 bb = *(const bf16x8*)&Xt[16 * ni + l15][32 * kk + 8 * l4]; acc[ni] = __builtin_amdgcn_mfma_f32_16x16x32_bf16(a, bb, acc[ni], 0, 0, 0); } }
#pragma unroll
    for (int rg = 0; rg < 4; ++rg)
#pragma unroll
      for (int ni = 0; ni < 4; ++ni) YIN[(r0 + 16 * w + 4 * l4 + rg) * 384 + h * 64 + 16 * ni + l15] = (bf16_t)f2bf(acc[ni][rg]);
  }
  {
    const int dir = w >> 2, mt = w & 3; const float* ww = dir == 0 ? wf : wb;
    f32x4 acc[4];
#pragma unroll
    for (int ni = 0; ni < 4; ++ni) acc[ni] = (f32x4){0.f, 0.f, 0.f, 0.f};
#pragma unroll
    for (int kk = 0; kk < 4; ++kk) { const bf16x8 raw = *(const bf16x8*)&Xt[16 * mt + l15][32 * kk + 8 * l4];
      const f32x4 w0 = *(const f32x4*)(ww + 32 * kk + 8 * l4), w1 = *(const f32x4*)(ww + 32 * kk + 8 * l4 + 4);
      u32x4 pk; pk.x = pk2bf(bf2f((bf16_t)raw[0]) * w0.x, bf2f((bf16_t)raw[1]) * w0.y); pk.y = pk2bf(bf2f((bf16_t)raw[2]) * w0.z, bf2f((bf16_t)raw[3]) * w0.w);
      pk.z = pk2bf(bf2f((bf16_t)raw[4]) * w1.x, bf2f((bf16_t)raw[5]) * w1.y); pk.w = pk2bf(bf2f((bf16_t)raw[6]) * w1.z, bf2f((bf16_t)raw[7]) * w1.w);
      const bf16x8 a = __builtin_bit_cast(bf16x8, pk);
#pragma unroll
      for (int ni = 0; ni < 4; ++ni) { const bf16x8 bb = *(const bf16x8*)&BT[16 * ni + l15][32 * kk + 8 * l4]; acc[ni] = __builtin_amdgcn_mfma_f32_16x16x32_bf16(a, bb, acc[ni], 0, 0, 0); } }
    bf16_t* sp = ST + ((((size_t)b * 34 + cidx) * 2 + dir) * 6 + h) * 4096;
#pragma unroll
    for (int rg = 0; rg < 4; ++rg)
#pragma unroll
      for (int ni = 0; ni < 4; ++ni) sp[(16 * mt + 4 * l4 + rg) * 64 + 16 * ni + l15] = (bf16_t)f2bf(acc[ni][rg]);
  }
  __syncthreads();
  }
#undef SSD1_LOADS
}

__device__ __forceinline__ void st_ssd_scan2(bf16_t* ST, const float* DEC) {
  for (int idx = BIDX * NT + TIDX; idx < 4 * 2 * 6 * 2048; idx += GDIM * NT) {
    const int e = (idx & 2047) * 2, bdh = idx >> 11, h = bdh % 6, dir = (bdh / 6) & 1, b = bdh / 12;
    unsigned v[34]; float d[34];
#pragma unroll
    for (int st = 0; st < 34; ++st) { const int cidx = dir == 0 ? st : (st < 2 ? 1 - st : 35 - st); const size_t o = (((size_t)b * 34 + cidx) * 2 + dir) * 6 + h; v[st] = *(const unsigned*)(ST + o * 4096 + e); d[st] = DEC[o]; }
    float H0 = 0.f, H1 = 0.f;
#pragma unroll
    for (int st = 0; st < 34; ++st) { const int cidx = dir == 0 ? st : (st < 2 ? 1 - st : 35 - st); const size_t o = (((size_t)b * 34 + cidx) * 2 + dir) * 6 + h;
      *(unsigned*)(ST + o * 4096 + e) = pk2bf(H0, H1); H0 = H0 * d[st] + __uint_as_float(v[st] << 16); H1 = H1 * d[st] + __uint_as_float(v[st] & 0xffff0000u); }
  }
}

__device__ __forceinline__ void ssd3_item(int b, int cidx, int g, const bf16_t* XBC, const bf16_t* VZ, const float* DT, const float* cw, const float* cb, const float* dt_bias, const float* a_log,
                                          const float* dskip, const float* nw, const bf16_t* YIN, const bf16_t* ST, bf16_t* MIX, char* lds) {
  bf16_t (*Cm)[72] = (bf16_t (*)[72])lds; bf16_t (*Hm)[72] = (bf16_t (*)[72])(lds + 18432);
  float* ef = (float*)(lds + 18432 + 55296);
  float (*Yt)[196] = (float (*)[196])lds;
  const int tid = TIDX, lane = tid & 63, w = tid >> 6, l15 = lane & 15, l4 = lane >> 4, j0 = ssd_chunk_j0(cidx);
  const size_t r0 = (size_t)b * TPB + j0;
#pragma unroll
  for (int i = 0; i < 2; ++i) { const int task = tid + NT * i, t = task >> 3, q = task & 7, j = j0 + t;
    float o[8]; ssd_conv8(XBC, r0 + t, 512 + g * 64 + 8 * q, j != 0 && j != CTXL, j != CTXL - 1 && j != TPB - 1, cw, cb, o);
    *(u32x4*)&Cm[t][8 * q] = (u32x4){pk2bf(o[0], o[1]), pk2bf(o[2], o[3]), pk2bf(o[4], o[5]), pk2bf(o[6], o[7])}; }
#pragma unroll
  for (int i = 0; i < 6; ++i) { const int f8 = tid + NT * i, hd = f8 >> 9, rem = f8 & 511, p = rem >> 3, n8 = (rem & 7) * 8, hh = hd >> 1, dir = hd & 1;
    *(u32x4*)&Hm[hd * 64 + p][n8] = *(const u32x4*)(ST + ((((size_t)b * 34 + cidx) * 2 + dir) * 6 + 3 * g + hh) * 4096 + p * 64 + n8); }
  if (w < 6) { const int hh = w >> 1, dir = w & 1, h = 3 * g + hh; const float a = -expf(a_log[dir * 6 + h]), bias = dt_bias[dir * 6 + h];
    const int t0 = dir == 0 ? 2 * lane : 127 - 2 * lane, t1 = dir == 0 ? 2 * lane + 1 : 126 - 2 * lane;
    const float d0 = softplusf(DT[(r0 + t0) * 12 + dir * 6 + h] + bias), d1 = softplusf(DT[(r0 + t1) * 12 + dir * 6 + h] + bias);
    float c0, c1; wave_scan128(d0 * a, d1 * a, lane, c0, c1);
    ef[w * 128 + t0] = __expf(c0); ef[w * 128 + t1] = __expf(c1); }
  __syncthreads();
  float yv[3][4][4];
  {
    bf16x8 ca[2];
#pragma unroll
    for (int kk = 0; kk < 2; ++kk) ca[kk] = *(const bf16x8*)&Cm[16 * w + l15][32 * kk + 8 * l4];
#pragma unroll
    for (int hh = 0; hh < 3; ++hh) {
      f32x4 accF[4], accB[4];
#pragma unroll
      for (int ni = 0; ni < 4; ++ni) { accF[ni] = (f32x4){0.f, 0.f, 0.f, 0.f}; accB[ni] = (f32x4){0.f, 0.f, 0.f, 0.f}; }
#pragma unroll
      for (int kk = 0; kk < 2; ++kk)
#pragma unroll
        for (int ni = 0; ni < 4; ++ni) {
          accF[ni] = __builtin_amdgcn_mfma_f32_16x16x32_bf16(ca[kk], *(const bf16x8*)&Hm[(hh * 2 + 0) * 64 + 16 * ni + l15][32 * kk + 8 * l4], accF[ni], 0, 0, 0);
          accB[ni] = __builtin_amdgcn_mfma_f32_16x16x32_bf16(ca[kk], *(const bf16x8*)&Hm[(hh * 2 + 1) * 64 + 16 * ni + l15][32 * kk + 8 * l4], accB[ni], 0, 0, 0); }
#pragma unroll
      for (int rg = 0; rg < 4; ++rg) { const int t = 16 * w + 4 * l4 + rg; const float eF = ef[(hh * 2 + 0) * 128 + t], eB = ef[(hh * 2 + 1) * 128 + t];
#pragma unroll
        for (int ni = 0; ni < 4; ++ni) yv[hh][ni][rg] = eF * accF[ni][rg] + eB * accB[ni][rg]; }
    }
  }
  __syncthreads();
#pragma unroll
  for (int hh = 0; hh < 3; ++hh)
#pragma unroll
    for (int rg = 0; rg < 4; ++rg)
#pragma unroll
      for (int ni = 0; ni < 4; ++ni) Yt[16 * w + 4 * l4 + rg][hh * 64 + 16 * ni + l15] = yv[hh][ni][rg];
  __syncthreads();
  {
    const int c4 = 4 * (lane < 48 ? lane : 47), hk = c4 >> 6; const bool lact = lane < 48;
    float cw0[4], cw1[4], cw2[4], cbv[4], nwv[4];
#pragma unroll
    for (int e = 0; e < 4; ++e) { const int col = g * 192 + c4 + e; cw0[e] = cw[col]; cw1[e] = cw[640 + col]; cw2[e] = cw[1280 + col]; cbv[e] = cb[col]; nwv[e] = nw[col]; }
    const float dsk = dskip[3 * g + hk];
#pragma unroll 1
    for (int rb = 0; rb < 16; rb += 4) {
      u32x2 xc_[4], xp_[4], xn_[4], zz_[4], yy_[4];
#pragma unroll
      for (int u = 0; u < 4; ++u) { const int t = 16 * w + rb + u, j = j0 + t; const size_t r = r0 + t; const bool hasp = j != 0 && j != CTXL, hasn = j != CTXL - 1 && j != TPB - 1;
        const bf16_t* xq = XBC + r * 768 + g * 192 + c4;
        xc_[u] = *(const u32x2*)xq; xp_[u] = *(const u32x2*)(xq + (hasp ? -768 : 0)); xn_[u] = *(const u32x2*)(xq + (hasn ? 768 : 0));
        yy_[u] = *(const u32x2*)(YIN + r * 384 + g * 192 + c4); zz_[u] = *(const u32x2*)(VZ + r * 512 + 128 + g * 192 + c4); }
#pragma unroll
      for (int u = 0; u < 4; ++u) { const int t = 16 * w + rb + u, j = j0 + t; const size_t r = r0 + t; const float wp = (j != 0 && j != CTXL) ? 1.f : 0.f, wn = (j != CTXL - 1 && j != TPB - 1) ? 1.f : 0.f;
        const f32x4 yt = *(const f32x4*)&Yt[t][c4];
        float gt[4]; float ss = 0.f;
#pragma unroll
        for (int e = 0; e < 4; ++e) { const unsigned sh = (e & 1) * 16; const unsigned wc_ = e < 2 ? xc_[u].x : xc_[u].y, wq_ = e < 2 ? xp_[u].x : xp_[u].y, wn_ = e < 2 ? xn_[u].x : xn_[u].y, wz_ = e < 2 ? zz_[u].x : zz_[u].y;
          float xv = cw1[e] * bf2f((bf16_t)(wc_ >> sh)) + cbv[e] + wp * cw0[e] * bf2f((bf16_t)(wq_ >> sh)) + wn * cw2[e] * bf2f((bf16_t)(wn_ >> sh));
          xv = siluf(xv);
          const float y = bf2f((bf16_t)((e < 2 ? yy_[u].x : yy_[u].y) >> sh)) + yt[e] + dsk * xv;
          gt[e] = lact ? y * siluf(bf2f((bf16_t)(wz_ >> sh))) : 0.f; ss += gt[e] * gt[e]; }
        const float rstd = rsqrtf(wave_sum(ss) * (1.0f / 192.0f) + EPS);
        if (lact) { u32x2 o; o.x = pk2bf(gt[0] * rstd * nwv[0], gt[1] * rstd * nwv[1]); o.y = pk2bf(gt[2] * rstd * nwv[2], gt[3] * rstd * nwv[3]);
          *(u32x2*)(MIX + r * DM + 384 + g * 192 + c4) = o; } }
    }
  }
  __syncthreads();
}

__device__ __forceinline__ void st_router(const float* xl, const float* xc, int from_inputs, bf16_t* XB, const bf16_t* MO, const float* g, const float* modv_layer, const float* w_router, const float* rbias,
                                          bf16_t* H2, int* ctl, int* tok_pair, float* tok_w, int skip_ctx, char* lds) {
  float* wl = (float*)lds;
  const int tid = TIDX, lane = tid & 63, gw = BIDX * 8 + (tid >> 6), ngw = GDIM * 8;
  int* hist = (int*)(lds + 81920);
  if (tid < 32) hist[tid] = 0;
  float* mA = (float*)(lds + 82176); float* mB = mA + 5 * 1024; float* mG = mB + 5 * 1024;
  for (int idx = tid; idx < 5 * 1024; idx += NT) { const int m = idx >> 10, k = idx & 1023; mA[idx] = g[k] * (1.f + modv_layer[(size_t)m * 6144 + 4096 + k]); mB[idx] = modv_layer[(size_t)m * 6144 + 3072 + k]; mG[idx] = modv_layer[(size_t)m * 6144 + 2048 + k]; }
  for (int idx = tid; idx < 4096; idx += NT) { const int k = idx >> 2, e4 = idx & 3, row = ((k & 3) * 4 + (k >> 8)) * 64 + ((k & 255) >> 2);
    *(f32x4*)(wl + row * 20 + 4 * e4) = *(const f32x4*)(w_router + (size_t)k * 16 + 4 * e4); }
  __syncthreads();
  for (int rb = gw; rb < MTOK; rb += 2 * ngw) {
    int rr[2]; bool act[2]; f32x4 v[2][4]; u32x2 mo[2][4]; float rstd[2]; int mo_[2];
#pragma unroll
    for (int u = 0; u < 2; ++u) { const int r = rb + u * ngw; rr[u] = r < MTOK ? r : MTOK - 1; act[u] = r < MTOK && !(skip_ctx && (rr[u] % TPB) < CTXL); mo_[u] = mrow_of(rr[u]) * 1024;
      const bf16_t* mr = MO + (size_t)rr[u] * DM;
      if (from_inputs) { const float* xr = xrow(xl, xc, rr[u]);
#pragma unroll
        for (int j = 0; j < 4; ++j) v[u][j] = *(const f32x4*)(xr + 4 * lane + 256 * j); }
      else { const bf16_t* xr = XB + (size_t)rr[u] * DM;
#pragma unroll
        for (int j = 0; j < 4; ++j) { const u32x2 t2 = *(const u32x2*)(xr + 4 * lane + 256 * j);
          v[u][j] = (f32x4){__uint_as_float(t2.x << 16), __uint_as_float(t2.x & 0xffff0000u), __uint_as_float(t2.y << 16), __uint_as_float(t2.y & 0xffff0000u)}; } }
#pragma unroll
      for (int j = 0; j < 4; ++j) mo[u][j] = *(const u32x2*)(mr + 4 * lane + 256 * j); }
    if (!act[0] && !act[1]) continue;
#pragma unroll
    for (int u = 0; u < 2; ++u) if (act[u]) { bf16_t* xd = XB + (size_t)rr[u] * DM;
#pragma unroll
      for (int j = 0; j < 4; ++j) { const int k = 4 * lane + 256 * j; const f32x4 g4 = *(const f32x4*)(mG + mo_[u] + k);
        const f32x4 m4 = (f32x4){__uint_as_float(mo[u][j].x << 16), __uint_as_float(mo[u][j].x & 0xffff0000u), __uint_as_float(mo[u][j].y << 16), __uint_as_float(mo[u][j].y & 0xffff0000u)};
        v[u][j] = v[u][j] + g4 * m4; u32x2 w2; w2.x = pk2bf(v[u][j].x, v[u][j].y); w2.y = pk2bf(v[u][j].z, v[u][j].w); *(u32x2*)(xd + k) = w2; } }
#pragma unroll
    for (int u = 0; u < 2; ++u) { float ss = 0.f;
#pragma unroll
      for (int j = 0; j < 4; ++j) ss += v[u][j].x * v[u][j].x + v[u][j].y * v[u][j].y + v[u][j].z * v[u][j].z + v[u][j].w * v[u][j].w;
      rstd[u] = rsqrtf(wave_sum(ss) * (1.0f / DM) + EPS); }
    float lg[2][16];
#pragma unroll
    for (int u = 0; u < 2; ++u)
#pragma unroll
      for (int e = 0; e < 16; ++e) lg[u][e] = 0.f;
#pragma unroll 1
    for (int j = 0; j < 4; ++j) { const int k = 4 * lane + 256 * j; float o[2][4];
#pragma unroll
      for (int u = 0; u < 2; ++u) { const f32x4 a4 = *(const f32x4*)(mA + mo_[u] + k), b4 = *(const f32x4*)(mB + mo_[u] + k); const f32x4 o4 = v[u][j] * rstd[u] * a4 + b4;
        o[u][0] = o4.x; o[u][1] = o4.y; o[u][2] = o4.z; o[u][3] = o4.w;
        if (act[u]) { u32x2 wpk; wpk.x = pk2bf(o4.x, o4.y); wpk.y = pk2bf(o4.z, o4.w); *(u32x2*)(H2 + (size_t)rr[u] * DM + k) = wpk; } }
#pragma unroll
      for (int q = 0; q < 4; ++q) { const float* wr_ = wl + ((q * 4 + j) * 64 + lane) * 20;
#pragma unroll
        for (int e4 = 0; e4 < 4; ++e4) { const f32x4 wr = *(const f32x4*)(wr_ + 4 * e4);
#pragma unroll
          for (int u = 0; u < 2; ++u) { lg[u][4 * e4] += o[u][q] * wr.x; lg[u][4 * e4 + 1] += o[u][q] * wr.y; lg[u][4 * e4 + 2] += o[u][q] * wr.z; lg[u][4 * e4 + 3] += o[u][q] * wr.w; } } } }
    float h1[2];
#pragma unroll
    for (int u = 0; u < 2; ++u) { float h8[8], h4[4], h2[2];
#pragma unroll
      for (int i = 0; i < 8; ++i) { const bool up = (lane & 32) != 0; const float keep = up ? lg[u][8 + i] : lg[u][i], give = up ? lg[u][i] : lg[u][8 + i]; h8[i] = keep + __shfl_xor(give, 32); }
#pragma unroll
      for (int i = 0; i < 4; ++i) { const bool up = (lane & 16) != 0; const float keep = up ? h8[4 + i] : h8[i], give = up ? h8[i] : h8[4 + i]; h4[i] = keep + __shfl_xor(give, 16); }
#pragma unroll
      for (int i = 0; i < 2; ++i) { const bool up = (lane & 8) != 0; const float keep = up ? h4[2 + i] : h4[i], give = up ? h4[i] : h4[2 + i]; h2[i] = keep + __shfl_xor(give, 8); }
      { const bool up = (lane & 4) != 0; const float keep = up ? h2[1] : h2[0], give = up ? h2[0] : h2[1]; h1[u] = keep + __shfl_xor(give, 4); }
      h1[u] += __shfl_xor(h1[u], 2); h1[u] += __shfl_xor(h1[u], 1); }
    float lx[16];
#pragma unroll
    for (int e = 0; e < 16; ++e) { const int src = ((e >> 3) & 1) * 32 + ((e >> 2) & 1) * 16 + ((e >> 1) & 1) * 8 + (e & 1) * 4;
      const float a0 = __uint_as_float(__builtin_amdgcn_readlane(__float_as_uint(h1[0]), src)), a1 = __uint_as_float(__builtin_amdgcn_readlane(__float_as_uint(h1[1]), src));
      lx[e] = lane < 32 ? a0 : a1; }
    const int us = lane >> 5;
    if ((lane & 31) == 0 && (us == 0 ? act[0] : act[1])) {
      const int r = us == 0 ? rr[0] : rr[1];
      int best = 0, bi1 = 0, bi2 = 1; float bestv = -1e30f, bs1 = 0.f, bs2 = 0.f;
#pragma unroll
      for (int gq = 0; gq < 4; ++gq) { float m1 = -1e30f, m2 = -1e30f, s1 = 0.f, s2 = 0.f; int i1 = 0, i2 = 0;
#pragma unroll
        for (int i = 0; i < 4; ++i) { const float scv = 1.0f / (1.0f + __expf(-lx[4 * gq + i])); const float sv = scv + rbias[4 * gq + i];
          if (sv > m1) { m2 = m1; s2 = s1; i2 = i1; m1 = sv; s1 = scv; i1 = i; } else if (sv > m2) { m2 = sv; s2 = scv; i2 = i; } }
        if (m1 + m2 > bestv) { bestv = m1 + m2; best = gq; bi1 = i1; bi2 = i2; bs1 = s1; bs2 = s2; } }
      const int ia = bi1 < bi2 ? bi1 : bi2, ib = bi1 < bi2 ? bi2 : bi1;
      const int tri = ia == 0 ? ib - 1 : (ia == 1 ? ib + 1 : 5);
      const int pidx = best * 6 + tri;
      const float sa = bi1 < bi2 ? bs1 : bs2, sb = bi1 < bi2 ? bs2 : bs1, inv = 1.0f / (sa + sb);
      const int rank = atomicAdd(&hist[pidx], 1);
      tok_pair[r] = pidx | (rank << 5); tok_w[2 * r] = sa * inv; tok_w[2 * r + 1] = sb * inv;
    }
  }
  __syncthreads();
  if (tid < 32) ctl[CT_CNTB + BIDX * 32 + tid] = tid < 24 ? hist[tid] : 0;
}
__device__ __forceinline__ void st_moe_gather(const bf16_t* H2, bf16_t* H2S, int* ctl, const int* tok_pair, const float* tok_w, int* sorted_tok, float* sorted_w, int* tok_slot, int skip_ctx, char* lds) {
  int* sbase = (int*)lds; int* rtot = sbase + 32; int* rpre = rtot + 512;
  const int tid = TIDX, bid = BIDX;
  { const int p = tid & 31, seg = tid >> 5; int tot = 0, pre = 0;
#pragma unroll 4
    for (int i = 0; i < 16; ++i) { const int bb = seg * 16 + i; const int cv = ctl[CT_CNTB + bb * 32 + p]; tot += cv; pre += bb < bid ? cv : 0; }
    rtot[seg * 32 + p] = tot; rpre[seg * 32 + p] = pre; }
  __syncthreads();
  if (tid < 32) { int tot = 0, pre = 0;
#pragma unroll
    for (int sg = 0; sg < 16; ++sg) { tot += rtot[sg * 32 + tid]; pre += rpre[sg * 32 + tid]; }
    rtot[tid] = tot; rpre[tid] = pre; }
  __syncthreads();
  if (tid == 0) { int base = 0, nt = 0;
#pragma unroll 1
    for (int p = 0; p < 24; ++p) { sbase[p] = base + rpre[p]; const int n = rtot[p], tl = (n + 255) >> 8;
      if (bid == 0) { ctl[CT_BASE + p] = base; for (int t = 0; t < tl; ++t) ctl[CT_TP + nt + t] = p; }
      nt += tl; base += tl * 256; }
    if (bid == 0) { ctl[CT_BASE + 24] = base; ctl[CT_NT] = nt; } }
  __syncthreads();
  const int lane = tid & 63, gw = bid * 8 + (tid >> 6), ngw = GDIM * 8;
  for (int rb = gw; rb < MTOK; rb += 3 * ngw) {
    u32x4 a0[3], a1[3]; int pk[3]; float w0[3], w1[3]; bool act[3];
#pragma unroll
    for (int u = 0; u < 3; ++u) { const int r = rb + u * ngw; act[u] = r < MTOK && !(skip_ctx && (r % TPB) < CTXL); const int rc = act[u] ? r : 0;
      pk[u] = tok_pair[rc]; w0[u] = tok_w[2 * rc]; w1[u] = tok_w[2 * rc + 1];
      const u32x4* sp = (const u32x4*)(H2 + (size_t)rc * DM); a0[u] = sp[lane]; a1[u] = sp[lane + 64]; }
#pragma unroll
    for (int u = 0; u < 3; ++u) if (act[u]) { const int r = rb + u * ngw; const int slot = sbase[pk[u] & 31] + (pk[u] >> 5);
      if (lane == 0) { sorted_tok[slot] = r; tok_slot[r] = slot; sorted_w[2 * slot] = w0[u]; sorted_w[2 * slot + 1] = w1[u]; }
      u32x4* d = (u32x4*)(H2S + (size_t)slot * DM); d[lane] = a0[u]; d[lane + 64] = a1[u]; }
  }
  __syncthreads();
}
__device__ __forceinline__ void st_final(float* out, const float* g, const bf16_t* XB, const bf16_t* YS, const int* tok_slot, const float* gate  ) {
  const int lane = TIDX & 63, gw = BIDX * 8 + (TIDX >> 6), ngw = GDIM * 8;
  f32x4 gg[4];
#pragma unroll
  for (int j = 0; j < 4; ++j) gg[j] = *(const f32x4*)(g + 4 * lane + 256 * j);
  for (int rb = gw; rb < NB * SEQ; rb += 4 * ngw) {
    u32x2 xb[4][4], ys[4][4];
#pragma unroll
    for (int u = 0; u < 4; ++u) { const int r = rb + u * ngw, rc = r < NB * SEQ ? r : NB * SEQ - 1;
      const int bb = rc >> 12, tr = bb * TPB + CTXL + (rc & 4095); const bf16_t* xr = XB + (size_t)tr * DM; const bf16_t* yr = YS + (size_t)tok_slot[tr] * DM;
#pragma unroll
      for (int j = 0; j < 4; ++j) { xb[u][j] = *(const u32x2*)(xr + 4 * lane + 256 * j); ys[u][j] = *(const u32x2*)(yr + 4 * lane + 256 * j); } }
#pragma unroll
    for (int u = 0; u < 4; ++u) { const int r = rb + u * ngw, rc = r < NB * SEQ ? r : NB * SEQ - 1; const float* gt = gate + (size_t)(rc >> 12) * 6144; float ss = 0.f; f32x4 v[4];
#pragma unroll
      for (int j = 0; j < 4; ++j) { const f32x4 g4 = *(const f32x4*)(gt + 4 * lane + 256 * j);
        const f32x4 x4 = (f32x4){__uint_as_float(xb[u][j].x << 16), __uint_as_float(xb[u][j].x & 0xffff0000u), __uint_as_float(xb[u][j].y << 16), __uint_as_float(xb[u][j].y & 0xffff0000u)};
        const f32x4 m4 = (f32x4){__uint_as_float(ys[u][j].x << 16), __uint_as_float(ys[u][j].x & 0xffff0000u), __uint_as_float(ys[u][j].y << 16), __uint_as_float(ys[u][j].y & 0xffff0000u)};
        v[j] = x4 + g4 * m4; ss += v[j].x * v[j].x + v[j].y * v[j].y + v[j].z * v[j].z + v[j].w * v[j].w; }
      const float rstd = rsqrtf(wave_sum(ss) * (1.0f / DM) + EPS);
      if (r < NB * SEQ) { float* orow = out + (size_t)r * DM;
#pragma unroll
        for (int j = 0; j < 4; ++j) *(f32x4*)(orow + 4 * lane + 256 * j) = (f32x4){v[j].x * rstd * gg[j].x, v[j].y * rstd * gg[j].y, v[j].z * rstd * gg[j].z, v[j].w * rstd * gg[j].w}; } }
  }
}

namespace pg8 {
#define PG8_LAS __attribute__((address_space(3)))
typedef unsigned short bf16_t;
typedef short bf16x8 __attribute__((ext_vector_type(8)));
typedef float f32x4 __attribute__((ext_vector_type(4)));
typedef unsigned u32x4 __attribute__((ext_vector_type(4)));
constexpr int BM = 256, BK = 64, HALF = 128, HTB = HALF * BK * 2  , STAGE_BYTES = 8 * HTB, NXCD = 8, WGM = 8;

__host__ __device__ __forceinline__ int lds_byte(int r, int c) { const int st = (r >> 4) * 2 + (c >> 5), rr = r & 15, cc = c & 31, ob = rr * 64 + cc * 2; return st * 1024 + (ob ^ (((ob >> 9) & 1) << 5)); }
__host__ __device__ __forceinline__ void stage_rc(int b, int& R, int& C) { const int st = b / 1024, sb = b % 1024, swz = sb ^ (((sb >> 9) & 1) << 5); R = (st >> 1) * 16 + swz / 64; C = (st & 1) * 32 + (swz % 64) / 2; }
__host__ __device__ __forceinline__ int perm32(int rho) { const int n = rho >> 4, i = rho & 15; return 8 * (i >> 2) + 4 * n + (i & 3); }

struct Unit { int pm, pn, fin, half; const char* A; const char* B; };
struct Gemm { int K, lda, ldb; };

__device__ __forceinline__ void tile_of(int L, int nM, int nN, int& pm, int& pn) {
    const int nwg = nM * nN; int wgid = L; { const int q = nwg / NXCD, r = nwg % NXCD, xcd = wgid % NXCD, off = wgid / NXCD; wgid = (xcd < r ? xcd * (q + 1) : r * (q + 1) + (xcd - r) * q) + off; }
    const int nig = WGM * nN, gid = wgid / nig, fm = gid * WGM, gsz = (nM - fm) < WGM ? (nM - fm) : WGM;
    pm = fm + ((wgid % nig) % gsz); pn = (wgid % nig) / gsz;
}
__device__ __forceinline__ unsigned cvt_pk_bf16(float lo, float hi) { unsigned r; asm volatile("v_cvt_pk_bf16_f32 %0, %1, %2" : "=v"(r) : "v"(lo), "v"(hi)); return r; }
template <class Epi, class Sched, bool ALIGN_EPI = false, bool SP2 = false, bool HALFM = false>
__device__ __forceinline__ void gemm_phase(PG8_LAS unsigned char* lds, const Gemm g, const Sched& S, const Epi& E) {
    const int tid = opq_v((int)threadIdx.x), wid = __builtin_amdgcn_readfirstlane(tid >> 6), lane = tid & 63, wr = wid >> 2, wc = wid & 3, fr = lane & 15, fq = lane >> 4;
    const int K = g.K, nt = K / BK;
    unsigned voffA[2], voffB[2];
#pragma unroll
    for (int i = 0; i < 2; ++i) { int R, C; stage_rc(tid * 16 + i * 8192, R, C); const int Rb = Epi::PERM ? ((R & ~31) + perm32(R & 31)) : R;
        voffA[i] = (unsigned)(R * g.lda + C) * 2u; voffB[i] = (unsigned)(Rb * g.ldb + C) * 2u; }
    const size_t kstep = (size_t)(BK * 2);
    static_assert(!HALFM || SP2, "half-height units need the SP2 loop");
    const size_t hstepA = (size_t)HALF * g.lda * 2, hstepB = (size_t)HALF * g.ldb * 2;
    const unsigned ldsw = (unsigned)wid * 1024u;
    const int aoff = lds_byte(wr * 64 + fr, fq * 8), boff = lds_byte(wc * 32 + fr, fq * 8);
#define PG8_SA(b, h) (((b) * 2 + (h)) * HTB)
#define PG8_SB(b, h) ((4 + (b) * 2 + (h)) * HTB)
#define PG8_STAGE(bufoff, gbase, voff) do { _Pragma("unroll") for (int _i = 0; _i < 2; ++_i) \
        __builtin_amdgcn_global_load_lds((const unsigned*)((const char*)(gbase) + (voff)[_i]), (PG8_LAS unsigned*)(lds + (bufoff) + ldsw + _i * 8192), 16, 0, 0); } while (0)
#define PG8_LDA(dst, b, h) do { _Pragma("unroll") for (int m = 0; m < 4; ++m) _Pragma("unroll") for (int k = 0; k < 2; ++k) dst[m][k] = *(const PG8_LAS bf16x8*)(lds + PG8_SA(b, h) + aoff + m * 2048 + k * 1024); } while (0)
#define PG8_LDB(dst, b, h) do { _Pragma("unroll") for (int n = 0; n < 2; ++n) _Pragma("unroll") for (int k = 0; k < 2; ++k) dst[n][k] = *(const PG8_LAS bf16x8*)(lds + PG8_SB(b, h) + boff + n * 2048 + k * 1024); } while (0)
#define PG8_MMA(ai, bj, At, Bt) do { __builtin_amdgcn_s_setprio(1); _Pragma("unroll") for (int m = 0; m < 4; ++m) _Pragma("unroll") for (int n = 0; n < 2; ++n) _Pragma("unroll") for (int k = 0; k < 2; ++k) \
        acc[ai][bj][m][n] = __builtin_amdgcn_mfma_f32_16x16x32_bf16(Bt[n][k], At[m][k], acc[ai][bj][m][n], 0, 0, 0); __builtin_amdgcn_s_setprio(0); } while (0)
#define PG8_WAIT_V(n) asm volatile("s_waitcnt vmcnt(" #n ")" ::: "memory")
#define PG8_WAIT_L(n) asm volatile("s_waitcnt lgkmcnt(" #n ")" ::: "memory")
#define PG8_BAR __builtin_amdgcn_s_barrier()
#define PG8_SCHED __builtin_amdgcn_sched_barrier(0)
    Unit cur, nxt; int ui = 0;
    if (!S.next(0, cur)) return;
    f32x4 acc[2][2][4][2];
#pragma unroll
    for (int a = 0; a < 2; ++a)
#pragma unroll
        for (int b = 0; b < 2; ++b)
#pragma unroll
            for (int m = 0; m < 4; ++m)
#pragma unroll
                for (int n = 0; n < 2; ++n) acc[a][b][m][n] = (f32x4){0.f, 0.f, 0.f, 0.f};
    bf16x8 At[4][2], B0[2][2], B1[2][2];
    const char* cA = cur.A; const char* cB = cur.B;
    S.a_ready(cur);
    if constexpr (SP2) {
        PG8_STAGE(PG8_SB(0, 0), cB, voffB); PG8_STAGE(PG8_SB(0, 1), cB + hstepB, voffB); PG8_STAGE(PG8_SA(0, 0), cA, voffA); if constexpr (!HALFM) PG8_STAGE(PG8_SA(0, 1), cA + hstepA, voffA);
        if (wr == 1) PG8_BAR;
        if constexpr (HALFM) PG8_WAIT_V(0); else PG8_WAIT_V(2);
        PG8_BAR;
        PG8_STAGE(PG8_SB(1, 0), cB + kstep, voffB); PG8_STAGE(PG8_SA(1, 0), cA + kstep, voffA); PG8_STAGE(PG8_SB(1, 1), cB + hstepB + kstep, voffB);
        PG8_WAIT_V(6); PG8_BAR;
    } else {
        PG8_STAGE(PG8_SB(0, 0), cB, voffB); PG8_STAGE(PG8_SA(0, 0), cA, voffA); PG8_STAGE(PG8_SB(0, 1), cB + hstepB, voffB); PG8_STAGE(PG8_SA(0, 1), cA + hstepA, voffA);
        if (wr == 1) PG8_BAR;
        PG8_WAIT_V(4); PG8_BAR;
        PG8_STAGE(PG8_SB(1, 0), cB + kstep, voffB); PG8_STAGE(PG8_SA(1, 0), cA + kstep, voffA); PG8_STAGE(PG8_SB(1, 1), cB + hstepB + kstep, voffB);
        PG8_WAIT_V(6); PG8_BAR;
    }
    for (;;) {
        const bool has_next = S.next(ui + 1, nxt);
        const char* nA = has_next ? nxt.A : cA; const char* nB = has_next ? nxt.B : cB;
        for (int t = 0; t < nt; t += 2) {
            const bool last = (t == nt - 2);
            const char* a1 = cA + (size_t)(t + 1) * kstep;
            const char* a2 = last ? nA : cA + (size_t)(t + 2) * kstep; const char* b2 = last ? nB : cB + (size_t)(t + 2) * kstep;
            const char* a3 = a2 + kstep; const char* b3 = b2 + kstep;
            if (last && has_next) S.a_ready(nxt);
            if constexpr (SP2) {
            PG8_LDB(B0, 0, 0); PG8_LDB(B1, 0, 1); PG8_SCHED; PG8_LDA(At, 0, 0); if constexpr (!HALFM) PG8_STAGE(PG8_SA(1, 1), a1 + hstepA, voffA);
            PG8_WAIT_V(8); PG8_WAIT_L(0); PG8_BAR; PG8_MMA(0, 0, At, B0); PG8_MMA(0, 1, At, B1); PG8_BAR; PG8_SCHED;
            if constexpr (!HALFM) PG8_LDA(At, 0, 1);
            PG8_STAGE(PG8_SB(0, 0), b2, voffB); PG8_STAGE(PG8_SB(0, 1), b2 + hstepB, voffB); PG8_STAGE(PG8_SA(0, 0), a2, voffA);
            if constexpr (HALFM) PG8_WAIT_V(6); else PG8_WAIT_V(8);
            PG8_WAIT_L(0); PG8_BAR; if constexpr (!HALFM) { PG8_MMA(1, 0, At, B0); PG8_MMA(1, 1, At, B1); } PG8_BAR; PG8_SCHED;
            PG8_LDB(B0, 1, 0); PG8_LDB(B1, 1, 1); PG8_SCHED; PG8_LDA(At, 1, 0); if constexpr (!HALFM) PG8_STAGE(PG8_SA(0, 1), a2 + hstepA, voffA);
            PG8_WAIT_V(8); PG8_WAIT_L(0); PG8_BAR; PG8_MMA(0, 0, At, B0); PG8_MMA(0, 1, At, B1); PG8_BAR; PG8_SCHED;
            if constexpr (!HALFM) PG8_LDA(At, 1, 1);
            PG8_STAGE(PG8_SB(1, 0), b3, voffB); PG8_STAGE(PG8_SB(1, 1), b3 + hstepB, voffB); PG8_STAGE(PG8_SA(1, 0), a3, voffA);
            if constexpr (HALFM) PG8_WAIT_V(6); else PG8_WAIT_V(8);
            PG8_WAIT_L(0); PG8_BAR; if constexpr (!HALFM) { PG8_MMA(1, 0, At, B0); PG8_MMA(1, 1, At, B1); } PG8_BAR; PG8_SCHED;
            } else {
            PG8_LDB(B0, 0, 0); PG8_SCHED; PG8_LDA(At, 0, 0); PG8_STAGE(PG8_SA(1, 1), a1 + hstepA, voffA);
            PG8_WAIT_L(8); PG8_BAR; PG8_WAIT_L(0); PG8_MMA(0, 0, At, B0); PG8_BAR; PG8_SCHED;
            PG8_LDB(B1, 0, 1); PG8_STAGE(PG8_SB(0, 0), b2, voffB);
            PG8_BAR; PG8_WAIT_L(0); PG8_MMA(0, 1, At, B1); PG8_BAR;
            PG8_LDA(At, 0, 1); PG8_STAGE(PG8_SA(0, 0), a2, voffA);
            PG8_BAR; PG8_WAIT_L(0); PG8_MMA(1, 0, At, B0); PG8_BAR; PG8_SCHED;
            PG8_STAGE(PG8_SB(0, 1), b2 + hstepB, voffB);
            PG8_WAIT_V(6); PG8_BAR; PG8_MMA(1, 1, At, B1); PG8_BAR;
            PG8_LDB(B0, 1, 0); PG8_SCHED; PG8_LDA(At, 1, 0); PG8_STAGE(PG8_SA(0, 1), a2 + hstepA, voffA);
            PG8_WAIT_L(8); PG8_BAR; PG8_WAIT_L(0); PG8_MMA(0, 0, At, B0); PG8_BAR; PG8_SCHED;
            PG8_LDB(B1, 1, 1); PG8_STAGE(PG8_SB(1, 0), b3, voffB);
            PG8_BAR; PG8_WAIT_L(0); PG8_MMA(0, 1, At, B1); PG8_BAR;
            PG8_LDA(At, 1, 1); PG8_STAGE(PG8_SA(1, 0), a3, voffA);
            PG8_BAR; PG8_WAIT_L(0); PG8_MMA(1, 0, At, B0); PG8_BAR; PG8_SCHED;
            PG8_STAGE(PG8_SB(1, 1), b3 + hstepB, voffB);
            PG8_WAIT_V(6); PG8_BAR; PG8_MMA(1, 1, At, B1); PG8_BAR;
            }
        }
        if constexpr (ALIGN_EPI) { if (wr == 0) PG8_BAR; }
        if constexpr (!Epi::AFTER_DRAIN) { if (cur.fin) { E(acc, cur, wr, wc, fr, fq, HALFM ? 1 : 2); S.done(cur); } }
        if (!has_next) break;
        if (cur.fin) {
#pragma unroll
        for (int a = 0; a < 2; ++a)
#pragma unroll
            for (int b = 0; b < 2; ++b)
#pragma unroll
                for (int m = 0; m < 4; ++m)
#pragma unroll
                    for (int n = 0; n < 2; ++n) acc[a][b][m][n] = (f32x4){0.f, 0.f, 0.f, 0.f};
        }
        cur = nxt; cA = nA; cB = nB; ++ui;
        if constexpr (ALIGN_EPI) { if (wr == 1) PG8_BAR; }
    }
    PG8_WAIT_V(0);
    if constexpr (!ALIGN_EPI) { if (wr == 0) PG8_BAR; }
    PG8_BAR;
    if constexpr (Epi::AFTER_DRAIN) { E.fused(acc, cur, wr, wc, fr, fq, lds, wid, lane); S.done(cur); }
#undef PG8_SA
#undef PG8_SB
#undef PG8_STAGE
#undef PG8_LDA
#undef PG8_LDB
#undef PG8_MMA
#undef PG8_WAIT_V
#undef PG8_WAIT_L
#undef PG8_BAR
#undef PG8_SCHED
}
}

struct SchedDense {
  int nM, nN, G, c, skip_ctx; const char* A; const char* B; size_t a_tile, b_tile; int part;
  __device__ __forceinline__ bool next(int i, pg8::Unit& u) const {
    const int nu = nM * nN, T = nu % G; const bool split = T > 0 && 2 * T <= G; int L, half = 0;
    if (part == 0) { L = i * G + c; if (L >= (split ? nu - T : nu)) return false; }
    else { if (i > 0 || !split || c >= 2 * T) return false; L = nu - T + (c >> 1); half = 1 + (c & 1); }
    int pm, pn; pg8::tile_of(L, nM, nN, pm, pn); if (skip_ctx) pm = pm + pm / 16 + 1;
    u.pm = pm; u.pn = pn; u.fin = 1; u.half = half; u.A = A + (size_t)pm * a_tile + (half == 2 ? a_tile / 2 : 0); u.B = B + (size_t)pn * b_tile; return true; }
  __device__ __forceinline__ void a_ready(const pg8::Unit&) const {}
  __device__ __forceinline__ void done(const pg8::Unit&) const {}
};
struct SchedMoe {
  int G, c, mode; const int* ctl; const char* A; size_t a_tile; const char* W; int tail;
  __device__ __forceinline__ bool next(int i, pg8::Unit& u) const {
    const int part = mode == 2 ? (i & 1) : 0, iu = mode == 2 ? (i >> 1) : i;
    const int nu = ctl[CT_NT] * 4, T = nu % G; const bool split = T > 0 && 2 * T <= G; int L, half = 0;
    if (tail == 0) { L = iu * G + c; if (L >= (split ? nu - T : nu)) return false; }
    else { if (iu > 0 || !split || c >= 2 * T) return false; L = nu - T + (c >> 1); half = 1 + (c & 1); }
    const int pm = L >> 2, pn = L & 3; int eA, eB; pair_experts(ctl[CT_TP + pm], eA, eB);
    u.pm = pm; u.pn = pn; u.half = half; const size_t ho = half == 2 ? a_tile / 2 : 0;
    if (mode == 1) { const int e = pn < 2 ? eA : eB; u.fin = 1; u.A = A + (size_t)pm * a_tile + ho; u.B = W + (size_t)e * (512 * 1024 * 2) + (size_t)(pn & 1) * (256 * 1024 * 2); }
    else { u.fin = part; u.A = A + (size_t)pm * a_tile + ho + part * 512; u.B = W + (size_t)(part ? eB : eA) * (1024 * 256 * 2) + (size_t)pn * (256 * 256 * 2); }
    return true; }
  __device__ __forceinline__ void a_ready(const pg8::Unit&) const {}
  __device__ __forceinline__ void done(const pg8::Unit&) const {}
};
__device__ __forceinline__ unsigned cvt_pk(float lo, float hi) { return pg8::cvt_pk_bf16(lo, hi); }
struct EpiInProj {
  static constexpr bool PERM = true, AFTER_DRAIN = false; bf16_t *QK, *VZ, *XBC, *HY; float* DT;
  __device__ __forceinline__ void operator()(const f32x4 (&acc)[2][2][4][2], const pg8::Unit& u, int wr, int wc, int fr, int fq, const int nai) const {
    const int pn = u.pn; bf16_t* base; int ldc, coff;
    if (pn < 2) { base = QK; ldc = 512; coff = pn * 256; } else if (pn < 4) { base = VZ; ldc = 512; coff = (pn - 2) * 256; }
    else if (pn < 7) { base = XBC; ldc = 768; coff = (pn - 4) * 256; } else { base = HY; ldc = 768; coff = (pn - 7) * 256; }
    const int row0 = u.pm * 256 + (u.half == 2 ? 128 : 0) + wr * 64 + fr, col0 = coff + wc * 32 + 8 * fq; const bool dtl = (pn == 6 && wc == 0 && fq < 2);
#pragma unroll
    for (int ai = 0; ai < 2; ++ai)
#pragma unroll
      for (int m = 0; m < 4; ++m) if (ai < nai) { const int row = row0 + ai * 128 + m * 16; bf16_t* rowp = base + (size_t)row * ldc + col0;
#pragma unroll
        for (int bj = 0; bj < 2; ++bj) { const f32x4 v0 = acc[ai][bj][m][0], v1 = acc[ai][bj][m][1];
          u32x4 w; w.x = cvt_pk(v0[0], v0[1]); w.y = cvt_pk(v0[2], v0[3]); w.z = cvt_pk(v1[0], v1[1]); w.w = cvt_pk(v1[2], v1[3]);
          *(u32x4*)(rowp + bj * 128) = w;
          if (bj == 1 && dtl) { float* dp = DT + (size_t)row * 12 + 8 * fq; *(f32x4*)dp = v0; if (fq == 0) *(f32x4*)(dp + 4) = v1; } } }
  }
};
struct EpiOutProj {
  static constexpr bool PERM = true, AFTER_DRAIN = false; bf16_t* MO;
  __device__ __forceinline__ void operator()(const f32x4 (&acc)[2][2][4][2], const pg8::Unit& u, int wr, int wc, int fr, int fq, const int nai) const {
    const int row0 = u.pm * 256 + (u.half == 2 ? 128 : 0) + wr * 64 + fr, col0 = u.pn * 256 + wc * 32 + 8 * fq;
#pragma unroll
    for (int ai = 0; ai < 2; ++ai)
#pragma unroll
      for (int m = 0; m < 4; ++m) if (ai < nai) { bf16_t* rowp = MO + (size_t)(row0 + ai * 128 + m * 16) * DM + col0;
#pragma unroll
        for (int bj = 0; bj < 2; ++bj) { const f32x4 v0 = acc[ai][bj][m][0], v1 = acc[ai][bj][m][1];
          u32x4 w; w.x = cvt_pk(v0[0], v0[1]); w.y = cvt_pk(v0[2], v0[3]); w.z = cvt_pk(v1[0], v1[1]); w.w = cvt_pk(v1[2], v1[3]);
          *(u32x4*)(rowp + bj * 128) = w; } }
  }
};
struct EpiMoe1 {
  static constexpr bool PERM = true, AFTER_DRAIN = false; bf16_t* ACT; const float* sorted_w;
  __device__ __forceinline__ void operator()(const f32x4 (&acc)[2][2][4][2], const pg8::Unit& u, int wr, int wc, int fr, int fq, const int nai) const {
    const int half = u.pn >> 1, j0 = (u.pn & 1) * 128 + 16 * wc + 4 * fq;
#pragma unroll
    for (int ai = 0; ai < 2; ++ai)
#pragma unroll
      for (int m = 0; m < 4; ++m) if (ai < nai) { const int slot = u.pm * 256 + (u.half == 2 ? 128 : 0) + ai * 128 + wr * 64 + m * 16 + fr; const float wt = sorted_w[2 * slot + half];
#pragma unroll
        for (int bj = 0; bj < 2; ++bj) { const f32x4 v0 = acc[ai][bj][m][0], v1 = acc[ai][bj][m][1];
          u32x2 w; w.x = cvt_pk(siluf(v0[0]) * v0[1] * wt, siluf(v0[2]) * v0[3] * wt); w.y = cvt_pk(siluf(v1[0]) * v1[1] * wt, siluf(v1[2]) * v1[3] * wt);
          *(u32x2*)(ACT + (size_t)slot * 512 + half * 256 + j0 + 64 * bj) = w; } }
  }
};
struct EpiMoe2 {
  static constexpr bool PERM = true, AFTER_DRAIN = false; bf16_t* YS;
  __device__ __forceinline__ void operator()(const f32x4 (&acc)[2][2][4][2], const pg8::Unit& u, int wr, int wc, int fr, int fq, const int nai) const {
    const int row0 = u.pm * 256 + (u.half == 2 ? 128 : 0) + wr * 64 + fr, col0 = u.pn * 256 + wc * 32 + 8 * fq;
#pragma unroll
    for (int ai = 0; ai < 2; ++ai)
#pragma unroll
      for (int m = 0; m < 4; ++m) if (ai < nai) { bf16_t* rowp = YS + (size_t)(row0 + ai * 128 + m * 16) * DM + col0;
#pragma unroll
        for (int bj = 0; bj < 2; ++bj) { const f32x4 v0 = acc[ai][bj][m][0], v1 = acc[ai][bj][m][1];
          u32x4 w; w.x = cvt_pk(v0[0], v0[1]); w.y = cvt_pk(v0[2], v0[3]); w.z = cvt_pk(v1[0], v1[1]); w.w = cvt_pk(v1[2], v1[3]);
          *(u32x4*)(rowp + bj * 128) = w; } }
  }
};

#include <hip/hip_bf16.h>
#include <cmath>
namespace attn_body {
using bf16=__hip_bfloat16;
using bf16x8=__attribute__((ext_vector_type(8)))short;
using s16x4=__attribute__((ext_vector_type(4)))short;
using f32x16=__attribute__((ext_vector_type(16)))float;
using u32x4=__attribute__((ext_vector_type(4)))unsigned;
constexpr int D=64,QP=512,KP=512,VP=512,OP=1024;
constexpr int NW=8,QBLK=32,QB=QBLK*NW,KVBLK=64;
constexpr int ATTN_UNIT_ROWS=QB;
__device__ __forceinline__ int crow(int r,int hi){return (r&3)+8*(r>>2)+4*hi;}
#define SBAR() __builtin_amdgcn_sched_barrier(0)
__device__ __forceinline__ void cmask(f32x16&p0,f32x16&p1,int jb,int qrel,int hi){
  const float NEG=-INFINITY; int kb=64*jb+4*hi;
  #pragma unroll
  for(int r=0;r<16;++r){int kv=kb+(r&3)+8*(r>>2); if(kv>qrel)p0[r]=NEG; if(kv+32>qrel)p1[r]=NEG;}
}

constexpr int NSLOT=3, SLOTB=8192;
constexpr int LDS_K=0, LDS_V=NSLOT*SLOTB, LDS_WS=2*NSLOT*SLOTB, LDS_OST=LDS_WS+NW*64*4, LDS_BYTES=LDS_OST+NW*4096;
constexpr float C2=0.125f*1.4426950408889634f;
__device__ __forceinline__ void glds16(const void*gsrc,unsigned lds_dst){unsigned keep;
  asm volatile("s_mov_b32 %0, m0\n\ts_mov_b32 m0, %2\n\ts_nop 0\n\tglobal_load_lds_dwordx4 %1, off\n\ts_mov_b32 m0, %0":"=&s"(keep):"v"(gsrc),"s"(lds_dst):"memory");}
__device__ __forceinline__ float max3f(float a,float b,float c){float r;asm("v_max3_f32 %0, %1, %2, %3":"=v"(r):"v"(a),"v"(b),"v"(c));return r;}
__device__ __forceinline__ float max2f(float a,float b){float r;asm("v_max_f32_e32 %0, %1, %2":"=v"(r):"v"(a),"v"(b));return r;}
__device__ __forceinline__ float fadd_s(float a,float b){float r;asm("v_add_f32_e32 %0, %1, %2":"=v"(r):"v"(a),"v"(b));return r;}
__device__ __forceinline__ float fsub_s(float a,float b){float r;asm("v_sub_f32_e32 %0, %1, %2":"=v"(r):"v"(a),"v"(b));return r;}
typedef float f32x2_t __attribute__((ext_vector_type(2))); typedef __bf16 bf16x2_t __attribute__((ext_vector_type(2)));
__device__ __forceinline__ unsigned cvtpk_s(float lo,float hi){f32x2_t v={lo,hi};bf16x2_t b=__builtin_convertvector(v,bf16x2_t);return __builtin_bit_cast(unsigned,b);}
#define WAIT_BAR(N) asm volatile("s_waitcnt vmcnt(" #N ") lgkmcnt(0)\n\ts_barrier":::"memory")

__device__ __forceinline__ void qkt(f32x16&p0,f32x16&p1,const char*Kslot,const bf16x8*qr,const f32x16&negm,int r32,int hi){
  const char*kb=Kslot+hi*1024+r32*16;
  #pragma unroll
  for(int d0=0;d0<4;++d0){
    const bf16x8 b0=*reinterpret_cast<const bf16x8*>(kb+d0*2048);
    const bf16x8 b1=*reinterpret_cast<const bf16x8*>(kb+d0*2048+512);
    if(d0==0){p0=__builtin_amdgcn_mfma_f32_32x32x16_bf16(b0,qr[0],negm,0,0,0);p1=__builtin_amdgcn_mfma_f32_32x32x16_bf16(b1,qr[0],negm,0,0,0);}
    else{p0=__builtin_amdgcn_mfma_f32_32x32x16_bf16(b0,qr[d0],p0,0,0,0);p1=__builtin_amdgcn_mfma_f32_32x32x16_bf16(b1,qr[d0],p1,0,0,0);}}
}
typedef __attribute__((address_space(3))) const char* lds_cptr;
typedef short v4i16_t __attribute__((ext_vector_type(4)));
__device__ __forceinline__ void kload8(bf16x8*kf,lds_cptr kp){
  kf[0]=*(const __attribute__((address_space(3))) bf16x8*)(kp);      kf[1]=*(const __attribute__((address_space(3))) bf16x8*)(kp+512);
  kf[2]=*(const __attribute__((address_space(3))) bf16x8*)(kp+2048); kf[3]=*(const __attribute__((address_space(3))) bf16x8*)(kp+2560);
  kf[4]=*(const __attribute__((address_space(3))) bf16x8*)(kp+4096); kf[5]=*(const __attribute__((address_space(3))) bf16x8*)(kp+4608);
  kf[6]=*(const __attribute__((address_space(3))) bf16x8*)(kp+6144); kf[7]=*(const __attribute__((address_space(3))) bf16x8*)(kp+6656);
}
__device__ __forceinline__ void kload2(bf16x8*kf,lds_cptr kp,int j){ kf[2*j]=*(const __attribute__((address_space(3))) bf16x8*)(kp+j*2048); kf[2*j+1]=*(const __attribute__((address_space(3))) bf16x8*)(kp+j*2048+512); }
__device__ __forceinline__ s16x4 vtr(lds_cptr p){ return __builtin_bit_cast(s16x4,__builtin_amdgcn_ds_read_tr16_b64_v4i16((__attribute__((address_space(3))) v4i16_t*)p)); }
__device__ __forceinline__ float rowmax(const f32x16&p0,const f32x16&p1){
  float a=max3f(p0[0],p0[1],p1[0]),b=max3f(p0[2],p0[3],p1[1]);a=max3f(a,p1[2],p1[3]);
  #pragma unroll
  for(int r=4;r<16;r+=4){a=max3f(a,p0[r],p0[r+1]);b=max3f(b,p0[r+2],p0[r+3]);a=max3f(a,p1[r],p1[r+1]);b=max3f(b,p1[r+2],p1[r+3]);}
  const float m=max2f(a,b);
  auto rr=__builtin_amdgcn_permlane32_swap(__float_as_uint(m),__float_as_uint(m),false,false);
  return max2f(__uint_as_float(rr[0]),__uint_as_float(rr[1]));
}
__device__ __forceinline__ void pv(f32x16*o,int vb,bf16x8 pa0,bf16x8 pa1,bf16x8 pa2,bf16x8 pa3){
  #pragma unroll
  for(int d0=0;d0<2;++d0){s16x4 lo[4],hi[4];
    #pragma unroll
    for(int ks=0;ks<4;++ks){
      asm volatile("ds_read_b64_tr_b16 %0,%1 offset:%c2":"=&v"(lo[ks]):"v"(vb),"i"(d0*4096+ks*1024):"memory");
      asm volatile("ds_read_b64_tr_b16 %0,%1 offset:%c2":"=&v"(hi[ks]):"v"(vb),"i"(d0*4096+ks*1024+512):"memory");}
    asm volatile("s_waitcnt lgkmcnt(0)":::"memory");SBAR();
    #define PK(k) (bf16x8){lo[k][0],lo[k][1],lo[k][2],lo[k][3],hi[k][0],hi[k][1],hi[k][2],hi[k][3]}
    o[d0]=__builtin_amdgcn_mfma_f32_32x32x16_bf16(pa0,PK(0),o[d0],0,0,0);
    o[d0]=__builtin_amdgcn_mfma_f32_32x32x16_bf16(pa1,PK(1),o[d0],0,0,0);
    o[d0]=__builtin_amdgcn_mfma_f32_32x32x16_bf16(pa2,PK(2),o[d0],0,0,0);
    o[d0]=__builtin_amdgcn_mfma_f32_32x32x16_bf16(pa3,PK(3),o[d0],0,0,0);
    #undef PK
  }
}

#ifndef ATTN_STORE16
#define ATTN_STORE16(p,v) (*(u32x4*)(p)=(v))
#endif
template<int THRL> __device__ __forceinline__ void attn_unit(const bf16*Qu,const bf16*__restrict__ Kh,const bf16*__restrict__ Vh,bf16*Ou,const int NT,char*shm){
  const int tid=opq_v((int)threadIdx.x),lane=tid&63,r32=lane&31,hi=lane>>5; const int wid=__builtin_amdgcn_readfirstlane(tid>>6);
  const bf16*Qw=Qu+(long)(wid*QBLK)*QP;
  const unsigned lds0=(unsigned)(uintptr_t)shm;
  float*wsf=(float*)(shm+LDS_WS)+wid*64;
  const bf16*ksrc=Kh+(long)lane*KP+wid*8;
  const bf16*vsrc=Vh+(long)(16*(wid&3)+(lane>>2))*VP+(wid>>2)*32+(lane&3)*8;
  const unsigned kdst=lds0+LDS_K+wid*1024, vdst=lds0+LDS_V+wid*1024;
  #define DMA_K(t,slot) glds16(ksrc+(long)(t)*KVBLK*KP,(unsigned)__builtin_amdgcn_readfirstlane(kdst+(slot)))
  #define DMA_V(t,slot) glds16(vsrc+(long)(t)*KVBLK*VP,(unsigned)__builtin_amdgcn_readfirstlane(vdst+(slot)))
  const int vb0=(int)(lds0+LDS_V)+((lane>>4)&1)*32+(lane&3)*8+(4*hi+((lane&15)>>2))*64;
  const char*Kbase=shm+LDS_K; bf16x8 kf[8];
  const lds_cptr shm3=(lds_cptr)shm; const lds_cptr kp0=shm3+LDS_K+hi*1024+r32*16; const lds_cptr vp0=shm3+LDS_V+((lane>>4)&1)*32+(lane&3)*8+(4*hi+((lane&15)>>2))*64;
  DMA_K(0,0);DMA_V(0,0);DMA_K(1,SLOTB);
  bf16x8 qr[4];
  #pragma unroll
  for(int d0=0;d0<4;++d0)qr[d0]=*reinterpret_cast<const bf16x8*>(&Qw[(long)r32*QP+d0*16+hi*8]);
  float mhat=0.f,l_reg=0.f;float z0_=0.f;asm volatile("":"+v"(z0_));f32x16 o[2];f32x16 negm;
  _Pragma("unroll") for(int r=0;r<16;++r){o[0][r]=z0_;o[1][r]=z0_;negm[r]=z0_;} asm volatile("":"+v"(negm));
  #define CMASK(P0,P1,t) do{}while(0)
  bool resc=false;
  #define START(P0,P1) do{ const float rm=rowmax(P0,P1); resc=false; \
    { const float dl=rm; mhat=fadd_s(mhat,dl); \
      _Pragma("unroll") for(int r=0;r<16;++r){P0[r]=fsub_s(P0[r],dl);P1[r]=fsub_s(P1[r],dl);} \
      _Pragma("unroll") for(int r=0;r<16;++r)negm[r]=-mhat; asm volatile("":"+v"(negm)); } \
    _Pragma("unroll") for(int r=0;r<16;++r)P0[r]=__builtin_amdgcn_exp2f(P0[r]); }while(0)
  #define RESC() do{ if(resc){ asm volatile("s_waitcnt lgkmcnt(0)":::"memory"); \
      _Pragma("unroll") for(int d_=0;d_<2;++d_) _Pragma("unroll") for(int r=0;r<16;++r)o[d_][r]*=wsf[crow(r,hi)]; } }while(0)
  f32x16 pA0,pA1,pB0,pB1;
  int sl_prev=0,sl_cur=0,sl_next=SLOTB;
  #define ROT() do{sl_prev=sl_cur;sl_cur=sl_next;sl_next=(sl_next==(NSLOT-1)*SLOTB)?0:sl_next+SLOTB;}while(0)
  DMA_K(2,2*SLOTB);
  WAIT_BAR(3);
  qkt(pA0,pA1,Kbase,qr,negm,r32,hi);asm volatile("s_nop 15\n\ts_nop 7":"+v"(pA0),"+v"(pA1));CMASK(pA0,pA1,0);
  START(pA0,pA1);
  _Pragma("unroll") for(int r=0;r<16;++r)pA1[r]=__builtin_amdgcn_exp2f(pA1[r]);
  WAIT_BAR(0);
  DMA_K(3,0);DMA_V(1,SLOTB);
  ROT();
  kload8(kf,kp0+sl_cur);
  WAIT_BAR(2);
  s16x4 vlo[8],vhi[8]; u32x4 pw0,pw1,pw2,pw3;
  #define PKW(P,B) cvtpk_s(P[B],P[B+1])
  #define PAF(k) __builtin_bit_cast(bf16x8,pw##k)
  #define VFR(i) (bf16x8){vlo[i][0],vlo[i][1],vlo[i][2],vlo[i][3],vhi[i][0],vhi[i][1],vhi[i][2],vhi[i][3]}
  #define PIN(x) asm volatile("":"+v"(x))
  #define MX3(a,b,c) __builtin_fmaxf(__builtin_fmaxf((a),(b)),(c))
  #define GAPA(MF,A0,A1,A2,A3,W0,W1,PW) do{ MF; sacc+=A0; sacc+=A1; sacc+=A2; sacc+=A3; PIN(sacc); W0; W1; PIN(PW); SBAR(); }while(0)
  #define EX(v) __builtin_amdgcn_exp2f(v)
  #define GAPB(MF,X,B) do{ MF; X[B]=EX(X[B]); X[B+1]=EX(X[B+1]); X[B+2]=EX(X[B+2]); X[B+3]=EX(X[B+3]); PIN(X); SBAR(); }while(0)
  #define VRD(i) do{ vlo[i]=vtr(vp_+(((i)>>2)*4096+((i)&3)*1024)); vhi[i]=vtr(vp_+(((i)>>2)*4096+((i)&3)*1024+512)); }while(0)
  #define KRD(G,j) do{ if(G){ kload2(kf,kp0+sl_next,j); SBAR(); } }while(0)
  #define STEP(C0,C1,P0,P1,t,GK,GV,GL) do{ SBAR(); \
    const lds_cptr vp_=vp0+sl_prev; \
    VRD(0); SBAR(); float sacc=(P0[0]+P0[1]); \
    GAPA(C0=__builtin_amdgcn_mfma_f32_32x32x16_bf16(kf[0],qr[0],negm,0,0,0), P0[2],P0[3],P0[4],P0[5],     pw0[0]=PKW(P0,0), pw0[1]=PKW(P0,2), pw0); \
    VRD(4); SBAR(); GAPA(C1=__builtin_amdgcn_mfma_f32_32x32x16_bf16(kf[1],qr[0],negm,0,0,0), P0[6],P0[7],P0[8],P0[9],     pw0[2]=PKW(P0,4), pw0[3]=PKW(P0,6), pw0); \
    VRD(1); SBAR(); GAPA(C0=__builtin_amdgcn_mfma_f32_32x32x16_bf16(kf[2],qr[1],C0,0,0,0),   P0[10],P0[11],P0[12],P0[13], pw1[0]=PKW(P0,8), pw1[1]=PKW(P0,10), pw1); \
    VRD(5); SBAR(); GAPA(C1=__builtin_amdgcn_mfma_f32_32x32x16_bf16(kf[3],qr[1],C1,0,0,0),   P0[14],P0[15],P1[0],P1[1],   pw1[2]=PKW(P0,12),pw1[3]=PKW(P0,14), pw1); \
    VRD(2); SBAR(); GAPA(C0=__builtin_amdgcn_mfma_f32_32x32x16_bf16(kf[4],qr[2],C0,0,0,0),   P1[2],P1[3],P1[4],P1[5],     pw2[0]=PKW(P1,0), pw2[1]=PKW(P1,2), pw2); \
    VRD(6); SBAR(); GAPA(C1=__builtin_amdgcn_mfma_f32_32x32x16_bf16(kf[5],qr[2],C1,0,0,0),   P1[6],P1[7],P1[8],P1[9],     pw2[2]=PKW(P1,4), pw2[3]=PKW(P1,6), pw2); \
    VRD(3); SBAR(); GAPA(C0=__builtin_amdgcn_mfma_f32_32x32x16_bf16(kf[6],qr[3],C0,0,0,0),   P1[10],P1[11],P1[12],P1[13], pw3[0]=PKW(P1,8), pw3[1]=PKW(P1,10), pw3); \
    VRD(7); SBAR(); GAPA(C1=__builtin_amdgcn_mfma_f32_32x32x16_bf16(kf[7],qr[3],C1,0,0,0),   P1[14],P1[15],0.f,0.f,       pw3[2]=PKW(P1,12),pw3[3]=PKW(P1,14), pw3); \
    l_reg+=sacc; \
    if(GK){DMA_K((t)+3,sl_cur);} if(GV){DMA_V((t)+1,sl_next);} \
    CMASK(C0,C1,t); \
    { float a=MX3(C0[0],C0[1],C1[0]),b=MX3(C0[2],C0[3],C1[1]); a=MX3(a,C1[2],C1[3]); \
      _Pragma("unroll") for(int r=4;r<16;r+=4){a=MX3(a,C0[r],C0[r+1]);b=MX3(b,C0[r+2],C0[r+3]);a=MX3(a,C1[r],C1[r+1]);b=MX3(b,C1[r+2],C1[r+3]);} \
      float rm=__builtin_fmaxf(a,b); { auto rr=__builtin_amdgcn_permlane32_swap(__float_as_uint(rm),__float_as_uint(rm),false,false); rm=__builtin_fmaxf(__uint_as_float(rr[0]),__uint_as_float(rr[1])); } \
      resc=false; \
      if(__builtin_expect(__any(rm>(float)THRL),0)){ const float dl=__builtin_fmaxf(rm,0.f); mhat+=dl; \
        _Pragma("unroll") for(int r=0;r<16;++r){C0[r]-=dl;C1[r]-=dl;} \
        _Pragma("unroll") for(int r=0;r<16;++r)negm[r]=-mhat; asm volatile("":"+v"(negm)); \
        const float f=__builtin_amdgcn_exp2f(-dl); l_reg*=f; if(hi==0)wsf[r32]=f; resc=true; } } \
    SBAR(); \
    GAPB(o[0]=__builtin_amdgcn_mfma_f32_32x32x16_bf16(PAF(0),VFR(0),o[0],0,0,0), C0,0); \
    GAPB(o[1]=__builtin_amdgcn_mfma_f32_32x32x16_bf16(PAF(0),VFR(4),o[1],0,0,0), C0,4); \
    KRD(GL,0); GAPB(o[0]=__builtin_amdgcn_mfma_f32_32x32x16_bf16(PAF(1),VFR(1),o[0],0,0,0), C0,8); \
    KRD(GL,1); GAPB(o[1]=__builtin_amdgcn_mfma_f32_32x32x16_bf16(PAF(1),VFR(5),o[1],0,0,0), C0,12); \
    KRD(GL,2); GAPB(o[0]=__builtin_amdgcn_mfma_f32_32x32x16_bf16(PAF(2),VFR(2),o[0],0,0,0), C1,0); \
    KRD(GL,3); GAPB(o[1]=__builtin_amdgcn_mfma_f32_32x32x16_bf16(PAF(2),VFR(6),o[1],0,0,0), C1,4); \
    GAPB(o[0]=__builtin_amdgcn_mfma_f32_32x32x16_bf16(PAF(3),VFR(3),o[0],0,0,0), C1,8); \
    GAPB(o[1]=__builtin_amdgcn_mfma_f32_32x32x16_bf16(PAF(3),VFR(7),o[1],0,0,0), C1,12); \
    }while(0)
  int t=1;
  for(;t+5<NT;t+=2){
    STEP(pB0,pB1,pA0,pA1,t,true,true,true);     WAIT_BAR(2); RESC(); ROT();
    STEP(pA0,pA1,pB0,pB1,t+1,true,true,true);   WAIT_BAR(2); RESC(); ROT();
  }
  #define ENDW(tt) do{ if((tt)+3<NT){WAIT_BAR(2);} else if((tt)+2<NT){WAIT_BAR(1);} else {WAIT_BAR(0);} }while(0)
  for(;t+1<NT;t+=2){
    STEP(pB0,pB1,pA0,pA1,t,(t+3<NT),(t+1<NT),(t+1<NT));       ENDW(t);   RESC(); ROT();
    STEP(pA0,pA1,pB0,pB1,t+1,(t+4<NT),(t+2<NT),(t+2<NT));     ENDW(t+1); RESC(); ROT();
  }
  STEP(pB0,pB1,pA0,pA1,NT-1,false,false,false); RESC();
  { float sacc=pB0[0]+pB0[1]; _Pragma("unroll") for(int r=2;r<16;++r)sacc+=pB0[r]; _Pragma("unroll") for(int r=0;r<16;++r)sacc+=pB1[r]; l_reg+=sacc;
    pw0=(u32x4){PKW(pB0,0),PKW(pB0,2),PKW(pB0,4),PKW(pB0,6)};pw1=(u32x4){PKW(pB0,8),PKW(pB0,10),PKW(pB0,12),PKW(pB0,14)};pw2=(u32x4){PKW(pB1,0),PKW(pB1,2),PKW(pB1,4),PKW(pB1,6)};pw3=(u32x4){PKW(pB1,8),PKW(pB1,10),PKW(pB1,12),PKW(pB1,14)};
    SBAR(); pv(o,vb0+sl_cur,PAF(0),PAF(1),PAF(2),PAF(3)); }
  #undef PKW
  #undef PAF
  #undef VFR
  #undef PIN
  #undef MX3
  #undef GAPA
  #undef GAPB
  #undef EX
  #undef VRD
  #undef KRD
  #undef STEP
  #undef ENDW
  {auto rr=__builtin_amdgcn_permlane32_swap(__float_as_uint(l_reg),__float_as_uint(l_reg),false,false);l_reg=__uint_as_float(rr[0])+__uint_as_float(rr[1]);}
  if(hi==0)wsf[32+r32]=l_reg;asm volatile("s_waitcnt lgkmcnt(0)":::"memory");
  float rli[16];
  #pragma unroll
  for(int r=0;r<16;++r)rli[r]=__builtin_amdgcn_rcpf(wsf[32+crow(r,hi)]);
  bf16*Ow=Ou+(long)(wid*QBLK)*OP;
  { bf16*stg=(bf16*)(shm+LDS_OST)+wid*2048;
    #pragma unroll
    for(int r=0;r<16;++r){const int orow=crow(r,hi);
      #pragma unroll
      for(int d0=0;d0<2;++d0)stg[orow*64+d0*32+r32]=__float2bfloat16(o[d0][r]*rli[r]);}
    asm volatile("s_waitcnt lgkmcnt(0)":::"memory");
    #pragma unroll
    for(int i=0;i<4;++i){const int row=i*8+(lane>>3),ch=lane&7; const u32x4 v=*(const u32x4*)(stg+row*64+ch*8); ATTN_STORE16(Ow+(long)row*OP+ch*8,v);} }
  asm volatile("s_waitcnt lgkmcnt(0)\n\ts_barrier":::"memory");
  #undef DMA_K
  #undef DMA_V
  #undef CMASK
  #undef START
  #undef RESC
  #undef ROT
}
constexpr int ATTN_LDS_BYTES=LDS_BYTES;
#undef SBAR
#undef WAIT_BAR
}


namespace hyf {
struct c32 { float x, y; };
typedef _Float16 h2 __attribute__((ext_vector_type(2)));
__device__ __forceinline__ c32 operator+(c32 a, c32 b) { return {a.x + b.x, a.y + b.y}; }
__device__ __forceinline__ c32 operator-(c32 a, c32 b) { return {a.x - b.x, a.y - b.y}; }
__device__ __forceinline__ c32 cmul(c32 a, c32 b) { return {a.x * b.x - a.y * b.y, a.x * b.y + a.y * b.x}; }
__device__ __forceinline__ constexpr float C32(int k) {
  switch (k) { case 0: return 1.f; case 1: return 0.98078528f; case 2: return 0.923879533f; case 3: return 0.831469612f; case 4: return 0.707106781f; case 5: return 0.555570233f; case 6: return 0.382683432f;
    case 7: return 0.195090322f; case 8: return 0.f; case 9: return -0.195090322f; case 10: return -0.382683432f; case 11: return -0.555570233f; case 12: return -0.707106781f; case 13: return -0.831469612f;
    case 14: return -0.923879533f; default: return -0.98078528f; } }
__device__ __forceinline__ constexpr float S32(int k) {
  switch (k) { case 0: return 0.f; case 1: return 0.195090322f; case 2: return 0.382683432f; case 3: return 0.555570233f; case 4: return 0.707106781f; case 5: return 0.831469612f; case 6: return 0.923879533f;
    case 7: return 0.98078528f; case 8: return 1.f; case 9: return 0.98078528f; case 10: return 0.923879533f; case 11: return 0.831469612f; case 12: return 0.707106781f; case 13: return 0.555570233f;
    case 14: return 0.382683432f; default: return 0.195090322f; } }
__device__ __forceinline__ constexpr int brev(int q, int bits) {
  return bits == 4 ? (((q & 1) << 3) | ((q & 2) << 1) | ((q & 4) >> 1) | ((q & 8) >> 3))
                   : (((q & 1) << 4) | ((q & 2) << 2) | (q & 4) | ((q & 8) >> 2) | ((q & 16) >> 4)); }
__device__ __forceinline__ int phys(int p) { return p + (p >> 5); }
template <int R, int HALF, bool INV> struct DftStage {
  static __device__ __forceinline__ void run(c32 (&x)[R]) {
#pragma unroll
    for (int blk = 0; blk < R; blk += 2 * HALF) {
#pragma unroll
      for (int j = 0; j < HALF; ++j) {
        const c32 a = x[blk + j], b = x[blk + j + HALF]; x[blk + j] = a + b; const c32 d = a - b;
        const int e = j * (R / (2 * HALF)) * (32 / R);
        if (e == 0) x[blk + j + HALF] = d;
        else if (e == 8) x[blk + j + HALF] = INV ? (c32){-d.y, d.x} : (c32){d.y, -d.x};
        else { const c32 wv = {C32(e), INV ? S32(e) : -S32(e)}; x[blk + j + HALF] = cmul(d, wv); }
      } }
    DftStage<R, HALF / 2, INV>::run(x);
  }
};
template <int R, bool INV> struct DftStage<R, 0, INV> { static __device__ __forceinline__ void run(c32 (&)[R]) {} };
template <int R, bool INV> __device__ __forceinline__ void dft_pow2(c32 (&x)[R]) { DftStage<R, R / 2, INV>::run(x); }
template <int R, int HALF> struct DitStage {
  static __device__ __forceinline__ void run(c32 (&x)[R]) {
#pragma unroll
    for (int blk = 0; blk < R; blk += 2 * HALF) {
#pragma unroll
      for (int j = 0; j < HALF; ++j) {
        const int e = j * (R / (2 * HALF)) * (32 / R);
        const c32 a = x[blk + j], b0 = x[blk + j + HALF];
        c32 b;
        if (e == 0) b = b0; else if (e == 8) b = (c32){-b0.y, b0.x}; else b = cmul(b0, (c32){C32(e), S32(e)});
        x[blk + j] = a + b; x[blk + j + HALF] = a - b;
      } }
    DitStage<R, HALF * 2>::run(x);
  }
};
template <int R> struct DitStage<R, R> { static __device__ __forceinline__ void run(c32 (&)[R]) {} };
template <int R> __device__ __forceinline__ void idft_dit(c32 (&x)[R]) { DitStage<R, 1>::run(x); }
template <int STRIDE, bool INV> __device__ __forceinline__ void pass16(c32* buf, int e0, float rev) {
  float rv = rev; asm volatile("" : "+v"(rv));
  const float cs = __builtin_amdgcn_cosf(rv), sn = __builtin_amdgcn_sinf(rv);
  const c32 w1 = {cs, INV ? sn : -sn};
  c32* p = buf + phys(e0); constexpr int PS = STRIDE + STRIDE / 32;
  c32 x[16];
  if (!INV) {
#pragma unroll
    for (int m = 0; m < 16; ++m) x[m] = p[PS * m];
    dft_pow2<16, false>(x);
    c32 w = w1; p[0] = x[0];
#pragma unroll
    for (int q = 1; q < 16; ++q) { p[PS * q] = cmul(x[brev(q, 4)], w); w = cmul(w, w1); }
  } else {
    c32 w = w1; x[0] = p[0];
#pragma unroll
    for (int q = 1; q < 16; ++q) { x[q] = cmul(p[PS * q], w); w = cmul(w, w1); }
    dft_pow2<16, true>(x);
#pragma unroll
    for (int m = 0; m < 16; ++m) p[PS * m] = x[brev(m, 4)];
  }
}
template <int MODE> __device__ __forceinline__ void mid32(c32* buf, h2* Hs, int j) {
  c32* p = buf + 33 * j; c32 x[32];
#pragma unroll
  for (int m = 0; m < 32; ++m) x[m] = p[m];
  dft_pow2<32, false>(x);
  if (MODE == 0) {
#pragma unroll
    for (int q = 0; q < 32; ++q) { const c32 v = x[brev(q, 5)]; Hs[q * 256 + j] = (h2){(_Float16)v.x, (_Float16)v.y}; }
  } else {
#pragma unroll
    for (int pp = 0; pp < 32; ++pp) { const h2 hv = Hs[brev(pp, 5) * 256 + j]; x[pp] = cmul(x[pp], (c32){(float)hv.x, (float)hv.y}); }
    idft_dit<32>(x);
#pragma unroll
    for (int m = 0; m < 32; ++m) p[m] = x[m];
  }
}
__device__ __forceinline__ void fwd2(c32* buf, int tid) {
  __syncthreads(); pass16<512, false>(buf, tid, (float)tid * (1.0f / 8192.0f));
  __syncthreads(); pass16<32, false>(buf, (tid >> 5) * 512 + (tid & 31), (float)(tid & 31) * (1.0f / 512.0f));
  __syncthreads();
}
__device__ __forceinline__ void conv(c32* buf, h2* Hs, int tid) {
  fwd2(buf, tid);
  if (tid < 256) mid32<1>(buf, Hs, tid);
  __syncthreads(); pass16<32, true>(buf, (tid >> 5) * 512 + (tid & 31), (float)(tid & 31) * (1.0f / 512.0f));
  __syncthreads(); pass16<512, true>(buf, tid, (float)tid * (1.0f / 8192.0f));
  __syncthreads();
}
__device__ __forceinline__ void item(int c, const bf16_t* HYT, const float* HK, const float* hy_bias, bf16_t* HYO, char* lds) {
  c32* buf = (c32*)lds; h2* H0 = (h2*)(lds + 67584); h2* H1 = H0 + 8192;
  const int tid = TIDX;
#pragma unroll 1
  for (int o = 0; o < 2; ++o) {
    const float* kp = HK + ((size_t)o * 256 + c) * 8192;
#pragma unroll
    for (int i = 0; i < 16; ++i) { const int n = tid + 512 * i; buf[phys(n)] = (c32){kp[n], 0.f}; }
    fwd2(buf, tid);
    if (tid < 256) mid32<0>(buf, o ? H1 : H0, tid);
    __syncthreads();
  }
  const float bias0 = hy_bias[c], bias1 = hy_bias[256 + c];
#pragma unroll 1
  for (int pr = 0; pr < 2; ++pr) {
    const bf16_t* v0 = HYT + ((size_t)(2 * pr) * 768 + c) * SEQ; const bf16_t* v1 = v0 + (size_t)768 * SEQ;
    c32 vv[8];
#pragma unroll
    for (int i = 0; i < 8; ++i) { const int t = tid + 512 * i; vv[i] = (c32){bf2f(v0[t]), bf2f(v1[t])}; buf[phys(t)] = vv[i]; buf[phys(t + 4096)] = (c32){0.f, 0.f}; }
    conv(buf, H0, tid);
#pragma unroll
    for (int i = 0; i < 8; ++i) { const int t = tid + 512 * i; const c32 y = buf[phys(t)];
      vv[i] = (c32){bf2f(v0[(size_t)256 * SEQ + t]) * (y.x * (1.0f / 8192.0f) + bias0 * vv[i].x), bf2f(v1[(size_t)256 * SEQ + t]) * (y.y * (1.0f / 8192.0f) + bias0 * vv[i].y)};
      buf[phys(t)] = vv[i]; buf[phys(t + 4096)] = (c32){0.f, 0.f}; }
    conv(buf, H1, tid);
#pragma unroll
    for (int i = 0; i < 8; ++i) { const int t = tid + 512 * i; const c32 y = buf[phys(t)];
      HYO[((size_t)(2 * pr) * 256 + c) * SEQ + t] = (bf16_t)f2bf(bf2f(v0[(size_t)512 * SEQ + t]) * (y.x * (1.0f / 8192.0f) + bias1 * vv[i].x));
      HYO[((size_t)(2 * pr + 1) * 256 + c) * SEQ + t] = (bf16_t)f2bf(bf2f(v1[(size_t)512 * SEQ + t]) * (y.y * (1.0f / 8192.0f) + bias1 * vv[i].y)); }
    __syncthreads();
  }
}
__device__ __forceinline__ void out_item(int it, const bf16_t* HYO, bf16_t* MIX, char* lds) {
  bf16_t (*T)[72] = (bf16_t (*)[72])lds;
  const int tid = TIDX, b = it >> 8, t0 = ((it >> 2) & 63) * 64, c0 = (it & 3) * 64;
  { const int cc = tid >> 3, t8 = (tid & 7) * 8; *(u32x4*)&T[cc][t8] = *(const u32x4*)(HYO + ((size_t)b * 256 + c0 + cc) * SEQ + t0 + t8); }
  __syncthreads();
  { const int tl = tid >> 3, c8 = (tid & 7) * 8; u32x4 o;
    o.x = (unsigned)T[c8][tl] | ((unsigned)T[c8 + 1][tl] << 16); o.y = (unsigned)T[c8 + 2][tl] | ((unsigned)T[c8 + 3][tl] << 16);
    o.z = (unsigned)T[c8 + 4][tl] | ((unsigned)T[c8 + 5][tl] << 16); o.w = (unsigned)T[c8 + 6][tl] | ((unsigned)T[c8 + 7][tl] << 16);
    *(u32x4*)(MIX + ((size_t)b * TPB + CTXL + t0 + tl) * DM + 768 + c0 + c8) = o; }
  __syncthreads();
}
}

#define LAS __attribute__((address_space(3)))
#define XB_TMO      128
#define XB_XCNT(j)  (256  + 64 * (j))
#define XB_XSUB(j)  (1280 + 64 * (j))
#define XB_XGEN(j)  (2304 + 64 * (j))
#define XB_TOP      3328
#define XB_TOPGEN   3392
#define XCD_BAR_WORDS 3456
#define XB_SPIN_CAP (1u << 18)

__device__ __forceinline__ unsigned xb_ld(unsigned* p)              { return __hip_atomic_load(p, __ATOMIC_RELAXED, __HIP_MEMORY_SCOPE_AGENT); }
__device__ __forceinline__ unsigned xb_add(unsigned* p, unsigned v) { return __hip_atomic_fetch_add(p, v, __ATOMIC_RELAXED, __HIP_MEMORY_SCOPE_AGENT); }
__device__ __forceinline__ unsigned xb_xcc_id() { return (unsigned)__builtin_amdgcn_s_getreg((3 << 11) | 20) & 0xFu; }
#define XB_SPIN(cond, bar) do { unsigned _sp = 0; while (cond) { __builtin_amdgcn_s_sleep(1); \
    if ((++_sp & 255u) == 0u) { if (xb_ld(&(bar)[XB_TMO])) break; if (_sp > XB_SPIN_CAP) { atomicAdd(&(bar)[XB_TMO], 1u); break; } } } } while (0)

struct XcdBarrier {
    unsigned* bar; unsigned x;
    volatile LAS unsigned* st;
};

__device__ __forceinline__ XcdBarrier xcd_barrier_post(unsigned* bar, volatile LAS unsigned* st) {
    XcdBarrier b; b.bar = bar; b.x = xb_xcc_id(); b.st = st;
    if (threadIdx.x == 0) (void)xb_add(&bar[XB_XCNT(b.x)], 1u);
    return b;
}
__device__ __forceinline__ void xcd_barrier_complete(unsigned* bar, unsigned x, unsigned& nloc, unsigned& nx) {
    const unsigned G = gridDim.x * gridDim.y * gridDim.z;
    unsigned sum, cnt, mine, sp = 0u;
    for (;;) {
        sum = 0u; cnt = 0u; mine = 0u;
#pragma unroll
        for (unsigned j = 0; j < 16; ++j) { const unsigned c = xb_ld(&bar[XB_XCNT(j)]); sum += c; cnt += (c > 0u) ? 1u : 0u; mine = (j == x) ? c : mine; }
        if (sum == G) break;
        __builtin_amdgcn_s_sleep(1);
        if ((++sp & 255u) == 0u) { if (xb_ld(&bar[XB_TMO])) break; if (sp > XB_SPIN_CAP) { atomicAdd(&bar[XB_TMO], 1u); break; } }
    }
    nloc = mine > 0u ? mine : 1u; nx = cnt > 0u ? cnt : 1u;
}

__device__ __forceinline__ void xcd_barrier(const XcdBarrier& b) {
    asm volatile("s_waitcnt vmcnt(0)" ::: "memory");
    __syncthreads();
    if (threadIdx.x == 0) {
        unsigned* bar = b.bar;
        __builtin_amdgcn_s_waitcnt(0);
        unsigned nloc = b.st[0], nx = b.st[1];
        if (nloc == 0u) { xcd_barrier_complete(bar, b.x, nloc, nx); b.st[0] = nloc; b.st[1] = nx; }
        const unsigned old = xb_add(&bar[XB_XSUB(b.x)], 1u);
        const unsigned gen = old / nloc;
        if (old + 1u == (gen + 1u) * nloc) {
            __builtin_amdgcn_fence(__ATOMIC_RELEASE, "agent");
            asm volatile("s_waitcnt vmcnt(0)" ::: "memory");
            const unsigned og = xb_add(&bar[XB_TOP], 1u);
            const unsigned tg = og / nx;
            if (og + 1u == (tg + 1u) * nx) xb_add(&bar[XB_TOPGEN], 1u);
            else XB_SPIN(xb_ld(&bar[XB_TOPGEN]) == tg, bar);
            __builtin_amdgcn_fence(__ATOMIC_ACQUIRE, "agent");
            xb_add(&bar[XB_XGEN(b.x)], 1u);
            asm volatile("s_waitcnt vmcnt(0)" ::: "memory");
        } else {
            XB_SPIN(xb_ld(&bar[XB_XGEN(b.x)]) == gen, bar);
            __builtin_amdgcn_fence(__ATOMIC_ACQUIRE, "agent");
            asm volatile("s_waitcnt vmcnt(0)" ::: "memory");
        }
    }
    __syncthreads();
}


struct MP { const float* in[33]; float* out; unsigned char* ws; };
typedef const float* const __attribute__((address_space(4))) * kargs_t;
#define KARGS() ({ kargs_t k_ = (kargs_t)__builtin_amdgcn_kernarg_segment_ptr(); asm volatile("" : "+s"(k_)); k_; })
#define WSP(K, off) ((unsigned char*)(K)[34] + (off))

__global__ void __launch_bounds__(NT, 2) mega(MP P) {
  cg::grid_group grid = cg::this_grid();
  extern __shared__ __attribute__((aligned(16))) char lds[];
  volatile LAS unsigned* xst = (volatile LAS unsigned*)(lds + LDS_BYTES - 16);
  if (threadIdx.x < 2) xst[threadIdx.x] = 0u;
  __syncthreads();
  { kargs_t K = KARGS(); (void)xcd_barrier_post((unsigned*)WSP(K, WS_CTL) + CT_BAR, xst); }
#define XBAR_HERE() do { kargs_t Kb_ = KARGS(); XcdBarrier xb_; xb_.bar = (unsigned*)WSP(Kb_, WS_CTL) + CT_BAR; xb_.x = xb_xcc_id(); xb_.st = (volatile LAS unsigned*)(lds + LDS_BYTES - 16); xcd_barrier(xb_); } while (0)
#define SEAM() XBAR_HERE()
  {
    kargs_t K = KARGS();
    st_adaln(K[1], K[3], K[4], K[5], (float*)WSP(K, WS_MODV), lds);
    st_rope((float*)WSP(K, WS_ROPE));
  }
  {
      kargs_t K = KARGS();
      st_weights(K[8], K[26], K[29], K[30], K[31], 0, (bf16_t*)WSP(K, WS_WIN), (bf16_t*)WSP(K, WS_WOUT), (bf16_t*)WSP(K, WS_WGU), (bf16_t*)WSP(K, WS_WD), lds);
    }
    { kargs_t K = KARGS(); const int bid = BIDX, G = GDIM;
      for (int it = bid; it < SEQ / 16; it += G) hyfilt_item<SEQ>(it, K[19] + 0 * 33 * 64, K[20] + 0 * 64, K[21] + 0 * 64, K[22] + 0 * 4096, K[23] + 0 * 64, K[24] + (size_t)0 * 65536, (float*)WSP(K, WS_HK), lds);
      if (true) for (int it = bid; it < CTXL / 16; it += G) hyfilt_item<CTXL>(it, K[19] + 0 * 33 * 64, K[20] + 0 * 64, K[21] + 0 * 64, K[22] + 0 * 4096, K[23] + 0 * 64, K[24] + (size_t)0 * 65536, (float*)WSP(K, WS_HKC), lds);
    }
  if (gridDim.x == 0x7fffffffu) grid.sync();
  XBAR_HERE();
#pragma nounroll
  for (int layer = 0; layer < 2; ++layer) {
    const bool last = layer == 1;
    if (layer == 1) {
    {
      kargs_t K = KARGS();
      st_weights(K[8], K[26], K[29], K[30], K[31], layer, (bf16_t*)WSP(K, WS_WIN), (bf16_t*)WSP(K, WS_WOUT), (bf16_t*)WSP(K, WS_WGU), (bf16_t*)WSP(K, WS_WD), lds);
    }
    { kargs_t K = KARGS(); const int bid = BIDX, G = GDIM;
      for (int it = bid; it < SEQ / 16; it += G) hyfilt_item<SEQ>(it, K[19] + layer * 33 * 64, K[20] + layer * 64, K[21] + layer * 64, K[22] + layer * 4096, K[23] + layer * 64, K[24] + (size_t)layer * 65536, (float*)WSP(K, WS_HK), lds);
      if (!last) for (int it = bid; it < CTXL / 16; it += G) hyfilt_item<CTXL>(it, K[19] + layer * 33 * 64, K[20] + layer * 64, K[21] + layer * 64, K[22] + layer * 4096, K[23] + layer * 64, K[24] + (size_t)layer * 65536, (float*)WSP(K, WS_HKC), lds);
    }
    }
    { kargs_t K = KARGS();
      st_normmod(K[0], K[2], (bf16_t*)WSP(K, WS_H), layer == 0 ? (const bf16_t*)nullptr : (const bf16_t*)WSP(K, WS_H2S), (const int*)WSP(K, WS_MOEM + 768 * 1024),
                 (const float*)WSP(K, WS_MODV) + 5120, K[6] + layer * 1024, (const float*)WSP(K, WS_MODV) + (size_t)layer * 5 * 6144, 0, 1024, (bf16_t*)K[33], lds);
    }
    SEAM();
    {
      kargs_t K = KARGS();
      pg8::Gemm g{1024, 1024, 1024}; SchedDense S{MTOK / 256, NPAD / 256, (int)GDIM, BIDX, 0, (const char*)K[33], (const char*)WSP(K, WS_WIN), (size_t)256 * 1024 * 2, (size_t)256 * 1024 * 2, 0};
      EpiInProj E{(bf16_t*)WSP(K, WS_QK), (bf16_t*)WSP(K, WS_VZ), (bf16_t*)WSP(K, WS_XBC), (bf16_t*)WSP(K, WS_HY), (float*)WSP(K, WS_DT)};
      pg8::gemm_phase<EpiInProj, SchedDense, true, true>((PG8_LAS unsigned char*)lds, g, S, E);
      if (IN_HALF) { S.part = 1; pg8::gemm_phase<EpiInProj, SchedDense, true, true, true>((PG8_LAS unsigned char*)lds, g, S, E); }
    }
    SEAM();
    {
      kargs_t K = KARGS();
      st_prep_qk((bf16_t*)WSP(K, WS_QK), K[9] + layer * 64, K[10] + layer * 64, (const float*)WSP(K, WS_ROPE));
    }
    { kargs_t K = KARGS();
      st_prep_hy((const bf16_t*)WSP(K, WS_HY), K[17] + layer * 3 * 768, K[18] + layer * 768, (bf16_t*)WSP(K, WS_HYT), last ? 0 : 1, lds);
    }
    { kargs_t K = KARGS();
      st_ssd1(BIDX, GDIM, 4 * 34 * 6, (const bf16_t*)WSP(K, WS_XBC), (const float*)WSP(K, WS_DT), K[11] + layer * 3 * 640, K[12] + layer * 640, K[13] + layer * 12, K[14] + layer * 12,
              (bf16_t*)WSP(K, WS_Y), (bf16_t*)WSP(K, WS_ST), (float*)WSP(K, WS_DEC), lds);
    }
    SEAM();
    {
      { kargs_t K2 = KARGS(); st_ssd_scan2((bf16_t*)WSP(K2, WS_ST), (const float*)WSP(K2, WS_DEC)); }
      const int bid = BIDX, G = GDIM;
#define P4_ATT(bb, hq, qrow_, nt_) do { kargs_t K = KARGS(); const int kvh_ = (hq) / 3; \
          const attn_body::bf16* QKp = (const attn_body::bf16*)WSP(K, WS_QK); const attn_body::bf16* VZp = (const attn_body::bf16*)WSP(K, WS_VZ); \
          attn_body::attn_unit<8>(QKp + (size_t)(qrow_) * 512 + (hq) * 64, QKp + (size_t)(bb) * TPB * 512 + 384 + kvh_ * 64, VZp + (size_t)(bb) * TPB * 512 + kvh_ * 64, \
                                  (attn_body::bf16*)K[33] + (size_t)(qrow_) * 1024 + (hq) * 64, (nt_), lds); } while (0)
#define P4_FFT(cch) do { kargs_t K = KARGS(); hyf::item((cch), (const bf16_t*)WSP(K, WS_HYT), (const float*)WSP(K, WS_HK), K[25] + layer * 512, (bf16_t*)WSP(K, WS_HY), lds); } while (0)
#define P4_CHY(itm) do { kargs_t K = KARGS(); hyconv_ctx_item((itm), (const bf16_t*)WSP(K, WS_HYT) + (size_t)4 * 768 * SEQ, (const float*)WSP(K, WS_HKC), K[25] + layer * 512, (bf16_t*)K[33], lds); } while (0)
      {
        const int x = bid & 7, y = bid >> 3, bb = x >> 1, kvh = x & 1;
        const int nun = y < 16 ? 2 : 1, natt = nun + ((!last && y < 3) ? 1 : 0);
#pragma unroll 1
        for (int k = 0; k < natt; ++k) { int hq, qrow, nt;
          if (k < nun) { const int v = y < 16 ? y + 16 * k : 16 + y; hq = 3 * kvh + (v >> 4); qrow = bb * TPB + CTXL + (v & 15) * 256; nt = TPB / 64; }
          else { hq = 3 * kvh + y; qrow = bb * TPB; nt = CTXL / 64; }
          P4_ATT(bb, hq, qrow, nt); }
        if (y >= 16) {
#pragma unroll 1
          for (int k = 0; k < 2; ++k) { const int cch = ((y - 16) * 8 + x) * 2 + k; P4_FFT(cch); } }
        if (!last && y >= 3 && y < 11) { P4_CHY((y - 3) * 8 + x); }
      }
      (void)G;
#undef P4_ATT
#undef P4_FFT
#undef P4_CHY
    }
    SEAM();
    {
      kargs_t K = KARGS();
      { const int bid = BIDX, G = GDIM, nit = last ? 4 * 32 * 2 : 4 * 34 * 2;
        for (int it = bid; it < nit; it += G) { const int g = it & 1, bc = it >> 1; const int b = last ? bc >> 5 : bc / 34, cidx = last ? 2 + (bc & 31) : bc % 34;
          ssd3_item(b, cidx, g, (const bf16_t*)WSP(K, WS_XBC), (const bf16_t*)WSP(K, WS_VZ), (const float*)WSP(K, WS_DT), K[11] + layer * 3 * 640, K[12] + layer * 640, K[13] + layer * 12, K[14] + layer * 12,
                    K[15] + layer * 6, K[16] + layer * 384, (const bf16_t*)WSP(K, WS_Y), (const bf16_t*)WSP(K, WS_ST), (bf16_t*)K[33], lds); } }
      { const int bid = BIDX, G = GDIM; for (int it = bid; it < 1024; it += G) hyf::out_item(it, (const bf16_t*)WSP(K, WS_HY), (bf16_t*)K[33], lds); }
      const int t = TIDX; if (BIDX == 0 && t < 256) ((int*)WSP(K, WS_CTL))[t] = 0;
      { int* stok = (int*)WSP(K, WS_MOEM + 384 * 1024); for (int i = BIDX * NT + t; i < MOE_ROWS; i += GDIM * NT) stok[i] = -1; }
    }
    SEAM();
    {
      kargs_t K = KARGS();
      pg8::Gemm g{1024, 1024, 1024}; SchedDense S{last ? 64 : 68, 4, (int)GDIM, BIDX, last ? 1 : 0, (const char*)K[33], (const char*)WSP(K, WS_WOUT), (size_t)256 * 1024 * 2, (size_t)256 * 1024 * 2, 0};
      EpiOutProj E{(bf16_t*)WSP(K, WS_QK)};
      pg8::gemm_phase<EpiOutProj, SchedDense, true, true>((PG8_LAS unsigned char*)lds, g, S, E);
      S.part = 1; pg8::gemm_phase<EpiOutProj, SchedDense, true, true, true>((PG8_LAS unsigned char*)lds, g, S, E);
    }
    SEAM();
    {
      kargs_t K = KARGS();
      st_router(K[0], K[2], layer == 0 ? 1 : 0, (bf16_t*)WSP(K, WS_H), (const bf16_t*)WSP(K, WS_QK), K[7] + layer * 1024, (const float*)WSP(K, WS_MODV) + (size_t)layer * 5 * 6144, K[27], K[28], (bf16_t*)K[33], (int*)WSP(K, WS_CTL),
                (int*)WSP(K, WS_MOEM), (float*)WSP(K, WS_MOEM + 128 * 1024), last ? 1 : 0, lds);
    }
    SEAM();
    { kargs_t K = KARGS();
      st_moe_gather((const bf16_t*)K[33], (bf16_t*)WSP(K, WS_H2S), (int*)WSP(K, WS_CTL), (const int*)WSP(K, WS_MOEM), (const float*)WSP(K, WS_MOEM + 128 * 1024),
                    (int*)WSP(K, WS_MOEM + 384 * 1024), (float*)WSP(K, WS_MOEM + 512 * 1024), (int*)WSP(K, WS_MOEM + 768 * 1024), last ? 1 : 0, lds);
    }
    SEAM();
    { kargs_t K = KARGS();
      pg8::Gemm g{1024, 1024, 1024}; SchedMoe S{(int)GDIM, BIDX, 1, (const int*)WSP(K, WS_CTL), (const char*)WSP(K, WS_H2S), (size_t)256 * 1024 * 2, (const char*)WSP(K, WS_WGU), 0};
      EpiMoe1 E{(bf16_t*)WSP(K, WS_ACT), (const float*)WSP(K, WS_MOEM + 512 * 1024)};
      pg8::gemm_phase<EpiMoe1, SchedMoe, true, true>((PG8_LAS unsigned char*)lds, g, S, E);
      S.tail = 1; pg8::gemm_phase<EpiMoe1, SchedMoe, true, true, true>((PG8_LAS unsigned char*)lds, g, S, E);
    }
    SEAM();
    { kargs_t K = KARGS();
      pg8::Gemm g{256, 512, 256}; SchedMoe S{(int)GDIM, BIDX, 2, (const int*)WSP(K, WS_CTL), (const char*)WSP(K, WS_ACT), (size_t)256 * 512 * 2, (const char*)WSP(K, WS_WD), 0};
      EpiMoe2 E{(bf16_t*)WSP(K, WS_H2S)};
      pg8::gemm_phase<EpiMoe2, SchedMoe, true, true>((PG8_LAS unsigned char*)lds, g, S, E);
      S.tail = 1; pg8::gemm_phase<EpiMoe2, SchedMoe, true, true, true>((PG8_LAS unsigned char*)lds, g, S, E);
    }
    SEAM();
  }
  { kargs_t K = KARGS(); st_final((float*)K[33], K[32], (const bf16_t*)WSP(K, WS_H), (const bf16_t*)WSP(K, WS_H2S), (const int*)WSP(K, WS_MOEM + 768 * 1024), (const float*)WSP(K, WS_MODV) + (size_t)5 * 6144 + 5120); }
}

extern "C" void kernel_launch(void* const* d_in, const int* in_sizes, int n_in, void* d_out, int out_size, void* d_ws, size_t ws_size, hipStream_t stream) {
  if (n_in != 33 || ws_size < WS_END) { fprintf(stderr, "kernel_launch: unexpected n_in %d / ws %zu\n", n_in, ws_size); return; }
  static int grid_blocks = 0;
  if (!grid_blocks) {
    int dev = 0, cus = 0, per_cu = 0;
    (void)hipGetDevice(&dev);
    (void)hipDeviceGetAttribute(&cus, hipDeviceAttributeMultiprocessorCount, dev);
    (void)hipFuncSetAttribute((const void*)mega, hipFuncAttributeMaxDynamicSharedMemorySize, LDS_BYTES);
    (void)hipOccupancyMaxActiveBlocksPerMultiprocessor(&per_cu, mega, NT, LDS_BYTES);
    if (per_cu < 1) per_cu = 1;
    if (per_cu > 2) per_cu = 2;
    grid_blocks = 256;
    if (cus != 256 || per_cu < 1) fprintf(stderr, "kernel_launch: expected 256 CUs with >= 1 workgroup each (got %d CUs, %d per CU)\n", cus, per_cu);
  }
  (void)hipMemsetAsync((char*)d_ws + WS_CTL + (size_t)CT_BAR * 4, 0, (size_t)XCD_BAR_WORDS * 4, stream);
  MP p{};
  for (int i = 0; i < 33; ++i) p.in[i] = (const float*)d_in[i];
  p.out = (float*)d_out; p.ws = (unsigned char*)d_ws;
  void* args[] = {&p};
  hipError_t e = hipLaunchCooperativeKernel((const void*)mega, dim3(grid_blocks), dim3(NT), args, LDS_BYTES, stream);
  if (e != hipSuccess) fprintf(stderr, "cooperative launch failed: %s (grid %d)\n", hipGetErrorString(e), grid_blocks);
}
```

```cpp
#include <hip/hip_runtime.h>
#include <hip/hip_cooperative_groups.h>
#include <cstdio>
#include <cstdint>
namespace cg = cooperative_groups;

typedef unsigned short bf16_t;
typedef short bf16x8 __attribute__((ext_vector_type(8)));
typedef float f32x4 __attribute__((ext_vector_type(4)));
typedef unsigned u32x4 __attribute__((ext_vector_type(4)));
typedef unsigned u32x2 __attribute__((ext_vector_type(2)));

constexpr int NB = 4, SEQ = 4096, CTXL = 256, DM = 1024, TPB = 4352, MTOK = NB * TPB;
constexpr int DIN = 2444, NPAD = 2560;
constexpr float EPS = 1e-6f;
constexpr float C2 = 0.125f * 1.4426950408889634f;
constexpr int MOE_ROWS = 23552;
constexpr int NT = 512;
constexpr int LDS_BYTES = 147456;

constexpr size_t MiB = 1u << 20;
constexpr size_t WS_CTL = 0;
constexpr size_t WS_MODV = 1 * MiB;
constexpr size_t WS_ROPE = 2 * MiB;
constexpr size_t WS_MOEM = 3 * MiB;
constexpr size_t WS_DT = 4 * MiB;
constexpr size_t WS_HKC = 5 * MiB;
constexpr size_t WS_XC = 6 * MiB;
constexpr size_t WS_WIN = 10 * MiB;
constexpr size_t WS_WOUT = 15 * MiB;
constexpr size_t WS_WGU = 17 * MiB;
constexpr size_t WS_WD = 33 * MiB;
constexpr size_t WS_HK = 41 * MiB;
constexpr size_t WS_H = 57 * MiB;
constexpr size_t WS_QK = 91 * MiB;
constexpr size_t WS_VZ = 108 * MiB;
constexpr size_t WS_XBC = 125 * MiB;
constexpr size_t WS_HY = WS_XBC + (size_t)MTOK * 768 * 2;
constexpr size_t WS_HYT = WS_HY + (size_t)MTOK * 768 * 2;
constexpr size_t WS_ST = WS_HYT + (size_t)MTOK * 768 * 2;
constexpr size_t WS_Y = WS_ST + (size_t)4 * 34 * 2 * 6 * 4096 * 4;
constexpr size_t WS_END = WS_Y + (size_t)MTOK * 384 * 4;
constexpr size_t WS_DEC = WS_DT + 900 * 1024;
constexpr size_t WS_H2S = WS_QK;
constexpr size_t WS_ACT = WS_H2S + (size_t)MOE_ROWS * 1024 * 2;
static_assert(WS_END <= 256 * MiB, "ws");
static_assert(WS_ACT + (size_t)MOE_ROWS * 512 * 2 <= WS_HYT, "moe alias");

constexpr int CT_CNT = 0, CT_FILL = 32, CT_BASE = 64, CT_NT = 96, CT_TP = 128;
constexpr int CT_BAR = 4096;
constexpr bool IN_HALF = false;
constexpr int CT_CNTB = 8192;

__device__ __forceinline__ int opq_v(int v) { asm volatile("" : "+v"(v)); return v; }
__device__ __forceinline__ int opq_s(int v) { asm volatile("" : "+s"(v)); return v; }
#define TIDX opq_v((int)threadIdx.x)
#define BIDX opq_s((int)blockIdx.x)
#define GDIM opq_s((int)gridDim.x)
__device__ __forceinline__ unsigned f2bf(float f) { unsigned u = __float_as_uint(f); return (u + 0x7fffu + ((u >> 16) & 1u)) >> 16; }
__device__ __forceinline__ unsigned pk2bf(float lo, float hi) { return f2bf(lo) | (f2bf(hi) << 16); }
__device__ __forceinline__ float bf2f(bf16_t h) { return __uint_as_float(((unsigned)h) << 16); }
__device__ __forceinline__ float wave_sum(float v) {
#pragma unroll
  for (int o = 1; o < 64; o <<= 1) v += __shfl_xor(v, o);
  return v;
}
__device__ __forceinline__ float siluf(float v) { return v / (1.0f + __expf(-v)); }
__device__ __forceinline__ float* xrow(const float* xl, const float* xc, int r) {
  const int b = r / TPB, j = r - b * TPB;
  return (float*)(j < CTXL ? xc + ((size_t)b * CTXL + j) * DM : xl + ((size_t)b * SEQ + (j - CTXL)) * DM);
}
__device__ __forceinline__ int mrow_of(int r) { const int b = r / TPB, j = r - b * TPB; return j < CTXL ? 4 : b; }

__device__ __forceinline__ void st_adaln(const float* c, const float* c_ctx, const float* w_mod, const float* b_mod, float* modv, char* lds) {
  float (*sc)[1024] = (float (*)[1024])lds;
  float (*red)[5][64] = (float (*)[5][64])(lds + 5 * 1024 * 4);
  const int tid = TIDX;
  for (int it = BIDX; it < 192; it += GDIM) {
    const int layer = it / 96, n0 = (it % 96) * 64;
    for (int i = tid; i < 5 * 1024; i += NT) { const int r = i >> 10, k = i & 1023; const float v = r < 4 ? c[r * 1024 + k] : c_ctx[k]; sc[r][k] = v / (1.0f + expf(-v)); }
    __syncthreads();
    const int kg = tid >> 6, n = tid & 63;
    float acc[5] = {0.f, 0.f, 0.f, 0.f, 0.f};
#pragma unroll 16
    for (int k = kg; k < 1024; k += 8) { const float w = w_mod[((size_t)layer * 1024 + k) * 6144 + n0 + n];
#pragma unroll
      for (int r = 0; r < 5; ++r) acc[r] += sc[r][k] * w; }
#pragma unroll
    for (int r = 0; r < 5; ++r) red[kg][r][n] = acc[r];
    __syncthreads();
    if (tid < 320) { const int r = tid >> 6, nn = tid & 63; float s = 0.f;
#pragma unroll
      for (int g = 0; g < 8; ++g) s += red[g][r][nn];
      modv[((size_t)layer * 5 + r) * 6144 + n0 + nn] = s + b_mod[layer * 6144 + n0 + nn]; }
    __syncthreads();
  }
}
__device__ __forceinline__ void st_rope(float* rope) {
  for (int i = BIDX * NT + TIDX; i < 4096 * 32; i += GDIM * NT) {
    const int t = i >> 5, d = i & 31, m = d & 15;
    const float inv = exp2f(-(float)(2 * m) * (13.287712379549449f / 32.0f));
    const float pos = (float)(d < 16 ? (t >> 6) : (t & 63));
    float rev = pos * inv * 0.15915494309189535f; rev -= floorf(rev);
    rope[2 * i] = __builtin_amdgcn_cosf(rev); rope[2 * i + 1] = __builtin_amdgcn_sinf(rev);
  }
}

__device__ __forceinline__ void st_normmod(const float* xl, const float* xc, bf16_t* XB, const bf16_t* YS, const int* tok_slot, const float* gate_prev,
                                           const float* g, const float* modv_layer, int off_sh, int off_sc, bf16_t* H, char* lds) {
  float* mA = (float*)lds; float* mB = mA + 5 * 1024; float* mG = mB + 5 * 1024;
  const int tid = TIDX, lane = tid & 63, gw = BIDX * 8 + (tid >> 6), ngw = GDIM * 8;
  { f32x4 g4[3], sc4[3], sh4[3], gp4[3];
#pragma unroll
    for (int i = 0; i < 3; ++i) { const int q = tid + NT * i, qc = q < 1280 ? q : 0, m = qc >> 8, k = (qc & 255) * 4;
      g4[i] = *(const f32x4*)(g + k); sc4[i] = *(const f32x4*)(modv_layer + (size_t)m * 6144 + off_sc + k); sh4[i] = *(const f32x4*)(modv_layer + (size_t)m * 6144 + off_sh + k);
      gp4[i] = YS ? *(const f32x4*)(gate_prev + (size_t)m * 6144 + k) : (f32x4){0.f, 0.f, 0.f, 0.f}; }
#pragma unroll
    for (int i = 0; i < 3; ++i) { const int q = tid + NT * i;
      if (q < 1280) { *(f32x4*)(mA + 4 * q) = g4[i] * ((f32x4){1.f, 1.f, 1.f, 1.f} + sc4[i]); *(f32x4*)(mB + 4 * q) = sh4[i]; *(f32x4*)(mG + 4 * q) = gp4[i]; } } }
  __syncthreads();
  for (int rb = gw; rb < MTOK; rb += 3 * ngw) {
    f32x4 v[3][4]; float rstd[3];
    if (!YS) {
#pragma unroll
      for (int u = 0; u < 3; ++u) { const int r = rb + u * ngw, rc = r < MTOK ? r : MTOK - 1; const float* xr = xrow(xl, xc, rc);
#pragma unroll
        for (int j = 0; j < 4; ++j) v[u][j] = *(const f32x4*)(xr + 4 * lane + 256 * j); }
    } else {
      u32x2 xb[3][4], ys[3][4];
#pragma unroll
      for (int u = 0; u < 3; ++u) { const int r = rb + u * ngw, rc = r < MTOK ? r : MTOK - 1; const bf16_t* xr = XB + (size_t)rc * DM; const bf16_t* yr = YS + (size_t)tok_slot[rc] * DM;
#pragma unroll
        for (int j = 0; j < 4; ++j) { xb[u][j] = *(const u32x2*)(xr + 4 * lane + 256 * j); ys[u][j] = *(const u32x2*)(yr + 4 * lane + 256 * j); } }
#pragma unroll
      for (int u = 0; u < 3; ++u) { const int r = rb + u * ngw, rc = r < MTOK ? r : MTOK - 1; const int mo = mrow_of(rc) * 1024;
#pragma unroll
        for (int j = 0; j < 4; ++j) { const int k = 4 * lane + 256 * j; const f32x4 g4 = *(const f32x4*)(mG + mo + k);
          const f32x4 x4 = (f32x4){__uint_as_float(xb[u][j].x << 16), __uint_as_float(xb[u][j].x & 0xffff0000u), __uint_as_float(xb[u][j].y << 16), __uint_as_float(xb[u][j].y & 0xffff0000u)};
          const f32x4 m4 = (f32x4){__uint_as_float(ys[u][j].x << 16), __uint_as_float(ys[u][j].x & 0xffff0000u), __uint_as_float(ys[u][j].y << 16), __uint_as_float(ys[u][j].y & 0xffff0000u)};
          v[u][j] = x4 + g4 * m4;
          if (r < MTOK) { u32x2 w; w.x = pk2bf(v[u][j].x, v[u][j].y); w.y = pk2bf(v[u][j].z, v[u][j].w); *(u32x2*)(XB + (size_t)r * DM + k) = w; } } }
    }
#pragma unroll
    for (int u = 0; u < 3; ++u) { float ss = 0.f;
#pragma unroll
      for (int j = 0; j < 4; ++j) ss += v[u][j].x * v[u][j].x + v[u][j].y * v[u][j].y + v[u][j].z * v[u][j].z + v[u][j].w * v[u][j].w;
      rstd[u] = rsqrtf(wave_sum(ss) * (1.0f / DM) + EPS); }
#pragma unroll
    for (int u = 0; u < 3; ++u) { const int r = rb + u * ngw;
      if (r < MTOK) { const int mo = mrow_of(r) * 1024;
#pragma unroll
        for (int j = 0; j < 4; ++j) { const int k = 4 * lane + 256 * j;
          const f32x4 a4 = *(const f32x4*)(mA + mo + k), b4 = *(const f32x4*)(mB + mo + k); const f32x4 o = v[u][j] * rstd[u] * a4 + b4;
          u32x2 w; w.x = pk2bf(o.x, o.y); w.y = pk2bf(o.z, o.w);
          *(u32x2*)(H + (size_t)r * DM + k) = w; } } }
  }
  __syncthreads();
}

template <int MODE> __device__ __forceinline__ void tr_wave_item(const float* src, const float* src2, int ldsrc, int K, bf16_t* out, int n0, int k0, float* scr, int lane) {
  const int nn = lane & 31, n = n0 + nn;
#pragma unroll 8
  for (int i = 0; i < 32; ++i) { const int kk = 2 * i + (lane >> 5); float v = 0.f;
    if (MODE == 0) { const int col = n < 1676 ? n : (n < 1792 ? -1 : n - 116); if (col >= 0) v = src[(size_t)(k0 + kk) * ldsrc + col]; }
    else if (MODE == 1) v = src[(size_t)(k0 + kk) * ldsrc + n];
    else v = (n & 1) ? src2[(size_t)(k0 + kk) * ldsrc + (n >> 1)] : src[(size_t)(k0 + kk) * ldsrc + (n >> 1)];
    scr[kk * 33 + nn] = v; }
  asm volatile("s_waitcnt lgkmcnt(0)" ::: "memory");
  const int c = lane & 7;
#pragma unroll
  for (int j = 0; j < 4; ++j) { const int nr = (lane >> 3) + 8 * j; const float* sp = scr + (8 * c) * 33 + nr;
    u32x4 o; o.x = f2bf(sp[0]) | (f2bf(sp[33]) << 16); o.y = f2bf(sp[66]) | (f2bf(sp[99]) << 16); o.z = f2bf(sp[132]) | (f2bf(sp[165]) << 16); o.w = f2bf(sp[198]) | (f2bf(sp[231]) << 16);
    *(u32x4*)(out + (size_t)(n0 + nr) * K + k0 + 8 * c) = o; }
  asm volatile("s_waitcnt lgkmcnt(0)" ::: "memory");
}
__device__ __forceinline__ void st_weights(const float* w_in, const float* w_out, const float* w_gate, const float* w_up, const float* w_down, int layer,
                                           bf16_t* WIN, bf16_t* WOUT, bf16_t* WGU, bf16_t* WD, char* lds) {
  const int tid = TIDX, lane = tid & 63, w = tid >> 6; float* scr = (float*)lds + w * (64 * 33);
  for (int it = BIDX * 8 + w; it < 7936; it += GDIM * 8) {
    if (it < 1280) tr_wave_item<0>(w_in + (size_t)layer * 1024 * DIN, nullptr, DIN, 1024, WIN, (it % 80) * 32, (it / 80) * 64, scr, lane);
    else if (it < 1792) { const int i2 = it - 1280; tr_wave_item<1>(w_out + (size_t)layer * 1024 * 1024, nullptr, 1024, 1024, WOUT, (i2 & 31) * 32, (i2 >> 5) * 64, scr, lane); }
    else if (it < 5888) { const int i2 = it - 1792, e = i2 >> 8, t = i2 & 255;
      tr_wave_item<2>(w_gate + ((size_t)layer * 16 + e) * 1024 * 256, w_up + ((size_t)layer * 16 + e) * 1024 * 256, 256, 1024, WGU + (size_t)e * 512 * 1024, (t & 15) * 32, (t >> 4) * 64, scr, lane); }
    else { const int i2 = it - 5888, e = i2 >> 7, t = i2 & 127;
      tr_wave_item<1>(w_down + ((size_t)layer * 16 + e) * 256 * 1024, nullptr, 1024, 256, WD + (size_t)e * 1024 * 256, (t & 31) * 32, (t >> 5) * 64, scr, lane); }
  }
  __syncthreads();
}

__device__ __forceinline__ void pair_experts(int pidx, int& eA, int& eB) {
  const int g = pidx / 6, t = pidx - 6 * g; const int i = t < 3 ? 0 : (t < 5 ? 1 : 2); const int j = t < 3 ? t + 1 : (t < 5 ? t - 1 : 3);
  eA = 4 * g + i; eB = 4 * g + j;
}
__device__ __forceinline__ void st_prep_qk(bf16_t* QK, const float* qn, const float* kn, const float* rope) {
  const int lane = TIDX & 63, gw = BIDX * 8 + (TIDX >> 6), ngw = GDIM * 8, hh = lane >> 3, sub = lane & 7;
  float gn[8];
#pragma unroll
  for (int e = 0; e < 8; ++e) gn[e] = ((hh < 6 ? qn : kn) + sub * 8)[e] * (hh < 6 ? C2 : 1.0f);
  for (int rb = gw; rb < MTOK; rb += 3 * ngw) {
    bf16x8 raw[3]; f32x4 rp4[3][4];
#pragma unroll
    for (int u = 0; u < 3; ++u) { const int r = rb + u * ngw < MTOK ? rb + u * ngw : MTOK - 1; const int j = r % TPB, t = j >= CTXL ? j - CTXL : 0;
      raw[u] = *(const bf16x8*)(QK + (size_t)r * 512 + hh * 64 + sub * 8);
      const float* rp = rope + ((size_t)t * 32 + (sub & 3) * 8) * 2;
#pragma unroll
      for (int q = 0; q < 4; ++q) rp4[u][q] = *(const f32x4*)(rp + 4 * q); }
#pragma unroll
    for (int u = 0; u < 3; ++u) { const int r = rb + u * ngw; const int j = (r < MTOK ? r : MTOK - 1) % TPB;
      float v[8]; float ss = 0.f;
#pragma unroll
      for (int e = 0; e < 8; ++e) { v[e] = bf2f((bf16_t)raw[u][e]); ss += v[e] * v[e]; }
      ss += __shfl_xor(ss, 1); ss += __shfl_xor(ss, 2); ss += __shfl_xor(ss, 4);
      const float rstd = rsqrtf(ss * (1.0f / 64.0f) + EPS);
#pragma unroll
      for (int e = 0; e < 8; ++e) v[e] = v[e] * rstd * gn[e];
      if (j >= CTXL) {
#pragma unroll
        for (int e = 0; e < 8; ++e) { const float other = __shfl_xor(v[e], 4); const float cs = rp4[u][e >> 1][(e & 1) * 2], sn = rp4[u][e >> 1][(e & 1) * 2 + 1]; v[e] = sub < 4 ? v[e] * cs - other * sn : v[e] * cs + other * sn; } }
      if (r < MTOK) *(u32x4*)(QK + (size_t)r * 512 + hh * 64 + sub * 8) = (u32x4){pk2bf(v[0], v[1]), pk2bf(v[2], v[3]), pk2bf(v[4], v[5]), pk2bf(v[6], v[7])}; }
  }
}

__device__ __forceinline__ void st_prep_hy(const bf16_t* HY, const float* cw, const float* cb, bf16_t* HYT, int do_ctx, char* lds) {
  const int tid = TIDX, lane = tid & 63, w = tid >> 6; float* tile = (float*)lds + w * (66 * 33);
  const int nlat = 4 * 64 * 24, nitem = nlat + (do_ctx ? 4 * 4 * 24 : 0), step = (GDIM - 48) * 8;
  bf16x8 raw[5];
#define PHY_DECODE(it) int b, tt, ct, L, joff; bf16_t* outb; \
    if ((it) < nlat) { b = (it) / 1536; tt = ((it) % 1536) / 24; ct = (it) % 24; L = SEQ; joff = CTXL; outb = HYT + (size_t)b * 768 * SEQ; } \
    else { const int i2 = (it) - nlat; b = i2 / 96; tt = (i2 % 96) / 24; ct = i2 % 24; L = CTXL; joff = 0; outb = HYT + (size_t)4 * 768 * SEQ + (size_t)b * 768 * CTXL; } \
    const int t0 = tt * 64, c0 = ct * 32; (void)outb;
#define PHY_LOADS(it) do { PHY_DECODE(it) _Pragma("unroll") for (int i = 0; i < 5; ++i) { const int rr = (lane >> 2) + 16 * i, c8 = (lane & 3) * 8; int t = t0 - 1 + rr; const bool ok = rr < 66 && t >= 0 && t < L; t = ok ? t : t0; \
      const bf16x8 v = *(const bf16x8*)(HY + ((size_t)b * TPB + joff + t) * 768 + c0 + c8); raw[i] = ok ? v : (bf16x8){0, 0, 0, 0, 0, 0, 0, 0}; } } while (0)
  int it = BIDX >= 48 ? (BIDX - 48) * 8 + w : nitem;
  if (it < nitem) PHY_LOADS(it);
  for (; it < nitem; it += step) {
    PHY_DECODE(it)
#pragma unroll
    for (int i = 0; i < 5; ++i) { const int rr = (lane >> 2) + 16 * i, c8 = (lane & 3) * 8;
      if (rr < 66) {
#pragma unroll
        for (int e = 0; e < 8; ++e) tile[rr * 33 + c8 + e] = bf2f((bf16_t)raw[i][e]); } }
    asm volatile("s_waitcnt lgkmcnt(0)" ::: "memory");
    if (it + step < nitem) PHY_LOADS(it + step);
#pragma unroll 4
    for (int cc = 0; cc < 32; ++cc) { const int c = c0 + cc;
      const float v = cw[c] * tile[lane * 33 + cc] + cw[768 + c] * tile[(lane + 1) * 33 + cc] + cw[1536 + c] * tile[(lane + 2) * 33 + cc] + cb[c];
      outb[(size_t)c * L + t0 + lane] = (bf16_t)f2bf(v); }
    asm volatile("s_waitcnt lgkmcnt(0)" ::: "memory");
  }
#undef PHY_LOADS
#undef PHY_DECODE
  __syncthreads();
}

template <int L> __device__ __forceinline__ void hyfilt_item(int item, const float* w1, const float* b1, const float* fr, const float* w2, const float* b2, const float* w3, float* HK, char* lds) {
  float* F = (float*)lds; float* W1 = F + 64 * 37; float* H1 = W1 + 36 * 68; float* W2 = H1 + 64 * 68; float* S1 = W2 + 64 * 68;
  const int tid = TIDX, n0 = (item >> 2) * 64, cq = item & 3, lane = tid & 63, wv = tid >> 6, l15 = lane & 15, l4 = lane >> 4;
  for (int e = tid; e < 64 * 36; e += NT) { const int pp = e / 36, f = e % 36; const int n = n0 + pp; float v = 0.f;
    if (f == 0) v = (float)n / (float)(L - 1);
    else if (f < 33) { const int m = (f - 1) & 15; const float band = 1e-4f + (float)m * ((15.0f - 1e-4f) / 15.0f); float rev = ((float)n * (1.0f / (float)L)) * band; rev -= floorf(rev);
      v = f <= 16 ? __builtin_amdgcn_cosf(rev) : -__builtin_amdgcn_sinf(rev); }
    F[pp * 37 + f] = v; }
  for (int e = tid; e < 36 * 64; e += NT) { const int k = e >> 6, j = e & 63; W1[k * 68 + j] = k < 33 ? w1[k * 64 + j] : 0.f; }
  for (int e = tid; e < 64 * 64; e += NT) { const int k = e >> 6, j = e & 63; W2[k * 68 + j] = w2[e]; }
  __syncthreads();
  { const int pt = wv >> 1, c0 = 32 * (wv & 1);
    f32x4 acc[2] = {(f32x4){0.f, 0.f, 0.f, 0.f}, (f32x4){0.f, 0.f, 0.f, 0.f}};
#pragma unroll
    for (int kk = 0; kk < 9; ++kk) { const float av = F[(pt * 16 + l15) * 37 + 4 * kk + l4];
      acc[0] = __builtin_amdgcn_mfma_f32_16x16x4f32(av, W1[(4 * kk + l4) * 68 + c0 + l15], acc[0], 0, 0, 0);
      acc[1] = __builtin_amdgcn_mfma_f32_16x16x4f32(av, W1[(4 * kk + l4) * 68 + c0 + 16 + l15], acc[1], 0, 0, 0); }
#pragma unroll
    for (int ct = 0; ct < 2; ++ct) { const int j = c0 + 16 * ct + l15; const float bj = b1[j], fj = fr[j] * 0.15915494309189535f;
#pragma unroll
      for (int rg = 0; rg < 4; ++rg) { float rev = fj * (acc[ct][rg] + bj); rev -= floorf(rev); H1[(pt * 16 + 4 * l4 + rg) * 68 + j] = __builtin_amdgcn_sinf(rev); } } }
  __syncthreads();
  { const int pt = wv >> 1, c0 = 32 * (wv & 1);
    f32x4 acc[2] = {(f32x4){0.f, 0.f, 0.f, 0.f}, (f32x4){0.f, 0.f, 0.f, 0.f}};
#pragma unroll
    for (int kk = 0; kk < 16; ++kk) { const float av = H1[(pt * 16 + l15) * 68 + 4 * kk + l4];
      acc[0] = __builtin_amdgcn_mfma_f32_16x16x4f32(av, W2[(4 * kk + l4) * 68 + c0 + l15], acc[0], 0, 0, 0);
      acc[1] = __builtin_amdgcn_mfma_f32_16x16x4f32(av, W2[(4 * kk + l4) * 68 + c0 + 16 + l15], acc[1], 0, 0, 0); }
#pragma unroll
    for (int ct = 0; ct < 2; ++ct) { const int j = c0 + 16 * ct + l15; const float bj = b2[j], fj = fr[j] * 0.15915494309189535f;
#pragma unroll
      for (int rg = 0; rg < 4; ++rg) { float rev = fj * (acc[ct][rg] + bj); rev -= floorf(rev); S1[(pt * 16 + 4 * l4 + rg) * 68 + j] = __builtin_amdgcn_sinf(rev); } } }
  __syncthreads();
  {
    const int colb = cq * 256 + 32 * wv;
    f32x4 acc[4][2];
#pragma unroll
    for (int pt = 0; pt < 4; ++pt) { acc[pt][0] = (f32x4){0.f, 0.f, 0.f, 0.f}; acc[pt][1] = (f32x4){0.f, 0.f, 0.f, 0.f}; }
#pragma unroll 4
    for (int kk = 0; kk < 16; ++kk) { const int k = 4 * kk + l4;
      const float bv0 = w3[k * 1024 + colb + l15], bv1 = w3[k * 1024 + colb + 16 + l15];
#pragma unroll
      for (int pt = 0; pt < 4; ++pt) { const float av = S1[(pt * 16 + l15) * 68 + k];
        acc[pt][0] = __builtin_amdgcn_mfma_f32_16x16x4f32(av, bv0, acc[pt][0], 0, 0, 0);
        acc[pt][1] = __builtin_amdgcn_mfma_f32_16x16x4f32(av, bv1, acc[pt][1], 0, 0, 0); } }
#pragma unroll
    for (int ct = 0; ct < 2; ++ct) { const int col = colb + 16 * ct + l15, dir = col >> 9, order = (col >> 8) & 1, c = col & 255;
      const float delta = 3.0701134573253943f + (float)c * ((15.350567286626972f - 3.0701134573253943f) / 255.0f);
      float* dst = HK + ((size_t)order * 256 + c) * (2 * L);
#pragma unroll
      for (int pt = 0; pt < 4; ++pt) { const int nb = n0 + pt * 16 + 4 * l4; f32x4 o;
#pragma unroll
        for (int rg = 0; rg < 4; ++rg) o[rg] = acc[pt][ct][rg] * __expf(-((float)(nb + rg) / (float)(L - 1)) * delta);
        if (dir == 0) *(f32x4*)(dst + nb) = o;
        else {
#pragma unroll
          for (int rg = 0; rg < 4; ++rg) { const int n = nb + rg; if (n >= 1) dst[2 * L - n] = o[rg]; else dst[L] = 0.f; } } } }
  }
  __syncthreads();
}

__device__ __forceinline__ void hyconv_ctx_item(int item, const bf16_t* HYTC, const float* HKC, const float* hy_bias, bf16_t* MIX, char* lds) {
  constexpr int L = CTXL;
  const int tid = TIDX, b = item >> 4, cc = tid >> 5, c = (item & 15) * 16 + cc, sub = tid & 31, tb = 8 * sub;
  float* kern = (float*)lds + cc * (2 * L); float* z = (float*)lds + 16 * 2 * L + cc * L;
  const bf16_t* vp = HYTC + ((size_t)b * 768 + c) * L; const bf16_t* x1p = vp + (size_t)256 * L; const bf16_t* x2p = vp + (size_t)512 * L;
#pragma unroll 1
  for (int o = 0; o < 2; ++o) {
    if (o == 0) for (int t = sub; t < L; t += 32) z[t] = bf2f(vp[t]);
    const float* kp = HKC + ((size_t)o * 256 + c) * (2 * L);
    for (int t = sub; t < 2 * L; t += 32) kern[t] = kp[t];
    __syncthreads();
    float acc[8], W[16];
#pragma unroll
    for (int i = 0; i < 8; ++i) { acc[i] = 0.f; W[8 + i] = kern[(tb + i) & (2 * L - 1)]; }
    for (int s0 = 0; s0 < L; s0 += 8) {
      const int bb = (tb - s0 - 8) & (2 * L - 1);
#pragma unroll
      for (int i = 0; i < 8; ++i) W[i] = kern[bb + i];
      float zs[8];
#pragma unroll
      for (int j = 0; j < 8; ++j) zs[j] = z[s0 + j];
#pragma unroll
      for (int j = 0; j < 8; ++j)
#pragma unroll
        for (int i = 0; i < 8; ++i) acc[i] += W[8 + i - j] * zs[j];
#pragma unroll
      for (int i = 0; i < 8; ++i) W[8 + i] = W[i];
    }
    __syncthreads();
    const float bias = hy_bias[o * 256 + c];
#pragma unroll
    for (int i = 0; i < 8; ++i) { const int t = tb + i; const float zz = acc[i] + bias * z[t];
      if (o == 0) z[t] = bf2f(x1p[t]) * zz;
      else MIX[((size_t)b * TPB + t) * DM + 768 + c] = (bf16_t)f2bf(bf2f(x2p[t]) * zz); }
    __syncthreads();
  }
}

__device__ __forceinline__ void ssd_conv8(const bf16_t* XBC, size_t r, int c0, bool hasp, bool hasn, const float* cw, const float* cb, float (&o)[8]) {
  const bf16x8 cur = *(const bf16x8*)(XBC + r * 768 + c0);
  const bf16x8 prv = *(const bf16x8*)(XBC + (hasp ? r - 1 : r) * 768 + c0), nxt = *(const bf16x8*)(XBC + (hasn ? r + 1 : r) * 768 + c0);
  const float wp = hasp ? 1.f : 0.f, wn = hasn ? 1.f : 0.f;
#pragma unroll
  for (int e = 0; e < 8; ++e) { const float v = wp * cw[c0 + e] * bf2f((bf16_t)prv[e]) + cw[640 + c0 + e] * bf2f((bf16_t)cur[e]) + wn * cw[1280 + c0 + e] * bf2f((bf16_t)nxt[e]) + cb[c0 + e]; o[e] = siluf(v); }
}
__device__ __forceinline__ float softplusf(float x) {
  const float y = __expf(-fabsf(x)); const float l = y < 0.06f ? y * (1.f - y * (0.5f - y * (0.33333334f - 0.25f * y))) : __logf(1.f + y); return fmaxf(x, 0.f) + l; }
__device__ __forceinline__ void wave_scan128(float e0, float e1, int lane, float& c0, float& c1) {
  float x = e0 + e1;
#pragma unroll
  for (int o = 1; o < 64; o <<= 1) { const float v = __shfl_up(x, o); if (lane >= o) x += v; }
  const float excl = x - (e0 + e1); c0 = excl + e0; c1 = excl + e0 + e1;
}
__device__ __forceinline__ int ssd_chunk_j0(int cidx) { return cidx < 2 ? cidx * 128 : CTXL + (cidx - 2) * 128; }

__device__ __forceinline__ void st_ssd1(int it0, int step, int nitems, const bf16_t* XBC, const float* DT, const float* cw, const float* cb, const float* dt_bias, const float* a_log,
                                        bf16_t* YIN, bf16_t* ST, float* DEC, char* lds) {
  bf16_t (*Cm)[72] = (bf16_t (*)[72])lds; bf16_t (*Bm)[72] = (bf16_t (*)[72])(lds + 18432);
  bf16_t (*BT)[136] = (bf16_t (*)[136])(lds + 36864); bf16_t (*Xt)[136] = (bf16_t (*)[136])(lds + 54272); bf16_t (*Mm)[136] = (bf16_t (*)[136])(lds + 71680);
  float* tab = (float*)(lds + 106496); float* dtf = tab; float* dtb = tab + 128; float* acf = tab + 256; float* acb = tab + 384; float* wf = tab + 512; float* wb = tab + 640;
  const int tid = TIDX;
  bf16x8 cu[6], pv[6], nx[6];
#define SSD1_LOADS(itm, I0, I1) do { const int h_ = (itm) % 6, bc_ = (itm) / 6, cidx_ = bc_ % 34, b_ = bc_ / 34, g_ = h_ / 3, j0_ = ssd_chunk_j0(cidx_); const size_t r0_ = (size_t)b_ * TPB + j0_; \
    _Pragma("unroll") for (int i = (I0); i < (I1); ++i) { const int task = tid + NT * i, t = task / 24, cg = task % 24, kind = cg >> 3, q = cg & 7, j = j0_ + t; \
      const int c0 = kind == 0 ? h_ * 64 + 8 * q : (kind == 1 ? 384 + g_ * 64 + 8 * q : 512 + g_ * 64 + 8 * q); \
      const bool hasp = j != 0 && j != CTXL, hasn = j != CTXL - 1 && j != TPB - 1; const bf16_t* p = XBC + (r0_ + t) * 768 + c0; \
      cu[i] = *(const bf16x8*)p; pv[i] = *(const bf16x8*)(p + (hasp ? -768 : 0)); nx[i] = *(const bf16x8*)(p + (hasn ? 768 : 0)); } } while (0)
  if (it0 < nitems) SSD1_LOADS(it0, 0, 6);
#pragma unroll 1
  for (int item = it0; item < nitems; item += step) {
  const int tid = TIDX, lane = tid & 63, w = tid >> 6, l15 = lane & 15, l4 = lane >> 4;
  const int h = item % 6, bc = item / 6, cidx = bc % 34, b = bc / 34, g = h / 3, j0 = ssd_chunk_j0(cidx);
  const size_t r0 = (size_t)b * TPB + j0;
  float dtr0 = 0.f, dtr1 = 0.f;
  if (w < 2) { const int t0 = w == 0 ? 2 * lane : 127 - 2 * lane, t1 = w == 0 ? 2 * lane + 1 : 126 - 2 * lane; dtr0 = DT[(r0 + t0) * 12 + w * 6 + h]; dtr1 = DT[(r0 + t1) * 12 + w * 6 + h]; }
  SSD1_LOADS(item, 6, 6);
  {
#pragma unroll
    for (int i = 0; i < 6; ++i) { const int task = tid + NT * i, t = task / 24, cg = task % 24, kind = cg >> 3, q = cg & 7, j = j0 + t;
      const int c0 = kind == 0 ? h * 64 + 8 * q : (kind == 1 ? 384 + g * 64 + 8 * q : 512 + g * 64 + 8 * q);
      const float wp = (j != 0 && j != CTXL) ? 1.f : 0.f, wn = (j != CTXL - 1 && j != TPB - 1) ? 1.f : 0.f;
      float o[8];
#pragma unroll
      for (int e = 0; e < 8; ++e) o[e] = siluf(wp * cw[c0 + e] * bf2f((bf16_t)pv[i][e]) + cw[640 + c0 + e] * bf2f((bf16_t)cu[i][e]) + wn * cw[1280 + c0 + e] * bf2f((bf16_t)nx[i][e]) + cb[c0 + e]);
      if (kind == 0) {
#pragma unroll
        for (int e = 0; e < 8; ++e) Xt[8 * q + e][t] = (bf16_t)f2bf(o[e]);
      } else { const u32x4 pk = (u32x4){pk2bf(o[0], o[1]), pk2bf(o[2], o[3]), pk2bf(o[4], o[5]), pk2bf(o[6], o[7])};
        if (kind == 1) { *(u32x4*)&Bm[t][8 * q] = pk;
#pragma unroll
          for (int e = 0; e < 8; ++e) BT[8 * q + e][t] = (bf16_t)f2bf(o[e]); }
        else *(u32x4*)&Cm[t][8 * q] = pk; } }
  }
  if (w < 2) { const int dir = w; const float a = -expf(a_log[dir * 6 + h]), bias = dt_bias[dir * 6 + h];
    const int t0 = dir == 0 ? 2 * lane : 127 - 2 * lane, t1 = dir == 0 ? 2 * lane + 1 : 126 - 2 * lane;
    const float d0 = softplusf(dtr0 + bias), d1 = softplusf(dtr1 + bias);
    float c0, c1; wave_scan128(d0 * a, d1 * a, lane, c0, c1);
    const float tot = __shfl(c1, 63);
    float* dtt = dir == 0 ? dtf : dtb; float* ac = dir == 0 ? acf : acb; float* ww = dir == 0 ? wf : wb;
    dtt[t0] = d0; dtt[t1] = d1; ac[t0] = c0; ac[t1] = c1; ww[t0] = __expf(tot - c0) * d0; ww[t1] = __expf(tot - c1) * d1;
    if (lane == 0) DEC[(((size_t)b * 34 + cidx) * 2 + dir) * 6 + h] = __expf(tot); }
  __syncthreads();
  if (item + step < nitems) SSD1_LOADS(item + step, 0, 6);
  {
    f32x4 accG[8];
#pragma unroll
    for (int ni = 0; ni < 8; ++ni) accG[ni] = (f32x4){0.f, 0.f, 0.f, 0.f};
#pragma unroll
    for (int kk = 0; kk < 2; ++kk) { const bf16x8 a = *(const bf16x8*)&Cm[16 * w + l15][32 * kk + 8 * l4];
#pragma unroll
      for (int ni = 0; ni < 8; ++ni) { const bf16x8 bb = *(const bf16x8*)&Bm[16 * ni + l15][32 * kk + 8 * l4]; accG[ni] = __builtin_amdgcn_mfma_f32_16x16x32_bf16(a, bb, accG[ni], 0, 0, 0); } }
    float aft[4], abt[4];
#pragma unroll
    for (int rg = 0; rg < 4; ++rg) { aft[rg] = acf[16 * w + 4 * l4 + rg]; abt[rg] = acb[16 * w + 4 * l4 + rg]; }
#pragma unroll
    for (int ni = 0; ni < 8; ++ni) { const int sidx = 16 * ni + l15; const float afs = acf[sidx], abs_ = acb[sidx], dfs = dtf[sidx], dbs = dtb[sidx];
#pragma unroll
      for (int rg = 0; rg < 4; ++rg) { const int t = 16 * w + 4 * l4 + rg;
        const float f = sidx <= t ? __expf(aft[rg] - afs) * dfs : 0.f, bk = sidx >= t ? __expf(abt[rg] - abs_) * dbs : 0.f;
        Mm[t][sidx] = (bf16_t)f2bf(accG[ni][rg] * (f + bk)); } }
  }
  __syncthreads();
  {
    f32x4 acc[4];
#pragma unroll
    for (int ni = 0; ni < 4; ++ni) acc[ni] = (f32x4){0.f, 0.f, 0.f, 0.f};
#pragma unroll
    for (int kk = 0; kk < 4; ++kk) { const bf16x8 a = *(const bf16x8*)&Mm[16 * w + l15][32 * kk + 8 * l4];
#pragma unroll
      for (int ni = 0; ni < 4; ++ni) { const bf16x8 bb = *(const bf16x8*)&Xt[16 * ni + l15][32 * kk + 8 * l4]; acc[ni] = __builtin_amdgcn_mfma_f32_16x16x32_bf16(a, bb, acc[ni], 0, 0, 0); } }
#pragma unroll
    for (int rg = 0; rg < 4; ++rg)
#pragma unroll
      for (int ni = 0; ni < 4; ++ni) YIN[(r0 + 16 * w + 4 * l4 + rg) * 384 + h * 64 + 16 * ni + l15] = (bf16_t)f2bf(acc[ni][rg]);
  }
  {
    const int dir = w >> 2, mt = w & 3; const float* ww = dir == 0 ? wf : wb;
    f32x4 acc[4];
#pragma unroll
    for (int ni = 0; ni < 4; ++ni) acc[ni] = (f32x4){0.f, 0.f, 0.f, 0.f};
#pragma unroll
    for (int kk = 0; kk < 4; ++kk) { const bf16x8 raw = *(const bf16x8*)&Xt[16 * mt + l15][32 * kk + 8 * l4];
      const f32x4 w0 = *(const f32x4*)(ww + 32 * kk + 8 * l4), w1 = *(const f32x4*)(ww + 32 * kk + 8 * l4 + 4);
      u32x4 pk; pk.x = pk2bf(bf2f((bf16_t)raw[0]) * w0.x, bf2f((bf16_t)raw[1]) * w0.y); pk.y = pk2bf(bf2f((bf16_t)raw[2]) * w0.z, bf2f((bf16_t)raw[3]) * w0.w);
      pk.z = pk2bf(bf2f((bf16_t)raw[4]) * w1.x, bf2f((bf16_t)raw[5]) * w1.y); pk.w = pk2bf(bf2f((bf16_t)raw[6]) * w1.z, bf2f((bf16_t)raw[7]) * w1.w);
      const bf16x8 a = __builtin_bit_cast(bf16x8, pk);
#pragma unroll
      for (int ni = 0; ni < 4; ++ni) { const bf16x8 bb = *(const bf16x8*)&BT[16 * ni + l15][32 * kk + 8 * l4]; acc[ni] = __builtin_amdgcn_mfma_f32_16x16x32_bf16(a, bb, acc[ni], 0, 0, 0); } }
    bf16_t* sp = ST + ((((size_t)b * 34 + cidx) * 2 + dir) * 6 + h) * 4096;
#pragma unroll
    for (int rg = 0; rg < 4; ++rg)
#pragma unroll
      for (int ni = 0; ni < 4; ++ni) sp[(16 * mt + 4 * l4 + rg) * 64 + 16 * ni + l15] = (bf16_t)f2bf(acc[ni][rg]);
  }
  __syncthreads();
  }
#undef SSD1_LOADS
}

__device__ __forceinline__ void st_ssd_scan2(bf16_t* ST, const float* DEC) {
  for (int idx = BIDX * NT + TIDX; idx < 4 * 2 * 6 * 2048; idx += GDIM * NT) {
    const int e = (idx & 2047) * 2, bdh = idx >> 11, h = bdh % 6, dir = (bdh / 6) & 1, b = bdh / 12;
    unsigned v[34]; float d[34];
#pragma unroll
    for (int st = 0; st < 34; ++st) { const int cidx = dir == 0 ? st : (st < 2 ? 1 - st : 35 - st); const size_t o = (((size_t)b * 34 + cidx) * 2 + dir) * 6 + h; v[st] = *(const unsigned*)(ST + o * 4096 + e); d[st] = DEC[o]; }
    float H0 = 0.f, H1 = 0.f;
#pragma unroll
    for (int st = 0; st < 34; ++st) { const int cidx = dir == 0 ? st : (st < 2 ? 1 - st : 35 - st); const size_t o = (((size_t)b * 34 + cidx) * 2 + dir) * 6 + h;
      *(unsigned*)(ST + o * 4096 + e) = pk2bf(H0, H1); H0 = H0 * d[st] + __uint_as_float(v[st] << 16); H1 = H1 * d[st] + __uint_as_float(v[st] & 0xffff0000u); }
  }
}

__device__ __forceinline__ void ssd3_item(int b, int cidx, int g, const bf16_t* XBC, const bf16_t* VZ, const float* DT, const float* cw, const float* cb, const float* dt_bias, const float* a_log,
                                          const float* dskip, const float* nw, const bf16_t* YIN, const bf16_t* ST, bf16_t* MIX, char* lds) {
  bf16_t (*Cm)[72] = (bf16_t (*)[72])lds; bf16_t (*Hm)[72] = (bf16_t (*)[72])(lds + 18432);
  float* ef = (float*)(lds + 18432 + 55296);
  float (*Yt)[196] = (float (*)[196])lds;
  const int tid = TIDX, lane = tid & 63, w = tid >> 6, l15 = lane & 15, l4 = lane >> 4, j0 = ssd_chunk_j0(cidx);
  const size_t r0 = (size_t)b * TPB + j0;
#pragma unroll
  for (int i = 0; i < 2; ++i) { const int task = tid + NT * i, t = task >> 3, q = task & 7, j = j0 + t;
    float o[8]; ssd_conv8(XBC, r0 + t, 512 + g * 64 + 8 * q, j != 0 && j != CTXL, j != CTXL - 1 && j != TPB - 1, cw, cb, o);
    *(u32x4*)&Cm[t][8 * q] = (u32x4){pk2bf(o[0], o[1]), pk2bf(o[2], o[3]), pk2bf(o[4], o[5]), pk2bf(o[6], o[7])}; }
#pragma unroll
  for (int i = 0; i < 6; ++i) { const int f8 = tid + NT * i, hd = f8 >> 9, rem = f8 & 511, p = rem >> 3, n8 = (rem & 7) * 8, hh = hd >> 1, dir = hd & 1;
    *(u32x4*)&Hm[hd * 64 + p][n8] = *(const u32x4*)(ST + ((((size_t)b * 34 + cidx) * 2 + dir) * 6 + 3 * g + hh) * 4096 + p * 64 + n8); }
  if (w < 6) { const int hh = w >> 1, dir = w & 1, h = 3 * g + hh; const float a = -expf(a_log[dir * 6 + h]), bias = dt_bias[dir * 6 + h];
    const int t0 = dir == 0 ? 2 * lane : 127 - 2 * lane, t1 = dir == 0 ? 2 * lane + 1 : 126 - 2 * lane;
    const float d0 = softplusf(DT[(r0 + t0) * 12 + dir * 6 + h] + bias), d1 = softplusf(DT[(r0 + t1) * 12 + dir * 6 + h] + bias);
    float c0, c1; wave_scan128(d0 * a, d1 * a, lane, c0, c1);
    ef[w * 128 + t0] = __expf(c0); ef[w * 128 + t1] = __expf(c1); }
  __syncthreads();
  float yv[3][4][4];
  {
    bf16x8 ca[2];
#pragma unroll
    for (int kk = 0; kk < 2; ++kk) ca[kk] = *(const bf16x8*)&Cm[16 * w + l15][32 * kk + 8 * l4];
#pragma unroll
    for (int hh = 0; hh < 3; ++hh) {
      f32x4 accF[4], accB[4];
#pragma unroll
      for (int ni = 0; ni < 4; ++ni) { accF[ni] = (f32x4){0.f, 0.f, 0.f, 0.f}; accB[ni] = (f32x4){0.f, 0.f, 0.f, 0.f}; }
#pragma unroll
      for (int kk = 0; kk < 2; ++kk)
#pragma unroll
        for (int ni = 0; ni < 4; ++ni) {
          accF[ni] = __builtin_amdgcn_mfma_f32_16x16x32_bf16(ca[kk], *(const bf16x8*)&Hm[(hh * 2 + 0) * 64 + 16 * ni + l15][32 * kk + 8 * l4], accF[ni], 0, 0, 0);
          accB[ni] = __builtin_amdgcn_mfma_f32_16x16x32_bf16(ca[kk], *(const bf16x8*)&Hm[(hh * 2 + 1) * 64 + 16 * ni + l15][32 * kk + 8 * l4], accB[ni], 0, 0, 0); }
#pragma unroll
      for (int rg = 0; rg < 4; ++rg) { const int t = 16 * w + 4 * l4 + rg; const float eF = ef[(hh * 2 + 0) * 128 + t], eB = ef[(hh * 2 + 1) * 128 + t];
#pragma unroll
        for (int ni = 0; ni < 4; ++ni) yv[hh][ni][rg] = eF * accF[ni][rg] + eB * accB[ni][rg]; }
    }
  }
  __syncthreads();
#pragma unroll
  for (int hh = 0; hh < 3; ++hh)
#pragma unroll
    for (int rg = 0; rg < 4; ++rg)
#pragma unroll
      for (int ni = 0; ni < 4; ++ni) Yt[16 * w + 4 * l4 + rg][hh * 64 + 16 * ni + l15] = yv[hh][ni][rg];
  __syncthreads();
  {
    const int c4 = 4 * (lane < 48 ? lane : 47), hk = c4 >> 6; const bool lact = lane < 48;
    float cw0[4], cw1[4], cw2[4], cbv[4], nwv[4];
#pragma unroll
    for (int e = 0; e < 4; ++e) { const int col = g * 192 + c4 + e; cw0[e] = cw[col]; cw1[e] = cw[640 + col]; cw2[e] = cw[1280 + col]; cbv[e] = cb[col]; nwv[e] = nw[col]; }
    const float dsk = dskip[3 * g + hk];
#pragma unroll 1
    for (int rb = 0; rb < 16; rb += 4) {
      u32x2 xc_[4], xp_[4], xn_[4], zz_[4], yy_[4];
#pragma unroll
      for (int u = 0; u < 4; ++u) { const int t = 16 * w + rb + u, j = j0 + t; const size_t r = r0 + t; const bool hasp = j != 0 && j != CTXL, hasn = j != CTXL - 1 && j != TPB - 1;
        const bf16_t* xq = XBC + r * 768 + g * 192 + c4;
        xc_[u] = *(const u32x2*)xq; xp_[u] = *(const u32x2*)(xq + (hasp ? -768 : 0)); xn_[u] = *(const u32x2*)(xq + (hasn ? 768 : 0));
        yy_[u] = *(const u32x2*)(YIN + r * 384 + g * 192 + c4); zz_[u] = *(const u32x2*)(VZ + r * 512 + 128 + g * 192 + c4); }
#pragma unroll
      for (int u = 0; u < 4; ++u) { const int t = 16 * w + rb + u, j = j0 + t; const size_t r = r0 + t; const float wp = (j != 0 && j != CTXL) ? 1.f : 0.f, wn = (j != CTXL - 1 && j != TPB - 1) ? 1.f : 0.f;
        const f32x4 yt = *(const f32x4*)&Yt[t][c4];
        float gt[4]; float ss = 0.f;
#pragma unroll
        for (int e = 0; e < 4; ++e) { const unsigned sh = (e & 1) * 16; const unsigned wc_ = e < 2 ? xc_[u].x : xc_[u].y, wq_ = e < 2 ? xp_[u].x : xp_[u].y, wn_ = e < 2 ? xn_[u].x : xn_[u].y, wz_ = e < 2 ? zz_[u].x : zz_[u].y;
          float xv = cw1[e] * bf2f((bf16_t)(wc_ >> sh)) + cbv[e] + wp * cw0[e] * bf2f((bf16_t)(wq_ >> sh)) + wn * cw2[e] * bf2f((bf16_t)(wn_ >> sh));
          xv = siluf(xv);
          const float y = bf2f((bf16_t)((e < 2 ? yy_[u].x : yy_[u].y) >> sh)) + yt[e] + dsk * xv;
          gt[e] = lact ? y * siluf(bf2f((bf16_t)(wz_ >> sh))) : 0.f; ss += gt[e] * gt[e]; }
        const float rstd = rsqrtf(wave_sum(ss) * (1.0f / 192.0f) + EPS);
        if (lact) { u32x2 o; o.x = pk2bf(gt[0] * rstd * nwv[0], gt[1] * rstd * nwv[1]); o.y = pk2bf(gt[2] * rstd * nwv[2], gt[3] * rstd * nwv[3]);
          *(u32x2*)(MIX + r * DM + 384 + g * 192 + c4) = o; } }
    }
  }
  __syncthreads();
}

__device__ __forceinline__ void st_router(const float* xl, const float* xc, int from_inputs, bf16_t* XB, const bf16_t* MO, const float* g, const float* modv_layer, const float* w_router, const float* rbias,
                                          bf16_t* H2, int* ctl, int* tok_pair, float* tok_w, int skip_ctx, char* lds) {
  float* wl = (float*)lds;
  const int tid = TIDX, lane = tid & 63, gw = BIDX * 8 + (tid >> 6), ngw = GDIM * 8;
  int* hist = (int*)(lds + 81920);
  if (tid < 32) hist[tid] = 0;
  float* mA = (float*)(lds + 82176); float* mB = mA + 5 * 1024; float* mG = mB + 5 * 1024;
  { f32x4 g4[3], sc4[3], sh4[3], gp4[3], wr4[8];
#pragma unroll
    for (int i = 0; i < 3; ++i) { const int q = tid + NT * i, qc = q < 1280 ? q : 0, m = qc >> 8, k = (qc & 255) * 4;
      g4[i] = *(const f32x4*)(g + k); sc4[i] = *(const f32x4*)(modv_layer + (size_t)m * 6144 + 4096 + k); sh4[i] = *(const f32x4*)(modv_layer + (size_t)m * 6144 + 3072 + k);
      gp4[i] = *(const f32x4*)(modv_layer + (size_t)m * 6144 + 2048 + k); }
#pragma unroll
    for (int i = 0; i < 8; ++i) wr4[i] = *(const f32x4*)(w_router + (size_t)(tid + NT * i) * 4);
#pragma unroll
    for (int i = 0; i < 3; ++i) { const int q = tid + NT * i;
      if (q < 1280) { *(f32x4*)(mA + 4 * q) = g4[i] * ((f32x4){1.f, 1.f, 1.f, 1.f} + sc4[i]); *(f32x4*)(mB + 4 * q) = sh4[i]; *(f32x4*)(mG + 4 * q) = gp4[i]; } }
#pragma unroll
    for (int i = 0; i < 8; ++i) { const int idx = tid + NT * i, k = idx >> 2, e4 = idx & 3, row = ((k & 3) * 4 + (k >> 8)) * 64 + ((k & 255) >> 2);
      *(f32x4*)(wl + row * 20 + 4 * e4) = wr4[i]; } }
  __syncthreads();
  for (int rb = gw; rb < MTOK; rb += 2 * ngw) {
    int rr[2]; bool act[2]; f32x4 v[2][4]; u32x2 mo[2][4]; float rstd[2]; int mo_[2];
#pragma unroll
    for (int u = 0; u < 2; ++u) { const int r = rb + u * ngw; rr[u] = r < MTOK ? r : MTOK - 1; act[u] = r < MTOK && !(skip_ctx && (rr[u] % TPB) < CTXL); mo_[u] = mrow_of(rr[u]) * 1024;
      const bf16_t* mr = MO + (size_t)rr[u] * DM;
      if (from_inputs) { const float* xr = xrow(xl, xc, rr[u]);
#pragma unroll
        for (int j = 0; j < 4; ++j) v[u][j] = *(const f32x4*)(xr + 4 * lane + 256 * j); }
      else { const bf16_t* xr = XB + (size_t)rr[u] * DM;
#pragma unroll
        for (int j = 0; j < 4; ++j) { const u32x2 t2 = *(const u32x2*)(xr + 4 * lane + 256 * j);
          v[u][j] = (f32x4){__uint_as_float(t2.x << 16), __uint_as_float(t2.x & 0xffff0000u), __uint_as_float(t2.y << 16), __uint_as_float(t2.y & 0xffff0000u)}; } }
#pragma unroll
      for (int j = 0; j < 4; ++j) mo[u][j] = *(const u32x2*)(mr + 4 * lane + 256 * j); }
    if (!act[0] && !act[1]) continue;
#pragma unroll
    for (int u = 0; u < 2; ++u) if (act[u]) { bf16_t* xd = XB + (size_t)rr[u] * DM;
#pragma unroll
      for (int j = 0; j < 4; ++j) { const int k = 4 * lane + 256 * j; const f32x4 g4 = *(const f32x4*)(mG + mo_[u] + k);
        const f32x4 m4 = (f32x4){__uint_as_float(mo[u][j].x << 16), __uint_as_float(mo[u][j].x & 0xffff0000u), __uint_as_float(mo[u][j].y << 16), __uint_as_float(mo[u][j].y & 0xffff0000u)};
        v[u][j] = v[u][j] + g4 * m4; u32x2 w2; w2.x = pk2bf(v[u][j].x, v[u][j].y); w2.y = pk2bf(v[u][j].z, v[u][j].w); *(u32x2*)(xd + k) = w2; } }
#pragma unroll
    for (int u = 0; u < 2; ++u) { float ss = 0.f;
#pragma unroll
      for (int j = 0; j < 4; ++j) ss += v[u][j].x * v[u][j].x + v[u][j].y * v[u][j].y + v[u][j].z * v[u][j].z + v[u][j].w * v[u][j].w;
      rstd[u] = rsqrtf(wave_sum(ss) * (1.0f / DM) + EPS); }
    float lg[2][16];
#pragma unroll
    for (int u = 0; u < 2; ++u)
#pragma unroll
      for (int e = 0; e < 16; ++e) lg[u][e] = 0.f;
#pragma unroll 1
    for (int j = 0; j < 4; ++j) { const int k = 4 * lane + 256 * j; float o[2][4];
#pragma unroll
      for (int u = 0; u < 2; ++u) { const f32x4 a4 = *(const f32x4*)(mA + mo_[u] + k), b4 = *(const f32x4*)(mB + mo_[u] + k); const f32x4 o4 = v[u][j] * rstd[u] * a4 + b4;
        o[u][0] = o4.x; o[u][1] = o4.y; o[u][2] = o4.z; o[u][3] = o4.w;
        if (act[u]) { u32x2 wpk; wpk.x = pk2bf(o4.x, o4.y); wpk.y = pk2bf(o4.z, o4.w); *(u32x2*)(H2 + (size_t)rr[u] * DM + k) = wpk; } }
#pragma unroll
      for (int q = 0; q < 4; ++q) { const float* wr_ = wl + ((q * 4 + j) * 64 + lane) * 20;
#pragma unroll
        for (int e4 = 0; e4 < 4; ++e4) { const f32x4 wr = *(const f32x4*)(wr_ + 4 * e4);
#pragma unroll
          for (int u = 0; u < 2; ++u) { lg[u][4 * e4] += o[u][q] * wr.x; lg[u][4 * e4 + 1] += o[u][q] * wr.y; lg[u][4 * e4 + 2] += o[u][q] * wr.z; lg[u][4 * e4 + 3] += o[u][q] * wr.w; } } } }
    float h1[2];
#pragma unroll
    for (int u = 0; u < 2; ++u) { float h8[8], h4[4], h2[2];
#pragma unroll
      for (int i = 0; i < 8; ++i) { const bool up = (lane & 32) != 0; const float keep = up ? lg[u][8 + i] : lg[u][i], give = up ? lg[u][i] : lg[u][8 + i]; h8[i] = keep + __shfl_xor(give, 32); }
#pragma unroll
      for (int i = 0; i < 4; ++i) { const bool up = (lane & 16) != 0; const float keep = up ? h8[4 + i] : h8[i], give = up ? h8[i] : h8[4 + i]; h4[i] = keep + __shfl_xor(give, 16); }
#pragma unroll
      for (int i = 0; i < 2; ++i) { const bool up = (lane & 8) != 0; const float keep = up ? h4[2 + i] : h4[i], give = up ? h4[i] : h4[2 + i]; h2[i] = keep + __shfl_xor(give, 8); }
      { const bool up = (lane & 4) != 0; const float keep = up ? h2[1] : h2[0], give = up ? h2[0] : h2[1]; h1[u] = keep + __shfl_xor(give, 4); }
      h1[u] += __shfl_xor(h1[u], 2); h1[u] += __shfl_xor(h1[u], 1); }
    float lx[16];
#pragma unroll
    for (int e = 0; e < 16; ++e) { const int src = ((e >> 3) & 1) * 32 + ((e >> 2) & 1) * 16 + ((e >> 1) & 1) * 8 + (e & 1) * 4;
      const float a0 = __uint_as_float(__builtin_amdgcn_readlane(__float_as_uint(h1[0]), src)), a1 = __uint_as_float(__builtin_amdgcn_readlane(__float_as_uint(h1[1]), src));
      lx[e] = lane < 32 ? a0 : a1; }
    const int us = lane >> 5;
    if ((lane & 31) == 0 && (us == 0 ? act[0] : act[1])) {
      const int r = us == 0 ? rr[0] : rr[1];
      int best = 0, bi1 = 0, bi2 = 1; float bestv = -1e30f, bs1 = 0.f, bs2 = 0.f;
#pragma unroll
      for (int gq = 0; gq < 4; ++gq) { float m1 = -1e30f, m2 = -1e30f, s1 = 0.f, s2 = 0.f; int i1 = 0, i2 = 0;
#pragma unroll
        for (int i = 0; i < 4; ++i) { const float scv = 1.0f / (1.0f + __expf(-lx[4 * gq + i])); const float sv = scv + rbias[4 * gq + i];
          if (sv > m1) { m2 = m1; s2 = s1; i2 = i1; m1 = sv; s1 = scv; i1 = i; } else if (sv > m2) { m2 = sv; s2 = scv; i2 = i; } }
        if (m1 + m2 > bestv) { bestv = m1 + m2; best = gq; bi1 = i1; bi2 = i2; bs1 = s1; bs2 = s2; } }
      const int ia = bi1 < bi2 ? bi1 : bi2, ib = bi1 < bi2 ? bi2 : bi1;
      const int tri = ia == 0 ? ib - 1 : (ia == 1 ? ib + 1 : 5);
      const int pidx = best * 6 + tri;
      const float sa = bi1 < bi2 ? bs1 : bs2, sb = bi1 < bi2 ? bs2 : bs1, inv = 1.0f / (sa + sb);
      const int rank = atomicAdd(&hist[pidx], 1);
      tok_pair[r] = pidx | (rank << 5); tok_w[2 * r] = sa * inv; tok_w[2 * r + 1] = sb * inv;
    }
  }
  __syncthreads();
  if (tid < 32) ctl[CT_CNTB + BIDX * 32 + tid] = tid < 24 ? hist[tid] : 0;
}
__device__ __forceinline__ void st_moe_gather(const bf16_t* H2, bf16_t* H2S, int* ctl, const int* tok_pair, const float* tok_w, int* sorted_tok, float* sorted_w, int* tok_slot, int skip_ctx, char* lds) {
  int* sbase = (int*)lds; int* rtot = sbase + 32; int* rpre = rtot + 512;
  const int tid = TIDX, bid = BIDX;
  { const int p = tid & 31, seg = tid >> 5; int tot = 0, pre = 0;
#pragma unroll 4
    for (int i = 0; i < 16; ++i) { const int bb = seg * 16 + i; const int cv = ctl[CT_CNTB + bb * 32 + p]; tot += cv; pre += bb < bid ? cv : 0; }
    rtot[seg * 32 + p] = tot; rpre[seg * 32 + p] = pre; }
  __syncthreads();
  if (tid < 32) { int tot = 0, pre = 0;
#pragma unroll
    for (int sg = 0; sg < 16; ++sg) { tot += rtot[sg * 32 + tid]; pre += rpre[sg * 32 + tid]; }
    rtot[tid] = tot; rpre[tid] = pre; }
  __syncthreads();
  if (tid == 0) { int base = 0, nt = 0;
#pragma unroll 1
    for (int p = 0; p < 24; ++p) { sbase[p] = base + rpre[p]; const int n = rtot[p], tl = (n + 255) >> 8;
      if (bid == 0) { ctl[CT_BASE + p] = base; for (int t = 0; t < tl; ++t) ctl[CT_TP + nt + t] = p; }
      nt += tl; base += tl * 256; }
    if (bid == 0) { ctl[CT_BASE + 24] = base; ctl[CT_NT] = nt; } }
  __syncthreads();
  const int lane = tid & 63, gw = bid * 8 + (tid >> 6), ngw = GDIM * 8;
  for (int rb = gw; rb < MTOK; rb += 3 * ngw) {
    u32x4 a0[3], a1[3]; int pk[3]; float w0[3], w1[3]; bool act[3];
#pragma unroll
    for (int u = 0; u < 3; ++u) { const int r = rb + u * ngw; act[u] = r < MTOK && !(skip_ctx && (r % TPB) < CTXL); const int rc = act[u] ? r : 0;
      pk[u] = tok_pair[rc]; w0[u] = tok_w[2 * rc]; w1[u] = tok_w[2 * rc + 1];
      const u32x4* sp = (const u32x4*)(H2 + (size_t)rc * DM); a0[u] = sp[lane]; a1[u] = sp[lane + 64]; }
#pragma unroll
    for (int u = 0; u < 3; ++u) if (act[u]) { const int r = rb + u * ngw; const int slot = sbase[pk[u] & 31] + (pk[u] >> 5);
      if (lane == 0) { sorted_tok[slot] = r; tok_slot[r] = slot; sorted_w[2 * slot] = w0[u]; sorted_w[2 * slot + 1] = w1[u]; }
      u32x4* d = (u32x4*)(H2S + (size_t)slot * DM); d[lane] = a0[u]; d[lane + 64] = a1[u]; }
  }
  __syncthreads();
}
__device__ __forceinline__ void st_final(float* out, const float* g, const bf16_t* XB, const bf16_t* YS, const int* tok_slot, const float* gate  ) {
  const int lane = TIDX & 63, gw = BIDX * 8 + (TIDX >> 6), ngw = GDIM * 8;
  f32x4 gg[4];
#pragma unroll
  for (int j = 0; j < 4; ++j) gg[j] = *(const f32x4*)(g + 4 * lane + 256 * j);
  for (int rb = gw; rb < NB * SEQ; rb += 4 * ngw) {
    u32x2 xb[4][4], ys[4][4];
#pragma unroll
    for (int u = 0; u < 4; ++u) { const int r = rb + u * ngw, rc = r < NB * SEQ ? r : NB * SEQ - 1;
      const int bb = rc >> 12, tr = bb * TPB + CTXL + (rc & 4095); const bf16_t* xr = XB + (size_t)tr * DM; const bf16_t* yr = YS + (size_t)tok_slot[tr] * DM;
#pragma unroll
      for (int j = 0; j < 4; ++j) { xb[u][j] = *(const u32x2*)(xr + 4 * lane + 256 * j); ys[u][j] = *(const u32x2*)(yr + 4 * lane + 256 * j); } }
#pragma unroll
    for (int u = 0; u < 4; ++u) { const int r = rb + u * ngw, rc = r < NB * SEQ ? r : NB * SEQ - 1; const float* gt = gate + (size_t)(rc >> 12) * 6144; float ss = 0.f; f32x4 v[4];
#pragma unroll
      for (int j = 0; j < 4; ++j) { const f32x4 g4 = *(const f32x4*)(gt + 4 * lane + 256 * j);
        const f32x4 x4 = (f32x4){__uint_as_float(xb[u][j].x << 16), __uint_as_float(xb[u][j].x & 0xffff0000u), __uint_as_float(xb[u][j].y << 16), __uint_as_float(xb[u][j].y & 0xffff0000u)};
        const f32x4 m4 = (f32x4){__uint_as_float(ys[u][j].x << 16), __uint_as_float(ys[u][j].x & 0xffff0000u), __uint_as_float(ys[u][j].y << 16), __uint_as_float(ys[u][j].y & 0xffff0000u)};
        v[j] = x4 + g4 * m4; ss += v[j].x * v[j].x + v[j].y * v[j].y + v[j].z * v[j].z + v[j].w * v[j].w; }
      const float rstd = rsqrtf(wave_sum(ss) * (1.0f / DM) + EPS);
      if (r < NB * SEQ) { float* orow = out + (size_t)r * DM;
#pragma unroll
        for (int j = 0; j < 4; ++j) *(f32x4*)(orow + 4 * lane + 256 * j) = (f32x4){v[j].x * rstd * gg[j].x, v[j].y * rstd * gg[j].y, v[j].z * rstd * gg[j].z, v[j].w * rstd * gg[j].w}; } }
  }
}

namespace pg8 {
#define PG8_LAS __attribute__((address_space(3)))
typedef unsigned short bf16_t;
typedef short bf16x8 __attribute__((ext_vector_type(8)));
typedef float f32x4 __attribute__((ext_vector_type(4)));
typedef unsigned u32x4 __attribute__((ext_vector_type(4)));
constexpr int BM = 256, BK = 64, HALF = 128, HTB = HALF * BK * 2  , STAGE_BYTES = 8 * HTB, NXCD = 8, WGM = 8;

__host__ __device__ __forceinline__ int lds_byte(int r, int c) { const int st = (r >> 4) * 2 + (c >> 5), rr = r & 15, cc = c & 31, ob = rr * 64 + cc * 2; return st * 1024 + (ob ^ (((ob >> 9) & 1) << 5)); }
__host__ __device__ __forceinline__ void stage_rc(int b, int& R, int& C) { const int st = b / 1024, sb = b % 1024, swz = sb ^ (((sb >> 9) & 1) << 5); R = (st >> 1) * 16 + swz / 64; C = (st & 1) * 32 + (swz % 64) / 2; }
__host__ __device__ __forceinline__ int perm32(int rho) { const int n = rho >> 4, i = rho & 15; return 8 * (i >> 2) + 4 * n + (i & 3); }

struct Unit { int pm, pn, fin, half; const char* A; const char* B; };
struct Gemm { int K, lda, ldb; };

__device__ __forceinline__ void tile_of(int L, int nM, int nN, int& pm, int& pn) {
    const int nwg = nM * nN; int wgid = L; { const int q = nwg / NXCD, r = nwg % NXCD, xcd = wgid % NXCD, off = wgid / NXCD; wgid = (xcd < r ? xcd * (q + 1) : r * (q + 1) + (xcd - r) * q) + off; }
    const int nig = WGM * nN, gid = wgid / nig, fm = gid * WGM, gsz = (nM - fm) < WGM ? (nM - fm) : WGM;
    pm = fm + ((wgid % nig) % gsz); pn = (wgid % nig) / gsz;
}
__device__ __forceinline__ unsigned cvt_pk_bf16(float lo, float hi) { unsigned r; asm volatile("v_cvt_pk_bf16_f32 %0, %1, %2" : "=v"(r) : "v"(lo), "v"(hi)); return r; }
template <class Epi, class Sched, bool ALIGN_EPI = false, bool SP2 = false, bool HALFM = false>
__device__ __forceinline__ void gemm_phase(PG8_LAS unsigned char* lds, const Gemm g, const Sched& S, const Epi& E) {
    const int tid = opq_v((int)threadIdx.x), wid = __builtin_amdgcn_readfirstlane(tid >> 6), lane = tid & 63, wr = wid >> 2, wc = wid & 3, fr = lane & 15, fq = lane >> 4;
    const int K = g.K, nt = K / BK;
    unsigned voffA[2], voffB[2];
#pragma unroll
    for (int i = 0; i < 2; ++i) { int R, C; stage_rc(tid * 16 + i * 8192, R, C); const int Rb = Epi::PERM ? ((R & ~31) + perm32(R & 31)) : R;
        voffA[i] = (unsigned)(R * g.lda + C) * 2u; voffB[i] = (unsigned)(Rb * g.ldb + C) * 2u; }
    const size_t kstep = (size_t)(BK * 2);
    static_assert(!HALFM || SP2, "half-height units need the SP2 loop");
    const size_t hstepA = (size_t)HALF * g.lda * 2, hstepB = (size_t)HALF * g.ldb * 2;
    const unsigned ldsw = (unsigned)wid * 1024u;
    const int aoff = lds_byte(wr * 64 + fr, fq * 8), boff = lds_byte(wc * 32 + fr, fq * 8);
#define PG8_SA(b, h) (((b) * 2 + (h)) * HTB)
#define PG8_SB(b, h) ((4 + (b) * 2 + (h)) * HTB)
#define PG8_STAGE(bufoff, gbase, voff) do { _Pragma("unroll") for (int _i = 0; _i < 2; ++_i) \
        __builtin_amdgcn_global_load_lds((const unsigned*)((const char*)(gbase) + (voff)[_i]), (PG8_LAS unsigned*)(lds + (bufoff) + ldsw + _i * 8192), 16, 0, 0); } while (0)
#define PG8_LDA(dst, b, h) do { _Pragma("unroll") for (int m = 0; m < 4; ++m) _Pragma("unroll") for (int k = 0; k < 2; ++k) dst[m][k] = *(const PG8_LAS bf16x8*)(lds + PG8_SA(b, h) + aoff + m * 2048 + k * 1024); } while (0)
#define PG8_LDB(dst, b, h) do { _Pragma("unroll") for (int n = 0; n < 2; ++n) _Pragma("unroll") for (int k = 0; k < 2; ++k) dst[n][k] = *(const PG8_LAS bf16x8*)(lds + PG8_SB(b, h) + boff + n * 2048 + k * 1024); } while (0)
#define PG8_MMA(ai, bj, At, Bt) do { __builtin_amdgcn_s_setprio(1); _Pragma("unroll") for (int m = 0; m < 4; ++m) _Pragma("unroll") for (int n = 0; n < 2; ++n) _Pragma("unroll") for (int k = 0; k < 2; ++k) \
        acc[ai][bj][m][n] = __builtin_amdgcn_mfma_f32_16x16x32_bf16(Bt[n][k], At[m][k], acc[ai][bj][m][n], 0, 0, 0); __builtin_amdgcn_s_setprio(0); } while (0)
#define PG8_WAIT_V(n) asm volatile("s_waitcnt vmcnt(" #n ")" ::: "memory")
#define PG8_WAIT_L(n) asm volatile("s_waitcnt lgkmcnt(" #n ")" ::: "memory")
#define PG8_BAR __builtin_amdgcn_s_barrier()
#define PG8_SCHED __builtin_amdgcn_sched_barrier(0)
    Unit cur, nxt; int ui = 0;
    if (!S.next(0, cur)) return;
    f32x4 acc[2][2][4][2];
#pragma unroll
    for (int a = 0; a < 2; ++a)
#pragma unroll
        for (int b = 0; b < 2; ++b)
#pragma unroll
            for (int m = 0; m < 4; ++m)
#pragma unroll
                for (int n = 0; n < 2; ++n) acc[a][b][m][n] = (f32x4){0.f, 0.f, 0.f, 0.f};
    bf16x8 At[4][2], B0[2][2], B1[2][2];
    const char* cA = cur.A; const char* cB = cur.B;
    S.a_ready(cur);
    if constexpr (SP2) {
        PG8_STAGE(PG8_SB(0, 0), cB, voffB); PG8_STAGE(PG8_SB(0, 1), cB + hstepB, voffB); PG8_STAGE(PG8_SA(0, 0), cA, voffA); if constexpr (!HALFM) PG8_STAGE(PG8_SA(0, 1), cA + hstepA, voffA);
        if (wr == 1) PG8_BAR;
        if constexpr (HALFM) PG8_WAIT_V(0); else PG8_WAIT_V(2);
        PG8_BAR;
        PG8_STAGE(PG8_SB(1, 0), cB + kstep, voffB); PG8_STAGE(PG8_SA(1, 0), cA + kstep, voffA); PG8_STAGE(PG8_SB(1, 1), cB + hstepB + kstep, voffB);
        PG8_WAIT_V(6); PG8_BAR;
    } else {
        PG8_STAGE(PG8_SB(0, 0), cB, voffB); PG8_STAGE(PG8_SA(0, 0), cA, voffA); PG8_STAGE(PG8_SB(0, 1), cB + hstepB, voffB); PG8_STAGE(PG8_SA(0, 1), cA + hstepA, voffA);
        if (wr == 1) PG8_BAR;
        PG8_WAIT_V(4); PG8_BAR;
        PG8_STAGE(PG8_SB(1, 0), cB + kstep, voffB); PG8_STAGE(PG8_SA(1, 0), cA + kstep, voffA); PG8_STAGE(PG8_SB(1, 1), cB + hstepB + kstep, voffB);
        PG8_WAIT_V(6); PG8_BAR;
    }
    for (;;) {
        const bool has_next = S.next(ui + 1, nxt);
        const char* nA = has_next ? nxt.A : cA; const char* nB = has_next ? nxt.B : cB;
        for (int t = 0; t < nt; t += 2) {
            const bool last = (t == nt - 2);
            const char* a1 = cA + (size_t)(t + 1) * kstep;
            const char* a2 = last ? nA : cA + (size_t)(t + 2) * kstep; const char* b2 = last ? nB : cB + (size_t)(t + 2) * kstep;
            const char* a3 = a2 + kstep; const char* b3 = b2 + kstep;
            if (last && has_next) S.a_ready(nxt);
            if constexpr (SP2) {
            PG8_LDB(B0, 0, 0); PG8_LDB(B1, 0, 1); PG8_SCHED; PG8_LDA(At, 0, 0); if constexpr (!HALFM) PG8_STAGE(PG8_SA(1, 1), a1 + hstepA, voffA);
            PG8_WAIT_V(8); PG8_WAIT_L(0); PG8_BAR; PG8_MMA(0, 0, At, B0); PG8_MMA(0, 1, At, B1); PG8_BAR; PG8_SCHED;
            if constexpr (!HALFM) PG8_LDA(At, 0, 1);
            PG8_STAGE(PG8_SB(0, 0), b2, voffB); PG8_STAGE(PG8_SB(0, 1), b2 + hstepB, voffB); PG8_STAGE(PG8_SA(0, 0), a2, voffA);
            if constexpr (HALFM) PG8_WAIT_V(6); else PG8_WAIT_V(8);
            PG8_WAIT_L(0); PG8_BAR; if constexpr (!HALFM) { PG8_MMA(1, 0, At, B0); PG8_MMA(1, 1, At, B1); } PG8_BAR; PG8_SCHED;
            PG8_LDB(B0, 1, 0); PG8_LDB(B1, 1, 1); PG8_SCHED; PG8_LDA(At, 1, 0); if constexpr (!HALFM) PG8_STAGE(PG8_SA(0, 1), a2 + hstepA, voffA);
            PG8_WAIT_V(8); PG8_WAIT_L(0); PG8_BAR; PG8_MMA(0, 0, At, B0); PG8_MMA(0, 1, At, B1); PG8_BAR; PG8_SCHED;
            if constexpr (!HALFM) PG8_LDA(At, 1, 1);
            PG8_STAGE(PG8_SB(1, 0), b3, voffB); PG8_STAGE(PG8_SB(1, 1), b3 + hstepB, voffB); PG8_STAGE(PG8_SA(1, 0), a3, voffA);
            if constexpr (HALFM) PG8_WAIT_V(6); else PG8_WAIT_V(8);
            PG8_WAIT_L(0); PG8_BAR; if constexpr (!HALFM) { PG8_MMA(1, 0, At, B0); PG8_MMA(1, 1, At, B1); } PG8_BAR; PG8_SCHED;
            } else {
            PG8_LDB(B0, 0, 0); PG8_SCHED; PG8_LDA(At, 0, 0); PG8_STAGE(PG8_SA(1, 1), a1 + hstepA, voffA);
            PG8_WAIT_L(8); PG8_BAR; PG8_WAIT_L(0); PG8_MMA(0, 0, At, B0); PG8_BAR; PG8_SCHED;
            PG8_LDB(B1, 0, 1); PG8_STAGE(PG8_SB(0, 0), b2, voffB);
            PG8_BAR; PG8_WAIT_L(0); PG8_MMA(0, 1, At, B1); PG8_BAR;
            PG8_LDA(At, 0, 1); PG8_STAGE(PG8_SA(0, 0), a2, voffA);
            PG8_BAR; PG8_WAIT_L(0); PG8_MMA(1, 0, At, B0); PG8_BAR; PG8_SCHED;
            PG8_STAGE(PG8_SB(0, 1), b2 + hstepB, voffB);
            PG8_WAIT_V(6); PG8_BAR; PG8_MMA(1, 1, At, B1); PG8_BAR;
            PG8_LDB(B0, 1, 0); PG8_SCHED; PG8_LDA(At, 1, 0); PG8_STAGE(PG8_SA(0, 1), a2 + hstepA, voffA);
            PG8_WAIT_L(8); PG8_BAR; PG8_WAIT_L(0); PG8_MMA(0, 0, At, B0); PG8_BAR; PG8_SCHED;
            PG8_LDB(B1, 1, 1); PG8_STAGE(PG8_SB(1, 0), b3, voffB);
            PG8_BAR; PG8_WAIT_L(0); PG8_MMA(0, 1, At, B1); PG8_BAR;
            PG8_LDA(At, 1, 1); PG8_STAGE(PG8_SA(1, 0), a3, voffA);
            PG8_BAR; PG8_WAIT_L(0); PG8_MMA(1, 0, At, B0); PG8_BAR; PG8_SCHED;
            PG8_STAGE(PG8_SB(1, 1), b3 + hstepB, voffB);
            PG8_WAIT_V(6); PG8_BAR; PG8_MMA(1, 1, At, B1); PG8_BAR;
            }
        }
        if constexpr (ALIGN_EPI) { if (wr == 0) PG8_BAR; }
        if constexpr (!Epi::AFTER_DRAIN) { if (cur.fin) { E(acc, cur, wr, wc, fr, fq, HALFM ? 1 : 2); S.done(cur); } }
        if (!has_next) break;
        if (cur.fin) {
#pragma unroll
        for (int a = 0; a < 2; ++a)
#pragma unroll
            for (int b = 0; b < 2; ++b)
#pragma unroll
                for (int m = 0; m < 4; ++m)
#pragma unroll
                    for (int n = 0; n < 2; ++n) acc[a][b][m][n] = (f32x4){0.f, 0.f, 0.f, 0.f};
        }
        cur = nxt; cA = nA; cB = nB; ++ui;
        if constexpr (ALIGN_EPI) { if (wr == 1) PG8_BAR; }
    }
    PG8_WAIT_V(0);
    if constexpr (!ALIGN_EPI) { if (wr == 0) PG8_BAR; }
    PG8_BAR;
    if constexpr (Epi::AFTER_DRAIN) { E.fused(acc, cur, wr, wc, fr, fq, lds, wid, lane); S.done(cur); }
#undef PG8_SA
#undef PG8_SB
#undef PG8_STAGE
#undef PG8_LDA
#undef PG8_LDB
#undef PG8_MMA
#undef PG8_WAIT_V
#undef PG8_WAIT_L
#undef PG8_BAR
#undef PG8_SCHED
}
}

struct SchedDense {
  int nM, nN, G, c, skip_ctx; const char* A; const char* B; size_t a_tile, b_tile; int part;
  __device__ __forceinline__ bool next(int i, pg8::Unit& u) const {
    const int nu = nM * nN, T = nu % G; const bool split = T > 0 && 2 * T <= G; int L, half = 0;
    if (part == 0) { L = i * G + c; if (L >= (split ? nu - T : nu)) return false; }
    else { if (i > 0 || !split || c >= 2 * T) return false; L = nu - T + (c >> 1); half = 1 + (c & 1); }
    int pm, pn; pg8::tile_of(L, nM, nN, pm, pn); if (skip_ctx) pm = pm + pm / 16 + 1;
    u.pm = pm; u.pn = pn; u.fin = 1; u.half = half; u.A = A + (size_t)pm * a_tile + (half == 2 ? a_tile / 2 : 0); u.B = B + (size_t)pn * b_tile; return true; }
  __device__ __forceinline__ void a_ready(const pg8::Unit&) const {}
  __device__ __forceinline__ void done(const pg8::Unit&) const {}
};
struct SchedMoe {
  int G, c, mode; const int* ctl; const char* A; size_t a_tile; const char* W; int tail;
  __device__ __forceinline__ bool next(int i, pg8::Unit& u) const {
    const int part = mode == 2 ? (i & 1) : 0, iu = mode == 2 ? (i >> 1) : i;
    const int nu = ctl[CT_NT] * 4, T = nu % G; const bool split = T > 0 && 2 * T <= G; int L, half = 0;
    if (tail == 0) { L = iu * G + c; if (L >= (split ? nu - T : nu)) return false; }
    else { if (iu > 0 || !split || c >= 2 * T) return false; L = nu - T + (c >> 1); half = 1 + (c & 1); }
    const int pm = L >> 2, pn = L & 3; int eA, eB; pair_experts(ctl[CT_TP + pm], eA, eB);
    u.pm = pm; u.pn = pn; u.half = half; const size_t ho = half == 2 ? a_tile / 2 : 0;
    if (mode == 1) { const int e = pn < 2 ? eA : eB; u.fin = 1; u.A = A + (size_t)pm * a_tile + ho; u.B = W + (size_t)e * (512 * 1024 * 2) + (size_t)(pn & 1) * (256 * 1024 * 2); }
    else { u.fin = part; u.A = A + (size_t)pm * a_tile + ho + part * 512; u.B = W + (size_t)(part ? eB : eA) * (1024 * 256 * 2) + (size_t)pn * (256 * 256 * 2); }
    return true; }
  __device__ __forceinline__ void a_ready(const pg8::Unit&) const {}
  __device__ __forceinline__ void done(const pg8::Unit&) const {}
};
__device__ __forceinline__ unsigned cvt_pk(float lo, float hi) { return pg8::cvt_pk_bf16(lo, hi); }
struct EpiInProj {
  static constexpr bool PERM = true, AFTER_DRAIN = false; bf16_t *QK, *VZ, *XBC, *HY; float* DT;
  __device__ __forceinline__ void operator()(const f32x4 (&acc)[2][2][4][2], const pg8::Unit& u, int wr, int wc, int fr, int fq, const int nai) const {
    const int pn = u.pn; bf16_t* base; int ldc, coff;
    if (pn < 2) { base = QK; ldc = 512; coff = pn * 256; } else if (pn < 4) { base = VZ; ldc = 512; coff = (pn - 2) * 256; }
    else if (pn < 7) { base = XBC; ldc = 768; coff = (pn - 4) * 256; } else { base = HY; ldc = 768; coff = (pn - 7) * 256; }
    const int row0 = u.pm * 256 + (u.half == 2 ? 128 : 0) + wr * 64 + fr, col0 = coff + wc * 32 + 8 * fq; const bool dtl = (pn == 6 && wc == 0 && fq < 2);
#pragma unroll
    for (int ai = 0; ai < 2; ++ai)
#pragma unroll
      for (int m = 0; m < 4; ++m) if (ai < nai) { const int row = row0 + ai * 128 + m * 16; bf16_t* rowp = base + (size_t)row * ldc + col0;
#pragma unroll
        for (int bj = 0; bj < 2; ++bj) { const f32x4 v0 = acc[ai][bj][m][0], v1 = acc[ai][bj][m][1];
          u32x4 w; w.x = cvt_pk(v0[0], v0[1]); w.y = cvt_pk(v0[2], v0[3]); w.z = cvt_pk(v1[0], v1[1]); w.w = cvt_pk(v1[2], v1[3]);
          *(u32x4*)(rowp + bj * 128) = w;
          if (bj == 1 && dtl) { float* dp = DT + (size_t)row * 12 + 8 * fq; *(f32x4*)dp = v0; if (fq == 0) *(f32x4*)(dp + 4) = v1; } } }
  }
};
struct EpiOutProj {
  static constexpr bool PERM = true, AFTER_DRAIN = false; bf16_t* MO;
  __device__ __forceinline__ void operator()(const f32x4 (&acc)[2][2][4][2], const pg8::Unit& u, int wr, int wc, int fr, int fq, const int nai) const {
    const int row0 = u.pm * 256 + (u.half == 2 ? 128 : 0) + wr * 64 + fr, col0 = u.pn * 256 + wc * 32 + 8 * fq;
#pragma unroll
    for (int ai = 0; ai < 2; ++ai)
#pragma unroll
      for (int m = 0; m < 4; ++m) if (ai < nai) { bf16_t* rowp = MO + (size_t)(row0 + ai * 128 + m * 16) * DM + col0;
#pragma unroll
        for (int bj = 0; bj < 2; ++bj) { const f32x4 v0 = acc[ai][bj][m][0], v1 = acc[ai][bj][m][1];
          u32x4 w; w.x = cvt_pk(v0[0], v0[1]); w.y = cvt_pk(v0[2], v0[3]); w.z = cvt_pk(v1[0], v1[1]); w.w = cvt_pk(v1[2], v1[3]);
          *(u32x4*)(rowp + bj * 128) = w; } }
  }
};
struct EpiMoe1 {
  static constexpr bool PERM = true, AFTER_DRAIN = false; bf16_t* ACT; const float* sorted_w;
  __device__ __forceinline__ void operator()(const f32x4 (&acc)[2][2][4][2], const pg8::Unit& u, int wr, int wc, int fr, int fq, const int nai) const {
    const int half = u.pn >> 1, j0 = (u.pn & 1) * 128 + 16 * wc + 4 * fq;
#pragma unroll
    for (int ai = 0; ai < 2; ++ai)
#pragma unroll
      for (int m = 0; m < 4; ++m) if (ai < nai) { const int slot = u.pm * 256 + (u.half == 2 ? 128 : 0) + ai * 128 + wr * 64 + m * 16 + fr; const float wt = sorted_w[2 * slot + half];
#pragma unroll
        for (int bj = 0; bj < 2; ++bj) { const f32x4 v0 = acc[ai][bj][m][0], v1 = acc[ai][bj][m][1];
          u32x2 w; w.x = cvt_pk(siluf(v0[0]) * v0[1] * wt, siluf(v0[2]) * v0[3] * wt); w.y = cvt_pk(siluf(v1[0]) * v1[1] * wt, siluf(v1[2]) * v1[3] * wt);
          *(u32x2*)(ACT + (size_t)slot * 512 + half * 256 + j0 + 64 * bj) = w; } }
  }
};
struct EpiMoe2 {
  static constexpr bool PERM = true, AFTER_DRAIN = false; bf16_t* YS;
  __device__ __forceinline__ void operator()(const f32x4 (&acc)[2][2][4][2], const pg8::Unit& u, int wr, int wc, int fr, int fq, const int nai) const {
    const int row0 = u.pm * 256 + (u.half == 2 ? 128 : 0) + wr * 64 + fr, col0 = u.pn * 256 + wc * 32 + 8 * fq;
#pragma unroll
    for (int ai = 0; ai < 2; ++ai)
#pragma unroll
      for (int m = 0; m < 4; ++m) if (ai < nai) { bf16_t* rowp = YS + (size_t)(row0 + ai * 128 + m * 16) * DM + col0;
#pragma unroll
        for (int bj = 0; bj < 2; ++bj) { const f32x4 v0 = acc[ai][bj][m][0], v1 = acc[ai][bj][m][1];
          u32x4 w; w.x = cvt_pk(v0[0], v0[1]); w.y = cvt_pk(v0[2], v0[3]); w.z = cvt_pk(v1[0], v1[1]); w.w = cvt_pk(v1[2], v1[3]);
          *(u32x4*)(rowp + bj * 128) = w; } }
  }
};

#include <hip/hip_bf16.h>
#include <cmath>
namespace attn_body {
using bf16=__hip_bfloat16;
using bf16x8=__attribute__((ext_vector_type(8)))short;
using s16x4=__attribute__((ext_vector_type(4)))short;
using f32x16=__attribute__((ext_vector_type(16)))float;
using u32x4=__attribute__((ext_vector_type(4)))unsigned;
constexpr int D=64,QP=512,KP=512,VP=512,OP=1024;
constexpr int NW=8,QBLK=32,QB=QBLK*NW,KVBLK=64;
constexpr int ATTN_UNIT_ROWS=QB;
__device__ __forceinline__ int crow(int r,int hi){return (r&3)+8*(r>>2)+4*hi;}
#define SBAR() __builtin_amdgcn_sched_barrier(0)
__device__ __forceinline__ void cmask(f32x16&p0,f32x16&p1,int jb,int qrel,int hi){
  const float NEG=-INFINITY; int kb=64*jb+4*hi;
  #pragma unroll
  for(int r=0;r<16;++r){int kv=kb+(r&3)+8*(r>>2); if(kv>qrel)p0[r]=NEG; if(kv+32>qrel)p1[r]=NEG;}
}

constexpr int NSLOT=3, SLOTB=8192;
constexpr int LDS_K=0, LDS_V=NSLOT*SLOTB, LDS_WS=2*NSLOT*SLOTB, LDS_OST=LDS_WS+NW*64*4, LDS_BYTES=LDS_OST+NW*4096;
constexpr float C2=0.125f*1.4426950408889634f;
__device__ __forceinline__ void glds16(const void*gsrc,unsigned lds_dst){unsigned keep;
  asm volatile("s_mov_b32 %0, m0\n\ts_mov_b32 m0, %2\n\ts_nop 0\n\tglobal_load_lds_dwordx4 %1, off\n\ts_mov_b32 m0, %0":"=&s"(keep):"v"(gsrc),"s"(lds_dst):"memory");}
__device__ __forceinline__ float max3f(float a,float b,float c){float r;asm("v_max3_f32 %0, %1, %2, %3":"=v"(r):"v"(a),"v"(b),"v"(c));return r;}
__device__ __forceinline__ float max2f(float a,float b){float r;asm("v_max_f32_e32 %0, %1, %2":"=v"(r):"v"(a),"v"(b));return r;}
__device__ __forceinline__ float fadd_s(float a,float b){float r;asm("v_add_f32_e32 %0, %1, %2":"=v"(r):"v"(a),"v"(b));return r;}
__device__ __forceinline__ float fsub_s(float a,float b){float r;asm("v_sub_f32_e32 %0, %1, %2":"=v"(r):"v"(a),"v"(b));return r;}
typedef float f32x2_t __attribute__((ext_vector_type(2))); typedef __bf16 bf16x2_t __attribute__((ext_vector_type(2)));
__device__ __forceinline__ unsigned cvtpk_s(float lo,float hi){f32x2_t v={lo,hi};bf16x2_t b=__builtin_convertvector(v,bf16x2_t);return __builtin_bit_cast(unsigned,b);}
#define WAIT_BAR(N) asm volatile("s_waitcnt vmcnt(" #N ") lgkmcnt(0)\n\ts_barrier":::"memory")

__device__ __forceinline__ void qkt(f32x16&p0,f32x16&p1,const char*Kslot,const bf16x8*qr,const f32x16&negm,int r32,int hi){
  const char*kb=Kslot+hi*1024+r32*16;
  #pragma unroll
  for(int d0=0;d0<4;++d0){
    const bf16x8 b0=*reinterpret_cast<const bf16x8*>(kb+d0*2048);
    const bf16x8 b1=*reinterpret_cast<const bf16x8*>(kb+d0*2048+512);
    if(d0==0){p0=__builtin_amdgcn_mfma_f32_32x32x16_bf16(b0,qr[0],negm,0,0,0);p1=__builtin_amdgcn_mfma_f32_32x32x16_bf16(b1,qr[0],negm,0,0,0);}
    else{p0=__builtin_amdgcn_mfma_f32_32x32x16_bf16(b0,qr[d0],p0,0,0,0);p1=__builtin_amdgcn_mfma_f32_32x32x16_bf16(b1,qr[d0],p1,0,0,0);}}
}
typedef __attribute__((address_space(3))) const char* lds_cptr;
typedef short v4i16_t __attribute__((ext_vector_type(4)));
__device__ __forceinline__ void kload8(bf16x8*kf,lds_cptr kp){
  kf[0]=*(const __attribute__((address_space(3))) bf16x8*)(kp);      kf[1]=*(const __attribute__((address_space(3))) bf16x8*)(kp+512);
  kf[2]=*(const __attribute__((address_space(3))) bf16x8*)(kp+2048); kf[3]=*(const __attribute__((address_space(3))) bf16x8*)(kp+2560);
  kf[4]=*(const __attribute__((address_space(3))) bf16x8*)(kp+4096); kf[5]=*(const __attribute__((address_space(3))) bf16x8*)(kp+4608);
  kf[6]=*(const __attribute__((address_space(3))) bf16x8*)(kp+6144); kf[7]=*(const __attribute__((address_space(3))) bf16x8*)(kp+6656);
}
__device__ __forceinline__ void kload2(bf16x8*kf,lds_cptr kp,int j){ kf[2*j]=*(const __attribute__((address_space(3))) bf16x8*)(kp+j*2048); kf[2*j+1]=*(const __attribute__((address_space(3))) bf16x8*)(kp+j*2048+512); }
__device__ __forceinline__ s16x4 vtr(lds_cptr p){ return __builtin_bit_cast(s16x4,__builtin_amdgcn_ds_read_tr16_b64_v4i16((__attribute__((address_space(3))) v4i16_t*)p)); }
__device__ __forceinline__ float rowmax(const f32x16&p0,const f32x16&p1){
  float a=max3f(p0[0],p0[1],p1[0]),b=max3f(p0[2],p0[3],p1[1]);a=max3f(a,p1[2],p1[3]);
  #pragma unroll
  for(int r=4;r<16;r+=4){a=max3f(a,p0[r],p0[r+1]);b=max3f(b,p0[r+2],p0[r+3]);a=max3f(a,p1[r],p1[r+1]);b=max3f(b,p1[r+2],p1[r+3]);}
  const float m=max2f(a,b);
  auto rr=__builtin_amdgcn_permlane32_swap(__float_as_uint(m),__float_as_uint(m),false,false);
  return max2f(__uint_as_float(rr[0]),__uint_as_float(rr[1]));
}
__device__ __forceinline__ void pv(f32x16*o,int vb,bf16x8 pa0,bf16x8 pa1,bf16x8 pa2,bf16x8 pa3){
  #pragma unroll
  for(int d0=0;d0<2;++d0){s16x4 lo[4],hi[4];
    #pragma unroll
    for(int ks=0;ks<4;++ks){
      asm volatile("ds_read_b64_tr_b16 %0,%1 offset:%c2":"=&v"(lo[ks]):"v"(vb),"i"(d0*4096+ks*1024):"memory");
      asm volatile("ds_read_b64_tr_b16 %0,%1 offset:%c2":"=&v"(hi[ks]):"v"(vb),"i"(d0*4096+ks*1024+512):"memory");}
    asm volatile("s_waitcnt lgkmcnt(0)":::"memory");SBAR();
    #define PK(k) (bf16x8){lo[k][0],lo[k][1],lo[k][2],lo[k][3],hi[k][0],hi[k][1],hi[k][2],hi[k][3]}
    o[d0]=__builtin_amdgcn_mfma_f32_32x32x16_bf16(pa0,PK(0),o[d0],0,0,0);
    o[d0]=__builtin_amdgcn_mfma_f32_32x32x16_bf16(pa1,PK(1),o[d0],0,0,0);
    o[d0]=__builtin_amdgcn_mfma_f32_32x32x16_bf16(pa2,PK(2),o[d0],0,0,0);
    o[d0]=__builtin_amdgcn_mfma_f32_32x32x16_bf16(pa3,PK(3),o[d0],0,0,0);
    #undef PK
  }
}

#ifndef ATTN_STORE16
#define ATTN_STORE16(p,v) (*(u32x4*)(p)=(v))
#endif
template<int THRL> __device__ __forceinline__ void attn_unit(const bf16*Qu,const bf16*__restrict__ Kh,const bf16*__restrict__ Vh,bf16*Ou,const int NT,char*shm){
  const int tid=opq_v((int)threadIdx.x),lane=tid&63,r32=lane&31,hi=lane>>5; const int wid=__builtin_amdgcn_readfirstlane(tid>>6);
  const bf16*Qw=Qu+(long)(wid*QBLK)*QP;
  const unsigned lds0=(unsigned)(uintptr_t)shm;
  float*wsf=(float*)(shm+LDS_WS)+wid*64;
  const bf16*ksrc=Kh+(long)lane*KP+wid*8;
  const bf16*vsrc=Vh+(long)(16*(wid&3)+(lane>>2))*VP+(wid>>2)*32+(lane&3)*8;
  const unsigned kdst=lds0+LDS_K+wid*1024, vdst=lds0+LDS_V+wid*1024;
  #define DMA_K(t,slot) glds16(ksrc+(long)(t)*KVBLK*KP,(unsigned)__builtin_amdgcn_readfirstlane(kdst+(slot)))
  #define DMA_V(t,slot) glds16(vsrc+(long)(t)*KVBLK*VP,(unsigned)__builtin_amdgcn_readfirstlane(vdst+(slot)))
  const int vb0=(int)(lds0+LDS_V)+((lane>>4)&1)*32+(lane&3)*8+(4*hi+((lane&15)>>2))*64;
  const char*Kbase=shm+LDS_K; bf16x8 kf[8];
  const lds_cptr shm3=(lds_cptr)shm; const lds_cptr kp0=shm3+LDS_K+hi*1024+r32*16; const lds_cptr vp0=shm3+LDS_V+((lane>>4)&1)*32+(lane&3)*8+(4*hi+((lane&15)>>2))*64;
  DMA_K(0,0);DMA_V(0,0);DMA_K(1,SLOTB);
  bf16x8 qr[4];
  #pragma unroll
  for(int d0=0;d0<4;++d0)qr[d0]=*reinterpret_cast<const bf16x8*>(&Qw[(long)r32*QP+d0*16+hi*8]);
  float mhat=0.f,l_reg=0.f;float z0_=0.f;asm volatile("":"+v"(z0_));f32x16 o[2];f32x16 negm;
  _Pragma("unroll") for(int r=0;r<16;++r){o[0][r]=z0_;o[1][r]=z0_;negm[r]=z0_;} asm volatile("":"+v"(negm));
  #define CMASK(P0,P1,t) do{}while(0)
  bool resc=false;
  #define START(P0,P1) do{ const float rm=rowmax(P0,P1); resc=false; \
    { const float dl=rm; mhat=fadd_s(mhat,dl); \
      _Pragma("unroll") for(int r=0;r<16;++r){P0[r]=fsub_s(P0[r],dl);P1[r]=fsub_s(P1[r],dl);} \
      _Pragma("unroll") for(int r=0;r<16;++r)negm[r]=-mhat; asm volatile("":"+v"(negm)); } \
    _Pragma("unroll") for(int r=0;r<16;++r)P0[r]=__builtin_amdgcn_exp2f(P0[r]); }while(0)
  #define RESC() do{ if(resc){ asm volatile("s_waitcnt lgkmcnt(0)":::"memory"); \
      _Pragma("unroll") for(int d_=0;d_<2;++d_) _Pragma("unroll") for(int r=0;r<16;++r)o[d_][r]*=wsf[crow(r,hi)]; } }while(0)
  f32x16 pA0,pA1,pB0,pB1;
  int sl_prev=0,sl_cur=0,sl_next=SLOTB;
  #define ROT() do{sl_prev=sl_cur;sl_cur=sl_next;sl_next=(sl_next==(NSLOT-1)*SLOTB)?0:sl_next+SLOTB;}while(0)
  DMA_K(2,2*SLOTB);
  WAIT_BAR(3);
  qkt(pA0,pA1,Kbase,qr,negm,r32,hi);asm volatile("s_nop 15\n\ts_nop 7":"+v"(pA0),"+v"(pA1));CMASK(pA0,pA1,0);
  START(pA0,pA1);
  _Pragma("unroll") for(int r=0;r<16;++r)pA1[r]=__builtin_amdgcn_exp2f(pA1[r]);
  WAIT_BAR(0);
  DMA_K(3,0);DMA_V(1,SLOTB);
  ROT();
  kload8(kf,kp0+sl_cur);
  WAIT_BAR(2);
  s16x4 vlo[8],vhi[8]; u32x4 pw0,pw1,pw2,pw3;
  #define PKW(P,B) cvtpk_s(P[B],P[B+1])
  #define PAF(k) __builtin_bit_cast(bf16x8,pw##k)
  #define VFR(i) (bf16x8){vlo[i][0],vlo[i][1],vlo[i][2],vlo[i][3],vhi[i][0],vhi[i][1],vhi[i][2],vhi[i][3]}
  #define PIN(x) asm volatile("":"+v"(x))
  #define MX3(a,b,c) __builtin_fmaxf(__builtin_fmaxf((a),(b)),(c))
  #define GAPA(MF,A0,A1,A2,A3,W0,W1,PW) do{ MF; sacc+=A0; sacc+=A1; sacc+=A2; sacc+=A3; PIN(sacc); W0; W1; PIN(PW); SBAR(); }while(0)
  #define EX(v) __builtin_amdgcn_exp2f(v)
  #define GAPB(MF,X,B) do{ MF; X[B]=EX(X[B]); X[B+1]=EX(X[B+1]); X[B+2]=EX(X[B+2]); X[B+3]=EX(X[B+3]); PIN(X); SBAR(); }while(0)
  #define VRD(i) do{ vlo[i]=vtr(vp_+(((i)>>2)*4096+((i)&3)*1024)); vhi[i]=vtr(vp_+(((i)>>2)*4096+((i)&3)*1024+512)); }while(0)
  #define KRD(G,j) do{ if(G){ kload2(kf,kp0+sl_next,j); SBAR(); } }while(0)
  #define STEP(C0,C1,P0,P1,t,GK,GV,GL) do{ SBAR(); \
    const lds_cptr vp_=vp0+sl_prev; \
    VRD(0); SBAR(); float sacc=(P0[0]+P0[1]); \
    GAPA(C0=__builtin_amdgcn_mfma_f32_32x32x16_bf16(kf[0],qr[0],negm,0,0,0), P0[2],P0[3],P0[4],P0[5],     pw0[0]=PKW(P0,0), pw0[1]=PKW(P0,2), pw0); \
    VRD(4); SBAR(); GAPA(C1=__builtin_amdgcn_mfma_f32_32x32x16_bf16(kf[1],qr[0],negm,0,0,0), P0[6],P0[7],P0[8],P0[9],     pw0[2]=PKW(P0,4), pw0[3]=PKW(P0,6), pw0); \
    VRD(1); SBAR(); GAPA(C0=__builtin_amdgcn_mfma_f32_32x32x16_bf16(kf[2],qr[1],C0,0,0,0),   P0[10],P0[11],P0[12],P0[13], pw1[0]=PKW(P0,8), pw1[1]=PKW(P0,10), pw1); \
    VRD(5); SBAR(); GAPA(C1=__builtin_amdgcn_mfma_f32_32x32x16_bf16(kf[3],qr[1],C1,0,0,0),   P0[14],P0[15],P1[0],P1[1],   pw1[2]=PKW(P0,12),pw1[3]=PKW(P0,14), pw1); \
    VRD(2); SBAR(); GAPA(C0=__builtin_amdgcn_mfma_f32_32x32x16_bf16(kf[4],qr[2],C0,0,0,0),   P1[2],P1[3],P1[4],P1[5],     pw2[0]=PKW(P1,0), pw2[1]=PKW(P1,2), pw2); \
    VRD(6); SBAR(); GAPA(C1=__builtin_amdgcn_mfma_f32_32x32x16_bf16(kf[5],qr[2],C1,0,0,0),   P1[6],P1[7],P1[8],P1[9],     pw2[2]=PKW(P1,4), pw2[3]=PKW(P1,6), pw2); \
    VRD(3); SBAR(); GAPA(C0=__builtin_amdgcn_mfma_f32_32x32x16_bf16(kf[6],qr[3],C0,0,0,0),   P1[10],P1[11],P1[12],P1[13], pw3[0]=PKW(P1,8), pw3[1]=PKW(P1,10), pw3); \
    VRD(7); SBAR(); GAPA(C1=__builtin_amdgcn_mfma_f32_32x32x16_bf16(kf[7],qr[3],C1,0,0,0),   P1[14],P1[15],0.f,0.f,       pw3[2]=PKW(P1,12),pw3[3]=PKW(P1,14), pw3); \
    l_reg+=sacc; \
    if(GK){DMA_K((t)+3,sl_cur);} if(GV){DMA_V((t)+1,sl_next);} \
    CMASK(C0,C1,t); \
    { float a=MX3(C0[0],C0[1],C1[0]),b=MX3(C0[2],C0[3],C1[1]); a=MX3(a,C1[2],C1[3]); \
      _Pragma("unroll") for(int r=4;r<16;r+=4){a=MX3(a,C0[r],C0[r+1]);b=MX3(b,C0[r+2],C0[r+3]);a=MX3(a,C1[r],C1[r+1]);b=MX3(b,C1[r+2],C1[r+3]);} \
      float rm=__builtin_fmaxf(a,b); { auto rr=__builtin_amdgcn_permlane32_swap(__float_as_uint(rm),__float_as_uint(rm),false,false); rm=__builtin_fmaxf(__uint_as_float(rr[0]),__uint_as_float(rr[1])); } \
      resc=false; \
      if(__builtin_expect(__any(rm>(float)THRL),0)){ const float dl=__builtin_fmaxf(rm,0.f); mhat+=dl; \
        _Pragma("unroll") for(int r=0;r<16;++r){C0[r]-=dl;C1[r]-=dl;} \
        _Pragma("unroll") for(int r=0;r<16;++r)negm[r]=-mhat; asm volatile("":"+v"(negm)); \
        const float f=__builtin_amdgcn_exp2f(-dl); l_reg*=f; if(hi==0)wsf[r32]=f; resc=true; } } \
    SBAR(); \
    GAPB(o[0]=__builtin_amdgcn_mfma_f32_32x32x16_bf16(PAF(0),VFR(0),o[0],0,0,0), C0,0); \
    GAPB(o[1]=__builtin_amdgcn_mfma_f32_32x32x16_bf16(PAF(0),VFR(4),o[1],0,0,0), C0,4); \
    KRD(GL,0); GAPB(o[0]=__builtin_amdgcn_mfma_f32_32x32x16_bf16(PAF(1),VFR(1),o[0],0,0,0), C0,8); \
    KRD(GL,1); GAPB(o[1]=__builtin_amdgcn_mfma_f32_32x32x16_bf16(PAF(1),VFR(5),o[1],0,0,0), C0,12); \
    KRD(GL,2); GAPB(o[0]=__builtin_amdgcn_mfma_f32_32x32x16_bf16(PAF(2),VFR(2),o[0],0,0,0), C1,0); \
    KRD(GL,3); GAPB(o[1]=__builtin_amdgcn_mfma_f32_32x32x16_bf16(PAF(2),VFR(6),o[1],0,0,0), C1,4); \
    GAPB(o[0]=__builtin_amdgcn_mfma_f32_32x32x16_bf16(PAF(3),VFR(3),o[0],0,0,0), C1,8); \
    GAPB(o[1]=__builtin_amdgcn_mfma_f32_32x32x16_bf16(PAF(3),VFR(7),o[1],0,0,0), C1,12); \
    }while(0)
  int t=1;
  for(;t+5<NT;t+=2){
    STEP(pB0,pB1,pA0,pA1,t,true,true,true);     WAIT_BAR(2); RESC(); ROT();
    STEP(pA0,pA1,pB0,pB1,t+1,true,true,true);   WAIT_BAR(2); RESC(); ROT();
  }
  #define ENDW(tt) do{ if((tt)+3<NT){WAIT_BAR(2);} else if((tt)+2<NT){WAIT_BAR(1);} else {WAIT_BAR(0);} }while(0)
  for(;t+1<NT;t+=2){
    STEP(pB0,pB1,pA0,pA1,t,(t+3<NT),(t+1<NT),(t+1<NT));       ENDW(t);   RESC(); ROT();
    STEP(pA0,pA1,pB0,pB1,t+1,(t+4<NT),(t+2<NT),(t+2<NT));     ENDW(t+1); RESC(); ROT();
  }
  STEP(pB0,pB1,pA0,pA1,NT-1,false,false,false); RESC();
  { float sacc=pB0[0]+pB0[1]; _Pragma("unroll") for(int r=2;r<16;++r)sacc+=pB0[r]; _Pragma("unroll") for(int r=0;r<16;++r)sacc+=pB1[r]; l_reg+=sacc;
    pw0=(u32x4){PKW(pB0,0),PKW(pB0,2),PKW(pB0,4),PKW(pB0,6)};pw1=(u32x4){PKW(pB0,8),PKW(pB0,10),PKW(pB0,12),PKW(pB0,14)};pw2=(u32x4){PKW(pB1,0),PKW(pB1,2),PKW(pB1,4),PKW(pB1,6)};pw3=(u32x4){PKW(pB1,8),PKW(pB1,10),PKW(pB1,12),PKW(pB1,14)};
    SBAR(); pv(o,vb0+sl_cur,PAF(0),PAF(1),PAF(2),PAF(3)); }
  #undef PKW
  #undef PAF
  #undef VFR
  #undef PIN
  #undef MX3
  #undef GAPA
  #undef GAPB
  #undef EX
  #undef VRD
  #undef KRD
  #undef STEP
  #undef ENDW
  {auto rr=__builtin_amdgcn_permlane32_swap(__float_as_uint(l_reg),__float_as_uint(l_reg),false,false);l_reg=__uint_as_float(rr[0])+__uint_as_float(rr[1]);}
  if(hi==0)wsf[32+r32]=l_reg;asm volatile("s_waitcnt lgkmcnt(0)":::"memory");
  float rli[16];
  #pragma unroll
  for(int r=0;r<16;++r)rli[r]=__builtin_amdgcn_rcpf(wsf[32+crow(r,hi)]);
  bf16*Ow=Ou+(long)(wid*QBLK)*OP;
  { bf16*stg=(bf16*)(shm+LDS_OST)+wid*2048;
    #pragma unroll
    for(int r=0;r<16;++r){const int orow=crow(r,hi);
      #pragma unroll
      for(int d0=0;d0<2;++d0)stg[orow*64+d0*32+r32]=__float2bfloat16(o[d0][r]*rli[r]);}
    asm volatile("s_waitcnt lgkmcnt(0)":::"memory");
    #pragma unroll
    for(int i=0;i<4;++i){const int row=i*8+(lane>>3),ch=lane&7; const u32x4 v=*(const u32x4*)(stg+row*64+ch*8); ATTN_STORE16(Ow+(long)row*OP+ch*8,v);} }
  asm volatile("s_waitcnt lgkmcnt(0)\n\ts_barrier":::"memory");
  #undef DMA_K
  #undef DMA_V
  #undef CMASK
  #undef START
  #undef RESC
  #undef ROT
}
constexpr int ATTN_LDS_BYTES=LDS_BYTES;
#undef SBAR
#undef WAIT_BAR
}


namespace hyf {
struct c32 { float x, y; };
typedef _Float16 h2 __attribute__((ext_vector_type(2)));
__device__ __forceinline__ c32 operator+(c32 a, c32 b) { return {a.x + b.x, a.y + b.y}; }
__device__ __forceinline__ c32 operator-(c32 a, c32 b) { return {a.x - b.x, a.y - b.y}; }
__device__ __forceinline__ c32 cmul(c32 a, c32 b) { return {a.x * b.x - a.y * b.y, a.x * b.y + a.y * b.x}; }
__device__ __forceinline__ constexpr float C32(int k) {
  switch (k) { case 0: return 1.f; case 1: return 0.98078528f; case 2: return 0.923879533f; case 3: return 0.831469612f; case 4: return 0.707106781f; case 5: return 0.555570233f; case 6: return 0.382683432f;
    case 7: return 0.195090322f; case 8: return 0.f; case 9: return -0.195090322f; case 10: return -0.382683432f; case 11: return -0.555570233f; case 12: return -0.707106781f; case 13: return -0.831469612f;
    case 14: return -0.923879533f; default: return -0.98078528f; } }
__device__ __forceinline__ constexpr float S32(int k) {
  switch (k) { case 0: return 0.f; case 1: return 0.195090322f; case 2: return 0.382683432f; case 3: return 0.555570233f; case 4: return 0.707106781f; case 5: return 0.831469612f; case 6: return 0.923879533f;
    case 7: return 0.98078528f; case 8: return 1.f; case 9: return 0.98078528f; case 10: return 0.923879533f; case 11: return 0.831469612f; case 12: return 0.707106781f; case 13: return 0.555570233f;
    case 14: return 0.382683432f; default: return 0.195090322f; } }
__device__ __forceinline__ constexpr int brev(int q, int bits) {
  return bits == 4 ? (((q & 1) << 3) | ((q & 2) << 1) | ((q & 4) >> 1) | ((q & 8) >> 3))
                   : (((q & 1) << 4) | ((q & 2) << 2) | (q & 4) | ((q & 8) >> 2) | ((q & 16) >> 4)); }
__device__ __forceinline__ int phys(int p) { return p + (p >> 5); }
template <int R, int HALF, bool INV> struct DftStage {
  static __device__ __forceinline__ void run(c32 (&x)[R]) {
#pragma unroll
    for (int blk = 0; blk < R; blk += 2 * HALF) {
#pragma unroll
      for (int j = 0; j < HALF; ++j) {
        const c32 a = x[blk + j], b = x[blk + j + HALF]; x[blk + j] = a + b; const c32 d = a - b;
        const int e = j * (R / (2 * HALF)) * (32 / R);
        if (e == 0) x[blk + j + HALF] = d;
        else if (e == 8) x[blk + j + HALF] = INV ? (c32){-d.y, d.x} : (c32){d.y, -d.x};
        else { const c32 wv = {C32(e), INV ? S32(e) : -S32(e)}; x[blk + j + HALF] = cmul(d, wv); }
      } }
    DftStage<R, HALF / 2, INV>::run(x);
  }
};
template <int R, bool INV> struct DftStage<R, 0, INV> { static __device__ __forceinline__ void run(c32 (&)[R]) {} };
template <int R, bool INV> __device__ __forceinline__ void dft_pow2(c32 (&x)[R]) { DftStage<R, R / 2, INV>::run(x); }
template <int R, int HALF> struct DitStage {
  static __device__ __forceinline__ void run(c32 (&x)[R]) {
#pragma unroll
    for (int blk = 0; blk < R; blk += 2 * HALF) {
#pragma unroll
      for (int j = 0; j < HALF; ++j) {
        const int e = j * (R / (2 * HALF)) * (32 / R);
        const c32 a = x[blk + j], b0 = x[blk + j + HALF];
        c32 b;
        if (e == 0) b = b0; else if (e == 8) b = (c32){-b0.y, b0.x}; else b = cmul(b0, (c32){C32(e), S32(e)});
        x[blk + j] = a + b; x[blk + j + HALF] = a - b;
      } }
    DitStage<R, HALF * 2>::run(x);
  }
};
template <int R> struct DitStage<R, R> { static __device__ __forceinline__ void run(c32 (&)[R]) {} };
template <int R> __device__ __forceinline__ void idft_dit(c32 (&x)[R]) { DitStage<R, 1>::run(x); }
template <int STRIDE, bool INV> __device__ __forceinline__ void pass16(c32* buf, int e0, float rev) {
  float rv = rev; asm volatile("" : "+v"(rv));
  const float cs = __builtin_amdgcn_cosf(rv), sn = __builtin_amdgcn_sinf(rv);
  const c32 w1 = {cs, INV ? sn : -sn};
  c32* p = buf + phys(e0); constexpr int PS = STRIDE + STRIDE / 32;
  c32 x[16];
  if (!INV) {
#pragma unroll
    for (int m = 0; m < 16; ++m) x[m] = p[PS * m];
    dft_pow2<16, false>(x);
    c32 w = w1; p[0] = x[0];
#pragma unroll
    for (int q = 1; q < 16; ++q) { p[PS * q] = cmul(x[brev(q, 4)], w); w = cmul(w, w1); }
  } else {
    c32 w = w1; x[0] = p[0];
#pragma unroll
    for (int q = 1; q < 16; ++q) { x[q] = cmul(p[PS * q], w); w = cmul(w, w1); }
    dft_pow2<16, true>(x);
#pragma unroll
    for (int m = 0; m < 16; ++m) p[PS * m] = x[brev(m, 4)];
  }
}
template <int MODE> __device__ __forceinline__ void mid32(c32* buf, h2* Hs, int j) {
  c32* p = buf + 33 * j; c32 x[32];
#pragma unroll
  for (int m = 0; m < 32; ++m) x[m] = p[m];
  dft_pow2<32, false>(x);
  if (MODE == 0) {
#pragma unroll
    for (int q = 0; q < 32; ++q) { const c32 v = x[brev(q, 5)]; Hs[q * 256 + j] = (h2){(_Float16)v.x, (_Float16)v.y}; }
  } else {
#pragma unroll
    for (int pp = 0; pp < 32; ++pp) { const h2 hv = Hs[brev(pp, 5) * 256 + j]; x[pp] = cmul(x[pp], (c32){(float)hv.x, (float)hv.y}); }
    idft_dit<32>(x);
#pragma unroll
    for (int m = 0; m < 32; ++m) p[m] = x[m];
  }
}
__device__ __forceinline__ void fwd2(c32* buf, int tid) {
  __syncthreads(); pass16<512, false>(buf, tid, (float)tid * (1.0f / 8192.0f));
  __syncthreads(); pass16<32, false>(buf, (tid >> 5) * 512 + (tid & 31), (float)(tid & 31) * (1.0f / 512.0f));
  __syncthreads();
}
__device__ __forceinline__ void conv(c32* buf, h2* Hs, int tid) {
  fwd2(buf, tid);
  if (tid < 256) mid32<1>(buf, Hs, tid);
  __syncthreads(); pass16<32, true>(buf, (tid >> 5) * 512 + (tid & 31), (float)(tid & 31) * (1.0f / 512.0f));
  __syncthreads(); pass16<512, true>(buf, tid, (float)tid * (1.0f / 8192.0f));
  __syncthreads();
}
__device__ __forceinline__ void item(int c, const bf16_t* HYT, const float* HK, const float* hy_bias, bf16_t* HYO, char* lds) {
  c32* buf = (c32*)lds; h2* H0 = (h2*)(lds + 67584); h2* H1 = H0 + 8192;
  const int tid = TIDX;
#pragma unroll 1
  for (int o = 0; o < 2; ++o) {
    const float* kp = HK + ((size_t)o * 256 + c) * 8192;
#pragma unroll
    for (int i = 0; i < 16; ++i) { const int n = tid + 512 * i; buf[phys(n)] = (c32){kp[n], 0.f}; }
    fwd2(buf, tid);
    if (tid < 256) mid32<0>(buf, o ? H1 : H0, tid);
    __syncthreads();
  }
  const float bias0 = hy_bias[c], bias1 = hy_bias[256 + c];
#pragma unroll 1
  for (int pr = 0; pr < 2; ++pr) {
    const bf16_t* v0 = HYT + ((size_t)(2 * pr) * 768 + c) * SEQ; const bf16_t* v1 = v0 + (size_t)768 * SEQ;
    c32 vv[8];
#pragma unroll
    for (int i = 0; i < 8; ++i) { const int t = tid + 512 * i; vv[i] = (c32){bf2f(v0[t]), bf2f(v1[t])}; buf[phys(t)] = vv[i]; buf[phys(t + 4096)] = (c32){0.f, 0.f}; }
    conv(buf, H0, tid);
#pragma unroll
    for (int i = 0; i < 8; ++i) { const int t = tid + 512 * i; const c32 y = buf[phys(t)];
      vv[i] = (c32){bf2f(v0[(size_t)256 * SEQ + t]) * (y.x * (1.0f / 8192.0f) + bias0 * vv[i].x), bf2f(v1[(size_t)256 * SEQ + t]) * (y.y * (1.0f / 8192.0f) + bias0 * vv[i].y)};
      buf[phys(t)] = vv[i]; buf[phys(t + 4096)] = (c32){0.f, 0.f}; }
    conv(buf, H1, tid);
#pragma unroll
    for (int i = 0; i < 8; ++i) { const int t = tid + 512 * i; const c32 y = buf[phys(t)];
      HYO[((size_t)(2 * pr) * 256 + c) * SEQ + t] = (bf16_t)f2bf(bf2f(v0[(size_t)512 * SEQ + t]) * (y.x * (1.0f / 8192.0f) + bias1 * vv[i].x));
      HYO[((size_t)(2 * pr + 1) * 256 + c) * SEQ + t] = (bf16_t)f2bf(bf2f(v1[(size_t)512 * SEQ + t]) * (y.y * (1.0f / 8192.0f) + bias1 * vv[i].y)); }
    __syncthreads();
  }
}
__device__ __forceinline__ void out_item(int it, const bf16_t* HYO, bf16_t* MIX, char* lds) {
  bf16_t (*T)[72] = (bf16_t (*)[72])lds;
  const int tid = TIDX, b = it >> 8, t0 = ((it >> 2) & 63) * 64, c0 = (it & 3) * 64;
  { const int cc = tid >> 3, t8 = (tid & 7) * 8; *(u32x4*)&T[cc][t8] = *(const u32x4*)(HYO + ((size_t)b * 256 + c0 + cc) * SEQ + t0 + t8); }
  __syncthreads();
  { const int tl = tid >> 3, c8 = (tid & 7) * 8; u32x4 o;
    o.x = (unsigned)T[c8][tl] | ((unsigned)T[c8 + 1][tl] << 16); o.y = (unsigned)T[c8 + 2][tl] | ((unsigned)T[c8 + 3][tl] << 16);
    o.z = (unsigned)T[c8 + 4][tl] | ((unsigned)T[c8 + 5][tl] << 16); o.w = (unsigned)T[c8 + 6][tl] | ((unsigned)T[c8 + 7][tl] << 16);
    *(u32x4*)(MIX + ((size_t)b * TPB + CTXL + t0 + tl) * DM + 768 + c0 + c8) = o; }
  __syncthreads();
}
}

#define LAS __attribute__((address_space(3)))
#define XB_TMO      128
#define XB_XCNT(j)  (256  + 64 * (j))
#define XB_XSUB(j)  (1280 + 64 * (j))
#define XB_XGEN(j)  (2304 + 64 * (j))
#define XB_TOP      3328
#define XB_TOPGEN   3392
#define XCD_BAR_WORDS 3456
#define XB_SPIN_CAP (1u << 18)

__device__ __forceinline__ unsigned xb_ld(unsigned* p)              { return __hip_atomic_load(p, __ATOMIC_RELAXED, __HIP_MEMORY_SCOPE_AGENT); }
__device__ __forceinline__ unsigned xb_add(unsigned* p, unsigned v) { return __hip_atomic_fetch_add(p, v, __ATOMIC_RELAXED, __HIP_MEMORY_SCOPE_AGENT); }
__device__ __forceinline__ unsigned xb_xcc_id() { return (unsigned)__builtin_amdgcn_s_getreg((3 << 11) | 20) & 0xFu; }
#define XB_SPIN(cond, bar) do { unsigned _sp = 0; while (cond) { __builtin_amdgcn_s_sleep(1); \
    if ((++_sp & 255u) == 0u) { if (xb_ld(&(bar)[XB_TMO])) break; if (_sp > XB_SPIN_CAP) { atomicAdd(&(bar)[XB_TMO], 1u); break; } } } } while (0)

struct XcdBarrier {
    unsigned* bar; unsigned x;
    volatile LAS unsigned* st;
};

__device__ __forceinline__ XcdBarrier xcd_barrier_post(unsigned* bar, volatile LAS unsigned* st) {
    XcdBarrier b; b.bar = bar; b.x = xb_xcc_id(); b.st = st;
    if (threadIdx.x == 0) (void)xb_add(&bar[XB_XCNT(b.x)], 1u);
    return b;
}
__device__ __forceinline__ void xcd_barrier_complete(unsigned* bar, unsigned x, unsigned& nloc, unsigned& nx) {
    const unsigned G = gridDim.x * gridDim.y * gridDim.z;
    unsigned sum, cnt, mine, sp = 0u;
    for (;;) {
        sum = 0u; cnt = 0u; mine = 0u;
#pragma unroll
        for (unsigned j = 0; j < 16; ++j) { const unsigned c = xb_ld(&bar[XB_XCNT(j)]); sum += c; cnt += (c > 0u) ? 1u : 0u; mine = (j == x) ? c : mine; }
        if (sum == G) break;
        __builtin_amdgcn_s_sleep(1);
        if ((++sp & 255u) == 0u) { if (xb_ld(&bar[XB_TMO])) break; if (sp > XB_SPIN_CAP) { atomicAdd(&bar[XB_TMO], 1u); break; } }
    }
    nloc = mine > 0u ? mine : 1u; nx = cnt > 0u ? cnt : 1u;
}

__device__ __forceinline__ void xcd_barrier(const XcdBarrier& b) {
    asm volatile("s_waitcnt vmcnt(0)" ::: "memory");
    __syncthreads();
    if (threadIdx.x == 0) {
        unsigned* bar = b.bar;
        __builtin_amdgcn_s_waitcnt(0);
        unsigned nloc = b.st[0], nx = b.st[1];
        if (nloc == 0u) { xcd_barrier_complete(bar, b.x, nloc, nx); b.st[0] = nloc; b.st[1] = nx; }
        const unsigned old = xb_add(&bar[XB_XSUB(b.x)], 1u);
        const unsigned gen = old / nloc;
        if (old + 1u == (gen + 1u) * nloc) {
            __builtin_amdgcn_fence(__ATOMIC_RELEASE, "agent");
            asm volatile("s_waitcnt vmcnt(0)" ::: "memory");
            const unsigned og = xb_add(&bar[XB_TOP], 1u);
            const unsigned tg = og / nx;
            if (og + 1u == (tg + 1u) * nx) xb_add(&bar[XB_TOPGEN], 1u);
            else XB_SPIN(xb_ld(&bar[XB_TOPGEN]) == tg, bar);
            __builtin_amdgcn_fence(__ATOMIC_ACQUIRE, "agent");
            xb_add(&bar[XB_XGEN(b.x)], 1u);
            asm volatile("s_waitcnt vmcnt(0)" ::: "memory");
        } else {
            XB_SPIN(xb_ld(&bar[XB_XGEN(b.x)]) == gen, bar);
            __builtin_amdgcn_fence(__ATOMIC_ACQUIRE, "agent");
            asm volatile("s_waitcnt vmcnt(0)" ::: "memory");
        }
    }
    __syncthreads();
}


struct MP { const float* in[33]; float* out; unsigned char* ws; };
typedef const float* const __attribute__((address_space(4))) * kargs_t;
#define KARGS() ({ kargs_t k_ = (kargs_t)__builtin_amdgcn_kernarg_segment_ptr(); asm volatile("" : "+s"(k_)); k_; })
#define WSP(K, off) ((unsigned char*)(K)[34] + (off))

__global__ void __launch_bounds__(NT, 2) mega(MP P) {
  cg::grid_group grid = cg::this_grid();
  extern __shared__ __attribute__((aligned(16))) char lds[];
  volatile LAS unsigned* xst = (volatile LAS unsigned*)(lds + LDS_BYTES - 16);
  if (threadIdx.x < 2) xst[threadIdx.x] = 0u;
  __syncthreads();
  { kargs_t K = KARGS(); (void)xcd_barrier_post((unsigned*)WSP(K, WS_CTL) + CT_BAR, xst); }
#define XBAR_HERE() do { kargs_t Kb_ = KARGS(); XcdBarrier xb_; xb_.bar = (unsigned*)WSP(Kb_, WS_CTL) + CT_BAR; xb_.x = xb_xcc_id(); xb_.st = (volatile LAS unsigned*)(lds + LDS_BYTES - 16); xcd_barrier(xb_); } while (0)
#define SEAM() XBAR_HERE()
  {
    kargs_t K = KARGS();
    st_adaln(K[1], K[3], K[4], K[5], (float*)WSP(K, WS_MODV), lds);
    st_rope((float*)WSP(K, WS_ROPE));
  }
  {
      kargs_t K = KARGS();
      st_weights(K[8], K[26], K[29], K[30], K[31], 0, (bf16_t*)WSP(K, WS_WIN), (bf16_t*)WSP(K, WS_WOUT), (bf16_t*)WSP(K, WS_WGU), (bf16_t*)WSP(K, WS_WD), lds);
    }
    { kargs_t K = KARGS(); const int bid = BIDX, G = GDIM;
      for (int it = bid; it < SEQ / 16; it += G) hyfilt_item<SEQ>(it, K[19] + 0 * 33 * 64, K[20] + 0 * 64, K[21] + 0 * 64, K[22] + 0 * 4096, K[23] + 0 * 64, K[24] + (size_t)0 * 65536, (float*)WSP(K, WS_HK), lds);
      if (true) for (int it = bid; it < CTXL / 16; it += G) hyfilt_item<CTXL>(it, K[19] + 0 * 33 * 64, K[20] + 0 * 64, K[21] + 0 * 64, K[22] + 0 * 4096, K[23] + 0 * 64, K[24] + (size_t)0 * 65536, (float*)WSP(K, WS_HKC), lds);
    }
  if (gridDim.x == 0x7fffffffu) grid.sync();
  XBAR_HERE();
#pragma nounroll
  for (int layer = 0; layer < 2; ++layer) {
    const bool last = layer == 1;
    if (layer == 1) {
    {
      kargs_t K = KARGS();
      st_weights(K[8], K[26], K[29], K[30], K[31], layer, (bf16_t*)WSP(K, WS_WIN), (bf16_t*)WSP(K, WS_WOUT), (bf16_t*)WSP(K, WS_WGU), (bf16_t*)WSP(K, WS_WD), lds);
    }
    { kargs_t K = KARGS(); const int bid = BIDX, G = GDIM;
      for (int it = bid; it < SEQ / 16; it += G) hyfilt_item<SEQ>(it, K[19] + layer * 33 * 64, K[20] + layer * 64, K[21] + layer * 64, K[22] + layer * 4096, K[23] + layer * 64, K[24] + (size_t)layer * 65536, (float*)WSP(K, WS_HK), lds);
      if (!last) for (int it = bid; it < CTXL / 16; it += G) hyfilt_item<CTXL>(it, K[19] + layer * 33 * 64, K[20] + layer * 64, K[21] + layer * 64, K[22] + layer * 4096, K[23] + layer * 64, K[24] + (size_t)layer * 65536, (float*)WSP(K, WS_HKC), lds);
    }
    }
    { kargs_t K = KARGS();
      st_normmod(K[0], K[2], (bf16_t*)WSP(K, WS_H), layer == 0 ? (const bf16_t*)nullptr : (const bf16_t*)WSP(K, WS_H2S), (const int*)WSP(K, WS_MOEM + 768 * 1024),
                 (const float*)WSP(K, WS_MODV) + 5120, K[6] + layer * 1024, (const float*)WSP(K, WS_MODV) + (size_t)layer * 5 * 6144, 0, 1024, (bf16_t*)K[33], lds);
    }
    SEAM();
    {
      kargs_t K = KARGS();
      pg8::Gemm g{1024, 1024, 1024}; SchedDense S{MTOK / 256, NPAD / 256, (int)GDIM, BIDX, 0, (const char*)K[33], (const char*)WSP(K, WS_WIN), (size_t)256 * 1024 * 2, (size_t)256 * 1024 * 2, 0};
      EpiInProj E{(bf16_t*)WSP(K, WS_QK), (bf16_t*)WSP(K, WS_VZ), (bf16_t*)WSP(K, WS_XBC), (bf16_t*)WSP(K, WS_HY), (float*)WSP(K, WS_DT)};
      pg8::gemm_phase<EpiInProj, SchedDense, true, true>((PG8_LAS unsigned char*)lds, g, S, E);
      if (IN_HALF) { S.part = 1; pg8::gemm_phase<EpiInProj, SchedDense, true, true, true>((PG8_LAS unsigned char*)lds, g, S, E); }
    }
    SEAM();
    {
      kargs_t K = KARGS();
      st_prep_qk((bf16_t*)WSP(K, WS_QK), K[9] + layer * 64, K[10] + layer * 64, (const float*)WSP(K, WS_ROPE));
    }
    { kargs_t K = KARGS();
      st_prep_hy((const bf16_t*)WSP(K, WS_HY), K[17] + layer * 3 * 768, K[18] + layer * 768, (bf16_t*)WSP(K, WS_HYT), last ? 0 : 1, lds);
    }
    { kargs_t K = KARGS();
      st_ssd1(BIDX, GDIM, 4 * 34 * 6, (const bf16_t*)WSP(K, WS_XBC), (const float*)WSP(K, WS_DT), K[11] + layer * 3 * 640, K[12] + layer * 640, K[13] + layer * 12, K[14] + layer * 12,
              (bf16_t*)WSP(K, WS_Y), (bf16_t*)WSP(K, WS_ST), (float*)WSP(K, WS_DEC), lds);
    }
    SEAM();
    {
      { kargs_t K2 = KARGS(); st_ssd_scan2((bf16_t*)WSP(K2, WS_ST), (const float*)WSP(K2, WS_DEC)); }
      const int bid = BIDX, G = GDIM;
#define P4_ATT(bb, hq, qrow_, nt_) do { kargs_t K = KARGS(); const int kvh_ = (hq) / 3; \
          const attn_body::bf16* QKp = (const attn_body::bf16*)WSP(K, WS_QK); const attn_body::bf16* VZp = (const attn_body::bf16*)WSP(K, WS_VZ); \
          attn_body::attn_unit<8>(QKp + (size_t)(qrow_) * 512 + (hq) * 64, QKp + (size_t)(bb) * TPB * 512 + 384 + kvh_ * 64, VZp + (size_t)(bb) * TPB * 512 + kvh_ * 64, \
                                  (attn_body::bf16*)K[33] + (size_t)(qrow_) * 1024 + (hq) * 64, (nt_), lds); } while (0)
#define P4_FFT(cch) do { kargs_t K = KARGS(); hyf::item((cch), (const bf16_t*)WSP(K, WS_HYT), (const float*)WSP(K, WS_HK), K[25] + layer * 512, (bf16_t*)WSP(K, WS_HY), lds); } while (0)
#define P4_CHY(itm) do { kargs_t K = KARGS(); hyconv_ctx_item((itm), (const bf16_t*)WSP(K, WS_HYT) + (size_t)4 * 768 * SEQ, (const float*)WSP(K, WS_HKC), K[25] + layer * 512, (bf16_t*)K[33], lds); } while (0)
      {
        const int x = bid & 7, y = bid >> 3, bb = x >> 1, kvh = x & 1;
        const int nun = y < 16 ? 2 : 1, natt = nun + ((!last && y < 3) ? 1 : 0);
#pragma unroll 1
        for (int k = 0; k < natt; ++k) { int hq, qrow, nt;
          if (k < nun) { const int v = y < 16 ? y + 16 * k : 16 + y; hq = 3 * kvh + (v >> 4); qrow = bb * TPB + CTXL + (v & 15) * 256; nt = TPB / 64; }
          else { hq = 3 * kvh + y; qrow = bb * TPB; nt = CTXL / 64; }
          P4_ATT(bb, hq, qrow, nt); }
        if (y >= 16) {
#pragma unroll 1
          for (int k = 0; k < 2; ++k) { const int cch = ((y - 16) * 8 + x) * 2 + k; P4_FFT(cch); } }
        if (!last && y >= 3 && y < 11) { P4_CHY((y - 3) * 8 + x); }
      }
      (void)G;
#undef P4_ATT
#undef P4_FFT
#undef P4_CHY
    }
    SEAM();
    {
      kargs_t K = KARGS();
      { const int bid = BIDX, G = GDIM, nit = last ? 4 * 32 * 2 : 4 * 34 * 2;
        for (int it = bid; it < nit; it += G) { const int g = it & 1, bc = it >> 1; const int b = last ? bc >> 5 : bc / 34, cidx = last ? 2 + (bc & 31) : bc % 34;
          ssd3_item(b, cidx, g, (const bf16_t*)WSP(K, WS_XBC), (const bf16_t*)WSP(K, WS_VZ), (const float*)WSP(K, WS_DT), K[11] + layer * 3 * 640, K[12] + layer * 640, K[13] + layer * 12, K[14] + layer * 12,
                    K[15] + layer * 6, K[16] + layer * 384, (const bf16_t*)WSP(K, WS_Y), (const bf16_t*)WSP(K, WS_ST), (bf16_t*)K[33], lds); } }
      { const int bid = BIDX, G = GDIM; for (int it = bid; it < 1024; it += G) hyf::out_item(it, (const bf16_t*)WSP(K, WS_HY), (bf16_t*)K[33], lds); }
      const int t = TIDX; if (BIDX == 0 && t < 256) ((int*)WSP(K, WS_CTL))[t] = 0;
      { int* stok = (int*)WSP(K, WS_MOEM + 384 * 1024); for (int i = BIDX * NT + t; i < MOE_ROWS; i += GDIM * NT) stok[i] = -1; }
    }
    SEAM();
    {
      kargs_t K = KARGS();
      pg8::Gemm g{1024, 1024, 1024}; SchedDense S{last ? 64 : 68, 4, (int)GDIM, BIDX, last ? 1 : 0, (const char*)K[33], (const char*)WSP(K, WS_WOUT), (size_t)256 * 1024 * 2, (size_t)256 * 1024 * 2, 0};
      EpiOutProj E{(bf16_t*)WSP(K, WS_QK)};
      pg8::gemm_phase<EpiOutProj, SchedDense, true, true>((PG8_LAS unsigned char*)lds, g, S, E);
      S.part = 1; pg8::gemm_phase<EpiOutProj, SchedDense, true, true, true>((PG8_LAS unsigned char*)lds, g, S, E);
    }
    SEAM();
    {
      kargs_t K = KARGS();
      st_router(K[0], K[2], layer == 0 ? 1 : 0, (bf16_t*)WSP(K, WS_H), (const bf16_t*)WSP(K, WS_QK), K[7] + layer * 1024, (const float*)WSP(K, WS_MODV) + (size_t)layer * 5 * 6144, K[27], K[28], (bf16_t*)K[33], (int*)WSP(K, WS_CTL),
                (int*)WSP(K, WS_MOEM), (float*)WSP(K, WS_MOEM + 128 * 1024), last ? 1 : 0, lds);
    }
    SEAM();
    { kargs_t K = KARGS();
      st_moe_gather((const bf16_t*)K[33], (bf16_t*)WSP(K, WS_H2S), (int*)WSP(K, WS_CTL), (const int*)WSP(K, WS_MOEM), (const float*)WSP(K, WS_MOEM + 128 * 1024),
                    (int*)WSP(K, WS_MOEM + 384 * 1024), (float*)WSP(K, WS_MOEM + 512 * 1024), (int*)WSP(K, WS_MOEM + 768 * 1024), last ? 1 : 0, lds);
    }
    SEAM();
    { kargs_t K = KARGS();
      pg8::Gemm g{1024, 1024, 1024}; SchedMoe S{(int)GDIM, BIDX, 1, (const int*)WSP(K, WS_CTL), (const char*)WSP(K, WS_H2S), (size_t)256 * 1024 * 2, (const char*)WSP(K, WS_WGU), 0};
      EpiMoe1 E{(bf16_t*)WSP(K, WS_ACT), (const float*)WSP(K, WS_MOEM + 512 * 1024)};
      pg8::gemm_phase<EpiMoe1, SchedMoe, true, true>((PG8_LAS unsigned char*)lds, g, S, E);
      S.tail = 1; pg8::gemm_phase<EpiMoe1, SchedMoe, true, true, true>((PG8_LAS unsigned char*)lds, g, S, E);
    }
    SEAM();
    { kargs_t K = KARGS();
      pg8::Gemm g{256, 512, 256}; SchedMoe S{(int)GDIM, BIDX, 2, (const int*)WSP(K, WS_CTL), (const char*)WSP(K, WS_ACT), (size_t)256 * 512 * 2, (const char*)WSP(K, WS_WD), 0};
      EpiMoe2 E{(bf16_t*)WSP(K, WS_H2S)};
      pg8::gemm_phase<EpiMoe2, SchedMoe, true, true>((PG8_LAS unsigned char*)lds, g, S, E);
      S.tail = 1; pg8::gemm_phase<EpiMoe2, SchedMoe, true, true, true>((PG8_LAS unsigned char*)lds, g, S, E);
    }
    SEAM();
  }
  { kargs_t K = KARGS(); st_final((float*)K[33], K[32], (const bf16_t*)WSP(K, WS_H), (const bf16_t*)WSP(K, WS_H2S), (const int*)WSP(K, WS_MOEM + 768 * 1024), (const float*)WSP(K, WS_MODV) + (size_t)5 * 6144 + 5120); }
}

extern "C" void kernel_launch(void* const* d_in, const int* in_sizes, int n_in, void* d_out, int out_size, void* d_ws, size_t ws_size, hipStream_t stream) {
  if (n_in != 33 || ws_size < WS_END) { fprintf(stderr, "kernel_launch: unexpected n_in %d / ws %zu\n", n_in, ws_size); return; }
  static int grid_blocks = 0;
  if (!grid_blocks) {
    int dev = 0, cus = 0, per_cu = 0;
    (void)hipGetDevice(&dev);
    (void)hipDeviceGetAttribute(&cus, hipDeviceAttributeMultiprocessorCount, dev);
    (void)hipFuncSetAttribute((const void*)mega, hipFuncAttributeMaxDynamicSharedMemorySize, LDS_BYTES);
    (void)hipOccupancyMaxActiveBlocksPerMultiprocessor(&per_cu, mega, NT, LDS_BYTES);
    if (per_cu < 1) per_cu = 1;
    if (per_cu > 2) per_cu = 2;
    grid_blocks = 256;
    if (cus != 256 || per_cu < 1) fprintf(stderr, "kernel_launch: expected 256 CUs with >= 1 workgroup each (got %d CUs, %d per CU)\n", cus, per_cu);
  }
  (void)hipMemsetAsync((char*)d_ws + WS_CTL + (size_t)CT_BAR * 4, 0, (size_t)XCD_BAR_WORDS * 4, stream);
  MP p{};
  for (int i = 0; i < 33; ++i) p.in[i] = (const float*)d_in[i];
  p.out = (float*)d_out; p.ws = (unsigned char*)d_ws;
  void* args[] = {&p};
  hipError_t e = hipLaunchCooperativeKernel((const void*)mega, dim3(grid_blocks), dim3(NT), args, LDS_BYTES, stream);
  if (e != hipSuccess) fprintf(stderr, "cooperative launch failed: %s (grid %d)\n", hipGetErrorString(e), grid_blocks);
}
```

```cpp
#include <hip/hip_runtime.h>
#include <hip/hip_cooperative_groups.h>
#include <cstdio>
#include <cstdint>
namespace cg = cooperative_groups;

typedef unsigned short bf16_t;
typedef short bf16x8 __attribute__((ext_vector_type(8)));
typedef float f32x4 __attribute__((ext_vector_type(4)));
typedef unsigned u32x4 __attribute__((ext_vector_type(4)));
typedef unsigned u32x2 __attribute__((ext_vector_type(2)));

constexpr int NB = 4, SEQ = 4096, CTXL = 256, DM = 1024, TPB = 4352, MTOK = NB * TPB;
constexpr int DIN = 2444, NPAD = 2560;
constexpr float EPS = 1e-6f;
constexpr float C2 = 0.125f * 1.4426950408889634f;
constexpr int MOE_ROWS = 23552;
constexpr int NT = 512;
constexpr int LDS_BYTES = 147456;

constexpr size_t MiB = 1u << 20;
constexpr size_t WS_CTL = 0;
constexpr size_t WS_MODV = 1 * MiB;
constexpr size_t WS_ROPE = 2 * MiB;
constexpr size_t WS_MOEM = 3 * MiB;
constexpr size_t WS_DT = 4 * MiB;
constexpr size_t WS_HKC = 5 * MiB;
constexpr size_t WS_XC = 6 * MiB;
constexpr size_t WS_WIN = 10 * MiB;
constexpr size_t WS_WOUT = 15 * MiB;
constexpr size_t WS_WGU = 17 * MiB;
constexpr size_t WS_WD = 33 * MiB;
constexpr size_t WS_HK = 41 * MiB;
constexpr size_t WS_H = 57 * MiB;
constexpr size_t WS_QK = 91 * MiB;
constexpr size_t WS_VZ = 108 * MiB;
constexpr size_t WS_XBC = 125 * MiB;
constexpr size_t WS_HY = WS_XBC + (size_t)MTOK * 768 * 2;
constexpr size_t WS_HYT = WS_HY + (size_t)MTOK * 768 * 2;
constexpr size_t WS_ST = WS_HYT + (size_t)MTOK * 768 * 2;
constexpr size_t WS_Y = WS_ST + (size_t)4 * 34 * 2 * 6 * 4096 * 4;
constexpr size_t WS_END = WS_Y + (size_t)MTOK * 384 * 4;
constexpr size_t WS_DEC = WS_DT + 900 * 1024;
constexpr size_t WS_H2S = WS_QK;
constexpr size_t WS_ACT = WS_H2S + (size_t)MOE_ROWS * 1024 * 2;
static_assert(WS_END <= 256 * MiB, "ws");
static_assert(WS_ACT + (size_t)MOE_ROWS * 512 * 2 <= WS_HYT, "moe alias");

constexpr int CT_CNT = 0, CT_FILL = 32, CT_BASE = 64, CT_NT = 96, CT_TP = 128;
constexpr int CT_BAR = 4096;
constexpr bool IN_HALF = false;
constexpr int CT_CNTB = 8192;

__device__ __forceinline__ int opq_v(int v) { asm volatile("" : "+v"(v)); return v; }
__device__ __forceinline__ int opq_s(int v) { asm volatile("" : "+s"(v)); return v; }
#define TIDX opq_v((int)threadIdx.x)
#define BIDX opq_s((int)blockIdx.x)
#define GDIM opq_s((int)gridDim.x)
__device__ __forceinline__ unsigned f2bf(float f) { unsigned u = __float_as_uint(f); return (u + 0x7fffu + ((u >> 16) & 1u)) >> 16; }
__device__ __forceinline__ unsigned pk2bf(float lo, float hi) { return f2bf(lo) | (f2bf(hi) << 16); }
__device__ __forceinline__ float bf2f(bf16_t h) { return __uint_as_float(((unsigned)h) << 16); }
__device__ __forceinline__ float wave_sum(float v) {
#pragma unroll
  for (int o = 1; o < 64; o <<= 1) v += __shfl_xor(v, o);
  return v;
}
__device__ __forceinline__ float siluf(float v) { return v / (1.0f + __expf(-v)); }
__device__ __forceinline__ float* xrow(const float* xl, const float* xc, int r) {
  const int b = r / TPB, j = r - b * TPB;
  return (float*)(j < CTXL ? xc + ((size_t)b * CTXL + j) * DM : xl + ((size_t)b * SEQ + (j - CTXL)) * DM);
}
__device__ __forceinline__ int mrow_of(int r) { const int b = r / TPB, j = r - b * TPB; return j < CTXL ? 4 : b; }

__device__ __forceinline__ void st_adaln(const float* c, const float* c_ctx, const float* w_mod, const float* b_mod, float* modv, char* lds) {
  float (*sc)[1024] = (float (*)[1024])lds;
  float (*red)[5][64] = (float (*)[5][64])(lds + 5 * 1024 * 4);
  const int tid = TIDX;
  for (int it = BIDX; it < 192; it += GDIM) {
    const int layer = it / 96, n0 = (it % 96) * 64;
#pragma unroll
    for (int i = tid; i < 5 * 1024; i += NT) { const int r = i >> 10, k = i & 1023; const float v = r < 4 ? c[r * 1024 + k] : c_ctx[k]; sc[r][k] = v / (1.0f + __expf(-v)); }
    __syncthreads();
    const int kg = tid >> 6, n = tid & 63;
    float acc[5] = {0.f, 0.f, 0.f, 0.f, 0.f};
#pragma unroll 16
    for (int k = kg; k < 1024; k += 8) { const float w = w_mod[((size_t)layer * 1024 + k) * 6144 + n0 + n];
#pragma unroll
      for (int r = 0; r < 5; ++r) acc[r] += sc[r][k] * w; }
#pragma unroll
    for (int r = 0; r < 5; ++r) red[kg][r][n] = acc[r];
    __syncthreads();
    if (tid < 320) { const int r = tid >> 6, nn = tid & 63; float s = 0.f;
#pragma unroll
      for (int g = 0; g < 8; ++g) s += red[g][r][nn];
      modv[((size_t)layer * 5 + r) * 6144 + n0 + nn] = s + b_mod[layer * 6144 + n0 + nn]; }
    __syncthreads();
  }
}
__device__ __forceinline__ void st_rope(float* rope) {
  for (int i = BIDX * NT + TIDX; i < 4096 * 32; i += GDIM * NT) {
    const int t = i >> 5, d = i & 31, m = d & 15;
    const float inv = exp2f(-(float)(2 * m) * (13.287712379549449f / 32.0f));
    const float pos = (float)(d < 16 ? (t >> 6) : (t & 63));
    float rev = pos * inv * 0.15915494309189535f; rev -= floorf(rev);
    rope[2 * i] = __builtin_amdgcn_cosf(rev); rope[2 * i + 1] = __builtin_amdgcn_sinf(rev);
  }
}

__device__ __forceinline__ void st_normmod(const float* xl, const float* xc, bf16_t* XB, const bf16_t* YS, const int* tok_slot, const float* gate_prev,
                                           const float* g, const float* modv_layer, int off_sh, int off_sc, bf16_t* H, char* lds) {
  float* mA = (float*)lds; float* mB = mA + 5 * 1024; float* mG = mB + 5 * 1024;
  const int tid = TIDX, lane = tid & 63, gw = BIDX * 8 + (tid >> 6), ngw = GDIM * 8;
  { f32x4 g4[3], sc4[3], sh4[3], gp4[3];
#pragma unroll
    for (int i = 0; i < 3; ++i) { const int q = tid + NT * i, qc = q < 1280 ? q : 0, m = qc >> 8, k = (qc & 255) * 4;
      g4[i] = *(const f32x4*)(g + k); sc4[i] = *(const f32x4*)(modv_layer + (size_t)m * 6144 + off_sc + k); sh4[i] = *(const f32x4*)(modv_layer + (size_t)m * 6144 + off_sh + k);
      gp4[i] = YS ? *(const f32x4*)(gate_prev + (size_t)m * 6144 + k) : (f32x4){0.f, 0.f, 0.f, 0.f}; }
#pragma unroll
    for (int i = 0; i < 3; ++i) { const int q = tid + NT * i;
      if (q < 1280) { *(f32x4*)(mA + 4 * q) = g4[i] * ((f32x4){1.f, 1.f, 1.f, 1.f} + sc4[i]); *(f32x4*)(mB + 4 * q) = sh4[i]; *(f32x4*)(mG + 4 * q) = gp4[i]; } } }
  __syncthreads();
  for (int rb = gw; rb < MTOK; rb += 3 * ngw) {
    f32x4 v[3][4]; float rstd[3];
    if (!YS) {
#pragma unroll
      for (int u = 0; u < 3; ++u) { const int r = rb + u * ngw, rc = r < MTOK ? r : MTOK - 1; const float* xr = xrow(xl, xc, rc);
#pragma unroll
        for (int j = 0; j < 4; ++j) v[u][j] = *(const f32x4*)(xr + 4 * lane + 256 * j); }
    } else {
      u32x2 xb[3][4], ys[3][4];
#pragma unroll
      for (int u = 0; u < 3; ++u) { const int r = rb + u * ngw, rc = r < MTOK ? r : MTOK - 1; const bf16_t* xr = XB + (size_t)rc * DM; const bf16_t* yr = YS + (size_t)tok_slot[rc] * DM;
#pragma unroll
        for (int j = 0; j < 4; ++j) { xb[u][j] = *(const u32x2*)(xr + 4 * lane + 256 * j); ys[u][j] = *(const u32x2*)(yr + 4 * lane + 256 * j); } }
#pragma unroll
      for (int u = 0; u < 3; ++u) { const int r = rb + u * ngw, rc = r < MTOK ? r : MTOK - 1; const int mo = mrow_of(rc) * 1024;
#pragma unroll
        for (int j = 0; j < 4; ++j) { const int k = 4 * lane + 256 * j; const f32x4 g4 = *(const f32x4*)(mG + mo + k);
          const f32x4 x4 = (f32x4){__uint_as_float(xb[u][j].x << 16), __uint_as_float(xb[u][j].x & 0xffff0000u), __uint_as_float(xb[u][j].y << 16), __uint_as_float(xb[u][j].y & 0xffff0000u)};
          const f32x4 m4 = (f32x4){__uint_as_float(ys[u][j].x << 16), __uint_as_float(ys[u][j].x & 0xffff0000u), __uint_as_float(ys[u][j].y << 16), __uint_as_float(ys[u][j].y & 0xffff0000u)};
          v[u][j] = x4 + g4 * m4;
          if (r < MTOK) { u32x2 w; w.x = pk2bf(v[u][j].x, v[u][j].y); w.y = pk2bf(v[u][j].z, v[u][j].w); *(u32x2*)(XB + (size_t)r * DM + k) = w; } } }
    }
#pragma unroll
    for (int u = 0; u < 3; ++u) { float ss = 0.f;
#pragma unroll
      for (int j = 0; j < 4; ++j) ss += v[u][j].x * v[u][j].x + v[u][j].y * v[u][j].y + v[u][j].z * v[u][j].z + v[u][j].w * v[u][j].w;
      rstd[u] = rsqrtf(wave_sum(ss) * (1.0f / DM) + EPS); }
#pragma unroll
    for (int u = 0; u < 3; ++u) { const int r = rb + u * ngw;
      if (r < MTOK) { const int mo = mrow_of(r) * 1024;
#pragma unroll
        for (int j = 0; j < 4; ++j) { const int k = 4 * lane + 256 * j;
          const f32x4 a4 = *(const f32x4*)(mA + mo + k), b4 = *(const f32x4*)(mB + mo + k); const f32x4 o = v[u][j] * rstd[u] * a4 + b4;
          u32x2 w; w.x = pk2bf(o.x, o.y); w.y = pk2bf(o.z, o.w);
          *(u32x2*)(H + (size_t)r * DM + k) = w; } } }
  }
  __syncthreads();
}

template <int MODE> __device__ __forceinline__ void tr_wave_item(const float* src, const float* src2, int ldsrc, int K, bf16_t* out, int n0, int k0, float* scr, int lane) {
  const int nn = lane & 31, n = n0 + nn;
#pragma unroll 8
  for (int i = 0; i < 32; ++i) { const int kk = 2 * i + (lane >> 5); float v = 0.f;
    if (MODE == 0) { const int col = n < 1676 ? n : (n < 1792 ? -1 : n - 116); if (col >= 0) v = src[(size_t)(k0 + kk) * ldsrc + col]; }
    else if (MODE == 1) v = src[(size_t)(k0 + kk) * ldsrc + n];
    else v = (n & 1) ? src2[(size_t)(k0 + kk) * ldsrc + (n >> 1)] : src[(size_t)(k0 + kk) * ldsrc + (n >> 1)];
    scr[kk * 33 + nn] = v; }
  asm volatile("s_waitcnt lgkmcnt(0)" ::: "memory");
  const int c = lane & 7;
#pragma unroll
  for (int j = 0; j < 4; ++j) { const int nr = (lane >> 3) + 8 * j; const float* sp = scr + (8 * c) * 33 + nr;
    u32x4 o; o.x = f2bf(sp[0]) | (f2bf(sp[33]) << 16); o.y = f2bf(sp[66]) | (f2bf(sp[99]) << 16); o.z = f2bf(sp[132]) | (f2bf(sp[165]) << 16); o.w = f2bf(sp[198]) | (f2bf(sp[231]) << 16);
    *(u32x4*)(out + (size_t)(n0 + nr) * K + k0 + 8 * c) = o; }
  asm volatile("s_waitcnt lgkmcnt(0)" ::: "memory");
}
__device__ __forceinline__ void st_weights(const float* w_in, const float* w_out, const float* w_gate, const float* w_up, const float* w_down, int layer,
                                           bf16_t* WIN, bf16_t* WOUT, bf16_t* WGU, bf16_t* WD, char* lds) {
  const int tid = TIDX, lane = tid & 63, w = tid >> 6; float* scr = (float*)lds + w * (64 * 33);
  for (int it = BIDX * 8 + w; it < 7936; it += GDIM * 8) {
    if (it < 1280) tr_wave_item<0>(w_in + (size_t)layer * 1024 * DIN, nullptr, DIN, 1024, WIN, (it % 80) * 32, (it / 80) * 64, scr, lane);
    else if (it < 1792) { const int i2 = it - 1280; tr_wave_item<1>(w_out + (size_t)layer * 1024 * 1024, nullptr, 1024, 1024, WOUT, (i2 & 31) * 32, (i2 >> 5) * 64, scr, lane); }
    else if (it < 5888) { const int i2 = it - 1792, e = i2 >> 8, t = i2 & 255;
      tr_wave_item<2>(w_gate + ((size_t)layer * 16 + e) * 1024 * 256, w_up + ((size_t)layer * 16 + e) * 1024 * 256, 256, 1024, WGU + (size_t)e * 512 * 1024, (t & 15) * 32, (t >> 4) * 64, scr, lane); }
    else { const int i2 = it - 5888, e = i2 >> 7, t = i2 & 127;
      tr_wave_item<1>(w_down + ((size_t)layer * 16 + e) * 256 * 1024, nullptr, 1024, 256, WD + (size_t)e * 1024 * 256, (t & 31) * 32, (t >> 5) * 64, scr, lane); }
  }
  __syncthreads();
}

__device__ __forceinline__ void pair_experts(int pidx, int& eA, int& eB) {
  const int g = pidx / 6, t = pidx - 6 * g; const int i = t < 3 ? 0 : (t < 5 ? 1 : 2); const int j = t < 3 ? t + 1 : (t < 5 ? t - 1 : 3);
  eA = 4 * g + i; eB = 4 * g + j;
}
__device__ __forceinline__ void st_prep_qk(bf16_t* QK, const float* qn, const float* kn, const float* rope) {
  const int lane = TIDX & 63, gw = BIDX * 8 + (TIDX >> 6), ngw = GDIM * 8, hh = lane >> 3, sub = lane & 7;
  float gn[8];
#pragma unroll
  for (int e = 0; e < 8; ++e) gn[e] = ((hh < 6 ? qn : kn) + sub * 8)[e] * (hh < 6 ? C2 : 1.0f);
  for (int rb = gw; rb < MTOK; rb += 3 * ngw) {
    bf16x8 raw[3]; f32x4 rp4[3][4];
#pragma unroll
    for (int u = 0; u < 3; ++u) { const int r = rb + u * ngw < MTOK ? rb + u * ngw : MTOK - 1; const int j = r % TPB, t = j >= CTXL ? j - CTXL : 0;
      raw[u] = *(const bf16x8*)(QK + (size_t)r * 512 + hh * 64 + sub * 8);
      const float* rp = rope + ((size_t)t * 32 + (sub & 3) * 8) * 2;
#pragma unroll
      for (int q = 0; q < 4; ++q) rp4[u][q] = *(const f32x4*)(rp + 4 * q); }
#pragma unroll
    for (int u = 0; u < 3; ++u) { const int r = rb + u * ngw; const int j = (r < MTOK ? r : MTOK - 1) % TPB;
      float v[8]; float ss = 0.f;
#pragma unroll
      for (int e = 0; e < 8; ++e) { v[e] = bf2f((bf16_t)raw[u][e]); ss += v[e] * v[e]; }
      ss += __shfl_xor(ss, 1); ss += __shfl_xor(ss, 2); ss += __shfl_xor(ss, 4);
      const float rstd = rsqrtf(ss * (1.0f / 64.0f) + EPS);
#pragma unroll
      for (int e = 0; e < 8; ++e) v[e] = v[e] * rstd * gn[e];
      if (j >= CTXL) {
#pragma unroll
        for (int e = 0; e < 8; ++e) { const float other = __shfl_xor(v[e], 4); const float cs = rp4[u][e >> 1][(e & 1) * 2], sn = rp4[u][e >> 1][(e & 1) * 2 + 1]; v[e] = sub < 4 ? v[e] * cs - other * sn : v[e] * cs + other * sn; } }
      if (r < MTOK) *(u32x4*)(QK + (size_t)r * 512 + hh * 64 + sub * 8) = (u32x4){pk2bf(v[0], v[1]), pk2bf(v[2], v[3]), pk2bf(v[4], v[5]), pk2bf(v[6], v[7])}; }
  }
}

__device__ __forceinline__ void st_prep_hy(const bf16_t* HY, const float* cw, const float* cb, bf16_t* HYT, int do_ctx, char* lds) {
  const int tid = TIDX, lane = tid & 63, w = tid >> 6; float* tile = (float*)lds + w * (66 * 33);
  const int nlat = 4 * 64 * 24, nitem = nlat + (do_ctx ? 4 * 4 * 24 : 0), step = (GDIM - 48) * 8;
  bf16x8 raw[5];
#define PHY_DECODE(it) int b, tt, ct, L, joff; bf16_t* outb; \
    if ((it) < nlat) { b = (it) / 1536; tt = ((it) % 1536) / 24; ct = (it) % 24; L = SEQ; joff = CTXL; outb = HYT + (size_t)b * 768 * SEQ; } \
    else { const int i2 = (it) - nlat; b = i2 / 96; tt = (i2 % 96) / 24; ct = i2 % 24; L = CTXL; joff = 0; outb = HYT + (size_t)4 * 768 * SEQ + (size_t)b * 768 * CTXL; } \
    const int t0 = tt * 64, c0 = ct * 32; (void)outb;
#define PHY_LOADS(it) do { PHY_DECODE(it) _Pragma("unroll") for (int i = 0; i < 5; ++i) { const int rr = (lane >> 2) + 16 * i, c8 = (lane & 3) * 8; int t = t0 - 1 + rr; const bool ok = rr < 66 && t >= 0 && t < L; t = ok ? t : t0; \
      const bf16x8 v = *(const bf16x8*)(HY + ((size_t)b * TPB + joff + t) * 768 + c0 + c8); raw[i] = ok ? v : (bf16x8){0, 0, 0, 0, 0, 0, 0, 0}; } \
    { const int c = c0 + (lane & 31); wq[0] = cw[c]; wq[1] = cw[768 + c]; wq[2] = cw[1536 + c]; wq[3] = cb[c]; } } while (0)
  float wq[4];
  int it = BIDX >= 48 ? (BIDX - 48) * 8 + w : nitem;
  if (it < nitem) PHY_LOADS(it);
  for (; it < nitem; it += step) {
    PHY_DECODE(it)
#pragma unroll
    for (int i = 0; i < 5; ++i) { const int rr = (lane >> 2) + 16 * i, c8 = (lane & 3) * 8;
      if (rr < 66) {
#pragma unroll
        for (int e = 0; e < 8; ++e) tile[rr * 33 + c8 + e] = bf2f((bf16_t)raw[i][e]); } }
    asm volatile("s_waitcnt lgkmcnt(0)" ::: "memory");
    const float wc0 = wq[0], wc1 = wq[1], wc2 = wq[2], wc3 = wq[3];
    if (it + step < nitem) PHY_LOADS(it + step);
#pragma unroll
    for (int cc = 0; cc < 32; ++cc) { const int c = c0 + cc;
      const float k0 = __int_as_float(__builtin_amdgcn_readlane(__float_as_int(wc0), cc)), k1 = __int_as_float(__builtin_amdgcn_readlane(__float_as_int(wc1), cc));
      const float k2 = __int_as_float(__builtin_amdgcn_readlane(__float_as_int(wc2), cc)), kb = __int_as_float(__builtin_amdgcn_readlane(__float_as_int(wc3), cc));
      const float v = k0 * tile[lane * 33 + cc] + k1 * tile[(lane + 1) * 33 + cc] + k2 * tile[(lane + 2) * 33 + cc] + kb;
      outb[(size_t)c * L + t0 + lane] = (bf16_t)f2bf(v); }
    asm volatile("s_waitcnt lgkmcnt(0)" ::: "memory");
  }
#undef PHY_LOADS
#undef PHY_DECODE
  __syncthreads();
}

template <int L> __device__ __forceinline__ void hyfilt_item(int item, const float* w1, const float* b1, const float* fr, const float* w2, const float* b2, const float* w3, float* HK, char* lds) {
  float* F = (float*)lds; float* W1 = F + 64 * 37; float* H1 = W1 + 36 * 68; float* W2 = H1 + 64 * 68; float* S1 = W2 + 64 * 68;
  const int tid = TIDX, n0 = (item >> 2) * 64, cq = item & 3, lane = tid & 63, wv = tid >> 6, l15 = lane & 15, l4 = lane >> 4;
  for (int e = tid; e < 64 * 36; e += NT) { const int pp = e / 36, f = e % 36; const int n = n0 + pp; float v = 0.f;
    if (f == 0) v = (float)n / (float)(L - 1);
    else if (f < 33) { const int m = (f - 1) & 15; const float band = 1e-4f + (float)m * ((15.0f - 1e-4f) / 15.0f); float rev = ((float)n * (1.0f / (float)L)) * band; rev -= floorf(rev);
      v = f <= 16 ? __builtin_amdgcn_cosf(rev) : -__builtin_amdgcn_sinf(rev); }
    F[pp * 37 + f] = v; }
#pragma unroll
  for (int e = tid; e < 36 * 64; e += NT) { const int k = e >> 6, j = e & 63; W1[k * 68 + j] = k < 33 ? w1[k * 64 + j] : 0.f; }
#pragma unroll
  for (int e = tid; e < 64 * 64; e += NT) { const int k = e >> 6, j = e & 63; W2[k * 68 + j] = w2[e]; }
  __syncthreads();
  { const int pt = wv >> 1, c0 = 32 * (wv & 1);
    f32x4 acc[2] = {(f32x4){0.f, 0.f, 0.f, 0.f}, (f32x4){0.f, 0.f, 0.f, 0.f}};
#pragma unroll
    for (int kk = 0; kk < 9; ++kk) { const float av = F[(pt * 16 + l15) * 37 + 4 * kk + l4];
      acc[0] = __builtin_amdgcn_mfma_f32_16x16x4f32(av, W1[(4 * kk + l4) * 68 + c0 + l15], acc[0], 0, 0, 0);
      acc[1] = __builtin_amdgcn_mfma_f32_16x16x4f32(av, W1[(4 * kk + l4) * 68 + c0 + 16 + l15], acc[1], 0, 0, 0); }
#pragma unroll
    for (int ct = 0; ct < 2; ++ct) { const int j = c0 + 16 * ct + l15; const float bj = b1[j], fj = fr[j] * 0.15915494309189535f;
#pragma unroll
      for (int rg = 0; rg < 4; ++rg) { float rev = fj * (acc[ct][rg] + bj); rev -= floorf(rev); H1[(pt * 16 + 4 * l4 + rg) * 68 + j] = __builtin_amdgcn_sinf(rev); } } }
  __syncthreads();
  { const int pt = wv >> 1, c0 = 32 * (wv & 1);
    f32x4 acc[2] = {(f32x4){0.f, 0.f, 0.f, 0.f}, (f32x4){0.f, 0.f, 0.f, 0.f}};
#pragma unroll
    for (int kk = 0; kk < 16; ++kk) { const float av = H1[(pt * 16 + l15) * 68 + 4 * kk + l4];
      acc[0] = __builtin_amdgcn_mfma_f32_16x16x4f32(av, W2[(4 * kk + l4) * 68 + c0 + l15], acc[0], 0, 0, 0);
      acc[1] = __builtin_amdgcn_mfma_f32_16x16x4f32(av, W2[(4 * kk + l4) * 68 + c0 + 16 + l15], acc[1], 0, 0, 0); }
#pragma unroll
    for (int ct = 0; ct < 2; ++ct) { const int j = c0 + 16 * ct + l15; const float bj = b2[j], fj = fr[j] * 0.15915494309189535f;
#pragma unroll
      for (int rg = 0; rg < 4; ++rg) { float rev = fj * (acc[ct][rg] + bj); rev -= floorf(rev); S1[(pt * 16 + 4 * l4 + rg) * 68 + j] = __builtin_amdgcn_sinf(rev); } } }
  __syncthreads();
  {
    const int colb = cq * 256 + 32 * wv;
    f32x4 acc[4][2];
#pragma unroll
    for (int pt = 0; pt < 4; ++pt) { acc[pt][0] = (f32x4){0.f, 0.f, 0.f, 0.f}; acc[pt][1] = (f32x4){0.f, 0.f, 0.f, 0.f}; }
#pragma unroll 4
    for (int kk = 0; kk < 16; ++kk) { const int k = 4 * kk + l4;
      const float bv0 = w3[k * 1024 + colb + l15], bv1 = w3[k * 1024 + colb + 16 + l15];
#pragma unroll
      for (int pt = 0; pt < 4; ++pt) { const float av = S1[(pt * 16 + l15) * 68 + k];
        acc[pt][0] = __builtin_amdgcn_mfma_f32_16x16x4f32(av, bv0, acc[pt][0], 0, 0, 0);
        acc[pt][1] = __builtin_amdgcn_mfma_f32_16x16x4f32(av, bv1, acc[pt][1], 0, 0, 0); } }
#pragma unroll
    for (int ct = 0; ct < 2; ++ct) { const int col = colb + 16 * ct + l15, dir = col >> 9, order = (col >> 8) & 1, c = col & 255;
      const float delta = 3.0701134573253943f + (float)c * ((15.350567286626972f - 3.0701134573253943f) / 255.0f);
      float* dst = HK + ((size_t)order * 256 + c) * (2 * L);
#pragma unroll
      for (int pt = 0; pt < 4; ++pt) { const int nb = n0 + pt * 16 + 4 * l4; f32x4 o;
#pragma unroll
        for (int rg = 0; rg < 4; ++rg) o[rg] = acc[pt][ct][rg] * __expf(-((float)(nb + rg) / (float)(L - 1)) * delta);
        if (dir == 0) *(f32x4*)(dst + nb) = o;
        else {
#pragma unroll
          for (int rg = 0; rg < 4; ++rg) { const int n = nb + rg; if (n >= 1) dst[2 * L - n] = o[rg]; else dst[L] = 0.f; } } } }
  }
  __syncthreads();
}

__device__ __forceinline__ void hyconv_ctx_item(int item, const bf16_t* HYTC, const float* HKC, const float* hy_bias, bf16_t* MIX, char* lds) {
  constexpr int L = CTXL;
  const int tid = TIDX, b = item >> 5, cc = tid >> 6, c = (item & 31) * 8 + cc, sub = tid & 63, tb = 4 * sub;
  float* kern = (float*)lds + cc * (2 * L); float* z = (float*)lds + 8 * 2 * L + cc * L; bf16_t* ob = (bf16_t*)((float*)lds + 8 * 2 * L + 8 * L);
  const bf16_t* vp = HYTC + ((size_t)b * 768 + c) * L;
  const u32x2 x1r = *(const u32x2*)(vp + (size_t)256 * L + tb), x2r = *(const u32x2*)(vp + (size_t)512 * L + tb);
  { float zr[4];
#pragma unroll
    for (int i = 0; i < 4; ++i) zr[i] = bf2f(vp[sub + 64 * i]);
#pragma unroll
    for (int i = 0; i < 4; ++i) z[sub + 64 * i] = zr[i]; }
#pragma unroll 1
  for (int o = 0; o < 2; ++o) {
    const float* kp = HKC + ((size_t)o * 256 + c) * (2 * L);
    { float kr[8];
#pragma unroll
      for (int i = 0; i < 8; ++i) kr[i] = kp[sub + 64 * i];
#pragma unroll
      for (int i = 0; i < 8; ++i) kern[sub + 64 * i] = kr[i]; }
    const float bias = hy_bias[o * 256 + c];
    __syncthreads();
    float acc[4], W[12];
#pragma unroll
    for (int i = 0; i < 4; ++i) { acc[i] = 0.f; W[8 + i] = kern[tb + i]; }
    for (int s0 = 0; s0 < L; s0 += 8) {
      const int bb = (tb - s0 - 8) & (2 * L - 1), bb2 = (bb + 4) & (2 * L - 1);
#pragma unroll
      for (int i = 0; i < 4; ++i) { W[i] = kern[bb + i]; W[4 + i] = kern[bb2 + i]; }
      float zs[8];
#pragma unroll
      for (int j = 0; j < 8; ++j) zs[j] = z[s0 + j];
#pragma unroll
      for (int j = 0; j < 8; ++j)
#pragma unroll
        for (int i = 0; i < 4; ++i) acc[i] += W[8 + i - j] * zs[j];
#pragma unroll
      for (int i = 0; i < 4; ++i) W[8 + i] = W[i];
    }
    __syncthreads();
#pragma unroll
    for (int i = 0; i < 4; ++i) { const int t = tb + i; const float zz = acc[i] + bias * z[t]; const unsigned xw = o == 0 ? (i < 2 ? x1r.x : x1r.y) : (i < 2 ? x2r.x : x2r.y);
      const float xv = (i & 1) ? __uint_as_float(xw & 0xffff0000u) : __uint_as_float(xw << 16);
      if (o == 0) z[t] = xv * zz; else ob[t * 8 + cc] = (bf16_t)f2bf(xv * zz); }
    __syncthreads();
  }
  if (tid < L) *(u32x4*)(MIX + ((size_t)b * TPB + tid) * DM + 768 + (item & 31) * 8) = *(const u32x4*)(ob + tid * 8);
  __syncthreads();
}

__device__ __forceinline__ void ssd_conv8(const bf16_t* XBC, size_t r, int c0, bool hasp, bool hasn, const float* cw, const float* cb, float (&o)[8]) {
  const bf16x8 cur = *(const bf16x8*)(XBC + r * 768 + c0);
  const bf16x8 prv = *(const bf16x8*)(XBC + (hasp ? r - 1 : r) * 768 + c0), nxt = *(const bf16x8*)(XBC + (hasn ? r + 1 : r) * 768 + c0);
  const float wp = hasp ? 1.f : 0.f, wn = hasn ? 1.f : 0.f;
#pragma unroll
  for (int e = 0; e < 8; ++e) { const float v = wp * cw[c0 + e] * bf2f((bf16_t)prv[e]) + cw[640 + c0 + e] * bf2f((bf16_t)cur[e]) + wn * cw[1280 + c0 + e] * bf2f((bf16_t)nxt[e]) + cb[c0 + e]; o[e] = siluf(v); }
}
__device__ __forceinline__ float softplusf(float x) {
  const float y = __expf(-fabsf(x)); const float l = y < 0.06f ? y * (1.f - y * (0.5f - y * (0.33333334f - 0.25f * y))) : __logf(1.f + y); return fmaxf(x, 0.f) + l; }
__device__ __forceinline__ void wave_scan128(float e0, float e1, int lane, float& c0, float& c1) {
  float x = e0 + e1;
#pragma unroll
  for (int o = 1; o < 64; o <<= 1) { const float v = __shfl_up(x, o); if (lane >= o) x += v; }
  const float excl = x - (e0 + e1); c0 = excl + e0; c1 = excl + e0 + e1;
}
__device__ __forceinline__ int ssd_chunk_j0(int cidx) { return cidx < 2 ? cidx * 128 : CTXL + (cidx - 2) * 128; }

__device__ __forceinline__ void st_ssd1(int it0, int step, int nitems, const bf16_t* XBC, const float* DT, const float* cw, const float* cb, const float* dt_bias, const float* a_log,
                                        bf16_t* YIN, bf16_t* ST, float* DEC, char* lds) {
  bf16_t (*Cm)[72] = (bf16_t (*)[72])lds; bf16_t (*Bm)[72] = (bf16_t (*)[72])(lds + 18432);
  bf16_t (*BT)[136] = (bf16_t (*)[136])(lds + 36864); bf16_t (*Xt)[136] = (bf16_t (*)[136])(lds + 54272); bf16_t (*Mm)[136] = (bf16_t (*)[136])(lds + 71680);
  float* tab = (float*)(lds + 106496); float* dtf = tab; float* dtb = tab + 128; float* acf = tab + 256; float* acb = tab + 384; float* wf = tab + 512; float* wb = tab + 640;
  const int tid = TIDX;
  bf16x8 cu[6], pv[6], nx[6];
#define SSD1_LOADS(itm, I0, I1) do { const int h_ = (itm) % 6, bc_ = (itm) / 6, cidx_ = bc_ % 34, b_ = bc_ / 34, g_ = h_ / 3, j0_ = ssd_chunk_j0(cidx_); const size_t r0_ = (size_t)b_ * TPB + j0_; \
    _Pragma("unroll") for (int i = (I0); i < (I1); ++i) { const int task = tid + NT * i, t = task / 24, cg = task % 24, kind = cg >> 3, q = cg & 7, j = j0_ + t; \
      const int c0 = kind == 0 ? h_ * 64 + 8 * q : (kind == 1 ? 384 + g_ * 64 + 8 * q : 512 + g_ * 64 + 8 * q); \
      const bool hasp = j != 0 && j != CTXL, hasn = j != CTXL - 1 && j != TPB - 1; const bf16_t* p = XBC + (r0_ + t) * 768 + c0; \
      cu[i] = *(const bf16x8*)p; pv[i] = *(const bf16x8*)(p + (hasp ? -768 : 0)); nx[i] = *(const bf16x8*)(p + (hasn ? 768 : 0)); } } while (0)
  if (it0 < nitems) SSD1_LOADS(it0, 0, 6);
#pragma unroll 1
  for (int item = it0; item < nitems; item += step) {
  const int tid = TIDX, lane = tid & 63, w = tid >> 6, l15 = lane & 15, l4 = lane >> 4;
  const int h = item % 6, bc = item / 6, cidx = bc % 34, b = bc / 34, g = h / 3, j0 = ssd_chunk_j0(cidx);
  const size_t r0 = (size_t)b * TPB + j0;
  float dtr0 = 0.f, dtr1 = 0.f;
  if (w < 2) { const int t0 = w == 0 ? 2 * lane : 127 - 2 * lane, t1 = w == 0 ? 2 * lane + 1 : 126 - 2 * lane; dtr0 = DT[(r0 + t0) * 12 + w * 6 + h]; dtr1 = DT[(r0 + t1) * 12 + w * 6 + h]; }
  SSD1_LOADS(item, 6, 6);
  {
#pragma unroll
    for (int i = 0; i < 6; ++i) { const int task = tid + NT * i, t = task / 24, cg = task % 24, kind = cg >> 3, q = cg & 7, j = j0 + t;
      const int c0 = kind == 0 ? h * 64 + 8 * q : (kind == 1 ? 384 + g * 64 + 8 * q : 512 + g * 64 + 8 * q);
      const float wp = (j != 0 && j != CTXL) ? 1.f : 0.f, wn = (j != CTXL - 1 && j != TPB - 1) ? 1.f : 0.f;
      float o[8];
#pragma unroll
      for (int e = 0; e < 8; ++e) o[e] = siluf(wp * cw[c0 + e] * bf2f((bf16_t)pv[i][e]) + cw[640 + c0 + e] * bf2f((bf16_t)cu[i][e]) + wn * cw[1280 + c0 + e] * bf2f((bf16_t)nx[i][e]) + cb[c0 + e]);
      if (kind == 0) {
#pragma unroll
        for (int e = 0; e < 8; ++e) Xt[8 * q + e][t] = (bf16_t)f2bf(o[e]);
      } else { const u32x4 pk = (u32x4){pk2bf(o[0], o[1]), pk2bf(o[2], o[3]), pk2bf(o[4], o[5]), pk2bf(o[6], o[7])};
        if (kind == 1) { *(u32x4*)&Bm[t][8 * q] = pk;
#pragma unroll
          for (int e = 0; e < 8; ++e) BT[8 * q + e][t] = (bf16_t)f2bf(o[e]); }
        else *(u32x4*)&Cm[t][8 * q] = pk; } }
  }
  if (w < 2) { const int dir = w; const float a = -expf(a_log[dir * 6 + h]), bias = dt_bias[dir * 6 + h];
    const int t0 = dir == 0 ? 2 * lane : 127 - 2 * lane, t1 = dir == 0 ? 2 * lane + 1 : 126 - 2 * lane;
    const float d0 = softplusf(dtr0 + bias), d1 = softplusf(dtr1 + bias);
    float c0, c1; wave_scan128(d0 * a, d1 * a, lane, c0, c1);
    const float tot = __shfl(c1, 63);
    float* dtt = dir == 0 ? dtf : dtb; float* ac = dir == 0 ? acf : acb; float* ww = dir == 0 ? wf : wb;
    dtt[t0] = d0; dtt[t1] = d1; ac[t0] = c0; ac[t1] = c1; ww[t0] = __expf(tot - c0) * d0; ww[t1] = __expf(tot - c1) * d1;
    if (lane == 0) DEC[(((size_t)b * 34 + cidx) * 2 + dir) * 6 + h] = __expf(tot); }
  __syncthreads();
  if (item + step < nitems) SSD1_LOADS(item + step, 0, 6);
  {
    f32x4 accG[8];
#pragma unroll
    for (int ni = 0; ni < 8; ++ni) accG[ni] = (f32x4){0.f, 0.f, 0.f, 0.f};
#pragma unroll
    for (int kk = 0; kk < 2; ++kk) { const bf16x8 a = *(const bf16x8*)&Cm[16 * w + l15][32 * kk + 8 * l4];
#pragma unroll
      for (int ni = 0; ni < 8; ++ni) { const bf16x8 bb = *(const bf16x8*)&Bm[16 * ni + l15][32 * kk + 8 * l4]; accG[ni] = __builtin_amdgcn_mfma_f32_16x16x32_bf16(a, bb, accG[ni], 0, 0, 0); } }
    float aft[4], abt[4];
#pragma unroll
    for (int rg = 0; rg < 4; ++rg) { aft[rg] = acf[16 * w + 4 * l4 + rg]; abt[rg] = acb[16 * w + 4 * l4 + rg]; }
#pragma unroll
    for (int ni = 0; ni < 8; ++ni) { const int sidx = 16 * ni + l15; const float afs = acf[sidx], abs_ = acb[sidx], dfs = dtf[sidx], dbs = dtb[sidx];
#pragma unroll
      for (int rg = 0; rg < 4; ++rg) { const int t = 16 * w + 4 * l4 + rg;
        const float f = sidx <= t ? __expf(aft[rg] - afs) * dfs : 0.f, bk = sidx >= t ? __expf(abt[rg] - abs_) * dbs : 0.f;
        Mm[t][sidx] = (bf16_t)f2bf(accG[ni][rg] * (f + bk)); } }
  }
  __syncthreads();
  {
    f32x4 acc[4];
#pragma unroll
    for (int ni = 0; ni < 4; ++ni) acc[ni] = (f32x4){0.f, 0.f, 0.f, 0.f};
#pragma unroll
    for (int kk = 0; kk < 4; ++kk) { const bf16x8 a = *(const bf16x8*)&Mm[16 * w + l15][32 * kk + 8 * l4];
#pragma unroll
      for (int ni = 0; ni < 4; ++ni) { const bf16x8 bb = *(const bf16x8*)&Xt[16 * ni + l15][32 * kk + 8 * l4]; acc[ni] = __builtin_amdgcn_mfma_f32_16x16x32_bf16(a, bb, acc[ni], 0, 0, 0); } }
#pragma unroll
    for (int rg = 0; rg < 4; ++rg)
#pragma unroll
      for (int ni = 0; ni < 4; ++ni) YIN[(r0 + 16 * w + 4 * l4 + rg) * 384 + h * 64 + 16 * ni + l15] = (bf16_t)f2bf(acc[ni][rg]);
  }
  {
    const int dir = w >> 2, mt = w & 3; const float* ww = dir == 0 ? wf : wb;
    f32x4 acc[4];
#pragma unroll
    for (int ni = 0; ni < 4; ++ni) acc[ni] = (f32x4){0.f, 0.f, 0.f, 0.f};
#pragma unroll
    for (int kk = 0; kk < 4; ++kk) { const bf16x8 raw = *(const bf16x8*)&Xt[16 * mt + l15][32 * kk + 8 * l4];
      const f32x4 w0 = *(const f32x4*)(ww + 32 * kk + 8 * l4), w1 = *(const f32x4*)(ww + 32 * kk + 8 * l4 + 4);
      u32x4 pk; pk.x = pk2bf(bf2f((bf16_t)raw[0]) * w0.x, bf2f((bf16_t)raw[1]) * w0.y); pk.y = pk2bf(bf2f((bf16_t)raw[2]) * w0.z, bf2f((bf16_t)raw[3]) * w0.w);
      pk.z = pk2bf(bf2f((bf16_t)raw[4]) * w1.x, bf2f((bf16_t)raw[5]) * w1.y); pk.w = pk2bf(bf2f((bf16_t)raw[6]) * w1.z, bf2f((bf16_t)raw[7]) * w1.w);
      const bf16x8 a = __builtin_bit_cast(bf16x8, pk);
#pragma unroll
      for (int ni = 0; ni < 4; ++ni) { const bf16x8 bb = *(const bf16x8*)&BT[16 * ni + l15][32 * kk + 8 * l4]; acc[ni] = __builtin_amdgcn_mfma_f32_16x16x32_bf16(a, bb, acc[ni], 0, 0, 0); } }
    bf16_t* sp = ST + ((((size_t)b * 34 + cidx) * 2 + dir) * 6 + h) * 4096;
#pragma unroll
    for (int rg = 0; rg < 4; ++rg)
#pragma unroll
      for (int ni = 0; ni < 4; ++ni) sp[(16 * mt + 4 * l4 + rg) * 64 + 16 * ni + l15] = (bf16_t)f2bf(acc[ni][rg]);
  }
  __syncthreads();
  }
#undef SSD1_LOADS
}

__device__ __forceinline__ void st_ssd_scan2(bf16_t* ST, const float* DEC) {
  for (int idx = BIDX * NT + TIDX; idx < 4 * 2 * 6 * 2048; idx += GDIM * NT) {
    const int e = (idx & 2047) * 2, bdh = idx >> 11, h = bdh % 6, dir = (bdh / 6) & 1, b = bdh / 12;
    unsigned v[34]; float d[34];
#pragma unroll
    for (int st = 0; st < 34; ++st) { const int cidx = dir == 0 ? st : (st < 2 ? 1 - st : 35 - st); const size_t o = (((size_t)b * 34 + cidx) * 2 + dir) * 6 + h; v[st] = *(const unsigned*)(ST + o * 4096 + e); d[st] = DEC[o]; }
    float H0 = 0.f, H1 = 0.f;
#pragma unroll
    for (int st = 0; st < 34; ++st) { const int cidx = dir == 0 ? st : (st < 2 ? 1 - st : 35 - st); const size_t o = (((size_t)b * 34 + cidx) * 2 + dir) * 6 + h;
      *(unsigned*)(ST + o * 4096 + e) = pk2bf(H0, H1); H0 = H0 * d[st] + __uint_as_float(v[st] << 16); H1 = H1 * d[st] + __uint_as_float(v[st] & 0xffff0000u); }
  }
}

__device__ __forceinline__ void ssd3_item(int b, int cidx, int g, const bf16_t* XBC, const bf16_t* VZ, const float* DT, const float* cw, const float* cb, const float* dt_bias, const float* a_log,
                                          const float* dskip, const float* nw, const bf16_t* YIN, const bf16_t* ST, bf16_t* MIX, char* lds) {
  bf16_t (*Cm)[72] = (bf16_t (*)[72])lds; bf16_t (*Hm)[72] = (bf16_t (*)[72])(lds + 18432);
  float* ef = (float*)(lds + 18432 + 55296);
  float (*Yt)[196] = (float (*)[196])lds;
  const int tid = TIDX, lane = tid & 63, w = tid >> 6, l15 = lane & 15, l4 = lane >> 4, j0 = ssd_chunk_j0(cidx);
  const size_t r0 = (size_t)b * TPB + j0;
#pragma unroll
  for (int i = 0; i < 2; ++i) { const int task = tid + NT * i, t = task >> 3, q = task & 7, j = j0 + t;
    float o[8]; ssd_conv8(XBC, r0 + t, 512 + g * 64 + 8 * q, j != 0 && j != CTXL, j != CTXL - 1 && j != TPB - 1, cw, cb, o);
    *(u32x4*)&Cm[t][8 * q] = (u32x4){pk2bf(o[0], o[1]), pk2bf(o[2], o[3]), pk2bf(o[4], o[5]), pk2bf(o[6], o[7])}; }
#pragma unroll
  for (int i = 0; i < 6; ++i) { const int f8 = tid + NT * i, hd = f8 >> 9, rem = f8 & 511, p = rem >> 3, n8 = (rem & 7) * 8, hh = hd >> 1, dir = hd & 1;
    *(u32x4*)&Hm[hd * 64 + p][n8] = *(const u32x4*)(ST + ((((size_t)b * 34 + cidx) * 2 + dir) * 6 + 3 * g + hh) * 4096 + p * 64 + n8); }
  if (w < 6) { const int hh = w >> 1, dir = w & 1, h = 3 * g + hh; const float a = -expf(a_log[dir * 6 + h]), bias = dt_bias[dir * 6 + h];
    const int t0 = dir == 0 ? 2 * lane : 127 - 2 * lane, t1 = dir == 0 ? 2 * lane + 1 : 126 - 2 * lane;
    const float d0 = softplusf(DT[(r0 + t0) * 12 + dir * 6 + h] + bias), d1 = softplusf(DT[(r0 + t1) * 12 + dir * 6 + h] + bias);
    float c0, c1; wave_scan128(d0 * a, d1 * a, lane, c0, c1);
    ef[w * 128 + t0] = __expf(c0); ef[w * 128 + t1] = __expf(c1); }
  __syncthreads();
  float yv[3][4][4];
  {
    bf16x8 ca[2];
#pragma unroll
    for (int kk = 0; kk < 2; ++kk) ca[kk] = *(const bf16x8*)&Cm[16 * w + l15][32 * kk + 8 * l4];
#pragma unroll
    for (int hh = 0; hh < 3; ++hh) {
      f32x4 accF[4], accB[4];
#pragma unroll
      for (int ni = 0; ni < 4; ++ni) { accF[ni] = (f32x4){0.f, 0.f, 0.f, 0.f}; accB[ni] = (f32x4){0.f, 0.f, 0.f, 0.f}; }
#pragma unroll
      for (int kk = 0; kk < 2; ++kk)
#pragma unroll
        for (int ni = 0; ni < 4; ++ni) {
          accF[ni] = __builtin_amdgcn_mfma_f32_16x16x32_bf16(ca[kk], *(const bf16x8*)&Hm[(hh * 2 + 0) * 64 + 16 * ni + l15][32 * kk + 8 * l4], accF[ni], 0, 0, 0);
          accB[ni] = __builtin_amdgcn_mfma_f32_16x16x32_bf16(ca[kk], *(const bf16x8*)&Hm[(hh * 2 + 1) * 64 + 16 * ni + l15][32 * kk + 8 * l4], accB[ni], 0, 0, 0); }
#pragma unroll
      for (int rg = 0; rg < 4; ++rg) { const int t = 16 * w + 4 * l4 + rg; const float eF = ef[(hh * 2 + 0) * 128 + t], eB = ef[(hh * 2 + 1) * 128 + t];
#pragma unroll
        for (int ni = 0; ni < 4; ++ni) yv[hh][ni][rg] = eF * accF[ni][rg] + eB * accB[ni][rg]; }
    }
  }
  __syncthreads();
#pragma unroll
  for (int hh = 0; hh < 3; ++hh)
#pragma unroll
    for (int rg = 0; rg < 4; ++rg)
#pragma unroll
      for (int ni = 0; ni < 4; ++ni) Yt[16 * w + 4 * l4 + rg][hh * 64 + 16 * ni + l15] = yv[hh][ni][rg];
  __syncthreads();
  {
    const int c4 = 4 * (lane < 48 ? lane : 47), hk = c4 >> 6; const bool lact = lane < 48;
    float cw0[4], cw1[4], cw2[4], cbv[4], nwv[4];
#pragma unroll
    for (int e = 0; e < 4; ++e) { const int col = g * 192 + c4 + e; cw0[e] = cw[col]; cw1[e] = cw[640 + col]; cw2[e] = cw[1280 + col]; cbv[e] = cb[col]; nwv[e] = nw[col]; }
    const float dsk = dskip[3 * g + hk];
#pragma unroll 1
    for (int rb = 0; rb < 16; rb += 4) {
      u32x2 xc_[4], xp_[4], xn_[4], zz_[4], yy_[4];
#pragma unroll
      for (int u = 0; u < 4; ++u) { const int t = 16 * w + rb + u, j = j0 + t; const size_t r = r0 + t; const bool hasp = j != 0 && j != CTXL, hasn = j != CTXL - 1 && j != TPB - 1;
        const bf16_t* xq = XBC + r * 768 + g * 192 + c4;
        xc_[u] = *(const u32x2*)xq; xp_[u] = *(const u32x2*)(xq + (hasp ? -768 : 0)); xn_[u] = *(const u32x2*)(xq + (hasn ? 768 : 0));
        yy_[u] = *(const u32x2*)(YIN + r * 384 + g * 192 + c4); zz_[u] = *(const u32x2*)(VZ + r * 512 + 128 + g * 192 + c4); }
#pragma unroll
      for (int u = 0; u < 4; ++u) { const int t = 16 * w + rb + u, j = j0 + t; const size_t r = r0 + t; const float wp = (j != 0 && j != CTXL) ? 1.f : 0.f, wn = (j != CTXL - 1 && j != TPB - 1) ? 1.f : 0.f;
        const f32x4 yt = *(const f32x4*)&Yt[t][c4];
        float gt[4]; float ss = 0.f;
#pragma unroll
        for (int e = 0; e < 4; ++e) { const unsigned sh = (e & 1) * 16; const unsigned wc_ = e < 2 ? xc_[u].x : xc_[u].y, wq_ = e < 2 ? xp_[u].x : xp_[u].y, wn_ = e < 2 ? xn_[u].x : xn_[u].y, wz_ = e < 2 ? zz_[u].x : zz_[u].y;
          float xv = cw1[e] * bf2f((bf16_t)(wc_ >> sh)) + cbv[e] + wp * cw0[e] * bf2f((bf16_t)(wq_ >> sh)) + wn * cw2[e] * bf2f((bf16_t)(wn_ >> sh));
          xv = siluf(xv);
          const float y = bf2f((bf16_t)((e < 2 ? yy_[u].x : yy_[u].y) >> sh)) + yt[e] + dsk * xv;
          gt[e] = lact ? y * siluf(bf2f((bf16_t)(wz_ >> sh))) : 0.f; ss += gt[e] * gt[e]; }
        const float rstd = rsqrtf(wave_sum(ss) * (1.0f / 192.0f) + EPS);
        if (lact) { u32x2 o; o.x = pk2bf(gt[0] * rstd * nwv[0], gt[1] * rstd * nwv[1]); o.y = pk2bf(gt[2] * rstd * nwv[2], gt[3] * rstd * nwv[3]);
          *(u32x2*)(MIX + r * DM + 384 + g * 192 + c4) = o; } }
    }
  }
  __syncthreads();
}

__device__ __forceinline__ void st_router(const float* xl, const float* xc, int from_inputs, bf16_t* XB, const bf16_t* MO, const float* g, const float* modv_layer, const float* w_router, const float* rbias,
                                          bf16_t* H2, int* ctl, int* tok_pair, float* tok_w, int skip_ctx, char* lds) {
  float* wl = (float*)lds;
  const int tid = TIDX, lane = tid & 63, gw = BIDX * 8 + (tid >> 6), ngw = GDIM * 8;
  int* hist = (int*)(lds + 81920);
  if (tid < 32) hist[tid] = 0;
  float* mA = (float*)(lds + 82176); float* mB = mA + 5 * 1024; float* mG = mB + 5 * 1024;
  { f32x4 g4[3], sc4[3], sh4[3], gp4[3], wr4[8];
#pragma unroll
    for (int i = 0; i < 3; ++i) { const int q = tid + NT * i, qc = q < 1280 ? q : 0, m = qc >> 8, k = (qc & 255) * 4;
      g4[i] = *(const f32x4*)(g + k); sc4[i] = *(const f32x4*)(modv_layer + (size_t)m * 6144 + 4096 + k); sh4[i] = *(const f32x4*)(modv_layer + (size_t)m * 6144 + 3072 + k);
      gp4[i] = *(const f32x4*)(modv_layer + (size_t)m * 6144 + 2048 + k); }
#pragma unroll
    for (int i = 0; i < 8; ++i) wr4[i] = *(const f32x4*)(w_router + (size_t)(tid + NT * i) * 4);
#pragma unroll
    for (int i = 0; i < 3; ++i) { const int q = tid + NT * i;
      if (q < 1280) { *(f32x4*)(mA + 4 * q) = g4[i] * ((f32x4){1.f, 1.f, 1.f, 1.f} + sc4[i]); *(f32x4*)(mB + 4 * q) = sh4[i]; *(f32x4*)(mG + 4 * q) = gp4[i]; } }
#pragma unroll
    for (int i = 0; i < 8; ++i) { const int idx = tid + NT * i, k = idx >> 2, e4 = idx & 3, row = ((k & 3) * 4 + (k >> 8)) * 64 + ((k & 255) >> 2);
      *(f32x4*)(wl + row * 20 + 4 * e4) = wr4[i]; } }
  __syncthreads();
  for (int rb = gw; rb < MTOK; rb += 2 * ngw) {
    int rr[2]; bool act[2]; f32x4 v[2][4]; u32x2 mo[2][4]; float rstd[2]; int mo_[2];
#pragma unroll
    for (int u = 0; u < 2; ++u) { const int r = rb + u * ngw; rr[u] = r < MTOK ? r : MTOK - 1; act[u] = r < MTOK && !(skip_ctx && (rr[u] % TPB) < CTXL); mo_[u] = mrow_of(rr[u]) * 1024;
      const bf16_t* mr = MO + (size_t)rr[u] * DM;
      if (from_inputs) { const float* xr = xrow(xl, xc, rr[u]);
#pragma unroll
        for (int j = 0; j < 4; ++j) v[u][j] = *(const f32x4*)(xr + 4 * lane + 256 * j); }
      else { const bf16_t* xr = XB + (size_t)rr[u] * DM;
#pragma unroll
        for (int j = 0; j < 4; ++j) { const u32x2 t2 = *(const u32x2*)(xr + 4 * lane + 256 * j);
          v[u][j] = (f32x4){__uint_as_float(t2.x << 16), __uint_as_float(t2.x & 0xffff0000u), __uint_as_float(t2.y << 16), __uint_as_float(t2.y & 0xffff0000u)}; } }
#pragma unroll
      for (int j = 0; j < 4; ++j) mo[u][j] = *(const u32x2*)(mr + 4 * lane + 256 * j); }
    if (!act[0] && !act[1]) continue;
#pragma unroll
    for (int u = 0; u < 2; ++u) if (act[u]) { bf16_t* xd = XB + (size_t)rr[u] * DM;
#pragma unroll
      for (int j = 0; j < 4; ++j) { const int k = 4 * lane + 256 * j; const f32x4 g4 = *(const f32x4*)(mG + mo_[u] + k);
        const f32x4 m4 = (f32x4){__uint_as_float(mo[u][j].x << 16), __uint_as_float(mo[u][j].x & 0xffff0000u), __uint_as_float(mo[u][j].y << 16), __uint_as_float(mo[u][j].y & 0xffff0000u)};
        v[u][j] = v[u][j] + g4 * m4; u32x2 w2; w2.x = pk2bf(v[u][j].x, v[u][j].y); w2.y = pk2bf(v[u][j].z, v[u][j].w); *(u32x2*)(xd + k) = w2; } }
#pragma unroll
    for (int u = 0; u < 2; ++u) { float ss = 0.f;
#pragma unroll
      for (int j = 0; j < 4; ++j) ss += v[u][j].x * v[u][j].x + v[u][j].y * v[u][j].y + v[u][j].z * v[u][j].z + v[u][j].w * v[u][j].w;
      rstd[u] = rsqrtf(wave_sum(ss) * (1.0f / DM) + EPS); }
    float lg[2][16];
#pragma unroll
    for (int u = 0; u < 2; ++u)
#pragma unroll
      for (int e = 0; e < 16; ++e) lg[u][e] = 0.f;
#pragma unroll 1
    for (int j = 0; j < 4; ++j) { const int k = 4 * lane + 256 * j; float o[2][4];
#pragma unroll
      for (int u = 0; u < 2; ++u) { const f32x4 a4 = *(const f32x4*)(mA + mo_[u] + k), b4 = *(const f32x4*)(mB + mo_[u] + k); const f32x4 o4 = v[u][j] * rstd[u] * a4 + b4;
        o[u][0] = o4.x; o[u][1] = o4.y; o[u][2] = o4.z; o[u][3] = o4.w;
        if (act[u]) { u32x2 wpk; wpk.x = pk2bf(o4.x, o4.y); wpk.y = pk2bf(o4.z, o4.w); *(u32x2*)(H2 + (size_t)rr[u] * DM + k) = wpk; } }
#pragma unroll
      for (int q = 0; q < 4; ++q) { const float* wr_ = wl + ((q * 4 + j) * 64 + lane) * 20;
#pragma unroll
        for (int e4 = 0; e4 < 4; ++e4) { const f32x4 wr = *(const f32x4*)(wr_ + 4 * e4);
#pragma unroll
          for (int u = 0; u < 2; ++u) { lg[u][4 * e4] += o[u][q] * wr.x; lg[u][4 * e4 + 1] += o[u][q] * wr.y; lg[u][4 * e4 + 2] += o[u][q] * wr.z; lg[u][4 * e4 + 3] += o[u][q] * wr.w; } } } }
    float h1[2];
#pragma unroll
    for (int u = 0; u < 2; ++u) { float h8[8], h4[4], h2[2];
#pragma unroll
      for (int i = 0; i < 8; ++i) { const bool up = (lane & 32) != 0; const float keep = up ? lg[u][8 + i] : lg[u][i], give = up ? lg[u][i] : lg[u][8 + i]; h8[i] = keep + __shfl_xor(give, 32); }
#pragma unroll
      for (int i = 0; i < 4; ++i) { const bool up = (lane & 16) != 0; const float keep = up ? h8[4 + i] : h8[i], give = up ? h8[i] : h8[4 + i]; h4[i] = keep + __shfl_xor(give, 16); }
#pragma unroll
      for (int i = 0; i < 2; ++i) { const bool up = (lane & 8) != 0; const float keep = up ? h4[2 + i] : h4[i], give = up ? h4[i] : h4[2 + i]; h2[i] = keep + __shfl_xor(give, 8); }
      { const bool up = (lane & 4) != 0; const float keep = up ? h2[1] : h2[0], give = up ? h2[0] : h2[1]; h1[u] = keep + __shfl_xor(give, 4); }
      h1[u] += __shfl_xor(h1[u], 2); h1[u] += __shfl_xor(h1[u], 1); }
    float lx[16];
#pragma unroll
    for (int e = 0; e < 16; ++e) { const int src = ((e >> 3) & 1) * 32 + ((e >> 2) & 1) * 16 + ((e >> 1) & 1) * 8 + (e & 1) * 4;
      const float a0 = __uint_as_float(__builtin_amdgcn_readlane(__float_as_uint(h1[0]), src)), a1 = __uint_as_float(__builtin_amdgcn_readlane(__float_as_uint(h1[1]), src));
      lx[e] = lane < 32 ? a0 : a1; }
    const int us = lane >> 5;
    if ((lane & 31) == 0 && (us == 0 ? act[0] : act[1])) {
      const int r = us == 0 ? rr[0] : rr[1];
      int best = 0, bi1 = 0, bi2 = 1; float bestv = -1e30f, bs1 = 0.f, bs2 = 0.f;
#pragma unroll
      for (int gq = 0; gq < 4; ++gq) { float m1 = -1e30f, m2 = -1e30f, s1 = 0.f, s2 = 0.f; int i1 = 0, i2 = 0;
#pragma unroll
        for (int i = 0; i < 4; ++i) { const float scv = 1.0f / (1.0f + __expf(-lx[4 * gq + i])); const float sv = scv + rbias[4 * gq + i];
          if (sv > m1) { m2 = m1; s2 = s1; i2 = i1; m1 = sv; s1 = scv; i1 = i; } else if (sv > m2) { m2 = sv; s2 = scv; i2 = i; } }
        if (m1 + m2 > bestv) { bestv = m1 + m2; best = gq; bi1 = i1; bi2 = i2; bs1 = s1; bs2 = s2; } }
      const int ia = bi1 < bi2 ? bi1 : bi2, ib = bi1 < bi2 ? bi2 : bi1;
      const int tri = ia == 0 ? ib - 1 : (ia == 1 ? ib + 1 : 5);
      const int pidx = best * 6 + tri;
      const float sa = bi1 < bi2 ? bs1 : bs2, sb = bi1 < bi2 ? bs2 : bs1, inv = 1.0f / (sa + sb);
      const int rank = atomicAdd(&hist[pidx], 1);
      tok_pair[r] = pidx | (rank << 5); tok_w[2 * r] = sa * inv; tok_w[2 * r + 1] = sb * inv;
    }
  }
  __syncthreads();
  if (tid < 32) ctl[CT_CNTB + BIDX * 32 + tid] = tid < 24 ? hist[tid] : 0;
}
__device__ __forceinline__ void st_moe_gather(const bf16_t* H2, bf16_t* H2S, int* ctl, const int* tok_pair, const float* tok_w, int* sorted_tok, float* sorted_w, int* tok_slot, int skip_ctx, char* lds) {
  int* sbase = (int*)lds; int* rtot = sbase + 32; int* rpre = rtot + 512;
  const int tid = TIDX, bid = BIDX;
  { const int p = tid & 31, seg = tid >> 5; int tot = 0, pre = 0;
#pragma unroll 4
    for (int i = 0; i < 16; ++i) { const int bb = seg * 16 + i; const int cv = ctl[CT_CNTB + bb * 32 + p]; tot += cv; pre += bb < bid ? cv : 0; }
    rtot[seg * 32 + p] = tot; rpre[seg * 32 + p] = pre; }
  __syncthreads();
  if (tid < 32) { int tot = 0, pre = 0;
#pragma unroll
    for (int sg = 0; sg < 16; ++sg) { tot += rtot[sg * 32 + tid]; pre += rpre[sg * 32 + tid]; }
    rtot[tid] = tot; rpre[tid] = pre; }
  __syncthreads();
  if (tid == 0) { int base = 0, nt = 0;
#pragma unroll 1
    for (int p = 0; p < 24; ++p) { sbase[p] = base + rpre[p]; const int n = rtot[p], tl = (n + 255) >> 8;
      if (bid == 0) { ctl[CT_BASE + p] = base; for (int t = 0; t < tl; ++t) ctl[CT_TP + nt + t] = p; }
      nt += tl; base += tl * 256; }
    if (bid == 0) { ctl[CT_BASE + 24] = base; ctl[CT_NT] = nt; } }
  __syncthreads();
  const int lane = tid & 63, gw = bid * 8 + (tid >> 6), ngw = GDIM * 8;
  for (int rb = gw; rb < MTOK; rb += 3 * ngw) {
    u32x4 a0[3], a1[3]; int pk[3]; float w0[3], w1[3]; bool act[3];
#pragma unroll
    for (int u = 0; u < 3; ++u) { const int r = rb + u * ngw; act[u] = r < MTOK && !(skip_ctx && (r % TPB) < CTXL); const int rc = act[u] ? r : 0;
      pk[u] = tok_pair[rc]; w0[u] = tok_w[2 * rc]; w1[u] = tok_w[2 * rc + 1];
      const u32x4* sp = (const u32x4*)(H2 + (size_t)rc * DM); a0[u] = sp[lane]; a1[u] = sp[lane + 64]; }
#pragma unroll
    for (int u = 0; u < 3; ++u) if (act[u]) { const int r = rb + u * ngw; const int slot = sbase[pk[u] & 31] + (pk[u] >> 5);
      if (lane == 0) { sorted_tok[slot] = r; tok_slot[r] = slot; sorted_w[2 * slot] = w0[u]; sorted_w[2 * slot + 1] = w1[u]; }
      u32x4* d = (u32x4*)(H2S + (size_t)slot * DM); d[lane] = a0[u]; d[lane + 64] = a1[u]; }
  }
  __syncthreads();
}
__device__ __forceinline__ void st_final(float* out, const float* g, const bf16_t* XB, const bf16_t* YS, const int* tok_slot, const float* gate  ) {
  const int lane = TIDX & 63, gw = BIDX * 8 + (TIDX >> 6), ngw = GDIM * 8;
  f32x4 gg[4];
#pragma unroll
  for (int j = 0; j < 4; ++j) gg[j] = *(const f32x4*)(g + 4 * lane + 256 * j);
  for (int rb = gw; rb < NB * SEQ; rb += 4 * ngw) {
    u32x2 xb[4][4], ys[4][4];
#pragma unroll
    for (int u = 0; u < 4; ++u) { const int r = rb + u * ngw, rc = r < NB * SEQ ? r : NB * SEQ - 1;
      const int bb = rc >> 12, tr = bb * TPB + CTXL + (rc & 4095); const bf16_t* xr = XB + (size_t)tr * DM; const bf16_t* yr = YS + (size_t)tok_slot[tr] * DM;
#pragma unroll
      for (int j = 0; j < 4; ++j) { xb[u][j] = *(const u32x2*)(xr + 4 * lane + 256 * j); ys[u][j] = *(const u32x2*)(yr + 4 * lane + 256 * j); } }
#pragma unroll
    for (int u = 0; u < 4; ++u) { const int r = rb + u * ngw, rc = r < NB * SEQ ? r : NB * SEQ - 1; const float* gt = gate + (size_t)(rc >> 12) * 6144; float ss = 0.f; f32x4 v[4];
#pragma unroll
      for (int j = 0; j < 4; ++j) { const f32x4 g4 = *(const f32x4*)(gt + 4 * lane + 256 * j);
        const f32x4 x4 = (f32x4){__uint_as_float(xb[u][j].x << 16), __uint_as_float(xb[u][j].x & 0xffff0000u), __uint_as_float(xb[u][j].y << 16), __uint_as_float(xb[u][j].y & 0xffff0000u)};
        const f32x4 m4 = (f32x4){__uint_as_float(ys[u][j].x << 16), __uint_as_float(ys[u][j].x & 0xffff0000u), __uint_as_float(ys[u][j].y << 16), __uint_as_float(ys[u][j].y & 0xffff0000u)};
        v[j] = x4 + g4 * m4; ss += v[j].x * v[j].x + v[j].y * v[j].y + v[j].z * v[j].z + v[j].w * v[j].w; }
      const float rstd = rsqrtf(wave_sum(ss) * (1.0f / DM) + EPS);
      if (r < NB * SEQ) { float* orow = out + (size_t)r * DM;
#pragma unroll
        for (int j = 0; j < 4; ++j) *(f32x4*)(orow + 4 * lane + 256 * j) = (f32x4){v[j].x * rstd * gg[j].x, v[j].y * rstd * gg[j].y, v[j].z * rstd * gg[j].z, v[j].w * rstd * gg[j].w}; } }
  }
}

namespace pg8 {
#define PG8_LAS __attribute__((address_space(3)))
typedef unsigned short bf16_t;
typedef short bf16x8 __attribute__((ext_vector_type(8)));
typedef float f32x4 __attribute__((ext_vector_type(4)));
typedef unsigned u32x4 __attribute__((ext_vector_type(4)));
constexpr int BM = 256, BK = 64, HALF = 128, HTB = HALF * BK * 2  , STAGE_BYTES = 8 * HTB, NXCD = 8, WGM = 8;

__host__ __device__ __forceinline__ int lds_byte(int r, int c) { const int st = (r >> 4) * 2 + (c >> 5), rr = r & 15, cc = c & 31, ob = rr * 64 + cc * 2; return st * 1024 + (ob ^ (((ob >> 9) & 1) << 5)); }
__host__ __device__ __forceinline__ void stage_rc(int b, int& R, int& C) { const int st = b / 1024, sb = b % 1024, swz = sb ^ (((sb >> 9) & 1) << 5); R = (st >> 1) * 16 + swz / 64; C = (st & 1) * 32 + (swz % 64) / 2; }
__host__ __device__ __forceinline__ int perm32(int rho) { const int n = rho >> 4, i = rho & 15; return 8 * (i >> 2) + 4 * n + (i & 3); }

struct Unit { int pm, pn, fin, half; const char* A; const char* B; };
struct Gemm { int K, lda, ldb; };

__device__ __forceinline__ void tile_of(int L, int nM, int nN, int& pm, int& pn) {
    const int nwg = nM * nN; int wgid = L; { const int q = nwg / NXCD, r = nwg % NXCD, xcd = wgid % NXCD, off = wgid / NXCD; wgid = (xcd < r ? xcd * (q + 1) : r * (q + 1) + (xcd - r) * q) + off; }
    const int nig = WGM * nN, gid = wgid / nig, fm = gid * WGM, gsz = (nM - fm) < WGM ? (nM - fm) : WGM;
    pm = fm + ((wgid % nig) % gsz); pn = (wgid % nig) / gsz;
}
__device__ __forceinline__ unsigned cvt_pk_bf16(float lo, float hi) { unsigned r; asm volatile("v_cvt_pk_bf16_f32 %0, %1, %2" : "=v"(r) : "v"(lo), "v"(hi)); return r; }
template <class Epi, class Sched, bool ALIGN_EPI = false, bool SP2 = false, bool HALFM = false>
__device__ __forceinline__ void gemm_phase(PG8_LAS unsigned char* lds, const Gemm g, const Sched& S, const Epi& E) {
    const int tid = opq_v((int)threadIdx.x), wid = __builtin_amdgcn_readfirstlane(tid >> 6), lane = tid & 63, wr = wid >> 2, wc = wid & 3, fr = lane & 15, fq = lane >> 4;
    const int K = g.K, nt = K / BK;
    unsigned voffA[2], voffB[2];
#pragma unroll
    for (int i = 0; i < 2; ++i) { int R, C; stage_rc(tid * 16 + i * 8192, R, C); const int Rb = Epi::PERM ? ((R & ~31) + perm32(R & 31)) : R;
        voffA[i] = (unsigned)(R * g.lda + C) * 2u; voffB[i] = (unsigned)(Rb * g.ldb + C) * 2u; }
    const size_t kstep = (size_t)(BK * 2);
    static_assert(!HALFM || SP2, "half-height units need the SP2 loop");
    const size_t hstepA = (size_t)HALF * g.lda * 2, hstepB = (size_t)HALF * g.ldb * 2;
    const unsigned ldsw = (unsigned)wid * 1024u;
    const int aoff = lds_byte(wr * 64 + fr, fq * 8), boff = lds_byte(wc * 32 + fr, fq * 8);
#define PG8_SA(b, h) (((b) * 2 + (h)) * HTB)
#define PG8_SB(b, h) ((4 + (b) * 2 + (h)) * HTB)
#define PG8_STAGE(bufoff, gbase, voff) do { _Pragma("unroll") for (int _i = 0; _i < 2; ++_i) \
        __builtin_amdgcn_global_load_lds((const unsigned*)((const char*)(gbase) + (voff)[_i]), (PG8_LAS unsigned*)(lds + (bufoff) + ldsw + _i * 8192), 16, 0, 0); } while (0)
#define PG8_LDA(dst, b, h) do { _Pragma("unroll") for (int m = 0; m < 4; ++m) _Pragma("unroll") for (int k = 0; k < 2; ++k) dst[m][k] = *(const PG8_LAS bf16x8*)(lds + PG8_SA(b, h) + aoff + m * 2048 + k * 1024); } while (0)
#define PG8_LDB(dst, b, h) do { _Pragma("unroll") for (int n = 0; n < 2; ++n) _Pragma("unroll") for (int k = 0; k < 2; ++k) dst[n][k] = *(const PG8_LAS bf16x8*)(lds + PG8_SB(b, h) + boff + n * 2048 + k * 1024); } while (0)
#define PG8_MMA(ai, bj, At, Bt) do { __builtin_amdgcn_s_setprio(1); _Pragma("unroll") for (int m = 0; m < 4; ++m) _Pragma("unroll") for (int n = 0; n < 2; ++n) _Pragma("unroll") for (int k = 0; k < 2; ++k) \
        acc[ai][bj][m][n] = __builtin_amdgcn_mfma_f32_16x16x32_bf16(Bt[n][k], At[m][k], acc[ai][bj][m][n], 0, 0, 0); __builtin_amdgcn_s_setprio(0); } while (0)
#define PG8_WAIT_V(n) asm volatile("s_waitcnt vmcnt(" #n ")" ::: "memory")
#define PG8_WAIT_L(n) asm volatile("s_waitcnt lgkmcnt(" #n ")" ::: "memory")
#define PG8_BAR __builtin_amdgcn_s_barrier()
#define PG8_SCHED __builtin_amdgcn_sched_barrier(0)
    Unit cur, nxt; int ui = 0;
    if (!S.next(0, cur)) return;
    f32x4 acc[2][2][4][2];
#pragma unroll
    for (int a = 0; a < 2; ++a)
#pragma unroll
        for (int b = 0; b < 2; ++b)
#pragma unroll
            for (int m = 0; m < 4; ++m)
#pragma unroll
                for (int n = 0; n < 2; ++n) acc[a][b][m][n] = (f32x4){0.f, 0.f, 0.f, 0.f};
    bf16x8 At[4][2], B0[2][2], B1[2][2];
    const char* cA = cur.A; const char* cB = cur.B;
    S.a_ready(cur);
    if constexpr (SP2) {
        PG8_STAGE(PG8_SB(0, 0), cB, voffB); PG8_STAGE(PG8_SB(0, 1), cB + hstepB, voffB); PG8_STAGE(PG8_SA(0, 0), cA, voffA); if constexpr (!HALFM) PG8_STAGE(PG8_SA(0, 1), cA + hstepA, voffA);
        if (wr == 1) PG8_BAR;
        if constexpr (HALFM) PG8_WAIT_V(0); else PG8_WAIT_V(2);
        PG8_BAR;
        PG8_STAGE(PG8_SB(1, 0), cB + kstep, voffB); PG8_STAGE(PG8_SA(1, 0), cA + kstep, voffA); PG8_STAGE(PG8_SB(1, 1), cB + hstepB + kstep, voffB);
        PG8_WAIT_V(6); PG8_BAR;
    } else {
        PG8_STAGE(PG8_SB(0, 0), cB, voffB); PG8_STAGE(PG8_SA(0, 0), cA, voffA); PG8_STAGE(PG8_SB(0, 1), cB + hstepB, voffB); PG8_STAGE(PG8_SA(0, 1), cA + hstepA, voffA);
        if (wr == 1) PG8_BAR;
        PG8_WAIT_V(4); PG8_BAR;
        PG8_STAGE(PG8_SB(1, 0), cB + kstep, voffB); PG8_STAGE(PG8_SA(1, 0), cA + kstep, voffA); PG8_STAGE(PG8_SB(1, 1), cB + hstepB + kstep, voffB);
        PG8_WAIT_V(6); PG8_BAR;
    }
    for (;;) {
        const bool has_next = S.next(ui + 1, nxt);
        const char* nA = has_next ? nxt.A : cA; const char* nB = has_next ? nxt.B : cB;
        for (int t = 0; t < nt; t += 2) {
            const bool last = (t == nt - 2);
            const char* a1 = cA + (size_t)(t + 1) * kstep;
            const char* a2 = last ? nA : cA + (size_t)(t + 2) * kstep; const char* b2 = last ? nB : cB + (size_t)(t + 2) * kstep;
            const char* a3 = a2 + kstep; const char* b3 = b2 + kstep;
            if (last && has_next) S.a_ready(nxt);
            if constexpr (SP2) {
            PG8_LDB(B0, 0, 0); PG8_LDB(B1, 0, 1); PG8_SCHED; PG8_LDA(At, 0, 0); if constexpr (!HALFM) PG8_STAGE(PG8_SA(1, 1), a1 + hstepA, voffA);
            PG8_WAIT_V(8); PG8_WAIT_L(0); PG8_BAR; PG8_MMA(0, 0, At, B0); PG8_MMA(0, 1, At, B1); PG8_BAR; PG8_SCHED;
            if constexpr (!HALFM) PG8_LDA(At, 0, 1);
            PG8_STAGE(PG8_SB(0, 0), b2, voffB); PG8_STAGE(PG8_SB(0, 1), b2 + hstepB, voffB); PG8_STAGE(PG8_SA(0, 0), a2, voffA);
            if constexpr (HALFM) PG8_WAIT_V(6); else PG8_WAIT_V(8);
            PG8_WAIT_L(0); PG8_BAR; if constexpr (!HALFM) { PG8_MMA(1, 0, At, B0); PG8_MMA(1, 1, At, B1); } PG8_BAR; PG8_SCHED;
            PG8_LDB(B0, 1, 0); PG8_LDB(B1, 1, 1); PG8_SCHED; PG8_LDA(At, 1, 0); if constexpr (!HALFM) PG8_STAGE(PG8_SA(0, 1), a2 + hstepA, voffA);
            PG8_WAIT_V(8); PG8_WAIT_L(0); PG8_BAR; PG8_MMA(0, 0, At, B0); PG8_MMA(0, 1, At, B1); PG8_BAR; PG8_SCHED;
            if constexpr (!HALFM) PG8_LDA(At, 1, 1);
            PG8_STAGE(PG8_SB(1, 0), b3, voffB); PG8_STAGE(PG8_SB(1, 1), b3 + hstepB, voffB); PG8_STAGE(PG8_SA(1, 0), a3, voffA);
            if constexpr (HALFM) PG8_WAIT_V(6); else PG8_WAIT_V(8);
            PG8_WAIT_L(0); PG8_BAR; if constexpr (!HALFM) { PG8_MMA(1, 0, At, B0); PG8_MMA(1, 1, At, B1); } PG8_BAR; PG8_SCHED;
            } else {
            PG8_LDB(B0, 0, 0); PG8_SCHED; PG8_LDA(At, 0, 0); PG8_STAGE(PG8_SA(1, 1), a1 + hstepA, voffA);
            PG8_WAIT_L(8); PG8_BAR; PG8_WAIT_L(0); PG8_MMA(0, 0, At, B0); PG8_BAR; PG8_SCHED;
            PG8_LDB(B1, 0, 1); PG8_STAGE(PG8_SB(0, 0), b2, voffB);
            PG8_BAR; PG8_WAIT_L(0); PG8_MMA(0, 1, At, B1); PG8_BAR;
            PG8_LDA(At, 0, 1); PG8_STAGE(PG8_SA(0, 0), a2, voffA);
            PG8_BAR; PG8_WAIT_L(0); PG8_MMA(1, 0, At, B0); PG8_BAR; PG8_SCHED;
            PG8_STAGE(PG8_SB(0, 1), b2 + hstepB, voffB);
            PG8_WAIT_V(6); PG8_BAR; PG8_MMA(1, 1, At, B1); PG8_BAR;
            PG8_LDB(B0, 1, 0); PG8_SCHED; PG8_LDA(At, 1, 0); PG8_STAGE(PG8_SA(0, 1), a2 + hstepA, voffA);
            PG8_WAIT_L(8); PG8_BAR; PG8_WAIT_L(0); PG8_MMA(0, 0, At, B0); PG8_BAR; PG8_SCHED;
            PG8_LDB(B1, 1, 1); PG8_STAGE(PG8_SB(1, 0), b3, voffB);
            PG8_BAR; PG8_WAIT_L(0); PG8_MMA(0, 1, At, B1); PG8_BAR;
            PG8_LDA(At, 1, 1); PG8_STAGE(PG8_SA(1, 0), a3, voffA);
            PG8_BAR; PG8_WAIT_L(0); PG8_MMA(1, 0, At, B0); PG8_BAR; PG8_SCHED;
            PG8_STAGE(PG8_SB(1, 1), b3 + hstepB, voffB);
            PG8_WAIT_V(6); PG8_BAR; PG8_MMA(1, 1, At, B1); PG8_BAR;
            }
        }
        if constexpr (ALIGN_EPI) { if (wr == 0) PG8_BAR; }
        if constexpr (!Epi::AFTER_DRAIN) { if (cur.fin) { E(acc, cur, wr, wc, fr, fq, HALFM ? 1 : 2); S.done(cur); } }
        if (!has_next) break;
        if (cur.fin) {
#pragma unroll
        for (int a = 0; a < 2; ++a)
#pragma unroll
            for (int b = 0; b < 2; ++b)
#pragma unroll
                for (int m = 0; m < 4; ++m)
#pragma unroll
                    for (int n = 0; n < 2; ++n) acc[a][b][m][n] = (f32x4){0.f, 0.f, 0.f, 0.f};
        }
        cur = nxt; cA = nA; cB = nB; ++ui;
        if constexpr (ALIGN_EPI) { if (wr == 1) PG8_BAR; }
    }
    PG8_WAIT_V(0);
    if constexpr (!ALIGN_EPI) { if (wr == 0) PG8_BAR; }
    PG8_BAR;
    if constexpr (Epi::AFTER_DRAIN) { E.fused(acc, cur, wr, wc, fr, fq, lds, wid, lane); S.done(cur); }
#undef PG8_SA
#undef PG8_SB
#undef PG8_STAGE
#undef PG8_LDA
#undef PG8_LDB
#undef PG8_MMA
#undef PG8_WAIT_V
#undef PG8_WAIT_L
#undef PG8_BAR
#undef PG8_SCHED
}
}

struct SchedDense {
  int nM, nN, G, c, skip_ctx; const char* A; const char* B; size_t a_tile, b_tile; int part;
  __device__ __forceinline__ bool next(int i, pg8::Unit& u) const {
    const int nu = nM * nN, T = nu % G; const bool split = T > 0 && 2 * T <= G; int L, half = 0;
    if (part == 0) { L = i * G + c; if (L >= (split ? nu - T : nu)) return false; }
    else { if (i > 0 || !split || c >= 2 * T) return false; L = nu - T + (c >> 1); half = 1 + (c & 1); }
    int pm, pn; pg8::tile_of(L, nM, nN, pm, pn); if (skip_ctx) pm = pm + pm / 16 + 1;
    u.pm = pm; u.pn = pn; u.fin = 1; u.half = half; u.A = A + (size_t)pm * a_tile + (half == 2 ? a_tile / 2 : 0); u.B = B + (size_t)pn * b_tile; return true; }
  __device__ __forceinline__ void a_ready(const pg8::Unit&) const {}
  __device__ __forceinline__ void done(const pg8::Unit&) const {}
};
struct SchedMoe {
  int G, c, mode; const int* ctl; const char* A; size_t a_tile; const char* W; int tail;
  __device__ __forceinline__ bool next(int i, pg8::Unit& u) const {
    const int part = mode == 2 ? (i & 1) : 0, iu = mode == 2 ? (i >> 1) : i;
    const int nu = ctl[CT_NT] * 4, T = nu % G; const bool split = T > 0 && 2 * T <= G; int L, half = 0;
    if (tail == 0) { L = iu * G + c; if (L >= (split ? nu - T : nu)) return false; }
    else { if (iu > 0 || !split || c >= 2 * T) return false; L = nu - T + (c >> 1); half = 1 + (c & 1); }
    const int pm = L >> 2, pn = L & 3; int eA, eB; pair_experts(ctl[CT_TP + pm], eA, eB);
    u.pm = pm; u.pn = pn; u.half = half; const size_t ho = half == 2 ? a_tile / 2 : 0;
    if (mode == 1) { const int e = pn < 2 ? eA : eB; u.fin = 1; u.A = A + (size_t)pm * a_tile + ho; u.B = W + (size_t)e * (512 * 1024 * 2) + (size_t)(pn & 1) * (256 * 1024 * 2); }
    else { u.fin = part; u.A = A + (size_t)pm * a_tile + ho + part * 512; u.B = W + (size_t)(part ? eB : eA) * (1024 * 256 * 2) + (size_t)pn * (256 * 256 * 2); }
    return true; }
  __device__ __forceinline__ void a_ready(const pg8::Unit&) const {}
  __device__ __forceinline__ void done(const pg8::Unit&) const {}
};
__device__ __forceinline__ unsigned cvt_pk(float lo, float hi) { return pg8::cvt_pk_bf16(lo, hi); }
struct EpiInProj {
  static constexpr bool PERM = true, AFTER_DRAIN = false; bf16_t *QK, *VZ, *XBC, *HY; float* DT;
  __device__ __forceinline__ void operator()(const f32x4 (&acc)[2][2][4][2], const pg8::Unit& u, int wr, int wc, int fr, int fq, const int nai) const {
    const int pn = u.pn; bf16_t* base; int ldc, coff;
    if (pn < 2) { base = QK; ldc = 512; coff = pn * 256; } else if (pn < 4) { base = VZ; ldc = 512; coff = (pn - 2) * 256; }
    else if (pn < 7) { base = XBC; ldc = 768; coff = (pn - 4) * 256; } else { base = HY; ldc = 768; coff = (pn - 7) * 256; }
    const int row0 = u.pm * 256 + (u.half == 2 ? 128 : 0) + wr * 64 + fr, col0 = coff + wc * 32 + 8 * fq; const bool dtl = (pn == 6 && wc == 0 && fq < 2);
#pragma unroll
    for (int ai = 0; ai < 2; ++ai)
#pragma unroll
      for (int m = 0; m < 4; ++m) if (ai < nai) { const int row = row0 + ai * 128 + m * 16; bf16_t* rowp = base + (size_t)row * ldc + col0;
#pragma unroll
        for (int bj = 0; bj < 2; ++bj) { const f32x4 v0 = acc[ai][bj][m][0], v1 = acc[ai][bj][m][1];
          u32x4 w; w.x = cvt_pk(v0[0], v0[1]); w.y = cvt_pk(v0[2], v0[3]); w.z = cvt_pk(v1[0], v1[1]); w.w = cvt_pk(v1[2], v1[3]);
          *(u32x4*)(rowp + bj * 128) = w;
          if (bj == 1 && dtl) { float* dp = DT + (size_t)row * 12 + 8 * fq; *(f32x4*)dp = v0; if (fq == 0) *(f32x4*)(dp + 4) = v1; } } }
  }
};
struct EpiOutProj {
  static constexpr bool PERM = true, AFTER_DRAIN = false; bf16_t* MO;
  __device__ __forceinline__ void operator()(const f32x4 (&acc)[2][2][4][2], const pg8::Unit& u, int wr, int wc, int fr, int fq, const int nai) const {
    const int row0 = u.pm * 256 + (u.half == 2 ? 128 : 0) + wr * 64 + fr, col0 = u.pn * 256 + wc * 32 + 8 * fq;
#pragma unroll
    for (int ai = 0; ai < 2; ++ai)
#pragma unroll
      for (int m = 0; m < 4; ++m) if (ai < nai) { bf16_t* rowp = MO + (size_t)(row0 + ai * 128 + m * 16) * DM + col0;
#pragma unroll
        for (int bj = 0; bj < 2; ++bj) { const f32x4 v0 = acc[ai][bj][m][0], v1 = acc[ai][bj][m][1];
          u32x4 w; w.x = cvt_pk(v0[0], v0[1]); w.y = cvt_pk(v0[2], v0[3]); w.z = cvt_pk(v1[0], v1[1]); w.w = cvt_pk(v1[2], v1[3]);
          *(u32x4*)(rowp + bj * 128) = w; } }
  }
};
struct EpiMoe1 {
  static constexpr bool PERM = true, AFTER_DRAIN = false; bf16_t* ACT; const float* sorted_w;
  __device__ __forceinline__ void operator()(const f32x4 (&acc)[2][2][4][2], const pg8::Unit& u, int wr, int wc, int fr, int fq, const int nai) const {
    const int half = u.pn >> 1, j0 = (u.pn & 1) * 128 + 16 * wc + 4 * fq;
#pragma unroll
    for (int ai = 0; ai < 2; ++ai)
#pragma unroll
      for (int m = 0; m < 4; ++m) if (ai < nai) { const int slot = u.pm * 256 + (u.half == 2 ? 128 : 0) + ai * 128 + wr * 64 + m * 16 + fr; const float wt = sorted_w[2 * slot + half];
#pragma unroll
        for (int bj = 0; bj < 2; ++bj) { const f32x4 v0 = acc[ai][bj][m][0], v1 = acc[ai][bj][m][1];
          u32x2 w; w.x = cvt_pk(siluf(v0[0]) * v0[1] * wt, siluf(v0[2]) * v0[3] * wt); w.y = cvt_pk(siluf(v1[0]) * v1[1] * wt, siluf(v1[2]) * v1[3] * wt);
          *(u32x2*)(ACT + (size_t)slot * 512 + half * 256 + j0 + 64 * bj) = w; } }
  }
};
struct EpiMoe2 {
  static constexpr bool PERM = true, AFTER_DRAIN = false; bf16_t* YS;
  __device__ __forceinline__ void operator()(const f32x4 (&acc)[2][2][4][2], const pg8::Unit& u, int wr, int wc, int fr, int fq, const int nai) const {
    const int row0 = u.pm * 256 + (u.half == 2 ? 128 : 0) + wr * 64 + fr, col0 = u.pn * 256 + wc * 32 + 8 * fq;
#pragma unroll
    for (int ai = 0; ai < 2; ++ai)
#pragma unroll
      for (int m = 0; m < 4; ++m) if (ai < nai) { bf16_t* rowp = YS + (size_t)(row0 + ai * 128 + m * 16) * DM + col0;
#pragma unroll
        for (int bj = 0; bj < 2; ++bj) { const f32x4 v0 = acc[ai][bj][m][0], v1 = acc[ai][bj][m][1];
          u32x4 w; w.x = cvt_pk(v0[0], v0[1]); w.y = cvt_pk(v0[2], v0[3]); w.z = cvt_pk(v1[0], v1[1]); w.w = cvt_pk(v1[2], v1[3]);
          *(u32x4*)(rowp + bj * 128) = w; } }
  }
};

#include <hip/hip_bf16.h>
#include <cmath>
namespace attn_body {
using bf16=__hip_bfloat16;
using bf16x8=__attribute__((ext_vector_type(8)))short;
using s16x4=__attribute__((ext_vector_type(4)))short;
using f32x16=__attribute__((ext_vector_type(16)))float;
using u32x4=__attribute__((ext_vector_type(4)))unsigned;
constexpr int D=64,QP=512,KP=512,VP=512,OP=1024;
constexpr int NW=8,QBLK=32,QB=QBLK*NW,KVBLK=64;
constexpr int ATTN_UNIT_ROWS=QB;
__device__ __forceinline__ int crow(int r,int hi){return (r&3)+8*(r>>2)+4*hi;}
#define SBAR() __builtin_amdgcn_sched_barrier(0)
__device__ __forceinline__ void cmask(f32x16&p0,f32x16&p1,int jb,int qrel,int hi){
  const float NEG=-INFINITY; int kb=64*jb+4*hi;
  #pragma unroll
  for(int r=0;r<16;++r){int kv=kb+(r&3)+8*(r>>2); if(kv>qrel)p0[r]=NEG; if(kv+32>qrel)p1[r]=NEG;}
}

constexpr int NSLOT=3, SLOTB=8192;
constexpr int LDS_K=0, LDS_V=NSLOT*SLOTB, LDS_WS=2*NSLOT*SLOTB, LDS_OST=LDS_WS+NW*64*4, LDS_BYTES=LDS_OST+NW*4096;
constexpr float C2=0.125f*1.4426950408889634f;
__device__ __forceinline__ void glds16(const void*gsrc,unsigned lds_dst){unsigned keep;
  asm volatile("s_mov_b32 %0, m0\n\ts_mov_b32 m0, %2\n\ts_nop 0\n\tglobal_load_lds_dwordx4 %1, off\n\ts_mov_b32 m0, %0":"=&s"(keep):"v"(gsrc),"s"(lds_dst):"memory");}
__device__ __forceinline__ float max3f(float a,float b,float c){float r;asm("v_max3_f32 %0, %1, %2, %3":"=v"(r):"v"(a),"v"(b),"v"(c));return r;}
__device__ __forceinline__ float max2f(float a,float b){float r;asm("v_max_f32_e32 %0, %1, %2":"=v"(r):"v"(a),"v"(b));return r;}
__device__ __forceinline__ float fadd_s(float a,float b){float r;asm("v_add_f32_e32 %0, %1, %2":"=v"(r):"v"(a),"v"(b));return r;}
__device__ __forceinline__ float fsub_s(float a,float b){float r;asm("v_sub_f32_e32 %0, %1, %2":"=v"(r):"v"(a),"v"(b));return r;}
typedef float f32x2_t __attribute__((ext_vector_type(2))); typedef __bf16 bf16x2_t __attribute__((ext_vector_type(2)));
__device__ __forceinline__ unsigned cvtpk_s(float lo,float hi){f32x2_t v={lo,hi};bf16x2_t b=__builtin_convertvector(v,bf16x2_t);return __builtin_bit_cast(unsigned,b);}
#define WAIT_BAR(N) asm volatile("s_waitcnt vmcnt(" #N ") lgkmcnt(0)\n\ts_barrier":::"memory")

__device__ __forceinline__ void qkt(f32x16&p0,f32x16&p1,const char*Kslot,const bf16x8*qr,const f32x16&negm,int r32,int hi){
  const char*kb=Kslot+hi*1024+r32*16;
  #pragma unroll
  for(int d0=0;d0<4;++d0){
    const bf16x8 b0=*reinterpret_cast<const bf16x8*>(kb+d0*2048);
    const bf16x8 b1=*reinterpret_cast<const bf16x8*>(kb+d0*2048+512);
    if(d0==0){p0=__builtin_amdgcn_mfma_f32_32x32x16_bf16(b0,qr[0],negm,0,0,0);p1=__builtin_amdgcn_mfma_f32_32x32x16_bf16(b1,qr[0],negm,0,0,0);}
    else{p0=__builtin_amdgcn_mfma_f32_32x32x16_bf16(b0,qr[d0],p0,0,0,0);p1=__builtin_amdgcn_mfma_f32_32x32x16_bf16(b1,qr[d0],p1,0,0,0);}}
}
typedef __attribute__((address_space(3))) const char* lds_cptr;
typedef short v4i16_t __attribute__((ext_vector_type(4)));
__device__ __forceinline__ void kload8(bf16x8*kf,lds_cptr kp){
  kf[0]=*(const __attribute__((address_space(3))) bf16x8*)(kp);      kf[1]=*(const __attribute__((address_space(3))) bf16x8*)(kp+512);
  kf[2]=*(const __attribute__((address_space(3))) bf16x8*)(kp+2048); kf[3]=*(const __attribute__((address_space(3))) bf16x8*)(kp+2560);
  kf[4]=*(const __attribute__((address_space(3))) bf16x8*)(kp+4096); kf[5]=*(const __attribute__((address_space(3))) bf16x8*)(kp+4608);
  kf[6]=*(const __attribute__((address_space(3))) bf16x8*)(kp+6144); kf[7]=*(const __attribute__((address_space(3))) bf16x8*)(kp+6656);
}
__device__ __forceinline__ void kload2(bf16x8*kf,lds_cptr kp,int j){ kf[2*j]=*(const __attribute__((address_space(3))) bf16x8*)(kp+j*2048); kf[2*j+1]=*(const __attribute__((address_space(3))) bf16x8*)(kp+j*2048+512); }
__device__ __forceinline__ s16x4 vtr(lds_cptr p){ return __builtin_bit_cast(s16x4,__builtin_amdgcn_ds_read_tr16_b64_v4i16((__attribute__((address_space(3))) v4i16_t*)p)); }
__device__ __forceinline__ float rowmax(const f32x16&p0,const f32x16&p1){
  float a=max3f(p0[0],p0[1],p1[0]),b=max3f(p0[2],p0[3],p1[1]);a=max3f(a,p1[2],p1[3]);
  #pragma unroll
  for(int r=4;r<16;r+=4){a=max3f(a,p0[r],p0[r+1]);b=max3f(b,p0[r+2],p0[r+3]);a=max3f(a,p1[r],p1[r+1]);b=max3f(b,p1[r+2],p1[r+3]);}
  const float m=max2f(a,b);
  auto rr=__builtin_amdgcn_permlane32_swap(__float_as_uint(m),__float_as_uint(m),false,false);
  return max2f(__uint_as_float(rr[0]),__uint_as_float(rr[1]));
}
__device__ __forceinline__ void pv(f32x16*o,int vb,bf16x8 pa0,bf16x8 pa1,bf16x8 pa2,bf16x8 pa3){
  #pragma unroll
  for(int d0=0;d0<2;++d0){s16x4 lo[4],hi[4];
    #pragma unroll
    for(int ks=0;ks<4;++ks){
      asm volatile("ds_read_b64_tr_b16 %0,%1 offset:%c2":"=&v"(lo[ks]):"v"(vb),"i"(d0*4096+ks*1024):"memory");
      asm volatile("ds_read_b64_tr_b16 %0,%1 offset:%c2":"=&v"(hi[ks]):"v"(vb),"i"(d0*4096+ks*1024+512):"memory");}
    asm volatile("s_waitcnt lgkmcnt(0)":::"memory");SBAR();
    #define PK(k) (bf16x8){lo[k][0],lo[k][1],lo[k][2],lo[k][3],hi[k][0],hi[k][1],hi[k][2],hi[k][3]}
    o[d0]=__builtin_amdgcn_mfma_f32_32x32x16_bf16(pa0,PK(0),o[d0],0,0,0);
    o[d0]=__builtin_amdgcn_mfma_f32_32x32x16_bf16(pa1,PK(1),o[d0],0,0,0);
    o[d0]=__builtin_amdgcn_mfma_f32_32x32x16_bf16(pa2,PK(2),o[d0],0,0,0);
    o[d0]=__builtin_amdgcn_mfma_f32_32x32x16_bf16(pa3,PK(3),o[d0],0,0,0);
    #undef PK
  }
}

#ifndef ATTN_STORE16
#define ATTN_STORE16(p,v) (*(u32x4*)(p)=(v))
#endif
template<int THRL> __device__ __forceinline__ void attn_unit(const bf16*Qu,const bf16*__restrict__ Kh,const bf16*__restrict__ Vh,bf16*Ou,const int NT,char*shm){
  const int tid=opq_v((int)threadIdx.x),lane=tid&63,r32=lane&31,hi=lane>>5; const int wid=__builtin_amdgcn_readfirstlane(tid>>6);
  const bf16*Qw=Qu+(long)(wid*QBLK)*QP;
  const unsigned lds0=(unsigned)(uintptr_t)shm;
  float*wsf=(float*)(shm+LDS_WS)+wid*64;
  const bf16*ksrc=Kh+(long)lane*KP+wid*8;
  const bf16*vsrc=Vh+(long)(16*(wid&3)+(lane>>2))*VP+(wid>>2)*32+(lane&3)*8;
  const unsigned kdst=lds0+LDS_K+wid*1024, vdst=lds0+LDS_V+wid*1024;
  #define DMA_K(t,slot) glds16(ksrc+(long)(t)*KVBLK*KP,(unsigned)__builtin_amdgcn_readfirstlane(kdst+(slot)))
  #define DMA_V(t,slot) glds16(vsrc+(long)(t)*KVBLK*VP,(unsigned)__builtin_amdgcn_readfirstlane(vdst+(slot)))
  const int vb0=(int)(lds0+LDS_V)+((lane>>4)&1)*32+(lane&3)*8+(4*hi+((lane&15)>>2))*64;
  const char*Kbase=shm+LDS_K; bf16x8 kf[8];
  const lds_cptr shm3=(lds_cptr)shm; const lds_cptr kp0=shm3+LDS_K+hi*1024+r32*16; const lds_cptr vp0=shm3+LDS_V+((lane>>4)&1)*32+(lane&3)*8+(4*hi+((lane&15)>>2))*64;
  DMA_K(0,0);DMA_V(0,0);DMA_K(1,SLOTB);
  bf16x8 qr[4];
  #pragma unroll
  for(int d0=0;d0<4;++d0)qr[d0]=*reinterpret_cast<const bf16x8*>(&Qw[(long)r32*QP+d0*16+hi*8]);
  float mhat=0.f,l_reg=0.f;float z0_=0.f;asm volatile("":"+v"(z0_));f32x16 o[2];f32x16 negm;
  _Pragma("unroll") for(int r=0;r<16;++r){o[0][r]=z0_;o[1][r]=z0_;negm[r]=z0_;} asm volatile("":"+v"(negm));
  #define CMASK(P0,P1,t) do{}while(0)
  bool resc=false;
  #define START(P0,P1) do{ const float rm=rowmax(P0,P1); resc=false; \
    { const float dl=rm; mhat=fadd_s(mhat,dl); \
      _Pragma("unroll") for(int r=0;r<16;++r){P0[r]=fsub_s(P0[r],dl);P1[r]=fsub_s(P1[r],dl);} \
      _Pragma("unroll") for(int r=0;r<16;++r)negm[r]=-mhat; asm volatile("":"+v"(negm)); } \
    _Pragma("unroll") for(int r=0;r<16;++r)P0[r]=__builtin_amdgcn_exp2f(P0[r]); }while(0)
  #define RESC() do{ if(resc){ asm volatile("s_waitcnt lgkmcnt(0)":::"memory"); \
      _Pragma("unroll") for(int d_=0;d_<2;++d_) _Pragma("unroll") for(int r=0;r<16;++r)o[d_][r]*=wsf[crow(r,hi)]; } }while(0)
  f32x16 pA0,pA1,pB0,pB1;
  int sl_prev=0,sl_cur=0,sl_next=SLOTB;
  #define ROT() do{sl_prev=sl_cur;sl_cur=sl_next;sl_next=(sl_next==(NSLOT-1)*SLOTB)?0:sl_next+SLOTB;}while(0)
  DMA_K(2,2*SLOTB);
  WAIT_BAR(3);
  qkt(pA0,pA1,Kbase,qr,negm,r32,hi);asm volatile("s_nop 15\n\ts_nop 7":"+v"(pA0),"+v"(pA1));CMASK(pA0,pA1,0);
  START(pA0,pA1);
  _Pragma("unroll") for(int r=0;r<16;++r)pA1[r]=__builtin_amdgcn_exp2f(pA1[r]);
  WAIT_BAR(0);
  DMA_K(3,0);DMA_V(1,SLOTB);
  ROT();
  kload8(kf,kp0+sl_cur);
  WAIT_BAR(2);
  s16x4 vlo[8],vhi[8]; u32x4 pw0,pw1,pw2,pw3;
  #define PKW(P,B) cvtpk_s(P[B],P[B+1])
  #define PAF(k) __builtin_bit_cast(bf16x8,pw##k)
  #define VFR(i) (bf16x8){vlo[i][0],vlo[i][1],vlo[i][2],vlo[i][3],vhi[i][0],vhi[i][1],vhi[i][2],vhi[i][3]}
  #define PIN(x) asm volatile("":"+v"(x))
  #define MX3(a,b,c) __builtin_fmaxf(__builtin_fmaxf((a),(b)),(c))
  #define GAPA(MF,A0,A1,A2,A3,W0,W1,PW) do{ MF; sacc+=A0; sacc+=A1; sacc+=A2; sacc+=A3; PIN(sacc); W0; W1; PIN(PW); SBAR(); }while(0)
  #define EX(v) __builtin_amdgcn_exp2f(v)
  #define GAPB(MF,X,B) do{ MF; X[B]=EX(X[B]); X[B+1]=EX(X[B+1]); X[B+2]=EX(X[B+2]); X[B+3]=EX(X[B+3]); PIN(X); SBAR(); }while(0)
  #define VRD(i) do{ vlo[i]=vtr(vp_+(((i)>>2)*4096+((i)&3)*1024)); vhi[i]=vtr(vp_+(((i)>>2)*4096+((i)&3)*1024+512)); }while(0)
  #define KRD(G,j) do{ if(G){ kload2(kf,kp0+sl_next,j); SBAR(); } }while(0)
  #define STEP(C0,C1,P0,P1,t,GK,GV,GL) do{ SBAR(); \
    const lds_cptr vp_=vp0+sl_prev; \
    VRD(0); SBAR(); float sacc=(P0[0]+P0[1]); \
    GAPA(C0=__builtin_amdgcn_mfma_f32_32x32x16_bf16(kf[0],qr[0],negm,0,0,0), P0[2],P0[3],P0[4],P0[5],     pw0[0]=PKW(P0,0), pw0[1]=PKW(P0,2), pw0); \
    VRD(4); SBAR(); GAPA(C1=__builtin_amdgcn_mfma_f32_32x32x16_bf16(kf[1],qr[0],negm,0,0,0), P0[6],P0[7],P0[8],P0[9],     pw0[2]=PKW(P0,4), pw0[3]=PKW(P0,6), pw0); \
    VRD(1); SBAR(); GAPA(C0=__builtin_amdgcn_mfma_f32_32x32x16_bf16(kf[2],qr[1],C0,0,0,0),   P0[10],P0[11],P0[12],P0[13], pw1[0]=PKW(P0,8), pw1[1]=PKW(P0,10), pw1); \
    VRD(5); SBAR(); GAPA(C1=__builtin_amdgcn_mfma_f32_32x32x16_bf16(kf[3],qr[1],C1,0,0,0),   P0[14],P0[15],P1[0],P1[1],   pw1[2]=PKW(P0,12),pw1[3]=PKW(P0,14), pw1); \
    VRD(2); SBAR(); GAPA(C0=__builtin_amdgcn_mfma_f32_32x32x16_bf16(kf[4],qr[2],C0,0,0,0),   P1[2],P1[3],P1[4],P1[5],     pw2[0]=PKW(P1,0), pw2[1]=PKW(P1,2), pw2); \
    VRD(6); SBAR(); GAPA(C1=__builtin_amdgcn_mfma_f32_32x32x16_bf16(kf[5],qr[2],C1,0,0,0),   P1[6],P1[7],P1[8],P1[9],     pw2[2]=PKW(P1,4), pw2[3]=PKW(P1,6), pw2); \
    VRD(3); SBAR(); GAPA(C0=__builtin_amdgcn_mfma_f32_32x32x16_bf16(kf[6],qr[3],C0,0,0,0),   P1[10],P1[11],P1[12],P1[13], pw3[0]=PKW(P1,8), pw3[1]=PKW(P1,10), pw3); \
    VRD(7); SBAR(); GAPA(C1=__builtin_amdgcn_mfma_f32_32x32x16_bf16(kf[7],qr[3],C1,0,0,0),   P1[14],P1[15],0.f,0.f,       pw3[2]=PKW(P1,12),pw3[3]=PKW(P1,14), pw3); \
    l_reg+=sacc; \
    if(GK){DMA_K((t)+3,sl_cur);} if(GV){DMA_V((t)+1,sl_next);} \
    CMASK(C0,C1,t); \
    { float a=MX3(C0[0],C0[1],C1[0]),b=MX3(C0[2],C0[3],C1[1]); a=MX3(a,C1[2],C1[3]); \
      _Pragma("unroll") for(int r=4;r<16;r+=4){a=MX3(a,C0[r],C0[r+1]);b=MX3(b,C0[r+2],C0[r+3]);a=MX3(a,C1[r],C1[r+1]);b=MX3(b,C1[r+2],C1[r+3]);} \
      float rm=__builtin_fmaxf(a,b); { auto rr=__builtin_amdgcn_permlane32_swap(__float_as_uint(rm),__float_as_uint(rm),false,false); rm=__builtin_fmaxf(__uint_as_float(rr[0]),__uint_as_float(rr[1])); } \
      resc=false; \
      if(__builtin_expect(__any(rm>(float)THRL),0)){ const float dl=__builtin_fmaxf(rm,0.f); mhat+=dl; \
        _Pragma("unroll") for(int r=0;r<16;++r){C0[r]-=dl;C1[r]-=dl;} \
        _Pragma("unroll") for(int r=0;r<16;++r)negm[r]=-mhat; asm volatile("":"+v"(negm)); \
        const float f=__builtin_amdgcn_exp2f(-dl); l_reg*=f; if(hi==0)wsf[r32]=f; resc=true; } } \
    SBAR(); \
    GAPB(o[0]=__builtin_amdgcn_mfma_f32_32x32x16_bf16(PAF(0),VFR(0),o[0],0,0,0), C0,0); \
    GAPB(o[1]=__builtin_amdgcn_mfma_f32_32x32x16_bf16(PAF(0),VFR(4),o[1],0,0,0), C0,4); \
    KRD(GL,0); GAPB(o[0]=__builtin_amdgcn_mfma_f32_32x32x16_bf16(PAF(1),VFR(1),o[0],0,0,0), C0,8); \
    KRD(GL,1); GAPB(o[1]=__builtin_amdgcn_mfma_f32_32x32x16_bf16(PAF(1),VFR(5),o[1],0,0,0), C0,12); \
    KRD(GL,2); GAPB(o[0]=__builtin_amdgcn_mfma_f32_32x32x16_bf16(PAF(2),VFR(2),o[0],0,0,0), C1,0); \
    KRD(GL,3); GAPB(o[1]=__builtin_amdgcn_mfma_f32_32x32x16_bf16(PAF(2),VFR(6),o[1],0,0,0), C1,4); \
    GAPB(o[0]=__builtin_amdgcn_mfma_f32_32x32x16_bf16(PAF(3),VFR(3),o[0],0,0,0), C1,8); \
    GAPB(o[1]=__builtin_amdgcn_mfma_f32_32x32x16_bf16(PAF(3),VFR(7),o[1],0,0,0), C1,12); \
    }while(0)
  int t=1;
  for(;t+5<NT;t+=2){
    STEP(pB0,pB1,pA0,pA1,t,true,true,true);     WAIT_BAR(2); RESC(); ROT();
    STEP(pA0,pA1,pB0,pB1,t+1,true,true,true);   WAIT_BAR(2); RESC(); ROT();
  }
  #define ENDW(tt) do{ if((tt)+3<NT){WAIT_BAR(2);} else if((tt)+2<NT){WAIT_BAR(1);} else {WAIT_BAR(0);} }while(0)
  for(;t+1<NT;t+=2){
    STEP(pB0,pB1,pA0,pA1,t,(t+3<NT),(t+1<NT),(t+1<NT));       ENDW(t);   RESC(); ROT();
    STEP(pA0,pA1,pB0,pB1,t+1,(t+4<NT),(t+2<NT),(t+2<NT));     ENDW(t+1); RESC(); ROT();
  }
  STEP(pB0,pB1,pA0,pA1,NT-1,false,false,false); RESC();
  { float sacc=pB0[0]+pB0[1]; _Pragma("unroll") for(int r=2;r<16;++r)sacc+=pB0[r]; _Pragma("unroll") for(int r=0;r<16;++r)sacc+=pB1[r]; l_reg+=sacc;
    pw0=(u32x4){PKW(pB0,0),PKW(pB0,2),PKW(pB0,4),PKW(pB0,6)};pw1=(u32x4){PKW(pB0,8),PKW(pB0,10),PKW(pB0,12),PKW(pB0,14)};pw2=(u32x4){PKW(pB1,0),PKW(pB1,2),PKW(pB1,4),PKW(pB1,6)};pw3=(u32x4){PKW(pB1,8),PKW(pB1,10),PKW(pB1,12),PKW(pB1,14)};
    SBAR(); pv(o,vb0+sl_cur,PAF(0),PAF(1),PAF(2),PAF(3)); }
  #undef PKW
  #undef PAF
  #undef VFR
  #undef PIN
  #undef MX3
  #undef GAPA
  #undef GAPB
  #undef EX
  #undef VRD
  #undef KRD
  #undef STEP
  #undef ENDW
  {auto rr=__builtin_amdgcn_permlane32_swap(__float_as_uint(l_reg),__float_as_uint(l_reg),false,false);l_reg=__uint_as_float(rr[0])+__uint_as_float(rr[1]);}
  if(hi==0)wsf[32+r32]=l_reg;asm volatile("s_waitcnt lgkmcnt(0)":::"memory");
  float rli[16];
  #pragma unroll
  for(int r=0;r<16;++r)rli[r]=__builtin_amdgcn_rcpf(wsf[32+crow(r,hi)]);
  bf16*Ow=Ou+(long)(wid*QBLK)*OP;
  { bf16*stg=(bf16*)(shm+LDS_OST)+wid*2048;
    #pragma unroll
    for(int r=0;r<16;++r){const int orow=crow(r,hi);
      #pragma unroll
      for(int d0=0;d0<2;++d0)stg[orow*64+d0*32+r32]=__float2bfloat16(o[d0][r]*rli[r]);}
    asm volatile("s_waitcnt lgkmcnt(0)":::"memory");
    #pragma unroll
    for(int i=0;i<4;++i){const int row=i*8+(lane>>3),ch=lane&7; const u32x4 v=*(const u32x4*)(stg+row*64+ch*8); ATTN_STORE16(Ow+(long)row*OP+ch*8,v);} }
  asm volatile("s_waitcnt lgkmcnt(0)\n\ts_barrier":::"memory");
  #undef DMA_K
  #undef DMA_V
  #undef CMASK
  #undef START
  #undef RESC
  #undef ROT
}
constexpr int ATTN_LDS_BYTES=LDS_BYTES;
#undef SBAR
#undef WAIT_BAR
}


namespace hyf {
struct c32 { float x, y; };
typedef _Float16 h2 __attribute__((ext_vector_type(2)));
__device__ __forceinline__ c32 operator+(c32 a, c32 b) { return {a.x + b.x, a.y + b.y}; }
__device__ __forceinline__ c32 operator-(c32 a, c32 b) { return {a.x - b.x, a.y - b.y}; }
__device__ __forceinline__ c32 cmul(c32 a, c32 b) { return {a.x * b.x - a.y * b.y, a.x * b.y + a.y * b.x}; }
__device__ __forceinline__ constexpr float C32(int k) {
  switch (k) { case 0: return 1.f; case 1: return 0.98078528f; case 2: return 0.923879533f; case 3: return 0.831469612f; case 4: return 0.707106781f; case 5: return 0.555570233f; case 6: return 0.382683432f;
    case 7: return 0.195090322f; case 8: return 0.f; case 9: return -0.195090322f; case 10: return -0.382683432f; case 11: return -0.555570233f; case 12: return -0.707106781f; case 13: return -0.831469612f;
    case 14: return -0.923879533f; default: return -0.98078528f; } }
__device__ __forceinline__ constexpr float S32(int k) {
  switch (k) { case 0: return 0.f; case 1: return 0.195090322f; case 2: return 0.382683432f; case 3: return 0.555570233f; case 4: return 0.707106781f; case 5: return 0.831469612f; case 6: return 0.923879533f;
    case 7: return 0.98078528f; case 8: return 1.f; case 9: return 0.98078528f; case 10: return 0.923879533f; case 11: return 0.831469612f; case 12: return 0.707106781f; case 13: return 0.555570233f;
    case 14: return 0.382683432f; default: return 0.195090322f; } }
__device__ __forceinline__ constexpr int brev(int q, int bits) {
  return bits == 4 ? (((q & 1) << 3) | ((q & 2) << 1) | ((q & 4) >> 1) | ((q & 8) >> 3))
                   : (((q & 1) << 4) | ((q & 2) << 2) | (q & 4) | ((q & 8) >> 2) | ((q & 16) >> 4)); }
__device__ __forceinline__ int phys(int p) { return p + (p >> 5); }
template <int R, int HALF, bool INV> struct DftStage {
  static __device__ __forceinline__ void run(c32 (&x)[R]) {
#pragma unroll
    for (int blk = 0; blk < R; blk += 2 * HALF) {
#pragma unroll
      for (int j = 0; j < HALF; ++j) {
        const c32 a = x[blk + j], b = x[blk + j + HALF]; x[blk + j] = a + b; const c32 d = a - b;
        const int e = j * (R / (2 * HALF)) * (32 / R);
        if (e == 0) x[blk + j + HALF] = d;
        else if (e == 8) x[blk + j + HALF] = INV ? (c32){-d.y, d.x} : (c32){d.y, -d.x};
        else { const c32 wv = {C32(e), INV ? S32(e) : -S32(e)}; x[blk + j + HALF] = cmul(d, wv); }
      } }
    DftStage<R, HALF / 2, INV>::run(x);
  }
};
template <int R, bool INV> struct DftStage<R, 0, INV> { static __device__ __forceinline__ void run(c32 (&)[R]) {} };
template <int R, bool INV> __device__ __forceinline__ void dft_pow2(c32 (&x)[R]) { DftStage<R, R / 2, INV>::run(x); }
template <int R, int HALF> struct DitStage {
  static __device__ __forceinline__ void run(c32 (&x)[R]) {
#pragma unroll
    for (int blk = 0; blk < R; blk += 2 * HALF) {
#pragma unroll
      for (int j = 0; j < HALF; ++j) {
        const int e = j * (R / (2 * HALF)) * (32 / R);
        const c32 a = x[blk + j], b0 = x[blk + j + HALF];
        c32 b;
        if (e == 0) b = b0; else if (e == 8) b = (c32){-b0.y, b0.x}; else b = cmul(b0, (c32){C32(e), S32(e)});
        x[blk + j] = a + b; x[blk + j + HALF] = a - b;
      } }
    DitStage<R, HALF * 2>::run(x);
  }
};
template <int R> struct DitStage<R, R> { static __device__ __forceinline__ void run(c32 (&)[R]) {} };
template <int R> __device__ __forceinline__ void idft_dit(c32 (&x)[R]) { DitStage<R, 1>::run(x); }
template <int STRIDE, bool INV> __device__ __forceinline__ void pass16(c32* buf, int e0, float rev) {
  float rv = rev; asm volatile("" : "+v"(rv));
  const float cs = __builtin_amdgcn_cosf(rv), sn = __builtin_amdgcn_sinf(rv);
  const c32 w1 = {cs, INV ? sn : -sn};
  c32* p = buf + phys(e0); constexpr int PS = STRIDE + STRIDE / 32;
  c32 x[16];
  if (!INV) {
#pragma unroll
    for (int m = 0; m < 16; ++m) x[m] = p[PS * m];
    dft_pow2<16, false>(x);
    c32 w = w1; p[0] = x[0];
#pragma unroll
    for (int q = 1; q < 16; ++q) { p[PS * q] = cmul(x[brev(q, 4)], w); w = cmul(w, w1); }
  } else {
    c32 w = w1; x[0] = p[0];
#pragma unroll
    for (int q = 1; q < 16; ++q) { x[q] = cmul(p[PS * q], w); w = cmul(w, w1); }
    dft_pow2<16, true>(x);
#pragma unroll
    for (int m = 0; m < 16; ++m) p[PS * m] = x[brev(m, 4)];
  }
}
template <int MODE> __device__ __forceinline__ void mid32(c32* buf, h2* Hs, int j) {
  c32* p = buf + 33 * j; c32 x[32];
#pragma unroll
  for (int m = 0; m < 32; ++m) x[m] = p[m];
  dft_pow2<32, false>(x);
  if (MODE == 0) {
#pragma unroll
    for (int q = 0; q < 32; ++q) { const c32 v = x[brev(q, 5)]; Hs[q * 256 + j] = (h2){(_Float16)v.x, (_Float16)v.y}; }
  } else {
#pragma unroll
    for (int pp = 0; pp < 32; ++pp) { const h2 hv = Hs[brev(pp, 5) * 256 + j]; x[pp] = cmul(x[pp], (c32){(float)hv.x, (float)hv.y}); }
    idft_dit<32>(x);
#pragma unroll
    for (int m = 0; m < 32; ++m) p[m] = x[m];
  }
}
__device__ __forceinline__ void fwd2(c32* buf, int tid) {
  __syncthreads(); pass16<512, false>(buf, tid, (float)tid * (1.0f / 8192.0f));
  __syncthreads(); pass16<32, false>(buf, (tid >> 5) * 512 + (tid & 31), (float)(tid & 31) * (1.0f / 512.0f));
  __syncthreads();
}
__device__ __forceinline__ void conv(c32* buf, h2* Hs, int tid) {
  fwd2(buf, tid);
  if (tid < 256) mid32<1>(buf, Hs, tid);
  __syncthreads(); pass16<32, true>(buf, (tid >> 5) * 512 + (tid & 31), (float)(tid & 31) * (1.0f / 512.0f));
  __syncthreads(); pass16<512, true>(buf, tid, (float)tid * (1.0f / 8192.0f));
  __syncthreads();
}
__device__ __forceinline__ void item(int c, const bf16_t* HYT, const float* HK, const float* hy_bias, bf16_t* HYO, char* lds) {
  c32* buf = (c32*)lds; h2* H0 = (h2*)(lds + 67584); h2* H1 = H0 + 8192;
  const int tid = TIDX;
#pragma unroll 1
  for (int o = 0; o < 2; ++o) {
    const float* kp = HK + ((size_t)o * 256 + c) * 8192;
#pragma unroll
    for (int i = 0; i < 16; ++i) { const int n = tid + 512 * i; buf[phys(n)] = (c32){kp[n], 0.f}; }
    fwd2(buf, tid);
    if (tid < 256) mid32<0>(buf, o ? H1 : H0, tid);
    __syncthreads();
  }
  const float bias0 = hy_bias[c], bias1 = hy_bias[256 + c];
#pragma unroll 1
  for (int pr = 0; pr < 2; ++pr) {
    const bf16_t* v0 = HYT + ((size_t)(2 * pr) * 768 + c) * SEQ; const bf16_t* v1 = v0 + (size_t)768 * SEQ;
    c32 vv[8];
#pragma unroll
    for (int i = 0; i < 8; ++i) { const int t = tid + 512 * i; vv[i] = (c32){bf2f(v0[t]), bf2f(v1[t])}; buf[phys(t)] = vv[i]; buf[phys(t + 4096)] = (c32){0.f, 0.f}; }
    conv(buf, H0, tid);
#pragma unroll
    for (int i = 0; i < 8; ++i) { const int t = tid + 512 * i; const c32 y = buf[phys(t)];
      vv[i] = (c32){bf2f(v0[(size_t)256 * SEQ + t]) * (y.x * (1.0f / 8192.0f) + bias0 * vv[i].x), bf2f(v1[(size_t)256 * SEQ + t]) * (y.y * (1.0f / 8192.0f) + bias0 * vv[i].y)};
      buf[phys(t)] = vv[i]; buf[phys(t + 4096)] = (c32){0.f, 0.f}; }
    conv(buf, H1, tid);
#pragma unroll
    for (int i = 0; i < 8; ++i) { const int t = tid + 512 * i; const c32 y = buf[phys(t)];
      HYO[((size_t)(2 * pr) * 256 + c) * SEQ + t] = (bf16_t)f2bf(bf2f(v0[(size_t)512 * SEQ + t]) * (y.x * (1.0f / 8192.0f) + bias1 * vv[i].x));
      HYO[((size_t)(2 * pr + 1) * 256 + c) * SEQ + t] = (bf16_t)f2bf(bf2f(v1[(size_t)512 * SEQ + t]) * (y.y * (1.0f / 8192.0f) + bias1 * vv[i].y)); }
    __syncthreads();
  }
}
__device__ __forceinline__ void out_items4(int it0, int step, int nitems, const bf16_t* HYO, bf16_t* MIX, char* lds) {
  bf16_t (*T)[64][72] = (bf16_t (*)[64][72])lds;
  const int tid = TIDX;
  { const int cc = tid >> 3, t8 = (tid & 7) * 8; u32x4 v[4];
#pragma unroll
    for (int k = 0; k < 4; ++k) { const int it = it0 + k * step, itc = it < nitems ? it : it0, b = itc >> 8, t0 = ((itc >> 2) & 63) * 64, c0 = (itc & 3) * 64;
      v[k] = *(const u32x4*)(HYO + ((size_t)b * 256 + c0 + cc) * SEQ + t0 + t8); }
#pragma unroll
    for (int k = 0; k < 4; ++k) *(u32x4*)&T[k][cc][t8] = v[k]; }
  __syncthreads();
  { const int tl = tid >> 3, c8 = (tid & 7) * 8;
#pragma unroll
    for (int k = 0; k < 4; ++k) { const int it = it0 + k * step; const int b = it >> 8, t0 = ((it >> 2) & 63) * 64, c0 = (it & 3) * 64; u32x4 o;
      o.x = (unsigned)T[k][c8][tl] | ((unsigned)T[k][c8 + 1][tl] << 16); o.y = (unsigned)T[k][c8 + 2][tl] | ((unsigned)T[k][c8 + 3][tl] << 16);
      o.z = (unsigned)T[k][c8 + 4][tl] | ((unsigned)T[k][c8 + 5][tl] << 16); o.w = (unsigned)T[k][c8 + 6][tl] | ((unsigned)T[k][c8 + 7][tl] << 16);
      if (it < nitems) *(u32x4*)(MIX + ((size_t)b * TPB + CTXL + t0 + tl) * DM + 768 + c0 + c8) = o; } }
  __syncthreads();
}
}

#define LAS __attribute__((address_space(3)))
#define XB_TMO      128
#define XB_XCNT(j)  (256  + 64 * (j))
#define XB_XSUB(j)  (1280 + 64 * (j))
#define XB_XGEN(j)  (2304 + 64 * (j))
#define XB_TOP      3328
#define XB_TOPGEN   3392
#define XCD_BAR_WORDS 3456
#define XB_SPIN_CAP (1u << 18)

__device__ __forceinline__ unsigned xb_ld(unsigned* p)              { return __hip_atomic_load(p, __ATOMIC_RELAXED, __HIP_MEMORY_SCOPE_AGENT); }
__device__ __forceinline__ unsigned xb_add(unsigned* p, unsigned v) { return __hip_atomic_fetch_add(p, v, __ATOMIC_RELAXED, __HIP_MEMORY_SCOPE_AGENT); }
__device__ __forceinline__ unsigned xb_xcc_id() { return (unsigned)__builtin_amdgcn_s_getreg((3 << 11) | 20) & 0xFu; }
#define XB_SPIN(cond, bar) do { unsigned _sp = 0; while (cond) { __builtin_amdgcn_s_sleep(1); \
    if ((++_sp & 255u) == 0u) { if (xb_ld(&(bar)[XB_TMO])) break; if (_sp > XB_SPIN_CAP) { atomicAdd(&(bar)[XB_TMO], 1u); break; } } } } while (0)

struct XcdBarrier {
    unsigned* bar; unsigned x;
    volatile LAS unsigned* st;
};

__device__ __forceinline__ XcdBarrier xcd_barrier_post(unsigned* bar, volatile LAS unsigned* st) {
    XcdBarrier b; b.bar = bar; b.x = xb_xcc_id(); b.st = st;
    if (threadIdx.x == 0) (void)xb_add(&bar[XB_XCNT(b.x)], 1u);
    return b;
}
__device__ __forceinline__ void xcd_barrier_complete(unsigned* bar, unsigned x, unsigned& nloc, unsigned& nx) {
    const unsigned G = gridDim.x * gridDim.y * gridDim.z;
    unsigned sum, cnt, mine, sp = 0u;
    for (;;) {
        sum = 0u; cnt = 0u; mine = 0u;
#pragma unroll
        for (unsigned j = 0; j < 16; ++j) { const unsigned c = xb_ld(&bar[XB_XCNT(j)]); sum += c; cnt += (c > 0u) ? 1u : 0u; mine = (j == x) ? c : mine; }
        if (sum == G) break;
        __builtin_amdgcn_s_sleep(1);
        if ((++sp & 255u) == 0u) { if (xb_ld(&bar[XB_TMO])) break; if (sp > XB_SPIN_CAP) { atomicAdd(&bar[XB_TMO], 1u); break; } }
    }
    nloc = mine > 0u ? mine : 1u; nx = cnt > 0u ? cnt : 1u;
}

__device__ __forceinline__ void xcd_barrier(const XcdBarrier& b) {
    asm volatile("s_waitcnt vmcnt(0)" ::: "memory");
    __syncthreads();
    if (threadIdx.x == 0) {
        unsigned* bar = b.bar;
        __builtin_amdgcn_s_waitcnt(0);
        unsigned nloc = b.st[0], nx = b.st[1];
        if (nloc == 0u) { xcd_barrier_complete(bar, b.x, nloc, nx); b.st[0] = nloc; b.st[1] = nx; }
        const unsigned old = xb_add(&bar[XB_XSUB(b.x)], 1u);
        const unsigned gen = old / nloc;
        if (old + 1u == (gen + 1u) * nloc) {
            __builtin_amdgcn_fence(__ATOMIC_RELEASE, "agent");
            asm volatile("s_waitcnt vmcnt(0)" ::: "memory");
            const unsigned og = xb_add(&bar[XB_TOP], 1u);
            const unsigned tg = og / nx;
            if (og + 1u == (tg + 1u) * nx) xb_add(&bar[XB_TOPGEN], 1u);
            else XB_SPIN(xb_ld(&bar[XB_TOPGEN]) == tg, bar);
            __builtin_amdgcn_fence(__ATOMIC_ACQUIRE, "agent");
            xb_add(&bar[XB_XGEN(b.x)], 1u);
            asm volatile("s_waitcnt vmcnt(0)" ::: "memory");
        } else {
            XB_SPIN(xb_ld(&bar[XB_XGEN(b.x)]) == gen, bar);
            __builtin_amdgcn_fence(__ATOMIC_ACQUIRE, "agent");
            asm volatile("s_waitcnt vmcnt(0)" ::: "memory");
        }
    }
    __syncthreads();
}


struct MP { const float* in[33]; float* out; unsigned char* ws; };
typedef const float* const __attribute__((address_space(4))) * kargs_t;
#define KARGS() ({ kargs_t k_ = (kargs_t)__builtin_amdgcn_kernarg_segment_ptr(); asm volatile("" : "+s"(k_)); k_; })
#define WSP(K, off) ((unsigned char*)(K)[34] + (off))

__global__ void __launch_bounds__(NT, 2) mega(MP P) {
  cg::grid_group grid = cg::this_grid();
  extern __shared__ __attribute__((aligned(16))) char lds[];
  volatile LAS unsigned* xst = (volatile LAS unsigned*)(lds + LDS_BYTES - 16);
  if (threadIdx.x < 2) xst[threadIdx.x] = 0u;
  __syncthreads();
  { kargs_t K = KARGS(); (void)xcd_barrier_post((unsigned*)WSP(K, WS_CTL) + CT_BAR, xst); }
#define XBAR_HERE() do { kargs_t Kb_ = KARGS(); XcdBarrier xb_; xb_.bar = (unsigned*)WSP(Kb_, WS_CTL) + CT_BAR; xb_.x = xb_xcc_id(); xb_.st = (volatile LAS unsigned*)(lds + LDS_BYTES - 16); xcd_barrier(xb_); } while (0)
#define SEAM() XBAR_HERE()
  {
    kargs_t K = KARGS();
    st_adaln(K[1], K[3], K[4], K[5], (float*)WSP(K, WS_MODV), lds);
    st_rope((float*)WSP(K, WS_ROPE));
  }
  {
      kargs_t K = KARGS();
      st_weights(K[8], K[26], K[29], K[30], K[31], 0, (bf16_t*)WSP(K, WS_WIN), (bf16_t*)WSP(K, WS_WOUT), (bf16_t*)WSP(K, WS_WGU), (bf16_t*)WSP(K, WS_WD), lds);
    }
    { kargs_t K = KARGS(); const int bid = BIDX, G = GDIM;
      for (int it = bid; it < SEQ / 16; it += G) hyfilt_item<SEQ>(it, K[19] + 0 * 33 * 64, K[20] + 0 * 64, K[21] + 0 * 64, K[22] + 0 * 4096, K[23] + 0 * 64, K[24] + (size_t)0 * 65536, (float*)WSP(K, WS_HK), lds);
      if (true) for (int it = bid; it < CTXL / 16; it += G) hyfilt_item<CTXL>(it, K[19] + 0 * 33 * 64, K[20] + 0 * 64, K[21] + 0 * 64, K[22] + 0 * 4096, K[23] + 0 * 64, K[24] + (size_t)0 * 65536, (float*)WSP(K, WS_HKC), lds);
    }
  if (gridDim.x == 0x7fffffffu) grid.sync();
  XBAR_HERE();
#pragma nounroll
  for (int layer = 0; layer < 2; ++layer) {
    const bool last = layer == 1;
    if (layer == 1) {
    {
      kargs_t K = KARGS();
      st_weights(K[8], K[26], K[29], K[30], K[31], layer, (bf16_t*)WSP(K, WS_WIN), (bf16_t*)WSP(K, WS_WOUT), (bf16_t*)WSP(K, WS_WGU), (bf16_t*)WSP(K, WS_WD), lds);
    }
    { kargs_t K = KARGS(); const int bid = BIDX, G = GDIM;
      for (int it = bid; it < SEQ / 16; it += G) hyfilt_item<SEQ>(it, K[19] + layer * 33 * 64, K[20] + layer * 64, K[21] + layer * 64, K[22] + layer * 4096, K[23] + layer * 64, K[24] + (size_t)layer * 65536, (float*)WSP(K, WS_HK), lds);
      if (!last) for (int it = bid; it < CTXL / 16; it += G) hyfilt_item<CTXL>(it, K[19] + layer * 33 * 64, K[20] + layer * 64, K[21] + layer * 64, K[22] + layer * 4096, K[23] + layer * 64, K[24] + (size_t)layer * 65536, (float*)WSP(K, WS_HKC), lds);
    }
    }
    { kargs_t K = KARGS();
      st_normmod(K[0], K[2], (bf16_t*)WSP(K, WS_H), layer == 0 ? (const bf16_t*)nullptr : (const bf16_t*)WSP(K, WS_H2S), (const int*)WSP(K, WS_MOEM + 768 * 1024),
                 (const float*)WSP(K, WS_MODV) + 5120, K[6] + layer * 1024, (const float*)WSP(K, WS_MODV) + (size_t)layer * 5 * 6144, 0, 1024, (bf16_t*)K[33], lds);
    }
    SEAM();
    {
      kargs_t K = KARGS();
      pg8::Gemm g{1024, 1024, 1024}; SchedDense S{MTOK / 256, NPAD / 256, (int)GDIM, BIDX, 0, (const char*)K[33], (const char*)WSP(K, WS_WIN), (size_t)256 * 1024 * 2, (size_t)256 * 1024 * 2, 0};
      EpiInProj E{(bf16_t*)WSP(K, WS_QK), (bf16_t*)WSP(K, WS_VZ), (bf16_t*)WSP(K, WS_XBC), (bf16_t*)WSP(K, WS_HY), (float*)WSP(K, WS_DT)};
      pg8::gemm_phase<EpiInProj, SchedDense, true, true>((PG8_LAS unsigned char*)lds, g, S, E);
      if (IN_HALF) { S.part = 1; pg8::gemm_phase<EpiInProj, SchedDense, true, true, true>((PG8_LAS unsigned char*)lds, g, S, E); }
    }
    SEAM();
    {
      kargs_t K = KARGS();
      st_prep_qk((bf16_t*)WSP(K, WS_QK), K[9] + layer * 64, K[10] + layer * 64, (const float*)WSP(K, WS_ROPE));
    }
    { kargs_t K = KARGS();
      st_prep_hy((const bf16_t*)WSP(K, WS_HY), K[17] + layer * 3 * 768, K[18] + layer * 768, (bf16_t*)WSP(K, WS_HYT), last ? 0 : 1, lds);
    }
    { kargs_t K = KARGS();
      st_ssd1(BIDX, GDIM, 4 * 34 * 6, (const bf16_t*)WSP(K, WS_XBC), (const float*)WSP(K, WS_DT), K[11] + layer * 3 * 640, K[12] + layer * 640, K[13] + layer * 12, K[14] + layer * 12,
              (bf16_t*)WSP(K, WS_Y), (bf16_t*)WSP(K, WS_ST), (float*)WSP(K, WS_DEC), lds);
    }
    SEAM();
    {
      { kargs_t K2 = KARGS(); st_ssd_scan2((bf16_t*)WSP(K2, WS_ST), (const float*)WSP(K2, WS_DEC)); }
      const int bid = BIDX, G = GDIM;
#define P4_ATT(bb, hq, qrow_, nt_) do { kargs_t K = KARGS(); const int kvh_ = (hq) / 3; \
          const attn_body::bf16* QKp = (const attn_body::bf16*)WSP(K, WS_QK); const attn_body::bf16* VZp = (const attn_body::bf16*)WSP(K, WS_VZ); \
          attn_body::attn_unit<8>(QKp + (size_t)(qrow_) * 512 + (hq) * 64, QKp + (size_t)(bb) * TPB * 512 + 384 + kvh_ * 64, VZp + (size_t)(bb) * TPB * 512 + kvh_ * 64, \
                                  (attn_body::bf16*)K[33] + (size_t)(qrow_) * 1024 + (hq) * 64, (nt_), lds); } while (0)
#define P4_FFT(cch) do { kargs_t K = KARGS(); hyf::item((cch), (const bf16_t*)WSP(K, WS_HYT), (const float*)WSP(K, WS_HK), K[25] + layer * 512, (bf16_t*)WSP(K, WS_HY), lds); } while (0)
      {
        const int x = bid & 7, y = bid >> 3, bb = x >> 1, kvh = x & 1;
        const int nun = y < 16 ? 2 : 1, natt = nun + ((!last && y < 3) ? 1 : 0);
#pragma unroll 1
        for (int k = 0; k < natt; ++k) { int hq, qrow, nt;
          if (k < nun) { const int v = y < 16 ? y + 16 * k : 16 + y; hq = 3 * kvh + (v >> 4); qrow = bb * TPB + CTXL + (v & 15) * 256; nt = TPB / 64; }
          else { hq = 3 * kvh + y; qrow = bb * TPB; nt = CTXL / 64; }
          P4_ATT(bb, hq, qrow, nt); }
        if (y >= 16) {
#pragma unroll 1
          for (int k = 0; k < 2; ++k) { const int cch = ((y - 16) * 8 + x) * 2 + k; P4_FFT(cch); } }
      }
      (void)G;
#undef P4_ATT
#undef P4_FFT
    }
    SEAM();
    {
      kargs_t K = KARGS();
      { const int bid = BIDX, G = GDIM, nit = last ? 4 * 32 * 2 : 4 * 34 * 2;
        for (int it = bid; it < nit; it += G) { const int g = it & 1, bc = it >> 1; const int b = last ? bc >> 5 : bc / 34, cidx = last ? 2 + (bc & 31) : bc % 34;
          ssd3_item(b, cidx, g, (const bf16_t*)WSP(K, WS_XBC), (const bf16_t*)WSP(K, WS_VZ), (const float*)WSP(K, WS_DT), K[11] + layer * 3 * 640, K[12] + layer * 640, K[13] + layer * 12, K[14] + layer * 12,
                    K[15] + layer * 6, K[16] + layer * 384, (const bf16_t*)WSP(K, WS_Y), (const bf16_t*)WSP(K, WS_ST), (bf16_t*)K[33], lds); } }
      if (!last) { const int bid = BIDX, G = GDIM;
        for (int it = bid - 16; it >= 0 && it < 128; it += G) hyconv_ctx_item(it, (const bf16_t*)WSP(K, WS_HYT) + (size_t)4 * 768 * SEQ, (const float*)WSP(K, WS_HKC), K[25] + layer * 512, (bf16_t*)K[33], lds); }
      { const int bid = BIDX, G = GDIM; for (int it = bid; it < 1024; it += 4 * G) hyf::out_items4(it, G, 1024, (const bf16_t*)WSP(K, WS_HY), (bf16_t*)K[33], lds); }
      const int t = TIDX; if (BIDX == 0 && t < 256) ((int*)WSP(K, WS_CTL))[t] = 0;
      { int* stok = (int*)WSP(K, WS_MOEM + 384 * 1024); for (int i = BIDX * NT + t; i < MOE_ROWS; i += GDIM * NT) stok[i] = -1; }
    }
    SEAM();
    {
      kargs_t K = KARGS();
      pg8::Gemm g{1024, 1024, 1024}; SchedDense S{last ? 64 : 68, 4, (int)GDIM, BIDX, last ? 1 : 0, (const char*)K[33], (const char*)WSP(K, WS_WOUT), (size_t)256 * 1024 * 2, (size_t)256 * 1024 * 2, 0};
      EpiOutProj E{(bf16_t*)WSP(K, WS_QK)};
      pg8::gemm_phase<EpiOutProj, SchedDense, true, true>((PG8_LAS unsigned char*)lds, g, S, E);
      S.part = 1; pg8::gemm_phase<EpiOutProj, SchedDense, true, true, true>((PG8_LAS unsigned char*)lds, g, S, E);
    }
    SEAM();
    {
      kargs_t K = KARGS();
      st_router(K[0], K[2], layer == 0 ? 1 : 0, (bf16_t*)WSP(K, WS_H), (const bf16_t*)WSP(K, WS_QK), K[7] + layer * 1024, (const float*)WSP(K, WS_MODV) + (size_t)layer * 5 * 6144, K[27], K[28], (bf16_t*)K[33], (int*)WSP(K, WS_CTL),
                (int*)WSP(K, WS_MOEM), (float*)WSP(K, WS_MOEM + 128 * 1024), last ? 1 : 0, lds);
    }
    SEAM();
    { kargs_t K = KARGS();
      st_moe_gather((const bf16_t*)K[33], (bf16_t*)WSP(K, WS_H2S), (int*)WSP(K, WS_CTL), (const int*)WSP(K, WS_MOEM), (const float*)WSP(K, WS_MOEM + 128 * 1024),
                    (int*)WSP(K, WS_MOEM + 384 * 1024), (float*)WSP(K, WS_MOEM + 512 * 1024), (int*)WSP(K, WS_MOEM + 768 * 1024), last ? 1 : 0, lds);
    }
    SEAM();
    { kargs_t K = KARGS();
      pg8::Gemm g{1024, 1024, 1024}; SchedMoe S{(int)GDIM, BIDX, 1, (const int*)WSP(K, WS_CTL), (const char*)WSP(K, WS_H2S), (size_t)256 * 1024 * 2, (const char*)WSP(K, WS_WGU), 0};
      EpiMoe1 E{(bf16_t*)WSP(K, WS_ACT), (const float*)WSP(K, WS_MOEM + 512 * 1024)};
      pg8::gemm_phase<EpiMoe1, SchedMoe, true, true>((PG8_LAS unsigned char*)lds, g, S, E);
      S.tail = 1; pg8::gemm_phase<EpiMoe1, SchedMoe, true, true, true>((PG8_LAS unsigned char*)lds, g, S, E);
    }
    SEAM();
    { kargs_t K = KARGS();
      pg8::Gemm g{256, 512, 256}; SchedMoe S{(int)GDIM, BIDX, 2, (const int*)WSP(K, WS_CTL), (const char*)WSP(K, WS_ACT), (size_t)256 * 512 * 2, (const char*)WSP(K, WS_WD), 0};
      EpiMoe2 E{(bf16_t*)WSP(K, WS_H2S)};
      pg8::gemm_phase<EpiMoe2, SchedMoe, true, true>((PG8_LAS unsigned char*)lds, g, S, E);
      S.tail = 1; pg8::gemm_phase<EpiMoe2, SchedMoe, true, true, true>((PG8_LAS unsigned char*)lds, g, S, E);
    }
    SEAM();
  }
  { kargs_t K = KARGS(); st_final((float*)K[33], K[32], (const bf16_t*)WSP(K, WS_H), (const bf16_t*)WSP(K, WS_H2S), (const int*)WSP(K, WS_MOEM + 768 * 1024), (const float*)WSP(K, WS_MODV) + (size_t)5 * 6144 + 5120); }
}

extern "C" void kernel_launch(void* const* d_in, const int* in_sizes, int n_in, void* d_out, int out_size, void* d_ws, size_t ws_size, hipStream_t stream) {
  if (n_in != 33 || ws_size < WS_END) { fprintf(stderr, "kernel_launch: unexpected n_in %d / ws %zu\n", n_in, ws_size); return; }
  static int grid_blocks = 0;
  if (!grid_blocks) {
    int dev = 0, cus = 0, per_cu = 0;
    (void)hipGetDevice(&dev);
    (void)hipDeviceGetAttribute(&cus, hipDeviceAttributeMultiprocessorCount, dev);
    (void)hipFuncSetAttribute((const void*)mega, hipFuncAttributeMaxDynamicSharedMemorySize, LDS_BYTES);
    (void)hipOccupancyMaxActiveBlocksPerMultiprocessor(&per_cu, mega, NT, LDS_BYTES);
    if (per_cu < 1) per_cu = 1;
    if (per_cu > 2) per_cu = 2;
    grid_blocks = 256;
    if (cus != 256 || per_cu < 1) fprintf(stderr, "kernel_launch: expected 256 CUs with >= 1 workgroup each (got %d CUs, %d per CU)\n", cus, per_cu);
  }
  (void)hipMemsetAsync((char*)d_ws + WS_CTL + (size_t)CT_BAR * 4, 0, (size_t)XCD_BAR_WORDS * 4, stream);
  MP p{};
  for (int i = 0; i < 33; ++i) p.in[i] = (const float*)d_in[i];
  p.out = (float*)d_out; p.ws = (unsigned char*)d_ws;
  void* args[] = {&p};
  hipError_t e = hipLaunchCooperativeKernel((const void*)mega, dim3(grid_blocks), dim3(NT), args, LDS_BYTES, stream);
  if (e != hipSuccess) fprintf(stderr, "cooperative launch failed: %s (grid %d)\n", hipGetErrorString(e), grid_blocks);
}
```

```cpp
#include <hip/hip_runtime.h>
#include <hip/hip_cooperative_groups.h>
#include <cstdio>
#include <cstdint>
namespace cg = cooperative_groups;

typedef unsigned short bf16_t;
typedef short bf16x8 __attribute__((ext_vector_type(8)));
typedef float f32x4 __attribute__((ext_vector_type(4)));
typedef unsigned u32x4 __attribute__((ext_vector_type(4)));
typedef unsigned u32x2 __attribute__((ext_vector_type(2)));

constexpr int NB = 4, SEQ = 4096, CTXL = 256, DM = 1024, TPB = 4352, MTOK = NB * TPB;
constexpr int DIN = 2444, NPAD = 2560;
constexpr float EPS = 1e-6f;
constexpr float C2 = 0.125f * 1.4426950408889634f;
constexpr int MOE_ROWS = 23552;
constexpr int NT = 512;
constexpr int LDS_BYTES = 147456;

constexpr size_t MiB = 1u << 20;
constexpr size_t WS_CTL = 0;
constexpr size_t WS_MODV = 1 * MiB;
constexpr size_t WS_ROPE = 2 * MiB;
constexpr size_t WS_MOEM = 3 * MiB;
constexpr size_t WS_DT = 4 * MiB;
constexpr size_t WS_HKC = 5 * MiB;
constexpr size_t WS_XC = 6 * MiB;
constexpr size_t WS_WIN = 10 * MiB;
constexpr size_t WS_WOUT = 15 * MiB;
constexpr size_t WS_WGU = 17 * MiB;
constexpr size_t WS_WD = 33 * MiB;
constexpr size_t WS_HK = 41 * MiB;
constexpr size_t WS_H = 57 * MiB;
constexpr size_t WS_QK = 91 * MiB;
constexpr size_t WS_VZ = 108 * MiB;
constexpr size_t WS_XBC = 125 * MiB;
constexpr size_t WS_HY = WS_XBC + (size_t)MTOK * 768 * 2;
constexpr size_t WS_HYT = WS_HY + (size_t)MTOK * 768 * 2;
constexpr size_t WS_ST = WS_HYT + (size_t)MTOK * 768 * 2;
constexpr size_t WS_Y = WS_ST + (size_t)4 * 34 * 2 * 6 * 4096 * 4;
constexpr size_t WS_END = WS_Y + (size_t)MTOK * 384 * 4;
constexpr size_t WS_DEC = WS_DT + 900 * 1024;
constexpr size_t WS_H2S = WS_QK;
constexpr size_t WS_ACT = WS_H2S + (size_t)MOE_ROWS * 1024 * 2;
static_assert(WS_END <= 256 * MiB, "ws");
static_assert(WS_ACT + (size_t)MOE_ROWS * 512 * 2 <= WS_HYT, "moe alias");

constexpr int CT_CNT = 0, CT_FILL = 32, CT_BASE = 64, CT_NT = 96, CT_TP = 128;
constexpr int CT_BAR = 4096;
constexpr bool IN_HALF = false;
constexpr int CT_CNTB = 8192;

__device__ __forceinline__ int opq_v(int v) { asm volatile("" : "+v"(v)); return v; }
__device__ __forceinline__ int opq_s(int v) { asm volatile("" : "+s"(v)); return v; }
#define TIDX opq_v((int)threadIdx.x)
#define BIDX opq_s((int)blockIdx.x)
#define GDIM opq_s((int)gridDim.x)
__device__ __forceinline__ unsigned f2bf(float f) { unsigned u = __float_as_uint(f); return (u + 0x7fffu + ((u >> 16) & 1u)) >> 16; }
__device__ __forceinline__ unsigned pk2bf(float lo, float hi) { return f2bf(lo) | (f2bf(hi) << 16); }
__device__ __forceinline__ float bf2f(bf16_t h) { return __uint_as_float(((unsigned)h) << 16); }
__device__ __forceinline__ float wave_sum(float v) {
#pragma unroll
  for (int o = 1; o < 64; o <<= 1) v += __shfl_xor(v, o);
  return v;
}
__device__ __forceinline__ float siluf(float v) { return v / (1.0f + __expf(-v)); }
__device__ __forceinline__ float* xrow(const float* xl, const float* xc, int r) {
  const int b = r / TPB, j = r - b * TPB;
  return (float*)(j < CTXL ? xc + ((size_t)b * CTXL + j) * DM : xl + ((size_t)b * SEQ + (j - CTXL)) * DM);
}
__device__ __forceinline__ int mrow_of(int r) { const int b = r / TPB, j = r - b * TPB; return j < CTXL ? 4 : b; }

__device__ __forceinline__ void st_adaln(const float* c, const float* c_ctx, const float* w_mod, const float* b_mod, float* modv, char* lds) {
  float (*sc)[1024] = (float (*)[1024])lds;
  float (*red)[5][64] = (float (*)[5][64])(lds + 5 * 1024 * 4);
  const int tid = TIDX;
  for (int it = BIDX; it < 192; it += GDIM) {
    const int layer = it / 96, n0 = (it % 96) * 64;
#pragma unroll
    for (int i = tid; i < 5 * 1024; i += NT) { const int r = i >> 10, k = i & 1023; const float v = r < 4 ? c[r * 1024 + k] : c_ctx[k]; sc[r][k] = v / (1.0f + __expf(-v)); }
    __syncthreads();
    const int kg = tid >> 6, n = tid & 63;
    float acc[5] = {0.f, 0.f, 0.f, 0.f, 0.f};
#pragma unroll 16
    for (int k = kg; k < 1024; k += 8) { const float w = w_mod[((size_t)layer * 1024 + k) * 6144 + n0 + n];
#pragma unroll
      for (int r = 0; r < 5; ++r) acc[r] += sc[r][k] * w; }
#pragma unroll
    for (int r = 0; r < 5; ++r) red[kg][r][n] = acc[r];
    __syncthreads();
    if (tid < 320) { const int r = tid >> 6, nn = tid & 63; float s = 0.f;
#pragma unroll
      for (int g = 0; g < 8; ++g) s += red[g][r][nn];
      modv[((size_t)layer * 5 + r) * 6144 + n0 + nn] = s + b_mod[layer * 6144 + n0 + nn]; }
    __syncthreads();
  }
}
__device__ __forceinline__ void st_rope(float* rope) {
  for (int i = BIDX * NT + TIDX; i < 4096 * 32; i += GDIM * NT) {
    const int t = i >> 5, d = i & 31, m = d & 15;
    const float inv = exp2f(-(float)(2 * m) * (13.287712379549449f / 32.0f));
    const float pos = (float)(d < 16 ? (t >> 6) : (t & 63));
    float rev = pos * inv * 0.15915494309189535f; rev -= floorf(rev);
    rope[2 * i] = __builtin_amdgcn_cosf(rev); rope[2 * i + 1] = __builtin_amdgcn_sinf(rev);
  }
}

__device__ __forceinline__ void st_normmod(const float* xl, const float* xc, bf16_t* XB, const bf16_t* YS, const int* tok_slot, const float* gate_prev,
                                           const float* g, const float* modv_layer, int off_sh, int off_sc, bf16_t* H, char* lds) {
  float* mA = (float*)lds; float* mB = mA + 5 * 1024; float* mG = mB + 5 * 1024;
  const int tid = TIDX, lane = tid & 63, gw = BIDX * 8 + (tid >> 6), ngw = GDIM * 8;
  { f32x4 g4[3], sc4[3], sh4[3], gp4[3];
#pragma unroll
    for (int i = 0; i < 3; ++i) { const int q = tid + NT * i, qc = q < 1280 ? q : 0, m = qc >> 8, k = (qc & 255) * 4;
      g4[i] = *(const f32x4*)(g + k); sc4[i] = *(const f32x4*)(modv_layer + (size_t)m * 6144 + off_sc + k); sh4[i] = *(const f32x4*)(modv_layer + (size_t)m * 6144 + off_sh + k);
      gp4[i] = YS ? *(const f32x4*)(gate_prev + (size_t)m * 6144 + k) : (f32x4){0.f, 0.f, 0.f, 0.f}; }
#pragma unroll
    for (int i = 0; i < 3; ++i) { const int q = tid + NT * i;
      if (q < 1280) { *(f32x4*)(mA + 4 * q) = g4[i] * ((f32x4){1.f, 1.f, 1.f, 1.f} + sc4[i]); *(f32x4*)(mB + 4 * q) = sh4[i]; *(f32x4*)(mG + 4 * q) = gp4[i]; } } }
  __syncthreads();
  for (int rb = gw; rb < MTOK; rb += 3 * ngw) {
    f32x4 v[3][4]; float rstd[3];
    if (!YS) {
#pragma unroll
      for (int u = 0; u < 3; ++u) { const int r = rb + u * ngw, rc = r < MTOK ? r : MTOK - 1; const float* xr = xrow(xl, xc, rc);
#pragma unroll
        for (int j = 0; j < 4; ++j) v[u][j] = *(const f32x4*)(xr + 4 * lane + 256 * j); }
    } else {
      u32x2 xb[3][4], ys[3][4];
#pragma unroll
      for (int u = 0; u < 3; ++u) { const int r = rb + u * ngw, rc = r < MTOK ? r : MTOK - 1; const bf16_t* xr = XB + (size_t)rc * DM; const bf16_t* yr = YS + (size_t)tok_slot[rc] * DM;
#pragma unroll
        for (int j = 0; j < 4; ++j) { xb[u][j] = *(const u32x2*)(xr + 4 * lane + 256 * j); ys[u][j] = *(const u32x2*)(yr + 4 * lane + 256 * j); } }
#pragma unroll
      for (int u = 0; u < 3; ++u) { const int r = rb + u * ngw, rc = r < MTOK ? r : MTOK - 1; const int mo = mrow_of(rc) * 1024;
#pragma unroll
        for (int j = 0; j < 4; ++j) { const int k = 4 * lane + 256 * j; const f32x4 g4 = *(const f32x4*)(mG + mo + k);
          const f32x4 x4 = (f32x4){__uint_as_float(xb[u][j].x << 16), __uint_as_float(xb[u][j].x & 0xffff0000u), __uint_as_float(xb[u][j].y << 16), __uint_as_float(xb[u][j].y & 0xffff0000u)};
          const f32x4 m4 = (f32x4){__uint_as_float(ys[u][j].x << 16), __uint_as_float(ys[u][j].x & 0xffff0000u), __uint_as_float(ys[u][j].y << 16), __uint_as_float(ys[u][j].y & 0xffff0000u)};
          v[u][j] = x4 + g4 * m4;
          if (r < MTOK) { u32x2 w; w.x = pk2bf(v[u][j].x, v[u][j].y); w.y = pk2bf(v[u][j].z, v[u][j].w); *(u32x2*)(XB + (size_t)r * DM + k) = w; } } }
    }
#pragma unroll
    for (int u = 0; u < 3; ++u) { float ss = 0.f;
#pragma unroll
      for (int j = 0; j < 4; ++j) ss += v[u][j].x * v[u][j].x + v[u][j].y * v[u][j].y + v[u][j].z * v[u][j].z + v[u][j].w * v[u][j].w;
      rstd[u] = rsqrtf(wave_sum(ss) * (1.0f / DM) + EPS); }
#pragma unroll
    for (int u = 0; u < 3; ++u) { const int r = rb + u * ngw;
      if (r < MTOK) { const int mo = mrow_of(r) * 1024;
#pragma unroll
        for (int j = 0; j < 4; ++j) { const int k = 4 * lane + 256 * j;
          const f32x4 a4 = *(const f32x4*)(mA + mo + k), b4 = *(const f32x4*)(mB + mo + k); const f32x4 o = v[u][j] * rstd[u] * a4 + b4;
          u32x2 w; w.x = pk2bf(o.x, o.y); w.y = pk2bf(o.z, o.w);
          *(u32x2*)(H + (size_t)r * DM + k) = w; } } }
  }
  __syncthreads();
}

template <int MODE> __device__ __forceinline__ void tr_wave_item(const float* src, const float* src2, int ldsrc, int K, bf16_t* out, int n0, int k0, float* scr, int lane) {
  const int nn = lane & 31, n = n0 + nn;
  float v[32];
  { const int col = MODE == 0 ? (n < 1676 ? n : (n < 1792 ? -1 : n - 116)) : (MODE == 1 ? n : (n >> 1)); const float* sp = (MODE == 2 && (n & 1)) ? src2 : src;
    const float* p0 = sp + (size_t)(k0 + (lane >> 5)) * ldsrc + (col >= 0 ? col : 0);
#pragma unroll
    for (int i = 0; i < 32; ++i) v[i] = p0[(size_t)(2 * i) * ldsrc];
#pragma unroll
    for (int i = 0; i < 32; ++i) scr[(2 * i + (lane >> 5)) * 33 + nn] = col >= 0 ? v[i] : 0.f; }
  asm volatile("s_waitcnt lgkmcnt(0)" ::: "memory");
  const int c = lane & 7;
#pragma unroll
  for (int j = 0; j < 4; ++j) { const int nr = (lane >> 3) + 8 * j; const float* sp = scr + (8 * c) * 33 + nr;
    u32x4 o; o.x = f2bf(sp[0]) | (f2bf(sp[33]) << 16); o.y = f2bf(sp[66]) | (f2bf(sp[99]) << 16); o.z = f2bf(sp[132]) | (f2bf(sp[165]) << 16); o.w = f2bf(sp[198]) | (f2bf(sp[231]) << 16);
    *(u32x4*)(out + (size_t)(n0 + nr) * K + k0 + 8 * c) = o; }
  asm volatile("s_waitcnt lgkmcnt(0)" ::: "memory");
}
__device__ __forceinline__ void st_weights(const float* w_in, const float* w_out, const float* w_gate, const float* w_up, const float* w_down, int layer,
                                           bf16_t* WIN, bf16_t* WOUT, bf16_t* WGU, bf16_t* WD, char* lds) {
  const int tid = TIDX, lane = tid & 63, w = tid >> 6; float* scr = (float*)lds + w * (64 * 33);
  for (int it = BIDX * 8 + w; it < 7936; it += GDIM * 8) {
    if (it < 1280) tr_wave_item<0>(w_in + (size_t)layer * 1024 * DIN, nullptr, DIN, 1024, WIN, (it % 80) * 32, (it / 80) * 64, scr, lane);
    else if (it < 1792) { const int i2 = it - 1280; tr_wave_item<1>(w_out + (size_t)layer * 1024 * 1024, nullptr, 1024, 1024, WOUT, (i2 & 31) * 32, (i2 >> 5) * 64, scr, lane); }
    else if (it < 5888) { const int i2 = it - 1792, e = i2 >> 8, t = i2 & 255;
      tr_wave_item<2>(w_gate + ((size_t)layer * 16 + e) * 1024 * 256, w_up + ((size_t)layer * 16 + e) * 1024 * 256, 256, 1024, WGU + (size_t)e * 512 * 1024, (t & 15) * 32, (t >> 4) * 64, scr, lane); }
    else { const int i2 = it - 5888, e = i2 >> 7, t = i2 & 127;
      tr_wave_item<1>(w_down + ((size_t)layer * 16 + e) * 256 * 1024, nullptr, 1024, 256, WD + (size_t)e * 1024 * 256, (t & 31) * 32, (t >> 5) * 64, scr, lane); }
  }
  __syncthreads();
}

__device__ __forceinline__ void pair_experts(int pidx, int& eA, int& eB) {
  const int g = pidx / 6, t = pidx - 6 * g; const int i = t < 3 ? 0 : (t < 5 ? 1 : 2); const int j = t < 3 ? t + 1 : (t < 5 ? t - 1 : 3);
  eA = 4 * g + i; eB = 4 * g + j;
}
__device__ __forceinline__ void st_prep_qk(bf16_t* QK, const float* qn, const float* kn, const float* rope) {
  const int lane = TIDX & 63, gw = BIDX * 8 + (TIDX >> 6), ngw = GDIM * 8, hh = lane >> 3, sub = lane & 7;
  float gn[8];
#pragma unroll
  for (int e = 0; e < 8; ++e) gn[e] = ((hh < 6 ? qn : kn) + sub * 8)[e] * (hh < 6 ? C2 : 1.0f);
  for (int rb = gw; rb < MTOK; rb += 3 * ngw) {
    bf16x8 raw[3]; f32x4 rp4[3][4];
#pragma unroll
    for (int u = 0; u < 3; ++u) { const int r = rb + u * ngw < MTOK ? rb + u * ngw : MTOK - 1; const int j = r % TPB, t = j >= CTXL ? j - CTXL : 0;
      raw[u] = *(const bf16x8*)(QK + (size_t)r * 512 + hh * 64 + sub * 8);
      const float* rp = rope + ((size_t)t * 32 + (sub & 3) * 8) * 2;
#pragma unroll
      for (int q = 0; q < 4; ++q) rp4[u][q] = *(const f32x4*)(rp + 4 * q); }
#pragma unroll
    for (int u = 0; u < 3; ++u) { const int r = rb + u * ngw; const int j = (r < MTOK ? r : MTOK - 1) % TPB;
      float v[8]; float ss = 0.f;
#pragma unroll
      for (int e = 0; e < 8; ++e) { v[e] = bf2f((bf16_t)raw[u][e]); ss += v[e] * v[e]; }
      ss += __shfl_xor(ss, 1); ss += __shfl_xor(ss, 2); ss += __shfl_xor(ss, 4);
      const float rstd = rsqrtf(ss * (1.0f / 64.0f) + EPS);
#pragma unroll
      for (int e = 0; e < 8; ++e) v[e] = v[e] * rstd * gn[e];
      if (j >= CTXL) {
#pragma unroll
        for (int e = 0; e < 8; ++e) { const float other = __shfl_xor(v[e], 4); const float cs = rp4[u][e >> 1][(e & 1) * 2], sn = rp4[u][e >> 1][(e & 1) * 2 + 1]; v[e] = sub < 4 ? v[e] * cs - other * sn : v[e] * cs + other * sn; } }
      if (r < MTOK) *(u32x4*)(QK + (size_t)r * 512 + hh * 64 + sub * 8) = (u32x4){pk2bf(v[0], v[1]), pk2bf(v[2], v[3]), pk2bf(v[4], v[5]), pk2bf(v[6], v[7])}; }
  }
}

__device__ __forceinline__ void st_prep_hy(const bf16_t* HY, const float* cw, const float* cb, bf16_t* HYT, int do_ctx, char* lds) {
  const int tid = TIDX, lane = tid & 63, w = tid >> 6; float* tile = (float*)lds + w * (66 * 33);
  const int nlat = 4 * 64 * 24, nitem = nlat + (do_ctx ? 4 * 4 * 24 : 0), step = (GDIM - 48) * 8;
  bf16x8 raw[5];
#define PHY_DECODE(it) int b, tt, ct, L, joff; bf16_t* outb; \
    if ((it) < nlat) { b = (it) / 1536; tt = ((it) % 1536) / 24; ct = (it) % 24; L = SEQ; joff = CTXL; outb = HYT + (size_t)b * 768 * SEQ; } \
    else { const int i2 = (it) - nlat; b = i2 / 96; tt = (i2 % 96) / 24; ct = i2 % 24; L = CTXL; joff = 0; outb = HYT + (size_t)4 * 768 * SEQ + (size_t)b * 768 * CTXL; } \
    const int t0 = tt * 64, c0 = ct * 32; (void)outb;
#define PHY_LOADS(it) do { PHY_DECODE(it) _Pragma("unroll") for (int i = 0; i < 5; ++i) { const int rr = (lane >> 2) + 16 * i, c8 = (lane & 3) * 8; int t = t0 - 1 + rr; const bool ok = rr < 66 && t >= 0 && t < L; t = ok ? t : t0; \
      const bf16x8 v = *(const bf16x8*)(HY + ((size_t)b * TPB + joff + t) * 768 + c0 + c8); raw[i] = ok ? v : (bf16x8){0, 0, 0, 0, 0, 0, 0, 0}; } \
    { const int c = c0 + (lane & 31); wq[0] = cw[c]; wq[1] = cw[768 + c]; wq[2] = cw[1536 + c]; wq[3] = cb[c]; } } while (0)
  float wq[4];
  int it = BIDX >= 48 ? (BIDX - 48) * 8 + w : nitem;
  if (it < nitem) PHY_LOADS(it);
  for (; it < nitem; it += step) {
    PHY_DECODE(it)
#pragma unroll
    for (int i = 0; i < 5; ++i) { const int rr = (lane >> 2) + 16 * i, c8 = (lane & 3) * 8;
      if (rr < 66) {
#pragma unroll
        for (int e = 0; e < 8; ++e) tile[rr * 33 + c8 + e] = bf2f((bf16_t)raw[i][e]); } }
    asm volatile("s_waitcnt lgkmcnt(0)" ::: "memory");
    const float wc0 = wq[0], wc1 = wq[1], wc2 = wq[2], wc3 = wq[3];
    if (it + step < nitem) PHY_LOADS(it + step);
#pragma unroll
    for (int cc = 0; cc < 32; ++cc) { const int c = c0 + cc;
      const float k0 = __int_as_float(__builtin_amdgcn_readlane(__float_as_int(wc0), cc)), k1 = __int_as_float(__builtin_amdgcn_readlane(__float_as_int(wc1), cc));
      const float k2 = __int_as_float(__builtin_amdgcn_readlane(__float_as_int(wc2), cc)), kb = __int_as_float(__builtin_amdgcn_readlane(__float_as_int(wc3), cc));
      const float v = k0 * tile[lane * 33 + cc] + k1 * tile[(lane + 1) * 33 + cc] + k2 * tile[(lane + 2) * 33 + cc] + kb;
      outb[(size_t)c * L + t0 + lane] = (bf16_t)f2bf(v); }
    asm volatile("s_waitcnt lgkmcnt(0)" ::: "memory");
  }
#undef PHY_LOADS
#undef PHY_DECODE
  __syncthreads();
}

template <int L> __device__ __forceinline__ void hyfilt_item(int item, const float* w1, const float* b1, const float* fr, const float* w2, const float* b2, const float* w3, float* HK, char* lds) {
  float* F = (float*)lds; float* W1 = F + 64 * 37; float* H1 = W1 + 36 * 68; float* W2 = H1 + 64 * 68; float* S1 = W2 + 64 * 68;
  const int tid = TIDX, n0 = (item >> 2) * 64, cq = item & 3, lane = tid & 63, wv = tid >> 6, l15 = lane & 15, l4 = lane >> 4;
  for (int e = tid; e < 64 * 36; e += NT) { const int pp = e / 36, f = e % 36; const int n = n0 + pp; float v = 0.f;
    if (f == 0) v = (float)n / (float)(L - 1);
    else if (f < 33) { const int m = (f - 1) & 15; const float band = 1e-4f + (float)m * ((15.0f - 1e-4f) / 15.0f); float rev = ((float)n * (1.0f / (float)L)) * band; rev -= floorf(rev);
      v = f <= 16 ? __builtin_amdgcn_cosf(rev) : -__builtin_amdgcn_sinf(rev); }
    F[pp * 37 + f] = v; }
#pragma unroll
  for (int e = tid; e < 36 * 64; e += NT) { const int k = e >> 6, j = e & 63; W1[k * 68 + j] = k < 33 ? w1[k * 64 + j] : 0.f; }
#pragma unroll
  for (int e = tid; e < 64 * 64; e += NT) { const int k = e >> 6, j = e & 63; W2[k * 68 + j] = w2[e]; }
  __syncthreads();
  { const int pt = wv >> 1, c0 = 32 * (wv & 1);
    f32x4 acc[2] = {(f32x4){0.f, 0.f, 0.f, 0.f}, (f32x4){0.f, 0.f, 0.f, 0.f}};
#pragma unroll
    for (int kk = 0; kk < 9; ++kk) { const float av = F[(pt * 16 + l15) * 37 + 4 * kk + l4];
      acc[0] = __builtin_amdgcn_mfma_f32_16x16x4f32(av, W1[(4 * kk + l4) * 68 + c0 + l15], acc[0], 0, 0, 0);
      acc[1] = __builtin_amdgcn_mfma_f32_16x16x4f32(av, W1[(4 * kk + l4) * 68 + c0 + 16 + l15], acc[1], 0, 0, 0); }
#pragma unroll
    for (int ct = 0; ct < 2; ++ct) { const int j = c0 + 16 * ct + l15; const float bj = b1[j], fj = fr[j] * 0.15915494309189535f;
#pragma unroll
      for (int rg = 0; rg < 4; ++rg) { float rev = fj * (acc[ct][rg] + bj); rev -= floorf(rev); H1[(pt * 16 + 4 * l4 + rg) * 68 + j] = __builtin_amdgcn_sinf(rev); } } }
  __syncthreads();
  { const int pt = wv >> 1, c0 = 32 * (wv & 1);
    f32x4 acc[2] = {(f32x4){0.f, 0.f, 0.f, 0.f}, (f32x4){0.f, 0.f, 0.f, 0.f}};
#pragma unroll
    for (int kk = 0; kk < 16; ++kk) { const float av = H1[(pt * 16 + l15) * 68 + 4 * kk + l4];
      acc[0] = __builtin_amdgcn_mfma_f32_16x16x4f32(av, W2[(4 * kk + l4) * 68 + c0 + l15], acc[0], 0, 0, 0);
      acc[1] = __builtin_amdgcn_mfma_f32_16x16x4f32(av, W2[(4 * kk + l4) * 68 + c0 + 16 + l15], acc[1], 0, 0, 0); }
#pragma unroll
    for (int ct = 0; ct < 2; ++ct) { const int j = c0 + 16 * ct + l15; const float bj = b2[j], fj = fr[j] * 0.15915494309189535f;
#pragma unroll
      for (int rg = 0; rg < 4; ++rg) { float rev = fj * (acc[ct][rg] + bj); rev -= floorf(rev); S1[(pt * 16 + 4 * l4 + rg) * 68 + j] = __builtin_amdgcn_sinf(rev); } } }
  __syncthreads();
  {
    const int colb = cq * 256 + 32 * wv;
    f32x4 acc[4][2];
#pragma unroll
    for (int pt = 0; pt < 4; ++pt) { acc[pt][0] = (f32x4){0.f, 0.f, 0.f, 0.f}; acc[pt][1] = (f32x4){0.f, 0.f, 0.f, 0.f}; }
#pragma unroll
    for (int kk = 0; kk < 16; ++kk) { const int k = 4 * kk + l4;
      const float bv0 = w3[k * 1024 + colb + l15], bv1 = w3[k * 1024 + colb + 16 + l15];
#pragma unroll
      for (int pt = 0; pt < 4; ++pt) { const float av = S1[(pt * 16 + l15) * 68 + k];
        acc[pt][0] = __builtin_amdgcn_mfma_f32_16x16x4f32(av, bv0, acc[pt][0], 0, 0, 0);
        acc[pt][1] = __builtin_amdgcn_mfma_f32_16x16x4f32(av, bv1, acc[pt][1], 0, 0, 0); } }
#pragma unroll
    for (int ct = 0; ct < 2; ++ct) { const int col = colb + 16 * ct + l15, dir = col >> 9, order = (col >> 8) & 1, c = col & 255;
      const float delta = 3.0701134573253943f + (float)c * ((15.350567286626972f - 3.0701134573253943f) / 255.0f);
      float* dst = HK + ((size_t)order * 256 + c) * (2 * L);
#pragma unroll
      for (int pt = 0; pt < 4; ++pt) { const int nb = n0 + pt * 16 + 4 * l4; f32x4 o;
#pragma unroll
        for (int rg = 0; rg < 4; ++rg) o[rg] = acc[pt][ct][rg] * __expf(-((float)(nb + rg) / (float)(L - 1)) * delta);
        if (dir == 0) *(f32x4*)(dst + nb) = o;
        else {
#pragma unroll
          for (int rg = 0; rg < 4; ++rg) { const int n = nb + rg; if (n >= 1) dst[2 * L - n] = o[rg]; else dst[L] = 0.f; } } } }
  }
  __syncthreads();
}

__device__ __forceinline__ void hyconv_ctx_item(int item, const bf16_t* HYTC, const float* HKC, const float* hy_bias, bf16_t* MIX, char* lds) {
  constexpr int L = CTXL;
  const int tid = TIDX, b = item >> 5, cc = tid >> 6, c = (item & 31) * 8 + cc, sub = tid & 63, tb = 4 * sub;
  float* kern = (float*)lds + cc * (2 * L); float* z = (float*)lds + 8 * 2 * L + cc * L; bf16_t* ob = (bf16_t*)((float*)lds + 8 * 2 * L + 8 * L);
  const bf16_t* vp = HYTC + ((size_t)b * 768 + c) * L;
  const u32x2 x1r = *(const u32x2*)(vp + (size_t)256 * L + tb), x2r = *(const u32x2*)(vp + (size_t)512 * L + tb);
  { float zr[4];
#pragma unroll
    for (int i = 0; i < 4; ++i) zr[i] = bf2f(vp[sub + 64 * i]);
#pragma unroll
    for (int i = 0; i < 4; ++i) z[sub + 64 * i] = zr[i]; }
#pragma unroll 1
  for (int o = 0; o < 2; ++o) {
    const float* kp = HKC + ((size_t)o * 256 + c) * (2 * L);
    { float kr[8];
#pragma unroll
      for (int i = 0; i < 8; ++i) kr[i] = kp[sub + 64 * i];
#pragma unroll
      for (int i = 0; i < 8; ++i) kern[sub + 64 * i] = kr[i]; }
    const float bias = hy_bias[o * 256 + c];
    __syncthreads();
    float acc[4], W[12];
#pragma unroll
    for (int i = 0; i < 4; ++i) { acc[i] = 0.f; W[8 + i] = kern[tb + i]; }
    for (int s0 = 0; s0 < L; s0 += 8) {
      const int bb = (tb - s0 - 8) & (2 * L - 1), bb2 = (bb + 4) & (2 * L - 1);
#pragma unroll
      for (int i = 0; i < 4; ++i) { W[i] = kern[bb + i]; W[4 + i] = kern[bb2 + i]; }
      float zs[8];
#pragma unroll
      for (int j = 0; j < 8; ++j) zs[j] = z[s0 + j];
#pragma unroll
      for (int j = 0; j < 8; ++j)
#pragma unroll
        for (int i = 0; i < 4; ++i) acc[i] += W[8 + i - j] * zs[j];
#pragma unroll
      for (int i = 0; i < 4; ++i) W[8 + i] = W[i];
    }
    __syncthreads();
#pragma unroll
    for (int i = 0; i < 4; ++i) { const int t = tb + i; const float zz = acc[i] + bias * z[t]; const unsigned xw = o == 0 ? (i < 2 ? x1r.x : x1r.y) : (i < 2 ? x2r.x : x2r.y);
      const float xv = (i & 1) ? __uint_as_float(xw & 0xffff0000u) : __uint_as_float(xw << 16);
      if (o == 0) z[t] = xv * zz; else ob[t * 8 + cc] = (bf16_t)f2bf(xv * zz); }
    __syncthreads();
  }
  if (tid < L) *(u32x4*)(MIX + ((size_t)b * TPB + tid) * DM + 768 + (item & 31) * 8) = *(const u32x4*)(ob + tid * 8);
  __syncthreads();
}

__device__ __forceinline__ void ssd_conv8(const bf16_t* XBC, size_t r, int c0, bool hasp, bool hasn, const float* cw, const float* cb, float (&o)[8]) {
  const bf16x8 cur = *(const bf16x8*)(XBC + r * 768 + c0);
  const bf16x8 prv = *(const bf16x8*)(XBC + (hasp ? r - 1 : r) * 768 + c0), nxt = *(const bf16x8*)(XBC + (hasn ? r + 1 : r) * 768 + c0);
  const float wp = hasp ? 1.f : 0.f, wn = hasn ? 1.f : 0.f;
#pragma unroll
  for (int e = 0; e < 8; ++e) { const float v = wp * cw[c0 + e] * bf2f((bf16_t)prv[e]) + cw[640 + c0 + e] * bf2f((bf16_t)cur[e]) + wn * cw[1280 + c0 + e] * bf2f((bf16_t)nxt[e]) + cb[c0 + e]; o[e] = siluf(v); }
}
__device__ __forceinline__ float softplusf(float x) {
  const float y = __expf(-fabsf(x)); const float l = y < 0.06f ? y * (1.f - y * (0.5f - y * (0.33333334f - 0.25f * y))) : __logf(1.f + y); return fmaxf(x, 0.f) + l; }
__device__ __forceinline__ void wave_scan128(float e0, float e1, int lane, float& c0, float& c1) {
  float x = e0 + e1;
#pragma unroll
  for (int o = 1; o < 64; o <<= 1) { const float v = __shfl_up(x, o); if (lane >= o) x += v; }
  const float excl = x - (e0 + e1); c0 = excl + e0; c1 = excl + e0 + e1;
}
__device__ __forceinline__ int ssd_chunk_j0(int cidx) { return cidx < 2 ? cidx * 128 : CTXL + (cidx - 2) * 128; }

__device__ __forceinline__ void st_ssd1(int it0, int step, int nitems, const bf16_t* XBC, const float* DT, const float* cw, const float* cb, const float* dt_bias, const float* a_log,
                                        bf16_t* YIN, bf16_t* ST, float* DEC, char* lds) {
  bf16_t (*Cm)[72] = (bf16_t (*)[72])lds; bf16_t (*Bm)[72] = (bf16_t (*)[72])(lds + 18432);
  bf16_t (*BT)[136] = (bf16_t (*)[136])(lds + 36864); bf16_t (*Xt)[136] = (bf16_t (*)[136])(lds + 54272); bf16_t (*Mm)[136] = (bf16_t (*)[136])(lds + 71680);
  float* tab = (float*)(lds + 106496); float* dtf = tab; float* dtb = tab + 128; float* acf = tab + 256; float* acb = tab + 384; float* wf = tab + 512; float* wb = tab + 640;
  const int tid = TIDX;
  bf16x8 cu[6], pv[6], nx[6];
#define SSD1_LOADS(itm, I0, I1) do { const int h_ = (itm) % 6, bc_ = (itm) / 6, cidx_ = bc_ % 34, b_ = bc_ / 34, g_ = h_ / 3, j0_ = ssd_chunk_j0(cidx_); const size_t r0_ = (size_t)b_ * TPB + j0_; \
    _Pragma("unroll") for (int i = (I0); i < (I1); ++i) { const int task = tid + NT * i, t = task / 24, cg = task % 24, kind = cg >> 3, q = cg & 7, j = j0_ + t; \
      const int c0 = kind == 0 ? h_ * 64 + 8 * q : (kind == 1 ? 384 + g_ * 64 + 8 * q : 512 + g_ * 64 + 8 * q); \
      const bool hasp = j != 0 && j != CTXL, hasn = j != CTXL - 1 && j != TPB - 1; const bf16_t* p = XBC + (r0_ + t) * 768 + c0; \
      cu[i] = *(const bf16x8*)p; pv[i] = *(const bf16x8*)(p + (hasp ? -768 : 0)); nx[i] = *(const bf16x8*)(p + (hasn ? 768 : 0)); } } while (0)
  if (it0 < nitems) SSD1_LOADS(it0, 0, 6);
#pragma unroll 1
  for (int item = it0; item < nitems; item += step) {
  const int tid = TIDX, lane = tid & 63, w = tid >> 6, l15 = lane & 15, l4 = lane >> 4;
  const int h = item % 6, bc = item / 6, cidx = bc % 34, b = bc / 34, g = h / 3, j0 = ssd_chunk_j0(cidx);
  const size_t r0 = (size_t)b * TPB + j0;
  float dtr0 = 0.f, dtr1 = 0.f;
  if (w < 2) { const int t0 = w == 0 ? 2 * lane : 127 - 2 * lane, t1 = w == 0 ? 2 * lane + 1 : 126 - 2 * lane; dtr0 = DT[(r0 + t0) * 12 + w * 6 + h]; dtr1 = DT[(r0 + t1) * 12 + w * 6 + h]; }
  SSD1_LOADS(item, 6, 6);
  {
#pragma unroll
    for (int i = 0; i < 6; ++i) { const int task = tid + NT * i, t = task / 24, cg = task % 24, kind = cg >> 3, q = cg & 7, j = j0 + t;
      const int c0 = kind == 0 ? h * 64 + 8 * q : (kind == 1 ? 384 + g * 64 + 8 * q : 512 + g * 64 + 8 * q);
      const float wp = (j != 0 && j != CTXL) ? 1.f : 0.f, wn = (j != CTXL - 1 && j != TPB - 1) ? 1.f : 0.f;
      float o[8];
#pragma unroll
      for (int e = 0; e < 8; ++e) o[e] = siluf(wp * cw[c0 + e] * bf2f((bf16_t)pv[i][e]) + cw[640 + c0 + e] * bf2f((bf16_t)cu[i][e]) + wn * cw[1280 + c0 + e] * bf2f((bf16_t)nx[i][e]) + cb[c0 + e]);
      if (kind == 0) {
#pragma unroll
        for (int e = 0; e < 8; ++e) Xt[8 * q + e][t] = (bf16_t)f2bf(o[e]);
      } else { const u32x4 pk = (u32x4){pk2bf(o[0], o[1]), pk2bf(o[2], o[3]), pk2bf(o[4], o[5]), pk2bf(o[6], o[7])};
        if (kind == 1) { *(u32x4*)&Bm[t][8 * q] = pk;
#pragma unroll
          for (int e = 0; e < 8; ++e) BT[8 * q + e][t] = (bf16_t)f2bf(o[e]); }
        else *(u32x4*)&Cm[t][8 * q] = pk; } }
  }
  if (w < 2) { const int dir = w; const float a = -expf(a_log[dir * 6 + h]), bias = dt_bias[dir * 6 + h];
    const int t0 = dir == 0 ? 2 * lane : 127 - 2 * lane, t1 = dir == 0 ? 2 * lane + 1 : 126 - 2 * lane;
    const float d0 = softplusf(dtr0 + bias), d1 = softplusf(dtr1 + bias);
    float c0, c1; wave_scan128(d0 * a, d1 * a, lane, c0, c1);
    const float tot = __shfl(c1, 63);
    float* dtt = dir == 0 ? dtf : dtb; float* ac = dir == 0 ? acf : acb; float* ww = dir == 0 ? wf : wb;
    dtt[t0] = d0; dtt[t1] = d1; ac[t0] = c0; ac[t1] = c1; ww[t0] = __expf(tot - c0) * d0; ww[t1] = __expf(tot - c1) * d1;
    if (lane == 0) DEC[(((size_t)b * 34 + cidx) * 2 + dir) * 6 + h] = __expf(tot); }
  __syncthreads();
  if (item + step < nitems) SSD1_LOADS(item + step, 0, 6);
  {
    f32x4 accG[8];
#pragma unroll
    for (int ni = 0; ni < 8; ++ni) accG[ni] = (f32x4){0.f, 0.f, 0.f, 0.f};
#pragma unroll
    for (int kk = 0; kk < 2; ++kk) { const bf16x8 a = *(const bf16x8*)&Cm[16 * w + l15][32 * kk + 8 * l4];
#pragma unroll
      for (int ni = 0; ni < 8; ++ni) { const bf16x8 bb = *(const bf16x8*)&Bm[16 * ni + l15][32 * kk + 8 * l4]; accG[ni] = __builtin_amdgcn_mfma_f32_16x16x32_bf16(a, bb, accG[ni], 0, 0, 0); } }
    float aft[4], abt[4];
#pragma unroll
    for (int rg = 0; rg < 4; ++rg) { aft[rg] = acf[16 * w + 4 * l4 + rg]; abt[rg] = acb[16 * w + 4 * l4 + rg]; }
#pragma unroll
    for (int ni = 0; ni < 8; ++ni) { const int sidx = 16 * ni + l15; const float afs = acf[sidx], abs_ = acb[sidx], dfs = dtf[sidx], dbs = dtb[sidx];
#pragma unroll
      for (int rg = 0; rg < 4; ++rg) { const int t = 16 * w + 4 * l4 + rg;
        const float f = sidx <= t ? __expf(aft[rg] - afs) * dfs : 0.f, bk = sidx >= t ? __expf(abt[rg] - abs_) * dbs : 0.f;
        Mm[t][sidx] = (bf16_t)f2bf(accG[ni][rg] * (f + bk)); } }
  }
  __syncthreads();
  {
    f32x4 acc[4];
#pragma unroll
    for (int ni = 0; ni < 4; ++ni) acc[ni] = (f32x4){0.f, 0.f, 0.f, 0.f};
#pragma unroll
    for (int kk = 0; kk < 4; ++kk) { const bf16x8 a = *(const bf16x8*)&Mm[16 * w + l15][32 * kk + 8 * l4];
#pragma unroll
      for (int ni = 0; ni < 4; ++ni) { const bf16x8 bb = *(const bf16x8*)&Xt[16 * ni + l15][32 * kk + 8 * l4]; acc[ni] = __builtin_amdgcn_mfma_f32_16x16x32_bf16(a, bb, acc[ni], 0, 0, 0); } }
#pragma unroll
    for (int rg = 0; rg < 4; ++rg)
#pragma unroll
      for (int ni = 0; ni < 4; ++ni) YIN[(r0 + 16 * w + 4 * l4 + rg) * 384 + h * 64 + 16 * ni + l15] = (bf16_t)f2bf(acc[ni][rg]);
  }
  {
    const int dir = w >> 2, mt = w & 3; const float* ww = dir == 0 ? wf : wb;
    f32x4 acc[4];
#pragma unroll
    for (int ni = 0; ni < 4; ++ni) acc[ni] = (f32x4){0.f, 0.f, 0.f, 0.f};
#pragma unroll
    for (int kk = 0; kk < 4; ++kk) { const bf16x8 raw = *(const bf16x8*)&Xt[16 * mt + l15][32 * kk + 8 * l4];
      const f32x4 w0 = *(const f32x4*)(ww + 32 * kk + 8 * l4), w1 = *(const f32x4*)(ww + 32 * kk + 8 * l4 + 4);
      u32x4 pk; pk.x = pk2bf(bf2f((bf16_t)raw[0]) * w0.x, bf2f((bf16_t)raw[1]) * w0.y); pk.y = pk2bf(bf2f((bf16_t)raw[2]) * w0.z, bf2f((bf16_t)raw[3]) * w0.w);
      pk.z = pk2bf(bf2f((bf16_t)raw[4]) * w1.x, bf2f((bf16_t)raw[5]) * w1.y); pk.w = pk2bf(bf2f((bf16_t)raw[6]) * w1.z, bf2f((bf16_t)raw[7]) * w1.w);
      const bf16x8 a = __builtin_bit_cast(bf16x8, pk);
#pragma unroll
      for (int ni = 0; ni < 4; ++ni) { const bf16x8 bb = *(const bf16x8*)&BT[16 * ni + l15][32 * kk + 8 * l4]; acc[ni] = __builtin_amdgcn_mfma_f32_16x16x32_bf16(a, bb, acc[ni], 0, 0, 0); } }
    bf16_t* sp = ST + ((((size_t)b * 34 + cidx) * 2 + dir) * 6 + h) * 4096;
#pragma unroll
    for (int rg = 0; rg < 4; ++rg)
#pragma unroll
      for (int ni = 0; ni < 4; ++ni) sp[(16 * mt + 4 * l4 + rg) * 64 + 16 * ni + l15] = (bf16_t)f2bf(acc[ni][rg]);
  }
  __syncthreads();
  }
#undef SSD1_LOADS
}

__device__ __forceinline__ void st_ssd_scan2(bf16_t* ST, const float* DEC) {
  for (int idx = BIDX * NT + TIDX; idx < 4 * 2 * 6 * 2048; idx += GDIM * NT) {
    const int e = (idx & 2047) * 2, bdh = idx >> 11, h = bdh % 6, dir = (bdh / 6) & 1, b = bdh / 12;
    unsigned v[34]; float d[34];
#pragma unroll
    for (int st = 0; st < 34; ++st) { const int cidx = dir == 0 ? st : (st < 2 ? 1 - st : 35 - st); const size_t o = (((size_t)b * 34 + cidx) * 2 + dir) * 6 + h; v[st] = *(const unsigned*)(ST + o * 4096 + e); d[st] = DEC[o]; }
    float H0 = 0.f, H1 = 0.f;
#pragma unroll
    for (int st = 0; st < 34; ++st) { const int cidx = dir == 0 ? st : (st < 2 ? 1 - st : 35 - st); const size_t o = (((size_t)b * 34 + cidx) * 2 + dir) * 6 + h;
      *(unsigned*)(ST + o * 4096 + e) = pk2bf(H0, H1); H0 = H0 * d[st] + __uint_as_float(v[st] << 16); H1 = H1 * d[st] + __uint_as_float(v[st] & 0xffff0000u); }
  }
}

__device__ __forceinline__ void ssd3_item(int b, int cidx, int g, const bf16_t* XBC, const bf16_t* VZ, const float* DT, const float* cw, const float* cb, const float* dt_bias, const float* a_log,
                                          const float* dskip, const float* nw, const bf16_t* YIN, const bf16_t* ST, bf16_t* MIX, char* lds) {
  bf16_t (*Cm)[72] = (bf16_t (*)[72])lds; bf16_t (*Hm)[72] = (bf16_t (*)[72])(lds + 18432);
  float* ef = (float*)(lds + 18432 + 55296);
  float (*Yt)[196] = (float (*)[196])lds;
  const int tid = TIDX, lane = tid & 63, w = tid >> 6, l15 = lane & 15, l4 = lane >> 4, j0 = ssd_chunk_j0(cidx);
  const size_t r0 = (size_t)b * TPB + j0;
#pragma unroll
  for (int i = 0; i < 2; ++i) { const int task = tid + NT * i, t = task >> 3, q = task & 7, j = j0 + t;
    float o[8]; ssd_conv8(XBC, r0 + t, 512 + g * 64 + 8 * q, j != 0 && j != CTXL, j != CTXL - 1 && j != TPB - 1, cw, cb, o);
    *(u32x4*)&Cm[t][8 * q] = (u32x4){pk2bf(o[0], o[1]), pk2bf(o[2], o[3]), pk2bf(o[4], o[5]), pk2bf(o[6], o[7])}; }
#pragma unroll
  for (int i = 0; i < 6; ++i) { const int f8 = tid + NT * i, hd = f8 >> 9, rem = f8 & 511, p = rem >> 3, n8 = (rem & 7) * 8, hh = hd >> 1, dir = hd & 1;
    *(u32x4*)&Hm[hd * 64 + p][n8] = *(const u32x4*)(ST + ((((size_t)b * 34 + cidx) * 2 + dir) * 6 + 3 * g + hh) * 4096 + p * 64 + n8); }
  if (w < 6) { const int hh = w >> 1, dir = w & 1, h = 3 * g + hh; const float a = -expf(a_log[dir * 6 + h]), bias = dt_bias[dir * 6 + h];
    const int t0 = dir == 0 ? 2 * lane : 127 - 2 * lane, t1 = dir == 0 ? 2 * lane + 1 : 126 - 2 * lane;
    const float d0 = softplusf(DT[(r0 + t0) * 12 + dir * 6 + h] + bias), d1 = softplusf(DT[(r0 + t1) * 12 + dir * 6 + h] + bias);
    float c0, c1; wave_scan128(d0 * a, d1 * a, lane, c0, c1);
    ef[w * 128 + t0] = __expf(c0); ef[w * 128 + t1] = __expf(c1); }
  __syncthreads();
  float yv[3][4][4];
  {
    bf16x8 ca[2];
#pragma unroll
    for (int kk = 0; kk < 2; ++kk) ca[kk] = *(const bf16x8*)&Cm[16 * w + l15][32 * kk + 8 * l4];
#pragma unroll
    for (int hh = 0; hh < 3; ++hh) {
      f32x4 accF[4], accB[4];
#pragma unroll
      for (int ni = 0; ni < 4; ++ni) { accF[ni] = (f32x4){0.f, 0.f, 0.f, 0.f}; accB[ni] = (f32x4){0.f, 0.f, 0.f, 0.f}; }
#pragma unroll
      for (int kk = 0; kk < 2; ++kk)
#pragma unroll
        for (int ni = 0; ni < 4; ++ni) {
          accF[ni] = __builtin_amdgcn_mfma_f32_16x16x32_bf16(ca[kk], *(const bf16x8*)&Hm[(hh * 2 + 0) * 64 + 16 * ni + l15][32 * kk + 8 * l4], accF[ni], 0, 0, 0);
          accB[ni] = __builtin_amdgcn_mfma_f32_16x16x32_bf16(ca[kk], *(const bf16x8*)&Hm[(hh * 2 + 1) * 64 + 16 * ni + l15][32 * kk + 8 * l4], accB[ni], 0, 0, 0); }
#pragma unroll
      for (int rg = 0; rg < 4; ++rg) { const int t = 16 * w + 4 * l4 + rg; const float eF = ef[(hh * 2 + 0) * 128 + t], eB = ef[(hh * 2 + 1) * 128 + t];
#pragma unroll
        for (int ni = 0; ni < 4; ++ni) yv[hh][ni][rg] = eF * accF[ni][rg] + eB * accB[ni][rg]; }
    }
  }
  __syncthreads();
#pragma unroll
  for (int hh = 0; hh < 3; ++hh)
#pragma unroll
    for (int rg = 0; rg < 4; ++rg)
#pragma unroll
      for (int ni = 0; ni < 4; ++ni) Yt[16 * w + 4 * l4 + rg][hh * 64 + 16 * ni + l15] = yv[hh][ni][rg];
  __syncthreads();
  {
    const int c4 = 4 * (lane < 48 ? lane : 47), hk = c4 >> 6; const bool lact = lane < 48;
    float cw0[4], cw1[4], cw2[4], cbv[4], nwv[4];
#pragma unroll
    for (int e = 0; e < 4; ++e) { const int col = g * 192 + c4 + e; cw0[e] = cw[col]; cw1[e] = cw[640 + col]; cw2[e] = cw[1280 + col]; cbv[e] = cb[col]; nwv[e] = nw[col]; }
    const float dsk = dskip[3 * g + hk];
#pragma unroll 1
    for (int rb = 0; rb < 16; rb += 4) {
      u32x2 xc_[4], xp_[4], xn_[4], zz_[4], yy_[4];
#pragma unroll
      for (int u = 0; u < 4; ++u) { const int t = 16 * w + rb + u, j = j0 + t; const size_t r = r0 + t; const bool hasp = j != 0 && j != CTXL, hasn = j != CTXL - 1 && j != TPB - 1;
        const bf16_t* xq = XBC + r * 768 + g * 192 + c4;
        xc_[u] = *(const u32x2*)xq; xp_[u] = *(const u32x2*)(xq + (hasp ? -768 : 0)); xn_[u] = *(const u32x2*)(xq + (hasn ? 768 : 0));
        yy_[u] = *(const u32x2*)(YIN + r * 384 + g * 192 + c4); zz_[u] = *(const u32x2*)(VZ + r * 512 + 128 + g * 192 + c4); }
#pragma unroll
      for (int u = 0; u < 4; ++u) { const int t = 16 * w + rb + u, j = j0 + t; const size_t r = r0 + t; const float wp = (j != 0 && j != CTXL) ? 1.f : 0.f, wn = (j != CTXL - 1 && j != TPB - 1) ? 1.f : 0.f;
        const f32x4 yt = *(const f32x4*)&Yt[t][c4];
        float gt[4]; float ss = 0.f;
#pragma unroll
        for (int e = 0; e < 4; ++e) { const unsigned sh = (e & 1) * 16; const unsigned wc_ = e < 2 ? xc_[u].x : xc_[u].y, wq_ = e < 2 ? xp_[u].x : xp_[u].y, wn_ = e < 2 ? xn_[u].x : xn_[u].y, wz_ = e < 2 ? zz_[u].x : zz_[u].y;
          float xv = cw1[e] * bf2f((bf16_t)(wc_ >> sh)) + cbv[e] + wp * cw0[e] * bf2f((bf16_t)(wq_ >> sh)) + wn * cw2[e] * bf2f((bf16_t)(wn_ >> sh));
          xv = siluf(xv);
          const float y = bf2f((bf16_t)((e < 2 ? yy_[u].x : yy_[u].y) >> sh)) + yt[e] + dsk * xv;
          gt[e] = lact ? y * siluf(bf2f((bf16_t)(wz_ >> sh))) : 0.f; ss += gt[e] * gt[e]; }
        const float rstd = rsqrtf(wave_sum(ss) * (1.0f / 192.0f) + EPS);
        if (lact) { u32x2 o; o.x = pk2bf(gt[0] * rstd * nwv[0], gt[1] * rstd * nwv[1]); o.y = pk2bf(gt[2] * rstd * nwv[2], gt[3] * rstd * nwv[3]);
          *(u32x2*)(MIX + r * DM + 384 + g * 192 + c4) = o; } }
    }
  }
  __syncthreads();
}

__device__ __forceinline__ void st_router(const float* xl, const float* xc, int from_inputs, bf16_t* XB, const bf16_t* MO, const float* g, const float* modv_layer, const float* w_router, const float* rbias,
                                          bf16_t* H2, int* ctl, int* tok_pair, float* tok_w, int skip_ctx, char* lds) {
  float* wl = (float*)lds;
  const int tid = TIDX, lane = tid & 63, gw = BIDX * 8 + (tid >> 6), ngw = GDIM * 8;
  int* hist = (int*)(lds + 81920);
  if (tid < 32) hist[tid] = 0;
  float* mA = (float*)(lds + 82176); float* mB = mA + 5 * 1024; float* mG = mB + 5 * 1024;
  { f32x4 g4[3], sc4[3], sh4[3], gp4[3], wr4[8];
#pragma unroll
    for (int i = 0; i < 3; ++i) { const int q = tid + NT * i, qc = q < 1280 ? q : 0, m = qc >> 8, k = (qc & 255) * 4;
      g4[i] = *(const f32x4*)(g + k); sc4[i] = *(const f32x4*)(modv_layer + (size_t)m * 6144 + 4096 + k); sh4[i] = *(const f32x4*)(modv_layer + (size_t)m * 6144 + 3072 + k);
      gp4[i] = *(const f32x4*)(modv_layer + (size_t)m * 6144 + 2048 + k); }
#pragma unroll
    for (int i = 0; i < 8; ++i) wr4[i] = *(const f32x4*)(w_router + (size_t)(tid + NT * i) * 4);
#pragma unroll
    for (int i = 0; i < 3; ++i) { const int q = tid + NT * i;
      if (q < 1280) { *(f32x4*)(mA + 4 * q) = g4[i] * ((f32x4){1.f, 1.f, 1.f, 1.f} + sc4[i]); *(f32x4*)(mB + 4 * q) = sh4[i]; *(f32x4*)(mG + 4 * q) = gp4[i]; } }
#pragma unroll
    for (int i = 0; i < 8; ++i) { const int idx = tid + NT * i, k = idx >> 2, e4 = idx & 3, row = ((k & 3) * 4 + (k >> 8)) * 64 + ((k & 255) >> 2);
      *(f32x4*)(wl + row * 20 + 4 * e4) = wr4[i]; } }
  __syncthreads();
  for (int rb = gw; rb < MTOK; rb += 2 * ngw) {
    int rr[2]; bool act[2]; f32x4 v[2][4]; u32x2 mo[2][4]; float rstd[2]; int mo_[2];
#pragma unroll
    for (int u = 0; u < 2; ++u) { const int r = rb + u * ngw; rr[u] = r < MTOK ? r : MTOK - 1; act[u] = r < MTOK && !(skip_ctx && (rr[u] % TPB) < CTXL); mo_[u] = mrow_of(rr[u]) * 1024;
      const bf16_t* mr = MO + (size_t)rr[u] * DM;
      if (from_inputs) { const float* xr = xrow(xl, xc, rr[u]);
#pragma unroll
        for (int j = 0; j < 4; ++j) v[u][j] = *(const f32x4*)(xr + 4 * lane + 256 * j); }
      else { const bf16_t* xr = XB + (size_t)rr[u] * DM;
#pragma unroll
        for (int j = 0; j < 4; ++j) { const u32x2 t2 = *(const u32x2*)(xr + 4 * lane + 256 * j);
          v[u][j] = (f32x4){__uint_as_float(t2.x << 16), __uint_as_float(t2.x & 0xffff0000u), __uint_as_float(t2.y << 16), __uint_as_float(t2.y & 0xffff0000u)}; } }
#pragma unroll
      for (int j = 0; j < 4; ++j) mo[u][j] = *(const u32x2*)(mr + 4 * lane + 256 * j); }
    if (!act[0] && !act[1]) continue;
#pragma unroll
    for (int u = 0; u < 2; ++u) if (act[u]) { bf16_t* xd = XB + (size_t)rr[u] * DM;
#pragma unroll
      for (int j = 0; j < 4; ++j) { const int k = 4 * lane + 256 * j; const f32x4 g4 = *(const f32x4*)(mG + mo_[u] + k);
        const f32x4 m4 = (f32x4){__uint_as_float(mo[u][j].x << 16), __uint_as_float(mo[u][j].x & 0xffff0000u), __uint_as_float(mo[u][j].y << 16), __uint_as_float(mo[u][j].y & 0xffff0000u)};
        v[u][j] = v[u][j] + g4 * m4; u32x2 w2; w2.x = pk2bf(v[u][j].x, v[u][j].y); w2.y = pk2bf(v[u][j].z, v[u][j].w); *(u32x2*)(xd + k) = w2; } }
#pragma unroll
    for (int u = 0; u < 2; ++u) { float ss = 0.f;
#pragma unroll
      for (int j = 0; j < 4; ++j) ss += v[u][j].x * v[u][j].x + v[u][j].y * v[u][j].y + v[u][j].z * v[u][j].z + v[u][j].w * v[u][j].w;
      rstd[u] = rsqrtf(wave_sum(ss) * (1.0f / DM) + EPS); }
    float lg[2][16];
#pragma unroll
    for (int u = 0; u < 2; ++u)
#pragma unroll
      for (int e = 0; e < 16; ++e) lg[u][e] = 0.f;
#pragma unroll 1
    for (int j = 0; j < 4; ++j) { const int k = 4 * lane + 256 * j; float o[2][4];
#pragma unroll
      for (int u = 0; u < 2; ++u) { const f32x4 a4 = *(const f32x4*)(mA + mo_[u] + k), b4 = *(const f32x4*)(mB + mo_[u] + k); const f32x4 o4 = v[u][j] * rstd[u] * a4 + b4;
        o[u][0] = o4.x; o[u][1] = o4.y; o[u][2] = o4.z; o[u][3] = o4.w;
        if (act[u]) { u32x2 wpk; wpk.x = pk2bf(o4.x, o4.y); wpk.y = pk2bf(o4.z, o4.w); *(u32x2*)(H2 + (size_t)rr[u] * DM + k) = wpk; } }
#pragma unroll
      for (int q = 0; q < 4; ++q) { const float* wr_ = wl + ((q * 4 + j) * 64 + lane) * 20;
#pragma unroll
        for (int e4 = 0; e4 < 4; ++e4) { const f32x4 wr = *(const f32x4*)(wr_ + 4 * e4);
#pragma unroll
          for (int u = 0; u < 2; ++u) { lg[u][4 * e4] += o[u][q] * wr.x; lg[u][4 * e4 + 1] += o[u][q] * wr.y; lg[u][4 * e4 + 2] += o[u][q] * wr.z; lg[u][4 * e4 + 3] += o[u][q] * wr.w; } } } }
    float h1[2];
#pragma unroll
    for (int u = 0; u < 2; ++u) { float h8[8], h4[4], h2[2];
#pragma unroll
      for (int i = 0; i < 8; ++i) { const bool up = (lane & 32) != 0; const float keep = up ? lg[u][8 + i] : lg[u][i], give = up ? lg[u][i] : lg[u][8 + i]; h8[i] = keep + __shfl_xor(give, 32); }
#pragma unroll
      for (int i = 0; i < 4; ++i) { const bool up = (lane & 16) != 0; const float keep = up ? h8[4 + i] : h8[i], give = up ? h8[i] : h8[4 + i]; h4[i] = keep + __shfl_xor(give, 16); }
#pragma unroll
      for (int i = 0; i < 2; ++i) { const bool up = (lane & 8) != 0; const float keep = up ? h4[2 + i] : h4[i], give = up ? h4[i] : h4[2 + i]; h2[i] = keep + __shfl_xor(give, 8); }
      { const bool up = (lane & 4) != 0; const float keep = up ? h2[1] : h2[0], give = up ? h2[0] : h2[1]; h1[u] = keep + __shfl_xor(give, 4); }
      h1[u] += __shfl_xor(h1[u], 2); h1[u] += __shfl_xor(h1[u], 1); }
    float lx[16];
#pragma unroll
    for (int e = 0; e < 16; ++e) { const int src = ((e >> 3) & 1) * 32 + ((e >> 2) & 1) * 16 + ((e >> 1) & 1) * 8 + (e & 1) * 4;
      const float a0 = __uint_as_float(__builtin_amdgcn_readlane(__float_as_uint(h1[0]), src)), a1 = __uint_as_float(__builtin_amdgcn_readlane(__float_as_uint(h1[1]), src));
      lx[e] = lane < 32 ? a0 : a1; }
    const int us = lane >> 5;
    if ((lane & 31) == 0 && (us == 0 ? act[0] : act[1])) {
      const int r = us == 0 ? rr[0] : rr[1];
      int best = 0, bi1 = 0, bi2 = 1; float bestv = -1e30f, bs1 = 0.f, bs2 = 0.f;
#pragma unroll
      for (int gq = 0; gq < 4; ++gq) { float m1 = -1e30f, m2 = -1e30f, s1 = 0.f, s2 = 0.f; int i1 = 0, i2 = 0;
#pragma unroll
        for (int i = 0; i < 4; ++i) { const float scv = 1.0f / (1.0f + __expf(-lx[4 * gq + i])); const float sv = scv + rbias[4 * gq + i];
          if (sv > m1) { m2 = m1; s2 = s1; i2 = i1; m1 = sv; s1 = scv; i1 = i; } else if (sv > m2) { m2 = sv; s2 = scv; i2 = i; } }
        if (m1 + m2 > bestv) { bestv = m1 + m2; best = gq; bi1 = i1; bi2 = i2; bs1 = s1; bs2 = s2; } }
      const int ia = bi1 < bi2 ? bi1 : bi2, ib = bi1 < bi2 ? bi2 : bi1;
      const int tri = ia == 0 ? ib - 1 : (ia == 1 ? ib + 1 : 5);
      const int pidx = best * 6 + tri;
      const float sa = bi1 < bi2 ? bs1 : bs2, sb = bi1 < bi2 ? bs2 : bs1, inv = 1.0f / (sa + sb);
      const int rank = atomicAdd(&hist[pidx], 1);
      tok_pair[r] = pidx | (rank << 5); tok_w[2 * r] = sa * inv; tok_w[2 * r + 1] = sb * inv;
    }
  }
  __syncthreads();
  if (tid < 32) ctl[CT_CNTB + BIDX * 32 + tid] = tid < 24 ? hist[tid] : 0;
}
__device__ __forceinline__ void st_moe_gather(const bf16_t* H2, bf16_t* H2S, int* ctl, const int* tok_pair, const float* tok_w, int* sorted_tok, float* sorted_w, int* tok_slot, int skip_ctx, char* lds) {
  int* sbase = (int*)lds; int* rtot = sbase + 32; int* rpre = rtot + 512;
  const int tid = TIDX, bid = BIDX;
  { const int p = tid & 31, seg = tid >> 5; int tot = 0, pre = 0;
#pragma unroll 4
    for (int i = 0; i < 16; ++i) { const int bb = seg * 16 + i; const int cv = ctl[CT_CNTB + bb * 32 + p]; tot += cv; pre += bb < bid ? cv : 0; }
    rtot[seg * 32 + p] = tot; rpre[seg * 32 + p] = pre; }
  __syncthreads();
  if (tid < 32) { int tot = 0, pre = 0;
#pragma unroll
    for (int sg = 0; sg < 16; ++sg) { tot += rtot[sg * 32 + tid]; pre += rpre[sg * 32 + tid]; }
    rtot[tid] = tot; rpre[tid] = pre; }
  __syncthreads();
  if (tid == 0) { int base = 0, nt = 0;
#pragma unroll 1
    for (int p = 0; p < 24; ++p) { sbase[p] = base + rpre[p]; const int n = rtot[p], tl = (n + 255) >> 8;
      if (bid == 0) { ctl[CT_BASE + p] = base; for (int t = 0; t < tl; ++t) ctl[CT_TP + nt + t] = p; }
      nt += tl; base += tl * 256; }
    if (bid == 0) { ctl[CT_BASE + 24] = base; ctl[CT_NT] = nt; } }
  __syncthreads();
  const int lane = tid & 63, gw = bid * 8 + (tid >> 6), ngw = GDIM * 8;
  for (int rb = gw; rb < MTOK; rb += 3 * ngw) {
    u32x4 a0[3], a1[3]; int pk[3]; float w0[3], w1[3]; bool act[3];
#pragma unroll
    for (int u = 0; u < 3; ++u) { const int r = rb + u * ngw; act[u] = r < MTOK && !(skip_ctx && (r % TPB) < CTXL); const int rc = act[u] ? r : 0;
      pk[u] = tok_pair[rc]; w0[u] = tok_w[2 * rc]; w1[u] = tok_w[2 * rc + 1];
      const u32x4* sp = (const u32x4*)(H2 + (size_t)rc * DM); a0[u] = sp[lane]; a1[u] = sp[lane + 64]; }
#pragma unroll
    for (int u = 0; u < 3; ++u) if (act[u]) { const int r = rb + u * ngw; const int slot = sbase[pk[u] & 31] + (pk[u] >> 5);
      if (lane == 0) { sorted_tok[slot] = r; tok_slot[r] = slot; sorted_w[2 * slot] = w0[u]; sorted_w[2 * slot + 1] = w1[u]; }
      u32x4* d = (u32x4*)(H2S + (size_t)slot * DM); d[lane] = a0[u]; d[lane + 64] = a1[u]; }
  }
  __syncthreads();
}
__device__ __forceinline__ void st_final(float* out, const float* g, const bf16_t* XB, const bf16_t* YS, const int* tok_slot, const float* gate  ) {
  const int lane = TIDX & 63, gw = BIDX * 8 + (TIDX >> 6), ngw = GDIM * 8;
  f32x4 gg[4];
#pragma unroll
  for (int j = 0; j < 4; ++j) gg[j] = *(const f32x4*)(g + 4 * lane + 256 * j);
  for (int rb = gw; rb < NB * SEQ; rb += 4 * ngw) {
    u32x2 xb[4][4], ys[4][4];
#pragma unroll
    for (int u = 0; u < 4; ++u) { const int r = rb + u * ngw, rc = r < NB * SEQ ? r : NB * SEQ - 1;
      const int bb = rc >> 12, tr = bb * TPB + CTXL + (rc & 4095); const bf16_t* xr = XB + (size_t)tr * DM; const bf16_t* yr = YS + (size_t)tok_slot[tr] * DM;
#pragma unroll
      for (int j = 0; j < 4; ++j) { xb[u][j] = *(const u32x2*)(xr + 4 * lane + 256 * j); ys[u][j] = *(const u32x2*)(yr + 4 * lane + 256 * j); } }
#pragma unroll
    for (int u = 0; u < 4; ++u) { const int r = rb + u * ngw, rc = r < NB * SEQ ? r : NB * SEQ - 1; const float* gt = gate + (size_t)(rc >> 12) * 6144; float ss = 0.f; f32x4 v[4];
#pragma unroll
      for (int j = 0; j < 4; ++j) { const f32x4 g4 = *(const f32x4*)(gt + 4 * lane + 256 * j);
        const f32x4 x4 = (f32x4){__uint_as_float(xb[u][j].x << 16), __uint_as_float(xb[u][j].x & 0xffff0000u), __uint_as_float(xb[u][j].y << 16), __uint_as_float(xb[u][j].y & 0xffff0000u)};
        const f32x4 m4 = (f32x4){__uint_as_float(ys[u][j].x << 16), __uint_as_float(ys[u][j].x & 0xffff0000u), __uint_as_float(ys[u][j].y << 16), __uint_as_float(ys[u][j].y & 0xffff0000u)};
        v[j] = x4 + g4 * m4; ss += v[j].x * v[j].x + v[j].y * v[j].y + v[j].z * v[j].z + v[j].w * v[j].w; }
      const float rstd = rsqrtf(wave_sum(ss) * (1.0f / DM) + EPS);
      if (r < NB * SEQ) { float* orow = out + (size_t)r * DM;
#pragma unroll
        for (int j = 0; j < 4; ++j) *(f32x4*)(orow + 4 * lane + 256 * j) = (f32x4){v[j].x * rstd * gg[j].x, v[j].y * rstd * gg[j].y, v[j].z * rstd * gg[j].z, v[j].w * rstd * gg[j].w}; } }
  }
}

namespace pg8 {
#define PG8_LAS __attribute__((address_space(3)))
typedef unsigned short bf16_t;
typedef short bf16x8 __attribute__((ext_vector_type(8)));
typedef float f32x4 __attribute__((ext_vector_type(4)));
typedef unsigned u32x4 __attribute__((ext_vector_type(4)));
constexpr int BM = 256, BK = 64, HALF = 128, HTB = HALF * BK * 2  , STAGE_BYTES = 8 * HTB, NXCD = 8, WGM = 8;

__host__ __device__ __forceinline__ int lds_byte(int r, int c) { const int st = (r >> 4) * 2 + (c >> 5), rr = r & 15, cc = c & 31, ob = rr * 64 + cc * 2; return st * 1024 + (ob ^ (((ob >> 9) & 1) << 5)); }
__host__ __device__ __forceinline__ void stage_rc(int b, int& R, int& C) { const int st = b / 1024, sb = b % 1024, swz = sb ^ (((sb >> 9) & 1) << 5); R = (st >> 1) * 16 + swz / 64; C = (st & 1) * 32 + (swz % 64) / 2; }
__host__ __device__ __forceinline__ int perm32(int rho) { const int n = rho >> 4, i = rho & 15; return 8 * (i >> 2) + 4 * n + (i & 3); }

struct Unit { int pm, pn, fin, half; const char* A; const char* B; };
struct Gemm { int K, lda, ldb; };

__device__ __forceinline__ void tile_of(int L, int nM, int nN, int& pm, int& pn) {
    const int nwg = nM * nN; int wgid = L; { const int q = nwg / NXCD, r = nwg % NXCD, xcd = wgid % NXCD, off = wgid / NXCD; wgid = (xcd < r ? xcd * (q + 1) : r * (q + 1) + (xcd - r) * q) + off; }
    const int nig = WGM * nN, gid = wgid / nig, fm = gid * WGM, gsz = (nM - fm) < WGM ? (nM - fm) : WGM;
    pm = fm + ((wgid % nig) % gsz); pn = (wgid % nig) / gsz;
}
__device__ __forceinline__ unsigned cvt_pk_bf16(float lo, float hi) { unsigned r; asm volatile("v_cvt_pk_bf16_f32 %0, %1, %2" : "=v"(r) : "v"(lo), "v"(hi)); return r; }
template <class Epi, class Sched, bool ALIGN_EPI = false, bool SP2 = false, bool HALFM = false>
__device__ __forceinline__ void gemm_phase(PG8_LAS unsigned char* lds, const Gemm g, const Sched& S, const Epi& E) {
    const int tid = opq_v((int)threadIdx.x), wid = __builtin_amdgcn_readfirstlane(tid >> 6), lane = tid & 63, wr = wid >> 2, wc = wid & 3, fr = lane & 15, fq = lane >> 4;
    const int K = g.K, nt = K / BK;
    unsigned voffA[2], voffB[2];
#pragma unroll
    for (int i = 0; i < 2; ++i) { int R, C; stage_rc(tid * 16 + i * 8192, R, C); const int Rb = Epi::PERM ? ((R & ~31) + perm32(R & 31)) : R;
        voffA[i] = (unsigned)(R * g.lda + C) * 2u; voffB[i] = (unsigned)(Rb * g.ldb + C) * 2u; }
    const size_t kstep = (size_t)(BK * 2);
    static_assert(!HALFM || SP2, "half-height units need the SP2 loop");
    const size_t hstepA = (size_t)HALF * g.lda * 2, hstepB = (size_t)HALF * g.ldb * 2;
    const unsigned ldsw = (unsigned)wid * 1024u;
    const int aoff = lds_byte(wr * 64 + fr, fq * 8), boff = lds_byte(wc * 32 + fr, fq * 8);
#define PG8_SA(b, h) (((b) * 2 + (h)) * HTB)
#define PG8_SB(b, h) ((4 + (b) * 2 + (h)) * HTB)
#define PG8_STAGE(bufoff, gbase, voff) do { _Pragma("unroll") for (int _i = 0; _i < 2; ++_i) \
        __builtin_amdgcn_global_load_lds((const unsigned*)((const char*)(gbase) + (voff)[_i]), (PG8_LAS unsigned*)(lds + (bufoff) + ldsw + _i * 8192), 16, 0, 0); } while (0)
#define PG8_LDA(dst, b, h) do { _Pragma("unroll") for (int m = 0; m < 4; ++m) _Pragma("unroll") for (int k = 0; k < 2; ++k) dst[m][k] = *(const PG8_LAS bf16x8*)(lds + PG8_SA(b, h) + aoff + m * 2048 + k * 1024); } while (0)
#define PG8_LDB(dst, b, h) do { _Pragma("unroll") for (int n = 0; n < 2; ++n) _Pragma("unroll") for (int k = 0; k < 2; ++k) dst[n][k] = *(const PG8_LAS bf16x8*)(lds + PG8_SB(b, h) + boff + n * 2048 + k * 1024); } while (0)
#define PG8_MMA(ai, bj, At, Bt) do { __builtin_amdgcn_s_setprio(1); _Pragma("unroll") for (int m = 0; m < 4; ++m) _Pragma("unroll") for (int n = 0; n < 2; ++n) _Pragma("unroll") for (int k = 0; k < 2; ++k) \
        acc[ai][bj][m][n] = __builtin_amdgcn_mfma_f32_16x16x32_bf16(Bt[n][k], At[m][k], acc[ai][bj][m][n], 0, 0, 0); __builtin_amdgcn_s_setprio(0); } while (0)
#define PG8_WAIT_V(n) asm volatile("s_waitcnt vmcnt(" #n ")" ::: "memory")
#define PG8_WAIT_L(n) asm volatile("s_waitcnt lgkmcnt(" #n ")" ::: "memory")
#define PG8_BAR __builtin_amdgcn_s_barrier()
#define PG8_SCHED __builtin_amdgcn_sched_barrier(0)
    Unit cur, nxt; int ui = 0;
    if (!S.next(0, cur)) return;
    f32x4 acc[2][2][4][2];
#pragma unroll
    for (int a = 0; a < 2; ++a)
#pragma unroll
        for (int b = 0; b < 2; ++b)
#pragma unroll
            for (int m = 0; m < 4; ++m)
#pragma unroll
                for (int n = 0; n < 2; ++n) acc[a][b][m][n] = (f32x4){0.f, 0.f, 0.f, 0.f};
    bf16x8 At[4][2], B0[2][2], B1[2][2];
    const char* cA = cur.A; const char* cB = cur.B;
    S.a_ready(cur);
    if constexpr (SP2) {
        PG8_STAGE(PG8_SB(0, 0), cB, voffB); PG8_STAGE(PG8_SB(0, 1), cB + hstepB, voffB); PG8_STAGE(PG8_SA(0, 0), cA, voffA); if constexpr (!HALFM) PG8_STAGE(PG8_SA(0, 1), cA + hstepA, voffA);
        if (wr == 1) PG8_BAR;
        if constexpr (HALFM) PG8_WAIT_V(0); else PG8_WAIT_V(2);
        PG8_BAR;
        PG8_STAGE(PG8_SB(1, 0), cB + kstep, voffB); PG8_STAGE(PG8_SA(1, 0), cA + kstep, voffA); PG8_STAGE(PG8_SB(1, 1), cB + hstepB + kstep, voffB);
        PG8_WAIT_V(6); PG8_BAR;
    } else {
        PG8_STAGE(PG8_SB(0, 0), cB, voffB); PG8_STAGE(PG8_SA(0, 0), cA, voffA); PG8_STAGE(PG8_SB(0, 1), cB + hstepB, voffB); PG8_STAGE(PG8_SA(0, 1), cA + hstepA, voffA);
        if (wr == 1) PG8_BAR;
        PG8_WAIT_V(4); PG8_BAR;
        PG8_STAGE(PG8_SB(1, 0), cB + kstep, voffB); PG8_STAGE(PG8_SA(1, 0), cA + kstep, voffA); PG8_STAGE(PG8_SB(1, 1), cB + hstepB + kstep, voffB);
        PG8_WAIT_V(6); PG8_BAR;
    }
    for (;;) {
        const bool has_next = S.next(ui + 1, nxt);
        const char* nA = has_next ? nxt.A : cA; const char* nB = has_next ? nxt.B : cB;
        for (int t = 0; t < nt; t += 2) {
            const bool last = (t == nt - 2);
            const char* a1 = cA + (size_t)(t + 1) * kstep;
            const char* a2 = last ? nA : cA + (size_t)(t + 2) * kstep; const char* b2 = last ? nB : cB + (size_t)(t + 2) * kstep;
            const char* a3 = a2 + kstep; const char* b3 = b2 + kstep;
            if (last && has_next) S.a_ready(nxt);
            if constexpr (SP2) {
            PG8_LDB(B0, 0, 0); PG8_LDB(B1, 0, 1); PG8_SCHED; PG8_LDA(At, 0, 0); if constexpr (!HALFM) PG8_STAGE(PG8_SA(1, 1), a1 + hstepA, voffA);
            PG8_WAIT_V(8); PG8_WAIT_L(0); PG8_BAR; PG8_MMA(0, 0, At, B0); PG8_MMA(0, 1, At, B1); PG8_BAR; PG8_SCHED;
            if constexpr (!HALFM) PG8_LDA(At, 0, 1);
            PG8_STAGE(PG8_SB(0, 0), b2, voffB); PG8_STAGE(PG8_SB(0, 1), b2 + hstepB, voffB); PG8_STAGE(PG8_SA(0, 0), a2, voffA);
            if constexpr (HALFM) PG8_WAIT_V(6); else PG8_WAIT_V(8);
            PG8_WAIT_L(0); PG8_BAR; if constexpr (!HALFM) { PG8_MMA(1, 0, At, B0); PG8_MMA(1, 1, At, B1); } PG8_BAR; PG8_SCHED;
            PG8_LDB(B0, 1, 0); PG8_LDB(B1, 1, 1); PG8_SCHED; PG8_LDA(At, 1, 0); if constexpr (!HALFM) PG8_STAGE(PG8_SA(0, 1), a2 + hstepA, voffA);
            PG8_WAIT_V(8); PG8_WAIT_L(0); PG8_BAR; PG8_MMA(0, 0, At, B0); PG8_MMA(0, 1, At, B1); PG8_BAR; PG8_SCHED;
            if constexpr (!HALFM) PG8_LDA(At, 1, 1);
            PG8_STAGE(PG8_SB(1, 0), b3, voffB); PG8_STAGE(PG8_SB(1, 1), b3 + hstepB, voffB); PG8_STAGE(PG8_SA(1, 0), a3, voffA);
            if constexpr (HALFM) PG8_WAIT_V(6); else PG8_WAIT_V(8);
            PG8_WAIT_L(0); PG8_BAR; if constexpr (!HALFM) { PG8_MMA(1, 0, At, B0); PG8_MMA(1, 1, At, B1); } PG8_BAR; PG8_SCHED;
            } else {
            PG8_LDB(B0, 0, 0); PG8_SCHED; PG8_LDA(At, 0, 0); PG8_STAGE(PG8_SA(1, 1), a1 + hstepA, voffA);
            PG8_WAIT_L(8); PG8_BAR; PG8_WAIT_L(0); PG8_MMA(0, 0, At, B0); PG8_BAR; PG8_SCHED;
            PG8_LDB(B1, 0, 1); PG8_STAGE(PG8_SB(0, 0), b2, voffB);
            PG8_BAR; PG8_WAIT_L(0); PG8_MMA(0, 1, At, B1); PG8_BAR;
            PG8_LDA(At, 0, 1); PG8_STAGE(PG8_SA(0, 0), a2, voffA);
            PG8_BAR; PG8_WAIT_L(0); PG8_MMA(1, 0, At, B0); PG8_BAR; PG8_SCHED;
            PG8_STAGE(PG8_SB(0, 1), b2 + hstepB, voffB);
            PG8_WAIT_V(6); PG8_BAR; PG8_MMA(1, 1, At, B1); PG8_BAR;
            PG8_LDB(B0, 1, 0); PG8_SCHED; PG8_LDA(At, 1, 0); PG8_STAGE(PG8_SA(0, 1), a2 + hstepA, voffA);
            PG8_WAIT_L(8); PG8_BAR; PG8_WAIT_L(0); PG8_MMA(0, 0, At, B0); PG8_BAR; PG8_SCHED;
            PG8_LDB(B1, 1, 1); PG8_STAGE(PG8_SB(1, 0), b3, voffB);
            PG8_BAR; PG8_WAIT_L(0); PG8_MMA(0, 1, At, B1); PG8_BAR;
            PG8_LDA(At, 1, 1); PG8_STAGE(PG8_SA(1, 0), a3, voffA);
            PG8_BAR; PG8_WAIT_L(0); PG8_MMA(1, 0, At, B0); PG8_BAR; PG8_SCHED;
            PG8_STAGE(PG8_SB(1, 1), b3 + hstepB, voffB);
            PG8_WAIT_V(6); PG8_BAR; PG8_MMA(1, 1, At, B1); PG8_BAR;
            }
        }
        if constexpr (ALIGN_EPI) { if (wr == 0) PG8_BAR; }
        if constexpr (!Epi::AFTER_DRAIN) { if (cur.fin) { E(acc, cur, wr, wc, fr, fq, HALFM ? 1 : 2); S.done(cur); } }
        if (!has_next) break;
        if (cur.fin) {
#pragma unroll
        for (int a = 0; a < 2; ++a)
#pragma unroll
            for (int b = 0; b < 2; ++b)
#pragma unroll
                for (int m = 0; m < 4; ++m)
#pragma unroll
                    for (int n = 0; n < 2; ++n) acc[a][b][m][n] = (f32x4){0.f, 0.f, 0.f, 0.f};
        }
        cur = nxt; cA = nA; cB = nB; ++ui;
        if constexpr (ALIGN_EPI) { if (wr == 1) PG8_BAR; }
    }
    PG8_WAIT_V(0);
    if constexpr (!ALIGN_EPI) { if (wr == 0) PG8_BAR; }
    PG8_BAR;
    if constexpr (Epi::AFTER_DRAIN) { E.fused(acc, cur, wr, wc, fr, fq, lds, wid, lane); S.done(cur); }
#undef PG8_SA
#undef PG8_SB
#undef PG8_STAGE
#undef PG8_LDA
#undef PG8_LDB
#undef PG8_MMA
#undef PG8_WAIT_V
#undef PG8_WAIT_L
#undef PG8_BAR
#undef PG8_SCHED
}
}

struct SchedDense {
  int nM, nN, G, c, skip_ctx; const char* A; const char* B; size_t a_tile, b_tile; int part;
  __device__ __forceinline__ bool next(int i, pg8::Unit& u) const {
    const int nu = nM * nN, T = nu % G; const bool split = T > 0 && 2 * T <= G; int L, half = 0;
    if (part == 0) { L = i * G + c; if (L >= (split ? nu - T : nu)) return false; }
    else { if (i > 0 || !split || c >= 2 * T) return false; L = nu - T + (c >> 1); half = 1 + (c & 1); }
    int pm, pn; pg8::tile_of(L, nM, nN, pm, pn); if (skip_ctx) pm = pm + pm / 16 + 1;
    u.pm = pm; u.pn = pn; u.fin = 1; u.half = half; u.A = A + (size_t)pm * a_tile + (half == 2 ? a_tile / 2 : 0); u.B = B + (size_t)pn * b_tile; return true; }
  __device__ __forceinline__ void a_ready(const pg8::Unit&) const {}
  __device__ __forceinline__ void done(const pg8::Unit&) const {}
};
struct SchedMoe {
  int G, c, mode; const int* ctl; const char* A; size_t a_tile; const char* W; int tail;
  __device__ __forceinline__ bool next(int i, pg8::Unit& u) const {
    const int part = mode == 2 ? (i & 1) : 0, iu = mode == 2 ? (i >> 1) : i;
    const int nu = ctl[CT_NT] * 4, T = nu % G; const bool split = T > 0 && 2 * T <= G; int L, half = 0;
    if (tail == 0) { L = iu * G + c; if (L >= (split ? nu - T : nu)) return false; }
    else { if (iu > 0 || !split || c >= 2 * T) return false; L = nu - T + (c >> 1); half = 1 + (c & 1); }
    const int pm = L >> 2, pn = L & 3; int eA, eB; pair_experts(ctl[CT_TP + pm], eA, eB);
    u.pm = pm; u.pn = pn; u.half = half; const size_t ho = half == 2 ? a_tile / 2 : 0;
    if (mode == 1) { const int e = pn < 2 ? eA : eB; u.fin = 1; u.A = A + (size_t)pm * a_tile + ho; u.B = W + (size_t)e * (512 * 1024 * 2) + (size_t)(pn & 1) * (256 * 1024 * 2); }
    else { u.fin = part; u.A = A + (size_t)pm * a_tile + ho + part * 512; u.B = W + (size_t)(part ? eB : eA) * (1024 * 256 * 2) + (size_t)pn * (256 * 256 * 2); }
    return true; }
  __device__ __forceinline__ void a_ready(const pg8::Unit&) const {}
  __device__ __forceinline__ void done(const pg8::Unit&) const {}
};
__device__ __forceinline__ unsigned cvt_pk(float lo, float hi) { return pg8::cvt_pk_bf16(lo, hi); }
struct EpiInProj {
  static constexpr bool PERM = true, AFTER_DRAIN = false; bf16_t *QK, *VZ, *XBC, *HY; float* DT;
  __device__ __forceinline__ void operator()(const f32x4 (&acc)[2][2][4][2], const pg8::Unit& u, int wr, int wc, int fr, int fq, const int nai) const {
    const int pn = u.pn; bf16_t* base; int ldc, coff;
    if (pn < 2) { base = QK; ldc = 512; coff = pn * 256; } else if (pn < 4) { base = VZ; ldc = 512; coff = (pn - 2) * 256; }
    else if (pn < 7) { base = XBC; ldc = 768; coff = (pn - 4) * 256; } else { base = HY; ldc = 768; coff = (pn - 7) * 256; }
    const int row0 = u.pm * 256 + (u.half == 2 ? 128 : 0) + wr * 64 + fr, col0 = coff + wc * 32 + 8 * fq; const bool dtl = (pn == 6 && wc == 0 && fq < 2);
#pragma unroll
    for (int ai = 0; ai < 2; ++ai)
#pragma unroll
      for (int m = 0; m < 4; ++m) if (ai < nai) { const int row = row0 + ai * 128 + m * 16; bf16_t* rowp = base + (size_t)row * ldc + col0;
#pragma unroll
        for (int bj = 0; bj < 2; ++bj) { const f32x4 v0 = acc[ai][bj][m][0], v1 = acc[ai][bj][m][1];
          u32x4 w; w.x = cvt_pk(v0[0], v0[1]); w.y = cvt_pk(v0[2], v0[3]); w.z = cvt_pk(v1[0], v1[1]); w.w = cvt_pk(v1[2], v1[3]);
          *(u32x4*)(rowp + bj * 128) = w;
          if (bj == 1 && dtl) { float* dp = DT + (size_t)row * 12 + 8 * fq; *(f32x4*)dp = v0; if (fq == 0) *(f32x4*)(dp + 4) = v1; } } }
  }
};
struct EpiOutProj {
  static constexpr bool PERM = true, AFTER_DRAIN = false; bf16_t* MO;
  __device__ __forceinline__ void operator()(const f32x4 (&acc)[2][2][4][2], const pg8::Unit& u, int wr, int wc, int fr, int fq, const int nai) const {
    const int row0 = u.pm * 256 + (u.half == 2 ? 128 : 0) + wr * 64 + fr, col0 = u.pn * 256 + wc * 32 + 8 * fq;
#pragma unroll
    for (int ai = 0; ai < 2; ++ai)
#pragma unroll
      for (int m = 0; m < 4; ++m) if (ai < nai) { bf16_t* rowp = MO + (size_t)(row0 + ai * 128 + m * 16) * DM + col0;
#pragma unroll
        for (int bj = 0; bj < 2; ++bj) { const f32x4 v0 = acc[ai][bj][m][0], v1 = acc[ai][bj][m][1];
          u32x4 w; w.x = cvt_pk(v0[0], v0[1]); w.y = cvt_pk(v0[2], v0[3]); w.z = cvt_pk(v1[0], v1[1]); w.w = cvt_pk(v1[2], v1[3]);
          *(u32x4*)(rowp + bj * 128) = w; } }
  }
};
struct EpiMoe1 {
  static constexpr bool PERM = true, AFTER_DRAIN = false; bf16_t* ACT; const float* sorted_w;
  __device__ __forceinline__ void operator()(const f32x4 (&acc)[2][2][4][2], const pg8::Unit& u, int wr, int wc, int fr, int fq, const int nai) const {
    const int half = u.pn >> 1, j0 = (u.pn & 1) * 128 + 16 * wc + 4 * fq;
#pragma unroll
    for (int ai = 0; ai < 2; ++ai)
#pragma unroll
      for (int m = 0; m < 4; ++m) if (ai < nai) { const int slot = u.pm * 256 + (u.half == 2 ? 128 : 0) + ai * 128 + wr * 64 + m * 16 + fr; const float wt = sorted_w[2 * slot + half];
#pragma unroll
        for (int bj = 0; bj < 2; ++bj) { const f32x4 v0 = acc[ai][bj][m][0], v1 = acc[ai][bj][m][1];
          u32x2 w; w.x = cvt_pk(siluf(v0[0]) * v0[1] * wt, siluf(v0[2]) * v0[3] * wt); w.y = cvt_pk(siluf(v1[0]) * v1[1] * wt, siluf(v1[2]) * v1[3] * wt);
          *(u32x2*)(ACT + (size_t)slot * 512 + half * 256 + j0 + 64 * bj) = w; } }
  }
};
struct EpiMoe2 {
  static constexpr bool PERM = true, AFTER_DRAIN = false; bf16_t* YS;
  __device__ __forceinline__ void operator()(const f32x4 (&acc)[2][2][4][2], const pg8::Unit& u, int wr, int wc, int fr, int fq, const int nai) const {
    const int row0 = u.pm * 256 + (u.half == 2 ? 128 : 0) + wr * 64 + fr, col0 = u.pn * 256 + wc * 32 + 8 * fq;
#pragma unroll
    for (int ai = 0; ai < 2; ++ai)
#pragma unroll
      for (int m = 0; m < 4; ++m) if (ai < nai) { bf16_t* rowp = YS + (size_t)(row0 + ai * 128 + m * 16) * DM + col0;
#pragma unroll
        for (int bj = 0; bj < 2; ++bj) { const f32x4 v0 = acc[ai][bj][m][0], v1 = acc[ai][bj][m][1];
          u32x4 w; w.x = cvt_pk(v0[0], v0[1]); w.y = cvt_pk(v0[2], v0[3]); w.z = cvt_pk(v1[0], v1[1]); w.w = cvt_pk(v1[2], v1[3]);
          *(u32x4*)(rowp + bj * 128) = w; } }
  }
};

#include <hip/hip_bf16.h>
#include <cmath>
namespace attn_body {
using bf16=__hip_bfloat16;
using bf16x8=__attribute__((ext_vector_type(8)))short;
using s16x4=__attribute__((ext_vector_type(4)))short;
using f32x16=__attribute__((ext_vector_type(16)))float;
using u32x4=__attribute__((ext_vector_type(4)))unsigned;
constexpr int D=64,QP=512,KP=512,VP=512,OP=1024;
constexpr int NW=8,QBLK=32,QB=QBLK*NW,KVBLK=64;
constexpr int ATTN_UNIT_ROWS=QB;
__device__ __forceinline__ int crow(int r,int hi){return (r&3)+8*(r>>2)+4*hi;}
#define SBAR() __builtin_amdgcn_sched_barrier(0)
__device__ __forceinline__ void cmask(f32x16&p0,f32x16&p1,int jb,int qrel,int hi){
  const float NEG=-INFINITY; int kb=64*jb+4*hi;
  #pragma unroll
  for(int r=0;r<16;++r){int kv=kb+(r&3)+8*(r>>2); if(kv>qrel)p0[r]=NEG; if(kv+32>qrel)p1[r]=NEG;}
}

constexpr int NSLOT=3, SLOTB=8192;
constexpr int LDS_K=0, LDS_V=NSLOT*SLOTB, LDS_WS=2*NSLOT*SLOTB, LDS_OST=LDS_WS+NW*64*4, LDS_BYTES=LDS_OST+NW*4096;
constexpr float C2=0.125f*1.4426950408889634f;
__device__ __forceinline__ void glds16(const void*gsrc,unsigned lds_dst){unsigned keep;
  asm volatile("s_mov_b32 %0, m0\n\ts_mov_b32 m0, %2\n\ts_nop 0\n\tglobal_load_lds_dwordx4 %1, off\n\ts_mov_b32 m0, %0":"=&s"(keep):"v"(gsrc),"s"(lds_dst):"memory");}
__device__ __forceinline__ float max3f(float a,float b,float c){float r;asm("v_max3_f32 %0, %1, %2, %3":"=v"(r):"v"(a),"v"(b),"v"(c));return r;}
__device__ __forceinline__ float max2f(float a,float b){float r;asm("v_max_f32_e32 %0, %1, %2":"=v"(r):"v"(a),"v"(b));return r;}
__device__ __forceinline__ float fadd_s(float a,float b){float r;asm("v_add_f32_e32 %0, %1, %2":"=v"(r):"v"(a),"v"(b));return r;}
__device__ __forceinline__ float fsub_s(float a,float b){float r;asm("v_sub_f32_e32 %0, %1, %2":"=v"(r):"v"(a),"v"(b));return r;}
typedef float f32x2_t __attribute__((ext_vector_type(2))); typedef __bf16 bf16x2_t __attribute__((ext_vector_type(2)));
__device__ __forceinline__ unsigned cvtpk_s(float lo,float hi){f32x2_t v={lo,hi};bf16x2_t b=__builtin_convertvector(v,bf16x2_t);return __builtin_bit_cast(unsigned,b);}
#define WAIT_BAR(N) asm volatile("s_waitcnt vmcnt(" #N ") lgkmcnt(0)\n\ts_barrier":::"memory")

__device__ __forceinline__ void qkt(f32x16&p0,f32x16&p1,const char*Kslot,const bf16x8*qr,const f32x16&negm,int r32,int hi){
  const char*kb=Kslot+hi*1024+r32*16;
  #pragma unroll
  for(int d0=0;d0<4;++d0){
    const bf16x8 b0=*reinterpret_cast<const bf16x8*>(kb+d0*2048);
    const bf16x8 b1=*reinterpret_cast<const bf16x8*>(kb+d0*2048+512);
    if(d0==0){p0=__builtin_amdgcn_mfma_f32_32x32x16_bf16(b0,qr[0],negm,0,0,0);p1=__builtin_amdgcn_mfma_f32_32x32x16_bf16(b1,qr[0],negm,0,0,0);}
    else{p0=__builtin_amdgcn_mfma_f32_32x32x16_bf16(b0,qr[d0],p0,0,0,0);p1=__builtin_amdgcn_mfma_f32_32x32x16_bf16(b1,qr[d0],p1,0,0,0);}}
}
typedef __attribute__((address_space(3))) const char* lds_cptr;
typedef short v4i16_t __attribute__((ext_vector_type(4)));
__device__ __forceinline__ void kload8(bf16x8*kf,lds_cptr kp){
  kf[0]=*(const __attribute__((address_space(3))) bf16x8*)(kp);      kf[1]=*(const __attribute__((address_space(3))) bf16x8*)(kp+512);
  kf[2]=*(const __attribute__((address_space(3))) bf16x8*)(kp+2048); kf[3]=*(const __attribute__((address_space(3))) bf16x8*)(kp+2560);
  kf[4]=*(const __attribute__((address_space(3))) bf16x8*)(kp+4096); kf[5]=*(const __attribute__((address_space(3))) bf16x8*)(kp+4608);
  kf[6]=*(const __attribute__((address_space(3))) bf16x8*)(kp+6144); kf[7]=*(const __attribute__((address_space(3))) bf16x8*)(kp+6656);
}
__device__ __forceinline__ void kload2(bf16x8*kf,lds_cptr kp,int j){ kf[2*j]=*(const __attribute__((address_space(3))) bf16x8*)(kp+j*2048); kf[2*j+1]=*(const __attribute__((address_space(3))) bf16x8*)(kp+j*2048+512); }
__device__ __forceinline__ s16x4 vtr(lds_cptr p){ return __builtin_bit_cast(s16x4,__builtin_amdgcn_ds_read_tr16_b64_v4i16((__attribute__((address_space(3))) v4i16_t*)p)); }
__device__ __forceinline__ float rowmax(const f32x16&p0,const f32x16&p1){
  float a=max3f(p0[0],p0[1],p1[0]),b=max3f(p0[2],p0[3],p1[1]);a=max3f(a,p1[2],p1[3]);
  #pragma unroll
  for(int r=4;r<16;r+=4){a=max3f(a,p0[r],p0[r+1]);b=max3f(b,p0[r+2],p0[r+3]);a=max3f(a,p1[r],p1[r+1]);b=max3f(b,p1[r+2],p1[r+3]);}
  const float m=max2f(a,b);
  auto rr=__builtin_amdgcn_permlane32_swap(__float_as_uint(m),__float_as_uint(m),false,false);
  return max2f(__uint_as_float(rr[0]),__uint_as_float(rr[1]));
}
__device__ __forceinline__ void pv(f32x16*o,int vb,bf16x8 pa0,bf16x8 pa1,bf16x8 pa2,bf16x8 pa3){
  #pragma unroll
  for(int d0=0;d0<2;++d0){s16x4 lo[4],hi[4];
    #pragma unroll
    for(int ks=0;ks<4;++ks){
      asm volatile("ds_read_b64_tr_b16 %0,%1 offset:%c2":"=&v"(lo[ks]):"v"(vb),"i"(d0*4096+ks*1024):"memory");
      asm volatile("ds_read_b64_tr_b16 %0,%1 offset:%c2":"=&v"(hi[ks]):"v"(vb),"i"(d0*4096+ks*1024+512):"memory");}
    asm volatile("s_waitcnt lgkmcnt(0)":::"memory");SBAR();
    #define PK(k) (bf16x8){lo[k][0],lo[k][1],lo[k][2],lo[k][3],hi[k][0],hi[k][1],hi[k][2],hi[k][3]}
    o[d0]=__builtin_amdgcn_mfma_f32_32x32x16_bf16(pa0,PK(0),o[d0],0,0,0);
    o[d0]=__builtin_amdgcn_mfma_f32_32x32x16_bf16(pa1,PK(1),o[d0],0,0,0);
    o[d0]=__builtin_amdgcn_mfma_f32_32x32x16_bf16(pa2,PK(2),o[d0],0,0,0);
    o[d0]=__builtin_amdgcn_mfma_f32_32x32x16_bf16(pa3,PK(3),o[d0],0,0,0);
    #undef PK
  }
}

#ifndef ATTN_STORE16
#define ATTN_STORE16(p,v) (*(u32x4*)(p)=(v))
#endif
template<int THRL> __device__ __forceinline__ void attn_unit(const bf16*Qu,const bf16*__restrict__ Kh,const bf16*__restrict__ Vh,bf16*Ou,const int NT,char*shm){
  const int tid=opq_v((int)threadIdx.x),lane=tid&63,r32=lane&31,hi=lane>>5; const int wid=__builtin_amdgcn_readfirstlane(tid>>6);
  const bf16*Qw=Qu+(long)(wid*QBLK)*QP;
  const unsigned lds0=(unsigned)(uintptr_t)shm;
  float*wsf=(float*)(shm+LDS_WS)+wid*64;
  const bf16*ksrc=Kh+(long)lane*KP+wid*8;
  const bf16*vsrc=Vh+(long)(16*(wid&3)+(lane>>2))*VP+(wid>>2)*32+(lane&3)*8;
  const unsigned kdst=lds0+LDS_K+wid*1024, vdst=lds0+LDS_V+wid*1024;
  #define DMA_K(t,slot) glds16(ksrc+(long)(t)*KVBLK*KP,(unsigned)__builtin_amdgcn_readfirstlane(kdst+(slot)))
  #define DMA_V(t,slot) glds16(vsrc+(long)(t)*KVBLK*VP,(unsigned)__builtin_amdgcn_readfirstlane(vdst+(slot)))
  const int vb0=(int)(lds0+LDS_V)+((lane>>4)&1)*32+(lane&3)*8+(4*hi+((lane&15)>>2))*64;
  const char*Kbase=shm+LDS_K; bf16x8 kf[8];
  const lds_cptr shm3=(lds_cptr)shm; const lds_cptr kp0=shm3+LDS_K+hi*1024+r32*16; const lds_cptr vp0=shm3+LDS_V+((lane>>4)&1)*32+(lane&3)*8+(4*hi+((lane&15)>>2))*64;
  DMA_K(0,0);DMA_V(0,0);DMA_K(1,SLOTB);
  bf16x8 qr[4];
  #pragma unroll
  for(int d0=0;d0<4;++d0)qr[d0]=*reinterpret_cast<const bf16x8*>(&Qw[(long)r32*QP+d0*16+hi*8]);
  float mhat=0.f,l_reg=0.f;float z0_=0.f;asm volatile("":"+v"(z0_));f32x16 o[2];f32x16 negm;
  _Pragma("unroll") for(int r=0;r<16;++r){o[0][r]=z0_;o[1][r]=z0_;negm[r]=z0_;} asm volatile("":"+v"(negm));
  #define CMASK(P0,P1,t) do{}while(0)
  bool resc=false;
  #define START(P0,P1) do{ const float rm=rowmax(P0,P1); resc=false; \
    { const float dl=rm; mhat=fadd_s(mhat,dl); \
      _Pragma("unroll") for(int r=0;r<16;++r){P0[r]=fsub_s(P0[r],dl);P1[r]=fsub_s(P1[r],dl);} \
      _Pragma("unroll") for(int r=0;r<16;++r)negm[r]=-mhat; asm volatile("":"+v"(negm)); } \
    _Pragma("unroll") for(int r=0;r<16;++r)P0[r]=__builtin_amdgcn_exp2f(P0[r]); }while(0)
  #define RESC() do{ if(resc){ asm volatile("s_waitcnt lgkmcnt(0)":::"memory"); \
      _Pragma("unroll") for(int d_=0;d_<2;++d_) _Pragma("unroll") for(int r=0;r<16;++r)o[d_][r]*=wsf[crow(r,hi)]; } }while(0)
  f32x16 pA0,pA1,pB0,pB1;
  int sl_prev=0,sl_cur=0,sl_next=SLOTB;
  #define ROT() do{sl_prev=sl_cur;sl_cur=sl_next;sl_next=(sl_next==(NSLOT-1)*SLOTB)?0:sl_next+SLOTB;}while(0)
  DMA_K(2,2*SLOTB);
  WAIT_BAR(3);
  qkt(pA0,pA1,Kbase,qr,negm,r32,hi);asm volatile("s_nop 15\n\ts_nop 7":"+v"(pA0),"+v"(pA1));CMASK(pA0,pA1,0);
  START(pA0,pA1);
  _Pragma("unroll") for(int r=0;r<16;++r)pA1[r]=__builtin_amdgcn_exp2f(pA1[r]);
  WAIT_BAR(0);
  DMA_K(3,0);DMA_V(1,SLOTB);
  ROT();
  kload8(kf,kp0+sl_cur);
  WAIT_BAR(2);
  s16x4 vlo[8],vhi[8]; u32x4 pw0,pw1,pw2,pw3;
  #define PKW(P,B) cvtpk_s(P[B],P[B+1])
  #define PAF(k) __builtin_bit_cast(bf16x8,pw##k)
  #define VFR(i) (bf16x8){vlo[i][0],vlo[i][1],vlo[i][2],vlo[i][3],vhi[i][0],vhi[i][1],vhi[i][2],vhi[i][3]}
  #define PIN(x) asm volatile("":"+v"(x))
  #define MX3(a,b,c) __builtin_fmaxf(__builtin_fmaxf((a),(b)),(c))
  #define GAPA(MF,A0,A1,A2,A3,W0,W1,PW) do{ MF; sacc+=A0; sacc+=A1; sacc+=A2; sacc+=A3; PIN(sacc); W0; W1; PIN(PW); SBAR(); }while(0)
  #define EX(v) __builtin_amdgcn_exp2f(v)
  #define GAPB(MF,X,B) do{ MF; X[B]=EX(X[B]); X[B+1]=EX(X[B+1]); X[B+2]=EX(X[B+2]); X[B+3]=EX(X[B+3]); PIN(X); SBAR(); }while(0)
  #define VRD(i) do{ vlo[i]=vtr(vp_+(((i)>>2)*4096+((i)&3)*1024)); vhi[i]=vtr(vp_+(((i)>>2)*4096+((i)&3)*1024+512)); }while(0)
  #define KRD(G,j) do{ if(G){ kload2(kf,kp0+sl_next,j); SBAR(); } }while(0)
  #define STEP(C0,C1,P0,P1,t,GK,GV,GL) do{ SBAR(); \
    const lds_cptr vp_=vp0+sl_prev; \
    VRD(0); SBAR(); float sacc=(P0[0]+P0[1]); \
    GAPA(C0=__builtin_amdgcn_mfma_f32_32x32x16_bf16(kf[0],qr[0],negm,0,0,0), P0[2],P0[3],P0[4],P0[5],     pw0[0]=PKW(P0,0), pw0[1]=PKW(P0,2), pw0); \
    VRD(4); SBAR(); GAPA(C1=__builtin_amdgcn_mfma_f32_32x32x16_bf16(kf[1],qr[0],negm,0,0,0), P0[6],P0[7],P0[8],P0[9],     pw0[2]=PKW(P0,4), pw0[3]=PKW(P0,6), pw0); \
    VRD(1); SBAR(); GAPA(C0=__builtin_amdgcn_mfma_f32_32x32x16_bf16(kf[2],qr[1],C0,0,0,0),   P0[10],P0[11],P0[12],P0[13], pw1[0]=PKW(P0,8), pw1[1]=PKW(P0,10), pw1); \
    VRD(5); SBAR(); GAPA(C1=__builtin_amdgcn_mfma_f32_32x32x16_bf16(kf[3],qr[1],C1,0,0,0),   P0[14],P0[15],P1[0],P1[1],   pw1[2]=PKW(P0,12),pw1[3]=PKW(P0,14), pw1); \
    VRD(2); SBAR(); GAPA(C0=__builtin_amdgcn_mfma_f32_32x32x16_bf16(kf[4],qr[2],C0,0,0,0),   P1[2],P1[3],P1[4],P1[5],     pw2[0]=PKW(P1,0), pw2[1]=PKW(P1,2), pw2); \
    VRD(6); SBAR(); GAPA(C1=__builtin_amdgcn_mfma_f32_32x32x16_bf16(kf[5],qr[2],C1,0,0,0),   P1[6],P1[7],P1[8],P1[9],     pw2[2]=PKW(P1,4), pw2[3]=PKW(P1,6), pw2); \
    VRD(3); SBAR(); GAPA(C0=__builtin_amdgcn_mfma_f32_32x32x16_bf16(kf[6],qr[3],C0,0,0,0),   P1[10],P1[11],P1[12],P1[13], pw3[0]=PKW(P1,8), pw3[1]=PKW(P1,10), pw3); \
    VRD(7); SBAR(); GAPA(C1=__builtin_amdgcn_mfma_f32_32x32x16_bf16(kf[7],qr[3],C1,0,0,0),   P1[14],P1[15],0.f,0.f,       pw3[2]=PKW(P1,12),pw3[3]=PKW(P1,14), pw3); \
    l_reg+=sacc; \
    if(GK){DMA_K((t)+3,sl_cur);} if(GV){DMA_V((t)+1,sl_next);} \
    CMASK(C0,C1,t); \
    { float a=MX3(C0[0],C0[1],C1[0]),b=MX3(C0[2],C0[3],C1[1]); a=MX3(a,C1[2],C1[3]); \
      _Pragma("unroll") for(int r=4;r<16;r+=4){a=MX3(a,C0[r],C0[r+1]);b=MX3(b,C0[r+2],C0[r+3]);a=MX3(a,C1[r],C1[r+1]);b=MX3(b,C1[r+2],C1[r+3]);} \
      float rm=__builtin_fmaxf(a,b); { auto rr=__builtin_amdgcn_permlane32_swap(__float_as_uint(rm),__float_as_uint(rm),false,false); rm=__builtin_fmaxf(__uint_as_float(rr[0]),__uint_as_float(rr[1])); } \
      resc=false; \
      if(__builtin_expect(__any(rm>(float)THRL),0)){ const float dl=__builtin_fmaxf(rm,0.f); mhat+=dl; \
        _Pragma("unroll") for(int r=0;r<16;++r){C0[r]-=dl;C1[r]-=dl;} \
        _Pragma("unroll") for(int r=0;r<16;++r)negm[r]=-mhat; asm volatile("":"+v"(negm)); \
        const float f=__builtin_amdgcn_exp2f(-dl); l_reg*=f; if(hi==0)wsf[r32]=f; resc=true; } } \
    SBAR(); \
    GAPB(o[0]=__builtin_amdgcn_mfma_f32_32x32x16_bf16(PAF(0),VFR(0),o[0],0,0,0), C0,0); \
    GAPB(o[1]=__builtin_amdgcn_mfma_f32_32x32x16_bf16(PAF(0),VFR(4),o[1],0,0,0), C0,4); \
    KRD(GL,0); GAPB(o[0]=__builtin_amdgcn_mfma_f32_32x32x16_bf16(PAF(1),VFR(1),o[0],0,0,0), C0,8); \
    KRD(GL,1); GAPB(o[1]=__builtin_amdgcn_mfma_f32_32x32x16_bf16(PAF(1),VFR(5),o[1],0,0,0), C0,12); \
    KRD(GL,2); GAPB(o[0]=__builtin_amdgcn_mfma_f32_32x32x16_bf16(PAF(2),VFR(2),o[0],0,0,0), C1,0); \
    KRD(GL,3); GAPB(o[1]=__builtin_amdgcn_mfma_f32_32x32x16_bf16(PAF(2),VFR(6),o[1],0,0,0), C1,4); \
    GAPB(o[0]=__builtin_amdgcn_mfma_f32_32x32x16_bf16(PAF(3),VFR(3),o[0],0,0,0), C1,8); \
    GAPB(o[1]=__builtin_amdgcn_mfma_f32_32x32x16_bf16(PAF(3),VFR(7),o[1],0,0,0), C1,12); \
    }while(0)
  int t=1;
  for(;t+5<NT;t+=2){
    STEP(pB0,pB1,pA0,pA1,t,true,true,true);     WAIT_BAR(2); RESC(); ROT();
    STEP(pA0,pA1,pB0,pB1,t+1,true,true,true);   WAIT_BAR(2); RESC(); ROT();
  }
  #define ENDW(tt) do{ if((tt)+3<NT){WAIT_BAR(2);} else if((tt)+2<NT){WAIT_BAR(1);} else {WAIT_BAR(0);} }while(0)
  for(;t+1<NT;t+=2){
    STEP(pB0,pB1,pA0,pA1,t,(t+3<NT),(t+1<NT),(t+1<NT));       ENDW(t);   RESC(); ROT();
    STEP(pA0,pA1,pB0,pB1,t+1,(t+4<NT),(t+2<NT),(t+2<NT));     ENDW(t+1); RESC(); ROT();
  }
  STEP(pB0,pB1,pA0,pA1,NT-1,false,false,false); RESC();
  { float sacc=pB0[0]+pB0[1]; _Pragma("unroll") for(int r=2;r<16;++r)sacc+=pB0[r]; _Pragma("unroll") for(int r=0;r<16;++r)sacc+=pB1[r]; l_reg+=sacc;
    pw0=(u32x4){PKW(pB0,0),PKW(pB0,2),PKW(pB0,4),PKW(pB0,6)};pw1=(u32x4){PKW(pB0,8),PKW(pB0,10),PKW(pB0,12),PKW(pB0,14)};pw2=(u32x4){PKW(pB1,0),PKW(pB1,2),PKW(pB1,4),PKW(pB1,6)};pw3=(u32x4){PKW(pB1,8),PKW(pB1,10),PKW(pB1,12),PKW(pB1,14)};
    SBAR(); pv(o,vb0+sl_cur,PAF(0),PAF(1),PAF(2),PAF(3)); }
  #undef PKW
  #undef PAF
  #undef VFR
  #undef PIN
  #undef MX3
  #undef GAPA
  #undef GAPB
  #undef EX
  #undef VRD
  #undef KRD
  #undef STEP
  #undef ENDW
  {auto rr=__builtin_amdgcn_permlane32_swap(__float_as_uint(l_reg),__float_as_uint(l_reg),false,false);l_reg=__uint_as_float(rr[0])+__uint_as_float(rr[1]);}
  if(hi==0)wsf[32+r32]=l_reg;asm volatile("s_waitcnt lgkmcnt(0)":::"memory");
  float rli[16];
  #pragma unroll
  for(int r=0;r<16;++r)rli[r]=__builtin_amdgcn_rcpf(wsf[32+crow(r,hi)]);
  bf16*Ow=Ou+(long)(wid*QBLK)*OP;
  { bf16*stg=(bf16*)(shm+LDS_OST)+wid*2048;
    #pragma unroll
    for(int r=0;r<16;++r){const int orow=crow(r,hi);
      #pragma unroll
      for(int d0=0;d0<2;++d0)stg[orow*64+d0*32+r32]=__float2bfloat16(o[d0][r]*rli[r]);}
    asm volatile("s_waitcnt lgkmcnt(0)":::"memory");
    #pragma unroll
    for(int i=0;i<4;++i){const int row=i*8+(lane>>3),ch=lane&7; const u32x4 v=*(const u32x4*)(stg+row*64+ch*8); ATTN_STORE16(Ow+(long)row*OP+ch*8,v);} }
  asm volatile("s_waitcnt lgkmcnt(0)\n\ts_barrier":::"memory");
  #undef DMA_K
  #undef DMA_V
  #undef CMASK
  #undef START
  #undef RESC
  #undef ROT
}
constexpr int ATTN_LDS_BYTES=LDS_BYTES;
#undef SBAR
#undef WAIT_BAR
}


namespace hyf {
struct c32 { float x, y; };
typedef _Float16 h2 __attribute__((ext_vector_type(2)));
__device__ __forceinline__ c32 operator+(c32 a, c32 b) { return {a.x + b.x, a.y + b.y}; }
__device__ __forceinline__ c32 operator-(c32 a, c32 b) { return {a.x - b.x, a.y - b.y}; }
__device__ __forceinline__ c32 cmul(c32 a, c32 b) { return {a.x * b.x - a.y * b.y, a.x * b.y + a.y * b.x}; }
__device__ __forceinline__ constexpr float C32(int k) {
  switch (k) { case 0: return 1.f; case 1: return 0.98078528f; case 2: return 0.923879533f; case 3: return 0.831469612f; case 4: return 0.707106781f; case 5: return 0.555570233f; case 6: return 0.382683432f;
    case 7: return 0.195090322f; case 8: return 0.f; case 9: return -0.195090322f; case 10: return -0.382683432f; case 11: return -0.555570233f; case 12: return -0.707106781f; case 13: return -0.831469612f;
    case 14: return -0.923879533f; default: return -0.98078528f; } }
__device__ __forceinline__ constexpr float S32(int k) {
  switch (k) { case 0: return 0.f; case 1: return 0.195090322f; case 2: return 0.382683432f; case 3: return 0.555570233f; case 4: return 0.707106781f; case 5: return 0.831469612f; case 6: return 0.923879533f;
    case 7: return 0.98078528f; case 8: return 1.f; case 9: return 0.98078528f; case 10: return 0.923879533f; case 11: return 0.831469612f; case 12: return 0.707106781f; case 13: return 0.555570233f;
    case 14: return 0.382683432f; default: return 0.195090322f; } }
__device__ __forceinline__ constexpr int brev(int q, int bits) {
  return bits == 4 ? (((q & 1) << 3) | ((q & 2) << 1) | ((q & 4) >> 1) | ((q & 8) >> 3))
                   : (((q & 1) << 4) | ((q & 2) << 2) | (q & 4) | ((q & 8) >> 2) | ((q & 16) >> 4)); }
__device__ __forceinline__ int phys(int p) { return p + (p >> 5); }
template <int R, int HALF, bool INV> struct DftStage {
  static __device__ __forceinline__ void run(c32 (&x)[R]) {
#pragma unroll
    for (int blk = 0; blk < R; blk += 2 * HALF) {
#pragma unroll
      for (int j = 0; j < HALF; ++j) {
        const c32 a = x[blk + j], b = x[blk + j + HALF]; x[blk + j] = a + b; const c32 d = a - b;
        const int e = j * (R / (2 * HALF)) * (32 / R);
        if (e == 0) x[blk + j + HALF] = d;
        else if (e == 8) x[blk + j + HALF] = INV ? (c32){-d.y, d.x} : (c32){d.y, -d.x};
        else { const c32 wv = {C32(e), INV ? S32(e) : -S32(e)}; x[blk + j + HALF] = cmul(d, wv); }
      } }
    DftStage<R, HALF / 2, INV>::run(x);
  }
};
template <int R, bool INV> struct DftStage<R, 0, INV> { static __device__ __forceinline__ void run(c32 (&)[R]) {} };
template <int R, bool INV> __device__ __forceinline__ void dft_pow2(c32 (&x)[R]) { DftStage<R, R / 2, INV>::run(x); }
template <int R, int HALF> struct DitStage {
  static __device__ __forceinline__ void run(c32 (&x)[R]) {
#pragma unroll
    for (int blk = 0; blk < R; blk += 2 * HALF) {
#pragma unroll
      for (int j = 0; j < HALF; ++j) {
        const int e = j * (R / (2 * HALF)) * (32 / R);
        const c32 a = x[blk + j], b0 = x[blk + j + HALF];
        c32 b;
        if (e == 0) b = b0; else if (e == 8) b = (c32){-b0.y, b0.x}; else b = cmul(b0, (c32){C32(e), S32(e)});
        x[blk + j] = a + b; x[blk + j + HALF] = a - b;
      } }
    DitStage<R, HALF * 2>::run(x);
  }
};
template <int R> struct DitStage<R, R> { static __device__ __forceinline__ void run(c32 (&)[R]) {} };
template <int R> __device__ __forceinline__ void idft_dit(c32 (&x)[R]) { DitStage<R, 1>::run(x); }
template <int STRIDE, bool INV> __device__ __forceinline__ void pass16(c32* buf, int e0, float rev) {
  float rv = rev; asm volatile("" : "+v"(rv));
  const float cs = __builtin_amdgcn_cosf(rv), sn = __builtin_amdgcn_sinf(rv);
  const c32 w1 = {cs, INV ? sn : -sn};
  c32* p = buf + phys(e0); constexpr int PS = STRIDE + STRIDE / 32;
  c32 x[16];
  if (!INV) {
#pragma unroll
    for (int m = 0; m < 16; ++m) x[m] = p[PS * m];
    dft_pow2<16, false>(x);
    c32 w = w1; p[0] = x[0];
#pragma unroll
    for (int q = 1; q < 16; ++q) { p[PS * q] = cmul(x[brev(q, 4)], w); w = cmul(w, w1); }
  } else {
    c32 w = w1; x[0] = p[0];
#pragma unroll
    for (int q = 1; q < 16; ++q) { x[q] = cmul(p[PS * q], w); w = cmul(w, w1); }
    dft_pow2<16, true>(x);
#pragma unroll
    for (int m = 0; m < 16; ++m) p[PS * m] = x[brev(m, 4)];
  }
}
template <int MODE> __device__ __forceinline__ void mid32(c32* buf, h2* Hs, int j) {
  c32* p = buf + 33 * j; c32 x[32];
#pragma unroll
  for (int m = 0; m < 32; ++m) x[m] = p[m];
  dft_pow2<32, false>(x);
  if (MODE == 0) {
#pragma unroll
    for (int q = 0; q < 32; ++q) { const c32 v = x[brev(q, 5)]; Hs[q * 256 + j] = (h2){(_Float16)v.x, (_Float16)v.y}; }
  } else {
#pragma unroll
    for (int pp = 0; pp < 32; ++pp) { const h2 hv = Hs[brev(pp, 5) * 256 + j]; x[pp] = cmul(x[pp], (c32){(float)hv.x, (float)hv.y}); }
    idft_dit<32>(x);
#pragma unroll
    for (int m = 0; m < 32; ++m) p[m] = x[m];
  }
}
__device__ __forceinline__ void fwd2(c32* buf, int tid) {
  __syncthreads(); pass16<512, false>(buf, tid, (float)tid * (1.0f / 8192.0f));
  __syncthreads(); pass16<32, false>(buf, (tid >> 5) * 512 + (tid & 31), (float)(tid & 31) * (1.0f / 512.0f));
  __syncthreads();
}
__device__ __forceinline__ void conv(c32* buf, h2* Hs, int tid) {
  fwd2(buf, tid);
  if (tid < 256) mid32<1>(buf, Hs, tid);
  __syncthreads(); pass16<32, true>(buf, (tid >> 5) * 512 + (tid & 31), (float)(tid & 31) * (1.0f / 512.0f));
  __syncthreads(); pass16<512, true>(buf, tid, (float)tid * (1.0f / 8192.0f));
  __syncthreads();
}
__device__ __forceinline__ void item(int c, const bf16_t* HYT, const float* HK, const float* hy_bias, bf16_t* HYO, char* lds) {
  c32* buf = (c32*)lds; h2* H0 = (h2*)(lds + 67584); h2* H1 = H0 + 8192;
  const int tid = TIDX;
#pragma unroll 1
  for (int o = 0; o < 2; ++o) {
    const float* kp = HK + ((size_t)o * 256 + c) * 8192;
#pragma unroll
    for (int i = 0; i < 16; ++i) { const int n = tid + 512 * i; buf[phys(n)] = (c32){kp[n], 0.f}; }
    fwd2(buf, tid);
    if (tid < 256) mid32<0>(buf, o ? H1 : H0, tid);
    __syncthreads();
  }
  const float bias0 = hy_bias[c], bias1 = hy_bias[256 + c];
#pragma unroll 1
  for (int pr = 0; pr < 2; ++pr) {
    const bf16_t* v0 = HYT + ((size_t)(2 * pr) * 768 + c) * SEQ; const bf16_t* v1 = v0 + (size_t)768 * SEQ;
    c32 vv[8];
#pragma unroll
    for (int i = 0; i < 8; ++i) { const int t = tid + 512 * i; vv[i] = (c32){bf2f(v0[t]), bf2f(v1[t])}; buf[phys(t)] = vv[i]; buf[phys(t + 4096)] = (c32){0.f, 0.f}; }
    conv(buf, H0, tid);
#pragma unroll
    for (int i = 0; i < 8; ++i) { const int t = tid + 512 * i; const c32 y = buf[phys(t)];
      vv[i] = (c32){bf2f(v0[(size_t)256 * SEQ + t]) * (y.x * (1.0f / 8192.0f) + bias0 * vv[i].x), bf2f(v1[(size_t)256 * SEQ + t]) * (y.y * (1.0f / 8192.0f) + bias0 * vv[i].y)};
      buf[phys(t)] = vv[i]; buf[phys(t + 4096)] = (c32){0.f, 0.f}; }
    conv(buf, H1, tid);
#pragma unroll
    for (int i = 0; i < 8; ++i) { const int t = tid + 512 * i; const c32 y = buf[phys(t)];
      HYO[((size_t)(2 * pr) * 256 + c) * SEQ + t] = (bf16_t)f2bf(bf2f(v0[(size_t)512 * SEQ + t]) * (y.x * (1.0f / 8192.0f) + bias1 * vv[i].x));
      HYO[((size_t)(2 * pr + 1) * 256 + c) * SEQ + t] = (bf16_t)f2bf(bf2f(v1[(size_t)512 * SEQ + t]) * (y.y * (1.0f / 8192.0f) + bias1 * vv[i].y)); }
    __syncthreads();
  }
}
__device__ __forceinline__ void out_items4(int it0, int step, int nitems, const bf16_t* HYO, bf16_t* MIX, char* lds) {
  bf16_t (*T)[64][72] = (bf16_t (*)[64][72])lds;
  const int tid = TIDX;
  { const int cc = tid >> 3, t8 = (tid & 7) * 8; u32x4 v[4];
#pragma unroll
    for (int k = 0; k < 4; ++k) { const int it = it0 + k * step, itc = it < nitems ? it : it0, b = itc >> 8, t0 = ((itc >> 2) & 63) * 64, c0 = (itc & 3) * 64;
      v[k] = *(const u32x4*)(HYO + ((size_t)b * 256 + c0 + cc) * SEQ + t0 + t8); }
#pragma unroll
    for (int k = 0; k < 4; ++k) *(u32x4*)&T[k][cc][t8] = v[k]; }
  __syncthreads();
  { const int tl = tid >> 3, c8 = (tid & 7) * 8;
#pragma unroll
    for (int k = 0; k < 4; ++k) { const int it = it0 + k * step; const int b = it >> 8, t0 = ((it >> 2) & 63) * 64, c0 = (it & 3) * 64; u32x4 o;
      o.x = (unsigned)T[k][c8][tl] | ((unsigned)T[k][c8 + 1][tl] << 16); o.y = (unsigned)T[k][c8 + 2][tl] | ((unsigned)T[k][c8 + 3][tl] << 16);
      o.z = (unsigned)T[k][c8 + 4][tl] | ((unsigned)T[k][c8 + 5][tl] << 16); o.w = (unsigned)T[k][c8 + 6][tl] | ((unsigned)T[k][c8 + 7][tl] << 16);
      if (it < nitems) *(u32x4*)(MIX + ((size_t)b * TPB + CTXL + t0 + tl) * DM + 768 + c0 + c8) = o; } }
  __syncthreads();
}
}

#define LAS __attribute__((address_space(3)))
#define XB_TMO      128
#define XB_XCNT(j)  (256  + 64 * (j))
#define XB_XSUB(j)  (1280 + 64 * (j))
#define XB_XGEN(j)  (2304 + 64 * (j))
#define XB_TOP      3328
#define XB_TOPGEN   3392
#define XCD_BAR_WORDS 3456
#define XB_SPIN_CAP (1u << 18)

__device__ __forceinline__ unsigned xb_ld(unsigned* p)              { return __hip_atomic_load(p, __ATOMIC_RELAXED, __HIP_MEMORY_SCOPE_AGENT); }
__device__ __forceinline__ unsigned xb_add(unsigned* p, unsigned v) { return __hip_atomic_fetch_add(p, v, __ATOMIC_RELAXED, __HIP_MEMORY_SCOPE_AGENT); }
__device__ __forceinline__ unsigned xb_xcc_id() { return (unsigned)__builtin_amdgcn_s_getreg((3 << 11) | 20) & 0xFu; }
#define XB_SPIN(cond, bar) do { unsigned _sp = 0; while (cond) { __builtin_amdgcn_s_sleep(1); \
    if ((++_sp & 255u) == 0u) { if (xb_ld(&(bar)[XB_TMO])) break; if (_sp > XB_SPIN_CAP) { atomicAdd(&(bar)[XB_TMO], 1u); break; } } } } while (0)

struct XcdBarrier {
    unsigned* bar; unsigned x;
    volatile LAS unsigned* st;
};

__device__ __forceinline__ XcdBarrier xcd_barrier_post(unsigned* bar, volatile LAS unsigned* st) {
    XcdBarrier b; b.bar = bar; b.x = xb_xcc_id(); b.st = st;
    if (threadIdx.x == 0) (void)xb_add(&bar[XB_XCNT(b.x)], 1u);
    return b;
}
__device__ __forceinline__ void xcd_barrier_complete(unsigned* bar, unsigned x, unsigned& nloc, unsigned& nx) {
    const unsigned G = gridDim.x * gridDim.y * gridDim.z;
    unsigned sum, cnt, mine, sp = 0u;
    for (;;) {
        sum = 0u; cnt = 0u; mine = 0u;
#pragma unroll
        for (unsigned j = 0; j < 16; ++j) { const unsigned c = xb_ld(&bar[XB_XCNT(j)]); sum += c; cnt += (c > 0u) ? 1u : 0u; mine = (j == x) ? c : mine; }
        if (sum == G) break;
        __builtin_amdgcn_s_sleep(1);
        if ((++sp & 255u) == 0u) { if (xb_ld(&bar[XB_TMO])) break; if (sp > XB_SPIN_CAP) { atomicAdd(&bar[XB_TMO], 1u); break; } }
    }
    nloc = mine > 0u ? mine : 1u; nx = cnt > 0u ? cnt : 1u;
}

__device__ __forceinline__ void xcd_barrier(const XcdBarrier& b) {
    asm volatile("s_waitcnt vmcnt(0)" ::: "memory");
    __syncthreads();
    if (threadIdx.x == 0) {
        unsigned* bar = b.bar;
        __builtin_amdgcn_s_waitcnt(0);
        unsigned nloc = b.st[0], nx = b.st[1];
        if (nloc == 0u) { xcd_barrier_complete(bar, b.x, nloc, nx); b.st[0] = nloc; b.st[1] = nx; }
        const unsigned old = xb_add(&bar[XB_XSUB(b.x)], 1u);
        const unsigned gen = old / nloc;
        if (old + 1u == (gen + 1u) * nloc) {
            __builtin_amdgcn_fence(__ATOMIC_RELEASE, "agent");
            asm volatile("s_waitcnt vmcnt(0)" ::: "memory");
            const unsigned og = xb_add(&bar[XB_TOP], 1u);
            const unsigned tg = og / nx;
            if (og + 1u == (tg + 1u) * nx) xb_add(&bar[XB_TOPGEN], 1u);
            else XB_SPIN(xb_ld(&bar[XB_TOPGEN]) == tg, bar);
            __builtin_amdgcn_fence(__ATOMIC_ACQUIRE, "agent");
            xb_add(&bar[XB_XGEN(b.x)], 1u);
            asm volatile("s_waitcnt vmcnt(0)" ::: "memory");
        } else {
            XB_SPIN(xb_ld(&bar[XB_XGEN(b.x)]) == gen, bar);
            __builtin_amdgcn_fence(__ATOMIC_ACQUIRE, "agent");
            asm volatile("s_waitcnt vmcnt(0)" ::: "memory");
        }
    }
    __syncthreads();
}


struct MP { const float* in[33]; float* out; unsigned char* ws; };
typedef const float* const __attribute__((address_space(4))) * kargs_t;
#define KARGS() ({ kargs_t k_ = (kargs_t)__builtin_amdgcn_kernarg_segment_ptr(); asm volatile("" : "+s"(k_)); k_; })
#define WSP(K, off) ((unsigned char*)(K)[34] + (off))

__global__ void __launch_bounds__(NT, 2) mega(MP P) {
  cg::grid_group grid = cg::this_grid();
  extern __shared__ __attribute__((aligned(16))) char lds[];
  volatile LAS unsigned* xst = (volatile LAS unsigned*)(lds + LDS_BYTES - 16);
  if (threadIdx.x < 2) xst[threadIdx.x] = 0u;
  __syncthreads();
  { kargs_t K = KARGS(); (void)xcd_barrier_post((unsigned*)WSP(K, WS_CTL) + CT_BAR, xst); }
#define XBAR_HERE() do { kargs_t Kb_ = KARGS(); XcdBarrier xb_; xb_.bar = (unsigned*)WSP(Kb_, WS_CTL) + CT_BAR; xb_.x = xb_xcc_id(); xb_.st = (volatile LAS unsigned*)(lds + LDS_BYTES - 16); xcd_barrier(xb_); } while (0)
#define SEAM() XBAR_HERE()
  {
    kargs_t K = KARGS();
    st_adaln(K[1], K[3], K[4], K[5], (float*)WSP(K, WS_MODV), lds);
    st_rope((float*)WSP(K, WS_ROPE));
  }
  {
      kargs_t K = KARGS();
      st_weights(K[8], K[26], K[29], K[30], K[31], 0, (bf16_t*)WSP(K, WS_WIN), (bf16_t*)WSP(K, WS_WOUT), (bf16_t*)WSP(K, WS_WGU), (bf16_t*)WSP(K, WS_WD), lds);
    }
    { kargs_t K = KARGS(); const int bid = BIDX, G = GDIM;
      for (int it = bid; it < SEQ / 16; it += G) hyfilt_item<SEQ>(it, K[19] + 0 * 33 * 64, K[20] + 0 * 64, K[21] + 0 * 64, K[22] + 0 * 4096, K[23] + 0 * 64, K[24] + (size_t)0 * 65536, (float*)WSP(K, WS_HK), lds);
      for (int it = bid - 192; it >= 0 && it < CTXL / 16; it += G) hyfilt_item<CTXL>(it,       K[19] + 0 * 33 * 64, K[20] + 0 * 64, K[21] + 0 * 64, K[22] + 0 * 4096, K[23] + 0 * 64, K[24] + (size_t)0 * 65536, (float*)WSP(K, WS_HKC), lds);
    }
  if (gridDim.x == 0x7fffffffu) grid.sync();
  XBAR_HERE();
#pragma nounroll
  for (int layer = 0; layer < 2; ++layer) {
    const bool last = layer == 1;
    if (layer == 1) {
    {
      kargs_t K = KARGS();
      st_weights(K[8], K[26], K[29], K[30], K[31], layer, (bf16_t*)WSP(K, WS_WIN), (bf16_t*)WSP(K, WS_WOUT), (bf16_t*)WSP(K, WS_WGU), (bf16_t*)WSP(K, WS_WD), lds);
    }
    { kargs_t K = KARGS(); const int bid = BIDX, G = GDIM;
      for (int it = bid; it < SEQ / 16; it += G) hyfilt_item<SEQ>(it, K[19] + layer * 33 * 64, K[20] + layer * 64, K[21] + layer * 64, K[22] + layer * 4096, K[23] + layer * 64, K[24] + (size_t)layer * 65536, (float*)WSP(K, WS_HK), lds);
      if (!last) for (int it = bid; it < CTXL / 16; it += G) hyfilt_item<CTXL>(it, K[19] + layer * 33 * 64, K[20] + layer * 64, K[21] + layer * 64, K[22] + layer * 4096, K[23] + layer * 64, K[24] + (size_t)layer * 65536, (float*)WSP(K, WS_HKC), lds);
    }
    }
    { kargs_t K = KARGS();
      st_normmod(K[0], K[2], (bf16_t*)WSP(K, WS_H), layer == 0 ? (const bf16_t*)nullptr : (const bf16_t*)WSP(K, WS_H2S), (const int*)WSP(K, WS_MOEM + 768 * 1024),
                 (const float*)WSP(K, WS_MODV) + 5120, K[6] + layer * 1024, (const float*)WSP(K, WS_MODV) + (size_t)layer * 5 * 6144, 0, 1024, (bf16_t*)K[33], lds);
    }
    SEAM();
    {
      kargs_t K = KARGS();
      pg8::Gemm g{1024, 1024, 1024}; SchedDense S{MTOK / 256, NPAD / 256, (int)GDIM, BIDX, 0, (const char*)K[33], (const char*)WSP(K, WS_WIN), (size_t)256 * 1024 * 2, (size_t)256 * 1024 * 2, 0};
      EpiInProj E{(bf16_t*)WSP(K, WS_QK), (bf16_t*)WSP(K, WS_VZ), (bf16_t*)WSP(K, WS_XBC), (bf16_t*)WSP(K, WS_HY), (float*)WSP(K, WS_DT)};
      pg8::gemm_phase<EpiInProj, SchedDense, true, true>((PG8_LAS unsigned char*)lds, g, S, E);
      if (IN_HALF) { S.part = 1; pg8::gemm_phase<EpiInProj, SchedDense, true, true, true>((PG8_LAS unsigned char*)lds, g, S, E); }
    }
    SEAM();
    {
      kargs_t K = KARGS();
      st_prep_qk((bf16_t*)WSP(K, WS_QK), K[9] + layer * 64, K[10] + layer * 64, (const float*)WSP(K, WS_ROPE));
    }
    { kargs_t K = KARGS();
      st_prep_hy((const bf16_t*)WSP(K, WS_HY), K[17] + layer * 3 * 768, K[18] + layer * 768, (bf16_t*)WSP(K, WS_HYT), last ? 0 : 1, lds);
    }
    { kargs_t K = KARGS();
      st_ssd1(BIDX, GDIM, 4 * 34 * 6, (const bf16_t*)WSP(K, WS_XBC), (const float*)WSP(K, WS_DT), K[11] + layer * 3 * 640, K[12] + layer * 640, K[13] + layer * 12, K[14] + layer * 12,
              (bf16_t*)WSP(K, WS_Y), (bf16_t*)WSP(K, WS_ST), (float*)WSP(K, WS_DEC), lds);
    }
    SEAM();
    {
      { kargs_t K2 = KARGS(); st_ssd_scan2((bf16_t*)WSP(K2, WS_ST), (const float*)WSP(K2, WS_DEC)); }
      const int bid = BIDX, G = GDIM;
#define P4_ATT(bb, hq, qrow_, nt_) do { kargs_t K = KARGS(); const int kvh_ = (hq) / 3; \
          const attn_body::bf16* QKp = (const attn_body::bf16*)WSP(K, WS_QK); const attn_body::bf16* VZp = (const attn_body::bf16*)WSP(K, WS_VZ); \
          attn_body::attn_unit<8>(QKp + (size_t)(qrow_) * 512 + (hq) * 64, QKp + (size_t)(bb) * TPB * 512 + 384 + kvh_ * 64, VZp + (size_t)(bb) * TPB * 512 + kvh_ * 64, \
                                  (attn_body::bf16*)K[33] + (size_t)(qrow_) * 1024 + (hq) * 64, (nt_), lds); } while (0)
#define P4_FFT(cch) do { kargs_t K = KARGS(); hyf::item((cch), (const bf16_t*)WSP(K, WS_HYT), (const float*)WSP(K, WS_HK), K[25] + layer * 512, (bf16_t*)WSP(K, WS_HY), lds); } while (0)
      {
        const int x = bid & 7, y = bid >> 3, bb = x >> 1, kvh = x & 1;
        const int nun = y < 16 ? 2 : 1, natt = nun + ((!last && y < 3) ? 1 : 0);
#pragma unroll 1
        for (int k = 0; k < natt; ++k) { int hq, qrow, nt;
          if (k < nun) { const int v = y < 16 ? y + 16 * k : 16 + y; hq = 3 * kvh + (v >> 4); qrow = bb * TPB + CTXL + (v & 15) * 256; nt = TPB / 64; }
          else { hq = 3 * kvh + y; qrow = bb * TPB; nt = CTXL / 64; }
          P4_ATT(bb, hq, qrow, nt); }
        if (y >= 16) {
#pragma unroll 1
          for (int k = 0; k < 2; ++k) { const int cch = ((y - 16) * 8 + x) * 2 + k; P4_FFT(cch); } }
      }
      (void)G;
#undef P4_ATT
#undef P4_FFT
    }
    SEAM();
    {
      kargs_t K = KARGS();
      { const int bid = BIDX, G = GDIM, nit = last ? 4 * 32 * 2 : 4 * 34 * 2;
        for (int it = bid; it < nit; it += G) { const int g = it & 1, bc = it >> 1; const int b = last ? bc >> 5 : bc / 34, cidx = last ? 2 + (bc & 31) : bc % 34;
          ssd3_item(b, cidx, g, (const bf16_t*)WSP(K, WS_XBC), (const bf16_t*)WSP(K, WS_VZ), (const float*)WSP(K, WS_DT), K[11] + layer * 3 * 640, K[12] + layer * 640, K[13] + layer * 12, K[14] + layer * 12,
                    K[15] + layer * 6, K[16] + layer * 384, (const bf16_t*)WSP(K, WS_Y), (const bf16_t*)WSP(K, WS_ST), (bf16_t*)K[33], lds); } }
      if (!last) { const int bid = BIDX, G = GDIM;
        for (int it = bid - 16; it >= 0 && it < 128; it += G) hyconv_ctx_item(it, (const bf16_t*)WSP(K, WS_HYT) + (size_t)4 * 768 * SEQ, (const float*)WSP(K, WS_HKC), K[25] + layer * 512, (bf16_t*)K[33], lds); }
      { const int bid = BIDX, G = GDIM; for (int it = bid; it < 1024; it += 4 * G) hyf::out_items4(it, G, 1024, (const bf16_t*)WSP(K, WS_HY), (bf16_t*)K[33], lds); }
      const int t = TIDX; if (BIDX == 0 && t < 256) ((int*)WSP(K, WS_CTL))[t] = 0;
      { int* stok = (int*)WSP(K, WS_MOEM + 384 * 1024); for (int i = BIDX * NT + t; i < MOE_ROWS; i += GDIM * NT) stok[i] = -1; }
    }
    SEAM();
    {
      kargs_t K = KARGS();
      pg8::Gemm g{1024, 1024, 1024}; SchedDense S{last ? 64 : 68, 4, (int)GDIM, BIDX, last ? 1 : 0, (const char*)K[33], (const char*)WSP(K, WS_WOUT), (size_t)256 * 1024 * 2, (size_t)256 * 1024 * 2, 0};
      EpiOutProj E{(bf16_t*)WSP(K, WS_QK)};
      pg8::gemm_phase<EpiOutProj, SchedDense, true, true>((PG8_LAS unsigned char*)lds, g, S, E);
      S.part = 1; pg8::gemm_phase<EpiOutProj, SchedDense, true, true, true>((PG8_LAS unsigned char*)lds, g, S, E);
    }
    SEAM();
    {
      kargs_t K = KARGS();
      st_router(K[0], K[2], layer == 0 ? 1 : 0, (bf16_t*)WSP(K, WS_H), (const bf16_t*)WSP(K, WS_QK), K[7] + layer * 1024, (const float*)WSP(K, WS_MODV) + (size_t)layer * 5 * 6144, K[27], K[28], (bf16_t*)K[33], (int*)WSP(K, WS_CTL),
                (int*)WSP(K, WS_MOEM), (float*)WSP(K, WS_MOEM + 128 * 1024), last ? 1 : 0, lds);
    }
    SEAM();
    { kargs_t K = KARGS();
      st_moe_gather((const bf16_t*)K[33], (bf16_t*)WSP(K, WS_H2S), (int*)WSP(K, WS_CTL), (const int*)WSP(K, WS_MOEM), (const float*)WSP(K, WS_MOEM + 128 * 1024),
                    (int*)WSP(K, WS_MOEM + 384 * 1024), (float*)WSP(K, WS_MOEM + 512 * 1024), (int*)WSP(K, WS_MOEM + 768 * 1024), last ? 1 : 0, lds);
    }
    SEAM();
    { kargs_t K = KARGS();
      pg8::Gemm g{1024, 1024, 1024}; SchedMoe S{(int)GDIM, BIDX, 1, (const int*)WSP(K, WS_CTL), (const char*)WSP(K, WS_H2S), (size_t)256 * 1024 * 2, (const char*)WSP(K, WS_WGU), 0};
      EpiMoe1 E{(bf16_t*)WSP(K, WS_ACT), (const float*)WSP(K, WS_MOEM + 512 * 1024)};
      pg8::gemm_phase<EpiMoe1, SchedMoe, true, true>((PG8_LAS unsigned char*)lds, g, S, E);
      S.tail = 1; pg8::gemm_phase<EpiMoe1, SchedMoe, true, true, true>((PG8_LAS unsigned char*)lds, g, S, E);
    }
    SEAM();
    { kargs_t K = KARGS();
      pg8::Gemm g{256, 512, 256}; SchedMoe S{(int)GDIM, BIDX, 2, (const int*)WSP(K, WS_CTL), (const char*)WSP(K, WS_ACT), (size_t)256 * 512 * 2, (const char*)WSP(K, WS_WD), 0};
      EpiMoe2 E{(bf16_t*)WSP(K, WS_H2S)};
      pg8::gemm_phase<EpiMoe2, SchedMoe, true, true>((PG8_LAS unsigned char*)lds, g, S, E);
      S.tail = 1; pg8::gemm_phase<EpiMoe2, SchedMoe, true, true, true>((PG8_LAS unsigned char*)lds, g, S, E);
    }
    SEAM();
  }
  { kargs_t K = KARGS(); st_final((float*)K[33], K[32], (const bf16_t*)WSP(K, WS_H), (const bf16_t*)WSP(K, WS_H2S), (const int*)WSP(K, WS_MOEM + 768 * 1024), (const float*)WSP(K, WS_MODV) + (size_t)5 * 6144 + 5120); }
}

extern "C" void kernel_launch(void* const* d_in, const int* in_sizes, int n_in, void* d_out, int out_size, void* d_ws, size_t ws_size, hipStream_t stream) {
  if (n_in != 33 || ws_size < WS_END) { fprintf(stderr, "kernel_launch: unexpected n_in %d / ws %zu\n", n_in, ws_size); return; }
  static int grid_blocks = 0;
  if (!grid_blocks) {
    int dev = 0, cus = 0, per_cu = 0;
    (void)hipGetDevice(&dev);
    (void)hipDeviceGetAttribute(&cus, hipDeviceAttributeMultiprocessorCount, dev);
    (void)hipFuncSetAttribute((const void*)mega, hipFuncAttributeMaxDynamicSharedMemorySize, LDS_BYTES);
    (void)hipOccupancyMaxActiveBlocksPerMultiprocessor(&per_cu, mega, NT, LDS_BYTES);
    if (per_cu < 1) per_cu = 1;
    if (per_cu > 2) per_cu = 2;
    grid_blocks = 256;
    if (cus != 256 || per_cu < 1) fprintf(stderr, "kernel_launch: expected 256 CUs with >= 1 workgroup each (got %d CUs, %d per CU)\n", cus, per_cu);
  }
  (void)hipMemsetAsync((char*)d_ws + WS_CTL + (size_t)CT_BAR * 4, 0, (size_t)XCD_BAR_WORDS * 4, stream);
  MP p{};
  for (int i = 0; i < 33; ++i) p.in[i] = (const float*)d_in[i];
  p.out = (float*)d_out; p.ws = (unsigned char*)d_ws;
  void* args[] = {&p};
  hipError_t e = hipLaunchCooperativeKernel((const void*)mega, dim3(grid_blocks), dim3(NT), args, LDS_BYTES, stream);
  if (e != hipSuccess) fprintf(stderr, "cooperative launch failed: %s (grid %d)\n", hipGetErrorString(e), grid_blocks);
}
```

```cpp
#include <hip/hip_runtime.h>
#include <hip/hip_cooperative_groups.h>
#include <cstdio>
#include <cstdint>
namespace cg = cooperative_groups;

typedef unsigned short bf16_t;
typedef short bf16x8 __attribute__((ext_vector_type(8)));
typedef float f32x4 __attribute__((ext_vector_type(4)));
typedef unsigned u32x4 __attribute__((ext_vector_type(4)));
typedef unsigned u32x2 __attribute__((ext_vector_type(2)));

constexpr int NB = 4, SEQ = 4096, CTXL = 256, DM = 1024, TPB = 4352, MTOK = NB * TPB;
constexpr int DIN = 2444, NPAD = 2560;
constexpr float EPS = 1e-6f;
constexpr float C2 = 0.125f * 1.4426950408889634f;
constexpr int MOE_ROWS = 23552;
constexpr int NT = 512;
constexpr int LDS_BYTES = 147456;

constexpr size_t MiB = 1u << 20;
constexpr size_t WS_CTL = 0;
constexpr size_t WS_MODV = 1 * MiB;
constexpr size_t WS_ROPE = 2 * MiB;
constexpr size_t WS_MOEM = 3 * MiB;
constexpr size_t WS_DT = 4 * MiB;
constexpr size_t WS_HKC = 5 * MiB;
constexpr size_t WS_XC = 6 * MiB;
constexpr size_t WS_WIN = 10 * MiB;
constexpr size_t WS_WOUT = 15 * MiB;
constexpr size_t WS_WGU = 17 * MiB;
constexpr size_t WS_WD = 33 * MiB;
constexpr size_t WS_HK = 41 * MiB;
constexpr size_t WS_H = 57 * MiB;
constexpr size_t WS_QK = 91 * MiB;
constexpr size_t WS_VZ = 108 * MiB;
constexpr size_t WS_XBC = 125 * MiB;
constexpr size_t WS_HY = WS_XBC + (size_t)MTOK * 768 * 2;
constexpr size_t WS_HYT = WS_HY + (size_t)MTOK * 768 * 2;
constexpr size_t WS_ST = WS_HYT + (size_t)MTOK * 768 * 2;
constexpr size_t WS_Y = WS_ST + (size_t)4 * 34 * 2 * 6 * 4096 * 4;
constexpr size_t WS_END = WS_Y + (size_t)MTOK * 384 * 4;
constexpr size_t WS_DEC = WS_DT + 900 * 1024;
constexpr size_t WS_H2S = WS_QK;
constexpr size_t WS_ACT = WS_H2S + (size_t)MOE_ROWS * 1024 * 2;
static_assert(WS_END <= 256 * MiB, "ws");
static_assert(WS_ACT + (size_t)MOE_ROWS * 512 * 2 <= WS_HYT, "moe alias");

constexpr int CT_CNT = 0, CT_FILL = 32, CT_BASE = 64, CT_NT = 96, CT_TP = 128;
constexpr int CT_BAR = 4096;
constexpr bool IN_HALF = false;
constexpr int CT_CNTB = 8192;

__device__ __forceinline__ int opq_v(int v) { asm volatile("" : "+v"(v)); return v; }
__device__ __forceinline__ int opq_s(int v) { asm volatile("" : "+s"(v)); return v; }
#define TIDX opq_v((int)threadIdx.x)
#define BIDX opq_s((int)blockIdx.x)
#define GDIM opq_s((int)gridDim.x)
typedef float f32x2_t __attribute__((ext_vector_type(2)));
typedef __bf16 bf16x2_t __attribute__((ext_vector_type(2)));
__device__ __forceinline__ unsigned pk2bf(float lo, float hi) { const bf16x2_t v = __builtin_convertvector((f32x2_t){lo, hi}, bf16x2_t); return __builtin_bit_cast(unsigned, v); }
__device__ __forceinline__ unsigned f2bf(float f) { const __bf16 b = (__bf16)f; return (unsigned)__builtin_bit_cast(unsigned short, b); }
__device__ __forceinline__ float bf2f(bf16_t h) { return __uint_as_float(((unsigned)h) << 16); }
__device__ __forceinline__ float wave_sum(float v) {
  v += __int_as_float(__builtin_amdgcn_update_dpp(0, __float_as_int(v), 0xB1, 0xf, 0xf, false));
  v += __int_as_float(__builtin_amdgcn_update_dpp(0, __float_as_int(v), 0x4E, 0xf, 0xf, false));
  v += __int_as_float(__builtin_amdgcn_update_dpp(0, __float_as_int(v), 0x141, 0xf, 0xf, false));
  v += __int_as_float(__builtin_amdgcn_update_dpp(0, __float_as_int(v), 0x140, 0xf, 0xf, false));
  const float r0 = __uint_as_float(__builtin_amdgcn_readlane(__float_as_uint(v), 0)), r1 = __uint_as_float(__builtin_amdgcn_readlane(__float_as_uint(v), 16));
  const float r2 = __uint_as_float(__builtin_amdgcn_readlane(__float_as_uint(v), 32)), r3 = __uint_as_float(__builtin_amdgcn_readlane(__float_as_uint(v), 48));
  return (r0 + r1) + (r2 + r3);
}
__device__ __forceinline__ float dpp_xor1(float v) { return __int_as_float(__builtin_amdgcn_update_dpp(0, __float_as_int(v), 0xB1, 0xf, 0xf, false)); }
__device__ __forceinline__ float dpp_xor2(float v) { return __int_as_float(__builtin_amdgcn_update_dpp(0, __float_as_int(v), 0x4E, 0xf, 0xf, false)); }
__device__ __forceinline__ float dpp_xor4(float v) { const int h = __builtin_amdgcn_update_dpp(0, __float_as_int(v), 0x141, 0xf, 0xf, false); return __int_as_float(__builtin_amdgcn_update_dpp(0, h, 0x1B, 0xf, 0xf, false)); }
__device__ __forceinline__ float dpp_xor8(float v) { return __int_as_float(__builtin_amdgcn_update_dpp(0, __float_as_int(v), 0x128, 0xf, 0xf, false)); }
__device__ __forceinline__ void lds_bar() { asm volatile("s_waitcnt lgkmcnt(0)\n\ts_barrier" ::: "memory"); }
__device__ __forceinline__ float siluf(float v) { return v * __builtin_amdgcn_rcpf(1.0f + __expf(-v)); }
__device__ __forceinline__ float* xrow(const float* xl, const float* xc, int r) {
  const int b = r / TPB, j = r - b * TPB;
  return (float*)(j < CTXL ? xc + ((size_t)b * CTXL + j) * DM : xl + ((size_t)b * SEQ + (j - CTXL)) * DM);
}
__device__ __forceinline__ int mrow_of(int r) { const int b = r / TPB, j = r - b * TPB; return j < CTXL ? 4 : b; }

__device__ __forceinline__ void st_adaln(const float* c, const float* c_ctx, const float* w_mod, const float* b_mod, float* modv, char* lds) {
  float (*sc)[1024] = (float (*)[1024])lds;
  float (*red)[5][64] = (float (*)[5][64])(lds + 5 * 1024 * 4);
  const int tid = TIDX;
  for (int it = BIDX; it < 192; it += GDIM) {
    const int layer = it / 96, n0 = (it % 96) * 64;
#pragma unroll
    for (int i = tid; i < 5 * 1024; i += NT) { const int r = i >> 10, k = i & 1023; const float v = r < 4 ? c[r * 1024 + k] : c_ctx[k]; sc[r][k] = siluf(v); }
    __syncthreads();
    const int kg = tid >> 6, n = tid & 63;
    float acc[5] = {0.f, 0.f, 0.f, 0.f, 0.f};
    const unsigned voff = (unsigned)kg * 6144u + (unsigned)n;
#pragma unroll 1
    for (int k0 = 0; k0 < 1024; k0 += 256) { float wv[32];
#pragma unroll
      for (int j = 0; j < 32; ++j) { const float* bj = w_mod + ((size_t)layer * 1024 + k0 + 8 * j) * 6144 + n0; asm volatile("" : "+s"(bj)); wv[j] = bj[voff]; }
#pragma unroll
      for (int j = 0; j < 32; ++j) { const int k = k0 + 8 * j + kg;
#pragma unroll
        for (int r = 0; r < 5; ++r) acc[r] += sc[r][k] * wv[j]; } }
#pragma unroll
    for (int r = 0; r < 5; ++r) red[kg][r][n] = acc[r];
    __syncthreads();
    if (tid < 320) { const int r = tid >> 6, nn = tid & 63; float s = 0.f;
#pragma unroll
      for (int g = 0; g < 8; ++g) s += red[g][r][nn];
      modv[((size_t)layer * 5 + r) * 6144 + n0 + nn] = s + b_mod[layer * 6144 + n0 + nn]; }
    __syncthreads();
  }
}
__device__ __forceinline__ void st_rope(float* rope) {
  for (int i = BIDX * NT + TIDX; i < 4096 * 32; i += GDIM * NT) {
    const int t = i >> 5, d = i & 31, m = d & 15;
    const float inv = exp2f(-(float)(2 * m) * (13.287712379549449f / 32.0f));
    const float pos = (float)(d < 16 ? (t >> 6) : (t & 63));
    float rev = pos * inv * 0.15915494309189535f; rev -= floorf(rev);
    rope[2 * i] = __builtin_amdgcn_cosf(rev); rope[2 * i + 1] = __builtin_amdgcn_sinf(rev);
  }
}

__device__ __forceinline__ void st_normmod(const float* xl, const float* xc, bf16_t* XB, const bf16_t* YS, const int* tok_slot, const float* gate_prev,
                                           const float* g, const float* modv_layer, int off_sh, int off_sc, bf16_t* H, char* lds) {
  float* mA = (float*)lds; float* mB = mA + 5 * 1024; float* mG = mB + 5 * 1024;
  const int tid = TIDX, lane = tid & 63, gw = BIDX * 8 + (tid >> 6), ngw = GDIM * 8;
  { f32x4 g4[3], sc4[3], sh4[3], gp4[3];
#pragma unroll
    for (int i = 0; i < 3; ++i) { const int q = tid + NT * i, qc = q < 1280 ? q : 0, m = qc >> 8, k = (qc & 255) * 4;
      g4[i] = *(const f32x4*)(g + k); sc4[i] = *(const f32x4*)(modv_layer + (size_t)m * 6144 + off_sc + k); sh4[i] = *(const f32x4*)(modv_layer + (size_t)m * 6144 + off_sh + k);
      gp4[i] = YS ? *(const f32x4*)(gate_prev + (size_t)m * 6144 + k) : (f32x4){0.f, 0.f, 0.f, 0.f}; }
#pragma unroll
    for (int i = 0; i < 3; ++i) { const int q = tid + NT * i;
      if (q < 1280) { *(f32x4*)(mA + 4 * q) = g4[i] * ((f32x4){1.f, 1.f, 1.f, 1.f} + sc4[i]); *(f32x4*)(mB + 4 * q) = sh4[i]; *(f32x4*)(mG + 4 * q) = gp4[i]; } } }
  __syncthreads();
  int ts[3] = {0, 0, 0};
  if (YS) {
#pragma unroll
    for (int u = 0; u < 3; ++u) { const int r = gw + u * ngw; ts[u] = tok_slot[r < MTOK ? r : MTOK - 1]; } }
  for (int rb = gw; rb < MTOK; rb += 3 * ngw) {
    f32x4 v[3][4]; float rstd[3];
    if (!YS) {
#pragma unroll
      for (int u = 0; u < 3; ++u) { const int r = rb + u * ngw, rc = r < MTOK ? r : MTOK - 1; const float* xr = xrow(xl, xc, rc);
#pragma unroll
        for (int j = 0; j < 4; ++j) v[u][j] = *(const f32x4*)(xr + 4 * lane + 256 * j); }
#pragma unroll
      for (int u = 0; u < 3; ++u) { const int r = rb + u * ngw;
        if (r < MTOK) {
#pragma unroll
          for (int j = 0; j < 4; ++j) { u32x2 w; w.x = pk2bf(v[u][j].x, v[u][j].y); w.y = pk2bf(v[u][j].z, v[u][j].w); *(u32x2*)(XB + (size_t)r * DM + 4 * lane + 256 * j) = w; } } }
    } else {
      u32x2 xb[3][4], ys[3][4];
#pragma unroll
      for (int u = 0; u < 3; ++u) { const int r = rb + u * ngw, rc = r < MTOK ? r : MTOK - 1; const bf16_t* xr = XB + (size_t)rc * DM; const bf16_t* yr = YS + (size_t)ts[u] * DM;
#pragma unroll
        for (int j = 0; j < 4; ++j) { xb[u][j] = *(const u32x2*)(xr + 4 * lane + 256 * j); ys[u][j] = *(const u32x2*)(yr + 4 * lane + 256 * j); } }
#pragma unroll
      for (int u = 0; u < 3; ++u) { const int r = rb + 3 * ngw + u * ngw; ts[u] = tok_slot[r < MTOK ? r : MTOK - 1]; }
#pragma unroll
      for (int u = 0; u < 3; ++u) { const int r = rb + u * ngw, rc = r < MTOK ? r : MTOK - 1; const int mo = mrow_of(rc) * 1024;
#pragma unroll
        for (int j = 0; j < 4; ++j) { const int k = 4 * lane + 256 * j; const f32x4 g4 = *(const f32x4*)(mG + mo + k);
          const f32x4 x4 = (f32x4){__uint_as_float(xb[u][j].x << 16), __uint_as_float(xb[u][j].x & 0xffff0000u), __uint_as_float(xb[u][j].y << 16), __uint_as_float(xb[u][j].y & 0xffff0000u)};
          const f32x4 m4 = (f32x4){__uint_as_float(ys[u][j].x << 16), __uint_as_float(ys[u][j].x & 0xffff0000u), __uint_as_float(ys[u][j].y << 16), __uint_as_float(ys[u][j].y & 0xffff0000u)};
          v[u][j] = x4 + g4 * m4;
          if (r < MTOK) { u32x2 w; w.x = pk2bf(v[u][j].x, v[u][j].y); w.y = pk2bf(v[u][j].z, v[u][j].w); *(u32x2*)(XB + (size_t)r * DM + k) = w; } } }
    }
#pragma unroll
    for (int u = 0; u < 3; ++u) { float ss = 0.f;
#pragma unroll
      for (int j = 0; j < 4; ++j) ss += v[u][j].x * v[u][j].x + v[u][j].y * v[u][j].y + v[u][j].z * v[u][j].z + v[u][j].w * v[u][j].w;
      rstd[u] = rsqrtf(wave_sum(ss) * (1.0f / DM) + EPS); }
#pragma unroll
    for (int u = 0; u < 3; ++u) { const int r = rb + u * ngw;
      if (r < MTOK) { const int mo = mrow_of(r) * 1024;
#pragma unroll
        for (int j = 0; j < 4; ++j) { const int k = 4 * lane + 256 * j;
          const f32x4 a4 = *(const f32x4*)(mA + mo + k), b4 = *(const f32x4*)(mB + mo + k); const f32x4 o = v[u][j] * rstd[u] * a4 + b4;
          u32x2 w; w.x = pk2bf(o.x, o.y); w.y = pk2bf(o.z, o.w);
          *(u32x2*)(H + (size_t)r * DM + k) = w; } } }
  }
  __syncthreads();
}

template <int MODE> __device__ __forceinline__ void tr_wave_item(const float* src, const float* src2, int ldsrc, int K, bf16_t* out, int n0, int k0, float* scr, int lane) {
  const int nn = lane & 31, n = n0 + nn;
  float v[32];
  { const int col = MODE == 0 ? (n < 1676 ? n : (n < 1792 ? -1 : n - 116)) : (MODE == 1 ? n : (n >> 1)); const float* sp = (MODE == 2 && (n & 1)) ? src2 : src;
    const float* p0 = sp + (size_t)(k0 + (lane >> 5)) * ldsrc + (col >= 0 ? col : 0);
#pragma unroll
    for (int i = 0; i < 32; ++i) v[i] = p0[(size_t)(2 * i) * ldsrc];
#pragma unroll
    for (int i = 0; i < 32; ++i) scr[(2 * i + (lane >> 5)) * 33 + nn] = col >= 0 ? v[i] : 0.f; }
  asm volatile("s_waitcnt lgkmcnt(0)" ::: "memory");
  const int c = lane & 7;
#pragma unroll
  for (int j = 0; j < 4; ++j) { const int nr = (lane >> 3) + 8 * j; const float* sp = scr + (8 * c) * 33 + nr;
    u32x4 o; o.x = f2bf(sp[0]) | (f2bf(sp[33]) << 16); o.y = f2bf(sp[66]) | (f2bf(sp[99]) << 16); o.z = f2bf(sp[132]) | (f2bf(sp[165]) << 16); o.w = f2bf(sp[198]) | (f2bf(sp[231]) << 16);
    *(u32x4*)(out + (size_t)(n0 + nr) * K + k0 + 8 * c) = o; }
  asm volatile("s_waitcnt lgkmcnt(0)" ::: "memory");
}
__device__ __forceinline__ void st_weights(const float* w_in, const float* w_out, const float* w_gate, const float* w_up, const float* w_down, int layer,
                                           bf16_t* WIN, bf16_t* WOUT, bf16_t* WGU, bf16_t* WD, char* lds) {
  const int tid = TIDX, lane = tid & 63, w = tid >> 6; float* scr = (float*)lds + w * (64 * 33);
  for (int it = BIDX * 8 + w; it < 7936; it += GDIM * 8) {
    if (it < 1280) tr_wave_item<0>(w_in + (size_t)layer * 1024 * DIN, nullptr, DIN, 1024, WIN, (it % 80) * 32, (it / 80) * 64, scr, lane);
    else if (it < 1792) { const int i2 = it - 1280; tr_wave_item<1>(w_out + (size_t)layer * 1024 * 1024, nullptr, 1024, 1024, WOUT, (i2 & 31) * 32, (i2 >> 5) * 64, scr, lane); }
    else if (it < 5888) { const int i2 = it - 1792, e = i2 >> 8, t = i2 & 255;
      tr_wave_item<2>(w_gate + ((size_t)layer * 16 + e) * 1024 * 256, w_up + ((size_t)layer * 16 + e) * 1024 * 256, 256, 1024, WGU + (size_t)e * 512 * 1024, (t & 15) * 32, (t >> 4) * 64, scr, lane); }
    else { const int i2 = it - 5888, e = i2 >> 7, t = i2 & 127;
      tr_wave_item<1>(w_down + ((size_t)layer * 16 + e) * 256 * 1024, nullptr, 1024, 256, WD + (size_t)e * 1024 * 256, (t & 31) * 32, (t >> 5) * 64, scr, lane); }
  }
  __syncthreads();
}

__device__ __forceinline__ void pair_experts(int pidx, int& eA, int& eB) {
  const int g = pidx / 6, t = pidx - 6 * g; const int i = t < 3 ? 0 : (t < 5 ? 1 : 2); const int j = t < 3 ? t + 1 : (t < 5 ? t - 1 : 3);
  eA = 4 * g + i; eB = 4 * g + j;
}
__device__ __forceinline__ void st_prep_qk(bf16_t* QK, const float* qn, const float* kn, const float* rope) {
  if (BIDX < 48) return;
  const int lane = TIDX & 63, gw = (BIDX - 48) * 8 + (TIDX >> 6), ngw = (GDIM - 48) * 8, hh = lane >> 3, sub = lane & 7;
  float gn[8];
#pragma unroll
  for (int e = 0; e < 8; ++e) gn[e] = ((hh < 6 ? qn : kn) + sub * 8)[e] * (hh < 6 ? C2 : 1.0f);
  bf16x8 nraw[3]; f32x4 nrp[3][4];
#define PQ_LOAD(rb_) do { _Pragma("unroll") for (int u = 0; u < 3; ++u) { const int r_ = (rb_) + u * ngw < MTOK ? (rb_) + u * ngw : MTOK - 1; const int j_ = r_ % TPB, t_ = j_ >= CTXL ? j_ - CTXL : 0; \
      nraw[u] = *(const bf16x8*)(QK + (size_t)r_ * 512 + hh * 64 + sub * 8); const float* rp_ = rope + ((size_t)t_ * 32 + (sub & 3) * 8) * 2; \
      _Pragma("unroll") for (int q = 0; q < 4; ++q) nrp[u][q] = *(const f32x4*)(rp_ + 4 * q); } } while (0)
  PQ_LOAD(gw);
  for (int rb = gw; rb < MTOK; rb += 3 * ngw) {
    bf16x8 raw[3]; f32x4 rp4[3][4];
#pragma unroll
    for (int u = 0; u < 3; ++u) { raw[u] = nraw[u];
#pragma unroll
      for (int q = 0; q < 4; ++q) rp4[u][q] = nrp[u][q]; }
    if (rb + 3 * ngw < MTOK) PQ_LOAD(rb + 3 * ngw);
#pragma unroll
    for (int u = 0; u < 3; ++u) { const int r = rb + u * ngw; const int j = (r < MTOK ? r : MTOK - 1) % TPB;
      float v[8]; float ss = 0.f;
#pragma unroll
      for (int e = 0; e < 8; ++e) { v[e] = bf2f((bf16_t)raw[u][e]); ss += v[e] * v[e]; }
      ss += __shfl_xor(ss, 1); ss += __shfl_xor(ss, 2); ss += __shfl_xor(ss, 4);
      const float rstd = rsqrtf(ss * (1.0f / 64.0f) + EPS);
#pragma unroll
      for (int e = 0; e < 8; ++e) v[e] = v[e] * rstd * gn[e];
      if (j >= CTXL) {
#pragma unroll
        for (int e = 0; e < 8; ++e) { const float other = __shfl_xor(v[e], 4); const float cs = rp4[u][e >> 1][(e & 1) * 2], sn = rp4[u][e >> 1][(e & 1) * 2 + 1]; v[e] = sub < 4 ? v[e] * cs - other * sn : v[e] * cs + other * sn; } }
      if (r < MTOK) *(u32x4*)(QK + (size_t)r * 512 + hh * 64 + sub * 8) = (u32x4){pk2bf(v[0], v[1]), pk2bf(v[2], v[3]), pk2bf(v[4], v[5]), pk2bf(v[6], v[7])}; }
  }
}

__device__ __forceinline__ void st_prep_hy(const bf16_t* HY, const float* cw, const float* cb, bf16_t* HYT, int do_ctx, char* lds) {
  const int tid = TIDX, lane = tid & 63, w = tid >> 6; float* tile = (float*)lds + w * (66 * 33);
  const int nlat = 4 * 64 * 24, nitem = nlat + (do_ctx ? 4 * 4 * 24 : 0), step = (GDIM - 48) * 8;
  bf16x8 raw[5];
#define PHY_DECODE(it) int b, tt, ct, L, joff; bf16_t* outb; \
    if ((it) < nlat) { b = (it) / 1536; tt = ((it) % 1536) / 24; ct = (it) % 24; L = SEQ; joff = CTXL; outb = HYT + (size_t)b * 768 * SEQ; } \
    else { const int i2 = (it) - nlat; b = i2 / 96; tt = (i2 % 96) / 24; ct = i2 % 24; L = CTXL; joff = 0; outb = HYT + (size_t)4 * 768 * SEQ + (size_t)b * 768 * CTXL; } \
    const int t0 = tt * 64, c0 = ct * 32; (void)outb;
#define PHY_LOADS(it) do { PHY_DECODE(it) _Pragma("unroll") for (int i = 0; i < 5; ++i) { const int rr = (lane >> 2) + 16 * i, c8 = (lane & 3) * 8; int t = t0 - 1 + rr; const bool ok = rr < 66 && t >= 0 && t < L; t = ok ? t : t0; \
      const bf16x8 v = *(const bf16x8*)(HY + ((size_t)b * TPB + joff + t) * 768 + c0 + c8); raw[i] = ok ? v : (bf16x8){0, 0, 0, 0, 0, 0, 0, 0}; } \
    { const int c = c0 + (lane & 31); wq[0] = cw[c]; wq[1] = cw[768 + c]; wq[2] = cw[1536 + c]; wq[3] = cb[c]; } } while (0)
  float wq[4];
  int it = BIDX >= 48 ? (BIDX - 48) * 8 + w : nitem;
  if (it < nitem) PHY_LOADS(it);
  for (; it < nitem; it += step) {
    PHY_DECODE(it)
#pragma unroll
    for (int i = 0; i < 5; ++i) { const int rr = (lane >> 2) + 16 * i, c8 = (lane & 3) * 8;
      if (rr < 66) {
#pragma unroll
        for (int e = 0; e < 8; ++e) tile[rr * 33 + c8 + e] = bf2f((bf16_t)raw[i][e]); } }
    asm volatile("s_waitcnt lgkmcnt(0)" ::: "memory");
    const float wc0 = wq[0], wc1 = wq[1], wc2 = wq[2], wc3 = wq[3];
    if (it + step < nitem) PHY_LOADS(it + step);
#pragma unroll
    for (int cc = 0; cc < 32; ++cc) { const int c = c0 + cc;
      const float k0 = __int_as_float(__builtin_amdgcn_readlane(__float_as_int(wc0), cc)), k1 = __int_as_float(__builtin_amdgcn_readlane(__float_as_int(wc1), cc));
      const float k2 = __int_as_float(__builtin_amdgcn_readlane(__float_as_int(wc2), cc)), kb = __int_as_float(__builtin_amdgcn_readlane(__float_as_int(wc3), cc));
      const float v = k0 * tile[lane * 33 + cc] + k1 * tile[(lane + 1) * 33 + cc] + k2 * tile[(lane + 2) * 33 + cc] + kb;
      outb[(size_t)c * L + t0 + lane] = (bf16_t)f2bf(v); }
    asm volatile("s_waitcnt lgkmcnt(0)" ::: "memory");
  }
#undef PHY_LOADS
#undef PHY_DECODE
  __syncthreads();
}

template <int L> __device__ __forceinline__ void hyfilt_item(int item, const float* w1, const float* b1, const float* fr, const float* w2, const float* b2, const float* w3, float* HK, char* lds) {
  float* F = (float*)lds; float* W1 = F + 64 * 37; float* H1 = W1 + 36 * 68; float* W2 = H1 + 64 * 68; float* S1 = W2 + 64 * 68;
  const int tid = TIDX, n0 = (item >> 2) * 64, cq = item & 3, lane = tid & 63, wv = tid >> 6, l15 = lane & 15, l4 = lane >> 4;
  for (int e = tid; e < 64 * 36; e += NT) { const int pp = e / 36, f = e % 36; const int n = n0 + pp; float v = 0.f;
    if (f == 0) v = (float)n * (1.0f / (float)(L - 1));
    else if (f < 33) { const int m = (f - 1) & 15; const float band = 1e-4f + (float)m * ((15.0f - 1e-4f) / 15.0f); float rev = ((float)n * (1.0f / (float)L)) * band; rev -= floorf(rev);
      v = f <= 16 ? __builtin_amdgcn_cosf(rev) : -__builtin_amdgcn_sinf(rev); }
    F[pp * 37 + f] = v; }
#pragma unroll
  for (int e = tid; e < 36 * 64; e += NT) { const int k = e >> 6, j = e & 63; W1[k * 68 + j] = k < 33 ? w1[k * 64 + j] : 0.f; }
#pragma unroll
  for (int e = tid; e < 64 * 64; e += NT) { const int k = e >> 6, j = e & 63; W2[k * 68 + j] = w2[e]; }
  __syncthreads();
  { const int pt = wv >> 1, c0 = 32 * (wv & 1);
    f32x4 acc[2] = {(f32x4){0.f, 0.f, 0.f, 0.f}, (f32x4){0.f, 0.f, 0.f, 0.f}};
#pragma unroll
    for (int kk = 0; kk < 9; ++kk) { const float av = F[(pt * 16 + l15) * 37 + 4 * kk + l4];
      acc[0] = __builtin_amdgcn_mfma_f32_16x16x4f32(av, W1[(4 * kk + l4) * 68 + c0 + l15], acc[0], 0, 0, 0);
      acc[1] = __builtin_amdgcn_mfma_f32_16x16x4f32(av, W1[(4 * kk + l4) * 68 + c0 + 16 + l15], acc[1], 0, 0, 0); }
#pragma unroll
    for (int ct = 0; ct < 2; ++ct) { const int j = c0 + 16 * ct + l15; const float bj = b1[j], fj = fr[j] * 0.15915494309189535f;
#pragma unroll
      for (int rg = 0; rg < 4; ++rg) { float rev = fj * (acc[ct][rg] + bj); rev -= floorf(rev); H1[(pt * 16 + 4 * l4 + rg) * 68 + j] = __builtin_amdgcn_sinf(rev); } } }
  __syncthreads();
  { const int pt = wv >> 1, c0 = 32 * (wv & 1);
    f32x4 acc[2] = {(f32x4){0.f, 0.f, 0.f, 0.f}, (f32x4){0.f, 0.f, 0.f, 0.f}};
#pragma unroll
    for (int kk = 0; kk < 16; ++kk) { const float av = H1[(pt * 16 + l15) * 68 + 4 * kk + l4];
      acc[0] = __builtin_amdgcn_mfma_f32_16x16x4f32(av, W2[(4 * kk + l4) * 68 + c0 + l15], acc[0], 0, 0, 0);
      acc[1] = __builtin_amdgcn_mfma_f32_16x16x4f32(av, W2[(4 * kk + l4) * 68 + c0 + 16 + l15], acc[1], 0, 0, 0); }
#pragma unroll
    for (int ct = 0; ct < 2; ++ct) { const int j = c0 + 16 * ct + l15; const float bj = b2[j], fj = fr[j] * 0.15915494309189535f;
#pragma unroll
      for (int rg = 0; rg < 4; ++rg) { float rev = fj * (acc[ct][rg] + bj); rev -= floorf(rev); S1[(pt * 16 + 4 * l4 + rg) * 68 + j] = __builtin_amdgcn_sinf(rev); } } }
  __syncthreads();
  {
    const int colb = cq * 256 + 32 * wv;
    f32x4 acc[4][2];
#pragma unroll
    for (int pt = 0; pt < 4; ++pt) { acc[pt][0] = (f32x4){0.f, 0.f, 0.f, 0.f}; acc[pt][1] = (f32x4){0.f, 0.f, 0.f, 0.f}; }
#pragma unroll
    for (int kk = 0; kk < 16; ++kk) { const int k = 4 * kk + l4;
      const float bv0 = w3[k * 1024 + colb + l15], bv1 = w3[k * 1024 + colb + 16 + l15];
#pragma unroll
      for (int pt = 0; pt < 4; ++pt) { const float av = S1[(pt * 16 + l15) * 68 + k];
        acc[pt][0] = __builtin_amdgcn_mfma_f32_16x16x4f32(av, bv0, acc[pt][0], 0, 0, 0);
        acc[pt][1] = __builtin_amdgcn_mfma_f32_16x16x4f32(av, bv1, acc[pt][1], 0, 0, 0); } }
#pragma unroll
    for (int ct = 0; ct < 2; ++ct) { const int col = colb + 16 * ct + l15, dir = col >> 9, order = (col >> 8) & 1, c = col & 255;
      const float delta = 3.0701134573253943f + (float)c * ((15.350567286626972f - 3.0701134573253943f) / 255.0f);
      float* dst = HK + ((size_t)order * 256 + c) * (2 * L);
#pragma unroll
      for (int pt = 0; pt < 4; ++pt) { const int nb = n0 + pt * 16 + 4 * l4; f32x4 o;
#pragma unroll
        for (int rg = 0; rg < 4; ++rg) o[rg] = acc[pt][ct][rg] * __expf(-((float)(nb + rg) * (1.0f / (float)(L - 1))) * delta);
        if (dir == 0) *(f32x4*)(dst + nb) = o;
        else {
#pragma unroll
          for (int rg = 0; rg < 4; ++rg) { const int n = nb + rg; if (n >= 1) dst[2 * L - n] = o[rg]; else dst[L] = 0.f; } } } }
  }
  __syncthreads();
}

__device__ __forceinline__ void hyconv_ctx_item(int item, const bf16_t* HYTC, const float* HKC, const float* hy_bias, bf16_t* MIX, char* lds) {
  constexpr int L = CTXL;
  const int tid = TIDX, b = item >> 5, cc = tid >> 6, c = (item & 31) * 8 + cc, sub = tid & 63, tb = 4 * sub;
  float* kern = (float*)lds + cc * (2 * L); float* z = (float*)lds + 8 * 2 * L + cc * L; bf16_t* ob = (bf16_t*)((float*)lds + 8 * 2 * L + 8 * L);
  const bf16_t* vp = HYTC + ((size_t)b * 768 + c) * L;
  const u32x2 x1r = *(const u32x2*)(vp + (size_t)256 * L + tb), x2r = *(const u32x2*)(vp + (size_t)512 * L + tb);
  { float zr[4];
#pragma unroll
    for (int i = 0; i < 4; ++i) zr[i] = bf2f(vp[sub + 64 * i]);
#pragma unroll
    for (int i = 0; i < 4; ++i) z[sub + 64 * i] = zr[i]; }
#pragma unroll 1
  for (int o = 0; o < 2; ++o) {
    const float* kp = HKC + ((size_t)o * 256 + c) * (2 * L);
    { float kr[8];
#pragma unroll
      for (int i = 0; i < 8; ++i) kr[i] = kp[sub + 64 * i];
#pragma unroll
      for (int i = 0; i < 8; ++i) kern[sub + 64 * i] = kr[i]; }
    const float bias = hy_bias[o * 256 + c];
    lds_bar();
    float acc[4], W[12];
#pragma unroll
    for (int i = 0; i < 4; ++i) { acc[i] = 0.f; W[8 + i] = kern[tb + i]; }
    for (int s0 = 0; s0 < L; s0 += 8) {
      const int bb = (tb - s0 - 8) & (2 * L - 1), bb2 = (bb + 4) & (2 * L - 1);
#pragma unroll
      for (int i = 0; i < 4; ++i) { W[i] = kern[bb + i]; W[4 + i] = kern[bb2 + i]; }
      float zs[8];
#pragma unroll
      for (int j = 0; j < 8; ++j) zs[j] = z[s0 + j];
#pragma unroll
      for (int j = 0; j < 8; ++j)
#pragma unroll
        for (int i = 0; i < 4; ++i) acc[i] += W[8 + i - j] * zs[j];
#pragma unroll
      for (int i = 0; i < 4; ++i) W[8 + i] = W[i];
    }
    lds_bar();
#pragma unroll
    for (int i = 0; i < 4; ++i) { const int t = tb + i; const float zz = acc[i] + bias * z[t]; const unsigned xw = o == 0 ? (i < 2 ? x1r.x : x1r.y) : (i < 2 ? x2r.x : x2r.y);
      const float xv = (i & 1) ? __uint_as_float(xw & 0xffff0000u) : __uint_as_float(xw << 16);
      if (o == 0) z[t] = xv * zz; else ob[t * 8 + cc] = (bf16_t)f2bf(xv * zz); }
    lds_bar();
  }
  if (tid < L) *(u32x4*)(MIX + ((size_t)b * TPB + tid) * DM + 768 + (item & 31) * 8) = *(const u32x4*)(ob + tid * 8);
  lds_bar();
}

__device__ __forceinline__ void ssd_conv8(const bf16_t* XBC, size_t r, int c0, bool hasp, bool hasn, const float* cw, const float* cb, float (&o)[8]) {
  const bf16x8 cur = *(const bf16x8*)(XBC + r * 768 + c0);
  const bf16x8 prv = *(const bf16x8*)(XBC + (hasp ? r - 1 : r) * 768 + c0), nxt = *(const bf16x8*)(XBC + (hasn ? r + 1 : r) * 768 + c0);
  const float wp = hasp ? 1.f : 0.f, wn = hasn ? 1.f : 0.f;
#pragma unroll
  for (int e = 0; e < 8; ++e) { const float v = wp * cw[c0 + e] * bf2f((bf16_t)prv[e]) + cw[640 + c0 + e] * bf2f((bf16_t)cur[e]) + wn * cw[1280 + c0 + e] * bf2f((bf16_t)nxt[e]) + cb[c0 + e]; o[e] = siluf(v); }
}
__device__ __forceinline__ float softplusf(float x) {
  const float y = __expf(-fabsf(x)); const float l = y < 0.06f ? y * (1.f - y * (0.5f - y * (0.33333334f - 0.25f * y))) : __logf(1.f + y); return fmaxf(x, 0.f) + l; }
__device__ __forceinline__ void wave_scan128(float e0, float e1, int lane, float& c0, float& c1) {
  float x = e0 + e1;
#pragma unroll
  for (int o = 1; o < 64; o <<= 1) { const float v = __shfl_up(x, o); if (lane >= o) x += v; }
  const float excl = x - (e0 + e1); c0 = excl + e0; c1 = excl + e0 + e1;
}
__device__ __forceinline__ int ssd_chunk_j0(int cidx) { return cidx < 2 ? cidx * 128 : CTXL + (cidx - 2) * 128; }

__device__ __forceinline__ void st_ssd1(int it0, int step, int nitems, const bf16_t* XBC, const float* DT, const float* cw, const float* cb, const float* dt_bias, const float* a_log,
                                        bf16_t* YIN, bf16_t* ST, float* DEC, char* lds) {
  bf16_t (*Cm)[72] = (bf16_t (*)[72])lds; bf16_t (*Bm)[72] = (bf16_t (*)[72])(lds + 18432);
  bf16_t (*Xs)[72] = (bf16_t (*)[72])(lds + 36864); bf16_t (*Mm)[136] = (bf16_t (*)[136])(lds + 71680);
  typedef short v4i16_l __attribute__((ext_vector_type(4)));
  typedef __attribute__((address_space(3))) v4i16_l* las_v4;
#define S1_TR8(dst, arr, k0_, ct_) do { const int ln_ = TIDX & 63, gg_ = ln_ >> 4, ii_ = ln_ & 15; const bf16_t* p_ = &(arr)[(k0_) + 8 * gg_ + (ii_ >> 2)][16 * (ct_) + 4 * (ii_ & 3)]; \
    const v4i16_l r0_ = __builtin_amdgcn_ds_read_tr16_b64_v4i16((las_v4)p_), r1_ = __builtin_amdgcn_ds_read_tr16_b64_v4i16((las_v4)(p_ + 4 * 72)); \
    dst = (bf16x8){r0_[0], r0_[1], r0_[2], r0_[3], r1_[0], r1_[1], r1_[2], r1_[3]}; } while (0)
  float* tab = (float*)(lds + 106496); float* dtf = tab; float* dtb = tab + 128; float* acf = tab + 256; float* acb = tab + 384; float* wf = tab + 512; float* wb = tab + 640;
  const int tid = TIDX;
  bf16x8 cu[6], pv[6], nx[6];
#define SSD1_LOADS(itm, I0, I1, XO) do { const int h_ = (itm) % 6, bc_ = (itm) / 6, cidx_ = bc_ % 34, b_ = bc_ / 34, g_ = h_ / 3, j0_ = ssd_chunk_j0(cidx_); const size_t r0_ = (size_t)b_ * TPB + j0_; \
    _Pragma("unroll") for (int i = (I0); i < (I1); ++i) if (!((XO) && i >= 2)) { const int task = tid + NT * i, t = (XO) ? task >> 3 : task / 24, cg = (XO) ? (task & 7) : task % 24, kind = cg >> 3, q = cg & 7, j = j0_ + t; \
      const int c0 = kind == 0 ? h_ * 64 + 8 * q : (kind == 1 ? 384 + g_ * 64 + 8 * q : 512 + g_ * 64 + 8 * q); \
      const bool hasp = j != 0 && j != CTXL, hasn = j != CTXL - 1 && j != TPB - 1; const bf16_t* p = XBC + (r0_ + t) * 768 + c0; \
      cu[i] = *(const bf16x8*)p; pv[i] = *(const bf16x8*)(p + (hasp ? -768 : 0)); nx[i] = *(const bf16x8*)(p + (hasn ? 768 : 0)); } } while (0)
  if (it0 < nitems) SSD1_LOADS(it0, 0, 6, false);
#pragma unroll 1
  for (int item = it0; item < nitems; item += step) {
  const int tid = TIDX, lane = tid & 63, w = tid >> 6, l15 = lane & 15, l4 = lane >> 4;
  const int h = item % 6, bc = item / 6, cidx = bc % 34, b = bc / 34, g = h / 3, j0 = ssd_chunk_j0(cidx);
  const size_t r0 = (size_t)b * TPB + j0;
  float dtr0 = 0.f, dtr1 = 0.f;
  if (w < 2) { const int t0 = w == 0 ? 2 * lane : 127 - 2 * lane, t1 = w == 0 ? 2 * lane + 1 : 126 - 2 * lane; dtr0 = DT[(r0 + t0) * 12 + w * 6 + h]; dtr1 = DT[(r0 + t1) * 12 + w * 6 + h]; }
  const bool reuse = item > it0 && (item / 3 == (item - 1) / 3);
  {
#pragma unroll
    for (int i = 0; i < 6; ++i) if (!(reuse && i >= 2)) { const int task = tid + NT * i, t = reuse ? task >> 3 : task / 24, cg = reuse ? (task & 7) : task % 24, kind = cg >> 3, q = cg & 7, j = j0 + t;
      const int c0 = kind == 0 ? h * 64 + 8 * q : (kind == 1 ? 384 + g * 64 + 8 * q : 512 + g * 64 + 8 * q);
      const float wp = (j != 0 && j != CTXL) ? 1.f : 0.f, wn = (j != CTXL - 1 && j != TPB - 1) ? 1.f : 0.f;
      float o[8];
#pragma unroll
      for (int e = 0; e < 8; ++e) o[e] = siluf(wp * cw[c0 + e] * bf2f((bf16_t)pv[i][e]) + cw[640 + c0 + e] * bf2f((bf16_t)cu[i][e]) + wn * cw[1280 + c0 + e] * bf2f((bf16_t)nx[i][e]) + cb[c0 + e]);
      const u32x4 pk = (u32x4){pk2bf(o[0], o[1]), pk2bf(o[2], o[3]), pk2bf(o[4], o[5]), pk2bf(o[6], o[7])};
      if (kind == 0) *(u32x4*)&Xs[t][8 * q] = pk; else if (kind == 1) *(u32x4*)&Bm[t][8 * q] = pk;
      else { *(u32x4*)&Cm[t][8 * q] = pk; *(u32x4*)(YIN + (size_t)MTOK * 384 + (((size_t)bc * 2 + g) * 128 + t) * 64 + 8 * q) = pk; } }
  }
  if (w < 2) { const int dir = w; const float a = -expf(a_log[dir * 6 + h]), bias = dt_bias[dir * 6 + h];
    const int t0 = dir == 0 ? 2 * lane : 127 - 2 * lane, t1 = dir == 0 ? 2 * lane + 1 : 126 - 2 * lane;
    const float d0 = softplusf(dtr0 + bias), d1 = softplusf(dtr1 + bias);
    float c0, c1; wave_scan128(d0 * a, d1 * a, lane, c0, c1);
    const float tot = __shfl(c1, 63);
    float* dtt = dir == 0 ? dtf : dtb; float* ac = dir == 0 ? acf : acb; float* ww = dir == 0 ? wf : wb;
    dtt[t0] = d0; dtt[t1] = d1; ac[t0] = c0; ac[t1] = c1; ww[t0] = __expf(tot - c0) * d0; ww[t1] = __expf(tot - c1) * d1;
    if (lane == 0) DEC[(((size_t)b * 34 + cidx) * 2 + dir) * 6 + h] = __expf(tot); }
  lds_bar();
  if (item + step < nitems) { const bool nreuse = (item + 1) / 3 == item / 3; SSD1_LOADS(item + step, 0, 6, nreuse); }
  {
    f32x4 accG[8];
#pragma unroll
    for (int ni = 0; ni < 8; ++ni) accG[ni] = (f32x4){0.f, 0.f, 0.f, 0.f};
#pragma unroll
    for (int kk = 0; kk < 2; ++kk) { const bf16x8 a = *(const bf16x8*)&Cm[16 * w + l15][32 * kk + 8 * l4];
#pragma unroll
      for (int ni = 0; ni < 8; ++ni) { const bf16x8 bb = *(const bf16x8*)&Bm[16 * ni + l15][32 * kk + 8 * l4]; accG[ni] = __builtin_amdgcn_mfma_f32_16x16x32_bf16(a, bb, accG[ni], 0, 0, 0); } }
    float aft[4], abt[4];
#pragma unroll
    for (int rg = 0; rg < 4; ++rg) { aft[rg] = acf[16 * w + 4 * l4 + rg]; abt[rg] = acb[16 * w + 4 * l4 + rg]; }
#pragma unroll
    for (int ni = 0; ni < 8; ++ni) { const int sidx = 16 * ni + l15; const float afs = acf[sidx], abs_ = acb[sidx], dfs = dtf[sidx], dbs = dtb[sidx];
#pragma unroll
      for (int rg = 0; rg < 4; ++rg) { const int t = 16 * w + 4 * l4 + rg;
        const bool lo = sidx <= t; const float ex = __expf(lo ? aft[rg] - afs : abt[rg] - abs_) * (lo ? dfs : dbs);
        Mm[t][sidx] = (bf16_t)f2bf(accG[ni][rg] * (sidx == t ? dfs + dbs : ex)); } }
  }
  lds_bar();
  {
    f32x4 acc[4];
#pragma unroll
    for (int ni = 0; ni < 4; ++ni) acc[ni] = (f32x4){0.f, 0.f, 0.f, 0.f};
#pragma unroll
    for (int kk = 0; kk < 4; ++kk) { const bf16x8 a = *(const bf16x8*)&Mm[16 * w + l15][32 * kk + 8 * l4];
#pragma unroll
      for (int ni = 0; ni < 4; ++ni) { bf16x8 bb; S1_TR8(bb, Xs, 32 * kk, ni); acc[ni] = __builtin_amdgcn_mfma_f32_16x16x32_bf16(a, bb, acc[ni], 0, 0, 0); } }
#pragma unroll
    for (int rg = 0; rg < 4; ++rg)
#pragma unroll
      for (int ni = 0; ni < 4; ++ni) YIN[(r0 + 16 * w + 4 * l4 + rg) * 384 + h * 64 + 16 * ni + l15] = (bf16_t)f2bf(acc[ni][rg]);
  }
  {
    const int dir = w >> 2, mt = w & 3; const float* ww = dir == 0 ? wf : wb;
    f32x4 acc[4];
#pragma unroll
    for (int ni = 0; ni < 4; ++ni) acc[ni] = (f32x4){0.f, 0.f, 0.f, 0.f};
#pragma unroll
    for (int kk = 0; kk < 4; ++kk) { bf16x8 raw; S1_TR8(raw, Xs, 32 * kk, mt);
      const f32x4 w0 = *(const f32x4*)(ww + 32 * kk + 8 * l4), w1 = *(const f32x4*)(ww + 32 * kk + 8 * l4 + 4);
      u32x4 pk; pk.x = pk2bf(bf2f((bf16_t)raw[0]) * w0.x, bf2f((bf16_t)raw[1]) * w0.y); pk.y = pk2bf(bf2f((bf16_t)raw[2]) * w0.z, bf2f((bf16_t)raw[3]) * w0.w);
      pk.z = pk2bf(bf2f((bf16_t)raw[4]) * w1.x, bf2f((bf16_t)raw[5]) * w1.y); pk.w = pk2bf(bf2f((bf16_t)raw[6]) * w1.z, bf2f((bf16_t)raw[7]) * w1.w);
      const bf16x8 a = __builtin_bit_cast(bf16x8, pk);
#pragma unroll
      for (int ni = 0; ni < 4; ++ni) { bf16x8 bb; S1_TR8(bb, Bm, 32 * kk, ni); acc[ni] = __builtin_amdgcn_mfma_f32_16x16x32_bf16(a, bb, acc[ni], 0, 0, 0); } }
    bf16_t* sp = ST + ((((size_t)b * 34 + cidx) * 2 + dir) * 6 + h) * 4096;
#pragma unroll
    for (int rg = 0; rg < 4; ++rg)
#pragma unroll
      for (int ni = 0; ni < 4; ++ni) sp[(16 * mt + 4 * l4 + rg) * 64 + 16 * ni + l15] = (bf16_t)f2bf(acc[ni][rg]);
  }
  lds_bar();
  }
#undef SSD1_LOADS
#undef S1_TR8
}

__device__ __forceinline__ void st_ssd_scan2(bf16_t* ST, const float* DEC) {
  for (int idx = BIDX * NT + TIDX; idx < 4 * 2 * 6 * 2048; idx += GDIM * NT) {
    const int e = (idx & 2047) * 2, bdh = idx >> 11, h = bdh % 6, dir = (bdh / 6) & 1, b = bdh / 12;
    unsigned v[34]; float d[34];
#pragma unroll
    for (int st = 0; st < 34; ++st) { const int cidx = dir == 0 ? st : (st < 2 ? 1 - st : 35 - st); const size_t o = (((size_t)b * 34 + cidx) * 2 + dir) * 6 + h; v[st] = *(const unsigned*)(ST + o * 4096 + e); d[st] = DEC[o]; }
    float H0 = 0.f, H1 = 0.f;
#pragma unroll
    for (int st = 0; st < 34; ++st) { const int cidx = dir == 0 ? st : (st < 2 ? 1 - st : 35 - st); const size_t o = (((size_t)b * 34 + cidx) * 2 + dir) * 6 + h;
      *(unsigned*)(ST + o * 4096 + e) = pk2bf(H0, H1); H0 = H0 * d[st] + __uint_as_float(v[st] << 16); H1 = H1 * d[st] + __uint_as_float(v[st] & 0xffff0000u); }
  }
}

__device__ __forceinline__ void ssd3_item(int b, int cidx, int g, const bf16_t* XBC, const bf16_t* VZ, const float* DT, const float* cw, const float* cb, const float* dt_bias, const float* a_log,
                                          const float* dskip, const float* nw, const bf16_t* YIN, const bf16_t* ST, bf16_t* MIX, char* lds) {
  bf16_t (*Cm)[72] = (bf16_t (*)[72])lds; bf16_t (*Hm)[72] = (bf16_t (*)[72])(lds + 18432);
  float* ef = (float*)(lds + 18432 + 55296);
  float (*Yt)[196] = (float (*)[196])lds;
  const int tid = TIDX, lane = tid & 63, w = tid >> 6, l15 = lane & 15, l4 = lane >> 4, j0 = ssd_chunk_j0(cidx);
  const size_t r0 = (size_t)b * TPB + j0;
#pragma unroll
  for (int i = 0; i < 2; ++i) { const int task = tid + NT * i, t = task >> 3, q = task & 7, j = j0 + t;
    (void)j; *(u32x4*)&Cm[t][8 * q] = *(const u32x4*)(YIN + (size_t)MTOK * 384 + (((size_t)(b * 34 + cidx) * 2 + g) * 128 + t) * 64 + 8 * q); }
#pragma unroll
  for (int i = 0; i < 6; ++i) { const int f8 = tid + NT * i, hd = f8 >> 9, rem = f8 & 511, p = rem >> 3, n8 = (rem & 7) * 8, hh = hd >> 1, dir = hd & 1;
    *(u32x4*)&Hm[hd * 64 + p][n8] = *(const u32x4*)(ST + ((((size_t)b * 34 + cidx) * 2 + dir) * 6 + 3 * g + hh) * 4096 + p * 64 + n8); }
  if (w < 6) { const int hh = w >> 1, dir = w & 1, h = 3 * g + hh; const float a = -expf(a_log[dir * 6 + h]), bias = dt_bias[dir * 6 + h];
    const int t0 = dir == 0 ? 2 * lane : 127 - 2 * lane, t1 = dir == 0 ? 2 * lane + 1 : 126 - 2 * lane;
    const float d0 = softplusf(DT[(r0 + t0) * 12 + dir * 6 + h] + bias), d1 = softplusf(DT[(r0 + t1) * 12 + dir * 6 + h] + bias);
    float c0, c1; wave_scan128(d0 * a, d1 * a, lane, c0, c1);
    ef[w * 128 + t0] = __expf(c0); ef[w * 128 + t1] = __expf(c1); }
  lds_bar();
  float yv[3][4][4];
  {
    bf16x8 ca[2];
#pragma unroll
    for (int kk = 0; kk < 2; ++kk) ca[kk] = *(const bf16x8*)&Cm[16 * w + l15][32 * kk + 8 * l4];
#pragma unroll
    for (int hh = 0; hh < 3; ++hh) {
      f32x4 accF[4], accB[4];
#pragma unroll
      for (int ni = 0; ni < 4; ++ni) { accF[ni] = (f32x4){0.f, 0.f, 0.f, 0.f}; accB[ni] = (f32x4){0.f, 0.f, 0.f, 0.f}; }
#pragma unroll
      for (int kk = 0; kk < 2; ++kk)
#pragma unroll
        for (int ni = 0; ni < 4; ++ni) {
          accF[ni] = __builtin_amdgcn_mfma_f32_16x16x32_bf16(ca[kk], *(const bf16x8*)&Hm[(hh * 2 + 0) * 64 + 16 * ni + l15][32 * kk + 8 * l4], accF[ni], 0, 0, 0);
          accB[ni] = __builtin_amdgcn_mfma_f32_16x16x32_bf16(ca[kk], *(const bf16x8*)&Hm[(hh * 2 + 1) * 64 + 16 * ni + l15][32 * kk + 8 * l4], accB[ni], 0, 0, 0); }
#pragma unroll
      for (int rg = 0; rg < 4; ++rg) { const int t = 16 * w + 4 * l4 + rg; const float eF = ef[(hh * 2 + 0) * 128 + t], eB = ef[(hh * 2 + 1) * 128 + t];
#pragma unroll
        for (int ni = 0; ni < 4; ++ni) yv[hh][ni][rg] = eF * accF[ni][rg] + eB * accB[ni][rg]; }
    }
  }
  lds_bar();
#pragma unroll
  for (int hh = 0; hh < 3; ++hh)
#pragma unroll
    for (int rg = 0; rg < 4; ++rg)
#pragma unroll
      for (int ni = 0; ni < 4; ++ni) Yt[16 * w + 4 * l4 + rg][hh * 64 + 16 * ni + l15] = yv[hh][ni][rg];
  lds_bar();
  {
    typedef unsigned u32x3a __attribute__((ext_vector_type(3))) __attribute__((aligned(4)));
    typedef float f32x2a __attribute__((ext_vector_type(2)));
    const int half = lane >> 5, c6 = 6 * (lane & 31);
    float cw0[6], cw1[6], cw2[6], cbv[6], nwv[6], dsk[6];
#pragma unroll
    for (int e = 0; e < 6; ++e) { const int col = g * 192 + c6 + e; cw0[e] = cw[col]; cw1[e] = cw[640 + col]; cw2[e] = cw[1280 + col]; cbv[e] = cb[col]; nwv[e] = nw[col]; dsk[e] = dskip[3 * g + ((c6 + e) >> 6)]; }
#pragma unroll 1
    for (int rb = 0; rb < 16; rb += 4) {
      u32x3a xc_[2], xp_[2], xn_[2], zz_[2], yy_[2];
#pragma unroll
      for (int u = 0; u < 2; ++u) { const int t = 16 * w + rb + 2 * u + half, j = j0 + t; const size_t r = r0 + t; const bool hasp = j != 0 && j != CTXL, hasn = j != CTXL - 1 && j != TPB - 1;
        const bf16_t* xq = XBC + r * 768 + g * 192 + c6;
        xc_[u] = *(const u32x3a*)xq; xp_[u] = *(const u32x3a*)(xq + (hasp ? -768 : 0)); xn_[u] = *(const u32x3a*)(xq + (hasn ? 768 : 0));
        yy_[u] = *(const u32x3a*)(YIN + r * 384 + g * 192 + c6); zz_[u] = *(const u32x3a*)(VZ + r * 512 + 128 + g * 192 + c6); }
#pragma unroll
      for (int u = 0; u < 2; ++u) { const int t = 16 * w + rb + 2 * u + half, j = j0 + t; const size_t r = r0 + t; const float wp = (j != 0 && j != CTXL) ? 1.f : 0.f, wn = (j != CTXL - 1 && j != TPB - 1) ? 1.f : 0.f;
        float yt[6];
#pragma unroll
        for (int q = 0; q < 3; ++q) { const f32x2a y2 = *(const f32x2a*)&Yt[t][c6 + 2 * q]; yt[2 * q] = y2.x; yt[2 * q + 1] = y2.y; }
        float gt[6]; float ss = 0.f;
#pragma unroll
        for (int e = 0; e < 6; ++e) { const unsigned sh = (e & 1) * 16; const int q = e >> 1;
          const unsigned wc_ = xc_[u][q], wq_ = xp_[u][q], wn_ = xn_[u][q], wz_ = zz_[u][q], wy_ = yy_[u][q];
          float xv = cw1[e] * bf2f((bf16_t)(wc_ >> sh)) + cbv[e] + wp * cw0[e] * bf2f((bf16_t)(wq_ >> sh)) + wn * cw2[e] * bf2f((bf16_t)(wn_ >> sh));
          xv = siluf(xv);
          const float y = bf2f((bf16_t)(wy_ >> sh)) + yt[e] + dsk[e] * xv;
          gt[e] = y * siluf(bf2f((bf16_t)(wz_ >> sh))); ss += gt[e] * gt[e]; }
        ss += __int_as_float(__builtin_amdgcn_update_dpp(0, __float_as_int(ss), 0xB1, 0xf, 0xf, false)); ss += __int_as_float(__builtin_amdgcn_update_dpp(0, __float_as_int(ss), 0x4E, 0xf, 0xf, false));
        ss += __int_as_float(__builtin_amdgcn_update_dpp(0, __float_as_int(ss), 0x141, 0xf, 0xf, false)); ss += __int_as_float(__builtin_amdgcn_update_dpp(0, __float_as_int(ss), 0x140, 0xf, 0xf, false));
        const float q0 = __uint_as_float(__builtin_amdgcn_readlane(__float_as_uint(ss), 0)), q1 = __uint_as_float(__builtin_amdgcn_readlane(__float_as_uint(ss), 16));
        const float q2 = __uint_as_float(__builtin_amdgcn_readlane(__float_as_uint(ss), 32)), q3 = __uint_as_float(__builtin_amdgcn_readlane(__float_as_uint(ss), 48));
        const float rstd = rsqrtf((half ? q2 + q3 : q0 + q1) * (1.0f / 192.0f) + EPS);
        u32x3a o; o.x = pk2bf(gt[0] * rstd * nwv[0], gt[1] * rstd * nwv[1]); o.y = pk2bf(gt[2] * rstd * nwv[2], gt[3] * rstd * nwv[3]); o.z = pk2bf(gt[4] * rstd * nwv[4], gt[5] * rstd * nwv[5]);
        *(u32x3a*)(MIX + r * DM + 384 + g * 192 + c6) = o; }
    }
  }
  lds_bar();
}

__device__ __forceinline__ void st_router(const float* xl, const float* xc, int from_inputs, bf16_t* XB, const bf16_t* MO, const float* g, const float* modv_layer, const float* w_router, const float* rbias,
                                          bf16_t* H2, int* ctl, int* tok_pair, float* tok_w, int skip_ctx, char* lds) {
  float* wl = (float*)lds;
  const int tid = TIDX, lane = tid & 63, gw = BIDX * 8 + (tid >> 6), ngw = GDIM * 8;
  int* hist = (int*)(lds + 81920);
  if (tid < 32) hist[tid] = 0;
  float* mA = (float*)(lds + 82176); float* mB = mA + 5 * 1024; float* mG = mB + 5 * 1024;
  { f32x4 g4[3], sc4[3], sh4[3], gp4[3], wr4[8];
#pragma unroll
    for (int i = 0; i < 3; ++i) { const int q = tid + NT * i, qc = q < 1280 ? q : 0, m = qc >> 8, k = (qc & 255) * 4;
      g4[i] = *(const f32x4*)(g + k); sc4[i] = *(const f32x4*)(modv_layer + (size_t)m * 6144 + 4096 + k); sh4[i] = *(const f32x4*)(modv_layer + (size_t)m * 6144 + 3072 + k);
      gp4[i] = *(const f32x4*)(modv_layer + (size_t)m * 6144 + 2048 + k); }
#pragma unroll
    for (int i = 0; i < 8; ++i) wr4[i] = *(const f32x4*)(w_router + (size_t)(tid + NT * i) * 4);
#pragma unroll
    for (int i = 0; i < 3; ++i) { const int q = tid + NT * i;
      if (q < 1280) { *(f32x4*)(mA + 4 * q) = g4[i] * ((f32x4){1.f, 1.f, 1.f, 1.f} + sc4[i]); *(f32x4*)(mB + 4 * q) = sh4[i]; *(f32x4*)(mG + 4 * q) = gp4[i]; } }
#pragma unroll
    for (int i = 0; i < 8; ++i) { const int idx = tid + NT * i, k = idx >> 2, e4 = idx & 3, row = ((k & 3) * 4 + (k >> 8)) * 64 + ((k & 255) >> 2);
      *(f32x4*)(wl + row * 20 + 4 * e4) = wr4[i]; } }
  __syncthreads();
  const float rbl = rbias[4 * (lane >> 4) + ((lane >> 2) & 3)];
  u32x2 nx[2][4], nm[2][4];
#define RT_LOAD(rb_) do { _Pragma("unroll") for (int u = 0; u < 2; ++u) { const int r_ = (rb_) + u * ngw, rc_ = r_ < MTOK ? r_ : MTOK - 1; \
      const bf16_t* xr_ = XB + (size_t)rc_ * DM + 4 * lane; const bf16_t* mr_ = MO + (size_t)rc_ * DM + 4 * lane; \
      _Pragma("unroll") for (int j = 0; j < 4; ++j) { nx[u][j] = *(const u32x2*)(xr_ + 256 * j); nm[u][j] = *(const u32x2*)(mr_ + 256 * j); } } } while (0)
  RT_LOAD(gw);
  for (int rb = gw; rb < MTOK; rb += 2 * ngw) {
    int rr[2]; bool act[2]; f32x4 v[2][4]; u32x2 mo[2][4]; float rstd[2]; int mo_[2];
#pragma unroll
    for (int u = 0; u < 2; ++u) { const int r = rb + u * ngw; rr[u] = r < MTOK ? r : MTOK - 1; act[u] = r < MTOK && !(skip_ctx && (rr[u] % TPB) < CTXL); mo_[u] = mrow_of(rr[u]) * 1024;
#pragma unroll
      for (int j = 0; j < 4; ++j) { const u32x2 t2 = nx[u][j]; mo[u][j] = nm[u][j];
        v[u][j] = (f32x4){__uint_as_float(t2.x << 16), __uint_as_float(t2.x & 0xffff0000u), __uint_as_float(t2.y << 16), __uint_as_float(t2.y & 0xffff0000u)}; } }
    if (rb + 2 * ngw < MTOK) RT_LOAD(rb + 2 * ngw);
    if (!act[0] && !act[1]) continue;
#pragma unroll
    for (int u = 0; u < 2; ++u) if (act[u]) { bf16_t* xd = XB + (size_t)rr[u] * DM;
#pragma unroll
      for (int j = 0; j < 4; ++j) { const int k = 4 * lane + 256 * j; const f32x4 g4 = *(const f32x4*)(mG + mo_[u] + k);
        const f32x4 m4 = (f32x4){__uint_as_float(mo[u][j].x << 16), __uint_as_float(mo[u][j].x & 0xffff0000u), __uint_as_float(mo[u][j].y << 16), __uint_as_float(mo[u][j].y & 0xffff0000u)};
        v[u][j] = v[u][j] + g4 * m4; u32x2 w2; w2.x = pk2bf(v[u][j].x, v[u][j].y); w2.y = pk2bf(v[u][j].z, v[u][j].w); *(u32x2*)(xd + k) = w2; } }
#pragma unroll
    for (int u = 0; u < 2; ++u) { float ss = 0.f;
#pragma unroll
      for (int j = 0; j < 4; ++j) ss += v[u][j].x * v[u][j].x + v[u][j].y * v[u][j].y + v[u][j].z * v[u][j].z + v[u][j].w * v[u][j].w;
      rstd[u] = rsqrtf(wave_sum(ss) * (1.0f / DM) + EPS); }
    float lg[2][16];
#pragma unroll
    for (int u = 0; u < 2; ++u)
#pragma unroll
      for (int e = 0; e < 16; ++e) lg[u][e] = 0.f;
#pragma unroll 1
    for (int j = 0; j < 4; ++j) { const int k = 4 * lane + 256 * j; float o[2][4];
#pragma unroll
      for (int u = 0; u < 2; ++u) { const f32x4 a4 = *(const f32x4*)(mA + mo_[u] + k), b4 = *(const f32x4*)(mB + mo_[u] + k); const f32x4 o4 = v[u][j] * rstd[u] * a4 + b4;
        o[u][0] = o4.x; o[u][1] = o4.y; o[u][2] = o4.z; o[u][3] = o4.w;
        if (act[u]) { u32x2 wpk; wpk.x = pk2bf(o4.x, o4.y); wpk.y = pk2bf(o4.z, o4.w); *(u32x2*)(H2 + (size_t)rr[u] * DM + k) = wpk; } }
#pragma unroll
      for (int q = 0; q < 4; ++q) { const float* wr_ = wl + ((q * 4 + j) * 64 + lane) * 20;
#pragma unroll
        for (int e4 = 0; e4 < 4; ++e4) { const f32x4 wr = *(const f32x4*)(wr_ + 4 * e4);
#pragma unroll
          for (int u = 0; u < 2; ++u) { lg[u][4 * e4] += o[u][q] * wr.x; lg[u][4 * e4 + 1] += o[u][q] * wr.y; lg[u][4 * e4 + 2] += o[u][q] * wr.z; lg[u][4 * e4 + 3] += o[u][q] * wr.w; } } } }
    float h1[2];
#pragma unroll
    for (int u = 0; u < 2; ++u) { float h8[8], h4[4], h2[2];
#pragma unroll
      for (int i = 0; i < 8; ++i) { const auto rr = __builtin_amdgcn_permlane32_swap(__float_as_uint(lg[u][i]), __float_as_uint(lg[u][8 + i]), false, false);
        h8[i] = __uint_as_float(rr[0]) + __uint_as_float(rr[1]); }
#pragma unroll
      for (int i = 0; i < 4; ++i) { const auto rr = __builtin_amdgcn_permlane16_swap(__float_as_uint(h8[i]), __float_as_uint(h8[4 + i]), false, false);
        h4[i] = __uint_as_float(rr[0]) + __uint_as_float(rr[1]); }
#pragma unroll
      for (int i = 0; i < 2; ++i) { const bool up = (lane & 8) != 0; const float keep = up ? h4[2 + i] : h4[i], give = up ? h4[i] : h4[2 + i]; h2[i] = keep + dpp_xor8(give); }
      { const bool up = (lane & 4) != 0; const float keep = up ? h2[1] : h2[0], give = up ? h2[0] : h2[1]; h1[u] = keep + dpp_xor4(give); }
      h1[u] += dpp_xor2(h1[u]); h1[u] += dpp_xor1(h1[u]); }
    const float sg0 = __builtin_amdgcn_rcpf(1.0f + __expf(-h1[0])), sg1 = __builtin_amdgcn_rcpf(1.0f + __expf(-h1[1]));
    int pidx_u[2]; float wa_u[2], wb_u[2];
#pragma unroll
    for (int u = 0; u < 2; ++u) { const float sc = u == 0 ? sg0 : sg1, sv = sc + rbl; const int ii = (lane >> 2) & 3;
      int rank = 0;
#define RT_RANK(k_, ctl_) do { const float so_ = __int_as_float(__builtin_amdgcn_update_dpp(0, __float_as_int(sv), (ctl_), 0xf, 0xf, false)); const int jj_ = (ii - (k_)) & 3; rank += ((so_ > sv) || (so_ == sv && jj_ < ii)) ? 1 : 0; } while (0)
      RT_RANK(1, 0x124); RT_RANK(2, 0x128); RT_RANK(3, 0x12c);
#undef RT_RANK
      const bool sel = rank < 2;
      float x = sel ? sv : 0.f;
      x += __int_as_float(__builtin_amdgcn_update_dpp(0, __float_as_int(x), 0x124, 0xf, 0xf, false));
      x += __int_as_float(__builtin_amdgcn_update_dpp(0, __float_as_int(x), 0x128, 0xf, 0xf, false));
      const float g0 = __uint_as_float(__builtin_amdgcn_readlane(__float_as_uint(x), 0)), g1 = __uint_as_float(__builtin_amdgcn_readlane(__float_as_uint(x), 16));
      const float g2 = __uint_as_float(__builtin_amdgcn_readlane(__float_as_uint(x), 32)), g3 = __uint_as_float(__builtin_amdgcn_readlane(__float_as_uint(x), 48));
      int best = 0; float bv = g0; if (g1 > bv) { bv = g1; best = 1; } if (g2 > bv) { bv = g2; best = 2; } if (g3 > bv) { bv = g3; best = 3; }
      const unsigned long long bal = __ballot(sel && (lane >> 4) == best);
      const unsigned mm = (unsigned)(bal >> (16 * best)) & 0x1111u;
      const int ia = (__ffs(mm) - 1) >> 2, ib = (__ffs(mm & ~(0xfu << (4 * ia))) - 1) >> 2;
      const float sa = __uint_as_float(__builtin_amdgcn_readlane(__float_as_uint(sc), 16 * best + 4 * ia)), sb = __uint_as_float(__builtin_amdgcn_readlane(__float_as_uint(sc), 16 * best + 4 * ib));
      const int tri = ia == 0 ? ib - 1 : (ia == 1 ? ib + 1 : 5); const float inv = 1.0f / (sa + sb);
      pidx_u[u] = best * 6 + tri; wa_u[u] = sa * inv; wb_u[u] = sb * inv; }
    const int us = lane >> 5;
    if ((lane & 31) == 0 && (us == 0 ? act[0] : act[1])) {
      const int r = us == 0 ? rr[0] : rr[1]; const int pidx = us == 0 ? pidx_u[0] : pidx_u[1];
      const int rank = atomicAdd(&hist[pidx], 1);
      tok_pair[r] = pidx | (rank << 5); tok_w[2 * r] = us == 0 ? wa_u[0] : wa_u[1]; tok_w[2 * r + 1] = us == 0 ? wb_u[0] : wb_u[1];
    }
  }
#undef RT_LOAD
  __syncthreads();
  if (tid < 32) ctl[CT_CNTB + BIDX * 32 + tid] = tid < 24 ? hist[tid] : 0;
}
__device__ __forceinline__ void st_moe_gather(const bf16_t* H2, bf16_t* H2S, int* ctl, const int* tok_pair, const float* tok_w, int* sorted_tok, float* sorted_w, int* tok_slot, int skip_ctx, char* lds) {
  int* sbase = (int*)lds; int* rtot = sbase + 32; int* rpre = rtot + 512;
  const int tid = TIDX, bid = BIDX;
  const int lane = tid & 63, gw = bid * 8 + (tid >> 6), ngw = GDIM * 8;
  u32x4 na0[3], na1[3]; int npk[3]; float nw0[3], nw1[3];
#define GT_LOAD(rb_) do { _Pragma("unroll") for (int u = 0; u < 3; ++u) { const int r_ = (rb_) + u * ngw; const bool a_ = r_ < MTOK && !(skip_ctx && (r_ % TPB) < CTXL); const int rc_ = a_ ? r_ : 0; \
      npk[u] = tok_pair[rc_]; nw0[u] = tok_w[2 * rc_]; nw1[u] = tok_w[2 * rc_ + 1]; const u32x4* sp_ = (const u32x4*)(H2 + (size_t)rc_ * DM); na0[u] = sp_[lane]; na1[u] = sp_[lane + 64]; } } while (0)
  GT_LOAD(gw);
  { const int p = tid & 31, seg = tid >> 5; int tot = 0, pre = 0;
#pragma unroll
    for (int i = 0; i < 16; ++i) { const int bb = seg * 16 + i; const int cv = ctl[CT_CNTB + bb * 32 + p]; tot += cv; pre += bb < bid ? cv : 0; }
    rtot[seg * 32 + p] = tot; rpre[seg * 32 + p] = pre; }
  __syncthreads();
  if (tid < 32) { int tot = 0, pre = 0;
#pragma unroll
    for (int sg = 0; sg < 16; ++sg) { tot += rtot[sg * 32 + tid]; pre += rpre[sg * 32 + tid]; }
    rtot[tid] = tot; rpre[tid] = pre; }
  __syncthreads();
  if (tid < 64) {
    const int p = tid, n = p < 24 ? rtot[p] : 0, tl = (n + 255) >> 8; int incl = tl;
#pragma unroll
    for (int o = 1; o < 32; o <<= 1) { const int v = __shfl_up(incl, o); if (p >= o) incl += v; }
    const int ntp = incl - tl, base = ntp * 256;
    if (p < 24) { sbase[p] = base + rpre[p];
      if (bid == 0) { ctl[CT_BASE + p] = base; for (int t = 0; t < tl; ++t) ctl[CT_TP + ntp + t] = p; } }
    if (p == 23 && bid == 0) { ctl[CT_BASE + 24] = incl * 256; ctl[CT_NT] = incl; } }
  __syncthreads();
  for (int rb = gw; rb < MTOK; rb += 3 * ngw) {
    u32x4 a0[3], a1[3]; int pk[3]; float w0[3], w1[3]; bool act[3];
#pragma unroll
    for (int u = 0; u < 3; ++u) { const int r = rb + u * ngw; act[u] = r < MTOK && !(skip_ctx && (r % TPB) < CTXL); pk[u] = npk[u]; w0[u] = nw0[u]; w1[u] = nw1[u]; a0[u] = na0[u]; a1[u] = na1[u]; }
    if (rb + 3 * ngw < MTOK) GT_LOAD(rb + 3 * ngw);
#pragma unroll
    for (int u = 0; u < 3; ++u) if (act[u]) { const int r = rb + u * ngw; const int slot = sbase[pk[u] & 31] + (pk[u] >> 5);
      if (lane == 0) { sorted_tok[slot] = r; tok_slot[r] = slot; sorted_w[2 * slot] = w0[u]; sorted_w[2 * slot + 1] = w1[u]; }
      u32x4* d = (u32x4*)(H2S + (size_t)slot * DM); d[lane] = a0[u]; d[lane + 64] = a1[u]; }
  }
#undef GT_LOAD
  __syncthreads();
}
__device__ __forceinline__ void st_final(float* out, const float* g, const bf16_t* XB, const bf16_t* YS, const int* tok_slot, const float* gate  ) {
  const int lane = TIDX & 63, gw = BIDX * 8 + (TIDX >> 6), ngw = GDIM * 8;
  f32x4 gg[4];
#pragma unroll
  for (int j = 0; j < 4; ++j) gg[j] = *(const f32x4*)(g + 4 * lane + 256 * j);
  int ts[4];
#pragma unroll
  for (int u = 0; u < 4; ++u) { const int r = gw + u * ngw, rc = r < NB * SEQ ? r : NB * SEQ - 1; ts[u] = tok_slot[(rc >> 12) * TPB + CTXL + (rc & 4095)]; }
  for (int rb = gw; rb < NB * SEQ; rb += 4 * ngw) {
    u32x2 xb[4][4], ys[4][4];
#pragma unroll
    for (int u = 0; u < 4; ++u) { const int r = rb + u * ngw, rc = r < NB * SEQ ? r : NB * SEQ - 1;
      const int bb = rc >> 12, tr = bb * TPB + CTXL + (rc & 4095); const bf16_t* xr = XB + (size_t)tr * DM; const bf16_t* yr = YS + (size_t)ts[u] * DM;
#pragma unroll
      for (int j = 0; j < 4; ++j) { xb[u][j] = *(const u32x2*)(xr + 4 * lane + 256 * j); ys[u][j] = *(const u32x2*)(yr + 4 * lane + 256 * j); } }
#pragma unroll
    for (int u = 0; u < 4; ++u) { const int r = rb + 4 * ngw + u * ngw, rc = r < NB * SEQ ? r : NB * SEQ - 1; ts[u] = tok_slot[(rc >> 12) * TPB + CTXL + (rc & 4095)]; }
#pragma unroll
    for (int u = 0; u < 4; ++u) { const int r = rb + u * ngw, rc = r < NB * SEQ ? r : NB * SEQ - 1; const float* gt = gate + (size_t)(rc >> 12) * 6144; float ss = 0.f; f32x4 v[4];
#pragma unroll
      for (int j = 0; j < 4; ++j) { const f32x4 g4 = *(const f32x4*)(gt + 4 * lane + 256 * j);
        const f32x4 x4 = (f32x4){__uint_as_float(xb[u][j].x << 16), __uint_as_float(xb[u][j].x & 0xffff0000u), __uint_as_float(xb[u][j].y << 16), __uint_as_float(xb[u][j].y & 0xffff0000u)};
        const f32x4 m4 = (f32x4){__uint_as_float(ys[u][j].x << 16), __uint_as_float(ys[u][j].x & 0xffff0000u), __uint_as_float(ys[u][j].y << 16), __uint_as_float(ys[u][j].y & 0xffff0000u)};
        v[j] = x4 + g4 * m4; ss += v[j].x * v[j].x + v[j].y * v[j].y + v[j].z * v[j].z + v[j].w * v[j].w; }
      const float rstd = rsqrtf(wave_sum(ss) * (1.0f / DM) + EPS);
      if (r < NB * SEQ) { float* orow = out + (size_t)r * DM;
#pragma unroll
        for (int j = 0; j < 4; ++j) *(f32x4*)(orow + 4 * lane + 256 * j) = (f32x4){v[j].x * rstd * gg[j].x, v[j].y * rstd * gg[j].y, v[j].z * rstd * gg[j].z, v[j].w * rstd * gg[j].w}; } }
  }
}

namespace pg8 {
#define PG8_LAS __attribute__((address_space(3)))
typedef unsigned short bf16_t;
typedef short bf16x8 __attribute__((ext_vector_type(8)));
typedef float f32x4 __attribute__((ext_vector_type(4)));
typedef unsigned u32x4 __attribute__((ext_vector_type(4)));
constexpr int BM = 256, BK = 64, HALF = 128, HTB = HALF * BK * 2  , STAGE_BYTES = 8 * HTB, NXCD = 8, WGM = 8;

__host__ __device__ __forceinline__ int lds_byte(int r, int c) { const int st = (r >> 4) * 2 + (c >> 5), rr = r & 15, cc = c & 31, ob = rr * 64 + cc * 2; return st * 1024 + (ob ^ (((ob >> 9) & 1) << 5)); }
__host__ __device__ __forceinline__ void stage_rc(int b, int& R, int& C) { const int st = b / 1024, sb = b % 1024, swz = sb ^ (((sb >> 9) & 1) << 5); R = (st >> 1) * 16 + swz / 64; C = (st & 1) * 32 + (swz % 64) / 2; }
__host__ __device__ __forceinline__ int perm32(int rho) { const int n = rho >> 4, i = rho & 15; return 8 * (i >> 2) + 4 * n + (i & 3); }

struct Unit { int pm, pn, fin, half, halfn; const char* A; const char* B; };
struct Gemm { int K, lda, ldb; };

__device__ __forceinline__ void tile_of(int L, int nM, int nN, int& pm, int& pn) {
    const int nwg = nM * nN; int wgid = L; { const int q = nwg / NXCD, r = nwg % NXCD, xcd = wgid % NXCD, off = wgid / NXCD; wgid = (xcd < r ? xcd * (q + 1) : r * (q + 1) + (xcd - r) * q) + off; }
    const int nig = WGM * nN, gid = wgid / nig, fm = gid * WGM, gsz = (nM - fm) < WGM ? (nM - fm) : WGM;
    pm = fm + ((wgid % nig) % gsz); pn = (wgid % nig) / gsz;
}
__device__ __forceinline__ unsigned cvt_pk_bf16(float lo, float hi) { return ::pk2bf(lo, hi); }
template <class Epi, class Sched, bool ALIGN_EPI = false, bool SP2 = false, bool HALFM = false, bool HALFN = false>
__device__ __forceinline__ void gemm_phase(PG8_LAS unsigned char* lds, const Gemm g, const Sched& S, const Epi& E) {
    const int tid = opq_v((int)threadIdx.x), wid = __builtin_amdgcn_readfirstlane(tid >> 6), lane = tid & 63, wr = wid >> 2, wc = wid & 3, fr = lane & 15, fq = lane >> 4;
    const int K = g.K, nt = K / BK;
    unsigned voffA[2], voffB[2];
#pragma unroll
    for (int i = 0; i < 2; ++i) { int R, C; stage_rc(tid * 16 + i * 8192, R, C); const int Rb = Epi::PERM ? ((R & ~31) + perm32(R & 31)) : R;
        voffA[i] = (unsigned)(R * g.lda + C) * 2u; voffB[i] = (unsigned)(Rb * g.ldb + C) * 2u; }
    const size_t kstep = (size_t)(BK * 2);
    static_assert(!HALFM || SP2, "half-height units need the SP2 loop"); static_assert(!HALFN || HALFM, "quarter units are half-height and half-width");
    const size_t hstepA = (size_t)HALF * g.lda * 2, hstepB = (size_t)HALF * g.ldb * 2;
    const unsigned ldsw = (unsigned)wid * 1024u;
    const int aoff = lds_byte(wr * 64 + fr, fq * 8), boff = lds_byte(wc * 32 + fr, fq * 8);
#define PG8_SA(b, h) (((b) * 2 + (h)) * HTB)
#define PG8_SB(b, h) ((4 + (b) * 2 + (h)) * HTB)
#define PG8_STAGE(bufoff, gbase, voff) do { _Pragma("unroll") for (int _i = 0; _i < 2; ++_i) \
        __builtin_amdgcn_global_load_lds((const unsigned*)((const char*)(gbase) + (voff)[_i]), (PG8_LAS unsigned*)(lds + (bufoff) + ldsw + _i * 8192), 16, 0, 0); } while (0)
#define PG8_LDA(dst, b, h) do { _Pragma("unroll") for (int m = 0; m < 4; ++m) _Pragma("unroll") for (int k = 0; k < 2; ++k) dst[m][k] = *(const PG8_LAS bf16x8*)(lds + PG8_SA(b, h) + aoff + m * 2048 + k * 1024); } while (0)
#define PG8_LDB(dst, b, h) do { _Pragma("unroll") for (int n = 0; n < 2; ++n) _Pragma("unroll") for (int k = 0; k < 2; ++k) dst[n][k] = *(const PG8_LAS bf16x8*)(lds + PG8_SB(b, h) + boff + n * 2048 + k * 1024); } while (0)
#define PG8_MMA(ai, bj, At, Bt) do { __builtin_amdgcn_s_setprio(1); _Pragma("unroll") for (int m = 0; m < 4; ++m) _Pragma("unroll") for (int n = 0; n < 2; ++n) _Pragma("unroll") for (int k = 0; k < 2; ++k) \
        acc[ai][bj][m][n] = __builtin_amdgcn_mfma_f32_16x16x32_bf16(Bt[n][k], At[m][k], acc[ai][bj][m][n], 0, 0, 0); __builtin_amdgcn_s_setprio(0); } while (0)
#define PG8_WAIT_V(n) asm volatile("s_waitcnt vmcnt(" #n ")" ::: "memory")
#define PG8_WAIT_L(n) asm volatile("s_waitcnt lgkmcnt(" #n ")" ::: "memory")
#define PG8_BAR __builtin_amdgcn_s_barrier()
#define PG8_SCHED __builtin_amdgcn_sched_barrier(0)
    Unit cur, nxt; int ui = 0;
    if (!S.next(0, cur)) return;
    f32x4 acc[2][2][4][2];
#pragma unroll
    for (int a = 0; a < 2; ++a)
#pragma unroll
        for (int b = 0; b < 2; ++b)
#pragma unroll
            for (int m = 0; m < 4; ++m)
#pragma unroll
                for (int n = 0; n < 2; ++n) acc[a][b][m][n] = (f32x4){0.f, 0.f, 0.f, 0.f};
    bf16x8 At[4][2], B0[2][2], B1[2][2];
    const char* cA = cur.A; const char* cB = cur.B;
    S.a_ready(cur);
    if constexpr (SP2) {
        PG8_STAGE(PG8_SB(0, 0), cB, voffB); if constexpr (!HALFN) PG8_STAGE(PG8_SB(0, 1), cB + hstepB, voffB); PG8_STAGE(PG8_SA(0, 0), cA, voffA); if constexpr (!HALFM) PG8_STAGE(PG8_SA(0, 1), cA + hstepA, voffA);
        if (wr == 1) PG8_BAR;
        if constexpr (HALFM) PG8_WAIT_V(0); else PG8_WAIT_V(2);
        PG8_BAR;
        PG8_STAGE(PG8_SB(1, 0), cB + kstep, voffB); PG8_STAGE(PG8_SA(1, 0), cA + kstep, voffA); if constexpr (!HALFN) PG8_STAGE(PG8_SB(1, 1), cB + hstepB + kstep, voffB);
        PG8_WAIT_V(6); PG8_BAR;
    } else {
        PG8_STAGE(PG8_SB(0, 0), cB, voffB); PG8_STAGE(PG8_SA(0, 0), cA, voffA); PG8_STAGE(PG8_SB(0, 1), cB + hstepB, voffB); PG8_STAGE(PG8_SA(0, 1), cA + hstepA, voffA);
        if (wr == 1) PG8_BAR;
        PG8_WAIT_V(4); PG8_BAR;
        PG8_STAGE(PG8_SB(1, 0), cB + kstep, voffB); PG8_STAGE(PG8_SA(1, 0), cA + kstep, voffA); PG8_STAGE(PG8_SB(1, 1), cB + hstepB + kstep, voffB);
        PG8_WAIT_V(6); PG8_BAR;
    }
    for (;;) {
        const bool has_next = S.next(ui + 1, nxt);
        const char* nA = has_next ? nxt.A : cA; const char* nB = has_next ? nxt.B : cB;
        for (int t = 0; t < nt; t += 2) {
            const bool last = (t == nt - 2);
            const char* a1 = cA + (size_t)(t + 1) * kstep;
            const char* a2 = last ? nA : cA + (size_t)(t + 2) * kstep; const char* b2 = last ? nB : cB + (size_t)(t + 2) * kstep;
            const char* a3 = a2 + kstep; const char* b3 = b2 + kstep;
            if (last && has_next) S.a_ready(nxt);
            if constexpr (SP2) {
            PG8_LDB(B0, 0, 0); if constexpr (!HALFN) PG8_LDB(B1, 0, 1); PG8_SCHED; PG8_LDA(At, 0, 0); if constexpr (!HALFM) PG8_STAGE(PG8_SA(1, 1), a1 + hstepA, voffA);
            PG8_WAIT_V(8); PG8_WAIT_L(0); PG8_BAR; PG8_MMA(0, 0, At, B0); if constexpr (!HALFN) PG8_MMA(0, 1, At, B1); PG8_BAR; PG8_SCHED;
            if constexpr (!HALFM) PG8_LDA(At, 0, 1);
            PG8_STAGE(PG8_SB(0, 0), b2, voffB); if constexpr (!HALFN) PG8_STAGE(PG8_SB(0, 1), b2 + hstepB, voffB); PG8_STAGE(PG8_SA(0, 0), a2, voffA);
            if constexpr (HALFN) PG8_WAIT_V(4); else if constexpr (HALFM) PG8_WAIT_V(6); else PG8_WAIT_V(8);
            PG8_WAIT_L(0); PG8_BAR; if constexpr (!HALFM) { PG8_MMA(1, 0, At, B0); PG8_MMA(1, 1, At, B1); } PG8_BAR; PG8_SCHED;
            PG8_LDB(B0, 1, 0); if constexpr (!HALFN) PG8_LDB(B1, 1, 1); PG8_SCHED; PG8_LDA(At, 1, 0); if constexpr (!HALFM) PG8_STAGE(PG8_SA(0, 1), a2 + hstepA, voffA);
            PG8_WAIT_V(8); PG8_WAIT_L(0); PG8_BAR; PG8_MMA(0, 0, At, B0); if constexpr (!HALFN) PG8_MMA(0, 1, At, B1); PG8_BAR; PG8_SCHED;
            if constexpr (!HALFM) PG8_LDA(At, 1, 1);
            PG8_STAGE(PG8_SB(1, 0), b3, voffB); if constexpr (!HALFN) PG8_STAGE(PG8_SB(1, 1), b3 + hstepB, voffB); PG8_STAGE(PG8_SA(1, 0), a3, voffA);
            if constexpr (HALFN) PG8_WAIT_V(4); else if constexpr (HALFM) PG8_WAIT_V(6); else PG8_WAIT_V(8);
            PG8_WAIT_L(0); PG8_BAR; if constexpr (!HALFM) { PG8_MMA(1, 0, At, B0); PG8_MMA(1, 1, At, B1); } PG8_BAR; PG8_SCHED;
            } else {
            PG8_LDB(B0, 0, 0); PG8_SCHED; PG8_LDA(At, 0, 0); PG8_STAGE(PG8_SA(1, 1), a1 + hstepA, voffA);
            PG8_WAIT_L(8); PG8_BAR; PG8_WAIT_L(0); PG8_MMA(0, 0, At, B0); PG8_BAR; PG8_SCHED;
            PG8_LDB(B1, 0, 1); PG8_STAGE(PG8_SB(0, 0), b2, voffB);
            PG8_BAR; PG8_WAIT_L(0); PG8_MMA(0, 1, At, B1); PG8_BAR;
            PG8_LDA(At, 0, 1); PG8_STAGE(PG8_SA(0, 0), a2, voffA);
            PG8_BAR; PG8_WAIT_L(0); PG8_MMA(1, 0, At, B0); PG8_BAR; PG8_SCHED;
            PG8_STAGE(PG8_SB(0, 1), b2 + hstepB, voffB);
            PG8_WAIT_V(6); PG8_BAR; PG8_MMA(1, 1, At, B1); PG8_BAR;
            PG8_LDB(B0, 1, 0); PG8_SCHED; PG8_LDA(At, 1, 0); PG8_STAGE(PG8_SA(0, 1), a2 + hstepA, voffA);
            PG8_WAIT_L(8); PG8_BAR; PG8_WAIT_L(0); PG8_MMA(0, 0, At, B0); PG8_BAR; PG8_SCHED;
            PG8_LDB(B1, 1, 1); PG8_STAGE(PG8_SB(1, 0), b3, voffB);
            PG8_BAR; PG8_WAIT_L(0); PG8_MMA(0, 1, At, B1); PG8_BAR;
            PG8_LDA(At, 1, 1); PG8_STAGE(PG8_SA(1, 0), a3, voffA);
            PG8_BAR; PG8_WAIT_L(0); PG8_MMA(1, 0, At, B0); PG8_BAR; PG8_SCHED;
            PG8_STAGE(PG8_SB(1, 1), b3 + hstepB, voffB);
            PG8_WAIT_V(6); PG8_BAR; PG8_MMA(1, 1, At, B1); PG8_BAR;
            }
        }
        if constexpr (ALIGN_EPI) { if (wr == 0) PG8_BAR; }
        if constexpr (!Epi::AFTER_DRAIN) { if (cur.fin) { E(acc, cur, wr, wc, fr, fq, HALFM ? 1 : 2, HALFN ? 1 : 2); S.done(cur); } }
        if (!has_next) break;
        if (cur.fin) {
#pragma unroll
        for (int a = 0; a < 2; ++a)
#pragma unroll
            for (int b = 0; b < 2; ++b)
#pragma unroll
                for (int m = 0; m < 4; ++m)
#pragma unroll
                    for (int n = 0; n < 2; ++n) acc[a][b][m][n] = (f32x4){0.f, 0.f, 0.f, 0.f};
        }
        cur = nxt; cA = nA; cB = nB; ++ui;
        if constexpr (ALIGN_EPI) { if (wr == 1) PG8_BAR; }
    }
    PG8_WAIT_V(0);
    if constexpr (!ALIGN_EPI) { if (wr == 0) PG8_BAR; }
    PG8_BAR;
    if constexpr (Epi::AFTER_DRAIN) { E.fused(acc, cur, wr, wc, fr, fq, lds, wid, lane); S.done(cur); }
#undef PG8_SA
#undef PG8_SB
#undef PG8_STAGE
#undef PG8_LDA
#undef PG8_LDB
#undef PG8_MMA
#undef PG8_WAIT_V
#undef PG8_WAIT_L
#undef PG8_BAR
#undef PG8_SCHED
}
}

struct SchedDense {
  int nM, nN, G, c, skip_ctx; const char* A; const char* B; size_t a_tile, b_tile; int part;
  __device__ __forceinline__ bool next(int i, pg8::Unit& u) const {
    const int nu = nM * nN, T = nu % G; const bool q4 = T > 0 && 4 * T <= G, h2 = T > 0 && !q4 && 2 * T <= G; int L, half = 0, halfn = 0;
    if (part == 0) { L = i * G + c; if (L >= ((q4 || h2) ? nu - T : nu)) return false; }
    else if (part == 1) { if (i > 0 || !h2 || c >= 2 * T) return false; L = nu - T + (c >> 1); half = 1 + (c & 1); }
    else { if (i > 0 || !q4 || c >= 4 * T) return false; L = nu - T + (c >> 2); half = 1 + (c & 1); halfn = 1 + ((c >> 1) & 1); }
    int pm, pn; pg8::tile_of(L, nM, nN, pm, pn); if (skip_ctx) pm = pm + pm / 16 + 1;
    u.pm = pm; u.pn = pn; u.fin = 1; u.half = half; u.halfn = halfn; u.A = A + (size_t)pm * a_tile + (half == 2 ? a_tile / 2 : 0); u.B = B + (size_t)pn * b_tile + (halfn == 2 ? b_tile / 2 : 0); return true; }
  __device__ __forceinline__ void a_ready(const pg8::Unit&) const {}
  __device__ __forceinline__ void done(const pg8::Unit&) const {}
};
struct SchedMoe {
  int G, c, mode; const int* ctl; const char* A; size_t a_tile; const char* W; int tail;
  __device__ __forceinline__ bool next(int i, pg8::Unit& u) const {
    const int part = mode == 2 ? (i & 1) : 0, iu = mode == 2 ? (i >> 1) : i;
    const int nu = ctl[CT_NT] * 4, T = nu % G; const bool q4 = T > 0 && 4 * T <= G, h2 = T > 0 && !q4 && 2 * T <= G; int L, half = 0, halfn = 0;
    if (tail == 0) { L = iu * G + c; if (L >= ((q4 || h2) ? nu - T : nu)) return false; }
    else if (tail == 1) { if (iu > 0 || !h2 || c >= 2 * T) return false; L = nu - T + (c >> 1); half = 1 + (c & 1); }
    else { if (iu > 0 || !q4 || c >= 4 * T) return false; L = nu - T + (c >> 2); half = 1 + (c & 1); halfn = 1 + ((c >> 1) & 1); }
    const int pm = L >> 2, pn = L & 3; int eA, eB; pair_experts(ctl[CT_TP + pm], eA, eB);
    u.pm = pm; u.pn = pn; u.half = half; u.halfn = halfn; const size_t ho = half == 2 ? a_tile / 2 : 0;
    if (mode == 1) { const int e = pn < 2 ? eA : eB; u.fin = 1; u.A = A + (size_t)pm * a_tile + ho; u.B = W + (size_t)e * (512 * 1024 * 2) + (size_t)(pn & 1) * (256 * 1024 * 2) + (halfn == 2 ? (size_t)128 * 1024 * 2 : 0); }
    else { u.fin = part; u.A = A + (size_t)pm * a_tile + ho + part * 512; u.B = W + (size_t)(part ? eB : eA) * (1024 * 256 * 2) + (size_t)pn * (256 * 256 * 2) + (halfn == 2 ? (size_t)128 * 256 * 2 : 0); }
    return true; }
  __device__ __forceinline__ void a_ready(const pg8::Unit&) const {}
  __device__ __forceinline__ void done(const pg8::Unit&) const {}
};
__device__ __forceinline__ unsigned cvt_pk(float lo, float hi) { return pg8::cvt_pk_bf16(lo, hi); }
struct EpiInProj {
  static constexpr bool PERM = true, AFTER_DRAIN = false; bf16_t *QK, *VZ, *XBC, *HY; float* DT;
  __device__ __forceinline__ void operator()(const f32x4 (&acc)[2][2][4][2], const pg8::Unit& u, int wr, int wc, int fr, int fq, const int nai, const int nbj) const {
    const int pn = u.pn; bf16_t* base; int ldc, coff;
    if (pn < 2) { base = QK; ldc = 512; coff = pn * 256; } else if (pn < 4) { base = VZ; ldc = 512; coff = (pn - 2) * 256; }
    else if (pn < 7) { base = XBC; ldc = 768; coff = (pn - 4) * 256; } else { base = HY; ldc = 768; coff = (pn - 7) * 256; }
    const int row0 = u.pm * 256 + (u.half == 2 ? 128 : 0) + wr * 64 + fr, col0 = coff + wc * 32 + 8 * fq; const bool dtl = (pn == 6 && wc == 0 && fq < 2);
#pragma unroll
    for (int ai = 0; ai < 2; ++ai)
#pragma unroll
      for (int m = 0; m < 4; ++m) if (ai < nai) { const int row = row0 + ai * 128 + m * 16; bf16_t* rowp = base + (size_t)row * ldc + col0;
#pragma unroll
        for (int bj = 0; bj < 2; ++bj) if (bj < nbj) { const f32x4 v0 = acc[ai][bj][m][0], v1 = acc[ai][bj][m][1];
          u32x4 w; w.x = cvt_pk(v0[0], v0[1]); w.y = cvt_pk(v0[2], v0[3]); w.z = cvt_pk(v1[0], v1[1]); w.w = cvt_pk(v1[2], v1[3]);
          *(u32x4*)(rowp + bj * 128) = w;
          if (bj == 1 && dtl) { float* dp = DT + (size_t)row * 12 + 8 * fq; *(f32x4*)dp = v0; if (fq == 0) *(f32x4*)(dp + 4) = v1; } } }
  }
};
struct EpiOutProj {
  static constexpr bool PERM = true, AFTER_DRAIN = false; bf16_t* MO;
  __device__ __forceinline__ void operator()(const f32x4 (&acc)[2][2][4][2], const pg8::Unit& u, int wr, int wc, int fr, int fq, const int nai, const int nbj) const {
    const int row0 = u.pm * 256 + (u.half == 2 ? 128 : 0) + wr * 64 + fr, col0 = u.pn * 256 + (u.halfn == 2 ? 128 : 0) + wc * 32 + 8 * fq;
#pragma unroll
    for (int ai = 0; ai < 2; ++ai)
#pragma unroll
      for (int m = 0; m < 4; ++m) if (ai < nai) { bf16_t* rowp = MO + (size_t)(row0 + ai * 128 + m * 16) * DM + col0;
#pragma unroll
        for (int bj = 0; bj < 2; ++bj) if (bj < nbj) { const f32x4 v0 = acc[ai][bj][m][0], v1 = acc[ai][bj][m][1];
          u32x4 w; w.x = cvt_pk(v0[0], v0[1]); w.y = cvt_pk(v0[2], v0[3]); w.z = cvt_pk(v1[0], v1[1]); w.w = cvt_pk(v1[2], v1[3]);
          *(u32x4*)(rowp + bj * 128) = w; } }
  }
};
struct EpiMoe1 {
  static constexpr bool PERM = true, AFTER_DRAIN = false; bf16_t* ACT; const float* sorted_w;
  __device__ __forceinline__ void operator()(const f32x4 (&acc)[2][2][4][2], const pg8::Unit& u, int wr, int wc, int fr, int fq, const int nai, const int nbj) const {
    const int half = u.pn >> 1, j0 = (u.pn & 1) * 128 + (u.halfn == 2 ? 64 : 0) + 16 * wc + 4 * fq;
#pragma unroll
    for (int ai = 0; ai < 2; ++ai)
#pragma unroll
      for (int m = 0; m < 4; ++m) if (ai < nai) { const int slot = u.pm * 256 + (u.half == 2 ? 128 : 0) + ai * 128 + wr * 64 + m * 16 + fr; const float wt = sorted_w[2 * slot + half];
#pragma unroll
        for (int bj = 0; bj < 2; ++bj) if (bj < nbj) { const f32x4 v0 = acc[ai][bj][m][0], v1 = acc[ai][bj][m][1];
          u32x2 w; w.x = cvt_pk(siluf(v0[0]) * v0[1] * wt, siluf(v0[2]) * v0[3] * wt); w.y = cvt_pk(siluf(v1[0]) * v1[1] * wt, siluf(v1[2]) * v1[3] * wt);
          *(u32x2*)(ACT + (size_t)slot * 512 + half * 256 + j0 + 64 * bj) = w; } }
  }
};
struct EpiMoe2 {
  static constexpr bool PERM = true, AFTER_DRAIN = false; bf16_t* YS;
  __device__ __forceinline__ void operator()(const f32x4 (&acc)[2][2][4][2], const pg8::Unit& u, int wr, int wc, int fr, int fq, const int nai, const int nbj) const {
    const int row0 = u.pm * 256 + (u.half == 2 ? 128 : 0) + wr * 64 + fr, col0 = u.pn * 256 + (u.halfn == 2 ? 128 : 0) + wc * 32 + 8 * fq;
#pragma unroll
    for (int ai = 0; ai < 2; ++ai)
#pragma unroll
      for (int m = 0; m < 4; ++m) if (ai < nai) { bf16_t* rowp = YS + (size_t)(row0 + ai * 128 + m * 16) * DM + col0;
#pragma unroll
        for (int bj = 0; bj < 2; ++bj) if (bj < nbj) { const f32x4 v0 = acc[ai][bj][m][0], v1 = acc[ai][bj][m][1];
          u32x4 w; w.x = cvt_pk(v0[0], v0[1]); w.y = cvt_pk(v0[2], v0[3]); w.z = cvt_pk(v1[0], v1[1]); w.w = cvt_pk(v1[2], v1[3]);
          *(u32x4*)(rowp + bj * 128) = w; } }
  }
};

#include <hip/hip_bf16.h>
#include <cmath>
namespace attn_body {
using bf16=__hip_bfloat16;
using bf16x8=__attribute__((ext_vector_type(8)))short;
using s16x4=__attribute__((ext_vector_type(4)))short;
using f32x16=__attribute__((ext_vector_type(16)))float;
using u32x4=__attribute__((ext_vector_type(4)))unsigned;
constexpr int D=64,QP=512,KP=512,VP=512,OP=1024;
constexpr int NW=8,QBLK=32,QB=QBLK*NW,KVBLK=64;
constexpr int ATTN_UNIT_ROWS=QB;
__device__ __forceinline__ int crow(int r,int hi){return (r&3)+8*(r>>2)+4*hi;}
#define SBAR() __builtin_amdgcn_sched_barrier(0)
__device__ __forceinline__ void cmask(f32x16&p0,f32x16&p1,int jb,int qrel,int hi){
  const float NEG=-INFINITY; int kb=64*jb+4*hi;
  #pragma unroll
  for(int r=0;r<16;++r){int kv=kb+(r&3)+8*(r>>2); if(kv>qrel)p0[r]=NEG; if(kv+32>qrel)p1[r]=NEG;}
}

constexpr int NSLOT=3, SLOTB=8192;
constexpr int LDS_K=0, LDS_V=NSLOT*SLOTB, LDS_WS=2*NSLOT*SLOTB, LDS_OST=LDS_WS+NW*64*4, LDS_BYTES=LDS_OST+NW*4096;
constexpr float C2=0.125f*1.4426950408889634f;
__device__ __forceinline__ void glds16(const void*gsrc,unsigned lds_dst){unsigned keep;
  asm volatile("s_mov_b32 %0, m0\n\ts_mov_b32 m0, %2\n\ts_nop 0\n\tglobal_load_lds_dwordx4 %1, off\n\ts_mov_b32 m0, %0":"=&s"(keep):"v"(gsrc),"s"(lds_dst):"memory");}
__device__ __forceinline__ float max3f(float a,float b,float c){float r;asm("v_max3_f32 %0, %1, %2, %3":"=v"(r):"v"(a),"v"(b),"v"(c));return r;}
__device__ __forceinline__ float max2f(float a,float b){float r;asm("v_max_f32_e32 %0, %1, %2":"=v"(r):"v"(a),"v"(b));return r;}
__device__ __forceinline__ float fadd_s(float a,float b){float r;asm("v_add_f32_e32 %0, %1, %2":"=v"(r):"v"(a),"v"(b));return r;}
__device__ __forceinline__ float fsub_s(float a,float b){float r;asm("v_sub_f32_e32 %0, %1, %2":"=v"(r):"v"(a),"v"(b));return r;}
typedef float f32x2_t __attribute__((ext_vector_type(2))); typedef __bf16 bf16x2_t __attribute__((ext_vector_type(2)));
__device__ __forceinline__ unsigned cvtpk_s(float lo,float hi){f32x2_t v={lo,hi};bf16x2_t b=__builtin_convertvector(v,bf16x2_t);return __builtin_bit_cast(unsigned,b);}
#define WAIT_BAR(N) asm volatile("s_waitcnt vmcnt(" #N ") lgkmcnt(0)\n\ts_barrier":::"memory")

__device__ __forceinline__ void qkt(f32x16&p0,f32x16&p1,const char*Kslot,const bf16x8*qr,const f32x16&negm,int r32,int hi){
  const char*kb=Kslot+hi*1024+r32*16;
  #pragma unroll
  for(int d0=0;d0<4;++d0){
    const bf16x8 b0=*reinterpret_cast<const bf16x8*>(kb+d0*2048);
    const bf16x8 b1=*reinterpret_cast<const bf16x8*>(kb+d0*2048+512);
    if(d0==0){p0=__builtin_amdgcn_mfma_f32_32x32x16_bf16(b0,qr[0],negm,0,0,0);p1=__builtin_amdgcn_mfma_f32_32x32x16_bf16(b1,qr[0],negm,0,0,0);}
    else{p0=__builtin_amdgcn_mfma_f32_32x32x16_bf16(b0,qr[d0],p0,0,0,0);p1=__builtin_amdgcn_mfma_f32_32x32x16_bf16(b1,qr[d0],p1,0,0,0);}}
}
typedef __attribute__((address_space(3))) const char* lds_cptr;
typedef short v4i16_t __attribute__((ext_vector_type(4)));
__device__ __forceinline__ void kload8(bf16x8*kf,lds_cptr kp){
  kf[0]=*(const __attribute__((address_space(3))) bf16x8*)(kp);      kf[1]=*(const __attribute__((address_space(3))) bf16x8*)(kp+512);
  kf[2]=*(const __attribute__((address_space(3))) bf16x8*)(kp+2048); kf[3]=*(const __attribute__((address_space(3))) bf16x8*)(kp+2560);
  kf[4]=*(const __attribute__((address_space(3))) bf16x8*)(kp+4096); kf[5]=*(const __attribute__((address_space(3))) bf16x8*)(kp+4608);
  kf[6]=*(const __attribute__((address_space(3))) bf16x8*)(kp+6144); kf[7]=*(const __attribute__((address_space(3))) bf16x8*)(kp+6656);
}
__device__ __forceinline__ void kload2(bf16x8*kf,lds_cptr kp,int j){ kf[2*j]=*(const __attribute__((address_space(3))) bf16x8*)(kp+j*2048); kf[2*j+1]=*(const __attribute__((address_space(3))) bf16x8*)(kp+j*2048+512); }
__device__ __forceinline__ s16x4 vtr(lds_cptr p){ return __builtin_bit_cast(s16x4,__builtin_amdgcn_ds_read_tr16_b64_v4i16((__attribute__((address_space(3))) v4i16_t*)p)); }
__device__ __forceinline__ float rowmax(const f32x16&p0,const f32x16&p1){
  float a=max3f(p0[0],p0[1],p1[0]),b=max3f(p0[2],p0[3],p1[1]);a=max3f(a,p1[2],p1[3]);
  #pragma unroll
  for(int r=4;r<16;r+=4){a=max3f(a,p0[r],p0[r+1]);b=max3f(b,p0[r+2],p0[r+3]);a=max3f(a,p1[r],p1[r+1]);b=max3f(b,p1[r+2],p1[r+3]);}
  const float m=max2f(a,b);
  auto rr=__builtin_amdgcn_permlane32_swap(__float_as_uint(m),__float_as_uint(m),false,false);
  return max2f(__uint_as_float(rr[0]),__uint_as_float(rr[1]));
}
__device__ __forceinline__ void pv(f32x16*o,int vb,bf16x8 pa0,bf16x8 pa1,bf16x8 pa2,bf16x8 pa3){
  #pragma unroll
  for(int d0=0;d0<2;++d0){s16x4 lo[4],hi[4];
    #pragma unroll
    for(int ks=0;ks<4;++ks){
      asm volatile("ds_read_b64_tr_b16 %0,%1 offset:%c2":"=&v"(lo[ks]):"v"(vb),"i"(d0*4096+ks*1024):"memory");
      asm volatile("ds_read_b64_tr_b16 %0,%1 offset:%c2":"=&v"(hi[ks]):"v"(vb),"i"(d0*4096+ks*1024+512):"memory");}
    asm volatile("s_waitcnt lgkmcnt(0)":::"memory");SBAR();
    #define PK(k) (bf16x8){lo[k][0],lo[k][1],lo[k][2],lo[k][3],hi[k][0],hi[k][1],hi[k][2],hi[k][3]}
    o[d0]=__builtin_amdgcn_mfma_f32_32x32x16_bf16(pa0,PK(0),o[d0],0,0,0);
    o[d0]=__builtin_amdgcn_mfma_f32_32x32x16_bf16(pa1,PK(1),o[d0],0,0,0);
    o[d0]=__builtin_amdgcn_mfma_f32_32x32x16_bf16(pa2,PK(2),o[d0],0,0,0);
    o[d0]=__builtin_amdgcn_mfma_f32_32x32x16_bf16(pa3,PK(3),o[d0],0,0,0);
    #undef PK
  }
}

#ifndef ATTN_STORE16
#define ATTN_STORE16(p,v) (*(u32x4*)(p)=(v))
#endif
template<int THRL> __device__ __forceinline__ void attn_unit(const bf16*Qu,const bf16*__restrict__ Kh,const bf16*__restrict__ Vh,bf16*Ou,const int NT,char*shm){
  const int tid=opq_v((int)threadIdx.x),lane=tid&63,r32=lane&31,hi=lane>>5; const int wid=__builtin_amdgcn_readfirstlane(tid>>6);
  const bf16*Qw=Qu+(long)(wid*QBLK)*QP;
  const unsigned lds0=(unsigned)(uintptr_t)shm;
  float*wsf=(float*)(shm+LDS_WS)+wid*64;
  const bf16*ksrc=Kh+(long)lane*KP+wid*8;
  const bf16*vsrc=Vh+(long)(16*(wid&3)+(lane>>2))*VP+(wid>>2)*32+(lane&3)*8;
  const unsigned kdst=lds0+LDS_K+wid*1024, vdst=lds0+LDS_V+wid*1024;
  #define DMA_K(t,slot) glds16(ksrc+(long)(t)*KVBLK*KP,(unsigned)__builtin_amdgcn_readfirstlane(kdst+(slot)))
  #define DMA_V(t,slot) glds16(vsrc+(long)(t)*KVBLK*VP,(unsigned)__builtin_amdgcn_readfirstlane(vdst+(slot)))
  const int vb0=(int)(lds0+LDS_V)+((lane>>4)&1)*32+(lane&3)*8+(4*hi+((lane&15)>>2))*64;
  const char*Kbase=shm+LDS_K; bf16x8 kf[8];
  const lds_cptr shm3=(lds_cptr)shm; const lds_cptr kp0=shm3+LDS_K+hi*1024+r32*16; const lds_cptr vp0=shm3+LDS_V+((lane>>4)&1)*32+(lane&3)*8+(4*hi+((lane&15)>>2))*64;
  DMA_K(0,0);DMA_V(0,0);DMA_K(1,SLOTB);
  bf16x8 qr[4];
  #pragma unroll
  for(int d0=0;d0<4;++d0)qr[d0]=*reinterpret_cast<const bf16x8*>(&Qw[(long)r32*QP+d0*16+hi*8]);
  float mhat=0.f,l_reg=0.f;float z0_=0.f;asm volatile("":"+v"(z0_));f32x16 o[2];f32x16 negm;
  _Pragma("unroll") for(int r=0;r<16;++r){o[0][r]=z0_;o[1][r]=z0_;negm[r]=z0_;} asm volatile("":"+v"(negm));
  #define CMASK(P0,P1,t) do{}while(0)
  bool resc=false;
  #define START(P0,P1) do{ const float rm=rowmax(P0,P1); resc=false; \
    { const float dl=rm; mhat=fadd_s(mhat,dl); \
      _Pragma("unroll") for(int r=0;r<16;++r){P0[r]=fsub_s(P0[r],dl);P1[r]=fsub_s(P1[r],dl);} \
      _Pragma("unroll") for(int r=0;r<16;++r)negm[r]=-mhat; asm volatile("":"+v"(negm)); } \
    _Pragma("unroll") for(int r=0;r<16;++r)P0[r]=__builtin_amdgcn_exp2f(P0[r]); }while(0)
  #define RESC() do{ if(resc){ asm volatile("s_waitcnt lgkmcnt(0)":::"memory"); \
      _Pragma("unroll") for(int d_=0;d_<2;++d_) _Pragma("unroll") for(int r=0;r<16;++r)o[d_][r]*=wsf[crow(r,hi)]; } }while(0)
  f32x16 pA0,pA1,pB0,pB1;
  int sl_prev=0,sl_cur=0,sl_next=SLOTB;
  #define ROT() do{sl_prev=sl_cur;sl_cur=sl_next;sl_next=(sl_next==(NSLOT-1)*SLOTB)?0:sl_next+SLOTB;}while(0)
  DMA_K(2,2*SLOTB);
  WAIT_BAR(3);
  qkt(pA0,pA1,Kbase,qr,negm,r32,hi);asm volatile("s_nop 15\n\ts_nop 7":"+v"(pA0),"+v"(pA1));CMASK(pA0,pA1,0);
  START(pA0,pA1);
  _Pragma("unroll") for(int r=0;r<16;++r)pA1[r]=__builtin_amdgcn_exp2f(pA1[r]);
  WAIT_BAR(0);
  DMA_K(3,0);DMA_V(1,SLOTB);
  ROT();
  kload8(kf,kp0+sl_cur);
  WAIT_BAR(2);
  s16x4 vlo[8],vhi[8]; u32x4 pw0,pw1,pw2,pw3;
  #define PKW(P,B) cvtpk_s(P[B],P[B+1])
  #define PAF(k) __builtin_bit_cast(bf16x8,pw##k)
  #define VFR(i) (bf16x8){vlo[i][0],vlo[i][1],vlo[i][2],vlo[i][3],vhi[i][0],vhi[i][1],vhi[i][2],vhi[i][3]}
  #define PIN(x) asm volatile("":"+v"(x))
  #define MX3(a,b,c) __builtin_fmaxf(__builtin_fmaxf((a),(b)),(c))
  #define GAPA(MF,A0,A1,A2,A3,W0,W1,PW) do{ MF; sacc+=A0; sacc+=A1; sacc+=A2; sacc+=A3; PIN(sacc); W0; W1; PIN(PW); SBAR(); }while(0)
  #define EX(v) __builtin_amdgcn_exp2f(v)
  #define GAPB(MF,X,B) do{ MF; X[B]=EX(X[B]); X[B+1]=EX(X[B+1]); X[B+2]=EX(X[B+2]); X[B+3]=EX(X[B+3]); PIN(X); SBAR(); }while(0)
  #define VRD(i) do{ vlo[i]=vtr(vp_+(((i)>>2)*4096+((i)&3)*1024)); vhi[i]=vtr(vp_+(((i)>>2)*4096+((i)&3)*1024+512)); }while(0)
  #define KRD(G,j) do{ if(G){ kload2(kf,kp0+sl_next,j); SBAR(); } }while(0)
  #define STEP(C0,C1,P0,P1,t,GK,GV,GL) do{ SBAR(); \
    const lds_cptr vp_=vp0+sl_prev; \
    VRD(0); SBAR(); float sacc=(P0[0]+P0[1]); \
    GAPA(C0=__builtin_amdgcn_mfma_f32_32x32x16_bf16(kf[0],qr[0],negm,0,0,0), P0[2],P0[3],P0[4],P0[5],     pw0[0]=PKW(P0,0), pw0[1]=PKW(P0,2), pw0); \
    VRD(4); SBAR(); GAPA(C1=__builtin_amdgcn_mfma_f32_32x32x16_bf16(kf[1],qr[0],negm,0,0,0), P0[6],P0[7],P0[8],P0[9],     pw0[2]=PKW(P0,4), pw0[3]=PKW(P0,6), pw0); \
    VRD(1); SBAR(); GAPA(C0=__builtin_amdgcn_mfma_f32_32x32x16_bf16(kf[2],qr[1],C0,0,0,0),   P0[10],P0[11],P0[12],P0[13], pw1[0]=PKW(P0,8), pw1[1]=PKW(P0,10), pw1); \
    VRD(5); SBAR(); GAPA(C1=__builtin_amdgcn_mfma_f32_32x32x16_bf16(kf[3],qr[1],C1,0,0,0),   P0[14],P0[15],P1[0],P1[1],   pw1[2]=PKW(P0,12),pw1[3]=PKW(P0,14), pw1); \
    VRD(2); SBAR(); GAPA(C0=__builtin_amdgcn_mfma_f32_32x32x16_bf16(kf[4],qr[2],C0,0,0,0),   P1[2],P1[3],P1[4],P1[5],     pw2[0]=PKW(P1,0), pw2[1]=PKW(P1,2), pw2); \
    VRD(6); SBAR(); GAPA(C1=__builtin_amdgcn_mfma_f32_32x32x16_bf16(kf[5],qr[2],C1,0,0,0),   P1[6],P1[7],P1[8],P1[9],     pw2[2]=PKW(P1,4), pw2[3]=PKW(P1,6), pw2); \
    VRD(3); SBAR(); GAPA(C0=__builtin_amdgcn_mfma_f32_32x32x16_bf16(kf[6],qr[3],C0,0,0,0),   P1[10],P1[11],P1[12],P1[13], pw3[0]=PKW(P1,8), pw3[1]=PKW(P1,10), pw3); \
    VRD(7); SBAR(); GAPA(C1=__builtin_amdgcn_mfma_f32_32x32x16_bf16(kf[7],qr[3],C1,0,0,0),   P1[14],P1[15],0.f,0.f,       pw3[2]=PKW(P1,12),pw3[3]=PKW(P1,14), pw3); \
    l_reg+=sacc; \
    if(GK){DMA_K((t)+3,sl_cur);} if(GV){DMA_V((t)+1,sl_next);} \
    CMASK(C0,C1,t); \
    { float a=MX3(C0[0],C0[1],C1[0]),b=MX3(C0[2],C0[3],C1[1]); a=MX3(a,C1[2],C1[3]); \
      _Pragma("unroll") for(int r=4;r<16;r+=4){a=MX3(a,C0[r],C0[r+1]);b=MX3(b,C0[r+2],C0[r+3]);a=MX3(a,C1[r],C1[r+1]);b=MX3(b,C1[r+2],C1[r+3]);} \
      float rm=__builtin_fmaxf(a,b); { auto rr=__builtin_amdgcn_permlane32_swap(__float_as_uint(rm),__float_as_uint(rm),false,false); rm=__builtin_fmaxf(__uint_as_float(rr[0]),__uint_as_float(rr[1])); } \
      resc=false; \
      if(__builtin_expect(__any(rm>(float)THRL),0)){ const float dl=__builtin_fmaxf(rm,0.f); mhat+=dl; \
        _Pragma("unroll") for(int r=0;r<16;++r){C0[r]-=dl;C1[r]-=dl;} \
        _Pragma("unroll") for(int r=0;r<16;++r)negm[r]=-mhat; asm volatile("":"+v"(negm)); \
        const float f=__builtin_amdgcn_exp2f(-dl); l_reg*=f; if(hi==0)wsf[r32]=f; resc=true; } } \
    SBAR(); \
    GAPB(o[0]=__builtin_amdgcn_mfma_f32_32x32x16_bf16(PAF(0),VFR(0),o[0],0,0,0), C0,0); \
    GAPB(o[1]=__builtin_amdgcn_mfma_f32_32x32x16_bf16(PAF(0),VFR(4),o[1],0,0,0), C0,4); \
    KRD(GL,0); GAPB(o[0]=__builtin_amdgcn_mfma_f32_32x32x16_bf16(PAF(1),VFR(1),o[0],0,0,0), C0,8); \
    KRD(GL,1); GAPB(o[1]=__builtin_amdgcn_mfma_f32_32x32x16_bf16(PAF(1),VFR(5),o[1],0,0,0), C0,12); \
    KRD(GL,2); GAPB(o[0]=__builtin_amdgcn_mfma_f32_32x32x16_bf16(PAF(2),VFR(2),o[0],0,0,0), C1,0); \
    KRD(GL,3); GAPB(o[1]=__builtin_amdgcn_mfma_f32_32x32x16_bf16(PAF(2),VFR(6),o[1],0,0,0), C1,4); \
    GAPB(o[0]=__builtin_amdgcn_mfma_f32_32x32x16_bf16(PAF(3),VFR(3),o[0],0,0,0), C1,8); \
    GAPB(o[1]=__builtin_amdgcn_mfma_f32_32x32x16_bf16(PAF(3),VFR(7),o[1],0,0,0), C1,12); \
    }while(0)
  int t=1;
  for(;t+5<NT;t+=2){
    STEP(pB0,pB1,pA0,pA1,t,true,true,true);     WAIT_BAR(2); RESC(); ROT();
    STEP(pA0,pA1,pB0,pB1,t+1,true,true,true);   WAIT_BAR(2); RESC(); ROT();
  }
  #define ENDW(tt) do{ if((tt)+3<NT){WAIT_BAR(2);} else if((tt)+2<NT){WAIT_BAR(1);} else {WAIT_BAR(0);} }while(0)
  for(;t+1<NT;t+=2){
    STEP(pB0,pB1,pA0,pA1,t,(t+3<NT),(t+1<NT),(t+1<NT));       ENDW(t);   RESC(); ROT();
    STEP(pA0,pA1,pB0,pB1,t+1,(t+4<NT),(t+2<NT),(t+2<NT));     ENDW(t+1); RESC(); ROT();
  }
  STEP(pB0,pB1,pA0,pA1,NT-1,false,false,false); RESC();
  { float sacc=pB0[0]+pB0[1]; _Pragma("unroll") for(int r=2;r<16;++r)sacc+=pB0[r]; _Pragma("unroll") for(int r=0;r<16;++r)sacc+=pB1[r]; l_reg+=sacc;
    pw0=(u32x4){PKW(pB0,0),PKW(pB0,2),PKW(pB0,4),PKW(pB0,6)};pw1=(u32x4){PKW(pB0,8),PKW(pB0,10),PKW(pB0,12),PKW(pB0,14)};pw2=(u32x4){PKW(pB1,0),PKW(pB1,2),PKW(pB1,4),PKW(pB1,6)};pw3=(u32x4){PKW(pB1,8),PKW(pB1,10),PKW(pB1,12),PKW(pB1,14)};
    SBAR(); pv(o,vb0+sl_cur,PAF(0),PAF(1),PAF(2),PAF(3)); }
  #undef PKW
  #undef PAF
  #undef VFR
  #undef PIN
  #undef MX3
  #undef GAPA
  #undef GAPB
  #undef EX
  #undef VRD
  #undef KRD
  #undef STEP
  #undef ENDW
  {auto rr=__builtin_amdgcn_permlane32_swap(__float_as_uint(l_reg),__float_as_uint(l_reg),false,false);l_reg=__uint_as_float(rr[0])+__uint_as_float(rr[1]);}
  if(hi==0)wsf[32+r32]=l_reg;asm volatile("s_waitcnt lgkmcnt(0)":::"memory");
  float rli[16];
  #pragma unroll
  for(int r=0;r<16;++r)rli[r]=__builtin_amdgcn_rcpf(wsf[32+crow(r,hi)]);
  bf16*Ow=Ou+(long)(wid*QBLK)*OP;
  { bf16*stg=(bf16*)(shm+LDS_OST)+wid*2048;
    #pragma unroll
    for(int r=0;r<16;++r){const int orow=crow(r,hi);
      #pragma unroll
      for(int d0=0;d0<2;++d0)stg[orow*64+d0*32+r32]=__float2bfloat16(o[d0][r]*rli[r]);}
    asm volatile("s_waitcnt lgkmcnt(0)":::"memory");
    #pragma unroll
    for(int i=0;i<4;++i){const int row=i*8+(lane>>3),ch=lane&7; const u32x4 v=*(const u32x4*)(stg+row*64+ch*8); ATTN_STORE16(Ow+(long)row*OP+ch*8,v);} }
  asm volatile("s_waitcnt lgkmcnt(0)\n\ts_barrier":::"memory");
  #undef DMA_K
  #undef DMA_V
  #undef CMASK
  #undef START
  #undef RESC
  #undef ROT
}
constexpr int ATTN_LDS_BYTES=LDS_BYTES;
#undef SBAR
#undef WAIT_BAR
}


namespace hyf {
typedef float c32 __attribute__((ext_vector_type(2)));
typedef _Float16 h2 __attribute__((ext_vector_type(2)));
__device__ __forceinline__ c32 cmul(c32 a, c32 b) {
  c32 t, r;
  asm("v_pk_mul_f32 %0, %1, %2 op_sel:[0,0] op_sel_hi:[0,1]" : "=v"(t) : "v"(a), "v"(b));
  asm("v_pk_fma_f32 %0, %1, %2, %3 op_sel:[1,1,0] op_sel_hi:[1,0,1] neg_lo:[0,1,0]" : "=v"(r) : "v"(a), "v"(b), "v"(t));
  return r;
}
__device__ __forceinline__ c32 cmulc(c32 a, c32 b) {
  c32 t, r;
  asm("v_pk_mul_f32 %0, %1, %2 op_sel:[0,0] op_sel_hi:[0,1]" : "=v"(t) : "v"(a), "s"(b));
  asm("v_pk_fma_f32 %0, %1, %2, %3 op_sel:[1,1,0] op_sel_hi:[1,0,1] neg_lo:[0,1,0]" : "=v"(r) : "v"(a), "s"(b), "v"(t));
  return r;
}
__device__ __forceinline__ constexpr float C32(int k) {
  switch (k) { case 0: return 1.f; case 1: return 0.98078528f; case 2: return 0.923879533f; case 3: return 0.831469612f; case 4: return 0.707106781f; case 5: return 0.555570233f; case 6: return 0.382683432f;
    case 7: return 0.195090322f; case 8: return 0.f; case 9: return -0.195090322f; case 10: return -0.382683432f; case 11: return -0.555570233f; case 12: return -0.707106781f; case 13: return -0.831469612f;
    case 14: return -0.923879533f; default: return -0.98078528f; } }
__device__ __forceinline__ constexpr float S32(int k) {
  switch (k) { case 0: return 0.f; case 1: return 0.195090322f; case 2: return 0.382683432f; case 3: return 0.555570233f; case 4: return 0.707106781f; case 5: return 0.831469612f; case 6: return 0.923879533f;
    case 7: return 0.98078528f; case 8: return 1.f; case 9: return 0.98078528f; case 10: return 0.923879533f; case 11: return 0.831469612f; case 12: return 0.707106781f; case 13: return 0.555570233f;
    case 14: return 0.382683432f; default: return 0.195090322f; } }
__device__ __forceinline__ constexpr int brev(int q, int bits) {
  return bits == 4 ? (((q & 1) << 3) | ((q & 2) << 1) | ((q & 4) >> 1) | ((q & 8) >> 3))
                   : (((q & 1) << 4) | ((q & 2) << 2) | (q & 4) | ((q & 8) >> 2) | ((q & 16) >> 4)); }
__device__ __forceinline__ int phys(int p) { return p + (p >> 5); }
template <int R, int HALF, bool INV> struct DftStage {
  static __device__ __forceinline__ void run(c32 (&x)[R]) {
#pragma unroll
    for (int blk = 0; blk < R; blk += 2 * HALF) {
#pragma unroll
      for (int j = 0; j < HALF; ++j) {
        const c32 a = x[blk + j], b = x[blk + j + HALF]; x[blk + j] = a + b; const c32 d = a - b;
        const int e = j * (R / (2 * HALF)) * (32 / R);
        if (e == 0) x[blk + j + HALF] = d;
        else if (e == 8) x[blk + j + HALF] = INV ? (c32){-d.y, d.x} : (c32){d.y, -d.x};
        else { const c32 wv = {C32(e), INV ? S32(e) : -S32(e)}; x[blk + j + HALF] = cmulc(d, wv); }
      } }
    DftStage<R, HALF / 2, INV>::run(x);
  }
};
template <int R, bool INV> struct DftStage<R, 0, INV> { static __device__ __forceinline__ void run(c32 (&)[R]) {} };
template <int R, bool INV> __device__ __forceinline__ void dft_pow2(c32 (&x)[R]) { DftStage<R, R / 2, INV>::run(x); }
template <int R, int HALF> struct DitStage {
  static __device__ __forceinline__ void run(c32 (&x)[R]) {
#pragma unroll
    for (int blk = 0; blk < R; blk += 2 * HALF) {
#pragma unroll
      for (int j = 0; j < HALF; ++j) {
        const int e = j * (R / (2 * HALF)) * (32 / R);
        const c32 a = x[blk + j], b0 = x[blk + j + HALF];
        c32 b;
        if (e == 0) b = b0; else if (e == 8) b = (c32){-b0.y, b0.x}; else b = cmulc(b0, (c32){C32(e), S32(e)});
        x[blk + j] = a + b; x[blk + j + HALF] = a - b;
      } }
    DitStage<R, HALF * 2>::run(x);
  }
};
template <int R> struct DitStage<R, R> { static __device__ __forceinline__ void run(c32 (&)[R]) {} };
template <int R> __device__ __forceinline__ void idft_dit(c32 (&x)[R]) { DitStage<R, 1>::run(x); }
template <int STRIDE, bool INV> __device__ __forceinline__ void pass16(c32* buf, int e0, float rev) {
  float rv = rev; asm volatile("" : "+v"(rv));
  float cs = __builtin_amdgcn_cosf(rv), sn = __builtin_amdgcn_sinf(rv);
  asm volatile("s_nop 0" : "+v"(cs), "+v"(sn));
  const c32 w1 = {cs, INV ? sn : -sn};
  c32* p = buf + phys(e0); constexpr int PS = STRIDE + STRIDE / 32;
  c32 x[16];
  if (!INV) {
#pragma unroll
    for (int m = 0; m < 16; ++m) x[m] = p[PS * m];
    dft_pow2<16, false>(x);
    c32 w = w1; p[0] = x[0];
#pragma unroll
    for (int q = 1; q < 16; ++q) { p[PS * q] = cmul(x[brev(q, 4)], w); w = cmul(w, w1); }
  } else {
    c32 w = w1; x[0] = p[0];
#pragma unroll
    for (int q = 1; q < 16; ++q) { x[q] = cmul(p[PS * q], w); w = cmul(w, w1); }
    dft_pow2<16, true>(x);
#pragma unroll
    for (int m = 0; m < 16; ++m) p[PS * m] = x[brev(m, 4)];
  }
}
template <int MODE> __device__ __forceinline__ void mid32(c32* buf, h2* Hs, int j) {
  c32* p = buf + 33 * j; c32 x[32];
#pragma unroll
  for (int m = 0; m < 32; ++m) x[m] = p[m];
  dft_pow2<32, false>(x);
  if (MODE == 0) {
#pragma unroll
    for (int q = 0; q < 32; ++q) { const c32 v = x[brev(q, 5)]; Hs[q * 256 + j] = (h2){(_Float16)v.x, (_Float16)v.y}; }
  } else {
#pragma unroll
    for (int pp = 0; pp < 32; ++pp) { const h2 hv = Hs[brev(pp, 5) * 256 + j]; x[pp] = cmul(x[pp], (c32){(float)hv.x, (float)hv.y}); }
    idft_dit<32>(x);
#pragma unroll
    for (int m = 0; m < 32; ++m) p[m] = x[m];
  }
}
__device__ __forceinline__ void fwd2(c32* buf, int tid) {
  lds_bar(); pass16<512, false>(buf, tid, (float)tid * (1.0f / 8192.0f));
  lds_bar(); pass16<32, false>(buf, (tid >> 5) * 512 + (tid & 31), (float)(tid & 31) * (1.0f / 512.0f));
  lds_bar();
}
__device__ __forceinline__ void inv2(c32* buf, int tid) {
  lds_bar(); pass16<32, true>(buf, (tid >> 5) * 512 + (tid & 31), (float)(tid & 31) * (1.0f / 512.0f));
  lds_bar(); pass16<512, true>(buf, tid, (float)tid * (1.0f / 8192.0f));
  lds_bar();
}
__device__ __forceinline__ void item(int c, const bf16_t* HYT, const float* HK, const float* hy_bias, bf16_t* HYO, char* lds) {
  c32* buf = (c32*)lds; h2* H0 = (h2*)(lds + 67584); h2* H1 = H0 + 8192;
  const int tid = TIDX;
  float kf[16]; bf16_t va[8], vb[8];
  { const float* kp = HK + (size_t)c * 8192; asm volatile("" : "+s"(kp));
#pragma unroll
    for (int i = 0; i < 16; ++i) kf[i] = kp[(unsigned)tid + 512u * i]; }
#pragma unroll 1
  for (int o = 0; o < 2; ++o) {
#pragma unroll
    for (int i = 0; i < 16; ++i) { const int n = tid + 512 * i; buf[phys(n)] = (c32){kf[i], 0.f}; }
    if (o == 0) { const float* kp = HK + ((size_t)256 + c) * 8192; asm volatile("" : "+s"(kp));
#pragma unroll
      for (int i = 0; i < 16; ++i) kf[i] = kp[(unsigned)tid + 512u * i]; }
    else { const bf16_t* v0 = HYT + (size_t)c * SEQ; const bf16_t* v1 = v0 + (size_t)768 * SEQ; asm volatile("" : "+s"(v0), "+s"(v1));
#pragma unroll
      for (int i = 0; i < 8; ++i) { const unsigned t = (unsigned)tid + 512u * i; va[i] = v0[t]; vb[i] = v1[t]; } }
    fwd2(buf, tid);
    if (tid < 256) mid32<0>(buf, o ? H1 : H0, tid);
    lds_bar();
  }
  const float bias0 = hy_bias[c], bias1 = hy_bias[256 + c];
#pragma unroll 1
  for (int pr = 0; pr < 2; ++pr) {
    const bf16_t* v0 = HYT + ((size_t)(2 * pr) * 768 + c) * SEQ; const bf16_t* v1 = v0 + (size_t)768 * SEQ;
    c32 vv[8]; bf16_t xa[8], xb[8];
#pragma unroll
    for (int i = 0; i < 8; ++i) { const int t = tid + 512 * i; vv[i] = (c32){bf2f(va[i]), bf2f(vb[i])}; buf[phys(t)] = vv[i]; buf[phys(t + 4096)] = (c32){0.f, 0.f}; }
    fwd2(buf, tid);
    if (tid < 256) mid32<1>(buf, H0, tid);
    { const bf16_t* q0 = v0 + (size_t)256 * SEQ; const bf16_t* q1 = v1 + (size_t)256 * SEQ; asm volatile("" : "+s"(q0), "+s"(q1));
#pragma unroll
      for (int i = 0; i < 8; ++i) { const unsigned t = (unsigned)tid + 512u * i; xa[i] = q0[t]; xb[i] = q1[t]; } }
    inv2(buf, tid);
#pragma unroll
    for (int i = 0; i < 8; ++i) { const int t = tid + 512 * i; const c32 y = buf[phys(t)];
      vv[i] = (c32){bf2f(xa[i]) * (y.x * (1.0f / 8192.0f) + bias0 * vv[i].x), bf2f(xb[i]) * (y.y * (1.0f / 8192.0f) + bias0 * vv[i].y)};
      buf[phys(t)] = vv[i]; buf[phys(t + 4096)] = (c32){0.f, 0.f}; }
    fwd2(buf, tid);
    if (tid < 256) mid32<1>(buf, H1, tid);
    { const bf16_t* q0 = v0 + (size_t)512 * SEQ; const bf16_t* q1 = v1 + (size_t)512 * SEQ; asm volatile("" : "+s"(q0), "+s"(q1));
#pragma unroll
      for (int i = 0; i < 8; ++i) { const unsigned t = (unsigned)tid + 512u * i; xa[i] = q0[t]; xb[i] = q1[t]; } }
    if (pr == 0) { const bf16_t* n0 = HYT + ((size_t)2 * 768 + c) * SEQ; const bf16_t* n1 = n0 + (size_t)768 * SEQ; asm volatile("" : "+s"(n0), "+s"(n1));
#pragma unroll
      for (int i = 0; i < 8; ++i) { const unsigned t = (unsigned)tid + 512u * i; va[i] = n0[t]; vb[i] = n1[t]; } }
    inv2(buf, tid);
#pragma unroll
    for (int i = 0; i < 8; ++i) { const int t = tid + 512 * i; const c32 y = buf[phys(t)];
      HYO[((size_t)(2 * pr) * 256 + c) * SEQ + t] = (bf16_t)f2bf(bf2f(xa[i]) * (y.x * (1.0f / 8192.0f) + bias1 * vv[i].x));
      HYO[((size_t)(2 * pr + 1) * 256 + c) * SEQ + t] = (bf16_t)f2bf(bf2f(xb[i]) * (y.y * (1.0f / 8192.0f) + bias1 * vv[i].y)); }
    lds_bar();
  }
}
__device__ __forceinline__ void out_items4(int it0, int step, int nitems, const bf16_t* HYO, bf16_t* MIX, char* lds) {
  bf16_t (*T)[64][72] = (bf16_t (*)[64][72])lds;
  const int tid = TIDX;
  { const int cc = tid >> 3, t8 = (tid & 7) * 8; u32x4 v[4];
#pragma unroll
    for (int k = 0; k < 4; ++k) { const int it = it0 + k * step, itc = it < nitems ? it : it0, b = itc >> 8, t0 = ((itc >> 2) & 63) * 64, c0 = (itc & 3) * 64;
      v[k] = *(const u32x4*)(HYO + ((size_t)b * 256 + c0 + cc) * SEQ + t0 + t8); }
#pragma unroll
    for (int k = 0; k < 4; ++k) *(u32x4*)&T[k][cc][t8] = v[k]; }
  lds_bar();
  { const int tl = tid >> 3, c8 = (tid & 7) * 8;
#pragma unroll
    for (int k = 0; k < 4; ++k) { const int it = it0 + k * step; const int b = it >> 8, t0 = ((it >> 2) & 63) * 64, c0 = (it & 3) * 64; u32x4 o;
      o.x = (unsigned)T[k][c8][tl] | ((unsigned)T[k][c8 + 1][tl] << 16); o.y = (unsigned)T[k][c8 + 2][tl] | ((unsigned)T[k][c8 + 3][tl] << 16);
      o.z = (unsigned)T[k][c8 + 4][tl] | ((unsigned)T[k][c8 + 5][tl] << 16); o.w = (unsigned)T[k][c8 + 6][tl] | ((unsigned)T[k][c8 + 7][tl] << 16);
      if (it < nitems) *(u32x4*)(MIX + ((size_t)b * TPB + CTXL + t0 + tl) * DM + 768 + c0 + c8) = o; } }
  lds_bar();
}
}

#define LAS __attribute__((address_space(3)))
#define XB_TMO      128
#define XB_XCNT(j)  (256  + 64 * (j))
#define XB_XSUB(j)  (1280 + 64 * (j))
#define XB_XGEN(j)  (2304 + 64 * (j))
#define XB_TOP      3328
#define XB_TOPGEN   3392
#define XCD_BAR_WORDS 3456
#define XB_SPIN_CAP (1u << 18)

__device__ __forceinline__ unsigned xb_ld(unsigned* p)              { return __hip_atomic_load(p, __ATOMIC_RELAXED, __HIP_MEMORY_SCOPE_AGENT); }
__device__ __forceinline__ unsigned xb_add(unsigned* p, unsigned v) { return __hip_atomic_fetch_add(p, v, __ATOMIC_RELAXED, __HIP_MEMORY_SCOPE_AGENT); }
__device__ __forceinline__ unsigned xb_xcc_id() { return (unsigned)__builtin_amdgcn_s_getreg((3 << 11) | 20) & 0xFu; }
#define XB_SPIN(cond, bar) do { unsigned _sp = 0; while (cond) { __builtin_amdgcn_s_sleep(1); \
    if ((++_sp & 255u) == 0u) { if (xb_ld(&(bar)[XB_TMO])) break; if (_sp > XB_SPIN_CAP) { atomicAdd(&(bar)[XB_TMO], 1u); break; } } } } while (0)

struct XcdBarrier {
    unsigned* bar; unsigned x;
    volatile LAS unsigned* st;
};

__device__ __forceinline__ XcdBarrier xcd_barrier_post(unsigned* bar, volatile LAS unsigned* st) {
    XcdBarrier b; b.bar = bar; b.x = xb_xcc_id(); b.st = st;
    if (threadIdx.x == 0) (void)xb_add(&bar[XB_XCNT(b.x)], 1u);
    return b;
}
__device__ __forceinline__ void xcd_barrier_complete(unsigned* bar, unsigned x, unsigned& nloc, unsigned& nx) {
    const unsigned G = gridDim.x * gridDim.y * gridDim.z;
    unsigned sum, cnt, mine, sp = 0u;
    for (;;) {
        sum = 0u; cnt = 0u; mine = 0u;
#pragma unroll
        for (unsigned j = 0; j < 16; ++j) { const unsigned c = xb_ld(&bar[XB_XCNT(j)]); sum += c; cnt += (c > 0u) ? 1u : 0u; mine = (j == x) ? c : mine; }
        if (sum == G) break;
        __builtin_amdgcn_s_sleep(1);
        if ((++sp & 255u) == 0u) { if (xb_ld(&bar[XB_TMO])) break; if (sp > XB_SPIN_CAP) { atomicAdd(&bar[XB_TMO], 1u); break; } }
    }
    nloc = mine > 0u ? mine : 1u; nx = cnt > 0u ? cnt : 1u;
}

__device__ __forceinline__ void xcd_barrier(const XcdBarrier& b) {
    asm volatile("s_waitcnt vmcnt(0)" ::: "memory");
    __syncthreads();
    if (threadIdx.x == 0) {
        unsigned* bar = b.bar;
        __builtin_amdgcn_s_waitcnt(0);
        unsigned nloc = b.st[0], nx = b.st[1];
        if (nloc == 0u) { xcd_barrier_complete(bar, b.x, nloc, nx); b.st[0] = nloc; b.st[1] = nx; }
        const unsigned old = xb_add(&bar[XB_XSUB(b.x)], 1u);
        const unsigned gen = old / nloc;
        if (old + 1u == (gen + 1u) * nloc) {
            __builtin_amdgcn_fence(__ATOMIC_RELEASE, "agent");
            asm volatile("s_waitcnt vmcnt(0)" ::: "memory");
            const unsigned og = xb_add(&bar[XB_TOP], 1u);
            const unsigned tg = og / nx;
            if (og + 1u == (tg + 1u) * nx) xb_add(&bar[XB_TOPGEN], 1u);
            else XB_SPIN(xb_ld(&bar[XB_TOPGEN]) == tg, bar);
            __builtin_amdgcn_fence(__ATOMIC_ACQUIRE, "agent");
            xb_add(&bar[XB_XGEN(b.x)], 1u);
            asm volatile("s_waitcnt vmcnt(0)" ::: "memory");
        } else {
            XB_SPIN(xb_ld(&bar[XB_XGEN(b.x)]) == gen, bar);
            __builtin_amdgcn_fence(__ATOMIC_ACQUIRE, "agent");
            asm volatile("s_waitcnt vmcnt(0)" ::: "memory");
        }
    }
    __syncthreads();
}


struct MP { const float* in[33]; float* out; unsigned char* ws; };
typedef const float* const __attribute__((address_space(4))) * kargs_t;
#define KARGS() ({ kargs_t k_ = (kargs_t)__builtin_amdgcn_kernarg_segment_ptr(); asm volatile("" : "+s"(k_)); k_; })
#define WSP(K, off) ((unsigned char*)(K)[34] + (off))

__global__ void __launch_bounds__(NT, 2) mega(MP P) {
  cg::grid_group grid = cg::this_grid();
  extern __shared__ __attribute__((aligned(16))) char lds[];
  volatile LAS unsigned* xst = (volatile LAS unsigned*)(lds + LDS_BYTES - 16);
  if (threadIdx.x < 2) xst[threadIdx.x] = 0u;
  __syncthreads();
  { kargs_t K = KARGS(); (void)xcd_barrier_post((unsigned*)WSP(K, WS_CTL) + CT_BAR, xst); }
#define XBAR_HERE() do { kargs_t Kb_ = KARGS(); XcdBarrier xb_; xb_.bar = (unsigned*)WSP(Kb_, WS_CTL) + CT_BAR; xb_.x = xb_xcc_id(); xb_.st = (volatile LAS unsigned*)(lds + LDS_BYTES - 16); xcd_barrier(xb_); } while (0)
#define SEAM() XBAR_HERE()
  {
    kargs_t K = KARGS();
    st_adaln(K[1], K[3], K[4], K[5], (float*)WSP(K, WS_MODV), lds);
    st_rope((float*)WSP(K, WS_ROPE));
  }
  {
      kargs_t K = KARGS();
      st_weights(K[8], K[26], K[29], K[30], K[31], 0, (bf16_t*)WSP(K, WS_WIN), (bf16_t*)WSP(K, WS_WOUT), (bf16_t*)WSP(K, WS_WGU), (bf16_t*)WSP(K, WS_WD), lds);
    }
    { kargs_t K = KARGS(); const int bid = BIDX, G = GDIM;
      for (int it = bid; it < SEQ / 16; it += G) hyfilt_item<SEQ>(it, K[19] + 0 * 33 * 64, K[20] + 0 * 64, K[21] + 0 * 64, K[22] + 0 * 4096, K[23] + 0 * 64, K[24] + (size_t)0 * 65536, (float*)WSP(K, WS_HK), lds);
      for (int it = bid - 192; it >= 0 && it < CTXL / 16; it += G) hyfilt_item<CTXL>(it,       K[19] + 0 * 33 * 64, K[20] + 0 * 64, K[21] + 0 * 64, K[22] + 0 * 4096, K[23] + 0 * 64, K[24] + (size_t)0 * 65536, (float*)WSP(K, WS_HKC), lds);
    }
  if (gridDim.x == 0x7fffffffu) grid.sync();
  XBAR_HERE();
#pragma nounroll
  for (int layer = 0; layer < 2; ++layer) {
    const bool last = layer == 1;
    if (layer == 1) {
    {
      kargs_t K = KARGS();
      st_weights(K[8], K[26], K[29], K[30], K[31], layer, (bf16_t*)WSP(K, WS_WIN), (bf16_t*)WSP(K, WS_WOUT), (bf16_t*)WSP(K, WS_WGU), (bf16_t*)WSP(K, WS_WD), lds);
    }
    { kargs_t K = KARGS(); const int bid = BIDX, G = GDIM;
      for (int it = bid; it < SEQ / 16; it += G) hyfilt_item<SEQ>(it, K[19] + layer * 33 * 64, K[20] + layer * 64, K[21] + layer * 64, K[22] + layer * 4096, K[23] + layer * 64, K[24] + (size_t)layer * 65536, (float*)WSP(K, WS_HK), lds);
      if (!last) for (int it = bid; it < CTXL / 16; it += G) hyfilt_item<CTXL>(it, K[19] + layer * 33 * 64, K[20] + layer * 64, K[21] + layer * 64, K[22] + layer * 4096, K[23] + layer * 64, K[24] + (size_t)layer * 65536, (float*)WSP(K, WS_HKC), lds);
    }
    }
    { kargs_t K = KARGS();
      st_normmod(K[0], K[2], (bf16_t*)WSP(K, WS_H), layer == 0 ? (const bf16_t*)nullptr : (const bf16_t*)WSP(K, WS_H2S), (const int*)WSP(K, WS_MOEM + 768 * 1024),
                 (const float*)WSP(K, WS_MODV) + 5120, K[6] + layer * 1024, (const float*)WSP(K, WS_MODV) + (size_t)layer * 5 * 6144, 0, 1024, (bf16_t*)K[33], lds);
    }
    SEAM();
    {
      kargs_t K = KARGS();
      pg8::Gemm g{1024, 1024, 1024}; SchedDense S{MTOK / 256, NPAD / 256, (int)GDIM, BIDX, 0, (const char*)K[33], (const char*)WSP(K, WS_WIN), (size_t)256 * 1024 * 2, (size_t)256 * 1024 * 2, 0};
      EpiInProj E{(bf16_t*)WSP(K, WS_QK), (bf16_t*)WSP(K, WS_VZ), (bf16_t*)WSP(K, WS_XBC), (bf16_t*)WSP(K, WS_HY), (float*)WSP(K, WS_DT)};
      pg8::gemm_phase<EpiInProj, SchedDense, true, true>((PG8_LAS unsigned char*)lds, g, S, E);
      if (IN_HALF) { S.part = 1; pg8::gemm_phase<EpiInProj, SchedDense, true, true, true>((PG8_LAS unsigned char*)lds, g, S, E); }
    }
    SEAM();
    {
      kargs_t K = KARGS();
      st_prep_qk((bf16_t*)WSP(K, WS_QK), K[9] + layer * 64, K[10] + layer * 64, (const float*)WSP(K, WS_ROPE));
    }
    { kargs_t K = KARGS();
      st_prep_hy((const bf16_t*)WSP(K, WS_HY), K[17] + layer * 3 * 768, K[18] + layer * 768, (bf16_t*)WSP(K, WS_HYT), last ? 0 : 1, lds);
    }
    { kargs_t K = KARGS();
      st_ssd1(BIDX < 48 ? 4 * BIDX : 192 + 3 * (BIDX - 48), 1, BIDX < 48 ? 4 * BIDX + 4 : 192 + 3 * (BIDX - 48) + 3,       (const bf16_t*)WSP(K, WS_XBC), (const float*)WSP(K, WS_DT), K[11] + layer * 3 * 640, K[12] + layer * 640, K[13] + layer * 12, K[14] + layer * 12,
              (bf16_t*)WSP(K, WS_Y), (bf16_t*)WSP(K, WS_ST), (float*)WSP(K, WS_DEC), lds);
    }
    SEAM();
    {
      { kargs_t K2 = KARGS(); st_ssd_scan2((bf16_t*)WSP(K2, WS_ST), (const float*)WSP(K2, WS_DEC)); }
      const int bid = BIDX, G = GDIM;
#define P4_ATT(bb, hq, qrow_, nt_) do { kargs_t K = KARGS(); const int kvh_ = (hq) / 3; \
          const attn_body::bf16* QKp = (const attn_body::bf16*)WSP(K, WS_QK); const attn_body::bf16* VZp = (const attn_body::bf16*)WSP(K, WS_VZ); \
          attn_body::attn_unit<8>(QKp + (size_t)(qrow_) * 512 + (hq) * 64, QKp + (size_t)(bb) * TPB * 512 + 384 + kvh_ * 64, VZp + (size_t)(bb) * TPB * 512 + kvh_ * 64, \
                                  (attn_body::bf16*)K[33] + (size_t)(qrow_) * 1024 + (hq) * 64, (nt_), lds); } while (0)
#define P4_FFT(cch) do { kargs_t K = KARGS(); hyf::item((cch), (const bf16_t*)WSP(K, WS_HYT), (const float*)WSP(K, WS_HK), K[25] + layer * 512, (bf16_t*)WSP(K, WS_HY), lds); } while (0)
      {
        const int x = bid & 7, y = bid >> 3, bb = x >> 1, kvh = x & 1;
        const int nun = y < 16 ? 2 : 1, natt = nun + ((!last && y < 3) ? 1 : 0);
#pragma unroll 1
        for (int k = 0; k < natt; ++k) { int hq, qrow, nt;
          if (k < nun) { const int v = y < 16 ? y + 16 * k : 16 + y; hq = 3 * kvh + (v >> 4); qrow = bb * TPB + CTXL + (v & 15) * 256; nt = TPB / 64; }
          else { hq = 3 * kvh + y; qrow = bb * TPB; nt = CTXL / 64; }
          P4_ATT(bb, hq, qrow, nt); }
        if (y >= 16) {
#pragma unroll 1
          for (int k = 0; k < 2; ++k) { const int cch = ((y - 16) * 8 + x) * 2 + k; P4_FFT(cch); } }
      }
      (void)G;
#undef P4_ATT
#undef P4_FFT
    }
    SEAM();
    {
      kargs_t K = KARGS();
      { const int bid = BIDX, G = GDIM, nit = last ? 4 * 32 * 2 : 4 * 34 * 2;
        for (int it = bid; it < nit; it += G) { const int g = it & 1, bc = it >> 1; const int b = last ? bc >> 5 : bc / 34, cidx = last ? 2 + (bc & 31) : bc % 34;
          ssd3_item(b, cidx, g, (const bf16_t*)WSP(K, WS_XBC), (const bf16_t*)WSP(K, WS_VZ), (const float*)WSP(K, WS_DT), K[11] + layer * 3 * 640, K[12] + layer * 640, K[13] + layer * 12, K[14] + layer * 12,
                    K[15] + layer * 6, K[16] + layer * 384, (const bf16_t*)WSP(K, WS_Y), (const bf16_t*)WSP(K, WS_ST), (bf16_t*)K[33], lds); } }
      if (!last) { const int bid = BIDX, G = GDIM;
        for (int it = bid - 128; it >= 0 && it < 128; it += G) hyconv_ctx_item(it, (const bf16_t*)WSP(K, WS_HYT) + (size_t)4 * 768 * SEQ, (const float*)WSP(K, WS_HKC), K[25] + layer * 512, (bf16_t*)K[33], lds); }
      { const int bid = BIDX, G = GDIM;
        int ns = 1, s0 = bid, s1 = 0, s2 = 0;
        if (!last) { if (bid < 16 || bid >= 128) ns = 0;
          else if (bid >= 32 && bid < 80) { const int k = 2 * (bid - 32); ns = 3; s1 = k < 16 ? k : 112 + k; s2 = k + 1 < 16 ? k + 1 : 113 + k; }
          else if (bid >= 80) { const int k = 96 + (bid - 80); ns = 2; s1 = 112 + k; } }
#pragma unroll 1
        for (int q = 0; q < ns; ++q) { const int sl = q == 0 ? s0 : (q == 1 ? s1 : s2); hyf::out_items4(sl, G, 1024, (const bf16_t*)WSP(K, WS_HY), (bf16_t*)K[33], lds); } }
      const int t = TIDX; if (BIDX == 0 && t < 256) ((int*)WSP(K, WS_CTL))[t] = 0;
      { int* stok = (int*)WSP(K, WS_MOEM + 384 * 1024); for (int i = BIDX * NT + t; i < MOE_ROWS; i += GDIM * NT) stok[i] = -1; }
    }
    SEAM();
    {
      kargs_t K = KARGS();
      pg8::Gemm g{1024, 1024, 1024}; SchedDense S{last ? 64 : 68, 4, (int)GDIM, BIDX, last ? 1 : 0, (const char*)K[33], (const char*)WSP(K, WS_WOUT), (size_t)256 * 1024 * 2, (size_t)256 * 1024 * 2, 0};
      EpiOutProj E{(bf16_t*)WSP(K, WS_QK)};
      pg8::gemm_phase<EpiOutProj, SchedDense, true, true>((PG8_LAS unsigned char*)lds, g, S, E);
      S.part = 1; pg8::gemm_phase<EpiOutProj, SchedDense, true, true, true>((PG8_LAS unsigned char*)lds, g, S, E);
      S.part = 2; pg8::gemm_phase<EpiOutProj, SchedDense, true, true, true, true>((PG8_LAS unsigned char*)lds, g, S, E);
    }
    SEAM();
    {
      kargs_t K = KARGS();
      st_router(K[0], K[2], layer == 0 ? 1 : 0, (bf16_t*)WSP(K, WS_H), (const bf16_t*)WSP(K, WS_QK), K[7] + layer * 1024, (const float*)WSP(K, WS_MODV) + (size_t)layer * 5 * 6144, K[27], K[28], (bf16_t*)K[33], (int*)WSP(K, WS_CTL),
                (int*)WSP(K, WS_MOEM), (float*)WSP(K, WS_MOEM + 128 * 1024), last ? 1 : 0, lds);
    }
    SEAM();
    { kargs_t K = KARGS();
      st_moe_gather((const bf16_t*)K[33], (bf16_t*)WSP(K, WS_H2S), (int*)WSP(K, WS_CTL), (const int*)WSP(K, WS_MOEM), (const float*)WSP(K, WS_MOEM + 128 * 1024),
                    (int*)WSP(K, WS_MOEM + 384 * 1024), (float*)WSP(K, WS_MOEM + 512 * 1024), (int*)WSP(K, WS_MOEM + 768 * 1024), last ? 1 : 0, lds);
    }
    SEAM();
    { kargs_t K = KARGS();
      pg8::Gemm g{1024, 1024, 1024}; SchedMoe S{(int)GDIM, BIDX, 1, (const int*)WSP(K, WS_CTL), (const char*)WSP(K, WS_H2S), (size_t)256 * 1024 * 2, (const char*)WSP(K, WS_WGU), 0};
      EpiMoe1 E{(bf16_t*)WSP(K, WS_ACT), (const float*)WSP(K, WS_MOEM + 512 * 1024)};
      pg8::gemm_phase<EpiMoe1, SchedMoe, true, true>((PG8_LAS unsigned char*)lds, g, S, E);
      S.tail = 1; pg8::gemm_phase<EpiMoe1, SchedMoe, true, true, true>((PG8_LAS unsigned char*)lds, g, S, E);
      S.tail = 2; pg8::gemm_phase<EpiMoe1, SchedMoe, true, true, true, true>((PG8_LAS unsigned char*)lds, g, S, E);
    }
    SEAM();
    { kargs_t K = KARGS();
      pg8::Gemm g{256, 512, 256}; SchedMoe S{(int)GDIM, BIDX, 2, (const int*)WSP(K, WS_CTL), (const char*)WSP(K, WS_ACT), (size_t)256 * 512 * 2, (const char*)WSP(K, WS_WD), 0};
      EpiMoe2 E{(bf16_t*)WSP(K, WS_H2S)};
      pg8::gemm_phase<EpiMoe2, SchedMoe, true, true>((PG8_LAS unsigned char*)lds, g, S, E);
      S.tail = 1; pg8::gemm_phase<EpiMoe2, SchedMoe, true, true, true>((PG8_LAS unsigned char*)lds, g, S, E);
      S.tail = 2; pg8::gemm_phase<EpiMoe2, SchedMoe, true, true, true, true>((PG8_LAS unsigned char*)lds, g, S, E);
    }
    SEAM();
  }
  { kargs_t K = KARGS(); st_final((float*)K[33], K[32], (const bf16_t*)WSP(K, WS_H), (const bf16_t*)WSP(K, WS_H2S), (const int*)WSP(K, WS_MOEM + 768 * 1024), (const float*)WSP(K, WS_MODV) + (size_t)5 * 6144 + 5120); }
}

extern "C" void kernel_launch(void* const* d_in, const int* in_sizes, int n_in, void* d_out, int out_size, void* d_ws, size_t ws_size, hipStream_t stream) {
  if (n_in != 33 || ws_size < WS_END) { fprintf(stderr, "kernel_launch: unexpected n_in %d / ws %zu\n", n_in, ws_size); return; }
  static int grid_blocks = 0;
  if (!grid_blocks) {
    int dev = 0, cus = 0, per_cu = 0;
    (void)hipGetDevice(&dev);
    (void)hipDeviceGetAttribute(&cus, hipDeviceAttributeMultiprocessorCount, dev);
    (void)hipFuncSetAttribute((const void*)mega, hipFuncAttributeMaxDynamicSharedMemorySize, LDS_BYTES);
    (void)hipOccupancyMaxActiveBlocksPerMultiprocessor(&per_cu, mega, NT, LDS_BYTES);
    if (per_cu < 1) per_cu = 1;
    if (per_cu > 2) per_cu = 2;
    grid_blocks = 256;
    if (cus != 256 || per_cu < 1) fprintf(stderr, "kernel_launch: expected 256 CUs with >= 1 workgroup each (got %d CUs, %d per CU)\n", cus, per_cu);
  }
  (void)hipMemsetAsync((char*)d_ws + WS_CTL + (size_t)CT_BAR * 4, 0, (size_t)XCD_BAR_WORDS * 4, stream);
  MP p{};
  for (int i = 0; i < 33; ++i) p.in[i] = (const float*)d_in[i];
  p.out = (float*)d_out; p.ws = (unsigned char*)d_ws;
  void* args[] = {&p};
  hipError_t e = hipLaunchCooperativeKernel((const void*)mega, dim3(grid_blocks), dim3(NT), args, LDS_BYTES, stream);
  if (e != hipSuccess) fprintf(stderr, "cooperative launch failed: %s (grid %d)\n", hipGetErrorString(e), grid_blocks);
}
```
